# Optimizing an MI355X kernel written in HIP

```python
import jax, jax.numpy as jnp
from jax import lax
import numpy as np

D_MODEL = 2048
BATCH = 1
SEQ = 8192
DEPTH = 2
DEC_BATCH = 32
DEC_SEQ = 4
PAST_LEN = 8192
PAGE_SIZE = 128

N_A_LAYERS = DEPTH // 2
N_B_LAYERS = DEPTH - N_A_LAYERS
HGRN_EXPAND = 128
HGRN_HEADS = D_MODEL // HGRN_EXPAND
HGRN_K = HGRN_EXPAND
HGRN_V = D_MODEL // HGRN_HEADS
HGRN_DK = HGRN_HEADS * HGRN_K
HGRN_DV = HGRN_HEADS * HGRN_V
GLA_CHUNK = 64
HEAD_DIM = 128
N_HEADS = D_MODEL // HEAD_DIM
N_KV_HEADS = 4
GROUP = N_HEADS // N_KV_HEADS
MOBA_BLOCK = 256
MOBA_TOPK = 3
QUERY_TOKENS = 64
SCALE = HEAD_DIM ** -0.5
D_FF = ((8 * D_MODEL + 3 * 256 - 1) // (3 * 256)) * 256
EPS = 1e-6

kernel_name = 'yoco_hgrn2_moba_decode_step'


def _rmsnorm(x, g):
    xf = x.astype(jnp.float32)
    r = lax.rsqrt(jnp.mean(xf * xf, axis=-1, keepdims=True) + EPS)
    return (xf * r * g.astype(jnp.float32)).astype(x.dtype)


def _divisor_at_most(n, cap):
    c = max(1, min(n, cap))
    while n % c:
        c -= 1
    return c


def _query_chunk(lq, b):
    cap = max(1, QUERY_TOKENS // b)
    c = 1
    while c * 2 <= cap and lq % (c * 2) == 0:
        c *= 2
    return c


def _swiglu(x, g, w_gu, w_down):
    a, u = jnp.split(_rmsnorm(x, g) @ w_gu, 2, axis=-1)
    return (jax.nn.silu(a) * u) @ w_down


def _gla_chunked(q, k, v, log_f, s0):
    b_, l_, h_, _ = q.shape
    dv = v.shape[-1]
    c = _divisor_at_most(l_, GLA_CHUNK)
    n = l_ // c

    def to_chunks(a):
        return a.reshape(b_, n, c, h_, a.shape[-1]).transpose(1, 0, 3, 2, 4)

    qc, kc, vc, gc = to_chunks(q), to_chunks(k), to_chunks(v), to_chunks(log_f)
    cum = jnp.cumsum(gc, axis=3)
    mid = (c - 1) // 2
    ref = cum[:, :, :, mid:mid + 1]
    last = cum[:, :, :, c - 1:c]
    att = jnp.einsum('nbhtk,nbhsk->nbhts', qc * jnp.exp(cum - ref), kc * jnp.exp(ref - cum))
    att = jnp.where(jnp.tril(jnp.ones((c, c), dtype=bool)), att, 0.0)
    o_intra = jnp.einsum('nbhts,nbhsv->nbhtv', att, vc)
    q_in = qc * jnp.exp(cum)
    k_out = kc * jnp.exp(last - cum)
    decay = jnp.exp(last[:, :, :, 0])

    def step(s, xs):
        q_i, k_i, v_i, d_i = xs
        o_i = jnp.einsum('bhtk,bhkv->bhtv', q_i, s)
        s = d_i[..., None] * s + jnp.einsum('bhtk,bhtv->bhkv', k_i, v_i)
        return s, o_i

    s_fin, o_inter = lax.scan(step, s0, (q_in, k_out, vc, decay))
    o = (o_intra + o_inter).transpose(1, 0, 3, 2, 4).reshape(b_, l_, h_, dv)
    return o, s_fin


def _hgrn2_mixer(x, s0, norm_g, w_in, lb, onorm_g, w_out):
    b_, l_, _ = x.shape
    f32 = jnp.float32
    zq, zf, zi, zg = jnp.split(_rmsnorm(x, norm_g) @ w_in, 4, axis=-1)
    hk = (b_, l_, HGRN_HEADS, HGRN_K)
    hv = (b_, l_, HGRN_HEADS, HGRN_V)
    lb = lb.reshape(HGRN_HEADS, HGRN_K)
    f = lb + (1.0 - lb) * jax.nn.sigmoid(zf.astype(f32).reshape(hk))
    q = jax.nn.silu(zq.astype(f32).reshape(hk))
    o, s_fin = _gla_chunked(q, 1.0 - f, zi.astype(f32).reshape(hv), jnp.log(f), s0.astype(f32))
    o = _rmsnorm(o, onorm_g) * jax.nn.silu(zg.astype(f32).reshape(hv))
    return o.reshape(b_, l_, HGRN_DV).astype(x.dtype) @ w_out, s_fin.astype(s0.dtype)


def _moba(q, k, v, q_pos):
    b_, lq, _, _ = q.shape
    t_ = k.shape[1]
    f32 = jnp.float32
    nb = -(-t_ // MOBA_BLOCK)
    pad = nb * MOBA_BLOCK - t_
    k = jnp.pad(k, ((0, 0), (0, pad), (0, 0), (0, 0)))
    v = jnp.pad(v, ((0, 0), (0, pad), (0, 0), (0, 0)))
    kb = k.reshape(b_, nb, MOBA_BLOCK, N_KV_HEADS, HEAD_DIM)
    vb = v.reshape(b_, nb, MOBA_BLOCK, N_KV_HEADS, HEAD_DIM)
    kmean = jnp.mean(kb.astype(f32), axis=2)
    kb_t = kb.transpose(0, 3, 1, 2, 4)
    vb_t = vb.transpose(0, 3, 1, 2, 4)
    k_sel = min(MOBA_TOPK, nb)
    n_q = _query_chunk(lq, b_)
    n_chunks = lq // n_q
    qg = q.reshape(b_, n_chunks, n_q, N_KV_HEADS, GROUP, HEAD_DIM).transpose(1, 0, 2, 3, 4, 5)
    pos = q_pos.reshape(n_chunks, n_q)
    b_ix = jnp.arange(b_)[:, None, None, None, None]
    kv_ix = jnp.arange(N_KV_HEADS)[None, None, :, None, None]

    def attend(args):
        q_c, p_c = args
        qf = q_c.astype(f32)
        qblk = p_c // MOBA_BLOCK
        gate = jnp.einsum('bqkgd,bnkd->bqkgn', qf, kmean)
        full_past = jnp.arange(nb)[None, :] < qblk[:, None]
        gate = jnp.where(full_past[None, :, None, None, :], gate, -jnp.inf)
        _, top = lax.top_k(gate, k_sel)
        own = jnp.broadcast_to(qblk[None, :, None, None, None], top.shape[:-1] + (1,))
        blk = jnp.concatenate([top, own.astype(top.dtype)], axis=-1)
        rank_ok = jnp.concatenate([jnp.arange(k_sel)[None, :] < qblk[:, None],
                                   jnp.ones((n_q, 1), dtype=bool)], axis=-1)
        kg = kb_t[b_ix, kv_ix, blk].astype(f32)
        vg = vb_t[b_ix, kv_ix, blk].astype(f32)
        s = jnp.einsum('bqkgd,bqkgrpd->bqkgrp', qf, kg) * SCALE
        kpos = blk[..., None] * MOBA_BLOCK + jnp.arange(MOBA_BLOCK)
        mask = rank_ok[None, :, None, None, :, None] & (kpos <= p_c[None, :, None, None, None, None])
        s = jnp.where(mask, s, -jnp.inf)
        p = jax.nn.softmax(s.reshape(s.shape[:-2] + (-1,)), axis=-1).reshape(s.shape)
        return jnp.einsum('bqkgrp,bqkgrpd->bqkgd', p, vg)

    out = lax.map(attend, (qg, pos))
    return out.transpose(1, 0, 2, 3, 4, 5).reshape(b_, lq, N_HEADS, HEAD_DIM).astype(q.dtype)


def _trunk(x, s0, k_past, v_past, norm_mix_a, w_in_a, lb_all, onorm_a, w_out_a, norm_kv, w_kv, k_norm,
           norm_mix_b, w_q_b, q_norm, w_o_b, norm_ffn, w_gate_up, w_down):
    b_, l_, _ = x.shape
    pos0 = 0 if k_past is None else k_past.shape[1]
    q_pos = pos0 + jnp.arange(l_, dtype=jnp.int32)
    h = x
    states = []
    k_new = v_new = k_all = v_all = None
    for layer in range(DEPTH):
        if layer < N_A_LAYERS:
            o, s = _hgrn2_mixer(h, s0[layer], norm_mix_a[layer], w_in_a[layer], lb_all[layer],
                                onorm_a[layer], w_out_a[layer])
            h = h + o
            states.append(s)
        else:
            if layer == N_A_LAYERS:
                k_new, v_new = jnp.split(_rmsnorm(h, norm_kv) @ w_kv, 2, axis=-1)
                k_new = _rmsnorm(k_new.reshape(b_, l_, N_KV_HEADS, HEAD_DIM), k_norm)
                v_new = v_new.reshape(b_, l_, N_KV_HEADS, HEAD_DIM)
                if k_past is None:
                    k_all, v_all = k_new, v_new
                else:
                    k_all = jnp.concatenate([k_past.astype(k_new.dtype), k_new], axis=1)
                    v_all = jnp.concatenate([v_past.astype(v_new.dtype), v_new], axis=1)
            j = layer - N_A_LAYERS
            q = (_rmsnorm(h, norm_mix_b[j]) @ w_q_b[j]).reshape(b_, l_, N_HEADS, HEAD_DIM)
            q = _rmsnorm(q, q_norm[j])
            h = h + _moba(q, k_all, v_all, q_pos).reshape(b_, l_, N_HEADS * HEAD_DIM) @ w_o_b[j]
        h = h + _swiglu(h, norm_ffn[layer], w_gate_up[layer], w_down[layer])
    return h, jnp.stack(states), k_new, v_new


def setup_inputs(seed: int = 0) -> dict:
    key = jax.random.key(seed)
    ks = jax.random.split(key, 24)
    f32 = jnp.float32
    n_pages = PAST_LEN // PAGE_SIZE
    n_phys = (5 * DEC_BATCH * n_pages + 3) // 4

    def nrm(k, shape, scale):
        return jax.random.normal(k, shape, f32) * scale

    def gain(k, shape):
        return 1.0 + 0.02 * jax.random.normal(k, shape, f32)

    perm = jax.random.permutation(ks[5], n_phys)
    page_table = perm[:DEC_BATCH * n_pages].reshape(DEC_BATCH, n_pages).astype(jnp.int32)
    return {
        'x_prompt': nrm(ks[0], (BATCH, SEQ, D_MODEL), 1.0),
        'x_sample': nrm(ks[1], (DEC_BATCH, DEC_SEQ, D_MODEL), 1.0),
        'state_hgrn': nrm(ks[2], (N_A_LAYERS, DEC_BATCH, HGRN_HEADS, HGRN_K, HGRN_V), 0.5),
        'cache_k': nrm(ks[3], (n_phys, PAGE_SIZE, N_KV_HEADS, HEAD_DIM), 1.0),
        'cache_v': nrm(ks[4], (n_phys, PAGE_SIZE, N_KV_HEADS, HEAD_DIM), 1.0),
        'page_table': page_table,
        'norm_mix_a': gain(ks[6], (N_A_LAYERS, D_MODEL)),
        'w_in_a': nrm(ks[7], (N_A_LAYERS, D_MODEL, 2 * HGRN_DK + 2 * HGRN_DV), D_MODEL ** -0.5),
        'lb_logits': nrm(ks[8], (N_A_LAYERS + 1, HGRN_DK), 0.5),
        'onorm_a': gain(ks[9], (N_A_LAYERS, HGRN_V)),
        'w_out_a': nrm(ks[10], (N_A_LAYERS, HGRN_DV, D_MODEL), HGRN_DV ** -0.5),
        'norm_kv': gain(ks[11], (D_MODEL,)),
        'w_kv': nrm(ks[12], (D_MODEL, 2 * N_KV_HEADS * HEAD_DIM), D_MODEL ** -0.5),
        'k_norm': gain(ks[13], (HEAD_DIM,)),
        'norm_mix_b': gain(ks[14], (N_B_LAYERS, D_MODEL)),
        'w_q_b': nrm(ks[15], (N_B_LAYERS, D_MODEL, N_HEADS * HEAD_DIM), D_MODEL ** -0.5),
        'q_norm': gain(ks[16], (N_B_LAYERS, HEAD_DIM)),
        'w_o_b': nrm(ks[17], (N_B_LAYERS, N_HEADS * HEAD_DIM, D_MODEL), (N_HEADS * HEAD_DIM) ** -0.5),
        'norm_ffn': gain(ks[18], (DEPTH, D_MODEL)),
        'w_gate_up': nrm(ks[19], (DEPTH, D_MODEL, 2 * D_FF), D_MODEL ** -0.5),
        'w_down': nrm(ks[20], (DEPTH, D_FF, D_MODEL), D_FF ** -0.5),
    }


def reference(x_prompt, x_sample, state_hgrn, cache_k, cache_v, page_table, norm_mix_a, w_in_a, lb_logits,
              onorm_a, w_out_a, norm_kv, w_kv, k_norm, norm_mix_b, w_q_b, q_norm, w_o_b, norm_ffn,
              w_gate_up, w_down):
    lb_all = jnp.cumsum(jax.nn.softmax(lb_logits.astype(jnp.float32), axis=0), axis=0)[:N_A_LAYERS]
    weights = (norm_mix_a, w_in_a, lb_all, onorm_a, w_out_a, norm_kv, w_kv, k_norm,
               norm_mix_b, w_q_b, q_norm, w_o_b, norm_ffn, w_gate_up, w_down)
    s0_prompt = jnp.zeros((N_A_LAYERS, x_prompt.shape[0], HGRN_HEADS, HGRN_K, HGRN_V), state_hgrn.dtype)
    y_prompt, s_prompt, k_prompt, v_prompt = _trunk(x_prompt, s0_prompt, None, None, *weights)
    dec_b, n_pages = page_table.shape
    past = n_pages * cache_k.shape[1]
    k_past = cache_k[page_table].reshape(dec_b, past, N_KV_HEADS, HEAD_DIM)
    v_past = cache_v[page_table].reshape(dec_b, past, N_KV_HEADS, HEAD_DIM)
    y_sample, s_sample, k_sample, v_sample = _trunk(x_sample, state_hgrn, k_past, v_past, *weights)
    return (y_prompt, y_sample, s_prompt, s_sample, k_prompt, v_prompt, k_sample, v_sample)
```

```cpp
#include <hip/hip_runtime.h>
#include <cstdio>
#include <cstdint>
constexpr size_t OY_P = 0, OY_S = OY_P + (size_t)8192 * 2048, OST_P = OY_S + (size_t)128 * 2048, OST_S = OST_P + (size_t)16 * 128 * 128,
                 OK_P = OST_S + (size_t)32 * 16 * 128 * 128, OV_P = OK_P + (size_t)8192 * 512, OK_S = OV_P + (size_t)8192 * 512, OV_S = OK_S + (size_t)128 * 512;
namespace orc {
constexpr int D = 2048, SEQ = 8192, DECB = 32, DECS = 4, MS = 128, M = SEQ + MS, NH = 16, HD = 128, NKV = 4, DFF = 5632;
constexpr float EPS = 1e-6f, SCALE = 0.08838834764831845f;
typedef float f32x4_t __attribute__((ext_vector_type(4)));
constexpr size_t B_XN = 0;
constexpr size_t B_Z = B_XN + (size_t)M * D;
constexpr size_t B_H = B_Z + (size_t)M * 11264;
constexpr size_t B_T = B_H + (size_t)M * D;
constexpr size_t B_Q = B_T + (size_t)M * D;
constexpr size_t B_F = B_Q + (size_t)M * D;
constexpr size_t B_V = B_F + (size_t)M * D;
constexpr size_t B_G = B_V + (size_t)M * D;
constexpr size_t B_O = B_G + (size_t)M * D;
constexpr size_t B_HM = B_O + (size_t)M * D;
constexpr size_t B_KV = B_HM + (size_t)M * DFF;
constexpr size_t B_KM = B_KV + (size_t)M * 1024;
constexpr size_t B_SEL = B_KM + (size_t)33 * 32 * 512;
constexpr size_t B_END = B_SEL + (size_t)M * 16;

__global__ void k_cat_x(const float* xp, const float* xs, float* h) {
    const size_t i = (size_t)blockIdx.x * 256 + threadIdx.x; if (i >= (size_t)M * D) return;
    h[i] = (i < (size_t)SEQ * D) ? xp[i] : xs[i - (size_t)SEQ * D];
}
__global__ void k_rmsnorm(const float* x, const float* g, float* o, int width) {
    __shared__ float red[256];
    const float* xr = x + (size_t)blockIdx.x * width; float s = 0.f;
    for (int i = threadIdx.x; i < width; i += 256) s += xr[i] * xr[i];
    red[threadIdx.x] = s; __syncthreads();
    for (int o2 = 128; o2 > 0; o2 >>= 1) { if ((int)threadIdx.x < o2) red[threadIdx.x] += red[threadIdx.x + o2]; __syncthreads(); }
    const float r = rsqrtf(red[0] / width + EPS);
    for (int i = threadIdx.x; i < width; i += 256) o[(size_t)blockIdx.x * width + i] = xr[i] * r * g[i];
}
__global__ void k_headnorm(const float* x, int ldx, const float* g, float* o, int ldo, int nheads) {
    __shared__ float red[128];
    const int row = blockIdx.x / nheads, hh = blockIdx.x % nheads;
    const float v = x[(size_t)row * ldx + hh * 128 + threadIdx.x]; red[threadIdx.x] = v * v; __syncthreads();
    for (int o2 = 64; o2 > 0; o2 >>= 1) { if ((int)threadIdx.x < o2) red[threadIdx.x] += red[threadIdx.x + o2]; __syncthreads(); }
    const float r = rsqrtf(red[0] / 128.f + EPS);
    o[(size_t)row * ldo + hh * 128 + threadIdx.x] = v * r * g[threadIdx.x];
}
__global__ void __launch_bounds__(256) k_gemm(const float* A, const float* W, float* C, const float* R, int Mm, int N, int K) {
    __shared__ float As[16][68], Bs[16][68];
    const int tx = threadIdx.x & 15, ty = threadIdx.x >> 4; const int m0 = blockIdx.y * 64, n0 = blockIdx.x * 64;
    float acc[4][4] = {};
    for (int k0 = 0; k0 < K; k0 += 16) {
        for (int i = threadIdx.x; i < 1024; i += 256) { const int r = i >> 4, c = i & 15; As[c][r] = A[(size_t)(m0 + r) * K + k0 + c]; }
        for (int i = threadIdx.x; i < 1024; i += 256) { const int r = i >> 6, c = i & 63; Bs[r][c] = W[(size_t)(k0 + r) * N + n0 + c]; }
        __syncthreads();
#pragma unroll
        for (int k = 0; k < 16; ++k) { float a[4], b[4];
#pragma unroll
            for (int i = 0; i < 4; ++i) { a[i] = As[k][ty * 4 + i]; b[i] = Bs[k][tx * 4 + i]; }
#pragma unroll
            for (int i = 0; i < 4; ++i)
#pragma unroll
                for (int j = 0; j < 4; ++j) acc[i][j] += a[i] * b[j]; }
        __syncthreads();
    }
#pragma unroll
    for (int i = 0; i < 4; ++i)
#pragma unroll
        for (int j = 0; j < 4; ++j) { const size_t o = (size_t)(m0 + ty * 4 + i) * N + n0 + tx * 4 + j; C[o] = acc[i][j] + (R ? R[o] : 0.f); }
}
__device__ __forceinline__ float silu(float x) { return x / (1.f + expf(-x)); }
__global__ void k_hgrn_act(const float* Z, const float* lbl, float* q, float* f, float* v, float* g) {
    const size_t i = (size_t)blockIdx.x * 256 + threadIdx.x; if (i >= (size_t)M * D) return;
    const size_t row = i / D; const int c = (int)(i % D); const float* z = Z + row * 8192;
    const float lb = 1.f / (1.f + expf(lbl[D + c] - lbl[c]));
    q[i] = silu(z[c]); f[i] = lb + (1.f - lb) / (1.f + expf(-z[2048 + c])); v[i] = z[4096 + c]; g[i] = silu(z[6144 + c]);
}
__global__ void __launch_bounds__(128) k_hgrn_rec(const float* q, const float* f, const float* v, const float* st_in, float* o, float* st_p, float* st_s) {
    const int seq = blockIdx.x / NH, h = blockIdx.x % NH, vd = threadIdx.x;
    float S[128];
#pragma unroll
    for (int k = 0; k < 128; ++k) S[k] = (seq == 0) ? 0.f : st_in[(((size_t)(seq - 1) * NH + h) * 128 + k) * 128 + vd];
    const int row0 = seq == 0 ? 0 : SEQ + 4 * (seq - 1), len = seq == 0 ? SEQ : 4;
    for (int t = 0; t < len; ++t) {
        const size_t ro = (size_t)(row0 + t) * D + h * 128; const float vv = v[ro + vd]; float acc = 0.f;
#pragma unroll
        for (int k = 0; k < 128; ++k) { const float ff = f[ro + k]; S[k] = ff * S[k] + (1.f - ff) * vv; acc += S[k] * q[ro + k]; }
        o[ro + vd] = acc;
    }
    float* so = seq == 0 ? st_p : st_s + (size_t)(seq - 1) * NH * 128 * 128;
#pragma unroll
    for (int k = 0; k < 128; ++k) so[((size_t)h * 128 + k) * 128 + vd] = S[k];
}
__global__ void k_mul(float* o, const float* g) { const size_t i = (size_t)blockIdx.x * 256 + threadIdx.x; if (i < (size_t)M * D) o[i] *= g[i]; }
__global__ void k_swiglu(const float* Z, float* hm) {
    const size_t i = (size_t)blockIdx.x * 256 + threadIdx.x; if (i >= (size_t)M * DFF) return;
    const size_t row = i / DFF; const int c = (int)(i % DFF); hm[i] = silu(Z[row * 11264 + c]) * Z[row * 11264 + DFF + c];
}
__global__ void k_kv_out(const float* kv, float* kp, float* vp, float* ks, float* vs) {
    const size_t i = (size_t)blockIdx.x * 256 + threadIdx.x; if (i >= (size_t)M * 512) return;
    const size_t row = i / 512; const int c = (int)(i % 512);
    if (row < SEQ) { kp[i] = kv[row * 1024 + c]; vp[i] = kv[row * 1024 + 512 + c]; }
    else { const size_t j = (row - SEQ) * 512 + c; ks[j] = kv[row * 1024 + c]; vs[j] = kv[row * 1024 + 512 + c]; }
}
__device__ __forceinline__ const float* krow(int seq, int pos, int kvh, const float* kv, const float* ck, const int* pt) {
    if (seq == 0) return kv + (size_t)pos * 1024 + kvh * 128;
    const int b = seq - 1;
    if (pos < 8192) { const int page = pt[b * 64 + (pos >> 7)]; return ck + (((size_t)page * 128 + (pos & 127)) * NKV + kvh) * 128; }
    return kv + (size_t)(SEQ + 4 * b + (pos - 8192)) * 1024 + kvh * 128;
}
__device__ __forceinline__ const float* vrow(int seq, int pos, int kvh, const float* kv, const float* cv, const int* pt) {
    if (seq == 0) return kv + (size_t)pos * 1024 + 512 + kvh * 128;
    const int b = seq - 1;
    if (pos < 8192) { const int page = pt[b * 64 + (pos >> 7)]; return cv + (((size_t)page * 128 + (pos & 127)) * NKV + kvh) * 128; }
    return kv + (size_t)(SEQ + 4 * b + (pos - 8192)) * 1024 + 512 + kvh * 128;
}
__global__ void k_kmean(const float* kv, const float* ck, const int* pt, float* km) {
    const int seq = blockIdx.x / 32, blk = blockIdx.x % 32, kvh = threadIdx.x >> 7, d = threadIdx.x & 127; float s = 0.f;
    for (int j = 0; j < 256; ++j) s += krow(seq, blk * 256 + j, kvh, kv, ck, pt)[d];
    km[((size_t)seq * 32 + blk) * 512 + threadIdx.x] = s / 256.f;
}
__global__ void __launch_bounds__(64) k_select(const float* qn, const float* km, unsigned* selm) {
    __shared__ float qs[128], gl[32];
    const int row = blockIdx.x / NH, h = blockIdx.x % NH, kvh = h >> 2, lane = threadIdx.x;
    const int seq = row < SEQ ? 0 : 1 + (row - SEQ) / 4; const int pos = row < SEQ ? row : 8192 + (row - SEQ) % 4; const int qblk = pos >> 8;
    qs[lane] = qn[(size_t)row * D + h * 128 + lane]; qs[lane + 64] = qn[(size_t)row * D + h * 128 + lane + 64]; __syncthreads();
    if (lane < 32) { float g = -INFINITY; if (lane < qblk) { g = 0.f; const float* kmr = km + ((size_t)seq * 32 + lane) * 512 + kvh * 128; for (int d = 0; d < 128; ++d) g += qs[d] * kmr[d]; } gl[lane] = g; }
    __syncthreads();
    if (lane == 0) { unsigned m = 0u; for (int r = 0; r < 3 && r < qblk; ++r) { int best = 0; float bv = -INFINITY; for (int n = 0; n < 32; ++n) if (gl[n] > bv) { bv = gl[n]; best = n; } m |= 1u << best; gl[best] = -INFINITY; } selm[(size_t)row * NH + h] = m; }
}
__global__ void __launch_bounds__(64) k_attn(const float* qn, const float* kv, const float* ck, const float* cv, const int* pt, const unsigned* selm, float* o) {
    __shared__ f32x4_t Ks[32][32], Vs[32][32];
    const int g = blockIdx.x, lane = threadIdx.x; int seq, row, h, kvh; bool active = true;
    if (g < 2048) { seq = 0; kvh = g & 3; row = 16 * (g >> 2) + (lane >> 2); h = 4 * kvh + (lane & 3); }
    else { const int gs = g - 2048, b = gs >> 2; kvh = gs & 3; seq = 1 + b; active = lane < 16; row = SEQ + 4 * b + ((lane >> 2) & 3); h = 4 * kvh + (lane & 3); }
    const int pos = row < SEQ ? row : 8192 + (row - SEQ) % 4; const int qblk = pos >> 8;
    const int posmax = (seq == 0) ? (16 * (g >> 2) + 15) : 8195;
    float qv[128];
#pragma unroll
    for (int d = 0; d < 128; ++d) qv[d] = qn[(size_t)row * D + h * 128 + d];
    const unsigned mask = selm[(size_t)row * NH + h];
    float m = -INFINITY, l = 0.f; float O[128];
#pragma unroll
    for (int d = 0; d < 128; ++d) O[d] = 0.f;
    for (int pass = 0; pass < 2; ++pass) {
        for (int n = 0; n <= qblk; ++n) {
            const bool use = active && ((n == qblk) || ((mask >> n) & 1u));
            if (!__any(use)) continue;
            for (int tile = 0; tile < 8; ++tile) {
                const int kp0 = n * 256 + tile * 32; if (kp0 > posmax) break;
                __syncthreads();
                for (int it = 0; it < 16; ++it) { const int idx = it * 64 + lane, r = idx >> 5, c4 = idx & 31; const int kp = kp0 + r;
                    f32x4_t kk = {0.f, 0.f, 0.f, 0.f}, vv = {0.f, 0.f, 0.f, 0.f};
                    if (kp <= posmax) { kk = ((const f32x4_t*)krow(seq, kp, kvh, kv, ck, pt))[c4]; if (pass) vv = ((const f32x4_t*)vrow(seq, kp, kvh, kv, cv, pt))[c4]; }
                    Ks[r][c4] = kk; Vs[r][c4] = vv; }
                __syncthreads();
                for (int j = 0; j < 32; ++j) { const int kp = kp0 + j; float s = 0.f;
#pragma unroll
                    for (int c = 0; c < 32; ++c) { const f32x4_t k4 = Ks[j][c]; s += qv[4 * c] * k4.x + qv[4 * c + 1] * k4.y + qv[4 * c + 2] * k4.z + qv[4 * c + 3] * k4.w; }
                    s *= SCALE; const bool ok = use && (kp <= pos);
                    if (pass == 0) { if (ok) m = fmaxf(m, s); }
                    else { const float p = ok ? expf(s - m) : 0.f; l += p;
#pragma unroll
                        for (int c = 0; c < 32; ++c) { const f32x4_t v4 = Vs[j][c]; O[4 * c] += p * v4.x; O[4 * c + 1] += p * v4.y; O[4 * c + 2] += p * v4.z; O[4 * c + 3] += p * v4.w; } }
                }
            }
        }
    }
    if (active) { const float il = 1.f / l;
#pragma unroll
        for (int d = 0; d < 128; ++d) o[(size_t)row * D + h * 128 + d] = O[d] * il; }
}
__global__ void k_y_out(const float* h, float* yp, float* ys) {
    const size_t i = (size_t)blockIdx.x * 256 + threadIdx.x; if (i >= (size_t)M * D) return;
    if (i < (size_t)SEQ * D) yp[i] = h[i]; else ys[i - (size_t)SEQ * D] = h[i];
}
#define ORC_GEMM(A_, W_, C_, R_, N_, K_) hipLaunchKernelGGL(k_gemm, dim3((N_) / 64, M / 64), dim3(256), 0, stream, (A_), (W_), (C_), (R_), M, (N_), (K_))
static void run(void* const* d_in, float* out, float* ob, hipStream_t stream,
                size_t OY_P, size_t OY_S, size_t OST_P, size_t OST_S, size_t OK_P, size_t OV_P, size_t OK_S, size_t OV_S) {
    const float* x_p = (const float*)d_in[0]; const float* x_s = (const float*)d_in[1]; const float* st_in = (const float*)d_in[2];
    const float* ck = (const float*)d_in[3]; const float* cv = (const float*)d_in[4]; const int* pt = (const int*)d_in[5];
    const float* norm_mix_a = (const float*)d_in[6]; const float* w_in = (const float*)d_in[7]; const float* lbl = (const float*)d_in[8];
    const float* onorm = (const float*)d_in[9]; const float* w_out = (const float*)d_in[10]; const float* norm_kv = (const float*)d_in[11];
    const float* w_kv = (const float*)d_in[12]; const float* k_norm = (const float*)d_in[13]; const float* norm_mix_b = (const float*)d_in[14];
    const float* w_q = (const float*)d_in[15]; const float* q_norm = (const float*)d_in[16]; const float* w_o = (const float*)d_in[17];
    const float* norm_ffn = (const float*)d_in[18]; const float* w_gu = (const float*)d_in[19]; const float* w_dn = (const float*)d_in[20];
    float *XN = ob + B_XN, *Z = ob + B_Z, *H = ob + B_H, *T = ob + B_T, *Q = ob + B_Q, *F = ob + B_F, *V = ob + B_V, *Gt = ob + B_G, *O = ob + B_O, *HM = ob + B_HM, *KV = ob + B_KV, *KM = ob + B_KM; unsigned* SEL = (unsigned*)(ob + B_SEL);
    const int nbMD = (int)(((size_t)M * D + 255) / 256);
    hipLaunchKernelGGL(k_cat_x, dim3(nbMD), dim3(256), 0, stream, x_p, x_s, H);
    hipLaunchKernelGGL(k_rmsnorm, dim3(M), dim3(256), 0, stream, H, norm_mix_a, XN, D);
    ORC_GEMM(XN, w_in, Z, (const float*)nullptr, 8192, D);
    hipLaunchKernelGGL(k_hgrn_act, dim3(nbMD), dim3(256), 0, stream, Z, lbl, Q, F, V, Gt);
    hipLaunchKernelGGL(k_hgrn_rec, dim3(33 * NH), dim3(128), 0, stream, Q, F, V, st_in, O, out + OST_P, out + OST_S);
    hipLaunchKernelGGL(k_headnorm, dim3(M * NH), dim3(128), 0, stream, O, D, onorm, O, D, NH);
    hipLaunchKernelGGL(k_mul, dim3(nbMD), dim3(256), 0, stream, O, Gt);
    ORC_GEMM(O, w_out, H, H, D, D);
    hipLaunchKernelGGL(k_rmsnorm, dim3(M), dim3(256), 0, stream, H, norm_ffn, XN, D);
    ORC_GEMM(XN, w_gu, Z, (const float*)nullptr, 11264, D);
    hipLaunchKernelGGL(k_swiglu, dim3((int)(((size_t)M * DFF + 255) / 256)), dim3(256), 0, stream, Z, HM);
    ORC_GEMM(HM, w_dn, H, H, D, DFF);
    hipLaunchKernelGGL(k_rmsnorm, dim3(M), dim3(256), 0, stream, H, norm_kv, XN, D);
    ORC_GEMM(XN, w_kv, KV, (const float*)nullptr, 1024, D);
    hipLaunchKernelGGL(k_headnorm, dim3(M * NKV), dim3(128), 0, stream, KV, 1024, k_norm, KV, 1024, NKV);
    hipLaunchKernelGGL(k_kv_out, dim3((int)(((size_t)M * 512 + 255) / 256)), dim3(256), 0, stream, KV, out + OK_P, out + OV_P, out + OK_S, out + OV_S);
    hipLaunchKernelGGL(k_rmsnorm, dim3(M), dim3(256), 0, stream, H, norm_mix_b, XN, D);
    ORC_GEMM(XN, w_q, Q, (const float*)nullptr, D, D);
    hipLaunchKernelGGL(k_headnorm, dim3(M * NH), dim3(128), 0, stream, Q, D, q_norm, Q, D, NH);
    hipLaunchKernelGGL(k_kmean, dim3(33 * 32), dim3(512), 0, stream, KV, ck, pt, KM);
    hipLaunchKernelGGL(k_select, dim3(M * NH), dim3(64), 0, stream, Q, KM, SEL);
    hipLaunchKernelGGL(k_attn, dim3(2048 + 128), dim3(64), 0, stream, Q, KV, ck, cv, pt, SEL, O);
    ORC_GEMM(O, w_o, H, H, D, D);
    hipLaunchKernelGGL(k_rmsnorm, dim3(M), dim3(256), 0, stream, H, norm_ffn + D, XN, D);
    ORC_GEMM(XN, w_gu + (size_t)D * 11264, Z, (const float*)nullptr, 11264, D);
    hipLaunchKernelGGL(k_swiglu, dim3((int)(((size_t)M * DFF + 255) / 256)), dim3(256), 0, stream, Z, HM);
    ORC_GEMM(HM, w_dn + (size_t)DFF * D, H, H, D, DFF);
    hipLaunchKernelGGL(k_y_out, dim3(nbMD), dim3(256), 0, stream, H, out + OY_P, out + OY_S);
}
}
extern "C" void kernel_launch(void* const* d_in, const int* in_sizes, int n_in, void* d_out, int out_size, void* d_ws, size_t ws_size, hipStream_t stream) {
    if (n_in != 21 || ws_size < orc::B_END * 4) { fprintf(stderr, "kernel_launch: bad n_in/ws\n"); return; }
    orc::run(d_in, (float*)d_out, (float*)d_ws, stream, OY_P, OY_S, OST_P, OST_S, OK_P, OV_P, OK_S, OV_S);
}
```

```cpp
#include <hip/hip_runtime.h>
#include <cstdio>
#include <cstdint>

namespace pg8 {
#define PG8_LAS __attribute__((address_space(3)))
typedef unsigned short bf16_t;
typedef short bf16x8 __attribute__((ext_vector_type(8)));
typedef float f32x4 __attribute__((ext_vector_type(4)));
typedef unsigned u32x4 __attribute__((ext_vector_type(4)));
typedef unsigned u32x2 __attribute__((ext_vector_type(2)));
constexpr int BM = 256, BK = 64, HALF = 128, HTB = HALF * BK * 2, STAGE_BYTES = 8 * HTB, NXCD = 8, WGM = 8;

__host__ __device__ __forceinline__ int lds_byte(int r, int c) { const int st = (r >> 4) * 2 + (c >> 5), rr = r & 15, cc = c & 31, ob = rr * 64 + cc * 2; return st * 1024 + (ob ^ (((ob >> 9) & 1) << 5)); }
__host__ __device__ __forceinline__ void stage_rc(int b, int& R, int& C) { const int st = b / 1024, sb = b % 1024, swz = sb ^ (((sb >> 9) & 1) << 5); R = (st >> 1) * 16 + swz / 64; C = (st & 1) * 32 + (swz % 64) / 2; }
__host__ __device__ __forceinline__ int perm32(int rho) { const int n = rho >> 4, i = rho & 15; return 8 * (i >> 2) + 4 * n + (i & 3); }

struct Unit { int pm, pn; };
struct Gemm { const bf16_t* A; const bf16_t* Bt; int M, N, K; };

struct StaticOrder {
    int nM, nN, nwg, G, c;
    __host__ __device__ void init(int M, int N, int G_, int c_) { nM = M / BM; nN = N / BM; nwg = nM * nN; G = G_; c = c_; }
    __host__ __device__ bool next(int i, Unit& u) const {
        const long L = (long)i * G + c; if (L >= nwg) return false;
        int wgid = (int)L; { const int q = nwg / NXCD, r = nwg % NXCD, xcd = wgid % NXCD, off = wgid / NXCD; wgid = (xcd < r ? xcd * (q + 1) : r * (q + 1) + (xcd - r) * q) + off; }
        const int nig = WGM * nN, gid = wgid / nig, fm = gid * WGM, gsz = (nM - fm) < WGM ? (nM - fm) : WGM;
        u.pm = fm + ((wgid % nig) % gsz); u.pn = (wgid % nig) / gsz; return true;
    }
    __device__ __forceinline__ void a_ready(const Unit&) const {}
    __device__ __forceinline__ void done(const Unit&) const {}
};

__device__ __forceinline__ unsigned cvt_pk_bf16(float lo, float hi) { unsigned r; asm volatile("v_cvt_pk_bf16_f32 %0, %1, %2" : "=v"(r) : "v"(lo), "v"(hi)); return r; }

template <class Epi, class Sched, bool ALIGN_EPI = false, bool SP2 = false>
__device__ __forceinline__ void gemm_phase(PG8_LAS unsigned char* lds, const Gemm g, const Sched& S, const Epi& E) {
    const int tid = threadIdx.x, wid = __builtin_amdgcn_readfirstlane(tid >> 6), lane = tid & 63, wr = wid >> 2, wc = wid & 3, fr = lane & 15, fq = lane >> 4;
    const int K = g.K, nt = K / BK;
    unsigned voffA[2], voffB[2];
#pragma unroll
    for (int i = 0; i < 2; ++i) { int R, C; stage_rc(tid * 16 + i * 8192, R, C); const int Rb = Epi::PERM ? ((R & ~31) + perm32(R & 31)) : R;
        voffA[i] = (unsigned)(R * K + C) * 2u; voffB[i] = (unsigned)(Rb * K + C) * 2u; }
    const size_t kstep = (size_t)(BK * 2);
    const size_t hstep = (size_t)HALF * K * 2;
    const size_t tstep = 2 * hstep;
    const unsigned ldsw = (unsigned)wid * 1024u;
    const int aoff = lds_byte(wr * 64 + fr, fq * 8), boff = lds_byte(wc * 32 + fr, fq * 8);
#define PG8_SA(b, h) (((b) * 2 + (h)) * HTB)
#define PG8_SB(b, h) ((4 + (b) * 2 + (h)) * HTB)
#define PG8_STAGE(bufoff, gbase, voff) do { _Pragma("unroll") for (int _i = 0; _i < 2; ++_i) \
        __builtin_amdgcn_global_load_lds((const unsigned*)((const char*)(gbase) + (voff)[_i]), (PG8_LAS unsigned*)(lds + (bufoff) + ldsw + _i * 8192), 16, 0, 0); } while (0)
#define PG8_LDA(dst, b, h) do { _Pragma("unroll") for (int m = 0; m < 4; ++m) _Pragma("unroll") for (int k = 0; k < 2; ++k) dst[m][k] = *(const PG8_LAS bf16x8*)(lds + PG8_SA(b, h) + aoff + m * 2048 + k * 1024); } while (0)
#define PG8_LDB(dst, b, h) do { _Pragma("unroll") for (int n = 0; n < 2; ++n) _Pragma("unroll") for (int k = 0; k < 2; ++k) dst[n][k] = *(const PG8_LAS bf16x8*)(lds + PG8_SB(b, h) + boff + n * 2048 + k * 1024); } while (0)
#define PG8_MMA(ai, bj, At, Bt) do { __builtin_amdgcn_s_setprio(1); _Pragma("unroll") for (int m = 0; m < 4; ++m) _Pragma("unroll") for (int n = 0; n < 2; ++n) _Pragma("unroll") for (int k = 0; k < 2; ++k) \
        acc[ai][bj][m][n] = __builtin_amdgcn_mfma_f32_16x16x32_bf16(Bt[n][k], At[m][k], acc[ai][bj][m][n], 0, 0, 0); __builtin_amdgcn_s_setprio(0); } while (0)
#define PG8_WAIT_V(n) asm volatile("s_waitcnt vmcnt(" #n ")" ::: "memory")
#define PG8_WAIT_L(n) asm volatile("s_waitcnt lgkmcnt(" #n ")" ::: "memory")
#define PG8_BAR __builtin_amdgcn_s_barrier()
#define PG8_SCHED __builtin_amdgcn_sched_barrier(0)
    Unit cur, nxt; int ui = 0;
    if (!S.next(0, cur)) return;
    f32x4 acc[2][2][4][2];
#pragma unroll
    for (int a = 0; a < 2; ++a)
#pragma unroll
        for (int b = 0; b < 2; ++b)
#pragma unroll
            for (int m = 0; m < 4; ++m)
#pragma unroll
                for (int n = 0; n < 2; ++n) acc[a][b][m][n] = (f32x4){0.f, 0.f, 0.f, 0.f};
    bf16x8 At[4][2], B0[2][2], B1[2][2];
    const char* cA = (const char*)g.A + (size_t)cur.pm * tstep; const char* cB = (const char*)g.Bt + (size_t)cur.pn * tstep;
    S.a_ready(cur);
    if constexpr (SP2) {
        PG8_STAGE(PG8_SB(0, 0), cB, voffB); PG8_STAGE(PG8_SB(0, 1), cB + hstep, voffB); PG8_STAGE(PG8_SA(0, 0), cA, voffA); PG8_STAGE(PG8_SA(0, 1), cA + hstep, voffA);
        if (wr == 1) PG8_BAR;
        PG8_WAIT_V(2); PG8_BAR;
        PG8_STAGE(PG8_SB(1, 0), cB + kstep, voffB); PG8_STAGE(PG8_SA(1, 0), cA + kstep, voffA); PG8_STAGE(PG8_SB(1, 1), cB + hstep + kstep, voffB);
        PG8_WAIT_V(6); PG8_BAR;
    } else {
        PG8_STAGE(PG8_SB(0, 0), cB, voffB); PG8_STAGE(PG8_SA(0, 0), cA, voffA); PG8_STAGE(PG8_SB(0, 1), cB + hstep, voffB); PG8_STAGE(PG8_SA(0, 1), cA + hstep, voffA);
        if (wr == 1) PG8_BAR;
        PG8_WAIT_V(4); PG8_BAR;
        PG8_STAGE(PG8_SB(1, 0), cB + kstep, voffB); PG8_STAGE(PG8_SA(1, 0), cA + kstep, voffA); PG8_STAGE(PG8_SB(1, 1), cB + hstep + kstep, voffB);
        PG8_WAIT_V(6); PG8_BAR;
    }
    for (;;) {
        const bool has_next = S.next(ui + 1, nxt);
        const char* nA = has_next ? (const char*)g.A + (size_t)nxt.pm * tstep : cA; const char* nB = has_next ? (const char*)g.Bt + (size_t)nxt.pn * tstep : cB;
        for (int t = 0; t < nt; t += 2) {
            const bool last = (t == nt - 2);
            const char* a1 = cA + (size_t)(t + 1) * kstep;
            const char* a2 = last ? nA : cA + (size_t)(t + 2) * kstep; const char* b2 = last ? nB : cB + (size_t)(t + 2) * kstep;
            const char* a3 = a2 + kstep; const char* b3 = b2 + kstep;
            if (last && has_next) S.a_ready(nxt);
            if constexpr (SP2) {
            PG8_LDB(B0, 0, 0); PG8_LDB(B1, 0, 1); PG8_SCHED; PG8_LDA(At, 0, 0); PG8_STAGE(PG8_SA(1, 1), a1 + hstep, voffA);
            PG8_WAIT_V(8); PG8_WAIT_L(0); PG8_BAR; PG8_MMA(0, 0, At, B0); PG8_MMA(0, 1, At, B1); PG8_BAR; PG8_SCHED;
            PG8_LDA(At, 0, 1); PG8_STAGE(PG8_SB(0, 0), b2, voffB); PG8_STAGE(PG8_SB(0, 1), b2 + hstep, voffB); PG8_STAGE(PG8_SA(0, 0), a2, voffA);
            PG8_WAIT_V(8); PG8_WAIT_L(0); PG8_BAR; PG8_MMA(1, 0, At, B0); PG8_MMA(1, 1, At, B1); PG8_BAR; PG8_SCHED;
            PG8_LDB(B0, 1, 0); PG8_LDB(B1, 1, 1); PG8_SCHED; PG8_LDA(At, 1, 0); PG8_STAGE(PG8_SA(0, 1), a2 + hstep, voffA);
            PG8_WAIT_V(8); PG8_WAIT_L(0); PG8_BAR; PG8_MMA(0, 0, At, B0); PG8_MMA(0, 1, At, B1); PG8_BAR; PG8_SCHED;
            PG8_LDA(At, 1, 1); PG8_STAGE(PG8_SB(1, 0), b3, voffB); PG8_STAGE(PG8_SB(1, 1), b3 + hstep, voffB); PG8_STAGE(PG8_SA(1, 0), a3, voffA);
            PG8_WAIT_V(8); PG8_WAIT_L(0); PG8_BAR; PG8_MMA(1, 0, At, B0); PG8_MMA(1, 1, At, B1); PG8_BAR; PG8_SCHED;
            } else {
            PG8_LDB(B0, 0, 0); PG8_SCHED; PG8_LDA(At, 0, 0); PG8_STAGE(PG8_SA(1, 1), a1 + hstep, voffA);
            PG8_WAIT_L(8); PG8_BAR; PG8_WAIT_L(0); PG8_MMA(0, 0, At, B0); PG8_BAR; PG8_SCHED;
            PG8_LDB(B1, 0, 1); PG8_STAGE(PG8_SB(0, 0), b2, voffB);
            PG8_BAR; PG8_WAIT_L(0); PG8_MMA(0, 1, At, B1); PG8_BAR;
            PG8_LDA(At, 0, 1); PG8_STAGE(PG8_SA(0, 0), a2, voffA);
            PG8_BAR; PG8_WAIT_L(0); PG8_MMA(1, 0, At, B0); PG8_BAR; PG8_SCHED;
            PG8_STAGE(PG8_SB(0, 1), b2 + hstep, voffB);
            PG8_WAIT_V(6); PG8_BAR; PG8_MMA(1, 1, At, B1); PG8_BAR;
            PG8_LDB(B0, 1, 0); PG8_SCHED; PG8_LDA(At, 1, 0); PG8_STAGE(PG8_SA(0, 1), a2 + hstep, voffA);
            PG8_WAIT_L(8); PG8_BAR; PG8_WAIT_L(0); PG8_MMA(0, 0, At, B0); PG8_BAR; PG8_SCHED;
            PG8_LDB(B1, 1, 1); PG8_STAGE(PG8_SB(1, 0), b3, voffB);
            PG8_BAR; PG8_WAIT_L(0); PG8_MMA(0, 1, At, B1); PG8_BAR;
            PG8_LDA(At, 1, 1); PG8_STAGE(PG8_SA(1, 0), a3, voffA);
            PG8_BAR; PG8_WAIT_L(0); PG8_MMA(1, 0, At, B0); PG8_BAR; PG8_SCHED;
            PG8_STAGE(PG8_SB(1, 1), b3 + hstep, voffB);
            PG8_WAIT_V(6); PG8_BAR; PG8_MMA(1, 1, At, B1); PG8_BAR;
            }
        }
        if constexpr (ALIGN_EPI) { if (wr == 0) PG8_BAR; }
        E(acc, cur, wr, wc, fr, fq);
        if (!has_next) break;
#pragma unroll
        for (int a = 0; a < 2; ++a)
#pragma unroll
            for (int b = 0; b < 2; ++b)
#pragma unroll
                for (int m = 0; m < 4; ++m)
#pragma unroll
                    for (int n = 0; n < 2; ++n) acc[a][b][m][n] = (f32x4){0.f, 0.f, 0.f, 0.f};
        cur = nxt; cA = nA; cB = nB; ++ui;
        if constexpr (ALIGN_EPI) { if (wr == 1) PG8_BAR; }
    }
    PG8_WAIT_V(0);
    if constexpr (!ALIGN_EPI) { if (wr == 0) PG8_BAR; }
    PG8_BAR;
#undef PG8_SA
#undef PG8_SB
#undef PG8_STAGE
#undef PG8_LDA
#undef PG8_LDB
#undef PG8_MMA
#undef PG8_WAIT_V
#undef PG8_WAIT_L
#undef PG8_BAR
#undef PG8_SCHED
}
}

constexpr int NWAVES = 8, NTHR = 512;
constexpr int D = 2048, SEQ = 8192, DECB = 32, DECS = 4, MS = DECB * DECS;
constexpr int MR = SEQ + MS;
constexpr int MP = 8448;
constexpr int NH = 16, HD = 128, NKV = 4, DFF = 5632, NGU = 2 * DFF;
constexpr int NCHUNK = SEQ / 64;
constexpr int NPAGES = 64, PAGE = 128, NBLK = 32;
constexpr float EPS = 1e-6f;
constexpr float C2 = 0.08838834764831845f * 1.4426950408889634f;

constexpr size_t OY_P = 0, OY_S = OY_P + (size_t)SEQ * D, OST_P = OY_S + (size_t)MS * D, OST_S = OST_P + (size_t)NH * 128 * 128,
                 OK_P = OST_S + (size_t)DECB * NH * 128 * 128, OV_P = OK_P + (size_t)SEQ * 512, OK_S = OV_P + (size_t)SEQ * 512, OV_S = OK_S + (size_t)MS * 512;

constexpr size_t MiB = 1u << 20;
constexpr size_t WS_CTL = 0, CTL_ZERO_BYTES = 1 * MiB;
constexpr size_t WS_WIN = 2 * MiB;
constexpr size_t WS_WOUT = WS_WIN + 32 * MiB;
constexpr size_t WS_WGU0 = WS_WOUT + 8 * MiB;
constexpr size_t WS_WDN0 = WS_WGU0 + 44 * MiB;
constexpr size_t WS_WKVQ = WS_WDN0 + 22 * MiB;
constexpr size_t WS_WO = WS_WKVQ + 12 * MiB;
constexpr size_t WS_WGU1 = WS_WO + 8 * MiB;
constexpr size_t WS_WDN1 = WS_WGU1 + 44 * MiB;
constexpr size_t WS_HB0 = WS_WDN1 + 22 * MiB;
constexpr size_t WS_HB1 = WS_HB0 + 34 * MiB, WS_HB2 = WS_HB1 + 34 * MiB, WS_HB3 = WS_HB2 + 34 * MiB;
constexpr size_t WS_HF1 = WS_HB3 + 34 * MiB;
constexpr size_t WS_HF2 = WS_HF1 + 67 * MiB, WS_HF3 = WS_HF2 + 67 * MiB;
constexpr size_t WS_QG = WS_HF3 + 67 * MiB;
constexpr size_t WS_VG = WS_QG + 34 * MiB;
constexpr size_t WS_GG = WS_VG + 34 * MiB;
constexpr size_t WS_F = WS_GG + 34 * MiB;
constexpr size_t WS_OB = WS_F + 67 * MiB;
constexpr size_t WS_AT = WS_OB + 34 * MiB;
constexpr size_t WS_HM = WS_AT + 34 * MiB;
constexpr size_t WS_U = WS_HM + 92 * MiB;
constexpr size_t WS_SST = WS_U + 64 * MiB;
constexpr size_t WS_DEC = WS_SST + 64 * MiB;
constexpr size_t WS_KRAW = WS_DEC + 2 * MiB;
constexpr size_t WS_VRAW = WS_KRAW + 17 * MiB;
constexpr size_t WS_QRAW = WS_VRAW + 17 * MiB;
constexpr size_t WS_KB = WS_QRAW + 67 * MiB;
constexpr size_t WS_VBT = WS_KB + 9 * MiB;
constexpr size_t WS_QB = WS_VBT + 8 * MiB;
constexpr size_t WS_KPART = WS_QB + 34 * MiB;
constexpr size_t WS_KMS = WS_KPART + 1 * MiB;
constexpr size_t WS_SUBL = WS_KMS + 2 * MiB;
constexpr size_t WS_SCNT = WS_SUBL + 16 * MiB;
constexpr size_t WS_OSLOT = WS_SCNT + 1 * MiB;
constexpr size_t WS_MLSLOT = WS_OSLOT + 192 * MiB;
constexpr size_t WS_SSLOT = WS_MLSLOT + 3 * MiB;
constexpr size_t WS_FOUT = WS_SSLOT + 34 * MiB;
constexpr size_t WS_END = WS_FOUT + 131 * MiB;
constexpr size_t WS_ORC = WS_END;
constexpr int CW_BAR = 4096;
constexpr int CW_Q0 = 8192;
constexpr int CW_SS0 = 16384, CW_SS1 = CW_SS0 + MP, CW_SS2 = CW_SS1 + MP, CW_SS3 = CW_SS2 + MP;
static_assert((CW_SS3 + MP) * 4 <= (int)CTL_ZERO_BYTES, "ctl");
static_assert(WS_VG - WS_QG == 34 * MiB && WS_GG - WS_VG == 34 * MiB, "Qg|Vg|Gg stride");

constexpr int LDS_BYTES = 160 * 1024;
constexpr int MISC_OFF = LDS_BYTES - 256;

#define GAS __attribute__((address_space(1)))
#define LAS __attribute__((address_space(3)))
typedef unsigned short bf16;
typedef unsigned v4u __attribute__((ext_vector_type(4)));
typedef unsigned v2u __attribute__((ext_vector_type(2)));
typedef float f32x4 __attribute__((ext_vector_type(4)));
typedef float f32x2 __attribute__((ext_vector_type(2)));
typedef short bf16x8 __attribute__((ext_vector_type(8)));
typedef short bf16x4 __attribute__((ext_vector_type(4)));
#define LDS_WAIT() asm volatile("s_waitcnt lgkmcnt(0)" ::: "memory")
__device__ __forceinline__ unsigned f2bf(float f) { unsigned u = __builtin_bit_cast(unsigned, f); return (u + 0x7fffu + ((u >> 16) & 1u)) >> 16; }
__device__ __forceinline__ unsigned pk2(float lo, float hi) { return f2bf(lo) | (f2bf(hi) << 16); }
__device__ __forceinline__ float bf2f(unsigned h) { return __uint_as_float(h << 16); }
__device__ __forceinline__ float silu_f(float x) { return x * __builtin_amdgcn_rcpf(1.0f + __expf(-x)); }
__device__ __forceinline__ float sigm_f(float x) { return __builtin_amdgcn_rcpf(1.0f + __expf(-x)); }
__device__ __forceinline__ float wave_sum(float v) {
#pragma unroll
    for (int o = 1; o < 64; o <<= 1) v += __shfl_xor(v, o);
    return v;
}
#define MFMA16(a, b, c) __builtin_amdgcn_mfma_f32_16x16x32_bf16((a), (b), (c), 0, 0, 0)

#define XB_TMO      128
#define XB_XCNT(j)  (256  + 64 * (j))
#define XB_XSUB(j)  (1280 + 64 * (j))
#define XB_XGEN(j)  (2304 + 64 * (j))
#define XB_TOP      3328
#define XB_TOPGEN   3392
#define XCD_BAR_WORDS 3456
#define XB_SPIN_CAP (1u << 18)
__device__ __forceinline__ unsigned xb_ld(unsigned* p)              { return __hip_atomic_load(p, __ATOMIC_RELAXED, __HIP_MEMORY_SCOPE_AGENT); }
__device__ __forceinline__ unsigned xb_add(unsigned* p, unsigned v) { return __hip_atomic_fetch_add(p, v, __ATOMIC_RELAXED, __HIP_MEMORY_SCOPE_AGENT); }
__device__ __forceinline__ unsigned xb_xcc_id() { return (unsigned)__builtin_amdgcn_s_getreg((3 << 11) | 20) & 0xFu; }
#define XB_SPIN(cond, bar) do { unsigned _sp = 0; while (cond) { __builtin_amdgcn_s_sleep(1); \
    if ((++_sp & 255u) == 0u) { if (xb_ld(&(bar)[XB_TMO])) break; if (_sp > XB_SPIN_CAP) { atomicAdd(&(bar)[XB_TMO], 1u); break; } } } } while (0)
struct XcdBarrier { unsigned* bar; unsigned x; volatile LAS unsigned* st; };
__device__ __forceinline__ XcdBarrier xcd_barrier_post(unsigned* bar, volatile LAS unsigned* st) {
    XcdBarrier b; b.bar = bar; b.x = xb_xcc_id(); b.st = st;
    if (threadIdx.x == 0) (void)xb_add(&bar[XB_XCNT(b.x)], 1u);
    return b;
}
__device__ __forceinline__ void xcd_barrier_complete(unsigned* bar, unsigned x, unsigned& nloc, unsigned& nx) {
    const unsigned G = gridDim.x * gridDim.y * gridDim.z;
    unsigned sum, cnt, mine, sp = 0u;
    for (;;) {
        sum = 0u; cnt = 0u; mine = 0u;
#pragma unroll
        for (unsigned j = 0; j < 16; ++j) { const unsigned c = xb_ld(&bar[XB_XCNT(j)]); sum += c; cnt += (c > 0u) ? 1u : 0u; mine = (j == x) ? c : mine; }
        if (sum == G) break;
        __builtin_amdgcn_s_sleep(1);
        if ((++sp & 255u) == 0u) { if (xb_ld(&bar[XB_TMO])) break; if (sp > XB_SPIN_CAP) { atomicAdd(&bar[XB_TMO], 1u); break; } }
    }
    nloc = mine > 0u ? mine : 1u; nx = cnt > 0u ? cnt : 1u;
}
__device__ __forceinline__ void xcd_barrier(const XcdBarrier& b) {
    asm volatile("s_waitcnt vmcnt(0)" ::: "memory");
    __syncthreads();
    if (threadIdx.x == 0) {
        unsigned* bar = b.bar;
        __builtin_amdgcn_s_waitcnt(0);
        unsigned nloc = b.st[0], nx = b.st[1];
        if (nloc == 0u) { xcd_barrier_complete(bar, b.x, nloc, nx); b.st[0] = nloc; b.st[1] = nx; }
        const unsigned old = xb_add(&bar[XB_XSUB(b.x)], 1u);
        const unsigned gen = old / nloc;
        if (old + 1u == (gen + 1u) * nloc) {
            __builtin_amdgcn_fence(__ATOMIC_RELEASE, "agent");
            asm volatile("s_waitcnt vmcnt(0)" ::: "memory");
            const unsigned og = xb_add(&bar[XB_TOP], 1u);
            const unsigned tg = og / nx;
            if (og + 1u == (tg + 1u) * nx) xb_add(&bar[XB_TOPGEN], 1u);
            else XB_SPIN(xb_ld(&bar[XB_TOPGEN]) == tg, bar);
            __builtin_amdgcn_fence(__ATOMIC_ACQUIRE, "agent");
            xb_add(&bar[XB_XGEN(b.x)], 1u);
            asm volatile("s_waitcnt vmcnt(0)" ::: "memory");
        } else {
            XB_SPIN(xb_ld(&bar[XB_XGEN(b.x)]) == gen, bar);
            __builtin_amdgcn_fence(__ATOMIC_ACQUIRE, "agent");
            asm volatile("s_waitcnt vmcnt(0)" ::: "memory");
        }
    }
    __syncthreads();
}

using pg8::Unit; using pg8::cvt_pk_bf16;
struct EpiIn {
    static constexpr bool PERM = true;
    const float* ss; const float* lbl; bf16* Qg; float* F;
    __device__ __forceinline__ void operator()(const f32x4 (&acc)[2][2][4][2], const Unit& u, int wr, int wc, int fr, int fq) const {
        const int seg = u.pn >> 3; const int col0 = (u.pn & 7) * 256 + wc * 32 + 8 * fq; const int rowb = u.pm * 256 + wr * 64;
        float lb[2][8];
        if (seg == 1) {
#pragma unroll
            for (int bj = 0; bj < 2; ++bj)
#pragma unroll
                for (int j = 0; j < 8; ++j) { const int c = col0 + bj * 128 + j; lb[bj][j] = __builtin_amdgcn_rcpf(1.0f + __expf(lbl[D + c] - lbl[c])); }
        }
#pragma unroll
        for (int ai = 0; ai < 2; ++ai)
#pragma unroll
            for (int m = 0; m < 4; ++m) {
                const int rb = rowb + ai * 128 + m * 16; if (rb >= MR) continue;
                const int row = rb + fr; const float r = rsqrtf(ss[row] * (1.0f / D) + EPS);
#pragma unroll
                for (int bj = 0; bj < 2; ++bj) {
                    f32x4 v0 = acc[ai][bj][m][0] * r, v1 = acc[ai][bj][m][1] * r; const size_t off = (size_t)row * D + col0 + bj * 128;
                    if (seg == 1) {
                        f32x4 o0, o1;
#pragma unroll
                        for (int j = 0; j < 4; ++j) { o0[j] = lb[bj][j] + (1.0f - lb[bj][j]) * sigm_f(v0[j]); o1[j] = lb[bj][4 + j] + (1.0f - lb[bj][4 + j]) * sigm_f(v1[j]); }
                        *(f32x4*)(F + off) = o0; *(f32x4*)(F + off + 4) = o1;
                    } else {
                        if (seg != 2) {
#pragma unroll
                            for (int j = 0; j < 4; ++j) { v0[j] = silu_f(v0[j]); v1[j] = silu_f(v1[j]); }
                        }
                        v4u w; w.x = cvt_pk_bf16(v0[0], v0[1]); w.y = cvt_pk_bf16(v0[2], v0[3]); w.z = cvt_pk_bf16(v1[0], v1[1]); w.w = cvt_pk_bf16(v1[2], v1[3]);
                        const size_t dsel = (seg == 0) ? 0 : ((seg == 2) ? 1 : 2);
                        *(v4u*)(Qg + dsel * (size_t)(17 * MiB) + off) = w;
                    }
                }
            }
    }
};

template <int MODE> struct EpiRes {
    static constexpr bool PERM = true;
    const float* r0; const float* r1; float* o0; float* o1; bf16* hb; float* ss;
    __device__ __forceinline__ void operator()(const f32x4 (&acc)[2][2][4][2], const Unit& u, int wr, int wc, int fr, int fq) const {
        const int col0 = u.pn * 256 + wc * 32 + 8 * fq; const int rowb = u.pm * 256 + wr * 64;
#pragma unroll
        for (int ai = 0; ai < 2; ++ai)
#pragma unroll
            for (int m = 0; m < 4; ++m) {
                const int rb = rowb + ai * 128 + m * 16; if (rb >= MR) continue;
                const int row = rb + fr;
                const float* rp = (MODE == 0) ? ((row < SEQ) ? r0 + (size_t)row * D : r1 + (size_t)(row - SEQ) * D) : r0 + (size_t)row * D;
                float* op = (MODE == 2) ? ((row < SEQ) ? o0 + (size_t)row * D : o1 + (size_t)(row - SEQ) * D) : o0 + (size_t)row * D;
                float sq = 0.f;
#pragma unroll
                for (int bj = 0; bj < 2; ++bj) {
                    const int c = col0 + bj * 128;
                    const f32x4 a0 = *(const f32x4*)(rp + c) + acc[ai][bj][m][0], a1 = *(const f32x4*)(rp + c + 4) + acc[ai][bj][m][1];
                    *(f32x4*)(op + c) = a0; *(f32x4*)(op + c + 4) = a1;
                    if (MODE != 2) {
                        v4u w; w.x = cvt_pk_bf16(a0[0], a0[1]); w.y = cvt_pk_bf16(a0[2], a0[3]); w.z = cvt_pk_bf16(a1[0], a1[1]); w.w = cvt_pk_bf16(a1[2], a1[3]);
                        *(v4u*)(hb + (size_t)row * D + c) = w;
                        sq += (a0[0] * a0[0] + a0[1] * a0[1]) + (a0[2] * a0[2] + a0[3] * a0[3]) + (a1[0] * a1[0] + a1[1] * a1[1]) + (a1[2] * a1[2] + a1[3] * a1[3]);
                    }
                }
                if (MODE != 2) { sq += __shfl_xor(sq, 16); sq += __shfl_xor(sq, 32); if (fq == 0) atomicAdd(ss + row, sq); }
            }
    }
};
struct EpiGU {
    static constexpr bool PERM = true;
    const float* ss; bf16* hm;
    __device__ __forceinline__ void operator()(const f32x4 (&acc)[2][2][4][2], const Unit& u, int wr, int wc, int fr, int fq) const {
        const int j0 = u.pn * 128 + wc * 32 + 8 * fq; const int rowb = u.pm * 256 + wr * 64;
#pragma unroll
        for (int ai = 0; ai < 2; ++ai)
#pragma unroll
            for (int m = 0; m < 4; ++m) {
                const int rb = rowb + ai * 128 + m * 16; if (rb >= MR) continue;
                const int row = rb + fr; const float r = rsqrtf(ss[row] * (1.0f / D) + EPS);
                float o[8];
#pragma unroll
                for (int n = 0; n < 2; ++n)
#pragma unroll
                    for (int j = 0; j < 4; ++j) o[4 * n + j] = silu_f(acc[ai][0][m][n][j] * r) * (acc[ai][1][m][n][j] * r);
                v4u w; w.x = cvt_pk_bf16(o[0], o[1]); w.y = cvt_pk_bf16(o[2], o[3]); w.z = cvt_pk_bf16(o[4], o[5]); w.w = cvt_pk_bf16(o[6], o[7]);
                *(v4u*)(hm + (size_t)row * DFF + j0) = w;
            }
    }
};
struct EpiKVQ {
    static constexpr bool PERM = true;
    const float* ss; unsigned char* ws;
    __device__ __forceinline__ void operator()(const f32x4 (&acc)[2][2][4][2], const Unit& u, int wr, int wc, int fr, int fq) const {
        const int c0 = wc * 32 + 8 * fq; const int rowb = u.pm * 256 + wr * 64;
        const size_t base = (u.pn < 2) ? WS_KRAW : ((u.pn < 4) ? WS_VRAW : WS_QRAW);
        const int ld = (u.pn < 4) ? 512 : 2048; const int tcol = (u.pn < 2) ? u.pn * 256 : ((u.pn < 4) ? (u.pn - 2) * 256 : (u.pn - 4) * 256);
        float* dst = (float*)(ws + base);
#pragma unroll
        for (int ai = 0; ai < 2; ++ai)
#pragma unroll
            for (int m = 0; m < 4; ++m) {
                const int rb = rowb + ai * 128 + m * 16; if (rb >= MR) continue;
                const int row = rb + fr; const float r = rsqrtf(ss[row] * (1.0f / D) + EPS);
#pragma unroll
                for (int bj = 0; bj < 2; ++bj) { float* p = dst + (size_t)row * ld + tcol + c0 + bj * 128; *(f32x4*)p = acc[ai][bj][m][0] * r; *(f32x4*)(p + 4) = acc[ai][bj][m][1] * r; }
            }
    }
};

struct Args { const void* in[21]; float* out; unsigned char* ws; };

__device__ __forceinline__ void p0_transpose_item(const float* W, int K, int N, bf16* WT, int row_off, int mode, const float* gain, LAS float* scr, int item, int lane) {
    const int nblk = N / 32, kb = item / nblk, nb = item % nblk, k0 = 64 * kb, n0 = 32 * nb;
#pragma unroll 8
    for (int i = 0; i < 32; ++i) { const int kk = 2 * i + (lane >> 5); float w = W[(size_t)(k0 + kk) * N + n0 + (lane & 31)]; if (gain) w *= gain[k0 + kk]; scr[kk * 33 + (lane & 31)] = w; }
    LDS_WAIT(); asm volatile("" ::: "memory");
    const int c = lane & 7;
    int d0;
    if (mode == 0) d0 = row_off + n0;
    else { const int j = (n0 < DFF) ? n0 : n0 - DFF; d0 = 256 * (j >> 7) + (j & 127) + ((n0 < DFF) ? 0 : 128); }
#pragma unroll
    for (int j = 0; j < 4; ++j) { const int n = (lane >> 3) + 8 * j; const LAS float* s = scr + (8 * c) * 33 + n;
        v4u o; o.x = pk2(s[0 * 33], s[1 * 33]); o.y = pk2(s[2 * 33], s[3 * 33]); o.z = pk2(s[4 * 33], s[5 * 33]); o.w = pk2(s[6 * 33], s[7 * 33]);
        *(v4u*)(WT + (size_t)(d0 + n) * K + k0 + 8 * c) = o; }
    LDS_WAIT(); asm volatile("" ::: "memory");
}

constexpr int KS_P = 136, VS_P = 264;
constexpr int KS_BYTES = 256 * KS_P * 2, VS_BYTES = 128 * VS_P * 2;
template <int NKT> __device__ __forceinline__ void attn_scores(const LAS bf16* Ks, const bf16x8 (&qf)[4], f32x4 (&acc)[16], int nkt, int fr, int fq) {
#pragma unroll
    for (int kt = 0; kt < NKT; ++kt) {
        acc[kt] = (f32x4){0.f, 0.f, 0.f, 0.f};
        if (kt < nkt) {
#pragma unroll
            for (int ks = 0; ks < 4; ++ks) { const bf16x8 a = *(const LAS bf16x8*)(Ks + (16 * kt + fr) * KS_P + 32 * ks + 8 * fq); acc[kt] = MFMA16(a, qf[ks], acc[kt]); }
        }
    }
}
__device__ __forceinline__ void attn_pv(const LAS bf16* Vs, const f32x4 (&acc)[16], f32x4 (&O)[8], int nj, int fr, int fq) {
#pragma unroll
    for (int j = 0; j < 8; ++j) {
        if (j < nj) {
            v4u pw; pw.x = cvt_pk_bf16(acc[2 * j][0], acc[2 * j][1]); pw.y = cvt_pk_bf16(acc[2 * j][2], acc[2 * j][3]); pw.z = cvt_pk_bf16(acc[2 * j + 1][0], acc[2 * j + 1][1]); pw.w = cvt_pk_bf16(acc[2 * j + 1][2], acc[2 * j + 1][3]);
            const bf16x8 pf = __builtin_bit_cast(bf16x8, pw);
#pragma unroll
            for (int vt = 0; vt < 8; ++vt) {
                const LAS bf16* vp = Vs + (16 * vt + fr) * VS_P + 32 * j + 4 * fq;
                const v2u lo = *(const LAS v2u*)vp, hi = *(const LAS v2u*)(vp + 16);
                const v4u aw = {lo.x, lo.y, hi.x, hi.y};
                O[vt] = MFMA16(__builtin_bit_cast(bf16x8, aw), pf, O[vt]);
            }
        }
    }
}

__global__ void __launch_bounds__(NTHR, 2) yoco_fwd(Args args) {
    extern __shared__ __attribute__((aligned(16))) unsigned char lds_raw[];
    LAS unsigned char* lds = (LAS unsigned char*)lds_raw;
#define TIDS const int tid = threadIdx.x, lane = tid & 63, wave = __builtin_amdgcn_readfirstlane(tid >> 6), fr = lane & 15, fq = lane >> 4; (void)fr; (void)fq; (void)wave; (void)lane; (void)tid
    const int G = gridDim.x, bid = blockIdx.x;
    unsigned char* ws = args.ws;
    unsigned* ctl = (unsigned*)(ws + WS_CTL);
    volatile LAS unsigned* MISC = (volatile LAS unsigned*)(lds + MISC_OFF);
    if (threadIdx.x < 64) MISC[threadIdx.x] = 0u;
    __syncthreads();
    XcdBarrier bar = xcd_barrier_post(ctl + CW_BAR, MISC + 8);

    const float* x_p = (const float*)args.in[0]; const float* x_s = (const float*)args.in[1];
    const float* st_in = (const float*)args.in[2]; const float* cache_k = (const float*)args.in[3]; const float* cache_v = (const float*)args.in[4];
    const int* ptab = (const int*)args.in[5];
    const float* norm_mix_a = (const float*)args.in[6]; const float* w_in = (const float*)args.in[7]; const float* lbl = (const float*)args.in[8];
    const float* onorm = (const float*)args.in[9]; const float* w_out = (const float*)args.in[10];
    const float* norm_kv = (const float*)args.in[11]; const float* w_kv = (const float*)args.in[12]; const float* k_norm = (const float*)args.in[13];
    const float* norm_mix_b = (const float*)args.in[14]; const float* w_q = (const float*)args.in[15]; const float* q_norm = (const float*)args.in[16];
    const float* w_o = (const float*)args.in[17]; const float* norm_ffn = (const float*)args.in[18];
    const float* w_gu = (const float*)args.in[19]; const float* w_dn = (const float*)args.in[20];
    float* out = args.out;
    bf16* Win_t = (bf16*)(ws + WS_WIN); bf16* Wout_t = (bf16*)(ws + WS_WOUT); bf16* Wgu0_t = (bf16*)(ws + WS_WGU0); bf16* Wdn0_t = (bf16*)(ws + WS_WDN0);
    bf16* Wkvq_t = (bf16*)(ws + WS_WKVQ); bf16* Wo_t = (bf16*)(ws + WS_WO); bf16* Wgu1_t = (bf16*)(ws + WS_WGU1); bf16* Wdn1_t = (bf16*)(ws + WS_WDN1);
    bf16* Hb0 = (bf16*)(ws + WS_HB0); bf16* Hb1 = (bf16*)(ws + WS_HB1); bf16* Hb2 = (bf16*)(ws + WS_HB2); bf16* Hb3 = (bf16*)(ws + WS_HB3);
    float* Hf1 = (float*)(ws + WS_HF1); float* Hf2 = (float*)(ws + WS_HF2); float* Hf3 = (float*)(ws + WS_HF3);
    bf16* Qg = (bf16*)(ws + WS_QG); bf16* Vg = (bf16*)(ws + WS_VG); bf16* Gg = (bf16*)(ws + WS_GG); float* Ff = (float*)(ws + WS_F);
    bf16* Ob = (bf16*)(ws + WS_OB); bf16* At = (bf16*)(ws + WS_AT); bf16* Hm = (bf16*)(ws + WS_HM);
    bf16* Ub = (bf16*)(ws + WS_U); bf16* Sst = (bf16*)(ws + WS_SST); float* Dec = (float*)(ws + WS_DEC);
    float* Kraw = (float*)(ws + WS_KRAW); float* Vraw = (float*)(ws + WS_VRAW); float* Qraw = (float*)(ws + WS_QRAW);
    bf16* Kb = (bf16*)(ws + WS_KB); bf16* VbT = (bf16*)(ws + WS_VBT); bf16* Qb = (bf16*)(ws + WS_QB);
    float* Kpart = (float*)(ws + WS_KPART); float* Kms = (float*)(ws + WS_KMS);
    unsigned* Subl = (unsigned*)(ws + WS_SUBL); unsigned* Scnt = (unsigned*)(ws + WS_SCNT); unsigned* Sels = (unsigned*)(ws + WS_SCNT + 256 * 1024);
    float* Oslot = (float*)(ws + WS_OSLOT); float* MLslot = (float*)(ws + WS_MLSLOT); float* Sslot = (float*)(ws + WS_SSLOT);
    float* ss0 = (float*)(ctl + CW_SS0); float* ss1 = (float*)(ctl + CW_SS1); float* ss2 = (float*)(ctl + CW_SS2); float* ss3 = (float*)(ctl + CW_SS3);

    {
        TIDS;
        LAS float* scr = (LAS float*)(lds + wave * 16384);
        const int gw = bid * NWAVES + wave, NGW = G * NWAVES;
        constexpr int I_IN = 32 * 256, I_SQ = 32 * 64, I_GU = 32 * 352, I_DN = 88 * 64, I_KV = 32 * 32;
        constexpr int NITEMS = I_IN + I_SQ + 2 * I_GU + 2 * I_DN + I_KV + I_SQ + I_SQ;
        for (int it = gw; it < NITEMS; it += NGW) {
            int r = it;
            if (r < I_IN) { p0_transpose_item(w_in, D, 4 * D, Win_t, 0, 0, norm_mix_a, scr, r, lane); continue; } r -= I_IN;
            if (r < I_SQ) { p0_transpose_item(w_out, D, D, Wout_t, 0, 0, nullptr, scr, r, lane); continue; } r -= I_SQ;
            if (r < I_GU) { p0_transpose_item(w_gu, D, NGU, Wgu0_t, 0, 1, norm_ffn, scr, r, lane); continue; } r -= I_GU;
            if (r < I_GU) { p0_transpose_item(w_gu + (size_t)D * NGU, D, NGU, Wgu1_t, 0, 1, norm_ffn + D, scr, r, lane); continue; } r -= I_GU;
            if (r < I_DN) { p0_transpose_item(w_dn, DFF, D, Wdn0_t, 0, 0, nullptr, scr, r, lane); continue; } r -= I_DN;
            if (r < I_DN) { p0_transpose_item(w_dn + (size_t)DFF * D, DFF, D, Wdn1_t, 0, 0, nullptr, scr, r, lane); continue; } r -= I_DN;
            if (r < I_KV) { p0_transpose_item(w_kv, D, 1024, Wkvq_t, 0, 0, norm_kv, scr, r, lane); continue; } r -= I_KV;
            if (r < I_SQ) { p0_transpose_item(w_q, D, D, Wkvq_t, 1024, 0, norm_mix_b, scr, r, lane); continue; } r -= I_SQ;
            p0_transpose_item(w_o, D, D, Wo_t, 0, 0, nullptr, scr, r, lane);
        }
        for (int m = gw; m < MR; m += NGW) {
            const float* src = (m < SEQ) ? x_p + (size_t)m * D : x_s + (size_t)(m - SEQ) * D;
            const f32x4* xr = (const f32x4*)src + lane; f32x4 v[8]; float s = 0.f;
#pragma unroll
            for (int j = 0; j < 8; ++j) { v[j] = xr[64 * j]; s += (v[j].x * v[j].x + v[j].y * v[j].y) + (v[j].z * v[j].z + v[j].w * v[j].w); }
            s = wave_sum(s);
            if (lane == 0) ss0[m] = s;
            v2u* o8 = (v2u*)(Hb0 + (size_t)m * D) + lane;
#pragma unroll
            for (int j = 0; j < 8; ++j) { v2u w; w.x = pk2(v[j].x, v[j].y); w.y = pk2(v[j].z, v[j].w); o8[64 * j] = w; }
        }
        {
            LAS f32x4* redk = (LAS f32x4*)(lds + 131072);
            for (int item = bid; item < DECB * NBLK; item += G) {
                const int b = item >> 5, n = item & 31; const int c4 = tid & 127, rg = tid >> 7;
                f32x4 a = {0.f, 0.f, 0.f, 0.f};
#pragma unroll
                for (int hp = 0; hp < 2; ++hp) { const int page = ptab[b * NPAGES + 2 * n + hp]; const f32x4* pp = (const f32x4*)(cache_k + (size_t)page * PAGE * 512) + c4;
#pragma unroll 8
                    for (int r = rg; r < 128; r += 4) a += pp[(size_t)r * 128]; }
                redk[rg * 128 + c4] = a;
                __syncthreads();
                if (tid < 128) { const f32x4 s4 = (redk[tid] + redk[128 + tid]) + (redk[256 + tid] + redk[384 + tid]); *(f32x4*)(Kms + (size_t)item * 512 + 4 * tid) = s4 * (1.0f / 256.0f); }
                __syncthreads();
            }
        }
    }
    xcd_barrier(bar);

    {
        TIDS;
        pg8::Gemm g{Hb0, Win_t, MP, 4 * D, D}; pg8::StaticOrder S; S.init(MP, 4 * D, G, bid);
        EpiIn E{ss0, lbl, Qg, Ff};
        pg8::gemm_phase<EpiIn, pg8::StaticOrder, true, true>(lds, g, S, E);
    }
    xcd_barrier(bar);

    {
        TIDS;
        LAS float* tot = (LAS float*)(lds);
        LAS bf16* koT = (LAS bf16*)(lds + 4096);
        LAS bf16* vT = (LAS bf16*)(lds + 4096 + 128 * 72 * 2);
        const int col = tid & 127, part = tid >> 7;
        for (int item = bid; item < NH * NCHUNK; item += G) {
            const int h = item >> 7, c = item & 127; const int row0 = c * 64;
            float cum[16], kk[16]; float run = 0.f;
            const float* fp = Ff + (size_t)(row0 + part * 16) * D + h * 128 + col;
#pragma unroll
            for (int i = 0; i < 16; ++i) { const float f = fp[(size_t)i * D]; kk[i] = 1.0f - f; run += __logf(f); cum[i] = run; }
            tot[part * 128 + col] = run;
            { const int t = tid >> 3, vd0 = (tid & 7) * 16; const bf16* vp = Vg + (size_t)(row0 + t) * D + h * 128 + vd0;
              const v4u a = *(const v4u*)vp, b = *(const v4u*)(vp + 8); unsigned w[8] = {a.x, a.y, a.z, a.w, b.x, b.y, b.z, b.w};
#pragma unroll
              for (int i = 0; i < 8; ++i) { vT[(vd0 + 2 * i) * 72 + t] = (bf16)(w[i] & 0xffffu); vT[(vd0 + 2 * i + 1) * 72 + t] = (bf16)(w[i] >> 16); } }
            __syncthreads();
            float offs = 0.f, lastv = 0.f;
#pragma unroll
            for (int p = 0; p < 4; ++p) { const float tv = tot[p * 128 + col]; lastv += tv; if (p < part) offs += tv; }
            unsigned kw[8];
#pragma unroll
            for (int i = 0; i < 8; ++i) { const float a = kk[2 * i] * __expf(lastv - (cum[2 * i] + offs)), b = kk[2 * i + 1] * __expf(lastv - (cum[2 * i + 1] + offs)); kw[i] = pk2(a, b); }
            *(LAS v4u*)(koT + col * 72 + part * 16) = (v4u){kw[0], kw[1], kw[2], kw[3]};
            *(LAS v4u*)(koT + col * 72 + part * 16 + 8) = (v4u){kw[4], kw[5], kw[6], kw[7]};
            if (part == 0) Dec[(size_t)item * 128 + col] = __expf(lastv);
            __syncthreads();
            { bf16x8 a[2]; a[0] = *(const LAS bf16x8*)(koT + (16 * wave + fr) * 72 + 8 * fq); a[1] = *(const LAS bf16x8*)(koT + (16 * wave + fr) * 72 + 32 + 8 * fq);
              bf16* ub = Ub + (size_t)item * 16384;
#pragma unroll
              for (int vt = 0; vt < 8; ++vt) {
                  f32x4 acc = {0.f, 0.f, 0.f, 0.f};
                  const bf16x8 b0 = *(const LAS bf16x8*)(vT + (16 * vt + fr) * 72 + 8 * fq), b1 = *(const LAS bf16x8*)(vT + (16 * vt + fr) * 72 + 32 + 8 * fq);
                  acc = MFMA16(a[0], b0, acc); acc = MFMA16(a[1], b1, acc);
                  v2u w; w.x = pk2(acc[0], acc[1]); w.y = pk2(acc[2], acc[3]);
                  *(v2u*)(ub + (size_t)(16 * vt + fr) * 128 + 16 * wave + 4 * fq) = w;
              } }
            __syncthreads();
        }
        LAS float* red = (LAS float*)(lds);
        LAS float* red2 = (LAS float*)(lds + 8192);
        float* st_out = out + OST_S;
        for (int item = bid; item < DECB * NH; item += G) {
            const int b = item >> 4, h = item & 15; const int vd = tid & 127, kq = tid >> 7;
            const float* sp = st_in + ((size_t)(b * NH + h) * 128 + 32 * kq) * 128 + vd;
            float Sx[32];
#pragma unroll
            for (int i = 0; i < 32; ++i) Sx[i] = sp[(size_t)i * 128];
#pragma unroll
            for (int t = 0; t < 4; ++t) {
                const int row = SEQ + 4 * b + t; const size_t ro = (size_t)row * D + h * 128;
                const float v = bf2f(Vg[ro + vd]); float op = 0.f;
#pragma unroll
                for (int i = 0; i < 32; ++i) { const float f = Ff[ro + 32 * kq + i]; const float q = bf2f(Qg[ro + 32 * kq + i]); Sx[i] = f * Sx[i] + (1.0f - f) * v; op += Sx[i] * q; }
                red[(t * 4 + kq) * 128 + vd] = op;
            }
            float* so = st_out + ((size_t)(b * NH + h) * 128 + 32 * kq) * 128 + vd;
#pragma unroll
            for (int i = 0; i < 32; ++i) so[(size_t)i * 128] = Sx[i];
            __syncthreads();
            { const int t = tid >> 7; const float o = (red[(t * 4 + 0) * 128 + vd] + red[(t * 4 + 1) * 128 + vd]) + (red[(t * 4 + 2) * 128 + vd] + red[(t * 4 + 3) * 128 + vd]);
              const float s = wave_sum(o * o); if (lane == 0) red2[t * 2 + (wave & 1)] = s;
              __syncthreads();
              const float r = rsqrtf((red2[t * 2] + red2[t * 2 + 1]) * (1.0f / 128.0f) + EPS);
              const int row = SEQ + 4 * b + t; const size_t ro = (size_t)row * D + h * 128 + vd;
              Ob[ro] = (bf16)f2bf(o * r * onorm[vd] * bf2f(Gg[ro])); }
            __syncthreads();
        }
    }
    xcd_barrier(bar);

    {
        TIDS;
        for (int gid = bid * NTHR + tid; gid < NH * 128 * 64; gid += G * NTHR) {
            const int h = gid >> 13, rem = gid & 8191, vd = rem >> 6, k = (rem & 63) * 2;
            float s0 = 0.f, s1 = 0.f;
            const unsigned* up = (const unsigned*)(Ub + ((size_t)h * 128 * 128 + vd) * 128 + k);
            unsigned* sp = (unsigned*)(Sst + ((size_t)h * 128 * 128 + vd) * 128 + k);
            const f32x2* dp = (const f32x2*)(Dec + (size_t)h * 128 * 128 + k);
#pragma unroll 8
            for (int c = 0; c < NCHUNK; ++c) {
                const unsigned u = up[(size_t)c * 8192]; const f32x2 d = dp[(size_t)c * 64];
                sp[(size_t)c * 8192] = pk2(s0, s1);
                s0 = d.x * s0 + bf2f(u & 0xffffu); s1 = d.y * s1 + bf2f(u >> 16);
            }
            out[OST_P + ((size_t)h * 128 + k) * 128 + vd] = s0; out[OST_P + ((size_t)h * 128 + k + 1) * 128 + vd] = s1;
        }
    }
    xcd_barrier(bar);

    {
        TIDS;
        LAS float* tot = (LAS float*)(lds);
        LAS float* refs = (LAS float*)(lds + 2048);
        LAS float* red = (LAS float*)(lds + 2560);
        LAS bf16* QE = (LAS bf16*)(lds + 4096);
        LAS bf16* KE = QE + 64 * 136;
        LAS bf16* QI = KE + 64 * 136;
        LAS bf16* vT = QI + 64 * 136;
        LAS bf16* STs = vT + 128 * 72;
        const int col = tid & 127, part = tid >> 7;
        for (int item = bid; item < NH * NCHUNK; item += G) {
            const int h = item >> 7, c = item & 127; const int row0 = c * 64;
            float cum[16], kk[16], qv[16]; float run = 0.f;
            const float* fp = Ff + (size_t)(row0 + part * 16) * D + h * 128 + col; const bf16* qp = Qg + (size_t)(row0 + part * 16) * D + h * 128 + col;
#pragma unroll
            for (int i = 0; i < 16; ++i) { const float f = fp[(size_t)i * D]; kk[i] = 1.0f - f; run += __logf(f); cum[i] = run; qv[i] = bf2f(qp[(size_t)i * D]); }
            tot[part * 128 + col] = run;
            { const int t = tid >> 3, vd0 = (tid & 7) * 16; const bf16* vp = Vg + (size_t)(row0 + t) * D + h * 128 + vd0;
              const v4u a = *(const v4u*)vp, b = *(const v4u*)(vp + 8); unsigned w[8] = {a.x, a.y, a.z, a.w, b.x, b.y, b.z, b.w};
#pragma unroll
              for (int i = 0; i < 8; ++i) { vT[(vd0 + 2 * i) * 72 + t] = (bf16)(w[i] & 0xffffu); vT[(vd0 + 2 * i + 1) * 72 + t] = (bf16)(w[i] >> 16); } }
            { const v4u* sp = (const v4u*)(Sst + (size_t)item * 16384);
#pragma unroll
              for (int i = 0; i < 4; ++i) { const int idx = i * 512 + tid, vd = idx >> 4, k8 = idx & 15; *(LAS v4u*)(STs + vd * 136 + k8 * 8) = sp[idx]; } }
            __syncthreads();
            float offs = 0.f;
#pragma unroll
            for (int p = 0; p < 4; ++p) { const float tv = tot[p * 128 + col]; if (p < part) offs += tv; }
            if (part == 1) refs[col] = cum[15] + offs;
            __syncthreads();
            const float ref = refs[col];
#pragma unroll
            for (int i = 0; i < 16; ++i) { const float cm = cum[i] + offs, d1 = cm - ref; const int t = part * 16 + i;
                QE[t * 136 + col] = (bf16)f2bf(qv[i] * __expf(d1)); KE[t * 136 + col] = (bf16)f2bf(kk[i] * __expf(-d1)); QI[t * 136 + col] = (bf16)f2bf(qv[i] * __expf(cm)); }
            __syncthreads();
            {
                const int tt = wave & 3, vh = wave >> 2;
                f32x4 aS[4];
#pragma unroll
                for (int st = 0; st < 4; ++st) {
                    aS[st] = (f32x4){0.f, 0.f, 0.f, 0.f};
                    if (st <= tt) {
#pragma unroll
                        for (int ks = 0; ks < 4; ++ks) { const bf16x8 a = *(const LAS bf16x8*)(KE + (16 * st + fr) * 136 + 32 * ks + 8 * fq), b = *(const LAS bf16x8*)(QE + (16 * tt + fr) * 136 + 32 * ks + 8 * fq); aS[st] = MFMA16(a, b, aS[st]); }
                        if (st == tt) {
#pragma unroll
                            for (int r = 0; r < 4; ++r) if (4 * fq + r > fr) aS[st][r] = 0.f;
                        }
                    }
                }
                f32x4 o[4];
#pragma unroll
                for (int vt = 0; vt < 4; ++vt) o[vt] = (f32x4){0.f, 0.f, 0.f, 0.f};
#pragma unroll
                for (int j = 0; j < 2; ++j) {
                    v4u pw; pw.x = cvt_pk_bf16(aS[2 * j][0], aS[2 * j][1]); pw.y = cvt_pk_bf16(aS[2 * j][2], aS[2 * j][3]); pw.z = cvt_pk_bf16(aS[2 * j + 1][0], aS[2 * j + 1][1]); pw.w = cvt_pk_bf16(aS[2 * j + 1][2], aS[2 * j + 1][3]);
                    const bf16x8 pf = __builtin_bit_cast(bf16x8, pw);
#pragma unroll
                    for (int vt = 0; vt < 4; ++vt) { const LAS bf16* vp = vT + (16 * (4 * vh + vt) + fr) * 72 + 32 * j + 4 * fq;
                        const v2u lo = *(const LAS v2u*)vp, hi = *(const LAS v2u*)(vp + 16); const v4u aw = {lo.x, lo.y, hi.x, hi.y};
                        o[vt] = MFMA16(__builtin_bit_cast(bf16x8, aw), pf, o[vt]); }
                }
#pragma unroll
                for (int ks = 0; ks < 4; ++ks) { const bf16x8 b = *(const LAS bf16x8*)(QI + (16 * tt + fr) * 136 + 32 * ks + 8 * fq);
#pragma unroll
                    for (int vt = 0; vt < 4; ++vt) { const bf16x8 a = *(const LAS bf16x8*)(STs + (16 * (4 * vh + vt) + fr) * 136 + 32 * ks + 8 * fq); o[vt] = MFMA16(a, b, o[vt]); } }
                float sq = 0.f;
#pragma unroll
                for (int vt = 0; vt < 4; ++vt) sq += (o[vt][0] * o[vt][0] + o[vt][1] * o[vt][1]) + (o[vt][2] * o[vt][2] + o[vt][3] * o[vt][3]);
                sq += __shfl_xor(sq, 16); sq += __shfl_xor(sq, 32);
                if (fq == 0) red[(16 * tt + fr) * 2 + vh] = sq;
                __syncthreads();
                const float r = rsqrtf((red[(16 * tt + fr) * 2] + red[(16 * tt + fr) * 2 + 1]) * (1.0f / 128.0f) + EPS);
                const size_t ro = (size_t)(row0 + 16 * tt + fr) * D + h * 128;
#pragma unroll
                for (int vt = 0; vt < 4; ++vt) { const int vd = 16 * (4 * vh + vt) + 4 * fq;
                    const v2u gw2 = *(const v2u*)(Gg + ro + vd); const f32x4 on = *(const f32x4*)(onorm + vd);
                    const float g0 = bf2f(gw2.x & 0xffffu), g1 = bf2f(gw2.x >> 16), g2 = bf2f(gw2.y & 0xffffu), g3 = bf2f(gw2.y >> 16);
                    v2u w; w.x = cvt_pk_bf16(o[vt][0] * r * on[0] * g0, o[vt][1] * r * on[1] * g1); w.y = cvt_pk_bf16(o[vt][2] * r * on[2] * g2, o[vt][3] * r * on[3] * g3);
                    *(v2u*)(Ob + ro + vd) = w; }
            }
            __syncthreads();
        }
    }
    xcd_barrier(bar);

    {
        TIDS;
        pg8::Gemm g{Ob, Wout_t, MP, D, D}; pg8::StaticOrder S; S.init(MP, D, G, bid);
        EpiRes<0> E{x_p, x_s, Hf1, nullptr, Hb1, ss1};
        pg8::gemm_phase<EpiRes<0>, pg8::StaticOrder, true, true>(lds, g, S, E);
    }
    xcd_barrier(bar);
    {
        TIDS;
        pg8::Gemm g{Hb1, Wgu0_t, MP, NGU, D}; pg8::StaticOrder S; S.init(MP, NGU, G, bid);
        EpiGU E{ss1, Hm};
        pg8::gemm_phase<EpiGU, pg8::StaticOrder, true, true>(lds, g, S, E);
    }
    xcd_barrier(bar);
    {
        TIDS;
        pg8::Gemm g{Hm, Wdn0_t, MP, D, DFF}; pg8::StaticOrder S; S.init(MP, D, G, bid);
        EpiRes<1> E{Hf1, nullptr, Hf2, nullptr, Hb2, ss2};
        pg8::gemm_phase<EpiRes<1>, pg8::StaticOrder, true, true>(lds, g, S, E);
    }
    xcd_barrier(bar);
    {
        TIDS;
        pg8::Gemm g{Hb2, Wkvq_t, MP, 3072, D}; pg8::StaticOrder S; S.init(MP, 3072, G, bid);
        EpiKVQ E{ss2, ws};
        pg8::gemm_phase<EpiKVQ, pg8::StaticOrder, true, true>(lds, g, S, E);
    }
    xcd_barrier(bar);

    {
        TIDS;
        LAS float* partk = (LAS float*)(lds);
        LAS bf16* vtile = (LAS bf16*)(lds + 16384);
        for (int grp = bid; grp < MR / 32; grp += G) {
            const int r0 = grp * 32; float cs[8];
#pragma unroll
            for (int j = 0; j < 8; ++j) cs[j] = 0.f;
#pragma unroll
            for (int i = 0; i < 4; ++i) {
                const int row = r0 + 4 * wave + i; const int c = lane * 8;
                const f32x4 k0 = *(const f32x4*)(Kraw + (size_t)row * 512 + c), k1 = *(const f32x4*)(Kraw + (size_t)row * 512 + c + 4);
                float sq = (k0[0] * k0[0] + k0[1] * k0[1]) + (k0[2] * k0[2] + k0[3] * k0[3]) + (k1[0] * k1[0] + k1[1] * k1[1]) + (k1[2] * k1[2] + k1[3] * k1[3]);
                sq += __shfl_xor(sq, 1); sq += __shfl_xor(sq, 2); sq += __shfl_xor(sq, 4); sq += __shfl_xor(sq, 8);
                const float rk = rsqrtf(sq * (1.0f / 128.0f) + EPS);
                const f32x4 g0 = *(const f32x4*)(k_norm + (c & 127)), g1 = *(const f32x4*)(k_norm + (c & 127) + 4);
                const f32x4 n0 = k0 * rk * g0, n1 = k1 * rk * g1;
                float* ko = (row < SEQ) ? out + OK_P + (size_t)row * 512 + c : out + OK_S + (size_t)(row - SEQ) * 512 + c;
                *(f32x4*)ko = n0; *(f32x4*)(ko + 4) = n1;
                v4u w; w.x = cvt_pk_bf16(n0[0], n0[1]); w.y = cvt_pk_bf16(n0[2], n0[3]); w.z = cvt_pk_bf16(n1[0], n1[1]); w.w = cvt_pk_bf16(n1[2], n1[3]);
                *(v4u*)(Kb + (size_t)row * 512 + c) = w;
#pragma unroll
                for (int j = 0; j < 4; ++j) { cs[j] += n0[j]; cs[4 + j] += n1[j]; }
                const f32x4 v0 = *(const f32x4*)(Vraw + (size_t)row * 512 + c), v1 = *(const f32x4*)(Vraw + (size_t)row * 512 + c + 4);
                float* vo = (row < SEQ) ? out + OV_P + (size_t)row * 512 + c : out + OV_S + (size_t)(row - SEQ) * 512 + c;
                *(f32x4*)vo = v0; *(f32x4*)(vo + 4) = v1;
                v4u wv; wv.x = cvt_pk_bf16(v0[0], v0[1]); wv.y = cvt_pk_bf16(v0[2], v0[3]); wv.z = cvt_pk_bf16(v1[0], v1[1]); wv.w = cvt_pk_bf16(v1[2], v1[3]);
                *(LAS v4u*)(vtile + (4 * wave + i) * 520 + c) = wv;
            }
#pragma unroll
            for (int j = 0; j < 8; ++j) partk[wave * 512 + lane * 8 + j] = cs[j];
            __syncthreads();
            if (r0 < SEQ) {
                float s = 0.f;
#pragma unroll
                for (int w8 = 0; w8 < 8; ++w8) s += partk[w8 * 512 + tid];
                Kpart[(size_t)grp * 512 + tid] = s;
                unsigned wv[16];
#pragma unroll
                for (int i = 0; i < 16; ++i) wv[i] = (unsigned)vtile[(2 * i) * 520 + tid] | ((unsigned)vtile[(2 * i + 1) * 520 + tid] << 16);
                v4u* dst = (v4u*)(VbT + (size_t)tid * SEQ + r0);
                dst[0] = (v4u){wv[0], wv[1], wv[2], wv[3]}; dst[1] = (v4u){wv[4], wv[5], wv[6], wv[7]}; dst[2] = (v4u){wv[8], wv[9], wv[10], wv[11]}; dst[3] = (v4u){wv[12], wv[13], wv[14], wv[15]};
            }
            __syncthreads();
        }
        for (int row = bid * NWAVES + wave; row < MR; row += G * NWAVES) {
#pragma unroll
            for (int j = 0; j < 4; ++j) {
                const int c = j * 512 + lane * 8;
                const f32x4 q0 = *(const f32x4*)(Qraw + (size_t)row * D + c), q1 = *(const f32x4*)(Qraw + (size_t)row * D + c + 4);
                float sq = (q0[0] * q0[0] + q0[1] * q0[1]) + (q0[2] * q0[2] + q0[3] * q0[3]) + (q1[0] * q1[0] + q1[1] * q1[1]) + (q1[2] * q1[2] + q1[3] * q1[3]);
                sq += __shfl_xor(sq, 1); sq += __shfl_xor(sq, 2); sq += __shfl_xor(sq, 4); sq += __shfl_xor(sq, 8);
                const float rq = rsqrtf(sq * (1.0f / 128.0f) + EPS) * C2;
                const f32x4 g0 = *(const f32x4*)(q_norm + (c & 127)), g1 = *(const f32x4*)(q_norm + (c & 127) + 4);
                const f32x4 n0 = q0 * rq * g0, n1 = q1 * rq * g1;
                v4u w; w.x = cvt_pk_bf16(n0[0], n0[1]); w.y = cvt_pk_bf16(n0[2], n0[3]); w.z = cvt_pk_bf16(n1[0], n1[1]); w.w = cvt_pk_bf16(n1[2], n1[3]);
                *(v4u*)(Qb + (size_t)row * D + c) = w;
            }
        }
    }
    xcd_barrier(bar);

    {
        TIDS;
        LAS float* KM = (LAS float*)(lds);
        LAS unsigned* lcnt = (LAS unsigned*)(lds + 16384);
        LAS float* gs = (LAS float*)(lds + 16384 + 256);
        for (int item = bid; item < 256; item += G) {
            const int j = item >> 2, kvh = item & 3; const int b = j >> 1;
            { const int n = tid >> 4, d8 = (tid & 15) * 8; f32x4 s0 = {0.f, 0.f, 0.f, 0.f}, s1 = {0.f, 0.f, 0.f, 0.f};
              if (n < b) {
#pragma unroll
                  for (int sub = 0; sub < 8; ++sub) { const float* kp = Kpart + (size_t)(n * 8 + sub) * 512 + kvh * 128 + d8; s0 += *(const f32x4*)kp; s1 += *(const f32x4*)(kp + 4); } }
              *(LAS f32x4*)(KM + n * 128 + d8) = s0 * (1.0f / 256.0f); *(LAS f32x4*)(KM + n * 128 + d8 + 4) = s1 * (1.0f / 256.0f); }
            if (tid < 32) lcnt[tid] = 0u;
            __syncthreads();
            const int tok = j * 128 + (tid >> 2), hg = tid & 3; const bf16* qp = Qb + (size_t)tok * D + (4 * kvh + hg) * 128;
            v4u qw[16];
#pragma unroll
            for (int dc = 0; dc < 16; ++dc) qw[dc] = *(const v4u*)(qp + dc * 8);
            float v0 = -INFINITY, v1 = -INFINITY, v2 = -INFINITY; int i0 = 0, i1 = 0, i2 = 0;
#pragma unroll 1
            for (int n = 0; n < b; ++n) {
                float g = 0.f;
#pragma unroll
                for (int dc = 0; dc < 16; ++dc) { const f32x4 k0 = *(const LAS f32x4*)(KM + n * 128 + dc * 8), k1 = *(const LAS f32x4*)(KM + n * 128 + dc * 8 + 4);
                    g += (bf2f(qw[dc].x & 0xffffu) * k0[0] + bf2f(qw[dc].x >> 16) * k0[1]) + (bf2f(qw[dc].y & 0xffffu) * k0[2] + bf2f(qw[dc].y >> 16) * k0[3])
                       + (bf2f(qw[dc].z & 0xffffu) * k1[0] + bf2f(qw[dc].z >> 16) * k1[1]) + (bf2f(qw[dc].w & 0xffffu) * k1[2] + bf2f(qw[dc].w >> 16) * k1[3]); }
                if (g > v0) { v2 = v1; i2 = i1; v1 = v0; i1 = i0; v0 = g; i0 = n; }
                else if (g > v1) { v2 = v1; i2 = i1; v1 = g; i1 = n; }
                else if (g > v2) { v2 = g; i2 = n; }
            }
            const int nsel = b < 3 ? b : 3;
#pragma unroll
            for (int r = 0; r < 3; ++r) {
                if (r < nsel) { const int best = (r == 0) ? i0 : ((r == 1) ? i1 : i2);
                    const unsigned pos = atomicAdd((unsigned*)&lcnt[best], 1u);
                    Subl[((size_t)(j * 4 + kvh) * 32 + best) * 512 + pos] = (unsigned)tid | ((unsigned)r << 9); }
            }
            __syncthreads();
            if (tid < 32) Scnt[(j * 4 + kvh) * 32 + tid] = lcnt[tid];
            __syncthreads();
        }
        for (int item = bid; item < DECB * NKV; item += G) {
            const int b = item >> 2, kvh = item & 3; const int pr = tid >> 5, n = tid & 31;
            const int row = SEQ + 4 * b + (pr >> 2), hg = pr & 3; const bf16* qp = Qb + (size_t)row * D + (4 * kvh + hg) * 128; const float* kmp = Kms + ((size_t)(b * 32 + n)) * 512 + kvh * 128;
            float s = 0.f;
#pragma unroll 4
            for (int d = 0; d < 128; d += 8) { const v4u qw = *(const v4u*)(qp + d); const f32x4 k0 = *(const f32x4*)(kmp + d), k1 = *(const f32x4*)(kmp + d + 4);
                s += (bf2f(qw.x & 0xffffu) * k0[0] + bf2f(qw.x >> 16) * k0[1]) + (bf2f(qw.y & 0xffffu) * k0[2] + bf2f(qw.y >> 16) * k0[3]) + (bf2f(qw.z & 0xffffu) * k1[0] + bf2f(qw.z >> 16) * k1[1]) + (bf2f(qw.w & 0xffffu) * k1[2] + bf2f(qw.w >> 16) * k1[3]); }
            gs[pr * 32 + n] = s;
            __syncthreads();
            if (tid < 16) { unsigned m = 0u;
                for (int r = 0; r < 3; ++r) { int best = 0; float bv = -INFINITY; for (int nn = 0; nn < 32; ++nn) { const float v = gs[tid * 32 + nn]; if (v > bv) { bv = v; best = nn; } } m |= 1u << best; gs[tid * 32 + best] = -INFINITY; }
                Sels[item * 16 + tid] = m; }
            __syncthreads();
        }
    }
    xcd_barrier(bar);

    {
        TIDS;
        LAS bf16* Ks = (LAS bf16*)(lds); LAS bf16* Vs = (LAS bf16*)(lds + KS_BYTES);
        LAS unsigned* qsh = (LAS unsigned*)(lds + KS_BYTES + VS_BYTES);
        constexpr int NPI = 4 * 496, NSI = DECB * NKV * NBLK;
        for (;;) {
            if (tid == 0) qsh[0] = __hip_atomic_fetch_add(ctl + CW_Q0, 1u, __ATOMIC_RELAXED, __HIP_MEMORY_SCOPE_AGENT);
            __syncthreads();
            const int item = (int)qsh[0];
            __syncthreads();
            if (item >= NPI + NSI) break;
            if (item < NPI) {
                int b = (int)((1.0f + sqrtf(1.0f + 2.0f * (float)item)) * 0.5f); while (2 * b * (b - 1) > item) --b; while (2 * (b + 1) * b <= item) ++b;
                const int rem = item - 2 * b * (b - 1); const int n = rem >> 2, kvh = rem & 3;
                const int cntA = (int)Scnt[((2 * b) * 4 + kvh) * 32 + n], cntB = (int)Scnt[((2 * b + 1) * 4 + kvh) * 32 + n]; const int total = cntA + cntB;
                if (total == 0) continue;
#pragma unroll
                for (int i = 0; i < 8; ++i) { const int idx = i * 512 + tid, key = idx >> 4, c8 = idx & 15; *(LAS v4u*)(Ks + key * KS_P + c8 * 8) = *(const v4u*)(Kb + (size_t)(256 * n + key) * 512 + kvh * 128 + c8 * 8); }
#pragma unroll
                for (int i = 0; i < 8; ++i) { const int idx = i * 512 + tid, vd = idx >> 5, c8 = idx & 31; *(LAS v4u*)(Vs + vd * VS_P + c8 * 8) = *(const v4u*)(VbT + (size_t)(kvh * 128 + vd) * SEQ + 256 * n + c8 * 8); }
                __syncthreads();
                const unsigned* LA = Subl + ((size_t)((2 * b) * 4 + kvh) * 32 + n) * 512; const unsigned* LB = Subl + ((size_t)((2 * b + 1) * 4 + kvh) * 32 + n) * 512;
                for (int t0 = 0; t0 < total; t0 += 128) {
                    const int i0 = t0 + 16 * wave; if (i0 >= total) continue;
                    int i = i0 + fr; const bool valid = i < total; if (!valid) i = total - 1;
                    const unsigned e = (i < cntA) ? LA[i] : LB[i - cntA];
                    const int tok = ((i < cntA) ? 2 * b : 2 * b + 1) * 128 + (int)((e >> 2) & 127u), hg = (int)(e & 3u), rk = (int)(e >> 9);
                    const int h = 4 * kvh + hg; const bf16* qp = Qb + (size_t)tok * D + h * 128 + 8 * fq;
                    bf16x8 qf[4];
#pragma unroll
                    for (int ks = 0; ks < 4; ++ks) qf[ks] = *(const bf16x8*)(qp + 32 * ks);
                    f32x4 acc[16]; attn_scores<16>(Ks, qf, acc, 16, fr, fq);
                    float mx = -INFINITY;
#pragma unroll
                    for (int kt = 0; kt < 16; ++kt) mx = fmaxf(fmaxf(mx, fmaxf(acc[kt][0], acc[kt][1])), fmaxf(acc[kt][2], acc[kt][3]));
                    mx = fmaxf(mx, __shfl_xor(mx, 16)); mx = fmaxf(mx, __shfl_xor(mx, 32));
                    float l = 0.f;
#pragma unroll
                    for (int kt = 0; kt < 16; ++kt) {
#pragma unroll
                        for (int r = 0; r < 4; ++r) { const float p = __builtin_amdgcn_exp2f(acc[kt][r] - mx); acc[kt][r] = p; l += p; } }
                    l += __shfl_xor(l, 16); l += __shfl_xor(l, 32);
                    f32x4 O[8];
#pragma unroll
                    for (int vt = 0; vt < 8; ++vt) O[vt] = (f32x4){0.f, 0.f, 0.f, 0.f};
                    attn_pv(Vs, acc, O, 8, fr, fq);
                    if (valid) {
                        const size_t slot = ((size_t)tok * NH + h) * 3 + rk; float* op = Oslot + slot * 128 + 4 * fq;
#pragma unroll
                        for (int vt = 0; vt < 8; ++vt) *(f32x4*)(op + 16 * vt) = O[vt];
                        if (fq == 0) { MLslot[slot * 2] = mx; MLslot[slot * 2 + 1] = l; }
                    }
                }
                __syncthreads();
            } else {
                const int si = item - NPI; const int b = si >> 7, kvh = (si >> 5) & 3, n = si & 31;
                unsigned any = 0u;
#pragma unroll
                for (int p = 0; p < 16; ++p) any |= Sels[(b * 4 + kvh) * 16 + p];
                if (!((any >> n) & 1u)) continue;
                const int pg0 = ptab[b * NPAGES + 2 * n], pg1 = ptab[b * NPAGES + 2 * n + 1];
#pragma unroll 4
                for (int i = 0; i < 16; ++i) { const int idx = i * 512 + tid, key = idx >> 5, c4 = idx & 31; const int page = (key < 128) ? pg0 : pg1;
                    const size_t go = (((size_t)page * PAGE + (key & 127)) * NKV + kvh) * 128 + c4 * 4;
                    const f32x4 kk4 = *(const f32x4*)(cache_k + go), vv4 = *(const f32x4*)(cache_v + go);
                    v2u w; w.x = cvt_pk_bf16(kk4[0], kk4[1]); w.y = cvt_pk_bf16(kk4[2], kk4[3]); *(LAS v2u*)(Ks + key * KS_P + c4 * 4) = w;
                    Vs[(c4 * 4 + 0) * VS_P + key] = (bf16)f2bf(vv4[0]); Vs[(c4 * 4 + 1) * VS_P + key] = (bf16)f2bf(vv4[1]); Vs[(c4 * 4 + 2) * VS_P + key] = (bf16)f2bf(vv4[2]); Vs[(c4 * 4 + 3) * VS_P + key] = (bf16)f2bf(vv4[3]); }
                __syncthreads();
                if (wave == 0) {
                    const int row = SEQ + 4 * b + (fr >> 2), hg = fr & 3; const int h = 4 * kvh + hg; const bf16* qp = Qb + (size_t)row * D + h * 128 + 8 * fq;
                    bf16x8 qf[4];
#pragma unroll
                    for (int ks = 0; ks < 4; ++ks) qf[ks] = *(const bf16x8*)(qp + 32 * ks);
                    f32x4 acc[16]; attn_scores<16>(Ks, qf, acc, 16, fr, fq);
                    float mx = -INFINITY;
#pragma unroll
                    for (int kt = 0; kt < 16; ++kt) mx = fmaxf(fmaxf(mx, fmaxf(acc[kt][0], acc[kt][1])), fmaxf(acc[kt][2], acc[kt][3]));
                    mx = fmaxf(mx, __shfl_xor(mx, 16)); mx = fmaxf(mx, __shfl_xor(mx, 32));
                    float l = 0.f;
#pragma unroll
                    for (int kt = 0; kt < 16; ++kt) {
#pragma unroll
                        for (int r = 0; r < 4; ++r) { const float p = __builtin_amdgcn_exp2f(acc[kt][r] - mx); acc[kt][r] = p; l += p; } }
                    l += __shfl_xor(l, 16); l += __shfl_xor(l, 32);
                    f32x4 O[8];
#pragma unroll
                    for (int vt = 0; vt < 8; ++vt) O[vt] = (f32x4){0.f, 0.f, 0.f, 0.f};
                    attn_pv(Vs, acc, O, 8, fr, fq);
                    float* sp = Sslot + ((size_t)((b * 4 + kvh) * 32 + n) * 16 + fr) * 132;
#pragma unroll
                    for (int vt = 0; vt < 8; ++vt) *(f32x4*)(sp + 16 * vt + 4 * fq) = O[vt];
                    if (fq == 0) { sp[128] = mx; sp[129] = l; }
                }
                __syncthreads();
            }
        }
    }
    xcd_barrier(bar);

    {
        TIDS;
        LAS bf16* Ks = (LAS bf16*)(lds); LAS bf16* Vs = (LAS bf16*)(lds + KS_BYTES);
        for (int item = bid; item < NBLK * NH * 2; item += G) {
            const int b = item >> 5, h = (item >> 1) & 15, half = item & 1; const int kvh = h >> 2; const int nkeys = 128 * (half + 1);
#pragma unroll
            for (int i = 0; i < 8; ++i) { const int idx = i * 512 + tid, key = idx >> 4, c8 = idx & 15; if (key < nkeys) *(LAS v4u*)(Ks + key * KS_P + c8 * 8) = *(const v4u*)(Kb + (size_t)(256 * b + key) * 512 + kvh * 128 + c8 * 8); }
#pragma unroll
            for (int i = 0; i < 8; ++i) { const int idx = i * 512 + tid, vd = idx >> 5, c8 = idx & 31; if (c8 * 8 < nkeys) *(LAS v4u*)(Vs + vd * VS_P + c8 * 8) = *(const v4u*)(VbT + (size_t)(kvh * 128 + vd) * SEQ + 256 * b + c8 * 8); }
            __syncthreads();
            {
                const int tl = 128 * half + 16 * wave + fr; const int tok = 256 * b + tl; const bf16* qp = Qb + (size_t)tok * D + h * 128 + 8 * fq;
                bf16x8 qf[4];
#pragma unroll
                for (int ks = 0; ks < 4; ++ks) qf[ks] = *(const bf16x8*)(qp + 32 * ks);
                const int nkt = 8 * half + wave + 1;
                f32x4 acc[16]; attn_scores<16>(Ks, qf, acc, nkt, fr, fq);
                float mx = -INFINITY;
#pragma unroll
                for (int kt = 0; kt < 16; ++kt) {
#pragma unroll
                    for (int r = 0; r < 4; ++r) { const bool ok = (kt < nkt) && (16 * kt + 4 * fq + r <= tl); const float s = ok ? acc[kt][r] : -INFINITY; acc[kt][r] = s; mx = fmaxf(mx, s); } }
                mx = fmaxf(mx, __shfl_xor(mx, 16)); mx = fmaxf(mx, __shfl_xor(mx, 32));
                const int nsel = b < 3 ? b : 3; float ms[3], ls[3]; float M = mx;
#pragma unroll
                for (int r = 0; r < 3; ++r) { ms[r] = -INFINITY; ls[r] = 0.f; if (r < nsel) { const size_t slot = ((size_t)tok * NH + h) * 3 + r; ms[r] = MLslot[slot * 2]; ls[r] = MLslot[slot * 2 + 1]; M = fmaxf(M, ms[r]); } }
                float l = 0.f;
#pragma unroll
                for (int kt = 0; kt < 16; ++kt) {
#pragma unroll
                    for (int r = 0; r < 4; ++r) { const float p = __builtin_amdgcn_exp2f(acc[kt][r] - M); acc[kt][r] = p; l += p; } }
                l += __shfl_xor(l, 16); l += __shfl_xor(l, 32);
                f32x4 O[8];
#pragma unroll
                for (int vt = 0; vt < 8; ++vt) O[vt] = (f32x4){0.f, 0.f, 0.f, 0.f};
                attn_pv(Vs, acc, O, (nkt + 1) >> 1, fr, fq);
#pragma unroll
                for (int r = 0; r < 3; ++r) { if (r < nsel) { const float sc = __builtin_amdgcn_exp2f(ms[r] - M); l += ls[r] * sc; const size_t slot = ((size_t)tok * NH + h) * 3 + r; const float* op = Oslot + slot * 128 + 4 * fq;
#pragma unroll
                    for (int vt = 0; vt < 8; ++vt) O[vt] += *(const f32x4*)(op + 16 * vt) * sc; } }
                const float il = 1.0f / l; bf16* ap = At + (size_t)tok * D + h * 128 + 4 * fq;
#pragma unroll
                for (int vt = 0; vt < 8; ++vt) { v2u w; w.x = cvt_pk_bf16(O[vt][0] * il, O[vt][1] * il); w.y = cvt_pk_bf16(O[vt][2] * il, O[vt][3] * il); *(v2u*)(ap + 16 * vt) = w; }
            }
            __syncthreads();
        }
        LAS float* ksn = (LAS float*)(lds);
        for (int item = bid; item < DECB * NKV; item += G) {
            const int b = item >> 2, kvh = item & 3;
            { const int key = tid >> 7, d = tid & 127; ksn[key * 128 + d] = out[OK_S + (size_t)(4 * b + key) * 512 + kvh * 128 + d]; ksn[512 + key * 128 + d] = Vraw[(size_t)(SEQ + 4 * b + key) * 512 + kvh * 128 + d]; }
            __syncthreads();
            const int pr = tid >> 5, l32 = tid & 31; const int t = pr >> 2, hg = pr & 3; const int row = SEQ + 4 * b + t, h = 4 * kvh + hg;
            const v2u qw = *(const v2u*)(Qb + (size_t)row * D + h * 128 + 4 * l32);
            const float q0 = bf2f(qw.x & 0xffffu), q1 = bf2f(qw.x >> 16), q2 = bf2f(qw.y & 0xffffu), q3 = bf2f(qw.y >> 16);
            float sk[4]; float M = -INFINITY;
#pragma unroll
            for (int key = 0; key < 4; ++key) { const f32x4 k4 = *(const LAS f32x4*)(ksn + key * 128 + 4 * l32); float s = (q0 * k4[0] + q1 * k4[1]) + (q2 * k4[2] + q3 * k4[3]);
                s += __shfl_xor(s, 1); s += __shfl_xor(s, 2); s += __shfl_xor(s, 4); s += __shfl_xor(s, 8); s += __shfl_xor(s, 16);
                sk[key] = (key <= t) ? s : -INFINITY; M = fmaxf(M, sk[key]); }
            const unsigned mask = Sels[item * 16 + pr];
#pragma unroll 1
            for (int n = 0; n < 32; ++n) if ((mask >> n) & 1u) M = fmaxf(M, Sslot[((size_t)(item * 32 + n) * 16 + pr) * 132 + 128]);
            float l = 0.f; f32x4 O = {0.f, 0.f, 0.f, 0.f};
#pragma unroll
            for (int key = 0; key < 4; ++key) { const float p = __builtin_amdgcn_exp2f(sk[key] - M); l += p; O += *(const LAS f32x4*)(ksn + 512 + key * 128 + 4 * l32) * p; }
#pragma unroll 1
            for (int n = 0; n < 32; ++n) if ((mask >> n) & 1u) { const float* sp = Sslot + ((size_t)(item * 32 + n) * 16 + pr) * 132; const float sc = __builtin_amdgcn_exp2f(sp[128] - M); l += sp[129] * sc; O += *(const f32x4*)(sp + 4 * l32) * sc; }
            const float il = 1.0f / l; v2u w; w.x = cvt_pk_bf16(O[0] * il, O[1] * il); w.y = cvt_pk_bf16(O[2] * il, O[3] * il);
            *(v2u*)(At + (size_t)row * D + h * 128 + 4 * l32) = w;
            __syncthreads();
        }
    }
    xcd_barrier(bar);

    {
        TIDS;
        pg8::Gemm g{At, Wo_t, MP, D, D}; pg8::StaticOrder S; S.init(MP, D, G, bid);
        EpiRes<1> E{Hf2, nullptr, Hf3, nullptr, Hb3, ss3};
        pg8::gemm_phase<EpiRes<1>, pg8::StaticOrder, true, true>(lds, g, S, E);
    }
    xcd_barrier(bar);
    {
        TIDS;
        pg8::Gemm g{Hb3, Wgu1_t, MP, NGU, D}; pg8::StaticOrder S; S.init(MP, NGU, G, bid);
        EpiGU E{ss3, Hm};
        pg8::gemm_phase<EpiGU, pg8::StaticOrder, true, true>(lds, g, S, E);
    }
    xcd_barrier(bar);
    {
        TIDS;
        pg8::Gemm g{Hm, Wdn1_t, MP, D, DFF}; pg8::StaticOrder S; S.init(MP, D, G, bid);
        EpiRes<2> E{Hf3, nullptr, out + OY_P, out + OY_S, nullptr, nullptr};
        pg8::gemm_phase<EpiRes<2>, pg8::StaticOrder, true, true>(lds, g, S, E);
    }
}

extern "C" void kernel_launch(void* const* d_in, const int* in_sizes, int n_in, void* d_out, int out_size, void* d_ws, size_t ws_size, hipStream_t stream) {
    static int grid = 0;
    if (grid == 0) {
        if (n_in != 21 || ws_size < WS_END) { fprintf(stderr, "kernel_launch: unexpected n_in %d / ws %zu\n", n_in, ws_size); grid = -1; return; }
        int dev = 0, cus = 0, per_cu = 0;
        if (hipGetDevice(&dev) != hipSuccess || hipDeviceGetAttribute(&cus, hipDeviceAttributeMultiprocessorCount, dev) != hipSuccess) { grid = -1; return; }
        if (hipFuncSetAttribute((const void*)yoco_fwd, hipFuncAttributeMaxDynamicSharedMemorySize, LDS_BYTES) != hipSuccess) { fprintf(stderr, "kernel_launch: hipFuncSetAttribute failed\n"); grid = -1; return; }
        if (hipOccupancyMaxActiveBlocksPerMultiprocessor(&per_cu, (const void*)yoco_fwd, NTHR, LDS_BYTES) != hipSuccess || per_cu < 1) fprintf(stderr, "kernel_launch: occupancy query says %d\n", per_cu);
        (void)hipGetLastError();
        grid = cus;
    }
    if (grid < 0) return;
    (void)hipMemsetAsync((char*)d_ws + WS_CTL, 0, CTL_ZERO_BYTES, stream);
    Args a{};
    for (int i = 0; i < 21; ++i) a.in[i] = d_in[i];
    a.out = (float*)d_out; a.ws = (unsigned char*)d_ws;
    hipLaunchKernelGGL(yoco_fwd, dim3(grid), dim3(NTHR), LDS_BYTES, stream, a);
}
```

```cpp
#include <hip/hip_runtime.h>
#include <cstdio>
#include <cstdint>
__device__ __forceinline__ int lane_id() { int l = (int)__builtin_amdgcn_mbcnt_hi(~0u, __builtin_amdgcn_mbcnt_lo(~0u, 0u)); asm volatile("" : "+v"(l)); return l; }

namespace pg8 {
#define PG8_LAS __attribute__((address_space(3)))
typedef unsigned short bf16_t;
typedef short bf16x8 __attribute__((ext_vector_type(8)));
typedef float f32x4 __attribute__((ext_vector_type(4)));
typedef unsigned u32x4 __attribute__((ext_vector_type(4)));
typedef unsigned u32x2 __attribute__((ext_vector_type(2)));
constexpr int BM = 256, BK = 64, HALF = 128, HTB = HALF * BK * 2, STAGE_BYTES = 8 * HTB, NXCD = 8, WGM = 8;

__host__ __device__ __forceinline__ int lds_byte(int r, int c) { const int st = (r >> 4) * 2 + (c >> 5), rr = r & 15, cc = c & 31, ob = rr * 64 + cc * 2; return st * 1024 + (ob ^ (((ob >> 9) & 1) << 5)); }
__host__ __device__ __forceinline__ void stage_rc(int b, int& R, int& C) { const int st = b / 1024, sb = b % 1024, swz = sb ^ (((sb >> 9) & 1) << 5); R = (st >> 1) * 16 + swz / 64; C = (st & 1) * 32 + (swz % 64) / 2; }
__host__ __device__ __forceinline__ int perm32(int rho) { const int n = rho >> 4, i = rho & 15; return 8 * (i >> 2) + 4 * n + (i & 3); }

struct Unit { int pm, pn; };
struct Gemm { const bf16_t* A; const bf16_t* Bt; int M, N, K; };

struct StaticOrder {
    int nM, nN, nwg, G, c;
    __host__ __device__ void init(int M, int N, int G_, int c_) { nM = M / BM; nN = N / BM; nwg = nM * nN; G = G_; c = c_; }
    __host__ __device__ bool next(int i, Unit& u) const {
        const long L = (long)i * G + c; if (L >= nwg) return false;
        int wgid = (int)L; { const int q = nwg / NXCD, r = nwg % NXCD, xcd = wgid % NXCD, off = wgid / NXCD; wgid = (xcd < r ? xcd * (q + 1) : r * (q + 1) + (xcd - r) * q) + off; }
        const int nig = WGM * nN, gid = wgid / nig, fm = gid * WGM, gsz = (nM - fm) < WGM ? (nM - fm) : WGM;
        u.pm = fm + ((wgid % nig) % gsz); u.pn = (wgid % nig) / gsz; return true;
    }
    __device__ __forceinline__ void a_ready(const Unit&) const {}
    __device__ __forceinline__ void done(const Unit&) const {}
};

__device__ __forceinline__ unsigned cvt_pk_bf16(float lo, float hi) { unsigned r; asm volatile("v_cvt_pk_bf16_f32 %0, %1, %2" : "=v"(r) : "v"(lo), "v"(hi)); return r; }

template <class Epi, class Sched, bool ALIGN_EPI = false, bool SP2 = false, bool HALF_LAST = true>
__device__ __forceinline__ void gemm_phase(PG8_LAS unsigned char* lds, const Gemm g, const Sched& S, const Epi& E, int tidx) {
    int tid_ = tidx; asm volatile("" : "+v"(tid_));
    const int tid = tid_, wid = __builtin_amdgcn_readfirstlane(tid >> 6), lane = tid & 63, wr = wid >> 2, wc = wid & 3, fr = lane & 15, fq = lane >> 4;
    const int K = g.K, nt = K / BK;
    unsigned voffA[2], voffB[2];
#pragma unroll
    for (int i = 0; i < 2; ++i) { int R, C; stage_rc(tid * 16 + i * 8192, R, C); const int Rb = Epi::PERM ? ((R & ~31) + perm32(R & 31)) : R;
        voffA[i] = (unsigned)(R * K + C) * 2u; voffB[i] = (unsigned)(Rb * K + C) * 2u; }
    const size_t kstep = (size_t)(BK * 2);
    const size_t hstep = (size_t)HALF * K * 2;
    const size_t tstep = 2 * hstep;
    const unsigned ldsw = (unsigned)wid * 1024u;
    const int aoff = lds_byte(wr * 64 + fr, fq * 8), boff = lds_byte(wc * 32 + fr, fq * 8);
#define PG8_SA(b, h) (((b) * 2 + (h)) * HTB)
#define PG8_SB(b, h) ((4 + (b) * 2 + (h)) * HTB)
#define PG8_STAGE(bufoff, gbase, voff) do { _Pragma("unroll") for (int _i = 0; _i < 2; ++_i) \
        __builtin_amdgcn_global_load_lds((const unsigned*)((const char*)(gbase) + (voff)[_i]), (PG8_LAS unsigned*)(lds + (bufoff) + ldsw + _i * 8192), 16, 0, 0); } while (0)
#define PG8_LDA(dst, b, h) do { _Pragma("unroll") for (int m = 0; m < 4; ++m) _Pragma("unroll") for (int k = 0; k < 2; ++k) dst[m][k] = *(const PG8_LAS bf16x8*)(lds + PG8_SA(b, h) + aoff + m * 2048 + k * 1024); } while (0)
#define PG8_LDB(dst, b, h) do { _Pragma("unroll") for (int n = 0; n < 2; ++n) _Pragma("unroll") for (int k = 0; k < 2; ++k) dst[n][k] = *(const PG8_LAS bf16x8*)(lds + PG8_SB(b, h) + boff + n * 2048 + k * 1024); } while (0)
#define PG8_MMA(ai, bj, At, Bt) do { __builtin_amdgcn_s_setprio(1); _Pragma("unroll") for (int m = 0; m < 4; ++m) _Pragma("unroll") for (int n = 0; n < 2; ++n) _Pragma("unroll") for (int k = 0; k < 2; ++k) \
        acc[ai][bj][m][n] = __builtin_amdgcn_mfma_f32_16x16x32_bf16(Bt[n][k], At[m][k], acc[ai][bj][m][n], 0, 0, 0); __builtin_amdgcn_s_setprio(0); } while (0)
#define PG8_WAIT_V(n) asm volatile("s_waitcnt vmcnt(" #n ")" ::: "memory")
#define PG8_WAIT_L(n) asm volatile("s_waitcnt lgkmcnt(" #n ")" ::: "memory")
#define PG8_BAR __builtin_amdgcn_s_barrier()
#define PG8_SCHED __builtin_amdgcn_sched_barrier(0)
    Unit cur, nxt; int ui = 0;
    if (!S.next(0, cur)) return;
    f32x4 acc[2][2][4][2];
#pragma unroll
    for (int a = 0; a < 2; ++a)
#pragma unroll
        for (int b = 0; b < 2; ++b)
#pragma unroll
            for (int m = 0; m < 4; ++m)
#pragma unroll
                for (int n = 0; n < 2; ++n) acc[a][b][m][n] = (f32x4){0.f, 0.f, 0.f, 0.f};
    bf16x8 At[4][2], B0[2][2], B1[2][2];
    const char* cA = (const char*)g.A + (size_t)cur.pm * tstep; const char* cB = (const char*)g.Bt + (size_t)cur.pn * tstep;
    S.a_ready(cur);
    if constexpr (SP2) {
        PG8_STAGE(PG8_SB(0, 0), cB, voffB); PG8_STAGE(PG8_SB(0, 1), cB + hstep, voffB); PG8_STAGE(PG8_SA(0, 0), cA, voffA); PG8_STAGE(PG8_SA(0, 1), cA + hstep, voffA);
        if (wr == 1) PG8_BAR;
        PG8_WAIT_V(2); PG8_BAR;
        PG8_STAGE(PG8_SB(1, 0), cB + kstep, voffB); PG8_STAGE(PG8_SA(1, 0), cA + kstep, voffA); PG8_STAGE(PG8_SB(1, 1), cB + hstep + kstep, voffB);
        PG8_WAIT_V(6); PG8_BAR;
    } else {
        PG8_STAGE(PG8_SB(0, 0), cB, voffB); PG8_STAGE(PG8_SA(0, 0), cA, voffA); PG8_STAGE(PG8_SB(0, 1), cB + hstep, voffB); PG8_STAGE(PG8_SA(0, 1), cA + hstep, voffA);
        if (wr == 1) PG8_BAR;
        PG8_WAIT_V(4); PG8_BAR;
        PG8_STAGE(PG8_SB(1, 0), cB + kstep, voffB); PG8_STAGE(PG8_SA(1, 0), cA + kstep, voffA); PG8_STAGE(PG8_SB(1, 1), cB + hstep + kstep, voffB);
        PG8_WAIT_V(6); PG8_BAR;
    }
    for (;;) {
        const bool has_next = S.next(ui + 1, nxt);
        const bool half1 = HALF_LAST && (cur.pm == g.M / BM - 1);
        const char* nA = has_next ? (const char*)g.A + (size_t)nxt.pm * tstep : cA; const char* nB = has_next ? (const char*)g.Bt + (size_t)nxt.pn * tstep : cB;
        for (int t = 0; t < nt; t += 2) {
            const bool last = (t == nt - 2);
            const char* a1 = cA + (size_t)(t + 1) * kstep;
            const char* a2 = last ? nA : cA + (size_t)(t + 2) * kstep; const char* b2 = last ? nB : cB + (size_t)(t + 2) * kstep;
            const char* a3 = a2 + kstep; const char* b3 = b2 + kstep;
            if (last && has_next) S.a_ready(nxt);
            if constexpr (SP2) {
            PG8_LDB(B0, 0, 0); PG8_LDB(B1, 0, 1); PG8_SCHED; PG8_LDA(At, 0, 0); PG8_STAGE(PG8_SA(1, 1), a1 + hstep, voffA);
            PG8_WAIT_V(8); PG8_WAIT_L(0); PG8_BAR; PG8_MMA(0, 0, At, B0); PG8_MMA(0, 1, At, B1); PG8_BAR; PG8_SCHED;
            if (!half1) { PG8_LDA(At, 0, 1); } PG8_STAGE(PG8_SB(0, 0), b2, voffB); PG8_STAGE(PG8_SB(0, 1), b2 + hstep, voffB); PG8_STAGE(PG8_SA(0, 0), a2, voffA);
            PG8_WAIT_V(8); PG8_WAIT_L(0); PG8_BAR; if (!half1) { PG8_MMA(1, 0, At, B0); PG8_MMA(1, 1, At, B1); } PG8_BAR; PG8_SCHED;
            PG8_LDB(B0, 1, 0); PG8_LDB(B1, 1, 1); PG8_SCHED; PG8_LDA(At, 1, 0); PG8_STAGE(PG8_SA(0, 1), a2 + hstep, voffA);
            PG8_WAIT_V(8); PG8_WAIT_L(0); PG8_BAR; PG8_MMA(0, 0, At, B0); PG8_MMA(0, 1, At, B1); PG8_BAR; PG8_SCHED;
            if (!half1) { PG8_LDA(At, 1, 1); } PG8_STAGE(PG8_SB(1, 0), b3, voffB); PG8_STAGE(PG8_SB(1, 1), b3 + hstep, voffB); PG8_STAGE(PG8_SA(1, 0), a3, voffA);
            PG8_WAIT_V(8); PG8_WAIT_L(0); PG8_BAR; if (!half1) { PG8_MMA(1, 0, At, B0); PG8_MMA(1, 1, At, B1); } PG8_BAR; PG8_SCHED;
            } else {
            PG8_LDB(B0, 0, 0); PG8_SCHED; PG8_LDA(At, 0, 0); PG8_STAGE(PG8_SA(1, 1), a1 + hstep, voffA);
            PG8_WAIT_L(8); PG8_BAR; PG8_WAIT_L(0); PG8_MMA(0, 0, At, B0); PG8_BAR; PG8_SCHED;
            PG8_LDB(B1, 0, 1); PG8_STAGE(PG8_SB(0, 0), b2, voffB);
            PG8_BAR; PG8_WAIT_L(0); PG8_MMA(0, 1, At, B1); PG8_BAR;
            PG8_LDA(At, 0, 1); PG8_STAGE(PG8_SA(0, 0), a2, voffA);
            PG8_BAR; PG8_WAIT_L(0); PG8_MMA(1, 0, At, B0); PG8_BAR; PG8_SCHED;
            PG8_STAGE(PG8_SB(0, 1), b2 + hstep, voffB);
            PG8_WAIT_V(6); PG8_BAR; PG8_MMA(1, 1, At, B1); PG8_BAR;
            PG8_LDB(B0, 1, 0); PG8_SCHED; PG8_LDA(At, 1, 0); PG8_STAGE(PG8_SA(0, 1), a2 + hstep, voffA);
            PG8_WAIT_L(8); PG8_BAR; PG8_WAIT_L(0); PG8_MMA(0, 0, At, B0); PG8_BAR; PG8_SCHED;
            PG8_LDB(B1, 1, 1); PG8_STAGE(PG8_SB(1, 0), b3, voffB);
            PG8_BAR; PG8_WAIT_L(0); PG8_MMA(0, 1, At, B1); PG8_BAR;
            PG8_LDA(At, 1, 1); PG8_STAGE(PG8_SA(1, 0), a3, voffA);
            PG8_BAR; PG8_WAIT_L(0); PG8_MMA(1, 0, At, B0); PG8_BAR; PG8_SCHED;
            PG8_STAGE(PG8_SB(1, 1), b3 + hstep, voffB);
            PG8_WAIT_V(6); PG8_BAR; PG8_MMA(1, 1, At, B1); PG8_BAR;
            }
        }
        if constexpr (ALIGN_EPI) { if (wr == 0) PG8_BAR; }
        E(acc, cur, wr, wc, fr, fq);
        if (!has_next) break;
#pragma unroll
        for (int a = 0; a < 2; ++a)
#pragma unroll
            for (int b = 0; b < 2; ++b)
#pragma unroll
                for (int m = 0; m < 4; ++m)
#pragma unroll
                    for (int n = 0; n < 2; ++n) acc[a][b][m][n] = (f32x4){0.f, 0.f, 0.f, 0.f};
        cur = nxt; cA = nA; cB = nB; ++ui;
        if constexpr (ALIGN_EPI) { if (wr == 1) PG8_BAR; }
    }
    PG8_WAIT_V(0);
    if constexpr (!ALIGN_EPI) { if (wr == 0) PG8_BAR; }
    PG8_BAR;
#undef PG8_SA
#undef PG8_SB
#undef PG8_STAGE
#undef PG8_LDA
#undef PG8_LDB
#undef PG8_MMA
#undef PG8_WAIT_V
#undef PG8_WAIT_L
#undef PG8_BAR
#undef PG8_SCHED
}
}

constexpr int NWAVES = 8, NTHR = 512;
constexpr int D = 2048, SEQ = 8192, DECB = 32, DECS = 4, MS = DECB * DECS;
constexpr int MR = SEQ + MS;
constexpr int MP = 8448;
constexpr int NH = 16, HD = 128, NKV = 4, DFF = 5632, NGU = 2 * DFF;
constexpr int NCHUNK = SEQ / 64;
constexpr int NPAGES = 64, PAGE = 128, NBLK = 32;
constexpr float EPS = 1e-6f;
constexpr float C2 = 0.08838834764831845f * 1.4426950408889634f;

constexpr size_t OY_P = 0, OY_S = OY_P + (size_t)SEQ * D, OST_P = OY_S + (size_t)MS * D, OST_S = OST_P + (size_t)NH * 128 * 128,
                 OK_P = OST_S + (size_t)DECB * NH * 128 * 128, OV_P = OK_P + (size_t)SEQ * 512, OK_S = OV_P + (size_t)SEQ * 512, OV_S = OK_S + (size_t)MS * 512;

constexpr size_t MiB = 1u << 20;
constexpr size_t WS_CTL = 0, CTL_ZERO_BYTES = 1 * MiB;
constexpr size_t WS_WIN = 2 * MiB;
constexpr size_t WS_WOUT = WS_WIN + 32 * MiB;
constexpr size_t WS_WGU0 = WS_WOUT + 8 * MiB;
constexpr size_t WS_WDN0 = WS_WGU0 + 44 * MiB;
constexpr size_t WS_WKVQ = WS_WDN0 + 22 * MiB;
constexpr size_t WS_WO = WS_WKVQ + 12 * MiB;
constexpr size_t WS_WGU1 = WS_WO + 8 * MiB;
constexpr size_t WS_WDN1 = WS_WGU1 + 44 * MiB;
constexpr size_t WS_HB0 = WS_WDN1 + 22 * MiB;
constexpr size_t WS_HB1 = WS_HB0 + 34 * MiB, WS_HB2 = WS_HB1 + 34 * MiB, WS_HB3 = WS_HB2 + 34 * MiB;
constexpr size_t WS_HF1 = WS_HB3 + 34 * MiB;
constexpr size_t WS_HF2 = WS_HF1 + 67 * MiB, WS_HF3 = WS_HF2 + 67 * MiB;
constexpr size_t WS_QG = WS_HF3 + 67 * MiB;
constexpr size_t WS_VG = WS_QG + 34 * MiB;
constexpr size_t WS_GG = WS_VG + 34 * MiB;
constexpr size_t WS_F = WS_GG + 34 * MiB;
constexpr size_t WS_OB = WS_F + 67 * MiB;
constexpr size_t WS_AT = WS_OB + 34 * MiB;
constexpr size_t WS_HM = WS_AT + 34 * MiB;
constexpr size_t WS_U = WS_HM + 92 * MiB;
constexpr size_t WS_SST = WS_U + 64 * MiB;
constexpr size_t WS_DEC = WS_SST + 64 * MiB;
constexpr size_t WS_KRAW = WS_DEC + 2 * MiB;
constexpr size_t WS_VRAW = WS_KRAW + 17 * MiB;
constexpr size_t WS_QRAW = WS_VRAW + 17 * MiB;
constexpr size_t WS_KB = WS_QRAW + 67 * MiB;
constexpr size_t WS_VB = WS_KB + 9 * MiB;
constexpr size_t WS_QB = WS_VB + 9 * MiB;
constexpr size_t WS_KPART = WS_QB + 34 * MiB;
constexpr size_t WS_KMS = WS_KPART + 1 * MiB;
constexpr size_t WS_SUBL = WS_KMS + 2 * MiB;
constexpr size_t WS_SCNT = WS_SUBL + 16 * MiB;
constexpr size_t WS_OSLOT = WS_SCNT + 1 * MiB;
constexpr size_t WS_MLSLOT = WS_OSLOT + 192 * MiB;
constexpr size_t WS_SSLOT = WS_MLSLOT + 3 * MiB;
constexpr size_t WS_FOUT = WS_SSLOT + 34 * MiB;
constexpr size_t WS_END = WS_FOUT + 131 * MiB;
constexpr size_t WS_ORC = WS_END;
constexpr int CW_BAR = 4096;
constexpr int CW_Q0 = 8192;
constexpr int CW_SS0 = 16384, CW_SS1 = CW_SS0 + MP, CW_SS2 = CW_SS1 + MP, CW_SS3 = CW_SS2 + MP;
static_assert((CW_SS3 + MP) * 4 <= (int)CTL_ZERO_BYTES, "ctl");
static_assert(WS_VG - WS_QG == 34 * MiB && WS_GG - WS_VG == 34 * MiB, "Qg|Vg|Gg stride");

constexpr int LDS_BYTES = 160 * 1024;
constexpr int MISC_OFF = LDS_BYTES - 256;

#define GAS __attribute__((address_space(1)))
#define LAS __attribute__((address_space(3)))
typedef unsigned short bf16;
typedef unsigned v4u __attribute__((ext_vector_type(4)));
typedef unsigned v2u __attribute__((ext_vector_type(2)));
typedef float f32x4 __attribute__((ext_vector_type(4)));
typedef float f32x2 __attribute__((ext_vector_type(2)));
typedef short bf16x8 __attribute__((ext_vector_type(8)));
typedef short bf16x4 __attribute__((ext_vector_type(4)));
#define LDS_WAIT() asm volatile("s_waitcnt lgkmcnt(0)" ::: "memory")
__device__ __forceinline__ unsigned f2bf(float f) { unsigned u = __builtin_bit_cast(unsigned, f); return (u + 0x7fffu + ((u >> 16) & 1u)) >> 16; }
__device__ __forceinline__ unsigned pk2(float lo, float hi) { return f2bf(lo) | (f2bf(hi) << 16); }
__device__ __forceinline__ float bf2f(unsigned h) { return __uint_as_float(h << 16); }
__device__ __forceinline__ float silu_f(float x) { return x * __builtin_amdgcn_rcpf(1.0f + __expf(-x)); }
__device__ __forceinline__ float sigm_f(float x) { return __builtin_amdgcn_rcpf(1.0f + __expf(-x)); }
template <int M> __device__ __forceinline__ float shx(float v) { return __uint_as_float((unsigned)__builtin_amdgcn_ds_swizzle((int)__float_as_uint(v), (M << 10) | 0x1f)); }
__device__ __forceinline__ float xadd32(float v) { auto rr = __builtin_amdgcn_permlane32_swap(__float_as_uint(v), __float_as_uint(v), false, false); return __uint_as_float(rr[0]) + __uint_as_float(rr[1]); }
__device__ __forceinline__ float xmax32(float v) { auto rr = __builtin_amdgcn_permlane32_swap(__float_as_uint(v), __float_as_uint(v), false, false); return fmaxf(__uint_as_float(rr[0]), __uint_as_float(rr[1])); }
__device__ __forceinline__ float wave_sum(float v) { v += shx<1>(v); v += shx<2>(v); v += shx<4>(v); v += shx<8>(v); v += shx<16>(v); return xadd32(v); }
#define MFMA16(a, b, c) __builtin_amdgcn_mfma_f32_16x16x32_bf16((a), (b), (c), 0, 0, 0)

#define XB_TMO      128
#define XB_XCNT(j)  (256  + 64 * (j))
#define XB_XSUB(j)  (1280 + 64 * (j))
#define XB_XGEN(j)  (2304 + 64 * (j))
#define XB_TOP      3328
#define XB_TOPGEN   3392
#define XCD_BAR_WORDS 3456
#define XB_SPIN_CAP (1u << 18)
__device__ __forceinline__ unsigned xb_ld(unsigned* p)              { return __hip_atomic_load(p, __ATOMIC_RELAXED, __HIP_MEMORY_SCOPE_AGENT); }
__device__ __forceinline__ unsigned xb_add(unsigned* p, unsigned v) { return __hip_atomic_fetch_add(p, v, __ATOMIC_RELAXED, __HIP_MEMORY_SCOPE_AGENT); }
__device__ __forceinline__ unsigned xb_xcc_id() { return (unsigned)__builtin_amdgcn_s_getreg((3 << 11) | 20) & 0xFu; }
#define XB_SPIN(cond, bar) do { unsigned _sp = 0; while (cond) { __builtin_amdgcn_s_sleep(1); \
    if ((++_sp & 255u) == 0u) { if (xb_ld(&(bar)[XB_TMO])) break; if (_sp > XB_SPIN_CAP) { atomicAdd(&(bar)[XB_TMO], 1u); break; } } } } while (0)
struct XcdBarrier { unsigned* bar; unsigned x; volatile LAS unsigned* st; };
__device__ __forceinline__ XcdBarrier xcd_barrier_post(unsigned* bar, volatile LAS unsigned* st, bool is_t0) {
    XcdBarrier b; b.bar = bar; b.x = xb_xcc_id(); b.st = st;
    if (is_t0) (void)xb_add(&bar[XB_XCNT(b.x)], 1u);
    return b;
}
__device__ __forceinline__ void xcd_barrier_complete(unsigned* bar, unsigned x, unsigned& nloc, unsigned& nx) {
    const unsigned G = gridDim.x * gridDim.y * gridDim.z;
    unsigned sum, cnt, mine, sp = 0u;
    for (;;) {
        sum = 0u; cnt = 0u; mine = 0u;
#pragma unroll
        for (unsigned j = 0; j < 16; ++j) { const unsigned c = xb_ld(&bar[XB_XCNT(j)]); sum += c; cnt += (c > 0u) ? 1u : 0u; mine = (j == x) ? c : mine; }
        if (sum == G) break;
        __builtin_amdgcn_s_sleep(1);
        if ((++sp & 255u) == 0u) { if (xb_ld(&bar[XB_TMO])) break; if (sp > XB_SPIN_CAP) { atomicAdd(&bar[XB_TMO], 1u); break; } }
    }
    nloc = mine > 0u ? mine : 1u; nx = cnt > 0u ? cnt : 1u;
}
__device__ __forceinline__ void xcd_barrier(const XcdBarrier& b, bool is_t0) {
    asm volatile("s_waitcnt vmcnt(0)" ::: "memory");
    __syncthreads();
    if (is_t0) {
        unsigned* bar = b.bar;
        __builtin_amdgcn_s_waitcnt(0);
        unsigned nloc = b.st[0], nx = b.st[1];
        if (nloc == 0u) { xcd_barrier_complete(bar, b.x, nloc, nx); b.st[0] = nloc; b.st[1] = nx; }
        const unsigned old = xb_add(&bar[XB_XSUB(b.x)], 1u);
        const unsigned gen = old / nloc;
        if (old + 1u == (gen + 1u) * nloc) {
            __builtin_amdgcn_fence(__ATOMIC_RELEASE, "agent");
            asm volatile("s_waitcnt vmcnt(0)" ::: "memory");
            const unsigned og = xb_add(&bar[XB_TOP], 1u);
            const unsigned tg = og / nx;
            if (og + 1u == (tg + 1u) * nx) xb_add(&bar[XB_TOPGEN], 1u);
            else XB_SPIN(xb_ld(&bar[XB_TOPGEN]) == tg, bar);
            __builtin_amdgcn_fence(__ATOMIC_ACQUIRE, "agent");
            xb_add(&bar[XB_XGEN(b.x)], 1u);
            asm volatile("s_waitcnt vmcnt(0)" ::: "memory");
        } else {
            XB_SPIN(xb_ld(&bar[XB_XGEN(b.x)]) == gen, bar);
            __builtin_amdgcn_fence(__ATOMIC_ACQUIRE, "agent");
            asm volatile("s_waitcnt vmcnt(0)" ::: "memory");
        }
    }
    __syncthreads();
}

using pg8::Unit; using pg8::cvt_pk_bf16;
struct EpiIn {
    static constexpr bool PERM = true;
    const float* ss; const float* lbl; bf16* Qg; float* F;
    __device__ __forceinline__ void operator()(const f32x4 (&acc)[2][2][4][2], const Unit& u, int wr, int wc, int fr, int fq) const {
        const int seg = u.pn >> 3; const int col0 = (u.pn & 7) * 256 + wc * 32 + 8 * fq; const int rowb = u.pm * 256 + wr * 64;
        float lb[2][8];
        if (seg == 1) {
#pragma unroll
            for (int bj = 0; bj < 2; ++bj)
#pragma unroll
                for (int j = 0; j < 8; ++j) { const int c = col0 + bj * 128 + j; lb[bj][j] = __builtin_amdgcn_rcpf(1.0f + __expf(lbl[D + c] - lbl[c])); }
        }
#pragma unroll
        for (int ai = 0; ai < 2; ++ai)
#pragma unroll
            for (int m = 0; m < 4; ++m) {
                const int rb = rowb + ai * 128 + m * 16; if (rb >= MR) continue;
                const int row = rb + fr; const float r = rsqrtf(ss[row] * (1.0f / D) + EPS);
#pragma unroll
                for (int bj = 0; bj < 2; ++bj) {
                    f32x4 v0 = acc[ai][bj][m][0] * r, v1 = acc[ai][bj][m][1] * r; const size_t off = (size_t)row * D + col0 + bj * 128;
                    if (seg == 1) {
                        f32x4 o0, o1;
#pragma unroll
                        for (int j = 0; j < 4; ++j) { o0[j] = lb[bj][j] + (1.0f - lb[bj][j]) * sigm_f(v0[j]); o1[j] = lb[bj][4 + j] + (1.0f - lb[bj][4 + j]) * sigm_f(v1[j]); }
                        *(f32x4*)(F + off) = o0; *(f32x4*)(F + off + 4) = o1;
                    } else {
                        if (seg != 2) {
#pragma unroll
                            for (int j = 0; j < 4; ++j) { v0[j] = silu_f(v0[j]); v1[j] = silu_f(v1[j]); }
                        }
                        v4u w; w.x = cvt_pk_bf16(v0[0], v0[1]); w.y = cvt_pk_bf16(v0[2], v0[3]); w.z = cvt_pk_bf16(v1[0], v1[1]); w.w = cvt_pk_bf16(v1[2], v1[3]);
                        const size_t dsel = (seg == 0) ? 0 : ((seg == 2) ? 1 : 2);
                        *(v4u*)(Qg + dsel * (size_t)(17 * MiB) + off) = w;
                    }
                }
            }
    }
    __device__ __forceinline__ void tail(int row, int col, f32x4 v) const {
        const int seg = col >> 11, c = col & 2047; const float r = rsqrtf(ss[row] * (1.0f / D) + EPS); v = v * r; const size_t off = (size_t)row * D + c;
        if (seg == 1) { f32x4 o;
#pragma unroll
            for (int j = 0; j < 4; ++j) { const float lbv = __builtin_amdgcn_rcpf(1.0f + __expf(lbl[D + c + j] - lbl[c + j])); o[j] = lbv + (1.0f - lbv) * sigm_f(v[j]); }
            *(f32x4*)(F + off) = o;
        } else {
            if (seg != 2) {
#pragma unroll
                for (int j = 0; j < 4; ++j) v[j] = silu_f(v[j]);
            }
            v2u w; w.x = cvt_pk_bf16(v[0], v[1]); w.y = cvt_pk_bf16(v[2], v[3]);
            const size_t dsel = (seg == 0) ? 0 : ((seg == 2) ? 1 : 2);
            *(v2u*)(Qg + dsel * (size_t)(17 * MiB) + off) = w;
        }
    }
};

template <int MODE> struct EpiRes {
    static constexpr bool PERM = true;
    const float* r0; const float* r1; float* o0; float* o1; bf16* hb; float* ss;
    __device__ __forceinline__ void operator()(const f32x4 (&acc)[2][2][4][2], const Unit& u, int wr, int wc, int fr, int fq) const {
        const int col0 = u.pn * 256 + wc * 32 + 8 * fq; const int rowb = u.pm * 256 + wr * 64;
#pragma unroll
        for (int ai = 0; ai < 2; ++ai)
#pragma unroll
            for (int m = 0; m < 4; ++m) {
                const int rb = rowb + ai * 128 + m * 16; if (rb >= MR) continue;
                const int row = rb + fr;
                const float* rp = (MODE == 0) ? ((row < SEQ) ? r0 + (size_t)row * D : r1 + (size_t)(row - SEQ) * D) : r0 + (size_t)row * D;
                float* op = (MODE == 2) ? ((row < SEQ) ? o0 + (size_t)row * D : o1 + (size_t)(row - SEQ) * D) : o0 + (size_t)row * D;
                float sq = 0.f;
#pragma unroll
                for (int bj = 0; bj < 2; ++bj) {
                    const int c = col0 + bj * 128;
                    const f32x4 r0v = (MODE == 0) ? __builtin_nontemporal_load((const f32x4*)(rp + c)) : *(const f32x4*)(rp + c), r1v = (MODE == 0) ? __builtin_nontemporal_load((const f32x4*)(rp + c + 4)) : *(const f32x4*)(rp + c + 4);
                    const f32x4 a0 = r0v + acc[ai][bj][m][0], a1 = r1v + acc[ai][bj][m][1];
                    if (MODE == 2) { __builtin_nontemporal_store(a0, (f32x4*)(op + c)); __builtin_nontemporal_store(a1, (f32x4*)(op + c + 4)); } else { *(f32x4*)(op + c) = a0; *(f32x4*)(op + c + 4) = a1; }
                    if (MODE != 2) {
                        v4u w; w.x = cvt_pk_bf16(a0[0], a0[1]); w.y = cvt_pk_bf16(a0[2], a0[3]); w.z = cvt_pk_bf16(a1[0], a1[1]); w.w = cvt_pk_bf16(a1[2], a1[3]);
                        *(v4u*)(hb + (size_t)row * D + c) = w;
                        sq += (a0[0] * a0[0] + a0[1] * a0[1]) + (a0[2] * a0[2] + a0[3] * a0[3]) + (a1[0] * a1[0] + a1[1] * a1[1]) + (a1[2] * a1[2] + a1[3] * a1[3]);
                    }
                }
                if (MODE != 2) { sq += shx<16>(sq); sq = xadd32(sq); if (fq == 0) atomicAdd(ss + row, sq); }
            }
    }
    __device__ __forceinline__ void tail(int row, int col, f32x4 v, int fq) const {
        const float* rp = (MODE == 0) ? r1 + (size_t)(row - SEQ) * D : r0 + (size_t)row * D;
        float* op = (MODE == 2) ? o1 + (size_t)(row - SEQ) * D : o0 + (size_t)row * D;
        const f32x4 a0 = *(const f32x4*)(rp + col) + v;
        *(f32x4*)(op + col) = a0;
        if (MODE != 2) {
            v2u w; w.x = cvt_pk_bf16(a0[0], a0[1]); w.y = cvt_pk_bf16(a0[2], a0[3]); *(v2u*)(hb + (size_t)row * D + col) = w;
            float sq = (a0[0] * a0[0] + a0[1] * a0[1]) + (a0[2] * a0[2] + a0[3] * a0[3]);
            sq += shx<16>(sq); sq = xadd32(sq); if (fq == 0) atomicAdd(ss + row, sq);
        }
    }
};
struct EpiGU {
    static constexpr bool PERM = true;
    const float* ss; bf16* hm;
    __device__ __forceinline__ void operator()(const f32x4 (&acc)[2][2][4][2], const Unit& u, int wr, int wc, int fr, int fq) const {
        const int j0 = u.pn * 128 + wc * 32 + 8 * fq; const int rowb = u.pm * 256 + wr * 64;
#pragma unroll
        for (int ai = 0; ai < 2; ++ai)
#pragma unroll
            for (int m = 0; m < 4; ++m) {
                const int rb = rowb + ai * 128 + m * 16; if (rb >= MR) continue;
                const int row = rb + fr; const float r = rsqrtf(ss[row] * (1.0f / D) + EPS);
                float o[8];
#pragma unroll
                for (int n = 0; n < 2; ++n)
#pragma unroll
                    for (int j = 0; j < 4; ++j) o[4 * n + j] = silu_f(acc[ai][0][m][n][j] * r) * (acc[ai][1][m][n][j] * r);
                v4u w; w.x = cvt_pk_bf16(o[0], o[1]); w.y = cvt_pk_bf16(o[2], o[3]); w.z = cvt_pk_bf16(o[4], o[5]); w.w = cvt_pk_bf16(o[6], o[7]);
                *(v4u*)(hm + (size_t)row * DFF + j0) = w;
            }
    }
};
struct EpiKVQ {
    static constexpr bool PERM = true;
    const float* ss; unsigned char* ws;
    __device__ __forceinline__ void operator()(const f32x4 (&acc)[2][2][4][2], const Unit& u, int wr, int wc, int fr, int fq) const {
        const int c0 = wc * 32 + 8 * fq; const int rowb = u.pm * 256 + wr * 64;
        const size_t base = (u.pn < 2) ? WS_KRAW : ((u.pn < 4) ? WS_VRAW : WS_QRAW);
        const int ld = (u.pn < 4) ? 512 : 2048; const int tcol = (u.pn < 2) ? u.pn * 256 : ((u.pn < 4) ? (u.pn - 2) * 256 : (u.pn - 4) * 256);
        float* dst = (float*)(ws + base);
#pragma unroll
        for (int ai = 0; ai < 2; ++ai)
#pragma unroll
            for (int m = 0; m < 4; ++m) {
                const int rb = rowb + ai * 128 + m * 16; if (rb >= MR) continue;
                const int row = rb + fr; const float r = rsqrtf(ss[row] * (1.0f / D) + EPS);
#pragma unroll
                for (int bj = 0; bj < 2; ++bj) { float* p = dst + (size_t)row * ld + tcol + c0 + bj * 128; *(f32x4*)p = acc[ai][bj][m][0] * r; *(f32x4*)(p + 4) = acc[ai][bj][m][1] * r; }
            }
    }
};

struct Args { const void* in[21]; float* out; unsigned char* ws; };

__device__ __forceinline__ void p0_transpose_item(const float* W, int K, int N, bf16* WT, int row_off, int mode, const float* gain, LAS float* scr, int item, int lane) {
    const int nblk = N / 64, kb = item / nblk, nb = item % nblk, k0 = 64 * kb, n0 = 64 * nb;
    const int r = lane >> 4, c4 = lane & 15;
#pragma unroll
    for (int i = 0; i < 16; ++i) { const int kk = 4 * i + r; f32x4 w = __builtin_nontemporal_load((const f32x4*)(W + (size_t)(k0 + kk) * N + n0 + 4 * c4)); if (gain) w *= gain[k0 + kk]; *(LAS f32x4*)(scr + kk * 68 + 4 * c4) = w; }
    LDS_WAIT(); asm volatile("" ::: "memory");
    const int c = lane & 7;
    int d0;
    if (mode == 0) d0 = row_off + n0;
    else { const int j = (n0 < DFF) ? n0 : n0 - DFF; d0 = 256 * (j >> 7) + (j & 127) + ((n0 < DFF) ? 0 : 128); }
#pragma unroll
    for (int j = 0; j < 8; ++j) { const int n = (lane >> 3) + 8 * j; const LAS float* sp = scr + (8 * c) * 68 + n;
        v4u o; o.x = pk2(sp[0 * 68], sp[1 * 68]); o.y = pk2(sp[2 * 68], sp[3 * 68]); o.z = pk2(sp[4 * 68], sp[5 * 68]); o.w = pk2(sp[6 * 68], sp[7 * 68]);
        *(v4u*)(WT + (size_t)(d0 + n) * K + k0 + 8 * c) = o; }
    LDS_WAIT(); asm volatile("" ::: "memory");
}

constexpr int KS_P = 144;
constexpr int KS_BYTES = 256 * KS_P * 2;
typedef short v4i16_t __attribute__((ext_vector_type(4)));
__device__ __forceinline__ v2u tr_read(const LAS bf16* p) { return __builtin_bit_cast(v2u, __builtin_amdgcn_ds_read_tr16_b64_v4i16((LAS v4i16_t*)p)); }
template <int NKT> __device__ __forceinline__ void attn_scores(const LAS bf16* Ks, const bf16x8 (&qf)[4], f32x4 (&acc)[16], int nkt, int fr, int fq) {
#pragma unroll
    for (int kt = 0; kt < NKT; ++kt) {
        acc[kt] = (f32x4){0.f, 0.f, 0.f, 0.f};
        if (kt < nkt) {
#pragma unroll
            for (int ks = 0; ks < 4; ++ks) { const bf16x8 a = *(const LAS bf16x8*)(Ks + (16 * kt + fr) * KS_P + 32 * ks + 8 * fq); acc[kt] = MFMA16(a, qf[ks], acc[kt]); }
        }
    }
}
__device__ __forceinline__ void attn_pv(const LAS bf16* Vr, const f32x4 (&acc)[16], f32x4 (&O)[8], int nj, int fr, int fq) {
#pragma unroll
    for (int j = 0; j < 8; ++j) {
        if (j < nj) {
            v4u pw; pw.x = cvt_pk_bf16(acc[2 * j][0], acc[2 * j][1]); pw.y = cvt_pk_bf16(acc[2 * j][2], acc[2 * j][3]); pw.z = cvt_pk_bf16(acc[2 * j + 1][0], acc[2 * j + 1][1]); pw.w = cvt_pk_bf16(acc[2 * j + 1][2], acc[2 * j + 1][3]);
            const bf16x8 pf = __builtin_bit_cast(bf16x8, pw);
            const LAS bf16* vb = Vr + (32 * j + 4 * fq + (fr >> 2)) * KS_P + 4 * (fr & 3);
#pragma unroll
            for (int vt = 0; vt < 8; ++vt) {
                const v2u lo = tr_read(vb + 16 * vt), hi = tr_read(vb + 16 * KS_P + 16 * vt);
                const v4u aw = {lo.x, lo.y, hi.x, hi.y};
                O[vt] = MFMA16(__builtin_bit_cast(bf16x8, aw), pf, O[vt]);
            }
        }
    }
}

template <int NT> __device__ __forceinline__ void tail_gemm(LAS unsigned char* lds, const bf16* A, const bf16* Bt, int K, int n0, int rowhalf, f32x4 (&acc)[NT], int tidx) {
    int tid_o = tidx; asm volatile("" : "+v"(tid_o));
    const int lane = tid_o & 63, wave = __builtin_amdgcn_readfirstlane(tid_o >> 6), fr = lane & 15, fq = lane >> 4;
    const int rt = wave & 3, kh = wave >> 2; const int Kh = K >> 1;
    const bf16* ap = A + (size_t)(64 * rowhalf + 16 * rt + fr) * K + kh * Kh + 8 * fq;
    const bf16* bp = Bt + (size_t)(n0 + fr) * K + kh * Kh + 8 * fq;
#pragma unroll
    for (int t = 0; t < NT; ++t) acc[t] = (f32x4){0.f, 0.f, 0.f, 0.f};
    bf16x8 a0[8], b0[NT][8], a1[8], b1[NT][8];
#define TG_LOAD(a_, b_, k0_) do { _Pragma("unroll") for (int s_ = 0; s_ < 8; ++s_) { a_[s_] = *(const bf16x8*)(ap + (k0_) + 32 * s_); _Pragma("unroll") for (int t_ = 0; t_ < NT; ++t_) b_[t_][s_] = *(const bf16x8*)(bp + (size_t)t_ * 16 * K + (k0_) + 32 * s_); } } while (0)
#define TG_MMA(a_, b_) do { _Pragma("unroll") for (int s_ = 0; s_ < 8; ++s_) { _Pragma("unroll") for (int t_ = 0; t_ < NT; ++t_) acc[t_] = MFMA16(b_[t_][s_], a_[s_], acc[t_]); } } while (0)
    TG_LOAD(a0, b0, 0);
    for (int k0 = 0; k0 < Kh; k0 += 512) {
        if (k0 + 256 < Kh) TG_LOAD(a1, b1, k0 + 256);
        TG_MMA(a0, b0);
        if (k0 + 256 < Kh) { if (k0 + 512 < Kh) TG_LOAD(a0, b0, k0 + 512); TG_MMA(a1, b1); }
    }
#undef TG_LOAD
#undef TG_MMA
    LAS f32x4* red = (LAS f32x4*)lds;
    if (kh == 1) {
#pragma unroll
        for (int t = 0; t < NT; ++t) red[(t * 4 + rt) * 64 + lane] = acc[t];
    }
    __syncthreads();
    if (kh == 0) {
#pragma unroll
        for (int t = 0; t < NT; ++t) acc[t] += red[(t * 4 + rt) * 64 + lane];
    }
    __syncthreads();
}

__device__ __forceinline__ void kmean_items(LAS unsigned char* lds, const float* cache_k_, const int* ptab_, float* Kms_, int i0, int i1, int c0, int cn, int tidx) {
    int tid_o = tidx; asm volatile("" : "+v"(tid_o)); const int tid = tid_o;
    const int me = (int)blockIdx.x - c0; if (me < 0 || me >= cn) return;
    LAS f32x4* redk = (LAS f32x4*)(lds);
    for (int item = i0 + me; item < i1; item += cn) {
        const int b = item >> 5, n = item & 31; const int c4 = tid & 127, rg = tid >> 7;
        f32x4 a = {0.f, 0.f, 0.f, 0.f};
#pragma unroll
        for (int hp = 0; hp < 2; ++hp) { const int page = ptab_[b * NPAGES + 2 * n + hp]; const f32x4* pp = (const f32x4*)(cache_k_ + (size_t)page * PAGE * 512) + c4;
#pragma unroll 16
            for (int r = rg; r < 128; r += 4) a += __builtin_nontemporal_load(pp + (size_t)r * 128); }
        redk[rg * 128 + c4] = a;
        __syncthreads();
        if (tid < 128) { const f32x4 s4 = (redk[tid] + redk[128 + tid]) + (redk[256 + tid] + redk[384 + tid]); *(f32x4*)(Kms_ + (size_t)item * 512 + 4 * tid) = s4 * (1.0f / 256.0f); }
        __syncthreads();
    }
}

__global__ void __launch_bounds__(NTHR, 2) yoco_fwd(Args args) {
    extern __shared__ __attribute__((aligned(16))) unsigned char lds_raw[];
    LAS unsigned char* lds = (LAS unsigned char*)lds_raw;
#define TIDS int tid_o = TIDX; asm volatile("" : "+v"(tid_o)); const int tid = tid_o, lane = tid & 63, wave = __builtin_amdgcn_readfirstlane(tid >> 6), fr = lane & 15, fq = lane >> 4; (void)fr; (void)fq; (void)wave; (void)lane; (void)tid
    const int G = gridDim.x, bid = blockIdx.x;
    unsigned char* ws = args.ws;
    unsigned* ctl = (unsigned*)(ws + WS_CTL);
    volatile LAS unsigned* MISC = (volatile LAS unsigned*)(lds + MISC_OFF);
    const int wave_sg = __builtin_amdgcn_readfirstlane((int)threadIdx.x & ~63);
#define TIDX (wave_sg + lane_id())
#define IS_T0 ((wave_sg == 0) && (lane_id() == 0))
    if (TIDX < 64) MISC[TIDX] = 0u;
    __syncthreads();
    XcdBarrier bar = xcd_barrier_post(ctl + CW_BAR, MISC + 8, IS_T0);
#ifdef PROF_A
    int n_stamp = 0;
#define STAMP() do { if (blockIdx.x == 0 && IS_T0) MISC[16 + n_stamp] = (unsigned)__builtin_amdgcn_s_memrealtime(); ++n_stamp; } while (0)
#define TNOW() ((unsigned)__builtin_amdgcn_s_memrealtime())
#define TACC(k, t0) do { if (blockIdx.x == 0 && IS_T0) MISC[40 + (k)] += TNOW() - (t0); } while (0)
#define PVAL(a0, a1) (((a0) >= 100) ? MISC[40 + (a0) - 100] : (MISC[16 + (a1)] - MISC[16 + (a0)]))
#else
#define STAMP() do {} while (0)
#define TNOW() 0u
#define TACC(k, t0) do { (void)(t0); } while (0)
#endif
    STAMP();

#define x_p ((const float*)args.in[0])
#define x_s ((const float*)args.in[1])
#define st_in ((const float*)args.in[2])
#define cache_k ((const float*)args.in[3])
#define cache_v ((const float*)args.in[4])
#define ptab ((const int*)args.in[5])
#define norm_mix_a ((const float*)args.in[6])
#define w_in ((const float*)args.in[7])
#define lbl ((const float*)args.in[8])
#define onorm ((const float*)args.in[9])
#define w_out ((const float*)args.in[10])
#define norm_kv ((const float*)args.in[11])
#define w_kv ((const float*)args.in[12])
#define k_norm ((const float*)args.in[13])
#define norm_mix_b ((const float*)args.in[14])
#define w_q ((const float*)args.in[15])
#define q_norm ((const float*)args.in[16])
#define w_o ((const float*)args.in[17])
#define norm_ffn ((const float*)args.in[18])
#define w_gu ((const float*)args.in[19])
#define w_dn ((const float*)args.in[20])
#define Win_t ((bf16*)(ws + WS_WIN))
#define Wout_t ((bf16*)(ws + WS_WOUT))
#define Wgu0_t ((bf16*)(ws + WS_WGU0))
#define Wdn0_t ((bf16*)(ws + WS_WDN0))
#define Wkvq_t ((bf16*)(ws + WS_WKVQ))
#define Wo_t ((bf16*)(ws + WS_WO))
#define Wgu1_t ((bf16*)(ws + WS_WGU1))
#define Wdn1_t ((bf16*)(ws + WS_WDN1))
#define Hb0 ((bf16*)(ws + WS_HB0))
#define Hb1 ((bf16*)(ws + WS_HB1))
#define Hb2 ((bf16*)(ws + WS_HB2))
#define Hb3 ((bf16*)(ws + WS_HB3))
#define Hf1 ((float*)(ws + WS_HF1))
#define Hf2 ((float*)(ws + WS_HF2))
#define Hf3 ((float*)(ws + WS_HF3))
#define Qg ((bf16*)(ws + WS_QG))
#define Vg ((bf16*)(ws + WS_VG))
#define Gg ((bf16*)(ws + WS_GG))
#define Ff ((float*)(ws + WS_F))
#define Ob ((bf16*)(ws + WS_OB))
#define At ((bf16*)(ws + WS_AT))
#define Hm ((bf16*)(ws + WS_HM))
#define Ub ((bf16*)(ws + WS_U))
#define Sst ((bf16*)(ws + WS_SST))
#define Dec ((float*)(ws + WS_DEC))
#define Kraw ((float*)(ws + WS_KRAW))
#define Vraw ((float*)(ws + WS_VRAW))
#define Qraw ((float*)(ws + WS_QRAW))
#define Kb ((bf16*)(ws + WS_KB))
#define Vb ((bf16*)(ws + WS_VB))
#define Qb ((bf16*)(ws + WS_QB))
#define Kpart ((float*)(ws + WS_KPART))
#define Kms ((float*)(ws + WS_KMS))
#define Subl ((unsigned*)(ws + WS_SUBL))
#define Scnt ((unsigned*)(ws + WS_SCNT))
#define Sels ((unsigned*)(ws + WS_SCNT + 256 * 1024))
#define Oslot ((bf16*)(ws + WS_OSLOT))
#define MLslot ((float*)(ws + WS_MLSLOT))
#define Sslot ((float*)(ws + WS_SSLOT))
#define ss0 ((float*)(ctl + CW_SS0))
#define ss1 ((float*)(ctl + CW_SS1))
#define ss2 ((float*)(ctl + CW_SS2))
#define ss3 ((float*)(ctl + CW_SS3))
#define out (args.out)
    {
        TIDS;
        LAS float* scr = (LAS float*)(lds + wave * 17408);
        const int gw = bid * NWAVES + wave, NGW = G * NWAVES;
        constexpr int I_IN = 32 * 128, I_SQ = 32 * 32, I_GU = 32 * 176, I_DN = 88 * 32, I_KV = 32 * 16;
        constexpr int NITEMS = I_IN + I_SQ + 2 * I_GU + 2 * I_DN + I_KV + I_SQ + I_SQ;
        for (int it = gw; it < NITEMS; it += NGW) {
            int r = it;
            if (r < I_IN) { p0_transpose_item(w_in, D, 4 * D, Win_t, 0, 0, norm_mix_a, scr, r, lane); continue; } r -= I_IN;
            if (r < I_SQ) { p0_transpose_item(w_out, D, D, Wout_t, 0, 0, nullptr, scr, r, lane); continue; } r -= I_SQ;
            if (r < I_GU) { p0_transpose_item(w_gu, D, NGU, Wgu0_t, 0, 1, norm_ffn, scr, r, lane); continue; } r -= I_GU;
            if (r < I_GU) { p0_transpose_item(w_gu + (size_t)D * NGU, D, NGU, Wgu1_t, 0, 1, norm_ffn + D, scr, r, lane); continue; } r -= I_GU;
            if (r < I_DN) { p0_transpose_item(w_dn, DFF, D, Wdn0_t, 0, 0, nullptr, scr, r, lane); continue; } r -= I_DN;
            if (r < I_DN) { p0_transpose_item(w_dn + (size_t)DFF * D, DFF, D, Wdn1_t, 0, 0, nullptr, scr, r, lane); continue; } r -= I_DN;
            if (r < I_KV) { p0_transpose_item(w_kv, D, 1024, Wkvq_t, 0, 0, norm_kv, scr, r, lane); continue; } r -= I_KV;
            if (r < I_SQ) { p0_transpose_item(w_q, D, D, Wkvq_t, 1024, 0, norm_mix_b, scr, r, lane); continue; } r -= I_SQ;
            p0_transpose_item(w_o, D, D, Wo_t, 0, 0, nullptr, scr, r, lane);
        }
        for (int m = gw; m < MR; m += NGW) {
            const float* src = (m < SEQ) ? x_p + (size_t)m * D : x_s + (size_t)(m - SEQ) * D;
            const f32x4* xr = (const f32x4*)src + lane; f32x4 v[8]; float s = 0.f;
#pragma unroll
            for (int j = 0; j < 8; ++j) { v[j] = __builtin_nontemporal_load(xr + 64 * j); s += (v[j].x * v[j].x + v[j].y * v[j].y) + (v[j].z * v[j].z + v[j].w * v[j].w); }
            s = wave_sum(s);
            if (lane == 0) ss0[m] = s;
            v2u* o8 = (v2u*)(Hb0 + (size_t)m * D) + lane;
#pragma unroll
            for (int j = 0; j < 8; ++j) { v2u w; w.x = pk2(v[j].x, v[j].y); w.y = pk2(v[j].z, v[j].w); o8[64 * j] = w; }
        }
        __syncthreads();
        kmean_items(lds, cache_k, ptab, Kms, 848, DECB * NBLK, 0, G, TIDX);
    }
    xcd_barrier(bar, IS_T0);
    STAMP();

    {
        TIDS;
        pg8::Gemm g{Hb0, Win_t, SEQ, 4 * D, D}; pg8::StaticOrder S; S.init(SEQ, 4 * D, G, bid);
        EpiIn E{ss0, lbl, Qg, Ff};
        pg8::gemm_phase<EpiIn, pg8::StaticOrder, true, true, false>(lds, g, S, E, TIDX);
        for (int it2 = 0; it2 < 2; ++it2) {
            const int w2 = bid + 256 * it2, t2 = w2 & 255, rh = (w2 >> 8) & 1;
            TIDS; f32x4 ta[2]; tail_gemm<2>(lds, Hb0 + (size_t)SEQ * D, Win_t, D, 32 * t2, rh, ta, TIDX);
            if (wave < 4) { const int row = SEQ + 64 * rh + 16 * wave + fr; E.tail(row, 32 * t2 + 4 * fq, ta[0]); E.tail(row, 32 * t2 + 16 + 4 * fq, ta[1]); }
        }
    }
    xcd_barrier(bar, IS_T0);
    STAMP();

    {
        TIDS;
        LAS float* tot = (LAS float*)(lds);
        LAS bf16* koT = (LAS bf16*)(lds + 4096);
        LAS bf16* Vr = (LAS bf16*)(lds + 4096 + 128 * 72 * 2);
        const int col = tid & 127, part = tid >> 7; const int vt_t = tid >> 3, vd0 = (tid & 7) * 16;
        float fN[16]; v4u vaN, vbN;
#define P2_LOADN(it_) do { const int h_ = (it_) >> 7, r0_ = ((it_) & 127) * 64; const float* fp_ = Ff + (size_t)(r0_ + part * 16) * D + h_ * 128 + col; \
            _Pragma("unroll") for (int i = 0; i < 16; ++i) fN[i] = fp_[(size_t)i * D]; \
            const bf16* vp_ = Vg + (size_t)(r0_ + vt_t) * D + h_ * 128 + vd0; vaN = *(const v4u*)vp_; vbN = *(const v4u*)(vp_ + 8); } while (0)
        if (bid < NH * NCHUNK) P2_LOADN(bid);
        for (int item = bid; item < NH * NCHUNK; item += G) {
            float cum[16], kk[16]; float run = 0.f;
#pragma unroll
            for (int i = 0; i < 16; ++i) { const float f = fN[i]; kk[i] = 1.0f - f; run += __logf(f); cum[i] = run; }
            tot[part * 128 + col] = run;
            *(LAS v4u*)(Vr + vt_t * 144 + vd0) = vaN; *(LAS v4u*)(Vr + vt_t * 144 + vd0 + 8) = vbN;
            if (item + G < NH * NCHUNK) P2_LOADN(item + G);
            __syncthreads();
            float offs = 0.f, lastv = 0.f;
#pragma unroll
            for (int p = 0; p < 4; ++p) { const float tv = tot[p * 128 + col]; lastv += tv; if (p < part) offs += tv; }
            unsigned kw[8];
#pragma unroll
            for (int i = 0; i < 8; ++i) { const float a = kk[2 * i] * __expf(lastv - (cum[2 * i] + offs)), b = kk[2 * i + 1] * __expf(lastv - (cum[2 * i + 1] + offs)); kw[i] = pk2(a, b); }
            *(LAS v4u*)(koT + col * 72 + part * 16) = (v4u){kw[0], kw[1], kw[2], kw[3]};
            *(LAS v4u*)(koT + col * 72 + part * 16 + 8) = (v4u){kw[4], kw[5], kw[6], kw[7]};
            if (part == 0) Dec[(size_t)item * 128 + col] = __expf(lastv);
            __syncthreads();
            { bf16x8 a[2]; a[0] = *(const LAS bf16x8*)(koT + (16 * wave + fr) * 72 + 8 * fq); a[1] = *(const LAS bf16x8*)(koT + (16 * wave + fr) * 72 + 32 + 8 * fq);
              bf16* ub = Ub + (size_t)item * 16384;
              const LAS bf16* vb = Vr + (8 * fq + (fr >> 2)) * 144 + 4 * (fr & 3);
#pragma unroll
              for (int vt = 0; vt < 8; ++vt) {
                  f32x4 acc = {0.f, 0.f, 0.f, 0.f};
                  const v2u l0 = tr_read(vb + 16 * vt), h0 = tr_read(vb + 4 * 144 + 16 * vt), l1 = tr_read(vb + 32 * 144 + 16 * vt), h1 = tr_read(vb + 36 * 144 + 16 * vt);
                  const v4u b0 = {l0.x, l0.y, h0.x, h0.y}, b1 = {l1.x, l1.y, h1.x, h1.y};
                  acc = MFMA16(a[0], __builtin_bit_cast(bf16x8, b0), acc); acc = MFMA16(a[1], __builtin_bit_cast(bf16x8, b1), acc);
                  v2u w; w.x = pk2(acc[0], acc[1]); w.y = pk2(acc[2], acc[3]);
                  *(v2u*)(ub + (size_t)(16 * vt + fr) * 128 + 16 * wave + 4 * fq) = w;
              } }
            __syncthreads();
        }
#undef P2_LOADN
        LAS float* red = (LAS float*)(lds);
        LAS float* red2 = (LAS float*)(lds + 8192);
        float* st_out = out + OST_S;
        for (int item = bid; item < DECB * NH; item += G) {
            const int b = item >> 4, h = item & 15; const int vd = tid & 127, kq = tid >> 7;
            const float* sp = st_in + ((size_t)(b * NH + h) * 128 + 32 * kq) * 128 + vd;
            float Sx[32];
#pragma unroll
            for (int i = 0; i < 32; ++i) Sx[i] = __builtin_nontemporal_load(sp + (size_t)i * 128);
#pragma unroll
            for (int t = 0; t < 4; ++t) {
                const int row = SEQ + 4 * b + t; const size_t ro = (size_t)row * D + h * 128;
                const float v = bf2f(Vg[ro + vd]); float op = 0.f;
#pragma unroll
                for (int i = 0; i < 32; ++i) { const float f = Ff[ro + 32 * kq + i]; const float q = bf2f(Qg[ro + 32 * kq + i]); Sx[i] = f * Sx[i] + (1.0f - f) * v; op += Sx[i] * q; }
                red[(t * 4 + kq) * 128 + vd] = op;
            }
            float* so = st_out + ((size_t)(b * NH + h) * 128 + 32 * kq) * 128 + vd;
#pragma unroll
            for (int i = 0; i < 32; ++i) __builtin_nontemporal_store(Sx[i], so + (size_t)i * 128);
            __syncthreads();
            { const int t = tid >> 7; const float o = (red[(t * 4 + 0) * 128 + vd] + red[(t * 4 + 1) * 128 + vd]) + (red[(t * 4 + 2) * 128 + vd] + red[(t * 4 + 3) * 128 + vd]);
              const float s = wave_sum(o * o); if (lane == 0) red2[t * 2 + (wave & 1)] = s;
              __syncthreads();
              const float r = rsqrtf((red2[t * 2] + red2[t * 2 + 1]) * (1.0f / 128.0f) + EPS);
              const int row = SEQ + 4 * b + t; const size_t ro = (size_t)row * D + h * 128 + vd;
              Ob[ro] = (bf16)f2bf(o * r * onorm[vd] * bf2f(Gg[ro])); }
            __syncthreads();
        }
    }
    xcd_barrier(bar, IS_T0);
    STAMP();

    {
        TIDS;
        for (int gid = bid * NTHR + tid; gid < NH * 128 * 32; gid += G * NTHR) {
            const int h = gid >> 12, rem = gid & 4095, vd = rem >> 5, k = (rem & 31) * 4;
            float s0 = 0.f, s1 = 0.f, s2 = 0.f, s3 = 0.f;
            const v2u* up = (const v2u*)(Ub + ((size_t)h * 128 * 128 + vd) * 128 + k);
            v2u* sp = (v2u*)(Sst + ((size_t)h * 128 * 128 + vd) * 128 + k);
            const f32x4* dp = (const f32x4*)(Dec + (size_t)h * 128 * 128 + k);
#pragma unroll 16
            for (int c = 0; c < NCHUNK; ++c) {
                const v2u u = up[(size_t)c * 4096]; const f32x4 d = dp[(size_t)c * 32];
                v2u w; w.x = pk2(s0, s1); w.y = pk2(s2, s3); sp[(size_t)c * 4096] = w;
                s0 = d.x * s0 + bf2f(u.x & 0xffffu); s1 = d.y * s1 + bf2f(u.x >> 16); s2 = d.z * s2 + bf2f(u.y & 0xffffu); s3 = d.w * s3 + bf2f(u.y >> 16);
            }
            float* so = out + OST_P + ((size_t)h * 128 + k) * 128 + vd;
            so[0] = s0; so[128] = s1; so[256] = s2; so[384] = s3;
        }
    }
    xcd_barrier(bar, IS_T0);
    STAMP();

    {
        TIDS;
        LAS float* tot = (LAS float*)(lds);
        LAS float* refs = (LAS float*)(lds + 2048);
        LAS float* red = (LAS float*)(lds + 2560);
        LAS bf16* QE = (LAS bf16*)(lds + 4096);
        LAS bf16* KE = QE + 64 * 136;
        LAS bf16* QI = KE + 64 * 136;
        LAS bf16* Vr = QI + 64 * 136;
        LAS bf16* STs = Vr + 64 * 144;
        const int col = tid & 127, part = tid >> 7; const int vt_t = tid >> 3, vd0 = (tid & 7) * 16;
        const int tt = wave & 3, vh = wave >> 2;
        float fN[16]; bf16 qN[16]; v4u vaN, vbN, stN[4];
#define P4_LOADN(it_) do { const int h_ = (it_) >> 7, r0_ = ((it_) & 127) * 64; const float* fp_ = Ff + (size_t)(r0_ + part * 16) * D + h_ * 128 + col; const bf16* qp_ = Qg + (size_t)(r0_ + part * 16) * D + h_ * 128 + col; \
            _Pragma("unroll") for (int i = 0; i < 16; ++i) { fN[i] = fp_[(size_t)i * D]; qN[i] = qp_[(size_t)i * D]; } \
            const bf16* vp_ = Vg + (size_t)(r0_ + vt_t) * D + h_ * 128 + vd0; vaN = *(const v4u*)vp_; vbN = *(const v4u*)(vp_ + 8); \
            const v4u* sp_ = (const v4u*)(Sst + (size_t)(it_) * 16384); _Pragma("unroll") for (int i = 0; i < 4; ++i) stN[i] = sp_[i * 512 + tid]; } while (0)
        if (bid < NH * NCHUNK) P4_LOADN(bid);
        for (int item = bid; item < NH * NCHUNK; item += G) {
            const int h = item >> 7, c = item & 127; const int row0 = c * 64;
            float cum[16], kk[16], qv[16]; float run = 0.f;
#pragma unroll
            for (int i = 0; i < 16; ++i) { const float f = fN[i]; kk[i] = 1.0f - f; run += __logf(f); cum[i] = run; qv[i] = bf2f(qN[i]); }
            tot[part * 128 + col] = run;
            *(LAS v4u*)(Vr + vt_t * 144 + vd0) = vaN; *(LAS v4u*)(Vr + vt_t * 144 + vd0 + 8) = vbN;
#pragma unroll
            for (int i = 0; i < 4; ++i) { const int idx = i * 512 + tid, vd = idx >> 4, k8 = idx & 15; *(LAS v4u*)(STs + vd * 136 + k8 * 8) = stN[i]; }
            const size_t ro = (size_t)(row0 + 16 * tt + fr) * D + h * 128;
            v2u gw2[4]; f32x4 on[4];
#pragma unroll
            for (int vt = 0; vt < 4; ++vt) { const int vd = 16 * (4 * vh + vt) + 4 * fq; gw2[vt] = *(const v2u*)(Gg + ro + vd); on[vt] = *(const f32x4*)(onorm + vd); }
            if (item + G < NH * NCHUNK) P4_LOADN(item + G);
            __syncthreads();
            float offs = 0.f;
#pragma unroll
            for (int p = 0; p < 4; ++p) { const float tv = tot[p * 128 + col]; if (p < part) offs += tv; }
            if (part == 1) refs[col] = cum[15] + offs;
            __syncthreads();
            const float ref = refs[col];
#pragma unroll
            for (int i = 0; i < 16; ++i) { const float cm = cum[i] + offs, d1 = cm - ref; const int t = part * 16 + i;
                QE[t * 136 + col] = (bf16)f2bf(qv[i] * __expf(d1)); KE[t * 136 + col] = (bf16)f2bf(kk[i] * __expf(-d1)); QI[t * 136 + col] = (bf16)f2bf(qv[i] * __expf(cm)); }
            __syncthreads();
            {
                f32x4 aS[4];
#pragma unroll
                for (int st = 0; st < 4; ++st) {
                    aS[st] = (f32x4){0.f, 0.f, 0.f, 0.f};
                    if (st <= tt) {
#pragma unroll
                        for (int ks = 0; ks < 4; ++ks) { const bf16x8 a = *(const LAS bf16x8*)(KE + (16 * st + fr) * 136 + 32 * ks + 8 * fq), b = *(const LAS bf16x8*)(QE + (16 * tt + fr) * 136 + 32 * ks + 8 * fq); aS[st] = MFMA16(a, b, aS[st]); }
                        if (st == tt) {
#pragma unroll
                            for (int r = 0; r < 4; ++r) if (4 * fq + r > fr) aS[st][r] = 0.f;
                        }
                    }
                }
                f32x4 o[4];
#pragma unroll
                for (int vt = 0; vt < 4; ++vt) o[vt] = (f32x4){0.f, 0.f, 0.f, 0.f};
#pragma unroll
                for (int j = 0; j < 2; ++j) {
                    v4u pw; pw.x = cvt_pk_bf16(aS[2 * j][0], aS[2 * j][1]); pw.y = cvt_pk_bf16(aS[2 * j][2], aS[2 * j][3]); pw.z = cvt_pk_bf16(aS[2 * j + 1][0], aS[2 * j + 1][1]); pw.w = cvt_pk_bf16(aS[2 * j + 1][2], aS[2 * j + 1][3]);
                    const bf16x8 pf = __builtin_bit_cast(bf16x8, pw);
                    const LAS bf16* vb = Vr + (32 * j + 4 * fq + (fr >> 2)) * 144 + 64 * vh + 4 * (fr & 3);
#pragma unroll
                    for (int vt = 0; vt < 4; ++vt) { const v2u lo = tr_read(vb + 16 * vt), hi = tr_read(vb + 16 * 144 + 16 * vt); const v4u aw = {lo.x, lo.y, hi.x, hi.y};
                        o[vt] = MFMA16(__builtin_bit_cast(bf16x8, aw), pf, o[vt]); }
                }
#pragma unroll
                for (int ks = 0; ks < 4; ++ks) { const bf16x8 b = *(const LAS bf16x8*)(QI + (16 * tt + fr) * 136 + 32 * ks + 8 * fq);
#pragma unroll
                    for (int vt = 0; vt < 4; ++vt) { const bf16x8 a = *(const LAS bf16x8*)(STs + (16 * (4 * vh + vt) + fr) * 136 + 32 * ks + 8 * fq); o[vt] = MFMA16(a, b, o[vt]); } }
                float sq = 0.f;
#pragma unroll
                for (int vt = 0; vt < 4; ++vt) sq += (o[vt][0] * o[vt][0] + o[vt][1] * o[vt][1]) + (o[vt][2] * o[vt][2] + o[vt][3] * o[vt][3]);
                sq += shx<16>(sq); sq = xadd32(sq);
                if (fq == 0) red[(16 * tt + fr) * 2 + vh] = sq;
                __syncthreads();
                const float r = rsqrtf((red[(16 * tt + fr) * 2] + red[(16 * tt + fr) * 2 + 1]) * (1.0f / 128.0f) + EPS);
#pragma unroll
                for (int vt = 0; vt < 4; ++vt) { const int vd = 16 * (4 * vh + vt) + 4 * fq;
                    const float g0 = bf2f(gw2[vt].x & 0xffffu), g1 = bf2f(gw2[vt].x >> 16), g2 = bf2f(gw2[vt].y & 0xffffu), g3 = bf2f(gw2[vt].y >> 16);
                    v2u w; w.x = cvt_pk_bf16(o[vt][0] * r * on[vt][0] * g0, o[vt][1] * r * on[vt][1] * g1); w.y = cvt_pk_bf16(o[vt][2] * r * on[vt][2] * g2, o[vt][3] * r * on[vt][3] * g3);
                    *(v2u*)(Ob + ro + vd) = w; }
            }
            __syncthreads();
        }
#undef P4_LOADN
    }
    xcd_barrier(bar, IS_T0);
    STAMP();

    {
        TIDS;
        pg8::Gemm g{Ob, Wout_t, SEQ, D, D}; pg8::StaticOrder S; S.init(SEQ, D, G, bid);
        EpiRes<0> E{x_p, x_s, Hf1, nullptr, Hb1, ss1};
        const unsigned tg0 = TNOW();
        pg8::gemm_phase<EpiRes<0>, pg8::StaticOrder, true, true, false>(lds, g, S, E, TIDX);
        TACC(5, tg0); const unsigned tg1 = TNOW();
        { const int t2 = bid & 127, rh = (bid >> 7) & 1; TIDS; f32x4 ta[1]; tail_gemm<1>(lds, Ob + (size_t)SEQ * D, Wout_t, D, 16 * t2, rh, ta, TIDX); if (wave < 4) E.tail(SEQ + 64 * rh + 16 * wave + fr, 16 * t2 + 4 * fq, ta[0], fq); }
        TACC(6, tg1);
    }
    xcd_barrier(bar, IS_T0);
    STAMP();
    {
        TIDS;
        pg8::Gemm g{Hb1, Wgu0_t, MP, NGU, D}; pg8::StaticOrder S; S.init(MP, NGU, G, bid);
        EpiGU E{ss1, Hm};
        pg8::gemm_phase<EpiGU, pg8::StaticOrder, true, true>(lds, g, S, E, TIDX);
        kmean_items(lds, cache_k, ptab, Kms, 0, 336, 172, G - 172, TIDX);
    }
    xcd_barrier(bar, IS_T0);
    STAMP();
    {
        TIDS;
        pg8::Gemm g{Hm, Wdn0_t, SEQ, D, DFF}; pg8::StaticOrder S; S.init(SEQ, D, G, bid);
        EpiRes<1> E{Hf1, nullptr, Hf2, nullptr, Hb2, ss2};
        const unsigned tg0 = TNOW();
        pg8::gemm_phase<EpiRes<1>, pg8::StaticOrder, true, true, false>(lds, g, S, E, TIDX);
        TACC(7, tg0); const unsigned tg1 = TNOW();
        { const int t2 = bid & 127, rh = (bid >> 7) & 1; TIDS; f32x4 ta[1]; tail_gemm<1>(lds, Hm + (size_t)SEQ * DFF, Wdn0_t, DFF, 16 * t2, rh, ta, TIDX); if (wave < 4) E.tail(SEQ + 64 * rh + 16 * wave + fr, 16 * t2 + 4 * fq, ta[0], fq); }
        TACC(8, tg1);
    }
    xcd_barrier(bar, IS_T0);
    STAMP();
    {
        TIDS;
        pg8::Gemm g{Hb2, Wkvq_t, MP, 3072, D}; pg8::StaticOrder S; S.init(MP, 3072, G, bid);
        EpiKVQ E{ss2, ws};
        pg8::gemm_phase<EpiKVQ, pg8::StaticOrder, true, true>(lds, g, S, E, TIDX);
        kmean_items(lds, cache_k, ptab, Kms, 336, 848, 140, G - 140, TIDX);
    }
    xcd_barrier(bar, IS_T0);
    STAMP();

    {
        TIDS;
        LAS float* partk = (LAS float*)(lds);
        for (int grp = bid; grp < MR / 32; grp += G) {
            const int r0 = grp * 32; float cs[8];
#pragma unroll
            for (int j = 0; j < 8; ++j) cs[j] = 0.f;
#pragma unroll
            for (int i = 0; i < 4; ++i) {
                const int row = r0 + 4 * wave + i; const int c = lane * 8;
                const f32x4 k0 = *(const f32x4*)(Kraw + (size_t)row * 512 + c), k1 = *(const f32x4*)(Kraw + (size_t)row * 512 + c + 4);
                float sq = (k0[0] * k0[0] + k0[1] * k0[1]) + (k0[2] * k0[2] + k0[3] * k0[3]) + (k1[0] * k1[0] + k1[1] * k1[1]) + (k1[2] * k1[2] + k1[3] * k1[3]);
                sq += shx<1>(sq); sq += shx<2>(sq); sq += shx<4>(sq); sq += shx<8>(sq);
                const float rk = rsqrtf(sq * (1.0f / 128.0f) + EPS);
                const f32x4 g0 = *(const f32x4*)(k_norm + (c & 127)), g1 = *(const f32x4*)(k_norm + (c & 127) + 4);
                const f32x4 n0 = k0 * rk * g0, n1 = k1 * rk * g1;
                float* ko = (row < SEQ) ? out + OK_P + (size_t)row * 512 + c : out + OK_S + (size_t)(row - SEQ) * 512 + c;
                __builtin_nontemporal_store(n0, (f32x4*)ko); __builtin_nontemporal_store(n1, (f32x4*)(ko + 4));
                v4u w; w.x = cvt_pk_bf16(n0[0], n0[1]); w.y = cvt_pk_bf16(n0[2], n0[3]); w.z = cvt_pk_bf16(n1[0], n1[1]); w.w = cvt_pk_bf16(n1[2], n1[3]);
                *(v4u*)(Kb + (size_t)row * 512 + c) = w;
#pragma unroll
                for (int j = 0; j < 4; ++j) { cs[j] += n0[j]; cs[4 + j] += n1[j]; }
                const f32x4 v0 = *(const f32x4*)(Vraw + (size_t)row * 512 + c), v1 = *(const f32x4*)(Vraw + (size_t)row * 512 + c + 4);
                float* vo = (row < SEQ) ? out + OV_P + (size_t)row * 512 + c : out + OV_S + (size_t)(row - SEQ) * 512 + c;
                __builtin_nontemporal_store(v0, (f32x4*)vo); __builtin_nontemporal_store(v1, (f32x4*)(vo + 4));
                v4u wv; wv.x = cvt_pk_bf16(v0[0], v0[1]); wv.y = cvt_pk_bf16(v0[2], v0[3]); wv.z = cvt_pk_bf16(v1[0], v1[1]); wv.w = cvt_pk_bf16(v1[2], v1[3]);
                *(v4u*)(Vb + (size_t)row * 512 + c) = wv;
            }
#pragma unroll
            for (int j = 0; j < 8; ++j) partk[wave * 512 + lane * 8 + j] = cs[j];
            __syncthreads();
            if (r0 < SEQ) {
                float s = 0.f;
#pragma unroll
                for (int w8 = 0; w8 < 8; ++w8) s += partk[w8 * 512 + tid];
                Kpart[(size_t)grp * 512 + tid] = s;
            }
            __syncthreads();
        }
        for (int row = bid * NWAVES + wave; row < MR; row += G * NWAVES) {
#pragma unroll
            for (int j = 0; j < 4; ++j) {
                const int c = j * 512 + lane * 8;
                const f32x4 q0 = *(const f32x4*)(Qraw + (size_t)row * D + c), q1 = *(const f32x4*)(Qraw + (size_t)row * D + c + 4);
                float sq = (q0[0] * q0[0] + q0[1] * q0[1]) + (q0[2] * q0[2] + q0[3] * q0[3]) + (q1[0] * q1[0] + q1[1] * q1[1]) + (q1[2] * q1[2] + q1[3] * q1[3]);
                sq += shx<1>(sq); sq += shx<2>(sq); sq += shx<4>(sq); sq += shx<8>(sq);
                const float rq = rsqrtf(sq * (1.0f / 128.0f) + EPS) * C2;
                const f32x4 g0 = *(const f32x4*)(q_norm + (c & 127)), g1 = *(const f32x4*)(q_norm + (c & 127) + 4);
                const f32x4 n0 = q0 * rq * g0, n1 = q1 * rq * g1;
                v4u w; w.x = cvt_pk_bf16(n0[0], n0[1]); w.y = cvt_pk_bf16(n0[2], n0[3]); w.z = cvt_pk_bf16(n1[0], n1[1]); w.w = cvt_pk_bf16(n1[2], n1[3]);
                *(v4u*)(Qb + (size_t)row * D + c) = w;
            }
        }
    }
    xcd_barrier(bar, IS_T0);
    STAMP();

    {
        TIDS;
        LAS bf16* KMb = (LAS bf16*)(lds);
        LAS unsigned* lcnt = (LAS unsigned*)(lds + 16384);
        LAS float* gs = (LAS float*)(lds + 16384 + 256);
#define G_BETTER(va, ia, vb, ib) (((va) > (vb)) || (((va) == (vb)) && ((ia) < (ib))))
#define G_INSERT(vx, ix) do { const float vx_ = (vx); const int ix_ = (ix); \
            if (G_BETTER(vx_, ix_, v0, i0)) { v2 = v1; i2 = i1; v1 = v0; i1 = i0; v0 = vx_; i0 = ix_; } \
            else if (G_BETTER(vx_, ix_, v1, i1)) { v2 = v1; i2 = i1; v1 = vx_; i1 = ix_; } \
            else if (G_BETTER(vx_, ix_, v2, i2)) { v2 = vx_; i2 = ix_; } } while (0)
        for (int item = bid; item < 256; item += G) {
            const int j = item >> 2, kvh = item & 3; const int b = j >> 1;
            { const int n = tid >> 4, d8 = (tid & 15) * 8; f32x4 s0 = {0.f, 0.f, 0.f, 0.f}, s1 = {0.f, 0.f, 0.f, 0.f};
              if (n < b) {
#pragma unroll
                  for (int sub = 0; sub < 8; ++sub) { const float* kp = Kpart + (size_t)(n * 8 + sub) * 512 + kvh * 128 + d8; s0 += *(const f32x4*)kp; s1 += *(const f32x4*)(kp + 4); } }
              s0 = s0 * (1.0f / 256.0f); s1 = s1 * (1.0f / 256.0f);
              v4u w; w.x = cvt_pk_bf16(s0[0], s0[1]); w.y = cvt_pk_bf16(s0[2], s0[3]); w.z = cvt_pk_bf16(s1[0], s1[1]); w.w = cvt_pk_bf16(s1[2], s1[3]);
              *(LAS v4u*)(KMb + n * 136 + d8) = w; }
            if (tid < 32) lcnt[tid] = 0u;
            __syncthreads();
            const int nsel = b < 3 ? b : 3;
#pragma unroll 1
            for (int rt = 0; rt < 4; ++rt) {
                const int r = 64 * wave + 16 * rt + fr; const int tok = j * 128 + (r >> 2), hg = r & 3; const bf16* qp = Qb + (size_t)tok * D + (4 * kvh + hg) * 128 + 8 * fq;
                bf16x8 qf[4];
#pragma unroll
                for (int ks = 0; ks < 4; ++ks) qf[ks] = *(const bf16x8*)(qp + 32 * ks);
                f32x4 ga[2];
#pragma unroll
                for (int nt = 0; nt < 2; ++nt) { ga[nt] = (f32x4){0.f, 0.f, 0.f, 0.f};
#pragma unroll
                    for (int ks = 0; ks < 4; ++ks) { const bf16x8 ka = *(const LAS bf16x8*)(KMb + (16 * nt + fr) * 136 + 32 * ks + 8 * fq); ga[nt] = MFMA16(ka, qf[ks], ga[nt]); } }
                float v0 = -INFINITY, v1 = -INFINITY, v2 = -INFINITY; int i0 = 99, i1 = 99, i2 = 99;
#pragma unroll
                for (int nt = 0; nt < 2; ++nt)
#pragma unroll
                    for (int q = 0; q < 4; ++q) { const int n = 16 * nt + 4 * fq + q; if (n < b) G_INSERT(ga[nt][q], n); }
                { const float a0 = shx<16>(v0), a1 = shx<16>(v1), a2 = shx<16>(v2);
                  const int c0 = __builtin_amdgcn_ds_swizzle(i0, (16 << 10) | 0x1f), c1 = __builtin_amdgcn_ds_swizzle(i1, (16 << 10) | 0x1f), c2 = __builtin_amdgcn_ds_swizzle(i2, (16 << 10) | 0x1f);
                  G_INSERT(a0, c0); G_INSERT(a1, c1); G_INSERT(a2, c2); }
                {
                  auto p0 = __builtin_amdgcn_permlane32_swap(__float_as_uint(v0), __float_as_uint(v0), false, false); auto p1 = __builtin_amdgcn_permlane32_swap(__float_as_uint(v1), __float_as_uint(v1), false, false);
                  auto p2 = __builtin_amdgcn_permlane32_swap(__float_as_uint(v2), __float_as_uint(v2), false, false);
                  auto q0 = __builtin_amdgcn_permlane32_swap((unsigned)i0, (unsigned)i0, false, false); auto q1 = __builtin_amdgcn_permlane32_swap((unsigned)i1, (unsigned)i1, false, false);
                  auto q2 = __builtin_amdgcn_permlane32_swap((unsigned)i2, (unsigned)i2, false, false);
                  v0 = __uint_as_float(p0[0]); v1 = __uint_as_float(p1[0]); v2 = __uint_as_float(p2[0]); i0 = (int)q0[0]; i1 = (int)q1[0]; i2 = (int)q2[0];
                  G_INSERT(__uint_as_float(p0[1]), (int)q0[1]); G_INSERT(__uint_as_float(p1[1]), (int)q1[1]); G_INSERT(__uint_as_float(p2[1]), (int)q2[1]); }
                if (fq == 0) {
#pragma unroll
                    for (int rk = 0; rk < 3; ++rk) {
                        if (rk < nsel) { const int best = (rk == 0) ? i0 : ((rk == 1) ? i1 : i2);
                            const unsigned pos = atomicAdd((unsigned*)&lcnt[best], 1u);
                            Subl[((size_t)(j * 4 + kvh) * 32 + best) * 512 + pos] = (unsigned)r | ((unsigned)rk << 9); }
                    }
                }
            }
            __syncthreads();
            if (tid < 32) Scnt[(j * 4 + kvh) * 32 + tid] = lcnt[tid];
            __syncthreads();
        }
#undef G_BETTER
#undef G_INSERT
        for (int item = bid; item < DECB * NKV; item += G) {
            const int b = item >> 2, kvh = item & 3; const int pr = tid >> 5, n = tid & 31;
            const int row = SEQ + 4 * b + (pr >> 2), hg = pr & 3; const bf16* qp = Qb + (size_t)row * D + (4 * kvh + hg) * 128; const float* kmp = Kms + ((size_t)(b * 32 + n)) * 512 + kvh * 128;
            float s = 0.f;
#pragma unroll 4
            for (int d = 0; d < 128; d += 8) { const v4u qw = *(const v4u*)(qp + d); const f32x4 k0 = *(const f32x4*)(kmp + d), k1 = *(const f32x4*)(kmp + d + 4);
                s += (bf2f(qw.x & 0xffffu) * k0[0] + bf2f(qw.x >> 16) * k0[1]) + (bf2f(qw.y & 0xffffu) * k0[2] + bf2f(qw.y >> 16) * k0[3]) + (bf2f(qw.z & 0xffffu) * k1[0] + bf2f(qw.z >> 16) * k1[1]) + (bf2f(qw.w & 0xffffu) * k1[2] + bf2f(qw.w >> 16) * k1[3]); }
            gs[pr * 32 + n] = s;
            __syncthreads();
            if (tid < 16) { unsigned m = 0u;
                for (int r = 0; r < 3; ++r) { int best = 0; float bv = -INFINITY; for (int nn = 0; nn < 32; ++nn) { const float v = gs[tid * 32 + nn]; if (v > bv) { bv = v; best = nn; } } m |= 1u << best; gs[tid * 32 + best] = -INFINITY; }
                Sels[item * 16 + tid] = m; }
            __syncthreads();
        }
    }
    xcd_barrier(bar, IS_T0);
    STAMP();

    {
        LAS bf16* Ks = (LAS bf16*)(lds); LAS bf16* Vs = (LAS bf16*)(lds + KS_BYTES);
        LAS unsigned* qsh = (LAS unsigned*)(lds + 2 * KS_BYTES);
        constexpr int NPI = 4 * 496, NSI = DECB * NKV * NBLK;
#define P11_FETCH() do { if (IS_T0) qsh[0] = __hip_atomic_fetch_add(ctl + CW_Q0, 1u, __ATOMIC_RELAXED, __HIP_MEMORY_SCOPE_AGENT); __syncthreads(); tick = (int)qsh[0]; __syncthreads(); } while (0)
#define P11_ITEM(t_) (((t_) < 3 * NPI) ? ((((t_) % 3) == 0) ? (t_) / 3 : NPI + 2 * ((t_) / 3) + ((t_) % 3 - 1)) : (t_))
#define P11_SLOAD(b_, kvh_, n_) do { const int pg0_ = ptab[(b_) * NPAGES + 2 * (n_)], pg1_ = ptab[(b_) * NPAGES + 2 * (n_) + 1]; \
            _Pragma("unroll") for (int i = 0; i < 16; ++i) { const int idx = i * 512 + tid, key = idx >> 5, c4 = idx & 31; const int page = (key < 128) ? pg0_ : pg1_; \
                const size_t go = (((size_t)page * PAGE + (key & 127)) * NKV + (kvh_)) * 128 + c4 * 4; \
                kst[i] = __builtin_nontemporal_load((const f32x4*)(cache_k + go)); vst[i] = __builtin_nontemporal_load((const f32x4*)(cache_v + go)); } } while (0)
        int tick; P11_FETCH();
        for (;;) {
            if (tick >= NPI + NSI) break;
            TIDS;
            const int item = P11_ITEM(tick);
            if (item < NPI) {
                int b = (int)((1.0f + sqrtf(1.0f + 2.0f * (float)item)) * 0.5f); while (2 * b * (b - 1) > item) --b; while (2 * (b + 1) * b <= item) ++b;
                const int rem = item - 2 * b * (b - 1); const int n = rem >> 2, kvh = rem & 3;
                const int cntA = (int)Scnt[((2 * b) * 4 + kvh) * 32 + n], cntB = (int)Scnt[((2 * b + 1) * 4 + kvh) * 32 + n]; const int total = cntA + cntB;
                if (total == 0) { P11_FETCH(); continue; }
                const unsigned tp0 = TNOW();
#pragma unroll
                for (int i = 0; i < 8; ++i) { const int idx = i * 512 + tid, key = idx >> 4, c8 = idx & 15; *(LAS v4u*)(Ks + key * KS_P + c8 * 8) = *(const v4u*)(Kb + (size_t)(256 * n + key) * 512 + kvh * 128 + c8 * 8); }
#pragma unroll
                for (int i = 0; i < 8; ++i) { const int idx = i * 512 + tid, key = idx >> 4, c8 = idx & 15; *(LAS v4u*)(Vs + key * KS_P + c8 * 8) = *(const v4u*)(Vb + (size_t)(256 * n + key) * 512 + kvh * 128 + c8 * 8); }
                __syncthreads();
                TACC(1, tp0); const unsigned tp1 = TNOW();
                const unsigned* LA = Subl + ((size_t)((2 * b) * 4 + kvh) * 32 + n) * 512; const unsigned* LB = Subl + ((size_t)((2 * b + 1) * 4 + kvh) * 32 + n) * 512;
#define LIST_ENT(i_) (((i_) < cntA) ? LA[(i_)] : LB[(i_) - cntA])
                const int iw = 16 * wave + fr;
                unsigned e1 = 0u, e2 = 0u; int ic1 = 0, ic2 = 0;
                if (16 * wave < total) { ic1 = iw < total ? iw : total - 1; e1 = LIST_ENT(ic1); }
                if (16 * wave + 128 < total) { ic2 = iw + 128 < total ? iw + 128 : total - 1; e2 = LIST_ENT(ic2); }
                bf16x8 qn[4];
                { const int tokn = ((ic1 < cntA) ? 2 * b : 2 * b + 1) * 128 + (int)((e1 >> 2) & 127u); const bf16* qp = Qb + (size_t)tokn * D + (4 * kvh + (int)(e1 & 3u)) * 128 + 8 * fq;
#pragma unroll
                  for (int ks = 0; ks < 4; ++ks) qn[ks] = *(const bf16x8*)(qp + 32 * ks); }
                for (int t0 = 0; t0 < total; t0 += 128) {
                    const int i0 = t0 + 16 * wave; if (i0 >= total) break;
                    const bool valid = (i0 + fr) < total; const int ic = ic1; const unsigned e = e1;
                    const int tok = ((ic < cntA) ? 2 * b : 2 * b + 1) * 128 + (int)((e >> 2) & 127u), hg = (int)(e & 3u), rk = (int)(e >> 9);
                    const int h = 4 * kvh + hg;
                    bf16x8 qf[4];
#pragma unroll
                    for (int ks = 0; ks < 4; ++ks) qf[ks] = qn[ks];
                    e1 = e2; ic1 = ic2;
                    if (i0 + 256 < total) { ic2 = (i0 + 256 + fr) < total ? (i0 + 256 + fr) : total - 1; e2 = LIST_ENT(ic2); }
                    if (i0 + 128 < total) { const int tokn = ((ic1 < cntA) ? 2 * b : 2 * b + 1) * 128 + (int)((e1 >> 2) & 127u); const bf16* qp = Qb + (size_t)tokn * D + (4 * kvh + (int)(e1 & 3u)) * 128 + 8 * fq;
#pragma unroll
                        for (int ks = 0; ks < 4; ++ks) qn[ks] = *(const bf16x8*)(qp + 32 * ks); }
                    f32x4 acc[16]; attn_scores<16>(Ks, qf, acc, 16, fr, fq);
                    float mx = -INFINITY;
#pragma unroll
                    for (int kt = 0; kt < 16; ++kt) mx = fmaxf(fmaxf(mx, fmaxf(acc[kt][0], acc[kt][1])), fmaxf(acc[kt][2], acc[kt][3]));
                    mx = fmaxf(mx, shx<16>(mx)); mx = xmax32(mx);
                    float l = 0.f;
#pragma unroll
                    for (int kt = 0; kt < 16; ++kt) {
#pragma unroll
                        for (int r = 0; r < 4; ++r) { const float p = __builtin_amdgcn_exp2f(acc[kt][r] - mx); acc[kt][r] = p; l += p; } }
                    l += shx<16>(l); l = xadd32(l);
                    f32x4 O[8];
#pragma unroll
                    for (int vt = 0; vt < 8; ++vt) O[vt] = (f32x4){0.f, 0.f, 0.f, 0.f};
                    attn_pv(Vs, acc, O, 8, fr, fq);
                    if (valid) {
                        const size_t slot = ((size_t)tok * NH + h) * 3 + rk; bf16* op = Oslot + slot * 128 + 4 * fq;
#pragma unroll
                        for (int vt = 0; vt < 8; ++vt) { v2u w; w.x = cvt_pk_bf16(O[vt][0], O[vt][1]); w.y = cvt_pk_bf16(O[vt][2], O[vt][3]); *(v2u*)(op + 16 * vt) = w; }
                        if (fq == 0) { MLslot[slot * 2] = mx; MLslot[slot * 2 + 1] = l; }
                    }
                }
                __syncthreads();
                TACC(2, tp1);
                P11_FETCH();
            } else {
                const int si = item - NPI; int b = si >> 7, kvh = (si >> 5) & 3, n = si & 31;
                {
                    unsigned any = 0u;
#pragma unroll
                    for (int p = 0; p < 16; ++p) any |= Sels[(b * 4 + kvh) * 16 + p];
                    if (!((any >> n) & 1u)) { P11_FETCH(); continue; }
                }
                f32x4 kst[16], vst[16];
                P11_SLOAD(b, kvh, n);
                for (;;) {
                bool pre = false; int nb = 0, nkvh = 0, nn = 0;
                const unsigned ts0 = TNOW();
#pragma unroll
                for (int i = 0; i < 16; ++i) { const int idx = i * 512 + tid, key = idx >> 5, c4 = idx & 31;
                    const f32x4 kk4 = kst[i], vv4 = vst[i];
                    v2u w; w.x = cvt_pk_bf16(kk4[0], kk4[1]); w.y = cvt_pk_bf16(kk4[2], kk4[3]); *(LAS v2u*)(Ks + key * KS_P + c4 * 4) = w;
                    v2u wv; wv.x = cvt_pk_bf16(vv4[0], vv4[1]); wv.y = cvt_pk_bf16(vv4[2], vv4[3]); *(LAS v2u*)(Vs + key * KS_P + c4 * 4) = wv; }
                if (IS_T0) qsh[0] = __hip_atomic_fetch_add(ctl + CW_Q0, 1u, __ATOMIC_RELAXED, __HIP_MEMORY_SCOPE_AGENT);
                __syncthreads();
                const int ntick = (int)qsh[0];
                if (ntick < NPI + NSI) { const int nitem = P11_ITEM(ntick);
                    if (nitem >= NPI) { const int nsi = nitem - NPI; nb = nsi >> 7; nkvh = (nsi >> 5) & 3; nn = nsi & 31;
                        unsigned any2 = 0u;
#pragma unroll
                        for (int p = 0; p < 16; ++p) any2 |= Sels[(nb * 4 + nkvh) * 16 + p];
                        if ((any2 >> nn) & 1u) { P11_SLOAD(nb, nkvh, nn); pre = true; } } }
                TACC(3, ts0); const unsigned ts1 = TNOW();
                {
                    LAS float* mxs = (LAS float*)(lds + 2 * KS_BYTES + 64); LAS float* lss = mxs + 128; LAS float* Ored = (LAS float*)(lds);
                    const int row = SEQ + 4 * b + (fr >> 2), hg = fr & 3; const int h = 4 * kvh + hg; const bf16* qp = Qb + (size_t)row * D + h * 128 + 8 * fq;
                    bf16x8 qf[4];
#pragma unroll
                    for (int ks = 0; ks < 4; ++ks) qf[ks] = *(const bf16x8*)(qp + 32 * ks);
                    f32x4 a2[2];
#pragma unroll
                    for (int t = 0; t < 2; ++t) { a2[t] = (f32x4){0.f, 0.f, 0.f, 0.f};
#pragma unroll
                        for (int ks = 0; ks < 4; ++ks) { const bf16x8 ka = *(const LAS bf16x8*)(Ks + (16 * (2 * wave + t) + fr) * KS_P + 32 * ks + 8 * fq); a2[t] = MFMA16(ka, qf[ks], a2[t]); } }
                    float mx = fmaxf(fmaxf(fmaxf(a2[0][0], a2[0][1]), fmaxf(a2[0][2], a2[0][3])), fmaxf(fmaxf(a2[1][0], a2[1][1]), fmaxf(a2[1][2], a2[1][3])));
                    mx = fmaxf(mx, shx<16>(mx)); mx = xmax32(mx);
                    if (fq == 0) mxs[wave * 16 + fr] = mx;
                    __syncthreads();
                    float M = mxs[fr];
#pragma unroll
                    for (int w8 = 1; w8 < 8; ++w8) M = fmaxf(M, mxs[w8 * 16 + fr]);
                    float l = 0.f;
#pragma unroll
                    for (int t = 0; t < 2; ++t) {
#pragma unroll
                        for (int r = 0; r < 4; ++r) { const float p = __builtin_amdgcn_exp2f(a2[t][r] - M); a2[t][r] = p; l += p; } }
                    l += shx<16>(l); l = xadd32(l);
                    if (fq == 0) lss[wave * 16 + fr] = l;
                    v4u pw; pw.x = cvt_pk_bf16(a2[0][0], a2[0][1]); pw.y = cvt_pk_bf16(a2[0][2], a2[0][3]); pw.z = cvt_pk_bf16(a2[1][0], a2[1][1]); pw.w = cvt_pk_bf16(a2[1][2], a2[1][3]);
                    const bf16x8 pf = __builtin_bit_cast(bf16x8, pw);
                    const LAS bf16* vb = Vs + (32 * wave + 4 * fq + (fr >> 2)) * KS_P + 4 * (fr & 3);
#pragma unroll
                    for (int vt = 0; vt < 8; ++vt) { const v2u lo = tr_read(vb + 16 * vt), hi = tr_read(vb + 16 * KS_P + 16 * vt); const v4u aw = {lo.x, lo.y, hi.x, hi.y};
                        const f32x4 o = MFMA16(__builtin_bit_cast(bf16x8, aw), pf, ((f32x4){0.f, 0.f, 0.f, 0.f}));
                        *(LAS f32x4*)(Ored + (wave * 16 + fr) * 132 + 16 * vt + 4 * fq) = o; }
                    __syncthreads();
                    { const int r16 = tid >> 5, c4 = tid & 31; f32x4 so = *(const LAS f32x4*)(Ored + r16 * 132 + 4 * c4);
#pragma unroll
                      for (int w8 = 1; w8 < 8; ++w8) so += *(const LAS f32x4*)(Ored + (w8 * 16 + r16) * 132 + 4 * c4);
                      float* sp = Sslot + ((size_t)((b * 4 + kvh) * 32 + n) * 16 + r16) * 132;
                      *(f32x4*)(sp + 4 * c4) = so;
                      if (c4 == 0) { float Mr = mxs[r16], lt = lss[r16];
#pragma unroll
                          for (int w8 = 1; w8 < 8; ++w8) { Mr = fmaxf(Mr, mxs[w8 * 16 + r16]); lt += lss[w8 * 16 + r16]; }
                          sp[128] = Mr; sp[129] = lt; } }
                }
                __syncthreads();
                TACC(4, ts1);
                tick = ntick;
                if (!pre) break;
                b = nb; kvh = nkvh; n = nn;
                }
            }
        }
#undef P11_FETCH
#undef P11_ITEM
#undef P11_SLOAD
    }
    xcd_barrier(bar, IS_T0);
    STAMP();

    {
        TIDS;
        LAS bf16* Ks = (LAS bf16*)(lds); LAS bf16* Vs = (LAS bf16*)(lds + KS_BYTES);
        for (int item = bid; item < NBLK * NKV * 2; item += G) {
            const int b = item >> 3, kvh = (item >> 1) & 3, hp = item & 1;
#pragma unroll
            for (int i = 0; i < 8; ++i) { const int idx = i * 512 + tid, key = idx >> 4, c8 = idx & 15; *(LAS v4u*)(Ks + key * KS_P + c8 * 8) = *(const v4u*)(Kb + (size_t)(256 * b + key) * 512 + kvh * 128 + c8 * 8); }
#pragma unroll
            for (int i = 0; i < 8; ++i) { const int idx = i * 512 + tid, key = idx >> 4, c8 = idx & 15; *(LAS v4u*)(Vs + key * KS_P + c8 * 8) = *(const v4u*)(Vb + (size_t)(256 * b + key) * 512 + kvh * 128 + c8 * 8); }
            const int nsel = b < 3 ? b : 3;
            bf16x8 qn[4];
            { const bf16* qp = Qb + (size_t)(256 * b + 16 * wave + fr) * D + (4 * kvh + 2 * hp) * 128 + 8 * fq;
#pragma unroll
              for (int ks = 0; ks < 4; ++ks) qn[ks] = *(const bf16x8*)(qp + 32 * ks); }
            __syncthreads();
#pragma unroll 1
            for (int u = 0; u < 4; ++u) {
                const int g = (u & 1) ? 15 - wave : wave, h = 4 * kvh + 2 * hp + (u >> 1); const int tl = 16 * g + fr; const int tok = 256 * b + tl;
                bf16x8 qf[4];
#pragma unroll
                for (int ks = 0; ks < 4; ++ks) qf[ks] = qn[ks];
                if (u < 3) { const int gn = ((u + 1) & 1) ? 15 - wave : wave, hn = 4 * kvh + 2 * hp + ((u + 1) >> 1); const bf16* qp = Qb + (size_t)(256 * b + 16 * gn + fr) * D + hn * 128 + 8 * fq;
#pragma unroll
                    for (int ks = 0; ks < 4; ++ks) qn[ks] = *(const bf16x8*)(qp + 32 * ks); }
                float msa[3], lsa[3];
#pragma unroll
                for (int r = 0; r < 3; ++r) { msa[r] = -INFINITY; lsa[r] = 0.f; if (r < nsel) { const size_t slot = ((size_t)tok * NH + h) * 3 + r; msa[r] = MLslot[slot * 2]; lsa[r] = MLslot[slot * 2 + 1]; } }
                const int nkt = g + 1;
                f32x4 acc[16]; attn_scores<16>(Ks, qf, acc, nkt, fr, fq);
                float mx = -INFINITY;
#pragma unroll
                for (int kt = 0; kt < 16; ++kt) {
#pragma unroll
                    for (int r = 0; r < 4; ++r) { const bool ok = (kt < nkt) && (16 * kt + 4 * fq + r <= tl); const float sv = ok ? acc[kt][r] : -INFINITY; acc[kt][r] = sv; mx = fmaxf(mx, sv); } }
                mx = fmaxf(mx, shx<16>(mx)); mx = xmax32(mx);
                float M = mx;
#pragma unroll
                for (int r = 0; r < 3; ++r) M = fmaxf(M, msa[r]);
                float l = 0.f;
#pragma unroll
                for (int kt = 0; kt < 16; ++kt) {
#pragma unroll
                    for (int r = 0; r < 4; ++r) { const float p = __builtin_amdgcn_exp2f(acc[kt][r] - M); acc[kt][r] = p; l += p; } }
                l += shx<16>(l); l = xadd32(l);
                f32x4 O[8];
#pragma unroll
                for (int vt = 0; vt < 8; ++vt) O[vt] = (f32x4){0.f, 0.f, 0.f, 0.f};
                attn_pv(Vs, acc, O, (nkt + 1) >> 1, fr, fq);
#pragma unroll
                for (int r = 0; r < 3; ++r) { if (r < nsel) { const float sc = __builtin_amdgcn_exp2f(msa[r] - M); l += lsa[r] * sc; const size_t slot = ((size_t)tok * NH + h) * 3 + r; const bf16* op = Oslot + slot * 128 + 4 * fq;
#pragma unroll
                    for (int vt = 0; vt < 8; ++vt) { const v2u w = *(const v2u*)(op + 16 * vt); O[vt][0] += bf2f(w.x & 0xffffu) * sc; O[vt][1] += bf2f(w.x >> 16) * sc; O[vt][2] += bf2f(w.y & 0xffffu) * sc; O[vt][3] += bf2f(w.y >> 16) * sc; } } }
                const float il = 1.0f / l; bf16* ap = At + (size_t)tok * D + h * 128 + 4 * fq;
#pragma unroll
                for (int vt = 0; vt < 8; ++vt) { v2u w; w.x = cvt_pk_bf16(O[vt][0] * il, O[vt][1] * il); w.y = cvt_pk_bf16(O[vt][2] * il, O[vt][3] * il); *(v2u*)(ap + 16 * vt) = w; }
            }
            __syncthreads();
        }
        LAS float* ksn = (LAS float*)(lds);
        for (int item = bid; item < DECB * NKV; item += G) {
            const int b = item >> 2, kvh = item & 3;
            { const int key = tid >> 7, d = tid & 127; ksn[key * 128 + d] = out[OK_S + (size_t)(4 * b + key) * 512 + kvh * 128 + d]; ksn[512 + key * 128 + d] = Vraw[(size_t)(SEQ + 4 * b + key) * 512 + kvh * 128 + d]; }
            __syncthreads();
            const int pr = tid >> 5, l32 = tid & 31; const int t = pr >> 2, hg = pr & 3; const int row = SEQ + 4 * b + t, h = 4 * kvh + hg;
            const v2u qw = *(const v2u*)(Qb + (size_t)row * D + h * 128 + 4 * l32);
            const float q0 = bf2f(qw.x & 0xffffu), q1 = bf2f(qw.x >> 16), q2 = bf2f(qw.y & 0xffffu), q3 = bf2f(qw.y >> 16);
            float sk[4]; float M = -INFINITY;
#pragma unroll
            for (int key = 0; key < 4; ++key) { const f32x4 k4 = *(const LAS f32x4*)(ksn + key * 128 + 4 * l32); float s = (q0 * k4[0] + q1 * k4[1]) + (q2 * k4[2] + q3 * k4[3]);
                s += shx<1>(s); s += shx<2>(s); s += shx<4>(s); s += shx<8>(s); s += shx<16>(s);
                sk[key] = (key <= t) ? s : -INFINITY; M = fmaxf(M, sk[key]); }
            const unsigned mask = Sels[item * 16 + pr];
#pragma unroll 1
            for (int n = 0; n < 32; ++n) if ((mask >> n) & 1u) M = fmaxf(M, Sslot[((size_t)(item * 32 + n) * 16 + pr) * 132 + 128]);
            float l = 0.f; f32x4 O = {0.f, 0.f, 0.f, 0.f};
#pragma unroll
            for (int key = 0; key < 4; ++key) { const float p = __builtin_amdgcn_exp2f(sk[key] - M); l += p; O += *(const LAS f32x4*)(ksn + 512 + key * 128 + 4 * l32) * p; }
#pragma unroll 1
            for (int n = 0; n < 32; ++n) if ((mask >> n) & 1u) { const float* sp = Sslot + ((size_t)(item * 32 + n) * 16 + pr) * 132; const float sc = __builtin_amdgcn_exp2f(sp[128] - M); l += sp[129] * sc; O += *(const f32x4*)(sp + 4 * l32) * sc; }
            const float il = 1.0f / l; v2u w; w.x = cvt_pk_bf16(O[0] * il, O[1] * il); w.y = cvt_pk_bf16(O[2] * il, O[3] * il);
            *(v2u*)(At + (size_t)row * D + h * 128 + 4 * l32) = w;
            __syncthreads();
        }
    }
    xcd_barrier(bar, IS_T0);
    STAMP();

    {
        TIDS;
        pg8::Gemm g{At, Wo_t, SEQ, D, D}; pg8::StaticOrder S; S.init(SEQ, D, G, bid);
        EpiRes<1> E{Hf2, nullptr, Hf3, nullptr, Hb3, ss3};
        pg8::gemm_phase<EpiRes<1>, pg8::StaticOrder, true, true, false>(lds, g, S, E, TIDX);
        { const int t2 = bid & 127, rh = (bid >> 7) & 1; TIDS; f32x4 ta[1]; tail_gemm<1>(lds, At + (size_t)SEQ * D, Wo_t, D, 16 * t2, rh, ta, TIDX); if (wave < 4) E.tail(SEQ + 64 * rh + 16 * wave + fr, 16 * t2 + 4 * fq, ta[0], fq); }
    }
    xcd_barrier(bar, IS_T0);
    STAMP();
    {
        TIDS;
        pg8::Gemm g{Hb3, Wgu1_t, MP, NGU, D}; pg8::StaticOrder S; S.init(MP, NGU, G, bid);
        EpiGU E{ss3, Hm};
        pg8::gemm_phase<EpiGU, pg8::StaticOrder, true, true>(lds, g, S, E, TIDX);
    }
    xcd_barrier(bar, IS_T0);
    STAMP();
    {
        TIDS;
        pg8::Gemm g{Hm, Wdn1_t, SEQ, D, DFF}; pg8::StaticOrder S; S.init(SEQ, D, G, bid);
        EpiRes<2> E{Hf3, nullptr, out + OY_P, out + OY_S, nullptr, nullptr};
        pg8::gemm_phase<EpiRes<2>, pg8::StaticOrder, true, true, false>(lds, g, S, E, TIDX);
        { const int t2 = bid & 127, rh = (bid >> 7) & 1; TIDS; f32x4 ta[1]; tail_gemm<1>(lds, Hm + (size_t)SEQ * DFF, Wdn1_t, DFF, 16 * t2, rh, ta, TIDX); if (wave < 4) E.tail(SEQ + 64 * rh + 16 * wave + fr, 16 * t2 + 4 * fq, ta[0], fq); }
    }
#ifdef PROF_A
    STAMP();
    if (blockIdx.x == 0 && IS_T0) {
        const unsigned ta = PVAL(PROF_A0, PROF_A1), tb = PVAL(PROF_B0, PROF_B1);
        unsigned qa = (ta + PROF_UA / 2) / PROF_UA, qb = (tb + PROF_UB / 2) / PROF_UB; if (qa > 99u) qa = 99u; if (qb > 99u) qb = 99u;
#ifdef PROF_MUL
        const unsigned long long extra = (unsigned long long)ta * PROF_MUL;
#else
        const unsigned long long extra = (unsigned long long)(qa + 100u * qb) * 5000ull;
#endif
        const unsigned long long t0 = __builtin_amdgcn_s_memrealtime();
        while (__builtin_amdgcn_s_memrealtime() - t0 < extra) __builtin_amdgcn_s_sleep(32);
    }
#endif
}
#undef x_p
#undef x_s
#undef st_in
#undef cache_k
#undef cache_v
#undef ptab
#undef norm_mix_a
#undef w_in
#undef lbl
#undef onorm
#undef w_out
#undef norm_kv
#undef w_kv
#undef k_norm
#undef norm_mix_b
#undef w_q
#undef q_norm
#undef w_o
#undef norm_ffn
#undef w_gu
#undef w_dn
#undef Win_t
#undef Wout_t
#undef Wgu0_t
#undef Wdn0_t
#undef Wkvq_t
#undef Wo_t
#undef Wgu1_t
#undef Wdn1_t
#undef Hb0
#undef Hb1
#undef Hb2
#undef Hb3
#undef Hf1
#undef Hf2
#undef Hf3
#undef Qg
#undef Vg
#undef Gg
#undef Ff
#undef Ob
#undef At
#undef Hm
#undef Ub
#undef Sst
#undef Dec
#undef Kraw
#undef Vraw
#undef Qraw
#undef Kb
#undef Vb
#undef Qb
#undef Kpart
#undef Kms
#undef Subl
#undef Scnt
#undef Sels
#undef Oslot
#undef MLslot
#undef Sslot
#undef ss0
#undef ss1
#undef ss2
#undef ss3
#undef out
#undef TIDS
#undef TIDX
#undef IS_T0

extern "C" void kernel_launch(void* const* d_in, const int* in_sizes, int n_in, void* d_out, int out_size, void* d_ws, size_t ws_size, hipStream_t stream) {
    static int grid = 0;
    if (grid == 0) {
        if (n_in != 21 || ws_size < WS_END) { fprintf(stderr, "kernel_launch: unexpected n_in %d / ws %zu\n", n_in, ws_size); grid = -1; return; }
        int dev = 0, cus = 0, per_cu = 0;
        if (hipGetDevice(&dev) != hipSuccess || hipDeviceGetAttribute(&cus, hipDeviceAttributeMultiprocessorCount, dev) != hipSuccess) { grid = -1; return; }
        if (hipFuncSetAttribute((const void*)yoco_fwd, hipFuncAttributeMaxDynamicSharedMemorySize, LDS_BYTES) != hipSuccess) { fprintf(stderr, "kernel_launch: hipFuncSetAttribute failed\n"); grid = -1; return; }
        if (hipOccupancyMaxActiveBlocksPerMultiprocessor(&per_cu, (const void*)yoco_fwd, NTHR, LDS_BYTES) != hipSuccess || per_cu < 1) fprintf(stderr, "kernel_launch: occupancy query says %d\n", per_cu);
        (void)hipGetLastError();
        grid = cus;
        if (grid < 256) { fprintf(stderr, "kernel_launch: built for 256 CUs (got %d)\n", grid); grid = -1; return; }
        grid = 256;
    }
    if (grid < 0) return;
    (void)hipMemsetAsync((char*)d_ws + WS_CTL, 0, CTL_ZERO_BYTES, stream);
    Args a{};
    for (int i = 0; i < 21; ++i) a.in[i] = d_in[i];
    a.out = (float*)d_out; a.ws = (unsigned char*)d_ws;
    hipLaunchKernelGGL(yoco_fwd, dim3(grid), dim3(NTHR), LDS_BYTES, stream, a);
}
```

```cpp
#include <hip/hip_runtime.h>
#include <cstdio>
#include <cstdint>
__device__ __forceinline__ int lane_id() { int l = (int)__builtin_amdgcn_mbcnt_hi(~0u, __builtin_amdgcn_mbcnt_lo(~0u, 0u)); asm volatile("" : "+v"(l)); return l; }

namespace pg8 {
#define PG8_LAS __attribute__((address_space(3)))
typedef unsigned short bf16_t;
typedef short bf16x8 __attribute__((ext_vector_type(8)));
typedef float f32x4 __attribute__((ext_vector_type(4)));
typedef unsigned u32x4 __attribute__((ext_vector_type(4)));
typedef unsigned u32x2 __attribute__((ext_vector_type(2)));
constexpr int BM = 256, BK = 64, HALF = 128, HTB = HALF * BK * 2, STAGE_BYTES = 8 * HTB, NXCD = 8, WGM = 8;

__host__ __device__ __forceinline__ int lds_byte(int r, int c) { const int st = (r >> 4) * 2 + (c >> 5), rr = r & 15, cc = c & 31, ob = rr * 64 + cc * 2; return st * 1024 + (ob ^ (((ob >> 9) & 1) << 5)); }
__host__ __device__ __forceinline__ void stage_rc(int b, int& R, int& C) { const int st = b / 1024, sb = b % 1024, swz = sb ^ (((sb >> 9) & 1) << 5); R = (st >> 1) * 16 + swz / 64; C = (st & 1) * 32 + (swz % 64) / 2; }
__host__ __device__ __forceinline__ int perm32(int rho) { const int n = rho >> 4, i = rho & 15; return 8 * (i >> 2) + 4 * n + (i & 3); }

struct Unit { int pm, pn; };
struct Gemm { const bf16_t* A; const bf16_t* Bt; int M, N, K; };

struct StaticOrder {
    int nM, nN, nwg, G, c;
    __host__ __device__ void init(int M, int N, int G_, int c_) { nM = M / BM; nN = N / BM; nwg = nM * nN; G = G_; c = c_; }
    __host__ __device__ bool next(int i, Unit& u) const {
        const long L = (long)i * G + c; if (L >= nwg) return false;
        int wgid = (int)L; { const int q = nwg / NXCD, r = nwg % NXCD, xcd = wgid % NXCD, off = wgid / NXCD; wgid = (xcd < r ? xcd * (q + 1) : r * (q + 1) + (xcd - r) * q) + off; }
        const int nig = WGM * nN, gid = wgid / nig, fm = gid * WGM, gsz = (nM - fm) < WGM ? (nM - fm) : WGM;
        u.pm = fm + ((wgid % nig) % gsz); u.pn = (wgid % nig) / gsz; return true;
    }
    __device__ __forceinline__ void a_ready(const Unit&) const {}
    __device__ __forceinline__ void done(const Unit&) const {}
};

__device__ __forceinline__ unsigned cvt_pk_bf16(float lo, float hi) { unsigned r; asm volatile("v_cvt_pk_bf16_f32 %0, %1, %2" : "=v"(r) : "v"(lo), "v"(hi)); return r; }

template <class Epi, class Sched, bool ALIGN_EPI = false, bool SP2 = false, bool HALF_LAST = true>
__device__ __forceinline__ void gemm_phase(PG8_LAS unsigned char* lds, const Gemm g, const Sched& S, const Epi& E, int tidx) {
    int tid_ = tidx; asm volatile("" : "+v"(tid_));
    const int tid = tid_, wid = __builtin_amdgcn_readfirstlane(tid >> 6), lane = tid & 63, wr = wid >> 2, wc = wid & 3, fr = lane & 15, fq = lane >> 4;
    const int K = g.K, nt = K / BK;
    unsigned voffA[2], voffB[2];
#pragma unroll
    for (int i = 0; i < 2; ++i) { int R, C; stage_rc(tid * 16 + i * 8192, R, C); const int Rb = Epi::PERM ? ((R & ~31) + perm32(R & 31)) : R;
        voffA[i] = (unsigned)(R * K + C) * 2u; voffB[i] = (unsigned)(Rb * K + C) * 2u; }
    const size_t kstep = (size_t)(BK * 2);
    const size_t hstep = (size_t)HALF * K * 2;
    const size_t tstep = 2 * hstep;
    const unsigned ldsw = (unsigned)wid * 1024u;
    const int aoff = lds_byte(wr * 64 + fr, fq * 8), boff = lds_byte(wc * 32 + fr, fq * 8);
#define PG8_SA(b, h) (((b) * 2 + (h)) * HTB)
#define PG8_SB(b, h) ((4 + (b) * 2 + (h)) * HTB)
#define PG8_STAGE(bufoff, gbase, voff) do { _Pragma("unroll") for (int _i = 0; _i < 2; ++_i) \
        __builtin_amdgcn_global_load_lds((const unsigned*)((const char*)(gbase) + (voff)[_i]), (PG8_LAS unsigned*)(lds + (bufoff) + ldsw + _i * 8192), 16, 0, 0); } while (0)
#define PG8_LDA(dst, b, h) do { _Pragma("unroll") for (int m = 0; m < 4; ++m) _Pragma("unroll") for (int k = 0; k < 2; ++k) dst[m][k] = *(const PG8_LAS bf16x8*)(lds + PG8_SA(b, h) + aoff + m * 2048 + k * 1024); } while (0)
#define PG8_LDB(dst, b, h) do { _Pragma("unroll") for (int n = 0; n < 2; ++n) _Pragma("unroll") for (int k = 0; k < 2; ++k) dst[n][k] = *(const PG8_LAS bf16x8*)(lds + PG8_SB(b, h) + boff + n * 2048 + k * 1024); } while (0)
#define PG8_MMA(ai, bj, At, Bt) do { __builtin_amdgcn_s_setprio(1); _Pragma("unroll") for (int m = 0; m < 4; ++m) _Pragma("unroll") for (int n = 0; n < 2; ++n) _Pragma("unroll") for (int k = 0; k < 2; ++k) \
        acc[ai][bj][m][n] = __builtin_amdgcn_mfma_f32_16x16x32_bf16(Bt[n][k], At[m][k], acc[ai][bj][m][n], 0, 0, 0); __builtin_amdgcn_s_setprio(0); } while (0)
#define PG8_WAIT_V(n) asm volatile("s_waitcnt vmcnt(" #n ")" ::: "memory")
#define PG8_WAIT_L(n) asm volatile("s_waitcnt lgkmcnt(" #n ")" ::: "memory")
#define PG8_BAR __builtin_amdgcn_s_barrier()
#define PG8_SCHED __builtin_amdgcn_sched_barrier(0)
    Unit cur, nxt; int ui = 0;
    if (!S.next(0, cur)) return;
    f32x4 acc[2][2][4][2];
#pragma unroll
    for (int a = 0; a < 2; ++a)
#pragma unroll
        for (int b = 0; b < 2; ++b)
#pragma unroll
            for (int m = 0; m < 4; ++m)
#pragma unroll
                for (int n = 0; n < 2; ++n) acc[a][b][m][n] = (f32x4){0.f, 0.f, 0.f, 0.f};
    bf16x8 At[4][2], B0[2][2], B1[2][2];
    const char* cA = (const char*)g.A + (size_t)cur.pm * tstep; const char* cB = (const char*)g.Bt + (size_t)cur.pn * tstep;
    S.a_ready(cur);
    if constexpr (SP2) {
        PG8_STAGE(PG8_SB(0, 0), cB, voffB); PG8_STAGE(PG8_SB(0, 1), cB + hstep, voffB); PG8_STAGE(PG8_SA(0, 0), cA, voffA); PG8_STAGE(PG8_SA(0, 1), cA + hstep, voffA);
        if (wr == 1) PG8_BAR;
        PG8_WAIT_V(2); PG8_BAR;
        PG8_STAGE(PG8_SB(1, 0), cB + kstep, voffB); PG8_STAGE(PG8_SA(1, 0), cA + kstep, voffA); PG8_STAGE(PG8_SB(1, 1), cB + hstep + kstep, voffB);
        PG8_WAIT_V(6); PG8_BAR;
    } else {
        PG8_STAGE(PG8_SB(0, 0), cB, voffB); PG8_STAGE(PG8_SA(0, 0), cA, voffA); PG8_STAGE(PG8_SB(0, 1), cB + hstep, voffB); PG8_STAGE(PG8_SA(0, 1), cA + hstep, voffA);
        if (wr == 1) PG8_BAR;
        PG8_WAIT_V(4); PG8_BAR;
        PG8_STAGE(PG8_SB(1, 0), cB + kstep, voffB); PG8_STAGE(PG8_SA(1, 0), cA + kstep, voffA); PG8_STAGE(PG8_SB(1, 1), cB + hstep + kstep, voffB);
        PG8_WAIT_V(6); PG8_BAR;
    }
    for (;;) {
        const bool has_next = S.next(ui + 1, nxt);
        const bool half1 = HALF_LAST && (cur.pm == g.M / BM - 1);
        const char* nA = has_next ? (const char*)g.A + (size_t)nxt.pm * tstep : cA; const char* nB = has_next ? (const char*)g.Bt + (size_t)nxt.pn * tstep : cB;
        for (int t = 0; t < nt; t += 2) {
            const bool last = (t == nt - 2);
            const char* a1 = cA + (size_t)(t + 1) * kstep;
            const char* a2 = last ? nA : cA + (size_t)(t + 2) * kstep; const char* b2 = last ? nB : cB + (size_t)(t + 2) * kstep;
            const char* a3 = a2 + kstep; const char* b3 = b2 + kstep;
            if (last && has_next) S.a_ready(nxt);
            if constexpr (SP2) {
            PG8_LDB(B0, 0, 0); PG8_LDB(B1, 0, 1); PG8_SCHED; PG8_LDA(At, 0, 0); PG8_STAGE(PG8_SA(1, 1), a1 + hstep, voffA);
            PG8_WAIT_V(8); PG8_WAIT_L(0); PG8_BAR; PG8_MMA(0, 0, At, B0); PG8_MMA(0, 1, At, B1); PG8_BAR; PG8_SCHED;
            if (!half1) { PG8_LDA(At, 0, 1); } PG8_STAGE(PG8_SB(0, 0), b2, voffB); PG8_STAGE(PG8_SB(0, 1), b2 + hstep, voffB); PG8_STAGE(PG8_SA(0, 0), a2, voffA);
            PG8_WAIT_V(8); PG8_WAIT_L(0); PG8_BAR; if (!half1) { PG8_MMA(1, 0, At, B0); PG8_MMA(1, 1, At, B1); } PG8_BAR; PG8_SCHED;
            PG8_LDB(B0, 1, 0); PG8_LDB(B1, 1, 1); PG8_SCHED; PG8_LDA(At, 1, 0); PG8_STAGE(PG8_SA(0, 1), a2 + hstep, voffA);
            PG8_WAIT_V(8); PG8_WAIT_L(0); PG8_BAR; PG8_MMA(0, 0, At, B0); PG8_MMA(0, 1, At, B1); PG8_BAR; PG8_SCHED;
            if (!half1) { PG8_LDA(At, 1, 1); } PG8_STAGE(PG8_SB(1, 0), b3, voffB); PG8_STAGE(PG8_SB(1, 1), b3 + hstep, voffB); PG8_STAGE(PG8_SA(1, 0), a3, voffA);
            PG8_WAIT_V(8); PG8_WAIT_L(0); PG8_BAR; if (!half1) { PG8_MMA(1, 0, At, B0); PG8_MMA(1, 1, At, B1); } PG8_BAR; PG8_SCHED;
            } else {
            PG8_LDB(B0, 0, 0); PG8_SCHED; PG8_LDA(At, 0, 0); PG8_STAGE(PG8_SA(1, 1), a1 + hstep, voffA);
            PG8_WAIT_L(8); PG8_BAR; PG8_WAIT_L(0); PG8_MMA(0, 0, At, B0); PG8_BAR; PG8_SCHED;
            PG8_LDB(B1, 0, 1); PG8_STAGE(PG8_SB(0, 0), b2, voffB);
            PG8_BAR; PG8_WAIT_L(0); PG8_MMA(0, 1, At, B1); PG8_BAR;
            PG8_LDA(At, 0, 1); PG8_STAGE(PG8_SA(0, 0), a2, voffA);
            PG8_BAR; PG8_WAIT_L(0); PG8_MMA(1, 0, At, B0); PG8_BAR; PG8_SCHED;
            PG8_STAGE(PG8_SB(0, 1), b2 + hstep, voffB);
            PG8_WAIT_V(6); PG8_BAR; PG8_MMA(1, 1, At, B1); PG8_BAR;
            PG8_LDB(B0, 1, 0); PG8_SCHED; PG8_LDA(At, 1, 0); PG8_STAGE(PG8_SA(0, 1), a2 + hstep, voffA);
            PG8_WAIT_L(8); PG8_BAR; PG8_WAIT_L(0); PG8_MMA(0, 0, At, B0); PG8_BAR; PG8_SCHED;
            PG8_LDB(B1, 1, 1); PG8_STAGE(PG8_SB(1, 0), b3, voffB);
            PG8_BAR; PG8_WAIT_L(0); PG8_MMA(0, 1, At, B1); PG8_BAR;
            PG8_LDA(At, 1, 1); PG8_STAGE(PG8_SA(1, 0), a3, voffA);
            PG8_BAR; PG8_WAIT_L(0); PG8_MMA(1, 0, At, B0); PG8_BAR; PG8_SCHED;
            PG8_STAGE(PG8_SB(1, 1), b3 + hstep, voffB);
            PG8_WAIT_V(6); PG8_BAR; PG8_MMA(1, 1, At, B1); PG8_BAR;
            }
        }
        if constexpr (ALIGN_EPI) { if (wr == 0) PG8_BAR; }
        E(acc, cur, wr, wc, fr, fq);
        if (!has_next) break;
#pragma unroll
        for (int a = 0; a < 2; ++a)
#pragma unroll
            for (int b = 0; b < 2; ++b)
#pragma unroll
                for (int m = 0; m < 4; ++m)
#pragma unroll
                    for (int n = 0; n < 2; ++n) acc[a][b][m][n] = (f32x4){0.f, 0.f, 0.f, 0.f};
        cur = nxt; cA = nA; cB = nB; ++ui;
        if constexpr (ALIGN_EPI) { if (wr == 1) PG8_BAR; }
    }
    PG8_WAIT_V(0);
    if constexpr (!ALIGN_EPI) { if (wr == 0) PG8_BAR; }
    PG8_BAR;
#undef PG8_SA
#undef PG8_SB
#undef PG8_STAGE
#undef PG8_LDA
#undef PG8_LDB
#undef PG8_MMA
#undef PG8_WAIT_V
#undef PG8_WAIT_L
#undef PG8_BAR
#undef PG8_SCHED
}
}

constexpr int NWAVES = 8, NTHR = 512;
constexpr int D = 2048, SEQ = 8192, DECB = 32, DECS = 4, MS = DECB * DECS;
constexpr int MR = SEQ + MS;
constexpr int MP = 8448;
constexpr int NH = 16, HD = 128, NKV = 4, DFF = 5632, NGU = 2 * DFF;
constexpr int NCHUNK = SEQ / 64;
constexpr int NPAGES = 64, PAGE = 128, NBLK = 32;
constexpr float EPS = 1e-6f;
constexpr float C2 = 0.08838834764831845f * 1.4426950408889634f;

constexpr size_t OY_P = 0, OY_S = OY_P + (size_t)SEQ * D, OST_P = OY_S + (size_t)MS * D, OST_S = OST_P + (size_t)NH * 128 * 128,
                 OK_P = OST_S + (size_t)DECB * NH * 128 * 128, OV_P = OK_P + (size_t)SEQ * 512, OK_S = OV_P + (size_t)SEQ * 512, OV_S = OK_S + (size_t)MS * 512;

constexpr size_t MiB = 1u << 20;
constexpr size_t WS_CTL = 0, CTL_ZERO_BYTES = 1 * MiB;
constexpr size_t WS_WIN = 2 * MiB;
constexpr size_t WS_WOUT = WS_WIN + 32 * MiB;
constexpr size_t WS_WGU0 = WS_WOUT + 8 * MiB;
constexpr size_t WS_WDN0 = WS_WGU0 + 44 * MiB;
constexpr size_t WS_WKVQ = WS_WDN0 + 22 * MiB;
constexpr size_t WS_WO = WS_WKVQ + 12 * MiB;
constexpr size_t WS_WGU1 = WS_WO + 8 * MiB;
constexpr size_t WS_WDN1 = WS_WGU1 + 44 * MiB;
constexpr size_t WS_HB0 = WS_WDN1 + 22 * MiB;
constexpr size_t WS_HB1 = WS_HB0 + 34 * MiB, WS_HB2 = WS_HB1 + 34 * MiB, WS_HB3 = WS_HB2 + 34 * MiB;
constexpr size_t WS_HF1 = WS_HB3 + 34 * MiB;
constexpr size_t WS_HF2 = WS_HF1 + 67 * MiB, WS_HF3 = WS_HF2 + 67 * MiB;
constexpr size_t WS_QG = WS_HF3 + 67 * MiB;
constexpr size_t WS_VG = WS_QG + 34 * MiB;
constexpr size_t WS_GG = WS_VG + 34 * MiB;
constexpr size_t WS_F = WS_GG + 34 * MiB;
constexpr size_t WS_OB = WS_F + 67 * MiB;
constexpr size_t WS_AT = WS_OB + 34 * MiB;
constexpr size_t WS_HM = WS_AT + 34 * MiB;
constexpr size_t WS_U = WS_HM + 92 * MiB;
constexpr size_t WS_SST = WS_U + 64 * MiB;
constexpr size_t WS_DEC = WS_SST + 64 * MiB;
constexpr size_t WS_KRAW = WS_DEC + 2 * MiB;
constexpr size_t WS_VRAW = WS_KRAW + 17 * MiB;
constexpr size_t WS_QRAW = WS_VRAW + 17 * MiB;
constexpr size_t WS_KB = WS_QRAW + 67 * MiB;
constexpr size_t WS_VB = WS_KB + 9 * MiB;
constexpr size_t WS_QB = WS_VB + 9 * MiB;
constexpr size_t WS_KPART = WS_QB + 34 * MiB;
constexpr size_t WS_KMS = WS_KPART + 1 * MiB;
constexpr size_t WS_SUBL = WS_KMS + 2 * MiB;
constexpr size_t WS_SCNT = WS_SUBL + 16 * MiB;
constexpr size_t WS_OSLOT = WS_SCNT + 1 * MiB;
constexpr size_t WS_MLSLOT = WS_OSLOT + 192 * MiB;
constexpr size_t WS_SSLOT = WS_MLSLOT + 3 * MiB;
constexpr size_t WS_FOUT = WS_SSLOT + 34 * MiB;
constexpr size_t WS_END = WS_FOUT + 131 * MiB;
constexpr size_t WS_ORC = WS_END;
constexpr int CW_BAR = 4096;
constexpr int CW_Q0 = 8192;
constexpr int CW_SS0 = 16384, CW_SS1 = CW_SS0 + MP, CW_SS2 = CW_SS1 + MP, CW_SS3 = CW_SS2 + MP;
static_assert((CW_SS3 + MP) * 4 <= (int)CTL_ZERO_BYTES, "ctl");
static_assert(WS_VG - WS_QG == 34 * MiB && WS_GG - WS_VG == 34 * MiB, "Qg|Vg|Gg stride");

constexpr int LDS_BYTES = 160 * 1024;
constexpr int MISC_OFF = LDS_BYTES - 256;

#define GAS __attribute__((address_space(1)))
#define LAS __attribute__((address_space(3)))
typedef unsigned short bf16;
typedef unsigned v4u __attribute__((ext_vector_type(4)));
typedef unsigned v2u __attribute__((ext_vector_type(2)));
typedef float f32x4 __attribute__((ext_vector_type(4)));
typedef float f32x2 __attribute__((ext_vector_type(2)));
typedef short bf16x8 __attribute__((ext_vector_type(8)));
typedef short bf16x4 __attribute__((ext_vector_type(4)));
#define LDS_WAIT() asm volatile("s_waitcnt lgkmcnt(0)" ::: "memory")
__device__ __forceinline__ unsigned f2bf(float f) { unsigned u = __builtin_bit_cast(unsigned, f); return (u + 0x7fffu + ((u >> 16) & 1u)) >> 16; }
__device__ __forceinline__ unsigned pk2(float lo, float hi) { return f2bf(lo) | (f2bf(hi) << 16); }
__device__ __forceinline__ float bf2f(unsigned h) { return __uint_as_float(h << 16); }
__device__ __forceinline__ float silu_f(float x) { return x * __builtin_amdgcn_rcpf(1.0f + __expf(-x)); }
__device__ __forceinline__ float sigm_f(float x) { return __builtin_amdgcn_rcpf(1.0f + __expf(-x)); }
template <int M> __device__ __forceinline__ float shx(float v) { return __uint_as_float((unsigned)__builtin_amdgcn_ds_swizzle((int)__float_as_uint(v), (M << 10) | 0x1f)); }
__device__ __forceinline__ float xadd32(float v) { auto rr = __builtin_amdgcn_permlane32_swap(__float_as_uint(v), __float_as_uint(v), false, false); return __uint_as_float(rr[0]) + __uint_as_float(rr[1]); }
__device__ __forceinline__ float xmax32(float v) { auto rr = __builtin_amdgcn_permlane32_swap(__float_as_uint(v), __float_as_uint(v), false, false); return fmaxf(__uint_as_float(rr[0]), __uint_as_float(rr[1])); }
__device__ __forceinline__ float wave_sum(float v) { v += shx<1>(v); v += shx<2>(v); v += shx<4>(v); v += shx<8>(v); v += shx<16>(v); return xadd32(v); }
#define MFMA16(a, b, c) __builtin_amdgcn_mfma_f32_16x16x32_bf16((a), (b), (c), 0, 0, 0)

#define XB_TMO      128
#define XB_XCNT(j)  (256  + 64 * (j))
#define XB_XSUB(j)  (1280 + 64 * (j))
#define XB_XGEN(j)  (2304 + 64 * (j))
#define XB_TOP      3328
#define XB_TOPGEN   3392
#define XCD_BAR_WORDS 3456
#define XB_SPIN_CAP (1u << 18)
__device__ __forceinline__ unsigned xb_ld(unsigned* p)              { return __hip_atomic_load(p, __ATOMIC_RELAXED, __HIP_MEMORY_SCOPE_AGENT); }
__device__ __forceinline__ unsigned xb_add(unsigned* p, unsigned v) { return __hip_atomic_fetch_add(p, v, __ATOMIC_RELAXED, __HIP_MEMORY_SCOPE_AGENT); }
__device__ __forceinline__ unsigned xb_xcc_id() { return (unsigned)__builtin_amdgcn_s_getreg((3 << 11) | 20) & 0xFu; }
#define XB_SPIN(cond, bar) do { unsigned _sp = 0; while (cond) { __builtin_amdgcn_s_sleep(1); \
    if ((++_sp & 255u) == 0u) { if (xb_ld(&(bar)[XB_TMO])) break; if (_sp > XB_SPIN_CAP) { atomicAdd(&(bar)[XB_TMO], 1u); break; } } } } while (0)
struct XcdBarrier { unsigned* bar; unsigned x; volatile LAS unsigned* st; };
__device__ __forceinline__ XcdBarrier xcd_barrier_post(unsigned* bar, volatile LAS unsigned* st, bool is_t0) {
    XcdBarrier b; b.bar = bar; b.x = xb_xcc_id(); b.st = st;
    if (is_t0) (void)xb_add(&bar[XB_XCNT(b.x)], 1u);
    return b;
}
__device__ __forceinline__ void xcd_barrier_complete(unsigned* bar, unsigned x, unsigned& nloc, unsigned& nx) {
    const unsigned G = gridDim.x * gridDim.y * gridDim.z;
    unsigned sum, cnt, mine, sp = 0u;
    for (;;) {
        sum = 0u; cnt = 0u; mine = 0u;
#pragma unroll
        for (unsigned j = 0; j < 16; ++j) { const unsigned c = xb_ld(&bar[XB_XCNT(j)]); sum += c; cnt += (c > 0u) ? 1u : 0u; mine = (j == x) ? c : mine; }
        if (sum == G) break;
        __builtin_amdgcn_s_sleep(1);
        if ((++sp & 255u) == 0u) { if (xb_ld(&bar[XB_TMO])) break; if (sp > XB_SPIN_CAP) { atomicAdd(&bar[XB_TMO], 1u); break; } }
    }
    nloc = mine > 0u ? mine : 1u; nx = cnt > 0u ? cnt : 1u;
}
__device__ __forceinline__ void xcd_barrier(const XcdBarrier& b, bool is_t0) {
    asm volatile("s_waitcnt vmcnt(0)" ::: "memory");
    __syncthreads();
    if (is_t0) {
        unsigned* bar = b.bar;
        __builtin_amdgcn_s_waitcnt(0);
        unsigned nloc = b.st[0], nx = b.st[1];
        if (nloc == 0u) { xcd_barrier_complete(bar, b.x, nloc, nx); b.st[0] = nloc; b.st[1] = nx; }
        const unsigned old = xb_add(&bar[XB_XSUB(b.x)], 1u);
        const unsigned gen = old / nloc;
        if (old + 1u == (gen + 1u) * nloc) {
            __builtin_amdgcn_fence(__ATOMIC_RELEASE, "agent");
            asm volatile("s_waitcnt vmcnt(0)" ::: "memory");
            const unsigned og = xb_add(&bar[XB_TOP], 1u);
            const unsigned tg = og / nx;
            if (og + 1u == (tg + 1u) * nx) xb_add(&bar[XB_TOPGEN], 1u);
            else XB_SPIN(xb_ld(&bar[XB_TOPGEN]) == tg, bar);
            __builtin_amdgcn_fence(__ATOMIC_ACQUIRE, "agent");
            xb_add(&bar[XB_XGEN(b.x)], 1u);
            asm volatile("s_waitcnt vmcnt(0)" ::: "memory");
        } else {
            XB_SPIN(xb_ld(&bar[XB_XGEN(b.x)]) == gen, bar);
            __builtin_amdgcn_fence(__ATOMIC_ACQUIRE, "agent");
            asm volatile("s_waitcnt vmcnt(0)" ::: "memory");
        }
    }
    __syncthreads();
}

using pg8::Unit; using pg8::cvt_pk_bf16;
struct EpiIn {
    static constexpr bool PERM = true;
    const float* ss; const float* lbl; bf16* Qg; float* F;
    __device__ __forceinline__ void operator()(const f32x4 (&acc)[2][2][4][2], const Unit& u, int wr, int wc, int fr, int fq) const {
        const int seg = u.pn >> 3; const int col0 = (u.pn & 7) * 256 + wc * 32 + 8 * fq; const int rowb = u.pm * 256 + wr * 64;
        float lb[2][8];
        if (seg == 1) {
#pragma unroll
            for (int bj = 0; bj < 2; ++bj)
#pragma unroll
                for (int j = 0; j < 8; ++j) { const int c = col0 + bj * 128 + j; lb[bj][j] = __builtin_amdgcn_rcpf(1.0f + __expf(lbl[D + c] - lbl[c])); }
        }
#pragma unroll
        for (int ai = 0; ai < 2; ++ai)
#pragma unroll
            for (int m = 0; m < 4; ++m) {
                const int rb = rowb + ai * 128 + m * 16; if (rb >= MR) continue;
                const int row = rb + fr; const float r = rsqrtf(ss[row] * (1.0f / D) + EPS);
#pragma unroll
                for (int bj = 0; bj < 2; ++bj) {
                    f32x4 v0 = acc[ai][bj][m][0] * r, v1 = acc[ai][bj][m][1] * r; const size_t off = (size_t)row * D + col0 + bj * 128;
                    if (seg == 1) {
                        f32x4 o0, o1;
#pragma unroll
                        for (int j = 0; j < 4; ++j) { o0[j] = lb[bj][j] + (1.0f - lb[bj][j]) * sigm_f(v0[j]); o1[j] = lb[bj][4 + j] + (1.0f - lb[bj][4 + j]) * sigm_f(v1[j]); }
                        *(f32x4*)(F + off) = o0; *(f32x4*)(F + off + 4) = o1;
                    } else {
                        if (seg != 2) {
#pragma unroll
                            for (int j = 0; j < 4; ++j) { v0[j] = silu_f(v0[j]); v1[j] = silu_f(v1[j]); }
                        }
                        v4u w; w.x = cvt_pk_bf16(v0[0], v0[1]); w.y = cvt_pk_bf16(v0[2], v0[3]); w.z = cvt_pk_bf16(v1[0], v1[1]); w.w = cvt_pk_bf16(v1[2], v1[3]);
                        const size_t dsel = (seg == 0) ? 0 : ((seg == 2) ? 1 : 2);
                        *(v4u*)(Qg + dsel * (size_t)(17 * MiB) + off) = w;
                    }
                }
            }
    }
    __device__ __forceinline__ void tail(int row, int col, f32x4 v) const {
        const int seg = col >> 11, c = col & 2047; const float r = rsqrtf(ss[row] * (1.0f / D) + EPS); v = v * r; const size_t off = (size_t)row * D + c;
        if (seg == 1) { f32x4 o;
#pragma unroll
            for (int j = 0; j < 4; ++j) { const float lbv = __builtin_amdgcn_rcpf(1.0f + __expf(lbl[D + c + j] - lbl[c + j])); o[j] = lbv + (1.0f - lbv) * sigm_f(v[j]); }
            *(f32x4*)(F + off) = o;
        } else {
            if (seg != 2) {
#pragma unroll
                for (int j = 0; j < 4; ++j) v[j] = silu_f(v[j]);
            }
            v2u w; w.x = cvt_pk_bf16(v[0], v[1]); w.y = cvt_pk_bf16(v[2], v[3]);
            const size_t dsel = (seg == 0) ? 0 : ((seg == 2) ? 1 : 2);
            *(v2u*)(Qg + dsel * (size_t)(17 * MiB) + off) = w;
        }
    }
};

template <int MODE> struct EpiRes {
    static constexpr bool PERM = true;
    const bf16* rb; float* o0; float* o1; bf16* hb; float* ss;
    __device__ __forceinline__ void operator()(const f32x4 (&acc)[2][2][4][2], const Unit& u, int wr, int wc, int fr, int fq) const {
        const int col0 = u.pn * 256 + wc * 32 + 8 * fq; const int rowb = u.pm * 256 + wr * 64;
#pragma unroll
        for (int ai = 0; ai < 2; ++ai)
#pragma unroll
            for (int m = 0; m < 4; ++m) {
                const int rb0 = rowb + ai * 128 + m * 16; if (rb0 >= MR) continue;
                const int row = rb0 + fr;
                const bf16* rp = rb + (size_t)row * D;
                float* op = (MODE == 2) ? ((row < SEQ) ? o0 + (size_t)row * D : o1 + (size_t)(row - SEQ) * D) : nullptr;
                float sq = 0.f;
#pragma unroll
                for (int bj = 0; bj < 2; ++bj) {
                    const int c = col0 + bj * 128;
                    const v4u rw = *(const v4u*)(rp + c);
                    f32x4 a0 = {bf2f(rw.x & 0xffffu), bf2f(rw.x >> 16), bf2f(rw.y & 0xffffu), bf2f(rw.y >> 16)}, a1 = {bf2f(rw.z & 0xffffu), bf2f(rw.z >> 16), bf2f(rw.w & 0xffffu), bf2f(rw.w >> 16)};
                    a0 += acc[ai][bj][m][0]; a1 += acc[ai][bj][m][1];
                    if (MODE == 2) { __builtin_nontemporal_store(a0, (f32x4*)(op + c)); __builtin_nontemporal_store(a1, (f32x4*)(op + c + 4)); }
                    else {
                        v4u w; w.x = cvt_pk_bf16(a0[0], a0[1]); w.y = cvt_pk_bf16(a0[2], a0[3]); w.z = cvt_pk_bf16(a1[0], a1[1]); w.w = cvt_pk_bf16(a1[2], a1[3]);
                        *(v4u*)(hb + (size_t)row * D + c) = w;
                        sq += (a0[0] * a0[0] + a0[1] * a0[1]) + (a0[2] * a0[2] + a0[3] * a0[3]) + (a1[0] * a1[0] + a1[1] * a1[1]) + (a1[2] * a1[2] + a1[3] * a1[3]);
                    }
                }
                if (MODE != 2) { sq += shx<16>(sq); sq = xadd32(sq); if (fq == 0) atomicAdd(ss + row, sq); }
            }
    }
    __device__ __forceinline__ void tail(int row, int col, f32x4 v, int fq) const {
        const v2u rw = *(const v2u*)(rb + (size_t)row * D + col);
        f32x4 a0 = {bf2f(rw.x & 0xffffu), bf2f(rw.x >> 16), bf2f(rw.y & 0xffffu), bf2f(rw.y >> 16)}; a0 += v;
        if (MODE == 2) { *(f32x4*)(o1 + (size_t)(row - SEQ) * D + col) = a0; }
        else {
            v2u w; w.x = cvt_pk_bf16(a0[0], a0[1]); w.y = cvt_pk_bf16(a0[2], a0[3]); *(v2u*)(hb + (size_t)row * D + col) = w;
            float sq = (a0[0] * a0[0] + a0[1] * a0[1]) + (a0[2] * a0[2] + a0[3] * a0[3]);
            sq += shx<16>(sq); sq = xadd32(sq); if (fq == 0) atomicAdd(ss + row, sq);
        }
    }
};
struct EpiGU {
    static constexpr bool PERM = true;
    const float* ss; bf16* hm;
    __device__ __forceinline__ void operator()(const f32x4 (&acc)[2][2][4][2], const Unit& u, int wr, int wc, int fr, int fq) const {
        const int j0 = u.pn * 128 + wc * 32 + 8 * fq; const int rowb = u.pm * 256 + wr * 64;
#pragma unroll
        for (int ai = 0; ai < 2; ++ai)
#pragma unroll
            for (int m = 0; m < 4; ++m) {
                const int rb = rowb + ai * 128 + m * 16; if (rb >= MR) continue;
                const int row = rb + fr; const float r = rsqrtf(ss[row] * (1.0f / D) + EPS);
                float o[8];
#pragma unroll
                for (int n = 0; n < 2; ++n)
#pragma unroll
                    for (int j = 0; j < 4; ++j) o[4 * n + j] = silu_f(acc[ai][0][m][n][j] * r) * (acc[ai][1][m][n][j] * r);
                v4u w; w.x = cvt_pk_bf16(o[0], o[1]); w.y = cvt_pk_bf16(o[2], o[3]); w.z = cvt_pk_bf16(o[4], o[5]); w.w = cvt_pk_bf16(o[6], o[7]);
                *(v4u*)(hm + (size_t)row * DFF + j0) = w;
            }
    }
};
struct EpiKVQ {
    static constexpr bool PERM = true;
    const float* ss; unsigned char* ws;
    __device__ __forceinline__ void operator()(const f32x4 (&acc)[2][2][4][2], const Unit& u, int wr, int wc, int fr, int fq) const {
        const int c0 = wc * 32 + 8 * fq; const int rowb = u.pm * 256 + wr * 64;
        const size_t base = (u.pn < 2) ? WS_KRAW : ((u.pn < 4) ? WS_VRAW : WS_QRAW);
        const int ld = (u.pn < 4) ? 512 : 2048; const int tcol = (u.pn < 2) ? u.pn * 256 : ((u.pn < 4) ? (u.pn - 2) * 256 : (u.pn - 4) * 256);
        float* dst = (float*)(ws + base);
#pragma unroll
        for (int ai = 0; ai < 2; ++ai)
#pragma unroll
            for (int m = 0; m < 4; ++m) {
                const int rb = rowb + ai * 128 + m * 16; if (rb >= MR) continue;
                const int row = rb + fr; const float r = rsqrtf(ss[row] * (1.0f / D) + EPS);
#pragma unroll
                for (int bj = 0; bj < 2; ++bj) { float* p = dst + (size_t)row * ld + tcol + c0 + bj * 128; *(f32x4*)p = acc[ai][bj][m][0] * r; *(f32x4*)(p + 4) = acc[ai][bj][m][1] * r; }
            }
    }
};

struct Args { const void* in[21]; float* out; unsigned char* ws; };

__device__ __forceinline__ void p0_transpose_item(const float* W, int K, int N, bf16* WT, int row_off, int mode, const float* gain, LAS float* scr, int item, int lane) {
    const int nblk = N / 64, kb = item / nblk, nb = item % nblk, k0 = 64 * kb, n0 = 64 * nb;
    const int r = lane >> 4, c4 = lane & 15;
#pragma unroll
    for (int i = 0; i < 16; ++i) { const int kk = 4 * i + r; f32x4 w = __builtin_nontemporal_load((const f32x4*)(W + (size_t)(k0 + kk) * N + n0 + 4 * c4)); if (gain) w *= gain[k0 + kk]; *(LAS f32x4*)(scr + kk * 68 + 4 * c4) = w; }
    LDS_WAIT(); asm volatile("" ::: "memory");
    const int c = lane & 7;
    int d0;
    if (mode == 0) d0 = row_off + n0;
    else { const int j = (n0 < DFF) ? n0 : n0 - DFF; d0 = 256 * (j >> 7) + (j & 127) + ((n0 < DFF) ? 0 : 128); }
#pragma unroll
    for (int j = 0; j < 8; ++j) { const int n = (lane >> 3) + 8 * j; const LAS float* sp = scr + (8 * c) * 68 + n;
        v4u o; o.x = pk2(sp[0 * 68], sp[1 * 68]); o.y = pk2(sp[2 * 68], sp[3 * 68]); o.z = pk2(sp[4 * 68], sp[5 * 68]); o.w = pk2(sp[6 * 68], sp[7 * 68]);
        *(v4u*)(WT + (size_t)(d0 + n) * K + k0 + 8 * c) = o; }
    LDS_WAIT(); asm volatile("" ::: "memory");
}

constexpr int KS_P = 144;
constexpr int KS_BYTES = 256 * KS_P * 2;
typedef short v4i16_t __attribute__((ext_vector_type(4)));
__device__ __forceinline__ v2u tr_read(const LAS bf16* p) { return __builtin_bit_cast(v2u, __builtin_amdgcn_ds_read_tr16_b64_v4i16((LAS v4i16_t*)p)); }
template <int NKT> __device__ __forceinline__ void attn_scores(const LAS bf16* Ks, const bf16x8 (&qf)[4], f32x4 (&acc)[16], int nkt, int fr, int fq) {
#pragma unroll
    for (int kt = 0; kt < NKT; ++kt) {
        acc[kt] = (f32x4){0.f, 0.f, 0.f, 0.f};
        if (kt < nkt) {
#pragma unroll
            for (int ks = 0; ks < 4; ++ks) { const bf16x8 a = *(const LAS bf16x8*)(Ks + (16 * kt + fr) * KS_P + 32 * ks + 8 * fq); acc[kt] = MFMA16(a, qf[ks], acc[kt]); }
        }
    }
}
__device__ __forceinline__ void attn_pv(const LAS bf16* Vr, const f32x4 (&acc)[16], f32x4 (&O)[8], int nj, int fr, int fq) {
#pragma unroll
    for (int j = 0; j < 8; ++j) {
        if (j < nj) {
            v4u pw; pw.x = cvt_pk_bf16(acc[2 * j][0], acc[2 * j][1]); pw.y = cvt_pk_bf16(acc[2 * j][2], acc[2 * j][3]); pw.z = cvt_pk_bf16(acc[2 * j + 1][0], acc[2 * j + 1][1]); pw.w = cvt_pk_bf16(acc[2 * j + 1][2], acc[2 * j + 1][3]);
            const bf16x8 pf = __builtin_bit_cast(bf16x8, pw);
            const LAS bf16* vb = Vr + (32 * j + 4 * fq + (fr >> 2)) * KS_P + 4 * (fr & 3);
#pragma unroll
            for (int vt = 0; vt < 8; ++vt) {
                const v2u lo = tr_read(vb + 16 * vt), hi = tr_read(vb + 16 * KS_P + 16 * vt);
                const v4u aw = {lo.x, lo.y, hi.x, hi.y};
                O[vt] = MFMA16(__builtin_bit_cast(bf16x8, aw), pf, O[vt]);
            }
        }
    }
}

template <int NT> __device__ __forceinline__ void tail_gemm(LAS unsigned char* lds, const bf16* A, const bf16* Bt, int K, int n0, int rowhalf, f32x4 (&acc)[NT], int tidx) {
    int tid_o = tidx; asm volatile("" : "+v"(tid_o));
    const int lane = tid_o & 63, wave = __builtin_amdgcn_readfirstlane(tid_o >> 6), fr = lane & 15, fq = lane >> 4;
    const int rt = wave & 3, kh = wave >> 2; const int Kh = K >> 1;
    const bf16* ap = A + (size_t)(64 * rowhalf + 16 * rt + fr) * K + kh * Kh + 8 * fq;
    const bf16* bp = Bt + (size_t)(n0 + fr) * K + kh * Kh + 8 * fq;
#pragma unroll
    for (int t = 0; t < NT; ++t) acc[t] = (f32x4){0.f, 0.f, 0.f, 0.f};
    bf16x8 a0[8], b0[NT][8], a1[8], b1[NT][8];
#define TG_LOAD(a_, b_, k0_) do { _Pragma("unroll") for (int s_ = 0; s_ < 8; ++s_) { a_[s_] = *(const bf16x8*)(ap + (k0_) + 32 * s_); _Pragma("unroll") for (int t_ = 0; t_ < NT; ++t_) b_[t_][s_] = *(const bf16x8*)(bp + (size_t)t_ * 16 * K + (k0_) + 32 * s_); } } while (0)
#define TG_MMA(a_, b_) do { _Pragma("unroll") for (int s_ = 0; s_ < 8; ++s_) { _Pragma("unroll") for (int t_ = 0; t_ < NT; ++t_) acc[t_] = MFMA16(b_[t_][s_], a_[s_], acc[t_]); } } while (0)
    TG_LOAD(a0, b0, 0);
    for (int k0 = 0; k0 < Kh; k0 += 512) {
        if (k0 + 256 < Kh) TG_LOAD(a1, b1, k0 + 256);
        TG_MMA(a0, b0);
        if (k0 + 256 < Kh) { if (k0 + 512 < Kh) TG_LOAD(a0, b0, k0 + 512); TG_MMA(a1, b1); }
    }
#undef TG_LOAD
#undef TG_MMA
    LAS f32x4* red = (LAS f32x4*)lds;
    if (kh == 1) {
#pragma unroll
        for (int t = 0; t < NT; ++t) red[(t * 4 + rt) * 64 + lane] = acc[t];
    }
    __syncthreads();
    if (kh == 0) {
#pragma unroll
        for (int t = 0; t < NT; ++t) acc[t] += red[(t * 4 + rt) * 64 + lane];
    }
    __syncthreads();
}

__device__ __forceinline__ void kmean_items(LAS unsigned char* lds, const float* cache_k_, const int* ptab_, float* Kms_, int i0, int i1, int c0, int cn, int tidx) {
    int tid_o = tidx; asm volatile("" : "+v"(tid_o)); const int tid = tid_o;
    const int me = (int)blockIdx.x - c0; if (me < 0 || me >= cn) return;
    LAS f32x4* redk = (LAS f32x4*)(lds);
    for (int item = i0 + me; item < i1; item += cn) {
        const int b = item >> 5, n = item & 31; const int c4 = tid & 127, rg = tid >> 7;
        f32x4 a = {0.f, 0.f, 0.f, 0.f};
#pragma unroll
        for (int hp = 0; hp < 2; ++hp) { const int page = ptab_[b * NPAGES + 2 * n + hp]; const f32x4* pp = (const f32x4*)(cache_k_ + (size_t)page * PAGE * 512) + c4;
#pragma unroll 16
            for (int r = rg; r < 128; r += 4) a += __builtin_nontemporal_load(pp + (size_t)r * 128); }
        redk[rg * 128 + c4] = a;
        __syncthreads();
        if (tid < 128) { const f32x4 s4 = (redk[tid] + redk[128 + tid]) + (redk[256 + tid] + redk[384 + tid]); *(f32x4*)(Kms_ + (size_t)item * 512 + 4 * tid) = s4 * (1.0f / 256.0f); }
        __syncthreads();
    }
}

__global__ void __launch_bounds__(NTHR, 2) yoco_fwd(Args args) {
    extern __shared__ __attribute__((aligned(16))) unsigned char lds_raw[];
    LAS unsigned char* lds = (LAS unsigned char*)lds_raw;
#define TIDS int tid_o = TIDX; asm volatile("" : "+v"(tid_o)); const int tid = tid_o, lane = tid & 63, wave = __builtin_amdgcn_readfirstlane(tid >> 6), fr = lane & 15, fq = lane >> 4; (void)fr; (void)fq; (void)wave; (void)lane; (void)tid
    const int G = gridDim.x, bid = blockIdx.x;
    unsigned char* ws = args.ws;
    unsigned* ctl = (unsigned*)(ws + WS_CTL);
    volatile LAS unsigned* MISC = (volatile LAS unsigned*)(lds + MISC_OFF);
    const int wave_sg = __builtin_amdgcn_readfirstlane((int)threadIdx.x & ~63);
#define TIDX (wave_sg + lane_id())
#define IS_T0 ((wave_sg == 0) && (lane_id() == 0))
    if (TIDX < 64) MISC[TIDX] = 0u;
    __syncthreads();
    XcdBarrier bar = xcd_barrier_post(ctl + CW_BAR, MISC + 8, IS_T0);
#ifdef PROF_A
    int n_stamp = 0;
#define STAMP() do { if (blockIdx.x == 0 && IS_T0) MISC[16 + n_stamp] = (unsigned)__builtin_amdgcn_s_memrealtime(); ++n_stamp; } while (0)
#define TNOW() ((unsigned)__builtin_amdgcn_s_memrealtime())
#define TACC(k, t0) do { if (blockIdx.x == 0 && IS_T0) MISC[40 + (k)] += TNOW() - (t0); } while (0)
#define PVAL(a0, a1) (((a0) >= 100) ? MISC[40 + (a0) - 100] : (MISC[16 + (a1)] - MISC[16 + (a0)]))
#else
#define STAMP() do {} while (0)
#define TNOW() 0u
#define TACC(k, t0) do { (void)(t0); } while (0)
#endif
    STAMP();

#define x_p ((const float*)args.in[0])
#define x_s ((const float*)args.in[1])
#define st_in ((const float*)args.in[2])
#define cache_k ((const float*)args.in[3])
#define cache_v ((const float*)args.in[4])
#define ptab ((const int*)args.in[5])
#define norm_mix_a ((const float*)args.in[6])
#define w_in ((const float*)args.in[7])
#define lbl ((const float*)args.in[8])
#define onorm ((const float*)args.in[9])
#define w_out ((const float*)args.in[10])
#define norm_kv ((const float*)args.in[11])
#define w_kv ((const float*)args.in[12])
#define k_norm ((const float*)args.in[13])
#define norm_mix_b ((const float*)args.in[14])
#define w_q ((const float*)args.in[15])
#define q_norm ((const float*)args.in[16])
#define w_o ((const float*)args.in[17])
#define norm_ffn ((const float*)args.in[18])
#define w_gu ((const float*)args.in[19])
#define w_dn ((const float*)args.in[20])
#define Win_t ((bf16*)(ws + WS_WIN))
#define Wout_t ((bf16*)(ws + WS_WOUT))
#define Wgu0_t ((bf16*)(ws + WS_WGU0))
#define Wdn0_t ((bf16*)(ws + WS_WDN0))
#define Wkvq_t ((bf16*)(ws + WS_WKVQ))
#define Wo_t ((bf16*)(ws + WS_WO))
#define Wgu1_t ((bf16*)(ws + WS_WGU1))
#define Wdn1_t ((bf16*)(ws + WS_WDN1))
#define Hb0 ((bf16*)(ws + WS_HB0))
#define Hb1 ((bf16*)(ws + WS_HB1))
#define Hb2 ((bf16*)(ws + WS_HB2))
#define Hb3 ((bf16*)(ws + WS_HB3))
#define Hf1 ((float*)(ws + WS_HF1))
#define Hf2 ((float*)(ws + WS_HF2))
#define Hf3 ((float*)(ws + WS_HF3))
#define Qg ((bf16*)(ws + WS_QG))
#define Vg ((bf16*)(ws + WS_VG))
#define Gg ((bf16*)(ws + WS_GG))
#define Ff ((float*)(ws + WS_F))
#define Ob ((bf16*)(ws + WS_OB))
#define At ((bf16*)(ws + WS_AT))
#define Hm ((bf16*)(ws + WS_HM))
#define Ub ((bf16*)(ws + WS_U))
#define Sst ((bf16*)(ws + WS_SST))
#define Dec ((float*)(ws + WS_DEC))
#define Kraw ((float*)(ws + WS_KRAW))
#define Vraw ((float*)(ws + WS_VRAW))
#define Qraw ((float*)(ws + WS_QRAW))
#define Kb ((bf16*)(ws + WS_KB))
#define Vb ((bf16*)(ws + WS_VB))
#define Qb ((bf16*)(ws + WS_QB))
#define Kpart ((float*)(ws + WS_KPART))
#define Kms ((float*)(ws + WS_KMS))
#define Subl ((unsigned*)(ws + WS_SUBL))
#define Scnt ((unsigned*)(ws + WS_SCNT))
#define Sels ((unsigned*)(ws + WS_SCNT + 256 * 1024))
#define Oslot ((bf16*)(ws + WS_OSLOT))
#define MLslot ((float*)(ws + WS_MLSLOT))
#define Sslot ((float*)(ws + WS_SSLOT))
#define ss0 ((float*)(ctl + CW_SS0))
#define ss1 ((float*)(ctl + CW_SS1))
#define ss2 ((float*)(ctl + CW_SS2))
#define ss3 ((float*)(ctl + CW_SS3))
#define out (args.out)
    {
        TIDS;
        LAS float* scr = (LAS float*)(lds + wave * 17408);
        const int gw = bid * NWAVES + wave, NGW = G * NWAVES;
        constexpr int I_IN = 32 * 128, I_SQ = 32 * 32, I_GU = 32 * 176, I_DN = 88 * 32, I_KV = 32 * 16;
        constexpr int NITEMS = I_IN + I_SQ + 2 * I_GU + 2 * I_DN + I_KV + I_SQ + I_SQ;
        for (int it = gw; it < NITEMS; it += NGW) {
            int r = it;
            if (r < I_IN) { p0_transpose_item(w_in, D, 4 * D, Win_t, 0, 0, norm_mix_a, scr, r, lane); continue; } r -= I_IN;
            if (r < I_SQ) { p0_transpose_item(w_out, D, D, Wout_t, 0, 0, nullptr, scr, r, lane); continue; } r -= I_SQ;
            if (r < I_GU) { p0_transpose_item(w_gu, D, NGU, Wgu0_t, 0, 1, norm_ffn, scr, r, lane); continue; } r -= I_GU;
            if (r < I_GU) { p0_transpose_item(w_gu + (size_t)D * NGU, D, NGU, Wgu1_t, 0, 1, norm_ffn + D, scr, r, lane); continue; } r -= I_GU;
            if (r < I_DN) { p0_transpose_item(w_dn, DFF, D, Wdn0_t, 0, 0, nullptr, scr, r, lane); continue; } r -= I_DN;
            if (r < I_DN) { p0_transpose_item(w_dn + (size_t)DFF * D, DFF, D, Wdn1_t, 0, 0, nullptr, scr, r, lane); continue; } r -= I_DN;
            if (r < I_KV) { p0_transpose_item(w_kv, D, 1024, Wkvq_t, 0, 0, norm_kv, scr, r, lane); continue; } r -= I_KV;
            if (r < I_SQ) { p0_transpose_item(w_q, D, D, Wkvq_t, 1024, 0, norm_mix_b, scr, r, lane); continue; } r -= I_SQ;
            p0_transpose_item(w_o, D, D, Wo_t, 0, 0, nullptr, scr, r, lane);
        }
        for (int m = gw; m < MR; m += NGW) {
            const float* src = (m < SEQ) ? x_p + (size_t)m * D : x_s + (size_t)(m - SEQ) * D;
            const f32x4* xr = (const f32x4*)src + lane; f32x4 v[8]; float s = 0.f;
#pragma unroll
            for (int j = 0; j < 8; ++j) { v[j] = __builtin_nontemporal_load(xr + 64 * j); s += (v[j].x * v[j].x + v[j].y * v[j].y) + (v[j].z * v[j].z + v[j].w * v[j].w); }
            s = wave_sum(s);
            if (lane == 0) ss0[m] = s;
            v2u* o8 = (v2u*)(Hb0 + (size_t)m * D) + lane;
#pragma unroll
            for (int j = 0; j < 8; ++j) { v2u w; w.x = pk2(v[j].x, v[j].y); w.y = pk2(v[j].z, v[j].w); o8[64 * j] = w; }
        }
        __syncthreads();
        kmean_items(lds, cache_k, ptab, Kms, 848, DECB * NBLK, 0, G, TIDX);
    }
    xcd_barrier(bar, IS_T0);
    STAMP();

    {
        TIDS;
        pg8::Gemm g{Hb0, Win_t, SEQ, 4 * D, D}; pg8::StaticOrder S; S.init(SEQ, 4 * D, G, bid);
        EpiIn E{ss0, lbl, Qg, Ff};
        pg8::gemm_phase<EpiIn, pg8::StaticOrder, true, true, false>(lds, g, S, E, TIDX);
        for (int it2 = 0; it2 < 2; ++it2) {
            const int w2 = bid + 256 * it2, t2 = w2 & 255, rh = (w2 >> 8) & 1;
            TIDS; f32x4 ta[2]; tail_gemm<2>(lds, Hb0 + (size_t)SEQ * D, Win_t, D, 32 * t2, rh, ta, TIDX);
            if (wave < 4) { const int row = SEQ + 64 * rh + 16 * wave + fr; E.tail(row, 32 * t2 + 4 * fq, ta[0]); E.tail(row, 32 * t2 + 16 + 4 * fq, ta[1]); }
        }
    }
    xcd_barrier(bar, IS_T0);
    STAMP();

    {
        TIDS;
        LAS float* tot = (LAS float*)(lds);
        LAS bf16* koT = (LAS bf16*)(lds + 4096);
        LAS bf16* Vr = (LAS bf16*)(lds + 4096 + 128 * 72 * 2);
        const int col = tid & 127, part = tid >> 7; const int vt_t = tid >> 3, vd0 = (tid & 7) * 16;
        float fN[16]; v4u vaN, vbN;
#define P2_LOADN(it_) do { const int h_ = (it_) >> 7, r0_ = ((it_) & 127) * 64; const float* fp_ = Ff + (size_t)(r0_ + part * 16) * D + h_ * 128 + col; \
            _Pragma("unroll") for (int i = 0; i < 16; ++i) fN[i] = fp_[(size_t)i * D]; \
            const bf16* vp_ = Vg + (size_t)(r0_ + vt_t) * D + h_ * 128 + vd0; vaN = *(const v4u*)vp_; vbN = *(const v4u*)(vp_ + 8); } while (0)
        if (bid < NH * NCHUNK) P2_LOADN(bid);
        for (int item = bid; item < NH * NCHUNK; item += G) {
            float cum[16], kk[16]; float run = 0.f;
#pragma unroll
            for (int i = 0; i < 16; ++i) { const float f = fN[i]; kk[i] = 1.0f - f; run += __logf(f); cum[i] = run; }
            tot[part * 128 + col] = run;
            *(LAS v4u*)(Vr + vt_t * 144 + vd0) = vaN; *(LAS v4u*)(Vr + vt_t * 144 + vd0 + 8) = vbN;
            if (item + G < NH * NCHUNK) P2_LOADN(item + G);
            __syncthreads();
            float offs = 0.f, lastv = 0.f;
#pragma unroll
            for (int p = 0; p < 4; ++p) { const float tv = tot[p * 128 + col]; lastv += tv; if (p < part) offs += tv; }
            unsigned kw[8];
#pragma unroll
            for (int i = 0; i < 8; ++i) { const float a = kk[2 * i] * __expf(lastv - (cum[2 * i] + offs)), b = kk[2 * i + 1] * __expf(lastv - (cum[2 * i + 1] + offs)); kw[i] = pk2(a, b); }
            *(LAS v4u*)(koT + col * 72 + part * 16) = (v4u){kw[0], kw[1], kw[2], kw[3]};
            *(LAS v4u*)(koT + col * 72 + part * 16 + 8) = (v4u){kw[4], kw[5], kw[6], kw[7]};
            if (part == 0) Dec[(size_t)item * 128 + col] = __expf(lastv);
            __syncthreads();
            { bf16x8 a[2]; a[0] = *(const LAS bf16x8*)(koT + (16 * wave + fr) * 72 + 8 * fq); a[1] = *(const LAS bf16x8*)(koT + (16 * wave + fr) * 72 + 32 + 8 * fq);
              bf16* ub = Ub + (size_t)item * 16384;
              const LAS bf16* vb = Vr + (8 * fq + (fr >> 2)) * 144 + 4 * (fr & 3);
#pragma unroll
              for (int vt = 0; vt < 8; ++vt) {
                  f32x4 acc = {0.f, 0.f, 0.f, 0.f};
                  const v2u l0 = tr_read(vb + 16 * vt), h0 = tr_read(vb + 4 * 144 + 16 * vt), l1 = tr_read(vb + 32 * 144 + 16 * vt), h1 = tr_read(vb + 36 * 144 + 16 * vt);
                  const v4u b0 = {l0.x, l0.y, h0.x, h0.y}, b1 = {l1.x, l1.y, h1.x, h1.y};
                  acc = MFMA16(a[0], __builtin_bit_cast(bf16x8, b0), acc); acc = MFMA16(a[1], __builtin_bit_cast(bf16x8, b1), acc);
                  v2u w; w.x = pk2(acc[0], acc[1]); w.y = pk2(acc[2], acc[3]);
                  *(v2u*)(ub + (size_t)(16 * vt + fr) * 128 + 16 * wave + 4 * fq) = w;
              } }
            __syncthreads();
        }
#undef P2_LOADN
        LAS float* red = (LAS float*)(lds);
        LAS float* red2 = (LAS float*)(lds + 8192);
        float* st_out = out + OST_S;
        for (int item = bid; item < DECB * NH; item += G) {
            const int b = item >> 4, h = item & 15; const int vd = tid & 127, kq = tid >> 7;
            const float* sp = st_in + ((size_t)(b * NH + h) * 128 + 32 * kq) * 128 + vd;
            float Sx[32];
#pragma unroll
            for (int i = 0; i < 32; ++i) Sx[i] = __builtin_nontemporal_load(sp + (size_t)i * 128);
#pragma unroll
            for (int t = 0; t < 4; ++t) {
                const int row = SEQ + 4 * b + t; const size_t ro = (size_t)row * D + h * 128;
                const float v = bf2f(Vg[ro + vd]); float op = 0.f;
#pragma unroll
                for (int i = 0; i < 32; ++i) { const float f = Ff[ro + 32 * kq + i]; const float q = bf2f(Qg[ro + 32 * kq + i]); Sx[i] = f * Sx[i] + (1.0f - f) * v; op += Sx[i] * q; }
                red[(t * 4 + kq) * 128 + vd] = op;
            }
            float* so = st_out + ((size_t)(b * NH + h) * 128 + 32 * kq) * 128 + vd;
#pragma unroll
            for (int i = 0; i < 32; ++i) __builtin_nontemporal_store(Sx[i], so + (size_t)i * 128);
            __syncthreads();
            { const int t = tid >> 7; const float o = (red[(t * 4 + 0) * 128 + vd] + red[(t * 4 + 1) * 128 + vd]) + (red[(t * 4 + 2) * 128 + vd] + red[(t * 4 + 3) * 128 + vd]);
              const float s = wave_sum(o * o); if (lane == 0) red2[t * 2 + (wave & 1)] = s;
              __syncthreads();
              const float r = rsqrtf((red2[t * 2] + red2[t * 2 + 1]) * (1.0f / 128.0f) + EPS);
              const int row = SEQ + 4 * b + t; const size_t ro = (size_t)row * D + h * 128 + vd;
              Ob[ro] = (bf16)f2bf(o * r * onorm[vd] * bf2f(Gg[ro])); }
            __syncthreads();
        }
    }
    xcd_barrier(bar, IS_T0);
    STAMP();

    {
        TIDS;
        for (int gid = bid * NTHR + tid; gid < NH * 128 * 32; gid += G * NTHR) {
            const int h = gid >> 12, rem = gid & 4095, vd = rem >> 5, k = (rem & 31) * 4;
            float s0 = 0.f, s1 = 0.f, s2 = 0.f, s3 = 0.f;
            const v2u* up = (const v2u*)(Ub + ((size_t)h * 128 * 128 + vd) * 128 + k);
            v2u* sp = (v2u*)(Sst + ((size_t)h * 128 * 128 + vd) * 128 + k);
            const f32x4* dp = (const f32x4*)(Dec + (size_t)h * 128 * 128 + k);
#pragma unroll 16
            for (int c = 0; c < NCHUNK; ++c) {
                const v2u u = up[(size_t)c * 4096]; const f32x4 d = dp[(size_t)c * 32];
                v2u w; w.x = pk2(s0, s1); w.y = pk2(s2, s3); sp[(size_t)c * 4096] = w;
                s0 = d.x * s0 + bf2f(u.x & 0xffffu); s1 = d.y * s1 + bf2f(u.x >> 16); s2 = d.z * s2 + bf2f(u.y & 0xffffu); s3 = d.w * s3 + bf2f(u.y >> 16);
            }
            float* so = out + OST_P + ((size_t)h * 128 + k) * 128 + vd;
            so[0] = s0; so[128] = s1; so[256] = s2; so[384] = s3;
        }
    }
    xcd_barrier(bar, IS_T0);
    STAMP();

    {
        TIDS;
        LAS float* tot = (LAS float*)(lds);
        LAS float* refs = (LAS float*)(lds + 2048);
        LAS float* red = (LAS float*)(lds + 2560);
        LAS bf16* QE = (LAS bf16*)(lds + 4096);
        LAS bf16* KE = QE + 64 * 136;
        LAS bf16* QI = KE + 64 * 136;
        LAS bf16* Vr = QI + 64 * 136;
        LAS bf16* STs = Vr + 64 * 144;
        const int col = tid & 127, part = tid >> 7; const int vt_t = tid >> 3, vd0 = (tid & 7) * 16;
        const int tt = wave & 3, vh = wave >> 2;
        float fN[16]; bf16 qN[16]; v4u vaN, vbN, stN[4];
#define P4_LOADN(it_) do { const int h_ = (it_) >> 7, r0_ = ((it_) & 127) * 64; const float* fp_ = Ff + (size_t)(r0_ + part * 16) * D + h_ * 128 + col; const bf16* qp_ = Qg + (size_t)(r0_ + part * 16) * D + h_ * 128 + col; \
            _Pragma("unroll") for (int i = 0; i < 16; ++i) { fN[i] = fp_[(size_t)i * D]; qN[i] = qp_[(size_t)i * D]; } \
            const bf16* vp_ = Vg + (size_t)(r0_ + vt_t) * D + h_ * 128 + vd0; vaN = *(const v4u*)vp_; vbN = *(const v4u*)(vp_ + 8); \
            const v4u* sp_ = (const v4u*)(Sst + (size_t)(it_) * 16384); _Pragma("unroll") for (int i = 0; i < 4; ++i) stN[i] = sp_[i * 512 + tid]; } while (0)
        if (bid < NH * NCHUNK) P4_LOADN(bid);
        for (int item = bid; item < NH * NCHUNK; item += G) {
            const int h = item >> 7, c = item & 127; const int row0 = c * 64;
            float cum[16], kk[16], qv[16]; float run = 0.f;
#pragma unroll
            for (int i = 0; i < 16; ++i) { const float f = fN[i]; kk[i] = 1.0f - f; run += __logf(f); cum[i] = run; qv[i] = bf2f(qN[i]); }
            tot[part * 128 + col] = run;
            *(LAS v4u*)(Vr + vt_t * 144 + vd0) = vaN; *(LAS v4u*)(Vr + vt_t * 144 + vd0 + 8) = vbN;
#pragma unroll
            for (int i = 0; i < 4; ++i) { const int idx = i * 512 + tid, vd = idx >> 4, k8 = idx & 15; *(LAS v4u*)(STs + vd * 136 + k8 * 8) = stN[i]; }
            const size_t ro = (size_t)(row0 + 16 * tt + fr) * D + h * 128;
            v2u gw2[4]; f32x4 on[4];
#pragma unroll
            for (int vt = 0; vt < 4; ++vt) { const int vd = 16 * (4 * vh + vt) + 4 * fq; gw2[vt] = *(const v2u*)(Gg + ro + vd); on[vt] = *(const f32x4*)(onorm + vd); }
            if (item + G < NH * NCHUNK) P4_LOADN(item + G);
            __syncthreads();
            float offs = 0.f;
#pragma unroll
            for (int p = 0; p < 4; ++p) { const float tv = tot[p * 128 + col]; if (p < part) offs += tv; }
            if (part == 1) refs[col] = cum[15] + offs;
            __syncthreads();
            const float ref = refs[col];
#pragma unroll
            for (int i = 0; i < 16; ++i) { const float cm = cum[i] + offs, d1 = cm - ref; const int t = part * 16 + i;
                QE[t * 136 + col] = (bf16)f2bf(qv[i] * __expf(d1)); KE[t * 136 + col] = (bf16)f2bf(kk[i] * __expf(-d1)); QI[t * 136 + col] = (bf16)f2bf(qv[i] * __expf(cm)); }
            __syncthreads();
            {
                f32x4 aS[4];
#pragma unroll
                for (int st = 0; st < 4; ++st) {
                    aS[st] = (f32x4){0.f, 0.f, 0.f, 0.f};
                    if (st <= tt) {
#pragma unroll
                        for (int ks = 0; ks < 4; ++ks) { const bf16x8 a = *(const LAS bf16x8*)(KE + (16 * st + fr) * 136 + 32 * ks + 8 * fq), b = *(const LAS bf16x8*)(QE + (16 * tt + fr) * 136 + 32 * ks + 8 * fq); aS[st] = MFMA16(a, b, aS[st]); }
                        if (st == tt) {
#pragma unroll
                            for (int r = 0; r < 4; ++r) if (4 * fq + r > fr) aS[st][r] = 0.f;
                        }
                    }
                }
                f32x4 o[4];
#pragma unroll
                for (int vt = 0; vt < 4; ++vt) o[vt] = (f32x4){0.f, 0.f, 0.f, 0.f};
#pragma unroll
                for (int j = 0; j < 2; ++j) {
                    v4u pw; pw.x = cvt_pk_bf16(aS[2 * j][0], aS[2 * j][1]); pw.y = cvt_pk_bf16(aS[2 * j][2], aS[2 * j][3]); pw.z = cvt_pk_bf16(aS[2 * j + 1][0], aS[2 * j + 1][1]); pw.w = cvt_pk_bf16(aS[2 * j + 1][2], aS[2 * j + 1][3]);
                    const bf16x8 pf = __builtin_bit_cast(bf16x8, pw);
                    const LAS bf16* vb = Vr + (32 * j + 4 * fq + (fr >> 2)) * 144 + 64 * vh + 4 * (fr & 3);
#pragma unroll
                    for (int vt = 0; vt < 4; ++vt) { const v2u lo = tr_read(vb + 16 * vt), hi = tr_read(vb + 16 * 144 + 16 * vt); const v4u aw = {lo.x, lo.y, hi.x, hi.y};
                        o[vt] = MFMA16(__builtin_bit_cast(bf16x8, aw), pf, o[vt]); }
                }
#pragma unroll
                for (int ks = 0; ks < 4; ++ks) { const bf16x8 b = *(const LAS bf16x8*)(QI + (16 * tt + fr) * 136 + 32 * ks + 8 * fq);
#pragma unroll
                    for (int vt = 0; vt < 4; ++vt) { const bf16x8 a = *(const LAS bf16x8*)(STs + (16 * (4 * vh + vt) + fr) * 136 + 32 * ks + 8 * fq); o[vt] = MFMA16(a, b, o[vt]); } }
                float sq = 0.f;
#pragma unroll
                for (int vt = 0; vt < 4; ++vt) sq += (o[vt][0] * o[vt][0] + o[vt][1] * o[vt][1]) + (o[vt][2] * o[vt][2] + o[vt][3] * o[vt][3]);
                sq += shx<16>(sq); sq = xadd32(sq);
                if (fq == 0) red[(16 * tt + fr) * 2 + vh] = sq;
                __syncthreads();
                const float r = rsqrtf((red[(16 * tt + fr) * 2] + red[(16 * tt + fr) * 2 + 1]) * (1.0f / 128.0f) + EPS);
#pragma unroll
                for (int vt = 0; vt < 4; ++vt) { const int vd = 16 * (4 * vh + vt) + 4 * fq;
                    const float g0 = bf2f(gw2[vt].x & 0xffffu), g1 = bf2f(gw2[vt].x >> 16), g2 = bf2f(gw2[vt].y & 0xffffu), g3 = bf2f(gw2[vt].y >> 16);
                    v2u w; w.x = cvt_pk_bf16(o[vt][0] * r * on[vt][0] * g0, o[vt][1] * r * on[vt][1] * g1); w.y = cvt_pk_bf16(o[vt][2] * r * on[vt][2] * g2, o[vt][3] * r * on[vt][3] * g3);
                    *(v2u*)(Ob + ro + vd) = w; }
            }
            __syncthreads();
        }
#undef P4_LOADN
    }
    xcd_barrier(bar, IS_T0);
    STAMP();

    {
        TIDS;
        pg8::Gemm g{Ob, Wout_t, SEQ, D, D}; pg8::StaticOrder S; S.init(SEQ, D, G, bid);
        EpiRes<1> E{Hb0, nullptr, nullptr, Hb1, ss1};
        const unsigned tg0 = TNOW();
        pg8::gemm_phase<EpiRes<1>, pg8::StaticOrder, true, true, false>(lds, g, S, E, TIDX);
        TACC(5, tg0); const unsigned tg1 = TNOW();
        { const int t2 = bid & 127, rh = (bid >> 7) & 1; TIDS; f32x4 ta[1]; tail_gemm<1>(lds, Ob + (size_t)SEQ * D, Wout_t, D, 16 * t2, rh, ta, TIDX); if (wave < 4) E.tail(SEQ + 64 * rh + 16 * wave + fr, 16 * t2 + 4 * fq, ta[0], fq); }
        TACC(6, tg1);
    }
    xcd_barrier(bar, IS_T0);
    STAMP();
    {
        TIDS;
        pg8::Gemm g{Hb1, Wgu0_t, MP, NGU, D}; pg8::StaticOrder S; S.init(MP, NGU, G, bid);
        EpiGU E{ss1, Hm};
        pg8::gemm_phase<EpiGU, pg8::StaticOrder, true, true>(lds, g, S, E, TIDX);
        kmean_items(lds, cache_k, ptab, Kms, 0, 336, 172, G - 172, TIDX);
    }
    xcd_barrier(bar, IS_T0);
    STAMP();
    {
        TIDS;
        pg8::Gemm g{Hm, Wdn0_t, SEQ, D, DFF}; pg8::StaticOrder S; S.init(SEQ, D, G, bid);
        EpiRes<1> E{Hb1, nullptr, nullptr, Hb2, ss2};
        const unsigned tg0 = TNOW();
        pg8::gemm_phase<EpiRes<1>, pg8::StaticOrder, true, true, false>(lds, g, S, E, TIDX);
        TACC(7, tg0); const unsigned tg1 = TNOW();
        { const int t2 = bid & 127, rh = (bid >> 7) & 1; TIDS; f32x4 ta[1]; tail_gemm<1>(lds, Hm + (size_t)SEQ * DFF, Wdn0_t, DFF, 16 * t2, rh, ta, TIDX); if (wave < 4) E.tail(SEQ + 64 * rh + 16 * wave + fr, 16 * t2 + 4 * fq, ta[0], fq); }
        TACC(8, tg1);
    }
    xcd_barrier(bar, IS_T0);
    STAMP();
    {
        TIDS;
        pg8::Gemm g{Hb2, Wkvq_t, MP, 3072, D}; pg8::StaticOrder S; S.init(MP, 3072, G, bid);
        EpiKVQ E{ss2, ws};
        pg8::gemm_phase<EpiKVQ, pg8::StaticOrder, true, true>(lds, g, S, E, TIDX);
        kmean_items(lds, cache_k, ptab, Kms, 336, 848, 140, G - 140, TIDX);
    }
    xcd_barrier(bar, IS_T0);
    STAMP();

    {
        TIDS;
        LAS float* partk = (LAS float*)(lds);
        for (int grp = bid; grp < MR / 32; grp += G) {
            const int r0 = grp * 32; float cs[8];
#pragma unroll
            for (int j = 0; j < 8; ++j) cs[j] = 0.f;
#pragma unroll
            for (int i = 0; i < 4; ++i) {
                const int row = r0 + 4 * wave + i; const int c = lane * 8;
                const f32x4 k0 = *(const f32x4*)(Kraw + (size_t)row * 512 + c), k1 = *(const f32x4*)(Kraw + (size_t)row * 512 + c + 4);
                float sq = (k0[0] * k0[0] + k0[1] * k0[1]) + (k0[2] * k0[2] + k0[3] * k0[3]) + (k1[0] * k1[0] + k1[1] * k1[1]) + (k1[2] * k1[2] + k1[3] * k1[3]);
                sq += shx<1>(sq); sq += shx<2>(sq); sq += shx<4>(sq); sq += shx<8>(sq);
                const float rk = rsqrtf(sq * (1.0f / 128.0f) + EPS);
                const f32x4 g0 = *(const f32x4*)(k_norm + (c & 127)), g1 = *(const f32x4*)(k_norm + (c & 127) + 4);
                const f32x4 n0 = k0 * rk * g0, n1 = k1 * rk * g1;
                float* ko = (row < SEQ) ? out + OK_P + (size_t)row * 512 + c : out + OK_S + (size_t)(row - SEQ) * 512 + c;
                __builtin_nontemporal_store(n0, (f32x4*)ko); __builtin_nontemporal_store(n1, (f32x4*)(ko + 4));
                v4u w; w.x = cvt_pk_bf16(n0[0], n0[1]); w.y = cvt_pk_bf16(n0[2], n0[3]); w.z = cvt_pk_bf16(n1[0], n1[1]); w.w = cvt_pk_bf16(n1[2], n1[3]);
                *(v4u*)(Kb + (size_t)row * 512 + c) = w;
#pragma unroll
                for (int j = 0; j < 4; ++j) { cs[j] += n0[j]; cs[4 + j] += n1[j]; }
                const f32x4 v0 = *(const f32x4*)(Vraw + (size_t)row * 512 + c), v1 = *(const f32x4*)(Vraw + (size_t)row * 512 + c + 4);
                float* vo = (row < SEQ) ? out + OV_P + (size_t)row * 512 + c : out + OV_S + (size_t)(row - SEQ) * 512 + c;
                __builtin_nontemporal_store(v0, (f32x4*)vo); __builtin_nontemporal_store(v1, (f32x4*)(vo + 4));
                v4u wv; wv.x = cvt_pk_bf16(v0[0], v0[1]); wv.y = cvt_pk_bf16(v0[2], v0[3]); wv.z = cvt_pk_bf16(v1[0], v1[1]); wv.w = cvt_pk_bf16(v1[2], v1[3]);
                *(v4u*)(Vb + (size_t)row * 512 + c) = wv;
            }
#pragma unroll
            for (int j = 0; j < 8; ++j) partk[wave * 512 + lane * 8 + j] = cs[j];
            __syncthreads();
            if (r0 < SEQ) {
                float s = 0.f;
#pragma unroll
                for (int w8 = 0; w8 < 8; ++w8) s += partk[w8 * 512 + tid];
                Kpart[(size_t)grp * 512 + tid] = s;
            }
            __syncthreads();
        }
        for (int row = bid * NWAVES + wave; row < MR; row += G * NWAVES) {
#pragma unroll
            for (int j = 0; j < 4; ++j) {
                const int c = j * 512 + lane * 8;
                const f32x4 q0 = *(const f32x4*)(Qraw + (size_t)row * D + c), q1 = *(const f32x4*)(Qraw + (size_t)row * D + c + 4);
                float sq = (q0[0] * q0[0] + q0[1] * q0[1]) + (q0[2] * q0[2] + q0[3] * q0[3]) + (q1[0] * q1[0] + q1[1] * q1[1]) + (q1[2] * q1[2] + q1[3] * q1[3]);
                sq += shx<1>(sq); sq += shx<2>(sq); sq += shx<4>(sq); sq += shx<8>(sq);
                const float rq = rsqrtf(sq * (1.0f / 128.0f) + EPS) * C2;
                const f32x4 g0 = *(const f32x4*)(q_norm + (c & 127)), g1 = *(const f32x4*)(q_norm + (c & 127) + 4);
                const f32x4 n0 = q0 * rq * g0, n1 = q1 * rq * g1;
                v4u w; w.x = cvt_pk_bf16(n0[0], n0[1]); w.y = cvt_pk_bf16(n0[2], n0[3]); w.z = cvt_pk_bf16(n1[0], n1[1]); w.w = cvt_pk_bf16(n1[2], n1[3]);
                *(v4u*)(Qb + (size_t)row * D + c) = w;
            }
        }
    }
    xcd_barrier(bar, IS_T0);
    STAMP();

    {
        TIDS;
        LAS bf16* KMb = (LAS bf16*)(lds);
        LAS unsigned* lcnt = (LAS unsigned*)(lds + 16384);
        LAS float* gs = (LAS float*)(lds + 16384 + 256);
#define G_BETTER(va, ia, vb, ib) (((va) > (vb)) || (((va) == (vb)) && ((ia) < (ib))))
#define G_INSERT(vx, ix) do { const float vx_ = (vx); const int ix_ = (ix); \
            if (G_BETTER(vx_, ix_, v0, i0)) { v2 = v1; i2 = i1; v1 = v0; i1 = i0; v0 = vx_; i0 = ix_; } \
            else if (G_BETTER(vx_, ix_, v1, i1)) { v2 = v1; i2 = i1; v1 = vx_; i1 = ix_; } \
            else if (G_BETTER(vx_, ix_, v2, i2)) { v2 = vx_; i2 = ix_; } } while (0)
        for (int item = bid; item < 256; item += G) {
            const int j = item >> 2, kvh = item & 3; const int b = j >> 1;
            { const int n = tid >> 4, d8 = (tid & 15) * 8; f32x4 s0 = {0.f, 0.f, 0.f, 0.f}, s1 = {0.f, 0.f, 0.f, 0.f};
              if (n < b) {
#pragma unroll
                  for (int sub = 0; sub < 8; ++sub) { const float* kp = Kpart + (size_t)(n * 8 + sub) * 512 + kvh * 128 + d8; s0 += *(const f32x4*)kp; s1 += *(const f32x4*)(kp + 4); } }
              s0 = s0 * (1.0f / 256.0f); s1 = s1 * (1.0f / 256.0f);
              v4u w; w.x = cvt_pk_bf16(s0[0], s0[1]); w.y = cvt_pk_bf16(s0[2], s0[3]); w.z = cvt_pk_bf16(s1[0], s1[1]); w.w = cvt_pk_bf16(s1[2], s1[3]);
              *(LAS v4u*)(KMb + n * 136 + d8) = w; }
            if (tid < 32) lcnt[tid] = 0u;
            __syncthreads();
            const int nsel = b < 3 ? b : 3;
#pragma unroll 1
            for (int rt = 0; rt < 4; ++rt) {
                const int r = 64 * wave + 16 * rt + fr; const int tok = j * 128 + (r >> 2), hg = r & 3; const bf16* qp = Qb + (size_t)tok * D + (4 * kvh + hg) * 128 + 8 * fq;
                bf16x8 qf[4];
#pragma unroll
                for (int ks = 0; ks < 4; ++ks) qf[ks] = *(const bf16x8*)(qp + 32 * ks);
                f32x4 ga[2];
#pragma unroll
                for (int nt = 0; nt < 2; ++nt) { ga[nt] = (f32x4){0.f, 0.f, 0.f, 0.f};
#pragma unroll
                    for (int ks = 0; ks < 4; ++ks) { const bf16x8 ka = *(const LAS bf16x8*)(KMb + (16 * nt + fr) * 136 + 32 * ks + 8 * fq); ga[nt] = MFMA16(ka, qf[ks], ga[nt]); } }
                float v0 = -INFINITY, v1 = -INFINITY, v2 = -INFINITY; int i0 = 99, i1 = 99, i2 = 99;
#pragma unroll
                for (int nt = 0; nt < 2; ++nt)
#pragma unroll
                    for (int q = 0; q < 4; ++q) { const int n = 16 * nt + 4 * fq + q; if (n < b) G_INSERT(ga[nt][q], n); }
                { const float a0 = shx<16>(v0), a1 = shx<16>(v1), a2 = shx<16>(v2);
                  const int c0 = __builtin_amdgcn_ds_swizzle(i0, (16 << 10) | 0x1f), c1 = __builtin_amdgcn_ds_swizzle(i1, (16 << 10) | 0x1f), c2 = __builtin_amdgcn_ds_swizzle(i2, (16 << 10) | 0x1f);
                  G_INSERT(a0, c0); G_INSERT(a1, c1); G_INSERT(a2, c2); }
                {
                  auto p0 = __builtin_amdgcn_permlane32_swap(__float_as_uint(v0), __float_as_uint(v0), false, false); auto p1 = __builtin_amdgcn_permlane32_swap(__float_as_uint(v1), __float_as_uint(v1), false, false);
                  auto p2 = __builtin_amdgcn_permlane32_swap(__float_as_uint(v2), __float_as_uint(v2), false, false);
                  auto q0 = __builtin_amdgcn_permlane32_swap((unsigned)i0, (unsigned)i0, false, false); auto q1 = __builtin_amdgcn_permlane32_swap((unsigned)i1, (unsigned)i1, false, false);
                  auto q2 = __builtin_amdgcn_permlane32_swap((unsigned)i2, (unsigned)i2, false, false);
                  v0 = __uint_as_float(p0[0]); v1 = __uint_as_float(p1[0]); v2 = __uint_as_float(p2[0]); i0 = (int)q0[0]; i1 = (int)q1[0]; i2 = (int)q2[0];
                  G_INSERT(__uint_as_float(p0[1]), (int)q0[1]); G_INSERT(__uint_as_float(p1[1]), (int)q1[1]); G_INSERT(__uint_as_float(p2[1]), (int)q2[1]); }
                if (fq == 0) {
#pragma unroll
                    for (int rk = 0; rk < 3; ++rk) {
                        if (rk < nsel) { const int best = (rk == 0) ? i0 : ((rk == 1) ? i1 : i2);
                            const unsigned pos = atomicAdd((unsigned*)&lcnt[best], 1u);
                            Subl[((size_t)(j * 4 + kvh) * 32 + best) * 512 + pos] = (unsigned)r | ((unsigned)rk << 9); }
                    }
                }
            }
            __syncthreads();
            if (tid < 32) Scnt[(j * 4 + kvh) * 32 + tid] = lcnt[tid];
            __syncthreads();
        }
#undef G_BETTER
#undef G_INSERT
        for (int item = bid; item < DECB * NKV; item += G) {
            const int b = item >> 2, kvh = item & 3; const int pr = tid >> 5, n = tid & 31;
            const int row = SEQ + 4 * b + (pr >> 2), hg = pr & 3; const bf16* qp = Qb + (size_t)row * D + (4 * kvh + hg) * 128; const float* kmp = Kms + ((size_t)(b * 32 + n)) * 512 + kvh * 128;
            float s = 0.f;
#pragma unroll 4
            for (int d = 0; d < 128; d += 8) { const v4u qw = *(const v4u*)(qp + d); const f32x4 k0 = *(const f32x4*)(kmp + d), k1 = *(const f32x4*)(kmp + d + 4);
                s += (bf2f(qw.x & 0xffffu) * k0[0] + bf2f(qw.x >> 16) * k0[1]) + (bf2f(qw.y & 0xffffu) * k0[2] + bf2f(qw.y >> 16) * k0[3]) + (bf2f(qw.z & 0xffffu) * k1[0] + bf2f(qw.z >> 16) * k1[1]) + (bf2f(qw.w & 0xffffu) * k1[2] + bf2f(qw.w >> 16) * k1[3]); }
            gs[pr * 32 + n] = s;
            __syncthreads();
            if (tid < 16) { unsigned m = 0u;
                for (int r = 0; r < 3; ++r) { int best = 0; float bv = -INFINITY; for (int nn = 0; nn < 32; ++nn) { const float v = gs[tid * 32 + nn]; if (v > bv) { bv = v; best = nn; } } m |= 1u << best; gs[tid * 32 + best] = -INFINITY; }
                Sels[item * 16 + tid] = m; }
            __syncthreads();
        }
    }
    xcd_barrier(bar, IS_T0);
    STAMP();

    {
        LAS bf16* Ks = (LAS bf16*)(lds); LAS bf16* Vs = (LAS bf16*)(lds + KS_BYTES);
        LAS unsigned* qsh = (LAS unsigned*)(lds + 2 * KS_BYTES);
        constexpr int NPI = 4 * 496, NSI = DECB * NKV * NBLK;
        for (;;) {
            const unsigned tq0 = TNOW();
            if (IS_T0) qsh[0] = __hip_atomic_fetch_add(ctl + CW_Q0, 1u, __ATOMIC_RELAXED, __HIP_MEMORY_SCOPE_AGENT);
            __syncthreads();
            const int tick = (int)qsh[0];
            __syncthreads();
            TACC(0, tq0);
            if (tick >= NPI + NSI) break;
            TIDS;
            int item; { const int g3 = tick / 3, r3 = tick - 3 * g3; item = (tick < 3 * NPI) ? ((r3 == 0) ? g3 : NPI + 2 * g3 + (r3 - 1)) : NPI + (tick - NPI); }
            if (item < NPI) {
                int b = (int)((1.0f + sqrtf(1.0f + 2.0f * (float)item)) * 0.5f); while (2 * b * (b - 1) > item) --b; while (2 * (b + 1) * b <= item) ++b;
                const int rem = item - 2 * b * (b - 1); const int n = rem >> 2, kvh = rem & 3;
                const int cntA = (int)Scnt[((2 * b) * 4 + kvh) * 32 + n], cntB = (int)Scnt[((2 * b + 1) * 4 + kvh) * 32 + n]; const int total = cntA + cntB;
                if (total == 0) continue;
                const unsigned tp0 = TNOW();
#pragma unroll
                for (int i = 0; i < 8; ++i) { const int idx = i * 512 + tid, key = idx >> 4, c8 = idx & 15; *(LAS v4u*)(Ks + key * KS_P + c8 * 8) = *(const v4u*)(Kb + (size_t)(256 * n + key) * 512 + kvh * 128 + c8 * 8); }
#pragma unroll
                for (int i = 0; i < 8; ++i) { const int idx = i * 512 + tid, key = idx >> 4, c8 = idx & 15; *(LAS v4u*)(Vs + key * KS_P + c8 * 8) = *(const v4u*)(Vb + (size_t)(256 * n + key) * 512 + kvh * 128 + c8 * 8); }
                __syncthreads();
                TACC(1, tp0); const unsigned tp1 = TNOW();
                const unsigned* LA = Subl + ((size_t)((2 * b) * 4 + kvh) * 32 + n) * 512; const unsigned* LB = Subl + ((size_t)((2 * b + 1) * 4 + kvh) * 32 + n) * 512;
#define LIST_ENT(i_) (((i_) < cntA) ? LA[(i_)] : LB[(i_) - cntA])
                const int iw = 16 * wave + fr;
                unsigned e1 = 0u, e2 = 0u; int ic1 = 0, ic2 = 0;
                if (16 * wave < total) { ic1 = iw < total ? iw : total - 1; e1 = LIST_ENT(ic1); }
                if (16 * wave + 128 < total) { ic2 = iw + 128 < total ? iw + 128 : total - 1; e2 = LIST_ENT(ic2); }
                bf16x8 qn[4];
                { const int tokn = ((ic1 < cntA) ? 2 * b : 2 * b + 1) * 128 + (int)((e1 >> 2) & 127u); const bf16* qp = Qb + (size_t)tokn * D + (4 * kvh + (int)(e1 & 3u)) * 128 + 8 * fq;
#pragma unroll
                  for (int ks = 0; ks < 4; ++ks) qn[ks] = *(const bf16x8*)(qp + 32 * ks); }
                for (int t0 = 0; t0 < total; t0 += 128) {
                    const int i0 = t0 + 16 * wave; if (i0 >= total) break;
                    const bool valid = (i0 + fr) < total; const int ic = ic1; const unsigned e = e1;
                    const int tok = ((ic < cntA) ? 2 * b : 2 * b + 1) * 128 + (int)((e >> 2) & 127u), hg = (int)(e & 3u), rk = (int)(e >> 9);
                    const int h = 4 * kvh + hg;
                    bf16x8 qf[4];
#pragma unroll
                    for (int ks = 0; ks < 4; ++ks) qf[ks] = qn[ks];
                    e1 = e2; ic1 = ic2;
                    if (i0 + 256 < total) { ic2 = (i0 + 256 + fr) < total ? (i0 + 256 + fr) : total - 1; e2 = LIST_ENT(ic2); }
                    if (i0 + 128 < total) { const int tokn = ((ic1 < cntA) ? 2 * b : 2 * b + 1) * 128 + (int)((e1 >> 2) & 127u); const bf16* qp = Qb + (size_t)tokn * D + (4 * kvh + (int)(e1 & 3u)) * 128 + 8 * fq;
#pragma unroll
                        for (int ks = 0; ks < 4; ++ks) qn[ks] = *(const bf16x8*)(qp + 32 * ks); }
                    f32x4 acc[16]; attn_scores<16>(Ks, qf, acc, 16, fr, fq);
                    float mx = -INFINITY;
#pragma unroll
                    for (int kt = 0; kt < 16; ++kt) mx = fmaxf(fmaxf(mx, fmaxf(acc[kt][0], acc[kt][1])), fmaxf(acc[kt][2], acc[kt][3]));
                    mx = fmaxf(mx, shx<16>(mx)); mx = xmax32(mx);
                    float l = 0.f;
#pragma unroll
                    for (int kt = 0; kt < 16; ++kt) {
#pragma unroll
                        for (int r = 0; r < 4; ++r) { const float p = __builtin_amdgcn_exp2f(acc[kt][r] - mx); acc[kt][r] = p; l += p; } }
                    l += shx<16>(l); l = xadd32(l);
                    f32x4 O[8];
#pragma unroll
                    for (int vt = 0; vt < 8; ++vt) O[vt] = (f32x4){0.f, 0.f, 0.f, 0.f};
                    attn_pv(Vs, acc, O, 8, fr, fq);
                    if (valid) {
                        const size_t slot = ((size_t)tok * NH + h) * 3 + rk; bf16* op = Oslot + slot * 128 + 4 * fq;
#pragma unroll
                        for (int vt = 0; vt < 8; ++vt) { v2u w; w.x = cvt_pk_bf16(O[vt][0], O[vt][1]); w.y = cvt_pk_bf16(O[vt][2], O[vt][3]); *(v2u*)(op + 16 * vt) = w; }
                        if (fq == 0) { MLslot[slot * 2] = mx; MLslot[slot * 2 + 1] = l; }
                    }
                }
                __syncthreads();
                TACC(2, tp1);
            } else {
                const int si = item - NPI; const int b = si >> 7, kvh = (si >> 5) & 3, n = si & 31;
                unsigned any = 0u;
#pragma unroll
                for (int p = 0; p < 16; ++p) any |= Sels[(b * 4 + kvh) * 16 + p];
                if (!((any >> n) & 1u)) continue;
                const unsigned ts0 = TNOW();
                const int pg0 = ptab[b * NPAGES + 2 * n], pg1 = ptab[b * NPAGES + 2 * n + 1];
                f32x4 kst[16], vst[16];
#pragma unroll
                for (int i = 0; i < 16; ++i) { const int idx = i * 512 + tid, key = idx >> 5, c4 = idx & 31; const int page = (key < 128) ? pg0 : pg1;
                    const size_t go = (((size_t)page * PAGE + (key & 127)) * NKV + kvh) * 128 + c4 * 4;
                    kst[i] = __builtin_nontemporal_load((const f32x4*)(cache_k + go)); vst[i] = __builtin_nontemporal_load((const f32x4*)(cache_v + go)); }
#pragma unroll
                for (int i = 0; i < 16; ++i) { const int idx = i * 512 + tid, key = idx >> 5, c4 = idx & 31; const int page = (key < 128) ? pg0 : pg1; (void)page;
                    const f32x4 kk4 = kst[i], vv4 = vst[i];
                    v2u w; w.x = cvt_pk_bf16(kk4[0], kk4[1]); w.y = cvt_pk_bf16(kk4[2], kk4[3]); *(LAS v2u*)(Ks + key * KS_P + c4 * 4) = w;
                    v2u wv; wv.x = cvt_pk_bf16(vv4[0], vv4[1]); wv.y = cvt_pk_bf16(vv4[2], vv4[3]); *(LAS v2u*)(Vs + key * KS_P + c4 * 4) = wv; }
                __syncthreads();
                TACC(3, ts0); const unsigned ts1 = TNOW();
                {
                    LAS float* mxs = (LAS float*)(lds + 2 * KS_BYTES + 64); LAS float* lss = mxs + 128; LAS float* Ored = (LAS float*)(lds);
                    const int row = SEQ + 4 * b + (fr >> 2), hg = fr & 3; const int h = 4 * kvh + hg; const bf16* qp = Qb + (size_t)row * D + h * 128 + 8 * fq;
                    bf16x8 qf[4];
#pragma unroll
                    for (int ks = 0; ks < 4; ++ks) qf[ks] = *(const bf16x8*)(qp + 32 * ks);
                    f32x4 a2[2];
#pragma unroll
                    for (int t = 0; t < 2; ++t) { a2[t] = (f32x4){0.f, 0.f, 0.f, 0.f};
#pragma unroll
                        for (int ks = 0; ks < 4; ++ks) { const bf16x8 ka = *(const LAS bf16x8*)(Ks + (16 * (2 * wave + t) + fr) * KS_P + 32 * ks + 8 * fq); a2[t] = MFMA16(ka, qf[ks], a2[t]); } }
                    float mx = fmaxf(fmaxf(fmaxf(a2[0][0], a2[0][1]), fmaxf(a2[0][2], a2[0][3])), fmaxf(fmaxf(a2[1][0], a2[1][1]), fmaxf(a2[1][2], a2[1][3])));
                    mx = fmaxf(mx, shx<16>(mx)); mx = xmax32(mx);
                    if (fq == 0) mxs[wave * 16 + fr] = mx;
                    __syncthreads();
                    float M = mxs[fr];
#pragma unroll
                    for (int w8 = 1; w8 < 8; ++w8) M = fmaxf(M, mxs[w8 * 16 + fr]);
                    float l = 0.f;
#pragma unroll
                    for (int t = 0; t < 2; ++t) {
#pragma unroll
                        for (int r = 0; r < 4; ++r) { const float p = __builtin_amdgcn_exp2f(a2[t][r] - M); a2[t][r] = p; l += p; } }
                    l += shx<16>(l); l = xadd32(l);
                    if (fq == 0) lss[wave * 16 + fr] = l;
                    v4u pw; pw.x = cvt_pk_bf16(a2[0][0], a2[0][1]); pw.y = cvt_pk_bf16(a2[0][2], a2[0][3]); pw.z = cvt_pk_bf16(a2[1][0], a2[1][1]); pw.w = cvt_pk_bf16(a2[1][2], a2[1][3]);
                    const bf16x8 pf = __builtin_bit_cast(bf16x8, pw);
                    const LAS bf16* vb = Vs + (32 * wave + 4 * fq + (fr >> 2)) * KS_P + 4 * (fr & 3);
#pragma unroll
                    for (int vt = 0; vt < 8; ++vt) { const v2u lo = tr_read(vb + 16 * vt), hi = tr_read(vb + 16 * KS_P + 16 * vt); const v4u aw = {lo.x, lo.y, hi.x, hi.y};
                        const f32x4 o = MFMA16(__builtin_bit_cast(bf16x8, aw), pf, ((f32x4){0.f, 0.f, 0.f, 0.f}));
                        *(LAS f32x4*)(Ored + (wave * 16 + fr) * 132 + 16 * vt + 4 * fq) = o; }
                    __syncthreads();
                    { const int r16 = tid >> 5, c4 = tid & 31; f32x4 so = *(const LAS f32x4*)(Ored + r16 * 132 + 4 * c4);
#pragma unroll
                      for (int w8 = 1; w8 < 8; ++w8) so += *(const LAS f32x4*)(Ored + (w8 * 16 + r16) * 132 + 4 * c4);
                      float* sp = Sslot + ((size_t)((b * 4 + kvh) * 32 + n) * 16 + r16) * 132;
                      *(f32x4*)(sp + 4 * c4) = so;
                      if (c4 == 0) { float Mr = mxs[r16], lt = lss[r16];
#pragma unroll
                          for (int w8 = 1; w8 < 8; ++w8) { Mr = fmaxf(Mr, mxs[w8 * 16 + r16]); lt += lss[w8 * 16 + r16]; }
                          sp[128] = Mr; sp[129] = lt; } }
                }
                __syncthreads();
                TACC(4, ts1);
            }
        }
    }
    xcd_barrier(bar, IS_T0);
    STAMP();

    {
        TIDS;
        LAS bf16* Ks = (LAS bf16*)(lds); LAS bf16* Vs = (LAS bf16*)(lds + KS_BYTES);
        for (int item = bid; item < NBLK * NKV * 2; item += G) {
            const int b = item >> 3, kvh = (item >> 1) & 3, hp = item & 1;
#pragma unroll
            for (int i = 0; i < 8; ++i) { const int idx = i * 512 + tid, key = idx >> 4, c8 = idx & 15; *(LAS v4u*)(Ks + key * KS_P + c8 * 8) = *(const v4u*)(Kb + (size_t)(256 * b + key) * 512 + kvh * 128 + c8 * 8); }
#pragma unroll
            for (int i = 0; i < 8; ++i) { const int idx = i * 512 + tid, key = idx >> 4, c8 = idx & 15; *(LAS v4u*)(Vs + key * KS_P + c8 * 8) = *(const v4u*)(Vb + (size_t)(256 * b + key) * 512 + kvh * 128 + c8 * 8); }
            const int nsel = b < 3 ? b : 3;
            bf16x8 qn[4];
            { const bf16* qp = Qb + (size_t)(256 * b + 16 * wave + fr) * D + (4 * kvh + 2 * hp) * 128 + 8 * fq;
#pragma unroll
              for (int ks = 0; ks < 4; ++ks) qn[ks] = *(const bf16x8*)(qp + 32 * ks); }
            __syncthreads();
#pragma unroll 1
            for (int u = 0; u < 4; ++u) {
                const int g = (u & 1) ? 15 - wave : wave, h = 4 * kvh + 2 * hp + (u >> 1); const int tl = 16 * g + fr; const int tok = 256 * b + tl;
                bf16x8 qf[4];
#pragma unroll
                for (int ks = 0; ks < 4; ++ks) qf[ks] = qn[ks];
                if (u < 3) { const int gn = ((u + 1) & 1) ? 15 - wave : wave, hn = 4 * kvh + 2 * hp + ((u + 1) >> 1); const bf16* qp = Qb + (size_t)(256 * b + 16 * gn + fr) * D + hn * 128 + 8 * fq;
#pragma unroll
                    for (int ks = 0; ks < 4; ++ks) qn[ks] = *(const bf16x8*)(qp + 32 * ks); }
                float msa[3], lsa[3];
#pragma unroll
                for (int r = 0; r < 3; ++r) { msa[r] = -INFINITY; lsa[r] = 0.f; if (r < nsel) { const size_t slot = ((size_t)tok * NH + h) * 3 + r; msa[r] = MLslot[slot * 2]; lsa[r] = MLslot[slot * 2 + 1]; } }
                const int nkt = g + 1;
                f32x4 acc[16]; attn_scores<16>(Ks, qf, acc, nkt, fr, fq);
                float mx = -INFINITY;
#pragma unroll
                for (int kt = 0; kt < 16; ++kt) {
#pragma unroll
                    for (int r = 0; r < 4; ++r) { const bool ok = (kt < nkt) && (16 * kt + 4 * fq + r <= tl); const float sv = ok ? acc[kt][r] : -INFINITY; acc[kt][r] = sv; mx = fmaxf(mx, sv); } }
                mx = fmaxf(mx, shx<16>(mx)); mx = xmax32(mx);
                float M = mx;
#pragma unroll
                for (int r = 0; r < 3; ++r) M = fmaxf(M, msa[r]);
                float l = 0.f;
#pragma unroll
                for (int kt = 0; kt < 16; ++kt) {
#pragma unroll
                    for (int r = 0; r < 4; ++r) { const float p = __builtin_amdgcn_exp2f(acc[kt][r] - M); acc[kt][r] = p; l += p; } }
                l += shx<16>(l); l = xadd32(l);
                f32x4 O[8];
#pragma unroll
                for (int vt = 0; vt < 8; ++vt) O[vt] = (f32x4){0.f, 0.f, 0.f, 0.f};
                attn_pv(Vs, acc, O, (nkt + 1) >> 1, fr, fq);
#pragma unroll
                for (int r = 0; r < 3; ++r) { if (r < nsel) { const float sc = __builtin_amdgcn_exp2f(msa[r] - M); l += lsa[r] * sc; const size_t slot = ((size_t)tok * NH + h) * 3 + r; const bf16* op = Oslot + slot * 128 + 4 * fq;
#pragma unroll
                    for (int vt = 0; vt < 8; ++vt) { const v2u w = *(const v2u*)(op + 16 * vt); O[vt][0] += bf2f(w.x & 0xffffu) * sc; O[vt][1] += bf2f(w.x >> 16) * sc; O[vt][2] += bf2f(w.y & 0xffffu) * sc; O[vt][3] += bf2f(w.y >> 16) * sc; } } }
                const float il = 1.0f / l; bf16* ap = At + (size_t)tok * D + h * 128 + 4 * fq;
#pragma unroll
                for (int vt = 0; vt < 8; ++vt) { v2u w; w.x = cvt_pk_bf16(O[vt][0] * il, O[vt][1] * il); w.y = cvt_pk_bf16(O[vt][2] * il, O[vt][3] * il); *(v2u*)(ap + 16 * vt) = w; }
            }
            __syncthreads();
        }
        LAS float* ksn = (LAS float*)(lds);
        for (int item = bid; item < DECB * NKV; item += G) {
            const int b = item >> 2, kvh = item & 3;
            { const int key = tid >> 7, d = tid & 127; ksn[key * 128 + d] = out[OK_S + (size_t)(4 * b + key) * 512 + kvh * 128 + d]; ksn[512 + key * 128 + d] = Vraw[(size_t)(SEQ + 4 * b + key) * 512 + kvh * 128 + d]; }
            __syncthreads();
            const int pr = tid >> 5, l32 = tid & 31; const int t = pr >> 2, hg = pr & 3; const int row = SEQ + 4 * b + t, h = 4 * kvh + hg;
            const v2u qw = *(const v2u*)(Qb + (size_t)row * D + h * 128 + 4 * l32);
            const float q0 = bf2f(qw.x & 0xffffu), q1 = bf2f(qw.x >> 16), q2 = bf2f(qw.y & 0xffffu), q3 = bf2f(qw.y >> 16);
            float sk[4]; float M = -INFINITY;
#pragma unroll
            for (int key = 0; key < 4; ++key) { const f32x4 k4 = *(const LAS f32x4*)(ksn + key * 128 + 4 * l32); float s = (q0 * k4[0] + q1 * k4[1]) + (q2 * k4[2] + q3 * k4[3]);
                s += shx<1>(s); s += shx<2>(s); s += shx<4>(s); s += shx<8>(s); s += shx<16>(s);
                sk[key] = (key <= t) ? s : -INFINITY; M = fmaxf(M, sk[key]); }
            const unsigned mask = Sels[item * 16 + pr];
#pragma unroll 1
            for (int n = 0; n < 32; ++n) if ((mask >> n) & 1u) M = fmaxf(M, Sslot[((size_t)(item * 32 + n) * 16 + pr) * 132 + 128]);
            float l = 0.f; f32x4 O = {0.f, 0.f, 0.f, 0.f};
#pragma unroll
            for (int key = 0; key < 4; ++key) { const float p = __builtin_amdgcn_exp2f(sk[key] - M); l += p; O += *(const LAS f32x4*)(ksn + 512 + key * 128 + 4 * l32) * p; }
#pragma unroll 1
            for (int n = 0; n < 32; ++n) if ((mask >> n) & 1u) { const float* sp = Sslot + ((size_t)(item * 32 + n) * 16 + pr) * 132; const float sc = __builtin_amdgcn_exp2f(sp[128] - M); l += sp[129] * sc; O += *(const f32x4*)(sp + 4 * l32) * sc; }
            const float il = 1.0f / l; v2u w; w.x = cvt_pk_bf16(O[0] * il, O[1] * il); w.y = cvt_pk_bf16(O[2] * il, O[3] * il);
            *(v2u*)(At + (size_t)row * D + h * 128 + 4 * l32) = w;
            __syncthreads();
        }
    }
    xcd_barrier(bar, IS_T0);
    STAMP();

    {
        TIDS;
        pg8::Gemm g{At, Wo_t, SEQ, D, D}; pg8::StaticOrder S; S.init(SEQ, D, G, bid);
        EpiRes<1> E{Hb2, nullptr, nullptr, Hb3, ss3};
        pg8::gemm_phase<EpiRes<1>, pg8::StaticOrder, true, true, false>(lds, g, S, E, TIDX);
        { const int t2 = bid & 127, rh = (bid >> 7) & 1; TIDS; f32x4 ta[1]; tail_gemm<1>(lds, At + (size_t)SEQ * D, Wo_t, D, 16 * t2, rh, ta, TIDX); if (wave < 4) E.tail(SEQ + 64 * rh + 16 * wave + fr, 16 * t2 + 4 * fq, ta[0], fq); }
    }
    xcd_barrier(bar, IS_T0);
    STAMP();
    {
        TIDS;
        pg8::Gemm g{Hb3, Wgu1_t, MP, NGU, D}; pg8::StaticOrder S; S.init(MP, NGU, G, bid);
        EpiGU E{ss3, Hm};
        pg8::gemm_phase<EpiGU, pg8::StaticOrder, true, true>(lds, g, S, E, TIDX);
    }
    xcd_barrier(bar, IS_T0);
    STAMP();
    {
        TIDS;
        pg8::Gemm g{Hm, Wdn1_t, SEQ, D, DFF}; pg8::StaticOrder S; S.init(SEQ, D, G, bid);
        EpiRes<2> E{Hb3, out + OY_P, out + OY_S, nullptr, nullptr};
        pg8::gemm_phase<EpiRes<2>, pg8::StaticOrder, true, true, false>(lds, g, S, E, TIDX);
        { const int t2 = bid & 127, rh = (bid >> 7) & 1; TIDS; f32x4 ta[1]; tail_gemm<1>(lds, Hm + (size_t)SEQ * DFF, Wdn1_t, DFF, 16 * t2, rh, ta, TIDX); if (wave < 4) E.tail(SEQ + 64 * rh + 16 * wave + fr, 16 * t2 + 4 * fq, ta[0], fq); }
    }
#ifdef PROF_A
    STAMP();
    if (blockIdx.x == 0 && IS_T0) {
        const unsigned ta = PVAL(PROF_A0, PROF_A1), tb = PVAL(PROF_B0, PROF_B1);
        unsigned qa = (ta + PROF_UA / 2) / PROF_UA, qb = (tb + PROF_UB / 2) / PROF_UB; if (qa > 99u) qa = 99u; if (qb > 99u) qb = 99u;
#ifdef PROF_MUL
        const unsigned long long extra = (unsigned long long)ta * PROF_MUL;
#else
        const unsigned long long extra = (unsigned long long)(qa + 100u * qb) * 5000ull;
#endif
        const unsigned long long t0 = __builtin_amdgcn_s_memrealtime();
        while (__builtin_amdgcn_s_memrealtime() - t0 < extra) __builtin_amdgcn_s_sleep(32);
    }
#endif
}
#undef x_p
#undef x_s
#undef st_in
#undef cache_k
#undef cache_v
#undef ptab
#undef norm_mix_a
#undef w_in
#undef lbl
#undef onorm
#undef w_out
#undef norm_kv
#undef w_kv
#undef k_norm
#undef norm_mix_b
#undef w_q
#undef q_norm
#undef w_o
#undef norm_ffn
#undef w_gu
#undef w_dn
#undef Win_t
#undef Wout_t
#undef Wgu0_t
#undef Wdn0_t
#undef Wkvq_t
#undef Wo_t
#undef Wgu1_t
#undef Wdn1_t
#undef Hb0
#undef Hb1
#undef Hb2
#undef Hb3
#undef Hf1
#undef Hf2
#undef Hf3
#undef Qg
#undef Vg
#undef Gg
#undef Ff
#undef Ob
#undef At
#undef Hm
#undef Ub
#undef Sst
#undef Dec
#undef Kraw
#undef Vraw
#undef Qraw
#undef Kb
#undef Vb
#undef Qb
#undef Kpart
#undef Kms
#undef Subl
#undef Scnt
#undef Sels
#undef Oslot
#undef MLslot
#undef Sslot
#undef ss0
#undef ss1
#undef ss2
#undef ss3
#undef out
#undef TIDS
#undef TIDX
#undef IS_T0

extern "C" void kernel_launch(void* const* d_in, const int* in_sizes, int n_in, void* d_out, int out_size, void* d_ws, size_t ws_size, hipStream_t stream) {
    static int grid = 0;
    if (grid == 0) {
        if (n_in != 21 || ws_size < WS_END) { fprintf(stderr, "kernel_launch: unexpected n_in %d / ws %zu\n", n_in, ws_size); grid = -1; return; }
        int dev = 0, cus = 0, per_cu = 0;
        if (hipGetDevice(&dev) != hipSuccess || hipDeviceGetAttribute(&cus, hipDeviceAttributeMultiprocessorCount, dev) != hipSuccess) { grid = -1; return; }
        if (hipFuncSetAttribute((const void*)yoco_fwd, hipFuncAttributeMaxDynamicSharedMemorySize, LDS_BYTES) != hipSuccess) { fprintf(stderr, "kernel_launch: hipFuncSetAttribute failed\n"); grid = -1; return; }
        if (hipOccupancyMaxActiveBlocksPerMultiprocessor(&per_cu, (const void*)yoco_fwd, NTHR, LDS_BYTES) != hipSuccess || per_cu < 1) fprintf(stderr, "kernel_launch: occupancy query says %d\n", per_cu);
        (void)hipGetLastError();
        grid = cus;
        if (grid < 256) { fprintf(stderr, "kernel_launch: built for 256 CUs (got %d)\n", grid); grid = -1; return; }
        grid = 256;
    }
    if (grid < 0) return;
    (void)hipMemsetAsync((char*)d_ws + WS_CTL, 0, CTL_ZERO_BYTES, stream);
    Args a{};
    for (int i = 0; i < 21; ++i) a.in[i] = d_in[i];
    a.out = (float*)d_out; a.ws = (unsigned char*)d_ws;
    hipLaunchKernelGGL(yoco_fwd, dim3(grid), dim3(NTHR), LDS_BYTES, stream, a);
}
```

```cpp
#include <hip/hip_runtime.h>
#include <cstdio>
#include <cstdint>
__device__ __forceinline__ int lane_id() { int l = (int)__builtin_amdgcn_mbcnt_hi(~0u, __builtin_amdgcn_mbcnt_lo(~0u, 0u)); asm volatile("" : "+v"(l)); return l; }

namespace pg8 {
#define PG8_LAS __attribute__((address_space(3)))
typedef unsigned short bf16_t;
typedef short bf16x8 __attribute__((ext_vector_type(8)));
typedef float f32x4 __attribute__((ext_vector_type(4)));
typedef unsigned u32x4 __attribute__((ext_vector_type(4)));
typedef unsigned u32x2 __attribute__((ext_vector_type(2)));
constexpr int BM = 256, BK = 64, HALF = 128, HTB = HALF * BK * 2, STAGE_BYTES = 8 * HTB, NXCD = 8, WGM = 8;

__host__ __device__ __forceinline__ int lds_byte(int r, int c) { const int st = (r >> 4) * 2 + (c >> 5), rr = r & 15, cc = c & 31, ob = rr * 64 + cc * 2; return st * 1024 + (ob ^ (((ob >> 9) & 1) << 5)); }
__host__ __device__ __forceinline__ void stage_rc(int b, int& R, int& C) { const int st = b / 1024, sb = b % 1024, swz = sb ^ (((sb >> 9) & 1) << 5); R = (st >> 1) * 16 + swz / 64; C = (st & 1) * 32 + (swz % 64) / 2; }
__host__ __device__ __forceinline__ int perm32(int rho) { const int n = rho >> 4, i = rho & 15; return 8 * (i >> 2) + 4 * n + (i & 3); }

struct Unit { int pm, pn; };
struct Gemm { const bf16_t* A; const bf16_t* Bt; int M, N, K; };

struct StaticOrder {
    int nM, nN, nwg, G, c;
    __host__ __device__ void init(int M, int N, int G_, int c_) { nM = M / BM; nN = N / BM; nwg = nM * nN; G = G_; c = c_; }
    __host__ __device__ bool next(int i, Unit& u) const {
        const long L = (long)i * G + c; if (L >= nwg) return false;
        int wgid = (int)L; { const int q = nwg / NXCD, r = nwg % NXCD, xcd = wgid % NXCD, off = wgid / NXCD; wgid = (xcd < r ? xcd * (q + 1) : r * (q + 1) + (xcd - r) * q) + off; }
        const int nig = WGM * nN, gid = wgid / nig, fm = gid * WGM, gsz = (nM - fm) < WGM ? (nM - fm) : WGM;
        u.pm = fm + ((wgid % nig) % gsz); u.pn = (wgid % nig) / gsz; return true;
    }
    __device__ __forceinline__ void a_ready(const Unit&) const {}
    __device__ __forceinline__ void done(const Unit&) const {}
};

__device__ __forceinline__ unsigned cvt_pk_bf16(float lo, float hi) { unsigned r; asm volatile("v_cvt_pk_bf16_f32 %0, %1, %2" : "=v"(r) : "v"(lo), "v"(hi)); return r; }

template <class Epi, class Sched, bool ALIGN_EPI = false, bool SP2 = false, bool HALF_LAST = true>
__device__ __forceinline__ void gemm_phase(PG8_LAS unsigned char* lds, const Gemm g, const Sched& S, const Epi& E, int tidx) {
    int tid_ = tidx; asm volatile("" : "+v"(tid_));
    const int tid = tid_, wid = __builtin_amdgcn_readfirstlane(tid >> 6), lane = tid & 63, wr = wid >> 2, wc = wid & 3, fr = lane & 15, fq = lane >> 4;
    const int K = g.K, nt = K / BK;
    unsigned voffA[2], voffB[2];
#pragma unroll
    for (int i = 0; i < 2; ++i) { int R, C; stage_rc(tid * 16 + i * 8192, R, C); const int Rb = Epi::PERM ? ((R & ~31) + perm32(R & 31)) : R;
        voffA[i] = (unsigned)(R * K + C) * 2u; voffB[i] = (unsigned)(Rb * K + C) * 2u; }
    const size_t kstep = (size_t)(BK * 2);
    const size_t hstep = (size_t)HALF * K * 2;
    const size_t tstep = 2 * hstep;
    const unsigned ldsw = (unsigned)wid * 1024u;
    const int aoff = lds_byte(wr * 64 + fr, fq * 8), boff = lds_byte(wc * 32 + fr, fq * 8);
#define PG8_SA(b, h) (((b) * 2 + (h)) * HTB)
#define PG8_SB(b, h) ((4 + (b) * 2 + (h)) * HTB)
#define PG8_STAGE(bufoff, gbase, voff) do { _Pragma("unroll") for (int _i = 0; _i < 2; ++_i) \
        __builtin_amdgcn_global_load_lds((const unsigned*)((const char*)(gbase) + (voff)[_i]), (PG8_LAS unsigned*)(lds + (bufoff) + ldsw + _i * 8192), 16, 0, 0); } while (0)
#define PG8_LDA(dst, b, h) do { _Pragma("unroll") for (int m = 0; m < 4; ++m) _Pragma("unroll") for (int k = 0; k < 2; ++k) dst[m][k] = *(const PG8_LAS bf16x8*)(lds + PG8_SA(b, h) + aoff + m * 2048 + k * 1024); } while (0)
#define PG8_LDB(dst, b, h) do { _Pragma("unroll") for (int n = 0; n < 2; ++n) _Pragma("unroll") for (int k = 0; k < 2; ++k) dst[n][k] = *(const PG8_LAS bf16x8*)(lds + PG8_SB(b, h) + boff + n * 2048 + k * 1024); } while (0)
#define PG8_MMA(ai, bj, At, Bt) do { __builtin_amdgcn_s_setprio(1); _Pragma("unroll") for (int m = 0; m < 4; ++m) _Pragma("unroll") for (int n = 0; n < 2; ++n) _Pragma("unroll") for (int k = 0; k < 2; ++k) \
        acc[ai][bj][m][n] = __builtin_amdgcn_mfma_f32_16x16x32_bf16(Bt[n][k], At[m][k], acc[ai][bj][m][n], 0, 0, 0); __builtin_amdgcn_s_setprio(0); } while (0)
#define PG8_WAIT_V(n) asm volatile("s_waitcnt vmcnt(" #n ")" ::: "memory")
#define PG8_WAIT_L(n) asm volatile("s_waitcnt lgkmcnt(" #n ")" ::: "memory")
#define PG8_BAR __builtin_amdgcn_s_barrier()
#define PG8_SCHED __builtin_amdgcn_sched_barrier(0)
    Unit cur, nxt; int ui = 0;
    if (!S.next(0, cur)) return;
    f32x4 acc[2][2][4][2];
#pragma unroll
    for (int a = 0; a < 2; ++a)
#pragma unroll
        for (int b = 0; b < 2; ++b)
#pragma unroll
            for (int m = 0; m < 4; ++m)
#pragma unroll
                for (int n = 0; n < 2; ++n) acc[a][b][m][n] = (f32x4){0.f, 0.f, 0.f, 0.f};
    bf16x8 At[4][2], B0[2][2], B1[2][2];
    const char* cA = (const char*)g.A + (size_t)cur.pm * tstep; const char* cB = (const char*)g.Bt + (size_t)cur.pn * tstep;
    S.a_ready(cur);
    if constexpr (SP2) {
        PG8_STAGE(PG8_SB(0, 0), cB, voffB); PG8_STAGE(PG8_SB(0, 1), cB + hstep, voffB); PG8_STAGE(PG8_SA(0, 0), cA, voffA); PG8_STAGE(PG8_SA(0, 1), cA + hstep, voffA);
        if (wr == 1) PG8_BAR;
        PG8_WAIT_V(2); PG8_BAR;
        PG8_STAGE(PG8_SB(1, 0), cB + kstep, voffB); PG8_STAGE(PG8_SA(1, 0), cA + kstep, voffA); PG8_STAGE(PG8_SB(1, 1), cB + hstep + kstep, voffB);
        PG8_WAIT_V(6); PG8_BAR;
    } else {
        PG8_STAGE(PG8_SB(0, 0), cB, voffB); PG8_STAGE(PG8_SA(0, 0), cA, voffA); PG8_STAGE(PG8_SB(0, 1), cB + hstep, voffB); PG8_STAGE(PG8_SA(0, 1), cA + hstep, voffA);
        if (wr == 1) PG8_BAR;
        PG8_WAIT_V(4); PG8_BAR;
        PG8_STAGE(PG8_SB(1, 0), cB + kstep, voffB); PG8_STAGE(PG8_SA(1, 0), cA + kstep, voffA); PG8_STAGE(PG8_SB(1, 1), cB + hstep + kstep, voffB);
        PG8_WAIT_V(6); PG8_BAR;
    }
    for (;;) {
        const bool has_next = S.next(ui + 1, nxt);
        const bool half1 = HALF_LAST && (cur.pm == g.M / BM - 1);
        const char* nA = has_next ? (const char*)g.A + (size_t)nxt.pm * tstep : cA; const char* nB = has_next ? (const char*)g.Bt + (size_t)nxt.pn * tstep : cB;
        for (int t = 0; t < nt; t += 2) {
            const bool last = (t == nt - 2);
            const char* a1 = cA + (size_t)(t + 1) * kstep;
            const char* a2 = last ? nA : cA + (size_t)(t + 2) * kstep; const char* b2 = last ? nB : cB + (size_t)(t + 2) * kstep;
            const char* a3 = a2 + kstep; const char* b3 = b2 + kstep;
            if (last && has_next) S.a_ready(nxt);
            if constexpr (SP2) {
            PG8_LDB(B0, 0, 0); PG8_LDB(B1, 0, 1); PG8_SCHED; PG8_LDA(At, 0, 0); PG8_STAGE(PG8_SA(1, 1), a1 + hstep, voffA);
            PG8_WAIT_V(8); PG8_WAIT_L(0); PG8_BAR; PG8_MMA(0, 0, At, B0); PG8_MMA(0, 1, At, B1); PG8_BAR; PG8_SCHED;
            if (!half1) { PG8_LDA(At, 0, 1); } PG8_STAGE(PG8_SB(0, 0), b2, voffB); PG8_STAGE(PG8_SB(0, 1), b2 + hstep, voffB); PG8_STAGE(PG8_SA(0, 0), a2, voffA);
            PG8_WAIT_V(8); PG8_WAIT_L(0); PG8_BAR; if (!half1) { PG8_MMA(1, 0, At, B0); PG8_MMA(1, 1, At, B1); } PG8_BAR; PG8_SCHED;
            PG8_LDB(B0, 1, 0); PG8_LDB(B1, 1, 1); PG8_SCHED; PG8_LDA(At, 1, 0); PG8_STAGE(PG8_SA(0, 1), a2 + hstep, voffA);
            PG8_WAIT_V(8); PG8_WAIT_L(0); PG8_BAR; PG8_MMA(0, 0, At, B0); PG8_MMA(0, 1, At, B1); PG8_BAR; PG8_SCHED;
            if (!half1) { PG8_LDA(At, 1, 1); } PG8_STAGE(PG8_SB(1, 0), b3, voffB); PG8_STAGE(PG8_SB(1, 1), b3 + hstep, voffB); PG8_STAGE(PG8_SA(1, 0), a3, voffA);
            PG8_WAIT_V(8); PG8_WAIT_L(0); PG8_BAR; if (!half1) { PG8_MMA(1, 0, At, B0); PG8_MMA(1, 1, At, B1); } PG8_BAR; PG8_SCHED;
            } else {
            PG8_LDB(B0, 0, 0); PG8_SCHED; PG8_LDA(At, 0, 0); PG8_STAGE(PG8_SA(1, 1), a1 + hstep, voffA);
            PG8_WAIT_L(8); PG8_BAR; PG8_WAIT_L(0); PG8_MMA(0, 0, At, B0); PG8_BAR; PG8_SCHED;
            PG8_LDB(B1, 0, 1); PG8_STAGE(PG8_SB(0, 0), b2, voffB);
            PG8_BAR; PG8_WAIT_L(0); PG8_MMA(0, 1, At, B1); PG8_BAR;
            PG8_LDA(At, 0, 1); PG8_STAGE(PG8_SA(0, 0), a2, voffA);
            PG8_BAR; PG8_WAIT_L(0); PG8_MMA(1, 0, At, B0); PG8_BAR; PG8_SCHED;
            PG8_STAGE(PG8_SB(0, 1), b2 + hstep, voffB);
            PG8_WAIT_V(6); PG8_BAR; PG8_MMA(1, 1, At, B1); PG8_BAR;
            PG8_LDB(B0, 1, 0); PG8_SCHED; PG8_LDA(At, 1, 0); PG8_STAGE(PG8_SA(0, 1), a2 + hstep, voffA);
            PG8_WAIT_L(8); PG8_BAR; PG8_WAIT_L(0); PG8_MMA(0, 0, At, B0); PG8_BAR; PG8_SCHED;
            PG8_LDB(B1, 1, 1); PG8_STAGE(PG8_SB(1, 0), b3, voffB);
            PG8_BAR; PG8_WAIT_L(0); PG8_MMA(0, 1, At, B1); PG8_BAR;
            PG8_LDA(At, 1, 1); PG8_STAGE(PG8_SA(1, 0), a3, voffA);
            PG8_BAR; PG8_WAIT_L(0); PG8_MMA(1, 0, At, B0); PG8_BAR; PG8_SCHED;
            PG8_STAGE(PG8_SB(1, 1), b3 + hstep, voffB);
            PG8_WAIT_V(6); PG8_BAR; PG8_MMA(1, 1, At, B1); PG8_BAR;
            }
        }
        if constexpr (ALIGN_EPI) { if (wr == 0) PG8_BAR; }
        E(acc, cur, wr, wc, fr, fq);
        if (!has_next) break;
#pragma unroll
        for (int a = 0; a < 2; ++a)
#pragma unroll
            for (int b = 0; b < 2; ++b)
#pragma unroll
                for (int m = 0; m < 4; ++m)
#pragma unroll
                    for (int n = 0; n < 2; ++n) acc[a][b][m][n] = (f32x4){0.f, 0.f, 0.f, 0.f};
        cur = nxt; cA = nA; cB = nB; ++ui;
        if constexpr (ALIGN_EPI) { if (wr == 1) PG8_BAR; }
    }
    PG8_WAIT_V(0);
    if constexpr (!ALIGN_EPI) { if (wr == 0) PG8_BAR; }
    PG8_BAR;
#undef PG8_SA
#undef PG8_SB
#undef PG8_STAGE
#undef PG8_LDA
#undef PG8_LDB
#undef PG8_MMA
#undef PG8_WAIT_V
#undef PG8_WAIT_L
#undef PG8_BAR
#undef PG8_SCHED
}
}

constexpr int NWAVES = 8, NTHR = 512;
constexpr int D = 2048, SEQ = 8192, DECB = 32, DECS = 4, MS = DECB * DECS;
constexpr int MR = SEQ + MS;
constexpr int MP = 8448;
constexpr int NH = 16, HD = 128, NKV = 4, DFF = 5632, NGU = 2 * DFF;
constexpr int NCHUNK = SEQ / 64;
constexpr int NPAGES = 64, PAGE = 128, NBLK = 32;
constexpr float EPS = 1e-6f;
constexpr float C2 = 0.08838834764831845f * 1.4426950408889634f;

constexpr size_t OY_P = 0, OY_S = OY_P + (size_t)SEQ * D, OST_P = OY_S + (size_t)MS * D, OST_S = OST_P + (size_t)NH * 128 * 128,
                 OK_P = OST_S + (size_t)DECB * NH * 128 * 128, OV_P = OK_P + (size_t)SEQ * 512, OK_S = OV_P + (size_t)SEQ * 512, OV_S = OK_S + (size_t)MS * 512;

constexpr size_t MiB = 1u << 20;
constexpr size_t WS_CTL = 0, CTL_ZERO_BYTES = 1 * MiB;
constexpr size_t WS_WIN = 2 * MiB;
constexpr size_t WS_WOUT = WS_WIN + 32 * MiB;
constexpr size_t WS_WGU0 = WS_WOUT + 8 * MiB;
constexpr size_t WS_WDN0 = WS_WGU0 + 44 * MiB;
constexpr size_t WS_WKVQ = WS_WDN0 + 22 * MiB;
constexpr size_t WS_WO = WS_WKVQ + 12 * MiB;
constexpr size_t WS_WGU1 = WS_WO + 8 * MiB;
constexpr size_t WS_WDN1 = WS_WGU1 + 44 * MiB;
constexpr size_t WS_HB0 = WS_WDN1 + 22 * MiB;
constexpr size_t WS_HB1 = WS_HB0 + 34 * MiB, WS_HB2 = WS_HB1 + 34 * MiB, WS_HB3 = WS_HB2 + 34 * MiB;
constexpr size_t WS_HF1 = WS_HB3 + 34 * MiB;
constexpr size_t WS_HF2 = WS_HF1 + 67 * MiB, WS_HF3 = WS_HF2 + 67 * MiB;
constexpr size_t WS_QG = WS_HF3 + 67 * MiB;
constexpr size_t WS_VG = WS_QG + 34 * MiB;
constexpr size_t WS_GG = WS_VG + 34 * MiB;
constexpr size_t WS_F = WS_GG + 34 * MiB;
constexpr size_t WS_OB = WS_F + 67 * MiB;
constexpr size_t WS_AT = WS_OB + 34 * MiB;
constexpr size_t WS_HM = WS_AT + 34 * MiB;
constexpr size_t WS_U = WS_HM + 92 * MiB;
constexpr size_t WS_SST = WS_U + 64 * MiB;
constexpr size_t WS_DEC = WS_SST + 64 * MiB;
constexpr size_t WS_KRAW = WS_DEC + 2 * MiB;
constexpr size_t WS_VRAW = WS_KRAW + 17 * MiB;
constexpr size_t WS_QRAW = WS_VRAW + 17 * MiB;
constexpr size_t WS_KB = WS_QRAW + 67 * MiB;
constexpr size_t WS_VB = WS_KB + 9 * MiB;
constexpr size_t WS_QB = WS_VB + 9 * MiB;
constexpr size_t WS_KPART = WS_QB + 34 * MiB;
constexpr size_t WS_KMS = WS_KPART + 1 * MiB;
constexpr size_t WS_SUBL = WS_KMS + 2 * MiB;
constexpr size_t WS_SCNT = WS_SUBL + 16 * MiB;
constexpr size_t WS_OSLOT = WS_SCNT + 1 * MiB;
constexpr size_t WS_MLSLOT = WS_OSLOT + 192 * MiB;
constexpr size_t WS_SSLOT = WS_MLSLOT + 3 * MiB;
constexpr size_t WS_FOUT = WS_SSLOT + 34 * MiB;
constexpr size_t WS_END = WS_FOUT + 131 * MiB;
constexpr size_t WS_ORC = WS_END;
constexpr int CW_BAR = 4096;
constexpr int CW_Q0 = 8192;
constexpr int CW_SS0 = 16384, CW_SS1 = CW_SS0 + MP, CW_SS2 = CW_SS1 + MP, CW_SS3 = CW_SS2 + MP;
static_assert((CW_SS3 + MP) * 4 <= (int)CTL_ZERO_BYTES, "ctl");
static_assert(WS_VG - WS_QG == 34 * MiB && WS_GG - WS_VG == 34 * MiB, "Qg|Vg|Gg stride");

constexpr int LDS_BYTES = 160 * 1024;
constexpr int MISC_OFF = LDS_BYTES - 256;

#define GAS __attribute__((address_space(1)))
#define LAS __attribute__((address_space(3)))
typedef unsigned short bf16;
typedef unsigned v4u __attribute__((ext_vector_type(4)));
typedef unsigned v2u __attribute__((ext_vector_type(2)));
typedef float f32x4 __attribute__((ext_vector_type(4)));
typedef float f32x2 __attribute__((ext_vector_type(2)));
typedef short bf16x8 __attribute__((ext_vector_type(8)));
typedef short bf16x4 __attribute__((ext_vector_type(4)));
typedef _Float16 f16;
typedef _Float16 f16x2 __attribute__((ext_vector_type(2)));
__device__ __forceinline__ unsigned pkh2(float lo, float hi) { const f16x2 v = {(f16)lo, (f16)hi}; return __builtin_bit_cast(unsigned, v); }
#define LDS_WAIT() asm volatile("s_waitcnt lgkmcnt(0)" ::: "memory")
__device__ __forceinline__ unsigned f2bf(float f) { unsigned u = __builtin_bit_cast(unsigned, f); return (u + 0x7fffu + ((u >> 16) & 1u)) >> 16; }
__device__ __forceinline__ unsigned pk2(float lo, float hi) { return f2bf(lo) | (f2bf(hi) << 16); }
__device__ __forceinline__ float bf2f(unsigned h) { return __uint_as_float(h << 16); }
__device__ __forceinline__ float silu_f(float x) { return x * __builtin_amdgcn_rcpf(1.0f + __expf(-x)); }
__device__ __forceinline__ float sigm_f(float x) { return __builtin_amdgcn_rcpf(1.0f + __expf(-x)); }
template <int M> __device__ __forceinline__ float shx(float v) { return __uint_as_float((unsigned)__builtin_amdgcn_ds_swizzle((int)__float_as_uint(v), (M << 10) | 0x1f)); }
__device__ __forceinline__ float xadd32(float v) { auto rr = __builtin_amdgcn_permlane32_swap(__float_as_uint(v), __float_as_uint(v), false, false); return __uint_as_float(rr[0]) + __uint_as_float(rr[1]); }
__device__ __forceinline__ float xmax32(float v) { auto rr = __builtin_amdgcn_permlane32_swap(__float_as_uint(v), __float_as_uint(v), false, false); return fmaxf(__uint_as_float(rr[0]), __uint_as_float(rr[1])); }
__device__ __forceinline__ float wave_sum(float v) { v += shx<1>(v); v += shx<2>(v); v += shx<4>(v); v += shx<8>(v); v += shx<16>(v); return xadd32(v); }
#define MFMA16(a, b, c) __builtin_amdgcn_mfma_f32_16x16x32_bf16((a), (b), (c), 0, 0, 0)

#define XB_TMO      128
#define XB_XCNT(j)  (256  + 64 * (j))
#define XB_XSUB(j)  (1280 + 64 * (j))
#define XB_XGEN(j)  (2304 + 64 * (j))
#define XB_TOP      3328
#define XB_TOPGEN   3392
#define XCD_BAR_WORDS 3456
#define XB_SPIN_CAP (1u << 18)
__device__ __forceinline__ unsigned xb_ld(unsigned* p)              { return __hip_atomic_load(p, __ATOMIC_RELAXED, __HIP_MEMORY_SCOPE_AGENT); }
__device__ __forceinline__ unsigned xb_add(unsigned* p, unsigned v) { return __hip_atomic_fetch_add(p, v, __ATOMIC_RELAXED, __HIP_MEMORY_SCOPE_AGENT); }
__device__ __forceinline__ unsigned xb_xcc_id() { return (unsigned)__builtin_amdgcn_s_getreg((3 << 11) | 20) & 0xFu; }
#define XB_SPIN(cond, bar) do { unsigned _sp = 0; while (cond) { __builtin_amdgcn_s_sleep(1); \
    if ((++_sp & 255u) == 0u) { if (xb_ld(&(bar)[XB_TMO])) break; if (_sp > XB_SPIN_CAP) { atomicAdd(&(bar)[XB_TMO], 1u); break; } } } } while (0)
struct XcdBarrier { unsigned* bar; unsigned x; volatile LAS unsigned* st; };
__device__ __forceinline__ XcdBarrier xcd_barrier_post(unsigned* bar, volatile LAS unsigned* st, bool is_t0) {
    XcdBarrier b; b.bar = bar; b.x = xb_xcc_id(); b.st = st;
    if (is_t0) (void)xb_add(&bar[XB_XCNT(b.x)], 1u);
    return b;
}
__device__ __forceinline__ void xcd_barrier_complete(unsigned* bar, unsigned x, unsigned& nloc, unsigned& nx) {
    const unsigned G = gridDim.x * gridDim.y * gridDim.z;
    unsigned sum, cnt, mine, sp = 0u;
    for (;;) {
        sum = 0u; cnt = 0u; mine = 0u;
#pragma unroll
        for (unsigned j = 0; j < 16; ++j) { const unsigned c = xb_ld(&bar[XB_XCNT(j)]); sum += c; cnt += (c > 0u) ? 1u : 0u; mine = (j == x) ? c : mine; }
        if (sum == G) break;
        __builtin_amdgcn_s_sleep(1);
        if ((++sp & 255u) == 0u) { if (xb_ld(&bar[XB_TMO])) break; if (sp > XB_SPIN_CAP) { atomicAdd(&bar[XB_TMO], 1u); break; } }
    }
    nloc = mine > 0u ? mine : 1u; nx = cnt > 0u ? cnt : 1u;
}
__device__ __forceinline__ void xcd_barrier(const XcdBarrier& b, bool is_t0) {
    asm volatile("s_waitcnt vmcnt(0)" ::: "memory");
    __syncthreads();
    if (is_t0) {
        unsigned* bar = b.bar;
        __builtin_amdgcn_s_waitcnt(0);
        unsigned nloc = b.st[0], nx = b.st[1];
        if (nloc == 0u) { xcd_barrier_complete(bar, b.x, nloc, nx); b.st[0] = nloc; b.st[1] = nx; }
        const unsigned old = xb_add(&bar[XB_XSUB(b.x)], 1u);
        const unsigned gen = old / nloc;
        if (old + 1u == (gen + 1u) * nloc) {
            __builtin_amdgcn_fence(__ATOMIC_RELEASE, "agent");
            asm volatile("s_waitcnt vmcnt(0)" ::: "memory");
            const unsigned og = xb_add(&bar[XB_TOP], 1u);
            const unsigned tg = og / nx;
            if (og + 1u == (tg + 1u) * nx) xb_add(&bar[XB_TOPGEN], 1u);
            else XB_SPIN(xb_ld(&bar[XB_TOPGEN]) == tg, bar);
            __builtin_amdgcn_fence(__ATOMIC_ACQUIRE, "agent");
            xb_add(&bar[XB_XGEN(b.x)], 1u);
            asm volatile("s_waitcnt vmcnt(0)" ::: "memory");
        } else {
            XB_SPIN(xb_ld(&bar[XB_XGEN(b.x)]) == gen, bar);
            __builtin_amdgcn_fence(__ATOMIC_ACQUIRE, "agent");
            asm volatile("s_waitcnt vmcnt(0)" ::: "memory");
        }
    }
    __syncthreads();
}

using pg8::Unit; using pg8::cvt_pk_bf16;
struct EpiIn {
    static constexpr bool PERM = true;
    const float* ss; const float* lbl; bf16* Qg; f16* F;
    __device__ __forceinline__ void operator()(const f32x4 (&acc)[2][2][4][2], const Unit& u, int wr, int wc, int fr, int fq) const {
        const int seg = u.pn >> 3; const int col0 = (u.pn & 7) * 256 + wc * 32 + 8 * fq; const int rowb = u.pm * 256 + wr * 64;
        float lb[2][8];
        if (seg == 1) {
#pragma unroll
            for (int bj = 0; bj < 2; ++bj)
#pragma unroll
                for (int j = 0; j < 8; ++j) { const int c = col0 + bj * 128 + j; lb[bj][j] = __builtin_amdgcn_rcpf(1.0f + __expf(lbl[D + c] - lbl[c])); }
        }
#pragma unroll
        for (int ai = 0; ai < 2; ++ai)
#pragma unroll
            for (int m = 0; m < 4; ++m) {
                const int rb = rowb + ai * 128 + m * 16; if (rb >= MR) continue;
                const int row = rb + fr; const float r = rsqrtf(ss[row] * (1.0f / D) + EPS);
#pragma unroll
                for (int bj = 0; bj < 2; ++bj) {
                    f32x4 v0 = acc[ai][bj][m][0] * r, v1 = acc[ai][bj][m][1] * r; const size_t off = (size_t)row * D + col0 + bj * 128;
                    if (seg == 1) {
                        f32x4 o0, o1;
#pragma unroll
                        for (int j = 0; j < 4; ++j) { o0[j] = lb[bj][j] + (1.0f - lb[bj][j]) * sigm_f(v0[j]); o1[j] = lb[bj][4 + j] + (1.0f - lb[bj][4 + j]) * sigm_f(v1[j]); }
                        { v4u w; w.x = pkh2(o0[0], o0[1]); w.y = pkh2(o0[2], o0[3]); w.z = pkh2(o1[0], o1[1]); w.w = pkh2(o1[2], o1[3]); *(v4u*)(F + off) = w; }
                    } else {
                        if (seg != 2) {
#pragma unroll
                            for (int j = 0; j < 4; ++j) { v0[j] = silu_f(v0[j]); v1[j] = silu_f(v1[j]); }
                        }
                        v4u w; w.x = cvt_pk_bf16(v0[0], v0[1]); w.y = cvt_pk_bf16(v0[2], v0[3]); w.z = cvt_pk_bf16(v1[0], v1[1]); w.w = cvt_pk_bf16(v1[2], v1[3]);
                        const size_t dsel = (seg == 0) ? 0 : ((seg == 2) ? 1 : 2);
                        *(v4u*)(Qg + dsel * (size_t)(17 * MiB) + off) = w;
                    }
                }
            }
    }
    __device__ __forceinline__ void tail(int row, int col, f32x4 v) const {
        const int seg = col >> 11, c = col & 2047; const float r = rsqrtf(ss[row] * (1.0f / D) + EPS); v = v * r; const size_t off = (size_t)row * D + c;
        if (seg == 1) { f32x4 o;
#pragma unroll
            for (int j = 0; j < 4; ++j) { const float lbv = __builtin_amdgcn_rcpf(1.0f + __expf(lbl[D + c + j] - lbl[c + j])); o[j] = lbv + (1.0f - lbv) * sigm_f(v[j]); }
            { v2u w; w.x = pkh2(o[0], o[1]); w.y = pkh2(o[2], o[3]); *(v2u*)(F + off) = w; }
        } else {
            if (seg != 2) {
#pragma unroll
                for (int j = 0; j < 4; ++j) v[j] = silu_f(v[j]);
            }
            v2u w; w.x = cvt_pk_bf16(v[0], v[1]); w.y = cvt_pk_bf16(v[2], v[3]);
            const size_t dsel = (seg == 0) ? 0 : ((seg == 2) ? 1 : 2);
            *(v2u*)(Qg + dsel * (size_t)(17 * MiB) + off) = w;
        }
    }
};

template <int MODE> struct EpiRes {
    static constexpr bool PERM = true;
    const bf16* rb; float* o0; float* o1; bf16* hb; float* ss;
    __device__ __forceinline__ void operator()(const f32x4 (&acc)[2][2][4][2], const Unit& u, int wr, int wc, int fr, int fq) const {
        const int col0 = u.pn * 256 + wc * 32 + 8 * fq; const int rowb = u.pm * 256 + wr * 64;
#pragma unroll
        for (int ai = 0; ai < 2; ++ai)
#pragma unroll
            for (int m = 0; m < 4; ++m) {
                const int rb0 = rowb + ai * 128 + m * 16; if (rb0 >= MR) continue;
                const int row = rb0 + fr;
                const bf16* rp = rb + (size_t)row * D;
                float* op = (MODE == 2) ? ((row < SEQ) ? o0 + (size_t)row * D : o1 + (size_t)(row - SEQ) * D) : nullptr;
                float sq = 0.f;
#pragma unroll
                for (int bj = 0; bj < 2; ++bj) {
                    const int c = col0 + bj * 128;
                    const v4u rw = *(const v4u*)(rp + c);
                    f32x4 a0 = {bf2f(rw.x & 0xffffu), bf2f(rw.x >> 16), bf2f(rw.y & 0xffffu), bf2f(rw.y >> 16)}, a1 = {bf2f(rw.z & 0xffffu), bf2f(rw.z >> 16), bf2f(rw.w & 0xffffu), bf2f(rw.w >> 16)};
                    a0 += acc[ai][bj][m][0]; a1 += acc[ai][bj][m][1];
                    if (MODE == 2) { __builtin_nontemporal_store(a0, (f32x4*)(op + c)); __builtin_nontemporal_store(a1, (f32x4*)(op + c + 4)); }
                    else {
                        v4u w; w.x = cvt_pk_bf16(a0[0], a0[1]); w.y = cvt_pk_bf16(a0[2], a0[3]); w.z = cvt_pk_bf16(a1[0], a1[1]); w.w = cvt_pk_bf16(a1[2], a1[3]);
                        *(v4u*)(hb + (size_t)row * D + c) = w;
                        sq += (a0[0] * a0[0] + a0[1] * a0[1]) + (a0[2] * a0[2] + a0[3] * a0[3]) + (a1[0] * a1[0] + a1[1] * a1[1]) + (a1[2] * a1[2] + a1[3] * a1[3]);
                    }
                }
                if (MODE != 2) { sq += shx<16>(sq); sq = xadd32(sq); if (fq == 0) atomicAdd(ss + row, sq); }
            }
    }
    __device__ __forceinline__ void tail(int row, int col, f32x4 v, int fq) const {
        const v2u rw = *(const v2u*)(rb + (size_t)row * D + col);
        f32x4 a0 = {bf2f(rw.x & 0xffffu), bf2f(rw.x >> 16), bf2f(rw.y & 0xffffu), bf2f(rw.y >> 16)}; a0 += v;
        if (MODE == 2) { *(f32x4*)(o1 + (size_t)(row - SEQ) * D + col) = a0; }
        else {
            v2u w; w.x = cvt_pk_bf16(a0[0], a0[1]); w.y = cvt_pk_bf16(a0[2], a0[3]); *(v2u*)(hb + (size_t)row * D + col) = w;
            float sq = (a0[0] * a0[0] + a0[1] * a0[1]) + (a0[2] * a0[2] + a0[3] * a0[3]);
            sq += shx<16>(sq); sq = xadd32(sq); if (fq == 0) atomicAdd(ss + row, sq);
        }
    }
};
struct EpiGU {
    static constexpr bool PERM = true;
    const float* ss; bf16* hm;
    __device__ __forceinline__ void operator()(const f32x4 (&acc)[2][2][4][2], const Unit& u, int wr, int wc, int fr, int fq) const {
        const int j0 = u.pn * 128 + wc * 32 + 8 * fq; const int rowb = u.pm * 256 + wr * 64;
#pragma unroll
        for (int ai = 0; ai < 2; ++ai)
#pragma unroll
            for (int m = 0; m < 4; ++m) {
                const int rb = rowb + ai * 128 + m * 16; if (rb >= MR) continue;
                const int row = rb + fr; const float r = rsqrtf(ss[row] * (1.0f / D) + EPS);
                float o[8];
#pragma unroll
                for (int n = 0; n < 2; ++n)
#pragma unroll
                    for (int j = 0; j < 4; ++j) o[4 * n + j] = silu_f(acc[ai][0][m][n][j] * r) * (acc[ai][1][m][n][j] * r);
                v4u w; w.x = cvt_pk_bf16(o[0], o[1]); w.y = cvt_pk_bf16(o[2], o[3]); w.z = cvt_pk_bf16(o[4], o[5]); w.w = cvt_pk_bf16(o[6], o[7]);
                *(v4u*)(hm + (size_t)row * DFF + j0) = w;
            }
    }
};
struct EpiKVQ {
    static constexpr bool PERM = true;
    const float* ss; unsigned char* ws;
    __device__ __forceinline__ void operator()(const f32x4 (&acc)[2][2][4][2], const Unit& u, int wr, int wc, int fr, int fq) const {
        const int c0 = wc * 32 + 8 * fq; const int rowb = u.pm * 256 + wr * 64;
        const bool isq = u.pn >= 4;
        const size_t base = (u.pn < 2) ? WS_KRAW : WS_VRAW;
        const int tcol = (u.pn < 2) ? u.pn * 256 : ((u.pn < 4) ? (u.pn - 2) * 256 : (u.pn - 4) * 256);
        float* dst = (float*)(ws + base); bf16* dq = (bf16*)(ws + WS_QRAW);
#pragma unroll
        for (int ai = 0; ai < 2; ++ai)
#pragma unroll
            for (int m = 0; m < 4; ++m) {
                const int rb = rowb + ai * 128 + m * 16; if (rb >= MR) continue;
                const int row = rb + fr; const float r = rsqrtf(ss[row] * (1.0f / D) + EPS);
#pragma unroll
                for (int bj = 0; bj < 2; ++bj) {
                    const f32x4 v0 = acc[ai][bj][m][0] * r, v1 = acc[ai][bj][m][1] * r;
                    if (isq) { v4u w; w.x = cvt_pk_bf16(v0[0], v0[1]); w.y = cvt_pk_bf16(v0[2], v0[3]); w.z = cvt_pk_bf16(v1[0], v1[1]); w.w = cvt_pk_bf16(v1[2], v1[3]); *(v4u*)(dq + (size_t)row * 2048 + tcol + c0 + bj * 128) = w; }
                    else { float* p = dst + (size_t)row * 512 + tcol + c0 + bj * 128; *(f32x4*)p = v0; *(f32x4*)(p + 4) = v1; }
                }
            }
    }
};

struct Args { const void* in[21]; float* out; unsigned char* ws; };

__device__ __forceinline__ void p0_transpose_item(const float* W, int K, int N, bf16* WT, int row_off, int mode, const float* gain, LAS float* scr, int item, int lane) {
    const int nblk = N / 64, kb = item / nblk, nb = item % nblk, k0 = 64 * kb, n0 = 64 * nb;
    const int r = lane >> 4, c4 = lane & 15;
#pragma unroll
    for (int i = 0; i < 16; ++i) { const int kk = 4 * i + r; f32x4 w = __builtin_nontemporal_load((const f32x4*)(W + (size_t)(k0 + kk) * N + n0 + 4 * c4)); if (gain) w *= gain[k0 + kk]; *(LAS f32x4*)(scr + kk * 68 + 4 * c4) = w; }
    LDS_WAIT(); asm volatile("" ::: "memory");
    const int c = lane & 7;
    int d0;
    if (mode == 0) d0 = row_off + n0;
    else { const int j = (n0 < DFF) ? n0 : n0 - DFF; d0 = 256 * (j >> 7) + (j & 127) + ((n0 < DFF) ? 0 : 128); }
#pragma unroll
    for (int j = 0; j < 8; ++j) { const int n = (lane >> 3) + 8 * j; const LAS float* sp = scr + (8 * c) * 68 + n;
        v4u o; o.x = pk2(sp[0 * 68], sp[1 * 68]); o.y = pk2(sp[2 * 68], sp[3 * 68]); o.z = pk2(sp[4 * 68], sp[5 * 68]); o.w = pk2(sp[6 * 68], sp[7 * 68]);
        *(v4u*)(WT + (size_t)(d0 + n) * K + k0 + 8 * c) = o; }
    LDS_WAIT(); asm volatile("" ::: "memory");
}

constexpr int KS_P = 144;
constexpr int KS_BYTES = 256 * KS_P * 2;
typedef short v4i16_t __attribute__((ext_vector_type(4)));
__device__ __forceinline__ v2u tr_read(const LAS bf16* p) { return __builtin_bit_cast(v2u, __builtin_amdgcn_ds_read_tr16_b64_v4i16((LAS v4i16_t*)p)); }
template <int NKT> __device__ __forceinline__ void attn_scores(const LAS bf16* Ks, const bf16x8 (&qf)[4], f32x4 (&acc)[16], int nkt, int fr, int fq) {
#pragma unroll
    for (int kt = 0; kt < NKT; ++kt) {
        acc[kt] = (f32x4){0.f, 0.f, 0.f, 0.f};
        if (kt < nkt) {
#pragma unroll
            for (int ks = 0; ks < 4; ++ks) { const bf16x8 a = *(const LAS bf16x8*)(Ks + (16 * kt + fr) * KS_P + 32 * ks + 8 * fq); acc[kt] = MFMA16(a, qf[ks], acc[kt]); }
        }
    }
}
__device__ __forceinline__ void attn_pv(const LAS bf16* Vr, const f32x4 (&acc)[16], f32x4 (&O)[8], int nj, int fr, int fq) {
#pragma unroll
    for (int j = 0; j < 8; ++j) {
        if (j < nj) {
            v4u pw; pw.x = cvt_pk_bf16(acc[2 * j][0], acc[2 * j][1]); pw.y = cvt_pk_bf16(acc[2 * j][2], acc[2 * j][3]); pw.z = cvt_pk_bf16(acc[2 * j + 1][0], acc[2 * j + 1][1]); pw.w = cvt_pk_bf16(acc[2 * j + 1][2], acc[2 * j + 1][3]);
            const bf16x8 pf = __builtin_bit_cast(bf16x8, pw);
            const LAS bf16* vb = Vr + (32 * j + 4 * fq + (fr >> 2)) * KS_P + 4 * (fr & 3);
#pragma unroll
            for (int vt = 0; vt < 8; ++vt) {
                const v2u lo = tr_read(vb + 16 * vt), hi = tr_read(vb + 16 * KS_P + 16 * vt);
                const v4u aw = {lo.x, lo.y, hi.x, hi.y};
                O[vt] = MFMA16(__builtin_bit_cast(bf16x8, aw), pf, O[vt]);
            }
        }
    }
}

template <int NT> __device__ __forceinline__ void tail_gemm(LAS unsigned char* lds, const bf16* A, const bf16* Bt, int K, int n0, int rowhalf, f32x4 (&acc)[NT], int tidx) {
    int tid_o = tidx; asm volatile("" : "+v"(tid_o));
    const int lane = tid_o & 63, wave = __builtin_amdgcn_readfirstlane(tid_o >> 6), fr = lane & 15, fq = lane >> 4;
    const int rt = wave & 3, kh = wave >> 2; const int Kh = K >> 1;
    const bf16* ap = A + (size_t)(64 * rowhalf + 16 * rt + fr) * K + kh * Kh + 8 * fq;
    const bf16* bp = Bt + (size_t)(n0 + fr) * K + kh * Kh + 8 * fq;
#pragma unroll
    for (int t = 0; t < NT; ++t) acc[t] = (f32x4){0.f, 0.f, 0.f, 0.f};
    bf16x8 a0[8], b0[NT][8], a1[8], b1[NT][8];
#define TG_LOAD(a_, b_, k0_) do { _Pragma("unroll") for (int s_ = 0; s_ < 8; ++s_) { a_[s_] = *(const bf16x8*)(ap + (k0_) + 32 * s_); _Pragma("unroll") for (int t_ = 0; t_ < NT; ++t_) b_[t_][s_] = *(const bf16x8*)(bp + (size_t)t_ * 16 * K + (k0_) + 32 * s_); } } while (0)
#define TG_MMA(a_, b_) do { _Pragma("unroll") for (int s_ = 0; s_ < 8; ++s_) { _Pragma("unroll") for (int t_ = 0; t_ < NT; ++t_) acc[t_] = MFMA16(b_[t_][s_], a_[s_], acc[t_]); } } while (0)
    TG_LOAD(a0, b0, 0);
    for (int k0 = 0; k0 < Kh; k0 += 512) {
        if (k0 + 256 < Kh) TG_LOAD(a1, b1, k0 + 256);
        TG_MMA(a0, b0);
        if (k0 + 256 < Kh) { if (k0 + 512 < Kh) TG_LOAD(a0, b0, k0 + 512); TG_MMA(a1, b1); }
    }
#undef TG_LOAD
#undef TG_MMA
    LAS f32x4* red = (LAS f32x4*)lds;
    if (kh == 1) {
#pragma unroll
        for (int t = 0; t < NT; ++t) red[(t * 4 + rt) * 64 + lane] = acc[t];
    }
    __syncthreads();
    if (kh == 0) {
#pragma unroll
        for (int t = 0; t < NT; ++t) acc[t] += red[(t * 4 + rt) * 64 + lane];
    }
    __syncthreads();
}

__device__ __forceinline__ void kmean_items(LAS unsigned char* lds, const float* cache_k_, const int* ptab_, float* Kms_, int i0, int i1, int c0, int cn, int tidx) {
    int tid_o = tidx; asm volatile("" : "+v"(tid_o)); const int tid = tid_o;
    const int me = (int)blockIdx.x - c0; if (me < 0 || me >= cn) return;
    LAS f32x4* redk = (LAS f32x4*)(lds);
    for (int item = i0 + me; item < i1; item += cn) {
        const int b = item >> 5, n = item & 31; const int c4 = tid & 127, rg = tid >> 7;
        f32x4 a = {0.f, 0.f, 0.f, 0.f};
#pragma unroll
        for (int hp = 0; hp < 2; ++hp) { const int page = ptab_[b * NPAGES + 2 * n + hp]; const f32x4* pp = (const f32x4*)(cache_k_ + (size_t)page * PAGE * 512) + c4;
#pragma unroll 16
            for (int r = rg; r < 128; r += 4) a += __builtin_nontemporal_load(pp + (size_t)r * 128); }
        redk[rg * 128 + c4] = a;
        __syncthreads();
        if (tid < 128) { const f32x4 s4 = (redk[tid] + redk[128 + tid]) + (redk[256 + tid] + redk[384 + tid]); *(f32x4*)(Kms_ + (size_t)item * 512 + 4 * tid) = s4 * (1.0f / 256.0f); }
        __syncthreads();
    }
}

__global__ void __launch_bounds__(NTHR, 2) yoco_fwd(Args args) {
    extern __shared__ __attribute__((aligned(16))) unsigned char lds_raw[];
    LAS unsigned char* lds = (LAS unsigned char*)lds_raw;
#define TIDS int tid_o = TIDX; asm volatile("" : "+v"(tid_o)); const int tid = tid_o, lane = tid & 63, wave = __builtin_amdgcn_readfirstlane(tid >> 6), fr = lane & 15, fq = lane >> 4; (void)fr; (void)fq; (void)wave; (void)lane; (void)tid
    const int G = gridDim.x, bid = blockIdx.x;
    unsigned char* ws = args.ws;
    unsigned* ctl = (unsigned*)(ws + WS_CTL);
    volatile LAS unsigned* MISC = (volatile LAS unsigned*)(lds + MISC_OFF);
    const int wave_sg = __builtin_amdgcn_readfirstlane((int)threadIdx.x & ~63);
#define TIDX (wave_sg + lane_id())
#define IS_T0 ((wave_sg == 0) && (lane_id() == 0))
    if (TIDX < 64) MISC[TIDX] = 0u;
    __syncthreads();
    XcdBarrier bar = xcd_barrier_post(ctl + CW_BAR, MISC + 8, IS_T0);
#ifdef PROF_A
    int n_stamp = 0;
#define STAMP() do { if (blockIdx.x == 0 && IS_T0) MISC[16 + n_stamp] = (unsigned)__builtin_amdgcn_s_memrealtime(); ++n_stamp; } while (0)
#define TNOW() ((unsigned)__builtin_amdgcn_s_memrealtime())
#define TACC(k, t0) do { if (blockIdx.x == 0 && IS_T0) MISC[40 + (k)] += TNOW() - (t0); } while (0)
#define PVAL(a0, a1) (((a0) >= 100) ? MISC[40 + (a0) - 100] : (MISC[16 + (a1)] - MISC[16 + (a0)]))
#else
#define STAMP() do {} while (0)
#define TNOW() 0u
#define TACC(k, t0) do { (void)(t0); } while (0)
#endif
    STAMP();

#define x_p ((const float*)args.in[0])
#define x_s ((const float*)args.in[1])
#define st_in ((const float*)args.in[2])
#define cache_k ((const float*)args.in[3])
#define cache_v ((const float*)args.in[4])
#define ptab ((const int*)args.in[5])
#define norm_mix_a ((const float*)args.in[6])
#define w_in ((const float*)args.in[7])
#define lbl ((const float*)args.in[8])
#define onorm ((const float*)args.in[9])
#define w_out ((const float*)args.in[10])
#define norm_kv ((const float*)args.in[11])
#define w_kv ((const float*)args.in[12])
#define k_norm ((const float*)args.in[13])
#define norm_mix_b ((const float*)args.in[14])
#define w_q ((const float*)args.in[15])
#define q_norm ((const float*)args.in[16])
#define w_o ((const float*)args.in[17])
#define norm_ffn ((const float*)args.in[18])
#define w_gu ((const float*)args.in[19])
#define w_dn ((const float*)args.in[20])
#define Win_t ((bf16*)(ws + WS_WIN))
#define Wout_t ((bf16*)(ws + WS_WOUT))
#define Wgu0_t ((bf16*)(ws + WS_WGU0))
#define Wdn0_t ((bf16*)(ws + WS_WDN0))
#define Wkvq_t ((bf16*)(ws + WS_WKVQ))
#define Wo_t ((bf16*)(ws + WS_WO))
#define Wgu1_t ((bf16*)(ws + WS_WGU1))
#define Wdn1_t ((bf16*)(ws + WS_WDN1))
#define Hb0 ((bf16*)(ws + WS_HB0))
#define Hb1 ((bf16*)(ws + WS_HB1))
#define Hb2 ((bf16*)(ws + WS_HB2))
#define Hb3 ((bf16*)(ws + WS_HB3))
#define Hf1 ((float*)(ws + WS_HF1))
#define Hf2 ((float*)(ws + WS_HF2))
#define Hf3 ((float*)(ws + WS_HF3))
#define Qg ((bf16*)(ws + WS_QG))
#define Vg ((bf16*)(ws + WS_VG))
#define Gg ((bf16*)(ws + WS_GG))
#define Ff ((f16*)(ws + WS_F))
#define Ob ((bf16*)(ws + WS_OB))
#define At ((bf16*)(ws + WS_AT))
#define Hm ((bf16*)(ws + WS_HM))
#define Ub ((bf16*)(ws + WS_U))
#define Sst ((bf16*)(ws + WS_SST))
#define Dec ((float*)(ws + WS_DEC))
#define Kraw ((float*)(ws + WS_KRAW))
#define Vraw ((float*)(ws + WS_VRAW))
#define Qraw ((bf16*)(ws + WS_QRAW))
#define Kb ((bf16*)(ws + WS_KB))
#define Vb ((bf16*)(ws + WS_VB))
#define Qb ((bf16*)(ws + WS_QB))
#define Kpart ((float*)(ws + WS_KPART))
#define Kms ((float*)(ws + WS_KMS))
#define Subl ((unsigned*)(ws + WS_SUBL))
#define Scnt ((unsigned*)(ws + WS_SCNT))
#define Sels ((unsigned*)(ws + WS_SCNT + 256 * 1024))
#define Oslot ((bf16*)(ws + WS_OSLOT))
#define MLslot ((float*)(ws + WS_MLSLOT))
#define Sslot ((float*)(ws + WS_SSLOT))
#define ss0 ((float*)(ctl + CW_SS0))
#define ss1 ((float*)(ctl + CW_SS1))
#define ss2 ((float*)(ctl + CW_SS2))
#define ss3 ((float*)(ctl + CW_SS3))
#define out (args.out)
    {
        TIDS;
        LAS float* scr = (LAS float*)(lds + wave * 17408);
        const int gw = bid * NWAVES + wave, NGW = G * NWAVES;
        constexpr int I_IN = 32 * 128, I_SQ = 32 * 32, I_GU = 32 * 176, I_DN = 88 * 32, I_KV = 32 * 16;
        constexpr int NITEMS = I_IN + I_SQ + 2 * I_GU + 2 * I_DN + I_KV + I_SQ + I_SQ;
        for (int it = gw; it < NITEMS; it += NGW) {
            int r = it;
            if (r < I_IN) { p0_transpose_item(w_in, D, 4 * D, Win_t, 0, 0, norm_mix_a, scr, r, lane); continue; } r -= I_IN;
            if (r < I_SQ) { p0_transpose_item(w_out, D, D, Wout_t, 0, 0, nullptr, scr, r, lane); continue; } r -= I_SQ;
            if (r < I_GU) { p0_transpose_item(w_gu, D, NGU, Wgu0_t, 0, 1, norm_ffn, scr, r, lane); continue; } r -= I_GU;
            if (r < I_GU) { p0_transpose_item(w_gu + (size_t)D * NGU, D, NGU, Wgu1_t, 0, 1, norm_ffn + D, scr, r, lane); continue; } r -= I_GU;
            if (r < I_DN) { p0_transpose_item(w_dn, DFF, D, Wdn0_t, 0, 0, nullptr, scr, r, lane); continue; } r -= I_DN;
            if (r < I_DN) { p0_transpose_item(w_dn + (size_t)DFF * D, DFF, D, Wdn1_t, 0, 0, nullptr, scr, r, lane); continue; } r -= I_DN;
            if (r < I_KV) { p0_transpose_item(w_kv, D, 1024, Wkvq_t, 0, 0, norm_kv, scr, r, lane); continue; } r -= I_KV;
            if (r < I_SQ) { p0_transpose_item(w_q, D, D, Wkvq_t, 1024, 0, norm_mix_b, scr, r, lane); continue; } r -= I_SQ;
            p0_transpose_item(w_o, D, D, Wo_t, 0, 0, nullptr, scr, r, lane);
        }
        for (int m = gw; m < MR; m += NGW) {
            const float* src = (m < SEQ) ? x_p + (size_t)m * D : x_s + (size_t)(m - SEQ) * D;
            const f32x4* xr = (const f32x4*)src + lane; f32x4 v[8]; float s = 0.f;
#pragma unroll
            for (int j = 0; j < 8; ++j) { v[j] = __builtin_nontemporal_load(xr + 64 * j); s += (v[j].x * v[j].x + v[j].y * v[j].y) + (v[j].z * v[j].z + v[j].w * v[j].w); }
            s = wave_sum(s);
            if (lane == 0) ss0[m] = s;
            v2u* o8 = (v2u*)(Hb0 + (size_t)m * D) + lane;
#pragma unroll
            for (int j = 0; j < 8; ++j) { v2u w; w.x = pk2(v[j].x, v[j].y); w.y = pk2(v[j].z, v[j].w); o8[64 * j] = w; }
        }
        __syncthreads();
        kmean_items(lds, cache_k, ptab, Kms, 848, DECB * NBLK, 0, G, TIDX);
    }
    xcd_barrier(bar, IS_T0);
    STAMP();

    {
        TIDS;
        pg8::Gemm g{Hb0, Win_t, SEQ, 4 * D, D}; pg8::StaticOrder S; S.init(SEQ, 4 * D, G, bid);
        EpiIn E{ss0, lbl, Qg, Ff};
        pg8::gemm_phase<EpiIn, pg8::StaticOrder, true, true, false>(lds, g, S, E, TIDX);
        for (int it2 = 0; it2 < 2; ++it2) {
            const int w2 = bid + 256 * it2, t2 = w2 & 255, rh = (w2 >> 8) & 1;
            TIDS; f32x4 ta[2]; tail_gemm<2>(lds, Hb0 + (size_t)SEQ * D, Win_t, D, 32 * t2, rh, ta, TIDX);
            if (wave < 4) { const int row = SEQ + 64 * rh + 16 * wave + fr; E.tail(row, 32 * t2 + 4 * fq, ta[0]); E.tail(row, 32 * t2 + 16 + 4 * fq, ta[1]); }
        }
    }
    xcd_barrier(bar, IS_T0);
    STAMP();

    {
        TIDS;
        LAS float* tot = (LAS float*)(lds);
        LAS bf16* koT = (LAS bf16*)(lds + 4096);
        LAS bf16* Vr = (LAS bf16*)(lds + 4096 + 128 * 72 * 2);
        const int col = tid & 127, part = tid >> 7; const int vt_t = tid >> 3, vd0 = (tid & 7) * 16;
        f16 fN[16]; v4u vaN, vbN;
#define P2_LOADN(it_) do { const int h_ = (it_) >> 7, r0_ = ((it_) & 127) * 64; const f16* fp_ = Ff + (size_t)(r0_ + part * 16) * D + h_ * 128 + col; \
            _Pragma("unroll") for (int i = 0; i < 16; ++i) fN[i] = fp_[(size_t)i * D]; \
            const bf16* vp_ = Vg + (size_t)(r0_ + vt_t) * D + h_ * 128 + vd0; vaN = *(const v4u*)vp_; vbN = *(const v4u*)(vp_ + 8); } while (0)
        if (bid < NH * NCHUNK) P2_LOADN(bid);
        for (int item = bid; item < NH * NCHUNK; item += G) {
            float cum[16], kk[16]; float run = 0.f;
#pragma unroll
            for (int i = 0; i < 16; ++i) { const float f = (float)fN[i]; kk[i] = 1.0f - f; run += __logf(f); cum[i] = run; }
            tot[part * 128 + col] = run;
            *(LAS v4u*)(Vr + vt_t * 144 + vd0) = vaN; *(LAS v4u*)(Vr + vt_t * 144 + vd0 + 8) = vbN;
            if (item + G < NH * NCHUNK) P2_LOADN(item + G);
            __syncthreads();
            float offs = 0.f, lastv = 0.f;
#pragma unroll
            for (int p = 0; p < 4; ++p) { const float tv = tot[p * 128 + col]; lastv += tv; if (p < part) offs += tv; }
            unsigned kw[8];
#pragma unroll
            for (int i = 0; i < 8; ++i) { const float a = kk[2 * i] * __expf(lastv - (cum[2 * i] + offs)), b = kk[2 * i + 1] * __expf(lastv - (cum[2 * i + 1] + offs)); kw[i] = pk2(a, b); }
            *(LAS v4u*)(koT + col * 72 + part * 16) = (v4u){kw[0], kw[1], kw[2], kw[3]};
            *(LAS v4u*)(koT + col * 72 + part * 16 + 8) = (v4u){kw[4], kw[5], kw[6], kw[7]};
            if (part == 0) Dec[(size_t)item * 128 + col] = __expf(lastv);
            __syncthreads();
            { bf16x8 a[2]; a[0] = *(const LAS bf16x8*)(koT + (16 * wave + fr) * 72 + 8 * fq); a[1] = *(const LAS bf16x8*)(koT + (16 * wave + fr) * 72 + 32 + 8 * fq);
              bf16* ub = Ub + (size_t)item * 16384;
              const LAS bf16* vb = Vr + (8 * fq + (fr >> 2)) * 144 + 4 * (fr & 3);
#pragma unroll
              for (int vt = 0; vt < 8; ++vt) {
                  f32x4 acc = {0.f, 0.f, 0.f, 0.f};
                  const v2u l0 = tr_read(vb + 16 * vt), h0 = tr_read(vb + 4 * 144 + 16 * vt), l1 = tr_read(vb + 32 * 144 + 16 * vt), h1 = tr_read(vb + 36 * 144 + 16 * vt);
                  const v4u b0 = {l0.x, l0.y, h0.x, h0.y}, b1 = {l1.x, l1.y, h1.x, h1.y};
                  acc = MFMA16(a[0], __builtin_bit_cast(bf16x8, b0), acc); acc = MFMA16(a[1], __builtin_bit_cast(bf16x8, b1), acc);
                  v2u w; w.x = pk2(acc[0], acc[1]); w.y = pk2(acc[2], acc[3]);
                  *(v2u*)(ub + (size_t)(16 * vt + fr) * 128 + 16 * wave + 4 * fq) = w;
              } }
            __syncthreads();
        }
#undef P2_LOADN
        LAS float* red = (LAS float*)(lds);
        LAS float* red2 = (LAS float*)(lds + 8192);
        float* st_out = out + OST_S;
        for (int item = bid; item < DECB * NH; item += G) {
            const int b = item >> 4, h = item & 15; const int vd = tid & 127, kq = tid >> 7;
            const float* sp = st_in + ((size_t)(b * NH + h) * 128 + 32 * kq) * 128 + vd;
            float Sx[32];
#pragma unroll
            for (int i = 0; i < 32; ++i) Sx[i] = __builtin_nontemporal_load(sp + (size_t)i * 128);
#pragma unroll
            for (int t = 0; t < 4; ++t) {
                const int row = SEQ + 4 * b + t; const size_t ro = (size_t)row * D + h * 128;
                const float v = bf2f(Vg[ro + vd]); float op = 0.f;
#pragma unroll
                for (int i = 0; i < 32; ++i) { const float f = (float)Ff[ro + 32 * kq + i]; const float q = bf2f(Qg[ro + 32 * kq + i]); Sx[i] = f * Sx[i] + (1.0f - f) * v; op += Sx[i] * q; }
                red[(t * 4 + kq) * 128 + vd] = op;
            }
            float* so = st_out + ((size_t)(b * NH + h) * 128 + 32 * kq) * 128 + vd;
#pragma unroll
            for (int i = 0; i < 32; ++i) __builtin_nontemporal_store(Sx[i], so + (size_t)i * 128);
            __syncthreads();
            { const int t = tid >> 7; const float o = (red[(t * 4 + 0) * 128 + vd] + red[(t * 4 + 1) * 128 + vd]) + (red[(t * 4 + 2) * 128 + vd] + red[(t * 4 + 3) * 128 + vd]);
              const float s = wave_sum(o * o); if (lane == 0) red2[t * 2 + (wave & 1)] = s;
              __syncthreads();
              const float r = rsqrtf((red2[t * 2] + red2[t * 2 + 1]) * (1.0f / 128.0f) + EPS);
              const int row = SEQ + 4 * b + t; const size_t ro = (size_t)row * D + h * 128 + vd;
              Ob[ro] = (bf16)f2bf(o * r * onorm[vd] * bf2f(Gg[ro])); }
            __syncthreads();
        }
    }
    xcd_barrier(bar, IS_T0);
    STAMP();

    {
        TIDS;
        for (int gid = bid * NTHR + tid; gid < NH * 128 * 32; gid += G * NTHR) {
            const int h = gid >> 12, rem = gid & 4095, vd = rem >> 5, k = (rem & 31) * 4;
            float s0 = 0.f, s1 = 0.f, s2 = 0.f, s3 = 0.f;
            const v2u* up = (const v2u*)(Ub + ((size_t)h * 128 * 128 + vd) * 128 + k);
            v2u* sp = (v2u*)(Sst + ((size_t)h * 128 * 128 + vd) * 128 + k);
            const f32x4* dp = (const f32x4*)(Dec + (size_t)h * 128 * 128 + k);
#pragma unroll 16
            for (int c = 0; c < NCHUNK; ++c) {
                const v2u u = up[(size_t)c * 4096]; const f32x4 d = dp[(size_t)c * 32];
                v2u w; w.x = pk2(s0, s1); w.y = pk2(s2, s3); sp[(size_t)c * 4096] = w;
                s0 = d.x * s0 + bf2f(u.x & 0xffffu); s1 = d.y * s1 + bf2f(u.x >> 16); s2 = d.z * s2 + bf2f(u.y & 0xffffu); s3 = d.w * s3 + bf2f(u.y >> 16);
            }
            float* so = out + OST_P + ((size_t)h * 128 + k) * 128 + vd;
            so[0] = s0; so[128] = s1; so[256] = s2; so[384] = s3;
        }
    }
    xcd_barrier(bar, IS_T0);
    STAMP();

    {
        TIDS;
        LAS float* tot = (LAS float*)(lds);
        LAS float* refs = (LAS float*)(lds + 2048);
        LAS float* red = (LAS float*)(lds + 2560);
        LAS bf16* QE = (LAS bf16*)(lds + 4096);
        LAS bf16* KE = QE + 64 * 136;
        LAS bf16* QI = KE + 64 * 136;
        LAS bf16* Vr = QI + 64 * 136;
        LAS bf16* STs = Vr + 64 * 144;
        const int col = tid & 127, part = tid >> 7; const int vt_t = tid >> 3, vd0 = (tid & 7) * 16;
        const int tt = wave & 3, vh = wave >> 2;
        f16 fN[16]; bf16 qN[16]; v4u vaN, vbN, stN[4];
#define P4_LOADN(it_) do { const int h_ = (it_) >> 7, r0_ = ((it_) & 127) * 64; const f16* fp_ = Ff + (size_t)(r0_ + part * 16) * D + h_ * 128 + col; const bf16* qp_ = Qg + (size_t)(r0_ + part * 16) * D + h_ * 128 + col; \
            _Pragma("unroll") for (int i = 0; i < 16; ++i) { fN[i] = fp_[(size_t)i * D]; qN[i] = qp_[(size_t)i * D]; } \
            const bf16* vp_ = Vg + (size_t)(r0_ + vt_t) * D + h_ * 128 + vd0; vaN = *(const v4u*)vp_; vbN = *(const v4u*)(vp_ + 8); \
            const v4u* sp_ = (const v4u*)(Sst + (size_t)(it_) * 16384); _Pragma("unroll") for (int i = 0; i < 4; ++i) stN[i] = sp_[i * 512 + tid]; } while (0)
        if (bid < NH * NCHUNK) P4_LOADN(bid);
        for (int item = bid; item < NH * NCHUNK; item += G) {
            const int h = item >> 7, c = item & 127; const int row0 = c * 64;
            float cum[16], kk[16], qv[16]; float run = 0.f;
#pragma unroll
            for (int i = 0; i < 16; ++i) { const float f = (float)fN[i]; kk[i] = 1.0f - f; run += __logf(f); cum[i] = run; qv[i] = bf2f(qN[i]); }
            tot[part * 128 + col] = run;
            *(LAS v4u*)(Vr + vt_t * 144 + vd0) = vaN; *(LAS v4u*)(Vr + vt_t * 144 + vd0 + 8) = vbN;
#pragma unroll
            for (int i = 0; i < 4; ++i) { const int idx = i * 512 + tid, vd = idx >> 4, k8 = idx & 15; *(LAS v4u*)(STs + vd * 136 + k8 * 8) = stN[i]; }
            const size_t ro = (size_t)(row0 + 16 * tt + fr) * D + h * 128;
            v2u gw2[4]; f32x4 on[4];
#pragma unroll
            for (int vt = 0; vt < 4; ++vt) { const int vd = 16 * (4 * vh + vt) + 4 * fq; gw2[vt] = *(const v2u*)(Gg + ro + vd); on[vt] = *(const f32x4*)(onorm + vd); }
            if (item + G < NH * NCHUNK) P4_LOADN(item + G);
            __syncthreads();
            float offs = 0.f;
#pragma unroll
            for (int p = 0; p < 4; ++p) { const float tv = tot[p * 128 + col]; if (p < part) offs += tv; }
            if (part == 1) refs[col] = cum[15] + offs;
            __syncthreads();
            const float ref = refs[col];
#pragma unroll
            for (int i = 0; i < 16; ++i) { const float cm = cum[i] + offs, d1 = cm - ref; const int t = part * 16 + i;
                QE[t * 136 + col] = (bf16)f2bf(qv[i] * __expf(d1)); KE[t * 136 + col] = (bf16)f2bf(kk[i] * __expf(-d1)); QI[t * 136 + col] = (bf16)f2bf(qv[i] * __expf(cm)); }
            __syncthreads();
            {
                f32x4 aS[4];
#pragma unroll
                for (int st = 0; st < 4; ++st) {
                    aS[st] = (f32x4){0.f, 0.f, 0.f, 0.f};
                    if (st <= tt) {
#pragma unroll
                        for (int ks = 0; ks < 4; ++ks) { const bf16x8 a = *(const LAS bf16x8*)(KE + (16 * st + fr) * 136 + 32 * ks + 8 * fq), b = *(const LAS bf16x8*)(QE + (16 * tt + fr) * 136 + 32 * ks + 8 * fq); aS[st] = MFMA16(a, b, aS[st]); }
                        if (st == tt) {
#pragma unroll
                            for (int r = 0; r < 4; ++r) if (4 * fq + r > fr) aS[st][r] = 0.f;
                        }
                    }
                }
                f32x4 o[4];
#pragma unroll
                for (int vt = 0; vt < 4; ++vt) o[vt] = (f32x4){0.f, 0.f, 0.f, 0.f};
#pragma unroll
                for (int j = 0; j < 2; ++j) {
                    v4u pw; pw.x = cvt_pk_bf16(aS[2 * j][0], aS[2 * j][1]); pw.y = cvt_pk_bf16(aS[2 * j][2], aS[2 * j][3]); pw.z = cvt_pk_bf16(aS[2 * j + 1][0], aS[2 * j + 1][1]); pw.w = cvt_pk_bf16(aS[2 * j + 1][2], aS[2 * j + 1][3]);
                    const bf16x8 pf = __builtin_bit_cast(bf16x8, pw);
                    const LAS bf16* vb = Vr + (32 * j + 4 * fq + (fr >> 2)) * 144 + 64 * vh + 4 * (fr & 3);
#pragma unroll
                    for (int vt = 0; vt < 4; ++vt) { const v2u lo = tr_read(vb + 16 * vt), hi = tr_read(vb + 16 * 144 + 16 * vt); const v4u aw = {lo.x, lo.y, hi.x, hi.y};
                        o[vt] = MFMA16(__builtin_bit_cast(bf16x8, aw), pf, o[vt]); }
                }
#pragma unroll
                for (int ks = 0; ks < 4; ++ks) { const bf16x8 b = *(const LAS bf16x8*)(QI + (16 * tt + fr) * 136 + 32 * ks + 8 * fq);
#pragma unroll
                    for (int vt = 0; vt < 4; ++vt) { const bf16x8 a = *(const LAS bf16x8*)(STs + (16 * (4 * vh + vt) + fr) * 136 + 32 * ks + 8 * fq); o[vt] = MFMA16(a, b, o[vt]); } }
                float sq = 0.f;
#pragma unroll
                for (int vt = 0; vt < 4; ++vt) sq += (o[vt][0] * o[vt][0] + o[vt][1] * o[vt][1]) + (o[vt][2] * o[vt][2] + o[vt][3] * o[vt][3]);
                sq += shx<16>(sq); sq = xadd32(sq);
                if (fq == 0) red[(16 * tt + fr) * 2 + vh] = sq;
                __syncthreads();
                const float r = rsqrtf((red[(16 * tt + fr) * 2] + red[(16 * tt + fr) * 2 + 1]) * (1.0f / 128.0f) + EPS);
#pragma unroll
                for (int vt = 0; vt < 4; ++vt) { const int vd = 16 * (4 * vh + vt) + 4 * fq;
                    const float g0 = bf2f(gw2[vt].x & 0xffffu), g1 = bf2f(gw2[vt].x >> 16), g2 = bf2f(gw2[vt].y & 0xffffu), g3 = bf2f(gw2[vt].y >> 16);
                    v2u w; w.x = cvt_pk_bf16(o[vt][0] * r * on[vt][0] * g0, o[vt][1] * r * on[vt][1] * g1); w.y = cvt_pk_bf16(o[vt][2] * r * on[vt][2] * g2, o[vt][3] * r * on[vt][3] * g3);
                    *(v2u*)(Ob + ro + vd) = w; }
            }
            __syncthreads();
        }
#undef P4_LOADN
    }
    xcd_barrier(bar, IS_T0);
    STAMP();

    {
        TIDS;
        pg8::Gemm g{Ob, Wout_t, SEQ, D, D}; pg8::StaticOrder S; S.init(SEQ, D, G, bid);
        EpiRes<1> E{Hb0, nullptr, nullptr, Hb1, ss1};
        const unsigned tg0 = TNOW();
        pg8::gemm_phase<EpiRes<1>, pg8::StaticOrder, true, true, false>(lds, g, S, E, TIDX);
        TACC(5, tg0); const unsigned tg1 = TNOW();
        { const int t2 = bid & 127, rh = (bid >> 7) & 1; TIDS; f32x4 ta[1]; tail_gemm<1>(lds, Ob + (size_t)SEQ * D, Wout_t, D, 16 * t2, rh, ta, TIDX); if (wave < 4) E.tail(SEQ + 64 * rh + 16 * wave + fr, 16 * t2 + 4 * fq, ta[0], fq); }
        TACC(6, tg1);
    }
    xcd_barrier(bar, IS_T0);
    STAMP();
    {
        TIDS;
        pg8::Gemm g{Hb1, Wgu0_t, MP, NGU, D}; pg8::StaticOrder S; S.init(MP, NGU, G, bid);
        EpiGU E{ss1, Hm};
        pg8::gemm_phase<EpiGU, pg8::StaticOrder, true, true>(lds, g, S, E, TIDX);
        kmean_items(lds, cache_k, ptab, Kms, 0, 336, 172, G - 172, TIDX);
    }
    xcd_barrier(bar, IS_T0);
    STAMP();
    {
        TIDS;
        pg8::Gemm g{Hm, Wdn0_t, SEQ, D, DFF}; pg8::StaticOrder S; S.init(SEQ, D, G, bid);
        EpiRes<1> E{Hb1, nullptr, nullptr, Hb2, ss2};
        const unsigned tg0 = TNOW();
        pg8::gemm_phase<EpiRes<1>, pg8::StaticOrder, true, true, false>(lds, g, S, E, TIDX);
        TACC(7, tg0); const unsigned tg1 = TNOW();
        { const int t2 = bid & 127, rh = (bid >> 7) & 1; TIDS; f32x4 ta[1]; tail_gemm<1>(lds, Hm + (size_t)SEQ * DFF, Wdn0_t, DFF, 16 * t2, rh, ta, TIDX); if (wave < 4) E.tail(SEQ + 64 * rh + 16 * wave + fr, 16 * t2 + 4 * fq, ta[0], fq); }
        TACC(8, tg1);
    }
    xcd_barrier(bar, IS_T0);
    STAMP();
    {
        TIDS;
        pg8::Gemm g{Hb2, Wkvq_t, MP, 3072, D}; pg8::StaticOrder S; S.init(MP, 3072, G, bid);
        EpiKVQ E{ss2, ws};
        pg8::gemm_phase<EpiKVQ, pg8::StaticOrder, true, true>(lds, g, S, E, TIDX);
        kmean_items(lds, cache_k, ptab, Kms, 336, 848, 140, G - 140, TIDX);
    }
    xcd_barrier(bar, IS_T0);
    STAMP();

    {
        TIDS;
        LAS float* partk = (LAS float*)(lds);
        for (int grp = bid; grp < MR / 32; grp += G) {
            const int r0 = grp * 32; float cs[8];
#pragma unroll
            for (int j = 0; j < 8; ++j) cs[j] = 0.f;
#pragma unroll
            for (int i = 0; i < 4; ++i) {
                const int row = r0 + 4 * wave + i; const int c = lane * 8;
                const f32x4 k0 = *(const f32x4*)(Kraw + (size_t)row * 512 + c), k1 = *(const f32x4*)(Kraw + (size_t)row * 512 + c + 4);
                float sq = (k0[0] * k0[0] + k0[1] * k0[1]) + (k0[2] * k0[2] + k0[3] * k0[3]) + (k1[0] * k1[0] + k1[1] * k1[1]) + (k1[2] * k1[2] + k1[3] * k1[3]);
                sq += shx<1>(sq); sq += shx<2>(sq); sq += shx<4>(sq); sq += shx<8>(sq);
                const float rk = rsqrtf(sq * (1.0f / 128.0f) + EPS);
                const f32x4 g0 = *(const f32x4*)(k_norm + (c & 127)), g1 = *(const f32x4*)(k_norm + (c & 127) + 4);
                const f32x4 n0 = k0 * rk * g0, n1 = k1 * rk * g1;
                float* ko = (row < SEQ) ? out + OK_P + (size_t)row * 512 + c : out + OK_S + (size_t)(row - SEQ) * 512 + c;
                __builtin_nontemporal_store(n0, (f32x4*)ko); __builtin_nontemporal_store(n1, (f32x4*)(ko + 4));
                v4u w; w.x = cvt_pk_bf16(n0[0], n0[1]); w.y = cvt_pk_bf16(n0[2], n0[3]); w.z = cvt_pk_bf16(n1[0], n1[1]); w.w = cvt_pk_bf16(n1[2], n1[3]);
                *(v4u*)(Kb + (size_t)row * 512 + c) = w;
#pragma unroll
                for (int j = 0; j < 4; ++j) { cs[j] += n0[j]; cs[4 + j] += n1[j]; }
                const f32x4 v0 = *(const f32x4*)(Vraw + (size_t)row * 512 + c), v1 = *(const f32x4*)(Vraw + (size_t)row * 512 + c + 4);
                float* vo = (row < SEQ) ? out + OV_P + (size_t)row * 512 + c : out + OV_S + (size_t)(row - SEQ) * 512 + c;
                __builtin_nontemporal_store(v0, (f32x4*)vo); __builtin_nontemporal_store(v1, (f32x4*)(vo + 4));
                v4u wv; wv.x = cvt_pk_bf16(v0[0], v0[1]); wv.y = cvt_pk_bf16(v0[2], v0[3]); wv.z = cvt_pk_bf16(v1[0], v1[1]); wv.w = cvt_pk_bf16(v1[2], v1[3]);
                *(v4u*)(Vb + (size_t)row * 512 + c) = wv;
            }
#pragma unroll
            for (int j = 0; j < 8; ++j) partk[wave * 512 + lane * 8 + j] = cs[j];
            __syncthreads();
            if (r0 < SEQ) {
                float s = 0.f;
#pragma unroll
                for (int w8 = 0; w8 < 8; ++w8) s += partk[w8 * 512 + tid];
                Kpart[(size_t)grp * 512 + tid] = s;
            }
            __syncthreads();
        }
        for (int row = bid * NWAVES + wave; row < MR; row += G * NWAVES) {
#pragma unroll
            for (int j = 0; j < 4; ++j) {
                const int c = j * 512 + lane * 8;
                const v4u qw_ = *(const v4u*)(Qraw + (size_t)row * D + c); const f32x4 q0 = {bf2f(qw_.x & 0xffffu), bf2f(qw_.x >> 16), bf2f(qw_.y & 0xffffu), bf2f(qw_.y >> 16)}, q1 = {bf2f(qw_.z & 0xffffu), bf2f(qw_.z >> 16), bf2f(qw_.w & 0xffffu), bf2f(qw_.w >> 16)};
                float sq = (q0[0] * q0[0] + q0[1] * q0[1]) + (q0[2] * q0[2] + q0[3] * q0[3]) + (q1[0] * q1[0] + q1[1] * q1[1]) + (q1[2] * q1[2] + q1[3] * q1[3]);
                sq += shx<1>(sq); sq += shx<2>(sq); sq += shx<4>(sq); sq += shx<8>(sq);
                const float rq = rsqrtf(sq * (1.0f / 128.0f) + EPS) * C2;
                const f32x4 g0 = *(const f32x4*)(q_norm + (c & 127)), g1 = *(const f32x4*)(q_norm + (c & 127) + 4);
                const f32x4 n0 = q0 * rq * g0, n1 = q1 * rq * g1;
                v4u w; w.x = cvt_pk_bf16(n0[0], n0[1]); w.y = cvt_pk_bf16(n0[2], n0[3]); w.z = cvt_pk_bf16(n1[0], n1[1]); w.w = cvt_pk_bf16(n1[2], n1[3]);
                *(v4u*)(Qb + (size_t)row * D + c) = w;
            }
        }
    }
    xcd_barrier(bar, IS_T0);
    STAMP();

    {
        TIDS;
        LAS bf16* KMb = (LAS bf16*)(lds);
        LAS unsigned* lcnt = (LAS unsigned*)(lds + 16384);
        LAS float* gs = (LAS float*)(lds + 16384 + 256);
#define G_BETTER(va, ia, vb, ib) (((va) > (vb)) || (((va) == (vb)) && ((ia) < (ib))))
#define G_INSERT(vx, ix) do { const float vx_ = (vx); const int ix_ = (ix); \
            if (G_BETTER(vx_, ix_, v0, i0)) { v2 = v1; i2 = i1; v1 = v0; i1 = i0; v0 = vx_; i0 = ix_; } \
            else if (G_BETTER(vx_, ix_, v1, i1)) { v2 = v1; i2 = i1; v1 = vx_; i1 = ix_; } \
            else if (G_BETTER(vx_, ix_, v2, i2)) { v2 = vx_; i2 = ix_; } } while (0)
        for (int item = bid; item < 256; item += G) {
            const int j = item >> 2, kvh = item & 3; const int b = j >> 1;
            { const int n = tid >> 4, d8 = (tid & 15) * 8; f32x4 s0 = {0.f, 0.f, 0.f, 0.f}, s1 = {0.f, 0.f, 0.f, 0.f};
              if (n < b) {
#pragma unroll
                  for (int sub = 0; sub < 8; ++sub) { const float* kp = Kpart + (size_t)(n * 8 + sub) * 512 + kvh * 128 + d8; s0 += *(const f32x4*)kp; s1 += *(const f32x4*)(kp + 4); } }
              s0 = s0 * (1.0f / 256.0f); s1 = s1 * (1.0f / 256.0f);
              v4u w; w.x = cvt_pk_bf16(s0[0], s0[1]); w.y = cvt_pk_bf16(s0[2], s0[3]); w.z = cvt_pk_bf16(s1[0], s1[1]); w.w = cvt_pk_bf16(s1[2], s1[3]);
              *(LAS v4u*)(KMb + n * 136 + d8) = w; }
            if (tid < 32) lcnt[tid] = 0u;
            __syncthreads();
            const int nsel = b < 3 ? b : 3;
#pragma unroll 1
            for (int rt = 0; rt < 4; ++rt) {
                const int r = 64 * wave + 16 * rt + fr; const int tok = j * 128 + (r >> 2), hg = r & 3; const bf16* qp = Qb + (size_t)tok * D + (4 * kvh + hg) * 128 + 8 * fq;
                bf16x8 qf[4];
#pragma unroll
                for (int ks = 0; ks < 4; ++ks) qf[ks] = *(const bf16x8*)(qp + 32 * ks);
                f32x4 ga[2];
#pragma unroll
                for (int nt = 0; nt < 2; ++nt) { ga[nt] = (f32x4){0.f, 0.f, 0.f, 0.f};
#pragma unroll
                    for (int ks = 0; ks < 4; ++ks) { const bf16x8 ka = *(const LAS bf16x8*)(KMb + (16 * nt + fr) * 136 + 32 * ks + 8 * fq); ga[nt] = MFMA16(ka, qf[ks], ga[nt]); } }
                float v0 = -INFINITY, v1 = -INFINITY, v2 = -INFINITY; int i0 = 99, i1 = 99, i2 = 99;
#pragma unroll
                for (int nt = 0; nt < 2; ++nt)
#pragma unroll
                    for (int q = 0; q < 4; ++q) { const int n = 16 * nt + 4 * fq + q; if (n < b) G_INSERT(ga[nt][q], n); }
                { const float a0 = shx<16>(v0), a1 = shx<16>(v1), a2 = shx<16>(v2);
                  const int c0 = __builtin_amdgcn_ds_swizzle(i0, (16 << 10) | 0x1f), c1 = __builtin_amdgcn_ds_swizzle(i1, (16 << 10) | 0x1f), c2 = __builtin_amdgcn_ds_swizzle(i2, (16 << 10) | 0x1f);
                  G_INSERT(a0, c0); G_INSERT(a1, c1); G_INSERT(a2, c2); }
                {
                  auto p0 = __builtin_amdgcn_permlane32_swap(__float_as_uint(v0), __float_as_uint(v0), false, false); auto p1 = __builtin_amdgcn_permlane32_swap(__float_as_uint(v1), __float_as_uint(v1), false, false);
                  auto p2 = __builtin_amdgcn_permlane32_swap(__float_as_uint(v2), __float_as_uint(v2), false, false);
                  auto q0 = __builtin_amdgcn_permlane32_swap((unsigned)i0, (unsigned)i0, false, false); auto q1 = __builtin_amdgcn_permlane32_swap((unsigned)i1, (unsigned)i1, false, false);
                  auto q2 = __builtin_amdgcn_permlane32_swap((unsigned)i2, (unsigned)i2, false, false);
                  v0 = __uint_as_float(p0[0]); v1 = __uint_as_float(p1[0]); v2 = __uint_as_float(p2[0]); i0 = (int)q0[0]; i1 = (int)q1[0]; i2 = (int)q2[0];
                  G_INSERT(__uint_as_float(p0[1]), (int)q0[1]); G_INSERT(__uint_as_float(p1[1]), (int)q1[1]); G_INSERT(__uint_as_float(p2[1]), (int)q2[1]); }
                if (fq == 0) {
#pragma unroll
                    for (int rk = 0; rk < 3; ++rk) {
                        if (rk < nsel) { const int best = (rk == 0) ? i0 : ((rk == 1) ? i1 : i2);
                            const unsigned pos = atomicAdd((unsigned*)&lcnt[best], 1u);
                            Subl[((size_t)(j * 4 + kvh) * 32 + best) * 512 + pos] = (unsigned)r | ((unsigned)rk << 9); }
                    }
                }
            }
            __syncthreads();
            if (tid < 32) Scnt[(j * 4 + kvh) * 32 + tid] = lcnt[tid];
            __syncthreads();
        }
#undef G_BETTER
#undef G_INSERT
        for (int item = bid; item < DECB * NKV; item += G) {
            const int b = item >> 2, kvh = item & 3; const int pr = tid >> 5, n = tid & 31;
            const int row = SEQ + 4 * b + (pr >> 2), hg = pr & 3; const bf16* qp = Qb + (size_t)row * D + (4 * kvh + hg) * 128; const float* kmp = Kms + ((size_t)(b * 32 + n)) * 512 + kvh * 128;
            float s = 0.f;
#pragma unroll 4
            for (int d = 0; d < 128; d += 8) { const v4u qw = *(const v4u*)(qp + d); const f32x4 k0 = *(const f32x4*)(kmp + d), k1 = *(const f32x4*)(kmp + d + 4);
                s += (bf2f(qw.x & 0xffffu) * k0[0] + bf2f(qw.x >> 16) * k0[1]) + (bf2f(qw.y & 0xffffu) * k0[2] + bf2f(qw.y >> 16) * k0[3]) + (bf2f(qw.z & 0xffffu) * k1[0] + bf2f(qw.z >> 16) * k1[1]) + (bf2f(qw.w & 0xffffu) * k1[2] + bf2f(qw.w >> 16) * k1[3]); }
            gs[pr * 32 + n] = s;
            __syncthreads();
            if (tid < 16) { unsigned m = 0u;
                for (int r = 0; r < 3; ++r) { int best = 0; float bv = -INFINITY; for (int nn = 0; nn < 32; ++nn) { const float v = gs[tid * 32 + nn]; if (v > bv) { bv = v; best = nn; } } m |= 1u << best; gs[tid * 32 + best] = -INFINITY; }
                Sels[item * 16 + tid] = m; }
            __syncthreads();
        }
    }
    xcd_barrier(bar, IS_T0);
    STAMP();

    {
        LAS bf16* Ks = (LAS bf16*)(lds); LAS bf16* Vs = (LAS bf16*)(lds + KS_BYTES);
        LAS unsigned* qsh = (LAS unsigned*)(lds + 2 * KS_BYTES);
        constexpr int NPI = 4 * 496, NSI = DECB * NKV * NBLK;
        for (;;) {
            const unsigned tq0 = TNOW();
            if (IS_T0) qsh[0] = __hip_atomic_fetch_add(ctl + CW_Q0, 1u, __ATOMIC_RELAXED, __HIP_MEMORY_SCOPE_AGENT);
            __syncthreads();
            const int tick = (int)qsh[0];
            __syncthreads();
            TACC(0, tq0);
            if (tick >= NPI + NSI) break;
            TIDS;
            int item; { const int g3 = tick / 3, r3 = tick - 3 * g3; item = (tick < 3 * NPI) ? ((r3 == 0) ? g3 : NPI + 2 * g3 + (r3 - 1)) : NPI + (tick - NPI); }
            if (item < NPI) {
                int b = (int)((1.0f + sqrtf(1.0f + 2.0f * (float)item)) * 0.5f); while (2 * b * (b - 1) > item) --b; while (2 * (b + 1) * b <= item) ++b;
                const int rem = item - 2 * b * (b - 1); const int n = rem >> 2, kvh = rem & 3;
                const int cntA = (int)Scnt[((2 * b) * 4 + kvh) * 32 + n], cntB = (int)Scnt[((2 * b + 1) * 4 + kvh) * 32 + n]; const int total = cntA + cntB;
                if (total == 0) continue;
                const unsigned tp0 = TNOW();
#pragma unroll
                for (int i = 0; i < 8; ++i) { const int idx = i * 512 + tid, key = idx >> 4, c8 = idx & 15; *(LAS v4u*)(Ks + key * KS_P + c8 * 8) = *(const v4u*)(Kb + (size_t)(256 * n + key) * 512 + kvh * 128 + c8 * 8); }
#pragma unroll
                for (int i = 0; i < 8; ++i) { const int idx = i * 512 + tid, key = idx >> 4, c8 = idx & 15; *(LAS v4u*)(Vs + key * KS_P + c8 * 8) = *(const v4u*)(Vb + (size_t)(256 * n + key) * 512 + kvh * 128 + c8 * 8); }
                __syncthreads();
                TACC(1, tp0); const unsigned tp1 = TNOW();
                const unsigned* LA = Subl + ((size_t)((2 * b) * 4 + kvh) * 32 + n) * 512; const unsigned* LB = Subl + ((size_t)((2 * b + 1) * 4 + kvh) * 32 + n) * 512;
#define LIST_ENT(i_) (((i_) < cntA) ? LA[(i_)] : LB[(i_) - cntA])
                const int iw = 16 * wave + fr;
                unsigned e1 = 0u, e2 = 0u; int ic1 = 0, ic2 = 0;
                if (16 * wave < total) { ic1 = iw < total ? iw : total - 1; e1 = LIST_ENT(ic1); }
                if (16 * wave + 128 < total) { ic2 = iw + 128 < total ? iw + 128 : total - 1; e2 = LIST_ENT(ic2); }
                bf16x8 qn[4];
                { const int tokn = ((ic1 < cntA) ? 2 * b : 2 * b + 1) * 128 + (int)((e1 >> 2) & 127u); const bf16* qp = Qb + (size_t)tokn * D + (4 * kvh + (int)(e1 & 3u)) * 128 + 8 * fq;
#pragma unroll
                  for (int ks = 0; ks < 4; ++ks) qn[ks] = *(const bf16x8*)(qp + 32 * ks); }
                for (int t0 = 0; t0 < total; t0 += 128) {
                    const int i0 = t0 + 16 * wave; if (i0 >= total) break;
                    const bool valid = (i0 + fr) < total; const int ic = ic1; const unsigned e = e1;
                    const int tok = ((ic < cntA) ? 2 * b : 2 * b + 1) * 128 + (int)((e >> 2) & 127u), hg = (int)(e & 3u), rk = (int)(e >> 9);
                    const int h = 4 * kvh + hg;
                    bf16x8 qf[4];
#pragma unroll
                    for (int ks = 0; ks < 4; ++ks) qf[ks] = qn[ks];
                    e1 = e2; ic1 = ic2;
                    if (i0 + 256 < total) { ic2 = (i0 + 256 + fr) < total ? (i0 + 256 + fr) : total - 1; e2 = LIST_ENT(ic2); }
                    if (i0 + 128 < total) { const int tokn = ((ic1 < cntA) ? 2 * b : 2 * b + 1) * 128 + (int)((e1 >> 2) & 127u); const bf16* qp = Qb + (size_t)tokn * D + (4 * kvh + (int)(e1 & 3u)) * 128 + 8 * fq;
#pragma unroll
                        for (int ks = 0; ks < 4; ++ks) qn[ks] = *(const bf16x8*)(qp + 32 * ks); }
                    f32x4 acc[16]; attn_scores<16>(Ks, qf, acc, 16, fr, fq);
                    float mx = -INFINITY;
#pragma unroll
                    for (int kt = 0; kt < 16; ++kt) mx = fmaxf(fmaxf(mx, fmaxf(acc[kt][0], acc[kt][1])), fmaxf(acc[kt][2], acc[kt][3]));
                    mx = fmaxf(mx, shx<16>(mx)); mx = xmax32(mx);
                    float l = 0.f;
#pragma unroll
                    for (int kt = 0; kt < 16; ++kt) {
#pragma unroll
                        for (int r = 0; r < 4; ++r) { const float p = __builtin_amdgcn_exp2f(acc[kt][r] - mx); acc[kt][r] = p; l += p; } }
                    l += shx<16>(l); l = xadd32(l);
                    f32x4 O[8];
#pragma unroll
                    for (int vt = 0; vt < 8; ++vt) O[vt] = (f32x4){0.f, 0.f, 0.f, 0.f};
                    attn_pv(Vs, acc, O, 8, fr, fq);
                    if (valid) {
                        const size_t slot = ((size_t)tok * NH + h) * 3 + rk; bf16* op = Oslot + slot * 128 + 4 * fq;
#pragma unroll
                        for (int vt = 0; vt < 8; ++vt) { v2u w; w.x = cvt_pk_bf16(O[vt][0], O[vt][1]); w.y = cvt_pk_bf16(O[vt][2], O[vt][3]); *(v2u*)(op + 16 * vt) = w; }
                        if (fq == 0) { MLslot[slot * 2] = mx; MLslot[slot * 2 + 1] = l; }
                    }
                }
                __syncthreads();
                TACC(2, tp1);
            } else {
                const int si = item - NPI; const int b = si >> 7, kvh = (si >> 5) & 3, n = si & 31;
                unsigned any = 0u;
#pragma unroll
                for (int p = 0; p < 16; ++p) any |= Sels[(b * 4 + kvh) * 16 + p];
                if (!((any >> n) & 1u)) continue;
                const unsigned ts0 = TNOW();
                const int pg0 = ptab[b * NPAGES + 2 * n], pg1 = ptab[b * NPAGES + 2 * n + 1];
                f32x4 kst[16], vst[16];
#pragma unroll
                for (int i = 0; i < 16; ++i) { const int idx = i * 512 + tid, key = idx >> 5, c4 = idx & 31; const int page = (key < 128) ? pg0 : pg1;
                    const size_t go = (((size_t)page * PAGE + (key & 127)) * NKV + kvh) * 128 + c4 * 4;
                    kst[i] = __builtin_nontemporal_load((const f32x4*)(cache_k + go)); vst[i] = __builtin_nontemporal_load((const f32x4*)(cache_v + go)); }
#pragma unroll
                for (int i = 0; i < 16; ++i) { const int idx = i * 512 + tid, key = idx >> 5, c4 = idx & 31; const int page = (key < 128) ? pg0 : pg1; (void)page;
                    const f32x4 kk4 = kst[i], vv4 = vst[i];
                    v2u w; w.x = cvt_pk_bf16(kk4[0], kk4[1]); w.y = cvt_pk_bf16(kk4[2], kk4[3]); *(LAS v2u*)(Ks + key * KS_P + c4 * 4) = w;
                    v2u wv; wv.x = cvt_pk_bf16(vv4[0], vv4[1]); wv.y = cvt_pk_bf16(vv4[2], vv4[3]); *(LAS v2u*)(Vs + key * KS_P + c4 * 4) = wv; }
                __syncthreads();
                TACC(3, ts0); const unsigned ts1 = TNOW();
                {
                    LAS float* mxs = (LAS float*)(lds + 2 * KS_BYTES + 64); LAS float* lss = mxs + 128; LAS float* Ored = (LAS float*)(lds);
                    const int row = SEQ + 4 * b + (fr >> 2), hg = fr & 3; const int h = 4 * kvh + hg; const bf16* qp = Qb + (size_t)row * D + h * 128 + 8 * fq;
                    bf16x8 qf[4];
#pragma unroll
                    for (int ks = 0; ks < 4; ++ks) qf[ks] = *(const bf16x8*)(qp + 32 * ks);
                    f32x4 a2[2];
#pragma unroll
                    for (int t = 0; t < 2; ++t) { a2[t] = (f32x4){0.f, 0.f, 0.f, 0.f};
#pragma unroll
                        for (int ks = 0; ks < 4; ++ks) { const bf16x8 ka = *(const LAS bf16x8*)(Ks + (16 * (2 * wave + t) + fr) * KS_P + 32 * ks + 8 * fq); a2[t] = MFMA16(ka, qf[ks], a2[t]); } }
                    float mx = fmaxf(fmaxf(fmaxf(a2[0][0], a2[0][1]), fmaxf(a2[0][2], a2[0][3])), fmaxf(fmaxf(a2[1][0], a2[1][1]), fmaxf(a2[1][2], a2[1][3])));
                    mx = fmaxf(mx, shx<16>(mx)); mx = xmax32(mx);
                    if (fq == 0) mxs[wave * 16 + fr] = mx;
                    __syncthreads();
                    float M = mxs[fr];
#pragma unroll
                    for (int w8 = 1; w8 < 8; ++w8) M = fmaxf(M, mxs[w8 * 16 + fr]);
                    float l = 0.f;
#pragma unroll
                    for (int t = 0; t < 2; ++t) {
#pragma unroll
                        for (int r = 0; r < 4; ++r) { const float p = __builtin_amdgcn_exp2f(a2[t][r] - M); a2[t][r] = p; l += p; } }
                    l += shx<16>(l); l = xadd32(l);
                    if (fq == 0) lss[wave * 16 + fr] = l;
                    v4u pw; pw.x = cvt_pk_bf16(a2[0][0], a2[0][1]); pw.y = cvt_pk_bf16(a2[0][2], a2[0][3]); pw.z = cvt_pk_bf16(a2[1][0], a2[1][1]); pw.w = cvt_pk_bf16(a2[1][2], a2[1][3]);
                    const bf16x8 pf = __builtin_bit_cast(bf16x8, pw);
                    const LAS bf16* vb = Vs + (32 * wave + 4 * fq + (fr >> 2)) * KS_P + 4 * (fr & 3);
#pragma unroll
                    for (int vt = 0; vt < 8; ++vt) { const v2u lo = tr_read(vb + 16 * vt), hi = tr_read(vb + 16 * KS_P + 16 * vt); const v4u aw = {lo.x, lo.y, hi.x, hi.y};
                        const f32x4 o = MFMA16(__builtin_bit_cast(bf16x8, aw), pf, ((f32x4){0.f, 0.f, 0.f, 0.f}));
                        *(LAS f32x4*)(Ored + (wave * 16 + fr) * 132 + 16 * vt + 4 * fq) = o; }
                    __syncthreads();
                    { const int r16 = tid >> 5, c4 = tid & 31; f32x4 so = *(const LAS f32x4*)(Ored + r16 * 132 + 4 * c4);
#pragma unroll
                      for (int w8 = 1; w8 < 8; ++w8) so += *(const LAS f32x4*)(Ored + (w8 * 16 + r16) * 132 + 4 * c4);
                      float* sp = Sslot + ((size_t)((b * 4 + kvh) * 32 + n) * 16 + r16) * 132;
                      *(f32x4*)(sp + 4 * c4) = so;
                      if (c4 == 0) { float Mr = mxs[r16], lt = lss[r16];
#pragma unroll
                          for (int w8 = 1; w8 < 8; ++w8) { Mr = fmaxf(Mr, mxs[w8 * 16 + r16]); lt += lss[w8 * 16 + r16]; }
                          sp[128] = Mr; sp[129] = lt; } }
                }
                __syncthreads();
                TACC(4, ts1);
            }
        }
    }
    xcd_barrier(bar, IS_T0);
    STAMP();

    {
        TIDS;
        LAS bf16* Ks = (LAS bf16*)(lds); LAS bf16* Vs = (LAS bf16*)(lds + KS_BYTES);
        for (int item = bid; item < NBLK * NKV * 2; item += G) {
            const int b = item >> 3, kvh = (item >> 1) & 3, hp = item & 1;
#pragma unroll
            for (int i = 0; i < 8; ++i) { const int idx = i * 512 + tid, key = idx >> 4, c8 = idx & 15; *(LAS v4u*)(Ks + key * KS_P + c8 * 8) = *(const v4u*)(Kb + (size_t)(256 * b + key) * 512 + kvh * 128 + c8 * 8); }
#pragma unroll
            for (int i = 0; i < 8; ++i) { const int idx = i * 512 + tid, key = idx >> 4, c8 = idx & 15; *(LAS v4u*)(Vs + key * KS_P + c8 * 8) = *(const v4u*)(Vb + (size_t)(256 * b + key) * 512 + kvh * 128 + c8 * 8); }
            const int nsel = b < 3 ? b : 3;
            bf16x8 qn[4];
            { const bf16* qp = Qb + (size_t)(256 * b + 16 * wave + fr) * D + (4 * kvh + 2 * hp) * 128 + 8 * fq;
#pragma unroll
              for (int ks = 0; ks < 4; ++ks) qn[ks] = *(const bf16x8*)(qp + 32 * ks); }
            __syncthreads();
#pragma unroll 1
            for (int u = 0; u < 4; ++u) {
                const int g = (u & 1) ? 15 - wave : wave, h = 4 * kvh + 2 * hp + (u >> 1); const int tl = 16 * g + fr; const int tok = 256 * b + tl;
                bf16x8 qf[4];
#pragma unroll
                for (int ks = 0; ks < 4; ++ks) qf[ks] = qn[ks];
                if (u < 3) { const int gn = ((u + 1) & 1) ? 15 - wave : wave, hn = 4 * kvh + 2 * hp + ((u + 1) >> 1); const bf16* qp = Qb + (size_t)(256 * b + 16 * gn + fr) * D + hn * 128 + 8 * fq;
#pragma unroll
                    for (int ks = 0; ks < 4; ++ks) qn[ks] = *(const bf16x8*)(qp + 32 * ks); }
                float msa[3], lsa[3];
#pragma unroll
                for (int r = 0; r < 3; ++r) { msa[r] = -INFINITY; lsa[r] = 0.f; if (r < nsel) { const size_t slot = ((size_t)tok * NH + h) * 3 + r; msa[r] = MLslot[slot * 2]; lsa[r] = MLslot[slot * 2 + 1]; } }
                const int nkt = g + 1;
                f32x4 acc[16]; attn_scores<16>(Ks, qf, acc, nkt, fr, fq);
                float mx = -INFINITY;
#pragma unroll
                for (int kt = 0; kt < 16; ++kt) {
#pragma unroll
                    for (int r = 0; r < 4; ++r) { const bool ok = (kt < nkt) && (16 * kt + 4 * fq + r <= tl); const float sv = ok ? acc[kt][r] : -INFINITY; acc[kt][r] = sv; mx = fmaxf(mx, sv); } }
                mx = fmaxf(mx, shx<16>(mx)); mx = xmax32(mx);
                float M = mx;
#pragma unroll
                for (int r = 0; r < 3; ++r) M = fmaxf(M, msa[r]);
                float l = 0.f;
#pragma unroll
                for (int kt = 0; kt < 16; ++kt) {
#pragma unroll
                    for (int r = 0; r < 4; ++r) { const float p = __builtin_amdgcn_exp2f(acc[kt][r] - M); acc[kt][r] = p; l += p; } }
                l += shx<16>(l); l = xadd32(l);
                f32x4 O[8];
#pragma unroll
                for (int vt = 0; vt < 8; ++vt) O[vt] = (f32x4){0.f, 0.f, 0.f, 0.f};
                attn_pv(Vs, acc, O, (nkt + 1) >> 1, fr, fq);
#pragma unroll
                for (int r = 0; r < 3; ++r) { if (r < nsel) { const float sc = __builtin_amdgcn_exp2f(msa[r] - M); l += lsa[r] * sc; const size_t slot = ((size_t)tok * NH + h) * 3 + r; const bf16* op = Oslot + slot * 128 + 4 * fq;
#pragma unroll
                    for (int vt = 0; vt < 8; ++vt) { const v2u w = *(const v2u*)(op + 16 * vt); O[vt][0] += bf2f(w.x & 0xffffu) * sc; O[vt][1] += bf2f(w.x >> 16) * sc; O[vt][2] += bf2f(w.y & 0xffffu) * sc; O[vt][3] += bf2f(w.y >> 16) * sc; } } }
                const float il = 1.0f / l; bf16* ap = At + (size_t)tok * D + h * 128 + 4 * fq;
#pragma unroll
                for (int vt = 0; vt < 8; ++vt) { v2u w; w.x = cvt_pk_bf16(O[vt][0] * il, O[vt][1] * il); w.y = cvt_pk_bf16(O[vt][2] * il, O[vt][3] * il); *(v2u*)(ap + 16 * vt) = w; }
            }
            __syncthreads();
        }
        LAS float* ksn = (LAS float*)(lds);
        for (int item = bid; item < DECB * NKV; item += G) {
            const int b = item >> 2, kvh = item & 3;
            { const int key = tid >> 7, d = tid & 127; ksn[key * 128 + d] = out[OK_S + (size_t)(4 * b + key) * 512 + kvh * 128 + d]; ksn[512 + key * 128 + d] = Vraw[(size_t)(SEQ + 4 * b + key) * 512 + kvh * 128 + d]; }
            __syncthreads();
            const int pr = tid >> 5, l32 = tid & 31; const int t = pr >> 2, hg = pr & 3; const int row = SEQ + 4 * b + t, h = 4 * kvh + hg;
            const v2u qw = *(const v2u*)(Qb + (size_t)row * D + h * 128 + 4 * l32);
            const float q0 = bf2f(qw.x & 0xffffu), q1 = bf2f(qw.x >> 16), q2 = bf2f(qw.y & 0xffffu), q3 = bf2f(qw.y >> 16);
            float sk[4]; float M = -INFINITY;
#pragma unroll
            for (int key = 0; key < 4; ++key) { const f32x4 k4 = *(const LAS f32x4*)(ksn + key * 128 + 4 * l32); float s = (q0 * k4[0] + q1 * k4[1]) + (q2 * k4[2] + q3 * k4[3]);
                s += shx<1>(s); s += shx<2>(s); s += shx<4>(s); s += shx<8>(s); s += shx<16>(s);
                sk[key] = (key <= t) ? s : -INFINITY; M = fmaxf(M, sk[key]); }
            const unsigned mask = Sels[item * 16 + pr];
#pragma unroll 1
            for (int n = 0; n < 32; ++n) if ((mask >> n) & 1u) M = fmaxf(M, Sslot[((size_t)(item * 32 + n) * 16 + pr) * 132 + 128]);
            float l = 0.f; f32x4 O = {0.f, 0.f, 0.f, 0.f};
#pragma unroll
            for (int key = 0; key < 4; ++key) { const float p = __builtin_amdgcn_exp2f(sk[key] - M); l += p; O += *(const LAS f32x4*)(ksn + 512 + key * 128 + 4 * l32) * p; }
#pragma unroll 1
            for (int n = 0; n < 32; ++n) if ((mask >> n) & 1u) { const float* sp = Sslot + ((size_t)(item * 32 + n) * 16 + pr) * 132; const float sc = __builtin_amdgcn_exp2f(sp[128] - M); l += sp[129] * sc; O += *(const f32x4*)(sp + 4 * l32) * sc; }
            const float il = 1.0f / l; v2u w; w.x = cvt_pk_bf16(O[0] * il, O[1] * il); w.y = cvt_pk_bf16(O[2] * il, O[3] * il);
            *(v2u*)(At + (size_t)row * D + h * 128 + 4 * l32) = w;
            __syncthreads();
        }
    }
    xcd_barrier(bar, IS_T0);
    STAMP();

    {
        TIDS;
        pg8::Gemm g{At, Wo_t, SEQ, D, D}; pg8::StaticOrder S; S.init(SEQ, D, G, bid);
        EpiRes<1> E{Hb2, nullptr, nullptr, Hb3, ss3};
        pg8::gemm_phase<EpiRes<1>, pg8::StaticOrder, true, true, false>(lds, g, S, E, TIDX);
        { const int t2 = bid & 127, rh = (bid >> 7) & 1; TIDS; f32x4 ta[1]; tail_gemm<1>(lds, At + (size_t)SEQ * D, Wo_t, D, 16 * t2, rh, ta, TIDX); if (wave < 4) E.tail(SEQ + 64 * rh + 16 * wave + fr, 16 * t2 + 4 * fq, ta[0], fq); }
    }
    xcd_barrier(bar, IS_T0);
    STAMP();
    {
        TIDS;
        pg8::Gemm g{Hb3, Wgu1_t, MP, NGU, D}; pg8::StaticOrder S; S.init(MP, NGU, G, bid);
        EpiGU E{ss3, Hm};
        pg8::gemm_phase<EpiGU, pg8::StaticOrder, true, true>(lds, g, S, E, TIDX);
    }
    xcd_barrier(bar, IS_T0);
    STAMP();
    {
        TIDS;
        pg8::Gemm g{Hm, Wdn1_t, SEQ, D, DFF}; pg8::StaticOrder S; S.init(SEQ, D, G, bid);
        EpiRes<2> E{Hb3, out + OY_P, out + OY_S, nullptr, nullptr};
        pg8::gemm_phase<EpiRes<2>, pg8::StaticOrder, true, true, false>(lds, g, S, E, TIDX);
        { const int t2 = bid & 127, rh = (bid >> 7) & 1; TIDS; f32x4 ta[1]; tail_gemm<1>(lds, Hm + (size_t)SEQ * DFF, Wdn1_t, DFF, 16 * t2, rh, ta, TIDX); if (wave < 4) E.tail(SEQ + 64 * rh + 16 * wave + fr, 16 * t2 + 4 * fq, ta[0], fq); }
    }
#ifdef PROF_A
    STAMP();
    if (blockIdx.x == 0 && IS_T0) {
        const unsigned ta = PVAL(PROF_A0, PROF_A1), tb = PVAL(PROF_B0, PROF_B1);
        unsigned qa = (ta + PROF_UA / 2) / PROF_UA, qb = (tb + PROF_UB / 2) / PROF_UB; if (qa > 99u) qa = 99u; if (qb > 99u) qb = 99u;
#ifdef PROF_MUL
        const unsigned long long extra = (unsigned long long)ta * PROF_MUL;
#else
        const unsigned long long extra = (unsigned long long)(qa + 100u * qb) * 5000ull;
#endif
        const unsigned long long t0 = __builtin_amdgcn_s_memrealtime();
        while (__builtin_amdgcn_s_memrealtime() - t0 < extra) __builtin_amdgcn_s_sleep(32);
    }
#endif
}
#undef x_p
#undef x_s
#undef st_in
#undef cache_k
#undef cache_v
#undef ptab
#undef norm_mix_a
#undef w_in
#undef lbl
#undef onorm
#undef w_out
#undef norm_kv
#undef w_kv
#undef k_norm
#undef norm_mix_b
#undef w_q
#undef q_norm
#undef w_o
#undef norm_ffn
#undef w_gu
#undef w_dn
#undef Win_t
#undef Wout_t
#undef Wgu0_t
#undef Wdn0_t
#undef Wkvq_t
#undef Wo_t
#undef Wgu1_t
#undef Wdn1_t
#undef Hb0
#undef Hb1
#undef Hb2
#undef Hb3
#undef Hf1
#undef Hf2
#undef Hf3
#undef Qg
#undef Vg
#undef Gg
#undef Ff
#undef Ob
#undef At
#undef Hm
#undef Ub
#undef Sst
#undef Dec
#undef Kraw
#undef Vraw
#undef Qraw
#undef Kb
#undef Vb
#undef Qb
#undef Kpart
#undef Kms
#undef Subl
#undef Scnt
#undef Sels
#undef Oslot
#undef MLslot
#undef Sslot
#undef ss0
#undef ss1
#undef ss2
#undef ss3
#undef out
#undef TIDS
#undef TIDX
#undef IS_T0

extern "C" void kernel_launch(void* const* d_in, const int* in_sizes, int n_in, void* d_out, int out_size, void* d_ws, size_t ws_size, hipStream_t stream) {
    static int grid = 0;
    if (grid == 0) {
        if (n_in != 21 || ws_size < WS_END) { fprintf(stderr, "kernel_launch: unexpected n_in %d / ws %zu\n", n_in, ws_size); grid = -1; return; }
        int dev = 0, cus = 0, per_cu = 0;
        if (hipGetDevice(&dev) != hipSuccess || hipDeviceGetAttribute(&cus, hipDeviceAttributeMultiprocessorCount, dev) != hipSuccess) { grid = -1; return; }
        if (hipFuncSetAttribute((const void*)yoco_fwd, hipFuncAttributeMaxDynamicSharedMemorySize, LDS_BYTES) != hipSuccess) { fprintf(stderr, "kernel_launch: hipFuncSetAttribute failed\n"); grid = -1; return; }
        if (hipOccupancyMaxActiveBlocksPerMultiprocessor(&per_cu, (const void*)yoco_fwd, NTHR, LDS_BYTES) != hipSuccess || per_cu < 1) fprintf(stderr, "kernel_launch: occupancy query says %d\n", per_cu);
        (void)hipGetLastError();
        grid = cus;
        if (grid < 256) { fprintf(stderr, "kernel_launch: built for 256 CUs (got %d)\n", grid); grid = -1; return; }
        grid = 256;
    }
    if (grid < 0) return;
    (void)hipMemsetAsync((char*)d_ws + WS_CTL, 0, CTL_ZERO_BYTES, stream);
    Args a{};
    for (int i = 0; i < 21; ++i) a.in[i] = d_in[i];
    a.out = (float*)d_out; a.ws = (unsigned char*)d_ws;
    hipLaunchKernelGGL(yoco_fwd, dim3(grid), dim3(NTHR), LDS_BYTES, stream, a);
}
```

```cpp
#include <hip/hip_runtime.h>
#include <cstdio>
#include <cstdint>
__device__ __forceinline__ int lane_id() { int l = (int)__builtin_amdgcn_mbcnt_hi(~0u, __builtin_amdgcn_mbcnt_lo(~0u, 0u)); asm volatile("" : "+v"(l)); return l; }

namespace pg8 {
#define PG8_LAS __attribute__((address_space(3)))
typedef unsigned short bf16_t;
typedef short bf16x8 __attribute__((ext_vector_type(8)));
typedef float f32x4 __attribute__((ext_vector_type(4)));
typedef unsigned u32x4 __attribute__((ext_vector_type(4)));
typedef unsigned u32x2 __attribute__((ext_vector_type(2)));
constexpr int BM = 256, BK = 64, HALF = 128, HTB = HALF * BK * 2, STAGE_BYTES = 8 * HTB, NXCD = 8, WGM = 8;

__host__ __device__ __forceinline__ int lds_byte(int r, int c) { const int st = (r >> 4) * 2 + (c >> 5), rr = r & 15, cc = c & 31, ob = rr * 64 + cc * 2; return st * 1024 + (ob ^ (((ob >> 9) & 1) << 5)); }
__host__ __device__ __forceinline__ void stage_rc(int b, int& R, int& C) { const int st = b / 1024, sb = b % 1024, swz = sb ^ (((sb >> 9) & 1) << 5); R = (st >> 1) * 16 + swz / 64; C = (st & 1) * 32 + (swz % 64) / 2; }
__host__ __device__ __forceinline__ int perm32(int rho) { const int n = rho >> 4, i = rho & 15; return 8 * (i >> 2) + 4 * n + (i & 3); }

struct Unit { int pm, pn; };
struct Gemm { const bf16_t* A; const bf16_t* Bt; int M, N, K; };

struct StaticOrder {
    int nM, nN, nwg, G, c;
    __host__ __device__ void init(int M, int N, int G_, int c_) { nM = M / BM; nN = N / BM; nwg = nM * nN; G = G_; c = c_; }
    __host__ __device__ bool next(int i, Unit& u) const {
        const long L = (long)i * G + c; if (L >= nwg) return false;
        int wgid = (int)L; { const int q = nwg / NXCD, r = nwg % NXCD, xcd = wgid % NXCD, off = wgid / NXCD; wgid = (xcd < r ? xcd * (q + 1) : r * (q + 1) + (xcd - r) * q) + off; }
        const int nig = WGM * nN, gid = wgid / nig, fm = gid * WGM, gsz = (nM - fm) < WGM ? (nM - fm) : WGM;
        u.pm = fm + ((wgid % nig) % gsz); u.pn = (wgid % nig) / gsz; return true;
    }
    __device__ __forceinline__ void a_ready(const Unit&) const {}
    __device__ __forceinline__ void done(const Unit&) const {}
};

__device__ __forceinline__ unsigned cvt_pk_bf16(float lo, float hi) { unsigned r; asm volatile("v_cvt_pk_bf16_f32 %0, %1, %2" : "=v"(r) : "v"(lo), "v"(hi)); return r; }

template <class Epi, class Sched, bool ALIGN_EPI = false, bool SP2 = false, bool HALF_LAST = true>
__device__ __forceinline__ void gemm_phase(PG8_LAS unsigned char* lds, const Gemm g, const Sched& S, const Epi& E, int tidx) {
    int tid_ = tidx; asm volatile("" : "+v"(tid_));
    const int tid = tid_, wid = __builtin_amdgcn_readfirstlane(tid >> 6), lane = tid & 63, wr = wid >> 2, wc = wid & 3, fr = lane & 15, fq = lane >> 4;
    const int K = g.K, nt = K / BK;
    unsigned voffA[2], voffB[2];
#pragma unroll
    for (int i = 0; i < 2; ++i) { int R, C; stage_rc(tid * 16 + i * 8192, R, C); const int Rb = Epi::PERM ? ((R & ~31) + perm32(R & 31)) : R;
        voffA[i] = (unsigned)(R * K + C) * 2u; voffB[i] = (unsigned)(Rb * K + C) * 2u; }
    const size_t kstep = (size_t)(BK * 2);
    const size_t hstep = (size_t)HALF * K * 2;
    const size_t tstep = 2 * hstep;
    const unsigned ldsw = (unsigned)wid * 1024u;
    const int aoff = lds_byte(wr * 64 + fr, fq * 8), boff = lds_byte(wc * 32 + fr, fq * 8);
#define PG8_SA(b, h) (((b) * 2 + (h)) * HTB)
#define PG8_SB(b, h) ((4 + (b) * 2 + (h)) * HTB)
#define PG8_STAGE(bufoff, gbase, voff) do { _Pragma("unroll") for (int _i = 0; _i < 2; ++_i) \
        __builtin_amdgcn_global_load_lds((const unsigned*)((const char*)(gbase) + (voff)[_i]), (PG8_LAS unsigned*)(lds + (bufoff) + ldsw + _i * 8192), 16, 0, 0); } while (0)
#define PG8_LDA(dst, b, h) do { _Pragma("unroll") for (int m = 0; m < 4; ++m) _Pragma("unroll") for (int k = 0; k < 2; ++k) dst[m][k] = *(const PG8_LAS bf16x8*)(lds + PG8_SA(b, h) + aoff + m * 2048 + k * 1024); } while (0)
#define PG8_LDB(dst, b, h) do { _Pragma("unroll") for (int n = 0; n < 2; ++n) _Pragma("unroll") for (int k = 0; k < 2; ++k) dst[n][k] = *(const PG8_LAS bf16x8*)(lds + PG8_SB(b, h) + boff + n * 2048 + k * 1024); } while (0)
#define PG8_MMA(ai, bj, At, Bt) do { __builtin_amdgcn_s_setprio(1); _Pragma("unroll") for (int m = 0; m < 4; ++m) _Pragma("unroll") for (int n = 0; n < 2; ++n) _Pragma("unroll") for (int k = 0; k < 2; ++k) \
        acc[ai][bj][m][n] = __builtin_amdgcn_mfma_f32_16x16x32_bf16(Bt[n][k], At[m][k], acc[ai][bj][m][n], 0, 0, 0); __builtin_amdgcn_s_setprio(0); } while (0)
#define PG8_WAIT_V(n) asm volatile("s_waitcnt vmcnt(" #n ")" ::: "memory")
#define PG8_WAIT_L(n) asm volatile("s_waitcnt lgkmcnt(" #n ")" ::: "memory")
#define PG8_BAR __builtin_amdgcn_s_barrier()
#define PG8_SCHED __builtin_amdgcn_sched_barrier(0)
    Unit cur, nxt; int ui = 0;
    if (!S.next(0, cur)) return;
    f32x4 acc[2][2][4][2];
#pragma unroll
    for (int a = 0; a < 2; ++a)
#pragma unroll
        for (int b = 0; b < 2; ++b)
#pragma unroll
            for (int m = 0; m < 4; ++m)
#pragma unroll
                for (int n = 0; n < 2; ++n) acc[a][b][m][n] = (f32x4){0.f, 0.f, 0.f, 0.f};
    bf16x8 At[4][2], B0[2][2], B1[2][2];
    const char* cA = (const char*)g.A + (size_t)cur.pm * tstep; const char* cB = (const char*)g.Bt + (size_t)cur.pn * tstep;
    S.a_ready(cur);
    if constexpr (SP2) {
        PG8_STAGE(PG8_SB(0, 0), cB, voffB); PG8_STAGE(PG8_SB(0, 1), cB + hstep, voffB); PG8_STAGE(PG8_SA(0, 0), cA, voffA); PG8_STAGE(PG8_SA(0, 1), cA + hstep, voffA);
        if (wr == 1) PG8_BAR;
        PG8_WAIT_V(2); PG8_BAR;
        PG8_STAGE(PG8_SB(1, 0), cB + kstep, voffB); PG8_STAGE(PG8_SA(1, 0), cA + kstep, voffA); PG8_STAGE(PG8_SB(1, 1), cB + hstep + kstep, voffB);
        PG8_WAIT_V(6); PG8_BAR;
    } else {
        PG8_STAGE(PG8_SB(0, 0), cB, voffB); PG8_STAGE(PG8_SA(0, 0), cA, voffA); PG8_STAGE(PG8_SB(0, 1), cB + hstep, voffB); PG8_STAGE(PG8_SA(0, 1), cA + hstep, voffA);
        if (wr == 1) PG8_BAR;
        PG8_WAIT_V(4); PG8_BAR;
        PG8_STAGE(PG8_SB(1, 0), cB + kstep, voffB); PG8_STAGE(PG8_SA(1, 0), cA + kstep, voffA); PG8_STAGE(PG8_SB(1, 1), cB + hstep + kstep, voffB);
        PG8_WAIT_V(6); PG8_BAR;
    }
    for (;;) {
        const bool has_next = S.next(ui + 1, nxt);
        const bool half1 = HALF_LAST && (cur.pm == g.M / BM - 1);
        const char* nA = has_next ? (const char*)g.A + (size_t)nxt.pm * tstep : cA; const char* nB = has_next ? (const char*)g.Bt + (size_t)nxt.pn * tstep : cB;
        for (int t = 0; t < nt; t += 2) {
            const bool last = (t == nt - 2);
            const char* a1 = cA + (size_t)(t + 1) * kstep;
            const char* a2 = last ? nA : cA + (size_t)(t + 2) * kstep; const char* b2 = last ? nB : cB + (size_t)(t + 2) * kstep;
            const char* a3 = a2 + kstep; const char* b3 = b2 + kstep;
            if (last && has_next) S.a_ready(nxt);
            if constexpr (SP2) {
            PG8_LDB(B0, 0, 0); PG8_LDB(B1, 0, 1); PG8_SCHED; PG8_LDA(At, 0, 0); PG8_STAGE(PG8_SA(1, 1), a1 + hstep, voffA);
            PG8_WAIT_V(8); PG8_WAIT_L(0); PG8_BAR; PG8_MMA(0, 0, At, B0); PG8_MMA(0, 1, At, B1); PG8_BAR; PG8_SCHED;
            if (!half1) { PG8_LDA(At, 0, 1); } PG8_STAGE(PG8_SB(0, 0), b2, voffB); PG8_STAGE(PG8_SB(0, 1), b2 + hstep, voffB); PG8_STAGE(PG8_SA(0, 0), a2, voffA);
            PG8_WAIT_V(8); PG8_WAIT_L(0); PG8_BAR; if (!half1) { PG8_MMA(1, 0, At, B0); PG8_MMA(1, 1, At, B1); } PG8_BAR; PG8_SCHED;
            PG8_LDB(B0, 1, 0); PG8_LDB(B1, 1, 1); PG8_SCHED; PG8_LDA(At, 1, 0); PG8_STAGE(PG8_SA(0, 1), a2 + hstep, voffA);
            PG8_WAIT_V(8); PG8_WAIT_L(0); PG8_BAR; PG8_MMA(0, 0, At, B0); PG8_MMA(0, 1, At, B1); PG8_BAR; PG8_SCHED;
            if (!half1) { PG8_LDA(At, 1, 1); } PG8_STAGE(PG8_SB(1, 0), b3, voffB); PG8_STAGE(PG8_SB(1, 1), b3 + hstep, voffB); PG8_STAGE(PG8_SA(1, 0), a3, voffA);
            PG8_WAIT_V(8); PG8_WAIT_L(0); PG8_BAR; if (!half1) { PG8_MMA(1, 0, At, B0); PG8_MMA(1, 1, At, B1); } PG8_BAR; PG8_SCHED;
            } else {
            PG8_LDB(B0, 0, 0); PG8_SCHED; PG8_LDA(At, 0, 0); PG8_STAGE(PG8_SA(1, 1), a1 + hstep, voffA);
            PG8_WAIT_L(8); PG8_BAR; PG8_WAIT_L(0); PG8_MMA(0, 0, At, B0); PG8_BAR; PG8_SCHED;
            PG8_LDB(B1, 0, 1); PG8_STAGE(PG8_SB(0, 0), b2, voffB);
            PG8_BAR; PG8_WAIT_L(0); PG8_MMA(0, 1, At, B1); PG8_BAR;
            PG8_LDA(At, 0, 1); PG8_STAGE(PG8_SA(0, 0), a2, voffA);
            PG8_BAR; PG8_WAIT_L(0); PG8_MMA(1, 0, At, B0); PG8_BAR; PG8_SCHED;
            PG8_STAGE(PG8_SB(0, 1), b2 + hstep, voffB);
            PG8_WAIT_V(6); PG8_BAR; PG8_MMA(1, 1, At, B1); PG8_BAR;
            PG8_LDB(B0, 1, 0); PG8_SCHED; PG8_LDA(At, 1, 0); PG8_STAGE(PG8_SA(0, 1), a2 + hstep, voffA);
            PG8_WAIT_L(8); PG8_BAR; PG8_WAIT_L(0); PG8_MMA(0, 0, At, B0); PG8_BAR; PG8_SCHED;
            PG8_LDB(B1, 1, 1); PG8_STAGE(PG8_SB(1, 0), b3, voffB);
            PG8_BAR; PG8_WAIT_L(0); PG8_MMA(0, 1, At, B1); PG8_BAR;
            PG8_LDA(At, 1, 1); PG8_STAGE(PG8_SA(1, 0), a3, voffA);
            PG8_BAR; PG8_WAIT_L(0); PG8_MMA(1, 0, At, B0); PG8_BAR; PG8_SCHED;
            PG8_STAGE(PG8_SB(1, 1), b3 + hstep, voffB);
            PG8_WAIT_V(6); PG8_BAR; PG8_MMA(1, 1, At, B1); PG8_BAR;
            }
        }
        if constexpr (ALIGN_EPI) { if (wr == 0) PG8_BAR; }
        E(acc, cur, wr, wc, fr, fq);
        if (!has_next) break;
#pragma unroll
        for (int a = 0; a < 2; ++a)
#pragma unroll
            for (int b = 0; b < 2; ++b)
#pragma unroll
                for (int m = 0; m < 4; ++m)
#pragma unroll
                    for (int n = 0; n < 2; ++n) acc[a][b][m][n] = (f32x4){0.f, 0.f, 0.f, 0.f};
        cur = nxt; cA = nA; cB = nB; ++ui;
        if constexpr (ALIGN_EPI) { if (wr == 1) PG8_BAR; }
    }
    PG8_WAIT_V(0);
    if constexpr (!ALIGN_EPI) { if (wr == 0) PG8_BAR; }
    PG8_BAR;
#undef PG8_SA
#undef PG8_SB
#undef PG8_STAGE
#undef PG8_LDA
#undef PG8_LDB
#undef PG8_MMA
#undef PG8_WAIT_V
#undef PG8_WAIT_L
#undef PG8_BAR
#undef PG8_SCHED
}
}

constexpr int NWAVES = 8, NTHR = 512;
constexpr int D = 2048, SEQ = 8192, DECB = 32, DECS = 4, MS = DECB * DECS;
constexpr int MR = SEQ + MS;
constexpr int MP = 8448;
constexpr int NH = 16, HD = 128, NKV = 4, DFF = 5632, NGU = 2 * DFF;
constexpr int NCHUNK = SEQ / 64;
constexpr int NPAGES = 64, PAGE = 128, NBLK = 32;
constexpr float EPS = 1e-6f;
constexpr float C2 = 0.08838834764831845f * 1.4426950408889634f;

constexpr size_t OY_P = 0, OY_S = OY_P + (size_t)SEQ * D, OST_P = OY_S + (size_t)MS * D, OST_S = OST_P + (size_t)NH * 128 * 128,
                 OK_P = OST_S + (size_t)DECB * NH * 128 * 128, OV_P = OK_P + (size_t)SEQ * 512, OK_S = OV_P + (size_t)SEQ * 512, OV_S = OK_S + (size_t)MS * 512;

constexpr size_t MiB = 1u << 20;
constexpr size_t WS_CTL = 0, CTL_ZERO_BYTES = 1 * MiB;
constexpr size_t WS_WIN = 2 * MiB;
constexpr size_t WS_WOUT = WS_WIN + 32 * MiB;
constexpr size_t WS_WGU0 = WS_WOUT + 8 * MiB;
constexpr size_t WS_WDN0 = WS_WGU0 + 44 * MiB;
constexpr size_t WS_WKVQ = WS_WDN0 + 22 * MiB;
constexpr size_t WS_WO = WS_WKVQ + 12 * MiB;
constexpr size_t WS_WGU1 = WS_WO + 8 * MiB;
constexpr size_t WS_WDN1 = WS_WGU1 + 44 * MiB;
constexpr size_t WS_HB0 = WS_WDN1 + 22 * MiB;
constexpr size_t WS_HB1 = WS_HB0 + 34 * MiB, WS_HB2 = WS_HB1 + 34 * MiB, WS_HB3 = WS_HB2 + 34 * MiB;
constexpr size_t WS_HF1 = WS_HB3 + 34 * MiB;
constexpr size_t WS_HF2 = WS_HF1 + 67 * MiB, WS_HF3 = WS_HF2 + 67 * MiB;
constexpr size_t WS_QG = WS_HF3 + 67 * MiB;
constexpr size_t WS_VG = WS_QG + 34 * MiB;
constexpr size_t WS_GG = WS_VG + 34 * MiB;
constexpr size_t WS_F = WS_GG + 34 * MiB;
constexpr size_t WS_OB = WS_F + 67 * MiB;
constexpr size_t WS_AT = WS_OB + 34 * MiB;
constexpr size_t WS_HM = WS_AT + 34 * MiB;
constexpr size_t WS_U = WS_HM + 92 * MiB;
constexpr size_t WS_SST = WS_U + 64 * MiB;
constexpr size_t WS_DEC = WS_SST + 64 * MiB;
constexpr size_t WS_KRAW = WS_DEC + 2 * MiB;
constexpr size_t WS_VRAW = WS_KRAW + 17 * MiB;
constexpr size_t WS_QRAW = WS_VRAW + 17 * MiB;
constexpr size_t WS_KB = WS_QRAW + 67 * MiB;
constexpr size_t WS_VB = WS_KB + 9 * MiB;
constexpr size_t WS_QB = WS_VB + 9 * MiB;
constexpr size_t WS_KPART = WS_QB + 34 * MiB;
constexpr size_t WS_KMS = WS_KPART + 1 * MiB;
constexpr size_t WS_SUBL = WS_KMS + 2 * MiB;
constexpr size_t WS_SCNT = WS_SUBL + 16 * MiB;
constexpr size_t WS_OSLOT = WS_SCNT + 1 * MiB;
constexpr size_t WS_MLSLOT = WS_OSLOT + 192 * MiB;
constexpr size_t WS_SSLOT = WS_MLSLOT + 3 * MiB;
constexpr size_t WS_FOUT = WS_SSLOT + 34 * MiB;
constexpr size_t WS_END = WS_FOUT + 131 * MiB;
constexpr size_t WS_ORC = WS_END;
constexpr int CW_BAR = 4096;
constexpr int CW_Q0 = 8192;
constexpr int CW_SS0 = 16384, CW_SS1 = CW_SS0 + MP, CW_SS2 = CW_SS1 + MP, CW_SS3 = CW_SS2 + MP;
static_assert((CW_SS3 + MP) * 4 <= (int)CTL_ZERO_BYTES, "ctl");
static_assert(WS_VG - WS_QG == 34 * MiB && WS_GG - WS_VG == 34 * MiB, "Qg|Vg|Gg stride");

constexpr int LDS_BYTES = 160 * 1024;
constexpr int MISC_OFF = LDS_BYTES - 256;

#define GAS __attribute__((address_space(1)))
#define LAS __attribute__((address_space(3)))
typedef unsigned short bf16;
typedef unsigned v4u __attribute__((ext_vector_type(4)));
typedef unsigned v2u __attribute__((ext_vector_type(2)));
typedef float f32x4 __attribute__((ext_vector_type(4)));
typedef float f32x2 __attribute__((ext_vector_type(2)));
typedef short bf16x8 __attribute__((ext_vector_type(8)));
typedef short bf16x4 __attribute__((ext_vector_type(4)));
typedef _Float16 f16;
typedef _Float16 f16x2 __attribute__((ext_vector_type(2)));
__device__ __forceinline__ unsigned pkh2(float lo, float hi) { const f16x2 v = {(f16)lo, (f16)hi}; return __builtin_bit_cast(unsigned, v); }
#define LDS_WAIT() asm volatile("s_waitcnt lgkmcnt(0)" ::: "memory")
__device__ __forceinline__ unsigned f2bf(float f) { unsigned u = __builtin_bit_cast(unsigned, f); return (u + 0x7fffu + ((u >> 16) & 1u)) >> 16; }
__device__ __forceinline__ unsigned pk2(float lo, float hi) { return f2bf(lo) | (f2bf(hi) << 16); }
__device__ __forceinline__ float bf2f(unsigned h) { return __uint_as_float(h << 16); }
__device__ __forceinline__ float silu_f(float x) { return x * __builtin_amdgcn_rcpf(1.0f + __expf(-x)); }
__device__ __forceinline__ float sigm_f(float x) { return __builtin_amdgcn_rcpf(1.0f + __expf(-x)); }
template <int M> __device__ __forceinline__ float shx(float v) { return __uint_as_float((unsigned)__builtin_amdgcn_ds_swizzle((int)__float_as_uint(v), (M << 10) | 0x1f)); }
__device__ __forceinline__ float xadd32(float v) { auto rr = __builtin_amdgcn_permlane32_swap(__float_as_uint(v), __float_as_uint(v), false, false); return __uint_as_float(rr[0]) + __uint_as_float(rr[1]); }
__device__ __forceinline__ float xmax32(float v) { auto rr = __builtin_amdgcn_permlane32_swap(__float_as_uint(v), __float_as_uint(v), false, false); return fmaxf(__uint_as_float(rr[0]), __uint_as_float(rr[1])); }
__device__ __forceinline__ float wave_sum(float v) { v += shx<1>(v); v += shx<2>(v); v += shx<4>(v); v += shx<8>(v); v += shx<16>(v); return xadd32(v); }
#define MFMA16(a, b, c) __builtin_amdgcn_mfma_f32_16x16x32_bf16((a), (b), (c), 0, 0, 0)

#define XB_TMO      128
#define XB_XCNT(j)  (256  + 64 * (j))
#define XB_XSUB(j)  (1280 + 64 * (j))
#define XB_XGEN(j)  (2304 + 64 * (j))
#define XB_TOP      3328
#define XB_TOPGEN   3392
#define XCD_BAR_WORDS 3456
#define XB_SPIN_CAP (1u << 18)
__device__ __forceinline__ unsigned xb_ld(unsigned* p)              { return __hip_atomic_load(p, __ATOMIC_RELAXED, __HIP_MEMORY_SCOPE_AGENT); }
__device__ __forceinline__ unsigned xb_add(unsigned* p, unsigned v) { return __hip_atomic_fetch_add(p, v, __ATOMIC_RELAXED, __HIP_MEMORY_SCOPE_AGENT); }
__device__ __forceinline__ unsigned xb_xcc_id() { return (unsigned)__builtin_amdgcn_s_getreg((3 << 11) | 20) & 0xFu; }
#define XB_SPIN(cond, bar) do { unsigned _sp = 0; while (cond) { __builtin_amdgcn_s_sleep(1); \
    if ((++_sp & 255u) == 0u) { if (xb_ld(&(bar)[XB_TMO])) break; if (_sp > XB_SPIN_CAP) { atomicAdd(&(bar)[XB_TMO], 1u); break; } } } } while (0)
struct XcdBarrier { unsigned* bar; unsigned x; volatile LAS unsigned* st; };
__device__ __forceinline__ XcdBarrier xcd_barrier_post(unsigned* bar, volatile LAS unsigned* st, bool is_t0) {
    XcdBarrier b; b.bar = bar; b.x = xb_xcc_id(); b.st = st;
    if (is_t0) (void)xb_add(&bar[XB_XCNT(b.x)], 1u);
    return b;
}
__device__ __forceinline__ void xcd_barrier_complete(unsigned* bar, unsigned x, unsigned& nloc, unsigned& nx) {
    const unsigned G = gridDim.x * gridDim.y * gridDim.z;
    unsigned sum, cnt, mine, sp = 0u;
    for (;;) {
        sum = 0u; cnt = 0u; mine = 0u;
#pragma unroll
        for (unsigned j = 0; j < 16; ++j) { const unsigned c = xb_ld(&bar[XB_XCNT(j)]); sum += c; cnt += (c > 0u) ? 1u : 0u; mine = (j == x) ? c : mine; }
        if (sum == G) break;
        __builtin_amdgcn_s_sleep(1);
        if ((++sp & 255u) == 0u) { if (xb_ld(&bar[XB_TMO])) break; if (sp > XB_SPIN_CAP) { atomicAdd(&bar[XB_TMO], 1u); break; } }
    }
    nloc = mine > 0u ? mine : 1u; nx = cnt > 0u ? cnt : 1u;
}
__device__ __forceinline__ void xcd_barrier(const XcdBarrier& b, bool is_t0) {
    asm volatile("s_waitcnt vmcnt(0)" ::: "memory");
    __syncthreads();
    if (is_t0) {
        unsigned* bar = b.bar;
        __builtin_amdgcn_s_waitcnt(0);
        unsigned nloc = b.st[0], nx = b.st[1];
        if (nloc == 0u) { xcd_barrier_complete(bar, b.x, nloc, nx); b.st[0] = nloc; b.st[1] = nx; }
        const unsigned old = xb_add(&bar[XB_XSUB(b.x)], 1u);
        const unsigned gen = old / nloc;
        if (old + 1u == (gen + 1u) * nloc) {
            __builtin_amdgcn_fence(__ATOMIC_RELEASE, "agent");
            asm volatile("s_waitcnt vmcnt(0)" ::: "memory");
            const unsigned og = xb_add(&bar[XB_TOP], 1u);
            const unsigned tg = og / nx;
            if (og + 1u == (tg + 1u) * nx) xb_add(&bar[XB_TOPGEN], 1u);
            else XB_SPIN(xb_ld(&bar[XB_TOPGEN]) == tg, bar);
            __builtin_amdgcn_fence(__ATOMIC_ACQUIRE, "agent");
            xb_add(&bar[XB_XGEN(b.x)], 1u);
            asm volatile("s_waitcnt vmcnt(0)" ::: "memory");
        } else {
            XB_SPIN(xb_ld(&bar[XB_XGEN(b.x)]) == gen, bar);
            __builtin_amdgcn_fence(__ATOMIC_ACQUIRE, "agent");
            asm volatile("s_waitcnt vmcnt(0)" ::: "memory");
        }
    }
    __syncthreads();
}

using pg8::Unit; using pg8::cvt_pk_bf16;
struct EpiIn {
    static constexpr bool PERM = true;
    const float* ss; const float* lbl; bf16* Qg; f16* F;
    __device__ __forceinline__ void operator()(const f32x4 (&acc)[2][2][4][2], const Unit& u, int wr, int wc, int fr, int fq) const {
        const int seg = u.pn >> 3; const int col0 = (u.pn & 7) * 256 + wc * 32 + 8 * fq; const int rowb = u.pm * 256 + wr * 64;
        float lb[2][8];
        if (seg == 1) {
#pragma unroll
            for (int bj = 0; bj < 2; ++bj)
#pragma unroll
                for (int j = 0; j < 8; ++j) { const int c = col0 + bj * 128 + j; lb[bj][j] = __builtin_amdgcn_rcpf(1.0f + __expf(lbl[D + c] - lbl[c])); }
        }
#pragma unroll
        for (int ai = 0; ai < 2; ++ai)
#pragma unroll
            for (int m = 0; m < 4; ++m) {
                const int rb = rowb + ai * 128 + m * 16; if (rb >= MR) continue;
                const int row = rb + fr; const float r = rsqrtf(ss[row] * (1.0f / D) + EPS);
#pragma unroll
                for (int bj = 0; bj < 2; ++bj) {
                    f32x4 v0 = acc[ai][bj][m][0] * r, v1 = acc[ai][bj][m][1] * r; const size_t off = (size_t)row * D + col0 + bj * 128;
                    if (seg == 1) {
                        f32x4 o0, o1;
#pragma unroll
                        for (int j = 0; j < 4; ++j) { o0[j] = lb[bj][j] + (1.0f - lb[bj][j]) * sigm_f(v0[j]); o1[j] = lb[bj][4 + j] + (1.0f - lb[bj][4 + j]) * sigm_f(v1[j]); }
                        { v4u w; w.x = pkh2(o0[0], o0[1]); w.y = pkh2(o0[2], o0[3]); w.z = pkh2(o1[0], o1[1]); w.w = pkh2(o1[2], o1[3]); *(v4u*)(F + off) = w; }
                    } else {
                        if (seg != 2) {
#pragma unroll
                            for (int j = 0; j < 4; ++j) { v0[j] = silu_f(v0[j]); v1[j] = silu_f(v1[j]); }
                        }
                        v4u w; w.x = cvt_pk_bf16(v0[0], v0[1]); w.y = cvt_pk_bf16(v0[2], v0[3]); w.z = cvt_pk_bf16(v1[0], v1[1]); w.w = cvt_pk_bf16(v1[2], v1[3]);
                        const size_t dsel = (seg == 0) ? 0 : ((seg == 2) ? 1 : 2);
                        *(v4u*)(Qg + dsel * (size_t)(17 * MiB) + off) = w;
                    }
                }
            }
    }
    __device__ __forceinline__ void tail(int row, int col, f32x4 v) const {
        const int seg = col >> 11, c = col & 2047; const float r = rsqrtf(ss[row] * (1.0f / D) + EPS); v = v * r; const size_t off = (size_t)row * D + c;
        if (seg == 1) { f32x4 o;
#pragma unroll
            for (int j = 0; j < 4; ++j) { const float lbv = __builtin_amdgcn_rcpf(1.0f + __expf(lbl[D + c + j] - lbl[c + j])); o[j] = lbv + (1.0f - lbv) * sigm_f(v[j]); }
            { v2u w; w.x = pkh2(o[0], o[1]); w.y = pkh2(o[2], o[3]); *(v2u*)(F + off) = w; }
        } else {
            if (seg != 2) {
#pragma unroll
                for (int j = 0; j < 4; ++j) v[j] = silu_f(v[j]);
            }
            v2u w; w.x = cvt_pk_bf16(v[0], v[1]); w.y = cvt_pk_bf16(v[2], v[3]);
            const size_t dsel = (seg == 0) ? 0 : ((seg == 2) ? 1 : 2);
            *(v2u*)(Qg + dsel * (size_t)(17 * MiB) + off) = w;
        }
    }
};

template <int MODE> struct EpiRes {
    static constexpr bool PERM = true;
    const bf16* rb; float* o0; float* o1; bf16* hb; float* ss;
    __device__ __forceinline__ void operator()(const f32x4 (&acc)[2][2][4][2], const Unit& u, int wr, int wc, int fr, int fq) const {
        const int col0 = u.pn * 256 + wc * 32 + 8 * fq; const int rowb = u.pm * 256 + wr * 64;
#pragma unroll
        for (int ai = 0; ai < 2; ++ai)
#pragma unroll
            for (int m = 0; m < 4; ++m) {
                const int rb0 = rowb + ai * 128 + m * 16; if (rb0 >= MR) continue;
                const int row = rb0 + fr;
                const bf16* rp = rb + (size_t)row * D;
                float* op = (MODE == 2) ? ((row < SEQ) ? o0 + (size_t)row * D : o1 + (size_t)(row - SEQ) * D) : nullptr;
                float sq = 0.f;
#pragma unroll
                for (int bj = 0; bj < 2; ++bj) {
                    const int c = col0 + bj * 128;
                    const v4u rw = *(const v4u*)(rp + c);
                    f32x4 a0 = {bf2f(rw.x & 0xffffu), bf2f(rw.x >> 16), bf2f(rw.y & 0xffffu), bf2f(rw.y >> 16)}, a1 = {bf2f(rw.z & 0xffffu), bf2f(rw.z >> 16), bf2f(rw.w & 0xffffu), bf2f(rw.w >> 16)};
                    a0 += acc[ai][bj][m][0]; a1 += acc[ai][bj][m][1];
                    if (MODE == 2) { __builtin_nontemporal_store(a0, (f32x4*)(op + c)); __builtin_nontemporal_store(a1, (f32x4*)(op + c + 4)); }
                    else {
                        v4u w; w.x = cvt_pk_bf16(a0[0], a0[1]); w.y = cvt_pk_bf16(a0[2], a0[3]); w.z = cvt_pk_bf16(a1[0], a1[1]); w.w = cvt_pk_bf16(a1[2], a1[3]);
                        *(v4u*)(hb + (size_t)row * D + c) = w;
                        sq += (a0[0] * a0[0] + a0[1] * a0[1]) + (a0[2] * a0[2] + a0[3] * a0[3]) + (a1[0] * a1[0] + a1[1] * a1[1]) + (a1[2] * a1[2] + a1[3] * a1[3]);
                    }
                }
                if (MODE != 2) { sq += shx<16>(sq); sq = xadd32(sq); if (fq == 0) atomicAdd(ss + row, sq); }
            }
    }
    __device__ __forceinline__ void tail(int row, int col, f32x4 v, int fq) const {
        const v2u rw = *(const v2u*)(rb + (size_t)row * D + col);
        f32x4 a0 = {bf2f(rw.x & 0xffffu), bf2f(rw.x >> 16), bf2f(rw.y & 0xffffu), bf2f(rw.y >> 16)}; a0 += v;
        if (MODE == 2) { *(f32x4*)(o1 + (size_t)(row - SEQ) * D + col) = a0; }
        else {
            v2u w; w.x = cvt_pk_bf16(a0[0], a0[1]); w.y = cvt_pk_bf16(a0[2], a0[3]); *(v2u*)(hb + (size_t)row * D + col) = w;
            float sq = (a0[0] * a0[0] + a0[1] * a0[1]) + (a0[2] * a0[2] + a0[3] * a0[3]);
            sq += shx<16>(sq); sq = xadd32(sq); if (fq == 0) atomicAdd(ss + row, sq);
        }
    }
};
struct EpiGU {
    static constexpr bool PERM = true;
    const float* ss; bf16* hm;
    __device__ __forceinline__ void operator()(const f32x4 (&acc)[2][2][4][2], const Unit& u, int wr, int wc, int fr, int fq) const {
        const int j0 = u.pn * 128 + wc * 32 + 8 * fq; const int rowb = u.pm * 256 + wr * 64;
#pragma unroll
        for (int ai = 0; ai < 2; ++ai)
#pragma unroll
            for (int m = 0; m < 4; ++m) {
                const int rb = rowb + ai * 128 + m * 16; if (rb >= MR) continue;
                const int row = rb + fr; const float r = rsqrtf(ss[row] * (1.0f / D) + EPS);
                float o[8];
#pragma unroll
                for (int n = 0; n < 2; ++n)
#pragma unroll
                    for (int j = 0; j < 4; ++j) o[4 * n + j] = silu_f(acc[ai][0][m][n][j] * r) * (acc[ai][1][m][n][j] * r);
                v4u w; w.x = cvt_pk_bf16(o[0], o[1]); w.y = cvt_pk_bf16(o[2], o[3]); w.z = cvt_pk_bf16(o[4], o[5]); w.w = cvt_pk_bf16(o[6], o[7]);
                *(v4u*)(hm + (size_t)row * DFF + j0) = w;
            }
    }
};
struct EpiKVQ {
    static constexpr bool PERM = true;
    const float* ss; unsigned char* ws; float* outp; const float* kn; const float* qn; LAS unsigned char* xl;
    __device__ __forceinline__ void operator()(const f32x4 (&acc)[2][2][4][2], const Unit& u, int wr, int wc, int fr, int fq) const {
        const int c0 = wc * 32 + 8 * fq; const int rowb = u.pm * 256 + wr * 64;
        bf16* Kb_ = (bf16*)(ws + WS_KB); bf16* Vb_ = (bf16*)(ws + WS_VB); bf16* Qb_ = (bf16*)(ws + WS_QB); float* Kp_ = (float*)(ws + WS_KPART);
        if (u.pn == 2 || u.pn == 3) {
#pragma unroll
            for (int ai = 0; ai < 2; ++ai)
#pragma unroll
                for (int m = 0; m < 4; ++m) {
                    const int rb = rowb + ai * 128 + m * 16; if (rb >= MR) continue;
                    const int row = rb + fr; const float r = rsqrtf(ss[row] * (1.0f / D) + EPS);
                    float* vo = outp + ((row < SEQ) ? OV_P + (size_t)row * 512 : OV_S + (size_t)(row - SEQ) * 512);
#pragma unroll
                    for (int bj = 0; bj < 2; ++bj) { const int col = (u.pn - 2) * 256 + bj * 128 + c0; const f32x4 v0 = acc[ai][bj][m][0] * r, v1 = acc[ai][bj][m][1] * r;
                        __builtin_nontemporal_store(v0, (f32x4*)(vo + col)); __builtin_nontemporal_store(v1, (f32x4*)(vo + col + 4));
                        v4u w; w.x = cvt_pk_bf16(v0[0], v0[1]); w.y = cvt_pk_bf16(v0[2], v0[3]); w.z = cvt_pk_bf16(v1[0], v1[1]); w.w = cvt_pk_bf16(v1[2], v1[3]);
                        *(v4u*)(Vb_ + (size_t)row * 512 + col) = w; }
                }
            return;
        }
        const bool isk = u.pn < 2;
        LAS float* P = (LAS float*)xl;
        LAS float* CS = (LAS float*)(xl + 8192);
#pragma unroll
        for (int ai = 0; ai < 2; ++ai)
#pragma unroll
            for (int m = 0; m < 4; ++m) {
                const int rl = ai * 128 + wr * 64 + m * 16 + fr; const float r = rsqrtf(ss[u.pm * 256 + rl] * (1.0f / D) + EPS);
#pragma unroll
                for (int bj = 0; bj < 2; ++bj) { const f32x4 v0 = acc[ai][bj][m][0] * r, v1 = acc[ai][bj][m][1] * r;
                    float sq = (v0[0] * v0[0] + v0[1] * v0[1]) + (v0[2] * v0[2] + v0[3] * v0[3]) + (v1[0] * v1[0] + v1[1] * v1[1]) + (v1[2] * v1[2] + v1[3] * v1[3]);
                    sq += shx<16>(sq); sq = xadd32(sq);
                    if (fq == 0) P[(rl * 2 + bj) * 4 + wc] = sq; }
            }
        asm volatile("s_waitcnt lgkmcnt(0)" ::: "memory"); __builtin_amdgcn_s_barrier(); asm volatile("" ::: "memory");
        float cs[2][8];
#pragma unroll
        for (int bj = 0; bj < 2; ++bj)
#pragma unroll
            for (int j = 0; j < 8; ++j) cs[bj][j] = 0.f;
        const float* gp = (isk ? kn : qn) + c0; const f32x4 g0 = *(const f32x4*)gp, g1 = *(const f32x4*)(gp + 4);
#pragma unroll
        for (int ai = 0; ai < 2; ++ai)
#pragma unroll
            for (int m = 0; m < 4; ++m) {
                const int rb = rowb + ai * 128 + m * 16; if (rb >= MR) continue;
                const int rl = ai * 128 + wr * 64 + m * 16 + fr; const int row = rb + fr; const float r = rsqrtf(ss[row] * (1.0f / D) + EPS);
#pragma unroll
                for (int bj = 0; bj < 2; ++bj) {
                    const f32x4 pp = *(const LAS f32x4*)(P + (rl * 2 + bj) * 4);
                    const float rh = rsqrtf(((pp[0] + pp[1]) + (pp[2] + pp[3])) * (1.0f / 128.0f) + EPS) * (isk ? 1.0f : C2);
                    const f32x4 n0 = acc[ai][bj][m][0] * (r * rh) * g0, n1 = acc[ai][bj][m][1] * (r * rh) * g1;
                    v4u w; w.x = cvt_pk_bf16(n0[0], n0[1]); w.y = cvt_pk_bf16(n0[2], n0[3]); w.z = cvt_pk_bf16(n1[0], n1[1]); w.w = cvt_pk_bf16(n1[2], n1[3]);
                    if (isk) {
                        const int col = u.pn * 256 + bj * 128 + c0;
                        float* ko = outp + ((row < SEQ) ? OK_P + (size_t)row * 512 : OK_S + (size_t)(row - SEQ) * 512) + col;
                        __builtin_nontemporal_store(n0, (f32x4*)ko); __builtin_nontemporal_store(n1, (f32x4*)(ko + 4));
                        *(v4u*)(Kb_ + (size_t)row * 512 + col) = w;
#pragma unroll
                        for (int j = 0; j < 4; ++j) { cs[bj][j] += n0[j]; cs[bj][4 + j] += n1[j]; }
                    } else {
                        *(v4u*)(Qb_ + (size_t)row * D + (u.pn - 4) * 256 + bj * 128 + c0) = w;
                    }
                }
            }
        if (isk && u.pm < SEQ / 256) {
#pragma unroll
            for (int bj = 0; bj < 2; ++bj)
#pragma unroll
                for (int j = 0; j < 8; ++j) { float v = cs[bj][j]; v += shx<1>(v); v += shx<2>(v); v += shx<4>(v); v += shx<8>(v); if (fr == 0) CS[wr * 256 + bj * 128 + c0 + j] = v; }
            asm volatile("s_waitcnt lgkmcnt(0)" ::: "memory"); __builtin_amdgcn_s_barrier(); asm volatile("" ::: "memory");
            const int t = (wr * 4 + wc) * 64 + fq * 16 + fr;
            if (t < 256) Kp_[(size_t)u.pm * 512 + u.pn * 256 + t] = CS[t] + CS[256 + t];
        }
    }
};

struct Args { const void* in[21]; float* out; unsigned char* ws; };

__device__ __forceinline__ void p0_transpose_item(const float* W, int K, int N, bf16* WT, int row_off, int mode, const float* gain, LAS float* scr, int item, int lane) {
    const int nblk = N / 64, kb = item / nblk, nb = item % nblk, k0 = 64 * kb, n0 = 64 * nb;
    const int r = lane >> 4, c4 = lane & 15;
#pragma unroll
    for (int i = 0; i < 16; ++i) { const int kk = 4 * i + r; f32x4 w = __builtin_nontemporal_load((const f32x4*)(W + (size_t)(k0 + kk) * N + n0 + 4 * c4)); if (gain) w *= gain[k0 + kk]; *(LAS f32x4*)(scr + kk * 68 + 4 * c4) = w; }
    LDS_WAIT(); asm volatile("" ::: "memory");
    const int c = lane & 7;
    int d0;
    if (mode == 0) d0 = row_off + n0;
    else { const int j = (n0 < DFF) ? n0 : n0 - DFF; d0 = 256 * (j >> 7) + (j & 127) + ((n0 < DFF) ? 0 : 128); }
#pragma unroll
    for (int j = 0; j < 8; ++j) { const int n = (lane >> 3) + 8 * j; const LAS float* sp = scr + (8 * c) * 68 + n;
        v4u o; o.x = pk2(sp[0 * 68], sp[1 * 68]); o.y = pk2(sp[2 * 68], sp[3 * 68]); o.z = pk2(sp[4 * 68], sp[5 * 68]); o.w = pk2(sp[6 * 68], sp[7 * 68]);
        *(v4u*)(WT + (size_t)(d0 + n) * K + k0 + 8 * c) = o; }
    LDS_WAIT(); asm volatile("" ::: "memory");
}

constexpr int KS_P = 144;
constexpr int KS_BYTES = 256 * KS_P * 2;
typedef short v4i16_t __attribute__((ext_vector_type(4)));
__device__ __forceinline__ v2u tr_read(const LAS bf16* p) { return __builtin_bit_cast(v2u, __builtin_amdgcn_ds_read_tr16_b64_v4i16((LAS v4i16_t*)p)); }
template <int NKT> __device__ __forceinline__ void attn_scores(const LAS bf16* Ks, const bf16x8 (&qf)[4], f32x4 (&acc)[16], int nkt, int fr, int fq) {
#pragma unroll
    for (int kt = 0; kt < NKT; ++kt) {
        acc[kt] = (f32x4){0.f, 0.f, 0.f, 0.f};
        if (kt < nkt) {
#pragma unroll
            for (int ks = 0; ks < 4; ++ks) { const bf16x8 a = *(const LAS bf16x8*)(Ks + (16 * kt + fr) * KS_P + 32 * ks + 8 * fq); acc[kt] = MFMA16(a, qf[ks], acc[kt]); }
        }
    }
}
__device__ __forceinline__ void attn_pv(const LAS bf16* Vr, const f32x4 (&acc)[16], f32x4 (&O)[8], int nj, int fr, int fq) {
#pragma unroll
    for (int j = 0; j < 8; ++j) {
        if (j < nj) {
            v4u pw; pw.x = cvt_pk_bf16(acc[2 * j][0], acc[2 * j][1]); pw.y = cvt_pk_bf16(acc[2 * j][2], acc[2 * j][3]); pw.z = cvt_pk_bf16(acc[2 * j + 1][0], acc[2 * j + 1][1]); pw.w = cvt_pk_bf16(acc[2 * j + 1][2], acc[2 * j + 1][3]);
            const bf16x8 pf = __builtin_bit_cast(bf16x8, pw);
            const LAS bf16* vb = Vr + (32 * j + 4 * fq + (fr >> 2)) * KS_P + 4 * (fr & 3);
#pragma unroll
            for (int vt = 0; vt < 8; ++vt) {
                const v2u lo = tr_read(vb + 16 * vt), hi = tr_read(vb + 16 * KS_P + 16 * vt);
                const v4u aw = {lo.x, lo.y, hi.x, hi.y};
                O[vt] = MFMA16(__builtin_bit_cast(bf16x8, aw), pf, O[vt]);
            }
        }
    }
}

template <int NT> __device__ __forceinline__ void tail_gemm(LAS unsigned char* lds, const bf16* A, const bf16* Bt, int K, int n0, int rowhalf, f32x4 (&acc)[NT], int tidx) {
    int tid_o = tidx; asm volatile("" : "+v"(tid_o));
    const int lane = tid_o & 63, wave = __builtin_amdgcn_readfirstlane(tid_o >> 6), fr = lane & 15, fq = lane >> 4;
    const int rt = wave & 3, kh = wave >> 2; const int Kh = K >> 1;
    const bf16* ap = A + (size_t)(64 * rowhalf + 16 * rt + fr) * K + kh * Kh + 8 * fq;
    const bf16* bp = Bt + (size_t)(n0 + fr) * K + kh * Kh + 8 * fq;
#pragma unroll
    for (int t = 0; t < NT; ++t) acc[t] = (f32x4){0.f, 0.f, 0.f, 0.f};
    bf16x8 a0[8], b0[NT][8], a1[8], b1[NT][8];
#define TG_LOAD(a_, b_, k0_) do { _Pragma("unroll") for (int s_ = 0; s_ < 8; ++s_) { a_[s_] = *(const bf16x8*)(ap + (k0_) + 32 * s_); _Pragma("unroll") for (int t_ = 0; t_ < NT; ++t_) b_[t_][s_] = *(const bf16x8*)(bp + (size_t)t_ * 16 * K + (k0_) + 32 * s_); } } while (0)
#define TG_MMA(a_, b_) do { _Pragma("unroll") for (int s_ = 0; s_ < 8; ++s_) { _Pragma("unroll") for (int t_ = 0; t_ < NT; ++t_) acc[t_] = MFMA16(b_[t_][s_], a_[s_], acc[t_]); } } while (0)
    TG_LOAD(a0, b0, 0);
    for (int k0 = 0; k0 < Kh; k0 += 512) {
        if (k0 + 256 < Kh) TG_LOAD(a1, b1, k0 + 256);
        TG_MMA(a0, b0);
        if (k0 + 256 < Kh) { if (k0 + 512 < Kh) TG_LOAD(a0, b0, k0 + 512); TG_MMA(a1, b1); }
    }
#undef TG_LOAD
#undef TG_MMA
    LAS f32x4* red = (LAS f32x4*)lds;
    if (kh == 1) {
#pragma unroll
        for (int t = 0; t < NT; ++t) red[(t * 4 + rt) * 64 + lane] = acc[t];
    }
    __syncthreads();
    if (kh == 0) {
#pragma unroll
        for (int t = 0; t < NT; ++t) acc[t] += red[(t * 4 + rt) * 64 + lane];
    }
    __syncthreads();
}

__device__ __forceinline__ void kmean_items(LAS unsigned char* lds, const float* cache_k_, const int* ptab_, float* Kms_, int i0, int i1, int c0, int cn, int tidx) {
    int tid_o = tidx; asm volatile("" : "+v"(tid_o)); const int tid = tid_o;
    const int me = (int)blockIdx.x - c0; if (me < 0 || me >= cn) return;
    LAS f32x4* redk = (LAS f32x4*)(lds);
    for (int item = i0 + me; item < i1; item += cn) {
        const int b = item >> 5, n = item & 31; const int c4 = tid & 127, rg = tid >> 7;
        f32x4 a = {0.f, 0.f, 0.f, 0.f};
#pragma unroll
        for (int hp = 0; hp < 2; ++hp) { const int page = ptab_[b * NPAGES + 2 * n + hp]; const f32x4* pp = (const f32x4*)(cache_k_ + (size_t)page * PAGE * 512) + c4;
#pragma unroll 16
            for (int r = rg; r < 128; r += 4) a += __builtin_nontemporal_load(pp + (size_t)r * 128); }
        redk[rg * 128 + c4] = a;
        __syncthreads();
        if (tid < 128) { const f32x4 s4 = (redk[tid] + redk[128 + tid]) + (redk[256 + tid] + redk[384 + tid]); *(f32x4*)(Kms_ + (size_t)item * 512 + 4 * tid) = s4 * (1.0f / 256.0f); }
        __syncthreads();
    }
}

__global__ void __launch_bounds__(NTHR, 2) yoco_fwd(Args args) {
    extern __shared__ __attribute__((aligned(16))) unsigned char lds_raw[];
    LAS unsigned char* lds = (LAS unsigned char*)lds_raw;
#define TIDS int tid_o = TIDX; asm volatile("" : "+v"(tid_o)); const int tid = tid_o, lane = tid & 63, wave = __builtin_amdgcn_readfirstlane(tid >> 6), fr = lane & 15, fq = lane >> 4; (void)fr; (void)fq; (void)wave; (void)lane; (void)tid
    const int G = gridDim.x, bid = blockIdx.x;
    unsigned char* ws = args.ws;
    unsigned* ctl = (unsigned*)(ws + WS_CTL);
    volatile LAS unsigned* MISC = (volatile LAS unsigned*)(lds + MISC_OFF);
    const int wave_sg = __builtin_amdgcn_readfirstlane((int)threadIdx.x & ~63);
#define TIDX (wave_sg + lane_id())
#define IS_T0 ((wave_sg == 0) && (lane_id() == 0))
    if (TIDX < 64) MISC[TIDX] = 0u;
    __syncthreads();
    XcdBarrier bar = xcd_barrier_post(ctl + CW_BAR, MISC + 8, IS_T0);
#ifdef PROF_A
    int n_stamp = 0;
#define STAMP() do { if (blockIdx.x == 0 && IS_T0) MISC[16 + n_stamp] = (unsigned)__builtin_amdgcn_s_memrealtime(); ++n_stamp; } while (0)
#define TNOW() ((unsigned)__builtin_amdgcn_s_memrealtime())
#define TACC(k, t0) do { if (blockIdx.x == 0 && IS_T0) MISC[40 + (k)] += TNOW() - (t0); } while (0)
#define PVAL(a0, a1) (((a0) >= 100) ? MISC[40 + (a0) - 100] : (MISC[16 + (a1)] - MISC[16 + (a0)]))
#else
#define STAMP() do {} while (0)
#define TNOW() 0u
#define TACC(k, t0) do { (void)(t0); } while (0)
#endif
    STAMP();

#define x_p ((const float*)args.in[0])
#define x_s ((const float*)args.in[1])
#define st_in ((const float*)args.in[2])
#define cache_k ((const float*)args.in[3])
#define cache_v ((const float*)args.in[4])
#define ptab ((const int*)args.in[5])
#define norm_mix_a ((const float*)args.in[6])
#define w_in ((const float*)args.in[7])
#define lbl ((const float*)args.in[8])
#define onorm ((const float*)args.in[9])
#define w_out ((const float*)args.in[10])
#define norm_kv ((const float*)args.in[11])
#define w_kv ((const float*)args.in[12])
#define k_norm ((const float*)args.in[13])
#define norm_mix_b ((const float*)args.in[14])
#define w_q ((const float*)args.in[15])
#define q_norm ((const float*)args.in[16])
#define w_o ((const float*)args.in[17])
#define norm_ffn ((const float*)args.in[18])
#define w_gu ((const float*)args.in[19])
#define w_dn ((const float*)args.in[20])
#define Win_t ((bf16*)(ws + WS_WIN))
#define Wout_t ((bf16*)(ws + WS_WOUT))
#define Wgu0_t ((bf16*)(ws + WS_WGU0))
#define Wdn0_t ((bf16*)(ws + WS_WDN0))
#define Wkvq_t ((bf16*)(ws + WS_WKVQ))
#define Wo_t ((bf16*)(ws + WS_WO))
#define Wgu1_t ((bf16*)(ws + WS_WGU1))
#define Wdn1_t ((bf16*)(ws + WS_WDN1))
#define Hb0 ((bf16*)(ws + WS_HB0))
#define Hb1 ((bf16*)(ws + WS_HB1))
#define Hb2 ((bf16*)(ws + WS_HB2))
#define Hb3 ((bf16*)(ws + WS_HB3))
#define Hf1 ((float*)(ws + WS_HF1))
#define Hf2 ((float*)(ws + WS_HF2))
#define Hf3 ((float*)(ws + WS_HF3))
#define Qg ((bf16*)(ws + WS_QG))
#define Vg ((bf16*)(ws + WS_VG))
#define Gg ((bf16*)(ws + WS_GG))
#define Ff ((f16*)(ws + WS_F))
#define Ob ((bf16*)(ws + WS_OB))
#define At ((bf16*)(ws + WS_AT))
#define Hm ((bf16*)(ws + WS_HM))
#define Ub ((bf16*)(ws + WS_U))
#define Sst ((bf16*)(ws + WS_SST))
#define Dec ((float*)(ws + WS_DEC))
#define Kraw ((float*)(ws + WS_KRAW))
#define Vraw ((float*)(ws + WS_VRAW))
#define Qraw ((bf16*)(ws + WS_QRAW))
#define Kb ((bf16*)(ws + WS_KB))
#define Vb ((bf16*)(ws + WS_VB))
#define Qb ((bf16*)(ws + WS_QB))
#define Kpart ((float*)(ws + WS_KPART))
#define Kms ((float*)(ws + WS_KMS))
#define Subl ((unsigned*)(ws + WS_SUBL))
#define Scnt ((unsigned*)(ws + WS_SCNT))
#define Sels ((unsigned*)(ws + WS_SCNT + 256 * 1024))
#define Oslot ((bf16*)(ws + WS_OSLOT))
#define MLslot ((float*)(ws + WS_MLSLOT))
#define Sslot ((float*)(ws + WS_SSLOT))
#define ss0 ((float*)(ctl + CW_SS0))
#define ss1 ((float*)(ctl + CW_SS1))
#define ss2 ((float*)(ctl + CW_SS2))
#define ss3 ((float*)(ctl + CW_SS3))
#define out (args.out)
    {
        TIDS;
        LAS float* scr = (LAS float*)(lds + wave * 17408);
        const int gw = bid * NWAVES + wave, NGW = G * NWAVES;
        constexpr int I_IN = 32 * 128, I_SQ = 32 * 32, I_GU = 32 * 176, I_DN = 88 * 32, I_KV = 32 * 16;
        constexpr int NITEMS = I_IN + I_SQ + 2 * I_GU + 2 * I_DN + I_KV + I_SQ + I_SQ;
        for (int it = gw; it < NITEMS; it += NGW) {
            int r = it;
            if (r < I_IN) { p0_transpose_item(w_in, D, 4 * D, Win_t, 0, 0, norm_mix_a, scr, r, lane); continue; } r -= I_IN;
            if (r < I_SQ) { p0_transpose_item(w_out, D, D, Wout_t, 0, 0, nullptr, scr, r, lane); continue; } r -= I_SQ;
            if (r < I_GU) { p0_transpose_item(w_gu, D, NGU, Wgu0_t, 0, 1, norm_ffn, scr, r, lane); continue; } r -= I_GU;
            if (r < I_GU) { p0_transpose_item(w_gu + (size_t)D * NGU, D, NGU, Wgu1_t, 0, 1, norm_ffn + D, scr, r, lane); continue; } r -= I_GU;
            if (r < I_DN) { p0_transpose_item(w_dn, DFF, D, Wdn0_t, 0, 0, nullptr, scr, r, lane); continue; } r -= I_DN;
            if (r < I_DN) { p0_transpose_item(w_dn + (size_t)DFF * D, DFF, D, Wdn1_t, 0, 0, nullptr, scr, r, lane); continue; } r -= I_DN;
            if (r < I_KV) { p0_transpose_item(w_kv, D, 1024, Wkvq_t, 0, 0, norm_kv, scr, r, lane); continue; } r -= I_KV;
            if (r < I_SQ) { p0_transpose_item(w_q, D, D, Wkvq_t, 1024, 0, norm_mix_b, scr, r, lane); continue; } r -= I_SQ;
            p0_transpose_item(w_o, D, D, Wo_t, 0, 0, nullptr, scr, r, lane);
        }
        for (int m = gw; m < MR; m += NGW) {
            const float* src = (m < SEQ) ? x_p + (size_t)m * D : x_s + (size_t)(m - SEQ) * D;
            const f32x4* xr = (const f32x4*)src + lane; f32x4 v[8]; float s = 0.f;
#pragma unroll
            for (int j = 0; j < 8; ++j) { v[j] = __builtin_nontemporal_load(xr + 64 * j); s += (v[j].x * v[j].x + v[j].y * v[j].y) + (v[j].z * v[j].z + v[j].w * v[j].w); }
            s = wave_sum(s);
            if (lane == 0) ss0[m] = s;
            v2u* o8 = (v2u*)(Hb0 + (size_t)m * D) + lane;
#pragma unroll
            for (int j = 0; j < 8; ++j) { v2u w; w.x = pk2(v[j].x, v[j].y); w.y = pk2(v[j].z, v[j].w); o8[64 * j] = w; }
        }
        __syncthreads();
        kmean_items(lds, cache_k, ptab, Kms, 848, DECB * NBLK, 0, G, TIDX);
    }
    xcd_barrier(bar, IS_T0);
    STAMP();

    {
        TIDS;
        pg8::Gemm g{Hb0, Win_t, SEQ, 4 * D, D}; pg8::StaticOrder S; S.init(SEQ, 4 * D, G, bid);
        EpiIn E{ss0, lbl, Qg, Ff};
        pg8::gemm_phase<EpiIn, pg8::StaticOrder, true, true, false>(lds, g, S, E, TIDX);
        for (int it2 = 0; it2 < 2; ++it2) {
            const int w2 = bid + 256 * it2, t2 = w2 & 255, rh = (w2 >> 8) & 1;
            TIDS; f32x4 ta[2]; tail_gemm<2>(lds, Hb0 + (size_t)SEQ * D, Win_t, D, 32 * t2, rh, ta, TIDX);
            if (wave < 4) { const int row = SEQ + 64 * rh + 16 * wave + fr; E.tail(row, 32 * t2 + 4 * fq, ta[0]); E.tail(row, 32 * t2 + 16 + 4 * fq, ta[1]); }
        }
    }
    xcd_barrier(bar, IS_T0);
    STAMP();

    {
        TIDS;
        LAS float* tot = (LAS float*)(lds);
        LAS bf16* koT = (LAS bf16*)(lds + 4096);
        LAS bf16* Vr = (LAS bf16*)(lds + 4096 + 128 * 72 * 2);
        const int col = tid & 127, part = tid >> 7; const int vt_t = tid >> 3, vd0 = (tid & 7) * 16;
        f16 fN[16]; v4u vaN, vbN;
#define P2_LOADN(it_) do { const int h_ = (it_) >> 7, r0_ = ((it_) & 127) * 64; const f16* fp_ = Ff + (size_t)(r0_ + part * 16) * D + h_ * 128 + col; \
            _Pragma("unroll") for (int i = 0; i < 16; ++i) fN[i] = fp_[(size_t)i * D]; \
            const bf16* vp_ = Vg + (size_t)(r0_ + vt_t) * D + h_ * 128 + vd0; vaN = *(const v4u*)vp_; vbN = *(const v4u*)(vp_ + 8); } while (0)
        if (bid < NH * NCHUNK) P2_LOADN(bid);
        for (int item = bid; item < NH * NCHUNK; item += G) {
            float cum[16], kk[16]; float run = 0.f;
#pragma unroll
            for (int i = 0; i < 16; ++i) { const float f = (float)fN[i]; kk[i] = 1.0f - f; run += __logf(f); cum[i] = run; }
            tot[part * 128 + col] = run;
            *(LAS v4u*)(Vr + vt_t * 144 + vd0) = vaN; *(LAS v4u*)(Vr + vt_t * 144 + vd0 + 8) = vbN;
            if (item + G < NH * NCHUNK) P2_LOADN(item + G);
            __syncthreads();
            float offs = 0.f, lastv = 0.f;
#pragma unroll
            for (int p = 0; p < 4; ++p) { const float tv = tot[p * 128 + col]; lastv += tv; if (p < part) offs += tv; }
            unsigned kw[8];
#pragma unroll
            for (int i = 0; i < 8; ++i) { const float a = kk[2 * i] * __expf(lastv - (cum[2 * i] + offs)), b = kk[2 * i + 1] * __expf(lastv - (cum[2 * i + 1] + offs)); kw[i] = pk2(a, b); }
            *(LAS v4u*)(koT + col * 72 + part * 16) = (v4u){kw[0], kw[1], kw[2], kw[3]};
            *(LAS v4u*)(koT + col * 72 + part * 16 + 8) = (v4u){kw[4], kw[5], kw[6], kw[7]};
            if (part == 0) Dec[(size_t)item * 128 + col] = __expf(lastv);
            __syncthreads();
            { bf16x8 a[2]; a[0] = *(const LAS bf16x8*)(koT + (16 * wave + fr) * 72 + 8 * fq); a[1] = *(const LAS bf16x8*)(koT + (16 * wave + fr) * 72 + 32 + 8 * fq);
              bf16* ub = Ub + (size_t)item * 16384;
              const LAS bf16* vb = Vr + (8 * fq + (fr >> 2)) * 144 + 4 * (fr & 3);
#pragma unroll
              for (int vt = 0; vt < 8; ++vt) {
                  f32x4 acc = {0.f, 0.f, 0.f, 0.f};
                  const v2u l0 = tr_read(vb + 16 * vt), h0 = tr_read(vb + 4 * 144 + 16 * vt), l1 = tr_read(vb + 32 * 144 + 16 * vt), h1 = tr_read(vb + 36 * 144 + 16 * vt);
                  const v4u b0 = {l0.x, l0.y, h0.x, h0.y}, b1 = {l1.x, l1.y, h1.x, h1.y};
                  acc = MFMA16(a[0], __builtin_bit_cast(bf16x8, b0), acc); acc = MFMA16(a[1], __builtin_bit_cast(bf16x8, b1), acc);
                  v2u w; w.x = pk2(acc[0], acc[1]); w.y = pk2(acc[2], acc[3]);
                  *(v2u*)(ub + (size_t)(16 * vt + fr) * 128 + 16 * wave + 4 * fq) = w;
              } }
            __syncthreads();
        }
#undef P2_LOADN
        LAS float* red = (LAS float*)(lds);
        LAS float* red2 = (LAS float*)(lds + 8192);
        float* st_out = out + OST_S;
        for (int item = bid; item < DECB * NH; item += G) {
            const int b = item >> 4, h = item & 15; const int vd = tid & 127, kq = tid >> 7;
            const float* sp = st_in + ((size_t)(b * NH + h) * 128 + 32 * kq) * 128 + vd;
            float Sx[32];
#pragma unroll
            for (int i = 0; i < 32; ++i) Sx[i] = __builtin_nontemporal_load(sp + (size_t)i * 128);
#pragma unroll
            for (int t = 0; t < 4; ++t) {
                const int row = SEQ + 4 * b + t; const size_t ro = (size_t)row * D + h * 128;
                const float v = bf2f(Vg[ro + vd]); float op = 0.f;
#pragma unroll
                for (int i = 0; i < 32; ++i) { const float f = (float)Ff[ro + 32 * kq + i]; const float q = bf2f(Qg[ro + 32 * kq + i]); Sx[i] = f * Sx[i] + (1.0f - f) * v; op += Sx[i] * q; }
                red[(t * 4 + kq) * 128 + vd] = op;
            }
            float* so = st_out + ((size_t)(b * NH + h) * 128 + 32 * kq) * 128 + vd;
#pragma unroll
            for (int i = 0; i < 32; ++i) __builtin_nontemporal_store(Sx[i], so + (size_t)i * 128);
            __syncthreads();
            { const int t = tid >> 7; const float o = (red[(t * 4 + 0) * 128 + vd] + red[(t * 4 + 1) * 128 + vd]) + (red[(t * 4 + 2) * 128 + vd] + red[(t * 4 + 3) * 128 + vd]);
              const float s = wave_sum(o * o); if (lane == 0) red2[t * 2 + (wave & 1)] = s;
              __syncthreads();
              const float r = rsqrtf((red2[t * 2] + red2[t * 2 + 1]) * (1.0f / 128.0f) + EPS);
              const int row = SEQ + 4 * b + t; const size_t ro = (size_t)row * D + h * 128 + vd;
              Ob[ro] = (bf16)f2bf(o * r * onorm[vd] * bf2f(Gg[ro])); }
            __syncthreads();
        }
    }
    xcd_barrier(bar, IS_T0);
    STAMP();

    {
        TIDS;
        for (int gid = bid * NTHR + tid; gid < NH * 128 * 32; gid += G * NTHR) {
            const int h = gid >> 12, rem = gid & 4095, vd = rem >> 5, k = (rem & 31) * 4;
            float s0 = 0.f, s1 = 0.f, s2 = 0.f, s3 = 0.f;
            const v2u* up = (const v2u*)(Ub + ((size_t)h * 128 * 128 + vd) * 128 + k);
            v2u* sp = (v2u*)(Sst + ((size_t)h * 128 * 128 + vd) * 128 + k);
            const f32x4* dp = (const f32x4*)(Dec + (size_t)h * 128 * 128 + k);
#pragma unroll 16
            for (int c = 0; c < NCHUNK; ++c) {
                const v2u u = up[(size_t)c * 4096]; const f32x4 d = dp[(size_t)c * 32];
                v2u w; w.x = pk2(s0, s1); w.y = pk2(s2, s3); sp[(size_t)c * 4096] = w;
                s0 = d.x * s0 + bf2f(u.x & 0xffffu); s1 = d.y * s1 + bf2f(u.x >> 16); s2 = d.z * s2 + bf2f(u.y & 0xffffu); s3 = d.w * s3 + bf2f(u.y >> 16);
            }
            float* so = out + OST_P + ((size_t)h * 128 + k) * 128 + vd;
            so[0] = s0; so[128] = s1; so[256] = s2; so[384] = s3;
        }
    }
    xcd_barrier(bar, IS_T0);
    STAMP();

    {
        TIDS;
        LAS float* tot = (LAS float*)(lds);
        LAS float* refs = (LAS float*)(lds + 2048);
        LAS float* red = (LAS float*)(lds + 2560);
        LAS bf16* QE = (LAS bf16*)(lds + 4096);
        LAS bf16* KE = QE + 64 * 136;
        LAS bf16* QI = KE + 64 * 136;
        LAS bf16* Vr = QI + 64 * 136;
        LAS bf16* STs = Vr + 64 * 144;
        const int col = tid & 127, part = tid >> 7; const int vt_t = tid >> 3, vd0 = (tid & 7) * 16;
        const int tt = wave & 3, vh = wave >> 2;
        f16 fN[16]; bf16 qN[16]; v4u vaN, vbN, stN[4];
#define P4_LOADN(it_) do { const int h_ = (it_) >> 7, r0_ = ((it_) & 127) * 64; const f16* fp_ = Ff + (size_t)(r0_ + part * 16) * D + h_ * 128 + col; const bf16* qp_ = Qg + (size_t)(r0_ + part * 16) * D + h_ * 128 + col; \
            _Pragma("unroll") for (int i = 0; i < 16; ++i) { fN[i] = fp_[(size_t)i * D]; qN[i] = qp_[(size_t)i * D]; } \
            const bf16* vp_ = Vg + (size_t)(r0_ + vt_t) * D + h_ * 128 + vd0; vaN = *(const v4u*)vp_; vbN = *(const v4u*)(vp_ + 8); \
            const v4u* sp_ = (const v4u*)(Sst + (size_t)(it_) * 16384); _Pragma("unroll") for (int i = 0; i < 4; ++i) stN[i] = sp_[i * 512 + tid]; } while (0)
        if (bid < NH * NCHUNK) P4_LOADN(bid);
        for (int item = bid; item < NH * NCHUNK; item += G) {
            const int h = item >> 7, c = item & 127; const int row0 = c * 64;
            float cum[16], kk[16], qv[16]; float run = 0.f;
#pragma unroll
            for (int i = 0; i < 16; ++i) { const float f = (float)fN[i]; kk[i] = 1.0f - f; run += __logf(f); cum[i] = run; qv[i] = bf2f(qN[i]); }
            tot[part * 128 + col] = run;
            *(LAS v4u*)(Vr + vt_t * 144 + vd0) = vaN; *(LAS v4u*)(Vr + vt_t * 144 + vd0 + 8) = vbN;
#pragma unroll
            for (int i = 0; i < 4; ++i) { const int idx = i * 512 + tid, vd = idx >> 4, k8 = idx & 15; *(LAS v4u*)(STs + vd * 136 + k8 * 8) = stN[i]; }
            const size_t ro = (size_t)(row0 + 16 * tt + fr) * D + h * 128;
            v2u gw2[4]; f32x4 on[4];
#pragma unroll
            for (int vt = 0; vt < 4; ++vt) { const int vd = 16 * (4 * vh + vt) + 4 * fq; gw2[vt] = *(const v2u*)(Gg + ro + vd); on[vt] = *(const f32x4*)(onorm + vd); }
            if (item + G < NH * NCHUNK) P4_LOADN(item + G);
            __syncthreads();
            float offs = 0.f;
#pragma unroll
            for (int p = 0; p < 4; ++p) { const float tv = tot[p * 128 + col]; if (p < part) offs += tv; }
            if (part == 1) refs[col] = cum[15] + offs;
            __syncthreads();
            const float ref = refs[col];
#pragma unroll
            for (int i = 0; i < 16; ++i) { const float cm = cum[i] + offs, d1 = cm - ref; const int t = part * 16 + i;
                QE[t * 136 + col] = (bf16)f2bf(qv[i] * __expf(d1)); KE[t * 136 + col] = (bf16)f2bf(kk[i] * __expf(-d1)); QI[t * 136 + col] = (bf16)f2bf(qv[i] * __expf(cm)); }
            __syncthreads();
            {
                f32x4 aS[4];
#pragma unroll
                for (int st = 0; st < 4; ++st) {
                    aS[st] = (f32x4){0.f, 0.f, 0.f, 0.f};
                    if (st <= tt) {
#pragma unroll
                        for (int ks = 0; ks < 4; ++ks) { const bf16x8 a = *(const LAS bf16x8*)(KE + (16 * st + fr) * 136 + 32 * ks + 8 * fq), b = *(const LAS bf16x8*)(QE + (16 * tt + fr) * 136 + 32 * ks + 8 * fq); aS[st] = MFMA16(a, b, aS[st]); }
                        if (st == tt) {
#pragma unroll
                            for (int r = 0; r < 4; ++r) if (4 * fq + r > fr) aS[st][r] = 0.f;
                        }
                    }
                }
                f32x4 o[4];
#pragma unroll
                for (int vt = 0; vt < 4; ++vt) o[vt] = (f32x4){0.f, 0.f, 0.f, 0.f};
#pragma unroll
                for (int j = 0; j < 2; ++j) {
                    v4u pw; pw.x = cvt_pk_bf16(aS[2 * j][0], aS[2 * j][1]); pw.y = cvt_pk_bf16(aS[2 * j][2], aS[2 * j][3]); pw.z = cvt_pk_bf16(aS[2 * j + 1][0], aS[2 * j + 1][1]); pw.w = cvt_pk_bf16(aS[2 * j + 1][2], aS[2 * j + 1][3]);
                    const bf16x8 pf = __builtin_bit_cast(bf16x8, pw);
                    const LAS bf16* vb = Vr + (32 * j + 4 * fq + (fr >> 2)) * 144 + 64 * vh + 4 * (fr & 3);
#pragma unroll
                    for (int vt = 0; vt < 4; ++vt) { const v2u lo = tr_read(vb + 16 * vt), hi = tr_read(vb + 16 * 144 + 16 * vt); const v4u aw = {lo.x, lo.y, hi.x, hi.y};
                        o[vt] = MFMA16(__builtin_bit_cast(bf16x8, aw), pf, o[vt]); }
                }
#pragma unroll
                for (int ks = 0; ks < 4; ++ks) { const bf16x8 b = *(const LAS bf16x8*)(QI + (16 * tt + fr) * 136 + 32 * ks + 8 * fq);
#pragma unroll
                    for (int vt = 0; vt < 4; ++vt) { const bf16x8 a = *(const LAS bf16x8*)(STs + (16 * (4 * vh + vt) + fr) * 136 + 32 * ks + 8 * fq); o[vt] = MFMA16(a, b, o[vt]); } }
                float sq = 0.f;
#pragma unroll
                for (int vt = 0; vt < 4; ++vt) sq += (o[vt][0] * o[vt][0] + o[vt][1] * o[vt][1]) + (o[vt][2] * o[vt][2] + o[vt][3] * o[vt][3]);
                sq += shx<16>(sq); sq = xadd32(sq);
                if (fq == 0) red[(16 * tt + fr) * 2 + vh] = sq;
                __syncthreads();
                const float r = rsqrtf((red[(16 * tt + fr) * 2] + red[(16 * tt + fr) * 2 + 1]) * (1.0f / 128.0f) + EPS);
#pragma unroll
                for (int vt = 0; vt < 4; ++vt) { const int vd = 16 * (4 * vh + vt) + 4 * fq;
                    const float g0 = bf2f(gw2[vt].x & 0xffffu), g1 = bf2f(gw2[vt].x >> 16), g2 = bf2f(gw2[vt].y & 0xffffu), g3 = bf2f(gw2[vt].y >> 16);
                    v2u w; w.x = cvt_pk_bf16(o[vt][0] * r * on[vt][0] * g0, o[vt][1] * r * on[vt][1] * g1); w.y = cvt_pk_bf16(o[vt][2] * r * on[vt][2] * g2, o[vt][3] * r * on[vt][3] * g3);
                    *(v2u*)(Ob + ro + vd) = w; }
            }
            __syncthreads();
        }
#undef P4_LOADN
    }
    xcd_barrier(bar, IS_T0);
    STAMP();

    {
        TIDS;
        pg8::Gemm g{Ob, Wout_t, SEQ, D, D}; pg8::StaticOrder S; S.init(SEQ, D, G, bid);
        EpiRes<1> E{Hb0, nullptr, nullptr, Hb1, ss1};
        const unsigned tg0 = TNOW();
        pg8::gemm_phase<EpiRes<1>, pg8::StaticOrder, true, true, false>(lds, g, S, E, TIDX);
        TACC(5, tg0); const unsigned tg1 = TNOW();
        { const int t2 = bid & 127, rh = (bid >> 7) & 1; TIDS; f32x4 ta[1]; tail_gemm<1>(lds, Ob + (size_t)SEQ * D, Wout_t, D, 16 * t2, rh, ta, TIDX); if (wave < 4) E.tail(SEQ + 64 * rh + 16 * wave + fr, 16 * t2 + 4 * fq, ta[0], fq); }
        TACC(6, tg1);
    }
    xcd_barrier(bar, IS_T0);
    STAMP();
    {
        TIDS;
        pg8::Gemm g{Hb1, Wgu0_t, MP, NGU, D}; pg8::StaticOrder S; S.init(MP, NGU, G, bid);
        EpiGU E{ss1, Hm};
        pg8::gemm_phase<EpiGU, pg8::StaticOrder, true, true>(lds, g, S, E, TIDX);
        kmean_items(lds, cache_k, ptab, Kms, 0, 336, 172, G - 172, TIDX);
    }
    xcd_barrier(bar, IS_T0);
    STAMP();
    {
        TIDS;
        pg8::Gemm g{Hm, Wdn0_t, SEQ, D, DFF}; pg8::StaticOrder S; S.init(SEQ, D, G, bid);
        EpiRes<1> E{Hb1, nullptr, nullptr, Hb2, ss2};
        const unsigned tg0 = TNOW();
        pg8::gemm_phase<EpiRes<1>, pg8::StaticOrder, true, true, false>(lds, g, S, E, TIDX);
        TACC(7, tg0); const unsigned tg1 = TNOW();
        { const int t2 = bid & 127, rh = (bid >> 7) & 1; TIDS; f32x4 ta[1]; tail_gemm<1>(lds, Hm + (size_t)SEQ * DFF, Wdn0_t, DFF, 16 * t2, rh, ta, TIDX); if (wave < 4) E.tail(SEQ + 64 * rh + 16 * wave + fr, 16 * t2 + 4 * fq, ta[0], fq); }
        TACC(8, tg1);
    }
    xcd_barrier(bar, IS_T0);
    STAMP();
    {
        TIDS;
        pg8::Gemm g{Hb2, Wkvq_t, MP, 3072, D}; pg8::StaticOrder S; S.init(MP, 3072, G, bid);
        EpiKVQ E{ss2, ws, out, k_norm, q_norm, lds + 131072};
        pg8::gemm_phase<EpiKVQ, pg8::StaticOrder, true, true>(lds, g, S, E, TIDX);
        kmean_items(lds, cache_k, ptab, Kms, 336, 848, 140, G - 140, TIDX);
    }
    xcd_barrier(bar, IS_T0);
    STAMP();

    {
        TIDS;
        LAS bf16* KMb = (LAS bf16*)(lds);
        LAS unsigned* lcnt = (LAS unsigned*)(lds + 16384);
        LAS float* gs = (LAS float*)(lds + 16384 + 256);
#define G_BETTER(va, ia, vb, ib) (((va) > (vb)) || (((va) == (vb)) && ((ia) < (ib))))
#define G_INSERT(vx, ix) do { const float vx_ = (vx); const int ix_ = (ix); \
            if (G_BETTER(vx_, ix_, v0, i0)) { v2 = v1; i2 = i1; v1 = v0; i1 = i0; v0 = vx_; i0 = ix_; } \
            else if (G_BETTER(vx_, ix_, v1, i1)) { v2 = v1; i2 = i1; v1 = vx_; i1 = ix_; } \
            else if (G_BETTER(vx_, ix_, v2, i2)) { v2 = vx_; i2 = ix_; } } while (0)
        for (int item = bid; item < 256; item += G) {
            const int j = item >> 2, kvh = item & 3; const int b = j >> 1;
            { const int n = tid >> 4, d8 = (tid & 15) * 8; f32x4 s0 = {0.f, 0.f, 0.f, 0.f}, s1 = {0.f, 0.f, 0.f, 0.f};
              if (n < b) { const float* kp = Kpart + (size_t)n * 512 + kvh * 128 + d8; s0 = *(const f32x4*)kp; s1 = *(const f32x4*)(kp + 4); }
              s0 = s0 * (1.0f / 256.0f); s1 = s1 * (1.0f / 256.0f);
              v4u w; w.x = cvt_pk_bf16(s0[0], s0[1]); w.y = cvt_pk_bf16(s0[2], s0[3]); w.z = cvt_pk_bf16(s1[0], s1[1]); w.w = cvt_pk_bf16(s1[2], s1[3]);
              *(LAS v4u*)(KMb + n * 136 + d8) = w; }
            if (tid < 32) lcnt[tid] = 0u;
            __syncthreads();
            const int nsel = b < 3 ? b : 3;
#pragma unroll 1
            for (int rt = 0; rt < 4; ++rt) {
                const int r = 64 * wave + 16 * rt + fr; const int tok = j * 128 + (r >> 2), hg = r & 3; const bf16* qp = Qb + (size_t)tok * D + (4 * kvh + hg) * 128 + 8 * fq;
                bf16x8 qf[4];
#pragma unroll
                for (int ks = 0; ks < 4; ++ks) qf[ks] = *(const bf16x8*)(qp + 32 * ks);
                f32x4 ga[2];
#pragma unroll
                for (int nt = 0; nt < 2; ++nt) { ga[nt] = (f32x4){0.f, 0.f, 0.f, 0.f};
#pragma unroll
                    for (int ks = 0; ks < 4; ++ks) { const bf16x8 ka = *(const LAS bf16x8*)(KMb + (16 * nt + fr) * 136 + 32 * ks + 8 * fq); ga[nt] = MFMA16(ka, qf[ks], ga[nt]); } }
                float v0 = -INFINITY, v1 = -INFINITY, v2 = -INFINITY; int i0 = 99, i1 = 99, i2 = 99;
#pragma unroll
                for (int nt = 0; nt < 2; ++nt)
#pragma unroll
                    for (int q = 0; q < 4; ++q) { const int n = 16 * nt + 4 * fq + q; if (n < b) G_INSERT(ga[nt][q], n); }
                { const float a0 = shx<16>(v0), a1 = shx<16>(v1), a2 = shx<16>(v2);
                  const int c0 = __builtin_amdgcn_ds_swizzle(i0, (16 << 10) | 0x1f), c1 = __builtin_amdgcn_ds_swizzle(i1, (16 << 10) | 0x1f), c2 = __builtin_amdgcn_ds_swizzle(i2, (16 << 10) | 0x1f);
                  G_INSERT(a0, c0); G_INSERT(a1, c1); G_INSERT(a2, c2); }
                {
                  auto p0 = __builtin_amdgcn_permlane32_swap(__float_as_uint(v0), __float_as_uint(v0), false, false); auto p1 = __builtin_amdgcn_permlane32_swap(__float_as_uint(v1), __float_as_uint(v1), false, false);
                  auto p2 = __builtin_amdgcn_permlane32_swap(__float_as_uint(v2), __float_as_uint(v2), false, false);
                  auto q0 = __builtin_amdgcn_permlane32_swap((unsigned)i0, (unsigned)i0, false, false); auto q1 = __builtin_amdgcn_permlane32_swap((unsigned)i1, (unsigned)i1, false, false);
                  auto q2 = __builtin_amdgcn_permlane32_swap((unsigned)i2, (unsigned)i2, false, false);
                  v0 = __uint_as_float(p0[0]); v1 = __uint_as_float(p1[0]); v2 = __uint_as_float(p2[0]); i0 = (int)q0[0]; i1 = (int)q1[0]; i2 = (int)q2[0];
                  G_INSERT(__uint_as_float(p0[1]), (int)q0[1]); G_INSERT(__uint_as_float(p1[1]), (int)q1[1]); G_INSERT(__uint_as_float(p2[1]), (int)q2[1]); }
                if (fq == 0) {
#pragma unroll
                    for (int rk = 0; rk < 3; ++rk) {
                        if (rk < nsel) { const int best = (rk == 0) ? i0 : ((rk == 1) ? i1 : i2);
                            const unsigned pos = atomicAdd((unsigned*)&lcnt[best], 1u);
                            Subl[((size_t)(j * 4 + kvh) * 32 + best) * 512 + pos] = (unsigned)r | ((unsigned)rk << 9); }
                    }
                }
            }
            __syncthreads();
            if (tid < 32) Scnt[(j * 4 + kvh) * 32 + tid] = lcnt[tid];
            __syncthreads();
        }
#undef G_BETTER
#undef G_INSERT
        for (int item = bid; item < DECB * NKV; item += G) {
            const int b = item >> 2, kvh = item & 3; const int pr = tid >> 5, n = tid & 31;
            const int row = SEQ + 4 * b + (pr >> 2), hg = pr & 3; const bf16* qp = Qb + (size_t)row * D + (4 * kvh + hg) * 128; const float* kmp = Kms + ((size_t)(b * 32 + n)) * 512 + kvh * 128;
            float s = 0.f;
#pragma unroll 4
            for (int d = 0; d < 128; d += 8) { const v4u qw = *(const v4u*)(qp + d); const f32x4 k0 = *(const f32x4*)(kmp + d), k1 = *(const f32x4*)(kmp + d + 4);
                s += (bf2f(qw.x & 0xffffu) * k0[0] + bf2f(qw.x >> 16) * k0[1]) + (bf2f(qw.y & 0xffffu) * k0[2] + bf2f(qw.y >> 16) * k0[3]) + (bf2f(qw.z & 0xffffu) * k1[0] + bf2f(qw.z >> 16) * k1[1]) + (bf2f(qw.w & 0xffffu) * k1[2] + bf2f(qw.w >> 16) * k1[3]); }
            gs[pr * 32 + n] = s;
            __syncthreads();
            if (tid < 16) { unsigned m = 0u;
                for (int r = 0; r < 3; ++r) { int best = 0; float bv = -INFINITY; for (int nn = 0; nn < 32; ++nn) { const float v = gs[tid * 32 + nn]; if (v > bv) { bv = v; best = nn; } } m |= 1u << best; gs[tid * 32 + best] = -INFINITY; }
                Sels[item * 16 + tid] = m; }
            __syncthreads();
        }
    }
    xcd_barrier(bar, IS_T0);
    STAMP();

    {
        LAS bf16* Ks = (LAS bf16*)(lds); LAS bf16* Vs = (LAS bf16*)(lds + KS_BYTES);
        LAS unsigned* qsh = (LAS unsigned*)(lds + 2 * KS_BYTES);
        constexpr int NPI = 4 * 496, NSI = DECB * NKV * NBLK;
        for (;;) {
            const unsigned tq0 = TNOW();
            if (IS_T0) qsh[0] = __hip_atomic_fetch_add(ctl + CW_Q0, 1u, __ATOMIC_RELAXED, __HIP_MEMORY_SCOPE_AGENT);
            __syncthreads();
            const int tick = (int)qsh[0];
            __syncthreads();
            TACC(0, tq0);
            if (tick >= NPI + NSI) break;
            TIDS;
            int item; { const int g3 = tick / 3, r3 = tick - 3 * g3; item = (tick < 3 * NPI) ? ((r3 == 0) ? g3 : NPI + 2 * g3 + (r3 - 1)) : NPI + (tick - NPI); }
            if (item < NPI) {
                int b = (int)((1.0f + sqrtf(1.0f + 2.0f * (float)item)) * 0.5f); while (2 * b * (b - 1) > item) --b; while (2 * (b + 1) * b <= item) ++b;
                const int rem = item - 2 * b * (b - 1); const int n = rem >> 2, kvh = rem & 3;
                const int cntA = (int)Scnt[((2 * b) * 4 + kvh) * 32 + n], cntB = (int)Scnt[((2 * b + 1) * 4 + kvh) * 32 + n]; const int total = cntA + cntB;
                if (total == 0) continue;
                const unsigned tp0 = TNOW();
#pragma unroll
                for (int i = 0; i < 8; ++i) { const int idx = i * 512 + tid, key = idx >> 4, c8 = idx & 15; *(LAS v4u*)(Ks + key * KS_P + c8 * 8) = *(const v4u*)(Kb + (size_t)(256 * n + key) * 512 + kvh * 128 + c8 * 8); }
#pragma unroll
                for (int i = 0; i < 8; ++i) { const int idx = i * 512 + tid, key = idx >> 4, c8 = idx & 15; *(LAS v4u*)(Vs + key * KS_P + c8 * 8) = *(const v4u*)(Vb + (size_t)(256 * n + key) * 512 + kvh * 128 + c8 * 8); }
                __syncthreads();
                TACC(1, tp0); const unsigned tp1 = TNOW();
                const unsigned* LA = Subl + ((size_t)((2 * b) * 4 + kvh) * 32 + n) * 512; const unsigned* LB = Subl + ((size_t)((2 * b + 1) * 4 + kvh) * 32 + n) * 512;
#define LIST_ENT(i_) (((i_) < cntA) ? LA[(i_)] : LB[(i_) - cntA])
                const int iw = 16 * wave + fr;
                unsigned e1 = 0u, e2 = 0u; int ic1 = 0, ic2 = 0;
                if (16 * wave < total) { ic1 = iw < total ? iw : total - 1; e1 = LIST_ENT(ic1); }
                if (16 * wave + 128 < total) { ic2 = iw + 128 < total ? iw + 128 : total - 1; e2 = LIST_ENT(ic2); }
                bf16x8 qn[4];
                { const int tokn = ((ic1 < cntA) ? 2 * b : 2 * b + 1) * 128 + (int)((e1 >> 2) & 127u); const bf16* qp = Qb + (size_t)tokn * D + (4 * kvh + (int)(e1 & 3u)) * 128 + 8 * fq;
#pragma unroll
                  for (int ks = 0; ks < 4; ++ks) qn[ks] = *(const bf16x8*)(qp + 32 * ks); }
                for (int t0 = 0; t0 < total; t0 += 128) {
                    const int i0 = t0 + 16 * wave; if (i0 >= total) break;
                    const bool valid = (i0 + fr) < total; const int ic = ic1; const unsigned e = e1;
                    const int tok = ((ic < cntA) ? 2 * b : 2 * b + 1) * 128 + (int)((e >> 2) & 127u), hg = (int)(e & 3u), rk = (int)(e >> 9);
                    const int h = 4 * kvh + hg;
                    bf16x8 qf[4];
#pragma unroll
                    for (int ks = 0; ks < 4; ++ks) qf[ks] = qn[ks];
                    e1 = e2; ic1 = ic2;
                    if (i0 + 256 < total) { ic2 = (i0 + 256 + fr) < total ? (i0 + 256 + fr) : total - 1; e2 = LIST_ENT(ic2); }
                    if (i0 + 128 < total) { const int tokn = ((ic1 < cntA) ? 2 * b : 2 * b + 1) * 128 + (int)((e1 >> 2) & 127u); const bf16* qp = Qb + (size_t)tokn * D + (4 * kvh + (int)(e1 & 3u)) * 128 + 8 * fq;
#pragma unroll
                        for (int ks = 0; ks < 4; ++ks) qn[ks] = *(const bf16x8*)(qp + 32 * ks); }
                    f32x4 acc[16]; attn_scores<16>(Ks, qf, acc, 16, fr, fq);
                    float mx = -INFINITY;
#pragma unroll
                    for (int kt = 0; kt < 16; ++kt) mx = fmaxf(fmaxf(mx, fmaxf(acc[kt][0], acc[kt][1])), fmaxf(acc[kt][2], acc[kt][3]));
                    mx = fmaxf(mx, shx<16>(mx)); mx = xmax32(mx);
                    float l = 0.f;
#pragma unroll
                    for (int kt = 0; kt < 16; ++kt) {
#pragma unroll
                        for (int r = 0; r < 4; ++r) { const float p = __builtin_amdgcn_exp2f(acc[kt][r] - mx); acc[kt][r] = p; l += p; } }
                    l += shx<16>(l); l = xadd32(l);
                    f32x4 O[8];
#pragma unroll
                    for (int vt = 0; vt < 8; ++vt) O[vt] = (f32x4){0.f, 0.f, 0.f, 0.f};
                    attn_pv(Vs, acc, O, 8, fr, fq);
                    if (valid) {
                        const size_t slot = ((size_t)tok * NH + h) * 3 + rk; bf16* op = Oslot + slot * 128 + 4 * fq;
#pragma unroll
                        for (int vt = 0; vt < 8; ++vt) { v2u w; w.x = cvt_pk_bf16(O[vt][0], O[vt][1]); w.y = cvt_pk_bf16(O[vt][2], O[vt][3]); *(v2u*)(op + 16 * vt) = w; }
                        if (fq == 0) { MLslot[slot * 2] = mx; MLslot[slot * 2 + 1] = l; }
                    }
                }
                __syncthreads();
                TACC(2, tp1);
            } else {
                const int si = item - NPI; const int b = si >> 7, kvh = (si >> 5) & 3, n = si & 31;
                unsigned any = 0u;
#pragma unroll
                for (int p = 0; p < 16; ++p) any |= Sels[(b * 4 + kvh) * 16 + p];
                if (!((any >> n) & 1u)) continue;
                const unsigned ts0 = TNOW();
                const int pg0 = ptab[b * NPAGES + 2 * n], pg1 = ptab[b * NPAGES + 2 * n + 1];
                f32x4 kst[16], vst[16];
#pragma unroll
                for (int i = 0; i < 16; ++i) { const int idx = i * 512 + tid, key = idx >> 5, c4 = idx & 31; const int page = (key < 128) ? pg0 : pg1;
                    const size_t go = (((size_t)page * PAGE + (key & 127)) * NKV + kvh) * 128 + c4 * 4;
                    kst[i] = __builtin_nontemporal_load((const f32x4*)(cache_k + go)); vst[i] = __builtin_nontemporal_load((const f32x4*)(cache_v + go)); }
#pragma unroll
                for (int i = 0; i < 16; ++i) { const int idx = i * 512 + tid, key = idx >> 5, c4 = idx & 31; const int page = (key < 128) ? pg0 : pg1; (void)page;
                    const f32x4 kk4 = kst[i], vv4 = vst[i];
                    v2u w; w.x = cvt_pk_bf16(kk4[0], kk4[1]); w.y = cvt_pk_bf16(kk4[2], kk4[3]); *(LAS v2u*)(Ks + key * KS_P + c4 * 4) = w;
                    v2u wv; wv.x = cvt_pk_bf16(vv4[0], vv4[1]); wv.y = cvt_pk_bf16(vv4[2], vv4[3]); *(LAS v2u*)(Vs + key * KS_P + c4 * 4) = wv; }
                __syncthreads();
                TACC(3, ts0); const unsigned ts1 = TNOW();
                {
                    LAS float* mxs = (LAS float*)(lds + 2 * KS_BYTES + 64); LAS float* lss = mxs + 128; LAS float* Ored = (LAS float*)(lds);
                    const int row = SEQ + 4 * b + (fr >> 2), hg = fr & 3; const int h = 4 * kvh + hg; const bf16* qp = Qb + (size_t)row * D + h * 128 + 8 * fq;
                    bf16x8 qf[4];
#pragma unroll
                    for (int ks = 0; ks < 4; ++ks) qf[ks] = *(const bf16x8*)(qp + 32 * ks);
                    f32x4 a2[2];
#pragma unroll
                    for (int t = 0; t < 2; ++t) { a2[t] = (f32x4){0.f, 0.f, 0.f, 0.f};
#pragma unroll
                        for (int ks = 0; ks < 4; ++ks) { const bf16x8 ka = *(const LAS bf16x8*)(Ks + (16 * (2 * wave + t) + fr) * KS_P + 32 * ks + 8 * fq); a2[t] = MFMA16(ka, qf[ks], a2[t]); } }
                    float mx = fmaxf(fmaxf(fmaxf(a2[0][0], a2[0][1]), fmaxf(a2[0][2], a2[0][3])), fmaxf(fmaxf(a2[1][0], a2[1][1]), fmaxf(a2[1][2], a2[1][3])));
                    mx = fmaxf(mx, shx<16>(mx)); mx = xmax32(mx);
                    if (fq == 0) mxs[wave * 16 + fr] = mx;
                    __syncthreads();
                    float M = mxs[fr];
#pragma unroll
                    for (int w8 = 1; w8 < 8; ++w8) M = fmaxf(M, mxs[w8 * 16 + fr]);
                    float l = 0.f;
#pragma unroll
                    for (int t = 0; t < 2; ++t) {
#pragma unroll
                        for (int r = 0; r < 4; ++r) { const float p = __builtin_amdgcn_exp2f(a2[t][r] - M); a2[t][r] = p; l += p; } }
                    l += shx<16>(l); l = xadd32(l);
                    if (fq == 0) lss[wave * 16 + fr] = l;
                    v4u pw; pw.x = cvt_pk_bf16(a2[0][0], a2[0][1]); pw.y = cvt_pk_bf16(a2[0][2], a2[0][3]); pw.z = cvt_pk_bf16(a2[1][0], a2[1][1]); pw.w = cvt_pk_bf16(a2[1][2], a2[1][3]);
                    const bf16x8 pf = __builtin_bit_cast(bf16x8, pw);
                    const LAS bf16* vb = Vs + (32 * wave + 4 * fq + (fr >> 2)) * KS_P + 4 * (fr & 3);
#pragma unroll
                    for (int vt = 0; vt < 8; ++vt) { const v2u lo = tr_read(vb + 16 * vt), hi = tr_read(vb + 16 * KS_P + 16 * vt); const v4u aw = {lo.x, lo.y, hi.x, hi.y};
                        const f32x4 o = MFMA16(__builtin_bit_cast(bf16x8, aw), pf, ((f32x4){0.f, 0.f, 0.f, 0.f}));
                        *(LAS f32x4*)(Ored + (wave * 16 + fr) * 132 + 16 * vt + 4 * fq) = o; }
                    __syncthreads();
                    { const int r16 = tid >> 5, c4 = tid & 31; f32x4 so = *(const LAS f32x4*)(Ored + r16 * 132 + 4 * c4);
#pragma unroll
                      for (int w8 = 1; w8 < 8; ++w8) so += *(const LAS f32x4*)(Ored + (w8 * 16 + r16) * 132 + 4 * c4);
                      float* sp = Sslot + ((size_t)((b * 4 + kvh) * 32 + n) * 16 + r16) * 132;
                      *(f32x4*)(sp + 4 * c4) = so;
                      if (c4 == 0) { float Mr = mxs[r16], lt = lss[r16];
#pragma unroll
                          for (int w8 = 1; w8 < 8; ++w8) { Mr = fmaxf(Mr, mxs[w8 * 16 + r16]); lt += lss[w8 * 16 + r16]; }
                          sp[128] = Mr; sp[129] = lt; } }
                }
                __syncthreads();
                TACC(4, ts1);
            }
        }
    }
    xcd_barrier(bar, IS_T0);
    STAMP();

    {
        TIDS;
        LAS bf16* Ks = (LAS bf16*)(lds); LAS bf16* Vs = (LAS bf16*)(lds + KS_BYTES);
        for (int item = bid; item < NBLK * NKV * 2; item += G) {
            const int b = item >> 3, kvh = (item >> 1) & 3, hp = item & 1;
#pragma unroll
            for (int i = 0; i < 8; ++i) { const int idx = i * 512 + tid, key = idx >> 4, c8 = idx & 15; *(LAS v4u*)(Ks + key * KS_P + c8 * 8) = *(const v4u*)(Kb + (size_t)(256 * b + key) * 512 + kvh * 128 + c8 * 8); }
#pragma unroll
            for (int i = 0; i < 8; ++i) { const int idx = i * 512 + tid, key = idx >> 4, c8 = idx & 15; *(LAS v4u*)(Vs + key * KS_P + c8 * 8) = *(const v4u*)(Vb + (size_t)(256 * b + key) * 512 + kvh * 128 + c8 * 8); }
            const int nsel = b < 3 ? b : 3;
            bf16x8 qn[4];
            { const bf16* qp = Qb + (size_t)(256 * b + 16 * wave + fr) * D + (4 * kvh + 2 * hp) * 128 + 8 * fq;
#pragma unroll
              for (int ks = 0; ks < 4; ++ks) qn[ks] = *(const bf16x8*)(qp + 32 * ks); }
            __syncthreads();
#pragma unroll 1
            for (int u = 0; u < 4; ++u) {
                const int g = (u & 1) ? 15 - wave : wave, h = 4 * kvh + 2 * hp + (u >> 1); const int tl = 16 * g + fr; const int tok = 256 * b + tl;
                bf16x8 qf[4];
#pragma unroll
                for (int ks = 0; ks < 4; ++ks) qf[ks] = qn[ks];
                if (u < 3) { const int gn = ((u + 1) & 1) ? 15 - wave : wave, hn = 4 * kvh + 2 * hp + ((u + 1) >> 1); const bf16* qp = Qb + (size_t)(256 * b + 16 * gn + fr) * D + hn * 128 + 8 * fq;
#pragma unroll
                    for (int ks = 0; ks < 4; ++ks) qn[ks] = *(const bf16x8*)(qp + 32 * ks); }
                float msa[3], lsa[3];
#pragma unroll
                for (int r = 0; r < 3; ++r) { msa[r] = -INFINITY; lsa[r] = 0.f; if (r < nsel) { const size_t slot = ((size_t)tok * NH + h) * 3 + r; msa[r] = MLslot[slot * 2]; lsa[r] = MLslot[slot * 2 + 1]; } }
                const int nkt = g + 1;
                f32x4 acc[16]; attn_scores<16>(Ks, qf, acc, nkt, fr, fq);
                float mx = -INFINITY;
#pragma unroll
                for (int kt = 0; kt < 16; ++kt) {
#pragma unroll
                    for (int r = 0; r < 4; ++r) { const bool ok = (kt < nkt) && (16 * kt + 4 * fq + r <= tl); const float sv = ok ? acc[kt][r] : -INFINITY; acc[kt][r] = sv; mx = fmaxf(mx, sv); } }
                mx = fmaxf(mx, shx<16>(mx)); mx = xmax32(mx);
                float M = mx;
#pragma unroll
                for (int r = 0; r < 3; ++r) M = fmaxf(M, msa[r]);
                float l = 0.f;
#pragma unroll
                for (int kt = 0; kt < 16; ++kt) {
#pragma unroll
                    for (int r = 0; r < 4; ++r) { const float p = __builtin_amdgcn_exp2f(acc[kt][r] - M); acc[kt][r] = p; l += p; } }
                l += shx<16>(l); l = xadd32(l);
                f32x4 O[8];
#pragma unroll
                for (int vt = 0; vt < 8; ++vt) O[vt] = (f32x4){0.f, 0.f, 0.f, 0.f};
                attn_pv(Vs, acc, O, (nkt + 1) >> 1, fr, fq);
#pragma unroll
                for (int r = 0; r < 3; ++r) { if (r < nsel) { const float sc = __builtin_amdgcn_exp2f(msa[r] - M); l += lsa[r] * sc; const size_t slot = ((size_t)tok * NH + h) * 3 + r; const bf16* op = Oslot + slot * 128 + 4 * fq;
#pragma unroll
                    for (int vt = 0; vt < 8; ++vt) { const v2u w = *(const v2u*)(op + 16 * vt); O[vt][0] += bf2f(w.x & 0xffffu) * sc; O[vt][1] += bf2f(w.x >> 16) * sc; O[vt][2] += bf2f(w.y & 0xffffu) * sc; O[vt][3] += bf2f(w.y >> 16) * sc; } } }
                const float il = 1.0f / l; bf16* ap = At + (size_t)tok * D + h * 128 + 4 * fq;
#pragma unroll
                for (int vt = 0; vt < 8; ++vt) { v2u w; w.x = cvt_pk_bf16(O[vt][0] * il, O[vt][1] * il); w.y = cvt_pk_bf16(O[vt][2] * il, O[vt][3] * il); *(v2u*)(ap + 16 * vt) = w; }
            }
            __syncthreads();
        }
        LAS float* ksn = (LAS float*)(lds);
        for (int item = bid; item < DECB * NKV; item += G) {
            const int b = item >> 2, kvh = item & 3;
            { const int key = tid >> 7, d = tid & 127; ksn[key * 128 + d] = out[OK_S + (size_t)(4 * b + key) * 512 + kvh * 128 + d]; ksn[512 + key * 128 + d] = out[OV_S + (size_t)(4 * b + key) * 512 + kvh * 128 + d]; }
            __syncthreads();
            const int pr = tid >> 5, l32 = tid & 31; const int t = pr >> 2, hg = pr & 3; const int row = SEQ + 4 * b + t, h = 4 * kvh + hg;
            const v2u qw = *(const v2u*)(Qb + (size_t)row * D + h * 128 + 4 * l32);
            const float q0 = bf2f(qw.x & 0xffffu), q1 = bf2f(qw.x >> 16), q2 = bf2f(qw.y & 0xffffu), q3 = bf2f(qw.y >> 16);
            float sk[4]; float M = -INFINITY;
#pragma unroll
            for (int key = 0; key < 4; ++key) { const f32x4 k4 = *(const LAS f32x4*)(ksn + key * 128 + 4 * l32); float s = (q0 * k4[0] + q1 * k4[1]) + (q2 * k4[2] + q3 * k4[3]);
                s += shx<1>(s); s += shx<2>(s); s += shx<4>(s); s += shx<8>(s); s += shx<16>(s);
                sk[key] = (key <= t) ? s : -INFINITY; M = fmaxf(M, sk[key]); }
            const unsigned mask = Sels[item * 16 + pr];
#pragma unroll 1
            for (int n = 0; n < 32; ++n) if ((mask >> n) & 1u) M = fmaxf(M, Sslot[((size_t)(item * 32 + n) * 16 + pr) * 132 + 128]);
            float l = 0.f; f32x4 O = {0.f, 0.f, 0.f, 0.f};
#pragma unroll
            for (int key = 0; key < 4; ++key) { const float p = __builtin_amdgcn_exp2f(sk[key] - M); l += p; O += *(const LAS f32x4*)(ksn + 512 + key * 128 + 4 * l32) * p; }
#pragma unroll 1
            for (int n = 0; n < 32; ++n) if ((mask >> n) & 1u) { const float* sp = Sslot + ((size_t)(item * 32 + n) * 16 + pr) * 132; const float sc = __builtin_amdgcn_exp2f(sp[128] - M); l += sp[129] * sc; O += *(const f32x4*)(sp + 4 * l32) * sc; }
            const float il = 1.0f / l; v2u w; w.x = cvt_pk_bf16(O[0] * il, O[1] * il); w.y = cvt_pk_bf16(O[2] * il, O[3] * il);
            *(v2u*)(At + (size_t)row * D + h * 128 + 4 * l32) = w;
            __syncthreads();
        }
    }
    xcd_barrier(bar, IS_T0);
    STAMP();

    {
        TIDS;
        pg8::Gemm g{At, Wo_t, SEQ, D, D}; pg8::StaticOrder S; S.init(SEQ, D, G, bid);
        EpiRes<1> E{Hb2, nullptr, nullptr, Hb3, ss3};
        pg8::gemm_phase<EpiRes<1>, pg8::StaticOrder, true, true, false>(lds, g, S, E, TIDX);
        { const int t2 = bid & 127, rh = (bid >> 7) & 1; TIDS; f32x4 ta[1]; tail_gemm<1>(lds, At + (size_t)SEQ * D, Wo_t, D, 16 * t2, rh, ta, TIDX); if (wave < 4) E.tail(SEQ + 64 * rh + 16 * wave + fr, 16 * t2 + 4 * fq, ta[0], fq); }
    }
    xcd_barrier(bar, IS_T0);
    STAMP();
    {
        TIDS;
        pg8::Gemm g{Hb3, Wgu1_t, MP, NGU, D}; pg8::StaticOrder S; S.init(MP, NGU, G, bid);
        EpiGU E{ss3, Hm};
        pg8::gemm_phase<EpiGU, pg8::StaticOrder, true, true>(lds, g, S, E, TIDX);
    }
    xcd_barrier(bar, IS_T0);
    STAMP();
    {
        TIDS;
        pg8::Gemm g{Hm, Wdn1_t, SEQ, D, DFF}; pg8::StaticOrder S; S.init(SEQ, D, G, bid);
        EpiRes<2> E{Hb3, out + OY_P, out + OY_S, nullptr, nullptr};
        pg8::gemm_phase<EpiRes<2>, pg8::StaticOrder, true, true, false>(lds, g, S, E, TIDX);
        { const int t2 = bid & 127, rh = (bid >> 7) & 1; TIDS; f32x4 ta[1]; tail_gemm<1>(lds, Hm + (size_t)SEQ * DFF, Wdn1_t, DFF, 16 * t2, rh, ta, TIDX); if (wave < 4) E.tail(SEQ + 64 * rh + 16 * wave + fr, 16 * t2 + 4 * fq, ta[0], fq); }
    }
#ifdef PROF_A
    STAMP();
    if (blockIdx.x == 0 && IS_T0) {
        const unsigned ta = PVAL(PROF_A0, PROF_A1), tb = PVAL(PROF_B0, PROF_B1);
        unsigned qa = (ta + PROF_UA / 2) / PROF_UA, qb = (tb + PROF_UB / 2) / PROF_UB; if (qa > 99u) qa = 99u; if (qb > 99u) qb = 99u;
#ifdef PROF_MUL
        const unsigned long long extra = (unsigned long long)ta * PROF_MUL;
#else
        const unsigned long long extra = (unsigned long long)(qa + 100u * qb) * 5000ull;
#endif
        const unsigned long long t0 = __builtin_amdgcn_s_memrealtime();
        while (__builtin_amdgcn_s_memrealtime() - t0 < extra) __builtin_amdgcn_s_sleep(32);
    }
#endif
}
#undef x_p
#undef x_s
#undef st_in
#undef cache_k
#undef cache_v
#undef ptab
#undef norm_mix_a
#undef w_in
#undef lbl
#undef onorm
#undef w_out
#undef norm_kv
#undef w_kv
#undef k_norm
#undef norm_mix_b
#undef w_q
#undef q_norm
#undef w_o
#undef norm_ffn
#undef w_gu
#undef w_dn
#undef Win_t
#undef Wout_t
#undef Wgu0_t
#undef Wdn0_t
#undef Wkvq_t
#undef Wo_t
#undef Wgu1_t
#undef Wdn1_t
#undef Hb0
#undef Hb1
#undef Hb2
#undef Hb3
#undef Hf1
#undef Hf2
#undef Hf3
#undef Qg
#undef Vg
#undef Gg
#undef Ff
#undef Ob
#undef At
#undef Hm
#undef Ub
#undef Sst
#undef Dec
#undef Kraw
#undef Vraw
#undef Qraw
#undef Kb
#undef Vb
#undef Qb
#undef Kpart
#undef Kms
#undef Subl
#undef Scnt
#undef Sels
#undef Oslot
#undef MLslot
#undef Sslot
#undef ss0
#undef ss1
#undef ss2
#undef ss3
#undef out
#undef TIDS
#undef TIDX
#undef IS_T0

extern "C" void kernel_launch(void* const* d_in, const int* in_sizes, int n_in, void* d_out, int out_size, void* d_ws, size_t ws_size, hipStream_t stream) {
    static int grid = 0;
    if (grid == 0) {
        if (n_in != 21 || ws_size < WS_END) { fprintf(stderr, "kernel_launch: unexpected n_in %d / ws %zu\n", n_in, ws_size); grid = -1; return; }
        int dev = 0, cus = 0, per_cu = 0;
        if (hipGetDevice(&dev) != hipSuccess || hipDeviceGetAttribute(&cus, hipDeviceAttributeMultiprocessorCount, dev) != hipSuccess) { grid = -1; return; }
        if (hipFuncSetAttribute((const void*)yoco_fwd, hipFuncAttributeMaxDynamicSharedMemorySize, LDS_BYTES) != hipSuccess) { fprintf(stderr, "kernel_launch: hipFuncSetAttribute failed\n"); grid = -1; return; }
        if (hipOccupancyMaxActiveBlocksPerMultiprocessor(&per_cu, (const void*)yoco_fwd, NTHR, LDS_BYTES) != hipSuccess || per_cu < 1) fprintf(stderr, "kernel_launch: occupancy query says %d\n", per_cu);
        (void)hipGetLastError();
        grid = cus;
        if (grid < 256) { fprintf(stderr, "kernel_launch: built for 256 CUs (got %d)\n", grid); grid = -1; return; }
        grid = 256;
    }
    if (grid < 0) return;
    (void)hipMemsetAsync((char*)d_ws + WS_CTL, 0, CTL_ZERO_BYTES, stream);
    Args a{};
    for (int i = 0; i < 21; ++i) a.in[i] = d_in[i];
    a.out = (float*)d_out; a.ws = (unsigned char*)d_ws;
    hipLaunchKernelGGL(yoco_fwd, dim3(grid), dim3(NTHR), LDS_BYTES, stream, a);
}
```

```cpp
#include <hip/hip_runtime.h>
#include <cstdio>
#include <cstdint>
__device__ __forceinline__ int lane_id() { int l = (int)__builtin_amdgcn_mbcnt_hi(~0u, __builtin_amdgcn_mbcnt_lo(~0u, 0u)); asm volatile("" : "+v"(l)); return l; }

namespace pg8 {
#define PG8_LAS __attribute__((address_space(3)))
typedef unsigned short bf16_t;
typedef short bf16x8 __attribute__((ext_vector_type(8)));
typedef float f32x4 __attribute__((ext_vector_type(4)));
typedef unsigned u32x4 __attribute__((ext_vector_type(4)));
typedef unsigned u32x2 __attribute__((ext_vector_type(2)));
constexpr int BM = 256, BK = 64, HALF = 128, HTB = HALF * BK * 2, STAGE_BYTES = 8 * HTB, NXCD = 8, WGM = 8;

__host__ __device__ __forceinline__ int lds_byte(int r, int c) { const int st = (r >> 4) * 2 + (c >> 5), rr = r & 15, cc = c & 31, ob = rr * 64 + cc * 2; return st * 1024 + (ob ^ (((ob >> 9) & 1) << 5)); }
__host__ __device__ __forceinline__ void stage_rc(int b, int& R, int& C) { const int st = b / 1024, sb = b % 1024, swz = sb ^ (((sb >> 9) & 1) << 5); R = (st >> 1) * 16 + swz / 64; C = (st & 1) * 32 + (swz % 64) / 2; }
__host__ __device__ __forceinline__ int perm32(int rho) { const int n = rho >> 4, i = rho & 15; return 8 * (i >> 2) + 4 * n + (i & 3); }

struct Unit { int pm, pn; };
struct Gemm { const bf16_t* A; const bf16_t* Bt; int M, N, K; };

struct StaticOrder {
    int nM, nN, nwg, G, c;
    __host__ __device__ void init(int M, int N, int G_, int c_) { nM = M / BM; nN = N / BM; nwg = nM * nN; G = G_; c = c_; }
    __host__ __device__ bool next(int i, Unit& u) const {
        const long L = (long)i * G + c; if (L >= nwg) return false;
        int wgid = (int)L; { const int q = nwg / NXCD, r = nwg % NXCD, xcd = wgid % NXCD, off = wgid / NXCD; wgid = (xcd < r ? xcd * (q + 1) : r * (q + 1) + (xcd - r) * q) + off; }
        const int nig = WGM * nN, gid = wgid / nig, fm = gid * WGM, gsz = (nM - fm) < WGM ? (nM - fm) : WGM;
        u.pm = fm + ((wgid % nig) % gsz); u.pn = (wgid % nig) / gsz; return true;
    }
    __device__ __forceinline__ void a_ready(const Unit&) const {}
    __device__ __forceinline__ void done(const Unit&) const {}
};

__device__ __forceinline__ unsigned cvt_pk_bf16(float lo, float hi) { unsigned r; asm volatile("v_cvt_pk_bf16_f32 %0, %1, %2" : "=v"(r) : "v"(lo), "v"(hi)); return r; }

template <class Epi, class Sched, bool ALIGN_EPI = false, bool SP2 = false, bool HALF_LAST = true>
__device__ __forceinline__ void gemm_phase(PG8_LAS unsigned char* lds, const Gemm g, const Sched& S, const Epi& E, int tidx) {
    int tid_ = tidx; asm volatile("" : "+v"(tid_));
    const int tid = tid_, wid = __builtin_amdgcn_readfirstlane(tid >> 6), lane = tid & 63, wr = wid >> 2, wc = wid & 3, fr = lane & 15, fq = lane >> 4;
    const int K = g.K, nt = K / BK;
    unsigned voffA[2], voffB[2];
#pragma unroll
    for (int i = 0; i < 2; ++i) { int R, C; stage_rc(tid * 16 + i * 8192, R, C); const int Rb = Epi::PERM ? ((R & ~31) + perm32(R & 31)) : R;
        voffA[i] = (unsigned)(R * K + C) * 2u; voffB[i] = (unsigned)(Rb * K + C) * 2u; }
    const size_t kstep = (size_t)(BK * 2);
    const size_t hstep = (size_t)HALF * K * 2;
    const size_t tstep = 2 * hstep;
    const unsigned ldsw = (unsigned)wid * 1024u;
    const int aoff = lds_byte(wr * 64 + fr, fq * 8), boff = lds_byte(wc * 32 + fr, fq * 8);
#define PG8_SA(b, h) (((b) * 2 + (h)) * HTB)
#define PG8_SB(b, h) ((4 + (b) * 2 + (h)) * HTB)
#define PG8_STAGE(bufoff, gbase, voff) do { _Pragma("unroll") for (int _i = 0; _i < 2; ++_i) \
        __builtin_amdgcn_global_load_lds((const unsigned*)((const char*)(gbase) + (voff)[_i]), (PG8_LAS unsigned*)(lds + (bufoff) + ldsw + _i * 8192), 16, 0, 0); } while (0)
#define PG8_LDA(dst, b, h) do { _Pragma("unroll") for (int m = 0; m < 4; ++m) _Pragma("unroll") for (int k = 0; k < 2; ++k) dst[m][k] = *(const PG8_LAS bf16x8*)(lds + PG8_SA(b, h) + aoff + m * 2048 + k * 1024); } while (0)
#define PG8_LDB(dst, b, h) do { _Pragma("unroll") for (int n = 0; n < 2; ++n) _Pragma("unroll") for (int k = 0; k < 2; ++k) dst[n][k] = *(const PG8_LAS bf16x8*)(lds + PG8_SB(b, h) + boff + n * 2048 + k * 1024); } while (0)
#define PG8_MMA(ai, bj, At, Bt) do { __builtin_amdgcn_s_setprio(1); _Pragma("unroll") for (int m = 0; m < 4; ++m) _Pragma("unroll") for (int n = 0; n < 2; ++n) _Pragma("unroll") for (int k = 0; k < 2; ++k) \
        acc[ai][bj][m][n] = __builtin_amdgcn_mfma_f32_16x16x32_bf16(Bt[n][k], At[m][k], acc[ai][bj][m][n], 0, 0, 0); __builtin_amdgcn_s_setprio(0); } while (0)
#define PG8_WAIT_V(n) asm volatile("s_waitcnt vmcnt(" #n ")" ::: "memory")
#define PG8_WAIT_L(n) asm volatile("s_waitcnt lgkmcnt(" #n ")" ::: "memory")
#define PG8_BAR __builtin_amdgcn_s_barrier()
#define PG8_SCHED __builtin_amdgcn_sched_barrier(0)
    Unit cur, nxt; int ui = 0;
    if (!S.next(0, cur)) return;
    f32x4 acc[2][2][4][2];
#pragma unroll
    for (int a = 0; a < 2; ++a)
#pragma unroll
        for (int b = 0; b < 2; ++b)
#pragma unroll
            for (int m = 0; m < 4; ++m)
#pragma unroll
                for (int n = 0; n < 2; ++n) acc[a][b][m][n] = (f32x4){0.f, 0.f, 0.f, 0.f};
    bf16x8 At[4][2], B0[2][2], B1[2][2];
    const char* cA = (const char*)g.A + (size_t)cur.pm * tstep; const char* cB = (const char*)g.Bt + (size_t)cur.pn * tstep;
    S.a_ready(cur);
    if constexpr (SP2) {
        PG8_STAGE(PG8_SB(0, 0), cB, voffB); PG8_STAGE(PG8_SB(0, 1), cB + hstep, voffB); PG8_STAGE(PG8_SA(0, 0), cA, voffA); PG8_STAGE(PG8_SA(0, 1), cA + hstep, voffA);
        if (wr == 1) PG8_BAR;
        PG8_WAIT_V(2); PG8_BAR;
        PG8_STAGE(PG8_SB(1, 0), cB + kstep, voffB); PG8_STAGE(PG8_SA(1, 0), cA + kstep, voffA); PG8_STAGE(PG8_SB(1, 1), cB + hstep + kstep, voffB);
        PG8_WAIT_V(6); PG8_BAR;
    } else {
        PG8_STAGE(PG8_SB(0, 0), cB, voffB); PG8_STAGE(PG8_SA(0, 0), cA, voffA); PG8_STAGE(PG8_SB(0, 1), cB + hstep, voffB); PG8_STAGE(PG8_SA(0, 1), cA + hstep, voffA);
        if (wr == 1) PG8_BAR;
        PG8_WAIT_V(4); PG8_BAR;
        PG8_STAGE(PG8_SB(1, 0), cB + kstep, voffB); PG8_STAGE(PG8_SA(1, 0), cA + kstep, voffA); PG8_STAGE(PG8_SB(1, 1), cB + hstep + kstep, voffB);
        PG8_WAIT_V(6); PG8_BAR;
    }
    for (;;) {
        const bool has_next = S.next(ui + 1, nxt);
        const bool half1 = HALF_LAST && (cur.pm == g.M / BM - 1);
        const char* nA = has_next ? (const char*)g.A + (size_t)nxt.pm * tstep : cA; const char* nB = has_next ? (const char*)g.Bt + (size_t)nxt.pn * tstep : cB;
        for (int t = 0; t < nt; t += 2) {
            const bool last = (t == nt - 2);
            const char* a1 = cA + (size_t)(t + 1) * kstep;
            const char* a2 = last ? nA : cA + (size_t)(t + 2) * kstep; const char* b2 = last ? nB : cB + (size_t)(t + 2) * kstep;
            const char* a3 = a2 + kstep; const char* b3 = b2 + kstep;
            if (last && has_next) S.a_ready(nxt);
            if constexpr (SP2) {
            PG8_LDB(B0, 0, 0); PG8_LDB(B1, 0, 1); PG8_SCHED; PG8_LDA(At, 0, 0); PG8_STAGE(PG8_SA(1, 1), a1 + hstep, voffA);
            PG8_WAIT_V(8); PG8_WAIT_L(0); PG8_BAR; PG8_MMA(0, 0, At, B0); PG8_MMA(0, 1, At, B1); PG8_BAR; PG8_SCHED;
            if (!half1) { PG8_LDA(At, 0, 1); } PG8_STAGE(PG8_SB(0, 0), b2, voffB); PG8_STAGE(PG8_SB(0, 1), b2 + hstep, voffB); PG8_STAGE(PG8_SA(0, 0), a2, voffA);
            PG8_WAIT_V(8); PG8_WAIT_L(0); PG8_BAR; if (!half1) { PG8_MMA(1, 0, At, B0); PG8_MMA(1, 1, At, B1); } PG8_BAR; PG8_SCHED;
            PG8_LDB(B0, 1, 0); PG8_LDB(B1, 1, 1); PG8_SCHED; PG8_LDA(At, 1, 0); PG8_STAGE(PG8_SA(0, 1), a2 + hstep, voffA);
            PG8_WAIT_V(8); PG8_WAIT_L(0); PG8_BAR; PG8_MMA(0, 0, At, B0); PG8_MMA(0, 1, At, B1); PG8_BAR; PG8_SCHED;
            if (!half1) { PG8_LDA(At, 1, 1); } PG8_STAGE(PG8_SB(1, 0), b3, voffB); PG8_STAGE(PG8_SB(1, 1), b3 + hstep, voffB); PG8_STAGE(PG8_SA(1, 0), a3, voffA);
            PG8_WAIT_V(8); PG8_WAIT_L(0); PG8_BAR; if (!half1) { PG8_MMA(1, 0, At, B0); PG8_MMA(1, 1, At, B1); } PG8_BAR; PG8_SCHED;
            } else {
            PG8_LDB(B0, 0, 0); PG8_SCHED; PG8_LDA(At, 0, 0); PG8_STAGE(PG8_SA(1, 1), a1 + hstep, voffA);
            PG8_WAIT_L(8); PG8_BAR; PG8_WAIT_L(0); PG8_MMA(0, 0, At, B0); PG8_BAR; PG8_SCHED;
            PG8_LDB(B1, 0, 1); PG8_STAGE(PG8_SB(0, 0), b2, voffB);
            PG8_BAR; PG8_WAIT_L(0); PG8_MMA(0, 1, At, B1); PG8_BAR;
            PG8_LDA(At, 0, 1); PG8_STAGE(PG8_SA(0, 0), a2, voffA);
            PG8_BAR; PG8_WAIT_L(0); PG8_MMA(1, 0, At, B0); PG8_BAR; PG8_SCHED;
            PG8_STAGE(PG8_SB(0, 1), b2 + hstep, voffB);
            PG8_WAIT_V(6); PG8_BAR; PG8_MMA(1, 1, At, B1); PG8_BAR;
            PG8_LDB(B0, 1, 0); PG8_SCHED; PG8_LDA(At, 1, 0); PG8_STAGE(PG8_SA(0, 1), a2 + hstep, voffA);
            PG8_WAIT_L(8); PG8_BAR; PG8_WAIT_L(0); PG8_MMA(0, 0, At, B0); PG8_BAR; PG8_SCHED;
            PG8_LDB(B1, 1, 1); PG8_STAGE(PG8_SB(1, 0), b3, voffB);
            PG8_BAR; PG8_WAIT_L(0); PG8_MMA(0, 1, At, B1); PG8_BAR;
            PG8_LDA(At, 1, 1); PG8_STAGE(PG8_SA(1, 0), a3, voffA);
            PG8_BAR; PG8_WAIT_L(0); PG8_MMA(1, 0, At, B0); PG8_BAR; PG8_SCHED;
            PG8_STAGE(PG8_SB(1, 1), b3 + hstep, voffB);
            PG8_WAIT_V(6); PG8_BAR; PG8_MMA(1, 1, At, B1); PG8_BAR;
            }
        }
        if constexpr (ALIGN_EPI) { if (wr == 0) PG8_BAR; }
        E(acc, cur, wr, wc, fr, fq);
        if (!has_next) break;
#pragma unroll
        for (int a = 0; a < 2; ++a)
#pragma unroll
            for (int b = 0; b < 2; ++b)
#pragma unroll
                for (int m = 0; m < 4; ++m)
#pragma unroll
                    for (int n = 0; n < 2; ++n) acc[a][b][m][n] = (f32x4){0.f, 0.f, 0.f, 0.f};
        cur = nxt; cA = nA; cB = nB; ++ui;
        if constexpr (ALIGN_EPI) { if (wr == 1) PG8_BAR; }
    }
    PG8_WAIT_V(0);
    if constexpr (!ALIGN_EPI) { if (wr == 0) PG8_BAR; }
    PG8_BAR;
#undef PG8_SA
#undef PG8_SB
#undef PG8_STAGE
#undef PG8_LDA
#undef PG8_LDB
#undef PG8_MMA
#undef PG8_WAIT_V
#undef PG8_WAIT_L
#undef PG8_BAR
#undef PG8_SCHED
}
}

constexpr int NWAVES = 8, NTHR = 512;
constexpr int D = 2048, SEQ = 8192, DECB = 32, DECS = 4, MS = DECB * DECS;
constexpr int MR = SEQ + MS;
constexpr int MP = 8448;
constexpr int NH = 16, HD = 128, NKV = 4, DFF = 5632, NGU = 2 * DFF;
constexpr int NCHUNK = SEQ / 64;
constexpr int NPAGES = 64, PAGE = 128, NBLK = 32;
constexpr float EPS = 1e-6f;
constexpr float C2 = 0.08838834764831845f * 1.4426950408889634f;

constexpr size_t OY_P = 0, OY_S = OY_P + (size_t)SEQ * D, OST_P = OY_S + (size_t)MS * D, OST_S = OST_P + (size_t)NH * 128 * 128,
                 OK_P = OST_S + (size_t)DECB * NH * 128 * 128, OV_P = OK_P + (size_t)SEQ * 512, OK_S = OV_P + (size_t)SEQ * 512, OV_S = OK_S + (size_t)MS * 512;

constexpr size_t MiB = 1u << 20;
constexpr size_t WS_CTL = 0, CTL_ZERO_BYTES = 1 * MiB;
constexpr size_t WS_WIN = 2 * MiB;
constexpr size_t WS_WOUT = WS_WIN + 32 * MiB;
constexpr size_t WS_WGU0 = WS_WOUT + 8 * MiB;
constexpr size_t WS_WDN0 = WS_WGU0 + 44 * MiB;
constexpr size_t WS_WKVQ = WS_WDN0 + 22 * MiB;
constexpr size_t WS_WO = WS_WKVQ + 12 * MiB;
constexpr size_t WS_WGU1 = WS_WO + 8 * MiB;
constexpr size_t WS_WDN1 = WS_WGU1 + 44 * MiB;
constexpr size_t WS_HB0 = WS_WDN1 + 22 * MiB;
constexpr size_t WS_HB1 = WS_HB0 + 34 * MiB, WS_HB2 = WS_HB1 + 34 * MiB, WS_HB3 = WS_HB2 + 34 * MiB;
constexpr size_t WS_HF1 = WS_HB3 + 34 * MiB;
constexpr size_t WS_HF2 = WS_HF1 + 67 * MiB, WS_HF3 = WS_HF2 + 67 * MiB;
constexpr size_t WS_QG = WS_HF3 + 67 * MiB;
constexpr size_t WS_VG = WS_QG + 34 * MiB;
constexpr size_t WS_GG = WS_VG + 34 * MiB;
constexpr size_t WS_F = WS_GG + 34 * MiB;
constexpr size_t WS_OB = WS_F + 67 * MiB;
constexpr size_t WS_AT = WS_OB + 34 * MiB;
constexpr size_t WS_HM = WS_AT + 34 * MiB;
constexpr size_t WS_U = WS_HM + 92 * MiB;
constexpr size_t WS_SST = WS_U + 64 * MiB;
constexpr size_t WS_DEC = WS_SST + 64 * MiB;
constexpr size_t WS_KRAW = WS_DEC + 2 * MiB;
constexpr size_t WS_VRAW = WS_KRAW + 17 * MiB;
constexpr size_t WS_QRAW = WS_VRAW + 17 * MiB;
constexpr size_t WS_KB = WS_QRAW + 67 * MiB;
constexpr size_t WS_VB = WS_KB + 9 * MiB;
constexpr size_t WS_QB = WS_VB + 9 * MiB;
constexpr size_t WS_KPART = WS_QB + 34 * MiB;
constexpr size_t WS_KMS = WS_KPART + 1 * MiB;
constexpr size_t WS_SUBL = WS_KMS + 2 * MiB;
constexpr size_t WS_SCNT = WS_SUBL + 16 * MiB;
constexpr size_t WS_OSLOT = WS_SCNT + 1 * MiB;
constexpr size_t WS_MLSLOT = WS_OSLOT + 192 * MiB;
constexpr size_t WS_SSLOT = WS_MLSLOT + 3 * MiB;
constexpr size_t WS_FOUT = WS_SSLOT + 34 * MiB;
constexpr size_t WS_END = WS_FOUT + 131 * MiB;
constexpr size_t WS_ORC = WS_END;
constexpr int CW_BAR = 4096;
constexpr int CW_Q0 = 8192;
constexpr int CW_SS0 = 16384, CW_SS1 = CW_SS0 + MP, CW_SS2 = CW_SS1 + MP, CW_SS3 = CW_SS2 + MP;
static_assert((CW_SS3 + MP) * 4 <= (int)CTL_ZERO_BYTES, "ctl");
static_assert(WS_VG - WS_QG == 34 * MiB && WS_GG - WS_VG == 34 * MiB, "Qg|Vg|Gg stride");

constexpr int LDS_BYTES = 160 * 1024;
constexpr int MISC_OFF = LDS_BYTES - 256;

#define GAS __attribute__((address_space(1)))
#define LAS __attribute__((address_space(3)))
typedef unsigned short bf16;
typedef unsigned v4u __attribute__((ext_vector_type(4)));
typedef unsigned v2u __attribute__((ext_vector_type(2)));
typedef float f32x4 __attribute__((ext_vector_type(4)));
typedef float f32x2 __attribute__((ext_vector_type(2)));
typedef short bf16x8 __attribute__((ext_vector_type(8)));
typedef short bf16x4 __attribute__((ext_vector_type(4)));
typedef _Float16 f16;
typedef _Float16 f16x2 __attribute__((ext_vector_type(2)));
__device__ __forceinline__ unsigned pkh2(float lo, float hi) { const f16x2 v = {(f16)lo, (f16)hi}; return __builtin_bit_cast(unsigned, v); }
#define LDS_WAIT() asm volatile("s_waitcnt lgkmcnt(0)" ::: "memory")
__device__ __forceinline__ unsigned f2bf(float f) { unsigned u = __builtin_bit_cast(unsigned, f); return (u + 0x7fffu + ((u >> 16) & 1u)) >> 16; }
__device__ __forceinline__ unsigned pk2(float lo, float hi) { return f2bf(lo) | (f2bf(hi) << 16); }
__device__ __forceinline__ float bf2f(unsigned h) { return __uint_as_float(h << 16); }
__device__ __forceinline__ float silu_f(float x) { return x * __builtin_amdgcn_rcpf(1.0f + __expf(-x)); }
__device__ __forceinline__ float sigm_f(float x) { return __builtin_amdgcn_rcpf(1.0f + __expf(-x)); }
template <int M> __device__ __forceinline__ float shx(float v) { return __uint_as_float((unsigned)__builtin_amdgcn_ds_swizzle((int)__float_as_uint(v), (M << 10) | 0x1f)); }
__device__ __forceinline__ float xadd32(float v) { auto rr = __builtin_amdgcn_permlane32_swap(__float_as_uint(v), __float_as_uint(v), false, false); return __uint_as_float(rr[0]) + __uint_as_float(rr[1]); }
__device__ __forceinline__ float xmax32(float v) { auto rr = __builtin_amdgcn_permlane32_swap(__float_as_uint(v), __float_as_uint(v), false, false); return fmaxf(__uint_as_float(rr[0]), __uint_as_float(rr[1])); }
__device__ __forceinline__ float wave_sum(float v) { v += shx<1>(v); v += shx<2>(v); v += shx<4>(v); v += shx<8>(v); v += shx<16>(v); return xadd32(v); }
#define MFMA16(a, b, c) __builtin_amdgcn_mfma_f32_16x16x32_bf16((a), (b), (c), 0, 0, 0)

#define XB_TMO      128
#define XB_XCNT(j)  (256  + 64 * (j))
#define XB_XSUB(j)  (1280 + 64 * (j))
#define XB_XGEN(j)  (2304 + 64 * (j))
#define XB_TOP      3328
#define XB_TOPGEN   3392
#define XCD_BAR_WORDS 3456
#define XB_SPIN_CAP (1u << 18)
__device__ __forceinline__ unsigned xb_ld(unsigned* p)              { return __hip_atomic_load(p, __ATOMIC_RELAXED, __HIP_MEMORY_SCOPE_AGENT); }
__device__ __forceinline__ unsigned xb_add(unsigned* p, unsigned v) { return __hip_atomic_fetch_add(p, v, __ATOMIC_RELAXED, __HIP_MEMORY_SCOPE_AGENT); }
__device__ __forceinline__ unsigned xb_xcc_id() { return (unsigned)__builtin_amdgcn_s_getreg((3 << 11) | 20) & 0xFu; }
#define XB_SPIN(cond, bar) do { unsigned _sp = 0; while (cond) { __builtin_amdgcn_s_sleep(1); \
    if ((++_sp & 255u) == 0u) { if (xb_ld(&(bar)[XB_TMO])) break; if (_sp > XB_SPIN_CAP) { atomicAdd(&(bar)[XB_TMO], 1u); break; } } } } while (0)
struct XcdBarrier { unsigned* bar; unsigned x; volatile LAS unsigned* st; };
__device__ __forceinline__ XcdBarrier xcd_barrier_post(unsigned* bar, volatile LAS unsigned* st, bool is_t0) {
    XcdBarrier b; b.bar = bar; b.x = xb_xcc_id(); b.st = st;
    if (is_t0) (void)xb_add(&bar[XB_XCNT(b.x)], 1u);
    return b;
}
__device__ __forceinline__ void xcd_barrier_complete(unsigned* bar, unsigned x, unsigned& nloc, unsigned& nx) {
    const unsigned G = gridDim.x * gridDim.y * gridDim.z;
    unsigned sum, cnt, mine, sp = 0u;
    for (;;) {
        sum = 0u; cnt = 0u; mine = 0u;
#pragma unroll
        for (unsigned j = 0; j < 16; ++j) { const unsigned c = xb_ld(&bar[XB_XCNT(j)]); sum += c; cnt += (c > 0u) ? 1u : 0u; mine = (j == x) ? c : mine; }
        if (sum == G) break;
        __builtin_amdgcn_s_sleep(1);
        if ((++sp & 255u) == 0u) { if (xb_ld(&bar[XB_TMO])) break; if (sp > XB_SPIN_CAP) { atomicAdd(&bar[XB_TMO], 1u); break; } }
    }
    nloc = mine > 0u ? mine : 1u; nx = cnt > 0u ? cnt : 1u;
}
__device__ __forceinline__ void xcd_barrier(const XcdBarrier& b, bool is_t0) {
    asm volatile("s_waitcnt vmcnt(0)" ::: "memory");
    __syncthreads();
    if (is_t0) {
        unsigned* bar = b.bar;
        __builtin_amdgcn_s_waitcnt(0);
        unsigned nloc = b.st[0], nx = b.st[1];
        if (nloc == 0u) { xcd_barrier_complete(bar, b.x, nloc, nx); b.st[0] = nloc; b.st[1] = nx; }
        const unsigned old = xb_add(&bar[XB_XSUB(b.x)], 1u);
        const unsigned gen = old / nloc;
        if (old + 1u == (gen + 1u) * nloc) {
            __builtin_amdgcn_fence(__ATOMIC_RELEASE, "agent");
            asm volatile("s_waitcnt vmcnt(0)" ::: "memory");
            const unsigned og = xb_add(&bar[XB_TOP], 1u);
            const unsigned tg = og / nx;
            if (og + 1u == (tg + 1u) * nx) xb_add(&bar[XB_TOPGEN], 1u);
            else XB_SPIN(xb_ld(&bar[XB_TOPGEN]) == tg, bar);
            __builtin_amdgcn_fence(__ATOMIC_ACQUIRE, "agent");
            xb_add(&bar[XB_XGEN(b.x)], 1u);
            asm volatile("s_waitcnt vmcnt(0)" ::: "memory");
        } else {
            XB_SPIN(xb_ld(&bar[XB_XGEN(b.x)]) == gen, bar);
            __builtin_amdgcn_fence(__ATOMIC_ACQUIRE, "agent");
            asm volatile("s_waitcnt vmcnt(0)" ::: "memory");
        }
    }
    __syncthreads();
}

using pg8::Unit; using pg8::cvt_pk_bf16;
struct EpiIn {
    static constexpr bool PERM = true;
    const float* ss; const float* lbl; bf16* Qg; f16* F;
    __device__ __forceinline__ void operator()(const f32x4 (&acc)[2][2][4][2], const Unit& u, int wr, int wc, int fr, int fq) const {
        const int seg = u.pn >> 3; const int col0 = (u.pn & 7) * 256 + wc * 32 + 8 * fq; const int rowb = u.pm * 256 + wr * 64;
        float lb[2][8];
        if (seg == 1) {
#pragma unroll
            for (int bj = 0; bj < 2; ++bj)
#pragma unroll
                for (int j = 0; j < 8; ++j) { const int c = col0 + bj * 128 + j; lb[bj][j] = __builtin_amdgcn_rcpf(1.0f + __expf(lbl[D + c] - lbl[c])); }
        }
#pragma unroll
        for (int ai = 0; ai < 2; ++ai)
#pragma unroll
            for (int m = 0; m < 4; ++m) {
                const int rb = rowb + ai * 128 + m * 16; if (rb >= MR) continue;
                const int row = rb + fr; const float r = rsqrtf(ss[row] * (1.0f / D) + EPS);
#pragma unroll
                for (int bj = 0; bj < 2; ++bj) {
                    f32x4 v0 = acc[ai][bj][m][0] * r, v1 = acc[ai][bj][m][1] * r; const size_t off = (size_t)row * D + col0 + bj * 128;
                    if (seg == 1) {
                        f32x4 o0, o1;
#pragma unroll
                        for (int j = 0; j < 4; ++j) { o0[j] = lb[bj][j] + (1.0f - lb[bj][j]) * sigm_f(v0[j]); o1[j] = lb[bj][4 + j] + (1.0f - lb[bj][4 + j]) * sigm_f(v1[j]); }
                        { v4u w; w.x = pkh2(o0[0], o0[1]); w.y = pkh2(o0[2], o0[3]); w.z = pkh2(o1[0], o1[1]); w.w = pkh2(o1[2], o1[3]); *(v4u*)(F + off) = w; }
                    } else {
                        if (seg != 2) {
#pragma unroll
                            for (int j = 0; j < 4; ++j) { v0[j] = silu_f(v0[j]); v1[j] = silu_f(v1[j]); }
                        }
                        v4u w; w.x = cvt_pk_bf16(v0[0], v0[1]); w.y = cvt_pk_bf16(v0[2], v0[3]); w.z = cvt_pk_bf16(v1[0], v1[1]); w.w = cvt_pk_bf16(v1[2], v1[3]);
                        const size_t dsel = (seg == 0) ? 0 : ((seg == 2) ? 1 : 2);
                        *(v4u*)(Qg + dsel * (size_t)(17 * MiB) + off) = w;
                    }
                }
            }
    }
    __device__ __forceinline__ void tail(int row, int col, f32x4 v) const {
        const int seg = col >> 11, c = col & 2047; const float r = rsqrtf(ss[row] * (1.0f / D) + EPS); v = v * r; const size_t off = (size_t)row * D + c;
        if (seg == 1) { f32x4 o;
#pragma unroll
            for (int j = 0; j < 4; ++j) { const float lbv = __builtin_amdgcn_rcpf(1.0f + __expf(lbl[D + c + j] - lbl[c + j])); o[j] = lbv + (1.0f - lbv) * sigm_f(v[j]); }
            { v2u w; w.x = pkh2(o[0], o[1]); w.y = pkh2(o[2], o[3]); *(v2u*)(F + off) = w; }
        } else {
            if (seg != 2) {
#pragma unroll
                for (int j = 0; j < 4; ++j) v[j] = silu_f(v[j]);
            }
            v2u w; w.x = cvt_pk_bf16(v[0], v[1]); w.y = cvt_pk_bf16(v[2], v[3]);
            const size_t dsel = (seg == 0) ? 0 : ((seg == 2) ? 1 : 2);
            *(v2u*)(Qg + dsel * (size_t)(17 * MiB) + off) = w;
        }
    }
};

template <int MODE> struct EpiRes {
    static constexpr bool PERM = true;
    const bf16* rb; float* o0; float* o1; bf16* hb; float* ss;
    __device__ __forceinline__ void operator()(const f32x4 (&acc)[2][2][4][2], const Unit& u, int wr, int wc, int fr, int fq) const {
        const int col0 = u.pn * 256 + wc * 32 + 8 * fq; const int rowb = u.pm * 256 + wr * 64;
#pragma unroll
        for (int ai = 0; ai < 2; ++ai)
#pragma unroll
            for (int m = 0; m < 4; ++m) {
                const int rb0 = rowb + ai * 128 + m * 16; if (rb0 >= MR) continue;
                const int row = rb0 + fr;
                const bf16* rp = rb + (size_t)row * D;
                float* op = (MODE == 2) ? ((row < SEQ) ? o0 + (size_t)row * D : o1 + (size_t)(row - SEQ) * D) : nullptr;
                float sq = 0.f;
#pragma unroll
                for (int bj = 0; bj < 2; ++bj) {
                    const int c = col0 + bj * 128;
                    const v4u rw = *(const v4u*)(rp + c);
                    f32x4 a0 = {bf2f(rw.x & 0xffffu), bf2f(rw.x >> 16), bf2f(rw.y & 0xffffu), bf2f(rw.y >> 16)}, a1 = {bf2f(rw.z & 0xffffu), bf2f(rw.z >> 16), bf2f(rw.w & 0xffffu), bf2f(rw.w >> 16)};
                    a0 += acc[ai][bj][m][0]; a1 += acc[ai][bj][m][1];
                    if (MODE == 2) { __builtin_nontemporal_store(a0, (f32x4*)(op + c)); __builtin_nontemporal_store(a1, (f32x4*)(op + c + 4)); }
                    else {
                        v4u w; w.x = cvt_pk_bf16(a0[0], a0[1]); w.y = cvt_pk_bf16(a0[2], a0[3]); w.z = cvt_pk_bf16(a1[0], a1[1]); w.w = cvt_pk_bf16(a1[2], a1[3]);
                        *(v4u*)(hb + (size_t)row * D + c) = w;
                        sq += (a0[0] * a0[0] + a0[1] * a0[1]) + (a0[2] * a0[2] + a0[3] * a0[3]) + (a1[0] * a1[0] + a1[1] * a1[1]) + (a1[2] * a1[2] + a1[3] * a1[3]);
                    }
                }
                if (MODE != 2) { sq += shx<16>(sq); sq = xadd32(sq); if (fq == 0) atomicAdd(ss + row, sq); }
            }
    }
    __device__ __forceinline__ void tail(int row, int col, f32x4 v, int fq) const {
        const v2u rw = *(const v2u*)(rb + (size_t)row * D + col);
        f32x4 a0 = {bf2f(rw.x & 0xffffu), bf2f(rw.x >> 16), bf2f(rw.y & 0xffffu), bf2f(rw.y >> 16)}; a0 += v;
        if (MODE == 2) { *(f32x4*)(o1 + (size_t)(row - SEQ) * D + col) = a0; }
        else {
            v2u w; w.x = cvt_pk_bf16(a0[0], a0[1]); w.y = cvt_pk_bf16(a0[2], a0[3]); *(v2u*)(hb + (size_t)row * D + col) = w;
            float sq = (a0[0] * a0[0] + a0[1] * a0[1]) + (a0[2] * a0[2] + a0[3] * a0[3]);
            sq += shx<16>(sq); sq = xadd32(sq); if (fq == 0) atomicAdd(ss + row, sq);
        }
    }
};
struct EpiGU {
    static constexpr bool PERM = true;
    const float* ss; bf16* hm;
    __device__ __forceinline__ void operator()(const f32x4 (&acc)[2][2][4][2], const Unit& u, int wr, int wc, int fr, int fq) const {
        const int j0 = u.pn * 128 + wc * 32 + 8 * fq; const int rowb = u.pm * 256 + wr * 64;
#pragma unroll
        for (int ai = 0; ai < 2; ++ai)
#pragma unroll
            for (int m = 0; m < 4; ++m) {
                const int rb = rowb + ai * 128 + m * 16; if (rb >= MR) continue;
                const int row = rb + fr; const float r = rsqrtf(ss[row] * (1.0f / D) + EPS);
                float o[8];
#pragma unroll
                for (int n = 0; n < 2; ++n)
#pragma unroll
                    for (int j = 0; j < 4; ++j) o[4 * n + j] = silu_f(acc[ai][0][m][n][j] * r) * (acc[ai][1][m][n][j] * r);
                v4u w; w.x = cvt_pk_bf16(o[0], o[1]); w.y = cvt_pk_bf16(o[2], o[3]); w.z = cvt_pk_bf16(o[4], o[5]); w.w = cvt_pk_bf16(o[6], o[7]);
                *(v4u*)(hm + (size_t)row * DFF + j0) = w;
            }
    }
};
struct EpiKVQ {
    static constexpr bool PERM = true;
    const float* ss; unsigned char* ws; float* outp; const float* kn; const float* qn; LAS unsigned char* xl;
    __device__ __forceinline__ void operator()(const f32x4 (&acc)[2][2][4][2], const Unit& u, int wr, int wc, int fr, int fq) const {
        const int c0 = wc * 32 + 8 * fq; const int rowb = u.pm * 256 + wr * 64;
        bf16* Kb_ = (bf16*)(ws + WS_KB); bf16* Vb_ = (bf16*)(ws + WS_VB); bf16* Qb_ = (bf16*)(ws + WS_QB); float* Kp_ = (float*)(ws + WS_KPART);
        if (u.pn == 2 || u.pn == 3) {
#pragma unroll
            for (int ai = 0; ai < 2; ++ai)
#pragma unroll
                for (int m = 0; m < 4; ++m) {
                    const int rb = rowb + ai * 128 + m * 16; if (rb >= MR) continue;
                    const int row = rb + fr; const float r = rsqrtf(ss[row] * (1.0f / D) + EPS);
                    float* vo = outp + ((row < SEQ) ? OV_P + (size_t)row * 512 : OV_S + (size_t)(row - SEQ) * 512);
#pragma unroll
                    for (int bj = 0; bj < 2; ++bj) { const int col = (u.pn - 2) * 256 + bj * 128 + c0; const f32x4 v0 = acc[ai][bj][m][0] * r, v1 = acc[ai][bj][m][1] * r;
                        __builtin_nontemporal_store(v0, (f32x4*)(vo + col)); __builtin_nontemporal_store(v1, (f32x4*)(vo + col + 4));
                        v4u w; w.x = cvt_pk_bf16(v0[0], v0[1]); w.y = cvt_pk_bf16(v0[2], v0[3]); w.z = cvt_pk_bf16(v1[0], v1[1]); w.w = cvt_pk_bf16(v1[2], v1[3]);
                        *(v4u*)(Vb_ + (size_t)row * 512 + col) = w; }
                }
            return;
        }
        const bool isk = u.pn < 2;
        LAS float* P = (LAS float*)xl;
        LAS float* CS = (LAS float*)(xl + 8192);
#pragma unroll
        for (int ai = 0; ai < 2; ++ai)
#pragma unroll
            for (int m = 0; m < 4; ++m) {
                const int rl = ai * 128 + wr * 64 + m * 16 + fr; const float r = rsqrtf(ss[u.pm * 256 + rl] * (1.0f / D) + EPS);
#pragma unroll
                for (int bj = 0; bj < 2; ++bj) { const f32x4 v0 = acc[ai][bj][m][0] * r, v1 = acc[ai][bj][m][1] * r;
                    float sq = (v0[0] * v0[0] + v0[1] * v0[1]) + (v0[2] * v0[2] + v0[3] * v0[3]) + (v1[0] * v1[0] + v1[1] * v1[1]) + (v1[2] * v1[2] + v1[3] * v1[3]);
                    sq += shx<16>(sq); sq = xadd32(sq);
                    if (fq == 0) P[(rl * 2 + bj) * 4 + wc] = sq; }
            }
        asm volatile("s_waitcnt lgkmcnt(0)" ::: "memory"); __builtin_amdgcn_s_barrier(); asm volatile("" ::: "memory");
        float cs[2][8];
#pragma unroll
        for (int bj = 0; bj < 2; ++bj)
#pragma unroll
            for (int j = 0; j < 8; ++j) cs[bj][j] = 0.f;
        const float* gp = (isk ? kn : qn) + c0; const f32x4 g0 = *(const f32x4*)gp, g1 = *(const f32x4*)(gp + 4);
#pragma unroll
        for (int ai = 0; ai < 2; ++ai)
#pragma unroll
            for (int m = 0; m < 4; ++m) {
                const int rb = rowb + ai * 128 + m * 16; if (rb >= MR) continue;
                const int rl = ai * 128 + wr * 64 + m * 16 + fr; const int row = rb + fr; const float r = rsqrtf(ss[row] * (1.0f / D) + EPS);
#pragma unroll
                for (int bj = 0; bj < 2; ++bj) {
                    const f32x4 pp = *(const LAS f32x4*)(P + (rl * 2 + bj) * 4);
                    const float rh = rsqrtf(((pp[0] + pp[1]) + (pp[2] + pp[3])) * (1.0f / 128.0f) + EPS) * (isk ? 1.0f : C2);
                    const f32x4 n0 = acc[ai][bj][m][0] * (r * rh) * g0, n1 = acc[ai][bj][m][1] * (r * rh) * g1;
                    v4u w; w.x = cvt_pk_bf16(n0[0], n0[1]); w.y = cvt_pk_bf16(n0[2], n0[3]); w.z = cvt_pk_bf16(n1[0], n1[1]); w.w = cvt_pk_bf16(n1[2], n1[3]);
                    if (isk) {
                        const int col = u.pn * 256 + bj * 128 + c0;
                        float* ko = outp + ((row < SEQ) ? OK_P + (size_t)row * 512 : OK_S + (size_t)(row - SEQ) * 512) + col;
                        __builtin_nontemporal_store(n0, (f32x4*)ko); __builtin_nontemporal_store(n1, (f32x4*)(ko + 4));
                        *(v4u*)(Kb_ + (size_t)row * 512 + col) = w;
#pragma unroll
                        for (int j = 0; j < 4; ++j) { cs[bj][j] += n0[j]; cs[bj][4 + j] += n1[j]; }
                    } else {
                        *(v4u*)(Qb_ + (size_t)row * D + (u.pn - 4) * 256 + bj * 128 + c0) = w;
                    }
                }
            }
        if (isk && u.pm < SEQ / 256) {
#pragma unroll
            for (int bj = 0; bj < 2; ++bj)
#pragma unroll
                for (int j = 0; j < 8; ++j) { float v = cs[bj][j]; v += shx<1>(v); v += shx<2>(v); v += shx<4>(v); v += shx<8>(v); if (fr == 0) CS[wr * 256 + bj * 128 + c0 + j] = v; }
            asm volatile("s_waitcnt lgkmcnt(0)" ::: "memory"); __builtin_amdgcn_s_barrier(); asm volatile("" ::: "memory");
            const int t = (wr * 4 + wc) * 64 + fq * 16 + fr;
            if (t < 256) Kp_[(size_t)u.pm * 512 + u.pn * 256 + t] = CS[t] + CS[256 + t];
        }
    }
};

struct Args { const void* in[21]; float* out; unsigned char* ws; };

__device__ __forceinline__ void p0_transpose_item(const float* W, int K, int N, bf16* WT, int row_off, int mode, const float* gain, LAS float* scr, int item, int lane) {
    const int nblk = N / 64, kb = item / nblk, nb = item % nblk, k0 = 64 * kb, n0 = 64 * nb;
    const int r = lane >> 4, c4 = lane & 15;
#pragma unroll
    for (int i = 0; i < 16; ++i) { const int kk = 4 * i + r; f32x4 w = __builtin_nontemporal_load((const f32x4*)(W + (size_t)(k0 + kk) * N + n0 + 4 * c4)); if (gain) w *= gain[k0 + kk]; *(LAS f32x4*)(scr + kk * 68 + 4 * c4) = w; }
    LDS_WAIT(); asm volatile("" ::: "memory");
    const int c = lane & 7;
    int d0;
    if (mode == 0) d0 = row_off + n0;
    else { const int j = (n0 < DFF) ? n0 : n0 - DFF; d0 = 256 * (j >> 7) + (j & 127) + ((n0 < DFF) ? 0 : 128); }
#pragma unroll
    for (int j = 0; j < 8; ++j) { const int n = (lane >> 3) + 8 * j; const LAS float* sp = scr + (8 * c) * 68 + n;
        v4u o; o.x = pk2(sp[0 * 68], sp[1 * 68]); o.y = pk2(sp[2 * 68], sp[3 * 68]); o.z = pk2(sp[4 * 68], sp[5 * 68]); o.w = pk2(sp[6 * 68], sp[7 * 68]);
        *(v4u*)(WT + (size_t)(d0 + n) * K + k0 + 8 * c) = o; }
    LDS_WAIT(); asm volatile("" ::: "memory");
}

constexpr int KS_P = 144;
constexpr int KS_BYTES = 256 * KS_P * 2;
typedef short v4i16_t __attribute__((ext_vector_type(4)));
__device__ __forceinline__ v2u tr_read(const LAS bf16* p) { return __builtin_bit_cast(v2u, __builtin_amdgcn_ds_read_tr16_b64_v4i16((LAS v4i16_t*)p)); }
template <int NKT> __device__ __forceinline__ void attn_scores(const LAS bf16* Ks, const bf16x8 (&qf)[4], f32x4 (&acc)[16], int nkt, int fr, int fq) {
#pragma unroll
    for (int kt = 0; kt < NKT; ++kt) {
        acc[kt] = (f32x4){0.f, 0.f, 0.f, 0.f};
        if (kt < nkt) {
#pragma unroll
            for (int ks = 0; ks < 4; ++ks) { const bf16x8 a = *(const LAS bf16x8*)(Ks + (16 * kt + fr) * KS_P + 32 * ks + 8 * fq); acc[kt] = MFMA16(a, qf[ks], acc[kt]); }
        }
    }
}
__device__ __forceinline__ void attn_pv(const LAS bf16* Vr, const f32x4 (&acc)[16], f32x4 (&O)[8], int nj, int fr, int fq) {
#pragma unroll
    for (int j = 0; j < 8; ++j) {
        if (j < nj) {
            v4u pw; pw.x = cvt_pk_bf16(acc[2 * j][0], acc[2 * j][1]); pw.y = cvt_pk_bf16(acc[2 * j][2], acc[2 * j][3]); pw.z = cvt_pk_bf16(acc[2 * j + 1][0], acc[2 * j + 1][1]); pw.w = cvt_pk_bf16(acc[2 * j + 1][2], acc[2 * j + 1][3]);
            const bf16x8 pf = __builtin_bit_cast(bf16x8, pw);
            const LAS bf16* vb = Vr + (32 * j + 4 * fq + (fr >> 2)) * KS_P + 4 * (fr & 3);
#pragma unroll
            for (int vt = 0; vt < 8; ++vt) {
                const v2u lo = tr_read(vb + 16 * vt), hi = tr_read(vb + 16 * KS_P + 16 * vt);
                const v4u aw = {lo.x, lo.y, hi.x, hi.y};
                O[vt] = MFMA16(__builtin_bit_cast(bf16x8, aw), pf, O[vt]);
            }
        }
    }
}

template <int NT> __device__ __forceinline__ void tail_gemm(LAS unsigned char* lds, const bf16* A, const bf16* Bt, int K, int n0, int rowhalf, f32x4 (&acc)[NT], int tidx) {
    int tid_o = tidx; asm volatile("" : "+v"(tid_o));
    const int tid = tid_o, lane = tid & 63, wave = __builtin_amdgcn_readfirstlane(tid >> 6), fr = lane & 15, fq = lane >> 4;
    const int rt = wave & 3, kh = wave >> 2; const int Kh = K >> 1;
    const int KC = (K == 2048) ? 1024 : 1408;
    const int NCH = Kh / KC, PB = KC + 8, UPR = KC >> 3, NS = KC >> 7;
    LAS bf16* Bs = (LAS bf16*)(lds + 8192);
    const bf16* ap = A + (size_t)(64 * rowhalf + 16 * rt + fr) * K + kh * Kh + 8 * fq;
    const LAS bf16* bl = Bs + (kh * 16 * NT + fr) * PB + 8 * fq;
#pragma unroll
    for (int t = 0; t < NT; ++t) acc[t] = (f32x4){0.f, 0.f, 0.f, 0.f};
#define TG_LDA(a_, k0_) do { _Pragma("unroll") for (int s_ = 0; s_ < 4; ++s_) a_[s_] = *(const bf16x8*)(ap + (k0_) + 32 * s_); } while (0)
#define TG_MMA(a_, kl_) do { _Pragma("unroll") for (int s_ = 0; s_ < 4; ++s_) { _Pragma("unroll") for (int t_ = 0; t_ < NT; ++t_) { \
        const bf16x8 b_ = *(const LAS bf16x8*)(bl + t_ * 16 * PB + (kl_) + 32 * s_); acc[t_] = MFMA16(b_, a_[s_], acc[t_]); } } } while (0)
    for (int ch = 0; ch < NCH; ++ch) {
        const int kb = ch * KC;
        bf16x8 a0[4], a1[4], a2[4], a3[4];
        TG_LDA(a0, kb); TG_LDA(a1, kb + 128); TG_LDA(a2, kb + 256); TG_LDA(a3, kb + 384);
        const int NU = 2 * 16 * NT * UPR;
        for (int u = tid; u < NU; u += NTHR) { const int r2 = u / UPR, kc = u - r2 * UPR; const int khh = (r2 >= 16 * NT) ? 1 : 0, row = r2 - khh * 16 * NT;
            const v4u w = *(const v4u*)(Bt + (size_t)(n0 + row) * K + khh * Kh + kb + 8 * kc); *(LAS v4u*)(Bs + r2 * PB + 8 * kc) = w; }
        __syncthreads();
        for (int st = 0; st < NS; st += 4) {
            TG_MMA(a0, 128 * st);           if (st + 4 < NS) TG_LDA(a0, kb + 128 * (st + 4));
            if (st + 1 < NS) { TG_MMA(a1, 128 * (st + 1)); if (st + 5 < NS) TG_LDA(a1, kb + 128 * (st + 5)); }
            if (st + 2 < NS) { TG_MMA(a2, 128 * (st + 2)); if (st + 6 < NS) TG_LDA(a2, kb + 128 * (st + 6)); }
            if (st + 3 < NS) { TG_MMA(a3, 128 * (st + 3)); if (st + 7 < NS) TG_LDA(a3, kb + 128 * (st + 7)); }
        }
        __syncthreads();
    }
#undef TG_LDA
#undef TG_MMA
    LAS f32x4* red = (LAS f32x4*)lds;
    if (kh == 1) {
#pragma unroll
        for (int t = 0; t < NT; ++t) red[(t * 4 + rt) * 64 + lane] = acc[t];
    }
    __syncthreads();
    if (kh == 0) {
#pragma unroll
        for (int t = 0; t < NT; ++t) acc[t] += red[(t * 4 + rt) * 64 + lane];
    }
    __syncthreads();
}

__device__ __forceinline__ void kmean_items(LAS unsigned char* lds, const float* cache_k_, const int* ptab_, float* Kms_, int i0, int i1, int c0, int cn, int tidx) {
    int tid_o = tidx; asm volatile("" : "+v"(tid_o)); const int tid = tid_o;
    const int me = (int)blockIdx.x - c0; if (me < 0 || me >= cn) return;
    LAS f32x4* redk = (LAS f32x4*)(lds);
    for (int item = i0 + me; item < i1; item += cn) {
        const int b = item >> 5, n = item & 31; const int c4 = tid & 127, rg = tid >> 7;
        f32x4 a = {0.f, 0.f, 0.f, 0.f};
#pragma unroll
        for (int hp = 0; hp < 2; ++hp) { const int page = ptab_[b * NPAGES + 2 * n + hp]; const f32x4* pp = (const f32x4*)(cache_k_ + (size_t)page * PAGE * 512) + c4;
#pragma unroll 16
            for (int r = rg; r < 128; r += 4) a += __builtin_nontemporal_load(pp + (size_t)r * 128); }
        redk[rg * 128 + c4] = a;
        __syncthreads();
        if (tid < 128) { const f32x4 s4 = (redk[tid] + redk[128 + tid]) + (redk[256 + tid] + redk[384 + tid]); *(f32x4*)(Kms_ + (size_t)item * 512 + 4 * tid) = s4 * (1.0f / 256.0f); }
        __syncthreads();
    }
}

__global__ void __launch_bounds__(NTHR, 2) yoco_fwd(Args args) {
    extern __shared__ __attribute__((aligned(16))) unsigned char lds_raw[];
    LAS unsigned char* lds = (LAS unsigned char*)lds_raw;
#define TIDS int tid_o = TIDX; asm volatile("" : "+v"(tid_o)); const int tid = tid_o, lane = tid & 63, wave = __builtin_amdgcn_readfirstlane(tid >> 6), fr = lane & 15, fq = lane >> 4; (void)fr; (void)fq; (void)wave; (void)lane; (void)tid
    const int G = gridDim.x, bid = blockIdx.x;
    unsigned char* ws = args.ws;
    unsigned* ctl = (unsigned*)(ws + WS_CTL);
    volatile LAS unsigned* MISC = (volatile LAS unsigned*)(lds + MISC_OFF);
    const int wave_sg = __builtin_amdgcn_readfirstlane((int)threadIdx.x & ~63);
#define TIDX (wave_sg + lane_id())
#define IS_T0 ((wave_sg == 0) && (lane_id() == 0))
    if (TIDX < 64) MISC[TIDX] = 0u;
    __syncthreads();
    XcdBarrier bar = xcd_barrier_post(ctl + CW_BAR, MISC + 8, IS_T0);
#ifdef PROF_A
    int n_stamp = 0;
#define STAMP() do { if (blockIdx.x == 0 && IS_T0) MISC[16 + n_stamp] = (unsigned)__builtin_amdgcn_s_memrealtime(); ++n_stamp; } while (0)
#define TNOW() ((unsigned)__builtin_amdgcn_s_memrealtime())
#define TACC(k, t0) do { if (blockIdx.x == 0 && IS_T0) MISC[40 + (k)] += TNOW() - (t0); } while (0)
#define PVAL(a0, a1) (((a0) >= 100) ? MISC[40 + (a0) - 100] : (MISC[16 + (a1)] - MISC[16 + (a0)]))
#else
#define STAMP() do {} while (0)
#define TNOW() 0u
#define TACC(k, t0) do { (void)(t0); } while (0)
#endif
    STAMP();

#define x_p ((const float*)args.in[0])
#define x_s ((const float*)args.in[1])
#define st_in ((const float*)args.in[2])
#define cache_k ((const float*)args.in[3])
#define cache_v ((const float*)args.in[4])
#define ptab ((const int*)args.in[5])
#define norm_mix_a ((const float*)args.in[6])
#define w_in ((const float*)args.in[7])
#define lbl ((const float*)args.in[8])
#define onorm ((const float*)args.in[9])
#define w_out ((const float*)args.in[10])
#define norm_kv ((const float*)args.in[11])
#define w_kv ((const float*)args.in[12])
#define k_norm ((const float*)args.in[13])
#define norm_mix_b ((const float*)args.in[14])
#define w_q ((const float*)args.in[15])
#define q_norm ((const float*)args.in[16])
#define w_o ((const float*)args.in[17])
#define norm_ffn ((const float*)args.in[18])
#define w_gu ((const float*)args.in[19])
#define w_dn ((const float*)args.in[20])
#define Win_t ((bf16*)(ws + WS_WIN))
#define Wout_t ((bf16*)(ws + WS_WOUT))
#define Wgu0_t ((bf16*)(ws + WS_WGU0))
#define Wdn0_t ((bf16*)(ws + WS_WDN0))
#define Wkvq_t ((bf16*)(ws + WS_WKVQ))
#define Wo_t ((bf16*)(ws + WS_WO))
#define Wgu1_t ((bf16*)(ws + WS_WGU1))
#define Wdn1_t ((bf16*)(ws + WS_WDN1))
#define Hb0 ((bf16*)(ws + WS_HB0))
#define Hb1 ((bf16*)(ws + WS_HB1))
#define Hb2 ((bf16*)(ws + WS_HB2))
#define Hb3 ((bf16*)(ws + WS_HB3))
#define Hf1 ((float*)(ws + WS_HF1))
#define Hf2 ((float*)(ws + WS_HF2))
#define Hf3 ((float*)(ws + WS_HF3))
#define Qg ((bf16*)(ws + WS_QG))
#define Vg ((bf16*)(ws + WS_VG))
#define Gg ((bf16*)(ws + WS_GG))
#define Ff ((f16*)(ws + WS_F))
#define Ob ((bf16*)(ws + WS_OB))
#define At ((bf16*)(ws + WS_AT))
#define Hm ((bf16*)(ws + WS_HM))
#define Ub ((bf16*)(ws + WS_U))
#define Sst ((bf16*)(ws + WS_SST))
#define Dec ((float*)(ws + WS_DEC))
#define Kraw ((float*)(ws + WS_KRAW))
#define Vraw ((float*)(ws + WS_VRAW))
#define Qraw ((bf16*)(ws + WS_QRAW))
#define Kb ((bf16*)(ws + WS_KB))
#define Vb ((bf16*)(ws + WS_VB))
#define Qb ((bf16*)(ws + WS_QB))
#define Kpart ((float*)(ws + WS_KPART))
#define Kms ((float*)(ws + WS_KMS))
#define Subl ((unsigned*)(ws + WS_SUBL))
#define Scnt ((unsigned*)(ws + WS_SCNT))
#define Sels ((unsigned*)(ws + WS_SCNT + 256 * 1024))
#define Oslot ((bf16*)(ws + WS_OSLOT))
#define MLslot ((float*)(ws + WS_MLSLOT))
#define Sslot ((float*)(ws + WS_SSLOT))
#define ss0 ((float*)(ctl + CW_SS0))
#define ss1 ((float*)(ctl + CW_SS1))
#define ss2 ((float*)(ctl + CW_SS2))
#define ss3 ((float*)(ctl + CW_SS3))
#define out (args.out)
    {
        TIDS;
        LAS float* scr = (LAS float*)(lds + wave * 17408);
        const int gw = bid * NWAVES + wave, NGW = G * NWAVES;
        constexpr int I_IN = 32 * 128, I_SQ = 32 * 32, I_GU = 32 * 176, I_DN = 88 * 32, I_KV = 32 * 16;
        constexpr int NITEMS = I_IN + I_SQ + 2 * I_GU + 2 * I_DN + I_KV + I_SQ + I_SQ;
        for (int it = gw; it < NITEMS; it += NGW) {
            int r = it;
            if (r < I_IN) { p0_transpose_item(w_in, D, 4 * D, Win_t, 0, 0, norm_mix_a, scr, r, lane); continue; } r -= I_IN;
            if (r < I_SQ) { p0_transpose_item(w_out, D, D, Wout_t, 0, 0, nullptr, scr, r, lane); continue; } r -= I_SQ;
            if (r < I_GU) { p0_transpose_item(w_gu, D, NGU, Wgu0_t, 0, 1, norm_ffn, scr, r, lane); continue; } r -= I_GU;
            if (r < I_GU) { p0_transpose_item(w_gu + (size_t)D * NGU, D, NGU, Wgu1_t, 0, 1, norm_ffn + D, scr, r, lane); continue; } r -= I_GU;
            if (r < I_DN) { p0_transpose_item(w_dn, DFF, D, Wdn0_t, 0, 0, nullptr, scr, r, lane); continue; } r -= I_DN;
            if (r < I_DN) { p0_transpose_item(w_dn + (size_t)DFF * D, DFF, D, Wdn1_t, 0, 0, nullptr, scr, r, lane); continue; } r -= I_DN;
            if (r < I_KV) { p0_transpose_item(w_kv, D, 1024, Wkvq_t, 0, 0, norm_kv, scr, r, lane); continue; } r -= I_KV;
            if (r < I_SQ) { p0_transpose_item(w_q, D, D, Wkvq_t, 1024, 0, norm_mix_b, scr, r, lane); continue; } r -= I_SQ;
            p0_transpose_item(w_o, D, D, Wo_t, 0, 0, nullptr, scr, r, lane);
        }
        for (int m = gw; m < MR; m += NGW) {
            const float* src = (m < SEQ) ? x_p + (size_t)m * D : x_s + (size_t)(m - SEQ) * D;
            const f32x4* xr = (const f32x4*)src + lane; f32x4 v[8]; float s = 0.f;
#pragma unroll
            for (int j = 0; j < 8; ++j) { v[j] = __builtin_nontemporal_load(xr + 64 * j); s += (v[j].x * v[j].x + v[j].y * v[j].y) + (v[j].z * v[j].z + v[j].w * v[j].w); }
            s = wave_sum(s);
            if (lane == 0) ss0[m] = s;
            v2u* o8 = (v2u*)(Hb0 + (size_t)m * D) + lane;
#pragma unroll
            for (int j = 0; j < 8; ++j) { v2u w; w.x = pk2(v[j].x, v[j].y); w.y = pk2(v[j].z, v[j].w); o8[64 * j] = w; }
        }
        __syncthreads();
        kmean_items(lds, cache_k, ptab, Kms, 848, DECB * NBLK, 0, G, TIDX);
    }
    xcd_barrier(bar, IS_T0);
    STAMP();

    {
        TIDS;
        pg8::Gemm g{Hb0, Win_t, SEQ, 4 * D, D}; pg8::StaticOrder S; S.init(SEQ, 4 * D, G, bid);
        EpiIn E{ss0, lbl, Qg, Ff};
        pg8::gemm_phase<EpiIn, pg8::StaticOrder, true, true, false>(lds, g, S, E, TIDX);
        for (int it2 = 0; it2 < 2; ++it2) {
            const int w2 = bid + 256 * it2, t2 = w2 & 255, rh = (w2 >> 8) & 1;
            TIDS; f32x4 ta[2]; tail_gemm<2>(lds, Hb0 + (size_t)SEQ * D, Win_t, D, 32 * t2, rh, ta, TIDX);
            if (wave < 4) { const int row = SEQ + 64 * rh + 16 * wave + fr; E.tail(row, 32 * t2 + 4 * fq, ta[0]); E.tail(row, 32 * t2 + 16 + 4 * fq, ta[1]); }
        }
    }
    xcd_barrier(bar, IS_T0);
    STAMP();

    {
        TIDS;
        LAS float* tot = (LAS float*)(lds);
        LAS bf16* koT = (LAS bf16*)(lds + 4096);
        LAS bf16* Vr = (LAS bf16*)(lds + 4096 + 128 * 72 * 2);
        const int col = tid & 127, part = tid >> 7; const int vt_t = tid >> 3, vd0 = (tid & 7) * 16;
        f16 fN[16]; v4u vaN, vbN;
#define P2_LOADN(it_) do { const int h_ = (it_) >> 7, r0_ = ((it_) & 127) * 64; const f16* fp_ = Ff + (size_t)(r0_ + part * 16) * D + h_ * 128 + col; \
            _Pragma("unroll") for (int i = 0; i < 16; ++i) fN[i] = fp_[(size_t)i * D]; \
            const bf16* vp_ = Vg + (size_t)(r0_ + vt_t) * D + h_ * 128 + vd0; vaN = *(const v4u*)vp_; vbN = *(const v4u*)(vp_ + 8); } while (0)
        if (bid < NH * NCHUNK) P2_LOADN(bid);
        for (int item = bid; item < NH * NCHUNK; item += G) {
            float cum[16], kk[16]; float run = 0.f;
#pragma unroll
            for (int i = 0; i < 16; ++i) { const float f = (float)fN[i]; kk[i] = 1.0f - f; run += __logf(f); cum[i] = run; }
            tot[part * 128 + col] = run;
            *(LAS v4u*)(Vr + vt_t * 144 + vd0) = vaN; *(LAS v4u*)(Vr + vt_t * 144 + vd0 + 8) = vbN;
            if (item + G < NH * NCHUNK) P2_LOADN(item + G);
            __syncthreads();
            float offs = 0.f, lastv = 0.f;
#pragma unroll
            for (int p = 0; p < 4; ++p) { const float tv = tot[p * 128 + col]; lastv += tv; if (p < part) offs += tv; }
            unsigned kw[8];
#pragma unroll
            for (int i = 0; i < 8; ++i) { const float a = kk[2 * i] * __expf(lastv - (cum[2 * i] + offs)), b = kk[2 * i + 1] * __expf(lastv - (cum[2 * i + 1] + offs)); kw[i] = pk2(a, b); }
            *(LAS v4u*)(koT + col * 72 + part * 16) = (v4u){kw[0], kw[1], kw[2], kw[3]};
            *(LAS v4u*)(koT + col * 72 + part * 16 + 8) = (v4u){kw[4], kw[5], kw[6], kw[7]};
            if (part == 0) Dec[(size_t)item * 128 + col] = __expf(lastv);
            __syncthreads();
            { bf16x8 a[2]; a[0] = *(const LAS bf16x8*)(koT + (16 * wave + fr) * 72 + 8 * fq); a[1] = *(const LAS bf16x8*)(koT + (16 * wave + fr) * 72 + 32 + 8 * fq);
              bf16* ub = Ub + (size_t)item * 16384;
              const LAS bf16* vb = Vr + (8 * fq + (fr >> 2)) * 144 + 4 * (fr & 3);
#pragma unroll
              for (int vt = 0; vt < 8; ++vt) {
                  f32x4 acc = {0.f, 0.f, 0.f, 0.f};
                  const v2u l0 = tr_read(vb + 16 * vt), h0 = tr_read(vb + 4 * 144 + 16 * vt), l1 = tr_read(vb + 32 * 144 + 16 * vt), h1 = tr_read(vb + 36 * 144 + 16 * vt);
                  const v4u b0 = {l0.x, l0.y, h0.x, h0.y}, b1 = {l1.x, l1.y, h1.x, h1.y};
                  acc = MFMA16(a[0], __builtin_bit_cast(bf16x8, b0), acc); acc = MFMA16(a[1], __builtin_bit_cast(bf16x8, b1), acc);
                  v2u w; w.x = pk2(acc[0], acc[1]); w.y = pk2(acc[2], acc[3]);
                  *(v2u*)(ub + (size_t)(16 * vt + fr) * 128 + 16 * wave + 4 * fq) = w;
              } }
            __syncthreads();
        }
#undef P2_LOADN
        LAS float* red = (LAS float*)(lds);
        LAS float* red2 = (LAS float*)(lds + 8192);
        float* st_out = out + OST_S;
        for (int item = bid; item < DECB * NH; item += G) {
            const int b = item >> 4, h = item & 15; const int vd = tid & 127, kq = tid >> 7;
            const float* sp = st_in + ((size_t)(b * NH + h) * 128 + 32 * kq) * 128 + vd;
            float Sx[32];
#pragma unroll
            for (int i = 0; i < 32; ++i) Sx[i] = __builtin_nontemporal_load(sp + (size_t)i * 128);
#pragma unroll
            for (int t = 0; t < 4; ++t) {
                const int row = SEQ + 4 * b + t; const size_t ro = (size_t)row * D + h * 128;
                const float v = bf2f(Vg[ro + vd]); float op = 0.f;
#pragma unroll
                for (int i = 0; i < 32; ++i) { const float f = (float)Ff[ro + 32 * kq + i]; const float q = bf2f(Qg[ro + 32 * kq + i]); Sx[i] = f * Sx[i] + (1.0f - f) * v; op += Sx[i] * q; }
                red[(t * 4 + kq) * 128 + vd] = op;
            }
            float* so = st_out + ((size_t)(b * NH + h) * 128 + 32 * kq) * 128 + vd;
#pragma unroll
            for (int i = 0; i < 32; ++i) __builtin_nontemporal_store(Sx[i], so + (size_t)i * 128);
            __syncthreads();
            { const int t = tid >> 7; const float o = (red[(t * 4 + 0) * 128 + vd] + red[(t * 4 + 1) * 128 + vd]) + (red[(t * 4 + 2) * 128 + vd] + red[(t * 4 + 3) * 128 + vd]);
              const float s = wave_sum(o * o); if (lane == 0) red2[t * 2 + (wave & 1)] = s;
              __syncthreads();
              const float r = rsqrtf((red2[t * 2] + red2[t * 2 + 1]) * (1.0f / 128.0f) + EPS);
              const int row = SEQ + 4 * b + t; const size_t ro = (size_t)row * D + h * 128 + vd;
              Ob[ro] = (bf16)f2bf(o * r * onorm[vd] * bf2f(Gg[ro])); }
            __syncthreads();
        }
    }
    xcd_barrier(bar, IS_T0);
    STAMP();

    {
        TIDS;
        for (int gid = bid * NTHR + tid; gid < NH * 128 * 32; gid += G * NTHR) {
            const int h = gid >> 12, rem = gid & 4095, vd = rem >> 5, k = (rem & 31) * 4;
            float s0 = 0.f, s1 = 0.f, s2 = 0.f, s3 = 0.f;
            const v2u* up = (const v2u*)(Ub + ((size_t)h * 128 * 128 + vd) * 128 + k);
            v2u* sp = (v2u*)(Sst + ((size_t)h * 128 * 128 + vd) * 128 + k);
            const f32x4* dp = (const f32x4*)(Dec + (size_t)h * 128 * 128 + k);
#pragma unroll 16
            for (int c = 0; c < NCHUNK; ++c) {
                const v2u u = up[(size_t)c * 4096]; const f32x4 d = dp[(size_t)c * 32];
                v2u w; w.x = pk2(s0, s1); w.y = pk2(s2, s3); sp[(size_t)c * 4096] = w;
                s0 = d.x * s0 + bf2f(u.x & 0xffffu); s1 = d.y * s1 + bf2f(u.x >> 16); s2 = d.z * s2 + bf2f(u.y & 0xffffu); s3 = d.w * s3 + bf2f(u.y >> 16);
            }
            float* so = out + OST_P + ((size_t)h * 128 + k) * 128 + vd;
            so[0] = s0; so[128] = s1; so[256] = s2; so[384] = s3;
        }
    }
    xcd_barrier(bar, IS_T0);
    STAMP();

    {
        TIDS;
        LAS float* tot = (LAS float*)(lds);
        LAS float* refs = (LAS float*)(lds + 2048);
        LAS float* red = (LAS float*)(lds + 2560);
        LAS bf16* QE = (LAS bf16*)(lds + 4096);
        LAS bf16* KE = QE + 64 * 136;
        LAS bf16* QI = KE + 64 * 136;
        LAS bf16* Vr = QI + 64 * 136;
        LAS bf16* STs = Vr + 64 * 144;
        const int col = tid & 127, part = tid >> 7; const int vt_t = tid >> 3, vd0 = (tid & 7) * 16;
        const int tt = wave & 3, vh = wave >> 2;
        f16 fN[16]; bf16 qN[16]; v4u vaN, vbN, stN[4];
#define P4_LOADN(it_) do { const int h_ = (it_) >> 7, r0_ = ((it_) & 127) * 64; const f16* fp_ = Ff + (size_t)(r0_ + part * 16) * D + h_ * 128 + col; const bf16* qp_ = Qg + (size_t)(r0_ + part * 16) * D + h_ * 128 + col; \
            _Pragma("unroll") for (int i = 0; i < 16; ++i) { fN[i] = fp_[(size_t)i * D]; qN[i] = qp_[(size_t)i * D]; } \
            const bf16* vp_ = Vg + (size_t)(r0_ + vt_t) * D + h_ * 128 + vd0; vaN = *(const v4u*)vp_; vbN = *(const v4u*)(vp_ + 8); \
            const v4u* sp_ = (const v4u*)(Sst + (size_t)(it_) * 16384); _Pragma("unroll") for (int i = 0; i < 4; ++i) stN[i] = sp_[i * 512 + tid]; } while (0)
        if (bid < NH * NCHUNK) P4_LOADN(bid);
        for (int item = bid; item < NH * NCHUNK; item += G) {
            const int h = item >> 7, c = item & 127; const int row0 = c * 64;
            float cum[16], kk[16], qv[16]; float run = 0.f;
#pragma unroll
            for (int i = 0; i < 16; ++i) { const float f = (float)fN[i]; kk[i] = 1.0f - f; run += __logf(f); cum[i] = run; qv[i] = bf2f(qN[i]); }
            tot[part * 128 + col] = run;
            *(LAS v4u*)(Vr + vt_t * 144 + vd0) = vaN; *(LAS v4u*)(Vr + vt_t * 144 + vd0 + 8) = vbN;
#pragma unroll
            for (int i = 0; i < 4; ++i) { const int idx = i * 512 + tid, vd = idx >> 4, k8 = idx & 15; *(LAS v4u*)(STs + vd * 136 + k8 * 8) = stN[i]; }
            const size_t ro = (size_t)(row0 + 16 * tt + fr) * D + h * 128;
            v2u gw2[4]; f32x4 on[4];
#pragma unroll
            for (int vt = 0; vt < 4; ++vt) { const int vd = 16 * (4 * vh + vt) + 4 * fq; gw2[vt] = *(const v2u*)(Gg + ro + vd); on[vt] = *(const f32x4*)(onorm + vd); }
            if (item + G < NH * NCHUNK) P4_LOADN(item + G);
            __syncthreads();
            float offs = 0.f;
#pragma unroll
            for (int p = 0; p < 4; ++p) { const float tv = tot[p * 128 + col]; if (p < part) offs += tv; }
            if (part == 1) refs[col] = cum[15] + offs;
            __syncthreads();
            const float ref = refs[col];
#pragma unroll
            for (int i = 0; i < 16; ++i) { const float cm = cum[i] + offs, d1 = cm - ref; const int t = part * 16 + i;
                QE[t * 136 + col] = (bf16)f2bf(qv[i] * __expf(d1)); KE[t * 136 + col] = (bf16)f2bf(kk[i] * __expf(-d1)); QI[t * 136 + col] = (bf16)f2bf(qv[i] * __expf(cm)); }
            __syncthreads();
            {
                f32x4 aS[4];
#pragma unroll
                for (int st = 0; st < 4; ++st) {
                    aS[st] = (f32x4){0.f, 0.f, 0.f, 0.f};
                    if (st <= tt) {
#pragma unroll
                        for (int ks = 0; ks < 4; ++ks) { const bf16x8 a = *(const LAS bf16x8*)(KE + (16 * st + fr) * 136 + 32 * ks + 8 * fq), b = *(const LAS bf16x8*)(QE + (16 * tt + fr) * 136 + 32 * ks + 8 * fq); aS[st] = MFMA16(a, b, aS[st]); }
                        if (st == tt) {
#pragma unroll
                            for (int r = 0; r < 4; ++r) if (4 * fq + r > fr) aS[st][r] = 0.f;
                        }
                    }
                }
                f32x4 o[4];
#pragma unroll
                for (int vt = 0; vt < 4; ++vt) o[vt] = (f32x4){0.f, 0.f, 0.f, 0.f};
#pragma unroll
                for (int j = 0; j < 2; ++j) {
                    v4u pw; pw.x = cvt_pk_bf16(aS[2 * j][0], aS[2 * j][1]); pw.y = cvt_pk_bf16(aS[2 * j][2], aS[2 * j][3]); pw.z = cvt_pk_bf16(aS[2 * j + 1][0], aS[2 * j + 1][1]); pw.w = cvt_pk_bf16(aS[2 * j + 1][2], aS[2 * j + 1][3]);
                    const bf16x8 pf = __builtin_bit_cast(bf16x8, pw);
                    const LAS bf16* vb = Vr + (32 * j + 4 * fq + (fr >> 2)) * 144 + 64 * vh + 4 * (fr & 3);
#pragma unroll
                    for (int vt = 0; vt < 4; ++vt) { const v2u lo = tr_read(vb + 16 * vt), hi = tr_read(vb + 16 * 144 + 16 * vt); const v4u aw = {lo.x, lo.y, hi.x, hi.y};
                        o[vt] = MFMA16(__builtin_bit_cast(bf16x8, aw), pf, o[vt]); }
                }
#pragma unroll
                for (int ks = 0; ks < 4; ++ks) { const bf16x8 b = *(const LAS bf16x8*)(QI + (16 * tt + fr) * 136 + 32 * ks + 8 * fq);
#pragma unroll
                    for (int vt = 0; vt < 4; ++vt) { const bf16x8 a = *(const LAS bf16x8*)(STs + (16 * (4 * vh + vt) + fr) * 136 + 32 * ks + 8 * fq); o[vt] = MFMA16(a, b, o[vt]); } }
                float sq = 0.f;
#pragma unroll
                for (int vt = 0; vt < 4; ++vt) sq += (o[vt][0] * o[vt][0] + o[vt][1] * o[vt][1]) + (o[vt][2] * o[vt][2] + o[vt][3] * o[vt][3]);
                sq += shx<16>(sq); sq = xadd32(sq);
                if (fq == 0) red[(16 * tt + fr) * 2 + vh] = sq;
                __syncthreads();
                const float r = rsqrtf((red[(16 * tt + fr) * 2] + red[(16 * tt + fr) * 2 + 1]) * (1.0f / 128.0f) + EPS);
#pragma unroll
                for (int vt = 0; vt < 4; ++vt) { const int vd = 16 * (4 * vh + vt) + 4 * fq;
                    const float g0 = bf2f(gw2[vt].x & 0xffffu), g1 = bf2f(gw2[vt].x >> 16), g2 = bf2f(gw2[vt].y & 0xffffu), g3 = bf2f(gw2[vt].y >> 16);
                    v2u w; w.x = cvt_pk_bf16(o[vt][0] * r * on[vt][0] * g0, o[vt][1] * r * on[vt][1] * g1); w.y = cvt_pk_bf16(o[vt][2] * r * on[vt][2] * g2, o[vt][3] * r * on[vt][3] * g3);
                    *(v2u*)(Ob + ro + vd) = w; }
            }
            __syncthreads();
        }
#undef P4_LOADN
    }
    xcd_barrier(bar, IS_T0);
    STAMP();

    {
        TIDS;
        pg8::Gemm g{Ob, Wout_t, SEQ, D, D}; pg8::StaticOrder S; S.init(SEQ, D, G, bid);
        EpiRes<1> E{Hb0, nullptr, nullptr, Hb1, ss1};
        const unsigned tg0 = TNOW();
        pg8::gemm_phase<EpiRes<1>, pg8::StaticOrder, true, true, false>(lds, g, S, E, TIDX);
        TACC(5, tg0); const unsigned tg1 = TNOW();
        { const int t2 = bid & 127, rh = (bid >> 7) & 1; TIDS; f32x4 ta[1]; tail_gemm<1>(lds, Ob + (size_t)SEQ * D, Wout_t, D, 16 * t2, rh, ta, TIDX); if (wave < 4) E.tail(SEQ + 64 * rh + 16 * wave + fr, 16 * t2 + 4 * fq, ta[0], fq); }
        TACC(6, tg1);
    }
    xcd_barrier(bar, IS_T0);
    STAMP();
    {
        TIDS;
        pg8::Gemm g{Hb1, Wgu0_t, MP, NGU, D}; pg8::StaticOrder S; S.init(MP, NGU, G, bid);
        EpiGU E{ss1, Hm};
        pg8::gemm_phase<EpiGU, pg8::StaticOrder, true, true>(lds, g, S, E, TIDX);
        kmean_items(lds, cache_k, ptab, Kms, 0, 336, 172, G - 172, TIDX);
    }
    xcd_barrier(bar, IS_T0);
    STAMP();
    {
        TIDS;
        pg8::Gemm g{Hm, Wdn0_t, SEQ, D, DFF}; pg8::StaticOrder S; S.init(SEQ, D, G, bid);
        EpiRes<1> E{Hb1, nullptr, nullptr, Hb2, ss2};
        const unsigned tg0 = TNOW();
        pg8::gemm_phase<EpiRes<1>, pg8::StaticOrder, true, true, false>(lds, g, S, E, TIDX);
        TACC(7, tg0); const unsigned tg1 = TNOW();
        { const int t2 = bid & 127, rh = (bid >> 7) & 1; TIDS; f32x4 ta[1]; tail_gemm<1>(lds, Hm + (size_t)SEQ * DFF, Wdn0_t, DFF, 16 * t2, rh, ta, TIDX); if (wave < 4) E.tail(SEQ + 64 * rh + 16 * wave + fr, 16 * t2 + 4 * fq, ta[0], fq); }
        TACC(8, tg1);
    }
    xcd_barrier(bar, IS_T0);
    STAMP();
    {
        TIDS;
        pg8::Gemm g{Hb2, Wkvq_t, MP, 3072, D}; pg8::StaticOrder S; S.init(MP, 3072, G, bid);
        EpiKVQ E{ss2, ws, out, k_norm, q_norm, lds + 131072};
        pg8::gemm_phase<EpiKVQ, pg8::StaticOrder, true, true>(lds, g, S, E, TIDX);
        kmean_items(lds, cache_k, ptab, Kms, 336, 848, 140, G - 140, TIDX);
    }
    xcd_barrier(bar, IS_T0);
    STAMP();

    {
        TIDS;
        LAS bf16* KMb = (LAS bf16*)(lds);
        LAS unsigned* lcnt = (LAS unsigned*)(lds + 16384);
        LAS float* gs = (LAS float*)(lds + 16384 + 256);
#define G_BETTER(va, ia, vb, ib) (((va) > (vb)) || (((va) == (vb)) && ((ia) < (ib))))
#define G_INSERT(vx, ix) do { const float vx_ = (vx); const int ix_ = (ix); \
            if (G_BETTER(vx_, ix_, v0, i0)) { v2 = v1; i2 = i1; v1 = v0; i1 = i0; v0 = vx_; i0 = ix_; } \
            else if (G_BETTER(vx_, ix_, v1, i1)) { v2 = v1; i2 = i1; v1 = vx_; i1 = ix_; } \
            else if (G_BETTER(vx_, ix_, v2, i2)) { v2 = vx_; i2 = ix_; } } while (0)
        for (int item = bid; item < 256; item += G) {
            const int j = item >> 2, kvh = item & 3; const int b = j >> 1;
            { const int n = tid >> 4, d8 = (tid & 15) * 8; f32x4 s0 = {0.f, 0.f, 0.f, 0.f}, s1 = {0.f, 0.f, 0.f, 0.f};
              if (n < b) { const float* kp = Kpart + (size_t)n * 512 + kvh * 128 + d8; s0 = *(const f32x4*)kp; s1 = *(const f32x4*)(kp + 4); }
              s0 = s0 * (1.0f / 256.0f); s1 = s1 * (1.0f / 256.0f);
              v4u w; w.x = cvt_pk_bf16(s0[0], s0[1]); w.y = cvt_pk_bf16(s0[2], s0[3]); w.z = cvt_pk_bf16(s1[0], s1[1]); w.w = cvt_pk_bf16(s1[2], s1[3]);
              *(LAS v4u*)(KMb + n * 136 + d8) = w; }
            if (tid < 32) lcnt[tid] = 0u;
            __syncthreads();
            const int nsel = b < 3 ? b : 3;
#pragma unroll 1
            for (int rt = 0; rt < 4; ++rt) {
                const int r = 64 * wave + 16 * rt + fr; const int tok = j * 128 + (r >> 2), hg = r & 3; const bf16* qp = Qb + (size_t)tok * D + (4 * kvh + hg) * 128 + 8 * fq;
                bf16x8 qf[4];
#pragma unroll
                for (int ks = 0; ks < 4; ++ks) qf[ks] = *(const bf16x8*)(qp + 32 * ks);
                f32x4 ga[2];
#pragma unroll
                for (int nt = 0; nt < 2; ++nt) { ga[nt] = (f32x4){0.f, 0.f, 0.f, 0.f};
#pragma unroll
                    for (int ks = 0; ks < 4; ++ks) { const bf16x8 ka = *(const LAS bf16x8*)(KMb + (16 * nt + fr) * 136 + 32 * ks + 8 * fq); ga[nt] = MFMA16(ka, qf[ks], ga[nt]); } }
                float v0 = -INFINITY, v1 = -INFINITY, v2 = -INFINITY; int i0 = 99, i1 = 99, i2 = 99;
#pragma unroll
                for (int nt = 0; nt < 2; ++nt)
#pragma unroll
                    for (int q = 0; q < 4; ++q) { const int n = 16 * nt + 4 * fq + q; if (n < b) G_INSERT(ga[nt][q], n); }
                { const float a0 = shx<16>(v0), a1 = shx<16>(v1), a2 = shx<16>(v2);
                  const int c0 = __builtin_amdgcn_ds_swizzle(i0, (16 << 10) | 0x1f), c1 = __builtin_amdgcn_ds_swizzle(i1, (16 << 10) | 0x1f), c2 = __builtin_amdgcn_ds_swizzle(i2, (16 << 10) | 0x1f);
                  G_INSERT(a0, c0); G_INSERT(a1, c1); G_INSERT(a2, c2); }
                {
                  auto p0 = __builtin_amdgcn_permlane32_swap(__float_as_uint(v0), __float_as_uint(v0), false, false); auto p1 = __builtin_amdgcn_permlane32_swap(__float_as_uint(v1), __float_as_uint(v1), false, false);
                  auto p2 = __builtin_amdgcn_permlane32_swap(__float_as_uint(v2), __float_as_uint(v2), false, false);
                  auto q0 = __builtin_amdgcn_permlane32_swap((unsigned)i0, (unsigned)i0, false, false); auto q1 = __builtin_amdgcn_permlane32_swap((unsigned)i1, (unsigned)i1, false, false);
                  auto q2 = __builtin_amdgcn_permlane32_swap((unsigned)i2, (unsigned)i2, false, false);
                  v0 = __uint_as_float(p0[0]); v1 = __uint_as_float(p1[0]); v2 = __uint_as_float(p2[0]); i0 = (int)q0[0]; i1 = (int)q1[0]; i2 = (int)q2[0];
                  G_INSERT(__uint_as_float(p0[1]), (int)q0[1]); G_INSERT(__uint_as_float(p1[1]), (int)q1[1]); G_INSERT(__uint_as_float(p2[1]), (int)q2[1]); }
                if (fq == 0) {
#pragma unroll
                    for (int rk = 0; rk < 3; ++rk) {
                        if (rk < nsel) { const int best = (rk == 0) ? i0 : ((rk == 1) ? i1 : i2);
                            const unsigned pos = atomicAdd((unsigned*)&lcnt[best], 1u);
                            Subl[((size_t)(j * 4 + kvh) * 32 + best) * 512 + pos] = (unsigned)r | ((unsigned)rk << 9); }
                    }
                }
            }
            __syncthreads();
            if (tid < 32) Scnt[(j * 4 + kvh) * 32 + tid] = lcnt[tid];
            __syncthreads();
        }
#undef G_BETTER
#undef G_INSERT
        for (int item = bid; item < DECB * NKV; item += G) {
            const int b = item >> 2, kvh = item & 3; const int pr = tid >> 5, n = tid & 31;
            const int row = SEQ + 4 * b + (pr >> 2), hg = pr & 3; const bf16* qp = Qb + (size_t)row * D + (4 * kvh + hg) * 128; const float* kmp = Kms + ((size_t)(b * 32 + n)) * 512 + kvh * 128;
            float s = 0.f;
#pragma unroll 4
            for (int d = 0; d < 128; d += 8) { const v4u qw = *(const v4u*)(qp + d); const f32x4 k0 = *(const f32x4*)(kmp + d), k1 = *(const f32x4*)(kmp + d + 4);
                s += (bf2f(qw.x & 0xffffu) * k0[0] + bf2f(qw.x >> 16) * k0[1]) + (bf2f(qw.y & 0xffffu) * k0[2] + bf2f(qw.y >> 16) * k0[3]) + (bf2f(qw.z & 0xffffu) * k1[0] + bf2f(qw.z >> 16) * k1[1]) + (bf2f(qw.w & 0xffffu) * k1[2] + bf2f(qw.w >> 16) * k1[3]); }
            gs[pr * 32 + n] = s;
            __syncthreads();
            if (tid < 16) { unsigned m = 0u;
                for (int r = 0; r < 3; ++r) { int best = 0; float bv = -INFINITY; for (int nn = 0; nn < 32; ++nn) { const float v = gs[tid * 32 + nn]; if (v > bv) { bv = v; best = nn; } } m |= 1u << best; gs[tid * 32 + best] = -INFINITY; }
                Sels[item * 16 + tid] = m; }
            __syncthreads();
        }
    }
    xcd_barrier(bar, IS_T0);
    STAMP();

    {
        LAS bf16* Ks = (LAS bf16*)(lds); LAS bf16* Vs = (LAS bf16*)(lds + KS_BYTES);
        LAS unsigned* qsh = (LAS unsigned*)(lds + 2 * KS_BYTES);
        constexpr int NPI = 4 * 496, NSI = DECB * NKV * NBLK;
        for (;;) {
            const unsigned tq0 = TNOW();
            if (IS_T0) qsh[0] = __hip_atomic_fetch_add(ctl + CW_Q0, 1u, __ATOMIC_RELAXED, __HIP_MEMORY_SCOPE_AGENT);
            __syncthreads();
            const int tick = (int)qsh[0];
            __syncthreads();
            TACC(0, tq0);
            if (tick >= NPI + NSI) break;
            TIDS;
            int item; { const int g3 = tick / 3, r3 = tick - 3 * g3; item = (tick < 3 * NPI) ? ((r3 == 0) ? g3 : NPI + 2 * g3 + (r3 - 1)) : NPI + (tick - NPI); }
            if (item < NPI) {
                int b = (int)((1.0f + sqrtf(1.0f + 2.0f * (float)item)) * 0.5f); while (2 * b * (b - 1) > item) --b; while (2 * (b + 1) * b <= item) ++b;
                const int rem = item - 2 * b * (b - 1); const int n = rem >> 2, kvh = rem & 3;
                const int cntA = (int)Scnt[((2 * b) * 4 + kvh) * 32 + n], cntB = (int)Scnt[((2 * b + 1) * 4 + kvh) * 32 + n]; const int total = cntA + cntB;
                if (total == 0) continue;
                const unsigned tp0 = TNOW();
#pragma unroll
                for (int i = 0; i < 8; ++i) { const int idx = i * 512 + tid, key = idx >> 4, c8 = idx & 15; *(LAS v4u*)(Ks + key * KS_P + c8 * 8) = *(const v4u*)(Kb + (size_t)(256 * n + key) * 512 + kvh * 128 + c8 * 8); }
#pragma unroll
                for (int i = 0; i < 8; ++i) { const int idx = i * 512 + tid, key = idx >> 4, c8 = idx & 15; *(LAS v4u*)(Vs + key * KS_P + c8 * 8) = *(const v4u*)(Vb + (size_t)(256 * n + key) * 512 + kvh * 128 + c8 * 8); }
                __syncthreads();
                TACC(1, tp0); const unsigned tp1 = TNOW();
                const unsigned* LA = Subl + ((size_t)((2 * b) * 4 + kvh) * 32 + n) * 512; const unsigned* LB = Subl + ((size_t)((2 * b + 1) * 4 + kvh) * 32 + n) * 512;
#define LIST_ENT(i_) (((i_) < cntA) ? LA[(i_)] : LB[(i_) - cntA])
                const int iw = 16 * wave + fr;
                unsigned e1 = 0u, e2 = 0u; int ic1 = 0, ic2 = 0;
                if (16 * wave < total) { ic1 = iw < total ? iw : total - 1; e1 = LIST_ENT(ic1); }
                if (16 * wave + 128 < total) { ic2 = iw + 128 < total ? iw + 128 : total - 1; e2 = LIST_ENT(ic2); }
                bf16x8 qn[4];
                { const int tokn = ((ic1 < cntA) ? 2 * b : 2 * b + 1) * 128 + (int)((e1 >> 2) & 127u); const bf16* qp = Qb + (size_t)tokn * D + (4 * kvh + (int)(e1 & 3u)) * 128 + 8 * fq;
#pragma unroll
                  for (int ks = 0; ks < 4; ++ks) qn[ks] = *(const bf16x8*)(qp + 32 * ks); }
                for (int t0 = 0; t0 < total; t0 += 128) {
                    const int i0 = t0 + 16 * wave; if (i0 >= total) break;
                    const bool valid = (i0 + fr) < total; const int ic = ic1; const unsigned e = e1;
                    const int tok = ((ic < cntA) ? 2 * b : 2 * b + 1) * 128 + (int)((e >> 2) & 127u), hg = (int)(e & 3u), rk = (int)(e >> 9);
                    const int h = 4 * kvh + hg;
                    bf16x8 qf[4];
#pragma unroll
                    for (int ks = 0; ks < 4; ++ks) qf[ks] = qn[ks];
                    e1 = e2; ic1 = ic2;
                    if (i0 + 256 < total) { ic2 = (i0 + 256 + fr) < total ? (i0 + 256 + fr) : total - 1; e2 = LIST_ENT(ic2); }
                    if (i0 + 128 < total) { const int tokn = ((ic1 < cntA) ? 2 * b : 2 * b + 1) * 128 + (int)((e1 >> 2) & 127u); const bf16* qp = Qb + (size_t)tokn * D + (4 * kvh + (int)(e1 & 3u)) * 128 + 8 * fq;
#pragma unroll
                        for (int ks = 0; ks < 4; ++ks) qn[ks] = *(const bf16x8*)(qp + 32 * ks); }
                    f32x4 acc[16]; attn_scores<16>(Ks, qf, acc, 16, fr, fq);
                    float mx = -INFINITY;
#pragma unroll
                    for (int kt = 0; kt < 16; ++kt) mx = fmaxf(fmaxf(mx, fmaxf(acc[kt][0], acc[kt][1])), fmaxf(acc[kt][2], acc[kt][3]));
                    mx = fmaxf(mx, shx<16>(mx)); mx = xmax32(mx);
                    float l = 0.f;
#pragma unroll
                    for (int kt = 0; kt < 16; ++kt) {
#pragma unroll
                        for (int r = 0; r < 4; ++r) { const float p = __builtin_amdgcn_exp2f(acc[kt][r] - mx); acc[kt][r] = p; l += p; } }
                    l += shx<16>(l); l = xadd32(l);
                    f32x4 O[8];
#pragma unroll
                    for (int vt = 0; vt < 8; ++vt) O[vt] = (f32x4){0.f, 0.f, 0.f, 0.f};
                    attn_pv(Vs, acc, O, 8, fr, fq);
                    if (valid) {
                        const size_t slot = ((size_t)tok * NH + h) * 3 + rk; bf16* op = Oslot + slot * 128 + 4 * fq;
#pragma unroll
                        for (int vt = 0; vt < 8; ++vt) { v2u w; w.x = cvt_pk_bf16(O[vt][0], O[vt][1]); w.y = cvt_pk_bf16(O[vt][2], O[vt][3]); *(v2u*)(op + 16 * vt) = w; }
                        if (fq == 0) { MLslot[slot * 2] = mx; MLslot[slot * 2 + 1] = l; }
                    }
                }
                __syncthreads();
                TACC(2, tp1);
            } else {
                const int si = item - NPI; const int b = si >> 7, kvh = (si >> 5) & 3, n = si & 31;
                unsigned any = 0u;
#pragma unroll
                for (int p = 0; p < 16; ++p) any |= Sels[(b * 4 + kvh) * 16 + p];
                if (!((any >> n) & 1u)) continue;
                const unsigned ts0 = TNOW();
                const int pg0 = ptab[b * NPAGES + 2 * n], pg1 = ptab[b * NPAGES + 2 * n + 1];
                f32x4 kst[16], vst[16];
#pragma unroll
                for (int i = 0; i < 16; ++i) { const int idx = i * 512 + tid, key = idx >> 5, c4 = idx & 31; const int page = (key < 128) ? pg0 : pg1;
                    const size_t go = (((size_t)page * PAGE + (key & 127)) * NKV + kvh) * 128 + c4 * 4;
                    kst[i] = __builtin_nontemporal_load((const f32x4*)(cache_k + go)); vst[i] = __builtin_nontemporal_load((const f32x4*)(cache_v + go)); }
#pragma unroll
                for (int i = 0; i < 16; ++i) { const int idx = i * 512 + tid, key = idx >> 5, c4 = idx & 31; const int page = (key < 128) ? pg0 : pg1; (void)page;
                    const f32x4 kk4 = kst[i], vv4 = vst[i];
                    v2u w; w.x = cvt_pk_bf16(kk4[0], kk4[1]); w.y = cvt_pk_bf16(kk4[2], kk4[3]); *(LAS v2u*)(Ks + key * KS_P + c4 * 4) = w;
                    v2u wv; wv.x = cvt_pk_bf16(vv4[0], vv4[1]); wv.y = cvt_pk_bf16(vv4[2], vv4[3]); *(LAS v2u*)(Vs + key * KS_P + c4 * 4) = wv; }
                __syncthreads();
                TACC(3, ts0); const unsigned ts1 = TNOW();
                {
                    LAS float* mxs = (LAS float*)(lds + 2 * KS_BYTES + 64); LAS float* lss = mxs + 128; LAS float* Ored = (LAS float*)(lds);
                    const int row = SEQ + 4 * b + (fr >> 2), hg = fr & 3; const int h = 4 * kvh + hg; const bf16* qp = Qb + (size_t)row * D + h * 128 + 8 * fq;
                    bf16x8 qf[4];
#pragma unroll
                    for (int ks = 0; ks < 4; ++ks) qf[ks] = *(const bf16x8*)(qp + 32 * ks);
                    f32x4 a2[2];
#pragma unroll
                    for (int t = 0; t < 2; ++t) { a2[t] = (f32x4){0.f, 0.f, 0.f, 0.f};
#pragma unroll
                        for (int ks = 0; ks < 4; ++ks) { const bf16x8 ka = *(const LAS bf16x8*)(Ks + (16 * (2 * wave + t) + fr) * KS_P + 32 * ks + 8 * fq); a2[t] = MFMA16(ka, qf[ks], a2[t]); } }
                    float mx = fmaxf(fmaxf(fmaxf(a2[0][0], a2[0][1]), fmaxf(a2[0][2], a2[0][3])), fmaxf(fmaxf(a2[1][0], a2[1][1]), fmaxf(a2[1][2], a2[1][3])));
                    mx = fmaxf(mx, shx<16>(mx)); mx = xmax32(mx);
                    if (fq == 0) mxs[wave * 16 + fr] = mx;
                    __syncthreads();
                    float M = mxs[fr];
#pragma unroll
                    for (int w8 = 1; w8 < 8; ++w8) M = fmaxf(M, mxs[w8 * 16 + fr]);
                    float l = 0.f;
#pragma unroll
                    for (int t = 0; t < 2; ++t) {
#pragma unroll
                        for (int r = 0; r < 4; ++r) { const float p = __builtin_amdgcn_exp2f(a2[t][r] - M); a2[t][r] = p; l += p; } }
                    l += shx<16>(l); l = xadd32(l);
                    if (fq == 0) lss[wave * 16 + fr] = l;
                    v4u pw; pw.x = cvt_pk_bf16(a2[0][0], a2[0][1]); pw.y = cvt_pk_bf16(a2[0][2], a2[0][3]); pw.z = cvt_pk_bf16(a2[1][0], a2[1][1]); pw.w = cvt_pk_bf16(a2[1][2], a2[1][3]);
                    const bf16x8 pf = __builtin_bit_cast(bf16x8, pw);
                    const LAS bf16* vb = Vs + (32 * wave + 4 * fq + (fr >> 2)) * KS_P + 4 * (fr & 3);
#pragma unroll
                    for (int vt = 0; vt < 8; ++vt) { const v2u lo = tr_read(vb + 16 * vt), hi = tr_read(vb + 16 * KS_P + 16 * vt); const v4u aw = {lo.x, lo.y, hi.x, hi.y};
                        const f32x4 o = MFMA16(__builtin_bit_cast(bf16x8, aw), pf, ((f32x4){0.f, 0.f, 0.f, 0.f}));
                        *(LAS f32x4*)(Ored + (wave * 16 + fr) * 132 + 16 * vt + 4 * fq) = o; }
                    __syncthreads();
                    { const int r16 = tid >> 5, c4 = tid & 31; f32x4 so = *(const LAS f32x4*)(Ored + r16 * 132 + 4 * c4);
#pragma unroll
                      for (int w8 = 1; w8 < 8; ++w8) so += *(const LAS f32x4*)(Ored + (w8 * 16 + r16) * 132 + 4 * c4);
                      float* sp = Sslot + ((size_t)((b * 4 + kvh) * 32 + n) * 16 + r16) * 132;
                      *(f32x4*)(sp + 4 * c4) = so;
                      if (c4 == 0) { float Mr = mxs[r16], lt = lss[r16];
#pragma unroll
                          for (int w8 = 1; w8 < 8; ++w8) { Mr = fmaxf(Mr, mxs[w8 * 16 + r16]); lt += lss[w8 * 16 + r16]; }
                          sp[128] = Mr; sp[129] = lt; } }
                }
                __syncthreads();
                TACC(4, ts1);
            }
        }
    }
    xcd_barrier(bar, IS_T0);
    STAMP();

    {
        TIDS;
        LAS bf16* Ks = (LAS bf16*)(lds); LAS bf16* Vs = (LAS bf16*)(lds + KS_BYTES);
        for (int item = bid; item < NBLK * NKV * 2; item += G) {
            const int b = item >> 3, kvh = (item >> 1) & 3, hp = item & 1;
#pragma unroll
            for (int i = 0; i < 8; ++i) { const int idx = i * 512 + tid, key = idx >> 4, c8 = idx & 15; *(LAS v4u*)(Ks + key * KS_P + c8 * 8) = *(const v4u*)(Kb + (size_t)(256 * b + key) * 512 + kvh * 128 + c8 * 8); }
#pragma unroll
            for (int i = 0; i < 8; ++i) { const int idx = i * 512 + tid, key = idx >> 4, c8 = idx & 15; *(LAS v4u*)(Vs + key * KS_P + c8 * 8) = *(const v4u*)(Vb + (size_t)(256 * b + key) * 512 + kvh * 128 + c8 * 8); }
            const int nsel = b < 3 ? b : 3;
            bf16x8 qn[4];
            { const bf16* qp = Qb + (size_t)(256 * b + 16 * wave + fr) * D + (4 * kvh + 2 * hp) * 128 + 8 * fq;
#pragma unroll
              for (int ks = 0; ks < 4; ++ks) qn[ks] = *(const bf16x8*)(qp + 32 * ks); }
            __syncthreads();
#pragma unroll 1
            for (int u = 0; u < 4; ++u) {
                const int g = (u & 1) ? 15 - wave : wave, h = 4 * kvh + 2 * hp + (u >> 1); const int tl = 16 * g + fr; const int tok = 256 * b + tl;
                bf16x8 qf[4];
#pragma unroll
                for (int ks = 0; ks < 4; ++ks) qf[ks] = qn[ks];
                if (u < 3) { const int gn = ((u + 1) & 1) ? 15 - wave : wave, hn = 4 * kvh + 2 * hp + ((u + 1) >> 1); const bf16* qp = Qb + (size_t)(256 * b + 16 * gn + fr) * D + hn * 128 + 8 * fq;
#pragma unroll
                    for (int ks = 0; ks < 4; ++ks) qn[ks] = *(const bf16x8*)(qp + 32 * ks); }
                float msa[3], lsa[3];
#pragma unroll
                for (int r = 0; r < 3; ++r) { msa[r] = -INFINITY; lsa[r] = 0.f; if (r < nsel) { const size_t slot = ((size_t)tok * NH + h) * 3 + r; msa[r] = MLslot[slot * 2]; lsa[r] = MLslot[slot * 2 + 1]; } }
                const int nkt = g + 1;
                f32x4 acc[16]; attn_scores<16>(Ks, qf, acc, nkt, fr, fq);
                float mx = -INFINITY;
#pragma unroll
                for (int kt = 0; kt < 16; ++kt) {
#pragma unroll
                    for (int r = 0; r < 4; ++r) { const bool ok = (kt < nkt) && (16 * kt + 4 * fq + r <= tl); const float sv = ok ? acc[kt][r] : -INFINITY; acc[kt][r] = sv; mx = fmaxf(mx, sv); } }
                mx = fmaxf(mx, shx<16>(mx)); mx = xmax32(mx);
                float M = mx;
#pragma unroll
                for (int r = 0; r < 3; ++r) M = fmaxf(M, msa[r]);
                float l = 0.f;
#pragma unroll
                for (int kt = 0; kt < 16; ++kt) {
#pragma unroll
                    for (int r = 0; r < 4; ++r) { const float p = __builtin_amdgcn_exp2f(acc[kt][r] - M); acc[kt][r] = p; l += p; } }
                l += shx<16>(l); l = xadd32(l);
                f32x4 O[8];
#pragma unroll
                for (int vt = 0; vt < 8; ++vt) O[vt] = (f32x4){0.f, 0.f, 0.f, 0.f};
                attn_pv(Vs, acc, O, (nkt + 1) >> 1, fr, fq);
#pragma unroll
                for (int r = 0; r < 3; ++r) { if (r < nsel) { const float sc = __builtin_amdgcn_exp2f(msa[r] - M); l += lsa[r] * sc; const size_t slot = ((size_t)tok * NH + h) * 3 + r; const bf16* op = Oslot + slot * 128 + 4 * fq;
#pragma unroll
                    for (int vt = 0; vt < 8; ++vt) { const v2u w = *(const v2u*)(op + 16 * vt); O[vt][0] += bf2f(w.x & 0xffffu) * sc; O[vt][1] += bf2f(w.x >> 16) * sc; O[vt][2] += bf2f(w.y & 0xffffu) * sc; O[vt][3] += bf2f(w.y >> 16) * sc; } } }
                const float il = 1.0f / l; bf16* ap = At + (size_t)tok * D + h * 128 + 4 * fq;
#pragma unroll
                for (int vt = 0; vt < 8; ++vt) { v2u w; w.x = cvt_pk_bf16(O[vt][0] * il, O[vt][1] * il); w.y = cvt_pk_bf16(O[vt][2] * il, O[vt][3] * il); *(v2u*)(ap + 16 * vt) = w; }
            }
            __syncthreads();
        }
        LAS float* ksn = (LAS float*)(lds);
        for (int item = bid; item < DECB * NKV; item += G) {
            const int b = item >> 2, kvh = item & 3;
            { const int key = tid >> 7, d = tid & 127; ksn[key * 128 + d] = out[OK_S + (size_t)(4 * b + key) * 512 + kvh * 128 + d]; ksn[512 + key * 128 + d] = out[OV_S + (size_t)(4 * b + key) * 512 + kvh * 128 + d]; }
            __syncthreads();
            const int pr = tid >> 5, l32 = tid & 31; const int t = pr >> 2, hg = pr & 3; const int row = SEQ + 4 * b + t, h = 4 * kvh + hg;
            const v2u qw = *(const v2u*)(Qb + (size_t)row * D + h * 128 + 4 * l32);
            const float q0 = bf2f(qw.x & 0xffffu), q1 = bf2f(qw.x >> 16), q2 = bf2f(qw.y & 0xffffu), q3 = bf2f(qw.y >> 16);
            float sk[4]; float M = -INFINITY;
#pragma unroll
            for (int key = 0; key < 4; ++key) { const f32x4 k4 = *(const LAS f32x4*)(ksn + key * 128 + 4 * l32); float s = (q0 * k4[0] + q1 * k4[1]) + (q2 * k4[2] + q3 * k4[3]);
                s += shx<1>(s); s += shx<2>(s); s += shx<4>(s); s += shx<8>(s); s += shx<16>(s);
                sk[key] = (key <= t) ? s : -INFINITY; M = fmaxf(M, sk[key]); }
            const unsigned mask = Sels[item * 16 + pr];
#pragma unroll 1
            for (int n = 0; n < 32; ++n) if ((mask >> n) & 1u) M = fmaxf(M, Sslot[((size_t)(item * 32 + n) * 16 + pr) * 132 + 128]);
            float l = 0.f; f32x4 O = {0.f, 0.f, 0.f, 0.f};
#pragma unroll
            for (int key = 0; key < 4; ++key) { const float p = __builtin_amdgcn_exp2f(sk[key] - M); l += p; O += *(const LAS f32x4*)(ksn + 512 + key * 128 + 4 * l32) * p; }
#pragma unroll 1
            for (int n = 0; n < 32; ++n) if ((mask >> n) & 1u) { const float* sp = Sslot + ((size_t)(item * 32 + n) * 16 + pr) * 132; const float sc = __builtin_amdgcn_exp2f(sp[128] - M); l += sp[129] * sc; O += *(const f32x4*)(sp + 4 * l32) * sc; }
            const float il = 1.0f / l; v2u w; w.x = cvt_pk_bf16(O[0] * il, O[1] * il); w.y = cvt_pk_bf16(O[2] * il, O[3] * il);
            *(v2u*)(At + (size_t)row * D + h * 128 + 4 * l32) = w;
            __syncthreads();
        }
    }
    xcd_barrier(bar, IS_T0);
    STAMP();

    {
        TIDS;
        pg8::Gemm g{At, Wo_t, SEQ, D, D}; pg8::StaticOrder S; S.init(SEQ, D, G, bid);
        EpiRes<1> E{Hb2, nullptr, nullptr, Hb3, ss3};
        pg8::gemm_phase<EpiRes<1>, pg8::StaticOrder, true, true, false>(lds, g, S, E, TIDX);
        { const int t2 = bid & 127, rh = (bid >> 7) & 1; TIDS; f32x4 ta[1]; tail_gemm<1>(lds, At + (size_t)SEQ * D, Wo_t, D, 16 * t2, rh, ta, TIDX); if (wave < 4) E.tail(SEQ + 64 * rh + 16 * wave + fr, 16 * t2 + 4 * fq, ta[0], fq); }
    }
    xcd_barrier(bar, IS_T0);
    STAMP();
    {
        TIDS;
        pg8::Gemm g{Hb3, Wgu1_t, MP, NGU, D}; pg8::StaticOrder S; S.init(MP, NGU, G, bid);
        EpiGU E{ss3, Hm};
        pg8::gemm_phase<EpiGU, pg8::StaticOrder, true, true>(lds, g, S, E, TIDX);
    }
    xcd_barrier(bar, IS_T0);
    STAMP();
    {
        TIDS;
        pg8::Gemm g{Hm, Wdn1_t, SEQ, D, DFF}; pg8::StaticOrder S; S.init(SEQ, D, G, bid);
        EpiRes<2> E{Hb3, out + OY_P, out + OY_S, nullptr, nullptr};
        pg8::gemm_phase<EpiRes<2>, pg8::StaticOrder, true, true, false>(lds, g, S, E, TIDX);
        { const int t2 = bid & 127, rh = (bid >> 7) & 1; TIDS; f32x4 ta[1]; tail_gemm<1>(lds, Hm + (size_t)SEQ * DFF, Wdn1_t, DFF, 16 * t2, rh, ta, TIDX); if (wave < 4) E.tail(SEQ + 64 * rh + 16 * wave + fr, 16 * t2 + 4 * fq, ta[0], fq); }
    }
#ifdef PROF_A
    STAMP();
    if (blockIdx.x == 0 && IS_T0) {
        const unsigned ta = PVAL(PROF_A0, PROF_A1), tb = PVAL(PROF_B0, PROF_B1);
        unsigned qa = (ta + PROF_UA / 2) / PROF_UA, qb = (tb + PROF_UB / 2) / PROF_UB; if (qa > 99u) qa = 99u; if (qb > 99u) qb = 99u;
#ifdef PROF_MUL
        const unsigned long long extra = (unsigned long long)ta * PROF_MUL;
#else
        const unsigned long long extra = (unsigned long long)(qa + 100u * qb) * 5000ull;
#endif
        const unsigned long long t0 = __builtin_amdgcn_s_memrealtime();
        while (__builtin_amdgcn_s_memrealtime() - t0 < extra) __builtin_amdgcn_s_sleep(32);
    }
#endif
}
#undef x_p
#undef x_s
#undef st_in
#undef cache_k
#undef cache_v
#undef ptab
#undef norm_mix_a
#undef w_in
#undef lbl
#undef onorm
#undef w_out
#undef norm_kv
#undef w_kv
#undef k_norm
#undef norm_mix_b
#undef w_q
#undef q_norm
#undef w_o
#undef norm_ffn
#undef w_gu
#undef w_dn
#undef Win_t
#undef Wout_t
#undef Wgu0_t
#undef Wdn0_t
#undef Wkvq_t
#undef Wo_t
#undef Wgu1_t
#undef Wdn1_t
#undef Hb0
#undef Hb1
#undef Hb2
#undef Hb3
#undef Hf1
#undef Hf2
#undef Hf3
#undef Qg
#undef Vg
#undef Gg
#undef Ff
#undef Ob
#undef At
#undef Hm
#undef Ub
#undef Sst
#undef Dec
#undef Kraw
#undef Vraw
#undef Qraw
#undef Kb
#undef Vb
#undef Qb
#undef Kpart
#undef Kms
#undef Subl
#undef Scnt
#undef Sels
#undef Oslot
#undef MLslot
#undef Sslot
#undef ss0
#undef ss1
#undef ss2
#undef ss3
#undef out
#undef TIDS
#undef TIDX
#undef IS_T0

extern "C" void kernel_launch(void* const* d_in, const int* in_sizes, int n_in, void* d_out, int out_size, void* d_ws, size_t ws_size, hipStream_t stream) {
    static int grid = 0;
    if (grid == 0) {
        if (n_in != 21 || ws_size < WS_END) { fprintf(stderr, "kernel_launch: unexpected n_in %d / ws %zu\n", n_in, ws_size); grid = -1; return; }
        int dev = 0, cus = 0, per_cu = 0;
        if (hipGetDevice(&dev) != hipSuccess || hipDeviceGetAttribute(&cus, hipDeviceAttributeMultiprocessorCount, dev) != hipSuccess) { grid = -1; return; }
        if (hipFuncSetAttribute((const void*)yoco_fwd, hipFuncAttributeMaxDynamicSharedMemorySize, LDS_BYTES) != hipSuccess) { fprintf(stderr, "kernel_launch: hipFuncSetAttribute failed\n"); grid = -1; return; }
        if (hipOccupancyMaxActiveBlocksPerMultiprocessor(&per_cu, (const void*)yoco_fwd, NTHR, LDS_BYTES) != hipSuccess || per_cu < 1) fprintf(stderr, "kernel_launch: occupancy query says %d\n", per_cu);
        (void)hipGetLastError();
        grid = cus;
        if (grid < 256) { fprintf(stderr, "kernel_launch: built for 256 CUs (got %d)\n", grid); grid = -1; return; }
        grid = 256;
    }
    if (grid < 0) return;
    (void)hipMemsetAsync((char*)d_ws + WS_CTL, 0, CTL_ZERO_BYTES, stream);
    Args a{};
    for (int i = 0; i < 21; ++i) a.in[i] = d_in[i];
    a.out = (float*)d_out; a.ws = (unsigned char*)d_ws;
    hipLaunchKernelGGL(yoco_fwd, dim3(grid), dim3(NTHR), LDS_BYTES, stream, a);
}
```

```cpp
#include <hip/hip_runtime.h>
#include <cstdio>
#include <cstdint>
__device__ __forceinline__ int lane_id() { int l = (int)__builtin_amdgcn_mbcnt_hi(~0u, __builtin_amdgcn_mbcnt_lo(~0u, 0u)); asm volatile("" : "+v"(l)); return l; }

namespace pg8 {
#define PG8_LAS __attribute__((address_space(3)))
typedef unsigned short bf16_t;
typedef short bf16x8 __attribute__((ext_vector_type(8)));
typedef float f32x4 __attribute__((ext_vector_type(4)));
typedef unsigned u32x4 __attribute__((ext_vector_type(4)));
typedef unsigned u32x2 __attribute__((ext_vector_type(2)));
constexpr int BM = 256, BK = 64, HALF = 128, HTB = HALF * BK * 2, STAGE_BYTES = 8 * HTB, NXCD = 8, WGM = 8;

__host__ __device__ __forceinline__ int lds_byte(int r, int c) { const int st = (r >> 4) * 2 + (c >> 5), rr = r & 15, cc = c & 31, ob = rr * 64 + cc * 2; return st * 1024 + (ob ^ (((ob >> 9) & 1) << 5)); }
__host__ __device__ __forceinline__ void stage_rc(int b, int& R, int& C) { const int st = b / 1024, sb = b % 1024, swz = sb ^ (((sb >> 9) & 1) << 5); R = (st >> 1) * 16 + swz / 64; C = (st & 1) * 32 + (swz % 64) / 2; }
__host__ __device__ __forceinline__ int perm32(int rho) { const int n = rho >> 4, i = rho & 15; return 8 * (i >> 2) + 4 * n + (i & 3); }

struct Unit { int pm, pn; };
struct Gemm { const bf16_t* A; const bf16_t* Bt; int M, N, K; };

struct StaticOrder {
    int nM, nN, nwg, G, c;
    __host__ __device__ void init(int M, int N, int G_, int c_) { nM = M / BM; nN = N / BM; nwg = nM * nN; G = G_; c = c_; }
    __host__ __device__ bool next(int i, Unit& u) const {
        const long L = (long)i * G + c; if (L >= nwg) return false;
        int wgid = (int)L; { const int q = nwg / NXCD, r = nwg % NXCD, xcd = wgid % NXCD, off = wgid / NXCD; wgid = (xcd < r ? xcd * (q + 1) : r * (q + 1) + (xcd - r) * q) + off; }
        const int nig = WGM * nN, gid = wgid / nig, fm = gid * WGM, gsz = (nM - fm) < WGM ? (nM - fm) : WGM;
        u.pm = fm + ((wgid % nig) % gsz); u.pn = (wgid % nig) / gsz; return true;
    }
    __device__ __forceinline__ void a_ready(const Unit&) const {}
    __device__ __forceinline__ void done(const Unit&) const {}
};

__device__ __forceinline__ unsigned cvt_pk_bf16(float lo, float hi) { unsigned r; asm volatile("v_cvt_pk_bf16_f32 %0, %1, %2" : "=v"(r) : "v"(lo), "v"(hi)); return r; }

template <class Epi, class Sched, bool ALIGN_EPI = false, bool SP2 = false, bool HALF_LAST = true>
__device__ __forceinline__ void gemm_phase(PG8_LAS unsigned char* lds, const Gemm g, const Sched& S, const Epi& E, int tidx) {
    int tid_ = tidx; asm volatile("" : "+v"(tid_));
    const int tid = tid_, wid = __builtin_amdgcn_readfirstlane(tid >> 6), lane = tid & 63, wr = wid >> 2, wc = wid & 3, fr = lane & 15, fq = lane >> 4;
    const int K = g.K, nt = K / BK;
    unsigned voffA[2], voffB[2];
#pragma unroll
    for (int i = 0; i < 2; ++i) { int R, C; stage_rc(tid * 16 + i * 8192, R, C); const int Rb = Epi::PERM ? ((R & ~31) + perm32(R & 31)) : R;
        voffA[i] = (unsigned)(R * K + C) * 2u; voffB[i] = (unsigned)(Rb * K + C) * 2u; }
    const size_t kstep = (size_t)(BK * 2);
    const size_t hstep = (size_t)HALF * K * 2;
    const size_t tstep = 2 * hstep;
    const unsigned ldsw = (unsigned)wid * 1024u;
    const int aoff = lds_byte(wr * 64 + fr, fq * 8), boff = lds_byte(wc * 32 + fr, fq * 8);
#define PG8_SA(b, h) (((b) * 2 + (h)) * HTB)
#define PG8_SB(b, h) ((4 + (b) * 2 + (h)) * HTB)
#define PG8_STAGE(bufoff, gbase, voff) do { _Pragma("unroll") for (int _i = 0; _i < 2; ++_i) \
        __builtin_amdgcn_global_load_lds((const unsigned*)((const char*)(gbase) + (voff)[_i]), (PG8_LAS unsigned*)(lds + (bufoff) + ldsw + _i * 8192), 16, 0, 0); } while (0)
#define PG8_LDA(dst, b, h) do { _Pragma("unroll") for (int m = 0; m < 4; ++m) _Pragma("unroll") for (int k = 0; k < 2; ++k) dst[m][k] = *(const PG8_LAS bf16x8*)(lds + PG8_SA(b, h) + aoff + m * 2048 + k * 1024); } while (0)
#define PG8_LDB(dst, b, h) do { _Pragma("unroll") for (int n = 0; n < 2; ++n) _Pragma("unroll") for (int k = 0; k < 2; ++k) dst[n][k] = *(const PG8_LAS bf16x8*)(lds + PG8_SB(b, h) + boff + n * 2048 + k * 1024); } while (0)
#define PG8_MMA(ai, bj, At, Bt) do { __builtin_amdgcn_s_setprio(1); _Pragma("unroll") for (int m = 0; m < 4; ++m) _Pragma("unroll") for (int n = 0; n < 2; ++n) _Pragma("unroll") for (int k = 0; k < 2; ++k) \
        acc[ai][bj][m][n] = __builtin_amdgcn_mfma_f32_16x16x32_bf16(Bt[n][k], At[m][k], acc[ai][bj][m][n], 0, 0, 0); __builtin_amdgcn_s_setprio(0); } while (0)
#define PG8_WAIT_V(n) asm volatile("s_waitcnt vmcnt(" #n ")" ::: "memory")
#define PG8_WAIT_L(n) asm volatile("s_waitcnt lgkmcnt(" #n ")" ::: "memory")
#define PG8_BAR __builtin_amdgcn_s_barrier()
#define PG8_SCHED __builtin_amdgcn_sched_barrier(0)
    Unit cur, nxt; int ui = 0;
    if (!S.next(0, cur)) return;
    f32x4 acc[2][2][4][2];
#pragma unroll
    for (int a = 0; a < 2; ++a)
#pragma unroll
        for (int b = 0; b < 2; ++b)
#pragma unroll
            for (int m = 0; m < 4; ++m)
#pragma unroll
                for (int n = 0; n < 2; ++n) acc[a][b][m][n] = (f32x4){0.f, 0.f, 0.f, 0.f};
    bf16x8 At[4][2], B0[2][2], B1[2][2];
    const char* cA = (const char*)g.A + (size_t)cur.pm * tstep; const char* cB = (const char*)g.Bt + (size_t)cur.pn * tstep;
    S.a_ready(cur);
    if constexpr (SP2) {
        PG8_STAGE(PG8_SB(0, 0), cB, voffB); PG8_STAGE(PG8_SB(0, 1), cB + hstep, voffB); PG8_STAGE(PG8_SA(0, 0), cA, voffA); PG8_STAGE(PG8_SA(0, 1), cA + hstep, voffA);
        if (wr == 1) PG8_BAR;
        PG8_WAIT_V(2); PG8_BAR;
        PG8_STAGE(PG8_SB(1, 0), cB + kstep, voffB); PG8_STAGE(PG8_SA(1, 0), cA + kstep, voffA); PG8_STAGE(PG8_SB(1, 1), cB + hstep + kstep, voffB);
        PG8_WAIT_V(6); PG8_BAR;
    } else {
        PG8_STAGE(PG8_SB(0, 0), cB, voffB); PG8_STAGE(PG8_SA(0, 0), cA, voffA); PG8_STAGE(PG8_SB(0, 1), cB + hstep, voffB); PG8_STAGE(PG8_SA(0, 1), cA + hstep, voffA);
        if (wr == 1) PG8_BAR;
        PG8_WAIT_V(4); PG8_BAR;
        PG8_STAGE(PG8_SB(1, 0), cB + kstep, voffB); PG8_STAGE(PG8_SA(1, 0), cA + kstep, voffA); PG8_STAGE(PG8_SB(1, 1), cB + hstep + kstep, voffB);
        PG8_WAIT_V(6); PG8_BAR;
    }
    for (;;) {
        const bool has_next = S.next(ui + 1, nxt);
        const bool half1 = HALF_LAST && (cur.pm == g.M / BM - 1);
        const char* nA = has_next ? (const char*)g.A + (size_t)nxt.pm * tstep : cA; const char* nB = has_next ? (const char*)g.Bt + (size_t)nxt.pn * tstep : cB;
        for (int t = 0; t < nt; t += 2) {
            const bool last = (t == nt - 2);
            const char* a1 = cA + (size_t)(t + 1) * kstep;
            const char* a2 = last ? nA : cA + (size_t)(t + 2) * kstep; const char* b2 = last ? nB : cB + (size_t)(t + 2) * kstep;
            const char* a3 = a2 + kstep; const char* b3 = b2 + kstep;
            if (last && has_next) S.a_ready(nxt);
            if constexpr (SP2) {
            PG8_LDB(B0, 0, 0); PG8_LDB(B1, 0, 1); PG8_SCHED; PG8_LDA(At, 0, 0); PG8_STAGE(PG8_SA(1, 1), a1 + hstep, voffA);
            PG8_WAIT_V(8); PG8_WAIT_L(0); PG8_BAR; PG8_MMA(0, 0, At, B0); PG8_MMA(0, 1, At, B1); PG8_BAR; PG8_SCHED;
            if (!half1) { PG8_LDA(At, 0, 1); } PG8_STAGE(PG8_SB(0, 0), b2, voffB); PG8_STAGE(PG8_SB(0, 1), b2 + hstep, voffB); PG8_STAGE(PG8_SA(0, 0), a2, voffA);
            PG8_WAIT_V(8); PG8_WAIT_L(0); PG8_BAR; if (!half1) { PG8_MMA(1, 0, At, B0); PG8_MMA(1, 1, At, B1); } PG8_BAR; PG8_SCHED;
            PG8_LDB(B0, 1, 0); PG8_LDB(B1, 1, 1); PG8_SCHED; PG8_LDA(At, 1, 0); PG8_STAGE(PG8_SA(0, 1), a2 + hstep, voffA);
            PG8_WAIT_V(8); PG8_WAIT_L(0); PG8_BAR; PG8_MMA(0, 0, At, B0); PG8_MMA(0, 1, At, B1); PG8_BAR; PG8_SCHED;
            if (!half1) { PG8_LDA(At, 1, 1); } PG8_STAGE(PG8_SB(1, 0), b3, voffB); PG8_STAGE(PG8_SB(1, 1), b3 + hstep, voffB); PG8_STAGE(PG8_SA(1, 0), a3, voffA);
            PG8_WAIT_V(8); PG8_WAIT_L(0); PG8_BAR; if (!half1) { PG8_MMA(1, 0, At, B0); PG8_MMA(1, 1, At, B1); } PG8_BAR; PG8_SCHED;
            } else {
            PG8_LDB(B0, 0, 0); PG8_SCHED; PG8_LDA(At, 0, 0); PG8_STAGE(PG8_SA(1, 1), a1 + hstep, voffA);
            PG8_WAIT_L(8); PG8_BAR; PG8_WAIT_L(0); PG8_MMA(0, 0, At, B0); PG8_BAR; PG8_SCHED;
            PG8_LDB(B1, 0, 1); PG8_STAGE(PG8_SB(0, 0), b2, voffB);
            PG8_BAR; PG8_WAIT_L(0); PG8_MMA(0, 1, At, B1); PG8_BAR;
            PG8_LDA(At, 0, 1); PG8_STAGE(PG8_SA(0, 0), a2, voffA);
            PG8_BAR; PG8_WAIT_L(0); PG8_MMA(1, 0, At, B0); PG8_BAR; PG8_SCHED;
            PG8_STAGE(PG8_SB(0, 1), b2 + hstep, voffB);
            PG8_WAIT_V(6); PG8_BAR; PG8_MMA(1, 1, At, B1); PG8_BAR;
            PG8_LDB(B0, 1, 0); PG8_SCHED; PG8_LDA(At, 1, 0); PG8_STAGE(PG8_SA(0, 1), a2 + hstep, voffA);
            PG8_WAIT_L(8); PG8_BAR; PG8_WAIT_L(0); PG8_MMA(0, 0, At, B0); PG8_BAR; PG8_SCHED;
            PG8_LDB(B1, 1, 1); PG8_STAGE(PG8_SB(1, 0), b3, voffB);
            PG8_BAR; PG8_WAIT_L(0); PG8_MMA(0, 1, At, B1); PG8_BAR;
            PG8_LDA(At, 1, 1); PG8_STAGE(PG8_SA(1, 0), a3, voffA);
            PG8_BAR; PG8_WAIT_L(0); PG8_MMA(1, 0, At, B0); PG8_BAR; PG8_SCHED;
            PG8_STAGE(PG8_SB(1, 1), b3 + hstep, voffB);
            PG8_WAIT_V(6); PG8_BAR; PG8_MMA(1, 1, At, B1); PG8_BAR;
            }
        }
        if constexpr (ALIGN_EPI) { if (wr == 0) PG8_BAR; }
        E(acc, cur, wr, wc, fr, fq);
        if (!has_next) break;
#pragma unroll
        for (int a = 0; a < 2; ++a)
#pragma unroll
            for (int b = 0; b < 2; ++b)
#pragma unroll
                for (int m = 0; m < 4; ++m)
#pragma unroll
                    for (int n = 0; n < 2; ++n) acc[a][b][m][n] = (f32x4){0.f, 0.f, 0.f, 0.f};
        cur = nxt; cA = nA; cB = nB; ++ui;
        if constexpr (ALIGN_EPI) { if (wr == 1) PG8_BAR; }
    }
    PG8_WAIT_V(0);
    if constexpr (!ALIGN_EPI) { if (wr == 0) PG8_BAR; }
    PG8_BAR;
#undef PG8_SA
#undef PG8_SB
#undef PG8_STAGE
#undef PG8_LDA
#undef PG8_LDB
#undef PG8_MMA
#undef PG8_WAIT_V
#undef PG8_WAIT_L
#undef PG8_BAR
#undef PG8_SCHED
}
}

constexpr int NWAVES = 8, NTHR = 512;
constexpr int D = 2048, SEQ = 8192, DECB = 32, DECS = 4, MS = DECB * DECS;
constexpr int MR = SEQ + MS;
constexpr int MP = 8448;
constexpr int NH = 16, HD = 128, NKV = 4, DFF = 5632, NGU = 2 * DFF;
constexpr int NCHUNK = SEQ / 64;
constexpr int NPAGES = 64, PAGE = 128, NBLK = 32;
constexpr float EPS = 1e-6f;
constexpr float C2 = 0.08838834764831845f * 1.4426950408889634f;

constexpr size_t OY_P = 0, OY_S = OY_P + (size_t)SEQ * D, OST_P = OY_S + (size_t)MS * D, OST_S = OST_P + (size_t)NH * 128 * 128,
                 OK_P = OST_S + (size_t)DECB * NH * 128 * 128, OV_P = OK_P + (size_t)SEQ * 512, OK_S = OV_P + (size_t)SEQ * 512, OV_S = OK_S + (size_t)MS * 512;

constexpr size_t MiB = 1u << 20;
constexpr size_t WS_CTL = 0, CTL_ZERO_BYTES = 1 * MiB;
constexpr size_t WS_WIN = 2 * MiB;
constexpr size_t WS_WOUT = WS_WIN + 32 * MiB;
constexpr size_t WS_WGU0 = WS_WOUT + 8 * MiB;
constexpr size_t WS_WDN0 = WS_WGU0 + 44 * MiB;
constexpr size_t WS_WKVQ = WS_WDN0 + 22 * MiB;
constexpr size_t WS_WO = WS_WKVQ + 12 * MiB;
constexpr size_t WS_WGU1 = WS_WO + 8 * MiB;
constexpr size_t WS_WDN1 = WS_WGU1 + 44 * MiB;
constexpr size_t WS_HB0 = WS_WDN1 + 22 * MiB;
constexpr size_t WS_HB1 = WS_HB0 + 34 * MiB, WS_HB2 = WS_HB1 + 34 * MiB, WS_HB3 = WS_HB2 + 34 * MiB;
constexpr size_t WS_HF1 = WS_HB3 + 34 * MiB;
constexpr size_t WS_HF2 = WS_HF1 + 67 * MiB, WS_HF3 = WS_HF2 + 67 * MiB;
constexpr size_t WS_QG = WS_HF3 + 67 * MiB;
constexpr size_t WS_VG = WS_QG + 34 * MiB;
constexpr size_t WS_GG = WS_VG + 34 * MiB;
constexpr size_t WS_F = WS_GG + 34 * MiB;
constexpr size_t WS_OB = WS_F + 67 * MiB;
constexpr size_t WS_AT = WS_OB + 34 * MiB;
constexpr size_t WS_HM = WS_AT + 34 * MiB;
constexpr size_t WS_U = WS_HM + 92 * MiB;
constexpr size_t WS_SST = WS_U + 64 * MiB;
constexpr size_t WS_DEC = WS_SST + 64 * MiB;
constexpr size_t WS_KRAW = WS_DEC + 2 * MiB;
constexpr size_t WS_VRAW = WS_KRAW + 17 * MiB;
constexpr size_t WS_QRAW = WS_VRAW + 17 * MiB;
constexpr size_t WS_KB = WS_QRAW + 67 * MiB;
constexpr size_t WS_VB = WS_KB + 9 * MiB;
constexpr size_t WS_QB = WS_VB + 9 * MiB;
constexpr size_t WS_KPART = WS_QB + 34 * MiB;
constexpr size_t WS_KMS = WS_KPART + 1 * MiB;
constexpr size_t WS_SUBL = WS_KMS + 2 * MiB;
constexpr size_t WS_SCNT = WS_SUBL + 16 * MiB;
constexpr size_t WS_OSLOT = WS_SCNT + 1 * MiB;
constexpr size_t WS_MLSLOT = WS_OSLOT + 192 * MiB;
constexpr size_t WS_SSLOT = WS_MLSLOT + 3 * MiB;
constexpr size_t WS_FOUT = WS_SSLOT + 34 * MiB;
constexpr size_t WS_END = WS_FOUT + 131 * MiB;
constexpr size_t WS_ORC = WS_END;
constexpr int CW_BAR = 4096;
constexpr int CW_Q0 = 8192;
constexpr int CW_SS0 = 16384, CW_SS1 = CW_SS0 + MP, CW_SS2 = CW_SS1 + MP, CW_SS3 = CW_SS2 + MP;
static_assert((CW_SS3 + MP) * 4 <= (int)CTL_ZERO_BYTES, "ctl");
static_assert(WS_VG - WS_QG == 34 * MiB && WS_GG - WS_VG == 34 * MiB, "Qg|Vg|Gg stride");

constexpr int LDS_BYTES = 160 * 1024;
constexpr int MISC_OFF = LDS_BYTES - 256;

#define GAS __attribute__((address_space(1)))
#define LAS __attribute__((address_space(3)))
typedef unsigned short bf16;
typedef unsigned v4u __attribute__((ext_vector_type(4)));
typedef unsigned v2u __attribute__((ext_vector_type(2)));
typedef float f32x4 __attribute__((ext_vector_type(4)));
typedef float f32x2 __attribute__((ext_vector_type(2)));
typedef short bf16x8 __attribute__((ext_vector_type(8)));
typedef short bf16x4 __attribute__((ext_vector_type(4)));
typedef _Float16 f16;
typedef _Float16 f16x2 __attribute__((ext_vector_type(2)));
__device__ __forceinline__ unsigned pkh2(float lo, float hi) { const f16x2 v = {(f16)lo, (f16)hi}; return __builtin_bit_cast(unsigned, v); }
#define LDS_WAIT() asm volatile("s_waitcnt lgkmcnt(0)" ::: "memory")
__device__ __forceinline__ unsigned f2bf(float f) { unsigned u = __builtin_bit_cast(unsigned, f); return (u + 0x7fffu + ((u >> 16) & 1u)) >> 16; }
__device__ __forceinline__ unsigned pk2(float lo, float hi) { return f2bf(lo) | (f2bf(hi) << 16); }
__device__ __forceinline__ float bf2f(unsigned h) { return __uint_as_float(h << 16); }
__device__ __forceinline__ float silu_f(float x) { return x * __builtin_amdgcn_rcpf(1.0f + __expf(-x)); }
__device__ __forceinline__ float sigm_f(float x) { return __builtin_amdgcn_rcpf(1.0f + __expf(-x)); }
template <int M> __device__ __forceinline__ float shx(float v) { return __uint_as_float((unsigned)__builtin_amdgcn_ds_swizzle((int)__float_as_uint(v), (M << 10) | 0x1f)); }
__device__ __forceinline__ float xadd32(float v) { auto rr = __builtin_amdgcn_permlane32_swap(__float_as_uint(v), __float_as_uint(v), false, false); return __uint_as_float(rr[0]) + __uint_as_float(rr[1]); }
__device__ __forceinline__ float xmax32(float v) { auto rr = __builtin_amdgcn_permlane32_swap(__float_as_uint(v), __float_as_uint(v), false, false); return fmaxf(__uint_as_float(rr[0]), __uint_as_float(rr[1])); }
__device__ __forceinline__ float wave_sum(float v) { v += shx<1>(v); v += shx<2>(v); v += shx<4>(v); v += shx<8>(v); v += shx<16>(v); return xadd32(v); }
#define MFMA16(a, b, c) __builtin_amdgcn_mfma_f32_16x16x32_bf16((a), (b), (c), 0, 0, 0)

#define XB_TMO      128
#define XB_XCNT(j)  (256  + 64 * (j))
#define XB_XSUB(j)  (1280 + 64 * (j))
#define XB_XGEN(j)  (2304 + 64 * (j))
#define XB_TOP      3328
#define XB_TOPGEN   3392
#define XCD_BAR_WORDS 3456
#define XB_SPIN_CAP (1u << 18)
__device__ __forceinline__ unsigned xb_ld(unsigned* p)              { return __hip_atomic_load(p, __ATOMIC_RELAXED, __HIP_MEMORY_SCOPE_AGENT); }
__device__ __forceinline__ unsigned xb_add(unsigned* p, unsigned v) { return __hip_atomic_fetch_add(p, v, __ATOMIC_RELAXED, __HIP_MEMORY_SCOPE_AGENT); }
__device__ __forceinline__ unsigned xb_xcc_id() { return (unsigned)__builtin_amdgcn_s_getreg((3 << 11) | 20) & 0xFu; }
#define XB_SPIN(cond, bar) do { unsigned _sp = 0; while (cond) { __builtin_amdgcn_s_sleep(1); \
    if ((++_sp & 255u) == 0u) { if (xb_ld(&(bar)[XB_TMO])) break; if (_sp > XB_SPIN_CAP) { atomicAdd(&(bar)[XB_TMO], 1u); break; } } } } while (0)
struct XcdBarrier { unsigned* bar; unsigned x; volatile LAS unsigned* st; };
__device__ __forceinline__ XcdBarrier xcd_barrier_post(unsigned* bar, volatile LAS unsigned* st, bool is_t0) {
    XcdBarrier b; b.bar = bar; b.x = xb_xcc_id(); b.st = st;
    if (is_t0) (void)xb_add(&bar[XB_XCNT(b.x)], 1u);
    return b;
}
__device__ __forceinline__ void xcd_barrier_complete(unsigned* bar, unsigned x, unsigned& nloc, unsigned& nx) {
    const unsigned G = gridDim.x * gridDim.y * gridDim.z;
    unsigned sum, cnt, mine, sp = 0u;
    for (;;) {
        sum = 0u; cnt = 0u; mine = 0u;
#pragma unroll
        for (unsigned j = 0; j < 16; ++j) { const unsigned c = xb_ld(&bar[XB_XCNT(j)]); sum += c; cnt += (c > 0u) ? 1u : 0u; mine = (j == x) ? c : mine; }
        if (sum == G) break;
        __builtin_amdgcn_s_sleep(1);
        if ((++sp & 255u) == 0u) { if (xb_ld(&bar[XB_TMO])) break; if (sp > XB_SPIN_CAP) { atomicAdd(&bar[XB_TMO], 1u); break; } }
    }
    nloc = mine > 0u ? mine : 1u; nx = cnt > 0u ? cnt : 1u;
}
__device__ __forceinline__ void xcd_barrier(const XcdBarrier& b, bool is_t0) {
    asm volatile("s_waitcnt vmcnt(0)" ::: "memory");
    __syncthreads();
    if (is_t0) {
        unsigned* bar = b.bar;
        __builtin_amdgcn_s_waitcnt(0);
        unsigned nloc = b.st[0], nx = b.st[1];
        if (nloc == 0u) { xcd_barrier_complete(bar, b.x, nloc, nx); b.st[0] = nloc; b.st[1] = nx; }
        const unsigned old = xb_add(&bar[XB_XSUB(b.x)], 1u);
        const unsigned gen = old / nloc;
        if (old + 1u == (gen + 1u) * nloc) {
            __builtin_amdgcn_fence(__ATOMIC_RELEASE, "agent");
            asm volatile("s_waitcnt vmcnt(0)" ::: "memory");
            const unsigned og = xb_add(&bar[XB_TOP], 1u);
            const unsigned tg = og / nx;
            if (og + 1u == (tg + 1u) * nx) xb_add(&bar[XB_TOPGEN], 1u);
            else XB_SPIN(xb_ld(&bar[XB_TOPGEN]) == tg, bar);
            __builtin_amdgcn_fence(__ATOMIC_ACQUIRE, "agent");
            xb_add(&bar[XB_XGEN(b.x)], 1u);
            asm volatile("s_waitcnt vmcnt(0)" ::: "memory");
        } else {
            XB_SPIN(xb_ld(&bar[XB_XGEN(b.x)]) == gen, bar);
            __builtin_amdgcn_fence(__ATOMIC_ACQUIRE, "agent");
            asm volatile("s_waitcnt vmcnt(0)" ::: "memory");
        }
    }
    __syncthreads();
}

using pg8::Unit; using pg8::cvt_pk_bf16;
struct EpiIn {
    static constexpr bool PERM = true;
    const float* ss; const float* lbl; bf16* Qg; f16* F;
    __device__ __forceinline__ void operator()(const f32x4 (&acc)[2][2][4][2], const Unit& u, int wr, int wc, int fr, int fq) const {
        const int seg = u.pn >> 3; const int col0 = (u.pn & 7) * 256 + wc * 32 + 8 * fq; const int rowb = u.pm * 256 + wr * 64;
        float lb[2][8];
        if (seg == 1) {
#pragma unroll
            for (int bj = 0; bj < 2; ++bj)
#pragma unroll
                for (int j = 0; j < 8; ++j) { const int c = col0 + bj * 128 + j; lb[bj][j] = __builtin_amdgcn_rcpf(1.0f + __expf(lbl[D + c] - lbl[c])); }
        }
#pragma unroll
        for (int ai = 0; ai < 2; ++ai)
#pragma unroll
            for (int m = 0; m < 4; ++m) {
                const int rb = rowb + ai * 128 + m * 16; if (rb >= MR) continue;
                const int row = rb + fr; const float r = rsqrtf(ss[row] * (1.0f / D) + EPS);
#pragma unroll
                for (int bj = 0; bj < 2; ++bj) {
                    f32x4 v0 = acc[ai][bj][m][0] * r, v1 = acc[ai][bj][m][1] * r; const size_t off = (size_t)row * D + col0 + bj * 128;
                    if (seg == 1) {
                        f32x4 o0, o1;
#pragma unroll
                        for (int j = 0; j < 4; ++j) { o0[j] = (1.0f - lb[bj][j]) * sigm_f(-v0[j]); o1[j] = (1.0f - lb[bj][4 + j]) * sigm_f(-v1[j]); }
                        { v4u w; w.x = pkh2(o0[0], o0[1]); w.y = pkh2(o0[2], o0[3]); w.z = pkh2(o1[0], o1[1]); w.w = pkh2(o1[2], o1[3]); *(v4u*)(F + off) = w; }
                    } else {
                        if (seg != 2) {
#pragma unroll
                            for (int j = 0; j < 4; ++j) { v0[j] = silu_f(v0[j]); v1[j] = silu_f(v1[j]); }
                        }
                        v4u w; w.x = cvt_pk_bf16(v0[0], v0[1]); w.y = cvt_pk_bf16(v0[2], v0[3]); w.z = cvt_pk_bf16(v1[0], v1[1]); w.w = cvt_pk_bf16(v1[2], v1[3]);
                        const size_t dsel = (seg == 0) ? 0 : ((seg == 2) ? 1 : 2);
                        *(v4u*)(Qg + dsel * (size_t)(17 * MiB) + off) = w;
                    }
                }
            }
    }
    __device__ __forceinline__ void tail(int row, int col, f32x4 v) const {
        const int seg = col >> 11, c = col & 2047; const float r = rsqrtf(ss[row] * (1.0f / D) + EPS); v = v * r; const size_t off = (size_t)row * D + c;
        if (seg == 1) { f32x4 o;
#pragma unroll
            for (int j = 0; j < 4; ++j) { const float lbv = __builtin_amdgcn_rcpf(1.0f + __expf(lbl[D + c + j] - lbl[c + j])); o[j] = (1.0f - lbv) * sigm_f(-v[j]); }
            { v2u w; w.x = pkh2(o[0], o[1]); w.y = pkh2(o[2], o[3]); *(v2u*)(F + off) = w; }
        } else {
            if (seg != 2) {
#pragma unroll
                for (int j = 0; j < 4; ++j) v[j] = silu_f(v[j]);
            }
            v2u w; w.x = cvt_pk_bf16(v[0], v[1]); w.y = cvt_pk_bf16(v[2], v[3]);
            const size_t dsel = (seg == 0) ? 0 : ((seg == 2) ? 1 : 2);
            *(v2u*)(Qg + dsel * (size_t)(17 * MiB) + off) = w;
        }
    }
};

template <int MODE> struct EpiRes {
    static constexpr bool PERM = true;
    const bf16* rb; float* o0; float* o1; bf16* hb; float* ss;
    __device__ __forceinline__ void operator()(const f32x4 (&acc)[2][2][4][2], const Unit& u, int wr, int wc, int fr, int fq) const {
        const int col0 = u.pn * 256 + wc * 32 + 8 * fq; const int rowb = u.pm * 256 + wr * 64;
#pragma unroll
        for (int ai = 0; ai < 2; ++ai)
#pragma unroll
            for (int m = 0; m < 4; ++m) {
                const int rb0 = rowb + ai * 128 + m * 16; if (rb0 >= MR) continue;
                const int row = rb0 + fr;
                const bf16* rp = rb + (size_t)row * D;
                float* op = (MODE == 2) ? ((row < SEQ) ? o0 + (size_t)row * D : o1 + (size_t)(row - SEQ) * D) : nullptr;
                float sq = 0.f;
#pragma unroll
                for (int bj = 0; bj < 2; ++bj) {
                    const int c = col0 + bj * 128;
                    const v4u rw = *(const v4u*)(rp + c);
                    f32x4 a0 = {bf2f(rw.x & 0xffffu), bf2f(rw.x >> 16), bf2f(rw.y & 0xffffu), bf2f(rw.y >> 16)}, a1 = {bf2f(rw.z & 0xffffu), bf2f(rw.z >> 16), bf2f(rw.w & 0xffffu), bf2f(rw.w >> 16)};
                    a0 += acc[ai][bj][m][0]; a1 += acc[ai][bj][m][1];
                    if (MODE == 2) { __builtin_nontemporal_store(a0, (f32x4*)(op + c)); __builtin_nontemporal_store(a1, (f32x4*)(op + c + 4)); }
                    else {
                        v4u w; w.x = cvt_pk_bf16(a0[0], a0[1]); w.y = cvt_pk_bf16(a0[2], a0[3]); w.z = cvt_pk_bf16(a1[0], a1[1]); w.w = cvt_pk_bf16(a1[2], a1[3]);
                        *(v4u*)(hb + (size_t)row * D + c) = w;
                        sq += (a0[0] * a0[0] + a0[1] * a0[1]) + (a0[2] * a0[2] + a0[3] * a0[3]) + (a1[0] * a1[0] + a1[1] * a1[1]) + (a1[2] * a1[2] + a1[3] * a1[3]);
                    }
                }
                if (MODE != 2) { sq += shx<16>(sq); sq = xadd32(sq); if (fq == 0) atomicAdd(ss + row, sq); }
            }
    }
    __device__ __forceinline__ void tail(int row, int col, f32x4 v, int fq) const {
        const v2u rw = *(const v2u*)(rb + (size_t)row * D + col);
        f32x4 a0 = {bf2f(rw.x & 0xffffu), bf2f(rw.x >> 16), bf2f(rw.y & 0xffffu), bf2f(rw.y >> 16)}; a0 += v;
        if (MODE == 2) { *(f32x4*)(o1 + (size_t)(row - SEQ) * D + col) = a0; }
        else {
            v2u w; w.x = cvt_pk_bf16(a0[0], a0[1]); w.y = cvt_pk_bf16(a0[2], a0[3]); *(v2u*)(hb + (size_t)row * D + col) = w;
            float sq = (a0[0] * a0[0] + a0[1] * a0[1]) + (a0[2] * a0[2] + a0[3] * a0[3]);
            sq += shx<16>(sq); sq = xadd32(sq); if (fq == 0) atomicAdd(ss + row, sq);
        }
    }
};
struct EpiGU {
    static constexpr bool PERM = true;
    const float* ss; bf16* hm;
    __device__ __forceinline__ void operator()(const f32x4 (&acc)[2][2][4][2], const Unit& u, int wr, int wc, int fr, int fq) const {
        const int j0 = u.pn * 128 + wc * 32 + 8 * fq; const int rowb = u.pm * 256 + wr * 64;
#pragma unroll
        for (int ai = 0; ai < 2; ++ai)
#pragma unroll
            for (int m = 0; m < 4; ++m) {
                const int rb = rowb + ai * 128 + m * 16; if (rb >= MR) continue;
                const int row = rb + fr; const float r = rsqrtf(ss[row] * (1.0f / D) + EPS);
                float o[8];
#pragma unroll
                for (int n = 0; n < 2; ++n)
#pragma unroll
                    for (int j = 0; j < 4; ++j) o[4 * n + j] = silu_f(acc[ai][0][m][n][j] * r) * (acc[ai][1][m][n][j] * r);
                v4u w; w.x = cvt_pk_bf16(o[0], o[1]); w.y = cvt_pk_bf16(o[2], o[3]); w.z = cvt_pk_bf16(o[4], o[5]); w.w = cvt_pk_bf16(o[6], o[7]);
                *(v4u*)(hm + (size_t)row * DFF + j0) = w;
            }
    }
};
struct EpiKVQ {
    static constexpr bool PERM = true;
    const float* ss; unsigned char* ws; float* outp; const float* kn; const float* qn; LAS unsigned char* xl;
    __device__ __forceinline__ void operator()(const f32x4 (&acc)[2][2][4][2], const Unit& u, int wr, int wc, int fr, int fq) const {
        const int c0 = wc * 32 + 8 * fq; const int rowb = u.pm * 256 + wr * 64;
        bf16* Kb_ = (bf16*)(ws + WS_KB); bf16* Vb_ = (bf16*)(ws + WS_VB); bf16* Qb_ = (bf16*)(ws + WS_QB); float* Kp_ = (float*)(ws + WS_KPART);
        if (u.pn == 2 || u.pn == 3) {
#pragma unroll
            for (int ai = 0; ai < 2; ++ai)
#pragma unroll
                for (int m = 0; m < 4; ++m) {
                    const int rb = rowb + ai * 128 + m * 16; if (rb >= MR) continue;
                    const int row = rb + fr; const float r = rsqrtf(ss[row] * (1.0f / D) + EPS);
                    float* vo = outp + ((row < SEQ) ? OV_P + (size_t)row * 512 : OV_S + (size_t)(row - SEQ) * 512);
#pragma unroll
                    for (int bj = 0; bj < 2; ++bj) { const int col = (u.pn - 2) * 256 + bj * 128 + c0; const f32x4 v0 = acc[ai][bj][m][0] * r, v1 = acc[ai][bj][m][1] * r;
                        __builtin_nontemporal_store(v0, (f32x4*)(vo + col)); __builtin_nontemporal_store(v1, (f32x4*)(vo + col + 4));
                        v4u w; w.x = cvt_pk_bf16(v0[0], v0[1]); w.y = cvt_pk_bf16(v0[2], v0[3]); w.z = cvt_pk_bf16(v1[0], v1[1]); w.w = cvt_pk_bf16(v1[2], v1[3]);
                        *(v4u*)(Vb_ + (size_t)row * 512 + col) = w; }
                }
            return;
        }
        const bool isk = u.pn < 2;
        LAS float* P = (LAS float*)xl;
        LAS float* CS = (LAS float*)(xl + 8192);
#pragma unroll
        for (int ai = 0; ai < 2; ++ai)
#pragma unroll
            for (int m = 0; m < 4; ++m) {
                const int rl = ai * 128 + wr * 64 + m * 16 + fr; const float r = rsqrtf(ss[u.pm * 256 + rl] * (1.0f / D) + EPS);
#pragma unroll
                for (int bj = 0; bj < 2; ++bj) { const f32x4 v0 = acc[ai][bj][m][0] * r, v1 = acc[ai][bj][m][1] * r;
                    float sq = (v0[0] * v0[0] + v0[1] * v0[1]) + (v0[2] * v0[2] + v0[3] * v0[3]) + (v1[0] * v1[0] + v1[1] * v1[1]) + (v1[2] * v1[2] + v1[3] * v1[3]);
                    sq += shx<16>(sq); sq = xadd32(sq);
                    if (fq == 0) P[(rl * 2 + bj) * 4 + wc] = sq; }
            }
        asm volatile("s_waitcnt lgkmcnt(0)" ::: "memory"); __builtin_amdgcn_s_barrier(); asm volatile("" ::: "memory");
        float cs[2][8];
#pragma unroll
        for (int bj = 0; bj < 2; ++bj)
#pragma unroll
            for (int j = 0; j < 8; ++j) cs[bj][j] = 0.f;
        const float* gp = (isk ? kn : qn) + c0; const f32x4 g0 = *(const f32x4*)gp, g1 = *(const f32x4*)(gp + 4);
#pragma unroll
        for (int ai = 0; ai < 2; ++ai)
#pragma unroll
            for (int m = 0; m < 4; ++m) {
                const int rb = rowb + ai * 128 + m * 16; if (rb >= MR) continue;
                const int rl = ai * 128 + wr * 64 + m * 16 + fr; const int row = rb + fr; const float r = rsqrtf(ss[row] * (1.0f / D) + EPS);
#pragma unroll
                for (int bj = 0; bj < 2; ++bj) {
                    const f32x4 pp = *(const LAS f32x4*)(P + (rl * 2 + bj) * 4);
                    const float rh = rsqrtf(((pp[0] + pp[1]) + (pp[2] + pp[3])) * (1.0f / 128.0f) + EPS) * (isk ? 1.0f : C2);
                    const f32x4 n0 = acc[ai][bj][m][0] * (r * rh) * g0, n1 = acc[ai][bj][m][1] * (r * rh) * g1;
                    v4u w; w.x = cvt_pk_bf16(n0[0], n0[1]); w.y = cvt_pk_bf16(n0[2], n0[3]); w.z = cvt_pk_bf16(n1[0], n1[1]); w.w = cvt_pk_bf16(n1[2], n1[3]);
                    if (isk) {
                        const int col = u.pn * 256 + bj * 128 + c0;
                        float* ko = outp + ((row < SEQ) ? OK_P + (size_t)row * 512 : OK_S + (size_t)(row - SEQ) * 512) + col;
                        __builtin_nontemporal_store(n0, (f32x4*)ko); __builtin_nontemporal_store(n1, (f32x4*)(ko + 4));
                        *(v4u*)(Kb_ + (size_t)row * 512 + col) = w;
#pragma unroll
                        for (int j = 0; j < 4; ++j) { cs[bj][j] += n0[j]; cs[bj][4 + j] += n1[j]; }
                    } else {
                        *(v4u*)(Qb_ + (size_t)row * D + (u.pn - 4) * 256 + bj * 128 + c0) = w;
                    }
                }
            }
        if (isk && u.pm < SEQ / 256) {
#pragma unroll
            for (int bj = 0; bj < 2; ++bj)
#pragma unroll
                for (int j = 0; j < 8; ++j) { float v = cs[bj][j]; v += shx<1>(v); v += shx<2>(v); v += shx<4>(v); v += shx<8>(v); if (fr == 0) CS[wr * 256 + bj * 128 + c0 + j] = v; }
            asm volatile("s_waitcnt lgkmcnt(0)" ::: "memory"); __builtin_amdgcn_s_barrier(); asm volatile("" ::: "memory");
            const int t = (wr * 4 + wc) * 64 + fq * 16 + fr;
            if (t < 256) Kp_[(size_t)u.pm * 512 + u.pn * 256 + t] = CS[t] + CS[256 + t];
        }
    }
};

struct Args { const void* in[21]; float* out; unsigned char* ws; };

__device__ __forceinline__ void p0_transpose_item(const float* W, int K, int N, bf16* WT, int row_off, int mode, const float* gain, LAS float* scr, int item, int lane) {
    const int nblk = N / 64, kb = item / nblk, nb = item % nblk, k0 = 64 * kb, n0 = 64 * nb;
    const int r = lane >> 4, c4 = lane & 15;
#pragma unroll
    for (int i = 0; i < 16; ++i) { const int kk = 4 * i + r; f32x4 w = __builtin_nontemporal_load((const f32x4*)(W + (size_t)(k0 + kk) * N + n0 + 4 * c4)); if (gain) w *= gain[k0 + kk]; *(LAS f32x4*)(scr + kk * 68 + 4 * c4) = w; }
    LDS_WAIT(); asm volatile("" ::: "memory");
    const int c = lane & 7;
    int d0;
    if (mode == 0) d0 = row_off + n0;
    else { const int j = (n0 < DFF) ? n0 : n0 - DFF; d0 = 256 * (j >> 7) + (j & 127) + ((n0 < DFF) ? 0 : 128); }
#pragma unroll
    for (int j = 0; j < 8; ++j) { const int n = (lane >> 3) + 8 * j; const LAS float* sp = scr + (8 * c) * 68 + n;
        v4u o; o.x = pk2(sp[0 * 68], sp[1 * 68]); o.y = pk2(sp[2 * 68], sp[3 * 68]); o.z = pk2(sp[4 * 68], sp[5 * 68]); o.w = pk2(sp[6 * 68], sp[7 * 68]);
        *(v4u*)(WT + (size_t)(d0 + n) * K + k0 + 8 * c) = o; }
    LDS_WAIT(); asm volatile("" ::: "memory");
}

constexpr int KS_P = 144;
constexpr int KS_BYTES = 256 * KS_P * 2;
typedef short v4i16_t __attribute__((ext_vector_type(4)));
__device__ __forceinline__ v2u tr_read(const LAS bf16* p) { return __builtin_bit_cast(v2u, __builtin_amdgcn_ds_read_tr16_b64_v4i16((LAS v4i16_t*)p)); }
template <int NKT> __device__ __forceinline__ void attn_scores(const LAS bf16* Ks, const bf16x8 (&qf)[4], f32x4 (&acc)[16], int nkt, int fr, int fq) {
#pragma unroll
    for (int kt = 0; kt < NKT; ++kt) {
        acc[kt] = (f32x4){0.f, 0.f, 0.f, 0.f};
        if (kt < nkt) {
#pragma unroll
            for (int ks = 0; ks < 4; ++ks) { const bf16x8 a = *(const LAS bf16x8*)(Ks + (16 * kt + fr) * KS_P + 32 * ks + 8 * fq); acc[kt] = MFMA16(a, qf[ks], acc[kt]); }
        }
    }
}
__device__ __forceinline__ void attn_pv(const LAS bf16* Vr, const f32x4 (&acc)[16], f32x4 (&O)[8], int nj, int fr, int fq) {
#pragma unroll
    for (int j = 0; j < 8; ++j) {
        if (j < nj) {
            v4u pw; pw.x = cvt_pk_bf16(acc[2 * j][0], acc[2 * j][1]); pw.y = cvt_pk_bf16(acc[2 * j][2], acc[2 * j][3]); pw.z = cvt_pk_bf16(acc[2 * j + 1][0], acc[2 * j + 1][1]); pw.w = cvt_pk_bf16(acc[2 * j + 1][2], acc[2 * j + 1][3]);
            const bf16x8 pf = __builtin_bit_cast(bf16x8, pw);
            const LAS bf16* vb = Vr + (32 * j + 4 * fq + (fr >> 2)) * KS_P + 4 * (fr & 3);
#pragma unroll
            for (int vt = 0; vt < 8; ++vt) {
                const v2u lo = tr_read(vb + 16 * vt), hi = tr_read(vb + 16 * KS_P + 16 * vt);
                const v4u aw = {lo.x, lo.y, hi.x, hi.y};
                O[vt] = MFMA16(__builtin_bit_cast(bf16x8, aw), pf, O[vt]);
            }
        }
    }
}

template <int NT> __device__ __forceinline__ void tail_gemm(LAS unsigned char* lds, const bf16* A, const bf16* Bt, int K, int n0, int rowhalf, f32x4 (&acc)[NT], int tidx) {
    int tid_o = tidx; asm volatile("" : "+v"(tid_o));
    const int tid = tid_o, lane = tid & 63, wave = __builtin_amdgcn_readfirstlane(tid >> 6), fr = lane & 15, fq = lane >> 4;
    const int rt = wave & 3, kh = wave >> 2; const int Kh = K >> 1;
    const int KC = (K == 2048) ? 1024 : 1408;
    const int NCH = Kh / KC, PB = KC + 8, UPR = KC >> 3, NS = KC >> 7;
    LAS bf16* Bs = (LAS bf16*)(lds + 8192);
    const bf16* ap = A + (size_t)(64 * rowhalf + 16 * rt + fr) * K + kh * Kh + 8 * fq;
    const LAS bf16* bl = Bs + (kh * 16 * NT + fr) * PB + 8 * fq;
#pragma unroll
    for (int t = 0; t < NT; ++t) acc[t] = (f32x4){0.f, 0.f, 0.f, 0.f};
#define TG_LDA(a_, k0_) do { _Pragma("unroll") for (int s_ = 0; s_ < 4; ++s_) a_[s_] = *(const bf16x8*)(ap + (k0_) + 32 * s_); } while (0)
#define TG_MMA(a_, kl_) do { _Pragma("unroll") for (int s_ = 0; s_ < 4; ++s_) { _Pragma("unroll") for (int t_ = 0; t_ < NT; ++t_) { \
        const bf16x8 b_ = *(const LAS bf16x8*)(bl + t_ * 16 * PB + (kl_) + 32 * s_); acc[t_] = MFMA16(b_, a_[s_], acc[t_]); } } } while (0)
    for (int ch = 0; ch < NCH; ++ch) {
        const int kb = ch * KC;
        bf16x8 a0[4], a1[4], a2[4], a3[4];
        TG_LDA(a0, kb); TG_LDA(a1, kb + 128); TG_LDA(a2, kb + 256); TG_LDA(a3, kb + 384);
        const int NU = 2 * 16 * NT * UPR;
        for (int u = tid; u < NU; u += NTHR) { const int r2 = u / UPR, kc = u - r2 * UPR; const int khh = (r2 >= 16 * NT) ? 1 : 0, row = r2 - khh * 16 * NT;
            const v4u w = *(const v4u*)(Bt + (size_t)(n0 + row) * K + khh * Kh + kb + 8 * kc); *(LAS v4u*)(Bs + r2 * PB + 8 * kc) = w; }
        __syncthreads();
        for (int st = 0; st < NS; st += 4) {
            TG_MMA(a0, 128 * st);           if (st + 4 < NS) TG_LDA(a0, kb + 128 * (st + 4));
            if (st + 1 < NS) { TG_MMA(a1, 128 * (st + 1)); if (st + 5 < NS) TG_LDA(a1, kb + 128 * (st + 5)); }
            if (st + 2 < NS) { TG_MMA(a2, 128 * (st + 2)); if (st + 6 < NS) TG_LDA(a2, kb + 128 * (st + 6)); }
            if (st + 3 < NS) { TG_MMA(a3, 128 * (st + 3)); if (st + 7 < NS) TG_LDA(a3, kb + 128 * (st + 7)); }
        }
        __syncthreads();
    }
#undef TG_LDA
#undef TG_MMA
    LAS f32x4* red = (LAS f32x4*)lds;
    if (kh == 1) {
#pragma unroll
        for (int t = 0; t < NT; ++t) red[(t * 4 + rt) * 64 + lane] = acc[t];
    }
    __syncthreads();
    if (kh == 0) {
#pragma unroll
        for (int t = 0; t < NT; ++t) acc[t] += red[(t * 4 + rt) * 64 + lane];
    }
    __syncthreads();
}

__device__ __forceinline__ void kmean_items(LAS unsigned char* lds, const float* cache_k_, const int* ptab_, float* Kms_, int i0, int i1, int c0, int cn, int tidx) {
    int tid_o = tidx; asm volatile("" : "+v"(tid_o)); const int tid = tid_o;
    const int me = (int)blockIdx.x - c0; if (me < 0 || me >= cn) return;
    LAS f32x4* redk = (LAS f32x4*)(lds);
    for (int item = i0 + me; item < i1; item += cn) {
        const int b = item >> 5, n = item & 31; const int c4 = tid & 127, rg = tid >> 7;
        f32x4 a = {0.f, 0.f, 0.f, 0.f};
#pragma unroll
        for (int hp = 0; hp < 2; ++hp) { const int page = ptab_[b * NPAGES + 2 * n + hp]; const f32x4* pp = (const f32x4*)(cache_k_ + (size_t)page * PAGE * 512) + c4;
#pragma unroll 16
            for (int r = rg; r < 128; r += 4) a += __builtin_nontemporal_load(pp + (size_t)r * 128); }
        redk[rg * 128 + c4] = a;
        __syncthreads();
        if (tid < 128) { const f32x4 s4 = (redk[tid] + redk[128 + tid]) + (redk[256 + tid] + redk[384 + tid]); *(f32x4*)(Kms_ + (size_t)item * 512 + 4 * tid) = s4 * (1.0f / 256.0f); }
        __syncthreads();
    }
}

__global__ void __launch_bounds__(NTHR, 2) yoco_fwd(Args args) {
    extern __shared__ __attribute__((aligned(16))) unsigned char lds_raw[];
    LAS unsigned char* lds = (LAS unsigned char*)lds_raw;
#define TIDS int tid_o = TIDX; asm volatile("" : "+v"(tid_o)); const int tid = tid_o, lane = tid & 63, wave = __builtin_amdgcn_readfirstlane(tid >> 6), fr = lane & 15, fq = lane >> 4; (void)fr; (void)fq; (void)wave; (void)lane; (void)tid
    const int G = gridDim.x, bid = blockIdx.x;
    unsigned char* ws = args.ws;
    unsigned* ctl = (unsigned*)(ws + WS_CTL);
    volatile LAS unsigned* MISC = (volatile LAS unsigned*)(lds + MISC_OFF);
    const int wave_sg = __builtin_amdgcn_readfirstlane((int)threadIdx.x & ~63);
#define TIDX (wave_sg + lane_id())
#define IS_T0 ((wave_sg == 0) && (lane_id() == 0))
    if (TIDX < 64) MISC[TIDX] = 0u;
    __syncthreads();
    XcdBarrier bar = xcd_barrier_post(ctl + CW_BAR, MISC + 8, IS_T0);
#ifdef PROF_A
    int n_stamp = 0;
#define STAMP() do { if (blockIdx.x == 0 && IS_T0) MISC[16 + n_stamp] = (unsigned)__builtin_amdgcn_s_memrealtime(); ++n_stamp; } while (0)
#define TNOW() ((unsigned)__builtin_amdgcn_s_memrealtime())
#define TACC(k, t0) do { if (blockIdx.x == 0 && IS_T0) MISC[40 + (k)] += TNOW() - (t0); } while (0)
#define PVAL(a0, a1) (((a0) >= 100) ? MISC[40 + (a0) - 100] : (MISC[16 + (a1)] - MISC[16 + (a0)]))
#else
#define STAMP() do {} while (0)
#define TNOW() 0u
#define TACC(k, t0) do { (void)(t0); } while (0)
#endif
    STAMP();

#define x_p ((const float*)args.in[0])
#define x_s ((const float*)args.in[1])
#define st_in ((const float*)args.in[2])
#define cache_k ((const float*)args.in[3])
#define cache_v ((const float*)args.in[4])
#define ptab ((const int*)args.in[5])
#define norm_mix_a ((const float*)args.in[6])
#define w_in ((const float*)args.in[7])
#define lbl ((const float*)args.in[8])
#define onorm ((const float*)args.in[9])
#define w_out ((const float*)args.in[10])
#define norm_kv ((const float*)args.in[11])
#define w_kv ((const float*)args.in[12])
#define k_norm ((const float*)args.in[13])
#define norm_mix_b ((const float*)args.in[14])
#define w_q ((const float*)args.in[15])
#define q_norm ((const float*)args.in[16])
#define w_o ((const float*)args.in[17])
#define norm_ffn ((const float*)args.in[18])
#define w_gu ((const float*)args.in[19])
#define w_dn ((const float*)args.in[20])
#define Win_t ((bf16*)(ws + WS_WIN))
#define Wout_t ((bf16*)(ws + WS_WOUT))
#define Wgu0_t ((bf16*)(ws + WS_WGU0))
#define Wdn0_t ((bf16*)(ws + WS_WDN0))
#define Wkvq_t ((bf16*)(ws + WS_WKVQ))
#define Wo_t ((bf16*)(ws + WS_WO))
#define Wgu1_t ((bf16*)(ws + WS_WGU1))
#define Wdn1_t ((bf16*)(ws + WS_WDN1))
#define Hb0 ((bf16*)(ws + WS_HB0))
#define Hb1 ((bf16*)(ws + WS_HB1))
#define Hb2 ((bf16*)(ws + WS_HB2))
#define Hb3 ((bf16*)(ws + WS_HB3))
#define Hf1 ((float*)(ws + WS_HF1))
#define Hf2 ((float*)(ws + WS_HF2))
#define Hf3 ((float*)(ws + WS_HF3))
#define Qg ((bf16*)(ws + WS_QG))
#define Vg ((bf16*)(ws + WS_VG))
#define Gg ((bf16*)(ws + WS_GG))
#define Ff ((f16*)(ws + WS_F))
#define Ob ((bf16*)(ws + WS_OB))
#define At ((bf16*)(ws + WS_AT))
#define Hm ((bf16*)(ws + WS_HM))
#define Ub ((bf16*)(ws + WS_U))
#define Sst ((bf16*)(ws + WS_SST))
#define Dec ((float*)(ws + WS_DEC))
#define Kraw ((float*)(ws + WS_KRAW))
#define Vraw ((float*)(ws + WS_VRAW))
#define Qraw ((bf16*)(ws + WS_QRAW))
#define Kb ((bf16*)(ws + WS_KB))
#define Vb ((bf16*)(ws + WS_VB))
#define Qb ((bf16*)(ws + WS_QB))
#define Kpart ((float*)(ws + WS_KPART))
#define Kms ((float*)(ws + WS_KMS))
#define Subl ((unsigned*)(ws + WS_SUBL))
#define Scnt ((unsigned*)(ws + WS_SCNT))
#define Sels ((unsigned*)(ws + WS_SCNT + 256 * 1024))
#define Oslot ((bf16*)(ws + WS_OSLOT))
#define MLslot ((float*)(ws + WS_MLSLOT))
#define Sslot ((float*)(ws + WS_SSLOT))
#define ss0 ((float*)(ctl + CW_SS0))
#define ss1 ((float*)(ctl + CW_SS1))
#define ss2 ((float*)(ctl + CW_SS2))
#define ss3 ((float*)(ctl + CW_SS3))
#define out (args.out)
    {
        TIDS;
        LAS float* scr = (LAS float*)(lds + wave * 17408);
        const int gw = bid * NWAVES + wave, NGW = G * NWAVES;
        constexpr int I_IN = 32 * 128, I_SQ = 32 * 32, I_GU = 32 * 176, I_DN = 88 * 32, I_KV = 32 * 16;
        constexpr int NITEMS = I_IN + I_SQ + 2 * I_GU + 2 * I_DN + I_KV + I_SQ + I_SQ;
        for (int it = gw; it < NITEMS; it += NGW) {
            int r = it;
            if (r < I_IN) { p0_transpose_item(w_in, D, 4 * D, Win_t, 0, 0, norm_mix_a, scr, r, lane); continue; } r -= I_IN;
            if (r < I_SQ) { p0_transpose_item(w_out, D, D, Wout_t, 0, 0, nullptr, scr, r, lane); continue; } r -= I_SQ;
            if (r < I_GU) { p0_transpose_item(w_gu, D, NGU, Wgu0_t, 0, 1, norm_ffn, scr, r, lane); continue; } r -= I_GU;
            if (r < I_GU) { p0_transpose_item(w_gu + (size_t)D * NGU, D, NGU, Wgu1_t, 0, 1, norm_ffn + D, scr, r, lane); continue; } r -= I_GU;
            if (r < I_DN) { p0_transpose_item(w_dn, DFF, D, Wdn0_t, 0, 0, nullptr, scr, r, lane); continue; } r -= I_DN;
            if (r < I_DN) { p0_transpose_item(w_dn + (size_t)DFF * D, DFF, D, Wdn1_t, 0, 0, nullptr, scr, r, lane); continue; } r -= I_DN;
            if (r < I_KV) { p0_transpose_item(w_kv, D, 1024, Wkvq_t, 0, 0, norm_kv, scr, r, lane); continue; } r -= I_KV;
            if (r < I_SQ) { p0_transpose_item(w_q, D, D, Wkvq_t, 1024, 0, norm_mix_b, scr, r, lane); continue; } r -= I_SQ;
            p0_transpose_item(w_o, D, D, Wo_t, 0, 0, nullptr, scr, r, lane);
        }
        for (int m = gw; m < MR; m += NGW) {
            const float* src = (m < SEQ) ? x_p + (size_t)m * D : x_s + (size_t)(m - SEQ) * D;
            const f32x4* xr = (const f32x4*)src + lane; f32x4 v[8]; float s = 0.f;
#pragma unroll
            for (int j = 0; j < 8; ++j) { v[j] = __builtin_nontemporal_load(xr + 64 * j); s += (v[j].x * v[j].x + v[j].y * v[j].y) + (v[j].z * v[j].z + v[j].w * v[j].w); }
            s = wave_sum(s);
            if (lane == 0) ss0[m] = s;
            v2u* o8 = (v2u*)(Hb0 + (size_t)m * D) + lane;
#pragma unroll
            for (int j = 0; j < 8; ++j) { v2u w; w.x = pk2(v[j].x, v[j].y); w.y = pk2(v[j].z, v[j].w); o8[64 * j] = w; }
        }
        __syncthreads();
        kmean_items(lds, cache_k, ptab, Kms, 848, DECB * NBLK, 0, G, TIDX);
    }
    xcd_barrier(bar, IS_T0);
    STAMP();

    {
        TIDS;
        pg8::Gemm g{Hb0, Win_t, SEQ, 4 * D, D}; pg8::StaticOrder S; S.init(SEQ, 4 * D, G, bid);
        EpiIn E{ss0, lbl, Qg, Ff};
        pg8::gemm_phase<EpiIn, pg8::StaticOrder, true, true, false>(lds, g, S, E, TIDX);
        for (int it2 = 0; it2 < 2; ++it2) {
            const int w2 = bid + 256 * it2, t2 = w2 & 255, rh = (w2 >> 8) & 1;
            TIDS; f32x4 ta[2]; tail_gemm<2>(lds, Hb0 + (size_t)SEQ * D, Win_t, D, 32 * t2, rh, ta, TIDX);
            if (wave < 4) { const int row = SEQ + 64 * rh + 16 * wave + fr; E.tail(row, 32 * t2 + 4 * fq, ta[0]); E.tail(row, 32 * t2 + 16 + 4 * fq, ta[1]); }
        }
    }
    xcd_barrier(bar, IS_T0);
    STAMP();

    {
        TIDS;
        LAS float* tot = (LAS float*)(lds);
        LAS bf16* koT = (LAS bf16*)(lds + 4096);
        LAS bf16* Vr = (LAS bf16*)(lds + 4096 + 128 * 72 * 2);
        const int col = tid & 127, part = tid >> 7; const int vt_t = tid >> 3, vd0 = (tid & 7) * 16;
        f16 fN[16]; v4u vaN, vbN;
#define P2_LOADN(it_) do { const int h_ = (it_) >> 7, r0_ = ((it_) & 127) * 64; const f16* fp_ = Ff + (size_t)(r0_ + part * 16) * D + h_ * 128 + col; \
            _Pragma("unroll") for (int i = 0; i < 16; ++i) fN[i] = fp_[(size_t)i * D]; \
            const bf16* vp_ = Vg + (size_t)(r0_ + vt_t) * D + h_ * 128 + vd0; vaN = *(const v4u*)vp_; vbN = *(const v4u*)(vp_ + 8); } while (0)
        if (bid < NH * NCHUNK) P2_LOADN(bid);
        for (int item = bid; item < NH * NCHUNK; item += G) {
            float cum[16], kk[16]; float run = 0.f;
#pragma unroll
            for (int i = 0; i < 16; ++i) { kk[i] = (float)fN[i]; const float f = 1.0f - kk[i]; run += __logf(f); cum[i] = run; }
            tot[part * 128 + col] = run;
            *(LAS v4u*)(Vr + vt_t * 144 + vd0) = vaN; *(LAS v4u*)(Vr + vt_t * 144 + vd0 + 8) = vbN;
            if (item + G < NH * NCHUNK) P2_LOADN(item + G);
            __syncthreads();
            float offs = 0.f, lastv = 0.f;
#pragma unroll
            for (int p = 0; p < 4; ++p) { const float tv = tot[p * 128 + col]; lastv += tv; if (p < part) offs += tv; }
            unsigned kw[8];
#pragma unroll
            for (int i = 0; i < 8; ++i) { const float a = kk[2 * i] * __expf(lastv - (cum[2 * i] + offs)), b = kk[2 * i + 1] * __expf(lastv - (cum[2 * i + 1] + offs)); kw[i] = pk2(a, b); }
            *(LAS v4u*)(koT + col * 72 + part * 16) = (v4u){kw[0], kw[1], kw[2], kw[3]};
            *(LAS v4u*)(koT + col * 72 + part * 16 + 8) = (v4u){kw[4], kw[5], kw[6], kw[7]};
            if (part == 0) Dec[(size_t)item * 128 + col] = __expf(lastv);
            __syncthreads();
            { bf16x8 a[2]; a[0] = *(const LAS bf16x8*)(koT + (16 * wave + fr) * 72 + 8 * fq); a[1] = *(const LAS bf16x8*)(koT + (16 * wave + fr) * 72 + 32 + 8 * fq);
              bf16* ub = Ub + (size_t)item * 16384;
              const LAS bf16* vb = Vr + (8 * fq + (fr >> 2)) * 144 + 4 * (fr & 3);
#pragma unroll
              for (int vt = 0; vt < 8; ++vt) {
                  f32x4 acc = {0.f, 0.f, 0.f, 0.f};
                  const v2u l0 = tr_read(vb + 16 * vt), h0 = tr_read(vb + 4 * 144 + 16 * vt), l1 = tr_read(vb + 32 * 144 + 16 * vt), h1 = tr_read(vb + 36 * 144 + 16 * vt);
                  const v4u b0 = {l0.x, l0.y, h0.x, h0.y}, b1 = {l1.x, l1.y, h1.x, h1.y};
                  acc = MFMA16(a[0], __builtin_bit_cast(bf16x8, b0), acc); acc = MFMA16(a[1], __builtin_bit_cast(bf16x8, b1), acc);
                  v2u w; w.x = pk2(acc[0], acc[1]); w.y = pk2(acc[2], acc[3]);
                  *(v2u*)(ub + (size_t)(16 * vt + fr) * 128 + 16 * wave + 4 * fq) = w;
              } }
            __syncthreads();
        }
#undef P2_LOADN
        LAS float* red = (LAS float*)(lds);
        LAS float* red2 = (LAS float*)(lds + 8192);
        float* st_out = out + OST_S;
        for (int item = bid; item < DECB * NH; item += G) {
            const int b = item >> 4, h = item & 15; const int vd = tid & 127, kq = tid >> 7;
            const float* sp = st_in + ((size_t)(b * NH + h) * 128 + 32 * kq) * 128 + vd;
            float Sx[32];
#pragma unroll
            for (int i = 0; i < 32; ++i) Sx[i] = __builtin_nontemporal_load(sp + (size_t)i * 128);
#pragma unroll
            for (int t = 0; t < 4; ++t) {
                const int row = SEQ + 4 * b + t; const size_t ro = (size_t)row * D + h * 128;
                const float v = bf2f(Vg[ro + vd]); float op = 0.f;
#pragma unroll
                for (int i = 0; i < 32; ++i) { const float f = 1.0f - (float)Ff[ro + 32 * kq + i]; const float q = bf2f(Qg[ro + 32 * kq + i]); Sx[i] = f * Sx[i] + (1.0f - f) * v; op += Sx[i] * q; }
                red[(t * 4 + kq) * 128 + vd] = op;
            }
            float* so = st_out + ((size_t)(b * NH + h) * 128 + 32 * kq) * 128 + vd;
#pragma unroll
            for (int i = 0; i < 32; ++i) __builtin_nontemporal_store(Sx[i], so + (size_t)i * 128);
            __syncthreads();
            { const int t = tid >> 7; const float o = (red[(t * 4 + 0) * 128 + vd] + red[(t * 4 + 1) * 128 + vd]) + (red[(t * 4 + 2) * 128 + vd] + red[(t * 4 + 3) * 128 + vd]);
              const float s = wave_sum(o * o); if (lane == 0) red2[t * 2 + (wave & 1)] = s;
              __syncthreads();
              const float r = rsqrtf((red2[t * 2] + red2[t * 2 + 1]) * (1.0f / 128.0f) + EPS);
              const int row = SEQ + 4 * b + t; const size_t ro = (size_t)row * D + h * 128 + vd;
              Ob[ro] = (bf16)f2bf(o * r * onorm[vd] * bf2f(Gg[ro])); }
            __syncthreads();
        }
    }
    xcd_barrier(bar, IS_T0);
    STAMP();

    {
        TIDS;
        for (int gid = bid * NTHR + tid; gid < NH * 128 * 32; gid += G * NTHR) {
            const int h = gid >> 12, rem = gid & 4095, vd = rem >> 5, k = (rem & 31) * 4;
            float s0 = 0.f, s1 = 0.f, s2 = 0.f, s3 = 0.f;
            const v2u* up = (const v2u*)(Ub + ((size_t)h * 128 * 128 + vd) * 128 + k);
            v2u* sp = (v2u*)(Sst + ((size_t)h * 128 * 128 + vd) * 128 + k);
            const f32x4* dp = (const f32x4*)(Dec + (size_t)h * 128 * 128 + k);
#pragma unroll 16
            for (int c = 0; c < NCHUNK; ++c) {
                const v2u u = up[(size_t)c * 4096]; const f32x4 d = dp[(size_t)c * 32];
                v2u w; w.x = pk2(s0, s1); w.y = pk2(s2, s3); sp[(size_t)c * 4096] = w;
                s0 = d.x * s0 + bf2f(u.x & 0xffffu); s1 = d.y * s1 + bf2f(u.x >> 16); s2 = d.z * s2 + bf2f(u.y & 0xffffu); s3 = d.w * s3 + bf2f(u.y >> 16);
            }
            float* so = out + OST_P + ((size_t)h * 128 + k) * 128 + vd;
            so[0] = s0; so[128] = s1; so[256] = s2; so[384] = s3;
        }
    }
    xcd_barrier(bar, IS_T0);
    STAMP();

    {
        TIDS;
        LAS float* tot = (LAS float*)(lds);
        LAS float* refs = (LAS float*)(lds + 2048);
        LAS float* red = (LAS float*)(lds + 2560);
        LAS bf16* QE = (LAS bf16*)(lds + 4096);
        LAS bf16* KE = QE + 64 * 136;
        LAS bf16* QI = KE + 64 * 136;
        LAS bf16* Vr = QI + 64 * 136;
        LAS bf16* STs = Vr + 64 * 144;
        const int col = tid & 127, part = tid >> 7; const int vt_t = tid >> 3, vd0 = (tid & 7) * 16;
        const int tt = wave & 3, vh = wave >> 2;
        f16 fN[16]; bf16 qN[16]; v4u vaN, vbN, stN[4];
#define P4_LOADN(it_) do { const int h_ = (it_) >> 7, r0_ = ((it_) & 127) * 64; const f16* fp_ = Ff + (size_t)(r0_ + part * 16) * D + h_ * 128 + col; const bf16* qp_ = Qg + (size_t)(r0_ + part * 16) * D + h_ * 128 + col; \
            _Pragma("unroll") for (int i = 0; i < 16; ++i) { fN[i] = fp_[(size_t)i * D]; qN[i] = qp_[(size_t)i * D]; } \
            const bf16* vp_ = Vg + (size_t)(r0_ + vt_t) * D + h_ * 128 + vd0; vaN = *(const v4u*)vp_; vbN = *(const v4u*)(vp_ + 8); \
            const v4u* sp_ = (const v4u*)(Sst + (size_t)(it_) * 16384); _Pragma("unroll") for (int i = 0; i < 4; ++i) stN[i] = sp_[i * 512 + tid]; } while (0)
        if (bid < NH * NCHUNK) P4_LOADN(bid);
        for (int item = bid; item < NH * NCHUNK; item += G) {
            const int h = item >> 7, c = item & 127; const int row0 = c * 64;
            float cum[16], kk[16], qv[16]; float run = 0.f;
#pragma unroll
            for (int i = 0; i < 16; ++i) { kk[i] = (float)fN[i]; const float f = 1.0f - kk[i]; run += __logf(f); cum[i] = run; qv[i] = bf2f(qN[i]); }
            tot[part * 128 + col] = run;
            *(LAS v4u*)(Vr + vt_t * 144 + vd0) = vaN; *(LAS v4u*)(Vr + vt_t * 144 + vd0 + 8) = vbN;
#pragma unroll
            for (int i = 0; i < 4; ++i) { const int idx = i * 512 + tid, vd = idx >> 4, k8 = idx & 15; *(LAS v4u*)(STs + vd * 136 + k8 * 8) = stN[i]; }
            const size_t ro = (size_t)(row0 + 16 * tt + fr) * D + h * 128;
            v2u gw2[4]; f32x4 on[4];
#pragma unroll
            for (int vt = 0; vt < 4; ++vt) { const int vd = 16 * (4 * vh + vt) + 4 * fq; gw2[vt] = *(const v2u*)(Gg + ro + vd); on[vt] = *(const f32x4*)(onorm + vd); }
            if (item + G < NH * NCHUNK) P4_LOADN(item + G);
            __syncthreads();
            float offs = 0.f;
#pragma unroll
            for (int p = 0; p < 4; ++p) { const float tv = tot[p * 128 + col]; if (p < part) offs += tv; }
            if (part == 1) refs[col] = cum[15] + offs;
            __syncthreads();
            const float ref = refs[col];
#pragma unroll
            for (int i = 0; i < 16; ++i) { const float cm = cum[i] + offs, d1 = cm - ref; const int t = part * 16 + i;
                QE[t * 136 + col] = (bf16)f2bf(qv[i] * __expf(d1)); KE[t * 136 + col] = (bf16)f2bf(kk[i] * __expf(-d1)); QI[t * 136 + col] = (bf16)f2bf(qv[i] * __expf(cm)); }
            __syncthreads();
            {
                f32x4 aS[4];
#pragma unroll
                for (int st = 0; st < 4; ++st) {
                    aS[st] = (f32x4){0.f, 0.f, 0.f, 0.f};
                    if (st <= tt) {
#pragma unroll
                        for (int ks = 0; ks < 4; ++ks) { const bf16x8 a = *(const LAS bf16x8*)(KE + (16 * st + fr) * 136 + 32 * ks + 8 * fq), b = *(const LAS bf16x8*)(QE + (16 * tt + fr) * 136 + 32 * ks + 8 * fq); aS[st] = MFMA16(a, b, aS[st]); }
                        if (st == tt) {
#pragma unroll
                            for (int r = 0; r < 4; ++r) if (4 * fq + r > fr) aS[st][r] = 0.f;
                        }
                    }
                }
                f32x4 o[4];
#pragma unroll
                for (int vt = 0; vt < 4; ++vt) o[vt] = (f32x4){0.f, 0.f, 0.f, 0.f};
#pragma unroll
                for (int j = 0; j < 2; ++j) {
                    v4u pw; pw.x = cvt_pk_bf16(aS[2 * j][0], aS[2 * j][1]); pw.y = cvt_pk_bf16(aS[2 * j][2], aS[2 * j][3]); pw.z = cvt_pk_bf16(aS[2 * j + 1][0], aS[2 * j + 1][1]); pw.w = cvt_pk_bf16(aS[2 * j + 1][2], aS[2 * j + 1][3]);
                    const bf16x8 pf = __builtin_bit_cast(bf16x8, pw);
                    const LAS bf16* vb = Vr + (32 * j + 4 * fq + (fr >> 2)) * 144 + 64 * vh + 4 * (fr & 3);
#pragma unroll
                    for (int vt = 0; vt < 4; ++vt) { const v2u lo = tr_read(vb + 16 * vt), hi = tr_read(vb + 16 * 144 + 16 * vt); const v4u aw = {lo.x, lo.y, hi.x, hi.y};
                        o[vt] = MFMA16(__builtin_bit_cast(bf16x8, aw), pf, o[vt]); }
                }
#pragma unroll
                for (int ks = 0; ks < 4; ++ks) { const bf16x8 b = *(const LAS bf16x8*)(QI + (16 * tt + fr) * 136 + 32 * ks + 8 * fq);
#pragma unroll
                    for (int vt = 0; vt < 4; ++vt) { const bf16x8 a = *(const LAS bf16x8*)(STs + (16 * (4 * vh + vt) + fr) * 136 + 32 * ks + 8 * fq); o[vt] = MFMA16(a, b, o[vt]); } }
                float sq = 0.f;
#pragma unroll
                for (int vt = 0; vt < 4; ++vt) sq += (o[vt][0] * o[vt][0] + o[vt][1] * o[vt][1]) + (o[vt][2] * o[vt][2] + o[vt][3] * o[vt][3]);
                sq += shx<16>(sq); sq = xadd32(sq);
                if (fq == 0) red[(16 * tt + fr) * 2 + vh] = sq;
                __syncthreads();
                const float r = rsqrtf((red[(16 * tt + fr) * 2] + red[(16 * tt + fr) * 2 + 1]) * (1.0f / 128.0f) + EPS);
#pragma unroll
                for (int vt = 0; vt < 4; ++vt) { const int vd = 16 * (4 * vh + vt) + 4 * fq;
                    const float g0 = bf2f(gw2[vt].x & 0xffffu), g1 = bf2f(gw2[vt].x >> 16), g2 = bf2f(gw2[vt].y & 0xffffu), g3 = bf2f(gw2[vt].y >> 16);
                    v2u w; w.x = cvt_pk_bf16(o[vt][0] * r * on[vt][0] * g0, o[vt][1] * r * on[vt][1] * g1); w.y = cvt_pk_bf16(o[vt][2] * r * on[vt][2] * g2, o[vt][3] * r * on[vt][3] * g3);
                    *(v2u*)(Ob + ro + vd) = w; }
            }
            __syncthreads();
        }
#undef P4_LOADN
    }
    xcd_barrier(bar, IS_T0);
    STAMP();

    {
        TIDS;
        pg8::Gemm g{Ob, Wout_t, SEQ, D, D}; pg8::StaticOrder S; S.init(SEQ, D, G, bid);
        EpiRes<1> E{Hb0, nullptr, nullptr, Hb1, ss1};
        const unsigned tg0 = TNOW();
        pg8::gemm_phase<EpiRes<1>, pg8::StaticOrder, true, true, false>(lds, g, S, E, TIDX);
        TACC(5, tg0); const unsigned tg1 = TNOW();
        { const int t2 = bid & 127, rh = (bid >> 7) & 1; TIDS; f32x4 ta[1]; tail_gemm<1>(lds, Ob + (size_t)SEQ * D, Wout_t, D, 16 * t2, rh, ta, TIDX); if (wave < 4) E.tail(SEQ + 64 * rh + 16 * wave + fr, 16 * t2 + 4 * fq, ta[0], fq); }
        TACC(6, tg1);
    }
    xcd_barrier(bar, IS_T0);
    STAMP();
    {
        TIDS;
        pg8::Gemm g{Hb1, Wgu0_t, MP, NGU, D}; pg8::StaticOrder S; S.init(MP, NGU, G, bid);
        EpiGU E{ss1, Hm};
        pg8::gemm_phase<EpiGU, pg8::StaticOrder, true, true>(lds, g, S, E, TIDX);
        kmean_items(lds, cache_k, ptab, Kms, 0, 336, 172, G - 172, TIDX);
    }
    xcd_barrier(bar, IS_T0);
    STAMP();
    {
        TIDS;
        pg8::Gemm g{Hm, Wdn0_t, SEQ, D, DFF}; pg8::StaticOrder S; S.init(SEQ, D, G, bid);
        EpiRes<1> E{Hb1, nullptr, nullptr, Hb2, ss2};
        const unsigned tg0 = TNOW();
        pg8::gemm_phase<EpiRes<1>, pg8::StaticOrder, true, true, false>(lds, g, S, E, TIDX);
        TACC(7, tg0); const unsigned tg1 = TNOW();
        { const int t2 = bid & 127, rh = (bid >> 7) & 1; TIDS; f32x4 ta[1]; tail_gemm<1>(lds, Hm + (size_t)SEQ * DFF, Wdn0_t, DFF, 16 * t2, rh, ta, TIDX); if (wave < 4) E.tail(SEQ + 64 * rh + 16 * wave + fr, 16 * t2 + 4 * fq, ta[0], fq); }
        TACC(8, tg1);
    }
    xcd_barrier(bar, IS_T0);
    STAMP();
    {
        TIDS;
        pg8::Gemm g{Hb2, Wkvq_t, MP, 3072, D}; pg8::StaticOrder S; S.init(MP, 3072, G, bid);
        EpiKVQ E{ss2, ws, out, k_norm, q_norm, lds + 131072};
        pg8::gemm_phase<EpiKVQ, pg8::StaticOrder, true, true>(lds, g, S, E, TIDX);
        kmean_items(lds, cache_k, ptab, Kms, 336, 848, 140, G - 140, TIDX);
    }
    xcd_barrier(bar, IS_T0);
    STAMP();

    {
        TIDS;
        LAS bf16* KMb = (LAS bf16*)(lds);
        LAS unsigned* lcnt = (LAS unsigned*)(lds + 16384);
        LAS float* gs = (LAS float*)(lds + 16384 + 256);
#define G_BETTER(va, ia, vb, ib) (((va) > (vb)) || (((va) == (vb)) && ((ia) < (ib))))
#define G_INSERT(vx, ix) do { const float vx_ = (vx); const int ix_ = (ix); \
            if (G_BETTER(vx_, ix_, v0, i0)) { v2 = v1; i2 = i1; v1 = v0; i1 = i0; v0 = vx_; i0 = ix_; } \
            else if (G_BETTER(vx_, ix_, v1, i1)) { v2 = v1; i2 = i1; v1 = vx_; i1 = ix_; } \
            else if (G_BETTER(vx_, ix_, v2, i2)) { v2 = vx_; i2 = ix_; } } while (0)
        for (int item = bid; item < 256; item += G) {
            const int j = item >> 2, kvh = item & 3; const int b = j >> 1;
            { const int n = tid >> 4, d8 = (tid & 15) * 8; f32x4 s0 = {0.f, 0.f, 0.f, 0.f}, s1 = {0.f, 0.f, 0.f, 0.f};
              if (n < b) { const float* kp = Kpart + (size_t)n * 512 + kvh * 128 + d8; s0 = *(const f32x4*)kp; s1 = *(const f32x4*)(kp + 4); }
              s0 = s0 * (1.0f / 256.0f); s1 = s1 * (1.0f / 256.0f);
              v4u w; w.x = cvt_pk_bf16(s0[0], s0[1]); w.y = cvt_pk_bf16(s0[2], s0[3]); w.z = cvt_pk_bf16(s1[0], s1[1]); w.w = cvt_pk_bf16(s1[2], s1[3]);
              *(LAS v4u*)(KMb + n * 136 + d8) = w; }
            if (tid < 32) lcnt[tid] = 0u;
            __syncthreads();
            const int nsel = b < 3 ? b : 3;
#pragma unroll 1
            for (int rt = 0; rt < 4; ++rt) {
                const int r = 64 * wave + 16 * rt + fr; const int tok = j * 128 + (r >> 2), hg = r & 3; const bf16* qp = Qb + (size_t)tok * D + (4 * kvh + hg) * 128 + 8 * fq;
                bf16x8 qf[4];
#pragma unroll
                for (int ks = 0; ks < 4; ++ks) qf[ks] = *(const bf16x8*)(qp + 32 * ks);
                f32x4 ga[2];
#pragma unroll
                for (int nt = 0; nt < 2; ++nt) { ga[nt] = (f32x4){0.f, 0.f, 0.f, 0.f};
#pragma unroll
                    for (int ks = 0; ks < 4; ++ks) { const bf16x8 ka = *(const LAS bf16x8*)(KMb + (16 * nt + fr) * 136 + 32 * ks + 8 * fq); ga[nt] = MFMA16(ka, qf[ks], ga[nt]); } }
                float v0 = -INFINITY, v1 = -INFINITY, v2 = -INFINITY; int i0 = 99, i1 = 99, i2 = 99;
#pragma unroll
                for (int nt = 0; nt < 2; ++nt)
#pragma unroll
                    for (int q = 0; q < 4; ++q) { const int n = 16 * nt + 4 * fq + q; if (n < b) G_INSERT(ga[nt][q], n); }
                { const float a0 = shx<16>(v0), a1 = shx<16>(v1), a2 = shx<16>(v2);
                  const int c0 = __builtin_amdgcn_ds_swizzle(i0, (16 << 10) | 0x1f), c1 = __builtin_amdgcn_ds_swizzle(i1, (16 << 10) | 0x1f), c2 = __builtin_amdgcn_ds_swizzle(i2, (16 << 10) | 0x1f);
                  G_INSERT(a0, c0); G_INSERT(a1, c1); G_INSERT(a2, c2); }
                {
                  auto p0 = __builtin_amdgcn_permlane32_swap(__float_as_uint(v0), __float_as_uint(v0), false, false); auto p1 = __builtin_amdgcn_permlane32_swap(__float_as_uint(v1), __float_as_uint(v1), false, false);
                  auto p2 = __builtin_amdgcn_permlane32_swap(__float_as_uint(v2), __float_as_uint(v2), false, false);
                  auto q0 = __builtin_amdgcn_permlane32_swap((unsigned)i0, (unsigned)i0, false, false); auto q1 = __builtin_amdgcn_permlane32_swap((unsigned)i1, (unsigned)i1, false, false);
                  auto q2 = __builtin_amdgcn_permlane32_swap((unsigned)i2, (unsigned)i2, false, false);
                  v0 = __uint_as_float(p0[0]); v1 = __uint_as_float(p1[0]); v2 = __uint_as_float(p2[0]); i0 = (int)q0[0]; i1 = (int)q1[0]; i2 = (int)q2[0];
                  G_INSERT(__uint_as_float(p0[1]), (int)q0[1]); G_INSERT(__uint_as_float(p1[1]), (int)q1[1]); G_INSERT(__uint_as_float(p2[1]), (int)q2[1]); }
                if (fq == 0) {
#pragma unroll
                    for (int rk = 0; rk < 3; ++rk) {
                        if (rk < nsel) { const int best = (rk == 0) ? i0 : ((rk == 1) ? i1 : i2);
                            const unsigned pos = atomicAdd((unsigned*)&lcnt[best], 1u);
                            Subl[((size_t)(j * 4 + kvh) * 32 + best) * 512 + pos] = (unsigned)r | ((unsigned)rk << 9); }
                    }
                }
            }
            __syncthreads();
            if (tid < 32) Scnt[(j * 4 + kvh) * 32 + tid] = lcnt[tid];
            __syncthreads();
        }
#undef G_BETTER
#undef G_INSERT
        for (int item = bid; item < DECB * NKV; item += G) {
            const int b = item >> 2, kvh = item & 3; const int pr = tid >> 5, n = tid & 31;
            const int row = SEQ + 4 * b + (pr >> 2), hg = pr & 3; const bf16* qp = Qb + (size_t)row * D + (4 * kvh + hg) * 128; const float* kmp = Kms + ((size_t)(b * 32 + n)) * 512 + kvh * 128;
            float s = 0.f;
#pragma unroll 4
            for (int d = 0; d < 128; d += 8) { const v4u qw = *(const v4u*)(qp + d); const f32x4 k0 = *(const f32x4*)(kmp + d), k1 = *(const f32x4*)(kmp + d + 4);
                s += (bf2f(qw.x & 0xffffu) * k0[0] + bf2f(qw.x >> 16) * k0[1]) + (bf2f(qw.y & 0xffffu) * k0[2] + bf2f(qw.y >> 16) * k0[3]) + (bf2f(qw.z & 0xffffu) * k1[0] + bf2f(qw.z >> 16) * k1[1]) + (bf2f(qw.w & 0xffffu) * k1[2] + bf2f(qw.w >> 16) * k1[3]); }
            gs[pr * 32 + n] = s;
            __syncthreads();
            if (tid < 16) { unsigned m = 0u;
                for (int r = 0; r < 3; ++r) { int best = 0; float bv = -INFINITY; for (int nn = 0; nn < 32; ++nn) { const float v = gs[tid * 32 + nn]; if (v > bv) { bv = v; best = nn; } } m |= 1u << best; gs[tid * 32 + best] = -INFINITY; }
                Sels[item * 16 + tid] = m; }
            __syncthreads();
        }
    }
    xcd_barrier(bar, IS_T0);
    STAMP();

    {
        LAS bf16* Ks = (LAS bf16*)(lds); LAS bf16* Vs = (LAS bf16*)(lds + KS_BYTES);
        LAS unsigned* qsh = (LAS unsigned*)(lds + 2 * KS_BYTES);
        constexpr int NPI = 4 * 496, NSI = DECB * NKV * NBLK;
        for (;;) {
            const unsigned tq0 = TNOW();
            if (IS_T0) qsh[0] = __hip_atomic_fetch_add(ctl + CW_Q0, 1u, __ATOMIC_RELAXED, __HIP_MEMORY_SCOPE_AGENT);
            __syncthreads();
            const int tick = (int)qsh[0];
            __syncthreads();
            TACC(0, tq0);
            if (tick >= NPI + NSI) break;
            TIDS;
            int item; { const int g3 = tick / 3, r3 = tick - 3 * g3; item = (tick < 3 * NPI) ? ((r3 == 0) ? g3 : NPI + 2 * g3 + (r3 - 1)) : NPI + (tick - NPI); }
            if (item < NPI) {
                int b = (int)((1.0f + sqrtf(1.0f + 2.0f * (float)item)) * 0.5f); while (2 * b * (b - 1) > item) --b; while (2 * (b + 1) * b <= item) ++b;
                const int rem = item - 2 * b * (b - 1); const int n = rem >> 2, kvh = rem & 3;
                const int cntA = (int)Scnt[((2 * b) * 4 + kvh) * 32 + n], cntB = (int)Scnt[((2 * b + 1) * 4 + kvh) * 32 + n]; const int total = cntA + cntB;
                if (total == 0) continue;
                const unsigned tp0 = TNOW();
#pragma unroll
                for (int i = 0; i < 8; ++i) { const int idx = i * 512 + tid, key = idx >> 4, c8 = idx & 15; *(LAS v4u*)(Ks + key * KS_P + c8 * 8) = *(const v4u*)(Kb + (size_t)(256 * n + key) * 512 + kvh * 128 + c8 * 8); }
#pragma unroll
                for (int i = 0; i < 8; ++i) { const int idx = i * 512 + tid, key = idx >> 4, c8 = idx & 15; *(LAS v4u*)(Vs + key * KS_P + c8 * 8) = *(const v4u*)(Vb + (size_t)(256 * n + key) * 512 + kvh * 128 + c8 * 8); }
                __syncthreads();
                TACC(1, tp0); const unsigned tp1 = TNOW();
                const unsigned* LA = Subl + ((size_t)((2 * b) * 4 + kvh) * 32 + n) * 512; const unsigned* LB = Subl + ((size_t)((2 * b + 1) * 4 + kvh) * 32 + n) * 512;
#define LIST_ENT(i_) (((i_) < cntA) ? LA[(i_)] : LB[(i_) - cntA])
                const int iw = 16 * wave + fr;
                unsigned e1 = 0u, e2 = 0u; int ic1 = 0, ic2 = 0;
                if (16 * wave < total) { ic1 = iw < total ? iw : total - 1; e1 = LIST_ENT(ic1); }
                if (16 * wave + 128 < total) { ic2 = iw + 128 < total ? iw + 128 : total - 1; e2 = LIST_ENT(ic2); }
                bf16x8 qn[4];
                { const int tokn = ((ic1 < cntA) ? 2 * b : 2 * b + 1) * 128 + (int)((e1 >> 2) & 127u); const bf16* qp = Qb + (size_t)tokn * D + (4 * kvh + (int)(e1 & 3u)) * 128 + 8 * fq;
#pragma unroll
                  for (int ks = 0; ks < 4; ++ks) qn[ks] = *(const bf16x8*)(qp + 32 * ks); }
                for (int t0 = 0; t0 < total; t0 += 128) {
                    const int i0 = t0 + 16 * wave; if (i0 >= total) break;
                    const bool valid = (i0 + fr) < total; const int ic = ic1; const unsigned e = e1;
                    const int tok = ((ic < cntA) ? 2 * b : 2 * b + 1) * 128 + (int)((e >> 2) & 127u), hg = (int)(e & 3u), rk = (int)(e >> 9);
                    const int h = 4 * kvh + hg;
                    bf16x8 qf[4];
#pragma unroll
                    for (int ks = 0; ks < 4; ++ks) qf[ks] = qn[ks];
                    e1 = e2; ic1 = ic2;
                    if (i0 + 256 < total) { ic2 = (i0 + 256 + fr) < total ? (i0 + 256 + fr) : total - 1; e2 = LIST_ENT(ic2); }
                    if (i0 + 128 < total) { const int tokn = ((ic1 < cntA) ? 2 * b : 2 * b + 1) * 128 + (int)((e1 >> 2) & 127u); const bf16* qp = Qb + (size_t)tokn * D + (4 * kvh + (int)(e1 & 3u)) * 128 + 8 * fq;
#pragma unroll
                        for (int ks = 0; ks < 4; ++ks) qn[ks] = *(const bf16x8*)(qp + 32 * ks); }
                    f32x4 acc[16]; attn_scores<16>(Ks, qf, acc, 16, fr, fq);
                    float mx = -INFINITY;
#pragma unroll
                    for (int kt = 0; kt < 16; ++kt) mx = fmaxf(fmaxf(mx, fmaxf(acc[kt][0], acc[kt][1])), fmaxf(acc[kt][2], acc[kt][3]));
                    mx = fmaxf(mx, shx<16>(mx)); mx = xmax32(mx);
                    float l = 0.f;
#pragma unroll
                    for (int kt = 0; kt < 16; ++kt) {
#pragma unroll
                        for (int r = 0; r < 4; ++r) { const float p = __builtin_amdgcn_exp2f(acc[kt][r] - mx); acc[kt][r] = p; l += p; } }
                    l += shx<16>(l); l = xadd32(l);
                    f32x4 O[8];
#pragma unroll
                    for (int vt = 0; vt < 8; ++vt) O[vt] = (f32x4){0.f, 0.f, 0.f, 0.f};
                    attn_pv(Vs, acc, O, 8, fr, fq);
                    if (valid) {
                        const size_t slot = ((size_t)tok * NH + h) * 3 + rk; bf16* op = Oslot + slot * 128 + 4 * fq;
#pragma unroll
                        for (int vt = 0; vt < 8; ++vt) { v2u w; w.x = cvt_pk_bf16(O[vt][0], O[vt][1]); w.y = cvt_pk_bf16(O[vt][2], O[vt][3]); *(v2u*)(op + 16 * vt) = w; }
                        if (fq == 0) { MLslot[slot * 2] = mx; MLslot[slot * 2 + 1] = l; }
                    }
                }
                __syncthreads();
                TACC(2, tp1);
            } else {
                const int si = item - NPI; const int b = si >> 7, kvh = (si >> 5) & 3, n = si & 31;
                unsigned any = 0u;
#pragma unroll
                for (int p = 0; p < 16; ++p) any |= Sels[(b * 4 + kvh) * 16 + p];
                if (!((any >> n) & 1u)) continue;
                const unsigned ts0 = TNOW();
                const int pg0 = ptab[b * NPAGES + 2 * n], pg1 = ptab[b * NPAGES + 2 * n + 1];
                f32x4 kst[16], vst[16];
#pragma unroll
                for (int i = 0; i < 16; ++i) { const int idx = i * 512 + tid, key = idx >> 5, c4 = idx & 31; const int page = (key < 128) ? pg0 : pg1;
                    const size_t go = (((size_t)page * PAGE + (key & 127)) * NKV + kvh) * 128 + c4 * 4;
                    kst[i] = __builtin_nontemporal_load((const f32x4*)(cache_k + go)); vst[i] = __builtin_nontemporal_load((const f32x4*)(cache_v + go)); }
#pragma unroll
                for (int i = 0; i < 16; ++i) { const int idx = i * 512 + tid, key = idx >> 5, c4 = idx & 31; const int page = (key < 128) ? pg0 : pg1; (void)page;
                    const f32x4 kk4 = kst[i], vv4 = vst[i];
                    v2u w; w.x = cvt_pk_bf16(kk4[0], kk4[1]); w.y = cvt_pk_bf16(kk4[2], kk4[3]); *(LAS v2u*)(Ks + key * KS_P + c4 * 4) = w;
                    v2u wv; wv.x = cvt_pk_bf16(vv4[0], vv4[1]); wv.y = cvt_pk_bf16(vv4[2], vv4[3]); *(LAS v2u*)(Vs + key * KS_P + c4 * 4) = wv; }
                __syncthreads();
                TACC(3, ts0); const unsigned ts1 = TNOW();
                {
                    LAS float* mxs = (LAS float*)(lds + 2 * KS_BYTES + 64); LAS float* lss = mxs + 128; LAS float* Ored = (LAS float*)(lds);
                    const int row = SEQ + 4 * b + (fr >> 2), hg = fr & 3; const int h = 4 * kvh + hg; const bf16* qp = Qb + (size_t)row * D + h * 128 + 8 * fq;
                    bf16x8 qf[4];
#pragma unroll
                    for (int ks = 0; ks < 4; ++ks) qf[ks] = *(const bf16x8*)(qp + 32 * ks);
                    f32x4 a2[2];
#pragma unroll
                    for (int t = 0; t < 2; ++t) { a2[t] = (f32x4){0.f, 0.f, 0.f, 0.f};
#pragma unroll
                        for (int ks = 0; ks < 4; ++ks) { const bf16x8 ka = *(const LAS bf16x8*)(Ks + (16 * (2 * wave + t) + fr) * KS_P + 32 * ks + 8 * fq); a2[t] = MFMA16(ka, qf[ks], a2[t]); } }
                    float mx = fmaxf(fmaxf(fmaxf(a2[0][0], a2[0][1]), fmaxf(a2[0][2], a2[0][3])), fmaxf(fmaxf(a2[1][0], a2[1][1]), fmaxf(a2[1][2], a2[1][3])));
                    mx = fmaxf(mx, shx<16>(mx)); mx = xmax32(mx);
                    if (fq == 0) mxs[wave * 16 + fr] = mx;
                    __syncthreads();
                    float M = mxs[fr];
#pragma unroll
                    for (int w8 = 1; w8 < 8; ++w8) M = fmaxf(M, mxs[w8 * 16 + fr]);
                    float l = 0.f;
#pragma unroll
                    for (int t = 0; t < 2; ++t) {
#pragma unroll
                        for (int r = 0; r < 4; ++r) { const float p = __builtin_amdgcn_exp2f(a2[t][r] - M); a2[t][r] = p; l += p; } }
                    l += shx<16>(l); l = xadd32(l);
                    if (fq == 0) lss[wave * 16 + fr] = l;
                    v4u pw; pw.x = cvt_pk_bf16(a2[0][0], a2[0][1]); pw.y = cvt_pk_bf16(a2[0][2], a2[0][3]); pw.z = cvt_pk_bf16(a2[1][0], a2[1][1]); pw.w = cvt_pk_bf16(a2[1][2], a2[1][3]);
                    const bf16x8 pf = __builtin_bit_cast(bf16x8, pw);
                    const LAS bf16* vb = Vs + (32 * wave + 4 * fq + (fr >> 2)) * KS_P + 4 * (fr & 3);
#pragma unroll
                    for (int vt = 0; vt < 8; ++vt) { const v2u lo = tr_read(vb + 16 * vt), hi = tr_read(vb + 16 * KS_P + 16 * vt); const v4u aw = {lo.x, lo.y, hi.x, hi.y};
                        const f32x4 o = MFMA16(__builtin_bit_cast(bf16x8, aw), pf, ((f32x4){0.f, 0.f, 0.f, 0.f}));
                        *(LAS f32x4*)(Ored + (wave * 16 + fr) * 132 + 16 * vt + 4 * fq) = o; }
                    __syncthreads();
                    { const int r16 = tid >> 5, c4 = tid & 31; f32x4 so = *(const LAS f32x4*)(Ored + r16 * 132 + 4 * c4);
#pragma unroll
                      for (int w8 = 1; w8 < 8; ++w8) so += *(const LAS f32x4*)(Ored + (w8 * 16 + r16) * 132 + 4 * c4);
                      float* sp = Sslot + ((size_t)((b * 4 + kvh) * 32 + n) * 16 + r16) * 132;
                      *(f32x4*)(sp + 4 * c4) = so;
                      if (c4 == 0) { float Mr = mxs[r16], lt = lss[r16];
#pragma unroll
                          for (int w8 = 1; w8 < 8; ++w8) { Mr = fmaxf(Mr, mxs[w8 * 16 + r16]); lt += lss[w8 * 16 + r16]; }
                          sp[128] = Mr; sp[129] = lt; } }
                }
                __syncthreads();
                TACC(4, ts1);
            }
        }
    }
    xcd_barrier(bar, IS_T0);
    STAMP();

    {
        TIDS;
        LAS bf16* Ks = (LAS bf16*)(lds); LAS bf16* Vs = (LAS bf16*)(lds + KS_BYTES);
        for (int item = bid; item < NBLK * NKV * 2; item += G) {
            const int b = item >> 3, kvh = (item >> 1) & 3, hp = item & 1;
#pragma unroll
            for (int i = 0; i < 8; ++i) { const int idx = i * 512 + tid, key = idx >> 4, c8 = idx & 15; *(LAS v4u*)(Ks + key * KS_P + c8 * 8) = *(const v4u*)(Kb + (size_t)(256 * b + key) * 512 + kvh * 128 + c8 * 8); }
#pragma unroll
            for (int i = 0; i < 8; ++i) { const int idx = i * 512 + tid, key = idx >> 4, c8 = idx & 15; *(LAS v4u*)(Vs + key * KS_P + c8 * 8) = *(const v4u*)(Vb + (size_t)(256 * b + key) * 512 + kvh * 128 + c8 * 8); }
            const int nsel = b < 3 ? b : 3;
            bf16x8 qn[4];
            { const bf16* qp = Qb + (size_t)(256 * b + 16 * wave + fr) * D + (4 * kvh + 2 * hp) * 128 + 8 * fq;
#pragma unroll
              for (int ks = 0; ks < 4; ++ks) qn[ks] = *(const bf16x8*)(qp + 32 * ks); }
            __syncthreads();
#pragma unroll 1
            for (int u = 0; u < 4; ++u) {
                const int g = (u & 1) ? 15 - wave : wave, h = 4 * kvh + 2 * hp + (u >> 1); const int tl = 16 * g + fr; const int tok = 256 * b + tl;
                bf16x8 qf[4];
#pragma unroll
                for (int ks = 0; ks < 4; ++ks) qf[ks] = qn[ks];
                if (u < 3) { const int gn = ((u + 1) & 1) ? 15 - wave : wave, hn = 4 * kvh + 2 * hp + ((u + 1) >> 1); const bf16* qp = Qb + (size_t)(256 * b + 16 * gn + fr) * D + hn * 128 + 8 * fq;
#pragma unroll
                    for (int ks = 0; ks < 4; ++ks) qn[ks] = *(const bf16x8*)(qp + 32 * ks); }
                float msa[3], lsa[3];
#pragma unroll
                for (int r = 0; r < 3; ++r) { msa[r] = -INFINITY; lsa[r] = 0.f; if (r < nsel) { const size_t slot = ((size_t)tok * NH + h) * 3 + r; msa[r] = MLslot[slot * 2]; lsa[r] = MLslot[slot * 2 + 1]; } }
                const int nkt = g + 1;
                f32x4 acc[16]; attn_scores<16>(Ks, qf, acc, nkt, fr, fq);
                float mx = -INFINITY;
#pragma unroll
                for (int kt = 0; kt < 16; ++kt) {
#pragma unroll
                    for (int r = 0; r < 4; ++r) { const bool ok = (kt < nkt) && (16 * kt + 4 * fq + r <= tl); const float sv = ok ? acc[kt][r] : -INFINITY; acc[kt][r] = sv; mx = fmaxf(mx, sv); } }
                mx = fmaxf(mx, shx<16>(mx)); mx = xmax32(mx);
                float M = mx;
#pragma unroll
                for (int r = 0; r < 3; ++r) M = fmaxf(M, msa[r]);
                float l = 0.f;
#pragma unroll
                for (int kt = 0; kt < 16; ++kt) {
#pragma unroll
                    for (int r = 0; r < 4; ++r) { const float p = __builtin_amdgcn_exp2f(acc[kt][r] - M); acc[kt][r] = p; l += p; } }
                l += shx<16>(l); l = xadd32(l);
                f32x4 O[8];
#pragma unroll
                for (int vt = 0; vt < 8; ++vt) O[vt] = (f32x4){0.f, 0.f, 0.f, 0.f};
                attn_pv(Vs, acc, O, (nkt + 1) >> 1, fr, fq);
#pragma unroll
                for (int r = 0; r < 3; ++r) { if (r < nsel) { const float sc = __builtin_amdgcn_exp2f(msa[r] - M); l += lsa[r] * sc; const size_t slot = ((size_t)tok * NH + h) * 3 + r; const bf16* op = Oslot + slot * 128 + 4 * fq;
#pragma unroll
                    for (int vt = 0; vt < 8; ++vt) { const v2u w = *(const v2u*)(op + 16 * vt); O[vt][0] += bf2f(w.x & 0xffffu) * sc; O[vt][1] += bf2f(w.x >> 16) * sc; O[vt][2] += bf2f(w.y & 0xffffu) * sc; O[vt][3] += bf2f(w.y >> 16) * sc; } } }
                const float il = 1.0f / l; bf16* ap = At + (size_t)tok * D + h * 128 + 4 * fq;
#pragma unroll
                for (int vt = 0; vt < 8; ++vt) { v2u w; w.x = cvt_pk_bf16(O[vt][0] * il, O[vt][1] * il); w.y = cvt_pk_bf16(O[vt][2] * il, O[vt][3] * il); *(v2u*)(ap + 16 * vt) = w; }
            }
            __syncthreads();
        }
        LAS float* ksn = (LAS float*)(lds);
        for (int item = bid; item < DECB * NKV; item += G) {
            const int b = item >> 2, kvh = item & 3;
            { const int key = tid >> 7, d = tid & 127; ksn[key * 128 + d] = out[OK_S + (size_t)(4 * b + key) * 512 + kvh * 128 + d]; ksn[512 + key * 128 + d] = out[OV_S + (size_t)(4 * b + key) * 512 + kvh * 128 + d]; }
            __syncthreads();
            const int pr = tid >> 5, l32 = tid & 31; const int t = pr >> 2, hg = pr & 3; const int row = SEQ + 4 * b + t, h = 4 * kvh + hg;
            const v2u qw = *(const v2u*)(Qb + (size_t)row * D + h * 128 + 4 * l32);
            const float q0 = bf2f(qw.x & 0xffffu), q1 = bf2f(qw.x >> 16), q2 = bf2f(qw.y & 0xffffu), q3 = bf2f(qw.y >> 16);
            float sk[4]; float M = -INFINITY;
#pragma unroll
            for (int key = 0; key < 4; ++key) { const f32x4 k4 = *(const LAS f32x4*)(ksn + key * 128 + 4 * l32); float s = (q0 * k4[0] + q1 * k4[1]) + (q2 * k4[2] + q3 * k4[3]);
                s += shx<1>(s); s += shx<2>(s); s += shx<4>(s); s += shx<8>(s); s += shx<16>(s);
                sk[key] = (key <= t) ? s : -INFINITY; M = fmaxf(M, sk[key]); }
            const unsigned mask = Sels[item * 16 + pr];
#pragma unroll 1
            for (int n = 0; n < 32; ++n) if ((mask >> n) & 1u) M = fmaxf(M, Sslot[((size_t)(item * 32 + n) * 16 + pr) * 132 + 128]);
            float l = 0.f; f32x4 O = {0.f, 0.f, 0.f, 0.f};
#pragma unroll
            for (int key = 0; key < 4; ++key) { const float p = __builtin_amdgcn_exp2f(sk[key] - M); l += p; O += *(const LAS f32x4*)(ksn + 512 + key * 128 + 4 * l32) * p; }
#pragma unroll 1
            for (int n = 0; n < 32; ++n) if ((mask >> n) & 1u) { const float* sp = Sslot + ((size_t)(item * 32 + n) * 16 + pr) * 132; const float sc = __builtin_amdgcn_exp2f(sp[128] - M); l += sp[129] * sc; O += *(const f32x4*)(sp + 4 * l32) * sc; }
            const float il = 1.0f / l; v2u w; w.x = cvt_pk_bf16(O[0] * il, O[1] * il); w.y = cvt_pk_bf16(O[2] * il, O[3] * il);
            *(v2u*)(At + (size_t)row * D + h * 128 + 4 * l32) = w;
            __syncthreads();
        }
    }
    xcd_barrier(bar, IS_T0);
    STAMP();

    {
        TIDS;
        pg8::Gemm g{At, Wo_t, SEQ, D, D}; pg8::StaticOrder S; S.init(SEQ, D, G, bid);
        EpiRes<1> E{Hb2, nullptr, nullptr, Hb3, ss3};
        pg8::gemm_phase<EpiRes<1>, pg8::StaticOrder, true, true, false>(lds, g, S, E, TIDX);
        { const int t2 = bid & 127, rh = (bid >> 7) & 1; TIDS; f32x4 ta[1]; tail_gemm<1>(lds, At + (size_t)SEQ * D, Wo_t, D, 16 * t2, rh, ta, TIDX); if (wave < 4) E.tail(SEQ + 64 * rh + 16 * wave + fr, 16 * t2 + 4 * fq, ta[0], fq); }
    }
    xcd_barrier(bar, IS_T0);
    STAMP();
    {
        TIDS;
        pg8::Gemm g{Hb3, Wgu1_t, MP, NGU, D}; pg8::StaticOrder S; S.init(MP, NGU, G, bid);
        EpiGU E{ss3, Hm};
        pg8::gemm_phase<EpiGU, pg8::StaticOrder, true, true>(lds, g, S, E, TIDX);
    }
    xcd_barrier(bar, IS_T0);
    STAMP();
    {
        TIDS;
        pg8::Gemm g{Hm, Wdn1_t, SEQ, D, DFF}; pg8::StaticOrder S; S.init(SEQ, D, G, bid);
        EpiRes<2> E{Hb3, out + OY_P, out + OY_S, nullptr, nullptr};
        pg8::gemm_phase<EpiRes<2>, pg8::StaticOrder, true, true, false>(lds, g, S, E, TIDX);
        { const int t2 = bid & 127, rh = (bid >> 7) & 1; TIDS; f32x4 ta[1]; tail_gemm<1>(lds, Hm + (size_t)SEQ * DFF, Wdn1_t, DFF, 16 * t2, rh, ta, TIDX); if (wave < 4) E.tail(SEQ + 64 * rh + 16 * wave + fr, 16 * t2 + 4 * fq, ta[0], fq); }
    }
#ifdef PROF_A
    STAMP();
    if (blockIdx.x == 0 && IS_T0) {
        const unsigned ta = PVAL(PROF_A0, PROF_A1), tb = PVAL(PROF_B0, PROF_B1);
        unsigned qa = (ta + PROF_UA / 2) / PROF_UA, qb = (tb + PROF_UB / 2) / PROF_UB; if (qa > 99u) qa = 99u; if (qb > 99u) qb = 99u;
#ifdef PROF_MUL
        const unsigned long long extra = (unsigned long long)ta * PROF_MUL;
#else
        const unsigned long long extra = (unsigned long long)(qa + 100u * qb) * 5000ull;
#endif
        const unsigned long long t0 = __builtin_amdgcn_s_memrealtime();
        while (__builtin_amdgcn_s_memrealtime() - t0 < extra) __builtin_amdgcn_s_sleep(32);
    }
#endif
}
#undef x_p
#undef x_s
#undef st_in
#undef cache_k
#undef cache_v
#undef ptab
#undef norm_mix_a
#undef w_in
#undef lbl
#undef onorm
#undef w_out
#undef norm_kv
#undef w_kv
#undef k_norm
#undef norm_mix_b
#undef w_q
#undef q_norm
#undef w_o
#undef norm_ffn
#undef w_gu
#undef w_dn
#undef Win_t
#undef Wout_t
#undef Wgu0_t
#undef Wdn0_t
#undef Wkvq_t
#undef Wo_t
#undef Wgu1_t
#undef Wdn1_t
#undef Hb0
#undef Hb1
#undef Hb2
#undef Hb3
#undef Hf1
#undef Hf2
#undef Hf3
#undef Qg
#undef Vg
#undef Gg
#undef Ff
#undef Ob
#undef At
#undef Hm
#undef Ub
#undef Sst
#undef Dec
#undef Kraw
#undef Vraw
#undef Qraw
#undef Kb
#undef Vb
#undef Qb
#undef Kpart
#undef Kms
#undef Subl
#undef Scnt
#undef Sels
#undef Oslot
#undef MLslot
#undef Sslot
#undef ss0
#undef ss1
#undef ss2
#undef ss3
#undef out
#undef TIDS
#undef TIDX
#undef IS_T0

extern "C" void kernel_launch(void* const* d_in, const int* in_sizes, int n_in, void* d_out, int out_size, void* d_ws, size_t ws_size, hipStream_t stream) {
    static int grid = 0;
    if (grid == 0) {
        if (n_in != 21 || ws_size < WS_END) { fprintf(stderr, "kernel_launch: unexpected n_in %d / ws %zu\n", n_in, ws_size); grid = -1; return; }
        int dev = 0, cus = 0, per_cu = 0;
        if (hipGetDevice(&dev) != hipSuccess || hipDeviceGetAttribute(&cus, hipDeviceAttributeMultiprocessorCount, dev) != hipSuccess) { grid = -1; return; }
        if (hipFuncSetAttribute((const void*)yoco_fwd, hipFuncAttributeMaxDynamicSharedMemorySize, LDS_BYTES) != hipSuccess) { fprintf(stderr, "kernel_launch: hipFuncSetAttribute failed\n"); grid = -1; return; }
        if (hipOccupancyMaxActiveBlocksPerMultiprocessor(&per_cu, (const void*)yoco_fwd, NTHR, LDS_BYTES) != hipSuccess || per_cu < 1) fprintf(stderr, "kernel_launch: occupancy query says %d\n", per_cu);
        (void)hipGetLastError();
        grid = cus;
        if (grid < 256) { fprintf(stderr, "kernel_launch: built for 256 CUs (got %d)\n", grid); grid = -1; return; }
        grid = 256;
    }
    if (grid < 0) return;
    (void)hipMemsetAsync((char*)d_ws + WS_CTL, 0, CTL_ZERO_BYTES, stream);
    Args a{};
    for (int i = 0; i < 21; ++i) a.in[i] = d_in[i];
    a.out = (float*)d_out; a.ws = (unsigned char*)d_ws;
    hipLaunchKernelGGL(yoco_fwd, dim3(grid), dim3(NTHR), LDS_BYTES, stream, a);
}
```

```cpp
#include <hip/hip_runtime.h>
#include <cstdio>
#include <cstdint>
__device__ __forceinline__ int lane_id() { int l = (int)__builtin_amdgcn_mbcnt_hi(~0u, __builtin_amdgcn_mbcnt_lo(~0u, 0u)); asm volatile("" : "+v"(l)); return l; }

namespace pg8 {
#define PG8_LAS __attribute__((address_space(3)))
typedef unsigned short bf16_t;
typedef short bf16x8 __attribute__((ext_vector_type(8)));
typedef float f32x4 __attribute__((ext_vector_type(4)));
typedef unsigned u32x4 __attribute__((ext_vector_type(4)));
typedef unsigned u32x2 __attribute__((ext_vector_type(2)));
constexpr int BM = 256, BK = 64, HALF = 128, HTB = HALF * BK * 2, STAGE_BYTES = 8 * HTB, NXCD = 8, WGM = 8;

__host__ __device__ __forceinline__ int lds_byte(int r, int c) { const int st = (r >> 4) * 2 + (c >> 5), rr = r & 15, cc = c & 31, ob = rr * 64 + cc * 2; return st * 1024 + (ob ^ (((ob >> 9) & 1) << 5)); }
__host__ __device__ __forceinline__ void stage_rc(int b, int& R, int& C) { const int st = b / 1024, sb = b % 1024, swz = sb ^ (((sb >> 9) & 1) << 5); R = (st >> 1) * 16 + swz / 64; C = (st & 1) * 32 + (swz % 64) / 2; }
__host__ __device__ __forceinline__ int perm32(int rho) { const int n = rho >> 4, i = rho & 15; return 8 * (i >> 2) + 4 * n + (i & 3); }

struct Unit { int pm, pn; };
struct Gemm { const bf16_t* A; const bf16_t* Bt; int M, N, K; };

struct StaticOrder {
    int nM, nN, nwg, G, c;
    __host__ __device__ void init(int M, int N, int G_, int c_) { nM = M / BM; nN = N / BM; nwg = nM * nN; G = G_; c = c_; }
    __host__ __device__ bool next(int i, Unit& u) const {
        const long L = (long)i * G + c; if (L >= nwg) return false;
        int wgid = (int)L; { const int q = nwg / NXCD, r = nwg % NXCD, xcd = wgid % NXCD, off = wgid / NXCD; wgid = (xcd < r ? xcd * (q + 1) : r * (q + 1) + (xcd - r) * q) + off; }
        const int nig = WGM * nN, gid = wgid / nig, fm = gid * WGM, gsz = (nM - fm) < WGM ? (nM - fm) : WGM;
        u.pm = fm + ((wgid % nig) % gsz); u.pn = (wgid % nig) / gsz; return true;
    }
    __device__ __forceinline__ void a_ready(const Unit&) const {}
    __device__ __forceinline__ void done(const Unit&) const {}
};

__device__ __forceinline__ unsigned cvt_pk_bf16(float lo, float hi) { unsigned r; asm volatile("v_cvt_pk_bf16_f32 %0, %1, %2" : "=v"(r) : "v"(lo), "v"(hi)); return r; }

template <class Epi, class Sched, bool ALIGN_EPI = false, bool SP2 = false, bool HALF_LAST = true>
__device__ __forceinline__ void gemm_phase(PG8_LAS unsigned char* lds, const Gemm g, const Sched& S, const Epi& E, int tidx) {
    int tid_ = tidx; asm volatile("" : "+v"(tid_));
    const int tid = tid_, wid = __builtin_amdgcn_readfirstlane(tid >> 6), lane = tid & 63, wr = wid >> 2, wc = wid & 3, fr = lane & 15, fq = lane >> 4;
    const int K = g.K, nt = K / BK;
    unsigned voffA[2], voffB[2];
#pragma unroll
    for (int i = 0; i < 2; ++i) { int R, C; stage_rc(tid * 16 + i * 8192, R, C); const int Rb = Epi::PERM ? ((R & ~31) + perm32(R & 31)) : R;
        voffA[i] = (unsigned)(R * K + C) * 2u; voffB[i] = (unsigned)(Rb * K + C) * 2u; }
    const size_t kstep = (size_t)(BK * 2);
    const size_t hstep = (size_t)HALF * K * 2;
    const size_t tstep = 2 * hstep;
    const unsigned ldsw = (unsigned)wid * 1024u;
    const int aoff = lds_byte(wr * 64 + fr, fq * 8), boff = lds_byte(wc * 32 + fr, fq * 8);
#define PG8_SA(b, h) (((b) * 2 + (h)) * HTB)
#define PG8_SB(b, h) ((4 + (b) * 2 + (h)) * HTB)
#define PG8_STAGE(bufoff, gbase, voff) do { _Pragma("unroll") for (int _i = 0; _i < 2; ++_i) \
        __builtin_amdgcn_global_load_lds((const unsigned*)((const char*)(gbase) + (voff)[_i]), (PG8_LAS unsigned*)(lds + (bufoff) + ldsw + _i * 8192), 16, 0, 0); } while (0)
#define PG8_LDA(dst, b, h) do { _Pragma("unroll") for (int m = 0; m < 4; ++m) _Pragma("unroll") for (int k = 0; k < 2; ++k) dst[m][k] = *(const PG8_LAS bf16x8*)(lds + PG8_SA(b, h) + aoff + m * 2048 + k * 1024); } while (0)
#define PG8_LDB(dst, b, h) do { _Pragma("unroll") for (int n = 0; n < 2; ++n) _Pragma("unroll") for (int k = 0; k < 2; ++k) dst[n][k] = *(const PG8_LAS bf16x8*)(lds + PG8_SB(b, h) + boff + n * 2048 + k * 1024); } while (0)
#define PG8_MMA(ai, bj, At, Bt) do { __builtin_amdgcn_s_setprio(1); _Pragma("unroll") for (int m = 0; m < 4; ++m) _Pragma("unroll") for (int n = 0; n < 2; ++n) _Pragma("unroll") for (int k = 0; k < 2; ++k) \
        acc[ai][bj][m][n] = __builtin_amdgcn_mfma_f32_16x16x32_bf16(Bt[n][k], At[m][k], acc[ai][bj][m][n], 0, 0, 0); __builtin_amdgcn_s_setprio(0); } while (0)
#define PG8_WAIT_V(n) asm volatile("s_waitcnt vmcnt(" #n ")" ::: "memory")
#define PG8_WAIT_L(n) asm volatile("s_waitcnt lgkmcnt(" #n ")" ::: "memory")
#define PG8_BAR __builtin_amdgcn_s_barrier()
#define PG8_SCHED __builtin_amdgcn_sched_barrier(0)
    Unit cur, nxt; int ui = 0;
    if (!S.next(0, cur)) return;
    f32x4 acc[2][2][4][2];
#pragma unroll
    for (int a = 0; a < 2; ++a)
#pragma unroll
        for (int b = 0; b < 2; ++b)
#pragma unroll
            for (int m = 0; m < 4; ++m)
#pragma unroll
                for (int n = 0; n < 2; ++n) acc[a][b][m][n] = (f32x4){0.f, 0.f, 0.f, 0.f};
    bf16x8 At[4][2], B0[2][2], B1[2][2];
    const char* cA = (const char*)g.A + (size_t)cur.pm * tstep; const char* cB = (const char*)g.Bt + (size_t)cur.pn * tstep;
    S.a_ready(cur);
    if constexpr (SP2) {
        PG8_STAGE(PG8_SB(0, 0), cB, voffB); PG8_STAGE(PG8_SB(0, 1), cB + hstep, voffB); PG8_STAGE(PG8_SA(0, 0), cA, voffA); PG8_STAGE(PG8_SA(0, 1), cA + hstep, voffA);
        if (wr == 1) PG8_BAR;
        PG8_WAIT_V(2); PG8_BAR;
        PG8_STAGE(PG8_SB(1, 0), cB + kstep, voffB); PG8_STAGE(PG8_SA(1, 0), cA + kstep, voffA); PG8_STAGE(PG8_SB(1, 1), cB + hstep + kstep, voffB);
        PG8_WAIT_V(6); PG8_BAR;
    } else {
        PG8_STAGE(PG8_SB(0, 0), cB, voffB); PG8_STAGE(PG8_SA(0, 0), cA, voffA); PG8_STAGE(PG8_SB(0, 1), cB + hstep, voffB); PG8_STAGE(PG8_SA(0, 1), cA + hstep, voffA);
        if (wr == 1) PG8_BAR;
        PG8_WAIT_V(4); PG8_BAR;
        PG8_STAGE(PG8_SB(1, 0), cB + kstep, voffB); PG8_STAGE(PG8_SA(1, 0), cA + kstep, voffA); PG8_STAGE(PG8_SB(1, 1), cB + hstep + kstep, voffB);
        PG8_WAIT_V(6); PG8_BAR;
    }
    for (;;) {
        const bool has_next = S.next(ui + 1, nxt);
        const bool half1 = HALF_LAST && (cur.pm == g.M / BM - 1);
        const char* nA = has_next ? (const char*)g.A + (size_t)nxt.pm * tstep : cA; const char* nB = has_next ? (const char*)g.Bt + (size_t)nxt.pn * tstep : cB;
        for (int t = 0; t < nt; t += 2) {
            const bool last = (t == nt - 2);
            const char* a1 = cA + (size_t)(t + 1) * kstep;
            const char* a2 = last ? nA : cA + (size_t)(t + 2) * kstep; const char* b2 = last ? nB : cB + (size_t)(t + 2) * kstep;
            const char* a3 = a2 + kstep; const char* b3 = b2 + kstep;
            if (last && has_next) S.a_ready(nxt);
            if constexpr (SP2) {
            PG8_LDB(B0, 0, 0); PG8_LDB(B1, 0, 1); PG8_SCHED; PG8_LDA(At, 0, 0); PG8_STAGE(PG8_SA(1, 1), a1 + hstep, voffA);
            PG8_WAIT_V(8); PG8_WAIT_L(0); PG8_BAR; PG8_MMA(0, 0, At, B0); PG8_MMA(0, 1, At, B1); PG8_BAR; PG8_SCHED;
            if (!half1) { PG8_LDA(At, 0, 1); } PG8_STAGE(PG8_SB(0, 0), b2, voffB); PG8_STAGE(PG8_SB(0, 1), b2 + hstep, voffB); PG8_STAGE(PG8_SA(0, 0), a2, voffA);
            PG8_WAIT_V(8); PG8_WAIT_L(0); PG8_BAR; if (!half1) { PG8_MMA(1, 0, At, B0); PG8_MMA(1, 1, At, B1); } PG8_BAR; PG8_SCHED;
            PG8_LDB(B0, 1, 0); PG8_LDB(B1, 1, 1); PG8_SCHED; PG8_LDA(At, 1, 0); PG8_STAGE(PG8_SA(0, 1), a2 + hstep, voffA);
            PG8_WAIT_V(8); PG8_WAIT_L(0); PG8_BAR; PG8_MMA(0, 0, At, B0); PG8_MMA(0, 1, At, B1); PG8_BAR; PG8_SCHED;
            if (!half1) { PG8_LDA(At, 1, 1); } PG8_STAGE(PG8_SB(1, 0), b3, voffB); PG8_STAGE(PG8_SB(1, 1), b3 + hstep, voffB); PG8_STAGE(PG8_SA(1, 0), a3, voffA);
            PG8_WAIT_V(8); PG8_WAIT_L(0); PG8_BAR; if (!half1) { PG8_MMA(1, 0, At, B0); PG8_MMA(1, 1, At, B1); } PG8_BAR; PG8_SCHED;
            } else {
            PG8_LDB(B0, 0, 0); PG8_SCHED; PG8_LDA(At, 0, 0); PG8_STAGE(PG8_SA(1, 1), a1 + hstep, voffA);
            PG8_WAIT_L(8); PG8_BAR; PG8_WAIT_L(0); PG8_MMA(0, 0, At, B0); PG8_BAR; PG8_SCHED;
            PG8_LDB(B1, 0, 1); PG8_STAGE(PG8_SB(0, 0), b2, voffB);
            PG8_BAR; PG8_WAIT_L(0); PG8_MMA(0, 1, At, B1); PG8_BAR;
            PG8_LDA(At, 0, 1); PG8_STAGE(PG8_SA(0, 0), a2, voffA);
            PG8_BAR; PG8_WAIT_L(0); PG8_MMA(1, 0, At, B0); PG8_BAR; PG8_SCHED;
            PG8_STAGE(PG8_SB(0, 1), b2 + hstep, voffB);
            PG8_WAIT_V(6); PG8_BAR; PG8_MMA(1, 1, At, B1); PG8_BAR;
            PG8_LDB(B0, 1, 0); PG8_SCHED; PG8_LDA(At, 1, 0); PG8_STAGE(PG8_SA(0, 1), a2 + hstep, voffA);
            PG8_WAIT_L(8); PG8_BAR; PG8_WAIT_L(0); PG8_MMA(0, 0, At, B0); PG8_BAR; PG8_SCHED;
            PG8_LDB(B1, 1, 1); PG8_STAGE(PG8_SB(1, 0), b3, voffB);
            PG8_BAR; PG8_WAIT_L(0); PG8_MMA(0, 1, At, B1); PG8_BAR;
            PG8_LDA(At, 1, 1); PG8_STAGE(PG8_SA(1, 0), a3, voffA);
            PG8_BAR; PG8_WAIT_L(0); PG8_MMA(1, 0, At, B0); PG8_BAR; PG8_SCHED;
            PG8_STAGE(PG8_SB(1, 1), b3 + hstep, voffB);
            PG8_WAIT_V(6); PG8_BAR; PG8_MMA(1, 1, At, B1); PG8_BAR;
            }
        }
        if constexpr (ALIGN_EPI) { if (wr == 0) PG8_BAR; }
        E(acc, cur, wr, wc, fr, fq);
        if (!has_next) break;
#pragma unroll
        for (int a = 0; a < 2; ++a)
#pragma unroll
            for (int b = 0; b < 2; ++b)
#pragma unroll
                for (int m = 0; m < 4; ++m)
#pragma unroll
                    for (int n = 0; n < 2; ++n) acc[a][b][m][n] = (f32x4){0.f, 0.f, 0.f, 0.f};
        cur = nxt; cA = nA; cB = nB; ++ui;
        if constexpr (ALIGN_EPI) { if (wr == 1) PG8_BAR; }
    }
    PG8_WAIT_V(0);
    if constexpr (!ALIGN_EPI) { if (wr == 0) PG8_BAR; }
    PG8_BAR;
#undef PG8_SA
#undef PG8_SB
#undef PG8_STAGE
#undef PG8_LDA
#undef PG8_LDB
#undef PG8_MMA
#undef PG8_WAIT_V
#undef PG8_WAIT_L
#undef PG8_BAR
#undef PG8_SCHED
}
}

constexpr int NWAVES = 8, NTHR = 512;
constexpr int D = 2048, SEQ = 8192, DECB = 32, DECS = 4, MS = DECB * DECS;
constexpr int MR = SEQ + MS;
constexpr int MP = 8448;
constexpr int NH = 16, HD = 128, NKV = 4, DFF = 5632, NGU = 2 * DFF;
constexpr int NCHUNK = SEQ / 64;
constexpr int NPAGES = 64, PAGE = 128, NBLK = 32;
constexpr float EPS = 1e-6f;
constexpr float C2 = 0.08838834764831845f * 1.4426950408889634f;

constexpr size_t OY_P = 0, OY_S = OY_P + (size_t)SEQ * D, OST_P = OY_S + (size_t)MS * D, OST_S = OST_P + (size_t)NH * 128 * 128,
                 OK_P = OST_S + (size_t)DECB * NH * 128 * 128, OV_P = OK_P + (size_t)SEQ * 512, OK_S = OV_P + (size_t)SEQ * 512, OV_S = OK_S + (size_t)MS * 512;

constexpr size_t MiB = 1u << 20;
constexpr size_t WS_CTL = 0, CTL_ZERO_BYTES = 1 * MiB;
constexpr size_t WS_WIN = 2 * MiB;
constexpr size_t WS_WOUT = WS_WIN + 32 * MiB;
constexpr size_t WS_WGU0 = WS_WOUT + 8 * MiB;
constexpr size_t WS_WDN0 = WS_WGU0 + 44 * MiB;
constexpr size_t WS_WKVQ = WS_WDN0 + 22 * MiB;
constexpr size_t WS_WO = WS_WKVQ + 12 * MiB;
constexpr size_t WS_WGU1 = WS_WO + 8 * MiB;
constexpr size_t WS_WDN1 = WS_WGU1 + 44 * MiB;
constexpr size_t WS_HB0 = WS_WDN1 + 22 * MiB;
constexpr size_t WS_HB1 = WS_HB0 + 34 * MiB, WS_HB2 = WS_HB1 + 34 * MiB, WS_HB3 = WS_HB2 + 34 * MiB;
constexpr size_t WS_HF1 = WS_HB3 + 34 * MiB;
constexpr size_t WS_HF2 = WS_HF1 + 67 * MiB, WS_HF3 = WS_HF2 + 67 * MiB;
constexpr size_t WS_QG = WS_HF3 + 67 * MiB;
constexpr size_t WS_VG = WS_QG + 34 * MiB;
constexpr size_t WS_GG = WS_VG + 34 * MiB;
constexpr size_t WS_F = WS_GG + 34 * MiB;
constexpr size_t WS_OB = WS_F + 67 * MiB;
constexpr size_t WS_AT = WS_OB + 34 * MiB;
constexpr size_t WS_HM = WS_AT + 34 * MiB;
constexpr size_t WS_U = WS_HM + 92 * MiB;
constexpr size_t WS_SST = WS_U + 64 * MiB;
constexpr size_t WS_DEC = WS_SST + 64 * MiB;
constexpr size_t WS_KRAW = WS_DEC + 2 * MiB;
constexpr size_t WS_VRAW = WS_KRAW + 17 * MiB;
constexpr size_t WS_QRAW = WS_VRAW + 17 * MiB;
constexpr size_t WS_KB = WS_QRAW + 67 * MiB;
constexpr size_t WS_VB = WS_KB + 9 * MiB;
constexpr size_t WS_QB = WS_VB + 9 * MiB;
constexpr size_t WS_KPART = WS_QB + 34 * MiB;
constexpr size_t WS_KMS = WS_KPART + 1 * MiB;
constexpr size_t WS_SUBL = WS_KMS + 2 * MiB;
constexpr size_t WS_SCNT = WS_SUBL + 16 * MiB;
constexpr size_t WS_OSLOT = WS_SCNT + 1 * MiB;
constexpr size_t WS_MLSLOT = WS_OSLOT + 192 * MiB;
constexpr size_t WS_SSLOT = WS_MLSLOT + 3 * MiB;
constexpr size_t WS_FOUT = WS_SSLOT + 34 * MiB;
constexpr size_t WS_END = WS_FOUT + 131 * MiB;
constexpr size_t WS_ORC = WS_END;
constexpr int CW_BAR = 4096;
constexpr int CW_Q0 = 8192;
constexpr int CW_SS0 = 16384, CW_SS1 = CW_SS0 + MP, CW_SS2 = CW_SS1 + MP, CW_SS3 = CW_SS2 + MP;
static_assert((CW_SS3 + MP) * 4 <= (int)CTL_ZERO_BYTES, "ctl");
static_assert(WS_VG - WS_QG == 34 * MiB && WS_GG - WS_VG == 34 * MiB, "Qg|Vg|Gg stride");

constexpr int LDS_BYTES = 160 * 1024;
constexpr int MISC_OFF = LDS_BYTES - 256;

#define GAS __attribute__((address_space(1)))
#define LAS __attribute__((address_space(3)))
typedef unsigned short bf16;
typedef unsigned v4u __attribute__((ext_vector_type(4)));
typedef unsigned v2u __attribute__((ext_vector_type(2)));
typedef float f32x4 __attribute__((ext_vector_type(4)));
typedef float f32x2 __attribute__((ext_vector_type(2)));
typedef short bf16x8 __attribute__((ext_vector_type(8)));
typedef short bf16x4 __attribute__((ext_vector_type(4)));
typedef _Float16 f16;
typedef _Float16 f16x2 __attribute__((ext_vector_type(2)));
__device__ __forceinline__ unsigned pkh2(float lo, float hi) { const f16x2 v = {(f16)lo, (f16)hi}; return __builtin_bit_cast(unsigned, v); }
#define LDS_WAIT() asm volatile("s_waitcnt lgkmcnt(0)" ::: "memory")
__device__ __forceinline__ unsigned f2bf(float f) { unsigned u = __builtin_bit_cast(unsigned, f); return (u + 0x7fffu + ((u >> 16) & 1u)) >> 16; }
__device__ __forceinline__ unsigned pk2(float lo, float hi) { return f2bf(lo) | (f2bf(hi) << 16); }
__device__ __forceinline__ float bf2f(unsigned h) { return __uint_as_float(h << 16); }
__device__ __forceinline__ float silu_f(float x) { return x * __builtin_amdgcn_rcpf(1.0f + __expf(-x)); }
__device__ __forceinline__ float sigm_f(float x) { return __builtin_amdgcn_rcpf(1.0f + __expf(-x)); }
template <int M> __device__ __forceinline__ float shx(float v) { return __uint_as_float((unsigned)__builtin_amdgcn_ds_swizzle((int)__float_as_uint(v), (M << 10) | 0x1f)); }
__device__ __forceinline__ float xadd32(float v) { auto rr = __builtin_amdgcn_permlane32_swap(__float_as_uint(v), __float_as_uint(v), false, false); return __uint_as_float(rr[0]) + __uint_as_float(rr[1]); }
__device__ __forceinline__ float xmax32(float v) { auto rr = __builtin_amdgcn_permlane32_swap(__float_as_uint(v), __float_as_uint(v), false, false); return fmaxf(__uint_as_float(rr[0]), __uint_as_float(rr[1])); }
__device__ __forceinline__ float wave_sum(float v) { v += shx<1>(v); v += shx<2>(v); v += shx<4>(v); v += shx<8>(v); v += shx<16>(v); return xadd32(v); }
#define MFMA16(a, b, c) __builtin_amdgcn_mfma_f32_16x16x32_bf16((a), (b), (c), 0, 0, 0)

#define XB_TMO      128
#define XB_XCNT(j)  (256  + 64 * (j))
#define XB_XSUB(j)  (1280 + 64 * (j))
#define XB_XGEN(j)  (2304 + 64 * (j))
#define XB_TOP      3328
#define XB_TOPGEN   3392
#define XCD_BAR_WORDS 3456
#define XB_SPIN_CAP (1u << 18)
__device__ __forceinline__ unsigned xb_ld(unsigned* p)              { return __hip_atomic_load(p, __ATOMIC_RELAXED, __HIP_MEMORY_SCOPE_AGENT); }
__device__ __forceinline__ unsigned xb_add(unsigned* p, unsigned v) { return __hip_atomic_fetch_add(p, v, __ATOMIC_RELAXED, __HIP_MEMORY_SCOPE_AGENT); }
__device__ __forceinline__ unsigned xb_xcc_id() { return (unsigned)__builtin_amdgcn_s_getreg((3 << 11) | 20) & 0xFu; }
#define XB_SPIN(cond, bar) do { unsigned _sp = 0; while (cond) { __builtin_amdgcn_s_sleep(1); \
    if ((++_sp & 255u) == 0u) { if (xb_ld(&(bar)[XB_TMO])) break; if (_sp > XB_SPIN_CAP) { atomicAdd(&(bar)[XB_TMO], 1u); break; } } } } while (0)
struct XcdBarrier { unsigned* bar; unsigned x; volatile LAS unsigned* st; };
__device__ __forceinline__ XcdBarrier xcd_barrier_post(unsigned* bar, volatile LAS unsigned* st, bool is_t0) {
    XcdBarrier b; b.bar = bar; b.x = xb_xcc_id(); b.st = st;
    if (is_t0) (void)xb_add(&bar[XB_XCNT(b.x)], 1u);
    return b;
}
__device__ __forceinline__ void xcd_barrier_complete(unsigned* bar, unsigned x, unsigned& nloc, unsigned& nx) {
    const unsigned G = gridDim.x * gridDim.y * gridDim.z;
    unsigned sum, cnt, mine, sp = 0u;
    for (;;) {
        sum = 0u; cnt = 0u; mine = 0u;
#pragma unroll
        for (unsigned j = 0; j < 16; ++j) { const unsigned c = xb_ld(&bar[XB_XCNT(j)]); sum += c; cnt += (c > 0u) ? 1u : 0u; mine = (j == x) ? c : mine; }
        if (sum == G) break;
        __builtin_amdgcn_s_sleep(1);
        if ((++sp & 255u) == 0u) { if (xb_ld(&bar[XB_TMO])) break; if (sp > XB_SPIN_CAP) { atomicAdd(&bar[XB_TMO], 1u); break; } }
    }
    nloc = mine > 0u ? mine : 1u; nx = cnt > 0u ? cnt : 1u;
}
__device__ __forceinline__ void xcd_barrier(const XcdBarrier& b, bool is_t0) {
    asm volatile("s_waitcnt vmcnt(0)" ::: "memory");
    __syncthreads();
    if (is_t0) {
        unsigned* bar = b.bar;
        __builtin_amdgcn_s_waitcnt(0);
        unsigned nloc = b.st[0], nx = b.st[1];
        if (nloc == 0u) { xcd_barrier_complete(bar, b.x, nloc, nx); b.st[0] = nloc; b.st[1] = nx; }
        const unsigned old = xb_add(&bar[XB_XSUB(b.x)], 1u);
        const unsigned gen = old / nloc;
        if (old + 1u == (gen + 1u) * nloc) {
            __builtin_amdgcn_fence(__ATOMIC_RELEASE, "agent");
            asm volatile("s_waitcnt vmcnt(0)" ::: "memory");
            const unsigned og = xb_add(&bar[XB_TOP], 1u);
            const unsigned tg = og / nx;
            if (og + 1u == (tg + 1u) * nx) xb_add(&bar[XB_TOPGEN], 1u);
            else XB_SPIN(xb_ld(&bar[XB_TOPGEN]) == tg, bar);
            __builtin_amdgcn_fence(__ATOMIC_ACQUIRE, "agent");
            xb_add(&bar[XB_XGEN(b.x)], 1u);
            asm volatile("s_waitcnt vmcnt(0)" ::: "memory");
        } else {
            XB_SPIN(xb_ld(&bar[XB_XGEN(b.x)]) == gen, bar);
            __builtin_amdgcn_fence(__ATOMIC_ACQUIRE, "agent");
            asm volatile("s_waitcnt vmcnt(0)" ::: "memory");
        }
    }
    __syncthreads();
}

using pg8::Unit; using pg8::cvt_pk_bf16;
struct EpiIn {
    static constexpr bool PERM = true;
    const float* ss; const float* lbl; bf16* Qg; f16* F;
    __device__ __forceinline__ void operator()(const f32x4 (&acc)[2][2][4][2], const Unit& u, int wr, int wc, int fr, int fq) const {
        const int seg = u.pn >> 3; const int col0 = (u.pn & 7) * 256 + wc * 32 + 8 * fq; const int rowb = u.pm * 256 + wr * 64;
        float lb[2][8];
        if (seg == 1) {
#pragma unroll
            for (int bj = 0; bj < 2; ++bj)
#pragma unroll
                for (int j = 0; j < 8; ++j) { const int c = col0 + bj * 128 + j; lb[bj][j] = __builtin_amdgcn_rcpf(1.0f + __expf(lbl[D + c] - lbl[c])); }
        }
#pragma unroll
        for (int ai = 0; ai < 2; ++ai)
#pragma unroll
            for (int m = 0; m < 4; ++m) {
                const int rb = rowb + ai * 128 + m * 16; if (rb >= MR) continue;
                const int row = rb + fr; const float r = rsqrtf(ss[row] * (1.0f / D) + EPS);
#pragma unroll
                for (int bj = 0; bj < 2; ++bj) {
                    f32x4 v0 = acc[ai][bj][m][0] * r, v1 = acc[ai][bj][m][1] * r; const size_t off = (size_t)row * D + col0 + bj * 128;
                    if (seg == 1) {
                        f32x4 o0, o1;
#pragma unroll
                        for (int j = 0; j < 4; ++j) { o0[j] = (1.0f - lb[bj][j]) * sigm_f(-v0[j]); o1[j] = (1.0f - lb[bj][4 + j]) * sigm_f(-v1[j]); }
                        { v4u w; w.x = pkh2(o0[0], o0[1]); w.y = pkh2(o0[2], o0[3]); w.z = pkh2(o1[0], o1[1]); w.w = pkh2(o1[2], o1[3]); *(v4u*)(F + off) = w; }
                    } else {
                        if (seg != 2) {
#pragma unroll
                            for (int j = 0; j < 4; ++j) { v0[j] = silu_f(v0[j]); v1[j] = silu_f(v1[j]); }
                        }
                        v4u w; w.x = cvt_pk_bf16(v0[0], v0[1]); w.y = cvt_pk_bf16(v0[2], v0[3]); w.z = cvt_pk_bf16(v1[0], v1[1]); w.w = cvt_pk_bf16(v1[2], v1[3]);
                        const size_t dsel = (seg == 0) ? 0 : ((seg == 2) ? 1 : 2);
                        *(v4u*)(Qg + dsel * (size_t)(17 * MiB) + off) = w;
                    }
                }
            }
    }
    __device__ __forceinline__ void tail(int row, int col, f32x4 v) const {
        const int seg = col >> 11, c = col & 2047; const float r = rsqrtf(ss[row] * (1.0f / D) + EPS); v = v * r; const size_t off = (size_t)row * D + c;
        if (seg == 1) { f32x4 o;
#pragma unroll
            for (int j = 0; j < 4; ++j) { const float lbv = __builtin_amdgcn_rcpf(1.0f + __expf(lbl[D + c + j] - lbl[c + j])); o[j] = (1.0f - lbv) * sigm_f(-v[j]); }
            { v2u w; w.x = pkh2(o[0], o[1]); w.y = pkh2(o[2], o[3]); *(v2u*)(F + off) = w; }
        } else {
            if (seg != 2) {
#pragma unroll
                for (int j = 0; j < 4; ++j) v[j] = silu_f(v[j]);
            }
            v2u w; w.x = cvt_pk_bf16(v[0], v[1]); w.y = cvt_pk_bf16(v[2], v[3]);
            const size_t dsel = (seg == 0) ? 0 : ((seg == 2) ? 1 : 2);
            *(v2u*)(Qg + dsel * (size_t)(17 * MiB) + off) = w;
        }
    }
};

template <int MODE> struct EpiRes {
    static constexpr bool PERM = true;
    const bf16* rb; float* o0; float* o1; bf16* hb; float* ss;
    __device__ __forceinline__ void operator()(const f32x4 (&acc)[2][2][4][2], const Unit& u, int wr, int wc, int fr, int fq) const {
        const int col0 = u.pn * 256 + wc * 32 + 8 * fq; const int rowb = u.pm * 256 + wr * 64;
#pragma unroll
        for (int ai = 0; ai < 2; ++ai)
#pragma unroll
            for (int m = 0; m < 4; ++m) {
                const int rb0 = rowb + ai * 128 + m * 16; if (rb0 >= MR) continue;
                const int row = rb0 + fr;
                const bf16* rp = rb + (size_t)row * D;
                float* op = (MODE == 2) ? ((row < SEQ) ? o0 + (size_t)row * D : o1 + (size_t)(row - SEQ) * D) : nullptr;
                float sq = 0.f;
#pragma unroll
                for (int bj = 0; bj < 2; ++bj) {
                    const int c = col0 + bj * 128;
                    const v4u rw = *(const v4u*)(rp + c);
                    f32x4 a0 = {bf2f(rw.x & 0xffffu), bf2f(rw.x >> 16), bf2f(rw.y & 0xffffu), bf2f(rw.y >> 16)}, a1 = {bf2f(rw.z & 0xffffu), bf2f(rw.z >> 16), bf2f(rw.w & 0xffffu), bf2f(rw.w >> 16)};
                    a0 += acc[ai][bj][m][0]; a1 += acc[ai][bj][m][1];
                    if (MODE == 2) { __builtin_nontemporal_store(a0, (f32x4*)(op + c)); __builtin_nontemporal_store(a1, (f32x4*)(op + c + 4)); }
                    else {
                        v4u w; w.x = cvt_pk_bf16(a0[0], a0[1]); w.y = cvt_pk_bf16(a0[2], a0[3]); w.z = cvt_pk_bf16(a1[0], a1[1]); w.w = cvt_pk_bf16(a1[2], a1[3]);
                        *(v4u*)(hb + (size_t)row * D + c) = w;
                        sq += (a0[0] * a0[0] + a0[1] * a0[1]) + (a0[2] * a0[2] + a0[3] * a0[3]) + (a1[0] * a1[0] + a1[1] * a1[1]) + (a1[2] * a1[2] + a1[3] * a1[3]);
                    }
                }
                if (MODE != 2) { sq += shx<16>(sq); sq = xadd32(sq); if (fq == 0) atomicAdd(ss + row, sq); }
            }
    }
    __device__ __forceinline__ void tail(int row, int col, f32x4 v, int fq) const {
        const v2u rw = *(const v2u*)(rb + (size_t)row * D + col);
        f32x4 a0 = {bf2f(rw.x & 0xffffu), bf2f(rw.x >> 16), bf2f(rw.y & 0xffffu), bf2f(rw.y >> 16)}; a0 += v;
        if (MODE == 2) { *(f32x4*)(o1 + (size_t)(row - SEQ) * D + col) = a0; }
        else {
            v2u w; w.x = cvt_pk_bf16(a0[0], a0[1]); w.y = cvt_pk_bf16(a0[2], a0[3]); *(v2u*)(hb + (size_t)row * D + col) = w;
            float sq = (a0[0] * a0[0] + a0[1] * a0[1]) + (a0[2] * a0[2] + a0[3] * a0[3]);
            sq += shx<16>(sq); sq = xadd32(sq); if (fq == 0) atomicAdd(ss + row, sq);
        }
    }
};
struct EpiGU {
    static constexpr bool PERM = true;
    const float* ss; bf16* hm;
    __device__ __forceinline__ void operator()(const f32x4 (&acc)[2][2][4][2], const Unit& u, int wr, int wc, int fr, int fq) const {
        const int j0 = u.pn * 128 + wc * 32 + 8 * fq; const int rowb = u.pm * 256 + wr * 64;
#pragma unroll
        for (int ai = 0; ai < 2; ++ai)
#pragma unroll
            for (int m = 0; m < 4; ++m) {
                const int rb = rowb + ai * 128 + m * 16; if (rb >= MR) continue;
                const int row = rb + fr; const float r = rsqrtf(ss[row] * (1.0f / D) + EPS);
                float o[8];
#pragma unroll
                for (int n = 0; n < 2; ++n)
#pragma unroll
                    for (int j = 0; j < 4; ++j) o[4 * n + j] = silu_f(acc[ai][0][m][n][j] * r) * (acc[ai][1][m][n][j] * r);
                v4u w; w.x = cvt_pk_bf16(o[0], o[1]); w.y = cvt_pk_bf16(o[2], o[3]); w.z = cvt_pk_bf16(o[4], o[5]); w.w = cvt_pk_bf16(o[6], o[7]);
                *(v4u*)(hm + (size_t)row * DFF + j0) = w;
            }
    }
};
struct EpiKVQ {
    static constexpr bool PERM = true;
    const float* ss; unsigned char* ws; float* outp; const float* kn; const float* qn; LAS unsigned char* xl;
    __device__ __forceinline__ void operator()(const f32x4 (&acc)[2][2][4][2], const Unit& u, int wr, int wc, int fr, int fq) const {
        const int c0 = wc * 32 + 8 * fq; const int rowb = u.pm * 256 + wr * 64;
        bf16* Kb_ = (bf16*)(ws + WS_KB); bf16* Vb_ = (bf16*)(ws + WS_VB); bf16* Qb_ = (bf16*)(ws + WS_QB); float* Kp_ = (float*)(ws + WS_KPART);
        if (u.pn == 2 || u.pn == 3) {
#pragma unroll
            for (int ai = 0; ai < 2; ++ai)
#pragma unroll
                for (int m = 0; m < 4; ++m) {
                    const int rb = rowb + ai * 128 + m * 16; if (rb >= MR) continue;
                    const int row = rb + fr; const float r = rsqrtf(ss[row] * (1.0f / D) + EPS);
                    float* vo = outp + ((row < SEQ) ? OV_P + (size_t)row * 512 : OV_S + (size_t)(row - SEQ) * 512);
#pragma unroll
                    for (int bj = 0; bj < 2; ++bj) { const int col = (u.pn - 2) * 256 + bj * 128 + c0; const f32x4 v0 = acc[ai][bj][m][0] * r, v1 = acc[ai][bj][m][1] * r;
                        __builtin_nontemporal_store(v0, (f32x4*)(vo + col)); __builtin_nontemporal_store(v1, (f32x4*)(vo + col + 4));
                        v4u w; w.x = cvt_pk_bf16(v0[0], v0[1]); w.y = cvt_pk_bf16(v0[2], v0[3]); w.z = cvt_pk_bf16(v1[0], v1[1]); w.w = cvt_pk_bf16(v1[2], v1[3]);
                        *(v4u*)(Vb_ + (size_t)row * 512 + col) = w; }
                }
            return;
        }
        const bool isk = u.pn < 2;
        LAS float* P = (LAS float*)xl;
        LAS float* CS = (LAS float*)(xl + 8192);
#pragma unroll
        for (int ai = 0; ai < 2; ++ai)
#pragma unroll
            for (int m = 0; m < 4; ++m) {
                const int rl = ai * 128 + wr * 64 + m * 16 + fr; const float r = rsqrtf(ss[u.pm * 256 + rl] * (1.0f / D) + EPS);
#pragma unroll
                for (int bj = 0; bj < 2; ++bj) { const f32x4 v0 = acc[ai][bj][m][0] * r, v1 = acc[ai][bj][m][1] * r;
                    float sq = (v0[0] * v0[0] + v0[1] * v0[1]) + (v0[2] * v0[2] + v0[3] * v0[3]) + (v1[0] * v1[0] + v1[1] * v1[1]) + (v1[2] * v1[2] + v1[3] * v1[3]);
                    sq += shx<16>(sq); sq = xadd32(sq);
                    if (fq == 0) P[(rl * 2 + bj) * 4 + wc] = sq; }
            }
        asm volatile("s_waitcnt lgkmcnt(0)" ::: "memory"); __builtin_amdgcn_s_barrier(); asm volatile("" ::: "memory");
        float cs[2][8];
#pragma unroll
        for (int bj = 0; bj < 2; ++bj)
#pragma unroll
            for (int j = 0; j < 8; ++j) cs[bj][j] = 0.f;
        const float* gp = (isk ? kn : qn) + c0; const f32x4 g0 = *(const f32x4*)gp, g1 = *(const f32x4*)(gp + 4);
#pragma unroll
        for (int ai = 0; ai < 2; ++ai)
#pragma unroll
            for (int m = 0; m < 4; ++m) {
                const int rb = rowb + ai * 128 + m * 16; if (rb >= MR) continue;
                const int rl = ai * 128 + wr * 64 + m * 16 + fr; const int row = rb + fr; const float r = rsqrtf(ss[row] * (1.0f / D) + EPS);
#pragma unroll
                for (int bj = 0; bj < 2; ++bj) {
                    const f32x4 pp = *(const LAS f32x4*)(P + (rl * 2 + bj) * 4);
                    const float rh = rsqrtf(((pp[0] + pp[1]) + (pp[2] + pp[3])) * (1.0f / 128.0f) + EPS) * (isk ? 1.0f : C2);
                    const f32x4 n0 = acc[ai][bj][m][0] * (r * rh) * g0, n1 = acc[ai][bj][m][1] * (r * rh) * g1;
                    v4u w; w.x = cvt_pk_bf16(n0[0], n0[1]); w.y = cvt_pk_bf16(n0[2], n0[3]); w.z = cvt_pk_bf16(n1[0], n1[1]); w.w = cvt_pk_bf16(n1[2], n1[3]);
                    if (isk) {
                        const int col = u.pn * 256 + bj * 128 + c0;
                        float* ko = outp + ((row < SEQ) ? OK_P + (size_t)row * 512 : OK_S + (size_t)(row - SEQ) * 512) + col;
                        __builtin_nontemporal_store(n0, (f32x4*)ko); __builtin_nontemporal_store(n1, (f32x4*)(ko + 4));
                        *(v4u*)(Kb_ + (size_t)row * 512 + col) = w;
#pragma unroll
                        for (int j = 0; j < 4; ++j) { cs[bj][j] += n0[j]; cs[bj][4 + j] += n1[j]; }
                    } else {
                        *(v4u*)(Qb_ + (size_t)row * D + (u.pn - 4) * 256 + bj * 128 + c0) = w;
                    }
                }
            }
        if (isk && u.pm < SEQ / 256) {
#pragma unroll
            for (int bj = 0; bj < 2; ++bj)
#pragma unroll
                for (int j = 0; j < 8; ++j) { float v = cs[bj][j]; v += shx<1>(v); v += shx<2>(v); v += shx<4>(v); v += shx<8>(v); if (fr == 0) CS[wr * 256 + bj * 128 + c0 + j] = v; }
            asm volatile("s_waitcnt lgkmcnt(0)" ::: "memory"); __builtin_amdgcn_s_barrier(); asm volatile("" ::: "memory");
            const int t = (wr * 4 + wc) * 64 + fq * 16 + fr;
            if (t < 256) Kp_[(size_t)u.pm * 512 + u.pn * 256 + t] = CS[t] + CS[256 + t];
        }
    }
};

struct Args { const void* in[21]; float* out; unsigned char* ws; };

__device__ __forceinline__ void p0_transpose_item(const float* W, int K, int N, bf16* WT, int row_off, int mode, const float* gain, LAS float* scr, int item, int lane) {
    const int nblk = N / 64, kb = item / nblk, nb = item % nblk, k0 = 64 * kb, n0 = 64 * nb;
    const int r = lane >> 4, c4 = lane & 15;
#pragma unroll
    for (int i = 0; i < 16; ++i) { const int kk = 4 * i + r; f32x4 w = __builtin_nontemporal_load((const f32x4*)(W + (size_t)(k0 + kk) * N + n0 + 4 * c4)); if (gain) w *= gain[k0 + kk]; *(LAS f32x4*)(scr + kk * 68 + 4 * c4) = w; }
    LDS_WAIT(); asm volatile("" ::: "memory");
    const int c = lane & 7;
    int d0;
    if (mode == 0) d0 = row_off + n0;
    else { const int j = (n0 < DFF) ? n0 : n0 - DFF; d0 = 256 * (j >> 7) + (j & 127) + ((n0 < DFF) ? 0 : 128); }
#pragma unroll
    for (int j = 0; j < 8; ++j) { const int n = (lane >> 3) + 8 * j; const LAS float* sp = scr + (8 * c) * 68 + n;
        v4u o; o.x = pk2(sp[0 * 68], sp[1 * 68]); o.y = pk2(sp[2 * 68], sp[3 * 68]); o.z = pk2(sp[4 * 68], sp[5 * 68]); o.w = pk2(sp[6 * 68], sp[7 * 68]);
        *(v4u*)(WT + (size_t)(d0 + n) * K + k0 + 8 * c) = o; }
    LDS_WAIT(); asm volatile("" ::: "memory");
}

constexpr int KS_P = 144;
constexpr int KS_BYTES = 256 * KS_P * 2;
typedef short v4i16_t __attribute__((ext_vector_type(4)));
__device__ __forceinline__ v2u tr_read(const LAS bf16* p) { return __builtin_bit_cast(v2u, __builtin_amdgcn_ds_read_tr16_b64_v4i16((LAS v4i16_t*)p)); }
template <int NKT> __device__ __forceinline__ void attn_scores(const LAS bf16* Ks, const bf16x8 (&qf)[4], f32x4 (&acc)[16], int nkt, int fr, int fq) {
#pragma unroll
    for (int kt = 0; kt < NKT; ++kt) {
        acc[kt] = (f32x4){0.f, 0.f, 0.f, 0.f};
        if (kt < nkt) {
#pragma unroll
            for (int ks = 0; ks < 4; ++ks) { const bf16x8 a = *(const LAS bf16x8*)(Ks + (16 * kt + fr) * KS_P + 32 * ks + 8 * fq); acc[kt] = MFMA16(a, qf[ks], acc[kt]); }
        }
    }
}
__device__ __forceinline__ void attn_pv(const LAS bf16* Vr, const f32x4 (&acc)[16], f32x4 (&O)[8], int nj, int fr, int fq) {
#pragma unroll
    for (int j = 0; j < 8; ++j) {
        if (j < nj) {
            v4u pw; pw.x = cvt_pk_bf16(acc[2 * j][0], acc[2 * j][1]); pw.y = cvt_pk_bf16(acc[2 * j][2], acc[2 * j][3]); pw.z = cvt_pk_bf16(acc[2 * j + 1][0], acc[2 * j + 1][1]); pw.w = cvt_pk_bf16(acc[2 * j + 1][2], acc[2 * j + 1][3]);
            const bf16x8 pf = __builtin_bit_cast(bf16x8, pw);
            const LAS bf16* vb = Vr + (32 * j + 4 * fq + (fr >> 2)) * KS_P + 4 * (fr & 3);
#pragma unroll
            for (int vt = 0; vt < 8; ++vt) {
                const v2u lo = tr_read(vb + 16 * vt), hi = tr_read(vb + 16 * KS_P + 16 * vt);
                const v4u aw = {lo.x, lo.y, hi.x, hi.y};
                O[vt] = MFMA16(__builtin_bit_cast(bf16x8, aw), pf, O[vt]);
            }
        }
    }
}

template <int NT> __device__ __forceinline__ void tail_gemm(LAS unsigned char* lds, const bf16* A, const bf16* Bt, int K, int n0, int rowhalf, f32x4 (&acc)[NT], int tidx) {
    int tid_o = tidx; asm volatile("" : "+v"(tid_o));
    const int tid = tid_o, lane = tid & 63, wave = __builtin_amdgcn_readfirstlane(tid >> 6), fr = lane & 15, fq = lane >> 4;
    const int rt = wave & 3, kh = wave >> 2; const int Kh = K >> 1;
    const int KC = (K == 2048) ? 1024 : 1408;
    const int NCH = Kh / KC, PB = KC + 8, UPR = KC >> 3, NS = KC >> 7;
    LAS bf16* Bs = (LAS bf16*)(lds + 8192);
    const bf16* ap = A + (size_t)(64 * rowhalf + 16 * rt + fr) * K + kh * Kh + 8 * fq;
    const LAS bf16* bl = Bs + (kh * 16 * NT + fr) * PB + 8 * fq;
#pragma unroll
    for (int t = 0; t < NT; ++t) acc[t] = (f32x4){0.f, 0.f, 0.f, 0.f};
#define TG_LDA(a_, k0_) do { _Pragma("unroll") for (int s_ = 0; s_ < 4; ++s_) a_[s_] = *(const bf16x8*)(ap + (k0_) + 32 * s_); } while (0)
#define TG_MMA(a_, kl_) do { _Pragma("unroll") for (int s_ = 0; s_ < 4; ++s_) { _Pragma("unroll") for (int t_ = 0; t_ < NT; ++t_) { \
        const bf16x8 b_ = *(const LAS bf16x8*)(bl + t_ * 16 * PB + (kl_) + 32 * s_); acc[t_] = MFMA16(b_, a_[s_], acc[t_]); } } } while (0)
    for (int ch = 0; ch < NCH; ++ch) {
        const int kb = ch * KC;
        bf16x8 a0[4], a1[4], a2[4], a3[4];
        TG_LDA(a0, kb); TG_LDA(a1, kb + 128); TG_LDA(a2, kb + 256); TG_LDA(a3, kb + 384);
        const int NU = 2 * 16 * NT * UPR;
        for (int u = tid; u < NU; u += NTHR) { const int r2 = u / UPR, kc = u - r2 * UPR; const int khh = (r2 >= 16 * NT) ? 1 : 0, row = r2 - khh * 16 * NT;
            const v4u w = *(const v4u*)(Bt + (size_t)(n0 + row) * K + khh * Kh + kb + 8 * kc); *(LAS v4u*)(Bs + r2 * PB + 8 * kc) = w; }
        __syncthreads();
        for (int st = 0; st < NS; st += 4) {
            TG_MMA(a0, 128 * st);           if (st + 4 < NS) TG_LDA(a0, kb + 128 * (st + 4));
            if (st + 1 < NS) { TG_MMA(a1, 128 * (st + 1)); if (st + 5 < NS) TG_LDA(a1, kb + 128 * (st + 5)); }
            if (st + 2 < NS) { TG_MMA(a2, 128 * (st + 2)); if (st + 6 < NS) TG_LDA(a2, kb + 128 * (st + 6)); }
            if (st + 3 < NS) { TG_MMA(a3, 128 * (st + 3)); if (st + 7 < NS) TG_LDA(a3, kb + 128 * (st + 7)); }
        }
        __syncthreads();
    }
#undef TG_LDA
#undef TG_MMA
    LAS f32x4* red = (LAS f32x4*)lds;
    if (kh == 1) {
#pragma unroll
        for (int t = 0; t < NT; ++t) red[(t * 4 + rt) * 64 + lane] = acc[t];
    }
    __syncthreads();
    if (kh == 0) {
#pragma unroll
        for (int t = 0; t < NT; ++t) acc[t] += red[(t * 4 + rt) * 64 + lane];
    }
    __syncthreads();
}

__device__ __forceinline__ void kmean_items(LAS unsigned char* lds, const float* cache_k_, const int* ptab_, float* Kms_, int i0, int i1, int c0, int cn, int tidx) {
    int tid_o = tidx; asm volatile("" : "+v"(tid_o)); const int tid = tid_o;
    const int me = (int)blockIdx.x - c0; if (me < 0 || me >= cn) return;
    LAS f32x4* redk = (LAS f32x4*)(lds);
    for (int item = i0 + me; item < i1; item += cn) {
        const int b = item >> 5, n = item & 31; const int c4 = tid & 127, rg = tid >> 7;
        f32x4 a = {0.f, 0.f, 0.f, 0.f};
#pragma unroll
        for (int hp = 0; hp < 2; ++hp) { const int page = ptab_[b * NPAGES + 2 * n + hp]; const f32x4* pp = (const f32x4*)(cache_k_ + (size_t)page * PAGE * 512) + c4;
#pragma unroll 16
            for (int r = rg; r < 128; r += 4) a += __builtin_nontemporal_load(pp + (size_t)r * 128); }
        redk[rg * 128 + c4] = a;
        __syncthreads();
        if (tid < 128) { const f32x4 s4 = (redk[tid] + redk[128 + tid]) + (redk[256 + tid] + redk[384 + tid]); *(f32x4*)(Kms_ + (size_t)item * 512 + 4 * tid) = s4 * (1.0f / 256.0f); }
        __syncthreads();
    }
}

__global__ void __launch_bounds__(NTHR, 2) yoco_fwd(Args args) {
    extern __shared__ __attribute__((aligned(16))) unsigned char lds_raw[];
    LAS unsigned char* lds = (LAS unsigned char*)lds_raw;
#define TIDS int tid_o = TIDX; asm volatile("" : "+v"(tid_o)); const int tid = tid_o, lane = tid & 63, wave = __builtin_amdgcn_readfirstlane(tid >> 6), fr = lane & 15, fq = lane >> 4; (void)fr; (void)fq; (void)wave; (void)lane; (void)tid
    const int G = gridDim.x, bid = blockIdx.x;
    unsigned char* ws = args.ws;
    unsigned* ctl = (unsigned*)(ws + WS_CTL);
    volatile LAS unsigned* MISC = (volatile LAS unsigned*)(lds + MISC_OFF);
    const int wave_sg = __builtin_amdgcn_readfirstlane((int)threadIdx.x & ~63);
#define TIDX (wave_sg + lane_id())
#define IS_T0 ((wave_sg == 0) && (lane_id() == 0))
    if (TIDX < 64) MISC[TIDX] = 0u;
    __syncthreads();
    XcdBarrier bar = xcd_barrier_post(ctl + CW_BAR, MISC + 8, IS_T0);
#ifdef PROF_A
    int n_stamp = 0;
#define STAMP() do { if (blockIdx.x == 0 && IS_T0) MISC[16 + n_stamp] = (unsigned)__builtin_amdgcn_s_memrealtime(); ++n_stamp; } while (0)
#define TNOW() ((unsigned)__builtin_amdgcn_s_memrealtime())
#define TACC(k, t0) do { if (blockIdx.x == 0 && IS_T0) MISC[40 + (k)] += TNOW() - (t0); } while (0)
#define PVAL(a0, a1) (((a0) >= 100) ? MISC[40 + (a0) - 100] : (MISC[16 + (a1)] - MISC[16 + (a0)]))
#else
#define STAMP() do {} while (0)
#define TNOW() 0u
#define TACC(k, t0) do { (void)(t0); } while (0)
#endif
    STAMP();

#define x_p ((const float*)args.in[0])
#define x_s ((const float*)args.in[1])
#define st_in ((const float*)args.in[2])
#define cache_k ((const float*)args.in[3])
#define cache_v ((const float*)args.in[4])
#define ptab ((const int*)args.in[5])
#define norm_mix_a ((const float*)args.in[6])
#define w_in ((const float*)args.in[7])
#define lbl ((const float*)args.in[8])
#define onorm ((const float*)args.in[9])
#define w_out ((const float*)args.in[10])
#define norm_kv ((const float*)args.in[11])
#define w_kv ((const float*)args.in[12])
#define k_norm ((const float*)args.in[13])
#define norm_mix_b ((const float*)args.in[14])
#define w_q ((const float*)args.in[15])
#define q_norm ((const float*)args.in[16])
#define w_o ((const float*)args.in[17])
#define norm_ffn ((const float*)args.in[18])
#define w_gu ((const float*)args.in[19])
#define w_dn ((const float*)args.in[20])
#define Win_t ((bf16*)(ws + WS_WIN))
#define Wout_t ((bf16*)(ws + WS_WOUT))
#define Wgu0_t ((bf16*)(ws + WS_WGU0))
#define Wdn0_t ((bf16*)(ws + WS_WDN0))
#define Wkvq_t ((bf16*)(ws + WS_WKVQ))
#define Wo_t ((bf16*)(ws + WS_WO))
#define Wgu1_t ((bf16*)(ws + WS_WGU1))
#define Wdn1_t ((bf16*)(ws + WS_WDN1))
#define Hb0 ((bf16*)(ws + WS_HB0))
#define Hb1 ((bf16*)(ws + WS_HB1))
#define Hb2 ((bf16*)(ws + WS_HB2))
#define Hb3 ((bf16*)(ws + WS_HB3))
#define Hf1 ((float*)(ws + WS_HF1))
#define Hf2 ((float*)(ws + WS_HF2))
#define Hf3 ((float*)(ws + WS_HF3))
#define Qg ((bf16*)(ws + WS_QG))
#define Vg ((bf16*)(ws + WS_VG))
#define Gg ((bf16*)(ws + WS_GG))
#define Ff ((f16*)(ws + WS_F))
#define Ob ((bf16*)(ws + WS_OB))
#define At ((bf16*)(ws + WS_AT))
#define Hm ((bf16*)(ws + WS_HM))
#define Ug ((float*)(ws + WS_U))
#define Sg0 ((float*)(ws + WS_SST))
#define Dg ((float*)(ws + WS_DEC))
#define Kraw ((float*)(ws + WS_KRAW))
#define Vraw ((float*)(ws + WS_VRAW))
#define Qraw ((bf16*)(ws + WS_QRAW))
#define Kb ((bf16*)(ws + WS_KB))
#define Vb ((bf16*)(ws + WS_VB))
#define Qb ((bf16*)(ws + WS_QB))
#define Kpart ((float*)(ws + WS_KPART))
#define Kms ((float*)(ws + WS_KMS))
#define Subl ((unsigned*)(ws + WS_SUBL))
#define Scnt ((unsigned*)(ws + WS_SCNT))
#define Sels ((unsigned*)(ws + WS_SCNT + 256 * 1024))
#define Oslot ((bf16*)(ws + WS_OSLOT))
#define MLslot ((float*)(ws + WS_MLSLOT))
#define Sslot ((float*)(ws + WS_SSLOT))
#define ss0 ((float*)(ctl + CW_SS0))
#define ss1 ((float*)(ctl + CW_SS1))
#define ss2 ((float*)(ctl + CW_SS2))
#define ss3 ((float*)(ctl + CW_SS3))
#define out (args.out)
    {
        TIDS;
        LAS float* scr = (LAS float*)(lds + wave * 17408);
        const int gw = bid * NWAVES + wave, NGW = G * NWAVES;
        constexpr int I_IN = 32 * 128, I_SQ = 32 * 32, I_GU = 32 * 176, I_DN = 88 * 32, I_KV = 32 * 16;
        constexpr int NITEMS = I_IN + I_SQ + 2 * I_GU + 2 * I_DN + I_KV + I_SQ + I_SQ;
        for (int it = gw; it < NITEMS; it += NGW) {
            int r = it;
            if (r < I_IN) { p0_transpose_item(w_in, D, 4 * D, Win_t, 0, 0, norm_mix_a, scr, r, lane); continue; } r -= I_IN;
            if (r < I_SQ) { p0_transpose_item(w_out, D, D, Wout_t, 0, 0, nullptr, scr, r, lane); continue; } r -= I_SQ;
            if (r < I_GU) { p0_transpose_item(w_gu, D, NGU, Wgu0_t, 0, 1, norm_ffn, scr, r, lane); continue; } r -= I_GU;
            if (r < I_GU) { p0_transpose_item(w_gu + (size_t)D * NGU, D, NGU, Wgu1_t, 0, 1, norm_ffn + D, scr, r, lane); continue; } r -= I_GU;
            if (r < I_DN) { p0_transpose_item(w_dn, DFF, D, Wdn0_t, 0, 0, nullptr, scr, r, lane); continue; } r -= I_DN;
            if (r < I_DN) { p0_transpose_item(w_dn + (size_t)DFF * D, DFF, D, Wdn1_t, 0, 0, nullptr, scr, r, lane); continue; } r -= I_DN;
            if (r < I_KV) { p0_transpose_item(w_kv, D, 1024, Wkvq_t, 0, 0, norm_kv, scr, r, lane); continue; } r -= I_KV;
            if (r < I_SQ) { p0_transpose_item(w_q, D, D, Wkvq_t, 1024, 0, norm_mix_b, scr, r, lane); continue; } r -= I_SQ;
            p0_transpose_item(w_o, D, D, Wo_t, 0, 0, nullptr, scr, r, lane);
        }
        for (int m = gw; m < MR; m += NGW) {
            const float* src = (m < SEQ) ? x_p + (size_t)m * D : x_s + (size_t)(m - SEQ) * D;
            const f32x4* xr = (const f32x4*)src + lane; f32x4 v[8]; float s = 0.f;
#pragma unroll
            for (int j = 0; j < 8; ++j) { v[j] = __builtin_nontemporal_load(xr + 64 * j); s += (v[j].x * v[j].x + v[j].y * v[j].y) + (v[j].z * v[j].z + v[j].w * v[j].w); }
            s = wave_sum(s);
            if (lane == 0) ss0[m] = s;
            v2u* o8 = (v2u*)(Hb0 + (size_t)m * D) + lane;
#pragma unroll
            for (int j = 0; j < 8; ++j) { v2u w; w.x = pk2(v[j].x, v[j].y); w.y = pk2(v[j].z, v[j].w); o8[64 * j] = w; }
        }
        __syncthreads();
        kmean_items(lds, cache_k, ptab, Kms, 848, DECB * NBLK, 0, G, TIDX);
    }
    xcd_barrier(bar, IS_T0);
    STAMP();

    {
        TIDS;
        pg8::Gemm g{Hb0, Win_t, SEQ, 4 * D, D}; pg8::StaticOrder S; S.init(SEQ, 4 * D, G, bid);
        EpiIn E{ss0, lbl, Qg, Ff};
        pg8::gemm_phase<EpiIn, pg8::StaticOrder, true, true, false>(lds, g, S, E, TIDX);
        for (int it2 = 0; it2 < 2; ++it2) {
            const int w2 = bid + 256 * it2, t2 = w2 & 255, rh = (w2 >> 8) & 1;
            TIDS; f32x4 ta[2]; tail_gemm<2>(lds, Hb0 + (size_t)SEQ * D, Win_t, D, 32 * t2, rh, ta, TIDX);
            if (wave < 4) { const int row = SEQ + 64 * rh + 16 * wave + fr; E.tail(row, 32 * t2 + 4 * fq, ta[0]); E.tail(row, 32 * t2 + 16 + 4 * fq, ta[1]); }
        }
    }
    xcd_barrier(bar, IS_T0);
    STAMP();

    {
        TIDS;
        LAS float* tot = (LAS float*)(lds);
        LAS float* decs = (LAS float*)(lds + 2048);
        LAS bf16* koT = (LAS bf16*)(lds + 4096);
        LAS bf16* Vr = (LAS bf16*)(lds + 4096 + 128 * 72 * 2);
        const int col = tid & 127, part = tid >> 7; const int vt_t = tid >> 3, vd0 = (tid & 7) * 16;
        f16 fN[16]; v4u vaN, vbN;
#define P2_LOADN(it_) do { const int h_ = (it_) >> 7, r0_ = ((it_) & 127) * 64; const f16* fp_ = Ff + (size_t)(r0_ + part * 16) * D + h_ * 128 + col; \
            _Pragma("unroll") for (int i = 0; i < 16; ++i) fN[i] = fp_[(size_t)i * D]; \
            const bf16* vp_ = Vg + (size_t)(r0_ + vt_t) * D + h_ * 128 + vd0; vaN = *(const v4u*)vp_; vbN = *(const v4u*)(vp_ + 8); } while (0)
        for (int it = bid; it < NH * 16; it += G) {
            const int h = it >> 4, g = it & 15;
            f32x4 S[8];
#pragma unroll
            for (int vt = 0; vt < 8; ++vt) S[vt] = (f32x4){0.f, 0.f, 0.f, 0.f};
            float dtot = 1.0f;
            P2_LOADN(h * 128 + 8 * g);
#pragma unroll 1
            for (int j = 0; j < 8; ++j) {
                const int item = h * 128 + 8 * g + j;
                float cum[16], kk[16]; float run = 0.f;
#pragma unroll
                for (int i = 0; i < 16; ++i) { kk[i] = (float)fN[i]; const float f = 1.0f - kk[i]; run += __logf(f); cum[i] = run; }
                tot[part * 128 + col] = run;
                *(LAS v4u*)(Vr + vt_t * 144 + vd0) = vaN; *(LAS v4u*)(Vr + vt_t * 144 + vd0 + 8) = vbN;
                if (j < 7) P2_LOADN(item + 1);
                __syncthreads();
                float offs = 0.f, lastv = 0.f;
#pragma unroll
                for (int p = 0; p < 4; ++p) { const float tv = tot[p * 128 + col]; lastv += tv; if (p < part) offs += tv; }
                unsigned kw[8];
#pragma unroll
                for (int i = 0; i < 8; ++i) { const float a = kk[2 * i] * __expf(lastv - (cum[2 * i] + offs)), b2 = kk[2 * i + 1] * __expf(lastv - (cum[2 * i + 1] + offs)); kw[i] = pk2(a, b2); }
                *(LAS v4u*)(koT + col * 72 + part * 16) = (v4u){kw[0], kw[1], kw[2], kw[3]};
                *(LAS v4u*)(koT + col * 72 + part * 16 + 8) = (v4u){kw[4], kw[5], kw[6], kw[7]};
                if (part == 0) { const float dc = __expf(lastv); decs[col] = dc; dtot *= dc; }
                __syncthreads();
                { bf16x8 a[2]; a[0] = *(const LAS bf16x8*)(koT + (16 * wave + fr) * 72 + 8 * fq); a[1] = *(const LAS bf16x8*)(koT + (16 * wave + fr) * 72 + 32 + 8 * fq);
                  const f32x4 dv = *(const LAS f32x4*)(decs + 16 * wave + 4 * fq);
                  const LAS bf16* vb = Vr + (8 * fq + (fr >> 2)) * 144 + 4 * (fr & 3);
#pragma unroll
                  for (int vt = 0; vt < 8; ++vt) {
                      f32x4 acc = {0.f, 0.f, 0.f, 0.f};
                      const v2u l0 = tr_read(vb + 16 * vt), h0 = tr_read(vb + 4 * 144 + 16 * vt), l1 = tr_read(vb + 32 * 144 + 16 * vt), h1 = tr_read(vb + 36 * 144 + 16 * vt);
                      const v4u b0 = {l0.x, l0.y, h0.x, h0.y}, b1 = {l1.x, l1.y, h1.x, h1.y};
                      acc = MFMA16(a[0], __builtin_bit_cast(bf16x8, b0), acc); acc = MFMA16(a[1], __builtin_bit_cast(bf16x8, b1), acc);
                      S[vt] = dv * S[vt] + acc;
                  } }
                __syncthreads();
            }
            float* ug = Ug + (size_t)it * 16384;
#pragma unroll
            for (int vt = 0; vt < 8; ++vt) *(f32x4*)(ug + (size_t)(16 * vt + fr) * 128 + 16 * wave + 4 * fq) = S[vt];
            if (part == 0) Dg[(size_t)it * 128 + col] = dtot;
        }
#undef P2_LOADN
        LAS float* red = (LAS float*)(lds);
        LAS float* red2 = (LAS float*)(lds + 8192);
        float* st_out = out + OST_S;
        for (int item = bid; item < DECB * NH; item += G) {
            const int b = item >> 4, h = item & 15; const int vd = tid & 127, kq = tid >> 7;
            const float* sp = st_in + ((size_t)(b * NH + h) * 128 + 32 * kq) * 128 + vd;
            float Sx[32];
#pragma unroll
            for (int i = 0; i < 32; ++i) Sx[i] = __builtin_nontemporal_load(sp + (size_t)i * 128);
#pragma unroll
            for (int t = 0; t < 4; ++t) {
                const int row = SEQ + 4 * b + t; const size_t ro = (size_t)row * D + h * 128;
                const float v = bf2f(Vg[ro + vd]); float op = 0.f;
#pragma unroll
                for (int i = 0; i < 32; ++i) { const float f = 1.0f - (float)Ff[ro + 32 * kq + i]; const float q = bf2f(Qg[ro + 32 * kq + i]); Sx[i] = f * Sx[i] + (1.0f - f) * v; op += Sx[i] * q; }
                red[(t * 4 + kq) * 128 + vd] = op;
            }
            float* so = st_out + ((size_t)(b * NH + h) * 128 + 32 * kq) * 128 + vd;
#pragma unroll
            for (int i = 0; i < 32; ++i) __builtin_nontemporal_store(Sx[i], so + (size_t)i * 128);
            __syncthreads();
            { const int t = tid >> 7; const float o = (red[(t * 4 + 0) * 128 + vd] + red[(t * 4 + 1) * 128 + vd]) + (red[(t * 4 + 2) * 128 + vd] + red[(t * 4 + 3) * 128 + vd]);
              const float s = wave_sum(o * o); if (lane == 0) red2[t * 2 + (wave & 1)] = s;
              __syncthreads();
              const float r = rsqrtf((red2[t * 2] + red2[t * 2 + 1]) * (1.0f / 128.0f) + EPS);
              const int row = SEQ + 4 * b + t; const size_t ro = (size_t)row * D + h * 128 + vd;
              Ob[ro] = (bf16)f2bf(o * r * onorm[vd] * bf2f(Gg[ro])); }
            __syncthreads();
        }
    }
    xcd_barrier(bar, IS_T0);
    STAMP();

    {
        TIDS;
        for (int gid = bid * NTHR + tid; gid < NH * 128 * 32; gid += G * NTHR) {
            const int h = gid >> 12, rem = gid & 4095, vd = rem >> 5, k = (rem & 31) * 4;
            f32x4 sv = {0.f, 0.f, 0.f, 0.f};
#pragma unroll
            for (int g = 0; g < 16; ++g) {
                const size_t idx = ((size_t)(h * 16 + g) * 128 + vd) * 128 + k;
                const f32x4 u = *(const f32x4*)(Ug + idx), d = *(const f32x4*)(Dg + (size_t)(h * 16 + g) * 128 + k);
                *(f32x4*)(Sg0 + idx) = sv;
                sv = d * sv + u;
            }
            float* so = out + OST_P + ((size_t)h * 128 + k) * 128 + vd;
            so[0] = sv[0]; so[128] = sv[1]; so[256] = sv[2]; so[384] = sv[3];
        }
    }
    xcd_barrier(bar, IS_T0);
    STAMP();

    {
        TIDS;
        LAS float* tot = (LAS float*)(lds);
        LAS float* refs = (LAS float*)(lds + 2048);
        LAS float* red = (LAS float*)(lds + 2560);
        LAS float* decs = (LAS float*)(lds + 3072);
        LAS bf16* QE = (LAS bf16*)(lds + 4096);
        LAS bf16* KE = QE + 64 * 136;
        LAS bf16* QI = KE + 64 * 136;
        LAS bf16* Vr = QI + 64 * 136;
        LAS bf16* STs = Vr + 64 * 144;
        LAS bf16* koT = STs + 128 * 136;
        const int col = tid & 127, part = tid >> 7; const int vt_t = tid >> 3, vd0 = (tid & 7) * 16;
        const int tt = wave & 3, vh = wave >> 2;
        f16 fN[16]; bf16 qN[16]; v4u vaN, vbN;
#define P4_LOADN(it_) do { const int h_ = (it_) >> 7, r0_ = ((it_) & 127) * 64; const f16* fp_ = Ff + (size_t)(r0_ + part * 16) * D + h_ * 128 + col; const bf16* qp_ = Qg + (size_t)(r0_ + part * 16) * D + h_ * 128 + col; \
            _Pragma("unroll") for (int i = 0; i < 16; ++i) { fN[i] = fp_[(size_t)i * D]; qN[i] = qp_[(size_t)i * D]; } \
            const bf16* vp_ = Vg + (size_t)(r0_ + vt_t) * D + h_ * 128 + vd0; vaN = *(const v4u*)vp_; vbN = *(const v4u*)(vp_ + 8); } while (0)
        for (int it = bid; it < NH * 16; it += G) {
            const int hh = it >> 4, gg = it & 15;
            f32x4 S[8];
            { const float* sg = Sg0 + (size_t)it * 16384;
#pragma unroll
              for (int vt = 0; vt < 8; ++vt) { S[vt] = *(const f32x4*)(sg + (size_t)(16 * vt + fr) * 128 + 16 * wave + 4 * fq);
                  v2u w; w.x = cvt_pk_bf16(S[vt][0], S[vt][1]); w.y = cvt_pk_bf16(S[vt][2], S[vt][3]); *(LAS v2u*)(STs + (16 * vt + fr) * 136 + 16 * wave + 4 * fq) = w; } }
            P4_LOADN(hh * 128 + 8 * gg);
#pragma unroll 1
            for (int jc = 0; jc < 8; ++jc) {
            const int item = hh * 128 + 8 * gg + jc;
            const int h = item >> 7, c = item & 127; const int row0 = c * 64;
            float cum[16], kk[16], qv[16]; float run = 0.f;
#pragma unroll
            for (int i = 0; i < 16; ++i) { kk[i] = (float)fN[i]; const float f = 1.0f - kk[i]; run += __logf(f); cum[i] = run; qv[i] = bf2f(qN[i]); }
            tot[part * 128 + col] = run;
            *(LAS v4u*)(Vr + vt_t * 144 + vd0) = vaN; *(LAS v4u*)(Vr + vt_t * 144 + vd0 + 8) = vbN;
            const size_t ro = (size_t)(row0 + 16 * tt + fr) * D + h * 128;
            v2u gw2[4]; f32x4 on[4];
#pragma unroll
            for (int vt = 0; vt < 4; ++vt) { const int vd = 16 * (4 * vh + vt) + 4 * fq; gw2[vt] = *(const v2u*)(Gg + ro + vd); on[vt] = *(const f32x4*)(onorm + vd); }
            if (jc < 7) P4_LOADN(item + 1);
            __syncthreads();
            float offs = 0.f, lastv = 0.f;
#pragma unroll
            for (int p = 0; p < 4; ++p) { const float tv = tot[p * 128 + col]; lastv += tv; if (p < part) offs += tv; }
            if (part == 1) refs[col] = cum[15] + offs;
            if (part == 0) decs[col] = __expf(lastv);
            __syncthreads();
            const float ref = refs[col];
#pragma unroll
            for (int i = 0; i < 16; ++i) { const float cm = cum[i] + offs, d1 = cm - ref; const int t = part * 16 + i;
                QE[t * 136 + col] = (bf16)f2bf(qv[i] * __expf(d1)); KE[t * 136 + col] = (bf16)f2bf(kk[i] * __expf(-d1)); QI[t * 136 + col] = (bf16)f2bf(qv[i] * __expf(cm)); }
            { unsigned kw[8];
#pragma unroll
              for (int i = 0; i < 8; ++i) { const float a = kk[2 * i] * __expf(lastv - (cum[2 * i] + offs)), b2 = kk[2 * i + 1] * __expf(lastv - (cum[2 * i + 1] + offs)); kw[i] = pk2(a, b2); }
              *(LAS v4u*)(koT + col * 72 + part * 16) = (v4u){kw[0], kw[1], kw[2], kw[3]};
              *(LAS v4u*)(koT + col * 72 + part * 16 + 8) = (v4u){kw[4], kw[5], kw[6], kw[7]}; }
            __syncthreads();
            {
                f32x4 aS[4];
#pragma unroll
                for (int st = 0; st < 4; ++st) {
                    aS[st] = (f32x4){0.f, 0.f, 0.f, 0.f};
                    if (st <= tt) {
#pragma unroll
                        for (int ks = 0; ks < 4; ++ks) { const bf16x8 a = *(const LAS bf16x8*)(KE + (16 * st + fr) * 136 + 32 * ks + 8 * fq), b = *(const LAS bf16x8*)(QE + (16 * tt + fr) * 136 + 32 * ks + 8 * fq); aS[st] = MFMA16(a, b, aS[st]); }
                        if (st == tt) {
#pragma unroll
                            for (int r = 0; r < 4; ++r) if (4 * fq + r > fr) aS[st][r] = 0.f;
                        }
                    }
                }
                f32x4 o[4];
#pragma unroll
                for (int vt = 0; vt < 4; ++vt) o[vt] = (f32x4){0.f, 0.f, 0.f, 0.f};
#pragma unroll
                for (int j = 0; j < 2; ++j) {
                    v4u pw; pw.x = cvt_pk_bf16(aS[2 * j][0], aS[2 * j][1]); pw.y = cvt_pk_bf16(aS[2 * j][2], aS[2 * j][3]); pw.z = cvt_pk_bf16(aS[2 * j + 1][0], aS[2 * j + 1][1]); pw.w = cvt_pk_bf16(aS[2 * j + 1][2], aS[2 * j + 1][3]);
                    const bf16x8 pf = __builtin_bit_cast(bf16x8, pw);
                    const LAS bf16* vb = Vr + (32 * j + 4 * fq + (fr >> 2)) * 144 + 64 * vh + 4 * (fr & 3);
#pragma unroll
                    for (int vt = 0; vt < 4; ++vt) { const v2u lo = tr_read(vb + 16 * vt), hi = tr_read(vb + 16 * 144 + 16 * vt); const v4u aw = {lo.x, lo.y, hi.x, hi.y};
                        o[vt] = MFMA16(__builtin_bit_cast(bf16x8, aw), pf, o[vt]); }
                }
#pragma unroll
                for (int ks = 0; ks < 4; ++ks) { const bf16x8 b = *(const LAS bf16x8*)(QI + (16 * tt + fr) * 136 + 32 * ks + 8 * fq);
#pragma unroll
                    for (int vt = 0; vt < 4; ++vt) { const bf16x8 a = *(const LAS bf16x8*)(STs + (16 * (4 * vh + vt) + fr) * 136 + 32 * ks + 8 * fq); o[vt] = MFMA16(a, b, o[vt]); } }
                float sq = 0.f;
#pragma unroll
                for (int vt = 0; vt < 4; ++vt) sq += (o[vt][0] * o[vt][0] + o[vt][1] * o[vt][1]) + (o[vt][2] * o[vt][2] + o[vt][3] * o[vt][3]);
                sq += shx<16>(sq); sq = xadd32(sq);
                if (fq == 0) red[(16 * tt + fr) * 2 + vh] = sq;
                __syncthreads();
                const float r = rsqrtf((red[(16 * tt + fr) * 2] + red[(16 * tt + fr) * 2 + 1]) * (1.0f / 128.0f) + EPS);
#pragma unroll
                for (int vt = 0; vt < 4; ++vt) { const int vd = 16 * (4 * vh + vt) + 4 * fq;
                    const float g0 = bf2f(gw2[vt].x & 0xffffu), g1 = bf2f(gw2[vt].x >> 16), g2 = bf2f(gw2[vt].y & 0xffffu), g3 = bf2f(gw2[vt].y >> 16);
                    v2u w; w.x = cvt_pk_bf16(o[vt][0] * r * on[vt][0] * g0, o[vt][1] * r * on[vt][1] * g1); w.y = cvt_pk_bf16(o[vt][2] * r * on[vt][2] * g2, o[vt][3] * r * on[vt][3] * g3);
                    *(v2u*)(Ob + ro + vd) = w; }
            }
            if (jc < 7) {
                bf16x8 a[2]; a[0] = *(const LAS bf16x8*)(koT + (16 * wave + fr) * 72 + 8 * fq); a[1] = *(const LAS bf16x8*)(koT + (16 * wave + fr) * 72 + 32 + 8 * fq);
                const f32x4 dv = *(const LAS f32x4*)(decs + 16 * wave + 4 * fq);
                const LAS bf16* vb = Vr + (8 * fq + (fr >> 2)) * 144 + 4 * (fr & 3);
#pragma unroll
                for (int vt = 0; vt < 8; ++vt) {
                    f32x4 acc = {0.f, 0.f, 0.f, 0.f};
                    const v2u l0 = tr_read(vb + 16 * vt), h0 = tr_read(vb + 4 * 144 + 16 * vt), l1 = tr_read(vb + 32 * 144 + 16 * vt), h1 = tr_read(vb + 36 * 144 + 16 * vt);
                    const v4u b0 = {l0.x, l0.y, h0.x, h0.y}, b1 = {l1.x, l1.y, h1.x, h1.y};
                    acc = MFMA16(a[0], __builtin_bit_cast(bf16x8, b0), acc); acc = MFMA16(a[1], __builtin_bit_cast(bf16x8, b1), acc);
                    S[vt] = dv * S[vt] + acc;
                    v2u w; w.x = cvt_pk_bf16(S[vt][0], S[vt][1]); w.y = cvt_pk_bf16(S[vt][2], S[vt][3]); *(LAS v2u*)(STs + (16 * vt + fr) * 136 + 16 * wave + 4 * fq) = w;
                }
            }
            __syncthreads();
            }
        }
#undef P4_LOADN
    }
    xcd_barrier(bar, IS_T0);
    STAMP();

    {
        TIDS;
        pg8::Gemm g{Ob, Wout_t, SEQ, D, D}; pg8::StaticOrder S; S.init(SEQ, D, G, bid);
        EpiRes<1> E{Hb0, nullptr, nullptr, Hb1, ss1};
        const unsigned tg0 = TNOW();
        pg8::gemm_phase<EpiRes<1>, pg8::StaticOrder, true, true, false>(lds, g, S, E, TIDX);
        TACC(5, tg0); const unsigned tg1 = TNOW();
        { const int t2 = bid & 127, rh = (bid >> 7) & 1; TIDS; f32x4 ta[1]; tail_gemm<1>(lds, Ob + (size_t)SEQ * D, Wout_t, D, 16 * t2, rh, ta, TIDX); if (wave < 4) E.tail(SEQ + 64 * rh + 16 * wave + fr, 16 * t2 + 4 * fq, ta[0], fq); }
        TACC(6, tg1);
    }
    xcd_barrier(bar, IS_T0);
    STAMP();
    {
        TIDS;
        pg8::Gemm g{Hb1, Wgu0_t, MP, NGU, D}; pg8::StaticOrder S; S.init(MP, NGU, G, bid);
        EpiGU E{ss1, Hm};
        pg8::gemm_phase<EpiGU, pg8::StaticOrder, true, true>(lds, g, S, E, TIDX);
        kmean_items(lds, cache_k, ptab, Kms, 0, 336, 172, G - 172, TIDX);
    }
    xcd_barrier(bar, IS_T0);
    STAMP();
    {
        TIDS;
        pg8::Gemm g{Hm, Wdn0_t, SEQ, D, DFF}; pg8::StaticOrder S; S.init(SEQ, D, G, bid);
        EpiRes<1> E{Hb1, nullptr, nullptr, Hb2, ss2};
        const unsigned tg0 = TNOW();
        pg8::gemm_phase<EpiRes<1>, pg8::StaticOrder, true, true, false>(lds, g, S, E, TIDX);
        TACC(7, tg0); const unsigned tg1 = TNOW();
        { const int t2 = bid & 127, rh = (bid >> 7) & 1; TIDS; f32x4 ta[1]; tail_gemm<1>(lds, Hm + (size_t)SEQ * DFF, Wdn0_t, DFF, 16 * t2, rh, ta, TIDX); if (wave < 4) E.tail(SEQ + 64 * rh + 16 * wave + fr, 16 * t2 + 4 * fq, ta[0], fq); }
        TACC(8, tg1);
    }
    xcd_barrier(bar, IS_T0);
    STAMP();
    {
        TIDS;
        pg8::Gemm g{Hb2, Wkvq_t, MP, 3072, D}; pg8::StaticOrder S; S.init(MP, 3072, G, bid);
        EpiKVQ E{ss2, ws, out, k_norm, q_norm, lds + 131072};
        pg8::gemm_phase<EpiKVQ, pg8::StaticOrder, true, true>(lds, g, S, E, TIDX);
        kmean_items(lds, cache_k, ptab, Kms, 336, 848, 140, G - 140, TIDX);
    }
    xcd_barrier(bar, IS_T0);
    STAMP();

    {
        TIDS;
        LAS bf16* KMb = (LAS bf16*)(lds);
        LAS unsigned* lcnt = (LAS unsigned*)(lds + 16384);
        LAS float* gs = (LAS float*)(lds + 16384 + 256);
#define G_BETTER(va, ia, vb, ib) (((va) > (vb)) || (((va) == (vb)) && ((ia) < (ib))))
#define G_INSERT(vx, ix) do { const float vx_ = (vx); const int ix_ = (ix); \
            if (G_BETTER(vx_, ix_, v0, i0)) { v2 = v1; i2 = i1; v1 = v0; i1 = i0; v0 = vx_; i0 = ix_; } \
            else if (G_BETTER(vx_, ix_, v1, i1)) { v2 = v1; i2 = i1; v1 = vx_; i1 = ix_; } \
            else if (G_BETTER(vx_, ix_, v2, i2)) { v2 = vx_; i2 = ix_; } } while (0)
        for (int item = bid; item < 256; item += G) {
            const int j = item >> 2, kvh = item & 3; const int b = j >> 1;
            { const int n = tid >> 4, d8 = (tid & 15) * 8; f32x4 s0 = {0.f, 0.f, 0.f, 0.f}, s1 = {0.f, 0.f, 0.f, 0.f};
              if (n < b) { const float* kp = Kpart + (size_t)n * 512 + kvh * 128 + d8; s0 = *(const f32x4*)kp; s1 = *(const f32x4*)(kp + 4); }
              s0 = s0 * (1.0f / 256.0f); s1 = s1 * (1.0f / 256.0f);
              v4u w; w.x = cvt_pk_bf16(s0[0], s0[1]); w.y = cvt_pk_bf16(s0[2], s0[3]); w.z = cvt_pk_bf16(s1[0], s1[1]); w.w = cvt_pk_bf16(s1[2], s1[3]);
              *(LAS v4u*)(KMb + n * 136 + d8) = w; }
            if (tid < 32) lcnt[tid] = 0u;
            __syncthreads();
            const int nsel = b < 3 ? b : 3;
#pragma unroll 1
            for (int rt = 0; rt < 4; ++rt) {
                const int r = 64 * wave + 16 * rt + fr; const int tok = j * 128 + (r >> 2), hg = r & 3; const bf16* qp = Qb + (size_t)tok * D + (4 * kvh + hg) * 128 + 8 * fq;
                bf16x8 qf[4];
#pragma unroll
                for (int ks = 0; ks < 4; ++ks) qf[ks] = *(const bf16x8*)(qp + 32 * ks);
                f32x4 ga[2];
#pragma unroll
                for (int nt = 0; nt < 2; ++nt) { ga[nt] = (f32x4){0.f, 0.f, 0.f, 0.f};
#pragma unroll
                    for (int ks = 0; ks < 4; ++ks) { const bf16x8 ka = *(const LAS bf16x8*)(KMb + (16 * nt + fr) * 136 + 32 * ks + 8 * fq); ga[nt] = MFMA16(ka, qf[ks], ga[nt]); } }
                float v0 = -INFINITY, v1 = -INFINITY, v2 = -INFINITY; int i0 = 99, i1 = 99, i2 = 99;
#pragma unroll
                for (int nt = 0; nt < 2; ++nt)
#pragma unroll
                    for (int q = 0; q < 4; ++q) { const int n = 16 * nt + 4 * fq + q; if (n < b) G_INSERT(ga[nt][q], n); }
                { const float a0 = shx<16>(v0), a1 = shx<16>(v1), a2 = shx<16>(v2);
                  const int c0 = __builtin_amdgcn_ds_swizzle(i0, (16 << 10) | 0x1f), c1 = __builtin_amdgcn_ds_swizzle(i1, (16 << 10) | 0x1f), c2 = __builtin_amdgcn_ds_swizzle(i2, (16 << 10) | 0x1f);
                  G_INSERT(a0, c0); G_INSERT(a1, c1); G_INSERT(a2, c2); }
                {
                  auto p0 = __builtin_amdgcn_permlane32_swap(__float_as_uint(v0), __float_as_uint(v0), false, false); auto p1 = __builtin_amdgcn_permlane32_swap(__float_as_uint(v1), __float_as_uint(v1), false, false);
                  auto p2 = __builtin_amdgcn_permlane32_swap(__float_as_uint(v2), __float_as_uint(v2), false, false);
                  auto q0 = __builtin_amdgcn_permlane32_swap((unsigned)i0, (unsigned)i0, false, false); auto q1 = __builtin_amdgcn_permlane32_swap((unsigned)i1, (unsigned)i1, false, false);
                  auto q2 = __builtin_amdgcn_permlane32_swap((unsigned)i2, (unsigned)i2, false, false);
                  v0 = __uint_as_float(p0[0]); v1 = __uint_as_float(p1[0]); v2 = __uint_as_float(p2[0]); i0 = (int)q0[0]; i1 = (int)q1[0]; i2 = (int)q2[0];
                  G_INSERT(__uint_as_float(p0[1]), (int)q0[1]); G_INSERT(__uint_as_float(p1[1]), (int)q1[1]); G_INSERT(__uint_as_float(p2[1]), (int)q2[1]); }
                if (fq == 0) {
#pragma unroll
                    for (int rk = 0; rk < 3; ++rk) {
                        if (rk < nsel) { const int best = (rk == 0) ? i0 : ((rk == 1) ? i1 : i2);
                            const unsigned pos = atomicAdd((unsigned*)&lcnt[best], 1u);
                            Subl[((size_t)(j * 4 + kvh) * 32 + best) * 512 + pos] = (unsigned)r | ((unsigned)rk << 9); }
                    }
                }
            }
            __syncthreads();
            if (tid < 32) Scnt[(j * 4 + kvh) * 32 + tid] = lcnt[tid];
            __syncthreads();
        }
#undef G_BETTER
#undef G_INSERT
        for (int item = bid; item < DECB * NKV; item += G) {
            const int b = item >> 2, kvh = item & 3; const int pr = tid >> 5, n = tid & 31;
            const int row = SEQ + 4 * b + (pr >> 2), hg = pr & 3; const bf16* qp = Qb + (size_t)row * D + (4 * kvh + hg) * 128; const float* kmp = Kms + ((size_t)(b * 32 + n)) * 512 + kvh * 128;
            float s = 0.f;
#pragma unroll 4
            for (int d = 0; d < 128; d += 8) { const v4u qw = *(const v4u*)(qp + d); const f32x4 k0 = *(const f32x4*)(kmp + d), k1 = *(const f32x4*)(kmp + d + 4);
                s += (bf2f(qw.x & 0xffffu) * k0[0] + bf2f(qw.x >> 16) * k0[1]) + (bf2f(qw.y & 0xffffu) * k0[2] + bf2f(qw.y >> 16) * k0[3]) + (bf2f(qw.z & 0xffffu) * k1[0] + bf2f(qw.z >> 16) * k1[1]) + (bf2f(qw.w & 0xffffu) * k1[2] + bf2f(qw.w >> 16) * k1[3]); }
            gs[pr * 32 + n] = s;
            __syncthreads();
            if (tid < 16) { unsigned m = 0u;
                for (int r = 0; r < 3; ++r) { int best = 0; float bv = -INFINITY; for (int nn = 0; nn < 32; ++nn) { const float v = gs[tid * 32 + nn]; if (v > bv) { bv = v; best = nn; } } m |= 1u << best; gs[tid * 32 + best] = -INFINITY; }
                Sels[item * 16 + tid] = m; }
            __syncthreads();
        }
    }
    xcd_barrier(bar, IS_T0);
    STAMP();

    {
        LAS bf16* Ks = (LAS bf16*)(lds); LAS bf16* Vs = (LAS bf16*)(lds + KS_BYTES);
        LAS unsigned* qsh = (LAS unsigned*)(lds + 2 * KS_BYTES);
        constexpr int NPI = 4 * 496, NSI = DECB * NKV * NBLK;
        for (;;) {
            const unsigned tq0 = TNOW();
            if (IS_T0) qsh[0] = __hip_atomic_fetch_add(ctl + CW_Q0, 1u, __ATOMIC_RELAXED, __HIP_MEMORY_SCOPE_AGENT);
            __syncthreads();
            const int tick = (int)qsh[0];
            __syncthreads();
            TACC(0, tq0);
            if (tick >= NPI + NSI) break;
            TIDS;
            int item; { const int g3 = tick / 3, r3 = tick - 3 * g3; item = (tick < 3 * NPI) ? ((r3 == 0) ? g3 : NPI + 2 * g3 + (r3 - 1)) : NPI + (tick - NPI); }
            if (item < NPI) {
                int b = (int)((1.0f + sqrtf(1.0f + 2.0f * (float)item)) * 0.5f); while (2 * b * (b - 1) > item) --b; while (2 * (b + 1) * b <= item) ++b;
                const int rem = item - 2 * b * (b - 1); const int n = rem >> 2, kvh = rem & 3;
                const int cntA = (int)Scnt[((2 * b) * 4 + kvh) * 32 + n], cntB = (int)Scnt[((2 * b + 1) * 4 + kvh) * 32 + n]; const int total = cntA + cntB;
                if (total == 0) continue;
                const unsigned tp0 = TNOW();
#pragma unroll
                for (int i = 0; i < 8; ++i) { const int idx = i * 512 + tid, key = idx >> 4, c8 = idx & 15; *(LAS v4u*)(Ks + key * KS_P + c8 * 8) = *(const v4u*)(Kb + (size_t)(256 * n + key) * 512 + kvh * 128 + c8 * 8); }
#pragma unroll
                for (int i = 0; i < 8; ++i) { const int idx = i * 512 + tid, key = idx >> 4, c8 = idx & 15; *(LAS v4u*)(Vs + key * KS_P + c8 * 8) = *(const v4u*)(Vb + (size_t)(256 * n + key) * 512 + kvh * 128 + c8 * 8); }
                __syncthreads();
                TACC(1, tp0); const unsigned tp1 = TNOW();
                const unsigned* LA = Subl + ((size_t)((2 * b) * 4 + kvh) * 32 + n) * 512; const unsigned* LB = Subl + ((size_t)((2 * b + 1) * 4 + kvh) * 32 + n) * 512;
#define LIST_ENT(i_) (((i_) < cntA) ? LA[(i_)] : LB[(i_) - cntA])
                const int iw = 16 * wave + fr;
                unsigned e1 = 0u, e2 = 0u; int ic1 = 0, ic2 = 0;
                if (16 * wave < total) { ic1 = iw < total ? iw : total - 1; e1 = LIST_ENT(ic1); }
                if (16 * wave + 128 < total) { ic2 = iw + 128 < total ? iw + 128 : total - 1; e2 = LIST_ENT(ic2); }
                bf16x8 qn[4];
                { const int tokn = ((ic1 < cntA) ? 2 * b : 2 * b + 1) * 128 + (int)((e1 >> 2) & 127u); const bf16* qp = Qb + (size_t)tokn * D + (4 * kvh + (int)(e1 & 3u)) * 128 + 8 * fq;
#pragma unroll
                  for (int ks = 0; ks < 4; ++ks) qn[ks] = *(const bf16x8*)(qp + 32 * ks); }
                for (int t0 = 0; t0 < total; t0 += 128) {
                    const int i0 = t0 + 16 * wave; if (i0 >= total) break;
                    const bool valid = (i0 + fr) < total; const int ic = ic1; const unsigned e = e1;
                    const int tok = ((ic < cntA) ? 2 * b : 2 * b + 1) * 128 + (int)((e >> 2) & 127u), hg = (int)(e & 3u), rk = (int)(e >> 9);
                    const int h = 4 * kvh + hg;
                    bf16x8 qf[4];
#pragma unroll
                    for (int ks = 0; ks < 4; ++ks) qf[ks] = qn[ks];
                    e1 = e2; ic1 = ic2;
                    if (i0 + 256 < total) { ic2 = (i0 + 256 + fr) < total ? (i0 + 256 + fr) : total - 1; e2 = LIST_ENT(ic2); }
                    if (i0 + 128 < total) { const int tokn = ((ic1 < cntA) ? 2 * b : 2 * b + 1) * 128 + (int)((e1 >> 2) & 127u); const bf16* qp = Qb + (size_t)tokn * D + (4 * kvh + (int)(e1 & 3u)) * 128 + 8 * fq;
#pragma unroll
                        for (int ks = 0; ks < 4; ++ks) qn[ks] = *(const bf16x8*)(qp + 32 * ks); }
                    f32x4 acc[16]; attn_scores<16>(Ks, qf, acc, 16, fr, fq);
                    float mx = -INFINITY;
#pragma unroll
                    for (int kt = 0; kt < 16; ++kt) mx = fmaxf(fmaxf(mx, fmaxf(acc[kt][0], acc[kt][1])), fmaxf(acc[kt][2], acc[kt][3]));
                    mx = fmaxf(mx, shx<16>(mx)); mx = xmax32(mx);
                    float l = 0.f;
#pragma unroll
                    for (int kt = 0; kt < 16; ++kt) {
#pragma unroll
                        for (int r = 0; r < 4; ++r) { const float p = __builtin_amdgcn_exp2f(acc[kt][r] - mx); acc[kt][r] = p; l += p; } }
                    l += shx<16>(l); l = xadd32(l);
                    f32x4 O[8];
#pragma unroll
                    for (int vt = 0; vt < 8; ++vt) O[vt] = (f32x4){0.f, 0.f, 0.f, 0.f};
                    attn_pv(Vs, acc, O, 8, fr, fq);
                    if (valid) {
                        const size_t slot = ((size_t)tok * NH + h) * 3 + rk; bf16* op = Oslot + slot * 128 + 4 * fq;
#pragma unroll
                        for (int vt = 0; vt < 8; ++vt) { v2u w; w.x = cvt_pk_bf16(O[vt][0], O[vt][1]); w.y = cvt_pk_bf16(O[vt][2], O[vt][3]); *(v2u*)(op + 16 * vt) = w; }
                        if (fq == 0) { MLslot[slot * 2] = mx; MLslot[slot * 2 + 1] = l; }
                    }
                }
                __syncthreads();
                TACC(2, tp1);
            } else {
                const int si = item - NPI; const int b = si >> 7, kvh = (si >> 5) & 3, n = si & 31;
                unsigned any = 0u;
#pragma unroll
                for (int p = 0; p < 16; ++p) any |= Sels[(b * 4 + kvh) * 16 + p];
                if (!((any >> n) & 1u)) continue;
                const unsigned ts0 = TNOW();
                const int pg0 = ptab[b * NPAGES + 2 * n], pg1 = ptab[b * NPAGES + 2 * n + 1];
                f32x4 kst[16], vst[16];
#pragma unroll
                for (int i = 0; i < 16; ++i) { const int idx = i * 512 + tid, key = idx >> 5, c4 = idx & 31; const int page = (key < 128) ? pg0 : pg1;
                    const size_t go = (((size_t)page * PAGE + (key & 127)) * NKV + kvh) * 128 + c4 * 4;
                    kst[i] = __builtin_nontemporal_load((const f32x4*)(cache_k + go)); vst[i] = __builtin_nontemporal_load((const f32x4*)(cache_v + go)); }
#pragma unroll
                for (int i = 0; i < 16; ++i) { const int idx = i * 512 + tid, key = idx >> 5, c4 = idx & 31; const int page = (key < 128) ? pg0 : pg1; (void)page;
                    const f32x4 kk4 = kst[i], vv4 = vst[i];
                    v2u w; w.x = cvt_pk_bf16(kk4[0], kk4[1]); w.y = cvt_pk_bf16(kk4[2], kk4[3]); *(LAS v2u*)(Ks + key * KS_P + c4 * 4) = w;
                    v2u wv; wv.x = cvt_pk_bf16(vv4[0], vv4[1]); wv.y = cvt_pk_bf16(vv4[2], vv4[3]); *(LAS v2u*)(Vs + key * KS_P + c4 * 4) = wv; }
                __syncthreads();
                TACC(3, ts0); const unsigned ts1 = TNOW();
                {
                    LAS float* mxs = (LAS float*)(lds + 2 * KS_BYTES + 64); LAS float* lss = mxs + 128; LAS float* Ored = (LAS float*)(lds);
                    const int row = SEQ + 4 * b + (fr >> 2), hg = fr & 3; const int h = 4 * kvh + hg; const bf16* qp = Qb + (size_t)row * D + h * 128 + 8 * fq;
                    bf16x8 qf[4];
#pragma unroll
                    for (int ks = 0; ks < 4; ++ks) qf[ks] = *(const bf16x8*)(qp + 32 * ks);
                    f32x4 a2[2];
#pragma unroll
                    for (int t = 0; t < 2; ++t) { a2[t] = (f32x4){0.f, 0.f, 0.f, 0.f};
#pragma unroll
                        for (int ks = 0; ks < 4; ++ks) { const bf16x8 ka = *(const LAS bf16x8*)(Ks + (16 * (2 * wave + t) + fr) * KS_P + 32 * ks + 8 * fq); a2[t] = MFMA16(ka, qf[ks], a2[t]); } }
                    float mx = fmaxf(fmaxf(fmaxf(a2[0][0], a2[0][1]), fmaxf(a2[0][2], a2[0][3])), fmaxf(fmaxf(a2[1][0], a2[1][1]), fmaxf(a2[1][2], a2[1][3])));
                    mx = fmaxf(mx, shx<16>(mx)); mx = xmax32(mx);
                    if (fq == 0) mxs[wave * 16 + fr] = mx;
                    __syncthreads();
                    float M = mxs[fr];
#pragma unroll
                    for (int w8 = 1; w8 < 8; ++w8) M = fmaxf(M, mxs[w8 * 16 + fr]);
                    float l = 0.f;
#pragma unroll
                    for (int t = 0; t < 2; ++t) {
#pragma unroll
                        for (int r = 0; r < 4; ++r) { const float p = __builtin_amdgcn_exp2f(a2[t][r] - M); a2[t][r] = p; l += p; } }
                    l += shx<16>(l); l = xadd32(l);
                    if (fq == 0) lss[wave * 16 + fr] = l;
                    v4u pw; pw.x = cvt_pk_bf16(a2[0][0], a2[0][1]); pw.y = cvt_pk_bf16(a2[0][2], a2[0][3]); pw.z = cvt_pk_bf16(a2[1][0], a2[1][1]); pw.w = cvt_pk_bf16(a2[1][2], a2[1][3]);
                    const bf16x8 pf = __builtin_bit_cast(bf16x8, pw);
                    const LAS bf16* vb = Vs + (32 * wave + 4 * fq + (fr >> 2)) * KS_P + 4 * (fr & 3);
#pragma unroll
                    for (int vt = 0; vt < 8; ++vt) { const v2u lo = tr_read(vb + 16 * vt), hi = tr_read(vb + 16 * KS_P + 16 * vt); const v4u aw = {lo.x, lo.y, hi.x, hi.y};
                        const f32x4 o = MFMA16(__builtin_bit_cast(bf16x8, aw), pf, ((f32x4){0.f, 0.f, 0.f, 0.f}));
                        *(LAS f32x4*)(Ored + (wave * 16 + fr) * 132 + 16 * vt + 4 * fq) = o; }
                    __syncthreads();
                    { const int r16 = tid >> 5, c4 = tid & 31; f32x4 so = *(const LAS f32x4*)(Ored + r16 * 132 + 4 * c4);
#pragma unroll
                      for (int w8 = 1; w8 < 8; ++w8) so += *(const LAS f32x4*)(Ored + (w8 * 16 + r16) * 132 + 4 * c4);
                      float* sp = Sslot + ((size_t)((b * 4 + kvh) * 32 + n) * 16 + r16) * 132;
                      *(f32x4*)(sp + 4 * c4) = so;
                      if (c4 == 0) { float Mr = mxs[r16], lt = lss[r16];
#pragma unroll
                          for (int w8 = 1; w8 < 8; ++w8) { Mr = fmaxf(Mr, mxs[w8 * 16 + r16]); lt += lss[w8 * 16 + r16]; }
                          sp[128] = Mr; sp[129] = lt; } }
                }
                __syncthreads();
                TACC(4, ts1);
            }
        }
    }
    xcd_barrier(bar, IS_T0);
    STAMP();

    {
        TIDS;
        LAS bf16* Ks = (LAS bf16*)(lds); LAS bf16* Vs = (LAS bf16*)(lds + KS_BYTES);
        for (int item = bid; item < NBLK * NKV * 2; item += G) {
            const int b = item >> 3, kvh = (item >> 1) & 3, hp = item & 1;
#pragma unroll
            for (int i = 0; i < 8; ++i) { const int idx = i * 512 + tid, key = idx >> 4, c8 = idx & 15; *(LAS v4u*)(Ks + key * KS_P + c8 * 8) = *(const v4u*)(Kb + (size_t)(256 * b + key) * 512 + kvh * 128 + c8 * 8); }
#pragma unroll
            for (int i = 0; i < 8; ++i) { const int idx = i * 512 + tid, key = idx >> 4, c8 = idx & 15; *(LAS v4u*)(Vs + key * KS_P + c8 * 8) = *(const v4u*)(Vb + (size_t)(256 * b + key) * 512 + kvh * 128 + c8 * 8); }
            const int nsel = b < 3 ? b : 3;
            bf16x8 qn[4];
            { const bf16* qp = Qb + (size_t)(256 * b + 16 * wave + fr) * D + (4 * kvh + 2 * hp) * 128 + 8 * fq;
#pragma unroll
              for (int ks = 0; ks < 4; ++ks) qn[ks] = *(const bf16x8*)(qp + 32 * ks); }
            __syncthreads();
#pragma unroll 1
            for (int u = 0; u < 4; ++u) {
                const int g = (u & 1) ? 15 - wave : wave, h = 4 * kvh + 2 * hp + (u >> 1); const int tl = 16 * g + fr; const int tok = 256 * b + tl;
                bf16x8 qf[4];
#pragma unroll
                for (int ks = 0; ks < 4; ++ks) qf[ks] = qn[ks];
                if (u < 3) { const int gn = ((u + 1) & 1) ? 15 - wave : wave, hn = 4 * kvh + 2 * hp + ((u + 1) >> 1); const bf16* qp = Qb + (size_t)(256 * b + 16 * gn + fr) * D + hn * 128 + 8 * fq;
#pragma unroll
                    for (int ks = 0; ks < 4; ++ks) qn[ks] = *(const bf16x8*)(qp + 32 * ks); }
                float msa[3], lsa[3];
#pragma unroll
                for (int r = 0; r < 3; ++r) { msa[r] = -INFINITY; lsa[r] = 0.f; if (r < nsel) { const size_t slot = ((size_t)tok * NH + h) * 3 + r; msa[r] = MLslot[slot * 2]; lsa[r] = MLslot[slot * 2 + 1]; } }
                const int nkt = g + 1;
                f32x4 acc[16]; attn_scores<16>(Ks, qf, acc, nkt, fr, fq);
                float mx = -INFINITY;
#pragma unroll
                for (int kt = 0; kt < 16; ++kt) {
#pragma unroll
                    for (int r = 0; r < 4; ++r) { const bool ok = (kt < nkt) && (16 * kt + 4 * fq + r <= tl); const float sv = ok ? acc[kt][r] : -INFINITY; acc[kt][r] = sv; mx = fmaxf(mx, sv); } }
                mx = fmaxf(mx, shx<16>(mx)); mx = xmax32(mx);
                float M = mx;
#pragma unroll
                for (int r = 0; r < 3; ++r) M = fmaxf(M, msa[r]);
                float l = 0.f;
#pragma unroll
                for (int kt = 0; kt < 16; ++kt) {
#pragma unroll
                    for (int r = 0; r < 4; ++r) { const float p = __builtin_amdgcn_exp2f(acc[kt][r] - M); acc[kt][r] = p; l += p; } }
                l += shx<16>(l); l = xadd32(l);
                f32x4 O[8];
#pragma unroll
                for (int vt = 0; vt < 8; ++vt) O[vt] = (f32x4){0.f, 0.f, 0.f, 0.f};
                attn_pv(Vs, acc, O, (nkt + 1) >> 1, fr, fq);
#pragma unroll
                for (int r = 0; r < 3; ++r) { if (r < nsel) { const float sc = __builtin_amdgcn_exp2f(msa[r] - M); l += lsa[r] * sc; const size_t slot = ((size_t)tok * NH + h) * 3 + r; const bf16* op = Oslot + slot * 128 + 4 * fq;
#pragma unroll
                    for (int vt = 0; vt < 8; ++vt) { const v2u w = *(const v2u*)(op + 16 * vt); O[vt][0] += bf2f(w.x & 0xffffu) * sc; O[vt][1] += bf2f(w.x >> 16) * sc; O[vt][2] += bf2f(w.y & 0xffffu) * sc; O[vt][3] += bf2f(w.y >> 16) * sc; } } }
                const float il = 1.0f / l; bf16* ap = At + (size_t)tok * D + h * 128 + 4 * fq;
#pragma unroll
                for (int vt = 0; vt < 8; ++vt) { v2u w; w.x = cvt_pk_bf16(O[vt][0] * il, O[vt][1] * il); w.y = cvt_pk_bf16(O[vt][2] * il, O[vt][3] * il); *(v2u*)(ap + 16 * vt) = w; }
            }
            __syncthreads();
        }
        LAS float* ksn = (LAS float*)(lds);
        for (int item = bid; item < DECB * NKV; item += G) {
            const int b = item >> 2, kvh = item & 3;
            { const int key = tid >> 7, d = tid & 127; ksn[key * 128 + d] = out[OK_S + (size_t)(4 * b + key) * 512 + kvh * 128 + d]; ksn[512 + key * 128 + d] = out[OV_S + (size_t)(4 * b + key) * 512 + kvh * 128 + d]; }
            __syncthreads();
            const int pr = tid >> 5, l32 = tid & 31; const int t = pr >> 2, hg = pr & 3; const int row = SEQ + 4 * b + t, h = 4 * kvh + hg;
            const v2u qw = *(const v2u*)(Qb + (size_t)row * D + h * 128 + 4 * l32);
            const float q0 = bf2f(qw.x & 0xffffu), q1 = bf2f(qw.x >> 16), q2 = bf2f(qw.y & 0xffffu), q3 = bf2f(qw.y >> 16);
            float sk[4]; float M = -INFINITY;
#pragma unroll
            for (int key = 0; key < 4; ++key) { const f32x4 k4 = *(const LAS f32x4*)(ksn + key * 128 + 4 * l32); float s = (q0 * k4[0] + q1 * k4[1]) + (q2 * k4[2] + q3 * k4[3]);
                s += shx<1>(s); s += shx<2>(s); s += shx<4>(s); s += shx<8>(s); s += shx<16>(s);
                sk[key] = (key <= t) ? s : -INFINITY; M = fmaxf(M, sk[key]); }
            const unsigned mask = Sels[item * 16 + pr];
#pragma unroll 1
            for (int n = 0; n < 32; ++n) if ((mask >> n) & 1u) M = fmaxf(M, Sslot[((size_t)(item * 32 + n) * 16 + pr) * 132 + 128]);
            float l = 0.f; f32x4 O = {0.f, 0.f, 0.f, 0.f};
#pragma unroll
            for (int key = 0; key < 4; ++key) { const float p = __builtin_amdgcn_exp2f(sk[key] - M); l += p; O += *(const LAS f32x4*)(ksn + 512 + key * 128 + 4 * l32) * p; }
#pragma unroll 1
            for (int n = 0; n < 32; ++n) if ((mask >> n) & 1u) { const float* sp = Sslot + ((size_t)(item * 32 + n) * 16 + pr) * 132; const float sc = __builtin_amdgcn_exp2f(sp[128] - M); l += sp[129] * sc; O += *(const f32x4*)(sp + 4 * l32) * sc; }
            const float il = 1.0f / l; v2u w; w.x = cvt_pk_bf16(O[0] * il, O[1] * il); w.y = cvt_pk_bf16(O[2] * il, O[3] * il);
            *(v2u*)(At + (size_t)row * D + h * 128 + 4 * l32) = w;
            __syncthreads();
        }
    }
    xcd_barrier(bar, IS_T0);
    STAMP();

    {
        TIDS;
        pg8::Gemm g{At, Wo_t, SEQ, D, D}; pg8::StaticOrder S; S.init(SEQ, D, G, bid);
        EpiRes<1> E{Hb2, nullptr, nullptr, Hb3, ss3};
        pg8::gemm_phase<EpiRes<1>, pg8::StaticOrder, true, true, false>(lds, g, S, E, TIDX);
        { const int t2 = bid & 127, rh = (bid >> 7) & 1; TIDS; f32x4 ta[1]; tail_gemm<1>(lds, At + (size_t)SEQ * D, Wo_t, D, 16 * t2, rh, ta, TIDX); if (wave < 4) E.tail(SEQ + 64 * rh + 16 * wave + fr, 16 * t2 + 4 * fq, ta[0], fq); }
    }
    xcd_barrier(bar, IS_T0);
    STAMP();
    {
        TIDS;
        pg8::Gemm g{Hb3, Wgu1_t, MP, NGU, D}; pg8::StaticOrder S; S.init(MP, NGU, G, bid);
        EpiGU E{ss3, Hm};
        pg8::gemm_phase<EpiGU, pg8::StaticOrder, true, true>(lds, g, S, E, TIDX);
    }
    xcd_barrier(bar, IS_T0);
    STAMP();
    {
        TIDS;
        pg8::Gemm g{Hm, Wdn1_t, SEQ, D, DFF}; pg8::StaticOrder S; S.init(SEQ, D, G, bid);
        EpiRes<2> E{Hb3, out + OY_P, out + OY_S, nullptr, nullptr};
        pg8::gemm_phase<EpiRes<2>, pg8::StaticOrder, true, true, false>(lds, g, S, E, TIDX);
        { const int t2 = bid & 127, rh = (bid >> 7) & 1; TIDS; f32x4 ta[1]; tail_gemm<1>(lds, Hm + (size_t)SEQ * DFF, Wdn1_t, DFF, 16 * t2, rh, ta, TIDX); if (wave < 4) E.tail(SEQ + 64 * rh + 16 * wave + fr, 16 * t2 + 4 * fq, ta[0], fq); }
    }
#ifdef PROF_A
    STAMP();
    if (blockIdx.x == 0 && IS_T0) {
        const unsigned ta = PVAL(PROF_A0, PROF_A1), tb = PVAL(PROF_B0, PROF_B1);
        unsigned qa = (ta + PROF_UA / 2) / PROF_UA, qb = (tb + PROF_UB / 2) / PROF_UB; if (qa > 99u) qa = 99u; if (qb > 99u) qb = 99u;
#ifdef PROF_MUL
        const unsigned long long extra = (unsigned long long)ta * PROF_MUL;
#else
        const unsigned long long extra = (unsigned long long)(qa + 100u * qb) * 5000ull;
#endif
        const unsigned long long t0 = __builtin_amdgcn_s_memrealtime();
        while (__builtin_amdgcn_s_memrealtime() - t0 < extra) __builtin_amdgcn_s_sleep(32);
    }
#endif
}
#undef x_p
#undef x_s
#undef st_in
#undef cache_k
#undef cache_v
#undef ptab
#undef norm_mix_a
#undef w_in
#undef lbl
#undef onorm
#undef w_out
#undef norm_kv
#undef w_kv
#undef k_norm
#undef norm_mix_b
#undef w_q
#undef q_norm
#undef w_o
#undef norm_ffn
#undef w_gu
#undef w_dn
#undef Win_t
#undef Wout_t
#undef Wgu0_t
#undef Wdn0_t
#undef Wkvq_t
#undef Wo_t
#undef Wgu1_t
#undef Wdn1_t
#undef Hb0
#undef Hb1
#undef Hb2
#undef Hb3
#undef Hf1
#undef Hf2
#undef Hf3
#undef Qg
#undef Vg
#undef Gg
#undef Ff
#undef Ob
#undef At
#undef Hm
#undef Ug
#undef Sg0
#undef Dg
#undef Kraw
#undef Vraw
#undef Qraw
#undef Kb
#undef Vb
#undef Qb
#undef Kpart
#undef Kms
#undef Subl
#undef Scnt
#undef Sels
#undef Oslot
#undef MLslot
#undef Sslot
#undef ss0
#undef ss1
#undef ss2
#undef ss3
#undef out
#undef TIDS
#undef TIDX
#undef IS_T0

extern "C" void kernel_launch(void* const* d_in, const int* in_sizes, int n_in, void* d_out, int out_size, void* d_ws, size_t ws_size, hipStream_t stream) {
    static int grid = 0;
    if (grid == 0) {
        if (n_in != 21 || ws_size < WS_END) { fprintf(stderr, "kernel_launch: unexpected n_in %d / ws %zu\n", n_in, ws_size); grid = -1; return; }
        int dev = 0, cus = 0, per_cu = 0;
        if (hipGetDevice(&dev) != hipSuccess || hipDeviceGetAttribute(&cus, hipDeviceAttributeMultiprocessorCount, dev) != hipSuccess) { grid = -1; return; }
        if (hipFuncSetAttribute((const void*)yoco_fwd, hipFuncAttributeMaxDynamicSharedMemorySize, LDS_BYTES) != hipSuccess) { fprintf(stderr, "kernel_launch: hipFuncSetAttribute failed\n"); grid = -1; return; }
        if (hipOccupancyMaxActiveBlocksPerMultiprocessor(&per_cu, (const void*)yoco_fwd, NTHR, LDS_BYTES) != hipSuccess || per_cu < 1) fprintf(stderr, "kernel_launch: occupancy query says %d\n", per_cu);
        (void)hipGetLastError();
        grid = cus;
        if (grid < 256) { fprintf(stderr, "kernel_launch: built for 256 CUs (got %d)\n", grid); grid = -1; return; }
        grid = 256;
    }
    if (grid < 0) return;
    (void)hipMemsetAsync((char*)d_ws + WS_CTL, 0, CTL_ZERO_BYTES, stream);
    Args a{};
    for (int i = 0; i < 21; ++i) a.in[i] = d_in[i];
    a.out = (float*)d_out; a.ws = (unsigned char*)d_ws;
    hipLaunchKernelGGL(yoco_fwd, dim3(grid), dim3(NTHR), LDS_BYTES, stream, a);
}
```

```cpp
#include <hip/hip_runtime.h>
#include <cstdio>
#include <cstdint>
__device__ __forceinline__ int lane_id() { int l = (int)__builtin_amdgcn_mbcnt_hi(~0u, __builtin_amdgcn_mbcnt_lo(~0u, 0u)); asm volatile("" : "+v"(l)); return l; }

namespace pg8 {
#define PG8_LAS __attribute__((address_space(3)))
typedef unsigned short bf16_t;
typedef short bf16x8 __attribute__((ext_vector_type(8)));
typedef float f32x4 __attribute__((ext_vector_type(4)));
typedef unsigned u32x4 __attribute__((ext_vector_type(4)));
typedef unsigned u32x2 __attribute__((ext_vector_type(2)));
constexpr int BM = 256, BK = 64, HALF = 128, HTB = HALF * BK * 2, STAGE_BYTES = 8 * HTB, NXCD = 8, WGM = 8;

__host__ __device__ __forceinline__ int lds_byte(int r, int c) { const int st = (r >> 4) * 2 + (c >> 5), rr = r & 15, cc = c & 31, ob = rr * 64 + cc * 2; return st * 1024 + (ob ^ (((ob >> 9) & 1) << 5)); }
__host__ __device__ __forceinline__ void stage_rc(int b, int& R, int& C) { const int st = b / 1024, sb = b % 1024, swz = sb ^ (((sb >> 9) & 1) << 5); R = (st >> 1) * 16 + swz / 64; C = (st & 1) * 32 + (swz % 64) / 2; }
__host__ __device__ __forceinline__ int perm32(int rho) { const int n = rho >> 4, i = rho & 15; return 8 * (i >> 2) + 4 * n + (i & 3); }

struct Unit { int pm, pn; };
struct Gemm { const bf16_t* A; const bf16_t* Bt; int M, N, K; };

struct StaticOrder {
    int nM, nN, nwg, G, c;
    __host__ __device__ void init(int M, int N, int G_, int c_) { nM = M / BM; nN = N / BM; nwg = nM * nN; G = G_; c = c_; }
    __host__ __device__ bool next(int i, Unit& u) const {
        const long L = (long)i * G + c; if (L >= nwg) return false;
        int wgid = (int)L; { const int q = nwg / NXCD, r = nwg % NXCD, xcd = wgid % NXCD, off = wgid / NXCD; wgid = (xcd < r ? xcd * (q + 1) : r * (q + 1) + (xcd - r) * q) + off; }
        const int nig = WGM * nN, gid = wgid / nig, fm = gid * WGM, gsz = (nM - fm) < WGM ? (nM - fm) : WGM;
        u.pm = fm + ((wgid % nig) % gsz); u.pn = (wgid % nig) / gsz; return true;
    }
    __device__ __forceinline__ void a_ready(const Unit&) const {}
    __device__ __forceinline__ void done(const Unit&) const {}
};

__device__ __forceinline__ unsigned cvt_pk_bf16(float lo, float hi) { unsigned r; asm volatile("v_cvt_pk_bf16_f32 %0, %1, %2" : "=v"(r) : "v"(lo), "v"(hi)); return r; }

template <class Epi, class Sched, bool ALIGN_EPI = false, bool SP2 = false, bool HALF_LAST = true>
__device__ __forceinline__ void gemm_phase(PG8_LAS unsigned char* lds, const Gemm g, const Sched& S, const Epi& E, int tidx) {
    int tid_ = tidx; asm volatile("" : "+v"(tid_));
    const int tid = tid_, wid = __builtin_amdgcn_readfirstlane(tid >> 6), lane = tid & 63, wr = wid >> 2, wc = wid & 3, fr = lane & 15, fq = lane >> 4;
    const int K = g.K, nt = K / BK;
    unsigned voffA[2], voffB[2];
#pragma unroll
    for (int i = 0; i < 2; ++i) { int R, C; stage_rc(tid * 16 + i * 8192, R, C); const int Rb = Epi::PERM ? ((R & ~31) + perm32(R & 31)) : R;
        voffA[i] = (unsigned)(R * K + C) * 2u; voffB[i] = (unsigned)(Rb * K + C) * 2u; }
    const size_t kstep = (size_t)(BK * 2);
    const size_t hstep = (size_t)HALF * K * 2;
    const size_t tstep = 2 * hstep;
    const unsigned ldsw = (unsigned)wid * 1024u;
    const int aoff = lds_byte(wr * 64 + fr, fq * 8), boff = lds_byte(wc * 32 + fr, fq * 8);
#define PG8_SA(b, h) (((b) * 2 + (h)) * HTB)
#define PG8_SB(b, h) ((4 + (b) * 2 + (h)) * HTB)
#define PG8_STAGE(bufoff, gbase, voff) do { _Pragma("unroll") for (int _i = 0; _i < 2; ++_i) \
        __builtin_amdgcn_global_load_lds((const unsigned*)((const char*)(gbase) + (voff)[_i]), (PG8_LAS unsigned*)(lds + (bufoff) + ldsw + _i * 8192), 16, 0, 0); } while (0)
#define PG8_LDA(dst, b, h) do { _Pragma("unroll") for (int m = 0; m < 4; ++m) _Pragma("unroll") for (int k = 0; k < 2; ++k) dst[m][k] = *(const PG8_LAS bf16x8*)(lds + PG8_SA(b, h) + aoff + m * 2048 + k * 1024); } while (0)
#define PG8_LDB(dst, b, h) do { _Pragma("unroll") for (int n = 0; n < 2; ++n) _Pragma("unroll") for (int k = 0; k < 2; ++k) dst[n][k] = *(const PG8_LAS bf16x8*)(lds + PG8_SB(b, h) + boff + n * 2048 + k * 1024); } while (0)
#define PG8_MMA(ai, bj, At, Bt) do { __builtin_amdgcn_s_setprio(1); _Pragma("unroll") for (int m = 0; m < 4; ++m) _Pragma("unroll") for (int n = 0; n < 2; ++n) _Pragma("unroll") for (int k = 0; k < 2; ++k) \
        acc[ai][bj][m][n] = __builtin_amdgcn_mfma_f32_16x16x32_bf16(Bt[n][k], At[m][k], acc[ai][bj][m][n], 0, 0, 0); __builtin_amdgcn_s_setprio(0); } while (0)
#define PG8_WAIT_V(n) asm volatile("s_waitcnt vmcnt(" #n ")" ::: "memory")
#define PG8_WAIT_L(n) asm volatile("s_waitcnt lgkmcnt(" #n ")" ::: "memory")
#define PG8_BAR __builtin_amdgcn_s_barrier()
#define PG8_SCHED __builtin_amdgcn_sched_barrier(0)
    Unit cur, nxt; int ui = 0;
    if (!S.next(0, cur)) return;
    f32x4 acc[2][2][4][2];
#pragma unroll
    for (int a = 0; a < 2; ++a)
#pragma unroll
        for (int b = 0; b < 2; ++b)
#pragma unroll
            for (int m = 0; m < 4; ++m)
#pragma unroll
                for (int n = 0; n < 2; ++n) acc[a][b][m][n] = (f32x4){0.f, 0.f, 0.f, 0.f};
    bf16x8 At[4][2], B0[2][2], B1[2][2];
    const char* cA = (const char*)g.A + (size_t)cur.pm * tstep; const char* cB = (const char*)g.Bt + (size_t)cur.pn * tstep;
    S.a_ready(cur);
    if constexpr (SP2) {
        PG8_STAGE(PG8_SB(0, 0), cB, voffB); PG8_STAGE(PG8_SB(0, 1), cB + hstep, voffB); PG8_STAGE(PG8_SA(0, 0), cA, voffA); PG8_STAGE(PG8_SA(0, 1), cA + hstep, voffA);
        if (wr == 1) PG8_BAR;
        PG8_WAIT_V(2); PG8_BAR;
        PG8_STAGE(PG8_SB(1, 0), cB + kstep, voffB); PG8_STAGE(PG8_SA(1, 0), cA + kstep, voffA); PG8_STAGE(PG8_SB(1, 1), cB + hstep + kstep, voffB);
        PG8_WAIT_V(6); PG8_BAR;
    } else {
        PG8_STAGE(PG8_SB(0, 0), cB, voffB); PG8_STAGE(PG8_SA(0, 0), cA, voffA); PG8_STAGE(PG8_SB(0, 1), cB + hstep, voffB); PG8_STAGE(PG8_SA(0, 1), cA + hstep, voffA);
        if (wr == 1) PG8_BAR;
        PG8_WAIT_V(4); PG8_BAR;
        PG8_STAGE(PG8_SB(1, 0), cB + kstep, voffB); PG8_STAGE(PG8_SA(1, 0), cA + kstep, voffA); PG8_STAGE(PG8_SB(1, 1), cB + hstep + kstep, voffB);
        PG8_WAIT_V(6); PG8_BAR;
    }
    for (;;) {
        const bool has_next = S.next(ui + 1, nxt);
        const bool half1 = HALF_LAST && (cur.pm == g.M / BM - 1);
        const char* nA = has_next ? (const char*)g.A + (size_t)nxt.pm * tstep : cA; const char* nB = has_next ? (const char*)g.Bt + (size_t)nxt.pn * tstep : cB;
        for (int t = 0; t < nt; t += 2) {
            const bool last = (t == nt - 2);
            const char* a1 = cA + (size_t)(t + 1) * kstep;
            const char* a2 = last ? nA : cA + (size_t)(t + 2) * kstep; const char* b2 = last ? nB : cB + (size_t)(t + 2) * kstep;
            const char* a3 = a2 + kstep; const char* b3 = b2 + kstep;
            if (last && has_next) S.a_ready(nxt);
            if constexpr (SP2) {
            PG8_LDB(B0, 0, 0); PG8_LDB(B1, 0, 1); PG8_SCHED; PG8_LDA(At, 0, 0); PG8_STAGE(PG8_SA(1, 1), a1 + hstep, voffA);
            PG8_WAIT_V(8); PG8_WAIT_L(0); PG8_BAR; PG8_MMA(0, 0, At, B0); PG8_MMA(0, 1, At, B1); PG8_BAR; PG8_SCHED;
            if (!half1) { PG8_LDA(At, 0, 1); } PG8_STAGE(PG8_SB(0, 0), b2, voffB); PG8_STAGE(PG8_SB(0, 1), b2 + hstep, voffB); PG8_STAGE(PG8_SA(0, 0), a2, voffA);
            PG8_WAIT_V(8); PG8_WAIT_L(0); PG8_BAR; if (!half1) { PG8_MMA(1, 0, At, B0); PG8_MMA(1, 1, At, B1); } PG8_BAR; PG8_SCHED;
            PG8_LDB(B0, 1, 0); PG8_LDB(B1, 1, 1); PG8_SCHED; PG8_LDA(At, 1, 0); PG8_STAGE(PG8_SA(0, 1), a2 + hstep, voffA);
            PG8_WAIT_V(8); PG8_WAIT_L(0); PG8_BAR; PG8_MMA(0, 0, At, B0); PG8_MMA(0, 1, At, B1); PG8_BAR; PG8_SCHED;
            if (!half1) { PG8_LDA(At, 1, 1); } PG8_STAGE(PG8_SB(1, 0), b3, voffB); PG8_STAGE(PG8_SB(1, 1), b3 + hstep, voffB); PG8_STAGE(PG8_SA(1, 0), a3, voffA);
            PG8_WAIT_V(8); PG8_WAIT_L(0); PG8_BAR; if (!half1) { PG8_MMA(1, 0, At, B0); PG8_MMA(1, 1, At, B1); } PG8_BAR; PG8_SCHED;
            } else {
            PG8_LDB(B0, 0, 0); PG8_SCHED; PG8_LDA(At, 0, 0); PG8_STAGE(PG8_SA(1, 1), a1 + hstep, voffA);
            PG8_WAIT_L(8); PG8_BAR; PG8_WAIT_L(0); PG8_MMA(0, 0, At, B0); PG8_BAR; PG8_SCHED;
            PG8_LDB(B1, 0, 1); PG8_STAGE(PG8_SB(0, 0), b2, voffB);
            PG8_BAR; PG8_WAIT_L(0); PG8_MMA(0, 1, At, B1); PG8_BAR;
            PG8_LDA(At, 0, 1); PG8_STAGE(PG8_SA(0, 0), a2, voffA);
            PG8_BAR; PG8_WAIT_L(0); PG8_MMA(1, 0, At, B0); PG8_BAR; PG8_SCHED;
            PG8_STAGE(PG8_SB(0, 1), b2 + hstep, voffB);
            PG8_WAIT_V(6); PG8_BAR; PG8_MMA(1, 1, At, B1); PG8_BAR;
            PG8_LDB(B0, 1, 0); PG8_SCHED; PG8_LDA(At, 1, 0); PG8_STAGE(PG8_SA(0, 1), a2 + hstep, voffA);
            PG8_WAIT_L(8); PG8_BAR; PG8_WAIT_L(0); PG8_MMA(0, 0, At, B0); PG8_BAR; PG8_SCHED;
            PG8_LDB(B1, 1, 1); PG8_STAGE(PG8_SB(1, 0), b3, voffB);
            PG8_BAR; PG8_WAIT_L(0); PG8_MMA(0, 1, At, B1); PG8_BAR;
            PG8_LDA(At, 1, 1); PG8_STAGE(PG8_SA(1, 0), a3, voffA);
            PG8_BAR; PG8_WAIT_L(0); PG8_MMA(1, 0, At, B0); PG8_BAR; PG8_SCHED;
            PG8_STAGE(PG8_SB(1, 1), b3 + hstep, voffB);
            PG8_WAIT_V(6); PG8_BAR; PG8_MMA(1, 1, At, B1); PG8_BAR;
            }
        }
        if constexpr (ALIGN_EPI) { if (wr == 0) PG8_BAR; }
        E(acc, cur, wr, wc, fr, fq);
        if (!has_next) break;
#pragma unroll
        for (int a = 0; a < 2; ++a)
#pragma unroll
            for (int b = 0; b < 2; ++b)
#pragma unroll
                for (int m = 0; m < 4; ++m)
#pragma unroll
                    for (int n = 0; n < 2; ++n) acc[a][b][m][n] = (f32x4){0.f, 0.f, 0.f, 0.f};
        cur = nxt; cA = nA; cB = nB; ++ui;
        if constexpr (ALIGN_EPI) { if (wr == 1) PG8_BAR; }
    }
    PG8_WAIT_V(0);
    if constexpr (!ALIGN_EPI) { if (wr == 0) PG8_BAR; }
    PG8_BAR;
#undef PG8_SA
#undef PG8_SB
#undef PG8_STAGE
#undef PG8_LDA
#undef PG8_LDB
#undef PG8_MMA
#undef PG8_WAIT_V
#undef PG8_WAIT_L
#undef PG8_BAR
#undef PG8_SCHED
}
}

constexpr int NWAVES = 8, NTHR = 512;
constexpr int D = 2048, SEQ = 8192, DECB = 32, DECS = 4, MS = DECB * DECS;
constexpr int MR = SEQ + MS;
constexpr int MP = 8448;
constexpr int NH = 16, HD = 128, NKV = 4, DFF = 5632, NGU = 2 * DFF;
constexpr int NCHUNK = SEQ / 64;
constexpr int NPAGES = 64, PAGE = 128, NBLK = 32;
constexpr float EPS = 1e-6f;
constexpr float C2 = 0.08838834764831845f * 1.4426950408889634f;

constexpr size_t OY_P = 0, OY_S = OY_P + (size_t)SEQ * D, OST_P = OY_S + (size_t)MS * D, OST_S = OST_P + (size_t)NH * 128 * 128,
                 OK_P = OST_S + (size_t)DECB * NH * 128 * 128, OV_P = OK_P + (size_t)SEQ * 512, OK_S = OV_P + (size_t)SEQ * 512, OV_S = OK_S + (size_t)MS * 512;

constexpr size_t MiB = 1u << 20;
constexpr size_t WS_CTL = 0, CTL_ZERO_BYTES = 1 * MiB;
constexpr size_t WS_WIN = 2 * MiB;
constexpr size_t WS_WOUT = WS_WIN + 32 * MiB;
constexpr size_t WS_WGU0 = WS_WOUT + 8 * MiB;
constexpr size_t WS_WDN0 = WS_WGU0 + 44 * MiB;
constexpr size_t WS_WKVQ = WS_WDN0 + 22 * MiB;
constexpr size_t WS_WO = WS_WKVQ + 12 * MiB;
constexpr size_t WS_WGU1 = WS_WO + 8 * MiB;
constexpr size_t WS_WDN1 = WS_WGU1 + 44 * MiB;
constexpr size_t WS_HB0 = WS_WDN1 + 22 * MiB;
constexpr size_t WS_HB1 = WS_HB0 + 34 * MiB, WS_HB2 = WS_HB1 + 34 * MiB, WS_HB3 = WS_HB2 + 34 * MiB;
constexpr size_t WS_HF1 = WS_HB3 + 34 * MiB;
constexpr size_t WS_HF2 = WS_HF1 + 67 * MiB, WS_HF3 = WS_HF2 + 67 * MiB;
constexpr size_t WS_QG = WS_HF3 + 67 * MiB;
constexpr size_t WS_VG = WS_QG + 34 * MiB;
constexpr size_t WS_GG = WS_VG + 34 * MiB;
constexpr size_t WS_F = WS_GG + 34 * MiB;
constexpr size_t WS_OB = WS_F + 67 * MiB;
constexpr size_t WS_AT = WS_OB + 34 * MiB;
constexpr size_t WS_HM = WS_AT + 34 * MiB;
constexpr size_t WS_U = WS_HM + 92 * MiB;
constexpr size_t WS_SST = WS_U + 64 * MiB;
constexpr size_t WS_DEC = WS_SST + 64 * MiB;
constexpr size_t WS_KRAW = WS_DEC + 2 * MiB;
constexpr size_t WS_VRAW = WS_KRAW + 17 * MiB;
constexpr size_t WS_QRAW = WS_VRAW + 17 * MiB;
constexpr size_t WS_KB = WS_QRAW + 67 * MiB;
constexpr size_t WS_VB = WS_KB + 9 * MiB;
constexpr size_t WS_QB = WS_VB + 9 * MiB;
constexpr size_t WS_KPART = WS_QB + 34 * MiB;
constexpr size_t WS_KMS = WS_KPART + 1 * MiB;
constexpr size_t WS_SUBL = WS_KMS + 2 * MiB;
constexpr size_t WS_SCNT = WS_SUBL + 16 * MiB;
constexpr size_t WS_OSLOT = WS_SCNT + 1 * MiB;
constexpr size_t WS_MLSLOT = WS_OSLOT + 192 * MiB;
constexpr size_t WS_SSLOT = WS_MLSLOT + 3 * MiB;
constexpr size_t WS_FOUT = WS_SSLOT + 34 * MiB;
constexpr size_t WS_END = WS_FOUT + 131 * MiB;
constexpr size_t WS_ORC = WS_END;
constexpr int CW_BAR = 4096;
constexpr int CW_Q0 = 8192;
constexpr int CW_SS0 = 16384, CW_SS1 = CW_SS0 + MP, CW_SS2 = CW_SS1 + MP, CW_SS3 = CW_SS2 + MP;
static_assert((CW_SS3 + MP) * 4 <= (int)CTL_ZERO_BYTES, "ctl");
static_assert(WS_VG - WS_QG == 34 * MiB && WS_GG - WS_VG == 34 * MiB, "Qg|Vg|Gg stride");

constexpr int LDS_BYTES = 160 * 1024;
constexpr int MISC_OFF = LDS_BYTES - 256;

#define GAS __attribute__((address_space(1)))
#define LAS __attribute__((address_space(3)))
typedef unsigned short bf16;
typedef unsigned v4u __attribute__((ext_vector_type(4)));
typedef unsigned v2u __attribute__((ext_vector_type(2)));
typedef float f32x4 __attribute__((ext_vector_type(4)));
typedef float f32x2 __attribute__((ext_vector_type(2)));
typedef short bf16x8 __attribute__((ext_vector_type(8)));
typedef short bf16x4 __attribute__((ext_vector_type(4)));
typedef _Float16 f16;
typedef _Float16 f16x2 __attribute__((ext_vector_type(2)));
__device__ __forceinline__ unsigned pkh2(float lo, float hi) { const f16x2 v = {(f16)lo, (f16)hi}; return __builtin_bit_cast(unsigned, v); }
#define LDS_WAIT() asm volatile("s_waitcnt lgkmcnt(0)" ::: "memory")
__device__ __forceinline__ unsigned f2bf(float f) { unsigned u = __builtin_bit_cast(unsigned, f); return (u + 0x7fffu + ((u >> 16) & 1u)) >> 16; }
__device__ __forceinline__ unsigned pk2(float lo, float hi) { return f2bf(lo) | (f2bf(hi) << 16); }
__device__ __forceinline__ float bf2f(unsigned h) { return __uint_as_float(h << 16); }
__device__ __forceinline__ float silu_f(float x) { return x * __builtin_amdgcn_rcpf(1.0f + __expf(-x)); }
__device__ __forceinline__ float sigm_f(float x) { return __builtin_amdgcn_rcpf(1.0f + __expf(-x)); }
template <int M> __device__ __forceinline__ float shx(float v) { return __uint_as_float((unsigned)__builtin_amdgcn_ds_swizzle((int)__float_as_uint(v), (M << 10) | 0x1f)); }
__device__ __forceinline__ float xadd32(float v) { auto rr = __builtin_amdgcn_permlane32_swap(__float_as_uint(v), __float_as_uint(v), false, false); return __uint_as_float(rr[0]) + __uint_as_float(rr[1]); }
__device__ __forceinline__ float xmax32(float v) { auto rr = __builtin_amdgcn_permlane32_swap(__float_as_uint(v), __float_as_uint(v), false, false); return fmaxf(__uint_as_float(rr[0]), __uint_as_float(rr[1])); }
__device__ __forceinline__ float wave_sum(float v) { v += shx<1>(v); v += shx<2>(v); v += shx<4>(v); v += shx<8>(v); v += shx<16>(v); return xadd32(v); }
#define MFMA16(a, b, c) __builtin_amdgcn_mfma_f32_16x16x32_bf16((a), (b), (c), 0, 0, 0)

#define XB_TMO      128
#define XB_XCNT(j)  (256  + 64 * (j))
#define XB_XSUB(j)  (1280 + 64 * (j))
#define XB_XGEN(j)  (2304 + 64 * (j))
#define XB_TOP      3328
#define XB_TOPGEN   3392
#define XCD_BAR_WORDS 3456
#define XB_SPIN_CAP (1u << 18)
__device__ __forceinline__ unsigned xb_ld(unsigned* p)              { return __hip_atomic_load(p, __ATOMIC_RELAXED, __HIP_MEMORY_SCOPE_AGENT); }
__device__ __forceinline__ unsigned xb_add(unsigned* p, unsigned v) { return __hip_atomic_fetch_add(p, v, __ATOMIC_RELAXED, __HIP_MEMORY_SCOPE_AGENT); }
__device__ __forceinline__ unsigned xb_xcc_id() { return (unsigned)__builtin_amdgcn_s_getreg((3 << 11) | 20) & 0xFu; }
#define XB_SPIN(cond, bar) do { unsigned _sp = 0; while (cond) { __builtin_amdgcn_s_sleep(1); \
    if ((++_sp & 255u) == 0u) { if (xb_ld(&(bar)[XB_TMO])) break; if (_sp > XB_SPIN_CAP) { atomicAdd(&(bar)[XB_TMO], 1u); break; } } } } while (0)
struct XcdBarrier { unsigned* bar; unsigned x; volatile LAS unsigned* st; };
__device__ __forceinline__ XcdBarrier xcd_barrier_post(unsigned* bar, volatile LAS unsigned* st, bool is_t0) {
    XcdBarrier b; b.bar = bar; b.x = xb_xcc_id(); b.st = st;
    if (is_t0) (void)xb_add(&bar[XB_XCNT(b.x)], 1u);
    return b;
}
__device__ __forceinline__ void xcd_barrier_complete(unsigned* bar, unsigned x, unsigned& nloc, unsigned& nx) {
    const unsigned G = gridDim.x * gridDim.y * gridDim.z;
    unsigned sum, cnt, mine, sp = 0u;
    for (;;) {
        sum = 0u; cnt = 0u; mine = 0u;
#pragma unroll
        for (unsigned j = 0; j < 16; ++j) { const unsigned c = xb_ld(&bar[XB_XCNT(j)]); sum += c; cnt += (c > 0u) ? 1u : 0u; mine = (j == x) ? c : mine; }
        if (sum == G) break;
        __builtin_amdgcn_s_sleep(1);
        if ((++sp & 255u) == 0u) { if (xb_ld(&bar[XB_TMO])) break; if (sp > XB_SPIN_CAP) { atomicAdd(&bar[XB_TMO], 1u); break; } }
    }
    nloc = mine > 0u ? mine : 1u; nx = cnt > 0u ? cnt : 1u;
}
__device__ __forceinline__ void xcd_barrier(const XcdBarrier& b, bool is_t0) {
    asm volatile("s_waitcnt vmcnt(0)" ::: "memory");
    __syncthreads();
    if (is_t0) {
        unsigned* bar = b.bar;
        __builtin_amdgcn_s_waitcnt(0);
        unsigned nloc = b.st[0], nx = b.st[1];
        if (nloc == 0u) { xcd_barrier_complete(bar, b.x, nloc, nx); b.st[0] = nloc; b.st[1] = nx; }
        const unsigned old = xb_add(&bar[XB_XSUB(b.x)], 1u);
        const unsigned gen = old / nloc;
        if (old + 1u == (gen + 1u) * nloc) {
            __builtin_amdgcn_fence(__ATOMIC_RELEASE, "agent");
            asm volatile("s_waitcnt vmcnt(0)" ::: "memory");
            const unsigned og = xb_add(&bar[XB_TOP], 1u);
            const unsigned tg = og / nx;
            if (og + 1u == (tg + 1u) * nx) xb_add(&bar[XB_TOPGEN], 1u);
            else XB_SPIN(xb_ld(&bar[XB_TOPGEN]) == tg, bar);
            __builtin_amdgcn_fence(__ATOMIC_ACQUIRE, "agent");
            xb_add(&bar[XB_XGEN(b.x)], 1u);
            asm volatile("s_waitcnt vmcnt(0)" ::: "memory");
        } else {
            XB_SPIN(xb_ld(&bar[XB_XGEN(b.x)]) == gen, bar);
            __builtin_amdgcn_fence(__ATOMIC_ACQUIRE, "agent");
            asm volatile("s_waitcnt vmcnt(0)" ::: "memory");
        }
    }
    __syncthreads();
}

using pg8::Unit; using pg8::cvt_pk_bf16;
struct EpiIn {
    static constexpr bool PERM = true;
    const float* ss; const float* lbl; bf16* Qg; f16* F;
    __device__ __forceinline__ void operator()(const f32x4 (&acc)[2][2][4][2], const Unit& u, int wr, int wc, int fr, int fq) const {
        const int seg = u.pn >> 3; const int col0 = (u.pn & 7) * 256 + wc * 32 + 8 * fq; const int rowb = u.pm * 256 + wr * 64;
        float lb[2][8];
        if (seg == 1) {
#pragma unroll
            for (int bj = 0; bj < 2; ++bj)
#pragma unroll
                for (int j = 0; j < 8; ++j) { const int c = col0 + bj * 128 + j; lb[bj][j] = __builtin_amdgcn_rcpf(1.0f + __expf(lbl[D + c] - lbl[c])); }
        }
#pragma unroll
        for (int ai = 0; ai < 2; ++ai)
#pragma unroll
            for (int m = 0; m < 4; ++m) {
                const int rb = rowb + ai * 128 + m * 16; if (rb >= MR) continue;
                const int row = rb + fr; const float r = rsqrtf(ss[row] * (1.0f / D) + EPS);
#pragma unroll
                for (int bj = 0; bj < 2; ++bj) {
                    f32x4 v0 = acc[ai][bj][m][0] * r, v1 = acc[ai][bj][m][1] * r; const size_t off = (size_t)row * D + col0 + bj * 128;
                    if (seg == 1) {
                        f32x4 o0, o1;
#pragma unroll
                        for (int j = 0; j < 4; ++j) { o0[j] = (1.0f - lb[bj][j]) * sigm_f(-v0[j]); o1[j] = (1.0f - lb[bj][4 + j]) * sigm_f(-v1[j]); }
                        { v4u w; w.x = pkh2(o0[0], o0[1]); w.y = pkh2(o0[2], o0[3]); w.z = pkh2(o1[0], o1[1]); w.w = pkh2(o1[2], o1[3]); *(v4u*)(F + off) = w; }
                    } else {
                        if (seg != 2) {
#pragma unroll
                            for (int j = 0; j < 4; ++j) { v0[j] = silu_f(v0[j]); v1[j] = silu_f(v1[j]); }
                        }
                        v4u w; w.x = cvt_pk_bf16(v0[0], v0[1]); w.y = cvt_pk_bf16(v0[2], v0[3]); w.z = cvt_pk_bf16(v1[0], v1[1]); w.w = cvt_pk_bf16(v1[2], v1[3]);
                        const size_t dsel = (seg == 0) ? 0 : ((seg == 2) ? 1 : 2);
                        *(v4u*)(Qg + dsel * (size_t)(17 * MiB) + off) = w;
                    }
                }
            }
    }
    __device__ __forceinline__ void tail(int row, int col, f32x4 v) const {
        const int seg = col >> 11, c = col & 2047; const float r = rsqrtf(ss[row] * (1.0f / D) + EPS); v = v * r; const size_t off = (size_t)row * D + c;
        if (seg == 1) { f32x4 o;
#pragma unroll
            for (int j = 0; j < 4; ++j) { const float lbv = __builtin_amdgcn_rcpf(1.0f + __expf(lbl[D + c + j] - lbl[c + j])); o[j] = (1.0f - lbv) * sigm_f(-v[j]); }
            { v2u w; w.x = pkh2(o[0], o[1]); w.y = pkh2(o[2], o[3]); *(v2u*)(F + off) = w; }
        } else {
            if (seg != 2) {
#pragma unroll
                for (int j = 0; j < 4; ++j) v[j] = silu_f(v[j]);
            }
            v2u w; w.x = cvt_pk_bf16(v[0], v[1]); w.y = cvt_pk_bf16(v[2], v[3]);
            const size_t dsel = (seg == 0) ? 0 : ((seg == 2) ? 1 : 2);
            *(v2u*)(Qg + dsel * (size_t)(17 * MiB) + off) = w;
        }
    }
};

template <int MODE> struct EpiRes {
    static constexpr bool PERM = true;
    const bf16* rb; float* o0; float* o1; bf16* hb; float* ss;
    __device__ __forceinline__ void operator()(const f32x4 (&acc)[2][2][4][2], const Unit& u, int wr, int wc, int fr, int fq) const {
        const int col0 = u.pn * 256 + wc * 32 + 8 * fq; const int rowb = u.pm * 256 + wr * 64;
#pragma unroll
        for (int ai = 0; ai < 2; ++ai)
#pragma unroll
            for (int m = 0; m < 4; ++m) {
                const int rb0 = rowb + ai * 128 + m * 16; if (rb0 >= MR) continue;
                const int row = rb0 + fr;
                const bf16* rp = rb + (size_t)row * D;
                float* op = (MODE == 2) ? ((row < SEQ) ? o0 + (size_t)row * D : o1 + (size_t)(row - SEQ) * D) : nullptr;
                float sq = 0.f;
#pragma unroll
                for (int bj = 0; bj < 2; ++bj) {
                    const int c = col0 + bj * 128;
                    const v4u rw = *(const v4u*)(rp + c);
                    f32x4 a0 = {bf2f(rw.x & 0xffffu), bf2f(rw.x >> 16), bf2f(rw.y & 0xffffu), bf2f(rw.y >> 16)}, a1 = {bf2f(rw.z & 0xffffu), bf2f(rw.z >> 16), bf2f(rw.w & 0xffffu), bf2f(rw.w >> 16)};
                    a0 += acc[ai][bj][m][0]; a1 += acc[ai][bj][m][1];
                    if (MODE == 2) { __builtin_nontemporal_store(a0, (f32x4*)(op + c)); __builtin_nontemporal_store(a1, (f32x4*)(op + c + 4)); }
                    else {
                        v4u w; w.x = cvt_pk_bf16(a0[0], a0[1]); w.y = cvt_pk_bf16(a0[2], a0[3]); w.z = cvt_pk_bf16(a1[0], a1[1]); w.w = cvt_pk_bf16(a1[2], a1[3]);
                        *(v4u*)(hb + (size_t)row * D + c) = w;
                        sq += (a0[0] * a0[0] + a0[1] * a0[1]) + (a0[2] * a0[2] + a0[3] * a0[3]) + (a1[0] * a1[0] + a1[1] * a1[1]) + (a1[2] * a1[2] + a1[3] * a1[3]);
                    }
                }
                if (MODE != 2) { sq += shx<16>(sq); sq = xadd32(sq); if (fq == 0) atomicAdd(ss + row, sq); }
            }
    }
    __device__ __forceinline__ void tail(int row, int col, f32x4 v, int fq) const {
        const v2u rw = *(const v2u*)(rb + (size_t)row * D + col);
        f32x4 a0 = {bf2f(rw.x & 0xffffu), bf2f(rw.x >> 16), bf2f(rw.y & 0xffffu), bf2f(rw.y >> 16)}; a0 += v;
        if (MODE == 2) { *(f32x4*)(o1 + (size_t)(row - SEQ) * D + col) = a0; }
        else {
            v2u w; w.x = cvt_pk_bf16(a0[0], a0[1]); w.y = cvt_pk_bf16(a0[2], a0[3]); *(v2u*)(hb + (size_t)row * D + col) = w;
            float sq = (a0[0] * a0[0] + a0[1] * a0[1]) + (a0[2] * a0[2] + a0[3] * a0[3]);
            sq += shx<16>(sq); sq = xadd32(sq); if (fq == 0) atomicAdd(ss + row, sq);
        }
    }
};
struct EpiGU {
    static constexpr bool PERM = true;
    const float* ss; bf16* hm;
    __device__ __forceinline__ void operator()(const f32x4 (&acc)[2][2][4][2], const Unit& u, int wr, int wc, int fr, int fq) const {
        const int j0 = u.pn * 128 + wc * 32 + 8 * fq; const int rowb = u.pm * 256 + wr * 64;
#pragma unroll
        for (int ai = 0; ai < 2; ++ai)
#pragma unroll
            for (int m = 0; m < 4; ++m) {
                const int rb = rowb + ai * 128 + m * 16; if (rb >= MR) continue;
                const int row = rb + fr; const float r = rsqrtf(ss[row] * (1.0f / D) + EPS);
                float o[8];
#pragma unroll
                for (int n = 0; n < 2; ++n)
#pragma unroll
                    for (int j = 0; j < 4; ++j) o[4 * n + j] = silu_f(acc[ai][0][m][n][j] * r) * (acc[ai][1][m][n][j] * r);
                v4u w; w.x = cvt_pk_bf16(o[0], o[1]); w.y = cvt_pk_bf16(o[2], o[3]); w.z = cvt_pk_bf16(o[4], o[5]); w.w = cvt_pk_bf16(o[6], o[7]);
                *(v4u*)(hm + (size_t)row * DFF + j0) = w;
            }
    }
};
struct EpiKVQ {
    static constexpr bool PERM = true;
    const float* ss; unsigned char* ws; float* outp; const float* kn; const float* qn; LAS unsigned char* xl;
    __device__ __forceinline__ void operator()(const f32x4 (&acc)[2][2][4][2], const Unit& u, int wr, int wc, int fr, int fq) const {
        const int c0 = wc * 32 + 8 * fq; const int rowb = u.pm * 256 + wr * 64;
        bf16* Kb_ = (bf16*)(ws + WS_KB); bf16* Vb_ = (bf16*)(ws + WS_VB); bf16* Qb_ = (bf16*)(ws + WS_QB); float* Kp_ = (float*)(ws + WS_KPART);
        if (u.pn == 2 || u.pn == 3) {
#pragma unroll
            for (int ai = 0; ai < 2; ++ai)
#pragma unroll
                for (int m = 0; m < 4; ++m) {
                    const int rb = rowb + ai * 128 + m * 16; if (rb >= MR) continue;
                    const int row = rb + fr; const float r = rsqrtf(ss[row] * (1.0f / D) + EPS);
                    float* vo = outp + ((row < SEQ) ? OV_P + (size_t)row * 512 : OV_S + (size_t)(row - SEQ) * 512);
#pragma unroll
                    for (int bj = 0; bj < 2; ++bj) { const int col = (u.pn - 2) * 256 + bj * 128 + c0; const f32x4 v0 = acc[ai][bj][m][0] * r, v1 = acc[ai][bj][m][1] * r;
                        __builtin_nontemporal_store(v0, (f32x4*)(vo + col)); __builtin_nontemporal_store(v1, (f32x4*)(vo + col + 4));
                        v4u w; w.x = cvt_pk_bf16(v0[0], v0[1]); w.y = cvt_pk_bf16(v0[2], v0[3]); w.z = cvt_pk_bf16(v1[0], v1[1]); w.w = cvt_pk_bf16(v1[2], v1[3]);
                        *(v4u*)(Vb_ + (size_t)row * 512 + col) = w; }
                }
            return;
        }
        const bool isk = u.pn < 2;
        LAS float* P = (LAS float*)xl;
        LAS float* CS = (LAS float*)(xl + 8192);
#pragma unroll
        for (int ai = 0; ai < 2; ++ai)
#pragma unroll
            for (int m = 0; m < 4; ++m) {
                const int rl = ai * 128 + wr * 64 + m * 16 + fr; const float r = rsqrtf(ss[u.pm * 256 + rl] * (1.0f / D) + EPS);
#pragma unroll
                for (int bj = 0; bj < 2; ++bj) { const f32x4 v0 = acc[ai][bj][m][0] * r, v1 = acc[ai][bj][m][1] * r;
                    float sq = (v0[0] * v0[0] + v0[1] * v0[1]) + (v0[2] * v0[2] + v0[3] * v0[3]) + (v1[0] * v1[0] + v1[1] * v1[1]) + (v1[2] * v1[2] + v1[3] * v1[3]);
                    sq += shx<16>(sq); sq = xadd32(sq);
                    if (fq == 0) P[(rl * 2 + bj) * 4 + wc] = sq; }
            }
        asm volatile("s_waitcnt lgkmcnt(0)" ::: "memory"); __builtin_amdgcn_s_barrier(); asm volatile("" ::: "memory");
        float cs[2][8];
#pragma unroll
        for (int bj = 0; bj < 2; ++bj)
#pragma unroll
            for (int j = 0; j < 8; ++j) cs[bj][j] = 0.f;
        const float* gp = (isk ? kn : qn) + c0; const f32x4 g0 = *(const f32x4*)gp, g1 = *(const f32x4*)(gp + 4);
#pragma unroll
        for (int ai = 0; ai < 2; ++ai)
#pragma unroll
            for (int m = 0; m < 4; ++m) {
                const int rb = rowb + ai * 128 + m * 16; if (rb >= MR) continue;
                const int rl = ai * 128 + wr * 64 + m * 16 + fr; const int row = rb + fr; const float r = rsqrtf(ss[row] * (1.0f / D) + EPS);
#pragma unroll
                for (int bj = 0; bj < 2; ++bj) {
                    const f32x4 pp = *(const LAS f32x4*)(P + (rl * 2 + bj) * 4);
                    const float rh = rsqrtf(((pp[0] + pp[1]) + (pp[2] + pp[3])) * (1.0f / 128.0f) + EPS) * (isk ? 1.0f : C2);
                    const f32x4 n0 = acc[ai][bj][m][0] * (r * rh) * g0, n1 = acc[ai][bj][m][1] * (r * rh) * g1;
                    v4u w; w.x = cvt_pk_bf16(n0[0], n0[1]); w.y = cvt_pk_bf16(n0[2], n0[3]); w.z = cvt_pk_bf16(n1[0], n1[1]); w.w = cvt_pk_bf16(n1[2], n1[3]);
                    if (isk) {
                        const int col = u.pn * 256 + bj * 128 + c0;
                        float* ko = outp + ((row < SEQ) ? OK_P + (size_t)row * 512 : OK_S + (size_t)(row - SEQ) * 512) + col;
                        __builtin_nontemporal_store(n0, (f32x4*)ko); __builtin_nontemporal_store(n1, (f32x4*)(ko + 4));
                        *(v4u*)(Kb_ + (size_t)row * 512 + col) = w;
#pragma unroll
                        for (int j = 0; j < 4; ++j) { cs[bj][j] += n0[j]; cs[bj][4 + j] += n1[j]; }
                    } else {
                        *(v4u*)(Qb_ + (size_t)row * D + (u.pn - 4) * 256 + bj * 128 + c0) = w;
                    }
                }
            }
        if (isk && u.pm < SEQ / 256) {
#pragma unroll
            for (int bj = 0; bj < 2; ++bj)
#pragma unroll
                for (int j = 0; j < 8; ++j) { float v = cs[bj][j]; v += shx<1>(v); v += shx<2>(v); v += shx<4>(v); v += shx<8>(v); if (fr == 0) CS[wr * 256 + bj * 128 + c0 + j] = v; }
            asm volatile("s_waitcnt lgkmcnt(0)" ::: "memory"); __builtin_amdgcn_s_barrier(); asm volatile("" ::: "memory");
            const int t = (wr * 4 + wc) * 64 + fq * 16 + fr;
            if (t < 256) Kp_[(size_t)u.pm * 512 + u.pn * 256 + t] = CS[t] + CS[256 + t];
        }
    }
};

struct Args { const void* in[21]; float* out; unsigned char* ws; };

__device__ __forceinline__ void p0_transpose_item(const float* W, int K, int N, bf16* WT, int row_off, int mode, const float* gain, LAS float* scr, int item, int lane) {
    const int nblk = N / 64, kb = item / nblk, nb = item % nblk, k0 = 64 * kb, n0 = 64 * nb;
    const int r = lane >> 4, c4 = lane & 15;
#pragma unroll
    for (int i = 0; i < 16; ++i) { const int kk = 4 * i + r; f32x4 w = __builtin_nontemporal_load((const f32x4*)(W + (size_t)(k0 + kk) * N + n0 + 4 * c4)); if (gain) w *= gain[k0 + kk]; *(LAS f32x4*)(scr + kk * 68 + 4 * c4) = w; }
    LDS_WAIT(); asm volatile("" ::: "memory");
    const int c = lane & 7;
    int d0;
    if (mode == 0) d0 = row_off + n0;
    else { const int j = (n0 < DFF) ? n0 : n0 - DFF; d0 = 256 * (j >> 7) + (j & 127) + ((n0 < DFF) ? 0 : 128); }
#pragma unroll
    for (int j = 0; j < 8; ++j) { const int n = (lane >> 3) + 8 * j; const LAS float* sp = scr + (8 * c) * 68 + n;
        v4u o; o.x = pk2(sp[0 * 68], sp[1 * 68]); o.y = pk2(sp[2 * 68], sp[3 * 68]); o.z = pk2(sp[4 * 68], sp[5 * 68]); o.w = pk2(sp[6 * 68], sp[7 * 68]);
        *(v4u*)(WT + (size_t)(d0 + n) * K + k0 + 8 * c) = o; }
    LDS_WAIT(); asm volatile("" ::: "memory");
}

constexpr int KS_P = 144;
constexpr int KS_BYTES = 256 * KS_P * 2;
typedef short v4i16_t __attribute__((ext_vector_type(4)));
__device__ __forceinline__ v2u tr_read(const LAS bf16* p) { return __builtin_bit_cast(v2u, __builtin_amdgcn_ds_read_tr16_b64_v4i16((LAS v4i16_t*)p)); }
template <int NKT> __device__ __forceinline__ void attn_scores(const LAS bf16* Ks, const bf16x8 (&qf)[4], f32x4 (&acc)[16], int nkt, int fr, int fq) {
#pragma unroll
    for (int kt = 0; kt < NKT; ++kt) {
        acc[kt] = (f32x4){0.f, 0.f, 0.f, 0.f};
        if (kt < nkt) {
#pragma unroll
            for (int ks = 0; ks < 4; ++ks) { const bf16x8 a = *(const LAS bf16x8*)(Ks + (16 * kt + fr) * KS_P + 32 * ks + 8 * fq); acc[kt] = MFMA16(a, qf[ks], acc[kt]); }
        }
    }
}
__device__ __forceinline__ void attn_pv(const LAS bf16* Vr, const f32x4 (&acc)[16], f32x4 (&O)[8], int nj, int fr, int fq) {
#pragma unroll
    for (int j = 0; j < 8; ++j) {
        if (j < nj) {
            v4u pw; pw.x = cvt_pk_bf16(acc[2 * j][0], acc[2 * j][1]); pw.y = cvt_pk_bf16(acc[2 * j][2], acc[2 * j][3]); pw.z = cvt_pk_bf16(acc[2 * j + 1][0], acc[2 * j + 1][1]); pw.w = cvt_pk_bf16(acc[2 * j + 1][2], acc[2 * j + 1][3]);
            const bf16x8 pf = __builtin_bit_cast(bf16x8, pw);
            const LAS bf16* vb = Vr + (32 * j + 4 * fq + (fr >> 2)) * KS_P + 4 * (fr & 3);
#pragma unroll
            for (int vt = 0; vt < 8; ++vt) {
                const v2u lo = tr_read(vb + 16 * vt), hi = tr_read(vb + 16 * KS_P + 16 * vt);
                const v4u aw = {lo.x, lo.y, hi.x, hi.y};
                O[vt] = MFMA16(__builtin_bit_cast(bf16x8, aw), pf, O[vt]);
            }
        }
    }
}

template <int NT, int K> __device__ __forceinline__ void tail_gemm(LAS unsigned char* lds, const bf16* A, const bf16* Bt, int n0, int rowhalf, f32x4 (&acc)[NT], int tidx) {
    int tid_o = tidx; asm volatile("" : "+v"(tid_o));
    const int tid = tid_o, lane = tid & 63, wave = __builtin_amdgcn_readfirstlane(tid >> 6), fr = lane & 15, fq = lane >> 4;
    const int rt = wave & 3, kh = wave >> 2; constexpr int Kh = K >> 1;
    constexpr int KC = (K == 2048) ? 1024 : 1408;
    constexpr int NCH = Kh / KC, PB = KC + 8, UPR = KC >> 3, NS = KC >> 7;
    constexpr int NU = 2 * 16 * NT * UPR, NIT = NU / NTHR;
    static_assert(NU % NTHR == 0, "tail B staging");
    LAS bf16* Bs = (LAS bf16*)(lds + 8192);
    const bf16* ap = A + (size_t)(64 * rowhalf + 16 * rt + fr) * K + kh * Kh + 8 * fq;
    const LAS bf16* bl = Bs + (kh * 16 * NT + fr) * PB + 8 * fq;
#pragma unroll
    for (int t = 0; t < NT; ++t) acc[t] = (f32x4){0.f, 0.f, 0.f, 0.f};
#define TG_LDA(a_, k0_) do { _Pragma("unroll") for (int s_ = 0; s_ < 4; ++s_) a_[s_] = *(const bf16x8*)(ap + (k0_) + 32 * s_); } while (0)
#define TG_MMA(a_, kl_) do { _Pragma("unroll") for (int s_ = 0; s_ < 4; ++s_) { _Pragma("unroll") for (int t_ = 0; t_ < NT; ++t_) { \
        const bf16x8 b_ = *(const LAS bf16x8*)(bl + t_ * 16 * PB + (kl_) + 32 * s_); acc[t_] = MFMA16(b_, a_[s_], acc[t_]); } } } while (0)
#define TG_LDB(kb_) do { _Pragma("unroll") for (int i_ = 0; i_ < NIT; ++i_) { const int u_ = tid + i_ * NTHR, r2_ = u_ / UPR, kc_ = u_ - r2_ * UPR; const int khh_ = (r2_ >= 16 * NT) ? 1 : 0, row_ = r2_ - khh_ * 16 * NT; \
        breg[i_] = *(const v4u*)(Bt + (size_t)(n0 + row_) * K + khh_ * Kh + (kb_) + 8 * kc_); } } while (0)
#define TG_STB() do { _Pragma("unroll") for (int i_ = 0; i_ < NIT; ++i_) { const int u_ = tid + i_ * NTHR, r2_ = u_ / UPR, kc_ = u_ - r2_ * UPR; *(LAS v4u*)(Bs + r2_ * PB + 8 * kc_) = breg[i_]; } } while (0)
    v4u breg[NIT];
    TG_LDB(0);
#pragma unroll
    for (int ch = 0; ch < NCH; ++ch) {
        const int kb = ch * KC;
        bf16x8 a0[4], a1[4], a2[4], a3[4];
        TG_LDA(a0, kb); TG_LDA(a1, kb + 128); TG_LDA(a2, kb + 256); TG_LDA(a3, kb + 384);
        TG_STB();
        __syncthreads();
        if (ch + 1 < NCH) TG_LDB(kb + KC);
        for (int st = 0; st < NS; st += 4) {
            TG_MMA(a0, 128 * st);           if (st + 4 < NS) TG_LDA(a0, kb + 128 * (st + 4));
            if (st + 1 < NS) { TG_MMA(a1, 128 * (st + 1)); if (st + 5 < NS) TG_LDA(a1, kb + 128 * (st + 5)); }
            if (st + 2 < NS) { TG_MMA(a2, 128 * (st + 2)); if (st + 6 < NS) TG_LDA(a2, kb + 128 * (st + 6)); }
            if (st + 3 < NS) { TG_MMA(a3, 128 * (st + 3)); if (st + 7 < NS) TG_LDA(a3, kb + 128 * (st + 7)); }
        }
        __syncthreads();
    }
#undef TG_LDA
#undef TG_MMA
#undef TG_LDB
#undef TG_STB
    LAS f32x4* red = (LAS f32x4*)lds;
    if (kh == 1) {
#pragma unroll
        for (int t = 0; t < NT; ++t) red[(t * 4 + rt) * 64 + lane] = acc[t];
    }
    __syncthreads();
    if (kh == 0) {
#pragma unroll
        for (int t = 0; t < NT; ++t) acc[t] += red[(t * 4 + rt) * 64 + lane];
    }
    __syncthreads();
}

__device__ __forceinline__ void kmean_items(LAS unsigned char* lds, const float* cache_k_, const int* ptab_, float* Kms_, int i0, int i1, int c0, int cn, int tidx) {
    int tid_o = tidx; asm volatile("" : "+v"(tid_o)); const int tid = tid_o;
    const int me = (int)blockIdx.x - c0; if (me < 0 || me >= cn) return;
    LAS f32x4* redk = (LAS f32x4*)(lds);
    for (int item = i0 + me; item < i1; item += cn) {
        const int b = item >> 5, n = item & 31; const int c4 = tid & 127, rg = tid >> 7;
        f32x4 a = {0.f, 0.f, 0.f, 0.f};
#pragma unroll
        for (int hp = 0; hp < 2; ++hp) { const int page = ptab_[b * NPAGES + 2 * n + hp]; const f32x4* pp = (const f32x4*)(cache_k_ + (size_t)page * PAGE * 512) + c4;
#pragma unroll 16
            for (int r = rg; r < 128; r += 4) a += __builtin_nontemporal_load(pp + (size_t)r * 128); }
        redk[rg * 128 + c4] = a;
        __syncthreads();
        if (tid < 128) { const f32x4 s4 = (redk[tid] + redk[128 + tid]) + (redk[256 + tid] + redk[384 + tid]); *(f32x4*)(Kms_ + (size_t)item * 512 + 4 * tid) = s4 * (1.0f / 256.0f); }
        __syncthreads();
    }
}

__global__ void __launch_bounds__(NTHR, 2) yoco_fwd(Args args) {
    extern __shared__ __attribute__((aligned(16))) unsigned char lds_raw[];
    LAS unsigned char* lds = (LAS unsigned char*)lds_raw;
#define TIDS int tid_o = TIDX; asm volatile("" : "+v"(tid_o)); const int tid = tid_o, lane = tid & 63, wave = __builtin_amdgcn_readfirstlane(tid >> 6), fr = lane & 15, fq = lane >> 4; (void)fr; (void)fq; (void)wave; (void)lane; (void)tid
    const int G = gridDim.x, bid = blockIdx.x;
    unsigned char* ws = args.ws;
    unsigned* ctl = (unsigned*)(ws + WS_CTL);
    volatile LAS unsigned* MISC = (volatile LAS unsigned*)(lds + MISC_OFF);
    const int wave_sg = __builtin_amdgcn_readfirstlane((int)threadIdx.x & ~63);
#define TIDX (wave_sg + lane_id())
#define IS_T0 ((wave_sg == 0) && (lane_id() == 0))
    if (TIDX < 64) MISC[TIDX] = 0u;
    __syncthreads();
    XcdBarrier bar = xcd_barrier_post(ctl + CW_BAR, MISC + 8, IS_T0);
#ifdef PROF_A
    int n_stamp = 0;
#define STAMP() do { if (blockIdx.x == 0 && IS_T0) MISC[16 + n_stamp] = (unsigned)__builtin_amdgcn_s_memrealtime(); ++n_stamp; } while (0)
#define TNOW() ((unsigned)__builtin_amdgcn_s_memrealtime())
#define TACC(k, t0) do { if (blockIdx.x == 0 && IS_T0) MISC[40 + (k)] += TNOW() - (t0); } while (0)
#define PVAL(a0, a1) (((a0) >= 100) ? MISC[40 + (a0) - 100] : (MISC[16 + (a1)] - MISC[16 + (a0)]))
#else
#define STAMP() do {} while (0)
#define TNOW() 0u
#define TACC(k, t0) do { (void)(t0); } while (0)
#endif
    STAMP();

#define x_p ((const float*)args.in[0])
#define x_s ((const float*)args.in[1])
#define st_in ((const float*)args.in[2])
#define cache_k ((const float*)args.in[3])
#define cache_v ((const float*)args.in[4])
#define ptab ((const int*)args.in[5])
#define norm_mix_a ((const float*)args.in[6])
#define w_in ((const float*)args.in[7])
#define lbl ((const float*)args.in[8])
#define onorm ((const float*)args.in[9])
#define w_out ((const float*)args.in[10])
#define norm_kv ((const float*)args.in[11])
#define w_kv ((const float*)args.in[12])
#define k_norm ((const float*)args.in[13])
#define norm_mix_b ((const float*)args.in[14])
#define w_q ((const float*)args.in[15])
#define q_norm ((const float*)args.in[16])
#define w_o ((const float*)args.in[17])
#define norm_ffn ((const float*)args.in[18])
#define w_gu ((const float*)args.in[19])
#define w_dn ((const float*)args.in[20])
#define Win_t ((bf16*)(ws + WS_WIN))
#define Wout_t ((bf16*)(ws + WS_WOUT))
#define Wgu0_t ((bf16*)(ws + WS_WGU0))
#define Wdn0_t ((bf16*)(ws + WS_WDN0))
#define Wkvq_t ((bf16*)(ws + WS_WKVQ))
#define Wo_t ((bf16*)(ws + WS_WO))
#define Wgu1_t ((bf16*)(ws + WS_WGU1))
#define Wdn1_t ((bf16*)(ws + WS_WDN1))
#define Hb0 ((bf16*)(ws + WS_HB0))
#define Hb1 ((bf16*)(ws + WS_HB1))
#define Hb2 ((bf16*)(ws + WS_HB2))
#define Hb3 ((bf16*)(ws + WS_HB3))
#define Hf1 ((float*)(ws + WS_HF1))
#define Hf2 ((float*)(ws + WS_HF2))
#define Hf3 ((float*)(ws + WS_HF3))
#define Qg ((bf16*)(ws + WS_QG))
#define Vg ((bf16*)(ws + WS_VG))
#define Gg ((bf16*)(ws + WS_GG))
#define Ff ((f16*)(ws + WS_F))
#define Ob ((bf16*)(ws + WS_OB))
#define At ((bf16*)(ws + WS_AT))
#define Hm ((bf16*)(ws + WS_HM))
#define Ug ((float*)(ws + WS_U))
#define Sg0 ((float*)(ws + WS_SST))
#define Dg ((float*)(ws + WS_DEC))
#define Kraw ((float*)(ws + WS_KRAW))
#define Vraw ((float*)(ws + WS_VRAW))
#define Qraw ((bf16*)(ws + WS_QRAW))
#define Kb ((bf16*)(ws + WS_KB))
#define Vb ((bf16*)(ws + WS_VB))
#define Qb ((bf16*)(ws + WS_QB))
#define Kpart ((float*)(ws + WS_KPART))
#define Kms ((float*)(ws + WS_KMS))
#define Subl ((unsigned*)(ws + WS_SUBL))
#define Scnt ((unsigned*)(ws + WS_SCNT))
#define Sels ((unsigned*)(ws + WS_SCNT + 256 * 1024))
#define Oslot ((bf16*)(ws + WS_OSLOT))
#define MLslot ((float*)(ws + WS_MLSLOT))
#define Sslot ((float*)(ws + WS_SSLOT))
#define ss0 ((float*)(ctl + CW_SS0))
#define ss1 ((float*)(ctl + CW_SS1))
#define ss2 ((float*)(ctl + CW_SS2))
#define ss3 ((float*)(ctl + CW_SS3))
#define out (args.out)
    {
        TIDS;
        LAS float* scr = (LAS float*)(lds + wave * 17408);
        const int gw = bid * NWAVES + wave, NGW = G * NWAVES;
        constexpr int I_IN = 32 * 128, I_SQ = 32 * 32, I_GU = 32 * 176, I_DN = 88 * 32, I_KV = 32 * 16;
        constexpr int NITEMS = I_IN + I_SQ + 2 * I_GU + 2 * I_DN + I_KV + I_SQ + I_SQ;
        for (int it = gw; it < NITEMS; it += NGW) {
            int r = it;
            if (r < I_IN) { p0_transpose_item(w_in, D, 4 * D, Win_t, 0, 0, norm_mix_a, scr, r, lane); continue; } r -= I_IN;
            if (r < I_SQ) { p0_transpose_item(w_out, D, D, Wout_t, 0, 0, nullptr, scr, r, lane); continue; } r -= I_SQ;
            if (r < I_GU) { p0_transpose_item(w_gu, D, NGU, Wgu0_t, 0, 1, norm_ffn, scr, r, lane); continue; } r -= I_GU;
            if (r < I_GU) { p0_transpose_item(w_gu + (size_t)D * NGU, D, NGU, Wgu1_t, 0, 1, norm_ffn + D, scr, r, lane); continue; } r -= I_GU;
            if (r < I_DN) { p0_transpose_item(w_dn, DFF, D, Wdn0_t, 0, 0, nullptr, scr, r, lane); continue; } r -= I_DN;
            if (r < I_DN) { p0_transpose_item(w_dn + (size_t)DFF * D, DFF, D, Wdn1_t, 0, 0, nullptr, scr, r, lane); continue; } r -= I_DN;
            if (r < I_KV) { p0_transpose_item(w_kv, D, 1024, Wkvq_t, 0, 0, norm_kv, scr, r, lane); continue; } r -= I_KV;
            if (r < I_SQ) { p0_transpose_item(w_q, D, D, Wkvq_t, 1024, 0, norm_mix_b, scr, r, lane); continue; } r -= I_SQ;
            p0_transpose_item(w_o, D, D, Wo_t, 0, 0, nullptr, scr, r, lane);
        }
        for (int m = gw; m < MR; m += NGW) {
            const float* src = (m < SEQ) ? x_p + (size_t)m * D : x_s + (size_t)(m - SEQ) * D;
            const f32x4* xr = (const f32x4*)src + lane; f32x4 v[8]; float s = 0.f;
#pragma unroll
            for (int j = 0; j < 8; ++j) { v[j] = __builtin_nontemporal_load(xr + 64 * j); s += (v[j].x * v[j].x + v[j].y * v[j].y) + (v[j].z * v[j].z + v[j].w * v[j].w); }
            s = wave_sum(s);
            if (lane == 0) ss0[m] = s;
            v2u* o8 = (v2u*)(Hb0 + (size_t)m * D) + lane;
#pragma unroll
            for (int j = 0; j < 8; ++j) { v2u w; w.x = pk2(v[j].x, v[j].y); w.y = pk2(v[j].z, v[j].w); o8[64 * j] = w; }
        }
        __syncthreads();
        kmean_items(lds, cache_k, ptab, Kms, 848, DECB * NBLK, 0, G, TIDX);
    }
    xcd_barrier(bar, IS_T0);
    STAMP();

    {
        TIDS;
        pg8::Gemm g{Hb0, Win_t, SEQ, 4 * D, D}; pg8::StaticOrder S; S.init(SEQ, 4 * D, G, bid);
        EpiIn E{ss0, lbl, Qg, Ff};
        pg8::gemm_phase<EpiIn, pg8::StaticOrder, true, true, false>(lds, g, S, E, TIDX);
        for (int it2 = 0; it2 < 2; ++it2) {
            const int w2 = bid + 256 * it2, t2 = w2 & 255, rh = (w2 >> 8) & 1;
            TIDS; f32x4 ta[2]; tail_gemm<2, D>(lds, Hb0 + (size_t)SEQ * D, Win_t, 32 * t2, rh, ta, TIDX);
            if (wave < 4) { const int row = SEQ + 64 * rh + 16 * wave + fr; E.tail(row, 32 * t2 + 4 * fq, ta[0]); E.tail(row, 32 * t2 + 16 + 4 * fq, ta[1]); }
        }
    }
    xcd_barrier(bar, IS_T0);
    STAMP();

    {
        TIDS;
        LAS float* tot = (LAS float*)(lds);
        LAS float* decs = (LAS float*)(lds + 2048);
        LAS bf16* koT = (LAS bf16*)(lds + 4096);
        LAS bf16* Vr = (LAS bf16*)(lds + 4096 + 128 * 72 * 2);
        const int col = tid & 127, part = tid >> 7; const int vt_t = tid >> 3, vd0 = (tid & 7) * 16;
        f16 fN[16]; v4u vaN, vbN;
#define P2_LOADN(it_) do { const int h_ = (it_) >> 7, r0_ = ((it_) & 127) * 64; const f16* fp_ = Ff + (size_t)(r0_ + part * 16) * D + h_ * 128 + col; \
            _Pragma("unroll") for (int i = 0; i < 16; ++i) fN[i] = fp_[(size_t)i * D]; \
            const bf16* vp_ = Vg + (size_t)(r0_ + vt_t) * D + h_ * 128 + vd0; vaN = *(const v4u*)vp_; vbN = *(const v4u*)(vp_ + 8); } while (0)
        for (int it = bid; it < NH * 16; it += G) {
            const int h = it >> 4, g = it & 15;
            f32x4 S[8];
#pragma unroll
            for (int vt = 0; vt < 8; ++vt) S[vt] = (f32x4){0.f, 0.f, 0.f, 0.f};
            float dtot = 1.0f;
            P2_LOADN(h * 128 + 8 * g);
#pragma unroll 1
            for (int j = 0; j < 8; ++j) {
                const int item = h * 128 + 8 * g + j;
                float cum[16], kk[16]; float run = 0.f;
#pragma unroll
                for (int i = 0; i < 16; ++i) { kk[i] = (float)fN[i]; const float f = 1.0f - kk[i]; run += __logf(f); cum[i] = run; }
                tot[part * 128 + col] = run;
                *(LAS v4u*)(Vr + vt_t * 144 + vd0) = vaN; *(LAS v4u*)(Vr + vt_t * 144 + vd0 + 8) = vbN;
                if (j < 7) P2_LOADN(item + 1);
                __syncthreads();
                float offs = 0.f, lastv = 0.f;
#pragma unroll
                for (int p = 0; p < 4; ++p) { const float tv = tot[p * 128 + col]; lastv += tv; if (p < part) offs += tv; }
                unsigned kw[8];
#pragma unroll
                for (int i = 0; i < 8; ++i) { const float a = kk[2 * i] * __expf(lastv - (cum[2 * i] + offs)), b2 = kk[2 * i + 1] * __expf(lastv - (cum[2 * i + 1] + offs)); kw[i] = pk2(a, b2); }
                *(LAS v4u*)(koT + col * 72 + part * 16) = (v4u){kw[0], kw[1], kw[2], kw[3]};
                *(LAS v4u*)(koT + col * 72 + part * 16 + 8) = (v4u){kw[4], kw[5], kw[6], kw[7]};
                if (part == 0) { const float dc = __expf(lastv); decs[col] = dc; dtot *= dc; }
                __syncthreads();
                { bf16x8 a[2]; a[0] = *(const LAS bf16x8*)(koT + (16 * wave + fr) * 72 + 8 * fq); a[1] = *(const LAS bf16x8*)(koT + (16 * wave + fr) * 72 + 32 + 8 * fq);
                  const f32x4 dv = *(const LAS f32x4*)(decs + 16 * wave + 4 * fq);
                  const LAS bf16* vb = Vr + (8 * fq + (fr >> 2)) * 144 + 4 * (fr & 3);
#pragma unroll
                  for (int vt = 0; vt < 8; ++vt) {
                      f32x4 acc = {0.f, 0.f, 0.f, 0.f};
                      const v2u l0 = tr_read(vb + 16 * vt), h0 = tr_read(vb + 4 * 144 + 16 * vt), l1 = tr_read(vb + 32 * 144 + 16 * vt), h1 = tr_read(vb + 36 * 144 + 16 * vt);
                      const v4u b0 = {l0.x, l0.y, h0.x, h0.y}, b1 = {l1.x, l1.y, h1.x, h1.y};
                      acc = MFMA16(a[0], __builtin_bit_cast(bf16x8, b0), acc); acc = MFMA16(a[1], __builtin_bit_cast(bf16x8, b1), acc);
                      S[vt] = dv * S[vt] + acc;
                  } }
                __syncthreads();
            }
            float* ug = Ug + (size_t)it * 16384;
#pragma unroll
            for (int vt = 0; vt < 8; ++vt) *(f32x4*)(ug + (size_t)(16 * vt + fr) * 128 + 16 * wave + 4 * fq) = S[vt];
            if (part == 0) Dg[(size_t)it * 128 + col] = dtot;
        }
#undef P2_LOADN
        LAS float* red = (LAS float*)(lds);
        LAS float* red2 = (LAS float*)(lds + 8192);
        float* st_out = out + OST_S;
        for (int item = bid; item < DECB * NH; item += G) {
            const int b = item >> 4, h = item & 15; const int vd = tid & 127, kq = tid >> 7;
            const float* sp = st_in + ((size_t)(b * NH + h) * 128 + 32 * kq) * 128 + vd;
            float Sx[32];
#pragma unroll
            for (int i = 0; i < 32; ++i) Sx[i] = __builtin_nontemporal_load(sp + (size_t)i * 128);
#pragma unroll
            for (int t = 0; t < 4; ++t) {
                const int row = SEQ + 4 * b + t; const size_t ro = (size_t)row * D + h * 128;
                const float v = bf2f(Vg[ro + vd]); float op = 0.f;
#pragma unroll
                for (int i = 0; i < 32; ++i) { const float f = 1.0f - (float)Ff[ro + 32 * kq + i]; const float q = bf2f(Qg[ro + 32 * kq + i]); Sx[i] = f * Sx[i] + (1.0f - f) * v; op += Sx[i] * q; }
                red[(t * 4 + kq) * 128 + vd] = op;
            }
            float* so = st_out + ((size_t)(b * NH + h) * 128 + 32 * kq) * 128 + vd;
#pragma unroll
            for (int i = 0; i < 32; ++i) __builtin_nontemporal_store(Sx[i], so + (size_t)i * 128);
            __syncthreads();
            { const int t = tid >> 7; const float o = (red[(t * 4 + 0) * 128 + vd] + red[(t * 4 + 1) * 128 + vd]) + (red[(t * 4 + 2) * 128 + vd] + red[(t * 4 + 3) * 128 + vd]);
              const float s = wave_sum(o * o); if (lane == 0) red2[t * 2 + (wave & 1)] = s;
              __syncthreads();
              const float r = rsqrtf((red2[t * 2] + red2[t * 2 + 1]) * (1.0f / 128.0f) + EPS);
              const int row = SEQ + 4 * b + t; const size_t ro = (size_t)row * D + h * 128 + vd;
              Ob[ro] = (bf16)f2bf(o * r * onorm[vd] * bf2f(Gg[ro])); }
            __syncthreads();
        }
    }
    xcd_barrier(bar, IS_T0);
    STAMP();

    {
        TIDS;
        for (int gid = bid * NTHR + tid; gid < NH * 128 * 32; gid += G * NTHR) {
            const int h = gid >> 12, rem = gid & 4095, vd = rem >> 5, k = (rem & 31) * 4;
            f32x4 sv = {0.f, 0.f, 0.f, 0.f};
#pragma unroll
            for (int g = 0; g < 16; ++g) {
                const size_t idx = ((size_t)(h * 16 + g) * 128 + vd) * 128 + k;
                const f32x4 u = *(const f32x4*)(Ug + idx), d = *(const f32x4*)(Dg + (size_t)(h * 16 + g) * 128 + k);
                *(f32x4*)(Sg0 + idx) = sv;
                sv = d * sv + u;
            }
            float* so = out + OST_P + ((size_t)h * 128 + k) * 128 + vd;
            so[0] = sv[0]; so[128] = sv[1]; so[256] = sv[2]; so[384] = sv[3];
        }
    }
    xcd_barrier(bar, IS_T0);
    STAMP();

    {
        TIDS;
        LAS float* tot = (LAS float*)(lds);
        LAS float* refs = (LAS float*)(lds + 2048);
        LAS float* red = (LAS float*)(lds + 2560);
        LAS float* decs = (LAS float*)(lds + 3072);
        LAS bf16* QE = (LAS bf16*)(lds + 4096);
        LAS bf16* KE = QE + 64 * 136;
        LAS bf16* QI = KE + 64 * 136;
        LAS bf16* Vr = QI + 64 * 136;
        LAS bf16* STs = Vr + 64 * 144;
        LAS bf16* koT = STs + 128 * 136;
        const int col = tid & 127, part = tid >> 7; const int vt_t = tid >> 3, vd0 = (tid & 7) * 16;
        const int tt = wave & 3, vh = wave >> 2;
        f16 fN[16]; bf16 qN[16]; v4u vaN, vbN;
#define P4_LOADN(it_) do { const int h_ = (it_) >> 7, r0_ = ((it_) & 127) * 64; const f16* fp_ = Ff + (size_t)(r0_ + part * 16) * D + h_ * 128 + col; const bf16* qp_ = Qg + (size_t)(r0_ + part * 16) * D + h_ * 128 + col; \
            _Pragma("unroll") for (int i = 0; i < 16; ++i) { fN[i] = fp_[(size_t)i * D]; qN[i] = qp_[(size_t)i * D]; } \
            const bf16* vp_ = Vg + (size_t)(r0_ + vt_t) * D + h_ * 128 + vd0; vaN = *(const v4u*)vp_; vbN = *(const v4u*)(vp_ + 8); } while (0)
        for (int it = bid; it < NH * 16; it += G) {
            const int hh = it >> 4, gg = it & 15;
            f32x4 S[8];
            { const float* sg = Sg0 + (size_t)it * 16384;
#pragma unroll
              for (int vt = 0; vt < 8; ++vt) { S[vt] = *(const f32x4*)(sg + (size_t)(16 * vt + fr) * 128 + 16 * wave + 4 * fq);
                  v2u w; w.x = cvt_pk_bf16(S[vt][0], S[vt][1]); w.y = cvt_pk_bf16(S[vt][2], S[vt][3]); *(LAS v2u*)(STs + (16 * vt + fr) * 136 + 16 * wave + 4 * fq) = w; } }
            P4_LOADN(hh * 128 + 8 * gg);
#pragma unroll 1
            for (int jc = 0; jc < 8; ++jc) {
            const int item = hh * 128 + 8 * gg + jc;
            const int h = item >> 7, c = item & 127; const int row0 = c * 64;
            float cum[16], kk[16], qv[16]; float run = 0.f;
#pragma unroll
            for (int i = 0; i < 16; ++i) { kk[i] = (float)fN[i]; const float f = 1.0f - kk[i]; run += __logf(f); cum[i] = run; qv[i] = bf2f(qN[i]); }
            tot[part * 128 + col] = run;
            *(LAS v4u*)(Vr + vt_t * 144 + vd0) = vaN; *(LAS v4u*)(Vr + vt_t * 144 + vd0 + 8) = vbN;
            const size_t ro = (size_t)(row0 + 16 * tt + fr) * D + h * 128;
            v2u gw2[4]; f32x4 on[4];
#pragma unroll
            for (int vt = 0; vt < 4; ++vt) { const int vd = 16 * (4 * vh + vt) + 4 * fq; gw2[vt] = *(const v2u*)(Gg + ro + vd); on[vt] = *(const f32x4*)(onorm + vd); }
            if (jc < 7) P4_LOADN(item + 1);
            __syncthreads();
            float offs = 0.f, lastv = 0.f;
#pragma unroll
            for (int p = 0; p < 4; ++p) { const float tv = tot[p * 128 + col]; lastv += tv; if (p < part) offs += tv; }
            if (part == 1) refs[col] = cum[15] + offs;
            if (part == 0) decs[col] = __expf(lastv);
            __syncthreads();
            const float ref = refs[col];
#pragma unroll
            for (int i = 0; i < 16; ++i) { const float cm = cum[i] + offs, d1 = cm - ref; const int t = part * 16 + i;
                QE[t * 136 + col] = (bf16)f2bf(qv[i] * __expf(d1)); KE[t * 136 + col] = (bf16)f2bf(kk[i] * __expf(-d1)); QI[t * 136 + col] = (bf16)f2bf(qv[i] * __expf(cm)); }
            { unsigned kw[8];
#pragma unroll
              for (int i = 0; i < 8; ++i) { const float a = kk[2 * i] * __expf(lastv - (cum[2 * i] + offs)), b2 = kk[2 * i + 1] * __expf(lastv - (cum[2 * i + 1] + offs)); kw[i] = pk2(a, b2); }
              *(LAS v4u*)(koT + col * 72 + part * 16) = (v4u){kw[0], kw[1], kw[2], kw[3]};
              *(LAS v4u*)(koT + col * 72 + part * 16 + 8) = (v4u){kw[4], kw[5], kw[6], kw[7]}; }
            __syncthreads();
            {
                f32x4 aS[4];
#pragma unroll
                for (int st = 0; st < 4; ++st) {
                    aS[st] = (f32x4){0.f, 0.f, 0.f, 0.f};
                    if (st <= tt) {
#pragma unroll
                        for (int ks = 0; ks < 4; ++ks) { const bf16x8 a = *(const LAS bf16x8*)(KE + (16 * st + fr) * 136 + 32 * ks + 8 * fq), b = *(const LAS bf16x8*)(QE + (16 * tt + fr) * 136 + 32 * ks + 8 * fq); aS[st] = MFMA16(a, b, aS[st]); }
                        if (st == tt) {
#pragma unroll
                            for (int r = 0; r < 4; ++r) if (4 * fq + r > fr) aS[st][r] = 0.f;
                        }
                    }
                }
                f32x4 o[4];
#pragma unroll
                for (int vt = 0; vt < 4; ++vt) o[vt] = (f32x4){0.f, 0.f, 0.f, 0.f};
#pragma unroll
                for (int j = 0; j < 2; ++j) {
                    v4u pw; pw.x = cvt_pk_bf16(aS[2 * j][0], aS[2 * j][1]); pw.y = cvt_pk_bf16(aS[2 * j][2], aS[2 * j][3]); pw.z = cvt_pk_bf16(aS[2 * j + 1][0], aS[2 * j + 1][1]); pw.w = cvt_pk_bf16(aS[2 * j + 1][2], aS[2 * j + 1][3]);
                    const bf16x8 pf = __builtin_bit_cast(bf16x8, pw);
                    const LAS bf16* vb = Vr + (32 * j + 4 * fq + (fr >> 2)) * 144 + 64 * vh + 4 * (fr & 3);
#pragma unroll
                    for (int vt = 0; vt < 4; ++vt) { const v2u lo = tr_read(vb + 16 * vt), hi = tr_read(vb + 16 * 144 + 16 * vt); const v4u aw = {lo.x, lo.y, hi.x, hi.y};
                        o[vt] = MFMA16(__builtin_bit_cast(bf16x8, aw), pf, o[vt]); }
                }
#pragma unroll
                for (int ks = 0; ks < 4; ++ks) { const bf16x8 b = *(const LAS bf16x8*)(QI + (16 * tt + fr) * 136 + 32 * ks + 8 * fq);
#pragma unroll
                    for (int vt = 0; vt < 4; ++vt) { const bf16x8 a = *(const LAS bf16x8*)(STs + (16 * (4 * vh + vt) + fr) * 136 + 32 * ks + 8 * fq); o[vt] = MFMA16(a, b, o[vt]); } }
                float sq = 0.f;
#pragma unroll
                for (int vt = 0; vt < 4; ++vt) sq += (o[vt][0] * o[vt][0] + o[vt][1] * o[vt][1]) + (o[vt][2] * o[vt][2] + o[vt][3] * o[vt][3]);
                sq += shx<16>(sq); sq = xadd32(sq);
                if (fq == 0) red[(16 * tt + fr) * 2 + vh] = sq;
                __syncthreads();
                const float r = rsqrtf((red[(16 * tt + fr) * 2] + red[(16 * tt + fr) * 2 + 1]) * (1.0f / 128.0f) + EPS);
#pragma unroll
                for (int vt = 0; vt < 4; ++vt) { const int vd = 16 * (4 * vh + vt) + 4 * fq;
                    const float g0 = bf2f(gw2[vt].x & 0xffffu), g1 = bf2f(gw2[vt].x >> 16), g2 = bf2f(gw2[vt].y & 0xffffu), g3 = bf2f(gw2[vt].y >> 16);
                    v2u w; w.x = cvt_pk_bf16(o[vt][0] * r * on[vt][0] * g0, o[vt][1] * r * on[vt][1] * g1); w.y = cvt_pk_bf16(o[vt][2] * r * on[vt][2] * g2, o[vt][3] * r * on[vt][3] * g3);
                    *(v2u*)(Ob + ro + vd) = w; }
            }
            if (jc < 7) {
                bf16x8 a[2]; a[0] = *(const LAS bf16x8*)(koT + (16 * wave + fr) * 72 + 8 * fq); a[1] = *(const LAS bf16x8*)(koT + (16 * wave + fr) * 72 + 32 + 8 * fq);
                const f32x4 dv = *(const LAS f32x4*)(decs + 16 * wave + 4 * fq);
                const LAS bf16* vb = Vr + (8 * fq + (fr >> 2)) * 144 + 4 * (fr & 3);
#pragma unroll
                for (int vt = 0; vt < 8; ++vt) {
                    f32x4 acc = {0.f, 0.f, 0.f, 0.f};
                    const v2u l0 = tr_read(vb + 16 * vt), h0 = tr_read(vb + 4 * 144 + 16 * vt), l1 = tr_read(vb + 32 * 144 + 16 * vt), h1 = tr_read(vb + 36 * 144 + 16 * vt);
                    const v4u b0 = {l0.x, l0.y, h0.x, h0.y}, b1 = {l1.x, l1.y, h1.x, h1.y};
                    acc = MFMA16(a[0], __builtin_bit_cast(bf16x8, b0), acc); acc = MFMA16(a[1], __builtin_bit_cast(bf16x8, b1), acc);
                    S[vt] = dv * S[vt] + acc;
                    v2u w; w.x = cvt_pk_bf16(S[vt][0], S[vt][1]); w.y = cvt_pk_bf16(S[vt][2], S[vt][3]); *(LAS v2u*)(STs + (16 * vt + fr) * 136 + 16 * wave + 4 * fq) = w;
                }
            }
            __syncthreads();
            }
        }
#undef P4_LOADN
    }
    xcd_barrier(bar, IS_T0);
    STAMP();

    {
        TIDS;
        pg8::Gemm g{Ob, Wout_t, SEQ, D, D}; pg8::StaticOrder S; S.init(SEQ, D, G, bid);
        EpiRes<1> E{Hb0, nullptr, nullptr, Hb1, ss1};
        const unsigned tg0 = TNOW();
        pg8::gemm_phase<EpiRes<1>, pg8::StaticOrder, true, true, false>(lds, g, S, E, TIDX);
        TACC(5, tg0); const unsigned tg1 = TNOW();
        { const int t2 = bid & 127, rh = (bid >> 7) & 1; TIDS; f32x4 ta[1]; tail_gemm<1, D>(lds, Ob + (size_t)SEQ * D, Wout_t, 16 * t2, rh, ta, TIDX); if (wave < 4) E.tail(SEQ + 64 * rh + 16 * wave + fr, 16 * t2 + 4 * fq, ta[0], fq); }
        TACC(6, tg1);
    }
    xcd_barrier(bar, IS_T0);
    STAMP();
    {
        TIDS;
        pg8::Gemm g{Hb1, Wgu0_t, MP, NGU, D}; pg8::StaticOrder S; S.init(MP, NGU, G, bid);
        EpiGU E{ss1, Hm};
        pg8::gemm_phase<EpiGU, pg8::StaticOrder, true, true>(lds, g, S, E, TIDX);
        kmean_items(lds, cache_k, ptab, Kms, 0, 336, 172, G - 172, TIDX);
    }
    xcd_barrier(bar, IS_T0);
    STAMP();
    {
        TIDS;
        pg8::Gemm g{Hm, Wdn0_t, SEQ, D, DFF}; pg8::StaticOrder S; S.init(SEQ, D, G, bid);
        EpiRes<1> E{Hb1, nullptr, nullptr, Hb2, ss2};
        const unsigned tg0 = TNOW();
        pg8::gemm_phase<EpiRes<1>, pg8::StaticOrder, true, true, false>(lds, g, S, E, TIDX);
        TACC(7, tg0); const unsigned tg1 = TNOW();
        { const int t2 = bid & 127, rh = (bid >> 7) & 1; TIDS; f32x4 ta[1]; tail_gemm<1, DFF>(lds, Hm + (size_t)SEQ * DFF, Wdn0_t, 16 * t2, rh, ta, TIDX); if (wave < 4) E.tail(SEQ + 64 * rh + 16 * wave + fr, 16 * t2 + 4 * fq, ta[0], fq); }
        TACC(8, tg1);
    }
    xcd_barrier(bar, IS_T0);
    STAMP();
    {
        TIDS;
        pg8::Gemm g{Hb2, Wkvq_t, MP, 3072, D}; pg8::StaticOrder S; S.init(MP, 3072, G, bid);
        EpiKVQ E{ss2, ws, out, k_norm, q_norm, lds + 131072};
        pg8::gemm_phase<EpiKVQ, pg8::StaticOrder, true, true>(lds, g, S, E, TIDX);
        kmean_items(lds, cache_k, ptab, Kms, 336, 848, 140, G - 140, TIDX);
    }
    xcd_barrier(bar, IS_T0);
    STAMP();

    {
        TIDS;
        LAS bf16* KMb = (LAS bf16*)(lds);
        LAS unsigned* lcnt = (LAS unsigned*)(lds + 16384);
        LAS float* gs = (LAS float*)(lds + 16384 + 256);
#define G_BETTER(va, ia, vb, ib) (((va) > (vb)) || (((va) == (vb)) && ((ia) < (ib))))
#define G_INSERT(vx, ix) do { const float vx_ = (vx); const int ix_ = (ix); \
            if (G_BETTER(vx_, ix_, v0, i0)) { v2 = v1; i2 = i1; v1 = v0; i1 = i0; v0 = vx_; i0 = ix_; } \
            else if (G_BETTER(vx_, ix_, v1, i1)) { v2 = v1; i2 = i1; v1 = vx_; i1 = ix_; } \
            else if (G_BETTER(vx_, ix_, v2, i2)) { v2 = vx_; i2 = ix_; } } while (0)
        for (int item = bid; item < 256; item += G) {
            const int j = item >> 2, kvh = item & 3; const int b = j >> 1;
            { const int n = tid >> 4, d8 = (tid & 15) * 8; f32x4 s0 = {0.f, 0.f, 0.f, 0.f}, s1 = {0.f, 0.f, 0.f, 0.f};
              if (n < b) { const float* kp = Kpart + (size_t)n * 512 + kvh * 128 + d8; s0 = *(const f32x4*)kp; s1 = *(const f32x4*)(kp + 4); }
              s0 = s0 * (1.0f / 256.0f); s1 = s1 * (1.0f / 256.0f);
              v4u w; w.x = cvt_pk_bf16(s0[0], s0[1]); w.y = cvt_pk_bf16(s0[2], s0[3]); w.z = cvt_pk_bf16(s1[0], s1[1]); w.w = cvt_pk_bf16(s1[2], s1[3]);
              *(LAS v4u*)(KMb + n * 136 + d8) = w; }
            if (tid < 32) lcnt[tid] = 0u;
            __syncthreads();
            const int nsel = b < 3 ? b : 3;
#pragma unroll 1
            for (int rt = 0; rt < 4; ++rt) {
                const int r = 64 * wave + 16 * rt + fr; const int tok = j * 128 + (r >> 2), hg = r & 3; const bf16* qp = Qb + (size_t)tok * D + (4 * kvh + hg) * 128 + 8 * fq;
                bf16x8 qf[4];
#pragma unroll
                for (int ks = 0; ks < 4; ++ks) qf[ks] = *(const bf16x8*)(qp + 32 * ks);
                f32x4 ga[2];
#pragma unroll
                for (int nt = 0; nt < 2; ++nt) { ga[nt] = (f32x4){0.f, 0.f, 0.f, 0.f};
#pragma unroll
                    for (int ks = 0; ks < 4; ++ks) { const bf16x8 ka = *(const LAS bf16x8*)(KMb + (16 * nt + fr) * 136 + 32 * ks + 8 * fq); ga[nt] = MFMA16(ka, qf[ks], ga[nt]); } }
                float v0 = -INFINITY, v1 = -INFINITY, v2 = -INFINITY; int i0 = 99, i1 = 99, i2 = 99;
#pragma unroll
                for (int nt = 0; nt < 2; ++nt)
#pragma unroll
                    for (int q = 0; q < 4; ++q) { const int n = 16 * nt + 4 * fq + q; if (n < b) G_INSERT(ga[nt][q], n); }
                { const float a0 = shx<16>(v0), a1 = shx<16>(v1), a2 = shx<16>(v2);
                  const int c0 = __builtin_amdgcn_ds_swizzle(i0, (16 << 10) | 0x1f), c1 = __builtin_amdgcn_ds_swizzle(i1, (16 << 10) | 0x1f), c2 = __builtin_amdgcn_ds_swizzle(i2, (16 << 10) | 0x1f);
                  G_INSERT(a0, c0); G_INSERT(a1, c1); G_INSERT(a2, c2); }
                {
                  auto p0 = __builtin_amdgcn_permlane32_swap(__float_as_uint(v0), __float_as_uint(v0), false, false); auto p1 = __builtin_amdgcn_permlane32_swap(__float_as_uint(v1), __float_as_uint(v1), false, false);
                  auto p2 = __builtin_amdgcn_permlane32_swap(__float_as_uint(v2), __float_as_uint(v2), false, false);
                  auto q0 = __builtin_amdgcn_permlane32_swap((unsigned)i0, (unsigned)i0, false, false); auto q1 = __builtin_amdgcn_permlane32_swap((unsigned)i1, (unsigned)i1, false, false);
                  auto q2 = __builtin_amdgcn_permlane32_swap((unsigned)i2, (unsigned)i2, false, false);
                  v0 = __uint_as_float(p0[0]); v1 = __uint_as_float(p1[0]); v2 = __uint_as_float(p2[0]); i0 = (int)q0[0]; i1 = (int)q1[0]; i2 = (int)q2[0];
                  G_INSERT(__uint_as_float(p0[1]), (int)q0[1]); G_INSERT(__uint_as_float(p1[1]), (int)q1[1]); G_INSERT(__uint_as_float(p2[1]), (int)q2[1]); }
                if (fq == 0) {
#pragma unroll
                    for (int rk = 0; rk < 3; ++rk) {
                        if (rk < nsel) { const int best = (rk == 0) ? i0 : ((rk == 1) ? i1 : i2);
                            const unsigned pos = atomicAdd((unsigned*)&lcnt[best], 1u);
                            Subl[((size_t)(j * 4 + kvh) * 32 + best) * 512 + pos] = (unsigned)r | ((unsigned)rk << 9); }
                    }
                }
            }
            __syncthreads();
            if (tid < 32) Scnt[(j * 4 + kvh) * 32 + tid] = lcnt[tid];
            __syncthreads();
        }
#undef G_BETTER
#undef G_INSERT
        for (int item = bid; item < DECB * NKV; item += G) {
            const int b = item >> 2, kvh = item & 3; const int pr = tid >> 5, n = tid & 31;
            const int row = SEQ + 4 * b + (pr >> 2), hg = pr & 3; const bf16* qp = Qb + (size_t)row * D + (4 * kvh + hg) * 128; const float* kmp = Kms + ((size_t)(b * 32 + n)) * 512 + kvh * 128;
            float s = 0.f;
#pragma unroll 4
            for (int d = 0; d < 128; d += 8) { const v4u qw = *(const v4u*)(qp + d); const f32x4 k0 = *(const f32x4*)(kmp + d), k1 = *(const f32x4*)(kmp + d + 4);
                s += (bf2f(qw.x & 0xffffu) * k0[0] + bf2f(qw.x >> 16) * k0[1]) + (bf2f(qw.y & 0xffffu) * k0[2] + bf2f(qw.y >> 16) * k0[3]) + (bf2f(qw.z & 0xffffu) * k1[0] + bf2f(qw.z >> 16) * k1[1]) + (bf2f(qw.w & 0xffffu) * k1[2] + bf2f(qw.w >> 16) * k1[3]); }
            gs[pr * 32 + n] = s;
            __syncthreads();
            if (tid < 16) { unsigned m = 0u;
                for (int r = 0; r < 3; ++r) { int best = 0; float bv = -INFINITY; for (int nn = 0; nn < 32; ++nn) { const float v = gs[tid * 32 + nn]; if (v > bv) { bv = v; best = nn; } } m |= 1u << best; gs[tid * 32 + best] = -INFINITY; }
                Sels[item * 16 + tid] = m; }
            __syncthreads();
        }
    }
    xcd_barrier(bar, IS_T0);
    STAMP();

    {
        LAS bf16* Ks = (LAS bf16*)(lds); LAS bf16* Vs = (LAS bf16*)(lds + KS_BYTES);
        LAS unsigned* qsh = (LAS unsigned*)(lds + 2 * KS_BYTES);
        constexpr int NPI = 4 * 496, NSI = DECB * NKV * NBLK;
        for (;;) {
            const unsigned tq0 = TNOW();
            if (IS_T0) qsh[0] = __hip_atomic_fetch_add(ctl + CW_Q0, 1u, __ATOMIC_RELAXED, __HIP_MEMORY_SCOPE_AGENT);
            __syncthreads();
            const int tick = (int)qsh[0];
            __syncthreads();
            TACC(0, tq0);
            if (tick >= NPI + NSI) break;
            TIDS;
            int item; { const int g3 = tick / 3, r3 = tick - 3 * g3; item = (tick < 3 * NPI) ? ((r3 == 0) ? g3 : NPI + 2 * g3 + (r3 - 1)) : NPI + (tick - NPI); }
            if (item < NPI) {
                int b = (int)((1.0f + sqrtf(1.0f + 2.0f * (float)item)) * 0.5f); while (2 * b * (b - 1) > item) --b; while (2 * (b + 1) * b <= item) ++b;
                const int rem = item - 2 * b * (b - 1); const int n = rem >> 2, kvh = rem & 3;
                const int cntA = (int)Scnt[((2 * b) * 4 + kvh) * 32 + n], cntB = (int)Scnt[((2 * b + 1) * 4 + kvh) * 32 + n]; const int total = cntA + cntB;
                if (total == 0) continue;
                const unsigned tp0 = TNOW();
#pragma unroll
                for (int i = 0; i < 8; ++i) { const int idx = i * 512 + tid, key = idx >> 4, c8 = idx & 15; *(LAS v4u*)(Ks + key * KS_P + c8 * 8) = *(const v4u*)(Kb + (size_t)(256 * n + key) * 512 + kvh * 128 + c8 * 8); }
#pragma unroll
                for (int i = 0; i < 8; ++i) { const int idx = i * 512 + tid, key = idx >> 4, c8 = idx & 15; *(LAS v4u*)(Vs + key * KS_P + c8 * 8) = *(const v4u*)(Vb + (size_t)(256 * n + key) * 512 + kvh * 128 + c8 * 8); }
                __syncthreads();
                TACC(1, tp0); const unsigned tp1 = TNOW();
                const unsigned* LA = Subl + ((size_t)((2 * b) * 4 + kvh) * 32 + n) * 512; const unsigned* LB = Subl + ((size_t)((2 * b + 1) * 4 + kvh) * 32 + n) * 512;
#define LIST_ENT(i_) (((i_) < cntA) ? LA[(i_)] : LB[(i_) - cntA])
                const int iw = 16 * wave + fr;
                unsigned e1 = 0u, e2 = 0u; int ic1 = 0, ic2 = 0;
                if (16 * wave < total) { ic1 = iw < total ? iw : total - 1; e1 = LIST_ENT(ic1); }
                if (16 * wave + 128 < total) { ic2 = iw + 128 < total ? iw + 128 : total - 1; e2 = LIST_ENT(ic2); }
                bf16x8 qn[4];
                { const int tokn = ((ic1 < cntA) ? 2 * b : 2 * b + 1) * 128 + (int)((e1 >> 2) & 127u); const bf16* qp = Qb + (size_t)tokn * D + (4 * kvh + (int)(e1 & 3u)) * 128 + 8 * fq;
#pragma unroll
                  for (int ks = 0; ks < 4; ++ks) qn[ks] = *(const bf16x8*)(qp + 32 * ks); }
                for (int t0 = 0; t0 < total; t0 += 128) {
                    const int i0 = t0 + 16 * wave; if (i0 >= total) break;
                    const bool valid = (i0 + fr) < total; const int ic = ic1; const unsigned e = e1;
                    const int tok = ((ic < cntA) ? 2 * b : 2 * b + 1) * 128 + (int)((e >> 2) & 127u), hg = (int)(e & 3u), rk = (int)(e >> 9);
                    const int h = 4 * kvh + hg;
                    bf16x8 qf[4];
#pragma unroll
                    for (int ks = 0; ks < 4; ++ks) qf[ks] = qn[ks];
                    e1 = e2; ic1 = ic2;
                    if (i0 + 256 < total) { ic2 = (i0 + 256 + fr) < total ? (i0 + 256 + fr) : total - 1; e2 = LIST_ENT(ic2); }
                    if (i0 + 128 < total) { const int tokn = ((ic1 < cntA) ? 2 * b : 2 * b + 1) * 128 + (int)((e1 >> 2) & 127u); const bf16* qp = Qb + (size_t)tokn * D + (4 * kvh + (int)(e1 & 3u)) * 128 + 8 * fq;
#pragma unroll
                        for (int ks = 0; ks < 4; ++ks) qn[ks] = *(const bf16x8*)(qp + 32 * ks); }
                    f32x4 acc[16]; attn_scores<16>(Ks, qf, acc, 16, fr, fq);
                    float mx = -INFINITY;
#pragma unroll
                    for (int kt = 0; kt < 16; ++kt) mx = fmaxf(fmaxf(mx, fmaxf(acc[kt][0], acc[kt][1])), fmaxf(acc[kt][2], acc[kt][3]));
                    mx = fmaxf(mx, shx<16>(mx)); mx = xmax32(mx);
                    float l = 0.f;
#pragma unroll
                    for (int kt = 0; kt < 16; ++kt) {
#pragma unroll
                        for (int r = 0; r < 4; ++r) { const float p = __builtin_amdgcn_exp2f(acc[kt][r] - mx); acc[kt][r] = p; l += p; } }
                    l += shx<16>(l); l = xadd32(l);
                    f32x4 O[8];
#pragma unroll
                    for (int vt = 0; vt < 8; ++vt) O[vt] = (f32x4){0.f, 0.f, 0.f, 0.f};
                    attn_pv(Vs, acc, O, 8, fr, fq);
                    if (valid) {
                        const size_t slot = ((size_t)tok * NH + h) * 3 + rk; bf16* op = Oslot + slot * 128 + 4 * fq;
#pragma unroll
                        for (int vt = 0; vt < 8; ++vt) { v2u w; w.x = cvt_pk_bf16(O[vt][0], O[vt][1]); w.y = cvt_pk_bf16(O[vt][2], O[vt][3]); *(v2u*)(op + 16 * vt) = w; }
                        if (fq == 0) { MLslot[slot * 2] = mx; MLslot[slot * 2 + 1] = l; }
                    }
                }
                __syncthreads();
                TACC(2, tp1);
            } else {
                const int si = item - NPI; const int b = si >> 7, kvh = (si >> 5) & 3, n = si & 31;
                unsigned any = 0u;
#pragma unroll
                for (int p = 0; p < 16; ++p) any |= Sels[(b * 4 + kvh) * 16 + p];
                if (!((any >> n) & 1u)) continue;
                const unsigned ts0 = TNOW();
                const int pg0 = ptab[b * NPAGES + 2 * n], pg1 = ptab[b * NPAGES + 2 * n + 1];
                f32x4 kst[16], vst[16];
#pragma unroll
                for (int i = 0; i < 16; ++i) { const int idx = i * 512 + tid, key = idx >> 5, c4 = idx & 31; const int page = (key < 128) ? pg0 : pg1;
                    const size_t go = (((size_t)page * PAGE + (key & 127)) * NKV + kvh) * 128 + c4 * 4;
                    kst[i] = __builtin_nontemporal_load((const f32x4*)(cache_k + go)); vst[i] = __builtin_nontemporal_load((const f32x4*)(cache_v + go)); }
#pragma unroll
                for (int i = 0; i < 16; ++i) { const int idx = i * 512 + tid, key = idx >> 5, c4 = idx & 31; const int page = (key < 128) ? pg0 : pg1; (void)page;
                    const f32x4 kk4 = kst[i], vv4 = vst[i];
                    v2u w; w.x = cvt_pk_bf16(kk4[0], kk4[1]); w.y = cvt_pk_bf16(kk4[2], kk4[3]); *(LAS v2u*)(Ks + key * KS_P + c4 * 4) = w;
                    v2u wv; wv.x = cvt_pk_bf16(vv4[0], vv4[1]); wv.y = cvt_pk_bf16(vv4[2], vv4[3]); *(LAS v2u*)(Vs + key * KS_P + c4 * 4) = wv; }
                __syncthreads();
                TACC(3, ts0); const unsigned ts1 = TNOW();
                {
                    LAS float* mxs = (LAS float*)(lds + 2 * KS_BYTES + 64); LAS float* lss = mxs + 128; LAS float* Ored = (LAS float*)(lds);
                    const int row = SEQ + 4 * b + (fr >> 2), hg = fr & 3; const int h = 4 * kvh + hg; const bf16* qp = Qb + (size_t)row * D + h * 128 + 8 * fq;
                    bf16x8 qf[4];
#pragma unroll
                    for (int ks = 0; ks < 4; ++ks) qf[ks] = *(const bf16x8*)(qp + 32 * ks);
                    f32x4 a2[2];
#pragma unroll
                    for (int t = 0; t < 2; ++t) { a2[t] = (f32x4){0.f, 0.f, 0.f, 0.f};
#pragma unroll
                        for (int ks = 0; ks < 4; ++ks) { const bf16x8 ka = *(const LAS bf16x8*)(Ks + (16 * (2 * wave + t) + fr) * KS_P + 32 * ks + 8 * fq); a2[t] = MFMA16(ka, qf[ks], a2[t]); } }
                    float mx = fmaxf(fmaxf(fmaxf(a2[0][0], a2[0][1]), fmaxf(a2[0][2], a2[0][3])), fmaxf(fmaxf(a2[1][0], a2[1][1]), fmaxf(a2[1][2], a2[1][3])));
                    mx = fmaxf(mx, shx<16>(mx)); mx = xmax32(mx);
                    if (fq == 0) mxs[wave * 16 + fr] = mx;
                    __syncthreads();
                    float M = mxs[fr];
#pragma unroll
                    for (int w8 = 1; w8 < 8; ++w8) M = fmaxf(M, mxs[w8 * 16 + fr]);
                    float l = 0.f;
#pragma unroll
                    for (int t = 0; t < 2; ++t) {
#pragma unroll
                        for (int r = 0; r < 4; ++r) { const float p = __builtin_amdgcn_exp2f(a2[t][r] - M); a2[t][r] = p; l += p; } }
                    l += shx<16>(l); l = xadd32(l);
                    if (fq == 0) lss[wave * 16 + fr] = l;
                    v4u pw; pw.x = cvt_pk_bf16(a2[0][0], a2[0][1]); pw.y = cvt_pk_bf16(a2[0][2], a2[0][3]); pw.z = cvt_pk_bf16(a2[1][0], a2[1][1]); pw.w = cvt_pk_bf16(a2[1][2], a2[1][3]);
                    const bf16x8 pf = __builtin_bit_cast(bf16x8, pw);
                    const LAS bf16* vb = Vs + (32 * wave + 4 * fq + (fr >> 2)) * KS_P + 4 * (fr & 3);
#pragma unroll
                    for (int vt = 0; vt < 8; ++vt) { const v2u lo = tr_read(vb + 16 * vt), hi = tr_read(vb + 16 * KS_P + 16 * vt); const v4u aw = {lo.x, lo.y, hi.x, hi.y};
                        const f32x4 o = MFMA16(__builtin_bit_cast(bf16x8, aw), pf, ((f32x4){0.f, 0.f, 0.f, 0.f}));
                        *(LAS f32x4*)(Ored + (wave * 16 + fr) * 132 + 16 * vt + 4 * fq) = o; }
                    __syncthreads();
                    { const int r16 = tid >> 5, c4 = tid & 31; f32x4 so = *(const LAS f32x4*)(Ored + r16 * 132 + 4 * c4);
#pragma unroll
                      for (int w8 = 1; w8 < 8; ++w8) so += *(const LAS f32x4*)(Ored + (w8 * 16 + r16) * 132 + 4 * c4);
                      float* sp = Sslot + ((size_t)((b * 4 + kvh) * 32 + n) * 16 + r16) * 132;
                      *(f32x4*)(sp + 4 * c4) = so;
                      if (c4 == 0) { float Mr = mxs[r16], lt = lss[r16];
#pragma unroll
                          for (int w8 = 1; w8 < 8; ++w8) { Mr = fmaxf(Mr, mxs[w8 * 16 + r16]); lt += lss[w8 * 16 + r16]; }
                          sp[128] = Mr; sp[129] = lt; } }
                }
                __syncthreads();
                TACC(4, ts1);
            }
        }
    }
    xcd_barrier(bar, IS_T0);
    STAMP();

    {
        TIDS;
        LAS bf16* Ks = (LAS bf16*)(lds); LAS bf16* Vs = (LAS bf16*)(lds + KS_BYTES);
        for (int item = bid; item < NBLK * NKV * 2; item += G) {
            const int b = item >> 3, kvh = (item >> 1) & 3, hp = item & 1;
#pragma unroll
            for (int i = 0; i < 8; ++i) { const int idx = i * 512 + tid, key = idx >> 4, c8 = idx & 15; *(LAS v4u*)(Ks + key * KS_P + c8 * 8) = *(const v4u*)(Kb + (size_t)(256 * b + key) * 512 + kvh * 128 + c8 * 8); }
#pragma unroll
            for (int i = 0; i < 8; ++i) { const int idx = i * 512 + tid, key = idx >> 4, c8 = idx & 15; *(LAS v4u*)(Vs + key * KS_P + c8 * 8) = *(const v4u*)(Vb + (size_t)(256 * b + key) * 512 + kvh * 128 + c8 * 8); }
            const int nsel = b < 3 ? b : 3;
            bf16x8 qn[4];
            { const bf16* qp = Qb + (size_t)(256 * b + 16 * wave + fr) * D + (4 * kvh + 2 * hp) * 128 + 8 * fq;
#pragma unroll
              for (int ks = 0; ks < 4; ++ks) qn[ks] = *(const bf16x8*)(qp + 32 * ks); }
            __syncthreads();
#pragma unroll 1
            for (int u = 0; u < 4; ++u) {
                const int g = (u & 1) ? 15 - wave : wave, h = 4 * kvh + 2 * hp + (u >> 1); const int tl = 16 * g + fr; const int tok = 256 * b + tl;
                bf16x8 qf[4];
#pragma unroll
                for (int ks = 0; ks < 4; ++ks) qf[ks] = qn[ks];
                if (u < 3) { const int gn = ((u + 1) & 1) ? 15 - wave : wave, hn = 4 * kvh + 2 * hp + ((u + 1) >> 1); const bf16* qp = Qb + (size_t)(256 * b + 16 * gn + fr) * D + hn * 128 + 8 * fq;
#pragma unroll
                    for (int ks = 0; ks < 4; ++ks) qn[ks] = *(const bf16x8*)(qp + 32 * ks); }
                float msa[3], lsa[3];
#pragma unroll
                for (int r = 0; r < 3; ++r) { msa[r] = -INFINITY; lsa[r] = 0.f; if (r < nsel) { const size_t slot = ((size_t)tok * NH + h) * 3 + r; msa[r] = MLslot[slot * 2]; lsa[r] = MLslot[slot * 2 + 1]; } }
                const int nkt = g + 1;
                f32x4 acc[16]; attn_scores<16>(Ks, qf, acc, nkt, fr, fq);
                float mx = -INFINITY;
#pragma unroll
                for (int kt = 0; kt < 16; ++kt) {
#pragma unroll
                    for (int r = 0; r < 4; ++r) { const bool ok = (kt < nkt) && (16 * kt + 4 * fq + r <= tl); const float sv = ok ? acc[kt][r] : -INFINITY; acc[kt][r] = sv; mx = fmaxf(mx, sv); } }
                mx = fmaxf(mx, shx<16>(mx)); mx = xmax32(mx);
                float M = mx;
#pragma unroll
                for (int r = 0; r < 3; ++r) M = fmaxf(M, msa[r]);
                float l = 0.f;
#pragma unroll
                for (int kt = 0; kt < 16; ++kt) {
#pragma unroll
                    for (int r = 0; r < 4; ++r) { const float p = __builtin_amdgcn_exp2f(acc[kt][r] - M); acc[kt][r] = p; l += p; } }
                l += shx<16>(l); l = xadd32(l);
                f32x4 O[8];
#pragma unroll
                for (int vt = 0; vt < 8; ++vt) O[vt] = (f32x4){0.f, 0.f, 0.f, 0.f};
                attn_pv(Vs, acc, O, (nkt + 1) >> 1, fr, fq);
#pragma unroll
                for (int r = 0; r < 3; ++r) { if (r < nsel) { const float sc = __builtin_amdgcn_exp2f(msa[r] - M); l += lsa[r] * sc; const size_t slot = ((size_t)tok * NH + h) * 3 + r; const bf16* op = Oslot + slot * 128 + 4 * fq;
#pragma unroll
                    for (int vt = 0; vt < 8; ++vt) { const v2u w = *(const v2u*)(op + 16 * vt); O[vt][0] += bf2f(w.x & 0xffffu) * sc; O[vt][1] += bf2f(w.x >> 16) * sc; O[vt][2] += bf2f(w.y & 0xffffu) * sc; O[vt][3] += bf2f(w.y >> 16) * sc; } } }
                const float il = 1.0f / l; bf16* ap = At + (size_t)tok * D + h * 128 + 4 * fq;
#pragma unroll
                for (int vt = 0; vt < 8; ++vt) { v2u w; w.x = cvt_pk_bf16(O[vt][0] * il, O[vt][1] * il); w.y = cvt_pk_bf16(O[vt][2] * il, O[vt][3] * il); *(v2u*)(ap + 16 * vt) = w; }
            }
            __syncthreads();
        }
        LAS float* ksn = (LAS float*)(lds);
        for (int item = bid; item < DECB * NKV; item += G) {
            const int b = item >> 2, kvh = item & 3;
            { const int key = tid >> 7, d = tid & 127; ksn[key * 128 + d] = out[OK_S + (size_t)(4 * b + key) * 512 + kvh * 128 + d]; ksn[512 + key * 128 + d] = out[OV_S + (size_t)(4 * b + key) * 512 + kvh * 128 + d]; }
            __syncthreads();
            const int pr = tid >> 5, l32 = tid & 31; const int t = pr >> 2, hg = pr & 3; const int row = SEQ + 4 * b + t, h = 4 * kvh + hg;
            const v2u qw = *(const v2u*)(Qb + (size_t)row * D + h * 128 + 4 * l32);
            const float q0 = bf2f(qw.x & 0xffffu), q1 = bf2f(qw.x >> 16), q2 = bf2f(qw.y & 0xffffu), q3 = bf2f(qw.y >> 16);
            float sk[4]; float M = -INFINITY;
#pragma unroll
            for (int key = 0; key < 4; ++key) { const f32x4 k4 = *(const LAS f32x4*)(ksn + key * 128 + 4 * l32); float s = (q0 * k4[0] + q1 * k4[1]) + (q2 * k4[2] + q3 * k4[3]);
                s += shx<1>(s); s += shx<2>(s); s += shx<4>(s); s += shx<8>(s); s += shx<16>(s);
                sk[key] = (key <= t) ? s : -INFINITY; M = fmaxf(M, sk[key]); }
            const unsigned mask = Sels[item * 16 + pr];
#pragma unroll 1
            for (int n = 0; n < 32; ++n) if ((mask >> n) & 1u) M = fmaxf(M, Sslot[((size_t)(item * 32 + n) * 16 + pr) * 132 + 128]);
            float l = 0.f; f32x4 O = {0.f, 0.f, 0.f, 0.f};
#pragma unroll
            for (int key = 0; key < 4; ++key) { const float p = __builtin_amdgcn_exp2f(sk[key] - M); l += p; O += *(const LAS f32x4*)(ksn + 512 + key * 128 + 4 * l32) * p; }
#pragma unroll 1
            for (int n = 0; n < 32; ++n) if ((mask >> n) & 1u) { const float* sp = Sslot + ((size_t)(item * 32 + n) * 16 + pr) * 132; const float sc = __builtin_amdgcn_exp2f(sp[128] - M); l += sp[129] * sc; O += *(const f32x4*)(sp + 4 * l32) * sc; }
            const float il = 1.0f / l; v2u w; w.x = cvt_pk_bf16(O[0] * il, O[1] * il); w.y = cvt_pk_bf16(O[2] * il, O[3] * il);
            *(v2u*)(At + (size_t)row * D + h * 128 + 4 * l32) = w;
            __syncthreads();
        }
    }
    xcd_barrier(bar, IS_T0);
    STAMP();

    {
        TIDS;
        pg8::Gemm g{At, Wo_t, SEQ, D, D}; pg8::StaticOrder S; S.init(SEQ, D, G, bid);
        EpiRes<1> E{Hb2, nullptr, nullptr, Hb3, ss3};
        pg8::gemm_phase<EpiRes<1>, pg8::StaticOrder, true, true, false>(lds, g, S, E, TIDX);
        { const int t2 = bid & 127, rh = (bid >> 7) & 1; TIDS; f32x4 ta[1]; tail_gemm<1, D>(lds, At + (size_t)SEQ * D, Wo_t, 16 * t2, rh, ta, TIDX); if (wave < 4) E.tail(SEQ + 64 * rh + 16 * wave + fr, 16 * t2 + 4 * fq, ta[0], fq); }
    }
    xcd_barrier(bar, IS_T0);
    STAMP();
    {
        TIDS;
        pg8::Gemm g{Hb3, Wgu1_t, MP, NGU, D}; pg8::StaticOrder S; S.init(MP, NGU, G, bid);
        EpiGU E{ss3, Hm};
        pg8::gemm_phase<EpiGU, pg8::StaticOrder, true, true>(lds, g, S, E, TIDX);
    }
    xcd_barrier(bar, IS_T0);
    STAMP();
    {
        TIDS;
        pg8::Gemm g{Hm, Wdn1_t, SEQ, D, DFF}; pg8::StaticOrder S; S.init(SEQ, D, G, bid);
        EpiRes<2> E{Hb3, out + OY_P, out + OY_S, nullptr, nullptr};
        pg8::gemm_phase<EpiRes<2>, pg8::StaticOrder, true, true, false>(lds, g, S, E, TIDX);
        { const int t2 = bid & 127, rh = (bid >> 7) & 1; TIDS; f32x4 ta[1]; tail_gemm<1, DFF>(lds, Hm + (size_t)SEQ * DFF, Wdn1_t, 16 * t2, rh, ta, TIDX); if (wave < 4) E.tail(SEQ + 64 * rh + 16 * wave + fr, 16 * t2 + 4 * fq, ta[0], fq); }
    }
#ifdef PROF_A
    STAMP();
    if (blockIdx.x == 0 && IS_T0) {
        const unsigned ta = PVAL(PROF_A0, PROF_A1), tb = PVAL(PROF_B0, PROF_B1);
        unsigned qa = (ta + PROF_UA / 2) / PROF_UA, qb = (tb + PROF_UB / 2) / PROF_UB; if (qa > 99u) qa = 99u; if (qb > 99u) qb = 99u;
#ifdef PROF_MUL
        const unsigned long long extra = (unsigned long long)ta * PROF_MUL;
#else
        const unsigned long long extra = (unsigned long long)(qa + 100u * qb) * 5000ull;
#endif
        const unsigned long long t0 = __builtin_amdgcn_s_memrealtime();
        while (__builtin_amdgcn_s_memrealtime() - t0 < extra) __builtin_amdgcn_s_sleep(32);
    }
#endif
}
#undef x_p
#undef x_s
#undef st_in
#undef cache_k
#undef cache_v
#undef ptab
#undef norm_mix_a
#undef w_in
#undef lbl
#undef onorm
#undef w_out
#undef norm_kv
#undef w_kv
#undef k_norm
#undef norm_mix_b
#undef w_q
#undef q_norm
#undef w_o
#undef norm_ffn
#undef w_gu
#undef w_dn
#undef Win_t
#undef Wout_t
#undef Wgu0_t
#undef Wdn0_t
#undef Wkvq_t
#undef Wo_t
#undef Wgu1_t
#undef Wdn1_t
#undef Hb0
#undef Hb1
#undef Hb2
#undef Hb3
#undef Hf1
#undef Hf2
#undef Hf3
#undef Qg
#undef Vg
#undef Gg
#undef Ff
#undef Ob
#undef At
#undef Hm
#undef Ug
#undef Sg0
#undef Dg
#undef Kraw
#undef Vraw
#undef Qraw
#undef Kb
#undef Vb
#undef Qb
#undef Kpart
#undef Kms
#undef Subl
#undef Scnt
#undef Sels
#undef Oslot
#undef MLslot
#undef Sslot
#undef ss0
#undef ss1
#undef ss2
#undef ss3
#undef out
#undef TIDS
#undef TIDX
#undef IS_T0

extern "C" void kernel_launch(void* const* d_in, const int* in_sizes, int n_in, void* d_out, int out_size, void* d_ws, size_t ws_size, hipStream_t stream) {
    static int grid = 0;
    if (grid == 0) {
        if (n_in != 21 || ws_size < WS_END) { fprintf(stderr, "kernel_launch: unexpected n_in %d / ws %zu\n", n_in, ws_size); grid = -1; return; }
        int dev = 0, cus = 0, per_cu = 0;
        if (hipGetDevice(&dev) != hipSuccess || hipDeviceGetAttribute(&cus, hipDeviceAttributeMultiprocessorCount, dev) != hipSuccess) { grid = -1; return; }
        if (hipFuncSetAttribute((const void*)yoco_fwd, hipFuncAttributeMaxDynamicSharedMemorySize, LDS_BYTES) != hipSuccess) { fprintf(stderr, "kernel_launch: hipFuncSetAttribute failed\n"); grid = -1; return; }
        if (hipOccupancyMaxActiveBlocksPerMultiprocessor(&per_cu, (const void*)yoco_fwd, NTHR, LDS_BYTES) != hipSuccess || per_cu < 1) fprintf(stderr, "kernel_launch: occupancy query says %d\n", per_cu);
        (void)hipGetLastError();
        grid = cus;
        if (grid < 256) { fprintf(stderr, "kernel_launch: built for 256 CUs (got %d)\n", grid); grid = -1; return; }
        grid = 256;
    }
    if (grid < 0) return;
    (void)hipMemsetAsync((char*)d_ws + WS_CTL, 0, CTL_ZERO_BYTES, stream);
    Args a{};
    for (int i = 0; i < 21; ++i) a.in[i] = d_in[i];
    a.out = (float*)d_out; a.ws = (unsigned char*)d_ws;
    hipLaunchKernelGGL(yoco_fwd, dim3(grid), dim3(NTHR), LDS_BYTES, stream, a);
}
```

```cpp
#include <hip/hip_runtime.h>
#include <cstdio>
#include <cstdint>
__device__ __forceinline__ int lane_id() { int l = (int)__builtin_amdgcn_mbcnt_hi(~0u, __builtin_amdgcn_mbcnt_lo(~0u, 0u)); asm volatile("" : "+v"(l)); return l; }

namespace pg8 {
#define PG8_LAS __attribute__((address_space(3)))
typedef unsigned short bf16_t;
typedef short bf16x8 __attribute__((ext_vector_type(8)));
typedef float f32x4 __attribute__((ext_vector_type(4)));
typedef unsigned u32x4 __attribute__((ext_vector_type(4)));
typedef unsigned u32x2 __attribute__((ext_vector_type(2)));
constexpr int BM = 256, BK = 64, HALF = 128, HTB = HALF * BK * 2, STAGE_BYTES = 8 * HTB, NXCD = 8, WGM = 8;

__host__ __device__ __forceinline__ int lds_byte(int r, int c) { const int st = (r >> 4) * 2 + (c >> 5), rr = r & 15, cc = c & 31, ob = rr * 64 + cc * 2; return st * 1024 + (ob ^ (((ob >> 9) & 1) << 5)); }
__host__ __device__ __forceinline__ void stage_rc(int b, int& R, int& C) { const int st = b / 1024, sb = b % 1024, swz = sb ^ (((sb >> 9) & 1) << 5); R = (st >> 1) * 16 + swz / 64; C = (st & 1) * 32 + (swz % 64) / 2; }
__host__ __device__ __forceinline__ int perm32(int rho) { const int n = rho >> 4, i = rho & 15; return 8 * (i >> 2) + 4 * n + (i & 3); }

struct Unit { int pm, pn; };
struct Gemm { const bf16_t* A; const bf16_t* Bt; int M, N, K; };

struct StaticOrder {
    int nM, nN, nwg, G, c;
    __host__ __device__ void init(int M, int N, int G_, int c_) { nM = M / BM; nN = N / BM; nwg = nM * nN; G = G_; c = c_; }
    __host__ __device__ bool next(int i, Unit& u) const {
        const long L = (long)i * G + c; if (L >= nwg) return false;
        int wgid = (int)L; { const int q = nwg / NXCD, r = nwg % NXCD, xcd = wgid % NXCD, off = wgid / NXCD; wgid = (xcd < r ? xcd * (q + 1) : r * (q + 1) + (xcd - r) * q) + off; }
        const int nig = WGM * nN, gid = wgid / nig, fm = gid * WGM, gsz = (nM - fm) < WGM ? (nM - fm) : WGM;
        u.pm = fm + ((wgid % nig) % gsz); u.pn = (wgid % nig) / gsz; return true;
    }
    __device__ __forceinline__ void a_ready(const Unit&) const {}
    __device__ __forceinline__ void done(const Unit&) const {}
};

__device__ __forceinline__ unsigned cvt_pk_bf16(float lo, float hi) { unsigned r; asm volatile("v_cvt_pk_bf16_f32 %0, %1, %2" : "=v"(r) : "v"(lo), "v"(hi)); return r; }

template <class Epi, class Sched, bool ALIGN_EPI = false, bool SP2 = false, bool HALF_LAST = true>
__device__ __forceinline__ void gemm_phase(PG8_LAS unsigned char* lds, const Gemm g, const Sched& S, const Epi& E, int tidx) {
    int tid_ = tidx; asm volatile("" : "+v"(tid_));
    const int tid = tid_, wid = __builtin_amdgcn_readfirstlane(tid >> 6), lane = tid & 63, wr = wid >> 2, wc = wid & 3, fr = lane & 15, fq = lane >> 4;
    const int K = g.K, nt = K / BK;
    unsigned voffA[2], voffB[2];
#pragma unroll
    for (int i = 0; i < 2; ++i) { int R, C; stage_rc(tid * 16 + i * 8192, R, C); const int Rb = Epi::PERM ? ((R & ~31) + perm32(R & 31)) : R;
        voffA[i] = (unsigned)(R * K + C) * 2u; voffB[i] = (unsigned)(Rb * K + C) * 2u; }
    const size_t kstep = (size_t)(BK * 2);
    const size_t hstep = (size_t)HALF * K * 2;
    const size_t tstep = 2 * hstep;
    const unsigned ldsw = (unsigned)wid * 1024u;
    const int aoff = lds_byte(wr * 64 + fr, fq * 8), boff = lds_byte(wc * 32 + fr, fq * 8);
#define PG8_SA(b, h) (((b) * 2 + (h)) * HTB)
#define PG8_SB(b, h) ((4 + (b) * 2 + (h)) * HTB)
#define PG8_STAGE(bufoff, gbase, voff) do { _Pragma("unroll") for (int _i = 0; _i < 2; ++_i) \
        __builtin_amdgcn_global_load_lds((const unsigned*)((const char*)(gbase) + (voff)[_i]), (PG8_LAS unsigned*)(lds + (bufoff) + ldsw + _i * 8192), 16, 0, 0); } while (0)
#define PG8_LDA(dst, b, h) do { _Pragma("unroll") for (int m = 0; m < 4; ++m) _Pragma("unroll") for (int k = 0; k < 2; ++k) dst[m][k] = *(const PG8_LAS bf16x8*)(lds + PG8_SA(b, h) + aoff + m * 2048 + k * 1024); } while (0)
#define PG8_LDB(dst, b, h) do { _Pragma("unroll") for (int n = 0; n < 2; ++n) _Pragma("unroll") for (int k = 0; k < 2; ++k) dst[n][k] = *(const PG8_LAS bf16x8*)(lds + PG8_SB(b, h) + boff + n * 2048 + k * 1024); } while (0)
#define PG8_MMA(ai, bj, At, Bt) do { __builtin_amdgcn_s_setprio(1); _Pragma("unroll") for (int m = 0; m < 4; ++m) _Pragma("unroll") for (int n = 0; n < 2; ++n) _Pragma("unroll") for (int k = 0; k < 2; ++k) \
        acc[ai][bj][m][n] = __builtin_amdgcn_mfma_f32_16x16x32_bf16(Bt[n][k], At[m][k], acc[ai][bj][m][n], 0, 0, 0); __builtin_amdgcn_s_setprio(0); } while (0)
#define PG8_WAIT_V(n) asm volatile("s_waitcnt vmcnt(" #n ")" ::: "memory")
#define PG8_WAIT_L(n) asm volatile("s_waitcnt lgkmcnt(" #n ")" ::: "memory")
#define PG8_BAR __builtin_amdgcn_s_barrier()
#define PG8_SCHED __builtin_amdgcn_sched_barrier(0)
    Unit cur, nxt; int ui = 0;
    if (!S.next(0, cur)) return;
    f32x4 acc[2][2][4][2];
#pragma unroll
    for (int a = 0; a < 2; ++a)
#pragma unroll
        for (int b = 0; b < 2; ++b)
#pragma unroll
            for (int m = 0; m < 4; ++m)
#pragma unroll
                for (int n = 0; n < 2; ++n) acc[a][b][m][n] = (f32x4){0.f, 0.f, 0.f, 0.f};
    bf16x8 At[4][2], B0[2][2], B1[2][2];
    const char* cA = (const char*)g.A + (size_t)cur.pm * tstep; const char* cB = (const char*)g.Bt + (size_t)cur.pn * tstep;
    S.a_ready(cur);
    if constexpr (SP2) {
        PG8_STAGE(PG8_SB(0, 0), cB, voffB); PG8_STAGE(PG8_SB(0, 1), cB + hstep, voffB); PG8_STAGE(PG8_SA(0, 0), cA, voffA); PG8_STAGE(PG8_SA(0, 1), cA + hstep, voffA);
        if (wr == 1) PG8_BAR;
        PG8_WAIT_V(2); PG8_BAR;
        PG8_STAGE(PG8_SB(1, 0), cB + kstep, voffB); PG8_STAGE(PG8_SA(1, 0), cA + kstep, voffA); PG8_STAGE(PG8_SB(1, 1), cB + hstep + kstep, voffB);
        PG8_WAIT_V(6); PG8_BAR;
    } else {
        PG8_STAGE(PG8_SB(0, 0), cB, voffB); PG8_STAGE(PG8_SA(0, 0), cA, voffA); PG8_STAGE(PG8_SB(0, 1), cB + hstep, voffB); PG8_STAGE(PG8_SA(0, 1), cA + hstep, voffA);
        if (wr == 1) PG8_BAR;
        PG8_WAIT_V(4); PG8_BAR;
        PG8_STAGE(PG8_SB(1, 0), cB + kstep, voffB); PG8_STAGE(PG8_SA(1, 0), cA + kstep, voffA); PG8_STAGE(PG8_SB(1, 1), cB + hstep + kstep, voffB);
        PG8_WAIT_V(6); PG8_BAR;
    }
    for (;;) {
        const bool has_next = S.next(ui + 1, nxt);
        const bool half1 = HALF_LAST && (cur.pm == g.M / BM - 1);
        const char* nA = has_next ? (const char*)g.A + (size_t)nxt.pm * tstep : cA; const char* nB = has_next ? (const char*)g.Bt + (size_t)nxt.pn * tstep : cB;
        for (int t = 0; t < nt; t += 2) {
            const bool last = (t == nt - 2);
            const char* a1 = cA + (size_t)(t + 1) * kstep;
            const char* a2 = last ? nA : cA + (size_t)(t + 2) * kstep; const char* b2 = last ? nB : cB + (size_t)(t + 2) * kstep;
            const char* a3 = a2 + kstep; const char* b3 = b2 + kstep;
            if (last && has_next) S.a_ready(nxt);
            if constexpr (SP2) {
            PG8_LDB(B0, 0, 0); PG8_LDB(B1, 0, 1); PG8_SCHED; PG8_LDA(At, 0, 0); PG8_STAGE(PG8_SA(1, 1), a1 + hstep, voffA);
            PG8_WAIT_V(8); PG8_WAIT_L(0); PG8_BAR; PG8_MMA(0, 0, At, B0); PG8_MMA(0, 1, At, B1); PG8_BAR; PG8_SCHED;
            if (!half1) { PG8_LDA(At, 0, 1); } PG8_STAGE(PG8_SB(0, 0), b2, voffB); PG8_STAGE(PG8_SB(0, 1), b2 + hstep, voffB); PG8_STAGE(PG8_SA(0, 0), a2, voffA);
            PG8_WAIT_V(8); PG8_WAIT_L(0); PG8_BAR; if (!half1) { PG8_MMA(1, 0, At, B0); PG8_MMA(1, 1, At, B1); } PG8_BAR; PG8_SCHED;
            PG8_LDB(B0, 1, 0); PG8_LDB(B1, 1, 1); PG8_SCHED; PG8_LDA(At, 1, 0); PG8_STAGE(PG8_SA(0, 1), a2 + hstep, voffA);
            PG8_WAIT_V(8); PG8_WAIT_L(0); PG8_BAR; PG8_MMA(0, 0, At, B0); PG8_MMA(0, 1, At, B1); PG8_BAR; PG8_SCHED;
            if (!half1) { PG8_LDA(At, 1, 1); } PG8_STAGE(PG8_SB(1, 0), b3, voffB); PG8_STAGE(PG8_SB(1, 1), b3 + hstep, voffB); PG8_STAGE(PG8_SA(1, 0), a3, voffA);
            PG8_WAIT_V(8); PG8_WAIT_L(0); PG8_BAR; if (!half1) { PG8_MMA(1, 0, At, B0); PG8_MMA(1, 1, At, B1); } PG8_BAR; PG8_SCHED;
            } else {
            PG8_LDB(B0, 0, 0); PG8_SCHED; PG8_LDA(At, 0, 0); PG8_STAGE(PG8_SA(1, 1), a1 + hstep, voffA);
            PG8_WAIT_L(8); PG8_BAR; PG8_WAIT_L(0); PG8_MMA(0, 0, At, B0); PG8_BAR; PG8_SCHED;
            PG8_LDB(B1, 0, 1); PG8_STAGE(PG8_SB(0, 0), b2, voffB);
            PG8_BAR; PG8_WAIT_L(0); PG8_MMA(0, 1, At, B1); PG8_BAR;
            PG8_LDA(At, 0, 1); PG8_STAGE(PG8_SA(0, 0), a2, voffA);
            PG8_BAR; PG8_WAIT_L(0); PG8_MMA(1, 0, At, B0); PG8_BAR; PG8_SCHED;
            PG8_STAGE(PG8_SB(0, 1), b2 + hstep, voffB);
            PG8_WAIT_V(6); PG8_BAR; PG8_MMA(1, 1, At, B1); PG8_BAR;
            PG8_LDB(B0, 1, 0); PG8_SCHED; PG8_LDA(At, 1, 0); PG8_STAGE(PG8_SA(0, 1), a2 + hstep, voffA);
            PG8_WAIT_L(8); PG8_BAR; PG8_WAIT_L(0); PG8_MMA(0, 0, At, B0); PG8_BAR; PG8_SCHED;
            PG8_LDB(B1, 1, 1); PG8_STAGE(PG8_SB(1, 0), b3, voffB);
            PG8_BAR; PG8_WAIT_L(0); PG8_MMA(0, 1, At, B1); PG8_BAR;
            PG8_LDA(At, 1, 1); PG8_STAGE(PG8_SA(1, 0), a3, voffA);
            PG8_BAR; PG8_WAIT_L(0); PG8_MMA(1, 0, At, B0); PG8_BAR; PG8_SCHED;
            PG8_STAGE(PG8_SB(1, 1), b3 + hstep, voffB);
            PG8_WAIT_V(6); PG8_BAR; PG8_MMA(1, 1, At, B1); PG8_BAR;
            }
        }
        if constexpr (ALIGN_EPI) { if (wr == 0) PG8_BAR; }
        E(acc, cur, wr, wc, fr, fq);
        if (!has_next) break;
#pragma unroll
        for (int a = 0; a < 2; ++a)
#pragma unroll
            for (int b = 0; b < 2; ++b)
#pragma unroll
                for (int m = 0; m < 4; ++m)
#pragma unroll
                    for (int n = 0; n < 2; ++n) acc[a][b][m][n] = (f32x4){0.f, 0.f, 0.f, 0.f};
        cur = nxt; cA = nA; cB = nB; ++ui;
        if constexpr (ALIGN_EPI) { if (wr == 1) PG8_BAR; }
    }
    PG8_WAIT_V(0);
    if constexpr (!ALIGN_EPI) { if (wr == 0) PG8_BAR; }
    PG8_BAR;
#undef PG8_SA
#undef PG8_SB
#undef PG8_STAGE
#undef PG8_LDA
#undef PG8_LDB
#undef PG8_MMA
#undef PG8_WAIT_V
#undef PG8_WAIT_L
#undef PG8_BAR
#undef PG8_SCHED
}
}

constexpr int NWAVES = 8, NTHR = 512;
constexpr int D = 2048, SEQ = 8192, DECB = 32, DECS = 4, MS = DECB * DECS;
constexpr int MR = SEQ + MS;
constexpr int MP = 8448;
constexpr int NH = 16, HD = 128, NKV = 4, DFF = 5632, NGU = 2 * DFF;
constexpr int NCHUNK = SEQ / 64;
constexpr int NPAGES = 64, PAGE = 128, NBLK = 32;
constexpr float EPS = 1e-6f;
constexpr float C2 = 0.08838834764831845f * 1.4426950408889634f;

constexpr size_t OY_P = 0, OY_S = OY_P + (size_t)SEQ * D, OST_P = OY_S + (size_t)MS * D, OST_S = OST_P + (size_t)NH * 128 * 128,
                 OK_P = OST_S + (size_t)DECB * NH * 128 * 128, OV_P = OK_P + (size_t)SEQ * 512, OK_S = OV_P + (size_t)SEQ * 512, OV_S = OK_S + (size_t)MS * 512;

constexpr size_t MiB = 1u << 20;
constexpr size_t WS_CTL = 0, CTL_ZERO_BYTES = 1 * MiB;
constexpr size_t WS_WIN = 2 * MiB;
constexpr size_t WS_WOUT = WS_WIN + 32 * MiB;
constexpr size_t WS_WGU0 = WS_WOUT + 8 * MiB;
constexpr size_t WS_WDN0 = WS_WGU0 + 44 * MiB;
constexpr size_t WS_WKVQ = WS_WDN0 + 22 * MiB;
constexpr size_t WS_WO = WS_WKVQ + 12 * MiB;
constexpr size_t WS_WGU1 = WS_WO + 8 * MiB;
constexpr size_t WS_WDN1 = WS_WGU1 + 44 * MiB;
constexpr size_t WS_HB0 = WS_WDN1 + 22 * MiB;
constexpr size_t WS_HB1 = WS_HB0 + 34 * MiB, WS_HB2 = WS_HB1 + 34 * MiB, WS_HB3 = WS_HB2 + 34 * MiB;
constexpr size_t WS_HF1 = WS_HB3 + 34 * MiB;
constexpr size_t WS_HF2 = WS_HF1 + 67 * MiB, WS_HF3 = WS_HF2 + 67 * MiB;
constexpr size_t WS_QG = WS_HF3 + 67 * MiB;
constexpr size_t WS_VG = WS_QG + 34 * MiB;
constexpr size_t WS_GG = WS_VG + 34 * MiB;
constexpr size_t WS_F = WS_GG + 34 * MiB;
constexpr size_t WS_OB = WS_F + 67 * MiB;
constexpr size_t WS_AT = WS_OB + 34 * MiB;
constexpr size_t WS_HM = WS_AT + 34 * MiB;
constexpr size_t WS_U = WS_HM + 92 * MiB;
constexpr size_t WS_SST = WS_U + 64 * MiB;
constexpr size_t WS_DEC = WS_SST + 64 * MiB;
constexpr size_t WS_KRAW = WS_DEC + 2 * MiB;
constexpr size_t WS_VRAW = WS_KRAW + 17 * MiB;
constexpr size_t WS_QRAW = WS_VRAW + 17 * MiB;
constexpr size_t WS_KB = WS_QRAW + 67 * MiB;
constexpr size_t WS_VB = WS_KB + 9 * MiB;
constexpr size_t WS_QB = WS_VB + 9 * MiB;
constexpr size_t WS_KPART = WS_QB + 34 * MiB;
constexpr size_t WS_KMS = WS_KPART + 1 * MiB;
constexpr size_t WS_SUBL = WS_KMS + 2 * MiB;
constexpr size_t WS_SCNT = WS_SUBL + 16 * MiB;
constexpr size_t WS_OSLOT = WS_SCNT + 1 * MiB;
constexpr size_t WS_MLSLOT = WS_OSLOT + 192 * MiB;
constexpr size_t WS_SSLOT = WS_MLSLOT + 3 * MiB;
constexpr size_t WS_FOUT = WS_SSLOT + 34 * MiB;
constexpr size_t WS_END = WS_FOUT + 131 * MiB;
constexpr size_t WS_ORC = WS_END;
constexpr int CW_BAR = 4096;
constexpr int CW_Q0 = 8192;
constexpr int CW_SS0 = 16384, CW_SS1 = CW_SS0 + MP, CW_SS2 = CW_SS1 + MP, CW_SS3 = CW_SS2 + MP;
static_assert((CW_SS3 + MP) * 4 <= (int)CTL_ZERO_BYTES, "ctl");
static_assert(WS_VG - WS_QG == 34 * MiB && WS_GG - WS_VG == 34 * MiB, "Qg|Vg|Gg stride");

constexpr int LDS_BYTES = 160 * 1024;
constexpr int MISC_OFF = LDS_BYTES - 256;

#define GAS __attribute__((address_space(1)))
#define LAS __attribute__((address_space(3)))
typedef unsigned short bf16;
typedef unsigned v4u __attribute__((ext_vector_type(4)));
typedef unsigned v2u __attribute__((ext_vector_type(2)));
typedef float f32x4 __attribute__((ext_vector_type(4)));
typedef float f32x2 __attribute__((ext_vector_type(2)));
typedef short bf16x8 __attribute__((ext_vector_type(8)));
typedef short bf16x4 __attribute__((ext_vector_type(4)));
typedef _Float16 f16;
typedef _Float16 f16x2 __attribute__((ext_vector_type(2)));
__device__ __forceinline__ unsigned pkh2(float lo, float hi) { const f16x2 v = {(f16)lo, (f16)hi}; return __builtin_bit_cast(unsigned, v); }
#define LDS_WAIT() asm volatile("s_waitcnt lgkmcnt(0)" ::: "memory")
__device__ __forceinline__ unsigned f2bf(float f) { unsigned u = __builtin_bit_cast(unsigned, f); return (u + 0x7fffu + ((u >> 16) & 1u)) >> 16; }
__device__ __forceinline__ unsigned pk2(float lo, float hi) { return f2bf(lo) | (f2bf(hi) << 16); }
__device__ __forceinline__ float bf2f(unsigned h) { return __uint_as_float(h << 16); }
__device__ __forceinline__ float silu_f(float x) { return x * __builtin_amdgcn_rcpf(1.0f + __expf(-x)); }
__device__ __forceinline__ float sigm_f(float x) { return __builtin_amdgcn_rcpf(1.0f + __expf(-x)); }
template <int M> __device__ __forceinline__ float shx(float v) { return __uint_as_float((unsigned)__builtin_amdgcn_ds_swizzle((int)__float_as_uint(v), (M << 10) | 0x1f)); }
__device__ __forceinline__ float xadd32(float v) { auto rr = __builtin_amdgcn_permlane32_swap(__float_as_uint(v), __float_as_uint(v), false, false); return __uint_as_float(rr[0]) + __uint_as_float(rr[1]); }
__device__ __forceinline__ float xmax32(float v) { auto rr = __builtin_amdgcn_permlane32_swap(__float_as_uint(v), __float_as_uint(v), false, false); return fmaxf(__uint_as_float(rr[0]), __uint_as_float(rr[1])); }
__device__ __forceinline__ float wave_sum(float v) { v += shx<1>(v); v += shx<2>(v); v += shx<4>(v); v += shx<8>(v); v += shx<16>(v); return xadd32(v); }
#define MFMA16(a, b, c) __builtin_amdgcn_mfma_f32_16x16x32_bf16((a), (b), (c), 0, 0, 0)

#define XB_TMO      128
#define XB_XCNT(j)  (256  + 64 * (j))
#define XB_XSUB(j)  (1280 + 64 * (j))
#define XB_XGEN(j)  (2304 + 64 * (j))
#define XB_TOP      3328
#define XB_TOPGEN   3392
#define XCD_BAR_WORDS 3456
#define XB_SPIN_CAP (1u << 18)
__device__ __forceinline__ unsigned xb_ld(unsigned* p)              { return __hip_atomic_load(p, __ATOMIC_RELAXED, __HIP_MEMORY_SCOPE_AGENT); }
__device__ __forceinline__ unsigned xb_add(unsigned* p, unsigned v) { return __hip_atomic_fetch_add(p, v, __ATOMIC_RELAXED, __HIP_MEMORY_SCOPE_AGENT); }
__device__ __forceinline__ unsigned xb_xcc_id() { return (unsigned)__builtin_amdgcn_s_getreg((3 << 11) | 20) & 0xFu; }
#define XB_SPIN(cond, bar) do { unsigned _sp = 0; while (cond) { __builtin_amdgcn_s_sleep(1); \
    if ((++_sp & 255u) == 0u) { if (xb_ld(&(bar)[XB_TMO])) break; if (_sp > XB_SPIN_CAP) { atomicAdd(&(bar)[XB_TMO], 1u); break; } } } } while (0)
struct XcdBarrier { unsigned* bar; unsigned x; volatile LAS unsigned* st; };
__device__ __forceinline__ XcdBarrier xcd_barrier_post(unsigned* bar, volatile LAS unsigned* st, bool is_t0) {
    XcdBarrier b; b.bar = bar; b.x = xb_xcc_id(); b.st = st;
    if (is_t0) (void)xb_add(&bar[XB_XCNT(b.x)], 1u);
    return b;
}
__device__ __forceinline__ void xcd_barrier_complete(unsigned* bar, unsigned x, unsigned& nloc, unsigned& nx) {
    const unsigned G = gridDim.x * gridDim.y * gridDim.z;
    unsigned sum, cnt, mine, sp = 0u;
    for (;;) {
        sum = 0u; cnt = 0u; mine = 0u;
#pragma unroll
        for (unsigned j = 0; j < 16; ++j) { const unsigned c = xb_ld(&bar[XB_XCNT(j)]); sum += c; cnt += (c > 0u) ? 1u : 0u; mine = (j == x) ? c : mine; }
        if (sum == G) break;
        __builtin_amdgcn_s_sleep(1);
        if ((++sp & 255u) == 0u) { if (xb_ld(&bar[XB_TMO])) break; if (sp > XB_SPIN_CAP) { atomicAdd(&bar[XB_TMO], 1u); break; } }
    }
    nloc = mine > 0u ? mine : 1u; nx = cnt > 0u ? cnt : 1u;
}
__device__ __forceinline__ void xcd_barrier(const XcdBarrier& b, bool is_t0) {
    asm volatile("s_waitcnt vmcnt(0)" ::: "memory");
    __syncthreads();
    if (is_t0) {
        unsigned* bar = b.bar;
        __builtin_amdgcn_s_waitcnt(0);
        unsigned nloc = b.st[0], nx = b.st[1];
        if (nloc == 0u) { xcd_barrier_complete(bar, b.x, nloc, nx); b.st[0] = nloc; b.st[1] = nx; }
        const unsigned old = xb_add(&bar[XB_XSUB(b.x)], 1u);
        const unsigned gen = old / nloc;
        if (old + 1u == (gen + 1u) * nloc) {
            __builtin_amdgcn_fence(__ATOMIC_RELEASE, "agent");
            asm volatile("s_waitcnt vmcnt(0)" ::: "memory");
            const unsigned og = xb_add(&bar[XB_TOP], 1u);
            const unsigned tg = og / nx;
            if (og + 1u == (tg + 1u) * nx) xb_add(&bar[XB_TOPGEN], 1u);
            else XB_SPIN(xb_ld(&bar[XB_TOPGEN]) == tg, bar);
            __builtin_amdgcn_fence(__ATOMIC_ACQUIRE, "agent");
            xb_add(&bar[XB_XGEN(b.x)], 1u);
            asm volatile("s_waitcnt vmcnt(0)" ::: "memory");
        } else {
            XB_SPIN(xb_ld(&bar[XB_XGEN(b.x)]) == gen, bar);
            __builtin_amdgcn_fence(__ATOMIC_ACQUIRE, "agent");
            asm volatile("s_waitcnt vmcnt(0)" ::: "memory");
        }
    }
    __syncthreads();
}

using pg8::Unit; using pg8::cvt_pk_bf16;
struct EpiIn {
    static constexpr bool PERM = true;
    const float* ss; const float* lbl; bf16* Qg; f16* F;
    __device__ __forceinline__ void operator()(const f32x4 (&acc)[2][2][4][2], const Unit& u, int wr, int wc, int fr, int fq) const {
        const int seg = u.pn >> 3; const int col0 = (u.pn & 7) * 256 + wc * 32 + 8 * fq; const int rowb = u.pm * 256 + wr * 64;
        float lb[2][8];
        if (seg == 1) {
#pragma unroll
            for (int bj = 0; bj < 2; ++bj)
#pragma unroll
                for (int j = 0; j < 8; ++j) { const int c = col0 + bj * 128 + j; lb[bj][j] = __builtin_amdgcn_rcpf(1.0f + __expf(lbl[D + c] - lbl[c])); }
        }
#pragma unroll
        for (int ai = 0; ai < 2; ++ai)
#pragma unroll
            for (int m = 0; m < 4; ++m) {
                const int rb = rowb + ai * 128 + m * 16; if (rb >= MR) continue;
                const int row = rb + fr; const float r = rsqrtf(ss[row] * (1.0f / D) + EPS);
#pragma unroll
                for (int bj = 0; bj < 2; ++bj) {
                    f32x4 v0 = acc[ai][bj][m][0] * r, v1 = acc[ai][bj][m][1] * r; const size_t off = (size_t)row * D + col0 + bj * 128;
                    if (seg == 1) {
                        f32x4 o0, o1;
#pragma unroll
                        for (int j = 0; j < 4; ++j) { o0[j] = (1.0f - lb[bj][j]) * sigm_f(-v0[j]); o1[j] = (1.0f - lb[bj][4 + j]) * sigm_f(-v1[j]); }
                        { v4u w; w.x = pkh2(o0[0], o0[1]); w.y = pkh2(o0[2], o0[3]); w.z = pkh2(o1[0], o1[1]); w.w = pkh2(o1[2], o1[3]); *(v4u*)(F + off) = w; }
                    } else {
                        if (seg != 2) {
#pragma unroll
                            for (int j = 0; j < 4; ++j) { v0[j] = silu_f(v0[j]); v1[j] = silu_f(v1[j]); }
                        }
                        v4u w; w.x = cvt_pk_bf16(v0[0], v0[1]); w.y = cvt_pk_bf16(v0[2], v0[3]); w.z = cvt_pk_bf16(v1[0], v1[1]); w.w = cvt_pk_bf16(v1[2], v1[3]);
                        const size_t dsel = (seg == 0) ? 0 : ((seg == 2) ? 1 : 2);
                        *(v4u*)(Qg + dsel * (size_t)(17 * MiB) + off) = w;
                    }
                }
            }
    }
    __device__ __forceinline__ void tail(int row, int col, f32x4 v) const {
        const int seg = col >> 11, c = col & 2047; const float r = rsqrtf(ss[row] * (1.0f / D) + EPS); v = v * r; const size_t off = (size_t)row * D + c;
        if (seg == 1) { f32x4 o;
#pragma unroll
            for (int j = 0; j < 4; ++j) { const float lbv = __builtin_amdgcn_rcpf(1.0f + __expf(lbl[D + c + j] - lbl[c + j])); o[j] = (1.0f - lbv) * sigm_f(-v[j]); }
            { v2u w; w.x = pkh2(o[0], o[1]); w.y = pkh2(o[2], o[3]); *(v2u*)(F + off) = w; }
        } else {
            if (seg != 2) {
#pragma unroll
                for (int j = 0; j < 4; ++j) v[j] = silu_f(v[j]);
            }
            v2u w; w.x = cvt_pk_bf16(v[0], v[1]); w.y = cvt_pk_bf16(v[2], v[3]);
            const size_t dsel = (seg == 0) ? 0 : ((seg == 2) ? 1 : 2);
            *(v2u*)(Qg + dsel * (size_t)(17 * MiB) + off) = w;
        }
    }
};

template <int MODE> struct EpiRes {
    static constexpr bool PERM = true;
    const bf16* rb; float* o0; float* o1; bf16* hb; float* ss;
    __device__ __forceinline__ void operator()(const f32x4 (&acc)[2][2][4][2], const Unit& u, int wr, int wc, int fr, int fq) const {
        const int col0 = u.pn * 256 + wc * 32 + 8 * fq; const int rowb = u.pm * 256 + wr * 64;
#pragma unroll
        for (int ai = 0; ai < 2; ++ai)
#pragma unroll
            for (int m = 0; m < 4; ++m) {
                const int rb0 = rowb + ai * 128 + m * 16; if (rb0 >= MR) continue;
                const int row = rb0 + fr;
                const bf16* rp = rb + (size_t)row * D;
                float* op = (MODE == 2) ? ((row < SEQ) ? o0 + (size_t)row * D : o1 + (size_t)(row - SEQ) * D) : nullptr;
                float sq = 0.f;
#pragma unroll
                for (int bj = 0; bj < 2; ++bj) {
                    const int c = col0 + bj * 128;
                    const v4u rw = *(const v4u*)(rp + c);
                    f32x4 a0 = {bf2f(rw.x & 0xffffu), bf2f(rw.x >> 16), bf2f(rw.y & 0xffffu), bf2f(rw.y >> 16)}, a1 = {bf2f(rw.z & 0xffffu), bf2f(rw.z >> 16), bf2f(rw.w & 0xffffu), bf2f(rw.w >> 16)};
                    a0 += acc[ai][bj][m][0]; a1 += acc[ai][bj][m][1];
                    if (MODE == 2) { __builtin_nontemporal_store(a0, (f32x4*)(op + c)); __builtin_nontemporal_store(a1, (f32x4*)(op + c + 4)); }
                    else {
                        v4u w; w.x = cvt_pk_bf16(a0[0], a0[1]); w.y = cvt_pk_bf16(a0[2], a0[3]); w.z = cvt_pk_bf16(a1[0], a1[1]); w.w = cvt_pk_bf16(a1[2], a1[3]);
                        *(v4u*)(hb + (size_t)row * D + c) = w;
                        sq += (a0[0] * a0[0] + a0[1] * a0[1]) + (a0[2] * a0[2] + a0[3] * a0[3]) + (a1[0] * a1[0] + a1[1] * a1[1]) + (a1[2] * a1[2] + a1[3] * a1[3]);
                    }
                }
                if (MODE != 2) { sq += shx<16>(sq); sq = xadd32(sq); if (fq == 0) atomicAdd(ss + row, sq); }
            }
    }
    __device__ __forceinline__ void tail(int row, int col, f32x4 v, int fq) const {
        const v2u rw = *(const v2u*)(rb + (size_t)row * D + col);
        f32x4 a0 = {bf2f(rw.x & 0xffffu), bf2f(rw.x >> 16), bf2f(rw.y & 0xffffu), bf2f(rw.y >> 16)}; a0 += v;
        if (MODE == 2) { *(f32x4*)(o1 + (size_t)(row - SEQ) * D + col) = a0; }
        else {
            v2u w; w.x = cvt_pk_bf16(a0[0], a0[1]); w.y = cvt_pk_bf16(a0[2], a0[3]); *(v2u*)(hb + (size_t)row * D + col) = w;
            float sq = (a0[0] * a0[0] + a0[1] * a0[1]) + (a0[2] * a0[2] + a0[3] * a0[3]);
            sq += shx<16>(sq); sq = xadd32(sq); if (fq == 0) atomicAdd(ss + row, sq);
        }
    }
};
struct EpiGU {
    static constexpr bool PERM = true;
    const float* ss; bf16* hm;
    __device__ __forceinline__ void operator()(const f32x4 (&acc)[2][2][4][2], const Unit& u, int wr, int wc, int fr, int fq) const {
        const int j0 = u.pn * 128 + wc * 32 + 8 * fq; const int rowb = u.pm * 256 + wr * 64;
#pragma unroll
        for (int ai = 0; ai < 2; ++ai)
#pragma unroll
            for (int m = 0; m < 4; ++m) {
                const int rb = rowb + ai * 128 + m * 16; if (rb >= MR) continue;
                const int row = rb + fr; const float r = rsqrtf(ss[row] * (1.0f / D) + EPS);
                float o[8];
#pragma unroll
                for (int n = 0; n < 2; ++n)
#pragma unroll
                    for (int j = 0; j < 4; ++j) o[4 * n + j] = silu_f(acc[ai][0][m][n][j] * r) * (acc[ai][1][m][n][j] * r);
                v4u w; w.x = cvt_pk_bf16(o[0], o[1]); w.y = cvt_pk_bf16(o[2], o[3]); w.z = cvt_pk_bf16(o[4], o[5]); w.w = cvt_pk_bf16(o[6], o[7]);
                *(v4u*)(hm + (size_t)row * DFF + j0) = w;
            }
    }
};
struct EpiKVQ {
    static constexpr bool PERM = true;
    const float* ss; unsigned char* ws; float* outp; const float* kn; const float* qn; LAS unsigned char* xl;
    __device__ __forceinline__ void operator()(const f32x4 (&acc)[2][2][4][2], const Unit& u, int wr, int wc, int fr, int fq) const {
        const int c0 = wc * 32 + 8 * fq; const int rowb = u.pm * 256 + wr * 64;
        bf16* Kb_ = (bf16*)(ws + WS_KB); bf16* Vb_ = (bf16*)(ws + WS_VB); bf16* Qb_ = (bf16*)(ws + WS_QB); float* Kp_ = (float*)(ws + WS_KPART);
        if (u.pn == 2 || u.pn == 3) {
#pragma unroll
            for (int ai = 0; ai < 2; ++ai)
#pragma unroll
                for (int m = 0; m < 4; ++m) {
                    const int rb = rowb + ai * 128 + m * 16; if (rb >= MR) continue;
                    const int row = rb + fr; const float r = rsqrtf(ss[row] * (1.0f / D) + EPS);
                    float* vo = outp + ((row < SEQ) ? OV_P + (size_t)row * 512 : OV_S + (size_t)(row - SEQ) * 512);
#pragma unroll
                    for (int bj = 0; bj < 2; ++bj) { const int col = (u.pn - 2) * 256 + bj * 128 + c0; const f32x4 v0 = acc[ai][bj][m][0] * r, v1 = acc[ai][bj][m][1] * r;
                        __builtin_nontemporal_store(v0, (f32x4*)(vo + col)); __builtin_nontemporal_store(v1, (f32x4*)(vo + col + 4));
                        v4u w; w.x = cvt_pk_bf16(v0[0], v0[1]); w.y = cvt_pk_bf16(v0[2], v0[3]); w.z = cvt_pk_bf16(v1[0], v1[1]); w.w = cvt_pk_bf16(v1[2], v1[3]);
                        *(v4u*)(Vb_ + (size_t)row * 512 + col) = w; }
                }
            return;
        }
        const bool isk = u.pn < 2;
        LAS float* P = (LAS float*)xl;
        LAS float* CS = (LAS float*)(xl + 8192);
#pragma unroll
        for (int ai = 0; ai < 2; ++ai)
#pragma unroll
            for (int m = 0; m < 4; ++m) {
                const int rl = ai * 128 + wr * 64 + m * 16 + fr; const float r = rsqrtf(ss[u.pm * 256 + rl] * (1.0f / D) + EPS);
#pragma unroll
                for (int bj = 0; bj < 2; ++bj) { const f32x4 v0 = acc[ai][bj][m][0] * r, v1 = acc[ai][bj][m][1] * r;
                    float sq = (v0[0] * v0[0] + v0[1] * v0[1]) + (v0[2] * v0[2] + v0[3] * v0[3]) + (v1[0] * v1[0] + v1[1] * v1[1]) + (v1[2] * v1[2] + v1[3] * v1[3]);
                    sq += shx<16>(sq); sq = xadd32(sq);
                    if (fq == 0) P[(rl * 2 + bj) * 4 + wc] = sq; }
            }
        asm volatile("s_waitcnt lgkmcnt(0)" ::: "memory"); __builtin_amdgcn_s_barrier(); asm volatile("" ::: "memory");
        float cs[2][8];
#pragma unroll
        for (int bj = 0; bj < 2; ++bj)
#pragma unroll
            for (int j = 0; j < 8; ++j) cs[bj][j] = 0.f;
        const float* gp = (isk ? kn : qn) + c0; const f32x4 g0 = *(const f32x4*)gp, g1 = *(const f32x4*)(gp + 4);
#pragma unroll
        for (int ai = 0; ai < 2; ++ai)
#pragma unroll
            for (int m = 0; m < 4; ++m) {
                const int rb = rowb + ai * 128 + m * 16; if (rb >= MR) continue;
                const int rl = ai * 128 + wr * 64 + m * 16 + fr; const int row = rb + fr; const float r = rsqrtf(ss[row] * (1.0f / D) + EPS);
#pragma unroll
                for (int bj = 0; bj < 2; ++bj) {
                    const f32x4 pp = *(const LAS f32x4*)(P + (rl * 2 + bj) * 4);
                    const float rh = rsqrtf(((pp[0] + pp[1]) + (pp[2] + pp[3])) * (1.0f / 128.0f) + EPS) * (isk ? 1.0f : C2);
                    const f32x4 n0 = acc[ai][bj][m][0] * (r * rh) * g0, n1 = acc[ai][bj][m][1] * (r * rh) * g1;
                    v4u w; w.x = cvt_pk_bf16(n0[0], n0[1]); w.y = cvt_pk_bf16(n0[2], n0[3]); w.z = cvt_pk_bf16(n1[0], n1[1]); w.w = cvt_pk_bf16(n1[2], n1[3]);
                    if (isk) {
                        const int col = u.pn * 256 + bj * 128 + c0;
                        float* ko = outp + ((row < SEQ) ? OK_P + (size_t)row * 512 : OK_S + (size_t)(row - SEQ) * 512) + col;
                        __builtin_nontemporal_store(n0, (f32x4*)ko); __builtin_nontemporal_store(n1, (f32x4*)(ko + 4));
                        *(v4u*)(Kb_ + (size_t)row * 512 + col) = w;
#pragma unroll
                        for (int j = 0; j < 4; ++j) { cs[bj][j] += n0[j]; cs[bj][4 + j] += n1[j]; }
                    } else {
                        *(v4u*)(Qb_ + (size_t)row * D + (u.pn - 4) * 256 + bj * 128 + c0) = w;
                    }
                }
            }
        if (isk && u.pm < SEQ / 256) {
#pragma unroll
            for (int bj = 0; bj < 2; ++bj)
#pragma unroll
                for (int j = 0; j < 8; ++j) { float v = cs[bj][j]; v += shx<1>(v); v += shx<2>(v); v += shx<4>(v); v += shx<8>(v); if (fr == 0) CS[wr * 256 + bj * 128 + c0 + j] = v; }
            asm volatile("s_waitcnt lgkmcnt(0)" ::: "memory"); __builtin_amdgcn_s_barrier(); asm volatile("" ::: "memory");
            const int t = (wr * 4 + wc) * 64 + fq * 16 + fr;
            if (t < 256) Kp_[(size_t)u.pm * 512 + u.pn * 256 + t] = CS[t] + CS[256 + t];
        }
    }
};

struct Args { const void* in[21]; float* out; unsigned char* ws; };

__device__ __forceinline__ void p0_transpose_item(const float* W, int K, int N, bf16* WT, int row_off, int mode, const float* gain, LAS float* scr, int item, int lane) {
    const int nblk = N / 64, kb = item / nblk, nb = item % nblk, k0 = 64 * kb, n0 = 64 * nb;
    const int r = lane >> 4, c4 = lane & 15;
#pragma unroll
    for (int i = 0; i < 16; ++i) { const int kk = 4 * i + r; f32x4 w = __builtin_nontemporal_load((const f32x4*)(W + (size_t)(k0 + kk) * N + n0 + 4 * c4)); if (gain) w *= gain[k0 + kk]; *(LAS f32x4*)(scr + kk * 68 + 4 * c4) = w; }
    LDS_WAIT(); asm volatile("" ::: "memory");
    const int c = lane & 7;
    int d0;
    if (mode == 0) d0 = row_off + n0;
    else { const int j = (n0 < DFF) ? n0 : n0 - DFF; d0 = 256 * (j >> 7) + (j & 127) + ((n0 < DFF) ? 0 : 128); }
#pragma unroll
    for (int j = 0; j < 8; ++j) { const int n = (lane >> 3) + 8 * j; const LAS float* sp = scr + (8 * c) * 68 + n;
        v4u o; o.x = pk2(sp[0 * 68], sp[1 * 68]); o.y = pk2(sp[2 * 68], sp[3 * 68]); o.z = pk2(sp[4 * 68], sp[5 * 68]); o.w = pk2(sp[6 * 68], sp[7 * 68]);
        *(v4u*)(WT + (size_t)(d0 + n) * K + k0 + 8 * c) = o; }
    LDS_WAIT(); asm volatile("" ::: "memory");
}

constexpr int KS_P = 144;
constexpr int KS_BYTES = 256 * KS_P * 2;
typedef short v4i16_t __attribute__((ext_vector_type(4)));
__device__ __forceinline__ v2u tr_read(const LAS bf16* p) { return __builtin_bit_cast(v2u, __builtin_amdgcn_ds_read_tr16_b64_v4i16((LAS v4i16_t*)p)); }
template <int NKT> __device__ __forceinline__ void attn_scores(const LAS bf16* Ks, const bf16x8 (&qf)[4], f32x4 (&acc)[16], int nkt, int fr, int fq) {
#pragma unroll
    for (int kt = 0; kt < NKT; ++kt) {
        acc[kt] = (f32x4){0.f, 0.f, 0.f, 0.f};
        if (kt < nkt) {
#pragma unroll
            for (int ks = 0; ks < 4; ++ks) { const bf16x8 a = *(const LAS bf16x8*)(Ks + (16 * kt + fr) * KS_P + 32 * ks + 8 * fq); acc[kt] = MFMA16(a, qf[ks], acc[kt]); }
        }
    }
}
__device__ __forceinline__ void attn_pv(const LAS bf16* Vr, const f32x4 (&acc)[16], f32x4 (&O)[8], int nj, int fr, int fq) {
#pragma unroll
    for (int j = 0; j < 8; ++j) {
        if (j < nj) {
            v4u pw; pw.x = cvt_pk_bf16(acc[2 * j][0], acc[2 * j][1]); pw.y = cvt_pk_bf16(acc[2 * j][2], acc[2 * j][3]); pw.z = cvt_pk_bf16(acc[2 * j + 1][0], acc[2 * j + 1][1]); pw.w = cvt_pk_bf16(acc[2 * j + 1][2], acc[2 * j + 1][3]);
            const bf16x8 pf = __builtin_bit_cast(bf16x8, pw);
            const LAS bf16* vb = Vr + (32 * j + 4 * fq + (fr >> 2)) * KS_P + 4 * (fr & 3);
#pragma unroll
            for (int vt = 0; vt < 8; ++vt) {
                const v2u lo = tr_read(vb + 16 * vt), hi = tr_read(vb + 16 * KS_P + 16 * vt);
                const v4u aw = {lo.x, lo.y, hi.x, hi.y};
                O[vt] = MFMA16(__builtin_bit_cast(bf16x8, aw), pf, O[vt]);
            }
        }
    }
}

template <int NT, int K> __device__ __forceinline__ void tail_gemm(LAS unsigned char* lds, const bf16* A, const bf16* Bt, int n0, int rowhalf, f32x4 (&acc)[NT], int tidx, int rsel) {
    int tid_o = tidx; asm volatile("" : "+v"(tid_o));
    const int tid = tid_o, lane = tid & 63, wave = __builtin_amdgcn_readfirstlane(tid >> 6), fr = lane & 15, fq = lane >> 4;
    const int rt = wave & 3, kh = wave >> 2; constexpr int Kh = K >> 1;
    constexpr int KC = (K == 2048) ? (NT == 2 ? 512 : 1024) : 1408;
    constexpr int NCH = Kh / KC, PB = KC + 8, UPR = KC >> 3, NS = KC >> 7;
    const int khk = kh ^ (rsel & 1), flip = (NCH > 1) ? ((rsel >> 1) & 1) : 0;
    constexpr int NU = 2 * 16 * NT * UPR, NIT = NU / NTHR;
    static_assert(NU % NTHR == 0, "tail B staging");
    LAS bf16* Bs = (LAS bf16*)(lds + 8192);
    const int lq = lane >> 4, lu = lane & 15;
    const bf16* ap = A + (size_t)(64 * rowhalf + 16 * rt + lq) * K + khk * Kh + 8 * lu;
    LAS unsigned char* stg = lds + 102400 + wave * 4096;
    int wof[4], rof[4];
#pragma unroll
    for (int j = 0; j < 4; ++j) { wof[j] = (4 * j + lq) * 256 + ((lu ^ (4 * j + lq)) << 4); rof[j] = fr * 256 + (((4 * j + fq) ^ fr) << 4); }
    const LAS bf16* bl = Bs + (khk * 16 * NT + fr) * PB + 8 * fq;
#pragma unroll
    for (int t = 0; t < NT; ++t) acc[t] = (f32x4){0.f, 0.f, 0.f, 0.f};
#define TG_LDA(a_, k0_) do { _Pragma("unroll") for (int s_ = 0; s_ < 4; ++s_) a_[s_] = *(const bf16x8*)(ap + (size_t)(4 * s_) * K + (k0_)); } while (0)
#define TG_MMA(a_, kl_) do { _Pragma("unroll") for (int s_ = 0; s_ < 4; ++s_) *(LAS bf16x8*)(stg + wof[s_]) = a_[s_]; asm volatile("" ::: "memory"); bf16x8 ar_[4]; \
        _Pragma("unroll") for (int s_ = 0; s_ < 4; ++s_) ar_[s_] = *(const LAS bf16x8*)(stg + rof[s_]); asm volatile("" ::: "memory"); \
        _Pragma("unroll") for (int s_ = 0; s_ < 4; ++s_) { _Pragma("unroll") for (int t_ = 0; t_ < NT; ++t_) { \
        const bf16x8 b_ = *(const LAS bf16x8*)(bl + t_ * 16 * PB + (kl_) + 32 * s_); acc[t_] = MFMA16(b_, ar_[s_], acc[t_]); } } } while (0)
#define TG_LDB(kb_) do { _Pragma("unroll") for (int i_ = 0; i_ < NIT; ++i_) { const int u_ = tid + i_ * NTHR, r2_ = u_ / UPR, kc_ = u_ - r2_ * UPR; const int khh_ = (r2_ >= 16 * NT) ? 1 : 0, row_ = r2_ - khh_ * 16 * NT; \
        breg[i_] = *(const v4u*)(Bt + (size_t)(n0 + row_) * K + khh_ * Kh + (kb_) + 8 * kc_); } } while (0)
#define TG_STB() do { _Pragma("unroll") for (int i_ = 0; i_ < NIT; ++i_) { const int u_ = tid + i_ * NTHR, r2_ = u_ / UPR, kc_ = u_ - r2_ * UPR; *(LAS v4u*)(Bs + r2_ * PB + 8 * kc_) = breg[i_]; } } while (0)
    v4u breg[NIT];
    TG_LDB(flip * KC);
#pragma unroll
    for (int ch = 0; ch < NCH; ++ch) {
        const int kb = (ch ^ flip) * KC;
        bf16x8 a0[4], a1[4], a2[4], a3[4];
        TG_LDA(a0, kb); TG_LDA(a1, kb + 128); TG_LDA(a2, kb + 256); TG_LDA(a3, kb + 384);
        TG_STB();
        __syncthreads();
        if (ch + 1 < NCH) TG_LDB(((ch + 1) ^ flip) * KC);
        for (int st = 0; st < NS; st += 4) {
            TG_MMA(a0, 128 * st);           if (st + 4 < NS) TG_LDA(a0, kb + 128 * (st + 4));
            if (st + 1 < NS) { TG_MMA(a1, 128 * (st + 1)); if (st + 5 < NS) TG_LDA(a1, kb + 128 * (st + 5)); }
            if (st + 2 < NS) { TG_MMA(a2, 128 * (st + 2)); if (st + 6 < NS) TG_LDA(a2, kb + 128 * (st + 6)); }
            if (st + 3 < NS) { TG_MMA(a3, 128 * (st + 3)); if (st + 7 < NS) TG_LDA(a3, kb + 128 * (st + 7)); }
        }
        __syncthreads();
    }
#undef TG_LDA
#undef TG_MMA
#undef TG_LDB
#undef TG_STB
    LAS f32x4* red = (LAS f32x4*)lds;
    if (kh == 1) {
#pragma unroll
        for (int t = 0; t < NT; ++t) red[(t * 4 + rt) * 64 + lane] = acc[t];
    }
    __syncthreads();
    if (kh == 0) {
#pragma unroll
        for (int t = 0; t < NT; ++t) acc[t] += red[(t * 4 + rt) * 64 + lane];
    }
    __syncthreads();
}

__device__ __forceinline__ void kmean_items(LAS unsigned char* lds, const float* cache_k_, const int* ptab_, float* Kms_, int i0, int i1, int c0, int cn, int tidx) {
    int tid_o = tidx; asm volatile("" : "+v"(tid_o)); const int tid = tid_o;
    const int me = (int)blockIdx.x - c0; if (me < 0 || me >= cn) return;
    LAS f32x4* redk = (LAS f32x4*)(lds);
    for (int item = i0 + me; item < i1; item += cn) {
        const int b = item >> 5, n = item & 31; const int c4 = tid & 127, rg = tid >> 7;
        f32x4 a = {0.f, 0.f, 0.f, 0.f};
#pragma unroll
        for (int hp = 0; hp < 2; ++hp) { const int page = ptab_[b * NPAGES + 2 * n + hp]; const f32x4* pp = (const f32x4*)(cache_k_ + (size_t)page * PAGE * 512) + c4;
#pragma unroll 16
            for (int r = rg; r < 128; r += 4) a += __builtin_nontemporal_load(pp + (size_t)r * 128); }
        redk[rg * 128 + c4] = a;
        __syncthreads();
        if (tid < 128) { const f32x4 s4 = (redk[tid] + redk[128 + tid]) + (redk[256 + tid] + redk[384 + tid]); *(f32x4*)(Kms_ + (size_t)item * 512 + 4 * tid) = s4 * (1.0f / 256.0f); }
        __syncthreads();
    }
}

__global__ void __launch_bounds__(NTHR, 2) yoco_fwd(Args args) {
    extern __shared__ __attribute__((aligned(16))) unsigned char lds_raw[];
    LAS unsigned char* lds = (LAS unsigned char*)lds_raw;
#define TIDS int tid_o = TIDX; asm volatile("" : "+v"(tid_o)); const int tid = tid_o, lane = tid & 63, wave = __builtin_amdgcn_readfirstlane(tid >> 6), fr = lane & 15, fq = lane >> 4; (void)fr; (void)fq; (void)wave; (void)lane; (void)tid
    const int G = gridDim.x, bid = blockIdx.x;
    unsigned char* ws = args.ws;
    unsigned* ctl = (unsigned*)(ws + WS_CTL);
    volatile LAS unsigned* MISC = (volatile LAS unsigned*)(lds + MISC_OFF);
    const int wave_sg = __builtin_amdgcn_readfirstlane((int)threadIdx.x & ~63);
#define TIDX (wave_sg + lane_id())
#define IS_T0 ((wave_sg == 0) && (lane_id() == 0))
    if (TIDX < 64) MISC[TIDX] = 0u;
    __syncthreads();
    XcdBarrier bar = xcd_barrier_post(ctl + CW_BAR, MISC + 8, IS_T0);
#ifdef PROF_A
    int n_stamp = 0;
#define STAMP() do { if (blockIdx.x == 0 && IS_T0) MISC[16 + n_stamp] = (unsigned)__builtin_amdgcn_s_memrealtime(); ++n_stamp; } while (0)
#define TNOW() ((unsigned)__builtin_amdgcn_s_memrealtime())
#define TACC(k, t0) do { if (blockIdx.x == 0 && IS_T0) MISC[40 + (k)] += TNOW() - (t0); } while (0)
#define PVAL(a0, a1) (((a0) >= 100) ? MISC[40 + (a0) - 100] : (MISC[16 + (a1)] - MISC[16 + (a0)]))
#else
#define STAMP() do {} while (0)
#define TNOW() 0u
#define TACC(k, t0) do { (void)(t0); } while (0)
#endif
    STAMP();

#define x_p ((const float*)args.in[0])
#define x_s ((const float*)args.in[1])
#define st_in ((const float*)args.in[2])
#define cache_k ((const float*)args.in[3])
#define cache_v ((const float*)args.in[4])
#define ptab ((const int*)args.in[5])
#define norm_mix_a ((const float*)args.in[6])
#define w_in ((const float*)args.in[7])
#define lbl ((const float*)args.in[8])
#define onorm ((const float*)args.in[9])
#define w_out ((const float*)args.in[10])
#define norm_kv ((const float*)args.in[11])
#define w_kv ((const float*)args.in[12])
#define k_norm ((const float*)args.in[13])
#define norm_mix_b ((const float*)args.in[14])
#define w_q ((const float*)args.in[15])
#define q_norm ((const float*)args.in[16])
#define w_o ((const float*)args.in[17])
#define norm_ffn ((const float*)args.in[18])
#define w_gu ((const float*)args.in[19])
#define w_dn ((const float*)args.in[20])
#define Win_t ((bf16*)(ws + WS_WIN))
#define Wout_t ((bf16*)(ws + WS_WOUT))
#define Wgu0_t ((bf16*)(ws + WS_WGU0))
#define Wdn0_t ((bf16*)(ws + WS_WDN0))
#define Wkvq_t ((bf16*)(ws + WS_WKVQ))
#define Wo_t ((bf16*)(ws + WS_WO))
#define Wgu1_t ((bf16*)(ws + WS_WGU1))
#define Wdn1_t ((bf16*)(ws + WS_WDN1))
#define Hb0 ((bf16*)(ws + WS_HB0))
#define Hb1 ((bf16*)(ws + WS_HB1))
#define Hb2 ((bf16*)(ws + WS_HB2))
#define Hb3 ((bf16*)(ws + WS_HB3))
#define Hf1 ((float*)(ws + WS_HF1))
#define Hf2 ((float*)(ws + WS_HF2))
#define Hf3 ((float*)(ws + WS_HF3))
#define Qg ((bf16*)(ws + WS_QG))
#define Vg ((bf16*)(ws + WS_VG))
#define Gg ((bf16*)(ws + WS_GG))
#define Ff ((f16*)(ws + WS_F))
#define Ob ((bf16*)(ws + WS_OB))
#define At ((bf16*)(ws + WS_AT))
#define Hm ((bf16*)(ws + WS_HM))
#define Ug ((float*)(ws + WS_U))
#define Sg0 ((float*)(ws + WS_SST))
#define Dg ((float*)(ws + WS_DEC))
#define Kraw ((float*)(ws + WS_KRAW))
#define Vraw ((float*)(ws + WS_VRAW))
#define Qraw ((bf16*)(ws + WS_QRAW))
#define Kb ((bf16*)(ws + WS_KB))
#define Vb ((bf16*)(ws + WS_VB))
#define Qb ((bf16*)(ws + WS_QB))
#define Kpart ((float*)(ws + WS_KPART))
#define Kms ((float*)(ws + WS_KMS))
#define Subl ((unsigned*)(ws + WS_SUBL))
#define Scnt ((unsigned*)(ws + WS_SCNT))
#define Sels ((unsigned*)(ws + WS_SCNT + 256 * 1024))
#define Oslot ((bf16*)(ws + WS_OSLOT))
#define MLslot ((float*)(ws + WS_MLSLOT))
#define Sslot ((float*)(ws + WS_SSLOT))
#define ss0 ((float*)(ctl + CW_SS0))
#define ss1 ((float*)(ctl + CW_SS1))
#define ss2 ((float*)(ctl + CW_SS2))
#define ss3 ((float*)(ctl + CW_SS3))
#define out (args.out)
    {
        TIDS;
        LAS float* scr = (LAS float*)(lds + wave * 17408);
        const int gw = bid * NWAVES + wave, NGW = G * NWAVES;
        constexpr int I_IN = 32 * 128, I_SQ = 32 * 32, I_GU = 32 * 176, I_DN = 88 * 32, I_KV = 32 * 16;
        constexpr int NITEMS = I_IN + I_SQ + 2 * I_GU + 2 * I_DN + I_KV + I_SQ + I_SQ;
        for (int it = gw; it < NITEMS; it += NGW) {
            int r = it;
            if (r < I_IN) { p0_transpose_item(w_in, D, 4 * D, Win_t, 0, 0, norm_mix_a, scr, r, lane); continue; } r -= I_IN;
            if (r < I_SQ) { p0_transpose_item(w_out, D, D, Wout_t, 0, 0, nullptr, scr, r, lane); continue; } r -= I_SQ;
            if (r < I_GU) { p0_transpose_item(w_gu, D, NGU, Wgu0_t, 0, 1, norm_ffn, scr, r, lane); continue; } r -= I_GU;
            if (r < I_GU) { p0_transpose_item(w_gu + (size_t)D * NGU, D, NGU, Wgu1_t, 0, 1, norm_ffn + D, scr, r, lane); continue; } r -= I_GU;
            if (r < I_DN) { p0_transpose_item(w_dn, DFF, D, Wdn0_t, 0, 0, nullptr, scr, r, lane); continue; } r -= I_DN;
            if (r < I_DN) { p0_transpose_item(w_dn + (size_t)DFF * D, DFF, D, Wdn1_t, 0, 0, nullptr, scr, r, lane); continue; } r -= I_DN;
            if (r < I_KV) { p0_transpose_item(w_kv, D, 1024, Wkvq_t, 0, 0, norm_kv, scr, r, lane); continue; } r -= I_KV;
            if (r < I_SQ) { p0_transpose_item(w_q, D, D, Wkvq_t, 1024, 0, norm_mix_b, scr, r, lane); continue; } r -= I_SQ;
            p0_transpose_item(w_o, D, D, Wo_t, 0, 0, nullptr, scr, r, lane);
        }
        for (int m = gw; m < MR; m += NGW) {
            const float* src = (m < SEQ) ? x_p + (size_t)m * D : x_s + (size_t)(m - SEQ) * D;
            const f32x4* xr = (const f32x4*)src + lane; f32x4 v[8]; float s = 0.f;
#pragma unroll
            for (int j = 0; j < 8; ++j) { v[j] = __builtin_nontemporal_load(xr + 64 * j); s += (v[j].x * v[j].x + v[j].y * v[j].y) + (v[j].z * v[j].z + v[j].w * v[j].w); }
            s = wave_sum(s);
            if (lane == 0) ss0[m] = s;
            v2u* o8 = (v2u*)(Hb0 + (size_t)m * D) + lane;
#pragma unroll
            for (int j = 0; j < 8; ++j) { v2u w; w.x = pk2(v[j].x, v[j].y); w.y = pk2(v[j].z, v[j].w); o8[64 * j] = w; }
        }
        __syncthreads();
        kmean_items(lds, cache_k, ptab, Kms, 848, DECB * NBLK, 0, G, TIDX);
    }
    xcd_barrier(bar, IS_T0);
    STAMP();

    {
        TIDS;
        pg8::Gemm g{Hb0, Win_t, SEQ, 4 * D, D}; pg8::StaticOrder S; S.init(SEQ, 4 * D, G, bid);
        EpiIn E{ss0, lbl, Qg, Ff};
        pg8::gemm_phase<EpiIn, pg8::StaticOrder, true, true, false>(lds, g, S, E, TIDX);
        for (int it2 = 0; it2 < 2; ++it2) {
            const int w2 = bid + 256 * it2, t2 = w2 & 255, rh = (w2 >> 8) & 1;
            TIDS; f32x4 ta[2]; tail_gemm<2, D>(lds, Hb0 + (size_t)SEQ * D, Win_t, 32 * t2, rh, ta, TIDX, bid & 127);
            if (wave < 4) { const int row = SEQ + 64 * rh + 16 * wave + fr; E.tail(row, 32 * t2 + 4 * fq, ta[0]); E.tail(row, 32 * t2 + 16 + 4 * fq, ta[1]); }
        }
    }
    xcd_barrier(bar, IS_T0);
    STAMP();

    {
        TIDS;
        LAS float* tot = (LAS float*)(lds);
        LAS float* decs = (LAS float*)(lds + 2048);
        LAS bf16* koT = (LAS bf16*)(lds + 4096);
        LAS bf16* Vr = (LAS bf16*)(lds + 4096 + 128 * 72 * 2);
        const int col = tid & 127, part = tid >> 7; const int vt_t = tid >> 3, vd0 = (tid & 7) * 16;
        f16 fN[16]; v4u vaN, vbN;
#define P2_LOADN(it_) do { const int h_ = (it_) >> 7, r0_ = ((it_) & 127) * 64; const f16* fp_ = Ff + (size_t)(r0_ + part * 16) * D + h_ * 128 + col; \
            _Pragma("unroll") for (int i = 0; i < 16; ++i) fN[i] = fp_[(size_t)i * D]; \
            const bf16* vp_ = Vg + (size_t)(r0_ + vt_t) * D + h_ * 128 + vd0; vaN = *(const v4u*)vp_; vbN = *(const v4u*)(vp_ + 8); } while (0)
        for (int it = bid; it < NH * 16; it += G) {
            const int h = it >> 4, g = it & 15;
            f32x4 S[8];
#pragma unroll
            for (int vt = 0; vt < 8; ++vt) S[vt] = (f32x4){0.f, 0.f, 0.f, 0.f};
            float dtot = 1.0f;
            P2_LOADN(h * 128 + 8 * g);
#pragma unroll 1
            for (int j = 0; j < 8; ++j) {
                const int item = h * 128 + 8 * g + j;
                float cum[16], kk[16]; float run = 0.f;
#pragma unroll
                for (int i = 0; i < 16; ++i) { kk[i] = (float)fN[i]; const float f = 1.0f - kk[i]; run += __logf(f); cum[i] = run; }
                tot[part * 128 + col] = run;
                *(LAS v4u*)(Vr + vt_t * 144 + vd0) = vaN; *(LAS v4u*)(Vr + vt_t * 144 + vd0 + 8) = vbN;
                if (j < 7) P2_LOADN(item + 1);
                __syncthreads();
                float offs = 0.f, lastv = 0.f;
#pragma unroll
                for (int p = 0; p < 4; ++p) { const float tv = tot[p * 128 + col]; lastv += tv; if (p < part) offs += tv; }
                unsigned kw[8];
#pragma unroll
                for (int i = 0; i < 8; ++i) { const float a = kk[2 * i] * __expf(lastv - (cum[2 * i] + offs)), b2 = kk[2 * i + 1] * __expf(lastv - (cum[2 * i + 1] + offs)); kw[i] = pk2(a, b2); }
                *(LAS v4u*)(koT + col * 72 + part * 16) = (v4u){kw[0], kw[1], kw[2], kw[3]};
                *(LAS v4u*)(koT + col * 72 + part * 16 + 8) = (v4u){kw[4], kw[5], kw[6], kw[7]};
                if (part == 0) { const float dc = __expf(lastv); decs[col] = dc; dtot *= dc; }
                __syncthreads();
                { bf16x8 a[2]; a[0] = *(const LAS bf16x8*)(koT + (16 * wave + fr) * 72 + 8 * fq); a[1] = *(const LAS bf16x8*)(koT + (16 * wave + fr) * 72 + 32 + 8 * fq);
                  const f32x4 dv = *(const LAS f32x4*)(decs + 16 * wave + 4 * fq);
                  const LAS bf16* vb = Vr + (8 * fq + (fr >> 2)) * 144 + 4 * (fr & 3);
#pragma unroll
                  for (int vt = 0; vt < 8; ++vt) {
                      f32x4 acc = {0.f, 0.f, 0.f, 0.f};
                      const v2u l0 = tr_read(vb + 16 * vt), h0 = tr_read(vb + 4 * 144 + 16 * vt), l1 = tr_read(vb + 32 * 144 + 16 * vt), h1 = tr_read(vb + 36 * 144 + 16 * vt);
                      const v4u b0 = {l0.x, l0.y, h0.x, h0.y}, b1 = {l1.x, l1.y, h1.x, h1.y};
                      acc = MFMA16(a[0], __builtin_bit_cast(bf16x8, b0), acc); acc = MFMA16(a[1], __builtin_bit_cast(bf16x8, b1), acc);
                      S[vt] = dv * S[vt] + acc;
                  } }
                __syncthreads();
            }
            float* ug = Ug + (size_t)it * 16384;
#pragma unroll
            for (int vt = 0; vt < 8; ++vt) *(f32x4*)(ug + (size_t)(16 * vt + fr) * 128 + 16 * wave + 4 * fq) = S[vt];
            if (part == 0) Dg[(size_t)it * 128 + col] = dtot;
        }
#undef P2_LOADN
        LAS float* red = (LAS float*)(lds);
        LAS float* red2 = (LAS float*)(lds + 8192);
        float* st_out = out + OST_S;
        for (int item = bid; item < DECB * NH; item += G) {
            const int b = item >> 4, h = item & 15; const int vd = tid & 127, kq = tid >> 7;
            const float* sp = st_in + ((size_t)(b * NH + h) * 128 + 32 * kq) * 128 + vd;
            float Sx[32];
#pragma unroll
            for (int i = 0; i < 32; ++i) Sx[i] = __builtin_nontemporal_load(sp + (size_t)i * 128);
#pragma unroll
            for (int t = 0; t < 4; ++t) {
                const int row = SEQ + 4 * b + t; const size_t ro = (size_t)row * D + h * 128;
                const float v = bf2f(Vg[ro + vd]); float op = 0.f;
#pragma unroll
                for (int i = 0; i < 32; ++i) { const float f = 1.0f - (float)Ff[ro + 32 * kq + i]; const float q = bf2f(Qg[ro + 32 * kq + i]); Sx[i] = f * Sx[i] + (1.0f - f) * v; op += Sx[i] * q; }
                red[(t * 4 + kq) * 128 + vd] = op;
            }
            float* so = st_out + ((size_t)(b * NH + h) * 128 + 32 * kq) * 128 + vd;
#pragma unroll
            for (int i = 0; i < 32; ++i) __builtin_nontemporal_store(Sx[i], so + (size_t)i * 128);
            __syncthreads();
            { const int t = tid >> 7; const float o = (red[(t * 4 + 0) * 128 + vd] + red[(t * 4 + 1) * 128 + vd]) + (red[(t * 4 + 2) * 128 + vd] + red[(t * 4 + 3) * 128 + vd]);
              const float s = wave_sum(o * o); if (lane == 0) red2[t * 2 + (wave & 1)] = s;
              __syncthreads();
              const float r = rsqrtf((red2[t * 2] + red2[t * 2 + 1]) * (1.0f / 128.0f) + EPS);
              const int row = SEQ + 4 * b + t; const size_t ro = (size_t)row * D + h * 128 + vd;
              Ob[ro] = (bf16)f2bf(o * r * onorm[vd] * bf2f(Gg[ro])); }
            __syncthreads();
        }
    }
    xcd_barrier(bar, IS_T0);
    STAMP();

    {
        TIDS;
        for (int gid = bid * NTHR + tid; gid < NH * 128 * 32; gid += G * NTHR) {
            const int h = gid >> 12, rem = gid & 4095, vd = rem >> 5, k = (rem & 31) * 4;
            f32x4 sv = {0.f, 0.f, 0.f, 0.f};
#pragma unroll
            for (int g = 0; g < 16; ++g) {
                const size_t idx = ((size_t)(h * 16 + g) * 128 + vd) * 128 + k;
                const f32x4 u = *(const f32x4*)(Ug + idx), d = *(const f32x4*)(Dg + (size_t)(h * 16 + g) * 128 + k);
                *(f32x4*)(Sg0 + idx) = sv;
                sv = d * sv + u;
            }
            float* so = out + OST_P + ((size_t)h * 128 + k) * 128 + vd;
            so[0] = sv[0]; so[128] = sv[1]; so[256] = sv[2]; so[384] = sv[3];
        }
    }
    xcd_barrier(bar, IS_T0);
    STAMP();

    {
        TIDS;
        LAS float* tot = (LAS float*)(lds);
        LAS float* refs = (LAS float*)(lds + 2048);
        LAS float* red = (LAS float*)(lds + 2560);
        LAS float* decs = (LAS float*)(lds + 3072);
        LAS bf16* QE = (LAS bf16*)(lds + 4096);
        LAS bf16* KE = QE + 64 * 136;
        LAS bf16* QI = KE + 64 * 136;
        LAS bf16* Vr = QI + 64 * 136;
        LAS bf16* STs = Vr + 64 * 144;
        LAS bf16* koT = STs + 128 * 136;
        const int col = tid & 127, part = tid >> 7; const int vt_t = tid >> 3, vd0 = (tid & 7) * 16;
        const int tt = wave & 3, vh = wave >> 2;
        f16 fN[16]; bf16 qN[16]; v4u vaN, vbN;
#define P4_LOADN(it_) do { const int h_ = (it_) >> 7, r0_ = ((it_) & 127) * 64; const f16* fp_ = Ff + (size_t)(r0_ + part * 16) * D + h_ * 128 + col; const bf16* qp_ = Qg + (size_t)(r0_ + part * 16) * D + h_ * 128 + col; \
            _Pragma("unroll") for (int i = 0; i < 16; ++i) { fN[i] = fp_[(size_t)i * D]; qN[i] = qp_[(size_t)i * D]; } \
            const bf16* vp_ = Vg + (size_t)(r0_ + vt_t) * D + h_ * 128 + vd0; vaN = *(const v4u*)vp_; vbN = *(const v4u*)(vp_ + 8); } while (0)
        for (int it = bid; it < NH * 16; it += G) {
            const int hh = it >> 4, gg = it & 15;
            f32x4 S[8];
            { const float* sg = Sg0 + (size_t)it * 16384;
#pragma unroll
              for (int vt = 0; vt < 8; ++vt) { S[vt] = *(const f32x4*)(sg + (size_t)(16 * vt + fr) * 128 + 16 * wave + 4 * fq);
                  v2u w; w.x = cvt_pk_bf16(S[vt][0], S[vt][1]); w.y = cvt_pk_bf16(S[vt][2], S[vt][3]); *(LAS v2u*)(STs + (16 * vt + fr) * 136 + 16 * wave + 4 * fq) = w; } }
            P4_LOADN(hh * 128 + 8 * gg);
#pragma unroll 1
            for (int jc = 0; jc < 8; ++jc) {
            const int item = hh * 128 + 8 * gg + jc;
            const int h = item >> 7, c = item & 127; const int row0 = c * 64;
            float cum[16], kk[16], qv[16]; float run = 0.f;
#pragma unroll
            for (int i = 0; i < 16; ++i) { kk[i] = (float)fN[i]; const float f = 1.0f - kk[i]; run += __logf(f); cum[i] = run; qv[i] = bf2f(qN[i]); }
            tot[part * 128 + col] = run;
            *(LAS v4u*)(Vr + vt_t * 144 + vd0) = vaN; *(LAS v4u*)(Vr + vt_t * 144 + vd0 + 8) = vbN;
            const size_t ro = (size_t)(row0 + 16 * tt + fr) * D + h * 128;
            v2u gw2[4]; f32x4 on[4];
#pragma unroll
            for (int vt = 0; vt < 4; ++vt) { const int vd = 16 * (4 * vh + vt) + 4 * fq; gw2[vt] = *(const v2u*)(Gg + ro + vd); on[vt] = *(const f32x4*)(onorm + vd); }
            if (jc < 7) P4_LOADN(item + 1);
            __syncthreads();
            float offs = 0.f, lastv = 0.f;
#pragma unroll
            for (int p = 0; p < 4; ++p) { const float tv = tot[p * 128 + col]; lastv += tv; if (p < part) offs += tv; }
            if (part == 1) refs[col] = cum[15] + offs;
            if (part == 0) decs[col] = __expf(lastv);
            __syncthreads();
            const float ref = refs[col];
#pragma unroll
            for (int i = 0; i < 16; ++i) { const float cm = cum[i] + offs, d1 = cm - ref; const int t = part * 16 + i;
                QE[t * 136 + col] = (bf16)f2bf(qv[i] * __expf(d1)); KE[t * 136 + col] = (bf16)f2bf(kk[i] * __expf(-d1)); QI[t * 136 + col] = (bf16)f2bf(qv[i] * __expf(cm)); }
            { unsigned kw[8];
#pragma unroll
              for (int i = 0; i < 8; ++i) { const float a = kk[2 * i] * __expf(lastv - (cum[2 * i] + offs)), b2 = kk[2 * i + 1] * __expf(lastv - (cum[2 * i + 1] + offs)); kw[i] = pk2(a, b2); }
              *(LAS v4u*)(koT + col * 72 + part * 16) = (v4u){kw[0], kw[1], kw[2], kw[3]};
              *(LAS v4u*)(koT + col * 72 + part * 16 + 8) = (v4u){kw[4], kw[5], kw[6], kw[7]}; }
            __syncthreads();
            {
                f32x4 aS[4];
#pragma unroll
                for (int st = 0; st < 4; ++st) {
                    aS[st] = (f32x4){0.f, 0.f, 0.f, 0.f};
                    if (st <= tt) {
#pragma unroll
                        for (int ks = 0; ks < 4; ++ks) { const bf16x8 a = *(const LAS bf16x8*)(KE + (16 * st + fr) * 136 + 32 * ks + 8 * fq), b = *(const LAS bf16x8*)(QE + (16 * tt + fr) * 136 + 32 * ks + 8 * fq); aS[st] = MFMA16(a, b, aS[st]); }
                        if (st == tt) {
#pragma unroll
                            for (int r = 0; r < 4; ++r) if (4 * fq + r > fr) aS[st][r] = 0.f;
                        }
                    }
                }
                f32x4 o[4];
#pragma unroll
                for (int vt = 0; vt < 4; ++vt) o[vt] = (f32x4){0.f, 0.f, 0.f, 0.f};
#pragma unroll
                for (int j = 0; j < 2; ++j) {
                    v4u pw; pw.x = cvt_pk_bf16(aS[2 * j][0], aS[2 * j][1]); pw.y = cvt_pk_bf16(aS[2 * j][2], aS[2 * j][3]); pw.z = cvt_pk_bf16(aS[2 * j + 1][0], aS[2 * j + 1][1]); pw.w = cvt_pk_bf16(aS[2 * j + 1][2], aS[2 * j + 1][3]);
                    const bf16x8 pf = __builtin_bit_cast(bf16x8, pw);
                    const LAS bf16* vb = Vr + (32 * j + 4 * fq + (fr >> 2)) * 144 + 64 * vh + 4 * (fr & 3);
#pragma unroll
                    for (int vt = 0; vt < 4; ++vt) { const v2u lo = tr_read(vb + 16 * vt), hi = tr_read(vb + 16 * 144 + 16 * vt); const v4u aw = {lo.x, lo.y, hi.x, hi.y};
                        o[vt] = MFMA16(__builtin_bit_cast(bf16x8, aw), pf, o[vt]); }
                }
#pragma unroll
                for (int ks = 0; ks < 4; ++ks) { const bf16x8 b = *(const LAS bf16x8*)(QI + (16 * tt + fr) * 136 + 32 * ks + 8 * fq);
#pragma unroll
                    for (int vt = 0; vt < 4; ++vt) { const bf16x8 a = *(const LAS bf16x8*)(STs + (16 * (4 * vh + vt) + fr) * 136 + 32 * ks + 8 * fq); o[vt] = MFMA16(a, b, o[vt]); } }
                float sq = 0.f;
#pragma unroll
                for (int vt = 0; vt < 4; ++vt) sq += (o[vt][0] * o[vt][0] + o[vt][1] * o[vt][1]) + (o[vt][2] * o[vt][2] + o[vt][3] * o[vt][3]);
                sq += shx<16>(sq); sq = xadd32(sq);
                if (fq == 0) red[(16 * tt + fr) * 2 + vh] = sq;
                __syncthreads();
                const float r = rsqrtf((red[(16 * tt + fr) * 2] + red[(16 * tt + fr) * 2 + 1]) * (1.0f / 128.0f) + EPS);
#pragma unroll
                for (int vt = 0; vt < 4; ++vt) { const int vd = 16 * (4 * vh + vt) + 4 * fq;
                    const float g0 = bf2f(gw2[vt].x & 0xffffu), g1 = bf2f(gw2[vt].x >> 16), g2 = bf2f(gw2[vt].y & 0xffffu), g3 = bf2f(gw2[vt].y >> 16);
                    v2u w; w.x = cvt_pk_bf16(o[vt][0] * r * on[vt][0] * g0, o[vt][1] * r * on[vt][1] * g1); w.y = cvt_pk_bf16(o[vt][2] * r * on[vt][2] * g2, o[vt][3] * r * on[vt][3] * g3);
                    *(v2u*)(Ob + ro + vd) = w; }
            }
            if (jc < 7) {
                bf16x8 a[2]; a[0] = *(const LAS bf16x8*)(koT + (16 * wave + fr) * 72 + 8 * fq); a[1] = *(const LAS bf16x8*)(koT + (16 * wave + fr) * 72 + 32 + 8 * fq);
                const f32x4 dv = *(const LAS f32x4*)(decs + 16 * wave + 4 * fq);
                const LAS bf16* vb = Vr + (8 * fq + (fr >> 2)) * 144 + 4 * (fr & 3);
#pragma unroll
                for (int vt = 0; vt < 8; ++vt) {
                    f32x4 acc = {0.f, 0.f, 0.f, 0.f};
                    const v2u l0 = tr_read(vb + 16 * vt), h0 = tr_read(vb + 4 * 144 + 16 * vt), l1 = tr_read(vb + 32 * 144 + 16 * vt), h1 = tr_read(vb + 36 * 144 + 16 * vt);
                    const v4u b0 = {l0.x, l0.y, h0.x, h0.y}, b1 = {l1.x, l1.y, h1.x, h1.y};
                    acc = MFMA16(a[0], __builtin_bit_cast(bf16x8, b0), acc); acc = MFMA16(a[1], __builtin_bit_cast(bf16x8, b1), acc);
                    S[vt] = dv * S[vt] + acc;
                    v2u w; w.x = cvt_pk_bf16(S[vt][0], S[vt][1]); w.y = cvt_pk_bf16(S[vt][2], S[vt][3]); *(LAS v2u*)(STs + (16 * vt + fr) * 136 + 16 * wave + 4 * fq) = w;
                }
            }
            __syncthreads();
            }
        }
#undef P4_LOADN
    }
    xcd_barrier(bar, IS_T0);
    STAMP();

    {
        TIDS;
        pg8::Gemm g{Ob, Wout_t, SEQ, D, D}; pg8::StaticOrder S; S.init(SEQ, D, G, bid);
        EpiRes<1> E{Hb0, nullptr, nullptr, Hb1, ss1};
        const unsigned tg0 = TNOW();
        pg8::gemm_phase<EpiRes<1>, pg8::StaticOrder, true, true, false>(lds, g, S, E, TIDX);
        TACC(5, tg0); const unsigned tg1 = TNOW();
        { const int t2 = bid & 127, rh = (bid >> 7) & 1; TIDS; f32x4 ta[1]; tail_gemm<1, D>(lds, Ob + (size_t)SEQ * D, Wout_t, 16 * t2, rh, ta, TIDX, bid & 127); if (wave < 4) E.tail(SEQ + 64 * rh + 16 * wave + fr, 16 * t2 + 4 * fq, ta[0], fq); }
        TACC(6, tg1);
    }
    xcd_barrier(bar, IS_T0);
    STAMP();
    {
        TIDS;
        pg8::Gemm g{Hb1, Wgu0_t, MP, NGU, D}; pg8::StaticOrder S; S.init(MP, NGU, G, bid);
        EpiGU E{ss1, Hm};
        pg8::gemm_phase<EpiGU, pg8::StaticOrder, true, true>(lds, g, S, E, TIDX);
        kmean_items(lds, cache_k, ptab, Kms, 0, 336, 172, G - 172, TIDX);
    }
    xcd_barrier(bar, IS_T0);
    STAMP();
    {
        TIDS;
        pg8::Gemm g{Hm, Wdn0_t, SEQ, D, DFF}; pg8::StaticOrder S; S.init(SEQ, D, G, bid);
        EpiRes<1> E{Hb1, nullptr, nullptr, Hb2, ss2};
        const unsigned tg0 = TNOW();
        pg8::gemm_phase<EpiRes<1>, pg8::StaticOrder, true, true, false>(lds, g, S, E, TIDX);
        TACC(7, tg0); const unsigned tg1 = TNOW();
        { const int t2 = bid & 127, rh = (bid >> 7) & 1; TIDS; f32x4 ta[1]; tail_gemm<1, DFF>(lds, Hm + (size_t)SEQ * DFF, Wdn0_t, 16 * t2, rh, ta, TIDX, bid & 127); if (wave < 4) E.tail(SEQ + 64 * rh + 16 * wave + fr, 16 * t2 + 4 * fq, ta[0], fq); }
        TACC(8, tg1);
    }
    xcd_barrier(bar, IS_T0);
    STAMP();
    {
        TIDS;
        pg8::Gemm g{Hb2, Wkvq_t, MP, 3072, D}; pg8::StaticOrder S; S.init(MP, 3072, G, bid);
        EpiKVQ E{ss2, ws, out, k_norm, q_norm, lds + 131072};
        pg8::gemm_phase<EpiKVQ, pg8::StaticOrder, true, true>(lds, g, S, E, TIDX);
        kmean_items(lds, cache_k, ptab, Kms, 336, 848, 140, G - 140, TIDX);
    }
    xcd_barrier(bar, IS_T0);
    STAMP();

    {
        TIDS;
        LAS bf16* KMb = (LAS bf16*)(lds);
        LAS unsigned* lcnt = (LAS unsigned*)(lds + 16384);
        LAS float* gs = (LAS float*)(lds + 16384 + 256);
#define G_BETTER(va, ia, vb, ib) (((va) > (vb)) || (((va) == (vb)) && ((ia) < (ib))))
#define G_INSERT(vx, ix) do { const float vx_ = (vx); const int ix_ = (ix); \
            if (G_BETTER(vx_, ix_, v0, i0)) { v2 = v1; i2 = i1; v1 = v0; i1 = i0; v0 = vx_; i0 = ix_; } \
            else if (G_BETTER(vx_, ix_, v1, i1)) { v2 = v1; i2 = i1; v1 = vx_; i1 = ix_; } \
            else if (G_BETTER(vx_, ix_, v2, i2)) { v2 = vx_; i2 = ix_; } } while (0)
        for (int item = bid; item < 256; item += G) {
            const int j = item >> 2, kvh = item & 3; const int b = j >> 1;
            { const int n = tid >> 4, d8 = (tid & 15) * 8; f32x4 s0 = {0.f, 0.f, 0.f, 0.f}, s1 = {0.f, 0.f, 0.f, 0.f};
              if (n < b) { const float* kp = Kpart + (size_t)n * 512 + kvh * 128 + d8; s0 = *(const f32x4*)kp; s1 = *(const f32x4*)(kp + 4); }
              s0 = s0 * (1.0f / 256.0f); s1 = s1 * (1.0f / 256.0f);
              v4u w; w.x = cvt_pk_bf16(s0[0], s0[1]); w.y = cvt_pk_bf16(s0[2], s0[3]); w.z = cvt_pk_bf16(s1[0], s1[1]); w.w = cvt_pk_bf16(s1[2], s1[3]);
              *(LAS v4u*)(KMb + n * 136 + d8) = w; }
            if (tid < 32) lcnt[tid] = 0u;
            __syncthreads();
            const int nsel = b < 3 ? b : 3;
#pragma unroll 1
            for (int rt = 0; rt < 4; ++rt) {
                const int r = 64 * wave + 16 * rt + fr; const int tok = j * 128 + (r >> 2), hg = r & 3; const bf16* qp = Qb + (size_t)tok * D + (4 * kvh + hg) * 128 + 8 * fq;
                bf16x8 qf[4];
#pragma unroll
                for (int ks = 0; ks < 4; ++ks) qf[ks] = *(const bf16x8*)(qp + 32 * ks);
                f32x4 ga[2];
#pragma unroll
                for (int nt = 0; nt < 2; ++nt) { ga[nt] = (f32x4){0.f, 0.f, 0.f, 0.f};
#pragma unroll
                    for (int ks = 0; ks < 4; ++ks) { const bf16x8 ka = *(const LAS bf16x8*)(KMb + (16 * nt + fr) * 136 + 32 * ks + 8 * fq); ga[nt] = MFMA16(ka, qf[ks], ga[nt]); } }
                float v0 = -INFINITY, v1 = -INFINITY, v2 = -INFINITY; int i0 = 99, i1 = 99, i2 = 99;
#pragma unroll
                for (int nt = 0; nt < 2; ++nt)
#pragma unroll
                    for (int q = 0; q < 4; ++q) { const int n = 16 * nt + 4 * fq + q; if (n < b) G_INSERT(ga[nt][q], n); }
                { const float a0 = shx<16>(v0), a1 = shx<16>(v1), a2 = shx<16>(v2);
                  const int c0 = __builtin_amdgcn_ds_swizzle(i0, (16 << 10) | 0x1f), c1 = __builtin_amdgcn_ds_swizzle(i1, (16 << 10) | 0x1f), c2 = __builtin_amdgcn_ds_swizzle(i2, (16 << 10) | 0x1f);
                  G_INSERT(a0, c0); G_INSERT(a1, c1); G_INSERT(a2, c2); }
                {
                  auto p0 = __builtin_amdgcn_permlane32_swap(__float_as_uint(v0), __float_as_uint(v0), false, false); auto p1 = __builtin_amdgcn_permlane32_swap(__float_as_uint(v1), __float_as_uint(v1), false, false);
                  auto p2 = __builtin_amdgcn_permlane32_swap(__float_as_uint(v2), __float_as_uint(v2), false, false);
                  auto q0 = __builtin_amdgcn_permlane32_swap((unsigned)i0, (unsigned)i0, false, false); auto q1 = __builtin_amdgcn_permlane32_swap((unsigned)i1, (unsigned)i1, false, false);
                  auto q2 = __builtin_amdgcn_permlane32_swap((unsigned)i2, (unsigned)i2, false, false);
                  v0 = __uint_as_float(p0[0]); v1 = __uint_as_float(p1[0]); v2 = __uint_as_float(p2[0]); i0 = (int)q0[0]; i1 = (int)q1[0]; i2 = (int)q2[0];
                  G_INSERT(__uint_as_float(p0[1]), (int)q0[1]); G_INSERT(__uint_as_float(p1[1]), (int)q1[1]); G_INSERT(__uint_as_float(p2[1]), (int)q2[1]); }
                if (fq == 0) {
#pragma unroll
                    for (int rk = 0; rk < 3; ++rk) {
                        if (rk < nsel) { const int best = (rk == 0) ? i0 : ((rk == 1) ? i1 : i2);
                            const unsigned pos = atomicAdd((unsigned*)&lcnt[best], 1u);
                            Subl[((size_t)(j * 4 + kvh) * 32 + best) * 512 + pos] = (unsigned)r | ((unsigned)rk << 9); }
                    }
                }
            }
            __syncthreads();
            if (tid < 32) Scnt[(j * 4 + kvh) * 32 + tid] = lcnt[tid];
            __syncthreads();
        }
#undef G_BETTER
#undef G_INSERT
        for (int item = bid; item < DECB * NKV; item += G) {
            const int b = item >> 2, kvh = item & 3; const int pr = tid >> 5, n = tid & 31;
            const int row = SEQ + 4 * b + (pr >> 2), hg = pr & 3; const bf16* qp = Qb + (size_t)row * D + (4 * kvh + hg) * 128; const float* kmp = Kms + ((size_t)(b * 32 + n)) * 512 + kvh * 128;
            float s = 0.f;
#pragma unroll 4
            for (int d = 0; d < 128; d += 8) { const v4u qw = *(const v4u*)(qp + d); const f32x4 k0 = *(const f32x4*)(kmp + d), k1 = *(const f32x4*)(kmp + d + 4);
                s += (bf2f(qw.x & 0xffffu) * k0[0] + bf2f(qw.x >> 16) * k0[1]) + (bf2f(qw.y & 0xffffu) * k0[2] + bf2f(qw.y >> 16) * k0[3]) + (bf2f(qw.z & 0xffffu) * k1[0] + bf2f(qw.z >> 16) * k1[1]) + (bf2f(qw.w & 0xffffu) * k1[2] + bf2f(qw.w >> 16) * k1[3]); }
            gs[pr * 32 + n] = s;
            __syncthreads();
            if (tid < 16) { unsigned m = 0u;
                for (int r = 0; r < 3; ++r) { int best = 0; float bv = -INFINITY; for (int nn = 0; nn < 32; ++nn) { const float v = gs[tid * 32 + nn]; if (v > bv) { bv = v; best = nn; } } m |= 1u << best; gs[tid * 32 + best] = -INFINITY; }
                Sels[item * 16 + tid] = m; }
            __syncthreads();
        }
    }
    xcd_barrier(bar, IS_T0);
    STAMP();

    {
        LAS bf16* Ks = (LAS bf16*)(lds); LAS bf16* Vs = (LAS bf16*)(lds + KS_BYTES);
        LAS unsigned* qsh = (LAS unsigned*)(lds + 2 * KS_BYTES);
        constexpr int NPI = 4 * 496, NSI = DECB * NKV * NBLK;
        for (;;) {
            const unsigned tq0 = TNOW();
            if (IS_T0) qsh[0] = __hip_atomic_fetch_add(ctl + CW_Q0, 1u, __ATOMIC_RELAXED, __HIP_MEMORY_SCOPE_AGENT);
            __syncthreads();
            const int tick = (int)qsh[0];
            __syncthreads();
            TACC(0, tq0);
            if (tick >= NPI + NSI) break;
            TIDS;
            int item; { const int g3 = tick / 3, r3 = tick - 3 * g3; item = (tick < 3 * NPI) ? ((r3 == 0) ? g3 : NPI + 2 * g3 + (r3 - 1)) : NPI + (tick - NPI); }
            if (item < NPI) {
                int b = (int)((1.0f + sqrtf(1.0f + 2.0f * (float)item)) * 0.5f); while (2 * b * (b - 1) > item) --b; while (2 * (b + 1) * b <= item) ++b;
                const int rem = item - 2 * b * (b - 1); const int n = rem >> 2, kvh = rem & 3;
                const int cntA = (int)Scnt[((2 * b) * 4 + kvh) * 32 + n], cntB = (int)Scnt[((2 * b + 1) * 4 + kvh) * 32 + n]; const int total = cntA + cntB;
                if (total == 0) continue;
                const unsigned tp0 = TNOW();
#pragma unroll
                for (int i = 0; i < 8; ++i) { const int idx = i * 512 + tid, key = idx >> 4, c8 = idx & 15; *(LAS v4u*)(Ks + key * KS_P + c8 * 8) = *(const v4u*)(Kb + (size_t)(256 * n + key) * 512 + kvh * 128 + c8 * 8); }
#pragma unroll
                for (int i = 0; i < 8; ++i) { const int idx = i * 512 + tid, key = idx >> 4, c8 = idx & 15; *(LAS v4u*)(Vs + key * KS_P + c8 * 8) = *(const v4u*)(Vb + (size_t)(256 * n + key) * 512 + kvh * 128 + c8 * 8); }
                __syncthreads();
                TACC(1, tp0); const unsigned tp1 = TNOW();
                const unsigned* LA = Subl + ((size_t)((2 * b) * 4 + kvh) * 32 + n) * 512; const unsigned* LB = Subl + ((size_t)((2 * b + 1) * 4 + kvh) * 32 + n) * 512;
#define LIST_ENT(i_) (((i_) < cntA) ? LA[(i_)] : LB[(i_) - cntA])
                const int iw = 16 * wave + fr;
                unsigned e1 = 0u, e2 = 0u; int ic1 = 0, ic2 = 0;
                if (16 * wave < total) { ic1 = iw < total ? iw : total - 1; e1 = LIST_ENT(ic1); }
                if (16 * wave + 128 < total) { ic2 = iw + 128 < total ? iw + 128 : total - 1; e2 = LIST_ENT(ic2); }
                bf16x8 qn[4];
                { const int tokn = ((ic1 < cntA) ? 2 * b : 2 * b + 1) * 128 + (int)((e1 >> 2) & 127u); const bf16* qp = Qb + (size_t)tokn * D + (4 * kvh + (int)(e1 & 3u)) * 128 + 8 * fq;
#pragma unroll
                  for (int ks = 0; ks < 4; ++ks) qn[ks] = *(const bf16x8*)(qp + 32 * ks); }
                for (int t0 = 0; t0 < total; t0 += 128) {
                    const int i0 = t0 + 16 * wave; if (i0 >= total) break;
                    const bool valid = (i0 + fr) < total; const int ic = ic1; const unsigned e = e1;
                    const int tok = ((ic < cntA) ? 2 * b : 2 * b + 1) * 128 + (int)((e >> 2) & 127u), hg = (int)(e & 3u), rk = (int)(e >> 9);
                    const int h = 4 * kvh + hg;
                    bf16x8 qf[4];
#pragma unroll
                    for (int ks = 0; ks < 4; ++ks) qf[ks] = qn[ks];
                    e1 = e2; ic1 = ic2;
                    if (i0 + 256 < total) { ic2 = (i0 + 256 + fr) < total ? (i0 + 256 + fr) : total - 1; e2 = LIST_ENT(ic2); }
                    if (i0 + 128 < total) { const int tokn = ((ic1 < cntA) ? 2 * b : 2 * b + 1) * 128 + (int)((e1 >> 2) & 127u); const bf16* qp = Qb + (size_t)tokn * D + (4 * kvh + (int)(e1 & 3u)) * 128 + 8 * fq;
#pragma unroll
                        for (int ks = 0; ks < 4; ++ks) qn[ks] = *(const bf16x8*)(qp + 32 * ks); }
                    f32x4 acc[16]; attn_scores<16>(Ks, qf, acc, 16, fr, fq);
                    float mx = -INFINITY;
#pragma unroll
                    for (int kt = 0; kt < 16; ++kt) mx = fmaxf(fmaxf(mx, fmaxf(acc[kt][0], acc[kt][1])), fmaxf(acc[kt][2], acc[kt][3]));
                    mx = fmaxf(mx, shx<16>(mx)); mx = xmax32(mx);
                    float l = 0.f;
#pragma unroll
                    for (int kt = 0; kt < 16; ++kt) {
#pragma unroll
                        for (int r = 0; r < 4; ++r) { const float p = __builtin_amdgcn_exp2f(acc[kt][r] - mx); acc[kt][r] = p; l += p; } }
                    l += shx<16>(l); l = xadd32(l);
                    f32x4 O[8];
#pragma unroll
                    for (int vt = 0; vt < 8; ++vt) O[vt] = (f32x4){0.f, 0.f, 0.f, 0.f};
                    attn_pv(Vs, acc, O, 8, fr, fq);
                    if (valid) {
                        const size_t slot = ((size_t)tok * NH + h) * 3 + rk; bf16* op = Oslot + slot * 128 + 4 * fq;
#pragma unroll
                        for (int vt = 0; vt < 8; ++vt) { v2u w; w.x = cvt_pk_bf16(O[vt][0], O[vt][1]); w.y = cvt_pk_bf16(O[vt][2], O[vt][3]); *(v2u*)(op + 16 * vt) = w; }
                        if (fq == 0) { MLslot[slot * 2] = mx; MLslot[slot * 2 + 1] = l; }
                    }
                }
                __syncthreads();
                TACC(2, tp1);
            } else {
                const int si = item - NPI; const int b = si >> 7, kvh = (si >> 5) & 3, n = si & 31;
                unsigned any = 0u;
#pragma unroll
                for (int p = 0; p < 16; ++p) any |= Sels[(b * 4 + kvh) * 16 + p];
                if (!((any >> n) & 1u)) continue;
                const unsigned ts0 = TNOW();
                const int pg0 = ptab[b * NPAGES + 2 * n], pg1 = ptab[b * NPAGES + 2 * n + 1];
                f32x4 kst[16], vst[16];
#pragma unroll
                for (int i = 0; i < 16; ++i) { const int idx = i * 512 + tid, key = idx >> 5, c4 = idx & 31; const int page = (key < 128) ? pg0 : pg1;
                    const size_t go = (((size_t)page * PAGE + (key & 127)) * NKV + kvh) * 128 + c4 * 4;
                    kst[i] = __builtin_nontemporal_load((const f32x4*)(cache_k + go)); vst[i] = __builtin_nontemporal_load((const f32x4*)(cache_v + go)); }
#pragma unroll
                for (int i = 0; i < 16; ++i) { const int idx = i * 512 + tid, key = idx >> 5, c4 = idx & 31; const int page = (key < 128) ? pg0 : pg1; (void)page;
                    const f32x4 kk4 = kst[i], vv4 = vst[i];
                    v2u w; w.x = cvt_pk_bf16(kk4[0], kk4[1]); w.y = cvt_pk_bf16(kk4[2], kk4[3]); *(LAS v2u*)(Ks + key * KS_P + c4 * 4) = w;
                    v2u wv; wv.x = cvt_pk_bf16(vv4[0], vv4[1]); wv.y = cvt_pk_bf16(vv4[2], vv4[3]); *(LAS v2u*)(Vs + key * KS_P + c4 * 4) = wv; }
                __syncthreads();
                TACC(3, ts0); const unsigned ts1 = TNOW();
                {
                    LAS float* mxs = (LAS float*)(lds + 2 * KS_BYTES + 64); LAS float* lss = mxs + 128; LAS float* Ored = (LAS float*)(lds);
                    const int row = SEQ + 4 * b + (fr >> 2), hg = fr & 3; const int h = 4 * kvh + hg; const bf16* qp = Qb + (size_t)row * D + h * 128 + 8 * fq;
                    bf16x8 qf[4];
#pragma unroll
                    for (int ks = 0; ks < 4; ++ks) qf[ks] = *(const bf16x8*)(qp + 32 * ks);
                    f32x4 a2[2];
#pragma unroll
                    for (int t = 0; t < 2; ++t) { a2[t] = (f32x4){0.f, 0.f, 0.f, 0.f};
#pragma unroll
                        for (int ks = 0; ks < 4; ++ks) { const bf16x8 ka = *(const LAS bf16x8*)(Ks + (16 * (2 * wave + t) + fr) * KS_P + 32 * ks + 8 * fq); a2[t] = MFMA16(ka, qf[ks], a2[t]); } }
                    float mx = fmaxf(fmaxf(fmaxf(a2[0][0], a2[0][1]), fmaxf(a2[0][2], a2[0][3])), fmaxf(fmaxf(a2[1][0], a2[1][1]), fmaxf(a2[1][2], a2[1][3])));
                    mx = fmaxf(mx, shx<16>(mx)); mx = xmax32(mx);
                    if (fq == 0) mxs[wave * 16 + fr] = mx;
                    __syncthreads();
                    float M = mxs[fr];
#pragma unroll
                    for (int w8 = 1; w8 < 8; ++w8) M = fmaxf(M, mxs[w8 * 16 + fr]);
                    float l = 0.f;
#pragma unroll
                    for (int t = 0; t < 2; ++t) {
#pragma unroll
                        for (int r = 0; r < 4; ++r) { const float p = __builtin_amdgcn_exp2f(a2[t][r] - M); a2[t][r] = p; l += p; } }
                    l += shx<16>(l); l = xadd32(l);
                    if (fq == 0) lss[wave * 16 + fr] = l;
                    v4u pw; pw.x = cvt_pk_bf16(a2[0][0], a2[0][1]); pw.y = cvt_pk_bf16(a2[0][2], a2[0][3]); pw.z = cvt_pk_bf16(a2[1][0], a2[1][1]); pw.w = cvt_pk_bf16(a2[1][2], a2[1][3]);
                    const bf16x8 pf = __builtin_bit_cast(bf16x8, pw);
                    const LAS bf16* vb = Vs + (32 * wave + 4 * fq + (fr >> 2)) * KS_P + 4 * (fr & 3);
#pragma unroll
                    for (int vt = 0; vt < 8; ++vt) { const v2u lo = tr_read(vb + 16 * vt), hi = tr_read(vb + 16 * KS_P + 16 * vt); const v4u aw = {lo.x, lo.y, hi.x, hi.y};
                        const f32x4 o = MFMA16(__builtin_bit_cast(bf16x8, aw), pf, ((f32x4){0.f, 0.f, 0.f, 0.f}));
                        *(LAS f32x4*)(Ored + (wave * 16 + fr) * 132 + 16 * vt + 4 * fq) = o; }
                    __syncthreads();
                    { const int r16 = tid >> 5, c4 = tid & 31; f32x4 so = *(const LAS f32x4*)(Ored + r16 * 132 + 4 * c4);
#pragma unroll
                      for (int w8 = 1; w8 < 8; ++w8) so += *(const LAS f32x4*)(Ored + (w8 * 16 + r16) * 132 + 4 * c4);
                      float* sp = Sslot + ((size_t)((b * 4 + kvh) * 32 + n) * 16 + r16) * 132;
                      *(f32x4*)(sp + 4 * c4) = so;
                      if (c4 == 0) { float Mr = mxs[r16], lt = lss[r16];
#pragma unroll
                          for (int w8 = 1; w8 < 8; ++w8) { Mr = fmaxf(Mr, mxs[w8 * 16 + r16]); lt += lss[w8 * 16 + r16]; }
                          sp[128] = Mr; sp[129] = lt; } }
                }
                __syncthreads();
                TACC(4, ts1);
            }
        }
    }
    xcd_barrier(bar, IS_T0);
    STAMP();

    {
        TIDS;
        LAS bf16* Ks = (LAS bf16*)(lds); LAS bf16* Vs = (LAS bf16*)(lds + KS_BYTES);
        for (int item = bid; item < NBLK * NKV * 2; item += G) {
            const int b = item >> 3, kvh = (item >> 1) & 3, hp = item & 1;
#pragma unroll
            for (int i = 0; i < 8; ++i) { const int idx = i * 512 + tid, key = idx >> 4, c8 = idx & 15; *(LAS v4u*)(Ks + key * KS_P + c8 * 8) = *(const v4u*)(Kb + (size_t)(256 * b + key) * 512 + kvh * 128 + c8 * 8); }
#pragma unroll
            for (int i = 0; i < 8; ++i) { const int idx = i * 512 + tid, key = idx >> 4, c8 = idx & 15; *(LAS v4u*)(Vs + key * KS_P + c8 * 8) = *(const v4u*)(Vb + (size_t)(256 * b + key) * 512 + kvh * 128 + c8 * 8); }
            const int nsel = b < 3 ? b : 3;
            bf16x8 qn[4];
            { const bf16* qp = Qb + (size_t)(256 * b + 16 * wave + fr) * D + (4 * kvh + 2 * hp) * 128 + 8 * fq;
#pragma unroll
              for (int ks = 0; ks < 4; ++ks) qn[ks] = *(const bf16x8*)(qp + 32 * ks); }
            __syncthreads();
#pragma unroll 1
            for (int u = 0; u < 4; ++u) {
                const int g = (u & 1) ? 15 - wave : wave, h = 4 * kvh + 2 * hp + (u >> 1); const int tl = 16 * g + fr; const int tok = 256 * b + tl;
                bf16x8 qf[4];
#pragma unroll
                for (int ks = 0; ks < 4; ++ks) qf[ks] = qn[ks];
                if (u < 3) { const int gn = ((u + 1) & 1) ? 15 - wave : wave, hn = 4 * kvh + 2 * hp + ((u + 1) >> 1); const bf16* qp = Qb + (size_t)(256 * b + 16 * gn + fr) * D + hn * 128 + 8 * fq;
#pragma unroll
                    for (int ks = 0; ks < 4; ++ks) qn[ks] = *(const bf16x8*)(qp + 32 * ks); }
                float msa[3], lsa[3];
#pragma unroll
                for (int r = 0; r < 3; ++r) { msa[r] = -INFINITY; lsa[r] = 0.f; if (r < nsel) { const size_t slot = ((size_t)tok * NH + h) * 3 + r; msa[r] = MLslot[slot * 2]; lsa[r] = MLslot[slot * 2 + 1]; } }
                const int nkt = g + 1;
                f32x4 acc[16]; attn_scores<16>(Ks, qf, acc, nkt, fr, fq);
                float mx = -INFINITY;
#pragma unroll
                for (int kt = 0; kt < 16; ++kt) {
#pragma unroll
                    for (int r = 0; r < 4; ++r) { const bool ok = (kt < nkt) && (16 * kt + 4 * fq + r <= tl); const float sv = ok ? acc[kt][r] : -INFINITY; acc[kt][r] = sv; mx = fmaxf(mx, sv); } }
                mx = fmaxf(mx, shx<16>(mx)); mx = xmax32(mx);
                float M = mx;
#pragma unroll
                for (int r = 0; r < 3; ++r) M = fmaxf(M, msa[r]);
                float l = 0.f;
#pragma unroll
                for (int kt = 0; kt < 16; ++kt) {
#pragma unroll
                    for (int r = 0; r < 4; ++r) { const float p = __builtin_amdgcn_exp2f(acc[kt][r] - M); acc[kt][r] = p; l += p; } }
                l += shx<16>(l); l = xadd32(l);
                f32x4 O[8];
#pragma unroll
                for (int vt = 0; vt < 8; ++vt) O[vt] = (f32x4){0.f, 0.f, 0.f, 0.f};
                attn_pv(Vs, acc, O, (nkt + 1) >> 1, fr, fq);
#pragma unroll
                for (int r = 0; r < 3; ++r) { if (r < nsel) { const float sc = __builtin_amdgcn_exp2f(msa[r] - M); l += lsa[r] * sc; const size_t slot = ((size_t)tok * NH + h) * 3 + r; const bf16* op = Oslot + slot * 128 + 4 * fq;
#pragma unroll
                    for (int vt = 0; vt < 8; ++vt) { const v2u w = *(const v2u*)(op + 16 * vt); O[vt][0] += bf2f(w.x & 0xffffu) * sc; O[vt][1] += bf2f(w.x >> 16) * sc; O[vt][2] += bf2f(w.y & 0xffffu) * sc; O[vt][3] += bf2f(w.y >> 16) * sc; } } }
                const float il = 1.0f / l; bf16* ap = At + (size_t)tok * D + h * 128 + 4 * fq;
#pragma unroll
                for (int vt = 0; vt < 8; ++vt) { v2u w; w.x = cvt_pk_bf16(O[vt][0] * il, O[vt][1] * il); w.y = cvt_pk_bf16(O[vt][2] * il, O[vt][3] * il); *(v2u*)(ap + 16 * vt) = w; }
            }
            __syncthreads();
        }
        LAS float* ksn = (LAS float*)(lds);
        for (int item = bid; item < DECB * NKV; item += G) {
            const int b = item >> 2, kvh = item & 3;
            { const int key = tid >> 7, d = tid & 127; ksn[key * 128 + d] = out[OK_S + (size_t)(4 * b + key) * 512 + kvh * 128 + d]; ksn[512 + key * 128 + d] = out[OV_S + (size_t)(4 * b + key) * 512 + kvh * 128 + d]; }
            __syncthreads();
            const int pr = tid >> 5, l32 = tid & 31; const int t = pr >> 2, hg = pr & 3; const int row = SEQ + 4 * b + t, h = 4 * kvh + hg;
            const v2u qw = *(const v2u*)(Qb + (size_t)row * D + h * 128 + 4 * l32);
            const float q0 = bf2f(qw.x & 0xffffu), q1 = bf2f(qw.x >> 16), q2 = bf2f(qw.y & 0xffffu), q3 = bf2f(qw.y >> 16);
            float sk[4]; float M = -INFINITY;
#pragma unroll
            for (int key = 0; key < 4; ++key) { const f32x4 k4 = *(const LAS f32x4*)(ksn + key * 128 + 4 * l32); float s = (q0 * k4[0] + q1 * k4[1]) + (q2 * k4[2] + q3 * k4[3]);
                s += shx<1>(s); s += shx<2>(s); s += shx<4>(s); s += shx<8>(s); s += shx<16>(s);
                sk[key] = (key <= t) ? s : -INFINITY; M = fmaxf(M, sk[key]); }
            const unsigned mask = Sels[item * 16 + pr];
#pragma unroll 1
            for (int n = 0; n < 32; ++n) if ((mask >> n) & 1u) M = fmaxf(M, Sslot[((size_t)(item * 32 + n) * 16 + pr) * 132 + 128]);
            float l = 0.f; f32x4 O = {0.f, 0.f, 0.f, 0.f};
#pragma unroll
            for (int key = 0; key < 4; ++key) { const float p = __builtin_amdgcn_exp2f(sk[key] - M); l += p; O += *(const LAS f32x4*)(ksn + 512 + key * 128 + 4 * l32) * p; }
#pragma unroll 1
            for (int n = 0; n < 32; ++n) if ((mask >> n) & 1u) { const float* sp = Sslot + ((size_t)(item * 32 + n) * 16 + pr) * 132; const float sc = __builtin_amdgcn_exp2f(sp[128] - M); l += sp[129] * sc; O += *(const f32x4*)(sp + 4 * l32) * sc; }
            const float il = 1.0f / l; v2u w; w.x = cvt_pk_bf16(O[0] * il, O[1] * il); w.y = cvt_pk_bf16(O[2] * il, O[3] * il);
            *(v2u*)(At + (size_t)row * D + h * 128 + 4 * l32) = w;
            __syncthreads();
        }
    }
    xcd_barrier(bar, IS_T0);
    STAMP();

    {
        TIDS;
        pg8::Gemm g{At, Wo_t, SEQ, D, D}; pg8::StaticOrder S; S.init(SEQ, D, G, bid);
        EpiRes<1> E{Hb2, nullptr, nullptr, Hb3, ss3};
        pg8::gemm_phase<EpiRes<1>, pg8::StaticOrder, true, true, false>(lds, g, S, E, TIDX);
        { const int t2 = bid & 127, rh = (bid >> 7) & 1; TIDS; f32x4 ta[1]; tail_gemm<1, D>(lds, At + (size_t)SEQ * D, Wo_t, 16 * t2, rh, ta, TIDX, bid & 127); if (wave < 4) E.tail(SEQ + 64 * rh + 16 * wave + fr, 16 * t2 + 4 * fq, ta[0], fq); }
    }
    xcd_barrier(bar, IS_T0);
    STAMP();
    {
        TIDS;
        pg8::Gemm g{Hb3, Wgu1_t, MP, NGU, D}; pg8::StaticOrder S; S.init(MP, NGU, G, bid);
        EpiGU E{ss3, Hm};
        pg8::gemm_phase<EpiGU, pg8::StaticOrder, true, true>(lds, g, S, E, TIDX);
    }
    xcd_barrier(bar, IS_T0);
    STAMP();
    {
        TIDS;
        pg8::Gemm g{Hm, Wdn1_t, SEQ, D, DFF}; pg8::StaticOrder S; S.init(SEQ, D, G, bid);
        EpiRes<2> E{Hb3, out + OY_P, out + OY_S, nullptr, nullptr};
        pg8::gemm_phase<EpiRes<2>, pg8::StaticOrder, true, true, false>(lds, g, S, E, TIDX);
        { const int t2 = bid & 127, rh = (bid >> 7) & 1; TIDS; f32x4 ta[1]; tail_gemm<1, DFF>(lds, Hm + (size_t)SEQ * DFF, Wdn1_t, 16 * t2, rh, ta, TIDX, bid & 127); if (wave < 4) E.tail(SEQ + 64 * rh + 16 * wave + fr, 16 * t2 + 4 * fq, ta[0], fq); }
    }
#ifdef PROF_A
    STAMP();
    if (blockIdx.x == 0 && IS_T0) {
        const unsigned ta = PVAL(PROF_A0, PROF_A1), tb = PVAL(PROF_B0, PROF_B1);
        unsigned qa = (ta + PROF_UA / 2) / PROF_UA, qb = (tb + PROF_UB / 2) / PROF_UB; if (qa > 99u) qa = 99u; if (qb > 99u) qb = 99u;
#ifdef PROF_MUL
        const unsigned long long extra = (unsigned long long)ta * PROF_MUL;
#else
        const unsigned long long extra = (unsigned long long)(qa + 100u * qb) * 5000ull;
#endif
        const unsigned long long t0 = __builtin_amdgcn_s_memrealtime();
        while (__builtin_amdgcn_s_memrealtime() - t0 < extra) __builtin_amdgcn_s_sleep(32);
    }
#endif
}
#undef x_p
#undef x_s
#undef st_in
#undef cache_k
#undef cache_v
#undef ptab
#undef norm_mix_a
#undef w_in
#undef lbl
#undef onorm
#undef w_out
#undef norm_kv
#undef w_kv
#undef k_norm
#undef norm_mix_b
#undef w_q
#undef q_norm
#undef w_o
#undef norm_ffn
#undef w_gu
#undef w_dn
#undef Win_t
#undef Wout_t
#undef Wgu0_t
#undef Wdn0_t
#undef Wkvq_t
#undef Wo_t
#undef Wgu1_t
#undef Wdn1_t
#undef Hb0
#undef Hb1
#undef Hb2
#undef Hb3
#undef Hf1
#undef Hf2
#undef Hf3
#undef Qg
#undef Vg
#undef Gg
#undef Ff
#undef Ob
#undef At
#undef Hm
#undef Ug
#undef Sg0
#undef Dg
#undef Kraw
#undef Vraw
#undef Qraw
#undef Kb
#undef Vb
#undef Qb
#undef Kpart
#undef Kms
#undef Subl
#undef Scnt
#undef Sels
#undef Oslot
#undef MLslot
#undef Sslot
#undef ss0
#undef ss1
#undef ss2
#undef ss3
#undef out
#undef TIDS
#undef TIDX
#undef IS_T0

extern "C" void kernel_launch(void* const* d_in, const int* in_sizes, int n_in, void* d_out, int out_size, void* d_ws, size_t ws_size, hipStream_t stream) {
    static int grid = 0;
    if (grid == 0) {
        if (n_in != 21 || ws_size < WS_END) { fprintf(stderr, "kernel_launch: unexpected n_in %d / ws %zu\n", n_in, ws_size); grid = -1; return; }
        int dev = 0, cus = 0, per_cu = 0;
        if (hipGetDevice(&dev) != hipSuccess || hipDeviceGetAttribute(&cus, hipDeviceAttributeMultiprocessorCount, dev) != hipSuccess) { grid = -1; return; }
        if (hipFuncSetAttribute((const void*)yoco_fwd, hipFuncAttributeMaxDynamicSharedMemorySize, LDS_BYTES) != hipSuccess) { fprintf(stderr, "kernel_launch: hipFuncSetAttribute failed\n"); grid = -1; return; }
        if (hipOccupancyMaxActiveBlocksPerMultiprocessor(&per_cu, (const void*)yoco_fwd, NTHR, LDS_BYTES) != hipSuccess || per_cu < 1) fprintf(stderr, "kernel_launch: occupancy query says %d\n", per_cu);
        (void)hipGetLastError();
        grid = cus;
        if (grid < 256) { fprintf(stderr, "kernel_launch: built for 256 CUs (got %d)\n", grid); grid = -1; return; }
        grid = 256;
    }
    if (grid < 0) return;
    (void)hipMemsetAsync((char*)d_ws + WS_CTL, 0, CTL_ZERO_BYTES, stream);
    Args a{};
    for (int i = 0; i < 21; ++i) a.in[i] = d_in[i];
    a.out = (float*)d_out; a.ws = (unsigned char*)d_ws;
    hipLaunchKernelGGL(yoco_fwd, dim3(grid), dim3(NTHR), LDS_BYTES, stream, a);
}
```

```cpp
#include <hip/hip_runtime.h>
#include <cstdio>
#include <cstdint>
__device__ __forceinline__ int lane_id() { int l; asm volatile("v_mbcnt_lo_u32_b32 %0, -1, 0\n\tv_mbcnt_hi_u32_b32 %0, -1, %0" : "=v"(l)); return l; }

namespace pg8 {
#define PG8_LAS __attribute__((address_space(3)))
typedef unsigned short bf16_t;
typedef short bf16x8 __attribute__((ext_vector_type(8)));
typedef float f32x4 __attribute__((ext_vector_type(4)));
typedef unsigned u32x4 __attribute__((ext_vector_type(4)));
typedef unsigned u32x2 __attribute__((ext_vector_type(2)));
constexpr int BM = 256, BK = 64, HALF = 128, HTB = HALF * BK * 2, STAGE_BYTES = 8 * HTB, NXCD = 8, WGM = 8;

__host__ __device__ __forceinline__ int lds_byte(int r, int c) { const int st = (r >> 4) * 2 + (c >> 5), rr = r & 15, cc = c & 31, ob = rr * 64 + cc * 2; return st * 1024 + (ob ^ (((ob >> 9) & 1) << 5)); }
__host__ __device__ __forceinline__ void stage_rc(int b, int& R, int& C) { const int st = b / 1024, sb = b % 1024, swz = sb ^ (((sb >> 9) & 1) << 5); R = (st >> 1) * 16 + swz / 64; C = (st & 1) * 32 + (swz % 64) / 2; }
__host__ __device__ __forceinline__ int perm32(int rho) { const int n = rho >> 4, i = rho & 15; return 8 * (i >> 2) + 4 * n + (i & 3); }

struct Unit { int pm, pn; };
struct Gemm { const bf16_t* A; const bf16_t* Bt; int M, N, K; };

struct StaticOrder {
    int nM, nN, nwg, G, c;
    __host__ __device__ void init(int M, int N, int G_, int c_) { nM = M / BM; nN = N / BM; nwg = nM * nN; G = G_; c = c_; }
    __host__ __device__ bool next(int i, Unit& u) const {
        const long L = (long)i * G + c; if (L >= nwg) return false;
        int wgid = (int)L; { const int q = nwg / NXCD, r = nwg % NXCD, xcd = wgid % NXCD, off = wgid / NXCD; wgid = (xcd < r ? xcd * (q + 1) : r * (q + 1) + (xcd - r) * q) + off; }
        const int nig = WGM * nN, gid = wgid / nig, fm = gid * WGM, gsz = (nM - fm) < WGM ? (nM - fm) : WGM;
        u.pm = fm + ((wgid % nig) % gsz); u.pn = (wgid % nig) / gsz; return true;
    }
    __device__ __forceinline__ void a_ready(const Unit&) const {}
    __device__ __forceinline__ void done(const Unit&) const {}
};

__device__ __forceinline__ unsigned cvt_pk_bf16(float lo, float hi) { unsigned r; asm volatile("v_cvt_pk_bf16_f32 %0, %1, %2" : "=v"(r) : "v"(lo), "v"(hi)); return r; }

template <class Epi, class Sched, bool ALIGN_EPI = false, bool SP2 = false, bool HALF_LAST = true>
__device__ __forceinline__ void gemm_phase(PG8_LAS unsigned char* lds, const Gemm g, const Sched& S, const Epi& E, int tidx) {
    int tid_ = tidx; asm volatile("" : "+v"(tid_));
    const int tid = tid_, wid = __builtin_amdgcn_readfirstlane(tid >> 6), lane = tid & 63, wr = wid >> 2, wc = wid & 3, fr = lane & 15, fq = lane >> 4;
    const int K = g.K, nt = K / BK;
    unsigned voffA[2], voffB[2];
#pragma unroll
    for (int i = 0; i < 2; ++i) { int R, C; stage_rc(tid * 16 + i * 8192, R, C); const int Rb = Epi::PERM ? ((R & ~31) + perm32(R & 31)) : R;
        voffA[i] = (unsigned)(R * K + C) * 2u; voffB[i] = (unsigned)(Rb * K + C) * 2u; }
    const size_t kstep = (size_t)(BK * 2);
    const size_t hstep = (size_t)HALF * K * 2;
    const size_t tstep = 2 * hstep;
    const unsigned ldsw = (unsigned)wid * 1024u;
    const int aoff = lds_byte(wr * 64 + fr, fq * 8), boff = lds_byte(wc * 32 + fr, fq * 8);
#define PG8_SA(b, h) (((b) * 2 + (h)) * HTB)
#define PG8_SB(b, h) ((4 + (b) * 2 + (h)) * HTB)
#define PG8_STAGE(bufoff, gbase, voff) do { _Pragma("unroll") for (int _i = 0; _i < 2; ++_i) \
        __builtin_amdgcn_global_load_lds((const unsigned*)((const char*)(gbase) + (voff)[_i]), (PG8_LAS unsigned*)(lds + (bufoff) + ldsw + _i * 8192), 16, 0, 0); } while (0)
#define PG8_LDA(dst, b, h) do { _Pragma("unroll") for (int m = 0; m < 4; ++m) _Pragma("unroll") for (int k = 0; k < 2; ++k) dst[m][k] = *(const PG8_LAS bf16x8*)(lds + PG8_SA(b, h) + aoff + m * 2048 + k * 1024); } while (0)
#define PG8_LDB(dst, b, h) do { _Pragma("unroll") for (int n = 0; n < 2; ++n) _Pragma("unroll") for (int k = 0; k < 2; ++k) dst[n][k] = *(const PG8_LAS bf16x8*)(lds + PG8_SB(b, h) + boff + n * 2048 + k * 1024); } while (0)
#define PG8_MMA(ai, bj, At, Bt) do { __builtin_amdgcn_s_setprio(1); _Pragma("unroll") for (int m = 0; m < 4; ++m) _Pragma("unroll") for (int n = 0; n < 2; ++n) _Pragma("unroll") for (int k = 0; k < 2; ++k) \
        acc[ai][bj][m][n] = __builtin_amdgcn_mfma_f32_16x16x32_bf16(Bt[n][k], At[m][k], acc[ai][bj][m][n], 0, 0, 0); __builtin_amdgcn_s_setprio(0); } while (0)
#define PG8_WAIT_V(n) asm volatile("s_waitcnt vmcnt(" #n ")" ::: "memory")
#define PG8_WAIT_L(n) asm volatile("s_waitcnt lgkmcnt(" #n ")" ::: "memory")
#define PG8_BAR __builtin_amdgcn_s_barrier()
#define PG8_SCHED __builtin_amdgcn_sched_barrier(0)
    Unit cur, nxt; int ui = 0;
    if (!S.next(0, cur)) return;
    f32x4 acc[2][2][4][2];
#pragma unroll
    for (int a = 0; a < 2; ++a)
#pragma unroll
        for (int b = 0; b < 2; ++b)
#pragma unroll
            for (int m = 0; m < 4; ++m)
#pragma unroll
                for (int n = 0; n < 2; ++n) acc[a][b][m][n] = (f32x4){0.f, 0.f, 0.f, 0.f};
    bf16x8 At[4][2], B0[2][2], B1[2][2];
    const char* cA = (const char*)g.A + (size_t)cur.pm * tstep; const char* cB = (const char*)g.Bt + (size_t)cur.pn * tstep;
    S.a_ready(cur);
    if constexpr (SP2) {
        PG8_STAGE(PG8_SB(0, 0), cB, voffB); PG8_STAGE(PG8_SB(0, 1), cB + hstep, voffB); PG8_STAGE(PG8_SA(0, 0), cA, voffA); PG8_STAGE(PG8_SA(0, 1), cA + hstep, voffA);
        if (wr == 1) PG8_BAR;
        PG8_WAIT_V(2); PG8_BAR;
        PG8_STAGE(PG8_SB(1, 0), cB + kstep, voffB); PG8_STAGE(PG8_SA(1, 0), cA + kstep, voffA); PG8_STAGE(PG8_SB(1, 1), cB + hstep + kstep, voffB);
        PG8_WAIT_V(6); PG8_BAR;
    } else {
        PG8_STAGE(PG8_SB(0, 0), cB, voffB); PG8_STAGE(PG8_SA(0, 0), cA, voffA); PG8_STAGE(PG8_SB(0, 1), cB + hstep, voffB); PG8_STAGE(PG8_SA(0, 1), cA + hstep, voffA);
        if (wr == 1) PG8_BAR;
        PG8_WAIT_V(4); PG8_BAR;
        PG8_STAGE(PG8_SB(1, 0), cB + kstep, voffB); PG8_STAGE(PG8_SA(1, 0), cA + kstep, voffA); PG8_STAGE(PG8_SB(1, 1), cB + hstep + kstep, voffB);
        PG8_WAIT_V(6); PG8_BAR;
    }
    for (;;) {
        const bool has_next = S.next(ui + 1, nxt);
        const bool half1 = HALF_LAST && (cur.pm == g.M / BM - 1);
        const char* nA = has_next ? (const char*)g.A + (size_t)nxt.pm * tstep : cA; const char* nB = has_next ? (const char*)g.Bt + (size_t)nxt.pn * tstep : cB;
        for (int t = 0; t < nt; t += 2) {
            const bool last = (t == nt - 2);
            const char* a1 = cA + (size_t)(t + 1) * kstep;
            const char* a2 = last ? nA : cA + (size_t)(t + 2) * kstep; const char* b2 = last ? nB : cB + (size_t)(t + 2) * kstep;
            const char* a3 = a2 + kstep; const char* b3 = b2 + kstep;
            if (last && has_next) S.a_ready(nxt);
            if constexpr (SP2) {
            PG8_LDB(B0, 0, 0); PG8_LDB(B1, 0, 1); PG8_SCHED; PG8_LDA(At, 0, 0); PG8_STAGE(PG8_SA(1, 1), a1 + hstep, voffA);
            PG8_WAIT_V(8); PG8_WAIT_L(0); PG8_BAR; PG8_MMA(0, 0, At, B0); PG8_MMA(0, 1, At, B1); PG8_BAR; PG8_SCHED;
            if (!half1) { PG8_LDA(At, 0, 1); } PG8_STAGE(PG8_SB(0, 0), b2, voffB); PG8_STAGE(PG8_SB(0, 1), b2 + hstep, voffB); PG8_STAGE(PG8_SA(0, 0), a2, voffA);
            PG8_WAIT_V(8); PG8_WAIT_L(0); PG8_BAR; if (!half1) { PG8_MMA(1, 0, At, B0); PG8_MMA(1, 1, At, B1); } PG8_BAR; PG8_SCHED;
            PG8_LDB(B0, 1, 0); PG8_LDB(B1, 1, 1); PG8_SCHED; PG8_LDA(At, 1, 0); PG8_STAGE(PG8_SA(0, 1), a2 + hstep, voffA);
            PG8_WAIT_V(8); PG8_WAIT_L(0); PG8_BAR; PG8_MMA(0, 0, At, B0); PG8_MMA(0, 1, At, B1); PG8_BAR; PG8_SCHED;
            if (!half1) { PG8_LDA(At, 1, 1); } PG8_STAGE(PG8_SB(1, 0), b3, voffB); PG8_STAGE(PG8_SB(1, 1), b3 + hstep, voffB); PG8_STAGE(PG8_SA(1, 0), a3, voffA);
            PG8_WAIT_V(8); PG8_WAIT_L(0); PG8_BAR; if (!half1) { PG8_MMA(1, 0, At, B0); PG8_MMA(1, 1, At, B1); } PG8_BAR; PG8_SCHED;
            } else {
            PG8_LDB(B0, 0, 0); PG8_SCHED; PG8_LDA(At, 0, 0); PG8_STAGE(PG8_SA(1, 1), a1 + hstep, voffA);
            PG8_WAIT_L(8); PG8_BAR; PG8_WAIT_L(0); PG8_MMA(0, 0, At, B0); PG8_BAR; PG8_SCHED;
            PG8_LDB(B1, 0, 1); PG8_STAGE(PG8_SB(0, 0), b2, voffB);
            PG8_BAR; PG8_WAIT_L(0); PG8_MMA(0, 1, At, B1); PG8_BAR;
            PG8_LDA(At, 0, 1); PG8_STAGE(PG8_SA(0, 0), a2, voffA);
            PG8_BAR; PG8_WAIT_L(0); PG8_MMA(1, 0, At, B0); PG8_BAR; PG8_SCHED;
            PG8_STAGE(PG8_SB(0, 1), b2 + hstep, voffB);
            PG8_WAIT_V(6); PG8_BAR; PG8_MMA(1, 1, At, B1); PG8_BAR;
            PG8_LDB(B0, 1, 0); PG8_SCHED; PG8_LDA(At, 1, 0); PG8_STAGE(PG8_SA(0, 1), a2 + hstep, voffA);
            PG8_WAIT_L(8); PG8_BAR; PG8_WAIT_L(0); PG8_MMA(0, 0, At, B0); PG8_BAR; PG8_SCHED;
            PG8_LDB(B1, 1, 1); PG8_STAGE(PG8_SB(1, 0), b3, voffB);
            PG8_BAR; PG8_WAIT_L(0); PG8_MMA(0, 1, At, B1); PG8_BAR;
            PG8_LDA(At, 1, 1); PG8_STAGE(PG8_SA(1, 0), a3, voffA);
            PG8_BAR; PG8_WAIT_L(0); PG8_MMA(1, 0, At, B0); PG8_BAR; PG8_SCHED;
            PG8_STAGE(PG8_SB(1, 1), b3 + hstep, voffB);
            PG8_WAIT_V(6); PG8_BAR; PG8_MMA(1, 1, At, B1); PG8_BAR;
            }
        }
        if constexpr (ALIGN_EPI) { if (wr == 0) PG8_BAR; }
        E(acc, cur, wr, wc, fr, fq);
        if (!has_next) break;
#pragma unroll
        for (int a = 0; a < 2; ++a)
#pragma unroll
            for (int b = 0; b < 2; ++b)
#pragma unroll
                for (int m = 0; m < 4; ++m)
#pragma unroll
                    for (int n = 0; n < 2; ++n) acc[a][b][m][n] = (f32x4){0.f, 0.f, 0.f, 0.f};
        cur = nxt; cA = nA; cB = nB; ++ui;
        if constexpr (ALIGN_EPI) { if (wr == 1) PG8_BAR; }
    }
    PG8_WAIT_V(0);
    if constexpr (!ALIGN_EPI) { if (wr == 0) PG8_BAR; }
    PG8_BAR;
#undef PG8_SA
#undef PG8_SB
#undef PG8_STAGE
#undef PG8_LDA
#undef PG8_LDB
#undef PG8_MMA
#undef PG8_WAIT_V
#undef PG8_WAIT_L
#undef PG8_BAR
#undef PG8_SCHED
}
}

constexpr int NWAVES = 8, NTHR = 512;
constexpr int D = 2048, SEQ = 8192, DECB = 32, DECS = 4, MS = DECB * DECS;
constexpr int MR = SEQ + MS;
constexpr int MP = 8448;
constexpr int NH = 16, HD = 128, NKV = 4, DFF = 5632, NGU = 2 * DFF;
constexpr int NCHUNK = SEQ / 64;
constexpr int NPAGES = 64, PAGE = 128, NBLK = 32;
constexpr float EPS = 1e-6f;
constexpr float C2 = 0.08838834764831845f * 1.4426950408889634f;

constexpr size_t OY_P = 0, OY_S = OY_P + (size_t)SEQ * D, OST_P = OY_S + (size_t)MS * D, OST_S = OST_P + (size_t)NH * 128 * 128,
                 OK_P = OST_S + (size_t)DECB * NH * 128 * 128, OV_P = OK_P + (size_t)SEQ * 512, OK_S = OV_P + (size_t)SEQ * 512, OV_S = OK_S + (size_t)MS * 512;

constexpr size_t MiB = 1u << 20;
constexpr size_t WS_CTL = 0, CTL_ZERO_BYTES = 1 * MiB;
constexpr size_t WS_WIN = 2 * MiB;
constexpr size_t WS_WOUT = WS_WIN + 32 * MiB;
constexpr size_t WS_WGU0 = WS_WOUT + 8 * MiB;
constexpr size_t WS_WDN0 = WS_WGU0 + 44 * MiB;
constexpr size_t WS_WKVQ = WS_WDN0 + 22 * MiB;
constexpr size_t WS_WO = WS_WKVQ + 12 * MiB;
constexpr size_t WS_WGU1 = WS_WO + 8 * MiB;
constexpr size_t WS_WDN1 = WS_WGU1 + 44 * MiB;
constexpr size_t WS_HB0 = WS_WDN1 + 22 * MiB;
constexpr size_t WS_HB1 = WS_HB0 + 34 * MiB, WS_HB2 = WS_HB1 + 34 * MiB, WS_HB3 = WS_HB2 + 34 * MiB;
constexpr size_t WS_HF1 = WS_HB3 + 34 * MiB;
constexpr size_t WS_HF2 = WS_HF1 + 67 * MiB, WS_HF3 = WS_HF2 + 67 * MiB;
constexpr size_t WS_QG = WS_HF3 + 67 * MiB;
constexpr size_t WS_VG = WS_QG + 34 * MiB;
constexpr size_t WS_GG = WS_VG + 34 * MiB;
constexpr size_t WS_F = WS_GG + 34 * MiB;
constexpr size_t WS_OB = WS_F + 67 * MiB;
constexpr size_t WS_AT = WS_OB + 34 * MiB;
constexpr size_t WS_HM = WS_AT + 34 * MiB;
constexpr size_t WS_U = WS_HM + 92 * MiB;
constexpr size_t WS_SST = WS_U + 64 * MiB;
constexpr size_t WS_DEC = WS_SST + 64 * MiB;
constexpr size_t WS_KRAW = WS_DEC + 2 * MiB;
constexpr size_t WS_VRAW = WS_KRAW + 17 * MiB;
constexpr size_t WS_QRAW = WS_VRAW + 17 * MiB;
constexpr size_t WS_KB = WS_QRAW + 67 * MiB;
constexpr size_t WS_VB = WS_KB + 9 * MiB;
constexpr size_t WS_QB = WS_VB + 9 * MiB;
constexpr size_t WS_KPART = WS_QB + 34 * MiB;
constexpr size_t WS_KMS = WS_KPART + 1 * MiB;
constexpr size_t WS_SUBL = WS_KMS + 2 * MiB;
constexpr size_t WS_SCNT = WS_SUBL + 16 * MiB;
constexpr size_t WS_OSLOT = WS_SCNT + 1 * MiB;
constexpr size_t WS_MLSLOT = WS_OSLOT + 192 * MiB;
constexpr size_t WS_SSLOT = WS_MLSLOT + 3 * MiB;
constexpr size_t WS_FOUT = WS_SSLOT + 34 * MiB;
constexpr size_t WS_END = WS_FOUT + 131 * MiB;
constexpr size_t WS_ORC = WS_END;
constexpr int CW_BAR = 4096;
constexpr int CW_Q0 = 8192;
constexpr int CW_SS0 = 16384, CW_SS1 = CW_SS0 + MP, CW_SS2 = CW_SS1 + MP, CW_SS3 = CW_SS2 + MP;
static_assert((CW_SS3 + MP) * 4 <= (int)CTL_ZERO_BYTES, "ctl");
static_assert(WS_VG - WS_QG == 34 * MiB && WS_GG - WS_VG == 34 * MiB, "Qg|Vg|Gg stride");

constexpr int LDS_BYTES = 160 * 1024;
constexpr int MISC_OFF = LDS_BYTES - 256;

#define GAS __attribute__((address_space(1)))
#define LAS __attribute__((address_space(3)))
typedef unsigned short bf16;
typedef unsigned v4u __attribute__((ext_vector_type(4)));
typedef unsigned v2u __attribute__((ext_vector_type(2)));
typedef float f32x4 __attribute__((ext_vector_type(4)));
typedef float f32x2 __attribute__((ext_vector_type(2)));
typedef short bf16x8 __attribute__((ext_vector_type(8)));
typedef short bf16x4 __attribute__((ext_vector_type(4)));
typedef _Float16 f16;
typedef _Float16 f16x2 __attribute__((ext_vector_type(2)));
__device__ __forceinline__ unsigned pkh2(float lo, float hi) { const f16x2 v = {(f16)lo, (f16)hi}; return __builtin_bit_cast(unsigned, v); }
#define LDS_WAIT() asm volatile("s_waitcnt lgkmcnt(0)" ::: "memory")
__device__ __forceinline__ unsigned f2bf(float f) { unsigned u = __builtin_bit_cast(unsigned, f); return (u + 0x7fffu + ((u >> 16) & 1u)) >> 16; }
__device__ __forceinline__ unsigned pk2(float lo, float hi) { return f2bf(lo) | (f2bf(hi) << 16); }
__device__ __forceinline__ float bf2f(unsigned h) { return __uint_as_float(h << 16); }
__device__ __forceinline__ float silu_f(float x) { return x * __builtin_amdgcn_rcpf(1.0f + __expf(-x)); }
__device__ __forceinline__ float sigm_f(float x) { return __builtin_amdgcn_rcpf(1.0f + __expf(-x)); }
template <int M> __device__ __forceinline__ float shx(float v) { return __uint_as_float((unsigned)__builtin_amdgcn_ds_swizzle((int)__float_as_uint(v), (M << 10) | 0x1f)); }
__device__ __forceinline__ float xadd32(float v) { auto rr = __builtin_amdgcn_permlane32_swap(__float_as_uint(v), __float_as_uint(v), false, false); return __uint_as_float(rr[0]) + __uint_as_float(rr[1]); }
__device__ __forceinline__ float xmax32(float v) { auto rr = __builtin_amdgcn_permlane32_swap(__float_as_uint(v), __float_as_uint(v), false, false); return fmaxf(__uint_as_float(rr[0]), __uint_as_float(rr[1])); }
__device__ __forceinline__ float wave_sum(float v) { v += shx<1>(v); v += shx<2>(v); v += shx<4>(v); v += shx<8>(v); v += shx<16>(v); return xadd32(v); }
#define MFMA16(a, b, c) __builtin_amdgcn_mfma_f32_16x16x32_bf16((a), (b), (c), 0, 0, 0)

#define XB_TMO      128
#define XB_XCNT(j)  (256  + 64 * (j))
#define XB_XSUB(j)  (1280 + 64 * (j))
#define XB_XGEN(j)  (2304 + 64 * (j))
#define XB_TOP      3328
#define XB_TOPGEN   3392
#define XCD_BAR_WORDS 3456
#define XB_SPIN_CAP (1u << 18)
__device__ __forceinline__ unsigned xb_ld(unsigned* p)              { return __hip_atomic_load(p, __ATOMIC_RELAXED, __HIP_MEMORY_SCOPE_AGENT); }
__device__ __forceinline__ unsigned xb_add(unsigned* p, unsigned v) { return __hip_atomic_fetch_add(p, v, __ATOMIC_RELAXED, __HIP_MEMORY_SCOPE_AGENT); }
__device__ __forceinline__ unsigned xb_xcc_id() { return (unsigned)__builtin_amdgcn_s_getreg((3 << 11) | 20) & 0xFu; }
#define XB_SPIN(cond, bar) do { unsigned _sp = 0; while (cond) { __builtin_amdgcn_s_sleep(1); \
    if ((++_sp & 255u) == 0u) { if (xb_ld(&(bar)[XB_TMO])) break; if (_sp > XB_SPIN_CAP) { atomicAdd(&(bar)[XB_TMO], 1u); break; } } } } while (0)
struct XcdBarrier { unsigned* bar; unsigned x; volatile LAS unsigned* st; };
__device__ __forceinline__ XcdBarrier xcd_barrier_post(unsigned* bar, volatile LAS unsigned* st, bool is_t0) {
    XcdBarrier b; b.bar = bar; b.x = xb_xcc_id(); b.st = st;
    if (is_t0) (void)xb_add(&bar[XB_XCNT(b.x)], 1u);
    return b;
}
__device__ __forceinline__ void xcd_barrier_complete(unsigned* bar, unsigned x, unsigned& nloc, unsigned& nx) {
    const unsigned G = gridDim.x * gridDim.y * gridDim.z;
    unsigned sum, cnt, mine, sp = 0u;
    for (;;) {
        sum = 0u; cnt = 0u; mine = 0u;
#pragma unroll
        for (unsigned j = 0; j < 16; ++j) { const unsigned c = xb_ld(&bar[XB_XCNT(j)]); sum += c; cnt += (c > 0u) ? 1u : 0u; mine = (j == x) ? c : mine; }
        if (sum == G) break;
        __builtin_amdgcn_s_sleep(1);
        if ((++sp & 255u) == 0u) { if (xb_ld(&bar[XB_TMO])) break; if (sp > XB_SPIN_CAP) { atomicAdd(&bar[XB_TMO], 1u); break; } }
    }
    nloc = mine > 0u ? mine : 1u; nx = cnt > 0u ? cnt : 1u;
}
__device__ __forceinline__ void xcd_barrier(const XcdBarrier& b, bool is_t0) {
    asm volatile("s_waitcnt vmcnt(0)" ::: "memory");
    __syncthreads();
    if (is_t0) {
        unsigned* bar = b.bar;
        __builtin_amdgcn_s_waitcnt(0);
        unsigned nloc = b.st[0], nx = b.st[1];
        if (nloc == 0u) { xcd_barrier_complete(bar, b.x, nloc, nx); b.st[0] = nloc; b.st[1] = nx; }
        const unsigned old = xb_add(&bar[XB_XSUB(b.x)], 1u);
        const unsigned gen = old / nloc;
        if (old + 1u == (gen + 1u) * nloc) {
            __builtin_amdgcn_fence(__ATOMIC_RELEASE, "agent");
            asm volatile("s_waitcnt vmcnt(0)" ::: "memory");
            const unsigned og = xb_add(&bar[XB_TOP], 1u);
            const unsigned tg = og / nx;
            if (og + 1u == (tg + 1u) * nx) xb_add(&bar[XB_TOPGEN], 1u);
            else XB_SPIN(xb_ld(&bar[XB_TOPGEN]) == tg, bar);
            __builtin_amdgcn_fence(__ATOMIC_ACQUIRE, "agent");
            xb_add(&bar[XB_XGEN(b.x)], 1u);
            asm volatile("s_waitcnt vmcnt(0)" ::: "memory");
        } else {
            XB_SPIN(xb_ld(&bar[XB_XGEN(b.x)]) == gen, bar);
            __builtin_amdgcn_fence(__ATOMIC_ACQUIRE, "agent");
            asm volatile("s_waitcnt vmcnt(0)" ::: "memory");
        }
    }
    __syncthreads();
}

using pg8::Unit; using pg8::cvt_pk_bf16;
struct EpiIn {
    static constexpr bool PERM = true;
    const float* ss; const float* lbl; bf16* Qg; f16* F;
    __device__ __forceinline__ void operator()(const f32x4 (&acc)[2][2][4][2], const Unit& u, int wr, int wc, int fr, int fq) const {
        const int seg = u.pn >> 3; const int col0 = (u.pn & 7) * 256 + wc * 32 + 8 * fq; const int rowb = u.pm * 256 + wr * 64;
        float lb[2][8];
        if (seg == 1) {
#pragma unroll
            for (int bj = 0; bj < 2; ++bj)
#pragma unroll
                for (int j = 0; j < 8; ++j) { const int c = col0 + bj * 128 + j; lb[bj][j] = __builtin_amdgcn_rcpf(1.0f + __expf(lbl[D + c] - lbl[c])); }
        }
        float rs[2][4];
#pragma unroll
        for (int ai = 0; ai < 2; ++ai)
#pragma unroll
            for (int m = 0; m < 4; ++m) rs[ai][m] = ss[rowb + ai * 128 + m * 16 + fr];
#pragma unroll
        for (int ai = 0; ai < 2; ++ai)
#pragma unroll
            for (int m = 0; m < 4; ++m) asm volatile("" : "+v"(rs[ai][m]));
#pragma unroll
        for (int ai = 0; ai < 2; ++ai)
#pragma unroll
            for (int m = 0; m < 4; ++m) {
                const int rb = rowb + ai * 128 + m * 16; if (rb >= MR) continue;
                const int row = rb + fr; const float r = rsqrtf(rs[ai][m] * (1.0f / D) + EPS);
#pragma unroll
                for (int bj = 0; bj < 2; ++bj) {
                    f32x4 v0 = acc[ai][bj][m][0] * r, v1 = acc[ai][bj][m][1] * r; const size_t off = (size_t)row * D + col0 + bj * 128;
                    if (seg == 1) {
                        f32x4 o0, o1;
#pragma unroll
                        for (int j = 0; j < 4; ++j) { o0[j] = (1.0f - lb[bj][j]) * sigm_f(-v0[j]); o1[j] = (1.0f - lb[bj][4 + j]) * sigm_f(-v1[j]); }
                        { v4u w; w.x = pkh2(o0[0], o0[1]); w.y = pkh2(o0[2], o0[3]); w.z = pkh2(o1[0], o1[1]); w.w = pkh2(o1[2], o1[3]); *(v4u*)(F + off) = w; }
                    } else {
                        if (seg != 2) {
#pragma unroll
                            for (int j = 0; j < 4; ++j) { v0[j] = silu_f(v0[j]); v1[j] = silu_f(v1[j]); }
                        }
                        v4u w; w.x = cvt_pk_bf16(v0[0], v0[1]); w.y = cvt_pk_bf16(v0[2], v0[3]); w.z = cvt_pk_bf16(v1[0], v1[1]); w.w = cvt_pk_bf16(v1[2], v1[3]);
                        const size_t dsel = (seg == 0) ? 0 : ((seg == 2) ? 1 : 2);
                        *(v4u*)(Qg + dsel * (size_t)(17 * MiB) + off) = w;
                    }
                }
            }
    }
    __device__ __forceinline__ void tail(int row, int col, f32x4 v) const {
        const int seg = col >> 11, c = col & 2047; const float r = rsqrtf(ss[row] * (1.0f / D) + EPS); v = v * r; const size_t off = (size_t)row * D + c;
        if (seg == 1) { f32x4 o;
#pragma unroll
            for (int j = 0; j < 4; ++j) { const float lbv = __builtin_amdgcn_rcpf(1.0f + __expf(lbl[D + c + j] - lbl[c + j])); o[j] = (1.0f - lbv) * sigm_f(-v[j]); }
            { v2u w; w.x = pkh2(o[0], o[1]); w.y = pkh2(o[2], o[3]); *(v2u*)(F + off) = w; }
        } else {
            if (seg != 2) {
#pragma unroll
                for (int j = 0; j < 4; ++j) v[j] = silu_f(v[j]);
            }
            v2u w; w.x = cvt_pk_bf16(v[0], v[1]); w.y = cvt_pk_bf16(v[2], v[3]);
            const size_t dsel = (seg == 0) ? 0 : ((seg == 2) ? 1 : 2);
            *(v2u*)(Qg + dsel * (size_t)(17 * MiB) + off) = w;
        }
    }
};

template <int MODE> struct EpiRes {
    static constexpr bool PERM = true;
    const bf16* rb; float* o0; float* o1; bf16* hb; float* ss;
    __device__ __forceinline__ void operator()(const f32x4 (&acc)[2][2][4][2], const Unit& u, int wr, int wc, int fr, int fq) const {
        const int col0 = u.pn * 256 + wc * 32 + 8 * fq; const int rowb = u.pm * 256 + wr * 64;
        v4u rw[2][4][2];
#pragma unroll
        for (int ai = 0; ai < 2; ++ai)
#pragma unroll
            for (int m = 0; m < 4; ++m)
#pragma unroll
                for (int bj = 0; bj < 2; ++bj) rw[ai][m][bj] = *(const v4u*)(rb + (size_t)(rowb + ai * 128 + m * 16 + fr) * D + col0 + bj * 128);
#pragma unroll
        for (int ai = 0; ai < 2; ++ai)
#pragma unroll
            for (int m = 0; m < 4; ++m)
#pragma unroll
                for (int bj = 0; bj < 2; ++bj) asm volatile("" : "+v"(rw[ai][m][bj]));
#pragma unroll
        for (int ai = 0; ai < 2; ++ai)
#pragma unroll
            for (int m = 0; m < 4; ++m) {
                const int row = rowb + ai * 128 + m * 16 + fr;
                float* op = (MODE == 2) ? o0 + (size_t)row * D : nullptr;
                float sq = 0.f;
#pragma unroll
                for (int bj = 0; bj < 2; ++bj) {
                    const int c = col0 + bj * 128;
                    const v4u w_ = rw[ai][m][bj];
                    f32x4 a0 = {bf2f(w_.x & 0xffffu), bf2f(w_.x >> 16), bf2f(w_.y & 0xffffu), bf2f(w_.y >> 16)}, a1 = {bf2f(w_.z & 0xffffu), bf2f(w_.z >> 16), bf2f(w_.w & 0xffffu), bf2f(w_.w >> 16)};
                    a0 += acc[ai][bj][m][0]; a1 += acc[ai][bj][m][1];
                    if (MODE == 2) { __builtin_nontemporal_store(a0, (f32x4*)(op + c)); __builtin_nontemporal_store(a1, (f32x4*)(op + c + 4)); }
                    else {
                        v4u w; w.x = cvt_pk_bf16(a0[0], a0[1]); w.y = cvt_pk_bf16(a0[2], a0[3]); w.z = cvt_pk_bf16(a1[0], a1[1]); w.w = cvt_pk_bf16(a1[2], a1[3]);
                        *(v4u*)(hb + (size_t)row * D + c) = w;
                        sq += (a0[0] * a0[0] + a0[1] * a0[1]) + (a0[2] * a0[2] + a0[3] * a0[3]) + (a1[0] * a1[0] + a1[1] * a1[1]) + (a1[2] * a1[2] + a1[3] * a1[3]);
                    }
                }
                if (MODE != 2) { sq += shx<16>(sq); sq = xadd32(sq); if (fq == 0) atomicAdd(ss + row, sq); }
            }
    }
    __device__ __forceinline__ void tail(int row, int col, f32x4 v, int fq) const {
        const v2u rw = *(const v2u*)(rb + (size_t)row * D + col);
        f32x4 a0 = {bf2f(rw.x & 0xffffu), bf2f(rw.x >> 16), bf2f(rw.y & 0xffffu), bf2f(rw.y >> 16)}; a0 += v;
        if (MODE == 2) { *(f32x4*)(o1 + (size_t)(row - SEQ) * D + col) = a0; }
        else {
            v2u w; w.x = cvt_pk_bf16(a0[0], a0[1]); w.y = cvt_pk_bf16(a0[2], a0[3]); *(v2u*)(hb + (size_t)row * D + col) = w;
            float sq = (a0[0] * a0[0] + a0[1] * a0[1]) + (a0[2] * a0[2] + a0[3] * a0[3]);
            sq += shx<16>(sq); sq = xadd32(sq); if (fq == 0) atomicAdd(ss + row, sq);
        }
    }
};
struct EpiGU {
    static constexpr bool PERM = true;
    const float* ss; bf16* hm;
    __device__ __forceinline__ void operator()(const f32x4 (&acc)[2][2][4][2], const Unit& u, int wr, int wc, int fr, int fq) const {
        const int j0 = u.pn * 128 + wc * 32 + 8 * fq; const int rowb = u.pm * 256 + wr * 64;
        float rs[2][4];
#pragma unroll
        for (int ai = 0; ai < 2; ++ai)
#pragma unroll
            for (int m = 0; m < 4; ++m) rs[ai][m] = ss[rowb + ai * 128 + m * 16 + fr];
#pragma unroll
        for (int ai = 0; ai < 2; ++ai)
#pragma unroll
            for (int m = 0; m < 4; ++m) asm volatile("" : "+v"(rs[ai][m]));
#pragma unroll
        for (int ai = 0; ai < 2; ++ai)
#pragma unroll
            for (int m = 0; m < 4; ++m) {
                const int rb = rowb + ai * 128 + m * 16; if (rb >= MR) continue;
                const int row = rb + fr; const float r = rsqrtf(rs[ai][m] * (1.0f / D) + EPS);
                float o[8];
#pragma unroll
                for (int n = 0; n < 2; ++n)
#pragma unroll
                    for (int j = 0; j < 4; ++j) o[4 * n + j] = silu_f(acc[ai][0][m][n][j] * r) * (acc[ai][1][m][n][j] * r);
                v4u w; w.x = cvt_pk_bf16(o[0], o[1]); w.y = cvt_pk_bf16(o[2], o[3]); w.z = cvt_pk_bf16(o[4], o[5]); w.w = cvt_pk_bf16(o[6], o[7]);
                *(v4u*)(hm + (size_t)row * DFF + j0) = w;
            }
    }
};
struct EpiKVQ {
    static constexpr bool PERM = true;
    const float* ss; unsigned char* ws; float* outp; const float* kn; const float* qn; LAS unsigned char* xl;
    __device__ __forceinline__ void operator()(const f32x4 (&acc)[2][2][4][2], const Unit& u, int wr, int wc, int fr, int fq) const {
        const int c0 = wc * 32 + 8 * fq; const int rowb = u.pm * 256 + wr * 64;
        bf16* Kb_ = (bf16*)(ws + WS_KB); bf16* Vb_ = (bf16*)(ws + WS_VB); bf16* Qb_ = (bf16*)(ws + WS_QB); float* Kp_ = (float*)(ws + WS_KPART);
        float rs[2][4];
#pragma unroll
        for (int ai = 0; ai < 2; ++ai)
#pragma unroll
            for (int m = 0; m < 4; ++m) rs[ai][m] = rsqrtf(ss[rowb + ai * 128 + m * 16 + fr] * (1.0f / D) + EPS);
        if (u.pn == 2 || u.pn == 3) {
#pragma unroll
            for (int ai = 0; ai < 2; ++ai)
#pragma unroll
                for (int m = 0; m < 4; ++m) {
                    const int rb = rowb + ai * 128 + m * 16; if (rb >= MR) continue;
                    const int row = rb + fr; const float r = rs[ai][m];
                    float* vo = outp + ((row < SEQ) ? OV_P + (size_t)row * 512 : OV_S + (size_t)(row - SEQ) * 512);
#pragma unroll
                    for (int bj = 0; bj < 2; ++bj) { const int col = (u.pn - 2) * 256 + bj * 128 + c0; const f32x4 v0 = acc[ai][bj][m][0] * r, v1 = acc[ai][bj][m][1] * r;
                        __builtin_nontemporal_store(v0, (f32x4*)(vo + col)); __builtin_nontemporal_store(v1, (f32x4*)(vo + col + 4));
                        v4u w; w.x = cvt_pk_bf16(v0[0], v0[1]); w.y = cvt_pk_bf16(v0[2], v0[3]); w.z = cvt_pk_bf16(v1[0], v1[1]); w.w = cvt_pk_bf16(v1[2], v1[3]);
                        *(v4u*)(Vb_ + (size_t)row * 512 + col) = w; }
                }
            return;
        }
        const bool isk = u.pn < 2;
        LAS float* P = (LAS float*)xl;
        LAS float* CS = (LAS float*)(xl + 8192);
#pragma unroll
        for (int ai = 0; ai < 2; ++ai)
#pragma unroll
            for (int m = 0; m < 4; ++m) {
                const int rl = ai * 128 + wr * 64 + m * 16 + fr; const float r = rs[ai][m];
#pragma unroll
                for (int bj = 0; bj < 2; ++bj) { const f32x4 v0 = acc[ai][bj][m][0] * r, v1 = acc[ai][bj][m][1] * r;
                    float sq = (v0[0] * v0[0] + v0[1] * v0[1]) + (v0[2] * v0[2] + v0[3] * v0[3]) + (v1[0] * v1[0] + v1[1] * v1[1]) + (v1[2] * v1[2] + v1[3] * v1[3]);
                    sq += shx<16>(sq); sq = xadd32(sq);
                    if (fq == 0) P[(rl * 2 + bj) * 4 + wc] = sq; }
            }
        asm volatile("s_waitcnt lgkmcnt(0)" ::: "memory"); __builtin_amdgcn_s_barrier(); asm volatile("" ::: "memory");
        float cs[2][8];
#pragma unroll
        for (int bj = 0; bj < 2; ++bj)
#pragma unroll
            for (int j = 0; j < 8; ++j) cs[bj][j] = 0.f;
        const float* gp = (isk ? kn : qn) + c0; const f32x4 g0 = *(const f32x4*)gp, g1 = *(const f32x4*)(gp + 4);
#pragma unroll
        for (int ai = 0; ai < 2; ++ai)
#pragma unroll
            for (int m = 0; m < 4; ++m) {
                const int rb = rowb + ai * 128 + m * 16; if (rb >= MR) continue;
                const int rl = ai * 128 + wr * 64 + m * 16 + fr; const int row = rb + fr; const float r = rs[ai][m];
#pragma unroll
                for (int bj = 0; bj < 2; ++bj) {
                    const f32x4 pp = *(const LAS f32x4*)(P + (rl * 2 + bj) * 4);
                    const float rh = rsqrtf(((pp[0] + pp[1]) + (pp[2] + pp[3])) * (1.0f / 128.0f) + EPS) * (isk ? 1.0f : C2);
                    const f32x4 n0 = acc[ai][bj][m][0] * (r * rh) * g0, n1 = acc[ai][bj][m][1] * (r * rh) * g1;
                    v4u w; w.x = cvt_pk_bf16(n0[0], n0[1]); w.y = cvt_pk_bf16(n0[2], n0[3]); w.z = cvt_pk_bf16(n1[0], n1[1]); w.w = cvt_pk_bf16(n1[2], n1[3]);
                    if (isk) {
                        const int col = u.pn * 256 + bj * 128 + c0;
                        float* ko = outp + ((row < SEQ) ? OK_P + (size_t)row * 512 : OK_S + (size_t)(row - SEQ) * 512) + col;
                        __builtin_nontemporal_store(n0, (f32x4*)ko); __builtin_nontemporal_store(n1, (f32x4*)(ko + 4));
                        *(v4u*)(Kb_ + (size_t)row * 512 + col) = w;
#pragma unroll
                        for (int j = 0; j < 4; ++j) { cs[bj][j] += n0[j]; cs[bj][4 + j] += n1[j]; }
                    } else {
                        *(v4u*)(Qb_ + (size_t)row * D + (u.pn - 4) * 256 + bj * 128 + c0) = w;
                    }
                }
            }
        if (isk && u.pm < SEQ / 256) {
#pragma unroll
            for (int bj = 0; bj < 2; ++bj)
#pragma unroll
                for (int j = 0; j < 8; ++j) { float v = cs[bj][j]; v += shx<1>(v); v += shx<2>(v); v += shx<4>(v); v += shx<8>(v); if (fr == 0) CS[wr * 256 + bj * 128 + c0 + j] = v; }
            asm volatile("s_waitcnt lgkmcnt(0)" ::: "memory"); __builtin_amdgcn_s_barrier(); asm volatile("" ::: "memory");
            const int t = (wr * 4 + wc) * 64 + fq * 16 + fr;
            if (t < 256) Kp_[(size_t)u.pm * 512 + u.pn * 256 + t] = CS[t] + CS[256 + t];
        }
    }
};

struct Args { const void* in[21]; float* out; unsigned char* ws; };

__device__ __forceinline__ void p0_transpose_item(const float* W, int K, int N, bf16* WT, int row_off, int mode, const float* gain, LAS float* scr, int item, int lane) {
    const int nblk = N / 64, kb = item / nblk, nb = item % nblk, k0 = 64 * kb, n0 = 64 * nb;
    const int r = lane >> 4, c4 = lane & 15;
#pragma unroll
    for (int i = 0; i < 16; ++i) { const int kk = 4 * i + r; f32x4 w = __builtin_nontemporal_load((const f32x4*)(W + (size_t)(k0 + kk) * N + n0 + 4 * c4)); if (gain) w *= gain[k0 + kk]; *(LAS f32x4*)(scr + kk * 68 + 4 * c4) = w; }
    LDS_WAIT(); asm volatile("" ::: "memory");
    const int c = lane & 7;
    int d0;
    if (mode == 0) d0 = row_off + n0;
    else { const int j = (n0 < DFF) ? n0 : n0 - DFF; d0 = 256 * (j >> 7) + (j & 127) + ((n0 < DFF) ? 0 : 128); }
#pragma unroll
    for (int j = 0; j < 8; ++j) { const int n = (lane >> 3) + 8 * j; const LAS float* sp = scr + (8 * c) * 68 + n;
        v4u o; o.x = pk2(sp[0 * 68], sp[1 * 68]); o.y = pk2(sp[2 * 68], sp[3 * 68]); o.z = pk2(sp[4 * 68], sp[5 * 68]); o.w = pk2(sp[6 * 68], sp[7 * 68]);
        *(v4u*)(WT + (size_t)(d0 + n) * K + k0 + 8 * c) = o; }
    LDS_WAIT(); asm volatile("" ::: "memory");
}

constexpr int KS_P = 144;
constexpr int KS_BYTES = 256 * KS_P * 2;
typedef short v4i16_t __attribute__((ext_vector_type(4)));
__device__ __forceinline__ v2u tr_read(const LAS bf16* p) { return __builtin_bit_cast(v2u, __builtin_amdgcn_ds_read_tr16_b64_v4i16((LAS v4i16_t*)p)); }
template <int NKT> __device__ __forceinline__ void attn_scores(const LAS bf16* Ks, const bf16x8 (&qf)[4], f32x4 (&acc)[16], int nkt, int fr, int fq) {
#pragma unroll
    for (int kt = 0; kt < NKT; ++kt) {
        acc[kt] = (f32x4){0.f, 0.f, 0.f, 0.f};
        if (kt < nkt) {
#pragma unroll
            for (int ks = 0; ks < 4; ++ks) { const bf16x8 a = *(const LAS bf16x8*)(Ks + (16 * kt + fr) * KS_P + 32 * ks + 8 * fq); acc[kt] = MFMA16(a, qf[ks], acc[kt]); }
        }
    }
}
__device__ __forceinline__ void attn_pv(const LAS bf16* Vr, const f32x4 (&acc)[16], f32x4 (&O)[8], int nj, int fr, int fq) {
#pragma unroll
    for (int j = 0; j < 8; ++j) {
        if (j < nj) {
            v4u pw; pw.x = cvt_pk_bf16(acc[2 * j][0], acc[2 * j][1]); pw.y = cvt_pk_bf16(acc[2 * j][2], acc[2 * j][3]); pw.z = cvt_pk_bf16(acc[2 * j + 1][0], acc[2 * j + 1][1]); pw.w = cvt_pk_bf16(acc[2 * j + 1][2], acc[2 * j + 1][3]);
            const bf16x8 pf = __builtin_bit_cast(bf16x8, pw);
            const LAS bf16* vb = Vr + (32 * j + 4 * fq + (fr >> 2)) * KS_P + 4 * (fr & 3);
#pragma unroll
            for (int vt = 0; vt < 8; ++vt) {
                const v2u lo = tr_read(vb + 16 * vt), hi = tr_read(vb + 16 * KS_P + 16 * vt);
                const v4u aw = {lo.x, lo.y, hi.x, hi.y};
                O[vt] = MFMA16(__builtin_bit_cast(bf16x8, aw), pf, O[vt]);
            }
        }
    }
}

template <int NT, int K> __device__ __forceinline__ void tail_gemm(LAS unsigned char* lds, const bf16* A, const bf16* Bt, int n0, int rowhalf, f32x4 (&acc)[NT], int tidx, int rsel) {
    int tid_o = tidx; asm volatile("" : "+v"(tid_o));
    const int tid = tid_o, lane = tid & 63, wave = __builtin_amdgcn_readfirstlane(tid >> 6), fr = lane & 15, fq = lane >> 4;
    const int rt = wave & 3, kh = wave >> 2; constexpr int Kh = K >> 1;
    constexpr int KC = (K == 2048) ? (NT == 2 ? 512 : 1024) : 1408;
    constexpr int NCH = Kh / KC, PB = KC + 8, UPR = KC >> 3, NS = KC >> 7;
    const int khk = kh ^ (rsel & 1), flip = (NCH > 1) ? ((rsel >> 1) & 1) : 0;
    constexpr int NU = 2 * 16 * NT * UPR, NIT = NU / NTHR;
    static_assert(NU % NTHR == 0, "tail B staging");
    LAS bf16* Bs = (LAS bf16*)(lds + 8192);
    const int lq = lane >> 4, lu = lane & 15;
    const bf16* ap = A + (size_t)(64 * rowhalf + 16 * rt + lq) * K + khk * Kh + 8 * lu;
    LAS unsigned char* stg = lds + 102400 + wave * 4096;
    int wof[4], rof[4];
#pragma unroll
    for (int j = 0; j < 4; ++j) { wof[j] = (4 * j + lq) * 256 + ((lu ^ (4 * j + lq)) << 4); rof[j] = fr * 256 + (((4 * j + fq) ^ fr) << 4); }
    const LAS bf16* bl = Bs + (khk * 16 * NT + fr) * PB + 8 * fq;
#pragma unroll
    for (int t = 0; t < NT; ++t) acc[t] = (f32x4){0.f, 0.f, 0.f, 0.f};
#define TG_LDA(a_, k0_) do { _Pragma("unroll") for (int s_ = 0; s_ < 4; ++s_) a_[s_] = *(const bf16x8*)(ap + (size_t)(4 * s_) * K + (k0_)); } while (0)
#define TG_MMA(a_, kl_) do { _Pragma("unroll") for (int s_ = 0; s_ < 4; ++s_) *(LAS bf16x8*)(stg + wof[s_]) = a_[s_]; asm volatile("" ::: "memory"); bf16x8 ar_[4]; \
        _Pragma("unroll") for (int s_ = 0; s_ < 4; ++s_) ar_[s_] = *(const LAS bf16x8*)(stg + rof[s_]); asm volatile("" ::: "memory"); \
        _Pragma("unroll") for (int s_ = 0; s_ < 4; ++s_) { _Pragma("unroll") for (int t_ = 0; t_ < NT; ++t_) { \
        const bf16x8 b_ = *(const LAS bf16x8*)(bl + t_ * 16 * PB + (kl_) + 32 * s_); acc[t_] = MFMA16(b_, ar_[s_], acc[t_]); } } } while (0)
#define TG_LDB(kb_) do { _Pragma("unroll") for (int i_ = 0; i_ < NIT; ++i_) { const int u_ = tid + i_ * NTHR, r2_ = u_ / UPR, kc_ = u_ - r2_ * UPR; const int khh_ = (r2_ >= 16 * NT) ? 1 : 0, row_ = r2_ - khh_ * 16 * NT; \
        breg[i_] = *(const v4u*)(Bt + (size_t)(n0 + row_) * K + khh_ * Kh + (kb_) + 8 * kc_); } } while (0)
#define TG_STB() do { _Pragma("unroll") for (int i_ = 0; i_ < NIT; ++i_) { const int u_ = tid + i_ * NTHR, r2_ = u_ / UPR, kc_ = u_ - r2_ * UPR; *(LAS v4u*)(Bs + r2_ * PB + 8 * kc_) = breg[i_]; } } while (0)
    v4u breg[NIT];
    TG_LDB(flip * KC);
#pragma unroll
    for (int ch = 0; ch < NCH; ++ch) {
        const int kb = (ch ^ flip) * KC;
        bf16x8 a0[4], a1[4], a2[4], a3[4];
        TG_LDA(a0, kb); TG_LDA(a1, kb + 128); TG_LDA(a2, kb + 256); TG_LDA(a3, kb + 384);
        TG_STB();
        __syncthreads();
        if (ch + 1 < NCH) TG_LDB(((ch + 1) ^ flip) * KC);
        for (int st = 0; st < NS; st += 4) {
            TG_MMA(a0, 128 * st);           if (st + 4 < NS) TG_LDA(a0, kb + 128 * (st + 4));
            if (st + 1 < NS) { TG_MMA(a1, 128 * (st + 1)); if (st + 5 < NS) TG_LDA(a1, kb + 128 * (st + 5)); }
            if (st + 2 < NS) { TG_MMA(a2, 128 * (st + 2)); if (st + 6 < NS) TG_LDA(a2, kb + 128 * (st + 6)); }
            if (st + 3 < NS) { TG_MMA(a3, 128 * (st + 3)); if (st + 7 < NS) TG_LDA(a3, kb + 128 * (st + 7)); }
        }
        __syncthreads();
    }
#undef TG_LDA
#undef TG_MMA
#undef TG_LDB
#undef TG_STB
    LAS f32x4* red = (LAS f32x4*)lds;
    if (kh == 1) {
#pragma unroll
        for (int t = 0; t < NT; ++t) red[(t * 4 + rt) * 64 + lane] = acc[t];
    }
    __syncthreads();
    if (kh == 0) {
#pragma unroll
        for (int t = 0; t < NT; ++t) acc[t] += red[(t * 4 + rt) * 64 + lane];
    }
    __syncthreads();
}

__device__ __forceinline__ void kmean_items(LAS unsigned char* lds, const float* cache_k_, const int* ptab_, float* Kms_, int i0, int i1, int c0, int cn, int tidx) {
    int tid_o = tidx; asm volatile("" : "+v"(tid_o)); const int tid = tid_o;
    const int me = (int)blockIdx.x - c0; if (me < 0 || me >= cn) return;
    LAS f32x4* redk = (LAS f32x4*)(lds);
    for (int item = i0 + me; item < i1; item += cn) {
        const int b = item >> 5, n = item & 31; const int c4 = tid & 127, rg = tid >> 7;
        f32x4 a = {0.f, 0.f, 0.f, 0.f};
#pragma unroll
        for (int hp = 0; hp < 2; ++hp) { const int page = ptab_[b * NPAGES + 2 * n + hp]; const f32x4* pp = (const f32x4*)(cache_k_ + (size_t)page * PAGE * 512) + c4;
#pragma unroll 16
            for (int r = rg; r < 128; r += 4) a += __builtin_nontemporal_load(pp + (size_t)r * 128); }
        redk[rg * 128 + c4] = a;
        __syncthreads();
        if (tid < 128) { const f32x4 s4 = (redk[tid] + redk[128 + tid]) + (redk[256 + tid] + redk[384 + tid]); *(f32x4*)(Kms_ + (size_t)item * 512 + 4 * tid) = s4 * (1.0f / 256.0f); }
        __syncthreads();
    }
}

__global__ void __launch_bounds__(NTHR, 2) yoco_fwd(Args args) {
    extern __shared__ __attribute__((aligned(16))) unsigned char lds_raw[];
    LAS unsigned char* lds = (LAS unsigned char*)lds_raw;
#define TIDS int tid_o = TIDX; asm volatile("" : "+v"(tid_o)); const int tid = tid_o, lane = tid & 63, wave = __builtin_amdgcn_readfirstlane(tid >> 6), fr = lane & 15, fq = lane >> 4; (void)fr; (void)fq; (void)wave; (void)lane; (void)tid
    const int G = gridDim.x, bid = blockIdx.x;
    unsigned char* ws = args.ws;
    unsigned* ctl = (unsigned*)(ws + WS_CTL);
    volatile LAS unsigned* MISC = (volatile LAS unsigned*)(lds + MISC_OFF);
    const int wave_sg = __builtin_amdgcn_readfirstlane((int)threadIdx.x & ~63);
#define TIDX (wave_sg + lane_id())
#define IS_T0 ((wave_sg == 0) && (lane_id() == 0))
    if (TIDX < 64) MISC[TIDX] = 0u;
    __syncthreads();
    XcdBarrier bar = xcd_barrier_post(ctl + CW_BAR, MISC + 8, IS_T0);
#ifdef PROF_A
    int n_stamp = 0;
#define STAMP() do { if (blockIdx.x == 0 && IS_T0) MISC[16 + n_stamp] = (unsigned)__builtin_amdgcn_s_memrealtime(); ++n_stamp; } while (0)
#define TNOW() ((unsigned)__builtin_amdgcn_s_memrealtime())
#define TACC(k, t0) do { if (blockIdx.x == 0 && IS_T0) MISC[40 + (k)] += TNOW() - (t0); } while (0)
#define PVAL(a0, a1) (((a0) >= 100) ? MISC[40 + (a0) - 100] : (MISC[16 + (a1)] - MISC[16 + (a0)]))
#else
#define STAMP() do {} while (0)
#define TNOW() 0u
#define TACC(k, t0) do { (void)(t0); } while (0)
#endif
    STAMP();

#define x_p ((const float*)args.in[0])
#define x_s ((const float*)args.in[1])
#define st_in ((const float*)args.in[2])
#define cache_k ((const float*)args.in[3])
#define cache_v ((const float*)args.in[4])
#define ptab ((const int*)args.in[5])
#define norm_mix_a ((const float*)args.in[6])
#define w_in ((const float*)args.in[7])
#define lbl ((const float*)args.in[8])
#define onorm ((const float*)args.in[9])
#define w_out ((const float*)args.in[10])
#define norm_kv ((const float*)args.in[11])
#define w_kv ((const float*)args.in[12])
#define k_norm ((const float*)args.in[13])
#define norm_mix_b ((const float*)args.in[14])
#define w_q ((const float*)args.in[15])
#define q_norm ((const float*)args.in[16])
#define w_o ((const float*)args.in[17])
#define norm_ffn ((const float*)args.in[18])
#define w_gu ((const float*)args.in[19])
#define w_dn ((const float*)args.in[20])
#define Win_t ((bf16*)(ws + WS_WIN))
#define Wout_t ((bf16*)(ws + WS_WOUT))
#define Wgu0_t ((bf16*)(ws + WS_WGU0))
#define Wdn0_t ((bf16*)(ws + WS_WDN0))
#define Wkvq_t ((bf16*)(ws + WS_WKVQ))
#define Wo_t ((bf16*)(ws + WS_WO))
#define Wgu1_t ((bf16*)(ws + WS_WGU1))
#define Wdn1_t ((bf16*)(ws + WS_WDN1))
#define Hb0 ((bf16*)(ws + WS_HB0))
#define Hb1 ((bf16*)(ws + WS_HB1))
#define Hb2 ((bf16*)(ws + WS_HB2))
#define Hb3 ((bf16*)(ws + WS_HB3))
#define Hf1 ((float*)(ws + WS_HF1))
#define Hf2 ((float*)(ws + WS_HF2))
#define Hf3 ((float*)(ws + WS_HF3))
#define Qg ((bf16*)(ws + WS_QG))
#define Vg ((bf16*)(ws + WS_VG))
#define Gg ((bf16*)(ws + WS_GG))
#define Ff ((f16*)(ws + WS_F))
#define Ob ((bf16*)(ws + WS_OB))
#define At ((bf16*)(ws + WS_AT))
#define Hm ((bf16*)(ws + WS_HM))
#define Ug ((float*)(ws + WS_U))
#define Sg0 ((float*)(ws + WS_SST))
#define Dg ((float*)(ws + WS_DEC))
#define Kraw ((float*)(ws + WS_KRAW))
#define Vraw ((float*)(ws + WS_VRAW))
#define Qraw ((bf16*)(ws + WS_QRAW))
#define Kb ((bf16*)(ws + WS_KB))
#define Vb ((bf16*)(ws + WS_VB))
#define Qb ((bf16*)(ws + WS_QB))
#define Kpart ((float*)(ws + WS_KPART))
#define Kms ((float*)(ws + WS_KMS))
#define Subl ((unsigned*)(ws + WS_SUBL))
#define Scnt ((unsigned*)(ws + WS_SCNT))
#define Sels ((unsigned*)(ws + WS_SCNT + 256 * 1024))
#define Oslot ((bf16*)(ws + WS_OSLOT))
#define MLslot ((float*)(ws + WS_MLSLOT))
#define Sslot ((float*)(ws + WS_SSLOT))
#define ss0 ((float*)(ctl + CW_SS0))
#define ss1 ((float*)(ctl + CW_SS1))
#define ss2 ((float*)(ctl + CW_SS2))
#define ss3 ((float*)(ctl + CW_SS3))
#define out (args.out)
    {
        TIDS;
        LAS float* scr = (LAS float*)(lds + wave * 17408);
        const int gw = bid * NWAVES + wave, NGW = G * NWAVES;
        constexpr int I_IN = 32 * 128, I_SQ = 32 * 32, I_GU = 32 * 176, I_DN = 88 * 32, I_KV = 32 * 16;
        constexpr int NITEMS = I_IN + I_SQ + 2 * I_GU + 2 * I_DN + I_KV + I_SQ + I_SQ;
        for (int it = gw; it < NITEMS; it += NGW) {
            int r = it;
            if (r < I_IN) { p0_transpose_item(w_in, D, 4 * D, Win_t, 0, 0, norm_mix_a, scr, r, lane); continue; } r -= I_IN;
            if (r < I_SQ) { p0_transpose_item(w_out, D, D, Wout_t, 0, 0, nullptr, scr, r, lane); continue; } r -= I_SQ;
            if (r < I_GU) { p0_transpose_item(w_gu, D, NGU, Wgu0_t, 0, 1, norm_ffn, scr, r, lane); continue; } r -= I_GU;
            if (r < I_GU) { p0_transpose_item(w_gu + (size_t)D * NGU, D, NGU, Wgu1_t, 0, 1, norm_ffn + D, scr, r, lane); continue; } r -= I_GU;
            if (r < I_DN) { p0_transpose_item(w_dn, DFF, D, Wdn0_t, 0, 0, nullptr, scr, r, lane); continue; } r -= I_DN;
            if (r < I_DN) { p0_transpose_item(w_dn + (size_t)DFF * D, DFF, D, Wdn1_t, 0, 0, nullptr, scr, r, lane); continue; } r -= I_DN;
            if (r < I_KV) { p0_transpose_item(w_kv, D, 1024, Wkvq_t, 0, 0, norm_kv, scr, r, lane); continue; } r -= I_KV;
            if (r < I_SQ) { p0_transpose_item(w_q, D, D, Wkvq_t, 1024, 0, norm_mix_b, scr, r, lane); continue; } r -= I_SQ;
            p0_transpose_item(w_o, D, D, Wo_t, 0, 0, nullptr, scr, r, lane);
        }
        for (int m = gw; m < MR; m += NGW) {
            const float* src = (m < SEQ) ? x_p + (size_t)m * D : x_s + (size_t)(m - SEQ) * D;
            const f32x4* xr = (const f32x4*)src + lane; f32x4 v[8]; float s = 0.f;
#pragma unroll
            for (int j = 0; j < 8; ++j) { v[j] = __builtin_nontemporal_load(xr + 64 * j); s += (v[j].x * v[j].x + v[j].y * v[j].y) + (v[j].z * v[j].z + v[j].w * v[j].w); }
            s = wave_sum(s);
            if (lane == 0) ss0[m] = s;
            v2u* o8 = (v2u*)(Hb0 + (size_t)m * D) + lane;
#pragma unroll
            for (int j = 0; j < 8; ++j) { v2u w; w.x = pk2(v[j].x, v[j].y); w.y = pk2(v[j].z, v[j].w); o8[64 * j] = w; }
        }
        __syncthreads();
        kmean_items(lds, cache_k, ptab, Kms, 848, DECB * NBLK, 0, G, TIDX);
    }
    xcd_barrier(bar, IS_T0);
    STAMP();

    {
        TIDS;
        pg8::Gemm g{Hb0, Win_t, SEQ, 4 * D, D}; pg8::StaticOrder S; S.init(SEQ, 4 * D, G, bid);
        EpiIn E{ss0, lbl, Qg, Ff};
        pg8::gemm_phase<EpiIn, pg8::StaticOrder, true, true, false>(lds, g, S, E, TIDX);
        for (int it2 = 0; it2 < 2; ++it2) {
            const int w2 = bid + 256 * it2, t2 = w2 & 255, rh = (w2 >> 8) & 1;
            TIDS; f32x4 ta[2]; tail_gemm<2, D>(lds, Hb0 + (size_t)SEQ * D, Win_t, 32 * t2, rh, ta, TIDX, bid & 127);
            if (wave < 4) { const int row = SEQ + 64 * rh + 16 * wave + fr; E.tail(row, 32 * t2 + 4 * fq, ta[0]); E.tail(row, 32 * t2 + 16 + 4 * fq, ta[1]); }
        }
    }
    xcd_barrier(bar, IS_T0);
    STAMP();

    {
        TIDS;
        LAS float* tot = (LAS float*)(lds);
        LAS float* decs = (LAS float*)(lds + 2048);
        LAS bf16* koT = (LAS bf16*)(lds + 4096);
        LAS bf16* Vr = (LAS bf16*)(lds + 4096 + 128 * 72 * 2);
        const int col = tid & 127, part = tid >> 7; const int vt_t = tid >> 3, vd0 = (tid & 7) * 16;
        f16 fN[16]; v4u vaN, vbN;
#define P2_LOADN(it_) do { const int h_ = (it_) >> 7, r0_ = ((it_) & 127) * 64; const f16* fp_ = Ff + (size_t)(r0_ + part * 16) * D + h_ * 128 + col; \
            _Pragma("unroll") for (int i = 0; i < 16; ++i) fN[i] = fp_[(size_t)i * D]; \
            const bf16* vp_ = Vg + (size_t)(r0_ + vt_t) * D + h_ * 128 + vd0; vaN = *(const v4u*)vp_; vbN = *(const v4u*)(vp_ + 8); } while (0)
        for (int it = bid; it < NH * 16; it += G) {
            const int h = it >> 4, g = it & 15;
            f32x4 S[8];
#pragma unroll
            for (int vt = 0; vt < 8; ++vt) S[vt] = (f32x4){0.f, 0.f, 0.f, 0.f};
            float dtot = 1.0f;
            P2_LOADN(h * 128 + 8 * g);
#pragma unroll 1
            for (int j = 0; j < 8; ++j) {
                const int item = h * 128 + 8 * g + j;
                float cum[16], kk[16]; float run = 0.f;
#pragma unroll
                for (int i = 0; i < 16; ++i) { kk[i] = (float)fN[i]; const float f = 1.0f - kk[i]; run += __logf(f); cum[i] = run; }
                tot[part * 128 + col] = run;
                *(LAS v4u*)(Vr + vt_t * 144 + vd0) = vaN; *(LAS v4u*)(Vr + vt_t * 144 + vd0 + 8) = vbN;
                if (j < 7) P2_LOADN(item + 1);
                __syncthreads();
                float offs = 0.f, lastv = 0.f;
#pragma unroll
                for (int p = 0; p < 4; ++p) { const float tv = tot[p * 128 + col]; lastv += tv; if (p < part) offs += tv; }
                unsigned kw[8];
#pragma unroll
                for (int i = 0; i < 8; ++i) { const float a = kk[2 * i] * __expf(lastv - (cum[2 * i] + offs)), b2 = kk[2 * i + 1] * __expf(lastv - (cum[2 * i + 1] + offs)); kw[i] = pk2(a, b2); }
                *(LAS v4u*)(koT + col * 72 + part * 16) = (v4u){kw[0], kw[1], kw[2], kw[3]};
                *(LAS v4u*)(koT + col * 72 + part * 16 + 8) = (v4u){kw[4], kw[5], kw[6], kw[7]};
                if (part == 0) { const float dc = __expf(lastv); decs[col] = dc; dtot *= dc; }
                __syncthreads();
                { bf16x8 a[2]; a[0] = *(const LAS bf16x8*)(koT + (16 * wave + fr) * 72 + 8 * fq); a[1] = *(const LAS bf16x8*)(koT + (16 * wave + fr) * 72 + 32 + 8 * fq);
                  const f32x4 dv = *(const LAS f32x4*)(decs + 16 * wave + 4 * fq);
                  const LAS bf16* vb = Vr + (8 * fq + (fr >> 2)) * 144 + 4 * (fr & 3);
#pragma unroll
                  for (int vt = 0; vt < 8; ++vt) {
                      f32x4 acc = {0.f, 0.f, 0.f, 0.f};
                      const v2u l0 = tr_read(vb + 16 * vt), h0 = tr_read(vb + 4 * 144 + 16 * vt), l1 = tr_read(vb + 32 * 144 + 16 * vt), h1 = tr_read(vb + 36 * 144 + 16 * vt);
                      const v4u b0 = {l0.x, l0.y, h0.x, h0.y}, b1 = {l1.x, l1.y, h1.x, h1.y};
                      acc = MFMA16(a[0], __builtin_bit_cast(bf16x8, b0), acc); acc = MFMA16(a[1], __builtin_bit_cast(bf16x8, b1), acc);
                      S[vt] = dv * S[vt] + acc;
                  } }
                __syncthreads();
            }
            float* ug = Ug + (size_t)it * 16384;
#pragma unroll
            for (int vt = 0; vt < 8; ++vt) *(f32x4*)(ug + (size_t)(16 * vt + fr) * 128 + 16 * wave + 4 * fq) = S[vt];
            if (part == 0) Dg[(size_t)it * 128 + col] = dtot;
        }
#undef P2_LOADN
        LAS float* red = (LAS float*)(lds);
        LAS float* red2 = (LAS float*)(lds + 8192);
        float* st_out = out + OST_S;
        for (int item = bid; item < DECB * NH; item += G) {
            const int b = item >> 4, h = item & 15; const int vd = tid & 127, kq = tid >> 7;
            const float* sp = st_in + ((size_t)(b * NH + h) * 128 + 32 * kq) * 128 + vd;
            float Sx[32];
#pragma unroll
            for (int i = 0; i < 32; ++i) Sx[i] = __builtin_nontemporal_load(sp + (size_t)i * 128);
#pragma unroll
            for (int t = 0; t < 4; ++t) {
                const int row = SEQ + 4 * b + t; const size_t ro = (size_t)row * D + h * 128;
                const float v = bf2f(Vg[ro + vd]); float op = 0.f;
#pragma unroll
                for (int i = 0; i < 32; ++i) { const float f = 1.0f - (float)Ff[ro + 32 * kq + i]; const float q = bf2f(Qg[ro + 32 * kq + i]); Sx[i] = f * Sx[i] + (1.0f - f) * v; op += Sx[i] * q; }
                red[(t * 4 + kq) * 128 + vd] = op;
            }
            float* so = st_out + ((size_t)(b * NH + h) * 128 + 32 * kq) * 128 + vd;
#pragma unroll
            for (int i = 0; i < 32; ++i) __builtin_nontemporal_store(Sx[i], so + (size_t)i * 128);
            __syncthreads();
            { const int t = tid >> 7; const float o = (red[(t * 4 + 0) * 128 + vd] + red[(t * 4 + 1) * 128 + vd]) + (red[(t * 4 + 2) * 128 + vd] + red[(t * 4 + 3) * 128 + vd]);
              const float s = wave_sum(o * o); if (lane == 0) red2[t * 2 + (wave & 1)] = s;
              __syncthreads();
              const float r = rsqrtf((red2[t * 2] + red2[t * 2 + 1]) * (1.0f / 128.0f) + EPS);
              const int row = SEQ + 4 * b + t; const size_t ro = (size_t)row * D + h * 128 + vd;
              Ob[ro] = (bf16)f2bf(o * r * onorm[vd] * bf2f(Gg[ro])); }
            __syncthreads();
        }
    }
    xcd_barrier(bar, IS_T0);
    STAMP();

    {
        TIDS;
        for (int gid = bid * NTHR + tid; gid < NH * 128 * 32; gid += G * NTHR) {
            const int h = gid >> 12, rem = gid & 4095, vd = rem >> 5, k = (rem & 31) * 4;
            f32x4 sv = {0.f, 0.f, 0.f, 0.f};
#pragma unroll
            for (int g = 0; g < 16; ++g) {
                const size_t idx = ((size_t)(h * 16 + g) * 128 + vd) * 128 + k;
                const f32x4 u = *(const f32x4*)(Ug + idx), d = *(const f32x4*)(Dg + (size_t)(h * 16 + g) * 128 + k);
                *(f32x4*)(Sg0 + idx) = sv;
                sv = d * sv + u;
            }
            float* so = out + OST_P + ((size_t)h * 128 + k) * 128 + vd;
            so[0] = sv[0]; so[128] = sv[1]; so[256] = sv[2]; so[384] = sv[3];
        }
    }
    xcd_barrier(bar, IS_T0);
    STAMP();

    {
        TIDS;
        LAS float* tot = (LAS float*)(lds);
        LAS float* refs = (LAS float*)(lds + 2048);
        LAS float* red = (LAS float*)(lds + 2560);
        LAS float* decs = (LAS float*)(lds + 3072);
        LAS bf16* QE = (LAS bf16*)(lds + 4096);
        LAS bf16* KE = QE + 64 * 136;
        LAS bf16* QI = KE + 64 * 136;
        LAS bf16* Vr = QI + 64 * 136;
        LAS bf16* STs = Vr + 64 * 144;
        LAS bf16* koT = STs + 128 * 136;
        const int col = tid & 127, part = tid >> 7; const int vt_t = tid >> 3, vd0 = (tid & 7) * 16;
        const int tt = wave & 3, vh = wave >> 2;
        f16 fN[16]; bf16 qN[16]; v4u vaN, vbN;
#define P4_LOADN(it_) do { const int h_ = (it_) >> 7, r0_ = ((it_) & 127) * 64; const f16* fp_ = Ff + (size_t)(r0_ + part * 16) * D + h_ * 128 + col; const bf16* qp_ = Qg + (size_t)(r0_ + part * 16) * D + h_ * 128 + col; \
            _Pragma("unroll") for (int i = 0; i < 16; ++i) { fN[i] = fp_[(size_t)i * D]; qN[i] = qp_[(size_t)i * D]; } \
            const bf16* vp_ = Vg + (size_t)(r0_ + vt_t) * D + h_ * 128 + vd0; vaN = *(const v4u*)vp_; vbN = *(const v4u*)(vp_ + 8); } while (0)
        for (int it = bid; it < NH * 16; it += G) {
            const int hh = it >> 4, gg = it & 15;
            f32x4 S[8];
            { const float* sg = Sg0 + (size_t)it * 16384;
#pragma unroll
              for (int vt = 0; vt < 8; ++vt) { S[vt] = *(const f32x4*)(sg + (size_t)(16 * vt + fr) * 128 + 16 * wave + 4 * fq);
                  v2u w; w.x = cvt_pk_bf16(S[vt][0], S[vt][1]); w.y = cvt_pk_bf16(S[vt][2], S[vt][3]); *(LAS v2u*)(STs + (16 * vt + fr) * 136 + 16 * wave + 4 * fq) = w; } }
            P4_LOADN(hh * 128 + 8 * gg);
#pragma unroll 1
            for (int jc = 0; jc < 8; ++jc) {
            const int item = hh * 128 + 8 * gg + jc;
            const int h = item >> 7, c = item & 127; const int row0 = c * 64;
            float cum[16], kk[16], qv[16]; float run = 0.f;
#pragma unroll
            for (int i = 0; i < 16; ++i) { kk[i] = (float)fN[i]; const float f = 1.0f - kk[i]; run += __logf(f); cum[i] = run; qv[i] = bf2f(qN[i]); }
            tot[part * 128 + col] = run;
            *(LAS v4u*)(Vr + vt_t * 144 + vd0) = vaN; *(LAS v4u*)(Vr + vt_t * 144 + vd0 + 8) = vbN;
            const size_t ro = (size_t)(row0 + 16 * tt + fr) * D + h * 128;
            v2u gw2[4]; f32x4 on[4];
#pragma unroll
            for (int vt = 0; vt < 4; ++vt) { const int vd = 16 * (4 * vh + vt) + 4 * fq; gw2[vt] = *(const v2u*)(Gg + ro + vd); on[vt] = *(const f32x4*)(onorm + vd); }
            if (jc < 7) P4_LOADN(item + 1);
            __syncthreads();
            float offs = 0.f, lastv = 0.f;
#pragma unroll
            for (int p = 0; p < 4; ++p) { const float tv = tot[p * 128 + col]; lastv += tv; if (p < part) offs += tv; }
            if (part == 1) refs[col] = cum[15] + offs;
            if (part == 0) decs[col] = __expf(lastv);
            __syncthreads();
            const float ref = refs[col];
#pragma unroll
            for (int i = 0; i < 16; ++i) { const float cm = cum[i] + offs, d1 = cm - ref; const int t = part * 16 + i;
                QE[t * 136 + col] = (bf16)f2bf(qv[i] * __expf(d1)); KE[t * 136 + col] = (bf16)f2bf(kk[i] * __expf(-d1)); QI[t * 136 + col] = (bf16)f2bf(qv[i] * __expf(cm)); }
            { unsigned kw[8];
#pragma unroll
              for (int i = 0; i < 8; ++i) { const float a = kk[2 * i] * __expf(lastv - (cum[2 * i] + offs)), b2 = kk[2 * i + 1] * __expf(lastv - (cum[2 * i + 1] + offs)); kw[i] = pk2(a, b2); }
              *(LAS v4u*)(koT + col * 72 + part * 16) = (v4u){kw[0], kw[1], kw[2], kw[3]};
              *(LAS v4u*)(koT + col * 72 + part * 16 + 8) = (v4u){kw[4], kw[5], kw[6], kw[7]}; }
            __syncthreads();
            {
                f32x4 aS[4];
#pragma unroll
                for (int st = 0; st < 4; ++st) {
                    aS[st] = (f32x4){0.f, 0.f, 0.f, 0.f};
                    if (st <= tt) {
#pragma unroll
                        for (int ks = 0; ks < 4; ++ks) { const bf16x8 a = *(const LAS bf16x8*)(KE + (16 * st + fr) * 136 + 32 * ks + 8 * fq), b = *(const LAS bf16x8*)(QE + (16 * tt + fr) * 136 + 32 * ks + 8 * fq); aS[st] = MFMA16(a, b, aS[st]); }
                        if (st == tt) {
#pragma unroll
                            for (int r = 0; r < 4; ++r) if (4 * fq + r > fr) aS[st][r] = 0.f;
                        }
                    }
                }
                f32x4 o[4];
#pragma unroll
                for (int vt = 0; vt < 4; ++vt) o[vt] = (f32x4){0.f, 0.f, 0.f, 0.f};
#pragma unroll
                for (int j = 0; j < 2; ++j) {
                    v4u pw; pw.x = cvt_pk_bf16(aS[2 * j][0], aS[2 * j][1]); pw.y = cvt_pk_bf16(aS[2 * j][2], aS[2 * j][3]); pw.z = cvt_pk_bf16(aS[2 * j + 1][0], aS[2 * j + 1][1]); pw.w = cvt_pk_bf16(aS[2 * j + 1][2], aS[2 * j + 1][3]);
                    const bf16x8 pf = __builtin_bit_cast(bf16x8, pw);
                    const LAS bf16* vb = Vr + (32 * j + 4 * fq + (fr >> 2)) * 144 + 64 * vh + 4 * (fr & 3);
#pragma unroll
                    for (int vt = 0; vt < 4; ++vt) { const v2u lo = tr_read(vb + 16 * vt), hi = tr_read(vb + 16 * 144 + 16 * vt); const v4u aw = {lo.x, lo.y, hi.x, hi.y};
                        o[vt] = MFMA16(__builtin_bit_cast(bf16x8, aw), pf, o[vt]); }
                }
#pragma unroll
                for (int ks = 0; ks < 4; ++ks) { const bf16x8 b = *(const LAS bf16x8*)(QI + (16 * tt + fr) * 136 + 32 * ks + 8 * fq);
#pragma unroll
                    for (int vt = 0; vt < 4; ++vt) { const bf16x8 a = *(const LAS bf16x8*)(STs + (16 * (4 * vh + vt) + fr) * 136 + 32 * ks + 8 * fq); o[vt] = MFMA16(a, b, o[vt]); } }
                float sq = 0.f;
#pragma unroll
                for (int vt = 0; vt < 4; ++vt) sq += (o[vt][0] * o[vt][0] + o[vt][1] * o[vt][1]) + (o[vt][2] * o[vt][2] + o[vt][3] * o[vt][3]);
                sq += shx<16>(sq); sq = xadd32(sq);
                if (fq == 0) red[(16 * tt + fr) * 2 + vh] = sq;
                __syncthreads();
                const float r = rsqrtf((red[(16 * tt + fr) * 2] + red[(16 * tt + fr) * 2 + 1]) * (1.0f / 128.0f) + EPS);
#pragma unroll
                for (int vt = 0; vt < 4; ++vt) { const int vd = 16 * (4 * vh + vt) + 4 * fq;
                    const float g0 = bf2f(gw2[vt].x & 0xffffu), g1 = bf2f(gw2[vt].x >> 16), g2 = bf2f(gw2[vt].y & 0xffffu), g3 = bf2f(gw2[vt].y >> 16);
                    v2u w; w.x = cvt_pk_bf16(o[vt][0] * r * on[vt][0] * g0, o[vt][1] * r * on[vt][1] * g1); w.y = cvt_pk_bf16(o[vt][2] * r * on[vt][2] * g2, o[vt][3] * r * on[vt][3] * g3);
                    *(v2u*)(Ob + ro + vd) = w; }
            }
            if (jc < 7) {
                bf16x8 a[2]; a[0] = *(const LAS bf16x8*)(koT + (16 * wave + fr) * 72 + 8 * fq); a[1] = *(const LAS bf16x8*)(koT + (16 * wave + fr) * 72 + 32 + 8 * fq);
                const f32x4 dv = *(const LAS f32x4*)(decs + 16 * wave + 4 * fq);
                const LAS bf16* vb = Vr + (8 * fq + (fr >> 2)) * 144 + 4 * (fr & 3);
#pragma unroll
                for (int vt = 0; vt < 8; ++vt) {
                    f32x4 acc = {0.f, 0.f, 0.f, 0.f};
                    const v2u l0 = tr_read(vb + 16 * vt), h0 = tr_read(vb + 4 * 144 + 16 * vt), l1 = tr_read(vb + 32 * 144 + 16 * vt), h1 = tr_read(vb + 36 * 144 + 16 * vt);
                    const v4u b0 = {l0.x, l0.y, h0.x, h0.y}, b1 = {l1.x, l1.y, h1.x, h1.y};
                    acc = MFMA16(a[0], __builtin_bit_cast(bf16x8, b0), acc); acc = MFMA16(a[1], __builtin_bit_cast(bf16x8, b1), acc);
                    S[vt] = dv * S[vt] + acc;
                    v2u w; w.x = cvt_pk_bf16(S[vt][0], S[vt][1]); w.y = cvt_pk_bf16(S[vt][2], S[vt][3]); *(LAS v2u*)(STs + (16 * vt + fr) * 136 + 16 * wave + 4 * fq) = w;
                }
            }
            __syncthreads();
            }
        }
#undef P4_LOADN
    }
    xcd_barrier(bar, IS_T0);
    STAMP();

    {
        TIDS;
        pg8::Gemm g{Ob, Wout_t, SEQ, D, D}; pg8::StaticOrder S; S.init(SEQ, D, G, bid);
        EpiRes<1> E{Hb0, nullptr, nullptr, Hb1, ss1};
        const unsigned tg0 = TNOW();
        pg8::gemm_phase<EpiRes<1>, pg8::StaticOrder, true, true, false>(lds, g, S, E, TIDX);
        TACC(5, tg0); const unsigned tg1 = TNOW();
        { const int t2 = bid & 127, rh = (bid >> 7) & 1; TIDS; f32x4 ta[1]; tail_gemm<1, D>(lds, Ob + (size_t)SEQ * D, Wout_t, 16 * t2, rh, ta, TIDX, bid & 127); if (wave < 4) E.tail(SEQ + 64 * rh + 16 * wave + fr, 16 * t2 + 4 * fq, ta[0], fq); }
        TACC(6, tg1);
    }
    xcd_barrier(bar, IS_T0);
    STAMP();
    {
        TIDS;
        pg8::Gemm g{Hb1, Wgu0_t, MP, NGU, D}; pg8::StaticOrder S; S.init(MP, NGU, G, bid);
        EpiGU E{ss1, Hm};
        pg8::gemm_phase<EpiGU, pg8::StaticOrder, true, true>(lds, g, S, E, TIDX);
        kmean_items(lds, cache_k, ptab, Kms, 0, 336, 172, G - 172, TIDX);
    }
    xcd_barrier(bar, IS_T0);
    STAMP();
    {
        TIDS;
        pg8::Gemm g{Hm, Wdn0_t, SEQ, D, DFF}; pg8::StaticOrder S; S.init(SEQ, D, G, bid);
        EpiRes<1> E{Hb1, nullptr, nullptr, Hb2, ss2};
        const unsigned tg0 = TNOW();
        pg8::gemm_phase<EpiRes<1>, pg8::StaticOrder, true, true, false>(lds, g, S, E, TIDX);
        TACC(7, tg0); const unsigned tg1 = TNOW();
        { const int t2 = bid & 127, rh = (bid >> 7) & 1; TIDS; f32x4 ta[1]; tail_gemm<1, DFF>(lds, Hm + (size_t)SEQ * DFF, Wdn0_t, 16 * t2, rh, ta, TIDX, bid & 127); if (wave < 4) E.tail(SEQ + 64 * rh + 16 * wave + fr, 16 * t2 + 4 * fq, ta[0], fq); }
        TACC(8, tg1);
    }
    xcd_barrier(bar, IS_T0);
    STAMP();
    {
        TIDS;
        pg8::Gemm g{Hb2, Wkvq_t, MP, 3072, D}; pg8::StaticOrder S; S.init(MP, 3072, G, bid);
        EpiKVQ E{ss2, ws, out, k_norm, q_norm, lds + 131072};
        pg8::gemm_phase<EpiKVQ, pg8::StaticOrder, true, true>(lds, g, S, E, TIDX);
        kmean_items(lds, cache_k, ptab, Kms, 336, 848, 140, G - 140, TIDX);
    }
    xcd_barrier(bar, IS_T0);
    STAMP();

    {
        TIDS;
        LAS bf16* KMb = (LAS bf16*)(lds);
        LAS unsigned* lcnt = (LAS unsigned*)(lds + 16384);
        LAS float* gs = (LAS float*)(lds + 16384 + 256);
#define G_BETTER(va, ia, vb, ib) (((va) > (vb)) || (((va) == (vb)) && ((ia) < (ib))))
#define G_INSERT(vx, ix) do { const float vx_ = (vx); const int ix_ = (ix); \
            if (G_BETTER(vx_, ix_, v0, i0)) { v2 = v1; i2 = i1; v1 = v0; i1 = i0; v0 = vx_; i0 = ix_; } \
            else if (G_BETTER(vx_, ix_, v1, i1)) { v2 = v1; i2 = i1; v1 = vx_; i1 = ix_; } \
            else if (G_BETTER(vx_, ix_, v2, i2)) { v2 = vx_; i2 = ix_; } } while (0)
        for (int item = bid; item < 256; item += G) {
            const int j = item >> 2, kvh = item & 3; const int b = j >> 1;
            { const int n = tid >> 4, d8 = (tid & 15) * 8; f32x4 s0 = {0.f, 0.f, 0.f, 0.f}, s1 = {0.f, 0.f, 0.f, 0.f};
              if (n < b) { const float* kp = Kpart + (size_t)n * 512 + kvh * 128 + d8; s0 = *(const f32x4*)kp; s1 = *(const f32x4*)(kp + 4); }
              s0 = s0 * (1.0f / 256.0f); s1 = s1 * (1.0f / 256.0f);
              v4u w; w.x = cvt_pk_bf16(s0[0], s0[1]); w.y = cvt_pk_bf16(s0[2], s0[3]); w.z = cvt_pk_bf16(s1[0], s1[1]); w.w = cvt_pk_bf16(s1[2], s1[3]);
              *(LAS v4u*)(KMb + n * 136 + d8) = w; }
            if (tid < 32) lcnt[tid] = 0u;
            __syncthreads();
            const int nsel = b < 3 ? b : 3;
#pragma unroll 1
            for (int rt = 0; rt < 4; ++rt) {
                const int r = 64 * wave + 16 * rt + fr; const int tok = j * 128 + (r >> 2), hg = r & 3; const bf16* qp = Qb + (size_t)tok * D + (4 * kvh + hg) * 128 + 8 * fq;
                bf16x8 qf[4];
#pragma unroll
                for (int ks = 0; ks < 4; ++ks) qf[ks] = *(const bf16x8*)(qp + 32 * ks);
                f32x4 ga[2];
#pragma unroll
                for (int nt = 0; nt < 2; ++nt) { ga[nt] = (f32x4){0.f, 0.f, 0.f, 0.f};
#pragma unroll
                    for (int ks = 0; ks < 4; ++ks) { const bf16x8 ka = *(const LAS bf16x8*)(KMb + (16 * nt + fr) * 136 + 32 * ks + 8 * fq); ga[nt] = MFMA16(ka, qf[ks], ga[nt]); } }
                float v0 = -INFINITY, v1 = -INFINITY, v2 = -INFINITY; int i0 = 99, i1 = 99, i2 = 99;
#pragma unroll
                for (int nt = 0; nt < 2; ++nt)
#pragma unroll
                    for (int q = 0; q < 4; ++q) { const int n = 16 * nt + 4 * fq + q; if (n < b) G_INSERT(ga[nt][q], n); }
                { const float a0 = shx<16>(v0), a1 = shx<16>(v1), a2 = shx<16>(v2);
                  const int c0 = __builtin_amdgcn_ds_swizzle(i0, (16 << 10) | 0x1f), c1 = __builtin_amdgcn_ds_swizzle(i1, (16 << 10) | 0x1f), c2 = __builtin_amdgcn_ds_swizzle(i2, (16 << 10) | 0x1f);
                  G_INSERT(a0, c0); G_INSERT(a1, c1); G_INSERT(a2, c2); }
                {
                  auto p0 = __builtin_amdgcn_permlane32_swap(__float_as_uint(v0), __float_as_uint(v0), false, false); auto p1 = __builtin_amdgcn_permlane32_swap(__float_as_uint(v1), __float_as_uint(v1), false, false);
                  auto p2 = __builtin_amdgcn_permlane32_swap(__float_as_uint(v2), __float_as_uint(v2), false, false);
                  auto q0 = __builtin_amdgcn_permlane32_swap((unsigned)i0, (unsigned)i0, false, false); auto q1 = __builtin_amdgcn_permlane32_swap((unsigned)i1, (unsigned)i1, false, false);
                  auto q2 = __builtin_amdgcn_permlane32_swap((unsigned)i2, (unsigned)i2, false, false);
                  v0 = __uint_as_float(p0[0]); v1 = __uint_as_float(p1[0]); v2 = __uint_as_float(p2[0]); i0 = (int)q0[0]; i1 = (int)q1[0]; i2 = (int)q2[0];
                  G_INSERT(__uint_as_float(p0[1]), (int)q0[1]); G_INSERT(__uint_as_float(p1[1]), (int)q1[1]); G_INSERT(__uint_as_float(p2[1]), (int)q2[1]); }
                if (fq == 0) {
#pragma unroll
                    for (int rk = 0; rk < 3; ++rk) {
                        if (rk < nsel) { const int best = (rk == 0) ? i0 : ((rk == 1) ? i1 : i2);
                            const unsigned pos = atomicAdd((unsigned*)&lcnt[best], 1u);
                            Subl[((size_t)(j * 4 + kvh) * 32 + best) * 512 + pos] = (unsigned)r | ((unsigned)rk << 9); }
                    }
                }
            }
            __syncthreads();
            if (tid < 32) Scnt[(j * 4 + kvh) * 32 + tid] = lcnt[tid];
            __syncthreads();
        }
#undef G_BETTER
#undef G_INSERT
        for (int item = bid; item < DECB * NKV; item += G) {
            const int b = item >> 2, kvh = item & 3; const int pr = tid >> 5, n = tid & 31;
            const int row = SEQ + 4 * b + (pr >> 2), hg = pr & 3; const bf16* qp = Qb + (size_t)row * D + (4 * kvh + hg) * 128; const float* kmp = Kms + ((size_t)(b * 32 + n)) * 512 + kvh * 128;
            float s = 0.f;
#pragma unroll 4
            for (int d = 0; d < 128; d += 8) { const v4u qw = *(const v4u*)(qp + d); const f32x4 k0 = *(const f32x4*)(kmp + d), k1 = *(const f32x4*)(kmp + d + 4);
                s += (bf2f(qw.x & 0xffffu) * k0[0] + bf2f(qw.x >> 16) * k0[1]) + (bf2f(qw.y & 0xffffu) * k0[2] + bf2f(qw.y >> 16) * k0[3]) + (bf2f(qw.z & 0xffffu) * k1[0] + bf2f(qw.z >> 16) * k1[1]) + (bf2f(qw.w & 0xffffu) * k1[2] + bf2f(qw.w >> 16) * k1[3]); }
            gs[pr * 32 + n] = s;
            __syncthreads();
            if (tid < 16) { unsigned m = 0u;
                for (int r = 0; r < 3; ++r) { int best = 0; float bv = -INFINITY; for (int nn = 0; nn < 32; ++nn) { const float v = gs[tid * 32 + nn]; if (v > bv) { bv = v; best = nn; } } m |= 1u << best; gs[tid * 32 + best] = -INFINITY; }
                Sels[item * 16 + tid] = m; }
            __syncthreads();
        }
    }
    xcd_barrier(bar, IS_T0);
    STAMP();

    {
        LAS bf16* Ks = (LAS bf16*)(lds); LAS bf16* Vs = (LAS bf16*)(lds + KS_BYTES);
        LAS unsigned* qsh = (LAS unsigned*)(lds + 2 * KS_BYTES);
        constexpr int NPI = 4 * 496, NSI = DECB * NKV * NBLK;
        for (;;) {
            const unsigned tq0 = TNOW();
            if (IS_T0) qsh[0] = __hip_atomic_fetch_add(ctl + CW_Q0, 1u, __ATOMIC_RELAXED, __HIP_MEMORY_SCOPE_AGENT);
            __syncthreads();
            const int tick = (int)qsh[0];
            __syncthreads();
            TACC(0, tq0);
            if (tick >= NPI + NSI) break;
            TIDS;
            int item; { const int g3 = tick / 3, r3 = tick - 3 * g3; item = (tick < 3 * NPI) ? ((r3 == 0) ? g3 : NPI + 2 * g3 + (r3 - 1)) : NPI + (tick - NPI); }
            if (item < NPI) {
                int b = (int)((1.0f + sqrtf(1.0f + 2.0f * (float)item)) * 0.5f); while (2 * b * (b - 1) > item) --b; while (2 * (b + 1) * b <= item) ++b;
                const int rem = item - 2 * b * (b - 1); const int n = rem >> 2, kvh = rem & 3;
                const int cntA = (int)Scnt[((2 * b) * 4 + kvh) * 32 + n], cntB = (int)Scnt[((2 * b + 1) * 4 + kvh) * 32 + n]; const int total = cntA + cntB;
                if (total == 0) continue;
                const unsigned tp0 = TNOW();
#pragma unroll
                for (int i = 0; i < 8; ++i) { const int idx = i * 512 + tid, key = idx >> 4, c8 = idx & 15; *(LAS v4u*)(Ks + key * KS_P + c8 * 8) = *(const v4u*)(Kb + (size_t)(256 * n + key) * 512 + kvh * 128 + c8 * 8); }
#pragma unroll
                for (int i = 0; i < 8; ++i) { const int idx = i * 512 + tid, key = idx >> 4, c8 = idx & 15; *(LAS v4u*)(Vs + key * KS_P + c8 * 8) = *(const v4u*)(Vb + (size_t)(256 * n + key) * 512 + kvh * 128 + c8 * 8); }
                __syncthreads();
                TACC(1, tp0); const unsigned tp1 = TNOW();
                const unsigned* LA = Subl + ((size_t)((2 * b) * 4 + kvh) * 32 + n) * 512; const unsigned* LB = Subl + ((size_t)((2 * b + 1) * 4 + kvh) * 32 + n) * 512;
#define LIST_ENT(i_) (((i_) < cntA) ? LA[(i_)] : LB[(i_) - cntA])
                const int iw = 16 * wave + fr;
                unsigned e1 = 0u, e2 = 0u; int ic1 = 0, ic2 = 0;
                if (16 * wave < total) { ic1 = iw < total ? iw : total - 1; e1 = LIST_ENT(ic1); }
                if (16 * wave + 128 < total) { ic2 = iw + 128 < total ? iw + 128 : total - 1; e2 = LIST_ENT(ic2); }
                bf16x8 qn[4];
                { const int tokn = ((ic1 < cntA) ? 2 * b : 2 * b + 1) * 128 + (int)((e1 >> 2) & 127u); const bf16* qp = Qb + (size_t)tokn * D + (4 * kvh + (int)(e1 & 3u)) * 128 + 8 * fq;
#pragma unroll
                  for (int ks = 0; ks < 4; ++ks) qn[ks] = *(const bf16x8*)(qp + 32 * ks); }
                for (int t0 = 0; t0 < total; t0 += 128) {
                    const int i0 = t0 + 16 * wave; if (i0 >= total) break;
                    const bool valid = (i0 + fr) < total; const int ic = ic1; const unsigned e = e1;
                    const int tok = ((ic < cntA) ? 2 * b : 2 * b + 1) * 128 + (int)((e >> 2) & 127u), hg = (int)(e & 3u), rk = (int)(e >> 9);
                    const int h = 4 * kvh + hg;
                    bf16x8 qf[4];
#pragma unroll
                    for (int ks = 0; ks < 4; ++ks) qf[ks] = qn[ks];
                    e1 = e2; ic1 = ic2;
                    if (i0 + 256 < total) { ic2 = (i0 + 256 + fr) < total ? (i0 + 256 + fr) : total - 1; e2 = LIST_ENT(ic2); }
                    if (i0 + 128 < total) { const int tokn = ((ic1 < cntA) ? 2 * b : 2 * b + 1) * 128 + (int)((e1 >> 2) & 127u); const bf16* qp = Qb + (size_t)tokn * D + (4 * kvh + (int)(e1 & 3u)) * 128 + 8 * fq;
#pragma unroll
                        for (int ks = 0; ks < 4; ++ks) qn[ks] = *(const bf16x8*)(qp + 32 * ks); }
                    f32x4 acc[16]; attn_scores<16>(Ks, qf, acc, 16, fr, fq);
                    float mx = -INFINITY;
#pragma unroll
                    for (int kt = 0; kt < 16; ++kt) mx = fmaxf(fmaxf(mx, fmaxf(acc[kt][0], acc[kt][1])), fmaxf(acc[kt][2], acc[kt][3]));
                    mx = fmaxf(mx, shx<16>(mx)); mx = xmax32(mx);
                    float l = 0.f;
#pragma unroll
                    for (int kt = 0; kt < 16; ++kt) {
#pragma unroll
                        for (int r = 0; r < 4; ++r) { const float p = __builtin_amdgcn_exp2f(acc[kt][r] - mx); acc[kt][r] = p; l += p; } }
                    l += shx<16>(l); l = xadd32(l);
                    f32x4 O[8];
#pragma unroll
                    for (int vt = 0; vt < 8; ++vt) O[vt] = (f32x4){0.f, 0.f, 0.f, 0.f};
                    attn_pv(Vs, acc, O, 8, fr, fq);
                    if (valid) {
                        const size_t slot = ((size_t)tok * NH + h) * 3 + rk; bf16* op = Oslot + slot * 128 + 8 * fq;
#pragma unroll
                        for (int c = 0; c < 4; ++c) { v4u w; w.x = cvt_pk_bf16(O[2 * c][0], O[2 * c][1]); w.y = cvt_pk_bf16(O[2 * c][2], O[2 * c][3]); w.z = cvt_pk_bf16(O[2 * c + 1][0], O[2 * c + 1][1]); w.w = cvt_pk_bf16(O[2 * c + 1][2], O[2 * c + 1][3]); *(v4u*)(op + 32 * c) = w; }
                        if (fq == 0) { MLslot[slot * 2] = mx; MLslot[slot * 2 + 1] = l; }
                    }
                }
                __syncthreads();
                TACC(2, tp1);
            } else {
                const int si = item - NPI; const int b = si >> 7, kvh = (si >> 5) & 3, n = si & 31;
                unsigned any = 0u;
#pragma unroll
                for (int p = 0; p < 16; ++p) any |= Sels[(b * 4 + kvh) * 16 + p];
                if (!((any >> n) & 1u)) continue;
                const unsigned ts0 = TNOW();
                const int pg0 = ptab[b * NPAGES + 2 * n], pg1 = ptab[b * NPAGES + 2 * n + 1];
                f32x4 kst[16], vst[16];
#pragma unroll
                for (int i = 0; i < 16; ++i) { const int idx = i * 512 + tid, key = idx >> 5, c4 = idx & 31; const int page = (key < 128) ? pg0 : pg1;
                    const size_t go = (((size_t)page * PAGE + (key & 127)) * NKV + kvh) * 128 + c4 * 4;
                    kst[i] = __builtin_nontemporal_load((const f32x4*)(cache_k + go)); vst[i] = __builtin_nontemporal_load((const f32x4*)(cache_v + go)); }
#pragma unroll
                for (int i = 0; i < 16; ++i) { const int idx = i * 512 + tid, key = idx >> 5, c4 = idx & 31; const int page = (key < 128) ? pg0 : pg1; (void)page;
                    const f32x4 kk4 = kst[i], vv4 = vst[i];
                    v2u w; w.x = cvt_pk_bf16(kk4[0], kk4[1]); w.y = cvt_pk_bf16(kk4[2], kk4[3]); *(LAS v2u*)(Ks + key * KS_P + c4 * 4) = w;
                    v2u wv; wv.x = cvt_pk_bf16(vv4[0], vv4[1]); wv.y = cvt_pk_bf16(vv4[2], vv4[3]); *(LAS v2u*)(Vs + key * KS_P + c4 * 4) = wv; }
                __syncthreads();
                TACC(3, ts0); const unsigned ts1 = TNOW();
                {
                    LAS float* mxs = (LAS float*)(lds + 2 * KS_BYTES + 64); LAS float* lss = mxs + 128; LAS float* Ored = (LAS float*)(lds);
                    const int row = SEQ + 4 * b + (fr >> 2), hg = fr & 3; const int h = 4 * kvh + hg; const bf16* qp = Qb + (size_t)row * D + h * 128 + 8 * fq;
                    bf16x8 qf[4];
#pragma unroll
                    for (int ks = 0; ks < 4; ++ks) qf[ks] = *(const bf16x8*)(qp + 32 * ks);
                    f32x4 a2[2];
#pragma unroll
                    for (int t = 0; t < 2; ++t) { a2[t] = (f32x4){0.f, 0.f, 0.f, 0.f};
#pragma unroll
                        for (int ks = 0; ks < 4; ++ks) { const bf16x8 ka = *(const LAS bf16x8*)(Ks + (16 * (2 * wave + t) + fr) * KS_P + 32 * ks + 8 * fq); a2[t] = MFMA16(ka, qf[ks], a2[t]); } }
                    float mx = fmaxf(fmaxf(fmaxf(a2[0][0], a2[0][1]), fmaxf(a2[0][2], a2[0][3])), fmaxf(fmaxf(a2[1][0], a2[1][1]), fmaxf(a2[1][2], a2[1][3])));
                    mx = fmaxf(mx, shx<16>(mx)); mx = xmax32(mx);
                    if (fq == 0) mxs[wave * 16 + fr] = mx;
                    __syncthreads();
                    float M = mxs[fr];
#pragma unroll
                    for (int w8 = 1; w8 < 8; ++w8) M = fmaxf(M, mxs[w8 * 16 + fr]);
                    float l = 0.f;
#pragma unroll
                    for (int t = 0; t < 2; ++t) {
#pragma unroll
                        for (int r = 0; r < 4; ++r) { const float p = __builtin_amdgcn_exp2f(a2[t][r] - M); a2[t][r] = p; l += p; } }
                    l += shx<16>(l); l = xadd32(l);
                    if (fq == 0) lss[wave * 16 + fr] = l;
                    v4u pw; pw.x = cvt_pk_bf16(a2[0][0], a2[0][1]); pw.y = cvt_pk_bf16(a2[0][2], a2[0][3]); pw.z = cvt_pk_bf16(a2[1][0], a2[1][1]); pw.w = cvt_pk_bf16(a2[1][2], a2[1][3]);
                    const bf16x8 pf = __builtin_bit_cast(bf16x8, pw);
                    const LAS bf16* vb = Vs + (32 * wave + 4 * fq + (fr >> 2)) * KS_P + 4 * (fr & 3);
#pragma unroll
                    for (int vt = 0; vt < 8; ++vt) { const v2u lo = tr_read(vb + 16 * vt), hi = tr_read(vb + 16 * KS_P + 16 * vt); const v4u aw = {lo.x, lo.y, hi.x, hi.y};
                        const f32x4 o = MFMA16(__builtin_bit_cast(bf16x8, aw), pf, ((f32x4){0.f, 0.f, 0.f, 0.f}));
                        *(LAS f32x4*)(Ored + (wave * 16 + fr) * 132 + 16 * vt + 4 * fq) = o; }
                    __syncthreads();
                    { const int r16 = tid >> 5, c4 = tid & 31; f32x4 so = *(const LAS f32x4*)(Ored + r16 * 132 + 4 * c4);
#pragma unroll
                      for (int w8 = 1; w8 < 8; ++w8) so += *(const LAS f32x4*)(Ored + (w8 * 16 + r16) * 132 + 4 * c4);
                      float* sp = Sslot + ((size_t)((b * 4 + kvh) * 32 + n) * 16 + r16) * 132;
                      *(f32x4*)(sp + 4 * c4) = so;
                      if (c4 == 0) { float Mr = mxs[r16], lt = lss[r16];
#pragma unroll
                          for (int w8 = 1; w8 < 8; ++w8) { Mr = fmaxf(Mr, mxs[w8 * 16 + r16]); lt += lss[w8 * 16 + r16]; }
                          sp[128] = Mr; sp[129] = lt; } }
                }
                __syncthreads();
                TACC(4, ts1);
            }
        }
    }
    xcd_barrier(bar, IS_T0);
    STAMP();

    {
        TIDS;
        LAS bf16* Ks = (LAS bf16*)(lds); LAS bf16* Vs = (LAS bf16*)(lds + KS_BYTES);
        const unsigned tq12 = TNOW();
        for (int item = bid; item < NBLK * NKV * 2; item += G) {
            const int b = item >> 3, kvh = (item >> 1) & 3, hp = item & 1;
            int tid_i = TIDX; asm volatile("" : "+v"(tid_i));
#pragma unroll
            for (int i = 0; i < 8; ++i) { const int idx = i * 512 + tid_i, key = idx >> 4, c8 = idx & 15; *(LAS v4u*)(Ks + key * KS_P + c8 * 8) = *(const v4u*)(Kb + (size_t)(256 * b + key) * 512 + kvh * 128 + c8 * 8); }
#pragma unroll
            for (int i = 0; i < 8; ++i) { const int idx = i * 512 + tid_i, key = idx >> 4, c8 = idx & 15; *(LAS v4u*)(Vs + key * KS_P + c8 * 8) = *(const v4u*)(Vb + (size_t)(256 * b + key) * 512 + kvh * 128 + c8 * 8); }
            const int nsel = b < 3 ? b : 3;
            bf16x8 qn[4];
            { const bf16* qp = Qb + (size_t)(256 * b + 16 * wave + fr) * D + (4 * kvh + 2 * hp) * 128 + 8 * fq;
#pragma unroll
              for (int ks = 0; ks < 4; ++ks) qn[ks] = *(const bf16x8*)(qp + 32 * ks); }
            __syncthreads();
#pragma unroll 1
            for (int u = 0; u < 4; ++u) {
                const int g = (u & 1) ? 15 - wave : wave, h = 4 * kvh + 2 * hp + (u >> 1); const int tl = 16 * g + fr; const int tok = 256 * b + tl;
                bf16x8 qf[4];
#pragma unroll
                for (int ks = 0; ks < 4; ++ks) qf[ks] = qn[ks];
                if (u < 3) { const int gn = ((u + 1) & 1) ? 15 - wave : wave, hn = 4 * kvh + 2 * hp + ((u + 1) >> 1); const bf16* qp = Qb + (size_t)(256 * b + 16 * gn + fr) * D + hn * 128 + 8 * fq;
#pragma unroll
                    for (int ks = 0; ks < 4; ++ks) qn[ks] = *(const bf16x8*)(qp + 32 * ks); }
                float msa[3], lsa[3];
#pragma unroll
                for (int r = 0; r < 3; ++r) { msa[r] = -INFINITY; lsa[r] = 0.f; if (r < nsel) { const size_t slot = ((size_t)tok * NH + h) * 3 + r; msa[r] = MLslot[slot * 2]; lsa[r] = MLslot[slot * 2 + 1]; } }
                v4u ow[3][4];
#pragma unroll
                for (int r = 0; r < 3; ++r) { if (r < nsel) { const bf16* op = Oslot + (((size_t)tok * NH + h) * 3 + r) * 128 + 8 * fq;
#pragma unroll
                    for (int c = 0; c < 4; ++c) ow[r][c] = *(const v4u*)(op + 32 * c); } }
                const int nkt = g + 1;
                f32x4 acc[16]; attn_scores<16>(Ks, qf, acc, nkt, fr, fq);
                float mx = -INFINITY;
#pragma unroll
                for (int kt = 0; kt < 16; ++kt) {
#pragma unroll
                    for (int r = 0; r < 4; ++r) { const bool ok = (kt < nkt) && (16 * kt + 4 * fq + r <= tl); const float sv = ok ? acc[kt][r] : -INFINITY; acc[kt][r] = sv; mx = fmaxf(mx, sv); } }
                mx = fmaxf(mx, shx<16>(mx)); mx = xmax32(mx);
                float M = mx;
#pragma unroll
                for (int r = 0; r < 3; ++r) M = fmaxf(M, msa[r]);
                f32x4 O[8]; float lp = 0.f;
#pragma unroll
                for (int vt = 0; vt < 8; ++vt) O[vt] = (f32x4){0.f, 0.f, 0.f, 0.f};
#pragma unroll
                for (int r = 0; r < 3; ++r) { if (r < nsel) { const float sc = __builtin_amdgcn_exp2f(msa[r] - M); lp += lsa[r] * sc;
#pragma unroll
                    for (int c = 0; c < 4; ++c) { const v4u w = ow[r][c];
                        O[2 * c][0] += bf2f(w.x & 0xffffu) * sc; O[2 * c][1] += bf2f(w.x >> 16) * sc; O[2 * c][2] += bf2f(w.y & 0xffffu) * sc; O[2 * c][3] += bf2f(w.y >> 16) * sc;
                        O[2 * c + 1][0] += bf2f(w.z & 0xffffu) * sc; O[2 * c + 1][1] += bf2f(w.z >> 16) * sc; O[2 * c + 1][2] += bf2f(w.w & 0xffffu) * sc; O[2 * c + 1][3] += bf2f(w.w >> 16) * sc; } } }
                float l = 0.f;
#pragma unroll
                for (int kt = 0; kt < 16; ++kt) {
#pragma unroll
                    for (int r = 0; r < 4; ++r) { const float p = __builtin_amdgcn_exp2f(acc[kt][r] - M); acc[kt][r] = p; l += p; } }
                l += shx<16>(l); l = xadd32(l); l += lp;
                attn_pv(Vs, acc, O, (nkt + 1) >> 1, fr, fq);
                const float il = 1.0f / l; bf16* ap = At + (size_t)tok * D + h * 128 + 4 * fq;
#pragma unroll
                for (int vt = 0; vt < 8; ++vt) { v2u w; w.x = cvt_pk_bf16(O[vt][0] * il, O[vt][1] * il); w.y = cvt_pk_bf16(O[vt][2] * il, O[vt][3] * il); *(v2u*)(ap + 16 * vt) = w; }
            }
            __syncthreads();
        }
        TACC(10, tq12); const unsigned ts12 = TNOW();
        LAS float* ksn = (LAS float*)(lds);
        for (int item = bid; item < DECB * NKV; item += G) {
            const int b = item >> 2, kvh = item & 3;
            TIDS;
            { const int key = tid >> 7, d = tid & 127; ksn[key * 128 + d] = out[OK_S + (size_t)(4 * b + key) * 512 + kvh * 128 + d]; ksn[512 + key * 128 + d] = out[OV_S + (size_t)(4 * b + key) * 512 + kvh * 128 + d]; }
            __syncthreads();
            const int pr = tid >> 5, l32 = tid & 31; const int t = pr >> 2, hg = pr & 3; const int row = SEQ + 4 * b + t, h = 4 * kvh + hg;
            const v2u qw = *(const v2u*)(Qb + (size_t)row * D + h * 128 + 4 * l32);
            const float q0 = bf2f(qw.x & 0xffffu), q1 = bf2f(qw.x >> 16), q2 = bf2f(qw.y & 0xffffu), q3 = bf2f(qw.y >> 16);
            float sk[4]; float M = -INFINITY;
#pragma unroll
            for (int key = 0; key < 4; ++key) { const f32x4 k4 = *(const LAS f32x4*)(ksn + key * 128 + 4 * l32); float s = (q0 * k4[0] + q1 * k4[1]) + (q2 * k4[2] + q3 * k4[3]);
                s += shx<1>(s); s += shx<2>(s); s += shx<4>(s); s += shx<8>(s); s += shx<16>(s);
                sk[key] = (key <= t) ? s : -INFINITY; M = fmaxf(M, sk[key]); }
            unsigned mk = Sels[item * 16 + pr];
            float sm[3], sl[3]; f32x4 so[3]; bool sv[3];
#pragma unroll
            for (int i = 0; i < 3; ++i) { sv[i] = mk != 0u; const int n = sv[i] ? __builtin_ctz(mk) : 0; mk &= mk - 1u;
                const float* sp = Sslot + ((size_t)(item * 32 + n) * 16 + pr) * 132; sm[i] = sp[128]; sl[i] = sp[129]; so[i] = *(const f32x4*)(sp + 4 * l32); }
#pragma unroll
            for (int i = 0; i < 3; ++i) if (sv[i]) M = fmaxf(M, sm[i]);
            float l = 0.f; f32x4 O = {0.f, 0.f, 0.f, 0.f};
#pragma unroll
            for (int key = 0; key < 4; ++key) { const float p = __builtin_amdgcn_exp2f(sk[key] - M); l += p; O += *(const LAS f32x4*)(ksn + 512 + key * 128 + 4 * l32) * p; }
#pragma unroll
            for (int i = 0; i < 3; ++i) if (sv[i]) { const float sc = __builtin_amdgcn_exp2f(sm[i] - M); l += sl[i] * sc; O += so[i] * sc; }
            const float il = 1.0f / l; v2u w; w.x = cvt_pk_bf16(O[0] * il, O[1] * il); w.y = cvt_pk_bf16(O[2] * il, O[3] * il);
            *(v2u*)(At + (size_t)row * D + h * 128 + 4 * l32) = w;
            __syncthreads();
        }
        TACC(11, ts12);
    }
    xcd_barrier(bar, IS_T0);
    STAMP();

    {
        TIDS;
        pg8::Gemm g{At, Wo_t, SEQ, D, D}; pg8::StaticOrder S; S.init(SEQ, D, G, bid);
        EpiRes<1> E{Hb2, nullptr, nullptr, Hb3, ss3};
        pg8::gemm_phase<EpiRes<1>, pg8::StaticOrder, true, true, false>(lds, g, S, E, TIDX);
        { const int t2 = bid & 127, rh = (bid >> 7) & 1; TIDS; f32x4 ta[1]; tail_gemm<1, D>(lds, At + (size_t)SEQ * D, Wo_t, 16 * t2, rh, ta, TIDX, bid & 127); if (wave < 4) E.tail(SEQ + 64 * rh + 16 * wave + fr, 16 * t2 + 4 * fq, ta[0], fq); }
    }
    xcd_barrier(bar, IS_T0);
    STAMP();
    {
        TIDS;
        pg8::Gemm g{Hb3, Wgu1_t, MP, NGU, D}; pg8::StaticOrder S; S.init(MP, NGU, G, bid);
        EpiGU E{ss3, Hm};
        pg8::gemm_phase<EpiGU, pg8::StaticOrder, true, true>(lds, g, S, E, TIDX);
    }
    xcd_barrier(bar, IS_T0);
    STAMP();
    {
        TIDS;
        pg8::Gemm g{Hm, Wdn1_t, SEQ, D, DFF}; pg8::StaticOrder S; S.init(SEQ, D, G, bid);
        EpiRes<2> E{Hb3, out + OY_P, out + OY_S, nullptr, nullptr};
        pg8::gemm_phase<EpiRes<2>, pg8::StaticOrder, true, true, false>(lds, g, S, E, TIDX);
        { const int t2 = bid & 127, rh = (bid >> 7) & 1; TIDS; f32x4 ta[1]; tail_gemm<1, DFF>(lds, Hm + (size_t)SEQ * DFF, Wdn1_t, 16 * t2, rh, ta, TIDX, bid & 127); if (wave < 4) E.tail(SEQ + 64 * rh + 16 * wave + fr, 16 * t2 + 4 * fq, ta[0], fq); }
    }
#ifdef PROF_A
    STAMP();
    if (blockIdx.x == 0 && IS_T0) {
        const unsigned ta = PVAL(PROF_A0, PROF_A1), tb = PVAL(PROF_B0, PROF_B1);
        unsigned qa = (ta + PROF_UA / 2) / PROF_UA, qb = (tb + PROF_UB / 2) / PROF_UB; if (qa > 99u) qa = 99u; if (qb > 99u) qb = 99u;
#ifdef PROF_MUL
        const unsigned long long extra = (unsigned long long)ta * PROF_MUL;
#else
        const unsigned long long extra = (unsigned long long)(qa + 100u * qb) * 5000ull;
#endif
        const unsigned long long t0 = __builtin_amdgcn_s_memrealtime();
        while (__builtin_amdgcn_s_memrealtime() - t0 < extra) __builtin_amdgcn_s_sleep(32);
    }
#endif
}
#undef x_p
#undef x_s
#undef st_in
#undef cache_k
#undef cache_v
#undef ptab
#undef norm_mix_a
#undef w_in
#undef lbl
#undef onorm
#undef w_out
#undef norm_kv
#undef w_kv
#undef k_norm
#undef norm_mix_b
#undef w_q
#undef q_norm
#undef w_o
#undef norm_ffn
#undef w_gu
#undef w_dn
#undef Win_t
#undef Wout_t
#undef Wgu0_t
#undef Wdn0_t
#undef Wkvq_t
#undef Wo_t
#undef Wgu1_t
#undef Wdn1_t
#undef Hb0
#undef Hb1
#undef Hb2
#undef Hb3
#undef Hf1
#undef Hf2
#undef Hf3
#undef Qg
#undef Vg
#undef Gg
#undef Ff
#undef Ob
#undef At
#undef Hm
#undef Ug
#undef Sg0
#undef Dg
#undef Kraw
#undef Vraw
#undef Qraw
#undef Kb
#undef Vb
#undef Qb
#undef Kpart
#undef Kms
#undef Subl
#undef Scnt
#undef Sels
#undef Oslot
#undef MLslot
#undef Sslot
#undef ss0
#undef ss1
#undef ss2
#undef ss3
#undef out
#undef TIDS
#undef TIDX
#undef IS_T0

extern "C" void kernel_launch(void* const* d_in, const int* in_sizes, int n_in, void* d_out, int out_size, void* d_ws, size_t ws_size, hipStream_t stream) {
    static int grid = 0;
    if (grid == 0) {
        if (n_in != 21 || ws_size < WS_END) { fprintf(stderr, "kernel_launch: unexpected n_in %d / ws %zu\n", n_in, ws_size); grid = -1; return; }
        int dev = 0, cus = 0, per_cu = 0;
        if (hipGetDevice(&dev) != hipSuccess || hipDeviceGetAttribute(&cus, hipDeviceAttributeMultiprocessorCount, dev) != hipSuccess) { grid = -1; return; }
        if (hipFuncSetAttribute((const void*)yoco_fwd, hipFuncAttributeMaxDynamicSharedMemorySize, LDS_BYTES) != hipSuccess) { fprintf(stderr, "kernel_launch: hipFuncSetAttribute failed\n"); grid = -1; return; }
        if (hipOccupancyMaxActiveBlocksPerMultiprocessor(&per_cu, (const void*)yoco_fwd, NTHR, LDS_BYTES) != hipSuccess || per_cu < 1) fprintf(stderr, "kernel_launch: occupancy query says %d\n", per_cu);
        (void)hipGetLastError();
        grid = cus;
        if (grid < 256) { fprintf(stderr, "kernel_launch: built for 256 CUs (got %d)\n", grid); grid = -1; return; }
        grid = 256;
    }
    if (grid < 0) return;
    (void)hipMemsetAsync((char*)d_ws + WS_CTL, 0, CTL_ZERO_BYTES, stream);
    Args a{};
    for (int i = 0; i < 21; ++i) a.in[i] = d_in[i];
    a.out = (float*)d_out; a.ws = (unsigned char*)d_ws;
    hipLaunchKernelGGL(yoco_fwd, dim3(grid), dim3(NTHR), LDS_BYTES, stream, a);
}
```

```cpp
#include <hip/hip_runtime.h>
#include <cstdio>
#include <cstdint>
__device__ __forceinline__ int lane_id() { int l; asm volatile("v_mbcnt_lo_u32_b32 %0, -1, 0\n\tv_mbcnt_hi_u32_b32 %0, -1, %0" : "=v"(l)); return l; }

namespace pg8 {
#define PG8_LAS __attribute__((address_space(3)))
typedef unsigned short bf16_t;
typedef short bf16x8 __attribute__((ext_vector_type(8)));
typedef float f32x4 __attribute__((ext_vector_type(4)));
typedef unsigned u32x4 __attribute__((ext_vector_type(4)));
typedef unsigned u32x2 __attribute__((ext_vector_type(2)));
constexpr int BM = 256, BK = 64, HALF = 128, HTB = HALF * BK * 2, STAGE_BYTES = 8 * HTB, NXCD = 8, WGM = 8;

__host__ __device__ __forceinline__ int lds_byte(int r, int c) { const int st = (r >> 4) * 2 + (c >> 5), rr = r & 15, cc = c & 31, ob = rr * 64 + cc * 2; return st * 1024 + (ob ^ (((ob >> 9) & 1) << 5)); }
__host__ __device__ __forceinline__ void stage_rc(int b, int& R, int& C) { const int st = b / 1024, sb = b % 1024, swz = sb ^ (((sb >> 9) & 1) << 5); R = (st >> 1) * 16 + swz / 64; C = (st & 1) * 32 + (swz % 64) / 2; }
__host__ __device__ __forceinline__ int perm32(int rho) { const int n = rho >> 4, i = rho & 15; return 8 * (i >> 2) + 4 * n + (i & 3); }

struct Unit { int pm, pn; };
struct Gemm { const bf16_t* A; const bf16_t* Bt; int M, N, K; };

struct StaticOrder {
    int nM, nN, nwg, G, c;
    __host__ __device__ void init(int M, int N, int G_, int c_) { nM = M / BM; nN = N / BM; nwg = nM * nN; G = G_; c = c_; }
    __host__ __device__ bool next(int i, Unit& u) const {
        const long L = (long)i * G + c; if (L >= nwg) return false;
        int wgid = (int)L; { const int q = nwg / NXCD, r = nwg % NXCD, xcd = wgid % NXCD, off = wgid / NXCD; wgid = (xcd < r ? xcd * (q + 1) : r * (q + 1) + (xcd - r) * q) + off; }
        const int nig = WGM * nN, gid = wgid / nig, fm = gid * WGM, gsz = (nM - fm) < WGM ? (nM - fm) : WGM;
        u.pm = fm + ((wgid % nig) % gsz); u.pn = (wgid % nig) / gsz; return true;
    }
    __device__ __forceinline__ void a_ready(const Unit&) const {}
    __device__ __forceinline__ void done(const Unit&) const {}
};

__device__ __forceinline__ unsigned cvt_pk_bf16(float lo, float hi) { unsigned r; asm volatile("v_cvt_pk_bf16_f32 %0, %1, %2" : "=v"(r) : "v"(lo), "v"(hi)); return r; }

template <class Epi, class Sched, bool ALIGN_EPI = false, bool SP2 = false, bool HALF_LAST = true>
__device__ __forceinline__ void gemm_phase(PG8_LAS unsigned char* lds, const Gemm g, const Sched& S, const Epi& E, int tidx) {
    int tid_ = tidx; asm volatile("" : "+v"(tid_));
    const int tid = tid_, wid = __builtin_amdgcn_readfirstlane(tid >> 6), lane = tid & 63, wr = wid >> 2, wc = wid & 3, fr = lane & 15, fq = lane >> 4;
    const int K = g.K, nt = K / BK;
    unsigned voffA[2], voffB[2];
#pragma unroll
    for (int i = 0; i < 2; ++i) { int R, C; stage_rc(tid * 16 + i * 8192, R, C); const int Rb = Epi::PERM ? ((R & ~31) + perm32(R & 31)) : R;
        voffA[i] = (unsigned)(R * K + C) * 2u; voffB[i] = (unsigned)(Rb * K + C) * 2u; }
    const size_t kstep = (size_t)(BK * 2);
    const size_t hstep = (size_t)HALF * K * 2;
    const size_t tstep = 2 * hstep;
    const unsigned ldsw = (unsigned)wid * 1024u;
    const int aoff = lds_byte(wr * 64 + fr, fq * 8), boff = lds_byte(wc * 32 + fr, fq * 8);
#define PG8_SA(b, h) (((b) * 2 + (h)) * HTB)
#define PG8_SB(b, h) ((4 + (b) * 2 + (h)) * HTB)
#define PG8_STAGE(bufoff, gbase, voff) do { _Pragma("unroll") for (int _i = 0; _i < 2; ++_i) \
        __builtin_amdgcn_global_load_lds((const unsigned*)((const char*)(gbase) + (voff)[_i]), (PG8_LAS unsigned*)(lds + (bufoff) + ldsw + _i * 8192), 16, 0, 0); } while (0)
#define PG8_LDA(dst, b, h) do { _Pragma("unroll") for (int m = 0; m < 4; ++m) _Pragma("unroll") for (int k = 0; k < 2; ++k) dst[m][k] = *(const PG8_LAS bf16x8*)(lds + PG8_SA(b, h) + aoff + m * 2048 + k * 1024); } while (0)
#define PG8_LDB(dst, b, h) do { _Pragma("unroll") for (int n = 0; n < 2; ++n) _Pragma("unroll") for (int k = 0; k < 2; ++k) dst[n][k] = *(const PG8_LAS bf16x8*)(lds + PG8_SB(b, h) + boff + n * 2048 + k * 1024); } while (0)
#define PG8_MMA(ai, bj, At, Bt) do { __builtin_amdgcn_s_setprio(1); _Pragma("unroll") for (int m = 0; m < 4; ++m) _Pragma("unroll") for (int n = 0; n < 2; ++n) _Pragma("unroll") for (int k = 0; k < 2; ++k) \
        acc[ai][bj][m][n] = __builtin_amdgcn_mfma_f32_16x16x32_bf16(Bt[n][k], At[m][k], acc[ai][bj][m][n], 0, 0, 0); __builtin_amdgcn_s_setprio(0); } while (0)
#define PG8_WAIT_V(n) asm volatile("s_waitcnt vmcnt(" #n ")" ::: "memory")
#define PG8_WAIT_L(n) asm volatile("s_waitcnt lgkmcnt(" #n ")" ::: "memory")
#define PG8_BAR __builtin_amdgcn_s_barrier()
#define PG8_SCHED __builtin_amdgcn_sched_barrier(0)
    Unit cur, nxt; int ui = 0;
    if (!S.next(0, cur)) return;
    f32x4 acc[2][2][4][2];
#pragma unroll
    for (int a = 0; a < 2; ++a)
#pragma unroll
        for (int b = 0; b < 2; ++b)
#pragma unroll
            for (int m = 0; m < 4; ++m)
#pragma unroll
                for (int n = 0; n < 2; ++n) acc[a][b][m][n] = (f32x4){0.f, 0.f, 0.f, 0.f};
    bf16x8 At[4][2], B0[2][2], B1[2][2];
    const char* cA = (const char*)g.A + (size_t)cur.pm * tstep; const char* cB = (const char*)g.Bt + (size_t)cur.pn * tstep;
    S.a_ready(cur);
    if constexpr (SP2) {
        PG8_STAGE(PG8_SB(0, 0), cB, voffB); PG8_STAGE(PG8_SB(0, 1), cB + hstep, voffB); PG8_STAGE(PG8_SA(0, 0), cA, voffA); PG8_STAGE(PG8_SA(0, 1), cA + hstep, voffA);
        if (wr == 1) PG8_BAR;
        PG8_WAIT_V(2); PG8_BAR;
        PG8_STAGE(PG8_SB(1, 0), cB + kstep, voffB); PG8_STAGE(PG8_SA(1, 0), cA + kstep, voffA); PG8_STAGE(PG8_SB(1, 1), cB + hstep + kstep, voffB);
        PG8_WAIT_V(6); PG8_BAR;
    } else {
        PG8_STAGE(PG8_SB(0, 0), cB, voffB); PG8_STAGE(PG8_SA(0, 0), cA, voffA); PG8_STAGE(PG8_SB(0, 1), cB + hstep, voffB); PG8_STAGE(PG8_SA(0, 1), cA + hstep, voffA);
        if (wr == 1) PG8_BAR;
        PG8_WAIT_V(4); PG8_BAR;
        PG8_STAGE(PG8_SB(1, 0), cB + kstep, voffB); PG8_STAGE(PG8_SA(1, 0), cA + kstep, voffA); PG8_STAGE(PG8_SB(1, 1), cB + hstep + kstep, voffB);
        PG8_WAIT_V(6); PG8_BAR;
    }
    for (;;) {
        const bool has_next = S.next(ui + 1, nxt);
        const bool half1 = HALF_LAST && (cur.pm == g.M / BM - 1);
        const char* nA = has_next ? (const char*)g.A + (size_t)nxt.pm * tstep : cA; const char* nB = has_next ? (const char*)g.Bt + (size_t)nxt.pn * tstep : cB;
        for (int t = 0; t < nt; t += 2) {
            const bool last = (t == nt - 2);
            const char* a1 = cA + (size_t)(t + 1) * kstep;
            const char* a2 = last ? nA : cA + (size_t)(t + 2) * kstep; const char* b2 = last ? nB : cB + (size_t)(t + 2) * kstep;
            const char* a3 = a2 + kstep; const char* b3 = b2 + kstep;
            if (last && has_next) S.a_ready(nxt);
            if constexpr (SP2) {
            PG8_LDB(B0, 0, 0); PG8_LDB(B1, 0, 1); PG8_SCHED; PG8_LDA(At, 0, 0); PG8_STAGE(PG8_SA(1, 1), a1 + hstep, voffA);
            PG8_WAIT_V(8); PG8_WAIT_L(0); PG8_BAR; PG8_MMA(0, 0, At, B0); PG8_MMA(0, 1, At, B1); PG8_BAR; PG8_SCHED;
            if (!half1) { PG8_LDA(At, 0, 1); } PG8_STAGE(PG8_SB(0, 0), b2, voffB); PG8_STAGE(PG8_SB(0, 1), b2 + hstep, voffB); PG8_STAGE(PG8_SA(0, 0), a2, voffA);
            PG8_WAIT_V(8); PG8_WAIT_L(0); PG8_BAR; if (!half1) { PG8_MMA(1, 0, At, B0); PG8_MMA(1, 1, At, B1); } PG8_BAR; PG8_SCHED;
            PG8_LDB(B0, 1, 0); PG8_LDB(B1, 1, 1); PG8_SCHED; PG8_LDA(At, 1, 0); PG8_STAGE(PG8_SA(0, 1), a2 + hstep, voffA);
            PG8_WAIT_V(8); PG8_WAIT_L(0); PG8_BAR; PG8_MMA(0, 0, At, B0); PG8_MMA(0, 1, At, B1); PG8_BAR; PG8_SCHED;
            if (!half1) { PG8_LDA(At, 1, 1); } PG8_STAGE(PG8_SB(1, 0), b3, voffB); PG8_STAGE(PG8_SB(1, 1), b3 + hstep, voffB); PG8_STAGE(PG8_SA(1, 0), a3, voffA);
            PG8_WAIT_V(8); PG8_WAIT_L(0); PG8_BAR; if (!half1) { PG8_MMA(1, 0, At, B0); PG8_MMA(1, 1, At, B1); } PG8_BAR; PG8_SCHED;
            } else {
            PG8_LDB(B0, 0, 0); PG8_SCHED; PG8_LDA(At, 0, 0); PG8_STAGE(PG8_SA(1, 1), a1 + hstep, voffA);
            PG8_WAIT_L(8); PG8_BAR; PG8_WAIT_L(0); PG8_MMA(0, 0, At, B0); PG8_BAR; PG8_SCHED;
            PG8_LDB(B1, 0, 1); PG8_STAGE(PG8_SB(0, 0), b2, voffB);
            PG8_BAR; PG8_WAIT_L(0); PG8_MMA(0, 1, At, B1); PG8_BAR;
            PG8_LDA(At, 0, 1); PG8_STAGE(PG8_SA(0, 0), a2, voffA);
            PG8_BAR; PG8_WAIT_L(0); PG8_MMA(1, 0, At, B0); PG8_BAR; PG8_SCHED;
            PG8_STAGE(PG8_SB(0, 1), b2 + hstep, voffB);
            PG8_WAIT_V(6); PG8_BAR; PG8_MMA(1, 1, At, B1); PG8_BAR;
            PG8_LDB(B0, 1, 0); PG8_SCHED; PG8_LDA(At, 1, 0); PG8_STAGE(PG8_SA(0, 1), a2 + hstep, voffA);
            PG8_WAIT_L(8); PG8_BAR; PG8_WAIT_L(0); PG8_MMA(0, 0, At, B0); PG8_BAR; PG8_SCHED;
            PG8_LDB(B1, 1, 1); PG8_STAGE(PG8_SB(1, 0), b3, voffB);
            PG8_BAR; PG8_WAIT_L(0); PG8_MMA(0, 1, At, B1); PG8_BAR;
            PG8_LDA(At, 1, 1); PG8_STAGE(PG8_SA(1, 0), a3, voffA);
            PG8_BAR; PG8_WAIT_L(0); PG8_MMA(1, 0, At, B0); PG8_BAR; PG8_SCHED;
            PG8_STAGE(PG8_SB(1, 1), b3 + hstep, voffB);
            PG8_WAIT_V(6); PG8_BAR; PG8_MMA(1, 1, At, B1); PG8_BAR;
            }
        }
        if constexpr (ALIGN_EPI) { if (wr == 0) PG8_BAR; }
        E(acc, cur, wr, wc, fr, fq);
        if (!has_next) break;
#pragma unroll
        for (int a = 0; a < 2; ++a)
#pragma unroll
            for (int b = 0; b < 2; ++b)
#pragma unroll
                for (int m = 0; m < 4; ++m)
#pragma unroll
                    for (int n = 0; n < 2; ++n) acc[a][b][m][n] = (f32x4){0.f, 0.f, 0.f, 0.f};
        cur = nxt; cA = nA; cB = nB; ++ui;
        if constexpr (ALIGN_EPI) { if (wr == 1) PG8_BAR; }
    }
    PG8_WAIT_V(0);
    if constexpr (!ALIGN_EPI) { if (wr == 0) PG8_BAR; }
    PG8_BAR;
#undef PG8_SA
#undef PG8_SB
#undef PG8_STAGE
#undef PG8_LDA
#undef PG8_LDB
#undef PG8_MMA
#undef PG8_WAIT_V
#undef PG8_WAIT_L
#undef PG8_BAR
#undef PG8_SCHED
}
}

constexpr int NWAVES = 8, NTHR = 512;
constexpr int D = 2048, SEQ = 8192, DECB = 32, DECS = 4, MS = DECB * DECS;
constexpr int MR = SEQ + MS;
constexpr int MP = 8448;
constexpr int NH = 16, HD = 128, NKV = 4, DFF = 5632, NGU = 2 * DFF;
constexpr int NCHUNK = SEQ / 64;
constexpr int NPAGES = 64, PAGE = 128, NBLK = 32;
constexpr float EPS = 1e-6f;
constexpr float C2 = 0.08838834764831845f * 1.4426950408889634f;

constexpr size_t OY_P = 0, OY_S = OY_P + (size_t)SEQ * D, OST_P = OY_S + (size_t)MS * D, OST_S = OST_P + (size_t)NH * 128 * 128,
                 OK_P = OST_S + (size_t)DECB * NH * 128 * 128, OV_P = OK_P + (size_t)SEQ * 512, OK_S = OV_P + (size_t)SEQ * 512, OV_S = OK_S + (size_t)MS * 512;

constexpr size_t MiB = 1u << 20;
constexpr size_t WS_CTL = 0, CTL_ZERO_BYTES = 1 * MiB;
constexpr size_t WS_WIN = 2 * MiB;
constexpr size_t WS_WOUT = WS_WIN + 32 * MiB;
constexpr size_t WS_WGU0 = WS_WOUT + 8 * MiB;
constexpr size_t WS_WDN0 = WS_WGU0 + 44 * MiB;
constexpr size_t WS_WKVQ = WS_WDN0 + 22 * MiB;
constexpr size_t WS_WO = WS_WKVQ + 12 * MiB;
constexpr size_t WS_WGU1 = WS_WO + 8 * MiB;
constexpr size_t WS_WDN1 = WS_WGU1 + 44 * MiB;
constexpr size_t WS_HB0 = WS_WDN1 + 22 * MiB;
constexpr size_t WS_HB1 = WS_HB0 + 34 * MiB, WS_HB2 = WS_HB1 + 34 * MiB, WS_HB3 = WS_HB2 + 34 * MiB;
constexpr size_t WS_HF1 = WS_HB3 + 34 * MiB;
constexpr size_t WS_HF2 = WS_HF1 + 67 * MiB, WS_HF3 = WS_HF2 + 67 * MiB;
constexpr size_t WS_QG = WS_HF3 + 67 * MiB;
constexpr size_t WS_VG = WS_QG + 34 * MiB;
constexpr size_t WS_GG = WS_VG + 34 * MiB;
constexpr size_t WS_F = WS_GG + 34 * MiB;
constexpr size_t WS_OB = WS_F + 67 * MiB;
constexpr size_t WS_AT = WS_OB + 34 * MiB;
constexpr size_t WS_HM = WS_AT + 34 * MiB;
constexpr size_t WS_U = WS_HM + 92 * MiB;
constexpr size_t WS_SST = WS_U + 64 * MiB;
constexpr size_t WS_DEC = WS_SST + 64 * MiB;
constexpr size_t WS_KRAW = WS_DEC + 2 * MiB;
constexpr size_t WS_VRAW = WS_KRAW + 17 * MiB;
constexpr size_t WS_QRAW = WS_VRAW + 17 * MiB;
constexpr size_t WS_KB = WS_QRAW + 67 * MiB;
constexpr size_t WS_VB = WS_KB + 9 * MiB;
constexpr size_t WS_QB = WS_VB + 9 * MiB;
constexpr size_t WS_KPART = WS_QB + 34 * MiB;
constexpr size_t WS_KMS = WS_KPART + 1 * MiB;
constexpr size_t WS_SUBL = WS_KMS + 2 * MiB;
constexpr size_t WS_SCNT = WS_SUBL + 16 * MiB;
constexpr size_t WS_OSLOT = WS_SCNT + 1 * MiB;
constexpr size_t WS_MLSLOT = WS_OSLOT + 192 * MiB;
constexpr size_t WS_SSLOT = WS_MLSLOT + 3 * MiB;
constexpr size_t WS_FOUT = WS_SSLOT + 34 * MiB;
constexpr size_t WS_END = WS_FOUT + 131 * MiB;
constexpr size_t WS_ORC = WS_END;
constexpr int CW_BAR = 4096;
constexpr int CW_Q0 = 8192;
constexpr int CW_SS0 = 16384, CW_SS1 = CW_SS0 + MP, CW_SS2 = CW_SS1 + MP, CW_SS3 = CW_SS2 + MP;
static_assert((CW_SS3 + MP) * 4 <= (int)CTL_ZERO_BYTES, "ctl");
static_assert(WS_VG - WS_QG == 34 * MiB && WS_GG - WS_VG == 34 * MiB, "Qg|Vg|Gg stride");

constexpr int LDS_BYTES = 160 * 1024;
constexpr int MISC_OFF = LDS_BYTES - 256;

#define GAS __attribute__((address_space(1)))
#define LAS __attribute__((address_space(3)))
typedef unsigned short bf16;
typedef unsigned v4u __attribute__((ext_vector_type(4)));
typedef unsigned v2u __attribute__((ext_vector_type(2)));
typedef float f32x4 __attribute__((ext_vector_type(4)));
typedef float f32x2 __attribute__((ext_vector_type(2)));
typedef short bf16x8 __attribute__((ext_vector_type(8)));
typedef short bf16x4 __attribute__((ext_vector_type(4)));
typedef _Float16 f16;
typedef _Float16 f16x2 __attribute__((ext_vector_type(2)));
__device__ __forceinline__ unsigned pkh2(float lo, float hi) { const f16x2 v = {(f16)lo, (f16)hi}; return __builtin_bit_cast(unsigned, v); }
#define LDS_WAIT() asm volatile("s_waitcnt lgkmcnt(0)" ::: "memory")
__device__ __forceinline__ unsigned f2bf(float f) { unsigned u = __builtin_bit_cast(unsigned, f); return (u + 0x7fffu + ((u >> 16) & 1u)) >> 16; }
__device__ __forceinline__ unsigned pk2(float lo, float hi) { return f2bf(lo) | (f2bf(hi) << 16); }
__device__ __forceinline__ float bf2f(unsigned h) { return __uint_as_float(h << 16); }
__device__ __forceinline__ float silu_f(float x) { return x * __builtin_amdgcn_rcpf(1.0f + __expf(-x)); }
__device__ __forceinline__ float sigm_f(float x) { return __builtin_amdgcn_rcpf(1.0f + __expf(-x)); }
template <int M> __device__ __forceinline__ float shx(float v) { return __uint_as_float((unsigned)__builtin_amdgcn_ds_swizzle((int)__float_as_uint(v), (M << 10) | 0x1f)); }
__device__ __forceinline__ float xadd32(float v) { auto rr = __builtin_amdgcn_permlane32_swap(__float_as_uint(v), __float_as_uint(v), false, false); return __uint_as_float(rr[0]) + __uint_as_float(rr[1]); }
__device__ __forceinline__ float xmax32(float v) { auto rr = __builtin_amdgcn_permlane32_swap(__float_as_uint(v), __float_as_uint(v), false, false); return fmaxf(__uint_as_float(rr[0]), __uint_as_float(rr[1])); }
__device__ __forceinline__ float wave_sum(float v) { v += shx<1>(v); v += shx<2>(v); v += shx<4>(v); v += shx<8>(v); v += shx<16>(v); return xadd32(v); }
#define MFMA16(a, b, c) __builtin_amdgcn_mfma_f32_16x16x32_bf16((a), (b), (c), 0, 0, 0)

#define XB_TMO      128
#define XB_XCNT(j)  (256  + 64 * (j))
#define XB_XSUB(j)  (1280 + 64 * (j))
#define XB_XGEN(j)  (2304 + 64 * (j))
#define XB_TOP      3328
#define XB_TOPGEN   3392
#define XCD_BAR_WORDS 3456
#define XB_SPIN_CAP (1u << 18)
__device__ __forceinline__ unsigned xb_ld(unsigned* p)              { return __hip_atomic_load(p, __ATOMIC_RELAXED, __HIP_MEMORY_SCOPE_AGENT); }
__device__ __forceinline__ unsigned xb_add(unsigned* p, unsigned v) { return __hip_atomic_fetch_add(p, v, __ATOMIC_RELAXED, __HIP_MEMORY_SCOPE_AGENT); }
__device__ __forceinline__ unsigned xb_xcc_id() { return (unsigned)__builtin_amdgcn_s_getreg((3 << 11) | 20) & 0xFu; }
#define XB_SPIN(cond, bar) do { unsigned _sp = 0; while (cond) { __builtin_amdgcn_s_sleep(1); \
    if ((++_sp & 255u) == 0u) { if (xb_ld(&(bar)[XB_TMO])) break; if (_sp > XB_SPIN_CAP) { atomicAdd(&(bar)[XB_TMO], 1u); break; } } } } while (0)
struct XcdBarrier { unsigned* bar; unsigned x; volatile LAS unsigned* st; };
__device__ __forceinline__ XcdBarrier xcd_barrier_post(unsigned* bar, volatile LAS unsigned* st, bool is_t0) {
    XcdBarrier b; b.bar = bar; b.x = xb_xcc_id(); b.st = st;
    if (is_t0) (void)xb_add(&bar[XB_XCNT(b.x)], 1u);
    return b;
}
__device__ __forceinline__ void xcd_barrier_complete(unsigned* bar, unsigned x, unsigned& nloc, unsigned& nx) {
    const unsigned G = gridDim.x * gridDim.y * gridDim.z;
    unsigned sum, cnt, mine, sp = 0u;
    for (;;) {
        sum = 0u; cnt = 0u; mine = 0u;
#pragma unroll
        for (unsigned j = 0; j < 16; ++j) { const unsigned c = xb_ld(&bar[XB_XCNT(j)]); sum += c; cnt += (c > 0u) ? 1u : 0u; mine = (j == x) ? c : mine; }
        if (sum == G) break;
        __builtin_amdgcn_s_sleep(1);
        if ((++sp & 255u) == 0u) { if (xb_ld(&bar[XB_TMO])) break; if (sp > XB_SPIN_CAP) { atomicAdd(&bar[XB_TMO], 1u); break; } }
    }
    nloc = mine > 0u ? mine : 1u; nx = cnt > 0u ? cnt : 1u;
}
__device__ __forceinline__ void xcd_barrier(const XcdBarrier& b, bool is_t0) {
    asm volatile("s_waitcnt vmcnt(0)" ::: "memory");
    __syncthreads();
    if (is_t0) {
        unsigned* bar = b.bar;
        __builtin_amdgcn_s_waitcnt(0);
        unsigned nloc = b.st[0], nx = b.st[1];
        if (nloc == 0u) { xcd_barrier_complete(bar, b.x, nloc, nx); b.st[0] = nloc; b.st[1] = nx; }
        const unsigned old = xb_add(&bar[XB_XSUB(b.x)], 1u);
        const unsigned gen = old / nloc;
        if (old + 1u == (gen + 1u) * nloc) {
            __builtin_amdgcn_fence(__ATOMIC_RELEASE, "agent");
            asm volatile("s_waitcnt vmcnt(0)" ::: "memory");
            const unsigned og = xb_add(&bar[XB_TOP], 1u);
            const unsigned tg = og / nx;
            if (og + 1u == (tg + 1u) * nx) xb_add(&bar[XB_TOPGEN], 1u);
            else XB_SPIN(xb_ld(&bar[XB_TOPGEN]) == tg, bar);
            __builtin_amdgcn_fence(__ATOMIC_ACQUIRE, "agent");
            xb_add(&bar[XB_XGEN(b.x)], 1u);
            asm volatile("s_waitcnt vmcnt(0)" ::: "memory");
        } else {
            XB_SPIN(xb_ld(&bar[XB_XGEN(b.x)]) == gen, bar);
            __builtin_amdgcn_fence(__ATOMIC_ACQUIRE, "agent");
            asm volatile("s_waitcnt vmcnt(0)" ::: "memory");
        }
    }
    __syncthreads();
}

using pg8::Unit; using pg8::cvt_pk_bf16;
struct EpiIn {
    static constexpr bool PERM = true;
    const float* ss; const float* lbl; bf16* Qg; f16* F;
    __device__ __forceinline__ void operator()(const f32x4 (&acc)[2][2][4][2], const Unit& u, int wr, int wc, int fr, int fq) const {
        const int seg = u.pn >> 3; const int col0 = (u.pn & 7) * 256 + wc * 32 + 8 * fq; const int rowb = u.pm * 256 + wr * 64;
        float lb[2][8];
        if (seg == 1) {
#pragma unroll
            for (int bj = 0; bj < 2; ++bj)
#pragma unroll
                for (int j = 0; j < 8; ++j) { const int c = col0 + bj * 128 + j; lb[bj][j] = __builtin_amdgcn_rcpf(1.0f + __expf(lbl[D + c] - lbl[c])); }
        }
        float rs[2][4];
#pragma unroll
        for (int ai = 0; ai < 2; ++ai)
#pragma unroll
            for (int m = 0; m < 4; ++m) rs[ai][m] = ss[rowb + ai * 128 + m * 16 + fr];
#pragma unroll
        for (int ai = 0; ai < 2; ++ai)
#pragma unroll
            for (int m = 0; m < 4; ++m) asm volatile("" : "+v"(rs[ai][m]));
#pragma unroll
        for (int ai = 0; ai < 2; ++ai)
#pragma unroll
            for (int m = 0; m < 4; ++m) {
                const int rb = rowb + ai * 128 + m * 16; if (rb >= MR) continue;
                const int row = rb + fr; const float r = rsqrtf(rs[ai][m] * (1.0f / D) + EPS);
#pragma unroll
                for (int bj = 0; bj < 2; ++bj) {
                    f32x4 v0 = acc[ai][bj][m][0] * r, v1 = acc[ai][bj][m][1] * r; const size_t off = (size_t)row * D + col0 + bj * 128;
                    if (seg == 1) {
                        f32x4 o0, o1;
#pragma unroll
                        for (int j = 0; j < 4; ++j) { o0[j] = (1.0f - lb[bj][j]) * sigm_f(-v0[j]); o1[j] = (1.0f - lb[bj][4 + j]) * sigm_f(-v1[j]); }
                        { v4u w; w.x = pkh2(o0[0], o0[1]); w.y = pkh2(o0[2], o0[3]); w.z = pkh2(o1[0], o1[1]); w.w = pkh2(o1[2], o1[3]); *(v4u*)(F + off) = w; }
                    } else {
                        if (seg != 2) {
#pragma unroll
                            for (int j = 0; j < 4; ++j) { v0[j] = silu_f(v0[j]); v1[j] = silu_f(v1[j]); }
                        }
                        v4u w; w.x = cvt_pk_bf16(v0[0], v0[1]); w.y = cvt_pk_bf16(v0[2], v0[3]); w.z = cvt_pk_bf16(v1[0], v1[1]); w.w = cvt_pk_bf16(v1[2], v1[3]);
                        const size_t dsel = (seg == 0) ? 0 : ((seg == 2) ? 1 : 2);
                        *(v4u*)(Qg + dsel * (size_t)(17 * MiB) + off) = w;
                    }
                }
            }
    }
    __device__ __forceinline__ void tail(int row, int col, f32x4 v) const {
        const int seg = col >> 11, c = col & 2047; const float r = rsqrtf(ss[row] * (1.0f / D) + EPS); v = v * r; const size_t off = (size_t)row * D + c;
        if (seg == 1) { f32x4 o;
#pragma unroll
            for (int j = 0; j < 4; ++j) { const float lbv = __builtin_amdgcn_rcpf(1.0f + __expf(lbl[D + c + j] - lbl[c + j])); o[j] = (1.0f - lbv) * sigm_f(-v[j]); }
            { v2u w; w.x = pkh2(o[0], o[1]); w.y = pkh2(o[2], o[3]); *(v2u*)(F + off) = w; }
        } else {
            if (seg != 2) {
#pragma unroll
                for (int j = 0; j < 4; ++j) v[j] = silu_f(v[j]);
            }
            v2u w; w.x = cvt_pk_bf16(v[0], v[1]); w.y = cvt_pk_bf16(v[2], v[3]);
            const size_t dsel = (seg == 0) ? 0 : ((seg == 2) ? 1 : 2);
            *(v2u*)(Qg + dsel * (size_t)(17 * MiB) + off) = w;
        }
    }
};

template <int MODE> struct EpiRes {
    static constexpr bool PERM = true;
    const bf16* rb; float* o0; float* o1; bf16* hb; float* ss;
    __device__ __forceinline__ void operator()(const f32x4 (&acc)[2][2][4][2], const Unit& u, int wr, int wc, int fr, int fq) const {
        const int col0 = u.pn * 256 + wc * 32 + 8 * fq; const int rowb = u.pm * 256 + wr * 64;
        v4u rw[2][4][2];
#pragma unroll
        for (int ai = 0; ai < 2; ++ai)
#pragma unroll
            for (int m = 0; m < 4; ++m)
#pragma unroll
                for (int bj = 0; bj < 2; ++bj) rw[ai][m][bj] = *(const v4u*)(rb + (size_t)(rowb + ai * 128 + m * 16 + fr) * D + col0 + bj * 128);
#pragma unroll
        for (int ai = 0; ai < 2; ++ai)
#pragma unroll
            for (int m = 0; m < 4; ++m)
#pragma unroll
                for (int bj = 0; bj < 2; ++bj) asm volatile("" : "+v"(rw[ai][m][bj]));
#pragma unroll
        for (int ai = 0; ai < 2; ++ai)
#pragma unroll
            for (int m = 0; m < 4; ++m) {
                const int row = rowb + ai * 128 + m * 16 + fr;
                float* op = (MODE == 2) ? o0 + (size_t)row * D : nullptr;
                float sq = 0.f;
#pragma unroll
                for (int bj = 0; bj < 2; ++bj) {
                    const int c = col0 + bj * 128;
                    const v4u w_ = rw[ai][m][bj];
                    f32x4 a0 = {bf2f(w_.x & 0xffffu), bf2f(w_.x >> 16), bf2f(w_.y & 0xffffu), bf2f(w_.y >> 16)}, a1 = {bf2f(w_.z & 0xffffu), bf2f(w_.z >> 16), bf2f(w_.w & 0xffffu), bf2f(w_.w >> 16)};
                    a0 += acc[ai][bj][m][0]; a1 += acc[ai][bj][m][1];
                    if (MODE == 2) { __builtin_nontemporal_store(a0, (f32x4*)(op + c)); __builtin_nontemporal_store(a1, (f32x4*)(op + c + 4)); }
                    else {
                        v4u w; w.x = cvt_pk_bf16(a0[0], a0[1]); w.y = cvt_pk_bf16(a0[2], a0[3]); w.z = cvt_pk_bf16(a1[0], a1[1]); w.w = cvt_pk_bf16(a1[2], a1[3]);
                        *(v4u*)(hb + (size_t)row * D + c) = w;
                        sq += (a0[0] * a0[0] + a0[1] * a0[1]) + (a0[2] * a0[2] + a0[3] * a0[3]) + (a1[0] * a1[0] + a1[1] * a1[1]) + (a1[2] * a1[2] + a1[3] * a1[3]);
                    }
                }
                if (MODE != 2) { sq += shx<16>(sq); sq = xadd32(sq); if (fq == 0) atomicAdd(ss + row, sq); }
            }
    }
    __device__ __forceinline__ void tail(int row, int col, f32x4 v, int fq) const {
        const v2u rw = *(const v2u*)(rb + (size_t)row * D + col);
        f32x4 a0 = {bf2f(rw.x & 0xffffu), bf2f(rw.x >> 16), bf2f(rw.y & 0xffffu), bf2f(rw.y >> 16)}; a0 += v;
        if (MODE == 2) { *(f32x4*)(o1 + (size_t)(row - SEQ) * D + col) = a0; }
        else {
            v2u w; w.x = cvt_pk_bf16(a0[0], a0[1]); w.y = cvt_pk_bf16(a0[2], a0[3]); *(v2u*)(hb + (size_t)row * D + col) = w;
            float sq = (a0[0] * a0[0] + a0[1] * a0[1]) + (a0[2] * a0[2] + a0[3] * a0[3]);
            sq += shx<16>(sq); sq = xadd32(sq); if (fq == 0) atomicAdd(ss + row, sq);
        }
    }
};
struct EpiGU {
    static constexpr bool PERM = true;
    const float* ss; bf16* hm;
    __device__ __forceinline__ void operator()(const f32x4 (&acc)[2][2][4][2], const Unit& u, int wr, int wc, int fr, int fq) const {
        const int j0 = u.pn * 128 + wc * 32 + 8 * fq; const int rowb = u.pm * 256 + wr * 64;
        float rs[2][4];
#pragma unroll
        for (int ai = 0; ai < 2; ++ai)
#pragma unroll
            for (int m = 0; m < 4; ++m) rs[ai][m] = ss[rowb + ai * 128 + m * 16 + fr];
#pragma unroll
        for (int ai = 0; ai < 2; ++ai)
#pragma unroll
            for (int m = 0; m < 4; ++m) asm volatile("" : "+v"(rs[ai][m]));
#pragma unroll
        for (int ai = 0; ai < 2; ++ai)
#pragma unroll
            for (int m = 0; m < 4; ++m) {
                const int rb = rowb + ai * 128 + m * 16; if (rb >= MR) continue;
                const int row = rb + fr; const float r = rsqrtf(rs[ai][m] * (1.0f / D) + EPS);
                float o[8];
#pragma unroll
                for (int n = 0; n < 2; ++n)
#pragma unroll
                    for (int j = 0; j < 4; ++j) o[4 * n + j] = silu_f(acc[ai][0][m][n][j] * r) * (acc[ai][1][m][n][j] * r);
                v4u w; w.x = cvt_pk_bf16(o[0], o[1]); w.y = cvt_pk_bf16(o[2], o[3]); w.z = cvt_pk_bf16(o[4], o[5]); w.w = cvt_pk_bf16(o[6], o[7]);
                *(v4u*)(hm + (size_t)row * DFF + j0) = w;
            }
    }
};
struct EpiKVQ {
    static constexpr bool PERM = true;
    const float* ss; unsigned char* ws; float* outp; const float* kn; const float* qn; LAS unsigned char* xl;
    __device__ __forceinline__ void operator()(const f32x4 (&acc)[2][2][4][2], const Unit& u, int wr, int wc, int fr, int fq) const {
        const int c0 = wc * 32 + 8 * fq; const int rowb = u.pm * 256 + wr * 64;
        bf16* Kb_ = (bf16*)(ws + WS_KB); bf16* Vb_ = (bf16*)(ws + WS_VB); bf16* Qb_ = (bf16*)(ws + WS_QB); float* Kp_ = (float*)(ws + WS_KPART);
        float rs[2][4];
#pragma unroll
        for (int ai = 0; ai < 2; ++ai)
#pragma unroll
            for (int m = 0; m < 4; ++m) rs[ai][m] = rsqrtf(ss[rowb + ai * 128 + m * 16 + fr] * (1.0f / D) + EPS);
        if (u.pn == 2 || u.pn == 3) {
#pragma unroll
            for (int ai = 0; ai < 2; ++ai)
#pragma unroll
                for (int m = 0; m < 4; ++m) {
                    const int rb = rowb + ai * 128 + m * 16; if (rb >= MR) continue;
                    const int row = rb + fr; const float r = rs[ai][m];
                    float* vo = outp + ((row < SEQ) ? OV_P + (size_t)row * 512 : OV_S + (size_t)(row - SEQ) * 512);
#pragma unroll
                    for (int bj = 0; bj < 2; ++bj) { const int col = (u.pn - 2) * 256 + bj * 128 + c0; const f32x4 v0 = acc[ai][bj][m][0] * r, v1 = acc[ai][bj][m][1] * r;
                        __builtin_nontemporal_store(v0, (f32x4*)(vo + col)); __builtin_nontemporal_store(v1, (f32x4*)(vo + col + 4));
                        v4u w; w.x = cvt_pk_bf16(v0[0], v0[1]); w.y = cvt_pk_bf16(v0[2], v0[3]); w.z = cvt_pk_bf16(v1[0], v1[1]); w.w = cvt_pk_bf16(v1[2], v1[3]);
                        *(v4u*)(Vb_ + (size_t)row * 512 + col) = w; }
                }
            return;
        }
        const bool isk = u.pn < 2;
        LAS float* P = (LAS float*)xl;
        LAS float* CS = (LAS float*)(xl + 8192);
#pragma unroll
        for (int ai = 0; ai < 2; ++ai)
#pragma unroll
            for (int m = 0; m < 4; ++m) {
                const int rl = ai * 128 + wr * 64 + m * 16 + fr; const float r = rs[ai][m];
#pragma unroll
                for (int bj = 0; bj < 2; ++bj) { const f32x4 v0 = acc[ai][bj][m][0] * r, v1 = acc[ai][bj][m][1] * r;
                    float sq = (v0[0] * v0[0] + v0[1] * v0[1]) + (v0[2] * v0[2] + v0[3] * v0[3]) + (v1[0] * v1[0] + v1[1] * v1[1]) + (v1[2] * v1[2] + v1[3] * v1[3]);
                    sq += shx<16>(sq); sq = xadd32(sq);
                    if (fq == 0) P[(rl * 2 + bj) * 4 + wc] = sq; }
            }
        asm volatile("s_waitcnt lgkmcnt(0)" ::: "memory"); __builtin_amdgcn_s_barrier(); asm volatile("" ::: "memory");
        float cs[2][8];
#pragma unroll
        for (int bj = 0; bj < 2; ++bj)
#pragma unroll
            for (int j = 0; j < 8; ++j) cs[bj][j] = 0.f;
        const float* gp = (isk ? kn : qn) + c0; const f32x4 g0 = *(const f32x4*)gp, g1 = *(const f32x4*)(gp + 4);
#pragma unroll
        for (int ai = 0; ai < 2; ++ai)
#pragma unroll
            for (int m = 0; m < 4; ++m) {
                const int rb = rowb + ai * 128 + m * 16; if (rb >= MR) continue;
                const int rl = ai * 128 + wr * 64 + m * 16 + fr; const int row = rb + fr; const float r = rs[ai][m];
#pragma unroll
                for (int bj = 0; bj < 2; ++bj) {
                    const f32x4 pp = *(const LAS f32x4*)(P + (rl * 2 + bj) * 4);
                    const float rh = rsqrtf(((pp[0] + pp[1]) + (pp[2] + pp[3])) * (1.0f / 128.0f) + EPS) * (isk ? 1.0f : C2);
                    const f32x4 n0 = acc[ai][bj][m][0] * (r * rh) * g0, n1 = acc[ai][bj][m][1] * (r * rh) * g1;
                    v4u w; w.x = cvt_pk_bf16(n0[0], n0[1]); w.y = cvt_pk_bf16(n0[2], n0[3]); w.z = cvt_pk_bf16(n1[0], n1[1]); w.w = cvt_pk_bf16(n1[2], n1[3]);
                    if (isk) {
                        const int col = u.pn * 256 + bj * 128 + c0;
                        float* ko = outp + ((row < SEQ) ? OK_P + (size_t)row * 512 : OK_S + (size_t)(row - SEQ) * 512) + col;
                        __builtin_nontemporal_store(n0, (f32x4*)ko); __builtin_nontemporal_store(n1, (f32x4*)(ko + 4));
                        *(v4u*)(Kb_ + (size_t)row * 512 + col) = w;
#pragma unroll
                        for (int j = 0; j < 4; ++j) { cs[bj][j] += n0[j]; cs[bj][4 + j] += n1[j]; }
                    } else {
                        *(v4u*)(Qb_ + (size_t)row * D + (u.pn - 4) * 256 + bj * 128 + c0) = w;
                    }
                }
            }
        if (isk && u.pm < SEQ / 256) {
#pragma unroll
            for (int bj = 0; bj < 2; ++bj)
#pragma unroll
                for (int j = 0; j < 8; ++j) { float v = cs[bj][j]; v += shx<1>(v); v += shx<2>(v); v += shx<4>(v); v += shx<8>(v); if (fr == 0) CS[wr * 256 + bj * 128 + c0 + j] = v; }
            asm volatile("s_waitcnt lgkmcnt(0)" ::: "memory"); __builtin_amdgcn_s_barrier(); asm volatile("" ::: "memory");
            const int t = (wr * 4 + wc) * 64 + fq * 16 + fr;
            if (t < 256) Kp_[(size_t)u.pm * 512 + u.pn * 256 + t] = CS[t] + CS[256 + t];
        }
    }
};

struct Args { const void* in[21]; float* out; unsigned char* ws; };

__device__ __forceinline__ void p0_transpose_item(const float* W, int K, int N, bf16* WT, int row_off, int mode, const float* gain, LAS float* scr, int item, int lane) {
    const int nblk = N / 64, kb = item / nblk, nb = item % nblk, k0 = 64 * kb, n0 = 64 * nb;
    const int r = lane >> 4, c4 = lane & 15;
#pragma unroll
    for (int i = 0; i < 16; ++i) { const int kk = 4 * i + r; f32x4 w = __builtin_nontemporal_load((const f32x4*)(W + (size_t)(k0 + kk) * N + n0 + 4 * c4)); if (gain) w *= gain[k0 + kk]; *(LAS f32x4*)(scr + kk * 68 + 4 * c4) = w; }
    LDS_WAIT(); asm volatile("" ::: "memory");
    const int c = lane & 7;
    int d0;
    if (mode == 0) d0 = row_off + n0;
    else { const int j = (n0 < DFF) ? n0 : n0 - DFF; d0 = 256 * (j >> 7) + (j & 127) + ((n0 < DFF) ? 0 : 128); }
#pragma unroll
    for (int j = 0; j < 8; ++j) { const int n = (lane >> 3) + 8 * j; const LAS float* sp = scr + (8 * c) * 68 + n;
        v4u o; o.x = pk2(sp[0 * 68], sp[1 * 68]); o.y = pk2(sp[2 * 68], sp[3 * 68]); o.z = pk2(sp[4 * 68], sp[5 * 68]); o.w = pk2(sp[6 * 68], sp[7 * 68]);
        *(v4u*)(WT + (size_t)(d0 + n) * K + k0 + 8 * c) = o; }
    LDS_WAIT(); asm volatile("" ::: "memory");
}

constexpr int KS_P = 144;
constexpr int KS_BYTES = 256 * KS_P * 2;
typedef short v4i16_t __attribute__((ext_vector_type(4)));
__device__ __forceinline__ v2u tr_read(const LAS bf16* p) { return __builtin_bit_cast(v2u, __builtin_amdgcn_ds_read_tr16_b64_v4i16((LAS v4i16_t*)p)); }
template <int NKT> __device__ __forceinline__ void attn_scores(const LAS bf16* Ks, const bf16x8 (&qf)[4], f32x4 (&acc)[16], int nkt, int fr, int fq) {
#pragma unroll
    for (int kt = 0; kt < NKT; ++kt) {
        acc[kt] = (f32x4){0.f, 0.f, 0.f, 0.f};
        if (kt < nkt) {
#pragma unroll
            for (int ks = 0; ks < 4; ++ks) { const bf16x8 a = *(const LAS bf16x8*)(Ks + (16 * kt + fr) * KS_P + 32 * ks + 8 * fq); acc[kt] = MFMA16(a, qf[ks], acc[kt]); }
        }
    }
}
__device__ __forceinline__ void attn_pv(const LAS bf16* Vr, const f32x4 (&acc)[16], f32x4 (&O)[8], int nj, int fr, int fq) {
#pragma unroll
    for (int j = 0; j < 8; ++j) {
        if (j < nj) {
            v4u pw; pw.x = cvt_pk_bf16(acc[2 * j][0], acc[2 * j][1]); pw.y = cvt_pk_bf16(acc[2 * j][2], acc[2 * j][3]); pw.z = cvt_pk_bf16(acc[2 * j + 1][0], acc[2 * j + 1][1]); pw.w = cvt_pk_bf16(acc[2 * j + 1][2], acc[2 * j + 1][3]);
            const bf16x8 pf = __builtin_bit_cast(bf16x8, pw);
            const LAS bf16* vb = Vr + (32 * j + 4 * fq + (fr >> 2)) * KS_P + 4 * (fr & 3);
#pragma unroll
            for (int vt = 0; vt < 8; ++vt) {
                const v2u lo = tr_read(vb + 16 * vt), hi = tr_read(vb + 16 * KS_P + 16 * vt);
                const v4u aw = {lo.x, lo.y, hi.x, hi.y};
                O[vt] = MFMA16(__builtin_bit_cast(bf16x8, aw), pf, O[vt]);
            }
        }
    }
}

struct TrItem { const float* W; const float* gain; bf16* WT; int K, N, row_off, item; };
__device__ __forceinline__ void tr_load(const TrItem& t, f32x4 (&w)[16], float (&g)[16], int lane) {
    const int nblk = t.N / 64, kb = t.item / nblk, nb = t.item - kb * nblk, k0 = 64 * kb, n0 = 64 * nb; const int r = lane >> 4, c4 = lane & 15;
#pragma unroll
    for (int i = 0; i < 16; ++i) { const int kk = 4 * i + r; w[i] = __builtin_nontemporal_load((const f32x4*)(t.W + (size_t)(k0 + kk) * t.N + n0 + 4 * c4)); g[i] = t.gain ? t.gain[k0 + kk] : 1.0f; }
}
__device__ __forceinline__ void tr_store(const TrItem& t, const f32x4 (&w)[16], const float (&g)[16], LAS float* scr, int lane) {
    const int nblk = t.N / 64, kb = t.item / nblk, nb = t.item - kb * nblk, k0 = 64 * kb, n0 = 64 * nb; const int r = lane >> 4, c4 = lane & 15;
#pragma unroll
    for (int i = 0; i < 16; ++i) { const int kk = 4 * i + r; *(LAS f32x4*)(scr + kk * 68 + 4 * c4) = w[i] * g[i]; }
    LDS_WAIT(); asm volatile("" ::: "memory");
    const int c = lane & 7; const int d0 = t.row_off + n0;
#pragma unroll
    for (int j = 0; j < 8; ++j) { const int n = (lane >> 3) + 8 * j; const LAS float* sp = scr + (8 * c) * 68 + n;
        v4u o; o.x = pk2(sp[0 * 68], sp[1 * 68]); o.y = pk2(sp[2 * 68], sp[3 * 68]); o.z = pk2(sp[4 * 68], sp[5 * 68]); o.w = pk2(sp[6 * 68], sp[7 * 68]);
        *(v4u*)(t.WT + (size_t)(d0 + n) * t.K + k0 + 8 * c) = o; }
    LDS_WAIT(); asm volatile("" ::: "memory");
}

template <int NT, int K> __device__ __forceinline__ void tail_gemm(LAS unsigned char* lds, const bf16* A, const bf16* Bt, int n0, int rowhalf, f32x4 (&acc)[NT], int tidx, int rsel) {
    int tid_o = tidx; asm volatile("" : "+v"(tid_o));
    const int tid = tid_o, lane = tid & 63, wave = __builtin_amdgcn_readfirstlane(tid >> 6), fr = lane & 15, fq = lane >> 4;
    const int rt = wave & 3, kh = wave >> 2; constexpr int Kh = K >> 1;
    constexpr int KC = (K == 2048) ? (NT == 2 ? 512 : 1024) : 1408;
    constexpr int NCH = Kh / KC, PB = KC + 8, UPR = KC >> 3, NS = KC >> 7;
    const int khk = kh ^ (rsel & 1), flip = (NCH > 1) ? ((rsel >> 1) & 1) : 0;
    constexpr int NU = 2 * 16 * NT * UPR, NIT = NU / NTHR;
    static_assert(NU % NTHR == 0, "tail B staging");
    LAS bf16* Bs = (LAS bf16*)(lds + 8192);
    const int lq = lane >> 4, lu = lane & 15;
    const bf16* ap = A + (size_t)(64 * rowhalf + 16 * rt + lq) * K + khk * Kh + 8 * lu;
    LAS unsigned char* stg = lds + 102400 + wave * 4096;
    int wof[4], rof[4];
#pragma unroll
    for (int j = 0; j < 4; ++j) { wof[j] = (4 * j + lq) * 256 + ((lu ^ (4 * j + lq)) << 4); rof[j] = fr * 256 + (((4 * j + fq) ^ fr) << 4); }
    const LAS bf16* bl = Bs + (khk * 16 * NT + fr) * PB + 8 * fq;
#pragma unroll
    for (int t = 0; t < NT; ++t) acc[t] = (f32x4){0.f, 0.f, 0.f, 0.f};
#define TG_LDA(a_, k0_) do { _Pragma("unroll") for (int s_ = 0; s_ < 4; ++s_) a_[s_] = *(const bf16x8*)(ap + (size_t)(4 * s_) * K + (k0_)); } while (0)
#define TG_MMA(a_, kl_) do { _Pragma("unroll") for (int s_ = 0; s_ < 4; ++s_) *(LAS bf16x8*)(stg + wof[s_]) = a_[s_]; asm volatile("" ::: "memory"); bf16x8 ar_[4]; \
        _Pragma("unroll") for (int s_ = 0; s_ < 4; ++s_) ar_[s_] = *(const LAS bf16x8*)(stg + rof[s_]); asm volatile("" ::: "memory"); \
        _Pragma("unroll") for (int s_ = 0; s_ < 4; ++s_) { _Pragma("unroll") for (int t_ = 0; t_ < NT; ++t_) { \
        const bf16x8 b_ = *(const LAS bf16x8*)(bl + t_ * 16 * PB + (kl_) + 32 * s_); acc[t_] = MFMA16(b_, ar_[s_], acc[t_]); } } } while (0)
#define TG_LDB(kb_) do { _Pragma("unroll") for (int i_ = 0; i_ < NIT; ++i_) { const int u_ = tid + i_ * NTHR, r2_ = u_ / UPR, kc_ = u_ - r2_ * UPR; const int khh_ = (r2_ >= 16 * NT) ? 1 : 0, row_ = r2_ - khh_ * 16 * NT; \
        breg[i_] = *(const v4u*)(Bt + (size_t)(n0 + row_) * K + khh_ * Kh + (kb_) + 8 * kc_); } } while (0)
#define TG_STB() do { _Pragma("unroll") for (int i_ = 0; i_ < NIT; ++i_) { const int u_ = tid + i_ * NTHR, r2_ = u_ / UPR, kc_ = u_ - r2_ * UPR; *(LAS v4u*)(Bs + r2_ * PB + 8 * kc_) = breg[i_]; } } while (0)
    v4u breg[NIT];
    TG_LDB(flip * KC);
#pragma unroll
    for (int ch = 0; ch < NCH; ++ch) {
        const int kb = (ch ^ flip) * KC;
        bf16x8 a0[4], a1[4], a2[4], a3[4];
        TG_LDA(a0, kb); TG_LDA(a1, kb + 128); TG_LDA(a2, kb + 256); TG_LDA(a3, kb + 384);
        TG_STB();
        __syncthreads();
        if (ch + 1 < NCH) TG_LDB(((ch + 1) ^ flip) * KC);
        for (int st = 0; st < NS; st += 4) {
            TG_MMA(a0, 128 * st);           if (st + 4 < NS) TG_LDA(a0, kb + 128 * (st + 4));
            if (st + 1 < NS) { TG_MMA(a1, 128 * (st + 1)); if (st + 5 < NS) TG_LDA(a1, kb + 128 * (st + 5)); }
            if (st + 2 < NS) { TG_MMA(a2, 128 * (st + 2)); if (st + 6 < NS) TG_LDA(a2, kb + 128 * (st + 6)); }
            if (st + 3 < NS) { TG_MMA(a3, 128 * (st + 3)); if (st + 7 < NS) TG_LDA(a3, kb + 128 * (st + 7)); }
        }
        __syncthreads();
    }
#undef TG_LDA
#undef TG_MMA
#undef TG_LDB
#undef TG_STB
    LAS f32x4* red = (LAS f32x4*)lds;
    if (kh == 1) {
#pragma unroll
        for (int t = 0; t < NT; ++t) red[(t * 4 + rt) * 64 + lane] = acc[t];
    }
    __syncthreads();
    if (kh == 0) {
#pragma unroll
        for (int t = 0; t < NT; ++t) acc[t] += red[(t * 4 + rt) * 64 + lane];
    }
    __syncthreads();
}

template <int UNR = 16> __device__ __forceinline__ void kmean_items(LAS unsigned char* lds, const float* cache_k_, const int* ptab_, float* Kms_, int i0, int i1, int c0, int cn, int tidx) {
    int tid_o = tidx; asm volatile("" : "+v"(tid_o)); const int tid = tid_o;
    const int me = (int)blockIdx.x - c0; if (me < 0 || me >= cn) return;
    LAS f32x4* redk = (LAS f32x4*)(lds);
    for (int item = i0 + me; item < i1; item += cn) {
        const int b = item >> 5, n = item & 31; const int c4 = tid & 127, rg = tid >> 7;
        f32x4 a = {0.f, 0.f, 0.f, 0.f};
#pragma unroll
        for (int hp = 0; hp < 2; ++hp) { const int page = ptab_[b * NPAGES + 2 * n + hp]; const f32x4* pp = (const f32x4*)(cache_k_ + (size_t)page * PAGE * 512) + c4;
#pragma unroll UNR
            for (int r = rg; r < 128; r += 4) a += __builtin_nontemporal_load(pp + (size_t)r * 128); }
        redk[rg * 128 + c4] = a;
        __syncthreads();
        if (tid < 128) { const f32x4 s4 = (redk[tid] + redk[128 + tid]) + (redk[256 + tid] + redk[384 + tid]); *(f32x4*)(Kms_ + (size_t)item * 512 + 4 * tid) = s4 * (1.0f / 256.0f); }
        __syncthreads();
    }
}

__global__ void __launch_bounds__(NTHR, 2) yoco_fwd(Args args) {
    extern __shared__ __attribute__((aligned(16))) unsigned char lds_raw[];
    LAS unsigned char* lds = (LAS unsigned char*)lds_raw;
#define TIDS int tid_o = TIDX; asm volatile("" : "+v"(tid_o)); const int tid = tid_o, lane = tid & 63, wave = __builtin_amdgcn_readfirstlane(tid >> 6), fr = lane & 15, fq = lane >> 4; (void)fr; (void)fq; (void)wave; (void)lane; (void)tid
    const int G = gridDim.x, bid = blockIdx.x;
    unsigned char* ws = args.ws;
    unsigned* ctl = (unsigned*)(ws + WS_CTL);
    volatile LAS unsigned* MISC = (volatile LAS unsigned*)(lds + MISC_OFF);
    const int wave_sg = __builtin_amdgcn_readfirstlane((int)threadIdx.x & ~63);
#define TIDX (wave_sg + lane_id())
#define IS_T0 ((wave_sg == 0) && (lane_id() == 0))
    if (TIDX < 64) MISC[TIDX] = 0u;
    __syncthreads();
    XcdBarrier bar = xcd_barrier_post(ctl + CW_BAR, MISC + 8, IS_T0);
#ifdef PROF_A
    int n_stamp = 0;
#define STAMP() do { if (blockIdx.x == 0 && IS_T0) MISC[16 + n_stamp] = (unsigned)__builtin_amdgcn_s_memrealtime(); ++n_stamp; } while (0)
#define TNOW() ((unsigned)__builtin_amdgcn_s_memrealtime())
#define TACC(k, t0) do { if (blockIdx.x == 0 && IS_T0) MISC[40 + (k)] += TNOW() - (t0); } while (0)
#define PVAL(a0, a1) (((a0) >= 100) ? MISC[40 + (a0) - 100] : (MISC[16 + (a1)] - MISC[16 + (a0)]))
#else
#define STAMP() do {} while (0)
#define TNOW() 0u
#define TACC(k, t0) do { (void)(t0); } while (0)
#endif
    STAMP();

#define x_p ((const float*)args.in[0])
#define x_s ((const float*)args.in[1])
#define st_in ((const float*)args.in[2])
#define cache_k ((const float*)args.in[3])
#define cache_v ((const float*)args.in[4])
#define ptab ((const int*)args.in[5])
#define norm_mix_a ((const float*)args.in[6])
#define w_in ((const float*)args.in[7])
#define lbl ((const float*)args.in[8])
#define onorm ((const float*)args.in[9])
#define w_out ((const float*)args.in[10])
#define norm_kv ((const float*)args.in[11])
#define w_kv ((const float*)args.in[12])
#define k_norm ((const float*)args.in[13])
#define norm_mix_b ((const float*)args.in[14])
#define w_q ((const float*)args.in[15])
#define q_norm ((const float*)args.in[16])
#define w_o ((const float*)args.in[17])
#define norm_ffn ((const float*)args.in[18])
#define w_gu ((const float*)args.in[19])
#define w_dn ((const float*)args.in[20])
#define Win_t ((bf16*)(ws + WS_WIN))
#define Wout_t ((bf16*)(ws + WS_WOUT))
#define Wgu0_t ((bf16*)(ws + WS_WGU0))
#define Wdn0_t ((bf16*)(ws + WS_WDN0))
#define Wkvq_t ((bf16*)(ws + WS_WKVQ))
#define Wo_t ((bf16*)(ws + WS_WO))
#define Wgu1_t ((bf16*)(ws + WS_WGU1))
#define Wdn1_t ((bf16*)(ws + WS_WDN1))
#define Hb0 ((bf16*)(ws + WS_HB0))
#define Hb1 ((bf16*)(ws + WS_HB1))
#define Hb2 ((bf16*)(ws + WS_HB2))
#define Hb3 ((bf16*)(ws + WS_HB3))
#define Hf1 ((float*)(ws + WS_HF1))
#define Hf2 ((float*)(ws + WS_HF2))
#define Hf3 ((float*)(ws + WS_HF3))
#define Qg ((bf16*)(ws + WS_QG))
#define Vg ((bf16*)(ws + WS_VG))
#define Gg ((bf16*)(ws + WS_GG))
#define Ff ((f16*)(ws + WS_F))
#define Ob ((bf16*)(ws + WS_OB))
#define At ((bf16*)(ws + WS_AT))
#define Hm ((bf16*)(ws + WS_HM))
#define Ug ((float*)(ws + WS_U))
#define Sg0 ((float*)(ws + WS_SST))
#define Dg ((float*)(ws + WS_DEC))
#define Kraw ((float*)(ws + WS_KRAW))
#define Vraw ((float*)(ws + WS_VRAW))
#define Qraw ((bf16*)(ws + WS_QRAW))
#define Kb ((bf16*)(ws + WS_KB))
#define Vb ((bf16*)(ws + WS_VB))
#define Qb ((bf16*)(ws + WS_QB))
#define Kpart ((float*)(ws + WS_KPART))
#define Kms ((float*)(ws + WS_KMS))
#define Subl ((unsigned*)(ws + WS_SUBL))
#define Scnt ((unsigned*)(ws + WS_SCNT))
#define Sels ((unsigned*)(ws + WS_SCNT + 256 * 1024))
#define Oslot ((bf16*)(ws + WS_OSLOT))
#define MLslot ((float*)(ws + WS_MLSLOT))
#define Sslot ((float*)(ws + WS_SSLOT))
#define ss0 ((float*)(ctl + CW_SS0))
#define ss1 ((float*)(ctl + CW_SS1))
#define ss2 ((float*)(ctl + CW_SS2))
#define ss3 ((float*)(ctl + CW_SS3))
#define out (args.out)
    {
        TIDS;
        LAS float* scr = (LAS float*)(lds + wave * 17408);
        const int gw = bid * NWAVES + wave, NGW = G * NWAVES;
        constexpr int I_IN = 32 * 128, I_SQ = 32 * 32, I_GU = 32 * 176, I_DN = 88 * 32, I_KV = 32 * 16;
        constexpr int NITEMS = I_IN + I_SQ + 2 * I_GU;
        (void)I_DN; (void)I_KV;
        for (int it = gw; it < NITEMS; it += NGW) {
            int r = it;
            if (r < I_IN) { p0_transpose_item(w_in, D, 4 * D, Win_t, 0, 0, norm_mix_a, scr, r, lane); continue; } r -= I_IN;
            if (r < I_SQ) { p0_transpose_item(w_out, D, D, Wout_t, 0, 0, nullptr, scr, r, lane); continue; } r -= I_SQ;
            if (r < I_GU) { p0_transpose_item(w_gu, D, NGU, Wgu0_t, 0, 1, norm_ffn, scr, r, lane); continue; } r -= I_GU;
            p0_transpose_item(w_gu + (size_t)D * NGU, D, NGU, Wgu1_t, 0, 1, norm_ffn + D, scr, r, lane);
        }
        for (int m = gw; m < MR; m += NGW) {
            const float* src = (m < SEQ) ? x_p + (size_t)m * D : x_s + (size_t)(m - SEQ) * D;
            const f32x4* xr = (const f32x4*)src + lane; f32x4 v[8]; float s = 0.f;
#pragma unroll
            for (int j = 0; j < 8; ++j) { v[j] = __builtin_nontemporal_load(xr + 64 * j); s += (v[j].x * v[j].x + v[j].y * v[j].y) + (v[j].z * v[j].z + v[j].w * v[j].w); }
            s = wave_sum(s);
            if (lane == 0) ss0[m] = s;
            v2u* o8 = (v2u*)(Hb0 + (size_t)m * D) + lane;
#pragma unroll
            for (int j = 0; j < 8; ++j) { v2u w; w.x = pk2(v[j].x, v[j].y); w.y = pk2(v[j].z, v[j].w); o8[64 * j] = w; }
        }
    }
    xcd_barrier(bar, IS_T0);
    STAMP();

    {
        TIDS;
        pg8::Gemm g{Hb0, Win_t, SEQ, 4 * D, D}; pg8::StaticOrder S; S.init(SEQ, 4 * D, G, bid);
        EpiIn E{ss0, lbl, Qg, Ff};
        pg8::gemm_phase<EpiIn, pg8::StaticOrder, true, true, false>(lds, g, S, E, TIDX);
        for (int it2 = 0; it2 < 2; ++it2) {
            const int w2 = bid + 256 * it2, t2 = w2 & 255, rh = (w2 >> 8) & 1;
            TIDS; f32x4 ta[2]; tail_gemm<2, D>(lds, Hb0 + (size_t)SEQ * D, Win_t, 32 * t2, rh, ta, TIDX, bid & 127);
            if (wave < 4) { const int row = SEQ + 64 * rh + 16 * wave + fr; E.tail(row, 32 * t2 + 4 * fq, ta[0]); E.tail(row, 32 * t2 + 16 + 4 * fq, ta[1]); }
        }
    }
    xcd_barrier(bar, IS_T0);
    STAMP();

    {
        TIDS;
        LAS float* tot = (LAS float*)(lds);
        LAS float* decs = (LAS float*)(lds + 2048);
        LAS bf16* koT = (LAS bf16*)(lds + 4096);
        LAS bf16* Vr = (LAS bf16*)(lds + 4096 + 128 * 72 * 2);
        LAS f32x4* kmr = (LAS f32x4*)(lds + 65536);
        const int col = tid & 127, part = tid >> 7; const int vt_t = tid >> 3, vd0 = (tid & 7) * 16;
        f16 fN[16]; v4u vaN, vbN;
#define P2_LOADN(it_) do { const int h_ = (it_) >> 7, r0_ = ((it_) & 127) * 64; const f16* fp_ = Ff + (size_t)(r0_ + part * 16) * D + h_ * 128 + col; \
            _Pragma("unroll") for (int i = 0; i < 16; ++i) fN[i] = fp_[(size_t)i * D]; \
            const bf16* vp_ = Vg + (size_t)(r0_ + vt_t) * D + h_ * 128 + vd0; vaN = *(const v4u*)vp_; vbN = *(const v4u*)(vp_ + 8); } while (0)
        for (int it = bid; it < NH * 16; it += G) {
            const int h = it >> 4, g = it & 15;
            f32x4 S[8];
#pragma unroll
            for (int vt = 0; vt < 8; ++vt) S[vt] = (f32x4){0.f, 0.f, 0.f, 0.f};
            float dtot = 1.0f;
            P2_LOADN(h * 128 + 8 * g);
            f32x4 ka = {0.f, 0.f, 0.f, 0.f};
            const int kpg0 = ptab[(it >> 5) * NPAGES + 2 * (it & 31)], kpg1 = ptab[(it >> 5) * NPAGES + 2 * (it & 31) + 1], kpg2 = ptab[((it + 256) >> 5) * NPAGES + 2 * (it & 31)], kpg3 = ptab[((it + 256) >> 5) * NPAGES + 2 * (it & 31) + 1];
#pragma unroll 1
            for (int j = 0; j < 8; ++j) {
                const int item = h * 128 + 8 * g + j;
                f32x4 kq[16];
                { const int q = j & 3; const int page = (j < 2) ? kpg0 : (j < 4) ? kpg1 : (j < 6) ? kpg2 : kpg3;
                  const f32x4* pp = (const f32x4*)(cache_k + (size_t)page * PAGE * 512) + (tid & 127) + (size_t)((q & 1) * 64 + (tid >> 7)) * 128;
#pragma unroll
                  for (int i = 0; i < 16; ++i) kq[i] = __builtin_nontemporal_load(pp + (size_t)(4 * i) * 128); }
                float cum[16], kk[16]; float run = 0.f;
#pragma unroll
                for (int i = 0; i < 16; ++i) { kk[i] = (float)fN[i]; const float f = 1.0f - kk[i]; run += __logf(f); cum[i] = run; }
                tot[part * 128 + col] = run;
                *(LAS v4u*)(Vr + vt_t * 144 + vd0) = vaN; *(LAS v4u*)(Vr + vt_t * 144 + vd0 + 8) = vbN;
                if (j < 7) P2_LOADN(item + 1);
                __syncthreads();
                float offs = 0.f, lastv = 0.f;
#pragma unroll
                for (int p = 0; p < 4; ++p) { const float tv = tot[p * 128 + col]; lastv += tv; if (p < part) offs += tv; }
                unsigned kw[8];
#pragma unroll
                for (int i = 0; i < 8; ++i) { const float a = kk[2 * i] * __expf(lastv - (cum[2 * i] + offs)), b2 = kk[2 * i + 1] * __expf(lastv - (cum[2 * i + 1] + offs)); kw[i] = pk2(a, b2); }
                *(LAS v4u*)(koT + col * 72 + part * 16) = (v4u){kw[0], kw[1], kw[2], kw[3]};
                *(LAS v4u*)(koT + col * 72 + part * 16 + 8) = (v4u){kw[4], kw[5], kw[6], kw[7]};
                if (part == 0) { const float dc = __expf(lastv); decs[col] = dc; dtot *= dc; }
                __syncthreads();
                { bf16x8 a[2]; a[0] = *(const LAS bf16x8*)(koT + (16 * wave + fr) * 72 + 8 * fq); a[1] = *(const LAS bf16x8*)(koT + (16 * wave + fr) * 72 + 32 + 8 * fq);
                  const f32x4 dv = *(const LAS f32x4*)(decs + 16 * wave + 4 * fq);
                  const LAS bf16* vb = Vr + (8 * fq + (fr >> 2)) * 144 + 4 * (fr & 3);
#pragma unroll
                  for (int vt = 0; vt < 8; ++vt) {
                      f32x4 acc = {0.f, 0.f, 0.f, 0.f};
                      const v2u l0 = tr_read(vb + 16 * vt), h0 = tr_read(vb + 4 * 144 + 16 * vt), l1 = tr_read(vb + 32 * 144 + 16 * vt), h1 = tr_read(vb + 36 * 144 + 16 * vt);
                      const v4u b0 = {l0.x, l0.y, h0.x, h0.y}, b1 = {l1.x, l1.y, h1.x, h1.y};
                      acc = MFMA16(a[0], __builtin_bit_cast(bf16x8, b0), acc); acc = MFMA16(a[1], __builtin_bit_cast(bf16x8, b1), acc);
                      S[vt] = dv * S[vt] + acc;
                  } }
#pragma unroll
                for (int i = 0; i < 16; ++i) ka += kq[i];
                if ((j & 3) == 3) kmr[(tid >> 7) * 128 + (tid & 127)] = ka;
                __syncthreads();
                if ((j & 3) == 3) { ka = (f32x4){0.f, 0.f, 0.f, 0.f};
                    if (tid < 128) { const f32x4 s4 = (kmr[tid] + kmr[128 + tid]) + (kmr[256 + tid] + kmr[384 + tid]); *(f32x4*)(Kms + (size_t)(it + 256 * (j >> 2)) * 512 + 4 * tid) = s4 * (1.0f / 256.0f); } }
            }
            float* ug = Ug + (size_t)it * 16384;
#pragma unroll
            for (int vt = 0; vt < 8; ++vt) *(f32x4*)(ug + (size_t)(16 * vt + fr) * 128 + 16 * wave + 4 * fq) = S[vt];
            if (part == 0) Dg[(size_t)it * 128 + col] = dtot;
        }
#undef P2_LOADN
        LAS float* red = (LAS float*)(lds);
        LAS float* red2 = (LAS float*)(lds + 8192);
        float* st_out = out + OST_S;
        for (int item = bid; item < DECB * NH; item += G) {
            const int b = item >> 4, h = item & 15; const int vd = tid & 127, kq = tid >> 7;
            const float* sp = st_in + ((size_t)(b * NH + h) * 128 + 32 * kq) * 128 + vd;
            float Sx[32];
#pragma unroll
            for (int i = 0; i < 32; ++i) Sx[i] = __builtin_nontemporal_load(sp + (size_t)i * 128);
#pragma unroll
            for (int t = 0; t < 4; ++t) {
                const int row = SEQ + 4 * b + t; const size_t ro = (size_t)row * D + h * 128;
                const float v = bf2f(Vg[ro + vd]); float op = 0.f;
#pragma unroll
                for (int i = 0; i < 32; ++i) { const float f = 1.0f - (float)Ff[ro + 32 * kq + i]; const float q = bf2f(Qg[ro + 32 * kq + i]); Sx[i] = f * Sx[i] + (1.0f - f) * v; op += Sx[i] * q; }
                red[(t * 4 + kq) * 128 + vd] = op;
            }
            float* so = st_out + ((size_t)(b * NH + h) * 128 + 32 * kq) * 128 + vd;
#pragma unroll
            for (int i = 0; i < 32; ++i) __builtin_nontemporal_store(Sx[i], so + (size_t)i * 128);
            __syncthreads();
            { const int t = tid >> 7; const float o = (red[(t * 4 + 0) * 128 + vd] + red[(t * 4 + 1) * 128 + vd]) + (red[(t * 4 + 2) * 128 + vd] + red[(t * 4 + 3) * 128 + vd]);
              const float s = wave_sum(o * o); if (lane == 0) red2[t * 2 + (wave & 1)] = s;
              __syncthreads();
              const float r = rsqrtf((red2[t * 2] + red2[t * 2 + 1]) * (1.0f / 128.0f) + EPS);
              const int row = SEQ + 4 * b + t; const size_t ro = (size_t)row * D + h * 128 + vd;
              Ob[ro] = (bf16)f2bf(o * r * onorm[vd] * bf2f(Gg[ro])); }
            __syncthreads();
        }
    }
    xcd_barrier(bar, IS_T0);
    STAMP();

    {
        TIDS;
        for (int gid = bid * NTHR + tid; gid < NH * 128 * 32; gid += G * NTHR) {
            const int h = gid >> 12, rem = gid & 4095, vd = rem >> 5, k = (rem & 31) * 4;
            f32x4 sv = {0.f, 0.f, 0.f, 0.f};
#pragma unroll
            for (int g = 0; g < 16; ++g) {
                const size_t idx = ((size_t)(h * 16 + g) * 128 + vd) * 128 + k;
                const f32x4 u = *(const f32x4*)(Ug + idx), d = *(const f32x4*)(Dg + (size_t)(h * 16 + g) * 128 + k);
                *(f32x4*)(Sg0 + idx) = sv;
                sv = d * sv + u;
            }
            float* so = out + OST_P + ((size_t)h * 128 + k) * 128 + vd;
            so[0] = sv[0]; so[128] = sv[1]; so[256] = sv[2]; so[384] = sv[3];
        }
    }
    xcd_barrier(bar, IS_T0);
    STAMP();

    {
        TIDS;
        LAS float* tot = (LAS float*)(lds);
        LAS float* refs = (LAS float*)(lds + 2048);
        LAS float* red = (LAS float*)(lds + 2560);
        LAS float* decs = (LAS float*)(lds + 3072);
        LAS bf16* QE = (LAS bf16*)(lds + 4096);
        LAS bf16* KE = QE + 64 * 136;
        LAS bf16* QI = KE + 64 * 136;
        LAS bf16* Vr = QI + 64 * 136;
        LAS bf16* STs = Vr + 64 * 144;
        LAS bf16* koT = STs + 128 * 136;
        const int col = tid & 127, part = tid >> 7; const int vt_t = tid >> 3, vd0 = (tid & 7) * 16;
        const int tt = wave & 3, vh = wave >> 2;
        f16 fN[16]; bf16 qN[16]; v4u vaN, vbN;
#define P4_LOADN(it_) do { const int h_ = (it_) >> 7, r0_ = ((it_) & 127) * 64; const f16* fp_ = Ff + (size_t)(r0_ + part * 16) * D + h_ * 128 + col; const bf16* qp_ = Qg + (size_t)(r0_ + part * 16) * D + h_ * 128 + col; \
            _Pragma("unroll") for (int i = 0; i < 16; ++i) { fN[i] = fp_[(size_t)i * D]; qN[i] = qp_[(size_t)i * D]; } \
            const bf16* vp_ = Vg + (size_t)(r0_ + vt_t) * D + h_ * 128 + vd0; vaN = *(const v4u*)vp_; vbN = *(const v4u*)(vp_ + 8); } while (0)
        for (int it = bid; it < NH * 16; it += G) {
            const int hh = it >> 4, gg = it & 15;
            f32x4 S[8];
            { const float* sg = Sg0 + (size_t)it * 16384;
#pragma unroll
              for (int vt = 0; vt < 8; ++vt) { S[vt] = *(const f32x4*)(sg + (size_t)(16 * vt + fr) * 128 + 16 * wave + 4 * fq);
                  v2u w; w.x = cvt_pk_bf16(S[vt][0], S[vt][1]); w.y = cvt_pk_bf16(S[vt][2], S[vt][3]); *(LAS v2u*)(STs + (16 * vt + fr) * 136 + 16 * wave + 4 * fq) = w; } }
            P4_LOADN(hh * 128 + 8 * gg);
#pragma unroll 1
            for (int jc = 0; jc < 8; ++jc) {
            const int item = hh * 128 + 8 * gg + jc;
            const int h = item >> 7, c = item & 127; const int row0 = c * 64;
            float cum[16], kk[16], qv[16]; float run = 0.f;
#pragma unroll
            for (int i = 0; i < 16; ++i) { kk[i] = (float)fN[i]; const float f = 1.0f - kk[i]; run += __logf(f); cum[i] = run; qv[i] = bf2f(qN[i]); }
            tot[part * 128 + col] = run;
            *(LAS v4u*)(Vr + vt_t * 144 + vd0) = vaN; *(LAS v4u*)(Vr + vt_t * 144 + vd0 + 8) = vbN;
            const size_t ro = (size_t)(row0 + 16 * tt + fr) * D + h * 128;
            v2u gw2[4]; f32x4 on[4];
#pragma unroll
            for (int vt = 0; vt < 4; ++vt) { const int vd = 16 * (4 * vh + vt) + 4 * fq; gw2[vt] = *(const v2u*)(Gg + ro + vd); on[vt] = *(const f32x4*)(onorm + vd); }
            if (jc < 7) P4_LOADN(item + 1);
            __syncthreads();
            float offs = 0.f, lastv = 0.f;
#pragma unroll
            for (int p = 0; p < 4; ++p) { const float tv = tot[p * 128 + col]; lastv += tv; if (p < part) offs += tv; }
            if (part == 1) refs[col] = cum[15] + offs;
            if (part == 0) decs[col] = __expf(lastv);
            __syncthreads();
            const float ref = refs[col];
#pragma unroll
            for (int i = 0; i < 16; ++i) { const float cm = cum[i] + offs, d1 = cm - ref; const int t = part * 16 + i;
                QE[t * 136 + col] = (bf16)f2bf(qv[i] * __expf(d1)); KE[t * 136 + col] = (bf16)f2bf(kk[i] * __expf(-d1)); QI[t * 136 + col] = (bf16)f2bf(qv[i] * __expf(cm)); }
            { unsigned kw[8];
#pragma unroll
              for (int i = 0; i < 8; ++i) { const float a = kk[2 * i] * __expf(lastv - (cum[2 * i] + offs)), b2 = kk[2 * i + 1] * __expf(lastv - (cum[2 * i + 1] + offs)); kw[i] = pk2(a, b2); }
              *(LAS v4u*)(koT + col * 72 + part * 16) = (v4u){kw[0], kw[1], kw[2], kw[3]};
              *(LAS v4u*)(koT + col * 72 + part * 16 + 8) = (v4u){kw[4], kw[5], kw[6], kw[7]}; }
            __syncthreads();
            {
                f32x4 aS[4];
#pragma unroll
                for (int st = 0; st < 4; ++st) {
                    aS[st] = (f32x4){0.f, 0.f, 0.f, 0.f};
                    if (st <= tt) {
#pragma unroll
                        for (int ks = 0; ks < 4; ++ks) { const bf16x8 a = *(const LAS bf16x8*)(KE + (16 * st + fr) * 136 + 32 * ks + 8 * fq), b = *(const LAS bf16x8*)(QE + (16 * tt + fr) * 136 + 32 * ks + 8 * fq); aS[st] = MFMA16(a, b, aS[st]); }
                        if (st == tt) {
#pragma unroll
                            for (int r = 0; r < 4; ++r) if (4 * fq + r > fr) aS[st][r] = 0.f;
                        }
                    }
                }
                f32x4 o[4];
#pragma unroll
                for (int vt = 0; vt < 4; ++vt) o[vt] = (f32x4){0.f, 0.f, 0.f, 0.f};
#pragma unroll
                for (int j = 0; j < 2; ++j) {
                    v4u pw; pw.x = cvt_pk_bf16(aS[2 * j][0], aS[2 * j][1]); pw.y = cvt_pk_bf16(aS[2 * j][2], aS[2 * j][3]); pw.z = cvt_pk_bf16(aS[2 * j + 1][0], aS[2 * j + 1][1]); pw.w = cvt_pk_bf16(aS[2 * j + 1][2], aS[2 * j + 1][3]);
                    const bf16x8 pf = __builtin_bit_cast(bf16x8, pw);
                    const LAS bf16* vb = Vr + (32 * j + 4 * fq + (fr >> 2)) * 144 + 64 * vh + 4 * (fr & 3);
#pragma unroll
                    for (int vt = 0; vt < 4; ++vt) { const v2u lo = tr_read(vb + 16 * vt), hi = tr_read(vb + 16 * 144 + 16 * vt); const v4u aw = {lo.x, lo.y, hi.x, hi.y};
                        o[vt] = MFMA16(__builtin_bit_cast(bf16x8, aw), pf, o[vt]); }
                }
#pragma unroll
                for (int ks = 0; ks < 4; ++ks) { const bf16x8 b = *(const LAS bf16x8*)(QI + (16 * tt + fr) * 136 + 32 * ks + 8 * fq);
#pragma unroll
                    for (int vt = 0; vt < 4; ++vt) { const bf16x8 a = *(const LAS bf16x8*)(STs + (16 * (4 * vh + vt) + fr) * 136 + 32 * ks + 8 * fq); o[vt] = MFMA16(a, b, o[vt]); } }
                float sq = 0.f;
#pragma unroll
                for (int vt = 0; vt < 4; ++vt) sq += (o[vt][0] * o[vt][0] + o[vt][1] * o[vt][1]) + (o[vt][2] * o[vt][2] + o[vt][3] * o[vt][3]);
                sq += shx<16>(sq); sq = xadd32(sq);
                if (fq == 0) red[(16 * tt + fr) * 2 + vh] = sq;
                __syncthreads();
                const float r = rsqrtf((red[(16 * tt + fr) * 2] + red[(16 * tt + fr) * 2 + 1]) * (1.0f / 128.0f) + EPS);
#pragma unroll
                for (int vt = 0; vt < 4; ++vt) { const int vd = 16 * (4 * vh + vt) + 4 * fq;
                    const float g0 = bf2f(gw2[vt].x & 0xffffu), g1 = bf2f(gw2[vt].x >> 16), g2 = bf2f(gw2[vt].y & 0xffffu), g3 = bf2f(gw2[vt].y >> 16);
                    v2u w; w.x = cvt_pk_bf16(o[vt][0] * r * on[vt][0] * g0, o[vt][1] * r * on[vt][1] * g1); w.y = cvt_pk_bf16(o[vt][2] * r * on[vt][2] * g2, o[vt][3] * r * on[vt][3] * g3);
                    *(v2u*)(Ob + ro + vd) = w; }
            }
            if (jc < 7) {
                bf16x8 a[2]; a[0] = *(const LAS bf16x8*)(koT + (16 * wave + fr) * 72 + 8 * fq); a[1] = *(const LAS bf16x8*)(koT + (16 * wave + fr) * 72 + 32 + 8 * fq);
                const f32x4 dv = *(const LAS f32x4*)(decs + 16 * wave + 4 * fq);
                const LAS bf16* vb = Vr + (8 * fq + (fr >> 2)) * 144 + 4 * (fr & 3);
#pragma unroll
                for (int vt = 0; vt < 8; ++vt) {
                    f32x4 acc = {0.f, 0.f, 0.f, 0.f};
                    const v2u l0 = tr_read(vb + 16 * vt), h0 = tr_read(vb + 4 * 144 + 16 * vt), l1 = tr_read(vb + 32 * 144 + 16 * vt), h1 = tr_read(vb + 36 * 144 + 16 * vt);
                    const v4u b0 = {l0.x, l0.y, h0.x, h0.y}, b1 = {l1.x, l1.y, h1.x, h1.y};
                    acc = MFMA16(a[0], __builtin_bit_cast(bf16x8, b0), acc); acc = MFMA16(a[1], __builtin_bit_cast(bf16x8, b1), acc);
                    S[vt] = dv * S[vt] + acc;
                    v2u w; w.x = cvt_pk_bf16(S[vt][0], S[vt][1]); w.y = cvt_pk_bf16(S[vt][2], S[vt][3]); *(LAS v2u*)(STs + (16 * vt + fr) * 136 + 16 * wave + 4 * fq) = w;
                }
            }
            __syncthreads();
            }
        }
#undef P4_LOADN
    }
    xcd_barrier(bar, IS_T0);
    STAMP();

    {
        TIDS;
        pg8::Gemm g{Ob, Wout_t, SEQ, D, D}; pg8::StaticOrder S; S.init(SEQ, D, G, bid);
        EpiRes<1> E{Hb0, nullptr, nullptr, Hb1, ss1};
        const unsigned tg0 = TNOW();
        pg8::gemm_phase<EpiRes<1>, pg8::StaticOrder, true, true, false>(lds, g, S, E, TIDX);
        TACC(5, tg0); const unsigned tg1 = TNOW();
        { const int t2 = bid & 127, rh = (bid >> 7) & 1; TIDS; f32x4 ta[1]; tail_gemm<1, D>(lds, Ob + (size_t)SEQ * D, Wout_t, 16 * t2, rh, ta, TIDX, bid & 127); if (wave < 4) E.tail(SEQ + 64 * rh + 16 * wave + fr, 16 * t2 + 4 * fq, ta[0], fq); }
        TACC(6, tg1);
    }
    xcd_barrier(bar, IS_T0);
    STAMP();
    {
        TIDS;
        pg8::Gemm g{Hb1, Wgu0_t, MP, NGU, D}; pg8::StaticOrder S; S.init(MP, NGU, G, bid);
        EpiGU E{ss1, Hm};
        pg8::gemm_phase<EpiGU, pg8::StaticOrder, true, true>(lds, g, S, E, TIDX);
        constexpr int GG = 172;
        if (bid >= GG) {
            constexpr int I_SQ = 32 * 32, I_DN = 88 * 32, I_KV = 32 * 16, NT6 = I_DN + I_KV + 2 * I_SQ;
            LAS float* scr = (LAS float*)(lds + wave * 17408);
            const int gw = (bid - GG) * NWAVES + wave, NGW = (G - GG) * NWAVES;
            auto dec = [&](int it) { TrItem t; int r = it;
                if (r < I_DN) { t.W = w_dn; t.gain = nullptr; t.WT = Wdn0_t; t.K = DFF; t.N = D; t.row_off = 0; t.item = r; return t; } r -= I_DN;
                if (r < I_KV) { t.W = w_kv; t.gain = norm_kv; t.WT = Wkvq_t; t.K = D; t.N = 1024; t.row_off = 0; t.item = r; return t; } r -= I_KV;
                if (r < I_SQ) { t.W = w_q; t.gain = norm_mix_b; t.WT = Wkvq_t; t.K = D; t.N = D; t.row_off = 1024; t.item = r; return t; } r -= I_SQ;
                t.W = w_o; t.gain = nullptr; t.WT = Wo_t; t.K = D; t.N = D; t.row_off = 0; t.item = r; return t; };
            for (int it = gw; it < NT6; it += 2 * NGW) {
                const bool hb = it + NGW < NT6; const TrItem ta = dec(it), tb = dec(hb ? it + NGW : it);
                f32x4 wa[16], wb[16]; float ga[16], gb[16];
                tr_load(ta, wa, ga, lane); if (hb) tr_load(tb, wb, gb, lane);
                tr_store(ta, wa, ga, scr, lane); if (hb) tr_store(tb, wb, gb, scr, lane);
            }
        }
    }
    xcd_barrier(bar, IS_T0);
    STAMP();
    {
        TIDS;
        pg8::Gemm g{Hm, Wdn0_t, SEQ, D, DFF}; pg8::StaticOrder S; S.init(SEQ, D, G, bid);
        EpiRes<1> E{Hb1, nullptr, nullptr, Hb2, ss2};
        const unsigned tg0 = TNOW();
        pg8::gemm_phase<EpiRes<1>, pg8::StaticOrder, true, true, false>(lds, g, S, E, TIDX);
        TACC(7, tg0); const unsigned tg1 = TNOW();
        { const int t2 = bid & 127, rh = (bid >> 7) & 1; TIDS; f32x4 ta[1]; tail_gemm<1, DFF>(lds, Hm + (size_t)SEQ * DFF, Wdn0_t, 16 * t2, rh, ta, TIDX, bid & 127); if (wave < 4) E.tail(SEQ + 64 * rh + 16 * wave + fr, 16 * t2 + 4 * fq, ta[0], fq); }
        TACC(8, tg1);
    }
    xcd_barrier(bar, IS_T0);
    STAMP();
    {
        TIDS;
        pg8::Gemm g{Hb2, Wkvq_t, MP, 3072, D}; pg8::StaticOrder S; S.init(MP, 3072, G, bid);
        EpiKVQ E{ss2, ws, out, k_norm, q_norm, lds + 131072};
        pg8::gemm_phase<EpiKVQ, pg8::StaticOrder, true, true>(lds, g, S, E, TIDX);
        kmean_items(lds, cache_k, ptab, Kms, 512, DECB * NBLK, 140, G - 140, TIDX);
    }
    xcd_barrier(bar, IS_T0);
    STAMP();

    {
        TIDS;
        LAS bf16* KMb = (LAS bf16*)(lds);
        LAS unsigned* lcnt = (LAS unsigned*)(lds + 16384);
        LAS float* gs = (LAS float*)(lds + 16384 + 256);
#define G_BETTER(va, ia, vb, ib) (((va) > (vb)) || (((va) == (vb)) && ((ia) < (ib))))
#define G_INSERT(vx, ix) do { const float vx_ = (vx); const int ix_ = (ix); \
            if (G_BETTER(vx_, ix_, v0, i0)) { v2 = v1; i2 = i1; v1 = v0; i1 = i0; v0 = vx_; i0 = ix_; } \
            else if (G_BETTER(vx_, ix_, v1, i1)) { v2 = v1; i2 = i1; v1 = vx_; i1 = ix_; } \
            else if (G_BETTER(vx_, ix_, v2, i2)) { v2 = vx_; i2 = ix_; } } while (0)
        for (int item = bid; item < 256; item += G) {
            const int j = item >> 2, kvh = item & 3; const int b = j >> 1;
            { const int n = tid >> 4, d8 = (tid & 15) * 8; f32x4 s0 = {0.f, 0.f, 0.f, 0.f}, s1 = {0.f, 0.f, 0.f, 0.f};
              if (n < b) { const float* kp = Kpart + (size_t)n * 512 + kvh * 128 + d8; s0 = *(const f32x4*)kp; s1 = *(const f32x4*)(kp + 4); }
              s0 = s0 * (1.0f / 256.0f); s1 = s1 * (1.0f / 256.0f);
              v4u w; w.x = cvt_pk_bf16(s0[0], s0[1]); w.y = cvt_pk_bf16(s0[2], s0[3]); w.z = cvt_pk_bf16(s1[0], s1[1]); w.w = cvt_pk_bf16(s1[2], s1[3]);
              *(LAS v4u*)(KMb + n * 136 + d8) = w; }
            if (tid < 32) lcnt[tid] = 0u;
            __syncthreads();
            const int nsel = b < 3 ? b : 3;
#pragma unroll 1
            for (int rt = 0; rt < 4; ++rt) {
                const int r = 64 * wave + 16 * rt + fr; const int tok = j * 128 + (r >> 2), hg = r & 3; const bf16* qp = Qb + (size_t)tok * D + (4 * kvh + hg) * 128 + 8 * fq;
                bf16x8 qf[4];
#pragma unroll
                for (int ks = 0; ks < 4; ++ks) qf[ks] = *(const bf16x8*)(qp + 32 * ks);
                f32x4 ga[2];
#pragma unroll
                for (int nt = 0; nt < 2; ++nt) { ga[nt] = (f32x4){0.f, 0.f, 0.f, 0.f};
#pragma unroll
                    for (int ks = 0; ks < 4; ++ks) { const bf16x8 ka = *(const LAS bf16x8*)(KMb + (16 * nt + fr) * 136 + 32 * ks + 8 * fq); ga[nt] = MFMA16(ka, qf[ks], ga[nt]); } }
                float v0 = -INFINITY, v1 = -INFINITY, v2 = -INFINITY; int i0 = 99, i1 = 99, i2 = 99;
#pragma unroll
                for (int nt = 0; nt < 2; ++nt)
#pragma unroll
                    for (int q = 0; q < 4; ++q) { const int n = 16 * nt + 4 * fq + q; if (n < b) G_INSERT(ga[nt][q], n); }
                { const float a0 = shx<16>(v0), a1 = shx<16>(v1), a2 = shx<16>(v2);
                  const int c0 = __builtin_amdgcn_ds_swizzle(i0, (16 << 10) | 0x1f), c1 = __builtin_amdgcn_ds_swizzle(i1, (16 << 10) | 0x1f), c2 = __builtin_amdgcn_ds_swizzle(i2, (16 << 10) | 0x1f);
                  G_INSERT(a0, c0); G_INSERT(a1, c1); G_INSERT(a2, c2); }
                {
                  auto p0 = __builtin_amdgcn_permlane32_swap(__float_as_uint(v0), __float_as_uint(v0), false, false); auto p1 = __builtin_amdgcn_permlane32_swap(__float_as_uint(v1), __float_as_uint(v1), false, false);
                  auto p2 = __builtin_amdgcn_permlane32_swap(__float_as_uint(v2), __float_as_uint(v2), false, false);
                  auto q0 = __builtin_amdgcn_permlane32_swap((unsigned)i0, (unsigned)i0, false, false); auto q1 = __builtin_amdgcn_permlane32_swap((unsigned)i1, (unsigned)i1, false, false);
                  auto q2 = __builtin_amdgcn_permlane32_swap((unsigned)i2, (unsigned)i2, false, false);
                  v0 = __uint_as_float(p0[0]); v1 = __uint_as_float(p1[0]); v2 = __uint_as_float(p2[0]); i0 = (int)q0[0]; i1 = (int)q1[0]; i2 = (int)q2[0];
                  G_INSERT(__uint_as_float(p0[1]), (int)q0[1]); G_INSERT(__uint_as_float(p1[1]), (int)q1[1]); G_INSERT(__uint_as_float(p2[1]), (int)q2[1]); }
                if (fq == 0) {
#pragma unroll
                    for (int rk = 0; rk < 3; ++rk) {
                        if (rk < nsel) { const int best = (rk == 0) ? i0 : ((rk == 1) ? i1 : i2);
                            const unsigned pos = atomicAdd((unsigned*)&lcnt[best], 1u);
                            Subl[((size_t)(j * 4 + kvh) * 32 + best) * 512 + pos] = (unsigned)r | ((unsigned)rk << 9); }
                    }
                }
            }
            __syncthreads();
            if (tid < 32) Scnt[(j * 4 + kvh) * 32 + tid] = lcnt[tid];
            __syncthreads();
        }
#undef G_BETTER
#undef G_INSERT
        for (int item = bid; item < DECB * NKV; item += G) {
            const int b = item >> 2, kvh = item & 3; const int pr = tid >> 5, n = tid & 31;
            const int row = SEQ + 4 * b + (pr >> 2), hg = pr & 3; const bf16* qp = Qb + (size_t)row * D + (4 * kvh + hg) * 128; const float* kmp = Kms + ((size_t)(b * 32 + n)) * 512 + kvh * 128;
            float s = 0.f;
#pragma unroll 4
            for (int d = 0; d < 128; d += 8) { const v4u qw = *(const v4u*)(qp + d); const f32x4 k0 = *(const f32x4*)(kmp + d), k1 = *(const f32x4*)(kmp + d + 4);
                s += (bf2f(qw.x & 0xffffu) * k0[0] + bf2f(qw.x >> 16) * k0[1]) + (bf2f(qw.y & 0xffffu) * k0[2] + bf2f(qw.y >> 16) * k0[3]) + (bf2f(qw.z & 0xffffu) * k1[0] + bf2f(qw.z >> 16) * k1[1]) + (bf2f(qw.w & 0xffffu) * k1[2] + bf2f(qw.w >> 16) * k1[3]); }
            gs[pr * 32 + n] = s;
            __syncthreads();
            if (tid < 16) { unsigned m = 0u;
                for (int r = 0; r < 3; ++r) { int best = 0; float bv = -INFINITY; for (int nn = 0; nn < 32; ++nn) { const float v = gs[tid * 32 + nn]; if (v > bv) { bv = v; best = nn; } } m |= 1u << best; gs[tid * 32 + best] = -INFINITY; }
                Sels[item * 16 + tid] = m; }
            __syncthreads();
        }
    }
    xcd_barrier(bar, IS_T0);
    STAMP();

    {
        LAS bf16* Ks = (LAS bf16*)(lds); LAS bf16* Vs = (LAS bf16*)(lds + KS_BYTES);
        LAS unsigned* qsh = (LAS unsigned*)(lds + 2 * KS_BYTES);
        constexpr int NPI = 4 * 496, NSI = DECB * NKV * NBLK;
        for (;;) {
            const unsigned tq0 = TNOW();
            if (IS_T0) qsh[0] = __hip_atomic_fetch_add(ctl + CW_Q0, 1u, __ATOMIC_RELAXED, __HIP_MEMORY_SCOPE_AGENT);
            __syncthreads();
            const int tick = (int)qsh[0];
            __syncthreads();
            TACC(0, tq0);
            if (tick >= NPI + NSI) break;
            TIDS;
            int item; { const int g3 = tick / 3, r3 = tick - 3 * g3; item = (tick < 3 * NPI) ? ((r3 == 0) ? g3 : NPI + 2 * g3 + (r3 - 1)) : NPI + (tick - NPI); }
            if (item < NPI) {
                int b = (int)((1.0f + sqrtf(1.0f + 2.0f * (float)item)) * 0.5f); while (2 * b * (b - 1) > item) --b; while (2 * (b + 1) * b <= item) ++b;
                const int rem = item - 2 * b * (b - 1); const int n = rem >> 2, kvh = rem & 3;
                const int cntA = (int)Scnt[((2 * b) * 4 + kvh) * 32 + n], cntB = (int)Scnt[((2 * b + 1) * 4 + kvh) * 32 + n]; const int total = cntA + cntB;
                if (total == 0) continue;
                const unsigned tp0 = TNOW();
#pragma unroll
                for (int i = 0; i < 8; ++i) { const int idx = i * 512 + tid, key = idx >> 4, c8 = idx & 15; *(LAS v4u*)(Ks + key * KS_P + c8 * 8) = *(const v4u*)(Kb + (size_t)(256 * n + key) * 512 + kvh * 128 + c8 * 8); }
#pragma unroll
                for (int i = 0; i < 8; ++i) { const int idx = i * 512 + tid, key = idx >> 4, c8 = idx & 15; *(LAS v4u*)(Vs + key * KS_P + c8 * 8) = *(const v4u*)(Vb + (size_t)(256 * n + key) * 512 + kvh * 128 + c8 * 8); }
                __syncthreads();
                TACC(1, tp0); const unsigned tp1 = TNOW();
                const unsigned* LA = Subl + ((size_t)((2 * b) * 4 + kvh) * 32 + n) * 512; const unsigned* LB = Subl + ((size_t)((2 * b + 1) * 4 + kvh) * 32 + n) * 512;
#define LIST_ENT(i_) (((i_) < cntA) ? LA[(i_)] : LB[(i_) - cntA])
                const int iw = 16 * wave + fr;
                unsigned e1 = 0u, e2 = 0u; int ic1 = 0, ic2 = 0;
                if (16 * wave < total) { ic1 = iw < total ? iw : total - 1; e1 = LIST_ENT(ic1); }
                if (16 * wave + 128 < total) { ic2 = iw + 128 < total ? iw + 128 : total - 1; e2 = LIST_ENT(ic2); }
                bf16x8 qn[4];
                { const int tokn = ((ic1 < cntA) ? 2 * b : 2 * b + 1) * 128 + (int)((e1 >> 2) & 127u); const bf16* qp = Qb + (size_t)tokn * D + (4 * kvh + (int)(e1 & 3u)) * 128 + 8 * fq;
#pragma unroll
                  for (int ks = 0; ks < 4; ++ks) qn[ks] = *(const bf16x8*)(qp + 32 * ks); }
                for (int t0 = 0; t0 < total; t0 += 128) {
                    const int i0 = t0 + 16 * wave; if (i0 >= total) break;
                    const bool valid = (i0 + fr) < total; const int ic = ic1; const unsigned e = e1;
                    const int tok = ((ic < cntA) ? 2 * b : 2 * b + 1) * 128 + (int)((e >> 2) & 127u), hg = (int)(e & 3u), rk = (int)(e >> 9);
                    const int h = 4 * kvh + hg;
                    bf16x8 qf[4];
#pragma unroll
                    for (int ks = 0; ks < 4; ++ks) qf[ks] = qn[ks];
                    e1 = e2; ic1 = ic2;
                    if (i0 + 256 < total) { ic2 = (i0 + 256 + fr) < total ? (i0 + 256 + fr) : total - 1; e2 = LIST_ENT(ic2); }
                    if (i0 + 128 < total) { const int tokn = ((ic1 < cntA) ? 2 * b : 2 * b + 1) * 128 + (int)((e1 >> 2) & 127u); const bf16* qp = Qb + (size_t)tokn * D + (4 * kvh + (int)(e1 & 3u)) * 128 + 8 * fq;
#pragma unroll
                        for (int ks = 0; ks < 4; ++ks) qn[ks] = *(const bf16x8*)(qp + 32 * ks); }
                    f32x4 acc[16]; attn_scores<16>(Ks, qf, acc, 16, fr, fq);
                    float mx = -INFINITY;
#pragma unroll
                    for (int kt = 0; kt < 16; ++kt) mx = fmaxf(fmaxf(mx, fmaxf(acc[kt][0], acc[kt][1])), fmaxf(acc[kt][2], acc[kt][3]));
                    mx = fmaxf(mx, shx<16>(mx)); mx = xmax32(mx);
                    float l = 0.f;
#pragma unroll
                    for (int kt = 0; kt < 16; ++kt) {
#pragma unroll
                        for (int r = 0; r < 4; ++r) { const float p = __builtin_amdgcn_exp2f(acc[kt][r] - mx); acc[kt][r] = p; l += p; } }
                    l += shx<16>(l); l = xadd32(l);
                    f32x4 O[8];
#pragma unroll
                    for (int vt = 0; vt < 8; ++vt) O[vt] = (f32x4){0.f, 0.f, 0.f, 0.f};
                    attn_pv(Vs, acc, O, 8, fr, fq);
                    if (valid) {
                        const size_t slot = ((size_t)tok * NH + h) * 3 + rk; bf16* op = Oslot + slot * 128 + 8 * fq;
#pragma unroll
                        for (int c = 0; c < 4; ++c) { v4u w; w.x = cvt_pk_bf16(O[2 * c][0], O[2 * c][1]); w.y = cvt_pk_bf16(O[2 * c][2], O[2 * c][3]); w.z = cvt_pk_bf16(O[2 * c + 1][0], O[2 * c + 1][1]); w.w = cvt_pk_bf16(O[2 * c + 1][2], O[2 * c + 1][3]); *(v4u*)(op + 32 * c) = w; }
                        if (fq == 0) { MLslot[slot * 2] = mx; MLslot[slot * 2 + 1] = l; }
                    }
                }
                __syncthreads();
                TACC(2, tp1);
            } else {
                const int si = item - NPI; const int b = si >> 7, kvh = (si >> 5) & 3, n = si & 31;
                unsigned any = 0u;
#pragma unroll
                for (int p = 0; p < 16; ++p) any |= Sels[(b * 4 + kvh) * 16 + p];
                if (!((any >> n) & 1u)) continue;
                const unsigned ts0 = TNOW();
                const int pg0 = ptab[b * NPAGES + 2 * n], pg1 = ptab[b * NPAGES + 2 * n + 1];
                f32x4 kst[16], vst[16];
#pragma unroll
                for (int i = 0; i < 16; ++i) { const int idx = i * 512 + tid, key = idx >> 5, c4 = idx & 31; const int page = (key < 128) ? pg0 : pg1;
                    const size_t go = (((size_t)page * PAGE + (key & 127)) * NKV + kvh) * 128 + c4 * 4;
                    kst[i] = __builtin_nontemporal_load((const f32x4*)(cache_k + go)); vst[i] = __builtin_nontemporal_load((const f32x4*)(cache_v + go)); }
#pragma unroll
                for (int i = 0; i < 16; ++i) { const int idx = i * 512 + tid, key = idx >> 5, c4 = idx & 31; const int page = (key < 128) ? pg0 : pg1; (void)page;
                    const f32x4 kk4 = kst[i], vv4 = vst[i];
                    v2u w; w.x = cvt_pk_bf16(kk4[0], kk4[1]); w.y = cvt_pk_bf16(kk4[2], kk4[3]); *(LAS v2u*)(Ks + key * KS_P + c4 * 4) = w;
                    v2u wv; wv.x = cvt_pk_bf16(vv4[0], vv4[1]); wv.y = cvt_pk_bf16(vv4[2], vv4[3]); *(LAS v2u*)(Vs + key * KS_P + c4 * 4) = wv; }
                __syncthreads();
                TACC(3, ts0); const unsigned ts1 = TNOW();
                {
                    LAS float* mxs = (LAS float*)(lds + 2 * KS_BYTES + 64); LAS float* lss = mxs + 128; LAS float* Ored = (LAS float*)(lds);
                    const int row = SEQ + 4 * b + (fr >> 2), hg = fr & 3; const int h = 4 * kvh + hg; const bf16* qp = Qb + (size_t)row * D + h * 128 + 8 * fq;
                    bf16x8 qf[4];
#pragma unroll
                    for (int ks = 0; ks < 4; ++ks) qf[ks] = *(const bf16x8*)(qp + 32 * ks);
                    f32x4 a2[2];
#pragma unroll
                    for (int t = 0; t < 2; ++t) { a2[t] = (f32x4){0.f, 0.f, 0.f, 0.f};
#pragma unroll
                        for (int ks = 0; ks < 4; ++ks) { const bf16x8 ka = *(const LAS bf16x8*)(Ks + (16 * (2 * wave + t) + fr) * KS_P + 32 * ks + 8 * fq); a2[t] = MFMA16(ka, qf[ks], a2[t]); } }
                    float mx = fmaxf(fmaxf(fmaxf(a2[0][0], a2[0][1]), fmaxf(a2[0][2], a2[0][3])), fmaxf(fmaxf(a2[1][0], a2[1][1]), fmaxf(a2[1][2], a2[1][3])));
                    mx = fmaxf(mx, shx<16>(mx)); mx = xmax32(mx);
                    if (fq == 0) mxs[wave * 16 + fr] = mx;
                    __syncthreads();
                    float M = mxs[fr];
#pragma unroll
                    for (int w8 = 1; w8 < 8; ++w8) M = fmaxf(M, mxs[w8 * 16 + fr]);
                    float l = 0.f;
#pragma unroll
                    for (int t = 0; t < 2; ++t) {
#pragma unroll
                        for (int r = 0; r < 4; ++r) { const float p = __builtin_amdgcn_exp2f(a2[t][r] - M); a2[t][r] = p; l += p; } }
                    l += shx<16>(l); l = xadd32(l);
                    if (fq == 0) lss[wave * 16 + fr] = l;
                    v4u pw; pw.x = cvt_pk_bf16(a2[0][0], a2[0][1]); pw.y = cvt_pk_bf16(a2[0][2], a2[0][3]); pw.z = cvt_pk_bf16(a2[1][0], a2[1][1]); pw.w = cvt_pk_bf16(a2[1][2], a2[1][3]);
                    const bf16x8 pf = __builtin_bit_cast(bf16x8, pw);
                    const LAS bf16* vb = Vs + (32 * wave + 4 * fq + (fr >> 2)) * KS_P + 4 * (fr & 3);
#pragma unroll
                    for (int vt = 0; vt < 8; ++vt) { const v2u lo = tr_read(vb + 16 * vt), hi = tr_read(vb + 16 * KS_P + 16 * vt); const v4u aw = {lo.x, lo.y, hi.x, hi.y};
                        const f32x4 o = MFMA16(__builtin_bit_cast(bf16x8, aw), pf, ((f32x4){0.f, 0.f, 0.f, 0.f}));
                        *(LAS f32x4*)(Ored + (wave * 16 + fr) * 132 + 16 * vt + 4 * fq) = o; }
                    __syncthreads();
                    { const int r16 = tid >> 5, c4 = tid & 31; f32x4 so = *(const LAS f32x4*)(Ored + r16 * 132 + 4 * c4);
#pragma unroll
                      for (int w8 = 1; w8 < 8; ++w8) so += *(const LAS f32x4*)(Ored + (w8 * 16 + r16) * 132 + 4 * c4);
                      float* sp = Sslot + ((size_t)((b * 4 + kvh) * 32 + n) * 16 + r16) * 132;
                      *(f32x4*)(sp + 4 * c4) = so;
                      if (c4 == 0) { float Mr = mxs[r16], lt = lss[r16];
#pragma unroll
                          for (int w8 = 1; w8 < 8; ++w8) { Mr = fmaxf(Mr, mxs[w8 * 16 + r16]); lt += lss[w8 * 16 + r16]; }
                          sp[128] = Mr; sp[129] = lt; } }
                }
                __syncthreads();
                TACC(4, ts1);
            }
        }
    }
    xcd_barrier(bar, IS_T0);
    STAMP();

    {
        TIDS;
        LAS bf16* Ks = (LAS bf16*)(lds); LAS bf16* Vs = (LAS bf16*)(lds + KS_BYTES);
        const unsigned tq12 = TNOW();
        for (int item = bid; item < NBLK * NKV * 2; item += G) {
            const int b = item >> 3, kvh = (item >> 1) & 3, hp = item & 1;
            int tid_i = TIDX; asm volatile("" : "+v"(tid_i));
#pragma unroll
            for (int i = 0; i < 8; ++i) { const int idx = i * 512 + tid_i, key = idx >> 4, c8 = idx & 15; *(LAS v4u*)(Ks + key * KS_P + c8 * 8) = *(const v4u*)(Kb + (size_t)(256 * b + key) * 512 + kvh * 128 + c8 * 8); }
#pragma unroll
            for (int i = 0; i < 8; ++i) { const int idx = i * 512 + tid_i, key = idx >> 4, c8 = idx & 15; *(LAS v4u*)(Vs + key * KS_P + c8 * 8) = *(const v4u*)(Vb + (size_t)(256 * b + key) * 512 + kvh * 128 + c8 * 8); }
            const int nsel = b < 3 ? b : 3;
            bf16x8 qn[4];
            { const bf16* qp = Qb + (size_t)(256 * b + 16 * wave + fr) * D + (4 * kvh + 2 * hp) * 128 + 8 * fq;
#pragma unroll
              for (int ks = 0; ks < 4; ++ks) qn[ks] = *(const bf16x8*)(qp + 32 * ks); }
            __syncthreads();
#pragma unroll 1
            for (int u = 0; u < 4; ++u) {
                const int g = (u & 1) ? 15 - wave : wave, h = 4 * kvh + 2 * hp + (u >> 1); const int tl = 16 * g + fr; const int tok = 256 * b + tl;
                bf16x8 qf[4];
#pragma unroll
                for (int ks = 0; ks < 4; ++ks) qf[ks] = qn[ks];
                if (u < 3) { const int gn = ((u + 1) & 1) ? 15 - wave : wave, hn = 4 * kvh + 2 * hp + ((u + 1) >> 1); const bf16* qp = Qb + (size_t)(256 * b + 16 * gn + fr) * D + hn * 128 + 8 * fq;
#pragma unroll
                    for (int ks = 0; ks < 4; ++ks) qn[ks] = *(const bf16x8*)(qp + 32 * ks); }
                float msa[3], lsa[3];
#pragma unroll
                for (int r = 0; r < 3; ++r) { msa[r] = -INFINITY; lsa[r] = 0.f; if (r < nsel) { const size_t slot = ((size_t)tok * NH + h) * 3 + r; msa[r] = MLslot[slot * 2]; lsa[r] = MLslot[slot * 2 + 1]; } }
                v4u ow[3][4];
#pragma unroll
                for (int r = 0; r < 3; ++r) { if (r < nsel) { const bf16* op = Oslot + (((size_t)tok * NH + h) * 3 + r) * 128 + 8 * fq;
#pragma unroll
                    for (int c = 0; c < 4; ++c) ow[r][c] = *(const v4u*)(op + 32 * c); } }
                const int nkt = g + 1;
                f32x4 acc[16]; attn_scores<16>(Ks, qf, acc, nkt, fr, fq);
                float mx = -INFINITY;
#pragma unroll
                for (int kt = 0; kt < 16; ++kt) {
#pragma unroll
                    for (int r = 0; r < 4; ++r) { const bool ok = (kt < nkt) && (16 * kt + 4 * fq + r <= tl); const float sv = ok ? acc[kt][r] : -INFINITY; acc[kt][r] = sv; mx = fmaxf(mx, sv); } }
                mx = fmaxf(mx, shx<16>(mx)); mx = xmax32(mx);
                float M = mx;
#pragma unroll
                for (int r = 0; r < 3; ++r) M = fmaxf(M, msa[r]);
                f32x4 O[8]; float lp = 0.f;
#pragma unroll
                for (int vt = 0; vt < 8; ++vt) O[vt] = (f32x4){0.f, 0.f, 0.f, 0.f};
#pragma unroll
                for (int r = 0; r < 3; ++r) { if (r < nsel) { const float sc = __builtin_amdgcn_exp2f(msa[r] - M); lp += lsa[r] * sc;
#pragma unroll
                    for (int c = 0; c < 4; ++c) { const v4u w = ow[r][c];
                        O[2 * c][0] += bf2f(w.x & 0xffffu) * sc; O[2 * c][1] += bf2f(w.x >> 16) * sc; O[2 * c][2] += bf2f(w.y & 0xffffu) * sc; O[2 * c][3] += bf2f(w.y >> 16) * sc;
                        O[2 * c + 1][0] += bf2f(w.z & 0xffffu) * sc; O[2 * c + 1][1] += bf2f(w.z >> 16) * sc; O[2 * c + 1][2] += bf2f(w.w & 0xffffu) * sc; O[2 * c + 1][3] += bf2f(w.w >> 16) * sc; } } }
                float l = 0.f;
#pragma unroll
                for (int kt = 0; kt < 16; ++kt) {
#pragma unroll
                    for (int r = 0; r < 4; ++r) { const float p = __builtin_amdgcn_exp2f(acc[kt][r] - M); acc[kt][r] = p; l += p; } }
                l += shx<16>(l); l = xadd32(l); l += lp;
                attn_pv(Vs, acc, O, (nkt + 1) >> 1, fr, fq);
                const float il = 1.0f / l; bf16* ap = At + (size_t)tok * D + h * 128 + 4 * fq;
#pragma unroll
                for (int vt = 0; vt < 8; ++vt) { v2u w; w.x = cvt_pk_bf16(O[vt][0] * il, O[vt][1] * il); w.y = cvt_pk_bf16(O[vt][2] * il, O[vt][3] * il); *(v2u*)(ap + 16 * vt) = w; }
            }
            __syncthreads();
        }
        TACC(10, tq12); const unsigned ts12 = TNOW();
        LAS float* ksn = (LAS float*)(lds);
        for (int item = bid; item < DECB * NKV; item += G) {
            const int b = item >> 2, kvh = item & 3;
            TIDS;
            { const int key = tid >> 7, d = tid & 127; ksn[key * 128 + d] = out[OK_S + (size_t)(4 * b + key) * 512 + kvh * 128 + d]; ksn[512 + key * 128 + d] = out[OV_S + (size_t)(4 * b + key) * 512 + kvh * 128 + d]; }
            __syncthreads();
            const int pr = tid >> 5, l32 = tid & 31; const int t = pr >> 2, hg = pr & 3; const int row = SEQ + 4 * b + t, h = 4 * kvh + hg;
            const v2u qw = *(const v2u*)(Qb + (size_t)row * D + h * 128 + 4 * l32);
            const float q0 = bf2f(qw.x & 0xffffu), q1 = bf2f(qw.x >> 16), q2 = bf2f(qw.y & 0xffffu), q3 = bf2f(qw.y >> 16);
            float sk[4]; float M = -INFINITY;
#pragma unroll
            for (int key = 0; key < 4; ++key) { const f32x4 k4 = *(const LAS f32x4*)(ksn + key * 128 + 4 * l32); float s = (q0 * k4[0] + q1 * k4[1]) + (q2 * k4[2] + q3 * k4[3]);
                s += shx<1>(s); s += shx<2>(s); s += shx<4>(s); s += shx<8>(s); s += shx<16>(s);
                sk[key] = (key <= t) ? s : -INFINITY; M = fmaxf(M, sk[key]); }
            unsigned mk = Sels[item * 16 + pr];
            float sm[3], sl[3]; f32x4 so[3]; bool sv[3];
#pragma unroll
            for (int i = 0; i < 3; ++i) { sv[i] = mk != 0u; const int n = sv[i] ? __builtin_ctz(mk) : 0; mk &= mk - 1u;
                const float* sp = Sslot + ((size_t)(item * 32 + n) * 16 + pr) * 132; sm[i] = sp[128]; sl[i] = sp[129]; so[i] = *(const f32x4*)(sp + 4 * l32); }
#pragma unroll
            for (int i = 0; i < 3; ++i) if (sv[i]) M = fmaxf(M, sm[i]);
            float l = 0.f; f32x4 O = {0.f, 0.f, 0.f, 0.f};
#pragma unroll
            for (int key = 0; key < 4; ++key) { const float p = __builtin_amdgcn_exp2f(sk[key] - M); l += p; O += *(const LAS f32x4*)(ksn + 512 + key * 128 + 4 * l32) * p; }
#pragma unroll
            for (int i = 0; i < 3; ++i) if (sv[i]) { const float sc = __builtin_amdgcn_exp2f(sm[i] - M); l += sl[i] * sc; O += so[i] * sc; }
            const float il = 1.0f / l; v2u w; w.x = cvt_pk_bf16(O[0] * il, O[1] * il); w.y = cvt_pk_bf16(O[2] * il, O[3] * il);
            *(v2u*)(At + (size_t)row * D + h * 128 + 4 * l32) = w;
            __syncthreads();
        }
        TACC(11, ts12);
    }
    xcd_barrier(bar, IS_T0);
    STAMP();

    {
        TIDS;
        pg8::Gemm g{At, Wo_t, SEQ, D, D}; pg8::StaticOrder S; S.init(SEQ, D, G, bid);
        EpiRes<1> E{Hb2, nullptr, nullptr, Hb3, ss3};
        pg8::gemm_phase<EpiRes<1>, pg8::StaticOrder, true, true, false>(lds, g, S, E, TIDX);
        { const int t2 = bid & 127, rh = (bid >> 7) & 1; TIDS; f32x4 ta[1]; tail_gemm<1, D>(lds, At + (size_t)SEQ * D, Wo_t, 16 * t2, rh, ta, TIDX, bid & 127); if (wave < 4) E.tail(SEQ + 64 * rh + 16 * wave + fr, 16 * t2 + 4 * fq, ta[0], fq); }
    }
    xcd_barrier(bar, IS_T0);
    STAMP();
    {
        TIDS;
        pg8::Gemm g{Hb3, Wgu1_t, MP, NGU, D}; pg8::StaticOrder S; S.init(MP, NGU, G, bid);
        EpiGU E{ss3, Hm};
        pg8::gemm_phase<EpiGU, pg8::StaticOrder, true, true>(lds, g, S, E, TIDX);
        constexpr int GG = 172;
        if (bid >= GG) {
            constexpr int I_DN = 88 * 32;
            LAS float* scr = (LAS float*)(lds + wave * 17408);
            const int gw = (bid - GG) * NWAVES + wave, NGW = (G - GG) * NWAVES;
            for (int it = gw; it < I_DN; it += 2 * NGW) {
                const bool hb = it + NGW < I_DN; TrItem ta, tb; ta.W = w_dn + (size_t)DFF * D; ta.gain = nullptr; ta.WT = Wdn1_t; ta.K = DFF; ta.N = D; ta.row_off = 0; ta.item = it; tb = ta; tb.item = hb ? it + NGW : it;
                f32x4 wa[16], wb[16]; float ga[16], gb[16];
                tr_load(ta, wa, ga, lane); if (hb) tr_load(tb, wb, gb, lane);
                tr_store(ta, wa, ga, scr, lane); if (hb) tr_store(tb, wb, gb, scr, lane);
            }
        }
    }
    xcd_barrier(bar, IS_T0);
    STAMP();
    {
        TIDS;
        pg8::Gemm g{Hm, Wdn1_t, SEQ, D, DFF}; pg8::StaticOrder S; S.init(SEQ, D, G, bid);
        EpiRes<2> E{Hb3, out + OY_P, out + OY_S, nullptr, nullptr};
        pg8::gemm_phase<EpiRes<2>, pg8::StaticOrder, true, true, false>(lds, g, S, E, TIDX);
        { const int t2 = bid & 127, rh = (bid >> 7) & 1; TIDS; f32x4 ta[1]; tail_gemm<1, DFF>(lds, Hm + (size_t)SEQ * DFF, Wdn1_t, 16 * t2, rh, ta, TIDX, bid & 127); if (wave < 4) E.tail(SEQ + 64 * rh + 16 * wave + fr, 16 * t2 + 4 * fq, ta[0], fq); }
    }
#ifdef PROF_A
    STAMP();
    if (blockIdx.x == 0 && IS_T0) {
        const unsigned ta = PVAL(PROF_A0, PROF_A1), tb = PVAL(PROF_B0, PROF_B1);
        unsigned qa = (ta + PROF_UA / 2) / PROF_UA, qb = (tb + PROF_UB / 2) / PROF_UB; if (qa > 99u) qa = 99u; if (qb > 99u) qb = 99u;
#ifdef PROF_MUL
        const unsigned long long extra = (unsigned long long)ta * PROF_MUL;
#else
        const unsigned long long extra = (unsigned long long)(qa + 100u * qb) * 5000ull;
#endif
        const unsigned long long t0 = __builtin_amdgcn_s_memrealtime();
        while (__builtin_amdgcn_s_memrealtime() - t0 < extra) __builtin_amdgcn_s_sleep(32);
    }
#endif
}
#undef x_p
#undef x_s
#undef st_in
#undef cache_k
#undef cache_v
#undef ptab
#undef norm_mix_a
#undef w_in
#undef lbl
#undef onorm
#undef w_out
#undef norm_kv
#undef w_kv
#undef k_norm
#undef norm_mix_b
#undef w_q
#undef q_norm
#undef w_o
#undef norm_ffn
#undef w_gu
#undef w_dn
#undef Win_t
#undef Wout_t
#undef Wgu0_t
#undef Wdn0_t
#undef Wkvq_t
#undef Wo_t
#undef Wgu1_t
#undef Wdn1_t
#undef Hb0
#undef Hb1
#undef Hb2
#undef Hb3
#undef Hf1
#undef Hf2
#undef Hf3
#undef Qg
#undef Vg
#undef Gg
#undef Ff
#undef Ob
#undef At
#undef Hm
#undef Ug
#undef Sg0
#undef Dg
#undef Kraw
#undef Vraw
#undef Qraw
#undef Kb
#undef Vb
#undef Qb
#undef Kpart
#undef Kms
#undef Subl
#undef Scnt
#undef Sels
#undef Oslot
#undef MLslot
#undef Sslot
#undef ss0
#undef ss1
#undef ss2
#undef ss3
#undef out
#undef TIDS
#undef TIDX
#undef IS_T0

extern "C" void kernel_launch(void* const* d_in, const int* in_sizes, int n_in, void* d_out, int out_size, void* d_ws, size_t ws_size, hipStream_t stream) {
    static int grid = 0;
    if (grid == 0) {
        if (n_in != 21 || ws_size < WS_END) { fprintf(stderr, "kernel_launch: unexpected n_in %d / ws %zu\n", n_in, ws_size); grid = -1; return; }
        int dev = 0, cus = 0, per_cu = 0;
        if (hipGetDevice(&dev) != hipSuccess || hipDeviceGetAttribute(&cus, hipDeviceAttributeMultiprocessorCount, dev) != hipSuccess) { grid = -1; return; }
        if (hipFuncSetAttribute((const void*)yoco_fwd, hipFuncAttributeMaxDynamicSharedMemorySize, LDS_BYTES) != hipSuccess) { fprintf(stderr, "kernel_launch: hipFuncSetAttribute failed\n"); grid = -1; return; }
        if (hipOccupancyMaxActiveBlocksPerMultiprocessor(&per_cu, (const void*)yoco_fwd, NTHR, LDS_BYTES) != hipSuccess || per_cu < 1) fprintf(stderr, "kernel_launch: occupancy query says %d\n", per_cu);
        (void)hipGetLastError();
        grid = cus;
        if (grid < 256) { fprintf(stderr, "kernel_launch: built for 256 CUs (got %d)\n", grid); grid = -1; return; }
        grid = 256;
    }
    if (grid < 0) return;
    (void)hipMemsetAsync((char*)d_ws + WS_CTL, 0, CTL_ZERO_BYTES, stream);
    Args a{};
    for (int i = 0; i < 21; ++i) a.in[i] = d_in[i];
    a.out = (float*)d_out; a.ws = (unsigned char*)d_ws;
    hipLaunchKernelGGL(yoco_fwd, dim3(grid), dim3(NTHR), LDS_BYTES, stream, a);
}
```

```cpp
#include <hip/hip_runtime.h>
#include <cstdio>
#include <cstdint>
__device__ __forceinline__ int lane_id() { int l; asm volatile("v_mbcnt_lo_u32_b32 %0, -1, 0\n\tv_mbcnt_hi_u32_b32 %0, -1, %0" : "=v"(l)); return l; }

namespace pg8 {
#define PG8_LAS __attribute__((address_space(3)))
typedef unsigned short bf16_t;
typedef short bf16x8 __attribute__((ext_vector_type(8)));
typedef float f32x4 __attribute__((ext_vector_type(4)));
typedef unsigned u32x4 __attribute__((ext_vector_type(4)));
typedef unsigned u32x2 __attribute__((ext_vector_type(2)));
constexpr int BM = 256, BK = 64, HALF = 128, HTB = HALF * BK * 2, STAGE_BYTES = 8 * HTB, NXCD = 8, WGM = 8;

__host__ __device__ __forceinline__ int lds_byte(int r, int c) { const int st = (r >> 4) * 2 + (c >> 5), rr = r & 15, cc = c & 31, ob = rr * 64 + cc * 2; return st * 1024 + (ob ^ (((ob >> 9) & 1) << 5)); }
__host__ __device__ __forceinline__ void stage_rc(int b, int& R, int& C) { const int st = b / 1024, sb = b % 1024, swz = sb ^ (((sb >> 9) & 1) << 5); R = (st >> 1) * 16 + swz / 64; C = (st & 1) * 32 + (swz % 64) / 2; }
__host__ __device__ __forceinline__ int perm32(int rho) { const int n = rho >> 4, i = rho & 15; return 8 * (i >> 2) + 4 * n + (i & 3); }

struct Unit { int pm, pn; };
struct Gemm { const bf16_t* A; const bf16_t* Bt; int M, N, K; };

struct StaticOrder {
    int nM, nN, nwg, G, c;
    __host__ __device__ void init(int M, int N, int G_, int c_) { nM = M / BM; nN = N / BM; nwg = nM * nN; G = G_; c = c_; }
    __host__ __device__ bool next(int i, Unit& u) const {
        const long L = (long)i * G + c; if (L >= nwg) return false;
        int wgid = (int)L; { const int q = nwg / NXCD, r = nwg % NXCD, xcd = wgid % NXCD, off = wgid / NXCD; wgid = (xcd < r ? xcd * (q + 1) : r * (q + 1) + (xcd - r) * q) + off; }
        const int nig = WGM * nN, gid = wgid / nig, fm = gid * WGM, gsz = (nM - fm) < WGM ? (nM - fm) : WGM;
        u.pm = fm + ((wgid % nig) % gsz); u.pn = (wgid % nig) / gsz; return true;
    }
    __device__ __forceinline__ void a_ready(const Unit&) const {}
    __device__ __forceinline__ void done(const Unit&) const {}
};

__device__ __forceinline__ unsigned cvt_pk_bf16(float lo, float hi) { unsigned r; asm volatile("v_cvt_pk_bf16_f32 %0, %1, %2" : "=v"(r) : "v"(lo), "v"(hi)); return r; }

template <class Epi, class Sched, bool ALIGN_EPI = false, bool SP2 = false, bool HALF_LAST = true>
__device__ __forceinline__ void gemm_phase(PG8_LAS unsigned char* lds, const Gemm g, const Sched& S, const Epi& E, int tidx) {
    int tid_ = tidx; asm volatile("" : "+v"(tid_));
    const int tid = tid_, wid = __builtin_amdgcn_readfirstlane(tid >> 6), lane = tid & 63, wr = wid >> 2, wc = wid & 3, fr = lane & 15, fq = lane >> 4;
    const int K = g.K, nt = K / BK;
    unsigned voffA[2], voffB[2];
#pragma unroll
    for (int i = 0; i < 2; ++i) { int R, C; stage_rc(tid * 16 + i * 8192, R, C); const int Rb = Epi::PERM ? ((R & ~31) + perm32(R & 31)) : R;
        voffA[i] = (unsigned)(R * K + C) * 2u; voffB[i] = (unsigned)(Rb * K + C) * 2u; }
    const size_t kstep = (size_t)(BK * 2);
    const size_t hstep = (size_t)HALF * K * 2;
    const size_t tstep = 2 * hstep;
    const unsigned ldsw = (unsigned)wid * 1024u;
    const int aoff = lds_byte(wr * 64 + fr, fq * 8), boff = lds_byte(wc * 32 + fr, fq * 8);
#define PG8_SA(b, h) (((b) * 2 + (h)) * HTB)
#define PG8_SB(b, h) ((4 + (b) * 2 + (h)) * HTB)
#define PG8_STAGE(bufoff, gbase, voff) do { _Pragma("unroll") for (int _i = 0; _i < 2; ++_i) \
        __builtin_amdgcn_global_load_lds((const unsigned*)((const char*)(gbase) + (voff)[_i]), (PG8_LAS unsigned*)(lds + (bufoff) + ldsw + _i * 8192), 16, 0, 0); } while (0)
#define PG8_LDA(dst, b, h) do { _Pragma("unroll") for (int m = 0; m < 4; ++m) _Pragma("unroll") for (int k = 0; k < 2; ++k) dst[m][k] = *(const PG8_LAS bf16x8*)(lds + PG8_SA(b, h) + aoff + m * 2048 + k * 1024); } while (0)
#define PG8_LDB(dst, b, h) do { _Pragma("unroll") for (int n = 0; n < 2; ++n) _Pragma("unroll") for (int k = 0; k < 2; ++k) dst[n][k] = *(const PG8_LAS bf16x8*)(lds + PG8_SB(b, h) + boff + n * 2048 + k * 1024); } while (0)
#define PG8_MMA(ai, bj, At, Bt) do { __builtin_amdgcn_s_setprio(1); _Pragma("unroll") for (int m = 0; m < 4; ++m) _Pragma("unroll") for (int n = 0; n < 2; ++n) _Pragma("unroll") for (int k = 0; k < 2; ++k) \
        acc[ai][bj][m][n] = __builtin_amdgcn_mfma_f32_16x16x32_bf16(Bt[n][k], At[m][k], acc[ai][bj][m][n], 0, 0, 0); __builtin_amdgcn_s_setprio(0); } while (0)
#define PG8_WAIT_V(n) asm volatile("s_waitcnt vmcnt(" #n ")" ::: "memory")
#define PG8_WAIT_L(n) asm volatile("s_waitcnt lgkmcnt(" #n ")" ::: "memory")
#define PG8_BAR __builtin_amdgcn_s_barrier()
#define PG8_SCHED __builtin_amdgcn_sched_barrier(0)
    Unit cur, nxt; int ui = 0;
    if (!S.next(0, cur)) return;
    f32x4 acc[2][2][4][2];
#pragma unroll
    for (int a = 0; a < 2; ++a)
#pragma unroll
        for (int b = 0; b < 2; ++b)
#pragma unroll
            for (int m = 0; m < 4; ++m)
#pragma unroll
                for (int n = 0; n < 2; ++n) acc[a][b][m][n] = (f32x4){0.f, 0.f, 0.f, 0.f};
    bf16x8 At[4][2], B0[2][2], B1[2][2];
    const char* cA = (const char*)g.A + (size_t)cur.pm * tstep; const char* cB = (const char*)g.Bt + (size_t)cur.pn * tstep;
    S.a_ready(cur);
    if constexpr (SP2) {
        PG8_STAGE(PG8_SB(0, 0), cB, voffB); PG8_STAGE(PG8_SB(0, 1), cB + hstep, voffB); PG8_STAGE(PG8_SA(0, 0), cA, voffA); PG8_STAGE(PG8_SA(0, 1), cA + hstep, voffA);
        if (wr == 1) PG8_BAR;
        PG8_WAIT_V(2); PG8_BAR;
        PG8_STAGE(PG8_SB(1, 0), cB + kstep, voffB); PG8_STAGE(PG8_SA(1, 0), cA + kstep, voffA); PG8_STAGE(PG8_SB(1, 1), cB + hstep + kstep, voffB);
        PG8_WAIT_V(6); PG8_BAR;
    } else {
        PG8_STAGE(PG8_SB(0, 0), cB, voffB); PG8_STAGE(PG8_SA(0, 0), cA, voffA); PG8_STAGE(PG8_SB(0, 1), cB + hstep, voffB); PG8_STAGE(PG8_SA(0, 1), cA + hstep, voffA);
        if (wr == 1) PG8_BAR;
        PG8_WAIT_V(4); PG8_BAR;
        PG8_STAGE(PG8_SB(1, 0), cB + kstep, voffB); PG8_STAGE(PG8_SA(1, 0), cA + kstep, voffA); PG8_STAGE(PG8_SB(1, 1), cB + hstep + kstep, voffB);
        PG8_WAIT_V(6); PG8_BAR;
    }
    for (;;) {
        const bool has_next = S.next(ui + 1, nxt);
        const bool half1 = HALF_LAST && (cur.pm == g.M / BM - 1);
        const char* nA = has_next ? (const char*)g.A + (size_t)nxt.pm * tstep : cA; const char* nB = has_next ? (const char*)g.Bt + (size_t)nxt.pn * tstep : cB;
        for (int t = 0; t < nt; t += 2) {
            const bool last = (t == nt - 2);
            const char* a1 = cA + (size_t)(t + 1) * kstep;
            const char* a2 = last ? nA : cA + (size_t)(t + 2) * kstep; const char* b2 = last ? nB : cB + (size_t)(t + 2) * kstep;
            const char* a3 = a2 + kstep; const char* b3 = b2 + kstep;
            if (last && has_next) S.a_ready(nxt);
            if constexpr (SP2) {
            PG8_LDB(B0, 0, 0); PG8_LDB(B1, 0, 1); PG8_SCHED; PG8_LDA(At, 0, 0); PG8_STAGE(PG8_SA(1, 1), a1 + hstep, voffA);
            PG8_WAIT_V(8); PG8_WAIT_L(0); PG8_BAR; PG8_MMA(0, 0, At, B0); PG8_MMA(0, 1, At, B1); PG8_BAR; PG8_SCHED;
            if (!half1) { PG8_LDA(At, 0, 1); } PG8_STAGE(PG8_SB(0, 0), b2, voffB); PG8_STAGE(PG8_SB(0, 1), b2 + hstep, voffB); PG8_STAGE(PG8_SA(0, 0), a2, voffA);
            PG8_WAIT_V(8); PG8_WAIT_L(0); PG8_BAR; if (!half1) { PG8_MMA(1, 0, At, B0); PG8_MMA(1, 1, At, B1); } PG8_BAR; PG8_SCHED;
            PG8_LDB(B0, 1, 0); PG8_LDB(B1, 1, 1); PG8_SCHED; PG8_LDA(At, 1, 0); PG8_STAGE(PG8_SA(0, 1), a2 + hstep, voffA);
            PG8_WAIT_V(8); PG8_WAIT_L(0); PG8_BAR; PG8_MMA(0, 0, At, B0); PG8_MMA(0, 1, At, B1); PG8_BAR; PG8_SCHED;
            if (!half1) { PG8_LDA(At, 1, 1); } PG8_STAGE(PG8_SB(1, 0), b3, voffB); PG8_STAGE(PG8_SB(1, 1), b3 + hstep, voffB); PG8_STAGE(PG8_SA(1, 0), a3, voffA);
            PG8_WAIT_V(8); PG8_WAIT_L(0); PG8_BAR; if (!half1) { PG8_MMA(1, 0, At, B0); PG8_MMA(1, 1, At, B1); } PG8_BAR; PG8_SCHED;
            } else {
            PG8_LDB(B0, 0, 0); PG8_SCHED; PG8_LDA(At, 0, 0); PG8_STAGE(PG8_SA(1, 1), a1 + hstep, voffA);
            PG8_WAIT_L(8); PG8_BAR; PG8_WAIT_L(0); PG8_MMA(0, 0, At, B0); PG8_BAR; PG8_SCHED;
            PG8_LDB(B1, 0, 1); PG8_STAGE(PG8_SB(0, 0), b2, voffB);
            PG8_BAR; PG8_WAIT_L(0); PG8_MMA(0, 1, At, B1); PG8_BAR;
            PG8_LDA(At, 0, 1); PG8_STAGE(PG8_SA(0, 0), a2, voffA);
            PG8_BAR; PG8_WAIT_L(0); PG8_MMA(1, 0, At, B0); PG8_BAR; PG8_SCHED;
            PG8_STAGE(PG8_SB(0, 1), b2 + hstep, voffB);
            PG8_WAIT_V(6); PG8_BAR; PG8_MMA(1, 1, At, B1); PG8_BAR;
            PG8_LDB(B0, 1, 0); PG8_SCHED; PG8_LDA(At, 1, 0); PG8_STAGE(PG8_SA(0, 1), a2 + hstep, voffA);
            PG8_WAIT_L(8); PG8_BAR; PG8_WAIT_L(0); PG8_MMA(0, 0, At, B0); PG8_BAR; PG8_SCHED;
            PG8_LDB(B1, 1, 1); PG8_STAGE(PG8_SB(1, 0), b3, voffB);
            PG8_BAR; PG8_WAIT_L(0); PG8_MMA(0, 1, At, B1); PG8_BAR;
            PG8_LDA(At, 1, 1); PG8_STAGE(PG8_SA(1, 0), a3, voffA);
            PG8_BAR; PG8_WAIT_L(0); PG8_MMA(1, 0, At, B0); PG8_BAR; PG8_SCHED;
            PG8_STAGE(PG8_SB(1, 1), b3 + hstep, voffB);
            PG8_WAIT_V(6); PG8_BAR; PG8_MMA(1, 1, At, B1); PG8_BAR;
            }
        }
        if constexpr (ALIGN_EPI) { if (wr == 0) PG8_BAR; }
        E(acc, cur, wr, wc, fr, fq);
        if (!has_next) break;
#pragma unroll
        for (int a = 0; a < 2; ++a)
#pragma unroll
            for (int b = 0; b < 2; ++b)
#pragma unroll
                for (int m = 0; m < 4; ++m)
#pragma unroll
                    for (int n = 0; n < 2; ++n) acc[a][b][m][n] = (f32x4){0.f, 0.f, 0.f, 0.f};
        cur = nxt; cA = nA; cB = nB; ++ui;
        if constexpr (ALIGN_EPI) { if (wr == 1) PG8_BAR; }
    }
    PG8_WAIT_V(0);
    if constexpr (!ALIGN_EPI) { if (wr == 0) PG8_BAR; }
    PG8_BAR;
#undef PG8_SA
#undef PG8_SB
#undef PG8_STAGE
#undef PG8_LDA
#undef PG8_LDB
#undef PG8_MMA
#undef PG8_WAIT_V
#undef PG8_WAIT_L
#undef PG8_BAR
#undef PG8_SCHED
}
}

constexpr int NWAVES = 8, NTHR = 512;
constexpr int D = 2048, SEQ = 8192, DECB = 32, DECS = 4, MS = DECB * DECS;
constexpr int MR = SEQ + MS;
constexpr int MP = 8448;
constexpr int NH = 16, HD = 128, NKV = 4, DFF = 5632, NGU = 2 * DFF;
constexpr int NCHUNK = SEQ / 64;
constexpr int NPAGES = 64, PAGE = 128, NBLK = 32;
constexpr float EPS = 1e-6f;
constexpr float C2 = 0.08838834764831845f * 1.4426950408889634f;

constexpr size_t OY_P = 0, OY_S = OY_P + (size_t)SEQ * D, OST_P = OY_S + (size_t)MS * D, OST_S = OST_P + (size_t)NH * 128 * 128,
                 OK_P = OST_S + (size_t)DECB * NH * 128 * 128, OV_P = OK_P + (size_t)SEQ * 512, OK_S = OV_P + (size_t)SEQ * 512, OV_S = OK_S + (size_t)MS * 512;

constexpr size_t MiB = 1u << 20;
constexpr size_t WS_CTL = 0, CTL_ZERO_BYTES = 1 * MiB;
constexpr size_t WS_WIN = 2 * MiB;
constexpr size_t WS_WOUT = WS_WIN + 32 * MiB;
constexpr size_t WS_WGU0 = WS_WOUT + 8 * MiB;
constexpr size_t WS_WDN0 = WS_WGU0 + 44 * MiB;
constexpr size_t WS_WKVQ = WS_WDN0 + 22 * MiB;
constexpr size_t WS_WO = WS_WKVQ + 12 * MiB;
constexpr size_t WS_WGU1 = WS_WO + 8 * MiB;
constexpr size_t WS_WDN1 = WS_WGU1 + 44 * MiB;
constexpr size_t WS_HB0 = WS_WDN1 + 22 * MiB;
constexpr size_t WS_HB1 = WS_HB0 + 34 * MiB, WS_HB2 = WS_HB1 + 34 * MiB, WS_HB3 = WS_HB2 + 34 * MiB;
constexpr size_t WS_HF1 = WS_HB3 + 34 * MiB;
constexpr size_t WS_HF2 = WS_HF1 + 67 * MiB, WS_HF3 = WS_HF2 + 67 * MiB;
constexpr size_t WS_QG = WS_HF3 + 67 * MiB;
constexpr size_t WS_VG = WS_QG + 34 * MiB;
constexpr size_t WS_GG = WS_VG + 34 * MiB;
constexpr size_t WS_F = WS_GG + 34 * MiB;
constexpr size_t WS_OB = WS_F + 67 * MiB;
constexpr size_t WS_AT = WS_OB + 34 * MiB;
constexpr size_t WS_HM = WS_AT + 34 * MiB;
constexpr size_t WS_U = WS_HM + 92 * MiB;
constexpr size_t WS_SST = WS_U + 64 * MiB;
constexpr size_t WS_DEC = WS_SST + 64 * MiB;
constexpr size_t WS_KRAW = WS_DEC + 2 * MiB;
constexpr size_t WS_VRAW = WS_KRAW + 17 * MiB;
constexpr size_t WS_QRAW = WS_VRAW + 17 * MiB;
constexpr size_t WS_KB = WS_QRAW + 67 * MiB;
constexpr size_t WS_VB = WS_KB + 9 * MiB;
constexpr size_t WS_QB = WS_VB + 9 * MiB;
constexpr size_t WS_KPART = WS_QB + 34 * MiB;
constexpr size_t WS_KMS = WS_KPART + 1 * MiB;
constexpr size_t WS_SUBL = WS_KMS + 2 * MiB;
constexpr size_t WS_SCNT = WS_SUBL + 16 * MiB;
constexpr size_t WS_OSLOT = WS_SCNT + 1 * MiB;
constexpr size_t WS_MLSLOT = WS_OSLOT + 192 * MiB;
constexpr size_t WS_SSLOT = WS_MLSLOT + 3 * MiB;
constexpr size_t WS_FOUT = WS_SSLOT + 34 * MiB;
constexpr size_t WS_END = WS_FOUT + 131 * MiB;
constexpr size_t WS_ORC = WS_END;
constexpr int CW_BAR = 4096;
constexpr int CW_Q0 = 8192;
constexpr int CW_SS0 = 16384, CW_SS1 = CW_SS0 + MP, CW_SS2 = CW_SS1 + MP, CW_SS3 = CW_SS2 + MP;
static_assert((CW_SS3 + MP) * 4 <= (int)CTL_ZERO_BYTES, "ctl");
static_assert(WS_VG - WS_QG == 34 * MiB && WS_GG - WS_VG == 34 * MiB, "Qg|Vg|Gg stride");

constexpr int LDS_BYTES = 160 * 1024;
constexpr int MISC_OFF = LDS_BYTES - 256;

#define GAS __attribute__((address_space(1)))
#define LAS __attribute__((address_space(3)))
typedef unsigned short bf16;
typedef unsigned v4u __attribute__((ext_vector_type(4)));
typedef unsigned v2u __attribute__((ext_vector_type(2)));
typedef float f32x4 __attribute__((ext_vector_type(4)));
typedef float f32x2 __attribute__((ext_vector_type(2)));
typedef short bf16x8 __attribute__((ext_vector_type(8)));
typedef short bf16x4 __attribute__((ext_vector_type(4)));
typedef _Float16 f16;
typedef _Float16 f16x2 __attribute__((ext_vector_type(2)));
__device__ __forceinline__ unsigned pkh2(float lo, float hi) { const f16x2 v = {(f16)lo, (f16)hi}; return __builtin_bit_cast(unsigned, v); }
#define LDS_WAIT() asm volatile("s_waitcnt lgkmcnt(0)" ::: "memory")
__device__ __forceinline__ unsigned f2bf(float f) { unsigned u = __builtin_bit_cast(unsigned, f); return (u + 0x7fffu + ((u >> 16) & 1u)) >> 16; }
__device__ __forceinline__ unsigned pk2(float lo, float hi) { return f2bf(lo) | (f2bf(hi) << 16); }
__device__ __forceinline__ float bf2f(unsigned h) { return __uint_as_float(h << 16); }
__device__ __forceinline__ float silu_f(float x) { return x * __builtin_amdgcn_rcpf(1.0f + __expf(-x)); }
__device__ __forceinline__ float sigm_f(float x) { return __builtin_amdgcn_rcpf(1.0f + __expf(-x)); }
template <int M> __device__ __forceinline__ float shx(float v) { return __uint_as_float((unsigned)__builtin_amdgcn_ds_swizzle((int)__float_as_uint(v), (M << 10) | 0x1f)); }
__device__ __forceinline__ float xadd32(float v) { auto rr = __builtin_amdgcn_permlane32_swap(__float_as_uint(v), __float_as_uint(v), false, false); return __uint_as_float(rr[0]) + __uint_as_float(rr[1]); }
__device__ __forceinline__ float xmax32(float v) { auto rr = __builtin_amdgcn_permlane32_swap(__float_as_uint(v), __float_as_uint(v), false, false); return fmaxf(__uint_as_float(rr[0]), __uint_as_float(rr[1])); }
__device__ __forceinline__ float wave_sum(float v) { v += shx<1>(v); v += shx<2>(v); v += shx<4>(v); v += shx<8>(v); v += shx<16>(v); return xadd32(v); }
#define MFMA16(a, b, c) __builtin_amdgcn_mfma_f32_16x16x32_bf16((a), (b), (c), 0, 0, 0)

#define XB_TMO      128
#define XB_XCNT(j)  (256  + 64 * (j))
#define XB_XSUB(j)  (1280 + 64 * (j))
#define XB_XGEN(j)  (2304 + 64 * (j))
#define XB_TOP      3328
#define XB_TOPGEN   3392
#define XCD_BAR_WORDS 3456
#define XB_SPIN_CAP (1u << 18)
__device__ __forceinline__ unsigned xb_ld(unsigned* p)              { return __hip_atomic_load(p, __ATOMIC_RELAXED, __HIP_MEMORY_SCOPE_AGENT); }
__device__ __forceinline__ unsigned xb_add(unsigned* p, unsigned v) { return __hip_atomic_fetch_add(p, v, __ATOMIC_RELAXED, __HIP_MEMORY_SCOPE_AGENT); }
__device__ __forceinline__ unsigned xb_xcc_id() { return (unsigned)__builtin_amdgcn_s_getreg((3 << 11) | 20) & 0xFu; }
#define XB_SPIN(cond, bar) do { unsigned _sp = 0; while (cond) { __builtin_amdgcn_s_sleep(1); \
    if ((++_sp & 255u) == 0u) { if (xb_ld(&(bar)[XB_TMO])) break; if (_sp > XB_SPIN_CAP) { atomicAdd(&(bar)[XB_TMO], 1u); break; } } } } while (0)
struct XcdBarrier { unsigned* bar; unsigned x; volatile LAS unsigned* st; };
__device__ __forceinline__ XcdBarrier xcd_barrier_post(unsigned* bar, volatile LAS unsigned* st, bool is_t0) {
    XcdBarrier b; b.bar = bar; b.x = xb_xcc_id(); b.st = st;
    if (is_t0) (void)xb_add(&bar[XB_XCNT(b.x)], 1u);
    return b;
}
__device__ __forceinline__ void xcd_barrier_complete(unsigned* bar, unsigned x, unsigned& nloc, unsigned& nx) {
    const unsigned G = gridDim.x * gridDim.y * gridDim.z;
    unsigned sum, cnt, mine, sp = 0u;
    for (;;) {
        sum = 0u; cnt = 0u; mine = 0u;
#pragma unroll
        for (unsigned j = 0; j < 16; ++j) { const unsigned c = xb_ld(&bar[XB_XCNT(j)]); sum += c; cnt += (c > 0u) ? 1u : 0u; mine = (j == x) ? c : mine; }
        if (sum == G) break;
        __builtin_amdgcn_s_sleep(1);
        if ((++sp & 255u) == 0u) { if (xb_ld(&bar[XB_TMO])) break; if (sp > XB_SPIN_CAP) { atomicAdd(&bar[XB_TMO], 1u); break; } }
    }
    nloc = mine > 0u ? mine : 1u; nx = cnt > 0u ? cnt : 1u;
}
__device__ __forceinline__ void xcd_barrier(const XcdBarrier& b, bool is_t0) {
    asm volatile("s_waitcnt vmcnt(0)" ::: "memory");
    __syncthreads();
    if (is_t0) {
        unsigned* bar = b.bar;
        __builtin_amdgcn_s_waitcnt(0);
        unsigned nloc = b.st[0], nx = b.st[1];
        if (nloc == 0u) { xcd_barrier_complete(bar, b.x, nloc, nx); b.st[0] = nloc; b.st[1] = nx; }
        const unsigned old = xb_add(&bar[XB_XSUB(b.x)], 1u);
        const unsigned gen = old / nloc;
        if (old + 1u == (gen + 1u) * nloc) {
            __builtin_amdgcn_fence(__ATOMIC_RELEASE, "agent");
            asm volatile("s_waitcnt vmcnt(0)" ::: "memory");
            const unsigned og = xb_add(&bar[XB_TOP], 1u);
            const unsigned tg = og / nx;
            if (og + 1u == (tg + 1u) * nx) xb_add(&bar[XB_TOPGEN], 1u);
            else XB_SPIN(xb_ld(&bar[XB_TOPGEN]) == tg, bar);
            __builtin_amdgcn_fence(__ATOMIC_ACQUIRE, "agent");
            xb_add(&bar[XB_XGEN(b.x)], 1u);
            asm volatile("s_waitcnt vmcnt(0)" ::: "memory");
        } else {
            XB_SPIN(xb_ld(&bar[XB_XGEN(b.x)]) == gen, bar);
            __builtin_amdgcn_fence(__ATOMIC_ACQUIRE, "agent");
            asm volatile("s_waitcnt vmcnt(0)" ::: "memory");
        }
    }
    __syncthreads();
}

using pg8::Unit; using pg8::cvt_pk_bf16;
struct EpiIn {
    static constexpr bool PERM = true;
    const float* ss; const float* lbl; bf16* Qg; f16* F;
    __device__ __forceinline__ void operator()(const f32x4 (&acc)[2][2][4][2], const Unit& u, int wr, int wc, int fr, int fq) const {
        const int seg = u.pn >> 3; const int col0 = (u.pn & 7) * 256 + wc * 32 + 8 * fq; const int rowb = u.pm * 256 + wr * 64;
        float lb[2][8];
        if (seg == 1) {
#pragma unroll
            for (int bj = 0; bj < 2; ++bj)
#pragma unroll
                for (int j = 0; j < 8; ++j) { const int c = col0 + bj * 128 + j; lb[bj][j] = __builtin_amdgcn_rcpf(1.0f + __expf(lbl[D + c] - lbl[c])); }
        }
        float rs[2][4];
#pragma unroll
        for (int ai = 0; ai < 2; ++ai)
#pragma unroll
            for (int m = 0; m < 4; ++m) rs[ai][m] = ss[rowb + ai * 128 + m * 16 + fr];
#pragma unroll
        for (int ai = 0; ai < 2; ++ai)
#pragma unroll
            for (int m = 0; m < 4; ++m) asm volatile("" : "+v"(rs[ai][m]));
#pragma unroll
        for (int ai = 0; ai < 2; ++ai)
#pragma unroll
            for (int m = 0; m < 4; ++m) {
                const int rb = rowb + ai * 128 + m * 16; if (rb >= MR) continue;
                const int row = rb + fr; const float r = rsqrtf(rs[ai][m] * (1.0f / D) + EPS);
#pragma unroll
                for (int bj = 0; bj < 2; ++bj) {
                    f32x4 v0 = acc[ai][bj][m][0] * r, v1 = acc[ai][bj][m][1] * r; const size_t off = (size_t)row * D + col0 + bj * 128;
                    if (seg == 1) {
                        f32x4 o0, o1;
#pragma unroll
                        for (int j = 0; j < 4; ++j) { o0[j] = (1.0f - lb[bj][j]) * sigm_f(-v0[j]); o1[j] = (1.0f - lb[bj][4 + j]) * sigm_f(-v1[j]); }
                        { v4u w; w.x = pkh2(o0[0], o0[1]); w.y = pkh2(o0[2], o0[3]); w.z = pkh2(o1[0], o1[1]); w.w = pkh2(o1[2], o1[3]); *(v4u*)(F + off) = w; }
                    } else {
                        if (seg != 2) {
#pragma unroll
                            for (int j = 0; j < 4; ++j) { v0[j] = silu_f(v0[j]); v1[j] = silu_f(v1[j]); }
                        }
                        v4u w; w.x = cvt_pk_bf16(v0[0], v0[1]); w.y = cvt_pk_bf16(v0[2], v0[3]); w.z = cvt_pk_bf16(v1[0], v1[1]); w.w = cvt_pk_bf16(v1[2], v1[3]);
                        const size_t dsel = (seg == 0) ? 0 : ((seg == 2) ? 1 : 2);
                        *(v4u*)(Qg + dsel * (size_t)(17 * MiB) + off) = w;
                    }
                }
            }
    }
    __device__ __forceinline__ void tail(int row, int col, f32x4 v) const {
        const int seg = col >> 11, c = col & 2047; const float r = rsqrtf(ss[row] * (1.0f / D) + EPS); v = v * r; const size_t off = (size_t)row * D + c;
        if (seg == 1) { f32x4 o;
#pragma unroll
            for (int j = 0; j < 4; ++j) { const float lbv = __builtin_amdgcn_rcpf(1.0f + __expf(lbl[D + c + j] - lbl[c + j])); o[j] = (1.0f - lbv) * sigm_f(-v[j]); }
            { v2u w; w.x = pkh2(o[0], o[1]); w.y = pkh2(o[2], o[3]); *(v2u*)(F + off) = w; }
        } else {
            if (seg != 2) {
#pragma unroll
                for (int j = 0; j < 4; ++j) v[j] = silu_f(v[j]);
            }
            v2u w; w.x = cvt_pk_bf16(v[0], v[1]); w.y = cvt_pk_bf16(v[2], v[3]);
            const size_t dsel = (seg == 0) ? 0 : ((seg == 2) ? 1 : 2);
            *(v2u*)(Qg + dsel * (size_t)(17 * MiB) + off) = w;
        }
    }
};

template <int MODE> struct EpiRes {
    static constexpr bool PERM = true;
    const bf16* rb; float* o0; float* o1; bf16* hb; float* ss;
    __device__ __forceinline__ void operator()(const f32x4 (&acc)[2][2][4][2], const Unit& u, int wr, int wc, int fr, int fq) const {
        const int col0 = u.pn * 256 + wc * 32 + 8 * fq; const int rowb = u.pm * 256 + wr * 64;
        v4u rw[2][4][2];
#pragma unroll
        for (int ai = 0; ai < 2; ++ai)
#pragma unroll
            for (int m = 0; m < 4; ++m)
#pragma unroll
                for (int bj = 0; bj < 2; ++bj) rw[ai][m][bj] = *(const v4u*)(rb + (size_t)(rowb + ai * 128 + m * 16 + fr) * D + col0 + bj * 128);
#pragma unroll
        for (int ai = 0; ai < 2; ++ai)
#pragma unroll
            for (int m = 0; m < 4; ++m)
#pragma unroll
                for (int bj = 0; bj < 2; ++bj) asm volatile("" : "+v"(rw[ai][m][bj]));
#pragma unroll
        for (int ai = 0; ai < 2; ++ai)
#pragma unroll
            for (int m = 0; m < 4; ++m) {
                const int row = rowb + ai * 128 + m * 16 + fr;
                float* op = (MODE == 2) ? o0 + (size_t)row * D : nullptr;
                float sq = 0.f;
#pragma unroll
                for (int bj = 0; bj < 2; ++bj) {
                    const int c = col0 + bj * 128;
                    const v4u w_ = rw[ai][m][bj];
                    f32x4 a0 = {bf2f(w_.x & 0xffffu), bf2f(w_.x >> 16), bf2f(w_.y & 0xffffu), bf2f(w_.y >> 16)}, a1 = {bf2f(w_.z & 0xffffu), bf2f(w_.z >> 16), bf2f(w_.w & 0xffffu), bf2f(w_.w >> 16)};
                    a0 += acc[ai][bj][m][0]; a1 += acc[ai][bj][m][1];
                    if (MODE == 2) { __builtin_nontemporal_store(a0, (f32x4*)(op + c)); __builtin_nontemporal_store(a1, (f32x4*)(op + c + 4)); }
                    else {
                        v4u w; w.x = cvt_pk_bf16(a0[0], a0[1]); w.y = cvt_pk_bf16(a0[2], a0[3]); w.z = cvt_pk_bf16(a1[0], a1[1]); w.w = cvt_pk_bf16(a1[2], a1[3]);
                        *(v4u*)(hb + (size_t)row * D + c) = w;
                        sq += (a0[0] * a0[0] + a0[1] * a0[1]) + (a0[2] * a0[2] + a0[3] * a0[3]) + (a1[0] * a1[0] + a1[1] * a1[1]) + (a1[2] * a1[2] + a1[3] * a1[3]);
                    }
                }
                if (MODE != 2) { sq += shx<16>(sq); sq = xadd32(sq); if (fq == 0) atomicAdd(ss + row, sq); }
            }
    }
    __device__ __forceinline__ void tail(int row, int col, f32x4 v, int fq) const {
        const v2u rw = *(const v2u*)(rb + (size_t)row * D + col);
        f32x4 a0 = {bf2f(rw.x & 0xffffu), bf2f(rw.x >> 16), bf2f(rw.y & 0xffffu), bf2f(rw.y >> 16)}; a0 += v;
        if (MODE == 2) { *(f32x4*)(o1 + (size_t)(row - SEQ) * D + col) = a0; }
        else {
            v2u w; w.x = cvt_pk_bf16(a0[0], a0[1]); w.y = cvt_pk_bf16(a0[2], a0[3]); *(v2u*)(hb + (size_t)row * D + col) = w;
            float sq = (a0[0] * a0[0] + a0[1] * a0[1]) + (a0[2] * a0[2] + a0[3] * a0[3]);
            sq += shx<16>(sq); sq = xadd32(sq); if (fq == 0) atomicAdd(ss + row, sq);
        }
    }
};
struct EpiGU {
    static constexpr bool PERM = true;
    const float* ss; bf16* hm;
    __device__ __forceinline__ void operator()(const f32x4 (&acc)[2][2][4][2], const Unit& u, int wr, int wc, int fr, int fq) const {
        const int j0 = u.pn * 128 + wc * 32 + 8 * fq; const int rowb = u.pm * 256 + wr * 64;
        float rs[2][4];
#pragma unroll
        for (int ai = 0; ai < 2; ++ai)
#pragma unroll
            for (int m = 0; m < 4; ++m) rs[ai][m] = ss[rowb + ai * 128 + m * 16 + fr];
#pragma unroll
        for (int ai = 0; ai < 2; ++ai)
#pragma unroll
            for (int m = 0; m < 4; ++m) asm volatile("" : "+v"(rs[ai][m]));
#pragma unroll
        for (int ai = 0; ai < 2; ++ai)
#pragma unroll
            for (int m = 0; m < 4; ++m) {
                const int rb = rowb + ai * 128 + m * 16; if (rb >= MR) continue;
                const int row = rb + fr; const float r = rsqrtf(rs[ai][m] * (1.0f / D) + EPS);
                float o[8];
#pragma unroll
                for (int n = 0; n < 2; ++n)
#pragma unroll
                    for (int j = 0; j < 4; ++j) o[4 * n + j] = silu_f(acc[ai][0][m][n][j] * r) * (acc[ai][1][m][n][j] * r);
                v4u w; w.x = cvt_pk_bf16(o[0], o[1]); w.y = cvt_pk_bf16(o[2], o[3]); w.z = cvt_pk_bf16(o[4], o[5]); w.w = cvt_pk_bf16(o[6], o[7]);
                *(v4u*)(hm + (size_t)row * DFF + j0) = w;
            }
    }
};
struct EpiKVQ {
    static constexpr bool PERM = true;
    const float* ss; unsigned char* ws; float* outp; const float* kn; const float* qn; LAS unsigned char* xl;
    __device__ __forceinline__ void operator()(const f32x4 (&acc)[2][2][4][2], const Unit& u, int wr, int wc, int fr, int fq) const {
        const int c0 = wc * 32 + 8 * fq; const int rowb = u.pm * 256 + wr * 64;
        bf16* Kb_ = (bf16*)(ws + WS_KB); bf16* Vb_ = (bf16*)(ws + WS_VB); bf16* Qb_ = (bf16*)(ws + WS_QB); float* Kp_ = (float*)(ws + WS_KPART);
        float rs[2][4];
#pragma unroll
        for (int ai = 0; ai < 2; ++ai)
#pragma unroll
            for (int m = 0; m < 4; ++m) rs[ai][m] = rsqrtf(ss[rowb + ai * 128 + m * 16 + fr] * (1.0f / D) + EPS);
        if (u.pn == 2 || u.pn == 3) {
#pragma unroll
            for (int ai = 0; ai < 2; ++ai)
#pragma unroll
                for (int m = 0; m < 4; ++m) {
                    const int rb = rowb + ai * 128 + m * 16; if (rb >= MR) continue;
                    const int row = rb + fr; const float r = rs[ai][m];
                    float* vo = outp + ((row < SEQ) ? OV_P + (size_t)row * 512 : OV_S + (size_t)(row - SEQ) * 512);
#pragma unroll
                    for (int bj = 0; bj < 2; ++bj) { const int col = (u.pn - 2) * 256 + bj * 128 + c0; const f32x4 v0 = acc[ai][bj][m][0] * r, v1 = acc[ai][bj][m][1] * r;
                        __builtin_nontemporal_store(v0, (f32x4*)(vo + col)); __builtin_nontemporal_store(v1, (f32x4*)(vo + col + 4));
                        v4u w; w.x = cvt_pk_bf16(v0[0], v0[1]); w.y = cvt_pk_bf16(v0[2], v0[3]); w.z = cvt_pk_bf16(v1[0], v1[1]); w.w = cvt_pk_bf16(v1[2], v1[3]);
                        *(v4u*)(Vb_ + (size_t)row * 512 + col) = w; }
                }
            return;
        }
        const bool isk = u.pn < 2;
        LAS float* P = (LAS float*)xl;
        LAS float* CS = (LAS float*)(xl + 8192);
#pragma unroll
        for (int ai = 0; ai < 2; ++ai)
#pragma unroll
            for (int m = 0; m < 4; ++m) {
                const int rl = ai * 128 + wr * 64 + m * 16 + fr; const float r = rs[ai][m];
#pragma unroll
                for (int bj = 0; bj < 2; ++bj) { const f32x4 v0 = acc[ai][bj][m][0] * r, v1 = acc[ai][bj][m][1] * r;
                    float sq = (v0[0] * v0[0] + v0[1] * v0[1]) + (v0[2] * v0[2] + v0[3] * v0[3]) + (v1[0] * v1[0] + v1[1] * v1[1]) + (v1[2] * v1[2] + v1[3] * v1[3]);
                    sq += shx<16>(sq); sq = xadd32(sq);
                    if (fq == 0) P[(rl * 2 + bj) * 4 + wc] = sq; }
            }
        asm volatile("s_waitcnt lgkmcnt(0)" ::: "memory"); __builtin_amdgcn_s_barrier(); asm volatile("" ::: "memory");
        float cs[2][8];
#pragma unroll
        for (int bj = 0; bj < 2; ++bj)
#pragma unroll
            for (int j = 0; j < 8; ++j) cs[bj][j] = 0.f;
        const float* gp = (isk ? kn : qn) + c0; const f32x4 g0 = *(const f32x4*)gp, g1 = *(const f32x4*)(gp + 4);
#pragma unroll
        for (int ai = 0; ai < 2; ++ai)
#pragma unroll
            for (int m = 0; m < 4; ++m) {
                const int rb = rowb + ai * 128 + m * 16; if (rb >= MR) continue;
                const int rl = ai * 128 + wr * 64 + m * 16 + fr; const int row = rb + fr; const float r = rs[ai][m];
#pragma unroll
                for (int bj = 0; bj < 2; ++bj) {
                    const f32x4 pp = *(const LAS f32x4*)(P + (rl * 2 + bj) * 4);
                    const float rh = rsqrtf(((pp[0] + pp[1]) + (pp[2] + pp[3])) * (1.0f / 128.0f) + EPS) * (isk ? 1.0f : C2);
                    const f32x4 n0 = acc[ai][bj][m][0] * (r * rh) * g0, n1 = acc[ai][bj][m][1] * (r * rh) * g1;
                    v4u w; w.x = cvt_pk_bf16(n0[0], n0[1]); w.y = cvt_pk_bf16(n0[2], n0[3]); w.z = cvt_pk_bf16(n1[0], n1[1]); w.w = cvt_pk_bf16(n1[2], n1[3]);
                    if (isk) {
                        const int col = u.pn * 256 + bj * 128 + c0;
                        float* ko = outp + ((row < SEQ) ? OK_P + (size_t)row * 512 : OK_S + (size_t)(row - SEQ) * 512) + col;
                        __builtin_nontemporal_store(n0, (f32x4*)ko); __builtin_nontemporal_store(n1, (f32x4*)(ko + 4));
                        *(v4u*)(Kb_ + (size_t)row * 512 + col) = w;
#pragma unroll
                        for (int j = 0; j < 4; ++j) { cs[bj][j] += n0[j]; cs[bj][4 + j] += n1[j]; }
                    } else {
                        *(v4u*)(Qb_ + (size_t)row * D + (u.pn - 4) * 256 + bj * 128 + c0) = w;
                    }
                }
            }
        if (isk && u.pm < SEQ / 256) {
#pragma unroll
            for (int bj = 0; bj < 2; ++bj)
#pragma unroll
                for (int j = 0; j < 8; ++j) { float v = cs[bj][j]; v += shx<1>(v); v += shx<2>(v); v += shx<4>(v); v += shx<8>(v); if (fr == 0) CS[wr * 256 + bj * 128 + c0 + j] = v; }
            asm volatile("s_waitcnt lgkmcnt(0)" ::: "memory"); __builtin_amdgcn_s_barrier(); asm volatile("" ::: "memory");
            const int t = (wr * 4 + wc) * 64 + fq * 16 + fr;
            if (t < 256) Kp_[(size_t)u.pm * 512 + u.pn * 256 + t] = CS[t] + CS[256 + t];
        }
    }
};

struct Args { const void* in[21]; float* out; unsigned char* ws; };

__device__ __forceinline__ void p0_transpose_item(const float* W, int K, int N, bf16* WT, int row_off, int mode, const float* gain, LAS float* scr, int item, int lane) {
    const int nblk = N / 64, kb = item / nblk, nb = item % nblk, k0 = 64 * kb, n0 = 64 * nb;
    const int r = lane >> 4, c4 = lane & 15;
#pragma unroll
    for (int i = 0; i < 16; ++i) { const int kk = 4 * i + r; f32x4 w = __builtin_nontemporal_load((const f32x4*)(W + (size_t)(k0 + kk) * N + n0 + 4 * c4)); if (gain) w *= gain[k0 + kk]; *(LAS f32x4*)(scr + kk * 68 + 4 * c4) = w; }
    LDS_WAIT(); asm volatile("" ::: "memory");
    const int c = lane & 7;
    int d0;
    if (mode == 0) d0 = row_off + n0;
    else { const int j = (n0 < DFF) ? n0 : n0 - DFF; d0 = 256 * (j >> 7) + (j & 127) + ((n0 < DFF) ? 0 : 128); }
#pragma unroll
    for (int j = 0; j < 8; ++j) { const int n = (lane >> 3) + 8 * j; const LAS float* sp = scr + (8 * c) * 68 + n;
        v4u o; o.x = pk2(sp[0 * 68], sp[1 * 68]); o.y = pk2(sp[2 * 68], sp[3 * 68]); o.z = pk2(sp[4 * 68], sp[5 * 68]); o.w = pk2(sp[6 * 68], sp[7 * 68]);
        *(v4u*)(WT + (size_t)(d0 + n) * K + k0 + 8 * c) = o; }
    LDS_WAIT(); asm volatile("" ::: "memory");
}

constexpr int KS_P = 144;
constexpr int KS_BYTES = 256 * KS_P * 2;
typedef short v4i16_t __attribute__((ext_vector_type(4)));
__device__ __forceinline__ v2u tr_read(const LAS bf16* p) { return __builtin_bit_cast(v2u, __builtin_amdgcn_ds_read_tr16_b64_v4i16((LAS v4i16_t*)p)); }
template <int NKT> __device__ __forceinline__ void attn_scores(const LAS bf16* Ks, const bf16x8 (&qf)[4], f32x4 (&acc)[16], int nkt, int fr, int fq) {
#pragma unroll
    for (int kt = 0; kt < NKT; ++kt) {
        acc[kt] = (f32x4){0.f, 0.f, 0.f, 0.f};
        if (kt < nkt) {
#pragma unroll
            for (int ks = 0; ks < 4; ++ks) { const bf16x8 a = *(const LAS bf16x8*)(Ks + (16 * kt + fr) * KS_P + 32 * ks + 8 * fq); acc[kt] = MFMA16(a, qf[ks], acc[kt]); }
        }
    }
}
__device__ __forceinline__ void attn_pv(const LAS bf16* Vr, const f32x4 (&acc)[16], f32x4 (&O)[8], int nj, int fr, int fq) {
#pragma unroll
    for (int j = 0; j < 8; ++j) {
        if (j < nj) {
            v4u pw; pw.x = cvt_pk_bf16(acc[2 * j][0], acc[2 * j][1]); pw.y = cvt_pk_bf16(acc[2 * j][2], acc[2 * j][3]); pw.z = cvt_pk_bf16(acc[2 * j + 1][0], acc[2 * j + 1][1]); pw.w = cvt_pk_bf16(acc[2 * j + 1][2], acc[2 * j + 1][3]);
            const bf16x8 pf = __builtin_bit_cast(bf16x8, pw);
            const LAS bf16* vb = Vr + (32 * j + 4 * fq + (fr >> 2)) * KS_P + 4 * (fr & 3);
#pragma unroll
            for (int vt = 0; vt < 8; ++vt) {
                const v2u lo = tr_read(vb + 16 * vt), hi = tr_read(vb + 16 * KS_P + 16 * vt);
                const v4u aw = {lo.x, lo.y, hi.x, hi.y};
                O[vt] = MFMA16(__builtin_bit_cast(bf16x8, aw), pf, O[vt]);
            }
        }
    }
}

struct TrItem { const float* W; const float* gain; bf16* WT; int K, N, row_off, item; };
__device__ __forceinline__ void tr_load(const TrItem& t, f32x4 (&w)[16], float (&g)[16], int lane) {
    const int nblk = t.N / 64, kb = t.item / nblk, nb = t.item - kb * nblk, k0 = 64 * kb, n0 = 64 * nb; const int r = lane >> 4, c4 = lane & 15;
#pragma unroll
    for (int i = 0; i < 16; ++i) { const int kk = 4 * i + r; w[i] = __builtin_nontemporal_load((const f32x4*)(t.W + (size_t)(k0 + kk) * t.N + n0 + 4 * c4)); g[i] = t.gain ? t.gain[k0 + kk] : 1.0f; }
}
__device__ __forceinline__ void tr_store(const TrItem& t, const f32x4 (&w)[16], const float (&g)[16], LAS float* scr, int lane) {
    const int nblk = t.N / 64, kb = t.item / nblk, nb = t.item - kb * nblk, k0 = 64 * kb, n0 = 64 * nb; const int r = lane >> 4, c4 = lane & 15;
#pragma unroll
    for (int i = 0; i < 16; ++i) { const int kk = 4 * i + r; *(LAS f32x4*)(scr + kk * 68 + 4 * c4) = w[i] * g[i]; }
    LDS_WAIT(); asm volatile("" ::: "memory");
    const int c = lane & 7; const int d0 = t.row_off + n0;
#pragma unroll
    for (int j = 0; j < 8; ++j) { const int n = (lane >> 3) + 8 * j; const LAS float* sp = scr + (8 * c) * 68 + n;
        v4u o; o.x = pk2(sp[0 * 68], sp[1 * 68]); o.y = pk2(sp[2 * 68], sp[3 * 68]); o.z = pk2(sp[4 * 68], sp[5 * 68]); o.w = pk2(sp[6 * 68], sp[7 * 68]);
        *(v4u*)(t.WT + (size_t)(d0 + n) * t.K + k0 + 8 * c) = o; }
    LDS_WAIT(); asm volatile("" ::: "memory");
}

template <int NT, int K> __device__ __forceinline__ void tail_gemm(LAS unsigned char* lds, const bf16* A, const bf16* Bt, int n0, int rowhalf, f32x4 (&acc)[NT], int tidx, int rsel) {
    int tid_o = tidx; asm volatile("" : "+v"(tid_o));
    const int tid = tid_o, lane = tid & 63, wave = __builtin_amdgcn_readfirstlane(tid >> 6), fr = lane & 15, fq = lane >> 4;
    const int rt = wave & 3, kh = wave >> 2; constexpr int Kh = K >> 1;
    constexpr int KC = (K == 2048) ? (NT == 2 ? 512 : 1024) : 1408;
    constexpr int NCH = Kh / KC, PB = KC + 8, UPR = KC >> 3, NS = KC >> 7;
    const int khk = kh ^ (rsel & 1), flip = (NCH > 1) ? ((rsel >> 1) & 1) : 0;
    constexpr int NU = 2 * 16 * NT * UPR, NIT = NU / NTHR;
    static_assert(NU % NTHR == 0, "tail B staging");
    LAS bf16* Bs = (LAS bf16*)(lds + 8192);
    const int lq = lane >> 4, lu = lane & 15;
    const bf16* ap = A + (size_t)(64 * rowhalf + 16 * rt + lq) * K + khk * Kh + 8 * lu;
    LAS unsigned char* stg = lds + 102400 + wave * 4096;
    int wof[4], rof[4];
#pragma unroll
    for (int j = 0; j < 4; ++j) { wof[j] = (4 * j + lq) * 256 + ((lu ^ (4 * j + lq)) << 4); rof[j] = fr * 256 + (((4 * j + fq) ^ fr) << 4); }
    const LAS bf16* bl = Bs + (khk * 16 * NT + fr) * PB + 8 * fq;
#pragma unroll
    for (int t = 0; t < NT; ++t) acc[t] = (f32x4){0.f, 0.f, 0.f, 0.f};
#define TG_LDA(a_, k0_) do { _Pragma("unroll") for (int s_ = 0; s_ < 4; ++s_) a_[s_] = *(const bf16x8*)(ap + (size_t)(4 * s_) * K + (k0_)); } while (0)
#define TG_MMA(a_, kl_) do { _Pragma("unroll") for (int s_ = 0; s_ < 4; ++s_) *(LAS bf16x8*)(stg + wof[s_]) = a_[s_]; asm volatile("" ::: "memory"); bf16x8 ar_[4]; \
        _Pragma("unroll") for (int s_ = 0; s_ < 4; ++s_) ar_[s_] = *(const LAS bf16x8*)(stg + rof[s_]); asm volatile("" ::: "memory"); \
        _Pragma("unroll") for (int s_ = 0; s_ < 4; ++s_) { _Pragma("unroll") for (int t_ = 0; t_ < NT; ++t_) { \
        const bf16x8 b_ = *(const LAS bf16x8*)(bl + t_ * 16 * PB + (kl_) + 32 * s_); acc[t_] = MFMA16(b_, ar_[s_], acc[t_]); } } } while (0)
#define TG_LDB(kb_) do { _Pragma("unroll") for (int i_ = 0; i_ < NIT; ++i_) { const int u_ = tid + i_ * NTHR, r2_ = u_ / UPR, kc_ = u_ - r2_ * UPR; const int khh_ = (r2_ >= 16 * NT) ? 1 : 0, row_ = r2_ - khh_ * 16 * NT; \
        breg[i_] = *(const v4u*)(Bt + (size_t)(n0 + row_) * K + khh_ * Kh + (kb_) + 8 * kc_); } } while (0)
#define TG_STB() do { _Pragma("unroll") for (int i_ = 0; i_ < NIT; ++i_) { const int u_ = tid + i_ * NTHR, r2_ = u_ / UPR, kc_ = u_ - r2_ * UPR; *(LAS v4u*)(Bs + r2_ * PB + 8 * kc_) = breg[i_]; } } while (0)
    v4u breg[NIT];
    TG_LDB(flip * KC);
#pragma unroll
    for (int ch = 0; ch < NCH; ++ch) {
        const int kb = (ch ^ flip) * KC;
        bf16x8 a0[4], a1[4], a2[4], a3[4];
        TG_LDA(a0, kb); TG_LDA(a1, kb + 128); TG_LDA(a2, kb + 256); TG_LDA(a3, kb + 384);
        TG_STB();
        __syncthreads();
        if (ch + 1 < NCH) TG_LDB(((ch + 1) ^ flip) * KC);
        for (int st = 0; st < NS; st += 4) {
            TG_MMA(a0, 128 * st);           if (st + 4 < NS) TG_LDA(a0, kb + 128 * (st + 4));
            if (st + 1 < NS) { TG_MMA(a1, 128 * (st + 1)); if (st + 5 < NS) TG_LDA(a1, kb + 128 * (st + 5)); }
            if (st + 2 < NS) { TG_MMA(a2, 128 * (st + 2)); if (st + 6 < NS) TG_LDA(a2, kb + 128 * (st + 6)); }
            if (st + 3 < NS) { TG_MMA(a3, 128 * (st + 3)); if (st + 7 < NS) TG_LDA(a3, kb + 128 * (st + 7)); }
        }
        __syncthreads();
    }
#undef TG_LDA
#undef TG_MMA
#undef TG_LDB
#undef TG_STB
    LAS f32x4* red = (LAS f32x4*)lds;
    if (kh == 1) {
#pragma unroll
        for (int t = 0; t < NT; ++t) red[(t * 4 + rt) * 64 + lane] = acc[t];
    }
    __syncthreads();
    if (kh == 0) {
#pragma unroll
        for (int t = 0; t < NT; ++t) acc[t] += red[(t * 4 + rt) * 64 + lane];
    }
    __syncthreads();
}

template <int UNR = 16> __device__ __forceinline__ void kmean_items(LAS unsigned char* lds, const float* cache_k_, const int* ptab_, float* Kms_, int i0, int i1, int c0, int cn, int tidx) {
    int tid_o = tidx; asm volatile("" : "+v"(tid_o)); const int tid = tid_o;
    const int me = (int)blockIdx.x - c0; if (me < 0 || me >= cn) return;
    LAS f32x4* redk = (LAS f32x4*)(lds);
    for (int item = i0 + me; item < i1; item += cn) {
        const int b = item >> 5, n = item & 31; const int c4 = tid & 127, rg = tid >> 7;
        f32x4 a = {0.f, 0.f, 0.f, 0.f};
#pragma unroll
        for (int hp = 0; hp < 2; ++hp) { const int page = ptab_[b * NPAGES + 2 * n + hp]; const f32x4* pp = (const f32x4*)(cache_k_ + (size_t)page * PAGE * 512) + c4;
#pragma unroll UNR
            for (int r = rg; r < 128; r += 4) a += __builtin_nontemporal_load(pp + (size_t)r * 128); }
        redk[rg * 128 + c4] = a;
        __syncthreads();
        if (tid < 128) { const f32x4 s4 = (redk[tid] + redk[128 + tid]) + (redk[256 + tid] + redk[384 + tid]); *(f32x4*)(Kms_ + (size_t)item * 512 + 4 * tid) = s4 * (1.0f / 256.0f); }
        __syncthreads();
    }
}

__global__ void __launch_bounds__(NTHR, 2) yoco_fwd(Args args) {
    extern __shared__ __attribute__((aligned(16))) unsigned char lds_raw[];
    LAS unsigned char* lds = (LAS unsigned char*)lds_raw;
#define TIDS int tid_o = TIDX; asm volatile("" : "+v"(tid_o)); const int tid = tid_o, lane = tid & 63, wave = __builtin_amdgcn_readfirstlane(tid >> 6), fr = lane & 15, fq = lane >> 4; (void)fr; (void)fq; (void)wave; (void)lane; (void)tid
    const int G = gridDim.x, bid = blockIdx.x;
    unsigned char* ws = args.ws;
    unsigned* ctl = (unsigned*)(ws + WS_CTL);
    volatile LAS unsigned* MISC = (volatile LAS unsigned*)(lds + MISC_OFF);
    const int wave_sg = __builtin_amdgcn_readfirstlane((int)threadIdx.x & ~63);
#define TIDX (wave_sg + lane_id())
#define IS_T0 ((wave_sg == 0) && (lane_id() == 0))
    if (TIDX < 64) MISC[TIDX] = 0u;
    __syncthreads();
    XcdBarrier bar = xcd_barrier_post(ctl + CW_BAR, MISC + 8, IS_T0);
#ifdef PROF_A
    int n_stamp = 0;
#define STAMP() do { if (blockIdx.x == 0 && IS_T0) MISC[16 + n_stamp] = (unsigned)__builtin_amdgcn_s_memrealtime(); ++n_stamp; } while (0)
#define TNOW() ((unsigned)__builtin_amdgcn_s_memrealtime())
#define TACC(k, t0) do { if (blockIdx.x == 0 && IS_T0) MISC[40 + (k)] += TNOW() - (t0); } while (0)
#define PVAL(a0, a1) (((a0) >= 100) ? MISC[40 + (a0) - 100] : (MISC[16 + (a1)] - MISC[16 + (a0)]))
#else
#define STAMP() do {} while (0)
#define TNOW() 0u
#define TACC(k, t0) do { (void)(t0); } while (0)
#endif
    STAMP();

#define x_p ((const float*)args.in[0])
#define x_s ((const float*)args.in[1])
#define st_in ((const float*)args.in[2])
#define cache_k ((const float*)args.in[3])
#define cache_v ((const float*)args.in[4])
#define ptab ((const int*)args.in[5])
#define norm_mix_a ((const float*)args.in[6])
#define w_in ((const float*)args.in[7])
#define lbl ((const float*)args.in[8])
#define onorm ((const float*)args.in[9])
#define w_out ((const float*)args.in[10])
#define norm_kv ((const float*)args.in[11])
#define w_kv ((const float*)args.in[12])
#define k_norm ((const float*)args.in[13])
#define norm_mix_b ((const float*)args.in[14])
#define w_q ((const float*)args.in[15])
#define q_norm ((const float*)args.in[16])
#define w_o ((const float*)args.in[17])
#define norm_ffn ((const float*)args.in[18])
#define w_gu ((const float*)args.in[19])
#define w_dn ((const float*)args.in[20])
#define Win_t ((bf16*)(ws + WS_WIN))
#define Wout_t ((bf16*)(ws + WS_WOUT))
#define Wgu0_t ((bf16*)(ws + WS_WGU0))
#define Wdn0_t ((bf16*)(ws + WS_WDN0))
#define Wkvq_t ((bf16*)(ws + WS_WKVQ))
#define Wo_t ((bf16*)(ws + WS_WO))
#define Wgu1_t ((bf16*)(ws + WS_WGU1))
#define Wdn1_t ((bf16*)(ws + WS_WDN1))
#define Hb0 ((bf16*)(ws + WS_HB0))
#define Hb1 ((bf16*)(ws + WS_HB1))
#define Hb2 ((bf16*)(ws + WS_HB2))
#define Hb3 ((bf16*)(ws + WS_HB3))
#define Hf1 ((float*)(ws + WS_HF1))
#define Hf2 ((float*)(ws + WS_HF2))
#define Hf3 ((float*)(ws + WS_HF3))
#define Qg ((bf16*)(ws + WS_QG))
#define Vg ((bf16*)(ws + WS_VG))
#define Gg ((bf16*)(ws + WS_GG))
#define Ff ((f16*)(ws + WS_F))
#define Ob ((bf16*)(ws + WS_OB))
#define At ((bf16*)(ws + WS_AT))
#define Hm ((bf16*)(ws + WS_HM))
#define Ug ((float*)(ws + WS_U))
#define Sg0 ((float*)(ws + WS_SST))
#define Dg ((float*)(ws + WS_DEC))
#define Kraw ((float*)(ws + WS_KRAW))
#define Vraw ((float*)(ws + WS_VRAW))
#define Qraw ((bf16*)(ws + WS_QRAW))
#define Kb ((bf16*)(ws + WS_KB))
#define Vb ((bf16*)(ws + WS_VB))
#define Qb ((bf16*)(ws + WS_QB))
#define Kpart ((float*)(ws + WS_KPART))
#define Kms ((float*)(ws + WS_KMS))
#define Subl ((unsigned*)(ws + WS_SUBL))
#define Scnt ((unsigned*)(ws + WS_SCNT))
#define Sels ((unsigned*)(ws + WS_SCNT + 256 * 1024))
#define Oslot ((bf16*)(ws + WS_OSLOT))
#define MLslot ((float*)(ws + WS_MLSLOT))
#define Sslot ((float*)(ws + WS_SSLOT))
#define ss0 ((float*)(ctl + CW_SS0))
#define ss1 ((float*)(ctl + CW_SS1))
#define ss2 ((float*)(ctl + CW_SS2))
#define ss3 ((float*)(ctl + CW_SS3))
#define out (args.out)
    {
        TIDS;
        LAS float* scr = (LAS float*)(lds + wave * 17408);
        const int gw = bid * NWAVES + wave, NGW = G * NWAVES;
        constexpr int I_IN = 32 * 128, I_SQ = 32 * 32, I_GU = 32 * 176, I_DN = 88 * 32, I_KV = 32 * 16;
        constexpr int NITEMS = I_IN + I_SQ + 2 * I_GU;
        (void)I_DN; (void)I_KV;
        for (int it = gw; it < NITEMS; it += NGW) {
            int r = it;
            if (r < I_IN) { p0_transpose_item(w_in, D, 4 * D, Win_t, 0, 0, norm_mix_a, scr, r, lane); continue; } r -= I_IN;
            if (r < I_SQ) { p0_transpose_item(w_out, D, D, Wout_t, 0, 0, nullptr, scr, r, lane); continue; } r -= I_SQ;
            if (r < I_GU) { p0_transpose_item(w_gu, D, NGU, Wgu0_t, 0, 1, norm_ffn, scr, r, lane); continue; } r -= I_GU;
            p0_transpose_item(w_gu + (size_t)D * NGU, D, NGU, Wgu1_t, 0, 1, norm_ffn + D, scr, r, lane);
        }
        for (int m = gw; m < MR; m += NGW) {
            const float* src = (m < SEQ) ? x_p + (size_t)m * D : x_s + (size_t)(m - SEQ) * D;
            const f32x4* xr = (const f32x4*)src + lane; f32x4 v[8]; float s = 0.f;
#pragma unroll
            for (int j = 0; j < 8; ++j) { v[j] = __builtin_nontemporal_load(xr + 64 * j); s += (v[j].x * v[j].x + v[j].y * v[j].y) + (v[j].z * v[j].z + v[j].w * v[j].w); }
            s = wave_sum(s);
            if (lane == 0) ss0[m] = s;
            v2u* o8 = (v2u*)(Hb0 + (size_t)m * D) + lane;
#pragma unroll
            for (int j = 0; j < 8; ++j) { v2u w; w.x = pk2(v[j].x, v[j].y); w.y = pk2(v[j].z, v[j].w); o8[64 * j] = w; }
        }
    }
    xcd_barrier(bar, IS_T0);
    STAMP();

    {
        TIDS;
        pg8::Gemm g{Hb0, Win_t, SEQ, 4 * D, D}; pg8::StaticOrder S; S.init(SEQ, 4 * D, G, bid);
        EpiIn E{ss0, lbl, Qg, Ff};
        pg8::gemm_phase<EpiIn, pg8::StaticOrder, true, true, false>(lds, g, S, E, TIDX);
        for (int it2 = 0; it2 < 2; ++it2) {
            const int w2 = bid + 256 * it2, t2 = w2 & 255, rh = (w2 >> 8) & 1;
            TIDS; f32x4 ta[2]; tail_gemm<2, D>(lds, Hb0 + (size_t)SEQ * D, Win_t, 32 * t2, rh, ta, TIDX, bid & 127);
            if (wave < 4) { const int row = SEQ + 64 * rh + 16 * wave + fr; E.tail(row, 32 * t2 + 4 * fq, ta[0]); E.tail(row, 32 * t2 + 16 + 4 * fq, ta[1]); }
        }
    }
    xcd_barrier(bar, IS_T0);
    STAMP();

    {
        TIDS;
        LAS float* tot = (LAS float*)(lds);
        LAS float* decs = (LAS float*)(lds + 2048);
        LAS bf16* koT = (LAS bf16*)(lds + 4096);
        LAS bf16* Vr = (LAS bf16*)(lds + 4096 + 128 * 72 * 2);
        LAS f32x4* kmr = (LAS f32x4*)(lds + 65536);
        const int col = tid & 127, part = tid >> 7; const int vt_t = tid >> 3, vd0 = (tid & 7) * 16;
        f16 fN[16]; v4u vaN, vbN;
#define P2_LOADN(it_) do { const int h_ = (it_) >> 7, r0_ = ((it_) & 127) * 64; const f16* fp_ = Ff + (size_t)(r0_ + part * 16) * D + h_ * 128 + col; \
            _Pragma("unroll") for (int i = 0; i < 16; ++i) fN[i] = fp_[(size_t)i * D]; \
            const bf16* vp_ = Vg + (size_t)(r0_ + vt_t) * D + h_ * 128 + vd0; vaN = *(const v4u*)vp_; vbN = *(const v4u*)(vp_ + 8); } while (0)
        for (int it = bid; it < NH * 16; it += G) {
            const int h = it >> 4, g = it & 15;
            f32x4 S[8];
#pragma unroll
            for (int vt = 0; vt < 8; ++vt) S[vt] = (f32x4){0.f, 0.f, 0.f, 0.f};
            float dtot = 1.0f;
            P2_LOADN(h * 128 + 8 * g);
            f32x4 ka = {0.f, 0.f, 0.f, 0.f};
            const int kpg0 = ptab[(it >> 5) * NPAGES + 2 * (it & 31)], kpg1 = ptab[(it >> 5) * NPAGES + 2 * (it & 31) + 1];
#pragma unroll 1
            for (int j = 0; j < 8; ++j) {
                const int item = h * 128 + 8 * g + j;
                f32x4 kq[8];
                { const int page = (j < 4) ? kpg0 : kpg1;
                  const f32x4* pp = (const f32x4*)(cache_k + (size_t)page * PAGE * 512) + (tid & 127) + (size_t)((j & 3) * 32 + (tid >> 7)) * 128;
#pragma unroll
                  for (int i = 0; i < 8; ++i) kq[i] = __builtin_nontemporal_load(pp + (size_t)(4 * i) * 128); }
                float cum[16], kk[16]; float run = 0.f;
#pragma unroll
                for (int i = 0; i < 16; ++i) { kk[i] = (float)fN[i]; const float f = 1.0f - kk[i]; run += __logf(f); cum[i] = run; }
                tot[part * 128 + col] = run;
                *(LAS v4u*)(Vr + vt_t * 144 + vd0) = vaN; *(LAS v4u*)(Vr + vt_t * 144 + vd0 + 8) = vbN;
                if (j < 7) P2_LOADN(item + 1);
                __syncthreads();
                float offs = 0.f, lastv = 0.f;
#pragma unroll
                for (int p = 0; p < 4; ++p) { const float tv = tot[p * 128 + col]; lastv += tv; if (p < part) offs += tv; }
                unsigned kw[8];
#pragma unroll
                for (int i = 0; i < 8; ++i) { const float a = kk[2 * i] * __expf(lastv - (cum[2 * i] + offs)), b2 = kk[2 * i + 1] * __expf(lastv - (cum[2 * i + 1] + offs)); kw[i] = pk2(a, b2); }
                *(LAS v4u*)(koT + col * 72 + part * 16) = (v4u){kw[0], kw[1], kw[2], kw[3]};
                *(LAS v4u*)(koT + col * 72 + part * 16 + 8) = (v4u){kw[4], kw[5], kw[6], kw[7]};
                if (part == 0) { const float dc = __expf(lastv); decs[col] = dc; dtot *= dc; }
                __syncthreads();
                { bf16x8 a[2]; a[0] = *(const LAS bf16x8*)(koT + (16 * wave + fr) * 72 + 8 * fq); a[1] = *(const LAS bf16x8*)(koT + (16 * wave + fr) * 72 + 32 + 8 * fq);
                  const f32x4 dv = *(const LAS f32x4*)(decs + 16 * wave + 4 * fq);
                  const LAS bf16* vb = Vr + (8 * fq + (fr >> 2)) * 144 + 4 * (fr & 3);
#pragma unroll
                  for (int vt = 0; vt < 8; ++vt) {
                      f32x4 acc = {0.f, 0.f, 0.f, 0.f};
                      const v2u l0 = tr_read(vb + 16 * vt), h0 = tr_read(vb + 4 * 144 + 16 * vt), l1 = tr_read(vb + 32 * 144 + 16 * vt), h1 = tr_read(vb + 36 * 144 + 16 * vt);
                      const v4u b0 = {l0.x, l0.y, h0.x, h0.y}, b1 = {l1.x, l1.y, h1.x, h1.y};
                      acc = MFMA16(a[0], __builtin_bit_cast(bf16x8, b0), acc); acc = MFMA16(a[1], __builtin_bit_cast(bf16x8, b1), acc);
                      S[vt] = dv * S[vt] + acc;
                  } }
#pragma unroll
                for (int i = 0; i < 8; ++i) ka += kq[i];
                if (j == 7) kmr[(tid >> 7) * 128 + (tid & 127)] = ka;
                __syncthreads();
                if (j == 7 && tid < 128) { const f32x4 s4 = (kmr[tid] + kmr[128 + tid]) + (kmr[256 + tid] + kmr[384 + tid]); *(f32x4*)(Kms + (size_t)it * 512 + 4 * tid) = s4 * (1.0f / 256.0f); }
            }
            float* ug = Ug + (size_t)it * 16384;
#pragma unroll
            for (int vt = 0; vt < 8; ++vt) *(f32x4*)(ug + (size_t)(16 * vt + fr) * 128 + 16 * wave + 4 * fq) = S[vt];
            if (part == 0) Dg[(size_t)it * 128 + col] = dtot;
        }
#undef P2_LOADN
        LAS float* red = (LAS float*)(lds);
        LAS float* red2 = (LAS float*)(lds + 8192);
        float* st_out = out + OST_S;
        for (int item = bid; item < DECB * NH; item += G) {
            const int b = item >> 4, h = item & 15; const int vd = tid & 127, kq = tid >> 7;
            const float* sp = st_in + ((size_t)(b * NH + h) * 128 + 32 * kq) * 128 + vd;
            float Sx[32];
#pragma unroll
            for (int i = 0; i < 32; ++i) Sx[i] = __builtin_nontemporal_load(sp + (size_t)i * 128);
#pragma unroll
            for (int t = 0; t < 4; ++t) {
                const int row = SEQ + 4 * b + t; const size_t ro = (size_t)row * D + h * 128;
                const float v = bf2f(Vg[ro + vd]); float op = 0.f;
#pragma unroll
                for (int i = 0; i < 32; ++i) { const float f = 1.0f - (float)Ff[ro + 32 * kq + i]; const float q = bf2f(Qg[ro + 32 * kq + i]); Sx[i] = f * Sx[i] + (1.0f - f) * v; op += Sx[i] * q; }
                red[(t * 4 + kq) * 128 + vd] = op;
            }
            float* so = st_out + ((size_t)(b * NH + h) * 128 + 32 * kq) * 128 + vd;
#pragma unroll
            for (int i = 0; i < 32; ++i) __builtin_nontemporal_store(Sx[i], so + (size_t)i * 128);
            __syncthreads();
            { const int t = tid >> 7; const float o = (red[(t * 4 + 0) * 128 + vd] + red[(t * 4 + 1) * 128 + vd]) + (red[(t * 4 + 2) * 128 + vd] + red[(t * 4 + 3) * 128 + vd]);
              const float s = wave_sum(o * o); if (lane == 0) red2[t * 2 + (wave & 1)] = s;
              __syncthreads();
              const float r = rsqrtf((red2[t * 2] + red2[t * 2 + 1]) * (1.0f / 128.0f) + EPS);
              const int row = SEQ + 4 * b + t; const size_t ro = (size_t)row * D + h * 128 + vd;
              Ob[ro] = (bf16)f2bf(o * r * onorm[vd] * bf2f(Gg[ro])); }
            __syncthreads();
        }
    }
    xcd_barrier(bar, IS_T0);
    STAMP();

    {
        TIDS;
        for (int gid = bid * NTHR + tid; gid < NH * 128 * 32; gid += G * NTHR) {
            const int h = gid >> 12, rem = gid & 4095, vd = rem >> 5, k = (rem & 31) * 4;
            f32x4 sv = {0.f, 0.f, 0.f, 0.f};
#pragma unroll
            for (int g = 0; g < 16; ++g) {
                const size_t idx = ((size_t)(h * 16 + g) * 128 + vd) * 128 + k;
                const f32x4 u = *(const f32x4*)(Ug + idx), d = *(const f32x4*)(Dg + (size_t)(h * 16 + g) * 128 + k);
                *(f32x4*)(Sg0 + idx) = sv;
                sv = d * sv + u;
            }
            float* so = out + OST_P + ((size_t)h * 128 + k) * 128 + vd;
            so[0] = sv[0]; so[128] = sv[1]; so[256] = sv[2]; so[384] = sv[3];
        }
    }
    xcd_barrier(bar, IS_T0);
    STAMP();

    {
        TIDS;
        LAS float* tot = (LAS float*)(lds);
        LAS float* refs = (LAS float*)(lds + 2048);
        LAS float* red = (LAS float*)(lds + 2560);
        LAS float* decs = (LAS float*)(lds + 3072);
        LAS bf16* QE = (LAS bf16*)(lds + 4096);
        LAS bf16* KE = QE + 64 * 136;
        LAS bf16* QI = KE + 64 * 136;
        LAS bf16* Vr = QI + 64 * 136;
        LAS bf16* STs = Vr + 64 * 144;
        LAS bf16* koT = STs + 128 * 136;
        LAS f32x4* kmr = (LAS f32x4*)(lds + 131072);
        const int col = tid & 127, part = tid >> 7; const int vt_t = tid >> 3, vd0 = (tid & 7) * 16;
        const int tt = wave & 3, vh = wave >> 2;
        f16 fN[16]; bf16 qN[16]; v4u vaN, vbN;
#define P4_LOADN(it_) do { const int h_ = (it_) >> 7, r0_ = ((it_) & 127) * 64; const f16* fp_ = Ff + (size_t)(r0_ + part * 16) * D + h_ * 128 + col; const bf16* qp_ = Qg + (size_t)(r0_ + part * 16) * D + h_ * 128 + col; \
            _Pragma("unroll") for (int i = 0; i < 16; ++i) { fN[i] = fp_[(size_t)i * D]; qN[i] = qp_[(size_t)i * D]; } \
            const bf16* vp_ = Vg + (size_t)(r0_ + vt_t) * D + h_ * 128 + vd0; vaN = *(const v4u*)vp_; vbN = *(const v4u*)(vp_ + 8); } while (0)
        for (int it = bid; it < NH * 16; it += G) {
            const int hh = it >> 4, gg = it & 15;
            f32x4 S[8];
            { const float* sg = Sg0 + (size_t)it * 16384;
#pragma unroll
              for (int vt = 0; vt < 8; ++vt) { S[vt] = *(const f32x4*)(sg + (size_t)(16 * vt + fr) * 128 + 16 * wave + 4 * fq);
                  v2u w; w.x = cvt_pk_bf16(S[vt][0], S[vt][1]); w.y = cvt_pk_bf16(S[vt][2], S[vt][3]); *(LAS v2u*)(STs + (16 * vt + fr) * 136 + 16 * wave + 4 * fq) = w; } }
            P4_LOADN(hh * 128 + 8 * gg);
            f32x4 ka = {0.f, 0.f, 0.f, 0.f};
            const int kpg0 = ptab[((it + 256) >> 5) * NPAGES + 2 * (it & 31)], kpg1 = ptab[((it + 256) >> 5) * NPAGES + 2 * (it & 31) + 1];
#pragma unroll 1
            for (int jc = 0; jc < 8; ++jc) {
            const int item = hh * 128 + 8 * gg + jc;
            const int h = item >> 7, c = item & 127; const int row0 = c * 64;
            f32x4 kq[8];
            { const int page = (jc < 4) ? kpg0 : kpg1;
              const f32x4* pp = (const f32x4*)(cache_k + (size_t)page * PAGE * 512) + (tid & 127) + (size_t)((jc & 3) * 32 + (tid >> 7)) * 128;
#pragma unroll
              for (int i = 0; i < 8; ++i) kq[i] = __builtin_nontemporal_load(pp + (size_t)(4 * i) * 128); }
            float cum[16], kk[16], qv[16]; float run = 0.f;
#pragma unroll
            for (int i = 0; i < 16; ++i) { kk[i] = (float)fN[i]; const float f = 1.0f - kk[i]; run += __logf(f); cum[i] = run; qv[i] = bf2f(qN[i]); }
            tot[part * 128 + col] = run;
            *(LAS v4u*)(Vr + vt_t * 144 + vd0) = vaN; *(LAS v4u*)(Vr + vt_t * 144 + vd0 + 8) = vbN;
            const size_t ro = (size_t)(row0 + 16 * tt + fr) * D + h * 128;
            v2u gw2[4]; f32x4 on[4];
#pragma unroll
            for (int vt = 0; vt < 4; ++vt) { const int vd = 16 * (4 * vh + vt) + 4 * fq; gw2[vt] = *(const v2u*)(Gg + ro + vd); on[vt] = *(const f32x4*)(onorm + vd); }
            if (jc < 7) P4_LOADN(item + 1);
            __syncthreads();
            float offs = 0.f, lastv = 0.f;
#pragma unroll
            for (int p = 0; p < 4; ++p) { const float tv = tot[p * 128 + col]; lastv += tv; if (p < part) offs += tv; }
            if (part == 1) refs[col] = cum[15] + offs;
            if (part == 0) decs[col] = __expf(lastv);
            __syncthreads();
            const float ref = refs[col];
#pragma unroll
            for (int i = 0; i < 16; ++i) { const float cm = cum[i] + offs, d1 = cm - ref; const int t = part * 16 + i;
                QE[t * 136 + col] = (bf16)f2bf(qv[i] * __expf(d1)); KE[t * 136 + col] = (bf16)f2bf(kk[i] * __expf(-d1)); QI[t * 136 + col] = (bf16)f2bf(qv[i] * __expf(cm)); }
            { unsigned kw[8];
#pragma unroll
              for (int i = 0; i < 8; ++i) { const float a = kk[2 * i] * __expf(lastv - (cum[2 * i] + offs)), b2 = kk[2 * i + 1] * __expf(lastv - (cum[2 * i + 1] + offs)); kw[i] = pk2(a, b2); }
              *(LAS v4u*)(koT + col * 72 + part * 16) = (v4u){kw[0], kw[1], kw[2], kw[3]};
              *(LAS v4u*)(koT + col * 72 + part * 16 + 8) = (v4u){kw[4], kw[5], kw[6], kw[7]}; }
            __syncthreads();
            {
                f32x4 aS[4];
#pragma unroll
                for (int st = 0; st < 4; ++st) {
                    aS[st] = (f32x4){0.f, 0.f, 0.f, 0.f};
                    if (st <= tt) {
#pragma unroll
                        for (int ks = 0; ks < 4; ++ks) { const bf16x8 a = *(const LAS bf16x8*)(KE + (16 * st + fr) * 136 + 32 * ks + 8 * fq), b = *(const LAS bf16x8*)(QE + (16 * tt + fr) * 136 + 32 * ks + 8 * fq); aS[st] = MFMA16(a, b, aS[st]); }
                        if (st == tt) {
#pragma unroll
                            for (int r = 0; r < 4; ++r) if (4 * fq + r > fr) aS[st][r] = 0.f;
                        }
                    }
                }
                f32x4 o[4];
#pragma unroll
                for (int vt = 0; vt < 4; ++vt) o[vt] = (f32x4){0.f, 0.f, 0.f, 0.f};
#pragma unroll
                for (int j = 0; j < 2; ++j) {
                    v4u pw; pw.x = cvt_pk_bf16(aS[2 * j][0], aS[2 * j][1]); pw.y = cvt_pk_bf16(aS[2 * j][2], aS[2 * j][3]); pw.z = cvt_pk_bf16(aS[2 * j + 1][0], aS[2 * j + 1][1]); pw.w = cvt_pk_bf16(aS[2 * j + 1][2], aS[2 * j + 1][3]);
                    const bf16x8 pf = __builtin_bit_cast(bf16x8, pw);
                    const LAS bf16* vb = Vr + (32 * j + 4 * fq + (fr >> 2)) * 144 + 64 * vh + 4 * (fr & 3);
#pragma unroll
                    for (int vt = 0; vt < 4; ++vt) { const v2u lo = tr_read(vb + 16 * vt), hi = tr_read(vb + 16 * 144 + 16 * vt); const v4u aw = {lo.x, lo.y, hi.x, hi.y};
                        o[vt] = MFMA16(__builtin_bit_cast(bf16x8, aw), pf, o[vt]); }
                }
#pragma unroll
                for (int ks = 0; ks < 4; ++ks) { const bf16x8 b = *(const LAS bf16x8*)(QI + (16 * tt + fr) * 136 + 32 * ks + 8 * fq);
#pragma unroll
                    for (int vt = 0; vt < 4; ++vt) { const bf16x8 a = *(const LAS bf16x8*)(STs + (16 * (4 * vh + vt) + fr) * 136 + 32 * ks + 8 * fq); o[vt] = MFMA16(a, b, o[vt]); } }
                float sq = 0.f;
#pragma unroll
                for (int vt = 0; vt < 4; ++vt) sq += (o[vt][0] * o[vt][0] + o[vt][1] * o[vt][1]) + (o[vt][2] * o[vt][2] + o[vt][3] * o[vt][3]);
                sq += shx<16>(sq); sq = xadd32(sq);
                if (fq == 0) red[(16 * tt + fr) * 2 + vh] = sq;
                __syncthreads();
                const float r = rsqrtf((red[(16 * tt + fr) * 2] + red[(16 * tt + fr) * 2 + 1]) * (1.0f / 128.0f) + EPS);
#pragma unroll
                for (int vt = 0; vt < 4; ++vt) { const int vd = 16 * (4 * vh + vt) + 4 * fq;
                    const float g0 = bf2f(gw2[vt].x & 0xffffu), g1 = bf2f(gw2[vt].x >> 16), g2 = bf2f(gw2[vt].y & 0xffffu), g3 = bf2f(gw2[vt].y >> 16);
                    v2u w; w.x = cvt_pk_bf16(o[vt][0] * r * on[vt][0] * g0, o[vt][1] * r * on[vt][1] * g1); w.y = cvt_pk_bf16(o[vt][2] * r * on[vt][2] * g2, o[vt][3] * r * on[vt][3] * g3);
                    *(v2u*)(Ob + ro + vd) = w; }
            }
            if (jc < 7) {
                bf16x8 a[2]; a[0] = *(const LAS bf16x8*)(koT + (16 * wave + fr) * 72 + 8 * fq); a[1] = *(const LAS bf16x8*)(koT + (16 * wave + fr) * 72 + 32 + 8 * fq);
                const f32x4 dv = *(const LAS f32x4*)(decs + 16 * wave + 4 * fq);
                const LAS bf16* vb = Vr + (8 * fq + (fr >> 2)) * 144 + 4 * (fr & 3);
#pragma unroll
                for (int vt = 0; vt < 8; ++vt) {
                    f32x4 acc = {0.f, 0.f, 0.f, 0.f};
                    const v2u l0 = tr_read(vb + 16 * vt), h0 = tr_read(vb + 4 * 144 + 16 * vt), l1 = tr_read(vb + 32 * 144 + 16 * vt), h1 = tr_read(vb + 36 * 144 + 16 * vt);
                    const v4u b0 = {l0.x, l0.y, h0.x, h0.y}, b1 = {l1.x, l1.y, h1.x, h1.y};
                    acc = MFMA16(a[0], __builtin_bit_cast(bf16x8, b0), acc); acc = MFMA16(a[1], __builtin_bit_cast(bf16x8, b1), acc);
                    S[vt] = dv * S[vt] + acc;
                    v2u w; w.x = cvt_pk_bf16(S[vt][0], S[vt][1]); w.y = cvt_pk_bf16(S[vt][2], S[vt][3]); *(LAS v2u*)(STs + (16 * vt + fr) * 136 + 16 * wave + 4 * fq) = w;
                }
            }
#pragma unroll
            for (int i = 0; i < 8; ++i) ka += kq[i];
            if (jc == 7) kmr[(tid >> 7) * 128 + (tid & 127)] = ka;
            __syncthreads();
            if (jc == 7 && tid < 128) { const f32x4 s4 = (kmr[tid] + kmr[128 + tid]) + (kmr[256 + tid] + kmr[384 + tid]); *(f32x4*)(Kms + (size_t)(it + 256) * 512 + 4 * tid) = s4 * (1.0f / 256.0f); }
            }
        }
#undef P4_LOADN
    }
    xcd_barrier(bar, IS_T0);
    STAMP();

    {
        TIDS;
        pg8::Gemm g{Ob, Wout_t, SEQ, D, D}; pg8::StaticOrder S; S.init(SEQ, D, G, bid);
        EpiRes<1> E{Hb0, nullptr, nullptr, Hb1, ss1};
        const unsigned tg0 = TNOW();
        pg8::gemm_phase<EpiRes<1>, pg8::StaticOrder, true, true, false>(lds, g, S, E, TIDX);
        TACC(5, tg0); const unsigned tg1 = TNOW();
        { const int t2 = bid & 127, rh = (bid >> 7) & 1; TIDS; f32x4 ta[1]; tail_gemm<1, D>(lds, Ob + (size_t)SEQ * D, Wout_t, 16 * t2, rh, ta, TIDX, bid & 127); if (wave < 4) E.tail(SEQ + 64 * rh + 16 * wave + fr, 16 * t2 + 4 * fq, ta[0], fq); }
        TACC(6, tg1);
    }
    xcd_barrier(bar, IS_T0);
    STAMP();
    {
        TIDS;
        pg8::Gemm g{Hb1, Wgu0_t, MP, NGU, D}; pg8::StaticOrder S; S.init(MP, NGU, G, bid);
        EpiGU E{ss1, Hm};
        pg8::gemm_phase<EpiGU, pg8::StaticOrder, true, true>(lds, g, S, E, TIDX);
        constexpr int GG = 172;
        if (bid >= GG) {
            constexpr int I_SQ = 32 * 32, I_DN = 88 * 32, I_KV = 32 * 16, NT6 = I_DN + I_KV + 2 * I_SQ;
            LAS float* scr = (LAS float*)(lds + wave * 17408);
            const int gw = (bid - GG) * NWAVES + wave, NGW = (G - GG) * NWAVES;
            auto dec = [&](int it) { TrItem t; int r = it;
                if (r < I_DN) { t.W = w_dn; t.gain = nullptr; t.WT = Wdn0_t; t.K = DFF; t.N = D; t.row_off = 0; t.item = r; return t; } r -= I_DN;
                if (r < I_KV) { t.W = w_kv; t.gain = norm_kv; t.WT = Wkvq_t; t.K = D; t.N = 1024; t.row_off = 0; t.item = r; return t; } r -= I_KV;
                if (r < I_SQ) { t.W = w_q; t.gain = norm_mix_b; t.WT = Wkvq_t; t.K = D; t.N = D; t.row_off = 1024; t.item = r; return t; } r -= I_SQ;
                t.W = w_o; t.gain = nullptr; t.WT = Wo_t; t.K = D; t.N = D; t.row_off = 0; t.item = r; return t; };
            for (int it = gw; it < NT6; it += 2 * NGW) {
                const bool hb = it + NGW < NT6; const TrItem ta = dec(it), tb = dec(hb ? it + NGW : it);
                f32x4 wa[16], wb[16]; float ga[16], gb[16];
                tr_load(ta, wa, ga, lane); if (hb) tr_load(tb, wb, gb, lane);
                tr_store(ta, wa, ga, scr, lane); if (hb) tr_store(tb, wb, gb, scr, lane);
            }
        }
    }
    xcd_barrier(bar, IS_T0);
    STAMP();
    {
        TIDS;
        pg8::Gemm g{Hm, Wdn0_t, SEQ, D, DFF}; pg8::StaticOrder S; S.init(SEQ, D, G, bid);
        EpiRes<1> E{Hb1, nullptr, nullptr, Hb2, ss2};
        const unsigned tg0 = TNOW();
        pg8::gemm_phase<EpiRes<1>, pg8::StaticOrder, true, true, false>(lds, g, S, E, TIDX);
        TACC(7, tg0); const unsigned tg1 = TNOW();
        { const int t2 = bid & 127, rh = (bid >> 7) & 1; TIDS; f32x4 ta[1]; tail_gemm<1, DFF>(lds, Hm + (size_t)SEQ * DFF, Wdn0_t, 16 * t2, rh, ta, TIDX, bid & 127); if (wave < 4) E.tail(SEQ + 64 * rh + 16 * wave + fr, 16 * t2 + 4 * fq, ta[0], fq); }
        TACC(8, tg1);
    }
    xcd_barrier(bar, IS_T0);
    STAMP();
    {
        TIDS;
        pg8::Gemm g{Hb2, Wkvq_t, MP, 3072, D}; pg8::StaticOrder S; S.init(MP, 3072, G, bid);
        EpiKVQ E{ss2, ws, out, k_norm, q_norm, lds + 131072};
        pg8::gemm_phase<EpiKVQ, pg8::StaticOrder, true, true>(lds, g, S, E, TIDX);
        kmean_items(lds, cache_k, ptab, Kms, 512, DECB * NBLK, 140, G - 140, TIDX);
    }
    xcd_barrier(bar, IS_T0);
    STAMP();

    {
        TIDS;
        LAS bf16* KMb = (LAS bf16*)(lds);
        LAS unsigned* lcnt = (LAS unsigned*)(lds + 16384);
        LAS float* gs = (LAS float*)(lds + 16384 + 256);
#define G_BETTER(va, ia, vb, ib) (((va) > (vb)) || (((va) == (vb)) && ((ia) < (ib))))
#define G_INSERT(vx, ix) do { const float vx_ = (vx); const int ix_ = (ix); \
            if (G_BETTER(vx_, ix_, v0, i0)) { v2 = v1; i2 = i1; v1 = v0; i1 = i0; v0 = vx_; i0 = ix_; } \
            else if (G_BETTER(vx_, ix_, v1, i1)) { v2 = v1; i2 = i1; v1 = vx_; i1 = ix_; } \
            else if (G_BETTER(vx_, ix_, v2, i2)) { v2 = vx_; i2 = ix_; } } while (0)
        for (int item = bid; item < 256; item += G) {
            const int j = item >> 2, kvh = item & 3; const int b = j >> 1;
            { const int n = tid >> 4, d8 = (tid & 15) * 8; f32x4 s0 = {0.f, 0.f, 0.f, 0.f}, s1 = {0.f, 0.f, 0.f, 0.f};
              if (n < b) { const float* kp = Kpart + (size_t)n * 512 + kvh * 128 + d8; s0 = *(const f32x4*)kp; s1 = *(const f32x4*)(kp + 4); }
              s0 = s0 * (1.0f / 256.0f); s1 = s1 * (1.0f / 256.0f);
              v4u w; w.x = cvt_pk_bf16(s0[0], s0[1]); w.y = cvt_pk_bf16(s0[2], s0[3]); w.z = cvt_pk_bf16(s1[0], s1[1]); w.w = cvt_pk_bf16(s1[2], s1[3]);
              *(LAS v4u*)(KMb + n * 136 + d8) = w; }
            if (tid < 32) lcnt[tid] = 0u;
            __syncthreads();
            const int nsel = b < 3 ? b : 3;
#pragma unroll 1
            for (int rt = 0; rt < 4; ++rt) {
                const int r = 64 * wave + 16 * rt + fr; const int tok = j * 128 + (r >> 2), hg = r & 3; const bf16* qp = Qb + (size_t)tok * D + (4 * kvh + hg) * 128 + 8 * fq;
                bf16x8 qf[4];
#pragma unroll
                for (int ks = 0; ks < 4; ++ks) qf[ks] = *(const bf16x8*)(qp + 32 * ks);
                f32x4 ga[2];
#pragma unroll
                for (int nt = 0; nt < 2; ++nt) { ga[nt] = (f32x4){0.f, 0.f, 0.f, 0.f};
#pragma unroll
                    for (int ks = 0; ks < 4; ++ks) { const bf16x8 ka = *(const LAS bf16x8*)(KMb + (16 * nt + fr) * 136 + 32 * ks + 8 * fq); ga[nt] = MFMA16(ka, qf[ks], ga[nt]); } }
                float v0 = -INFINITY, v1 = -INFINITY, v2 = -INFINITY; int i0 = 99, i1 = 99, i2 = 99;
#pragma unroll
                for (int nt = 0; nt < 2; ++nt)
#pragma unroll
                    for (int q = 0; q < 4; ++q) { const int n = 16 * nt + 4 * fq + q; if (n < b) G_INSERT(ga[nt][q], n); }
                { const float a0 = shx<16>(v0), a1 = shx<16>(v1), a2 = shx<16>(v2);
                  const int c0 = __builtin_amdgcn_ds_swizzle(i0, (16 << 10) | 0x1f), c1 = __builtin_amdgcn_ds_swizzle(i1, (16 << 10) | 0x1f), c2 = __builtin_amdgcn_ds_swizzle(i2, (16 << 10) | 0x1f);
                  G_INSERT(a0, c0); G_INSERT(a1, c1); G_INSERT(a2, c2); }
                {
                  auto p0 = __builtin_amdgcn_permlane32_swap(__float_as_uint(v0), __float_as_uint(v0), false, false); auto p1 = __builtin_amdgcn_permlane32_swap(__float_as_uint(v1), __float_as_uint(v1), false, false);
                  auto p2 = __builtin_amdgcn_permlane32_swap(__float_as_uint(v2), __float_as_uint(v2), false, false);
                  auto q0 = __builtin_amdgcn_permlane32_swap((unsigned)i0, (unsigned)i0, false, false); auto q1 = __builtin_amdgcn_permlane32_swap((unsigned)i1, (unsigned)i1, false, false);
                  auto q2 = __builtin_amdgcn_permlane32_swap((unsigned)i2, (unsigned)i2, false, false);
                  v0 = __uint_as_float(p0[0]); v1 = __uint_as_float(p1[0]); v2 = __uint_as_float(p2[0]); i0 = (int)q0[0]; i1 = (int)q1[0]; i2 = (int)q2[0];
                  G_INSERT(__uint_as_float(p0[1]), (int)q0[1]); G_INSERT(__uint_as_float(p1[1]), (int)q1[1]); G_INSERT(__uint_as_float(p2[1]), (int)q2[1]); }
                if (fq == 0) {
#pragma unroll
                    for (int rk = 0; rk < 3; ++rk) {
                        if (rk < nsel) { const int best = (rk == 0) ? i0 : ((rk == 1) ? i1 : i2);
                            const unsigned pos = atomicAdd((unsigned*)&lcnt[best], 1u);
                            Subl[((size_t)(j * 4 + kvh) * 32 + best) * 512 + pos] = (unsigned)r | ((unsigned)rk << 9); }
                    }
                }
            }
            __syncthreads();
            if (tid < 32) Scnt[(j * 4 + kvh) * 32 + tid] = lcnt[tid];
            __syncthreads();
        }
#undef G_BETTER
#undef G_INSERT
        for (int item = bid; item < DECB * NKV; item += G) {
            const int b = item >> 2, kvh = item & 3; const int pr = tid >> 5, n = tid & 31;
            const int row = SEQ + 4 * b + (pr >> 2), hg = pr & 3; const bf16* qp = Qb + (size_t)row * D + (4 * kvh + hg) * 128; const float* kmp = Kms + ((size_t)(b * 32 + n)) * 512 + kvh * 128;
            float s = 0.f;
#pragma unroll 4
            for (int d = 0; d < 128; d += 8) { const v4u qw = *(const v4u*)(qp + d); const f32x4 k0 = *(const f32x4*)(kmp + d), k1 = *(const f32x4*)(kmp + d + 4);
                s += (bf2f(qw.x & 0xffffu) * k0[0] + bf2f(qw.x >> 16) * k0[1]) + (bf2f(qw.y & 0xffffu) * k0[2] + bf2f(qw.y >> 16) * k0[3]) + (bf2f(qw.z & 0xffffu) * k1[0] + bf2f(qw.z >> 16) * k1[1]) + (bf2f(qw.w & 0xffffu) * k1[2] + bf2f(qw.w >> 16) * k1[3]); }
            gs[pr * 32 + n] = s;
            __syncthreads();
            if (tid < 16) { unsigned m = 0u;
                for (int r = 0; r < 3; ++r) { int best = 0; float bv = -INFINITY; for (int nn = 0; nn < 32; ++nn) { const float v = gs[tid * 32 + nn]; if (v > bv) { bv = v; best = nn; } } m |= 1u << best; gs[tid * 32 + best] = -INFINITY; }
                Sels[item * 16 + tid] = m; }
            __syncthreads();
        }
    }
    xcd_barrier(bar, IS_T0);
    STAMP();

    {
        LAS bf16* Ks = (LAS bf16*)(lds); LAS bf16* Vs = (LAS bf16*)(lds + KS_BYTES);
        LAS unsigned* qsh = (LAS unsigned*)(lds + 2 * KS_BYTES);
        constexpr int NPI = 4 * 496, NSI = DECB * NKV * NBLK;
        for (;;) {
            const unsigned tq0 = TNOW();
            if (IS_T0) qsh[0] = __hip_atomic_fetch_add(ctl + CW_Q0, 1u, __ATOMIC_RELAXED, __HIP_MEMORY_SCOPE_AGENT);
            __syncthreads();
            const int tick = (int)qsh[0];
            __syncthreads();
            TACC(0, tq0);
            if (tick >= NPI + NSI) break;
            TIDS;
            int item; { const int g3 = tick / 3, r3 = tick - 3 * g3; item = (tick < 3 * NPI) ? ((r3 == 0) ? g3 : NPI + 2 * g3 + (r3 - 1)) : NPI + (tick - NPI); }
            if (item < NPI) {
                int b = (int)((1.0f + sqrtf(1.0f + 2.0f * (float)item)) * 0.5f); while (2 * b * (b - 1) > item) --b; while (2 * (b + 1) * b <= item) ++b;
                const int rem = item - 2 * b * (b - 1); const int n = rem >> 2, kvh = rem & 3;
                const int cntA = (int)Scnt[((2 * b) * 4 + kvh) * 32 + n], cntB = (int)Scnt[((2 * b + 1) * 4 + kvh) * 32 + n]; const int total = cntA + cntB;
                if (total == 0) continue;
                const unsigned tp0 = TNOW();
#pragma unroll
                for (int i = 0; i < 8; ++i) { const int idx = i * 512 + tid, key = idx >> 4, c8 = idx & 15; *(LAS v4u*)(Ks + key * KS_P + c8 * 8) = *(const v4u*)(Kb + (size_t)(256 * n + key) * 512 + kvh * 128 + c8 * 8); }
#pragma unroll
                for (int i = 0; i < 8; ++i) { const int idx = i * 512 + tid, key = idx >> 4, c8 = idx & 15; *(LAS v4u*)(Vs + key * KS_P + c8 * 8) = *(const v4u*)(Vb + (size_t)(256 * n + key) * 512 + kvh * 128 + c8 * 8); }
                __syncthreads();
                TACC(1, tp0); const unsigned tp1 = TNOW();
                const unsigned* LA = Subl + ((size_t)((2 * b) * 4 + kvh) * 32 + n) * 512; const unsigned* LB = Subl + ((size_t)((2 * b + 1) * 4 + kvh) * 32 + n) * 512;
#define LIST_ENT(i_) (((i_) < cntA) ? LA[(i_)] : LB[(i_) - cntA])
                const int iw = 16 * wave + fr;
                unsigned e1 = 0u, e2 = 0u; int ic1 = 0, ic2 = 0;
                if (16 * wave < total) { ic1 = iw < total ? iw : total - 1; e1 = LIST_ENT(ic1); }
                if (16 * wave + 128 < total) { ic2 = iw + 128 < total ? iw + 128 : total - 1; e2 = LIST_ENT(ic2); }
                bf16x8 qn[4];
                { const int tokn = ((ic1 < cntA) ? 2 * b : 2 * b + 1) * 128 + (int)((e1 >> 2) & 127u); const bf16* qp = Qb + (size_t)tokn * D + (4 * kvh + (int)(e1 & 3u)) * 128 + 8 * fq;
#pragma unroll
                  for (int ks = 0; ks < 4; ++ks) qn[ks] = *(const bf16x8*)(qp + 32 * ks); }
                for (int t0 = 0; t0 < total; t0 += 128) {
                    const int i0 = t0 + 16 * wave; if (i0 >= total) break;
                    const bool valid = (i0 + fr) < total; const int ic = ic1; const unsigned e = e1;
                    const int tok = ((ic < cntA) ? 2 * b : 2 * b + 1) * 128 + (int)((e >> 2) & 127u), hg = (int)(e & 3u), rk = (int)(e >> 9);
                    const int h = 4 * kvh + hg;
                    bf16x8 qf[4];
#pragma unroll
                    for (int ks = 0; ks < 4; ++ks) qf[ks] = qn[ks];
                    e1 = e2; ic1 = ic2;
                    if (i0 + 256 < total) { ic2 = (i0 + 256 + fr) < total ? (i0 + 256 + fr) : total - 1; e2 = LIST_ENT(ic2); }
                    if (i0 + 128 < total) { const int tokn = ((ic1 < cntA) ? 2 * b : 2 * b + 1) * 128 + (int)((e1 >> 2) & 127u); const bf16* qp = Qb + (size_t)tokn * D + (4 * kvh + (int)(e1 & 3u)) * 128 + 8 * fq;
#pragma unroll
                        for (int ks = 0; ks < 4; ++ks) qn[ks] = *(const bf16x8*)(qp + 32 * ks); }
                    f32x4 acc[16]; attn_scores<16>(Ks, qf, acc, 16, fr, fq);
                    float mx = -INFINITY;
#pragma unroll
                    for (int kt = 0; kt < 16; ++kt) mx = fmaxf(fmaxf(mx, fmaxf(acc[kt][0], acc[kt][1])), fmaxf(acc[kt][2], acc[kt][3]));
                    mx = fmaxf(mx, shx<16>(mx)); mx = xmax32(mx);
                    float l = 0.f;
#pragma unroll
                    for (int kt = 0; kt < 16; ++kt) {
#pragma unroll
                        for (int r = 0; r < 4; ++r) { const float p = __builtin_amdgcn_exp2f(acc[kt][r] - mx); acc[kt][r] = p; l += p; } }
                    l += shx<16>(l); l = xadd32(l);
                    f32x4 O[8];
#pragma unroll
                    for (int vt = 0; vt < 8; ++vt) O[vt] = (f32x4){0.f, 0.f, 0.f, 0.f};
                    attn_pv(Vs, acc, O, 8, fr, fq);
                    if (valid) {
                        const size_t slot = ((size_t)tok * NH + h) * 3 + rk; bf16* op = Oslot + slot * 128 + 8 * fq;
#pragma unroll
                        for (int c = 0; c < 4; ++c) { v4u w; w.x = cvt_pk_bf16(O[2 * c][0], O[2 * c][1]); w.y = cvt_pk_bf16(O[2 * c][2], O[2 * c][3]); w.z = cvt_pk_bf16(O[2 * c + 1][0], O[2 * c + 1][1]); w.w = cvt_pk_bf16(O[2 * c + 1][2], O[2 * c + 1][3]); *(v4u*)(op + 32 * c) = w; }
                        if (fq == 0) { MLslot[slot * 2] = mx; MLslot[slot * 2 + 1] = l; }
                    }
                }
                __syncthreads();
                TACC(2, tp1);
            } else {
                const int si = item - NPI; const int b = si >> 7, kvh = (si >> 5) & 3, n = si & 31;
                unsigned any = 0u;
#pragma unroll
                for (int p = 0; p < 16; ++p) any |= Sels[(b * 4 + kvh) * 16 + p];
                if (!((any >> n) & 1u)) continue;
                const unsigned ts0 = TNOW();
                const int pg0 = ptab[b * NPAGES + 2 * n], pg1 = ptab[b * NPAGES + 2 * n + 1];
                f32x4 kst[16], vst[16];
#pragma unroll
                for (int i = 0; i < 16; ++i) { const int idx = i * 512 + tid, key = idx >> 5, c4 = idx & 31; const int page = (key < 128) ? pg0 : pg1;
                    const size_t go = (((size_t)page * PAGE + (key & 127)) * NKV + kvh) * 128 + c4 * 4;
                    kst[i] = __builtin_nontemporal_load((const f32x4*)(cache_k + go)); vst[i] = __builtin_nontemporal_load((const f32x4*)(cache_v + go)); }
#pragma unroll
                for (int i = 0; i < 16; ++i) { const int idx = i * 512 + tid, key = idx >> 5, c4 = idx & 31; const int page = (key < 128) ? pg0 : pg1; (void)page;
                    const f32x4 kk4 = kst[i], vv4 = vst[i];
                    v2u w; w.x = cvt_pk_bf16(kk4[0], kk4[1]); w.y = cvt_pk_bf16(kk4[2], kk4[3]); *(LAS v2u*)(Ks + key * KS_P + c4 * 4) = w;
                    v2u wv; wv.x = cvt_pk_bf16(vv4[0], vv4[1]); wv.y = cvt_pk_bf16(vv4[2], vv4[3]); *(LAS v2u*)(Vs + key * KS_P + c4 * 4) = wv; }
                __syncthreads();
                TACC(3, ts0); const unsigned ts1 = TNOW();
                {
                    LAS float* mxs = (LAS float*)(lds + 2 * KS_BYTES + 64); LAS float* lss = mxs + 128; LAS float* Ored = (LAS float*)(lds);
                    const int row = SEQ + 4 * b + (fr >> 2), hg = fr & 3; const int h = 4 * kvh + hg; const bf16* qp = Qb + (size_t)row * D + h * 128 + 8 * fq;
                    bf16x8 qf[4];
#pragma unroll
                    for (int ks = 0; ks < 4; ++ks) qf[ks] = *(const bf16x8*)(qp + 32 * ks);
                    f32x4 a2[2];
#pragma unroll
                    for (int t = 0; t < 2; ++t) { a2[t] = (f32x4){0.f, 0.f, 0.f, 0.f};
#pragma unroll
                        for (int ks = 0; ks < 4; ++ks) { const bf16x8 ka = *(const LAS bf16x8*)(Ks + (16 * (2 * wave + t) + fr) * KS_P + 32 * ks + 8 * fq); a2[t] = MFMA16(ka, qf[ks], a2[t]); } }
                    float mx = fmaxf(fmaxf(fmaxf(a2[0][0], a2[0][1]), fmaxf(a2[0][2], a2[0][3])), fmaxf(fmaxf(a2[1][0], a2[1][1]), fmaxf(a2[1][2], a2[1][3])));
                    mx = fmaxf(mx, shx<16>(mx)); mx = xmax32(mx);
                    if (fq == 0) mxs[wave * 16 + fr] = mx;
                    __syncthreads();
                    float M = mxs[fr];
#pragma unroll
                    for (int w8 = 1; w8 < 8; ++w8) M = fmaxf(M, mxs[w8 * 16 + fr]);
                    float l = 0.f;
#pragma unroll
                    for (int t = 0; t < 2; ++t) {
#pragma unroll
                        for (int r = 0; r < 4; ++r) { const float p = __builtin_amdgcn_exp2f(a2[t][r] - M); a2[t][r] = p; l += p; } }
                    l += shx<16>(l); l = xadd32(l);
                    if (fq == 0) lss[wave * 16 + fr] = l;
                    v4u pw; pw.x = cvt_pk_bf16(a2[0][0], a2[0][1]); pw.y = cvt_pk_bf16(a2[0][2], a2[0][3]); pw.z = cvt_pk_bf16(a2[1][0], a2[1][1]); pw.w = cvt_pk_bf16(a2[1][2], a2[1][3]);
                    const bf16x8 pf = __builtin_bit_cast(bf16x8, pw);
                    const LAS bf16* vb = Vs + (32 * wave + 4 * fq + (fr >> 2)) * KS_P + 4 * (fr & 3);
#pragma unroll
                    for (int vt = 0; vt < 8; ++vt) { const v2u lo = tr_read(vb + 16 * vt), hi = tr_read(vb + 16 * KS_P + 16 * vt); const v4u aw = {lo.x, lo.y, hi.x, hi.y};
                        const f32x4 o = MFMA16(__builtin_bit_cast(bf16x8, aw), pf, ((f32x4){0.f, 0.f, 0.f, 0.f}));
                        *(LAS f32x4*)(Ored + (wave * 16 + fr) * 132 + 16 * vt + 4 * fq) = o; }
                    __syncthreads();
                    { const int r16 = tid >> 5, c4 = tid & 31; f32x4 so = *(const LAS f32x4*)(Ored + r16 * 132 + 4 * c4);
#pragma unroll
                      for (int w8 = 1; w8 < 8; ++w8) so += *(const LAS f32x4*)(Ored + (w8 * 16 + r16) * 132 + 4 * c4);
                      float* sp = Sslot + ((size_t)((b * 4 + kvh) * 32 + n) * 16 + r16) * 132;
                      *(f32x4*)(sp + 4 * c4) = so;
                      if (c4 == 0) { float Mr = mxs[r16], lt = lss[r16];
#pragma unroll
                          for (int w8 = 1; w8 < 8; ++w8) { Mr = fmaxf(Mr, mxs[w8 * 16 + r16]); lt += lss[w8 * 16 + r16]; }
                          sp[128] = Mr; sp[129] = lt; } }
                }
                __syncthreads();
                TACC(4, ts1);
            }
        }
    }
    xcd_barrier(bar, IS_T0);
    STAMP();

    {
        TIDS;
        LAS bf16* Ks = (LAS bf16*)(lds); LAS bf16* Vs = (LAS bf16*)(lds + KS_BYTES);
        const unsigned tq12 = TNOW();
        for (int item = bid; item < NBLK * NKV * 2; item += G) {
            const int b = item >> 3, kvh = (item >> 1) & 3, hp = item & 1;
            int tid_i = TIDX; asm volatile("" : "+v"(tid_i));
#pragma unroll
            for (int i = 0; i < 8; ++i) { const int idx = i * 512 + tid_i, key = idx >> 4, c8 = idx & 15; *(LAS v4u*)(Ks + key * KS_P + c8 * 8) = *(const v4u*)(Kb + (size_t)(256 * b + key) * 512 + kvh * 128 + c8 * 8); }
#pragma unroll
            for (int i = 0; i < 8; ++i) { const int idx = i * 512 + tid_i, key = idx >> 4, c8 = idx & 15; *(LAS v4u*)(Vs + key * KS_P + c8 * 8) = *(const v4u*)(Vb + (size_t)(256 * b + key) * 512 + kvh * 128 + c8 * 8); }
            const int nsel = b < 3 ? b : 3;
            bf16x8 qn[4];
            { const bf16* qp = Qb + (size_t)(256 * b + 16 * wave + fr) * D + (4 * kvh + 2 * hp) * 128 + 8 * fq;
#pragma unroll
              for (int ks = 0; ks < 4; ++ks) qn[ks] = *(const bf16x8*)(qp + 32 * ks); }
            __syncthreads();
#pragma unroll 1
            for (int u = 0; u < 4; ++u) {
                const int g = (u & 1) ? 15 - wave : wave, h = 4 * kvh + 2 * hp + (u >> 1); const int tl = 16 * g + fr; const int tok = 256 * b + tl;
                bf16x8 qf[4];
#pragma unroll
                for (int ks = 0; ks < 4; ++ks) qf[ks] = qn[ks];
                if (u < 3) { const int gn = ((u + 1) & 1) ? 15 - wave : wave, hn = 4 * kvh + 2 * hp + ((u + 1) >> 1); const bf16* qp = Qb + (size_t)(256 * b + 16 * gn + fr) * D + hn * 128 + 8 * fq;
#pragma unroll
                    for (int ks = 0; ks < 4; ++ks) qn[ks] = *(const bf16x8*)(qp + 32 * ks); }
                float msa[3], lsa[3];
#pragma unroll
                for (int r = 0; r < 3; ++r) { msa[r] = -INFINITY; lsa[r] = 0.f; if (r < nsel) { const size_t slot = ((size_t)tok * NH + h) * 3 + r; msa[r] = MLslot[slot * 2]; lsa[r] = MLslot[slot * 2 + 1]; } }
                v4u ow[3][4];
#pragma unroll
                for (int r = 0; r < 3; ++r) { if (r < nsel) { const bf16* op = Oslot + (((size_t)tok * NH + h) * 3 + r) * 128 + 8 * fq;
#pragma unroll
                    for (int c = 0; c < 4; ++c) ow[r][c] = *(const v4u*)(op + 32 * c); } }
                const int nkt = g + 1;
                f32x4 acc[16]; attn_scores<16>(Ks, qf, acc, nkt, fr, fq);
                float mx = -INFINITY;
#pragma unroll
                for (int kt = 0; kt < 16; ++kt) {
#pragma unroll
                    for (int r = 0; r < 4; ++r) { const bool ok = (kt < nkt) && (16 * kt + 4 * fq + r <= tl); const float sv = ok ? acc[kt][r] : -INFINITY; acc[kt][r] = sv; mx = fmaxf(mx, sv); } }
                mx = fmaxf(mx, shx<16>(mx)); mx = xmax32(mx);
                float M = mx;
#pragma unroll
                for (int r = 0; r < 3; ++r) M = fmaxf(M, msa[r]);
                f32x4 O[8]; float lp = 0.f;
#pragma unroll
                for (int vt = 0; vt < 8; ++vt) O[vt] = (f32x4){0.f, 0.f, 0.f, 0.f};
#pragma unroll
                for (int r = 0; r < 3; ++r) { if (r < nsel) { const float sc = __builtin_amdgcn_exp2f(msa[r] - M); lp += lsa[r] * sc;
#pragma unroll
                    for (int c = 0; c < 4; ++c) { const v4u w = ow[r][c];
                        O[2 * c][0] += bf2f(w.x & 0xffffu) * sc; O[2 * c][1] += bf2f(w.x >> 16) * sc; O[2 * c][2] += bf2f(w.y & 0xffffu) * sc; O[2 * c][3] += bf2f(w.y >> 16) * sc;
                        O[2 * c + 1][0] += bf2f(w.z & 0xffffu) * sc; O[2 * c + 1][1] += bf2f(w.z >> 16) * sc; O[2 * c + 1][2] += bf2f(w.w & 0xffffu) * sc; O[2 * c + 1][3] += bf2f(w.w >> 16) * sc; } } }
                float l = 0.f;
#pragma unroll
                for (int kt = 0; kt < 16; ++kt) {
#pragma unroll
                    for (int r = 0; r < 4; ++r) { const float p = __builtin_amdgcn_exp2f(acc[kt][r] - M); acc[kt][r] = p; l += p; } }
                l += shx<16>(l); l = xadd32(l); l += lp;
                attn_pv(Vs, acc, O, (nkt + 1) >> 1, fr, fq);
                const float il = 1.0f / l; bf16* ap = At + (size_t)tok * D + h * 128 + 4 * fq;
#pragma unroll
                for (int vt = 0; vt < 8; ++vt) { v2u w; w.x = cvt_pk_bf16(O[vt][0] * il, O[vt][1] * il); w.y = cvt_pk_bf16(O[vt][2] * il, O[vt][3] * il); *(v2u*)(ap + 16 * vt) = w; }
            }
            __syncthreads();
        }
        TACC(10, tq12); const unsigned ts12 = TNOW();
        LAS float* ksn = (LAS float*)(lds);
        for (int item = bid; item < DECB * NKV; item += G) {
            const int b = item >> 2, kvh = item & 3;
            TIDS;
            { const int key = tid >> 7, d = tid & 127; ksn[key * 128 + d] = out[OK_S + (size_t)(4 * b + key) * 512 + kvh * 128 + d]; ksn[512 + key * 128 + d] = out[OV_S + (size_t)(4 * b + key) * 512 + kvh * 128 + d]; }
            __syncthreads();
            const int pr = tid >> 5, l32 = tid & 31; const int t = pr >> 2, hg = pr & 3; const int row = SEQ + 4 * b + t, h = 4 * kvh + hg;
            const v2u qw = *(const v2u*)(Qb + (size_t)row * D + h * 128 + 4 * l32);
            const float q0 = bf2f(qw.x & 0xffffu), q1 = bf2f(qw.x >> 16), q2 = bf2f(qw.y & 0xffffu), q3 = bf2f(qw.y >> 16);
            float sk[4]; float M = -INFINITY;
#pragma unroll
            for (int key = 0; key < 4; ++key) { const f32x4 k4 = *(const LAS f32x4*)(ksn + key * 128 + 4 * l32); float s = (q0 * k4[0] + q1 * k4[1]) + (q2 * k4[2] + q3 * k4[3]);
                s += shx<1>(s); s += shx<2>(s); s += shx<4>(s); s += shx<8>(s); s += shx<16>(s);
                sk[key] = (key <= t) ? s : -INFINITY; M = fmaxf(M, sk[key]); }
            unsigned mk = Sels[item * 16 + pr];
            float sm[3], sl[3]; f32x4 so[3]; bool sv[3];
#pragma unroll
            for (int i = 0; i < 3; ++i) { sv[i] = mk != 0u; const int n = sv[i] ? __builtin_ctz(mk) : 0; mk &= mk - 1u;
                const float* sp = Sslot + ((size_t)(item * 32 + n) * 16 + pr) * 132; sm[i] = sp[128]; sl[i] = sp[129]; so[i] = *(const f32x4*)(sp + 4 * l32); }
#pragma unroll
            for (int i = 0; i < 3; ++i) if (sv[i]) M = fmaxf(M, sm[i]);
            float l = 0.f; f32x4 O = {0.f, 0.f, 0.f, 0.f};
#pragma unroll
            for (int key = 0; key < 4; ++key) { const float p = __builtin_amdgcn_exp2f(sk[key] - M); l += p; O += *(const LAS f32x4*)(ksn + 512 + key * 128 + 4 * l32) * p; }
#pragma unroll
            for (int i = 0; i < 3; ++i) if (sv[i]) { const float sc = __builtin_amdgcn_exp2f(sm[i] - M); l += sl[i] * sc; O += so[i] * sc; }
            const float il = 1.0f / l; v2u w; w.x = cvt_pk_bf16(O[0] * il, O[1] * il); w.y = cvt_pk_bf16(O[2] * il, O[3] * il);
            *(v2u*)(At + (size_t)row * D + h * 128 + 4 * l32) = w;
            __syncthreads();
        }
        TACC(11, ts12);
    }
    xcd_barrier(bar, IS_T0);
    STAMP();

    {
        TIDS;
        pg8::Gemm g{At, Wo_t, SEQ, D, D}; pg8::StaticOrder S; S.init(SEQ, D, G, bid);
        EpiRes<1> E{Hb2, nullptr, nullptr, Hb3, ss3};
        pg8::gemm_phase<EpiRes<1>, pg8::StaticOrder, true, true, false>(lds, g, S, E, TIDX);
        { const int t2 = bid & 127, rh = (bid >> 7) & 1; TIDS; f32x4 ta[1]; tail_gemm<1, D>(lds, At + (size_t)SEQ * D, Wo_t, 16 * t2, rh, ta, TIDX, bid & 127); if (wave < 4) E.tail(SEQ + 64 * rh + 16 * wave + fr, 16 * t2 + 4 * fq, ta[0], fq); }
    }
    xcd_barrier(bar, IS_T0);
    STAMP();
    {
        TIDS;
        pg8::Gemm g{Hb3, Wgu1_t, MP, NGU, D}; pg8::StaticOrder S; S.init(MP, NGU, G, bid);
        EpiGU E{ss3, Hm};
        pg8::gemm_phase<EpiGU, pg8::StaticOrder, true, true>(lds, g, S, E, TIDX);
        constexpr int GG = 172;
        if (bid >= GG) {
            constexpr int I_DN = 88 * 32;
            LAS float* scr = (LAS float*)(lds + wave * 17408);
            const int gw = (bid - GG) * NWAVES + wave, NGW = (G - GG) * NWAVES;
            for (int it = gw; it < I_DN; it += 2 * NGW) {
                const bool hb = it + NGW < I_DN; TrItem ta, tb; ta.W = w_dn + (size_t)DFF * D; ta.gain = nullptr; ta.WT = Wdn1_t; ta.K = DFF; ta.N = D; ta.row_off = 0; ta.item = it; tb = ta; tb.item = hb ? it + NGW : it;
                f32x4 wa[16], wb[16]; float ga[16], gb[16];
                tr_load(ta, wa, ga, lane); if (hb) tr_load(tb, wb, gb, lane);
                tr_store(ta, wa, ga, scr, lane); if (hb) tr_store(tb, wb, gb, scr, lane);
            }
        }
    }
    xcd_barrier(bar, IS_T0);
    STAMP();
    {
        TIDS;
        pg8::Gemm g{Hm, Wdn1_t, SEQ, D, DFF}; pg8::StaticOrder S; S.init(SEQ, D, G, bid);
        EpiRes<2> E{Hb3, out + OY_P, out + OY_S, nullptr, nullptr};
        pg8::gemm_phase<EpiRes<2>, pg8::StaticOrder, true, true, false>(lds, g, S, E, TIDX);
        { const int t2 = bid & 127, rh = (bid >> 7) & 1; TIDS; f32x4 ta[1]; tail_gemm<1, DFF>(lds, Hm + (size_t)SEQ * DFF, Wdn1_t, 16 * t2, rh, ta, TIDX, bid & 127); if (wave < 4) E.tail(SEQ + 64 * rh + 16 * wave + fr, 16 * t2 + 4 * fq, ta[0], fq); }
    }
#ifdef PROF_A
    STAMP();
    if (blockIdx.x == 0 && IS_T0) {
        const unsigned ta = PVAL(PROF_A0, PROF_A1), tb = PVAL(PROF_B0, PROF_B1);
        unsigned qa = (ta + PROF_UA / 2) / PROF_UA, qb = (tb + PROF_UB / 2) / PROF_UB; if (qa > 99u) qa = 99u; if (qb > 99u) qb = 99u;
#ifdef PROF_MUL
        const unsigned long long extra = (unsigned long long)ta * PROF_MUL;
#else
        const unsigned long long extra = (unsigned long long)(qa + 100u * qb) * 5000ull;
#endif
        const unsigned long long t0 = __builtin_amdgcn_s_memrealtime();
        while (__builtin_amdgcn_s_memrealtime() - t0 < extra) __builtin_amdgcn_s_sleep(32);
    }
#endif
}
#undef x_p
#undef x_s
#undef st_in
#undef cache_k
#undef cache_v
#undef ptab
#undef norm_mix_a
#undef w_in
#undef lbl
#undef onorm
#undef w_out
#undef norm_kv
#undef w_kv
#undef k_norm
#undef norm_mix_b
#undef w_q
#undef q_norm
#undef w_o
#undef norm_ffn
#undef w_gu
#undef w_dn
#undef Win_t
#undef Wout_t
#undef Wgu0_t
#undef Wdn0_t
#undef Wkvq_t
#undef Wo_t
#undef Wgu1_t
#undef Wdn1_t
#undef Hb0
#undef Hb1
#undef Hb2
#undef Hb3
#undef Hf1
#undef Hf2
#undef Hf3
#undef Qg
#undef Vg
#undef Gg
#undef Ff
#undef Ob
#undef At
#undef Hm
#undef Ug
#undef Sg0
#undef Dg
#undef Kraw
#undef Vraw
#undef Qraw
#undef Kb
#undef Vb
#undef Qb
#undef Kpart
#undef Kms
#undef Subl
#undef Scnt
#undef Sels
#undef Oslot
#undef MLslot
#undef Sslot
#undef ss0
#undef ss1
#undef ss2
#undef ss3
#undef out
#undef TIDS
#undef TIDX
#undef IS_T0

extern "C" void kernel_launch(void* const* d_in, const int* in_sizes, int n_in, void* d_out, int out_size, void* d_ws, size_t ws_size, hipStream_t stream) {
    static int grid = 0;
    if (grid == 0) {
        if (n_in != 21 || ws_size < WS_END) { fprintf(stderr, "kernel_launch: unexpected n_in %d / ws %zu\n", n_in, ws_size); grid = -1; return; }
        int dev = 0, cus = 0, per_cu = 0;
        if (hipGetDevice(&dev) != hipSuccess || hipDeviceGetAttribute(&cus, hipDeviceAttributeMultiprocessorCount, dev) != hipSuccess) { grid = -1; return; }
        if (hipFuncSetAttribute((const void*)yoco_fwd, hipFuncAttributeMaxDynamicSharedMemorySize, LDS_BYTES) != hipSuccess) { fprintf(stderr, "kernel_launch: hipFuncSetAttribute failed\n"); grid = -1; return; }
        if (hipOccupancyMaxActiveBlocksPerMultiprocessor(&per_cu, (const void*)yoco_fwd, NTHR, LDS_BYTES) != hipSuccess || per_cu < 1) fprintf(stderr, "kernel_launch: occupancy query says %d\n", per_cu);
        (void)hipGetLastError();
        grid = cus;
        if (grid < 256) { fprintf(stderr, "kernel_launch: built for 256 CUs (got %d)\n", grid); grid = -1; return; }
        grid = 256;
    }
    if (grid < 0) return;
    (void)hipMemsetAsync((char*)d_ws + WS_CTL, 0, CTL_ZERO_BYTES, stream);
    Args a{};
    for (int i = 0; i < 21; ++i) a.in[i] = d_in[i];
    a.out = (float*)d_out; a.ws = (unsigned char*)d_ws;
    hipLaunchKernelGGL(yoco_fwd, dim3(grid), dim3(NTHR), LDS_BYTES, stream, a);
}
```

```cpp
#include <hip/hip_runtime.h>
#include <cstdio>
#include <cstdint>
__device__ __forceinline__ int lane_id() { int l; asm volatile("v_mbcnt_lo_u32_b32 %0, -1, 0\n\tv_mbcnt_hi_u32_b32 %0, -1, %0" : "=v"(l)); return l; }

namespace pg8 {
#define PG8_LAS __attribute__((address_space(3)))
typedef unsigned short bf16_t;
typedef short bf16x8 __attribute__((ext_vector_type(8)));
typedef float f32x4 __attribute__((ext_vector_type(4)));
typedef unsigned u32x4 __attribute__((ext_vector_type(4)));
typedef unsigned u32x2 __attribute__((ext_vector_type(2)));
constexpr int BM = 256, BK = 64, HALF = 128, HTB = HALF * BK * 2, STAGE_BYTES = 8 * HTB, NXCD = 8, WGM = 8;

__host__ __device__ __forceinline__ int lds_byte(int r, int c) { const int st = (r >> 4) * 2 + (c >> 5), rr = r & 15, cc = c & 31, ob = rr * 64 + cc * 2; return st * 1024 + (ob ^ (((ob >> 9) & 1) << 5)); }
__host__ __device__ __forceinline__ void stage_rc(int b, int& R, int& C) { const int st = b / 1024, sb = b % 1024, swz = sb ^ (((sb >> 9) & 1) << 5); R = (st >> 1) * 16 + swz / 64; C = (st & 1) * 32 + (swz % 64) / 2; }
__host__ __device__ __forceinline__ int perm32(int rho) { const int n = rho >> 4, i = rho & 15; return 8 * (i >> 2) + 4 * n + (i & 3); }

struct Unit { int pm, pn; };
struct Gemm { const bf16_t* A; const bf16_t* Bt; int M, N, K; };

struct StaticOrder {
    int nM, nN, nwg, G, c;
    __host__ __device__ void init(int M, int N, int G_, int c_) { nM = M / BM; nN = N / BM; nwg = nM * nN; G = G_; c = c_; }
    __host__ __device__ bool next(int i, Unit& u) const {
        const long L = (long)i * G + c; if (L >= nwg) return false;
        int wgid = (int)L; { const int q = nwg / NXCD, r = nwg % NXCD, xcd = wgid % NXCD, off = wgid / NXCD; wgid = (xcd < r ? xcd * (q + 1) : r * (q + 1) + (xcd - r) * q) + off; }
        const int nig = WGM * nN, gid = wgid / nig, fm = gid * WGM, gsz = (nM - fm) < WGM ? (nM - fm) : WGM;
        u.pm = fm + ((wgid % nig) % gsz); u.pn = (wgid % nig) / gsz; return true;
    }
    __device__ __forceinline__ void a_ready(const Unit&) const {}
    __device__ __forceinline__ void done(const Unit&) const {}
};

__device__ __forceinline__ unsigned cvt_pk_bf16(float lo, float hi) { unsigned r; asm volatile("v_cvt_pk_bf16_f32 %0, %1, %2" : "=v"(r) : "v"(lo), "v"(hi)); return r; }

template <class Epi, class Sched, bool ALIGN_EPI = false, bool SP2 = false, bool HALF_LAST = true>
__device__ __forceinline__ void gemm_phase(PG8_LAS unsigned char* lds, const Gemm g, const Sched& S, const Epi& E, int tidx) {
    int tid_ = tidx; asm volatile("" : "+v"(tid_));
    const int tid = tid_, wid = __builtin_amdgcn_readfirstlane(tid >> 6), lane = tid & 63, wr = wid >> 2, wc = wid & 3, fr = lane & 15, fq = lane >> 4;
    const int K = g.K, nt = K / BK;
    unsigned voffA[2], voffB[2];
#pragma unroll
    for (int i = 0; i < 2; ++i) { int R, C; stage_rc(tid * 16 + i * 8192, R, C); const int Rb = Epi::PERM ? ((R & ~31) + perm32(R & 31)) : R;
        voffA[i] = (unsigned)(R * K + C) * 2u; voffB[i] = (unsigned)(Rb * K + C) * 2u; }
    const size_t kstep = (size_t)(BK * 2);
    const size_t hstep = (size_t)HALF * K * 2;
    const size_t tstep = 2 * hstep;
    const unsigned ldsw = (unsigned)wid * 1024u;
    const int aoff = lds_byte(wr * 64 + fr, fq * 8), boff = lds_byte(wc * 32 + fr, fq * 8);
#define PG8_SA(b, h) (((b) * 2 + (h)) * HTB)
#define PG8_SB(b, h) ((4 + (b) * 2 + (h)) * HTB)
#define PG8_STAGE(bufoff, gbase, voff) do { _Pragma("unroll") for (int _i = 0; _i < 2; ++_i) \
        __builtin_amdgcn_global_load_lds((const unsigned*)((const char*)(gbase) + (voff)[_i]), (PG8_LAS unsigned*)(lds + (bufoff) + ldsw + _i * 8192), 16, 0, 0); } while (0)
#define PG8_LDA(dst, b, h) do { _Pragma("unroll") for (int m = 0; m < 4; ++m) _Pragma("unroll") for (int k = 0; k < 2; ++k) dst[m][k] = *(const PG8_LAS bf16x8*)(lds + PG8_SA(b, h) + aoff + m * 2048 + k * 1024); } while (0)
#define PG8_LDB(dst, b, h) do { _Pragma("unroll") for (int n = 0; n < 2; ++n) _Pragma("unroll") for (int k = 0; k < 2; ++k) dst[n][k] = *(const PG8_LAS bf16x8*)(lds + PG8_SB(b, h) + boff + n * 2048 + k * 1024); } while (0)
#define PG8_MMA(ai, bj, At, Bt) do { __builtin_amdgcn_s_setprio(1); _Pragma("unroll") for (int m = 0; m < 4; ++m) _Pragma("unroll") for (int n = 0; n < 2; ++n) _Pragma("unroll") for (int k = 0; k < 2; ++k) \
        acc[ai][bj][m][n] = __builtin_amdgcn_mfma_f32_16x16x32_bf16(Bt[n][k], At[m][k], acc[ai][bj][m][n], 0, 0, 0); __builtin_amdgcn_s_setprio(0); } while (0)
#define PG8_WAIT_V(n) asm volatile("s_waitcnt vmcnt(" #n ")" ::: "memory")
#define PG8_WAIT_L(n) asm volatile("s_waitcnt lgkmcnt(" #n ")" ::: "memory")
#define PG8_BAR __builtin_amdgcn_s_barrier()
#define PG8_SCHED __builtin_amdgcn_sched_barrier(0)
    Unit cur, nxt; int ui = 0;
    if (!S.next(0, cur)) return;
    f32x4 acc[2][2][4][2];
#pragma unroll
    for (int a = 0; a < 2; ++a)
#pragma unroll
        for (int b = 0; b < 2; ++b)
#pragma unroll
            for (int m = 0; m < 4; ++m)
#pragma unroll
                for (int n = 0; n < 2; ++n) acc[a][b][m][n] = (f32x4){0.f, 0.f, 0.f, 0.f};
    bf16x8 At[4][2], B0[2][2], B1[2][2];
    const char* cA = (const char*)g.A + (size_t)cur.pm * tstep; const char* cB = (const char*)g.Bt + (size_t)cur.pn * tstep;
    S.a_ready(cur);
    if constexpr (SP2) {
        PG8_STAGE(PG8_SB(0, 0), cB, voffB); PG8_STAGE(PG8_SB(0, 1), cB + hstep, voffB); PG8_STAGE(PG8_SA(0, 0), cA, voffA); PG8_STAGE(PG8_SA(0, 1), cA + hstep, voffA);
        if (wr == 1) PG8_BAR;
        PG8_WAIT_V(2); PG8_BAR;
        PG8_STAGE(PG8_SB(1, 0), cB + kstep, voffB); PG8_STAGE(PG8_SA(1, 0), cA + kstep, voffA); PG8_STAGE(PG8_SB(1, 1), cB + hstep + kstep, voffB);
        PG8_WAIT_V(6); PG8_BAR;
    } else {
        PG8_STAGE(PG8_SB(0, 0), cB, voffB); PG8_STAGE(PG8_SA(0, 0), cA, voffA); PG8_STAGE(PG8_SB(0, 1), cB + hstep, voffB); PG8_STAGE(PG8_SA(0, 1), cA + hstep, voffA);
        if (wr == 1) PG8_BAR;
        PG8_WAIT_V(4); PG8_BAR;
        PG8_STAGE(PG8_SB(1, 0), cB + kstep, voffB); PG8_STAGE(PG8_SA(1, 0), cA + kstep, voffA); PG8_STAGE(PG8_SB(1, 1), cB + hstep + kstep, voffB);
        PG8_WAIT_V(6); PG8_BAR;
    }
    for (;;) {
        const bool has_next = S.next(ui + 1, nxt);
        const bool half1 = HALF_LAST && (cur.pm == g.M / BM - 1);
        const char* nA = has_next ? (const char*)g.A + (size_t)nxt.pm * tstep : cA; const char* nB = has_next ? (const char*)g.Bt + (size_t)nxt.pn * tstep : cB;
        for (int t = 0; t < nt; t += 2) {
            const bool last = (t == nt - 2);
            const char* a1 = cA + (size_t)(t + 1) * kstep;
            const char* a2 = last ? nA : cA + (size_t)(t + 2) * kstep; const char* b2 = last ? nB : cB + (size_t)(t + 2) * kstep;
            const char* a3 = a2 + kstep; const char* b3 = b2 + kstep;
            if (last && has_next) S.a_ready(nxt);
            if constexpr (SP2) {
            PG8_LDB(B0, 0, 0); PG8_LDB(B1, 0, 1); PG8_SCHED; PG8_LDA(At, 0, 0); PG8_STAGE(PG8_SA(1, 1), a1 + hstep, voffA);
            PG8_WAIT_V(8); PG8_WAIT_L(0); PG8_BAR; PG8_MMA(0, 0, At, B0); PG8_MMA(0, 1, At, B1); PG8_BAR; PG8_SCHED;
            if (!half1) { PG8_LDA(At, 0, 1); } PG8_STAGE(PG8_SB(0, 0), b2, voffB); PG8_STAGE(PG8_SB(0, 1), b2 + hstep, voffB); PG8_STAGE(PG8_SA(0, 0), a2, voffA);
            PG8_WAIT_V(8); PG8_WAIT_L(0); PG8_BAR; if (!half1) { PG8_MMA(1, 0, At, B0); PG8_MMA(1, 1, At, B1); } PG8_BAR; PG8_SCHED;
            PG8_LDB(B0, 1, 0); PG8_LDB(B1, 1, 1); PG8_SCHED; PG8_LDA(At, 1, 0); PG8_STAGE(PG8_SA(0, 1), a2 + hstep, voffA);
            PG8_WAIT_V(8); PG8_WAIT_L(0); PG8_BAR; PG8_MMA(0, 0, At, B0); PG8_MMA(0, 1, At, B1); PG8_BAR; PG8_SCHED;
            if (!half1) { PG8_LDA(At, 1, 1); } PG8_STAGE(PG8_SB(1, 0), b3, voffB); PG8_STAGE(PG8_SB(1, 1), b3 + hstep, voffB); PG8_STAGE(PG8_SA(1, 0), a3, voffA);
            PG8_WAIT_V(8); PG8_WAIT_L(0); PG8_BAR; if (!half1) { PG8_MMA(1, 0, At, B0); PG8_MMA(1, 1, At, B1); } PG8_BAR; PG8_SCHED;
            } else {
            PG8_LDB(B0, 0, 0); PG8_SCHED; PG8_LDA(At, 0, 0); PG8_STAGE(PG8_SA(1, 1), a1 + hstep, voffA);
            PG8_WAIT_L(8); PG8_BAR; PG8_WAIT_L(0); PG8_MMA(0, 0, At, B0); PG8_BAR; PG8_SCHED;
            PG8_LDB(B1, 0, 1); PG8_STAGE(PG8_SB(0, 0), b2, voffB);
            PG8_BAR; PG8_WAIT_L(0); PG8_MMA(0, 1, At, B1); PG8_BAR;
            PG8_LDA(At, 0, 1); PG8_STAGE(PG8_SA(0, 0), a2, voffA);
            PG8_BAR; PG8_WAIT_L(0); PG8_MMA(1, 0, At, B0); PG8_BAR; PG8_SCHED;
            PG8_STAGE(PG8_SB(0, 1), b2 + hstep, voffB);
            PG8_WAIT_V(6); PG8_BAR; PG8_MMA(1, 1, At, B1); PG8_BAR;
            PG8_LDB(B0, 1, 0); PG8_SCHED; PG8_LDA(At, 1, 0); PG8_STAGE(PG8_SA(0, 1), a2 + hstep, voffA);
            PG8_WAIT_L(8); PG8_BAR; PG8_WAIT_L(0); PG8_MMA(0, 0, At, B0); PG8_BAR; PG8_SCHED;
            PG8_LDB(B1, 1, 1); PG8_STAGE(PG8_SB(1, 0), b3, voffB);
            PG8_BAR; PG8_WAIT_L(0); PG8_MMA(0, 1, At, B1); PG8_BAR;
            PG8_LDA(At, 1, 1); PG8_STAGE(PG8_SA(1, 0), a3, voffA);
            PG8_BAR; PG8_WAIT_L(0); PG8_MMA(1, 0, At, B0); PG8_BAR; PG8_SCHED;
            PG8_STAGE(PG8_SB(1, 1), b3 + hstep, voffB);
            PG8_WAIT_V(6); PG8_BAR; PG8_MMA(1, 1, At, B1); PG8_BAR;
            }
        }
        if constexpr (ALIGN_EPI) { if (wr == 0) PG8_BAR; }
        E(acc, cur, wr, wc, fr, fq);
        if (!has_next) break;
#pragma unroll
        for (int a = 0; a < 2; ++a)
#pragma unroll
            for (int b = 0; b < 2; ++b)
#pragma unroll
                for (int m = 0; m < 4; ++m)
#pragma unroll
                    for (int n = 0; n < 2; ++n) acc[a][b][m][n] = (f32x4){0.f, 0.f, 0.f, 0.f};
        cur = nxt; cA = nA; cB = nB; ++ui;
        if constexpr (ALIGN_EPI) { if (wr == 1) PG8_BAR; }
    }
    PG8_WAIT_V(0);
    if constexpr (!ALIGN_EPI) { if (wr == 0) PG8_BAR; }
    PG8_BAR;
#undef PG8_SA
#undef PG8_SB
#undef PG8_STAGE
#undef PG8_LDA
#undef PG8_LDB
#undef PG8_MMA
#undef PG8_WAIT_V
#undef PG8_WAIT_L
#undef PG8_BAR
#undef PG8_SCHED
}
}

constexpr int NWAVES = 8, NTHR = 512;
constexpr int D = 2048, SEQ = 8192, DECB = 32, DECS = 4, MS = DECB * DECS;
constexpr int MR = SEQ + MS;
constexpr int MP = 8448;
constexpr int NH = 16, HD = 128, NKV = 4, DFF = 5632, NGU = 2 * DFF;
constexpr int NCHUNK = SEQ / 64;
constexpr int NPAGES = 64, PAGE = 128, NBLK = 32;
constexpr float EPS = 1e-6f;
constexpr float C2 = 0.08838834764831845f * 1.4426950408889634f;

constexpr size_t OY_P = 0, OY_S = OY_P + (size_t)SEQ * D, OST_P = OY_S + (size_t)MS * D, OST_S = OST_P + (size_t)NH * 128 * 128,
                 OK_P = OST_S + (size_t)DECB * NH * 128 * 128, OV_P = OK_P + (size_t)SEQ * 512, OK_S = OV_P + (size_t)SEQ * 512, OV_S = OK_S + (size_t)MS * 512;

constexpr size_t MiB = 1u << 20;
constexpr size_t WS_CTL = 0, CTL_ZERO_BYTES = 1 * MiB;
constexpr size_t WS_WIN = 2 * MiB;
constexpr size_t WS_WOUT = WS_WIN + 32 * MiB;
constexpr size_t WS_WGU0 = WS_WOUT + 8 * MiB;
constexpr size_t WS_WDN0 = WS_WGU0 + 44 * MiB;
constexpr size_t WS_WKVQ = WS_WDN0 + 22 * MiB;
constexpr size_t WS_WO = WS_WKVQ + 12 * MiB;
constexpr size_t WS_WGU1 = WS_WO + 8 * MiB;
constexpr size_t WS_WDN1 = WS_WGU1 + 44 * MiB;
constexpr size_t WS_HB0 = WS_WDN1 + 22 * MiB;
constexpr size_t WS_HB1 = WS_HB0 + 34 * MiB, WS_HB2 = WS_HB1 + 34 * MiB, WS_HB3 = WS_HB2 + 34 * MiB;
constexpr size_t WS_HF1 = WS_HB3 + 34 * MiB;
constexpr size_t WS_HF2 = WS_HF1 + 67 * MiB, WS_HF3 = WS_HF2 + 67 * MiB;
constexpr size_t WS_QG = WS_HF3 + 67 * MiB;
constexpr size_t WS_VG = WS_QG + 34 * MiB;
constexpr size_t WS_GG = WS_VG + 34 * MiB;
constexpr size_t WS_F = WS_GG + 34 * MiB;
constexpr size_t WS_OB = WS_F + 67 * MiB;
constexpr size_t WS_AT = WS_OB + 34 * MiB;
constexpr size_t WS_HM = WS_AT + 34 * MiB;
constexpr size_t WS_U = WS_HM + 92 * MiB;
constexpr size_t WS_SST = WS_U + 64 * MiB;
constexpr size_t WS_DEC = WS_SST + 64 * MiB;
constexpr size_t WS_KRAW = WS_DEC + 2 * MiB;
constexpr size_t WS_VRAW = WS_KRAW + 17 * MiB;
constexpr size_t WS_QRAW = WS_VRAW + 17 * MiB;
constexpr size_t WS_KB = WS_QRAW + 67 * MiB;
constexpr size_t WS_VB = WS_KB + 9 * MiB;
constexpr size_t WS_QB = WS_VB + 9 * MiB;
constexpr size_t WS_KPART = WS_QB + 34 * MiB;
constexpr size_t WS_KMS = WS_KPART + 1 * MiB;
constexpr size_t WS_SUBL = WS_KMS + 2 * MiB;
constexpr size_t WS_SCNT = WS_SUBL + 16 * MiB;
constexpr size_t WS_OSLOT = WS_SCNT + 1 * MiB;
constexpr size_t WS_MLSLOT = WS_OSLOT + 192 * MiB;
constexpr size_t WS_SSLOT = WS_MLSLOT + 3 * MiB;
constexpr size_t WS_FOUT = WS_SSLOT + 34 * MiB;
constexpr size_t WS_END = WS_FOUT + 131 * MiB;
constexpr size_t WS_ORC = WS_END;
constexpr int CW_BAR = 4096;
constexpr int CW_Q0 = 8192;
constexpr int CW_SS0 = 16384, CW_SS1 = CW_SS0 + MP, CW_SS2 = CW_SS1 + MP, CW_SS3 = CW_SS2 + MP;
static_assert((CW_SS3 + MP) * 4 <= (int)CTL_ZERO_BYTES, "ctl");
static_assert(WS_VG - WS_QG == 34 * MiB && WS_GG - WS_VG == 34 * MiB, "Qg|Vg|Gg stride");

constexpr int LDS_BYTES = 160 * 1024;
constexpr int MISC_OFF = LDS_BYTES - 256;

#define GAS __attribute__((address_space(1)))
#define LAS __attribute__((address_space(3)))
typedef unsigned short bf16;
typedef unsigned v4u __attribute__((ext_vector_type(4)));
typedef unsigned v2u __attribute__((ext_vector_type(2)));
typedef float f32x4 __attribute__((ext_vector_type(4)));
typedef float f32x2 __attribute__((ext_vector_type(2)));
typedef short bf16x8 __attribute__((ext_vector_type(8)));
typedef short bf16x4 __attribute__((ext_vector_type(4)));
typedef _Float16 f16;
typedef _Float16 f16x2 __attribute__((ext_vector_type(2)));
__device__ __forceinline__ unsigned pkh2(float lo, float hi) { const f16x2 v = {(f16)lo, (f16)hi}; return __builtin_bit_cast(unsigned, v); }
#define LDS_WAIT() asm volatile("s_waitcnt lgkmcnt(0)" ::: "memory")
__device__ __forceinline__ unsigned f2bf(float f) { unsigned u = __builtin_bit_cast(unsigned, f); return (u + 0x7fffu + ((u >> 16) & 1u)) >> 16; }
__device__ __forceinline__ unsigned pk2(float lo, float hi) { return f2bf(lo) | (f2bf(hi) << 16); }
__device__ __forceinline__ float bf2f(unsigned h) { return __uint_as_float(h << 16); }
__device__ __forceinline__ float silu_f(float x) { return x * __builtin_amdgcn_rcpf(1.0f + __expf(-x)); }
__device__ __forceinline__ float sigm_f(float x) { return __builtin_amdgcn_rcpf(1.0f + __expf(-x)); }
template <int M> __device__ __forceinline__ float shx(float v) { return __uint_as_float((unsigned)__builtin_amdgcn_ds_swizzle((int)__float_as_uint(v), (M << 10) | 0x1f)); }
__device__ __forceinline__ float xadd32(float v) { auto rr = __builtin_amdgcn_permlane32_swap(__float_as_uint(v), __float_as_uint(v), false, false); return __uint_as_float(rr[0]) + __uint_as_float(rr[1]); }
__device__ __forceinline__ float xmax32(float v) { auto rr = __builtin_amdgcn_permlane32_swap(__float_as_uint(v), __float_as_uint(v), false, false); return fmaxf(__uint_as_float(rr[0]), __uint_as_float(rr[1])); }
__device__ __forceinline__ float wave_sum(float v) { v += shx<1>(v); v += shx<2>(v); v += shx<4>(v); v += shx<8>(v); v += shx<16>(v); return xadd32(v); }
#define MFMA16(a, b, c) __builtin_amdgcn_mfma_f32_16x16x32_bf16((a), (b), (c), 0, 0, 0)

#define XB_TMO      128
#define XB_XCNT(j)  (256  + 64 * (j))
#define XB_XSUB(j)  (1280 + 64 * (j))
#define XB_XGEN(j)  (2304 + 64 * (j))
#define XB_TOP      3328
#define XB_TOPGEN   3392
#define XCD_BAR_WORDS 3456
#define XB_SPIN_CAP (1u << 18)
__device__ __forceinline__ unsigned xb_ld(unsigned* p)              { return __hip_atomic_load(p, __ATOMIC_RELAXED, __HIP_MEMORY_SCOPE_AGENT); }
__device__ __forceinline__ unsigned xb_add(unsigned* p, unsigned v) { return __hip_atomic_fetch_add(p, v, __ATOMIC_RELAXED, __HIP_MEMORY_SCOPE_AGENT); }
__device__ __forceinline__ unsigned xb_xcc_id() { return (unsigned)__builtin_amdgcn_s_getreg((3 << 11) | 20) & 0xFu; }
#define XB_SPIN(cond, bar) do { unsigned _sp = 0; while (cond) { __builtin_amdgcn_s_sleep(1); \
    if ((++_sp & 255u) == 0u) { if (xb_ld(&(bar)[XB_TMO])) break; if (_sp > XB_SPIN_CAP) { atomicAdd(&(bar)[XB_TMO], 1u); break; } } } } while (0)
struct XcdBarrier { unsigned* bar; unsigned x; volatile LAS unsigned* st; };
__device__ __forceinline__ XcdBarrier xcd_barrier_post(unsigned* bar, volatile LAS unsigned* st, bool is_t0) {
    XcdBarrier b; b.bar = bar; b.x = xb_xcc_id(); b.st = st;
    if (is_t0) (void)xb_add(&bar[XB_XCNT(b.x)], 1u);
    return b;
}
__device__ __forceinline__ void xcd_barrier_complete(unsigned* bar, unsigned x, unsigned& nloc, unsigned& nx) {
    const unsigned G = gridDim.x * gridDim.y * gridDim.z;
    unsigned sum, cnt, mine, sp = 0u;
    for (;;) {
        sum = 0u; cnt = 0u; mine = 0u;
#pragma unroll
        for (unsigned j = 0; j < 16; ++j) { const unsigned c = xb_ld(&bar[XB_XCNT(j)]); sum += c; cnt += (c > 0u) ? 1u : 0u; mine = (j == x) ? c : mine; }
        if (sum == G) break;
        __builtin_amdgcn_s_sleep(1);
        if ((++sp & 255u) == 0u) { if (xb_ld(&bar[XB_TMO])) break; if (sp > XB_SPIN_CAP) { atomicAdd(&bar[XB_TMO], 1u); break; } }
    }
    nloc = mine > 0u ? mine : 1u; nx = cnt > 0u ? cnt : 1u;
}
__device__ __forceinline__ void xcd_barrier(const XcdBarrier& b, bool is_t0) {
    asm volatile("s_waitcnt vmcnt(0)" ::: "memory");
    __syncthreads();
    if (is_t0) {
        unsigned* bar = b.bar;
        __builtin_amdgcn_s_waitcnt(0);
        unsigned nloc = b.st[0], nx = b.st[1];
        if (nloc == 0u) { xcd_barrier_complete(bar, b.x, nloc, nx); b.st[0] = nloc; b.st[1] = nx; }
        const unsigned old = xb_add(&bar[XB_XSUB(b.x)], 1u);
        const unsigned gen = old / nloc;
        if (old + 1u == (gen + 1u) * nloc) {
            __builtin_amdgcn_fence(__ATOMIC_RELEASE, "agent");
            asm volatile("s_waitcnt vmcnt(0)" ::: "memory");
            const unsigned og = xb_add(&bar[XB_TOP], 1u);
            const unsigned tg = og / nx;
            if (og + 1u == (tg + 1u) * nx) xb_add(&bar[XB_TOPGEN], 1u);
            else XB_SPIN(xb_ld(&bar[XB_TOPGEN]) == tg, bar);
            __builtin_amdgcn_fence(__ATOMIC_ACQUIRE, "agent");
            xb_add(&bar[XB_XGEN(b.x)], 1u);
            asm volatile("s_waitcnt vmcnt(0)" ::: "memory");
        } else {
            XB_SPIN(xb_ld(&bar[XB_XGEN(b.x)]) == gen, bar);
            __builtin_amdgcn_fence(__ATOMIC_ACQUIRE, "agent");
            asm volatile("s_waitcnt vmcnt(0)" ::: "memory");
        }
    }
    __syncthreads();
}

using pg8::Unit; using pg8::cvt_pk_bf16;
struct EpiIn {
    static constexpr bool PERM = true;
    const float* ss; const float* lbl; bf16* Qg; f16* F;
    __device__ __forceinline__ void operator()(const f32x4 (&acc)[2][2][4][2], const Unit& u, int wr, int wc, int fr, int fq) const {
        const int seg = u.pn >> 3; const int col0 = (u.pn & 7) * 256 + wc * 32 + 8 * fq; const int rowb = u.pm * 256 + wr * 64;
        float lb[2][8];
        if (seg == 1) {
#pragma unroll
            for (int bj = 0; bj < 2; ++bj)
#pragma unroll
                for (int j = 0; j < 8; ++j) { const int c = col0 + bj * 128 + j; lb[bj][j] = __builtin_amdgcn_rcpf(1.0f + __expf(lbl[D + c] - lbl[c])); }
        }
        float rs[2][4];
#pragma unroll
        for (int ai = 0; ai < 2; ++ai)
#pragma unroll
            for (int m = 0; m < 4; ++m) rs[ai][m] = ss[rowb + ai * 128 + m * 16 + fr];
#pragma unroll
        for (int ai = 0; ai < 2; ++ai)
#pragma unroll
            for (int m = 0; m < 4; ++m) asm volatile("" : "+v"(rs[ai][m]));
#pragma unroll
        for (int ai = 0; ai < 2; ++ai)
#pragma unroll
            for (int m = 0; m < 4; ++m) {
                const int rb = rowb + ai * 128 + m * 16; if (rb >= MR) continue;
                const int row = rb + fr; const float r = rsqrtf(rs[ai][m] * (1.0f / D) + EPS);
#pragma unroll
                for (int bj = 0; bj < 2; ++bj) {
                    f32x4 v0 = acc[ai][bj][m][0] * r, v1 = acc[ai][bj][m][1] * r; const size_t off = (size_t)row * D + col0 + bj * 128;
                    if (seg == 1) {
                        f32x4 o0, o1;
#pragma unroll
                        for (int j = 0; j < 4; ++j) { o0[j] = (1.0f - lb[bj][j]) * sigm_f(-v0[j]); o1[j] = (1.0f - lb[bj][4 + j]) * sigm_f(-v1[j]); }
                        { v4u w; w.x = pkh2(o0[0], o0[1]); w.y = pkh2(o0[2], o0[3]); w.z = pkh2(o1[0], o1[1]); w.w = pkh2(o1[2], o1[3]); *(v4u*)(F + off) = w; }
                    } else {
                        if (seg != 2) {
#pragma unroll
                            for (int j = 0; j < 4; ++j) { v0[j] = silu_f(v0[j]); v1[j] = silu_f(v1[j]); }
                        }
                        v4u w; w.x = cvt_pk_bf16(v0[0], v0[1]); w.y = cvt_pk_bf16(v0[2], v0[3]); w.z = cvt_pk_bf16(v1[0], v1[1]); w.w = cvt_pk_bf16(v1[2], v1[3]);
                        const size_t dsel = (seg == 0) ? 0 : ((seg == 2) ? 1 : 2);
                        *(v4u*)(Qg + dsel * (size_t)(17 * MiB) + off) = w;
                    }
                }
            }
    }
    __device__ __forceinline__ void tail(int row, int col, f32x4 v) const {
        const int seg = col >> 11, c = col & 2047; const float r = rsqrtf(ss[row] * (1.0f / D) + EPS); v = v * r; const size_t off = (size_t)row * D + c;
        if (seg == 1) { f32x4 o;
#pragma unroll
            for (int j = 0; j < 4; ++j) { const float lbv = __builtin_amdgcn_rcpf(1.0f + __expf(lbl[D + c + j] - lbl[c + j])); o[j] = (1.0f - lbv) * sigm_f(-v[j]); }
            { v2u w; w.x = pkh2(o[0], o[1]); w.y = pkh2(o[2], o[3]); *(v2u*)(F + off) = w; }
        } else {
            if (seg != 2) {
#pragma unroll
                for (int j = 0; j < 4; ++j) v[j] = silu_f(v[j]);
            }
            v2u w; w.x = cvt_pk_bf16(v[0], v[1]); w.y = cvt_pk_bf16(v[2], v[3]);
            const size_t dsel = (seg == 0) ? 0 : ((seg == 2) ? 1 : 2);
            *(v2u*)(Qg + dsel * (size_t)(17 * MiB) + off) = w;
        }
    }
};

template <int MODE> struct EpiRes {
    static constexpr bool PERM = true;
    const bf16* rb; float* o0; float* o1; bf16* hb; float* ss;
    __device__ __forceinline__ void operator()(const f32x4 (&acc)[2][2][4][2], const Unit& u, int wr, int wc, int fr, int fq) const {
        const int col0 = u.pn * 256 + wc * 32 + 8 * fq; const int rowb = u.pm * 256 + wr * 64;
        v4u rw[2][4][2];
#pragma unroll
        for (int ai = 0; ai < 2; ++ai)
#pragma unroll
            for (int m = 0; m < 4; ++m)
#pragma unroll
                for (int bj = 0; bj < 2; ++bj) rw[ai][m][bj] = *(const v4u*)(rb + (size_t)(rowb + ai * 128 + m * 16 + fr) * D + col0 + bj * 128);
#pragma unroll
        for (int ai = 0; ai < 2; ++ai)
#pragma unroll
            for (int m = 0; m < 4; ++m)
#pragma unroll
                for (int bj = 0; bj < 2; ++bj) asm volatile("" : "+v"(rw[ai][m][bj]));
#pragma unroll
        for (int ai = 0; ai < 2; ++ai)
#pragma unroll
            for (int m = 0; m < 4; ++m) {
                const int row = rowb + ai * 128 + m * 16 + fr;
                float* op = (MODE == 2) ? o0 + (size_t)row * D : nullptr;
                float sq = 0.f;
#pragma unroll
                for (int bj = 0; bj < 2; ++bj) {
                    const int c = col0 + bj * 128;
                    const v4u w_ = rw[ai][m][bj];
                    f32x4 a0 = {bf2f(w_.x & 0xffffu), bf2f(w_.x >> 16), bf2f(w_.y & 0xffffu), bf2f(w_.y >> 16)}, a1 = {bf2f(w_.z & 0xffffu), bf2f(w_.z >> 16), bf2f(w_.w & 0xffffu), bf2f(w_.w >> 16)};
                    a0 += acc[ai][bj][m][0]; a1 += acc[ai][bj][m][1];
                    if (MODE == 2) { __builtin_nontemporal_store(a0, (f32x4*)(op + c)); __builtin_nontemporal_store(a1, (f32x4*)(op + c + 4)); }
                    else {
                        v4u w; w.x = cvt_pk_bf16(a0[0], a0[1]); w.y = cvt_pk_bf16(a0[2], a0[3]); w.z = cvt_pk_bf16(a1[0], a1[1]); w.w = cvt_pk_bf16(a1[2], a1[3]);
                        *(v4u*)(hb + (size_t)row * D + c) = w;
                        sq += (a0[0] * a0[0] + a0[1] * a0[1]) + (a0[2] * a0[2] + a0[3] * a0[3]) + (a1[0] * a1[0] + a1[1] * a1[1]) + (a1[2] * a1[2] + a1[3] * a1[3]);
                    }
                }
                if (MODE != 2) { sq += shx<16>(sq); sq = xadd32(sq); if (fq == 0) atomicAdd(ss + row, sq); }
            }
    }
    __device__ __forceinline__ void tail(int row, int col, f32x4 v, int fq) const {
        const v2u rw = *(const v2u*)(rb + (size_t)row * D + col);
        f32x4 a0 = {bf2f(rw.x & 0xffffu), bf2f(rw.x >> 16), bf2f(rw.y & 0xffffu), bf2f(rw.y >> 16)}; a0 += v;
        if (MODE == 2) { *(f32x4*)(o1 + (size_t)(row - SEQ) * D + col) = a0; }
        else {
            v2u w; w.x = cvt_pk_bf16(a0[0], a0[1]); w.y = cvt_pk_bf16(a0[2], a0[3]); *(v2u*)(hb + (size_t)row * D + col) = w;
            float sq = (a0[0] * a0[0] + a0[1] * a0[1]) + (a0[2] * a0[2] + a0[3] * a0[3]);
            sq += shx<16>(sq); sq = xadd32(sq); if (fq == 0) atomicAdd(ss + row, sq);
        }
    }
};
struct EpiGU {
    static constexpr bool PERM = true;
    const float* ss; bf16* hm;
    __device__ __forceinline__ void operator()(const f32x4 (&acc)[2][2][4][2], const Unit& u, int wr, int wc, int fr, int fq) const {
        const int j0 = u.pn * 128 + wc * 32 + 8 * fq; const int rowb = u.pm * 256 + wr * 64;
        float rs[2][4];
#pragma unroll
        for (int ai = 0; ai < 2; ++ai)
#pragma unroll
            for (int m = 0; m < 4; ++m) rs[ai][m] = ss[rowb + ai * 128 + m * 16 + fr];
#pragma unroll
        for (int ai = 0; ai < 2; ++ai)
#pragma unroll
            for (int m = 0; m < 4; ++m) asm volatile("" : "+v"(rs[ai][m]));
#pragma unroll
        for (int ai = 0; ai < 2; ++ai)
#pragma unroll
            for (int m = 0; m < 4; ++m) {
                const int rb = rowb + ai * 128 + m * 16; if (rb >= MR) continue;
                const int row = rb + fr; const float r = rsqrtf(rs[ai][m] * (1.0f / D) + EPS);
                float o[8];
#pragma unroll
                for (int n = 0; n < 2; ++n)
#pragma unroll
                    for (int j = 0; j < 4; ++j) o[4 * n + j] = silu_f(acc[ai][0][m][n][j] * r) * (acc[ai][1][m][n][j] * r);
                v4u w; w.x = cvt_pk_bf16(o[0], o[1]); w.y = cvt_pk_bf16(o[2], o[3]); w.z = cvt_pk_bf16(o[4], o[5]); w.w = cvt_pk_bf16(o[6], o[7]);
                *(v4u*)(hm + (size_t)row * DFF + j0) = w;
            }
    }
};
struct EpiKVQ {
    static constexpr bool PERM = true;
    const float* ss; unsigned char* ws; float* outp; const float* kn; const float* qn; LAS unsigned char* xl;
    __device__ __forceinline__ void operator()(const f32x4 (&acc)[2][2][4][2], const Unit& u, int wr, int wc, int fr, int fq) const {
        const int c0 = wc * 32 + 8 * fq; const int rowb = u.pm * 256 + wr * 64;
        bf16* Kb_ = (bf16*)(ws + WS_KB); bf16* Vb_ = (bf16*)(ws + WS_VB); bf16* Qb_ = (bf16*)(ws + WS_QB); float* Kp_ = (float*)(ws + WS_KPART);
        float rs[2][4];
#pragma unroll
        for (int ai = 0; ai < 2; ++ai)
#pragma unroll
            for (int m = 0; m < 4; ++m) rs[ai][m] = rsqrtf(ss[rowb + ai * 128 + m * 16 + fr] * (1.0f / D) + EPS);
        if (u.pn == 2 || u.pn == 3) {
#pragma unroll
            for (int ai = 0; ai < 2; ++ai)
#pragma unroll
                for (int m = 0; m < 4; ++m) {
                    const int rb = rowb + ai * 128 + m * 16; if (rb >= MR) continue;
                    const int row = rb + fr; const float r = rs[ai][m];
                    float* vo = outp + ((row < SEQ) ? OV_P + (size_t)row * 512 : OV_S + (size_t)(row - SEQ) * 512);
#pragma unroll
                    for (int bj = 0; bj < 2; ++bj) { const int col = (u.pn - 2) * 256 + bj * 128 + c0; const f32x4 v0 = acc[ai][bj][m][0] * r, v1 = acc[ai][bj][m][1] * r;
                        __builtin_nontemporal_store(v0, (f32x4*)(vo + col)); __builtin_nontemporal_store(v1, (f32x4*)(vo + col + 4));
                        v4u w; w.x = cvt_pk_bf16(v0[0], v0[1]); w.y = cvt_pk_bf16(v0[2], v0[3]); w.z = cvt_pk_bf16(v1[0], v1[1]); w.w = cvt_pk_bf16(v1[2], v1[3]);
                        *(v4u*)(Vb_ + (size_t)row * 512 + col) = w; }
                }
            return;
        }
        const bool isk = u.pn < 2;
        LAS float* P = (LAS float*)xl;
        LAS float* CS = (LAS float*)(xl + 8192);
#pragma unroll
        for (int ai = 0; ai < 2; ++ai)
#pragma unroll
            for (int m = 0; m < 4; ++m) {
                const int rl = ai * 128 + wr * 64 + m * 16 + fr; const float r = rs[ai][m];
#pragma unroll
                for (int bj = 0; bj < 2; ++bj) { const f32x4 v0 = acc[ai][bj][m][0] * r, v1 = acc[ai][bj][m][1] * r;
                    float sq = (v0[0] * v0[0] + v0[1] * v0[1]) + (v0[2] * v0[2] + v0[3] * v0[3]) + (v1[0] * v1[0] + v1[1] * v1[1]) + (v1[2] * v1[2] + v1[3] * v1[3]);
                    sq += shx<16>(sq); sq = xadd32(sq);
                    if (fq == 0) P[(rl * 2 + bj) * 4 + wc] = sq; }
            }
        asm volatile("s_waitcnt lgkmcnt(0)" ::: "memory"); __builtin_amdgcn_s_barrier(); asm volatile("" ::: "memory");
        float cs[2][8];
#pragma unroll
        for (int bj = 0; bj < 2; ++bj)
#pragma unroll
            for (int j = 0; j < 8; ++j) cs[bj][j] = 0.f;
        const float* gp = (isk ? kn : qn) + c0; const f32x4 g0 = *(const f32x4*)gp, g1 = *(const f32x4*)(gp + 4);
#pragma unroll
        for (int ai = 0; ai < 2; ++ai)
#pragma unroll
            for (int m = 0; m < 4; ++m) {
                const int rb = rowb + ai * 128 + m * 16; if (rb >= MR) continue;
                const int rl = ai * 128 + wr * 64 + m * 16 + fr; const int row = rb + fr; const float r = rs[ai][m];
#pragma unroll
                for (int bj = 0; bj < 2; ++bj) {
                    const f32x4 pp = *(const LAS f32x4*)(P + (rl * 2 + bj) * 4);
                    const float rh = rsqrtf(((pp[0] + pp[1]) + (pp[2] + pp[3])) * (1.0f / 128.0f) + EPS) * (isk ? 1.0f : C2);
                    const f32x4 n0 = acc[ai][bj][m][0] * (r * rh) * g0, n1 = acc[ai][bj][m][1] * (r * rh) * g1;
                    v4u w; w.x = cvt_pk_bf16(n0[0], n0[1]); w.y = cvt_pk_bf16(n0[2], n0[3]); w.z = cvt_pk_bf16(n1[0], n1[1]); w.w = cvt_pk_bf16(n1[2], n1[3]);
                    if (isk) {
                        const int col = u.pn * 256 + bj * 128 + c0;
                        float* ko = outp + ((row < SEQ) ? OK_P + (size_t)row * 512 : OK_S + (size_t)(row - SEQ) * 512) + col;
                        __builtin_nontemporal_store(n0, (f32x4*)ko); __builtin_nontemporal_store(n1, (f32x4*)(ko + 4));
                        *(v4u*)(Kb_ + (size_t)row * 512 + col) = w;
#pragma unroll
                        for (int j = 0; j < 4; ++j) { cs[bj][j] += n0[j]; cs[bj][4 + j] += n1[j]; }
                    } else {
                        *(v4u*)(Qb_ + (size_t)row * D + (u.pn - 4) * 256 + bj * 128 + c0) = w;
                    }
                }
            }
        if (isk && u.pm < SEQ / 256) {
#pragma unroll
            for (int bj = 0; bj < 2; ++bj)
#pragma unroll
                for (int j = 0; j < 8; ++j) { float v = cs[bj][j]; v += shx<1>(v); v += shx<2>(v); v += shx<4>(v); v += shx<8>(v); if (fr == 0) CS[wr * 256 + bj * 128 + c0 + j] = v; }
            asm volatile("s_waitcnt lgkmcnt(0)" ::: "memory"); __builtin_amdgcn_s_barrier(); asm volatile("" ::: "memory");
            const int t = (wr * 4 + wc) * 64 + fq * 16 + fr;
            if (t < 256) Kp_[(size_t)u.pm * 512 + u.pn * 256 + t] = CS[t] + CS[256 + t];
        }
    }
};

struct Args { const void* in[21]; float* out; unsigned char* ws; };

__device__ __forceinline__ void p0_transpose_item(const float* W, int K, int N, bf16* WT, int row_off, int mode, const float* gain, LAS float* scr, int item, int lane) {
    const int nblk = N / 64, kb = item / nblk, nb = item % nblk, k0 = 64 * kb, n0 = 64 * nb;
    const int r = lane >> 4, c4 = lane & 15;
#pragma unroll
    for (int i = 0; i < 16; ++i) { const int kk = 4 * i + r; f32x4 w = __builtin_nontemporal_load((const f32x4*)(W + (size_t)(k0 + kk) * N + n0 + 4 * c4)); if (gain) w *= gain[k0 + kk]; *(LAS f32x4*)(scr + kk * 68 + 4 * c4) = w; }
    LDS_WAIT(); asm volatile("" ::: "memory");
    const int c = lane & 7;
    int d0;
    if (mode == 0) d0 = row_off + n0;
    else { const int j = (n0 < DFF) ? n0 : n0 - DFF; d0 = 256 * (j >> 7) + (j & 127) + ((n0 < DFF) ? 0 : 128); }
#pragma unroll
    for (int j = 0; j < 8; ++j) { const int n = (lane >> 3) + 8 * j; const LAS float* sp = scr + (8 * c) * 68 + n;
        v4u o; o.x = pk2(sp[0 * 68], sp[1 * 68]); o.y = pk2(sp[2 * 68], sp[3 * 68]); o.z = pk2(sp[4 * 68], sp[5 * 68]); o.w = pk2(sp[6 * 68], sp[7 * 68]);
        *(v4u*)(WT + (size_t)(d0 + n) * K + k0 + 8 * c) = o; }
    LDS_WAIT(); asm volatile("" ::: "memory");
}

constexpr int KS_P = 144;
constexpr int KS_BYTES = 256 * KS_P * 2;
typedef short v4i16_t __attribute__((ext_vector_type(4)));
__device__ __forceinline__ v2u tr_read(const LAS bf16* p) { return __builtin_bit_cast(v2u, __builtin_amdgcn_ds_read_tr16_b64_v4i16((LAS v4i16_t*)p)); }
template <int NKT> __device__ __forceinline__ void attn_scores(const LAS bf16* Ks, const bf16x8 (&qf)[4], f32x4 (&acc)[16], int nkt, int fr, int fq) {
#pragma unroll
    for (int kt = 0; kt < NKT; ++kt) {
        acc[kt] = (f32x4){0.f, 0.f, 0.f, 0.f};
        if (kt < nkt) {
#pragma unroll
            for (int ks = 0; ks < 4; ++ks) { const bf16x8 a = *(const LAS bf16x8*)(Ks + (16 * kt + fr) * KS_P + 32 * ks + 8 * fq); acc[kt] = MFMA16(a, qf[ks], acc[kt]); }
        }
    }
}
__device__ __forceinline__ void attn_pv(const LAS bf16* Vr, const f32x4 (&acc)[16], f32x4 (&O)[8], int nj, int fr, int fq) {
#pragma unroll
    for (int j = 0; j < 8; ++j) {
        if (j < nj) {
            v4u pw; pw.x = cvt_pk_bf16(acc[2 * j][0], acc[2 * j][1]); pw.y = cvt_pk_bf16(acc[2 * j][2], acc[2 * j][3]); pw.z = cvt_pk_bf16(acc[2 * j + 1][0], acc[2 * j + 1][1]); pw.w = cvt_pk_bf16(acc[2 * j + 1][2], acc[2 * j + 1][3]);
            const bf16x8 pf = __builtin_bit_cast(bf16x8, pw);
            const LAS bf16* vb = Vr + (32 * j + 4 * fq + (fr >> 2)) * KS_P + 4 * (fr & 3);
#pragma unroll
            for (int vt = 0; vt < 8; ++vt) {
                const v2u lo = tr_read(vb + 16 * vt), hi = tr_read(vb + 16 * KS_P + 16 * vt);
                const v4u aw = {lo.x, lo.y, hi.x, hi.y};
                O[vt] = MFMA16(__builtin_bit_cast(bf16x8, aw), pf, O[vt]);
            }
        }
    }
}

struct TrItem { const float* W; const float* gain; bf16* WT; int K, N, row_off, item, mode; };
__device__ __forceinline__ void tr_load(const TrItem& t, f32x4 (&w)[16], float (&g)[16], int lane) {
    const int nblk = t.N / 64, kb = t.item / nblk, nb = t.item - kb * nblk, k0 = 64 * kb, n0 = 64 * nb; const int r = lane >> 4, c4 = lane & 15;
#pragma unroll
    for (int i = 0; i < 16; ++i) { const int kk = 4 * i + r; w[i] = __builtin_nontemporal_load((const f32x4*)(t.W + (size_t)(k0 + kk) * t.N + n0 + 4 * c4)); g[i] = t.gain ? t.gain[k0 + kk] : 1.0f; }
}
__device__ __forceinline__ void tr_store(const TrItem& t, const f32x4 (&w)[16], const float (&g)[16], LAS float* scr, int lane) {
    const int nblk = t.N / 64, kb = t.item / nblk, nb = t.item - kb * nblk, k0 = 64 * kb, n0 = 64 * nb; const int r = lane >> 4, c4 = lane & 15;
#pragma unroll
    for (int i = 0; i < 16; ++i) { const int kk = 4 * i + r; *(LAS f32x4*)(scr + kk * 68 + 4 * c4) = w[i] * g[i]; }
    LDS_WAIT(); asm volatile("" ::: "memory");
    const int c = lane & 7; int d0;
    if (t.mode == 0) d0 = t.row_off + n0; else { const int j = (n0 < DFF) ? n0 : n0 - DFF; d0 = 256 * (j >> 7) + (j & 127) + ((n0 < DFF) ? 0 : 128); }
#pragma unroll
    for (int j = 0; j < 8; ++j) { const int n = (lane >> 3) + 8 * j; const LAS float* sp = scr + (8 * c) * 68 + n;
        v4u o; o.x = pk2(sp[0 * 68], sp[1 * 68]); o.y = pk2(sp[2 * 68], sp[3 * 68]); o.z = pk2(sp[4 * 68], sp[5 * 68]); o.w = pk2(sp[6 * 68], sp[7 * 68]);
        *(v4u*)(t.WT + (size_t)(d0 + n) * t.K + k0 + 8 * c) = o; }
    LDS_WAIT(); asm volatile("" ::: "memory");
}

template <int NT, int K> __device__ __forceinline__ void tail_gemm(LAS unsigned char* lds, const bf16* A, const bf16* Bt, int n0, int rowhalf, f32x4 (&acc)[NT], int tidx, int rsel) {
    int tid_o = tidx; asm volatile("" : "+v"(tid_o));
    const int tid = tid_o, lane = tid & 63, wave = __builtin_amdgcn_readfirstlane(tid >> 6), fr = lane & 15, fq = lane >> 4;
    const int rt = wave & 3, kh = wave >> 2; constexpr int Kh = K >> 1;
    constexpr int KC = (K == 2048) ? (NT == 2 ? 512 : 1024) : 1408;
    constexpr int NCH = Kh / KC, PB = KC + 8, UPR = KC >> 3, NS = KC >> 7;
    const int khk = kh ^ (rsel & 1), flip = (NCH > 1) ? ((rsel >> 1) & 1) : 0;
    constexpr int NU = 2 * 16 * NT * UPR, NIT = NU / NTHR;
    static_assert(NU % NTHR == 0, "tail B staging");
    LAS bf16* Bs = (LAS bf16*)(lds + 8192);
    const int lq = lane >> 4, lu = lane & 15;
    const bf16* ap = A + (size_t)(64 * rowhalf + 16 * rt + lq) * K + khk * Kh + 8 * lu;
    LAS unsigned char* stg = lds + 102400 + wave * 4096;
    int wof[4], rof[4];
#pragma unroll
    for (int j = 0; j < 4; ++j) { wof[j] = (4 * j + lq) * 256 + ((lu ^ (4 * j + lq)) << 4); rof[j] = fr * 256 + (((4 * j + fq) ^ fr) << 4); }
    const LAS bf16* bl = Bs + (khk * 16 * NT + fr) * PB + 8 * fq;
#pragma unroll
    for (int t = 0; t < NT; ++t) acc[t] = (f32x4){0.f, 0.f, 0.f, 0.f};
#define TG_LDA(a_, k0_) do { _Pragma("unroll") for (int s_ = 0; s_ < 4; ++s_) a_[s_] = *(const bf16x8*)(ap + (size_t)(4 * s_) * K + (k0_)); } while (0)
#define TG_MMA(a_, kl_) do { _Pragma("unroll") for (int s_ = 0; s_ < 4; ++s_) *(LAS bf16x8*)(stg + wof[s_]) = a_[s_]; asm volatile("" ::: "memory"); bf16x8 ar_[4]; \
        _Pragma("unroll") for (int s_ = 0; s_ < 4; ++s_) ar_[s_] = *(const LAS bf16x8*)(stg + rof[s_]); asm volatile("" ::: "memory"); \
        _Pragma("unroll") for (int s_ = 0; s_ < 4; ++s_) { _Pragma("unroll") for (int t_ = 0; t_ < NT; ++t_) { \
        const bf16x8 b_ = *(const LAS bf16x8*)(bl + t_ * 16 * PB + (kl_) + 32 * s_); acc[t_] = MFMA16(b_, ar_[s_], acc[t_]); } } } while (0)
#define TG_LDB(kb_) do { _Pragma("unroll") for (int i_ = 0; i_ < NIT; ++i_) { const int u_ = tid + i_ * NTHR, r2_ = u_ / UPR, kc_ = u_ - r2_ * UPR; const int khh_ = (r2_ >= 16 * NT) ? 1 : 0, row_ = r2_ - khh_ * 16 * NT; \
        breg[i_] = *(const v4u*)(Bt + (size_t)(n0 + row_) * K + khh_ * Kh + (kb_) + 8 * kc_); } } while (0)
#define TG_STB() do { _Pragma("unroll") for (int i_ = 0; i_ < NIT; ++i_) { const int u_ = tid + i_ * NTHR, r2_ = u_ / UPR, kc_ = u_ - r2_ * UPR; *(LAS v4u*)(Bs + r2_ * PB + 8 * kc_) = breg[i_]; } } while (0)
    v4u breg[NIT];
    TG_LDB(flip * KC);
#pragma unroll
    for (int ch = 0; ch < NCH; ++ch) {
        const int kb = (ch ^ flip) * KC;
        bf16x8 a0[4], a1[4], a2[4], a3[4];
        TG_LDA(a0, kb); TG_LDA(a1, kb + 128); TG_LDA(a2, kb + 256); TG_LDA(a3, kb + 384);
        TG_STB();
        __syncthreads();
        if (ch + 1 < NCH) TG_LDB(((ch + 1) ^ flip) * KC);
        for (int st = 0; st < NS; st += 4) {
            TG_MMA(a0, 128 * st);           if (st + 4 < NS) TG_LDA(a0, kb + 128 * (st + 4));
            if (st + 1 < NS) { TG_MMA(a1, 128 * (st + 1)); if (st + 5 < NS) TG_LDA(a1, kb + 128 * (st + 5)); }
            if (st + 2 < NS) { TG_MMA(a2, 128 * (st + 2)); if (st + 6 < NS) TG_LDA(a2, kb + 128 * (st + 6)); }
            if (st + 3 < NS) { TG_MMA(a3, 128 * (st + 3)); if (st + 7 < NS) TG_LDA(a3, kb + 128 * (st + 7)); }
        }
        __syncthreads();
    }
#undef TG_LDA
#undef TG_MMA
#undef TG_LDB
#undef TG_STB
    LAS f32x4* red = (LAS f32x4*)lds;
    if (kh == 1) {
#pragma unroll
        for (int t = 0; t < NT; ++t) red[(t * 4 + rt) * 64 + lane] = acc[t];
    }
    __syncthreads();
    if (kh == 0) {
#pragma unroll
        for (int t = 0; t < NT; ++t) acc[t] += red[(t * 4 + rt) * 64 + lane];
    }
    __syncthreads();
}

template <int UNR = 16> __device__ __forceinline__ void kmean_items(LAS unsigned char* lds, const float* cache_k_, const int* ptab_, float* Kms_, int i0, int i1, int c0, int cn, int tidx) {
    int tid_o = tidx; asm volatile("" : "+v"(tid_o)); const int tid = tid_o;
    const int me = (int)blockIdx.x - c0; if (me < 0 || me >= cn) return;
    LAS f32x4* redk = (LAS f32x4*)(lds);
    for (int item = i0 + me; item < i1; item += cn) {
        const int b = item >> 5, n = item & 31; const int c4 = tid & 127, rg = tid >> 7;
        f32x4 a = {0.f, 0.f, 0.f, 0.f};
#pragma unroll
        for (int hp = 0; hp < 2; ++hp) { const int page = ptab_[b * NPAGES + 2 * n + hp]; const f32x4* pp = (const f32x4*)(cache_k_ + (size_t)page * PAGE * 512) + c4;
#pragma unroll UNR
            for (int r = rg; r < 128; r += 4) a += __builtin_nontemporal_load(pp + (size_t)r * 128); }
        redk[rg * 128 + c4] = a;
        __syncthreads();
        if (tid < 128) { const f32x4 s4 = (redk[tid] + redk[128 + tid]) + (redk[256 + tid] + redk[384 + tid]); *(f32x4*)(Kms_ + (size_t)item * 512 + 4 * tid) = s4 * (1.0f / 256.0f); }
        __syncthreads();
    }
}

__global__ void __launch_bounds__(NTHR, 2) yoco_fwd(Args args) {
    extern __shared__ __attribute__((aligned(16))) unsigned char lds_raw[];
    LAS unsigned char* lds = (LAS unsigned char*)lds_raw;
#define TIDS int tid_o = TIDX; asm volatile("" : "+v"(tid_o)); const int tid = tid_o, lane = tid & 63, wave = __builtin_amdgcn_readfirstlane(tid >> 6), fr = lane & 15, fq = lane >> 4; (void)fr; (void)fq; (void)wave; (void)lane; (void)tid
    const int G = gridDim.x, bid = blockIdx.x;
    unsigned char* ws = args.ws;
    unsigned* ctl = (unsigned*)(ws + WS_CTL);
    volatile LAS unsigned* MISC = (volatile LAS unsigned*)(lds + MISC_OFF);
    const int wave_sg = __builtin_amdgcn_readfirstlane((int)threadIdx.x & ~63);
#define TIDX (wave_sg + lane_id())
#define IS_T0 ((wave_sg == 0) && (lane_id() == 0))
    if (TIDX < 64) MISC[TIDX] = 0u;
    __syncthreads();
    XcdBarrier bar = xcd_barrier_post(ctl + CW_BAR, MISC + 8, IS_T0);
#ifdef PROF_A
    int n_stamp = 0;
#define STAMP() do { if (blockIdx.x == 0 && IS_T0) MISC[16 + n_stamp] = (unsigned)__builtin_amdgcn_s_memrealtime(); ++n_stamp; } while (0)
#define TNOW() ((unsigned)__builtin_amdgcn_s_memrealtime())
#define TACC(k, t0) do { if (blockIdx.x == 0 && IS_T0) MISC[40 + (k)] += TNOW() - (t0); } while (0)
#define PVAL(a0, a1) (((a0) >= 100) ? MISC[40 + (a0) - 100] : (MISC[16 + (a1)] - MISC[16 + (a0)]))
#else
#define STAMP() do {} while (0)
#define TNOW() 0u
#define TACC(k, t0) do { (void)(t0); } while (0)
#endif
    STAMP();

#define x_p ((const float*)args.in[0])
#define x_s ((const float*)args.in[1])
#define st_in ((const float*)args.in[2])
#define cache_k ((const float*)args.in[3])
#define cache_v ((const float*)args.in[4])
#define ptab ((const int*)args.in[5])
#define norm_mix_a ((const float*)args.in[6])
#define w_in ((const float*)args.in[7])
#define lbl ((const float*)args.in[8])
#define onorm ((const float*)args.in[9])
#define w_out ((const float*)args.in[10])
#define norm_kv ((const float*)args.in[11])
#define w_kv ((const float*)args.in[12])
#define k_norm ((const float*)args.in[13])
#define norm_mix_b ((const float*)args.in[14])
#define w_q ((const float*)args.in[15])
#define q_norm ((const float*)args.in[16])
#define w_o ((const float*)args.in[17])
#define norm_ffn ((const float*)args.in[18])
#define w_gu ((const float*)args.in[19])
#define w_dn ((const float*)args.in[20])
#define Win_t ((bf16*)(ws + WS_WIN))
#define Wout_t ((bf16*)(ws + WS_WOUT))
#define Wgu0_t ((bf16*)(ws + WS_WGU0))
#define Wdn0_t ((bf16*)(ws + WS_WDN0))
#define Wkvq_t ((bf16*)(ws + WS_WKVQ))
#define Wo_t ((bf16*)(ws + WS_WO))
#define Wgu1_t ((bf16*)(ws + WS_WGU1))
#define Wdn1_t ((bf16*)(ws + WS_WDN1))
#define Hb0 ((bf16*)(ws + WS_HB0))
#define Hb1 ((bf16*)(ws + WS_HB1))
#define Hb2 ((bf16*)(ws + WS_HB2))
#define Hb3 ((bf16*)(ws + WS_HB3))
#define Hf1 ((float*)(ws + WS_HF1))
#define Hf2 ((float*)(ws + WS_HF2))
#define Hf3 ((float*)(ws + WS_HF3))
#define Qg ((bf16*)(ws + WS_QG))
#define Vg ((bf16*)(ws + WS_VG))
#define Gg ((bf16*)(ws + WS_GG))
#define Ff ((f16*)(ws + WS_F))
#define Ob ((bf16*)(ws + WS_OB))
#define At ((bf16*)(ws + WS_AT))
#define Hm ((bf16*)(ws + WS_HM))
#define Ug ((float*)(ws + WS_U))
#define Sg0 ((float*)(ws + WS_SST))
#define Dg ((float*)(ws + WS_DEC))
#define Kraw ((float*)(ws + WS_KRAW))
#define Vraw ((float*)(ws + WS_VRAW))
#define Qraw ((bf16*)(ws + WS_QRAW))
#define Kb ((bf16*)(ws + WS_KB))
#define Vb ((bf16*)(ws + WS_VB))
#define Qb ((bf16*)(ws + WS_QB))
#define Kpart ((float*)(ws + WS_KPART))
#define Kms ((float*)(ws + WS_KMS))
#define Subl ((unsigned*)(ws + WS_SUBL))
#define Scnt ((unsigned*)(ws + WS_SCNT))
#define Sels ((unsigned*)(ws + WS_SCNT + 256 * 1024))
#define Oslot ((bf16*)(ws + WS_OSLOT))
#define MLslot ((float*)(ws + WS_MLSLOT))
#define Sslot ((float*)(ws + WS_SSLOT))
#define ss0 ((float*)(ctl + CW_SS0))
#define ss1 ((float*)(ctl + CW_SS1))
#define ss2 ((float*)(ctl + CW_SS2))
#define ss3 ((float*)(ctl + CW_SS3))
#define out (args.out)
    {
        TIDS;
        LAS float* scr = (LAS float*)(lds + wave * 17408);
        const int gw = bid * NWAVES + wave, NGW = G * NWAVES;
        constexpr int I_IN = 32 * 128, I_SQ = 32 * 32, I_GU = 32 * 176, I_DN = 88 * 32, I_KV = 32 * 16;
        constexpr int NITEMS = I_IN + I_SQ + 2 * I_GU;
        (void)I_DN; (void)I_KV;
        for (int it = gw; it < NITEMS; it += NGW) {
            int r = it;
            if (r < I_IN) { p0_transpose_item(w_in, D, 4 * D, Win_t, 0, 0, norm_mix_a, scr, r, lane); continue; } r -= I_IN;
            if (r < I_SQ) { p0_transpose_item(w_out, D, D, Wout_t, 0, 0, nullptr, scr, r, lane); continue; } r -= I_SQ;
            if (r < I_GU) { p0_transpose_item(w_gu, D, NGU, Wgu0_t, 0, 1, norm_ffn, scr, r, lane); continue; } r -= I_GU;
            p0_transpose_item(w_gu + (size_t)D * NGU, D, NGU, Wgu1_t, 0, 1, norm_ffn + D, scr, r, lane);
        }
        for (int m = gw; m < MR; m += NGW) {
            const float* src = (m < SEQ) ? x_p + (size_t)m * D : x_s + (size_t)(m - SEQ) * D;
            const f32x4* xr = (const f32x4*)src + lane; f32x4 v[8]; float s = 0.f;
#pragma unroll
            for (int j = 0; j < 8; ++j) { v[j] = __builtin_nontemporal_load(xr + 64 * j); s += (v[j].x * v[j].x + v[j].y * v[j].y) + (v[j].z * v[j].z + v[j].w * v[j].w); }
            s = wave_sum(s);
            if (lane == 0) ss0[m] = s;
            v2u* o8 = (v2u*)(Hb0 + (size_t)m * D) + lane;
#pragma unroll
            for (int j = 0; j < 8; ++j) { v2u w; w.x = pk2(v[j].x, v[j].y); w.y = pk2(v[j].z, v[j].w); o8[64 * j] = w; }
        }
    }
    xcd_barrier(bar, IS_T0);
    STAMP();

    {
        TIDS;
        pg8::Gemm g{Hb0, Win_t, SEQ, 4 * D, D}; pg8::StaticOrder S; S.init(SEQ, 4 * D, G, bid);
        EpiIn E{ss0, lbl, Qg, Ff};
        pg8::gemm_phase<EpiIn, pg8::StaticOrder, true, true, false>(lds, g, S, E, TIDX);
        for (int it2 = 0; it2 < 2; ++it2) {
            const int w2 = bid + 256 * it2, t2 = w2 & 255, rh = (w2 >> 8) & 1;
            TIDS; f32x4 ta[2]; tail_gemm<2, D>(lds, Hb0 + (size_t)SEQ * D, Win_t, 32 * t2, rh, ta, TIDX, bid & 127);
            if (wave < 4) { const int row = SEQ + 64 * rh + 16 * wave + fr; E.tail(row, 32 * t2 + 4 * fq, ta[0]); E.tail(row, 32 * t2 + 16 + 4 * fq, ta[1]); }
        }
    }
    xcd_barrier(bar, IS_T0);
    STAMP();

    {
        TIDS;
        LAS float* tot = (LAS float*)(lds);
        LAS float* decs = (LAS float*)(lds + 2048);
        LAS bf16* koT = (LAS bf16*)(lds + 4096);
        LAS bf16* Vr = (LAS bf16*)(lds + 4096 + 128 * 72 * 2);
        LAS f32x4* kmr = (LAS f32x4*)(lds + 65536);
        const int col = tid & 127, part = tid >> 7; const int vt_t = tid >> 3, vd0 = (tid & 7) * 16;
        f16 fN[16]; v4u vaN, vbN;
#define P2_LOADN(it_) do { const int h_ = (it_) >> 7, r0_ = ((it_) & 127) * 64; const f16* fp_ = Ff + (size_t)(r0_ + part * 16) * D + h_ * 128 + col; \
            _Pragma("unroll") for (int i = 0; i < 16; ++i) fN[i] = fp_[(size_t)i * D]; \
            const bf16* vp_ = Vg + (size_t)(r0_ + vt_t) * D + h_ * 128 + vd0; vaN = *(const v4u*)vp_; vbN = *(const v4u*)(vp_ + 8); } while (0)
        for (int it = bid; it < NH * 16; it += G) {
            const int h = it >> 4, g = it & 15;
            f32x4 S[8];
#pragma unroll
            for (int vt = 0; vt < 8; ++vt) S[vt] = (f32x4){0.f, 0.f, 0.f, 0.f};
            float dtot = 1.0f;
            P2_LOADN(h * 128 + 8 * g);
            f32x4 ka = {0.f, 0.f, 0.f, 0.f};
            const int kpg0 = ptab[(it >> 5) * NPAGES + 2 * (it & 31)], kpg1 = ptab[(it >> 5) * NPAGES + 2 * (it & 31) + 1];
#pragma unroll 1
            for (int j = 0; j < 8; ++j) {
                const int item = h * 128 + 8 * g + j;
                f32x4 kq[8];
                { const int page = (j < 4) ? kpg0 : kpg1;
                  const f32x4* pp = (const f32x4*)(cache_k + (size_t)page * PAGE * 512) + (tid & 127) + (size_t)((j & 3) * 32 + (tid >> 7)) * 128;
#pragma unroll
                  for (int i = 0; i < 8; ++i) kq[i] = __builtin_nontemporal_load(pp + (size_t)(4 * i) * 128); }
                float cum[16], kk[16]; float run = 0.f;
#pragma unroll
                for (int i = 0; i < 16; ++i) { kk[i] = (float)fN[i]; const float f = 1.0f - kk[i]; run += __logf(f); cum[i] = run; }
                tot[part * 128 + col] = run;
                *(LAS v4u*)(Vr + vt_t * 144 + vd0) = vaN; *(LAS v4u*)(Vr + vt_t * 144 + vd0 + 8) = vbN;
                if (j < 7) P2_LOADN(item + 1);
                __syncthreads();
                float offs = 0.f, lastv = 0.f;
#pragma unroll
                for (int p = 0; p < 4; ++p) { const float tv = tot[p * 128 + col]; lastv += tv; if (p < part) offs += tv; }
                unsigned kw[8];
#pragma unroll
                for (int i = 0; i < 8; ++i) { const float a = kk[2 * i] * __expf(lastv - (cum[2 * i] + offs)), b2 = kk[2 * i + 1] * __expf(lastv - (cum[2 * i + 1] + offs)); kw[i] = pk2(a, b2); }
                *(LAS v4u*)(koT + col * 72 + part * 16) = (v4u){kw[0], kw[1], kw[2], kw[3]};
                *(LAS v4u*)(koT + col * 72 + part * 16 + 8) = (v4u){kw[4], kw[5], kw[6], kw[7]};
                if (part == 0) { const float dc = __expf(lastv); decs[col] = dc; dtot *= dc; }
                __syncthreads();
                { bf16x8 a[2]; a[0] = *(const LAS bf16x8*)(koT + (16 * wave + fr) * 72 + 8 * fq); a[1] = *(const LAS bf16x8*)(koT + (16 * wave + fr) * 72 + 32 + 8 * fq);
                  const f32x4 dv = *(const LAS f32x4*)(decs + 16 * wave + 4 * fq);
                  const LAS bf16* vb = Vr + (8 * fq + (fr >> 2)) * 144 + 4 * (fr & 3);
#pragma unroll
                  for (int vt = 0; vt < 8; ++vt) {
                      f32x4 acc = {0.f, 0.f, 0.f, 0.f};
                      const v2u l0 = tr_read(vb + 16 * vt), h0 = tr_read(vb + 4 * 144 + 16 * vt), l1 = tr_read(vb + 32 * 144 + 16 * vt), h1 = tr_read(vb + 36 * 144 + 16 * vt);
                      const v4u b0 = {l0.x, l0.y, h0.x, h0.y}, b1 = {l1.x, l1.y, h1.x, h1.y};
                      acc = MFMA16(a[0], __builtin_bit_cast(bf16x8, b0), acc); acc = MFMA16(a[1], __builtin_bit_cast(bf16x8, b1), acc);
                      S[vt] = dv * S[vt] + acc;
                  } }
#pragma unroll
                for (int i = 0; i < 8; ++i) ka += kq[i];
                if (j == 7) kmr[(tid >> 7) * 128 + (tid & 127)] = ka;
                __syncthreads();
                if (j == 7 && tid < 128) { const f32x4 s4 = (kmr[tid] + kmr[128 + tid]) + (kmr[256 + tid] + kmr[384 + tid]); *(f32x4*)(Kms + (size_t)it * 512 + 4 * tid) = s4 * (1.0f / 256.0f); }
            }
            float* ug = Ug + (size_t)it * 16384;
#pragma unroll
            for (int vt = 0; vt < 8; ++vt) *(f32x4*)(ug + (size_t)(16 * vt + fr) * 128 + 16 * wave + 4 * fq) = S[vt];
            if (part == 0) Dg[(size_t)it * 128 + col] = dtot;
        }
#undef P2_LOADN
        LAS float* red = (LAS float*)(lds);
        LAS float* red2 = (LAS float*)(lds + 8192);
        float* st_out = out + OST_S;
        for (int item = bid; item < DECB * NH; item += G) {
            const int b = item >> 4, h = item & 15; const int vd = tid & 127, kq = tid >> 7;
            const float* sp = st_in + ((size_t)(b * NH + h) * 128 + 32 * kq) * 128 + vd;
            float Sx[32];
#pragma unroll
            for (int i = 0; i < 32; ++i) Sx[i] = __builtin_nontemporal_load(sp + (size_t)i * 128);
#pragma unroll
            for (int t = 0; t < 4; ++t) {
                const int row = SEQ + 4 * b + t; const size_t ro = (size_t)row * D + h * 128;
                const float v = bf2f(Vg[ro + vd]); float op = 0.f;
#pragma unroll
                for (int i = 0; i < 32; ++i) { const float f = 1.0f - (float)Ff[ro + 32 * kq + i]; const float q = bf2f(Qg[ro + 32 * kq + i]); Sx[i] = f * Sx[i] + (1.0f - f) * v; op += Sx[i] * q; }
                red[(t * 4 + kq) * 128 + vd] = op;
            }
            float* so = st_out + ((size_t)(b * NH + h) * 128 + 32 * kq) * 128 + vd;
#pragma unroll
            for (int i = 0; i < 32; ++i) __builtin_nontemporal_store(Sx[i], so + (size_t)i * 128);
            __syncthreads();
            { const int t = tid >> 7; const float o = (red[(t * 4 + 0) * 128 + vd] + red[(t * 4 + 1) * 128 + vd]) + (red[(t * 4 + 2) * 128 + vd] + red[(t * 4 + 3) * 128 + vd]);
              const float s = wave_sum(o * o); if (lane == 0) red2[t * 2 + (wave & 1)] = s;
              __syncthreads();
              const float r = rsqrtf((red2[t * 2] + red2[t * 2 + 1]) * (1.0f / 128.0f) + EPS);
              const int row = SEQ + 4 * b + t; const size_t ro = (size_t)row * D + h * 128 + vd;
              Ob[ro] = (bf16)f2bf(o * r * onorm[vd] * bf2f(Gg[ro])); }
            __syncthreads();
        }
    }
    xcd_barrier(bar, IS_T0);
    STAMP();

    {
        TIDS;
        for (int gid = bid * NTHR + tid; gid < NH * 128 * 32; gid += G * NTHR) {
            const int h = gid >> 12, rem = gid & 4095, vd = rem >> 5, k = (rem & 31) * 4;
            f32x4 sv = {0.f, 0.f, 0.f, 0.f};
#pragma unroll
            for (int g = 0; g < 16; ++g) {
                const size_t idx = ((size_t)(h * 16 + g) * 128 + vd) * 128 + k;
                const f32x4 u = *(const f32x4*)(Ug + idx), d = *(const f32x4*)(Dg + (size_t)(h * 16 + g) * 128 + k);
                *(f32x4*)(Sg0 + idx) = sv;
                sv = d * sv + u;
            }
            float* so = out + OST_P + ((size_t)h * 128 + k) * 128 + vd;
            so[0] = sv[0]; so[128] = sv[1]; so[256] = sv[2]; so[384] = sv[3];
        }
    }
    xcd_barrier(bar, IS_T0);
    STAMP();

    {
        TIDS;
        LAS float* tot = (LAS float*)(lds);
        LAS float* refs = (LAS float*)(lds + 2048);
        LAS float* red = (LAS float*)(lds + 2560);
        LAS float* decs = (LAS float*)(lds + 3072);
        LAS bf16* QE = (LAS bf16*)(lds + 4096);
        LAS bf16* KE = QE + 64 * 136;
        LAS bf16* QI = KE + 64 * 136;
        LAS bf16* Vr = QI + 64 * 136;
        LAS bf16* STs = Vr + 64 * 144;
        LAS bf16* koT = STs + 128 * 136;
        LAS f32x4* kmr = (LAS f32x4*)(lds + 131072);
        const int col = tid & 127, part = tid >> 7; const int vt_t = tid >> 3, vd0 = (tid & 7) * 16;
        const int tt = wave & 3, vh = wave >> 2;
        f16 fN[16]; bf16 qN[16]; v4u vaN, vbN;
#define P4_LOADN(it_) do { const int h_ = (it_) >> 7, r0_ = ((it_) & 127) * 64; const f16* fp_ = Ff + (size_t)(r0_ + part * 16) * D + h_ * 128 + col; const bf16* qp_ = Qg + (size_t)(r0_ + part * 16) * D + h_ * 128 + col; \
            _Pragma("unroll") for (int i = 0; i < 16; ++i) { fN[i] = fp_[(size_t)i * D]; qN[i] = qp_[(size_t)i * D]; } \
            const bf16* vp_ = Vg + (size_t)(r0_ + vt_t) * D + h_ * 128 + vd0; vaN = *(const v4u*)vp_; vbN = *(const v4u*)(vp_ + 8); } while (0)
        for (int it = bid; it < NH * 16; it += G) {
            const int hh = it >> 4, gg = it & 15;
            f32x4 S[8];
            { const float* sg = Sg0 + (size_t)it * 16384;
#pragma unroll
              for (int vt = 0; vt < 8; ++vt) { S[vt] = *(const f32x4*)(sg + (size_t)(16 * vt + fr) * 128 + 16 * wave + 4 * fq);
                  v2u w; w.x = cvt_pk_bf16(S[vt][0], S[vt][1]); w.y = cvt_pk_bf16(S[vt][2], S[vt][3]); *(LAS v2u*)(STs + (16 * vt + fr) * 136 + 16 * wave + 4 * fq) = w; } }
            P4_LOADN(hh * 128 + 8 * gg);
            f32x4 ka = {0.f, 0.f, 0.f, 0.f}, kb = {0.f, 0.f, 0.f, 0.f}; f32x4 kq2[8];
            const int kpg0 = ptab[((it + 256) >> 5) * NPAGES + 2 * (it & 31)], kpg1 = ptab[((it + 256) >> 5) * NPAGES + 2 * (it & 31) + 1];
            const int kpg2 = ptab[((it + 512) >> 5) * NPAGES + 2 * (it & 31)], kpg3 = ptab[((it + 512) >> 5) * NPAGES + 2 * (it & 31) + 1];
#pragma unroll 1
            for (int jc = 0; jc < 8; ++jc) {
            const int item = hh * 128 + 8 * gg + jc;
            const int h = item >> 7, c = item & 127; const int row0 = c * 64;
            if (jc > 0) {
#pragma unroll
                for (int i = 0; i < 8; ++i) kb += kq2[i];
            }
            f32x4 kq[8];
            { const int page = (jc < 4) ? kpg0 : kpg1;
              const f32x4* pp = (const f32x4*)(cache_k + (size_t)page * PAGE * 512) + (tid & 127) + (size_t)((jc & 3) * 32 + (tid >> 7)) * 128;
#pragma unroll
              for (int i = 0; i < 8; ++i) kq[i] = __builtin_nontemporal_load(pp + (size_t)(4 * i) * 128); }
            float cum[16], kk[16], qv[16]; float run = 0.f;
#pragma unroll
            for (int i = 0; i < 16; ++i) { kk[i] = (float)fN[i]; const float f = 1.0f - kk[i]; run += __logf(f); cum[i] = run; qv[i] = bf2f(qN[i]); }
            tot[part * 128 + col] = run;
            *(LAS v4u*)(Vr + vt_t * 144 + vd0) = vaN; *(LAS v4u*)(Vr + vt_t * 144 + vd0 + 8) = vbN;
            const size_t ro = (size_t)(row0 + 16 * tt + fr) * D + h * 128;
            v2u gw2[4]; f32x4 on[4];
#pragma unroll
            for (int vt = 0; vt < 4; ++vt) { const int vd = 16 * (4 * vh + vt) + 4 * fq; gw2[vt] = *(const v2u*)(Gg + ro + vd); on[vt] = *(const f32x4*)(onorm + vd); }
            if (jc < 7) P4_LOADN(item + 1);
            __syncthreads();
            float offs = 0.f, lastv = 0.f;
#pragma unroll
            for (int p = 0; p < 4; ++p) { const float tv = tot[p * 128 + col]; lastv += tv; if (p < part) offs += tv; }
            if (part == 1) refs[col] = cum[15] + offs;
            if (part == 0) decs[col] = __expf(lastv);
            __syncthreads();
            const float ref = refs[col];
#pragma unroll
            for (int i = 0; i < 16; ++i) { const float cm = cum[i] + offs, d1 = cm - ref; const int t = part * 16 + i;
                QE[t * 136 + col] = (bf16)f2bf(qv[i] * __expf(d1)); KE[t * 136 + col] = (bf16)f2bf(kk[i] * __expf(-d1)); QI[t * 136 + col] = (bf16)f2bf(qv[i] * __expf(cm)); }
            { unsigned kw[8];
#pragma unroll
              for (int i = 0; i < 8; ++i) { const float a = kk[2 * i] * __expf(lastv - (cum[2 * i] + offs)), b2 = kk[2 * i + 1] * __expf(lastv - (cum[2 * i + 1] + offs)); kw[i] = pk2(a, b2); }
              *(LAS v4u*)(koT + col * 72 + part * 16) = (v4u){kw[0], kw[1], kw[2], kw[3]};
              *(LAS v4u*)(koT + col * 72 + part * 16 + 8) = (v4u){kw[4], kw[5], kw[6], kw[7]}; }
            __syncthreads();
            { const int page = (jc < 4) ? kpg2 : kpg3;
              const f32x4* pp = (const f32x4*)(cache_k + (size_t)page * PAGE * 512) + (tid & 127) + (size_t)((jc & 3) * 32 + (tid >> 7)) * 128;
#pragma unroll
              for (int i = 0; i < 8; ++i) kq2[i] = __builtin_nontemporal_load(pp + (size_t)(4 * i) * 128); }
            {
                f32x4 aS[4];
#pragma unroll
                for (int st = 0; st < 4; ++st) {
                    aS[st] = (f32x4){0.f, 0.f, 0.f, 0.f};
                    if (st <= tt) {
#pragma unroll
                        for (int ks = 0; ks < 4; ++ks) { const bf16x8 a = *(const LAS bf16x8*)(KE + (16 * st + fr) * 136 + 32 * ks + 8 * fq), b = *(const LAS bf16x8*)(QE + (16 * tt + fr) * 136 + 32 * ks + 8 * fq); aS[st] = MFMA16(a, b, aS[st]); }
                        if (st == tt) {
#pragma unroll
                            for (int r = 0; r < 4; ++r) if (4 * fq + r > fr) aS[st][r] = 0.f;
                        }
                    }
                }
                f32x4 o[4];
#pragma unroll
                for (int vt = 0; vt < 4; ++vt) o[vt] = (f32x4){0.f, 0.f, 0.f, 0.f};
#pragma unroll
                for (int j = 0; j < 2; ++j) {
                    v4u pw; pw.x = cvt_pk_bf16(aS[2 * j][0], aS[2 * j][1]); pw.y = cvt_pk_bf16(aS[2 * j][2], aS[2 * j][3]); pw.z = cvt_pk_bf16(aS[2 * j + 1][0], aS[2 * j + 1][1]); pw.w = cvt_pk_bf16(aS[2 * j + 1][2], aS[2 * j + 1][3]);
                    const bf16x8 pf = __builtin_bit_cast(bf16x8, pw);
                    const LAS bf16* vb = Vr + (32 * j + 4 * fq + (fr >> 2)) * 144 + 64 * vh + 4 * (fr & 3);
#pragma unroll
                    for (int vt = 0; vt < 4; ++vt) { const v2u lo = tr_read(vb + 16 * vt), hi = tr_read(vb + 16 * 144 + 16 * vt); const v4u aw = {lo.x, lo.y, hi.x, hi.y};
                        o[vt] = MFMA16(__builtin_bit_cast(bf16x8, aw), pf, o[vt]); }
                }
#pragma unroll
                for (int ks = 0; ks < 4; ++ks) { const bf16x8 b = *(const LAS bf16x8*)(QI + (16 * tt + fr) * 136 + 32 * ks + 8 * fq);
#pragma unroll
                    for (int vt = 0; vt < 4; ++vt) { const bf16x8 a = *(const LAS bf16x8*)(STs + (16 * (4 * vh + vt) + fr) * 136 + 32 * ks + 8 * fq); o[vt] = MFMA16(a, b, o[vt]); } }
                float sq = 0.f;
#pragma unroll
                for (int vt = 0; vt < 4; ++vt) sq += (o[vt][0] * o[vt][0] + o[vt][1] * o[vt][1]) + (o[vt][2] * o[vt][2] + o[vt][3] * o[vt][3]);
                sq += shx<16>(sq); sq = xadd32(sq);
                if (fq == 0) red[(16 * tt + fr) * 2 + vh] = sq;
                __syncthreads();
                const float r = rsqrtf((red[(16 * tt + fr) * 2] + red[(16 * tt + fr) * 2 + 1]) * (1.0f / 128.0f) + EPS);
#pragma unroll
                for (int vt = 0; vt < 4; ++vt) { const int vd = 16 * (4 * vh + vt) + 4 * fq;
                    const float g0 = bf2f(gw2[vt].x & 0xffffu), g1 = bf2f(gw2[vt].x >> 16), g2 = bf2f(gw2[vt].y & 0xffffu), g3 = bf2f(gw2[vt].y >> 16);
                    v2u w; w.x = cvt_pk_bf16(o[vt][0] * r * on[vt][0] * g0, o[vt][1] * r * on[vt][1] * g1); w.y = cvt_pk_bf16(o[vt][2] * r * on[vt][2] * g2, o[vt][3] * r * on[vt][3] * g3);
                    *(v2u*)(Ob + ro + vd) = w; }
            }
            if (jc < 7) {
                bf16x8 a[2]; a[0] = *(const LAS bf16x8*)(koT + (16 * wave + fr) * 72 + 8 * fq); a[1] = *(const LAS bf16x8*)(koT + (16 * wave + fr) * 72 + 32 + 8 * fq);
                const f32x4 dv = *(const LAS f32x4*)(decs + 16 * wave + 4 * fq);
                const LAS bf16* vb = Vr + (8 * fq + (fr >> 2)) * 144 + 4 * (fr & 3);
#pragma unroll
                for (int vt = 0; vt < 8; ++vt) {
                    f32x4 acc = {0.f, 0.f, 0.f, 0.f};
                    const v2u l0 = tr_read(vb + 16 * vt), h0 = tr_read(vb + 4 * 144 + 16 * vt), l1 = tr_read(vb + 32 * 144 + 16 * vt), h1 = tr_read(vb + 36 * 144 + 16 * vt);
                    const v4u b0 = {l0.x, l0.y, h0.x, h0.y}, b1 = {l1.x, l1.y, h1.x, h1.y};
                    acc = MFMA16(a[0], __builtin_bit_cast(bf16x8, b0), acc); acc = MFMA16(a[1], __builtin_bit_cast(bf16x8, b1), acc);
                    S[vt] = dv * S[vt] + acc;
                    v2u w; w.x = cvt_pk_bf16(S[vt][0], S[vt][1]); w.y = cvt_pk_bf16(S[vt][2], S[vt][3]); *(LAS v2u*)(STs + (16 * vt + fr) * 136 + 16 * wave + 4 * fq) = w;
                }
            }
#pragma unroll
            for (int i = 0; i < 8; ++i) ka += kq[i];
            if (jc == 7) kmr[(tid >> 7) * 128 + (tid & 127)] = ka;
            __syncthreads();
            if (jc == 7 && tid < 128) { const f32x4 s4 = (kmr[tid] + kmr[128 + tid]) + (kmr[256 + tid] + kmr[384 + tid]); *(f32x4*)(Kms + (size_t)(it + 256) * 512 + 4 * tid) = s4 * (1.0f / 256.0f); }
            }
#pragma unroll
            for (int i = 0; i < 8; ++i) kb += kq2[i];
            __syncthreads();
            kmr[(tid >> 7) * 128 + (tid & 127)] = kb;
            __syncthreads();
            if (tid < 128) { const f32x4 s4 = (kmr[tid] + kmr[128 + tid]) + (kmr[256 + tid] + kmr[384 + tid]); *(f32x4*)(Kms + (size_t)(it + 512) * 512 + 4 * tid) = s4 * (1.0f / 256.0f); }
        }
#undef P4_LOADN
    }
    xcd_barrier(bar, IS_T0);
    STAMP();

    {
        TIDS;
        pg8::Gemm g{Ob, Wout_t, SEQ, D, D}; pg8::StaticOrder S; S.init(SEQ, D, G, bid);
        EpiRes<1> E{Hb0, nullptr, nullptr, Hb1, ss1};
        const unsigned tg0 = TNOW();
        pg8::gemm_phase<EpiRes<1>, pg8::StaticOrder, true, true, false>(lds, g, S, E, TIDX);
        TACC(5, tg0); const unsigned tg1 = TNOW();
        { const int t2 = bid & 127, rh = (bid >> 7) & 1; TIDS; f32x4 ta[1]; tail_gemm<1, D>(lds, Ob + (size_t)SEQ * D, Wout_t, 16 * t2, rh, ta, TIDX, bid & 127); if (wave < 4) E.tail(SEQ + 64 * rh + 16 * wave + fr, 16 * t2 + 4 * fq, ta[0], fq); }
        TACC(6, tg1);
    }
    xcd_barrier(bar, IS_T0);
    STAMP();
    {
        TIDS;
        pg8::Gemm g{Hb1, Wgu0_t, MP, NGU, D}; pg8::StaticOrder S; S.init(MP, NGU, G, bid);
        EpiGU E{ss1, Hm};
        pg8::gemm_phase<EpiGU, pg8::StaticOrder, true, true>(lds, g, S, E, TIDX);
        constexpr int GG = 172;
        if (bid >= GG) {
            constexpr int I_SQ = 32 * 32, I_DN = 88 * 32, I_KV = 32 * 16, NT6 = I_DN + I_KV + 2 * I_SQ;
            LAS float* scr = (LAS float*)(lds + wave * 17408);
            const int gw = (bid - GG) * NWAVES + wave, NGW = (G - GG) * NWAVES;
            auto dec = [&](int it) { TrItem t; int r = it;
                if (r < I_DN) { t.W = w_dn; t.gain = nullptr; t.WT = Wdn0_t; t.K = DFF; t.N = D; t.row_off = 0; t.item = r; t.mode = 0; return t; } r -= I_DN;
                if (r < I_KV) { t.W = w_kv; t.gain = norm_kv; t.WT = Wkvq_t; t.K = D; t.N = 1024; t.row_off = 0; t.item = r; t.mode = 0; return t; } r -= I_KV;
                if (r < I_SQ) { t.W = w_q; t.gain = norm_mix_b; t.WT = Wkvq_t; t.K = D; t.N = D; t.row_off = 1024; t.item = r; t.mode = 0; return t; } r -= I_SQ;
                t.W = w_o; t.gain = nullptr; t.WT = Wo_t; t.K = D; t.N = D; t.row_off = 0; t.item = r; t.mode = 0; return t; };
            for (int it = gw; it < NT6; it += 2 * NGW) {
                const bool hb = it + NGW < NT6; const TrItem ta = dec(it), tb = dec(hb ? it + NGW : it);
                f32x4 wa[16], wb[16]; float ga[16], gb[16];
                tr_load(ta, wa, ga, lane); if (hb) tr_load(tb, wb, gb, lane);
                tr_store(ta, wa, ga, scr, lane); if (hb) tr_store(tb, wb, gb, scr, lane);
            }
        }
    }
    xcd_barrier(bar, IS_T0);
    STAMP();
    {
        TIDS;
        pg8::Gemm g{Hm, Wdn0_t, SEQ, D, DFF}; pg8::StaticOrder S; S.init(SEQ, D, G, bid);
        EpiRes<1> E{Hb1, nullptr, nullptr, Hb2, ss2};
        const unsigned tg0 = TNOW();
        pg8::gemm_phase<EpiRes<1>, pg8::StaticOrder, true, true, false>(lds, g, S, E, TIDX);
        TACC(7, tg0); const unsigned tg1 = TNOW();
        { const int t2 = bid & 127, rh = (bid >> 7) & 1; TIDS; f32x4 ta[1]; tail_gemm<1, DFF>(lds, Hm + (size_t)SEQ * DFF, Wdn0_t, 16 * t2, rh, ta, TIDX, bid & 127); if (wave < 4) E.tail(SEQ + 64 * rh + 16 * wave + fr, 16 * t2 + 4 * fq, ta[0], fq); }
        TACC(8, tg1);
    }
    xcd_barrier(bar, IS_T0);
    STAMP();
    {
        TIDS;
        pg8::Gemm g{Hb2, Wkvq_t, MP, 3072, D}; pg8::StaticOrder S; S.init(MP, 3072, G, bid);
        EpiKVQ E{ss2, ws, out, k_norm, q_norm, lds + 131072};
        pg8::gemm_phase<EpiKVQ, pg8::StaticOrder, true, true>(lds, g, S, E, TIDX);
        kmean_items(lds, cache_k, ptab, Kms, 768, DECB * NBLK, 140, G - 140, TIDX);
    }
    xcd_barrier(bar, IS_T0);
    STAMP();

    {
        TIDS;
        LAS bf16* KMb = (LAS bf16*)(lds);
        LAS unsigned* lcnt = (LAS unsigned*)(lds + 16384);
        LAS float* gs = (LAS float*)(lds + 16384 + 256);
#define G_BETTER(va, ia, vb, ib) (((va) > (vb)) || (((va) == (vb)) && ((ia) < (ib))))
#define G_INSERT(vx, ix) do { const float vx_ = (vx); const int ix_ = (ix); \
            if (G_BETTER(vx_, ix_, v0, i0)) { v2 = v1; i2 = i1; v1 = v0; i1 = i0; v0 = vx_; i0 = ix_; } \
            else if (G_BETTER(vx_, ix_, v1, i1)) { v2 = v1; i2 = i1; v1 = vx_; i1 = ix_; } \
            else if (G_BETTER(vx_, ix_, v2, i2)) { v2 = vx_; i2 = ix_; } } while (0)
        for (int item = bid; item < 256; item += G) {
            const int j = item >> 2, kvh = item & 3; const int b = j >> 1;
            { const int n = tid >> 4, d8 = (tid & 15) * 8; f32x4 s0 = {0.f, 0.f, 0.f, 0.f}, s1 = {0.f, 0.f, 0.f, 0.f};
              if (n < b) { const float* kp = Kpart + (size_t)n * 512 + kvh * 128 + d8; s0 = *(const f32x4*)kp; s1 = *(const f32x4*)(kp + 4); }
              s0 = s0 * (1.0f / 256.0f); s1 = s1 * (1.0f / 256.0f);
              v4u w; w.x = cvt_pk_bf16(s0[0], s0[1]); w.y = cvt_pk_bf16(s0[2], s0[3]); w.z = cvt_pk_bf16(s1[0], s1[1]); w.w = cvt_pk_bf16(s1[2], s1[3]);
              *(LAS v4u*)(KMb + n * 136 + d8) = w; }
            if (tid < 32) lcnt[tid] = 0u;
            __syncthreads();
            const int nsel = b < 3 ? b : 3;
#pragma unroll 1
            for (int rt = 0; rt < 4; ++rt) {
                const int r = 64 * wave + 16 * rt + fr; const int tok = j * 128 + (r >> 2), hg = r & 3; const bf16* qp = Qb + (size_t)tok * D + (4 * kvh + hg) * 128 + 8 * fq;
                bf16x8 qf[4];
#pragma unroll
                for (int ks = 0; ks < 4; ++ks) qf[ks] = *(const bf16x8*)(qp + 32 * ks);
                f32x4 ga[2];
#pragma unroll
                for (int nt = 0; nt < 2; ++nt) { ga[nt] = (f32x4){0.f, 0.f, 0.f, 0.f};
#pragma unroll
                    for (int ks = 0; ks < 4; ++ks) { const bf16x8 ka = *(const LAS bf16x8*)(KMb + (16 * nt + fr) * 136 + 32 * ks + 8 * fq); ga[nt] = MFMA16(ka, qf[ks], ga[nt]); } }
                float v0 = -INFINITY, v1 = -INFINITY, v2 = -INFINITY; int i0 = 99, i1 = 99, i2 = 99;
#pragma unroll
                for (int nt = 0; nt < 2; ++nt)
#pragma unroll
                    for (int q = 0; q < 4; ++q) { const int n = 16 * nt + 4 * fq + q; if (n < b) G_INSERT(ga[nt][q], n); }
                { const float a0 = shx<16>(v0), a1 = shx<16>(v1), a2 = shx<16>(v2);
                  const int c0 = __builtin_amdgcn_ds_swizzle(i0, (16 << 10) | 0x1f), c1 = __builtin_amdgcn_ds_swizzle(i1, (16 << 10) | 0x1f), c2 = __builtin_amdgcn_ds_swizzle(i2, (16 << 10) | 0x1f);
                  G_INSERT(a0, c0); G_INSERT(a1, c1); G_INSERT(a2, c2); }
                {
                  auto p0 = __builtin_amdgcn_permlane32_swap(__float_as_uint(v0), __float_as_uint(v0), false, false); auto p1 = __builtin_amdgcn_permlane32_swap(__float_as_uint(v1), __float_as_uint(v1), false, false);
                  auto p2 = __builtin_amdgcn_permlane32_swap(__float_as_uint(v2), __float_as_uint(v2), false, false);
                  auto q0 = __builtin_amdgcn_permlane32_swap((unsigned)i0, (unsigned)i0, false, false); auto q1 = __builtin_amdgcn_permlane32_swap((unsigned)i1, (unsigned)i1, false, false);
                  auto q2 = __builtin_amdgcn_permlane32_swap((unsigned)i2, (unsigned)i2, false, false);
                  v0 = __uint_as_float(p0[0]); v1 = __uint_as_float(p1[0]); v2 = __uint_as_float(p2[0]); i0 = (int)q0[0]; i1 = (int)q1[0]; i2 = (int)q2[0];
                  G_INSERT(__uint_as_float(p0[1]), (int)q0[1]); G_INSERT(__uint_as_float(p1[1]), (int)q1[1]); G_INSERT(__uint_as_float(p2[1]), (int)q2[1]); }
                if (fq == 0) {
#pragma unroll
                    for (int rk = 0; rk < 3; ++rk) {
                        if (rk < nsel) { const int best = (rk == 0) ? i0 : ((rk == 1) ? i1 : i2);
                            const unsigned pos = atomicAdd((unsigned*)&lcnt[best], 1u);
                            Subl[((size_t)(j * 4 + kvh) * 32 + best) * 512 + pos] = (unsigned)r | ((unsigned)rk << 9); }
                    }
                }
            }
            __syncthreads();
            if (tid < 32) Scnt[(j * 4 + kvh) * 32 + tid] = lcnt[tid];
            __syncthreads();
        }
#undef G_BETTER
#undef G_INSERT
        for (int item = bid; item < DECB * NKV; item += G) {
            const int b = item >> 2, kvh = item & 3; const int pr = tid >> 5, n = tid & 31;
            const int row = SEQ + 4 * b + (pr >> 2), hg = pr & 3; const bf16* qp = Qb + (size_t)row * D + (4 * kvh + hg) * 128; const float* kmp = Kms + ((size_t)(b * 32 + n)) * 512 + kvh * 128;
            float s = 0.f;
#pragma unroll 4
            for (int d = 0; d < 128; d += 8) { const v4u qw = *(const v4u*)(qp + d); const f32x4 k0 = *(const f32x4*)(kmp + d), k1 = *(const f32x4*)(kmp + d + 4);
                s += (bf2f(qw.x & 0xffffu) * k0[0] + bf2f(qw.x >> 16) * k0[1]) + (bf2f(qw.y & 0xffffu) * k0[2] + bf2f(qw.y >> 16) * k0[3]) + (bf2f(qw.z & 0xffffu) * k1[0] + bf2f(qw.z >> 16) * k1[1]) + (bf2f(qw.w & 0xffffu) * k1[2] + bf2f(qw.w >> 16) * k1[3]); }
            gs[pr * 32 + n] = s;
            __syncthreads();
            if (tid < 16) { unsigned m = 0u;
                for (int r = 0; r < 3; ++r) { int best = 0; float bv = -INFINITY; for (int nn = 0; nn < 32; ++nn) { const float v = gs[tid * 32 + nn]; if (v > bv) { bv = v; best = nn; } } m |= 1u << best; gs[tid * 32 + best] = -INFINITY; }
                Sels[item * 16 + tid] = m; }
            __syncthreads();
        }
    }
    xcd_barrier(bar, IS_T0);
    STAMP();

    {
        LAS bf16* Ks = (LAS bf16*)(lds); LAS bf16* Vs = (LAS bf16*)(lds + KS_BYTES);
        LAS unsigned* qsh = (LAS unsigned*)(lds + 2 * KS_BYTES);
        constexpr int NPI = 4 * 496, NSI = DECB * NKV * NBLK;
        for (;;) {
            const unsigned tq0 = TNOW();
            if (IS_T0) qsh[0] = __hip_atomic_fetch_add(ctl + CW_Q0, 1u, __ATOMIC_RELAXED, __HIP_MEMORY_SCOPE_AGENT);
            __syncthreads();
            const int tick = (int)qsh[0];
            __syncthreads();
            TACC(0, tq0);
            if (tick >= NPI + NSI) break;
            TIDS;
            int item; { const int g3 = tick / 3, r3 = tick - 3 * g3; item = (tick < 3 * NPI) ? ((r3 == 0) ? g3 : NPI + 2 * g3 + (r3 - 1)) : NPI + (tick - NPI); }
            if (item < NPI) {
                int b = (int)((1.0f + sqrtf(1.0f + 2.0f * (float)item)) * 0.5f); while (2 * b * (b - 1) > item) --b; while (2 * (b + 1) * b <= item) ++b;
                const int rem = item - 2 * b * (b - 1); const int n = rem >> 2, kvh = rem & 3;
                const int cntA = (int)Scnt[((2 * b) * 4 + kvh) * 32 + n], cntB = (int)Scnt[((2 * b + 1) * 4 + kvh) * 32 + n]; const int total = cntA + cntB;
                if (total == 0) continue;
                const unsigned tp0 = TNOW();
#pragma unroll
                for (int i = 0; i < 8; ++i) { const int idx = i * 512 + tid, key = idx >> 4, c8 = idx & 15; *(LAS v4u*)(Ks + key * KS_P + c8 * 8) = *(const v4u*)(Kb + (size_t)(256 * n + key) * 512 + kvh * 128 + c8 * 8); }
#pragma unroll
                for (int i = 0; i < 8; ++i) { const int idx = i * 512 + tid, key = idx >> 4, c8 = idx & 15; *(LAS v4u*)(Vs + key * KS_P + c8 * 8) = *(const v4u*)(Vb + (size_t)(256 * n + key) * 512 + kvh * 128 + c8 * 8); }
                __syncthreads();
                TACC(1, tp0); const unsigned tp1 = TNOW();
                const unsigned* LA = Subl + ((size_t)((2 * b) * 4 + kvh) * 32 + n) * 512; const unsigned* LB = Subl + ((size_t)((2 * b + 1) * 4 + kvh) * 32 + n) * 512;
#define LIST_ENT(i_) (((i_) < cntA) ? LA[(i_)] : LB[(i_) - cntA])
                const int iw = 16 * wave + fr;
                unsigned e1 = 0u, e2 = 0u; int ic1 = 0, ic2 = 0;
                if (16 * wave < total) { ic1 = iw < total ? iw : total - 1; e1 = LIST_ENT(ic1); }
                if (16 * wave + 128 < total) { ic2 = iw + 128 < total ? iw + 128 : total - 1; e2 = LIST_ENT(ic2); }
                bf16x8 qn[4];
                { const int tokn = ((ic1 < cntA) ? 2 * b : 2 * b + 1) * 128 + (int)((e1 >> 2) & 127u); const bf16* qp = Qb + (size_t)tokn * D + (4 * kvh + (int)(e1 & 3u)) * 128 + 8 * fq;
#pragma unroll
                  for (int ks = 0; ks < 4; ++ks) qn[ks] = *(const bf16x8*)(qp + 32 * ks); }
                for (int t0 = 0; t0 < total; t0 += 128) {
                    const int i0 = t0 + 16 * wave; if (i0 >= total) break;
                    const bool valid = (i0 + fr) < total; const int ic = ic1; const unsigned e = e1;
                    const int tok = ((ic < cntA) ? 2 * b : 2 * b + 1) * 128 + (int)((e >> 2) & 127u), hg = (int)(e & 3u), rk = (int)(e >> 9);
                    const int h = 4 * kvh + hg;
                    bf16x8 qf[4];
#pragma unroll
                    for (int ks = 0; ks < 4; ++ks) qf[ks] = qn[ks];
                    e1 = e2; ic1 = ic2;
                    if (i0 + 256 < total) { ic2 = (i0 + 256 + fr) < total ? (i0 + 256 + fr) : total - 1; e2 = LIST_ENT(ic2); }
                    if (i0 + 128 < total) { const int tokn = ((ic1 < cntA) ? 2 * b : 2 * b + 1) * 128 + (int)((e1 >> 2) & 127u); const bf16* qp = Qb + (size_t)tokn * D + (4 * kvh + (int)(e1 & 3u)) * 128 + 8 * fq;
#pragma unroll
                        for (int ks = 0; ks < 4; ++ks) qn[ks] = *(const bf16x8*)(qp + 32 * ks); }
                    f32x4 acc[16]; attn_scores<16>(Ks, qf, acc, 16, fr, fq);
                    float mx = -INFINITY;
#pragma unroll
                    for (int kt = 0; kt < 16; ++kt) mx = fmaxf(fmaxf(mx, fmaxf(acc[kt][0], acc[kt][1])), fmaxf(acc[kt][2], acc[kt][3]));
                    mx = fmaxf(mx, shx<16>(mx)); mx = xmax32(mx);
                    float l = 0.f;
#pragma unroll
                    for (int kt = 0; kt < 16; ++kt) {
#pragma unroll
                        for (int r = 0; r < 4; ++r) { const float p = __builtin_amdgcn_exp2f(acc[kt][r] - mx); acc[kt][r] = p; l += p; } }
                    l += shx<16>(l); l = xadd32(l);
                    f32x4 O[8];
#pragma unroll
                    for (int vt = 0; vt < 8; ++vt) O[vt] = (f32x4){0.f, 0.f, 0.f, 0.f};
                    attn_pv(Vs, acc, O, 8, fr, fq);
                    if (valid) {
                        const size_t slot = ((size_t)tok * NH + h) * 3 + rk; bf16* op = Oslot + slot * 128 + 8 * fq;
#pragma unroll
                        for (int c = 0; c < 4; ++c) { v4u w; w.x = cvt_pk_bf16(O[2 * c][0], O[2 * c][1]); w.y = cvt_pk_bf16(O[2 * c][2], O[2 * c][3]); w.z = cvt_pk_bf16(O[2 * c + 1][0], O[2 * c + 1][1]); w.w = cvt_pk_bf16(O[2 * c + 1][2], O[2 * c + 1][3]); *(v4u*)(op + 32 * c) = w; }
                        if (fq == 0) { MLslot[slot * 2] = mx; MLslot[slot * 2 + 1] = l; }
                    }
                }
                __syncthreads();
                TACC(2, tp1);
            } else {
                const int si = item - NPI; const int b = si >> 7, kvh = (si >> 5) & 3, n = si & 31;
                unsigned any = 0u;
#pragma unroll
                for (int p = 0; p < 16; ++p) any |= Sels[(b * 4 + kvh) * 16 + p];
                if (!((any >> n) & 1u)) continue;
                const unsigned ts0 = TNOW();
                const int pg0 = ptab[b * NPAGES + 2 * n], pg1 = ptab[b * NPAGES + 2 * n + 1];
                f32x4 kst[16], vst[16];
#pragma unroll
                for (int i = 0; i < 16; ++i) { const int idx = i * 512 + tid, key = idx >> 5, c4 = idx & 31; const int page = (key < 128) ? pg0 : pg1;
                    const size_t go = (((size_t)page * PAGE + (key & 127)) * NKV + kvh) * 128 + c4 * 4;
                    kst[i] = __builtin_nontemporal_load((const f32x4*)(cache_k + go)); vst[i] = __builtin_nontemporal_load((const f32x4*)(cache_v + go)); }
#pragma unroll
                for (int i = 0; i < 16; ++i) { const int idx = i * 512 + tid, key = idx >> 5, c4 = idx & 31; const int page = (key < 128) ? pg0 : pg1; (void)page;
                    const f32x4 kk4 = kst[i], vv4 = vst[i];
                    v2u w; w.x = cvt_pk_bf16(kk4[0], kk4[1]); w.y = cvt_pk_bf16(kk4[2], kk4[3]); *(LAS v2u*)(Ks + key * KS_P + c4 * 4) = w;
                    v2u wv; wv.x = cvt_pk_bf16(vv4[0], vv4[1]); wv.y = cvt_pk_bf16(vv4[2], vv4[3]); *(LAS v2u*)(Vs + key * KS_P + c4 * 4) = wv; }
                __syncthreads();
                TACC(3, ts0); const unsigned ts1 = TNOW();
                {
                    LAS float* mxs = (LAS float*)(lds + 2 * KS_BYTES + 64); LAS float* lss = mxs + 128; LAS float* Ored = (LAS float*)(lds);
                    const int row = SEQ + 4 * b + (fr >> 2), hg = fr & 3; const int h = 4 * kvh + hg; const bf16* qp = Qb + (size_t)row * D + h * 128 + 8 * fq;
                    bf16x8 qf[4];
#pragma unroll
                    for (int ks = 0; ks < 4; ++ks) qf[ks] = *(const bf16x8*)(qp + 32 * ks);
                    f32x4 a2[2];
#pragma unroll
                    for (int t = 0; t < 2; ++t) { a2[t] = (f32x4){0.f, 0.f, 0.f, 0.f};
#pragma unroll
                        for (int ks = 0; ks < 4; ++ks) { const bf16x8 ka = *(const LAS bf16x8*)(Ks + (16 * (2 * wave + t) + fr) * KS_P + 32 * ks + 8 * fq); a2[t] = MFMA16(ka, qf[ks], a2[t]); } }
                    float mx = fmaxf(fmaxf(fmaxf(a2[0][0], a2[0][1]), fmaxf(a2[0][2], a2[0][3])), fmaxf(fmaxf(a2[1][0], a2[1][1]), fmaxf(a2[1][2], a2[1][3])));
                    mx = fmaxf(mx, shx<16>(mx)); mx = xmax32(mx);
                    if (fq == 0) mxs[wave * 16 + fr] = mx;
                    __syncthreads();
                    float M = mxs[fr];
#pragma unroll
                    for (int w8 = 1; w8 < 8; ++w8) M = fmaxf(M, mxs[w8 * 16 + fr]);
                    float l = 0.f;
#pragma unroll
                    for (int t = 0; t < 2; ++t) {
#pragma unroll
                        for (int r = 0; r < 4; ++r) { const float p = __builtin_amdgcn_exp2f(a2[t][r] - M); a2[t][r] = p; l += p; } }
                    l += shx<16>(l); l = xadd32(l);
                    if (fq == 0) lss[wave * 16 + fr] = l;
                    v4u pw; pw.x = cvt_pk_bf16(a2[0][0], a2[0][1]); pw.y = cvt_pk_bf16(a2[0][2], a2[0][3]); pw.z = cvt_pk_bf16(a2[1][0], a2[1][1]); pw.w = cvt_pk_bf16(a2[1][2], a2[1][3]);
                    const bf16x8 pf = __builtin_bit_cast(bf16x8, pw);
                    const LAS bf16* vb = Vs + (32 * wave + 4 * fq + (fr >> 2)) * KS_P + 4 * (fr & 3);
#pragma unroll
                    for (int vt = 0; vt < 8; ++vt) { const v2u lo = tr_read(vb + 16 * vt), hi = tr_read(vb + 16 * KS_P + 16 * vt); const v4u aw = {lo.x, lo.y, hi.x, hi.y};
                        const f32x4 o = MFMA16(__builtin_bit_cast(bf16x8, aw), pf, ((f32x4){0.f, 0.f, 0.f, 0.f}));
                        *(LAS f32x4*)(Ored + (wave * 16 + fr) * 132 + 16 * vt + 4 * fq) = o; }
                    __syncthreads();
                    { const int r16 = tid >> 5, c4 = tid & 31; f32x4 so = *(const LAS f32x4*)(Ored + r16 * 132 + 4 * c4);
#pragma unroll
                      for (int w8 = 1; w8 < 8; ++w8) so += *(const LAS f32x4*)(Ored + (w8 * 16 + r16) * 132 + 4 * c4);
                      float* sp = Sslot + ((size_t)((b * 4 + kvh) * 32 + n) * 16 + r16) * 132;
                      *(f32x4*)(sp + 4 * c4) = so;
                      if (c4 == 0) { float Mr = mxs[r16], lt = lss[r16];
#pragma unroll
                          for (int w8 = 1; w8 < 8; ++w8) { Mr = fmaxf(Mr, mxs[w8 * 16 + r16]); lt += lss[w8 * 16 + r16]; }
                          sp[128] = Mr; sp[129] = lt; } }
                }
                __syncthreads();
                TACC(4, ts1);
            }
        }
    }
    xcd_barrier(bar, IS_T0);
    STAMP();

    {
        TIDS;
        LAS bf16* Ks = (LAS bf16*)(lds); LAS bf16* Vs = (LAS bf16*)(lds + KS_BYTES);
        const unsigned tq12 = TNOW();
        for (int item = bid; item < NBLK * NKV * 2; item += G) {
            const int b = item >> 3, kvh = (item >> 1) & 3, hp = item & 1;
            int tid_i = TIDX; asm volatile("" : "+v"(tid_i));
#pragma unroll
            for (int i = 0; i < 8; ++i) { const int idx = i * 512 + tid_i, key = idx >> 4, c8 = idx & 15; *(LAS v4u*)(Ks + key * KS_P + c8 * 8) = *(const v4u*)(Kb + (size_t)(256 * b + key) * 512 + kvh * 128 + c8 * 8); }
#pragma unroll
            for (int i = 0; i < 8; ++i) { const int idx = i * 512 + tid_i, key = idx >> 4, c8 = idx & 15; *(LAS v4u*)(Vs + key * KS_P + c8 * 8) = *(const v4u*)(Vb + (size_t)(256 * b + key) * 512 + kvh * 128 + c8 * 8); }
            const int nsel = b < 3 ? b : 3;
            bf16x8 qn[4];
            { const bf16* qp = Qb + (size_t)(256 * b + 16 * wave + fr) * D + (4 * kvh + 2 * hp) * 128 + 8 * fq;
#pragma unroll
              for (int ks = 0; ks < 4; ++ks) qn[ks] = *(const bf16x8*)(qp + 32 * ks); }
            __syncthreads();
#pragma unroll 1
            for (int u = 0; u < 4; ++u) {
                const int g = (u & 1) ? 15 - wave : wave, h = 4 * kvh + 2 * hp + (u >> 1); const int tl = 16 * g + fr; const int tok = 256 * b + tl;
                bf16x8 qf[4];
#pragma unroll
                for (int ks = 0; ks < 4; ++ks) qf[ks] = qn[ks];
                if (u < 3) { const int gn = ((u + 1) & 1) ? 15 - wave : wave, hn = 4 * kvh + 2 * hp + ((u + 1) >> 1); const bf16* qp = Qb + (size_t)(256 * b + 16 * gn + fr) * D + hn * 128 + 8 * fq;
#pragma unroll
                    for (int ks = 0; ks < 4; ++ks) qn[ks] = *(const bf16x8*)(qp + 32 * ks); }
                float msa[3], lsa[3];
#pragma unroll
                for (int r = 0; r < 3; ++r) { msa[r] = -INFINITY; lsa[r] = 0.f; if (r < nsel) { const size_t slot = ((size_t)tok * NH + h) * 3 + r; msa[r] = MLslot[slot * 2]; lsa[r] = MLslot[slot * 2 + 1]; } }
                v4u ow[3][4];
#pragma unroll
                for (int r = 0; r < 3; ++r) { if (r < nsel) { const bf16* op = Oslot + (((size_t)tok * NH + h) * 3 + r) * 128 + 8 * fq;
#pragma unroll
                    for (int c = 0; c < 4; ++c) ow[r][c] = *(const v4u*)(op + 32 * c); } }
                const int nkt = g + 1;
                f32x4 acc[16]; attn_scores<16>(Ks, qf, acc, nkt, fr, fq);
                float mx = -INFINITY;
#pragma unroll
                for (int kt = 0; kt < 16; ++kt) {
#pragma unroll
                    for (int r = 0; r < 4; ++r) { const bool ok = (kt < nkt) && (16 * kt + 4 * fq + r <= tl); const float sv = ok ? acc[kt][r] : -INFINITY; acc[kt][r] = sv; mx = fmaxf(mx, sv); } }
                mx = fmaxf(mx, shx<16>(mx)); mx = xmax32(mx);
                float M = mx;
#pragma unroll
                for (int r = 0; r < 3; ++r) M = fmaxf(M, msa[r]);
                f32x4 O[8]; float lp = 0.f;
#pragma unroll
                for (int vt = 0; vt < 8; ++vt) O[vt] = (f32x4){0.f, 0.f, 0.f, 0.f};
#pragma unroll
                for (int r = 0; r < 3; ++r) { if (r < nsel) { const float sc = __builtin_amdgcn_exp2f(msa[r] - M); lp += lsa[r] * sc;
#pragma unroll
                    for (int c = 0; c < 4; ++c) { const v4u w = ow[r][c];
                        O[2 * c][0] += bf2f(w.x & 0xffffu) * sc; O[2 * c][1] += bf2f(w.x >> 16) * sc; O[2 * c][2] += bf2f(w.y & 0xffffu) * sc; O[2 * c][3] += bf2f(w.y >> 16) * sc;
                        O[2 * c + 1][0] += bf2f(w.z & 0xffffu) * sc; O[2 * c + 1][1] += bf2f(w.z >> 16) * sc; O[2 * c + 1][2] += bf2f(w.w & 0xffffu) * sc; O[2 * c + 1][3] += bf2f(w.w >> 16) * sc; } } }
                float l = 0.f;
#pragma unroll
                for (int kt = 0; kt < 16; ++kt) {
#pragma unroll
                    for (int r = 0; r < 4; ++r) { const float p = __builtin_amdgcn_exp2f(acc[kt][r] - M); acc[kt][r] = p; l += p; } }
                l += shx<16>(l); l = xadd32(l); l += lp;
                attn_pv(Vs, acc, O, (nkt + 1) >> 1, fr, fq);
                const float il = 1.0f / l; bf16* ap = At + (size_t)tok * D + h * 128 + 4 * fq;
#pragma unroll
                for (int vt = 0; vt < 8; ++vt) { v2u w; w.x = cvt_pk_bf16(O[vt][0] * il, O[vt][1] * il); w.y = cvt_pk_bf16(O[vt][2] * il, O[vt][3] * il); *(v2u*)(ap + 16 * vt) = w; }
            }
            __syncthreads();
        }
        TACC(10, tq12); const unsigned ts12 = TNOW();
        LAS float* ksn = (LAS float*)(lds);
        for (int item = bid; item < DECB * NKV; item += G) {
            const int b = item >> 2, kvh = item & 3;
            TIDS;
            { const int key = tid >> 7, d = tid & 127; ksn[key * 128 + d] = out[OK_S + (size_t)(4 * b + key) * 512 + kvh * 128 + d]; ksn[512 + key * 128 + d] = out[OV_S + (size_t)(4 * b + key) * 512 + kvh * 128 + d]; }
            __syncthreads();
            const int pr = tid >> 5, l32 = tid & 31; const int t = pr >> 2, hg = pr & 3; const int row = SEQ + 4 * b + t, h = 4 * kvh + hg;
            const v2u qw = *(const v2u*)(Qb + (size_t)row * D + h * 128 + 4 * l32);
            const float q0 = bf2f(qw.x & 0xffffu), q1 = bf2f(qw.x >> 16), q2 = bf2f(qw.y & 0xffffu), q3 = bf2f(qw.y >> 16);
            float sk[4]; float M = -INFINITY;
#pragma unroll
            for (int key = 0; key < 4; ++key) { const f32x4 k4 = *(const LAS f32x4*)(ksn + key * 128 + 4 * l32); float s = (q0 * k4[0] + q1 * k4[1]) + (q2 * k4[2] + q3 * k4[3]);
                s += shx<1>(s); s += shx<2>(s); s += shx<4>(s); s += shx<8>(s); s += shx<16>(s);
                sk[key] = (key <= t) ? s : -INFINITY; M = fmaxf(M, sk[key]); }
            unsigned mk = Sels[item * 16 + pr];
            float sm[3], sl[3]; f32x4 so[3]; bool sv[3];
#pragma unroll
            for (int i = 0; i < 3; ++i) { sv[i] = mk != 0u; const int n = sv[i] ? __builtin_ctz(mk) : 0; mk &= mk - 1u;
                const float* sp = Sslot + ((size_t)(item * 32 + n) * 16 + pr) * 132; sm[i] = sp[128]; sl[i] = sp[129]; so[i] = *(const f32x4*)(sp + 4 * l32); }
#pragma unroll
            for (int i = 0; i < 3; ++i) if (sv[i]) M = fmaxf(M, sm[i]);
            float l = 0.f; f32x4 O = {0.f, 0.f, 0.f, 0.f};
#pragma unroll
            for (int key = 0; key < 4; ++key) { const float p = __builtin_amdgcn_exp2f(sk[key] - M); l += p; O += *(const LAS f32x4*)(ksn + 512 + key * 128 + 4 * l32) * p; }
#pragma unroll
            for (int i = 0; i < 3; ++i) if (sv[i]) { const float sc = __builtin_amdgcn_exp2f(sm[i] - M); l += sl[i] * sc; O += so[i] * sc; }
            const float il = 1.0f / l; v2u w; w.x = cvt_pk_bf16(O[0] * il, O[1] * il); w.y = cvt_pk_bf16(O[2] * il, O[3] * il);
            *(v2u*)(At + (size_t)row * D + h * 128 + 4 * l32) = w;
            __syncthreads();
        }
        TACC(11, ts12);
    }
    xcd_barrier(bar, IS_T0);
    STAMP();

    {
        TIDS;
        pg8::Gemm g{At, Wo_t, SEQ, D, D}; pg8::StaticOrder S; S.init(SEQ, D, G, bid);
        EpiRes<1> E{Hb2, nullptr, nullptr, Hb3, ss3};
        pg8::gemm_phase<EpiRes<1>, pg8::StaticOrder, true, true, false>(lds, g, S, E, TIDX);
        { const int t2 = bid & 127, rh = (bid >> 7) & 1; TIDS; f32x4 ta[1]; tail_gemm<1, D>(lds, At + (size_t)SEQ * D, Wo_t, 16 * t2, rh, ta, TIDX, bid & 127); if (wave < 4) E.tail(SEQ + 64 * rh + 16 * wave + fr, 16 * t2 + 4 * fq, ta[0], fq); }
    }
    xcd_barrier(bar, IS_T0);
    STAMP();
    {
        TIDS;
        pg8::Gemm g{Hb3, Wgu1_t, MP, NGU, D}; pg8::StaticOrder S; S.init(MP, NGU, G, bid);
        EpiGU E{ss3, Hm};
        pg8::gemm_phase<EpiGU, pg8::StaticOrder, true, true>(lds, g, S, E, TIDX);
        constexpr int GG = 172;
        if (bid >= GG) {
            constexpr int I_DN = 88 * 32;
            LAS float* scr = (LAS float*)(lds + wave * 17408);
            const int gw = (bid - GG) * NWAVES + wave, NGW = (G - GG) * NWAVES;
            for (int it = gw; it < I_DN; it += 2 * NGW) {
                const bool hb = it + NGW < I_DN; TrItem ta, tb; ta.W = w_dn + (size_t)DFF * D; ta.gain = nullptr; ta.WT = Wdn1_t; ta.K = DFF; ta.N = D; ta.row_off = 0; ta.item = it; ta.mode = 0; tb = ta; tb.item = hb ? it + NGW : it;
                f32x4 wa[16], wb[16]; float ga[16], gb[16];
                tr_load(ta, wa, ga, lane); if (hb) tr_load(tb, wb, gb, lane);
                tr_store(ta, wa, ga, scr, lane); if (hb) tr_store(tb, wb, gb, scr, lane);
            }
        }
    }
    xcd_barrier(bar, IS_T0);
    STAMP();
    {
        TIDS;
        pg8::Gemm g{Hm, Wdn1_t, SEQ, D, DFF}; pg8::StaticOrder S; S.init(SEQ, D, G, bid);
        EpiRes<2> E{Hb3, out + OY_P, out + OY_S, nullptr, nullptr};
        pg8::gemm_phase<EpiRes<2>, pg8::StaticOrder, true, true, false>(lds, g, S, E, TIDX);
        { const int t2 = bid & 127, rh = (bid >> 7) & 1; TIDS; f32x4 ta[1]; tail_gemm<1, DFF>(lds, Hm + (size_t)SEQ * DFF, Wdn1_t, 16 * t2, rh, ta, TIDX, bid & 127); if (wave < 4) E.tail(SEQ + 64 * rh + 16 * wave + fr, 16 * t2 + 4 * fq, ta[0], fq); }
    }
#ifdef PROF_A
    STAMP();
    if (blockIdx.x == 0 && IS_T0) {
        const unsigned ta = PVAL(PROF_A0, PROF_A1), tb = PVAL(PROF_B0, PROF_B1);
        unsigned qa = (ta + PROF_UA / 2) / PROF_UA, qb = (tb + PROF_UB / 2) / PROF_UB; if (qa > 99u) qa = 99u; if (qb > 99u) qb = 99u;
#ifdef PROF_MUL
        const unsigned long long extra = (unsigned long long)ta * PROF_MUL;
#else
        const unsigned long long extra = (unsigned long long)(qa + 100u * qb) * 5000ull;
#endif
        const unsigned long long t0 = __builtin_amdgcn_s_memrealtime();
        while (__builtin_amdgcn_s_memrealtime() - t0 < extra) __builtin_amdgcn_s_sleep(32);
    }
#endif
}
#undef x_p
#undef x_s
#undef st_in
#undef cache_k
#undef cache_v
#undef ptab
#undef norm_mix_a
#undef w_in
#undef lbl
#undef onorm
#undef w_out
#undef norm_kv
#undef w_kv
#undef k_norm
#undef norm_mix_b
#undef w_q
#undef q_norm
#undef w_o
#undef norm_ffn
#undef w_gu
#undef w_dn
#undef Win_t
#undef Wout_t
#undef Wgu0_t
#undef Wdn0_t
#undef Wkvq_t
#undef Wo_t
#undef Wgu1_t
#undef Wdn1_t
#undef Hb0
#undef Hb1
#undef Hb2
#undef Hb3
#undef Hf1
#undef Hf2
#undef Hf3
#undef Qg
#undef Vg
#undef Gg
#undef Ff
#undef Ob
#undef At
#undef Hm
#undef Ug
#undef Sg0
#undef Dg
#undef Kraw
#undef Vraw
#undef Qraw
#undef Kb
#undef Vb
#undef Qb
#undef Kpart
#undef Kms
#undef Subl
#undef Scnt
#undef Sels
#undef Oslot
#undef MLslot
#undef Sslot
#undef ss0
#undef ss1
#undef ss2
#undef ss3
#undef out
#undef TIDS
#undef TIDX
#undef IS_T0

extern "C" void kernel_launch(void* const* d_in, const int* in_sizes, int n_in, void* d_out, int out_size, void* d_ws, size_t ws_size, hipStream_t stream) {
    static int grid = 0;
    if (grid == 0) {
        if (n_in != 21 || ws_size < WS_END) { fprintf(stderr, "kernel_launch: unexpected n_in %d / ws %zu\n", n_in, ws_size); grid = -1; return; }
        int dev = 0, cus = 0, per_cu = 0;
        if (hipGetDevice(&dev) != hipSuccess || hipDeviceGetAttribute(&cus, hipDeviceAttributeMultiprocessorCount, dev) != hipSuccess) { grid = -1; return; }
        if (hipFuncSetAttribute((const void*)yoco_fwd, hipFuncAttributeMaxDynamicSharedMemorySize, LDS_BYTES) != hipSuccess) { fprintf(stderr, "kernel_launch: hipFuncSetAttribute failed\n"); grid = -1; return; }
        if (hipOccupancyMaxActiveBlocksPerMultiprocessor(&per_cu, (const void*)yoco_fwd, NTHR, LDS_BYTES) != hipSuccess || per_cu < 1) fprintf(stderr, "kernel_launch: occupancy query says %d\n", per_cu);
        (void)hipGetLastError();
        grid = cus;
        if (grid < 256) { fprintf(stderr, "kernel_launch: built for 256 CUs (got %d)\n", grid); grid = -1; return; }
        grid = 256;
    }
    if (grid < 0) return;
    (void)hipMemsetAsync((char*)d_ws + WS_CTL, 0, CTL_ZERO_BYTES, stream);
    Args a{};
    for (int i = 0; i < 21; ++i) a.in[i] = d_in[i];
    a.out = (float*)d_out; a.ws = (unsigned char*)d_ws;
    hipLaunchKernelGGL(yoco_fwd, dim3(grid), dim3(NTHR), LDS_BYTES, stream, a);
}
```
